# Optimizing an MI355X kernel written in HIP

```python
import jax
import jax.numpy as jnp
from jax import lax
import numpy as np

D_MODEL = 1024
BATCH = 4
SEQ = 8192
DEPTH = 1

GRID_W = 64
MEM_LEN = 256
EPS = 1e-6
NEG_INF = -1e30

NA_HEADS = 8
NA_WIDTH = D_MODEL // 2
NA_HEAD_DIM = NA_WIDTH // NA_HEADS
NA_WIN_ROWS = 8
NA_WIN_COLS = 16
NA_QBLOCK_COLS = 16
NA_KBLOCK_COLS = NA_QBLOCK_COLS + NA_WIN_COLS

POOL_SIZES = (2, 4, 8, 16)
POOL_WIDTH = D_MODEL // 2
POOL_GROUP = POOL_WIDTH // len(POOL_SIZES)

XA_HEADS = 4
XA_WIDTH = D_MODEL // 2
XA_HEAD_DIM = XA_WIDTH // XA_HEADS

N_BRANCH = 3
IN_COLS = 3 * NA_WIDTH + POOL_WIDTH + XA_WIDTH + N_BRANCH * D_MODEL

PEER_HEADS = 8
PEER_KEYS = 128
PEER_EXPERTS = PEER_KEYS * PEER_KEYS
PEER_QDIM = 256
PEER_TOPK = 16
PEER_CHUNK = 64

kernel_name = 'hybrid_na_pool_memxattn_peer_encoder'


def rms_norm(x, g):
    xf = x.astype(jnp.float32)
    y = xf * lax.rsqrt(jnp.mean(xf * xf, axis=-1, keepdims=True) + EPS)
    return (y * g.astype(jnp.float32)).astype(x.dtype)


def neighbourhood_attention(q, k, v, rpb):
    B, S, H, dh = q.shape
    rows = S // GRID_W
    wr = min(NA_WIN_ROWS, rows)
    n_cb = GRID_W // NA_QBLOCK_COLS
    qg = q.reshape(B, rows, GRID_W, H, dh)
    kg = k.reshape(B, rows, GRID_W, H, dh)
    vg = v.reshape(B, rows, GRID_W, H, dh)
    qc = np.arange(GRID_W).reshape(n_cb, NA_QBLOCK_COLS)
    kb0 = np.clip(np.arange(n_cb) * NA_QBLOCK_COLS - NA_WIN_COLS // 2, 0, GRID_W - NA_KBLOCK_COLS)
    kc = kb0[:, None] + np.arange(NA_KBLOCK_COLS)[None, :]
    cs = np.clip(qc - NA_WIN_COLS // 2, 0, GRID_W - NA_WIN_COLS)
    col_ok = (kc[:, None, :] >= cs[:, :, None]) & (kc[:, None, :] < cs[:, :, None] + NA_WIN_COLS)
    dc_idx = np.clip(kc[:, None, :] - qc[:, :, None], -(NA_WIN_COLS - 1), NA_WIN_COLS - 1) + NA_WIN_COLS - 1
    mask = np.broadcast_to(col_ok[:, :, None, :], (n_cb, NA_QBLOCK_COLS, wr, NA_KBLOCK_COLS))
    mask = mask.reshape(n_cb, NA_QBLOCK_COLS, wr * NA_KBLOCK_COLS)
    scale = dh ** -0.5

    def row_block(r):
        rs = jnp.clip(r - wr // 2, 0, rows - wr)
        q_r = lax.dynamic_index_in_dim(qg, r, axis=1, keepdims=False)
        k_r = lax.dynamic_slice_in_dim(kg, rs, wr, axis=1)
        v_r = lax.dynamic_slice_in_dim(vg, rs, wr, axis=1)
        q_b = q_r.reshape(B, n_cb, NA_QBLOCK_COLS, H, dh)
        k_b = jnp.stack([k_r[:, :, int(s):int(s) + NA_KBLOCK_COLS] for s in kb0], axis=1)
        v_b = jnp.stack([v_r[:, :, int(s):int(s) + NA_KBLOCK_COLS] for s in kb0], axis=1)
        k_b = k_b.reshape(B, n_cb, wr * NA_KBLOCK_COLS, H, dh)
        v_b = v_b.reshape(B, n_cb, wr * NA_KBLOCK_COLS, H, dh)
        dr_idx = rs + jnp.arange(wr) - r + (NA_WIN_ROWS - 1)
        bias = rpb[:, dr_idx[None, None, :, None], dc_idx[:, :, None, :]]
        bias = bias.reshape(H, n_cb, NA_QBLOCK_COLS, wr * NA_KBLOCK_COLS).astype(jnp.float32)
        s = jnp.einsum('bjqhd,bjkhd->bhjqk', q_b, k_b).astype(jnp.float32) * scale + bias[None]
        s = jnp.where(mask[None, None], s, NEG_INF)
        p = jax.nn.softmax(s, axis=-1).astype(v.dtype)
        o = jnp.einsum('bhjqk,bjkhd->bjqhd', p, v_b)
        return o.reshape(B, GRID_W, H, dh)

    out = lax.map(row_block, jnp.arange(rows))
    return out.transpose(1, 0, 2, 3, 4).reshape(B, S, H * dh)


def multiscale_pool(p, w_group, scale):
    B, S, C = p.shape
    pf = p.astype(jnp.float32)
    csum = jnp.concatenate([jnp.zeros((B, 1, C), jnp.float32), jnp.cumsum(pf, axis=1)], axis=1)
    t = np.arange(S)
    outs = []
    for g, w in enumerate(POOL_SIZES):
        lo = np.clip(t - w // 2, 0, S)
        hi = np.clip(t + w // 2, 0, S)
        cnt = (hi - lo).astype(np.float32)[None, :, None]
        sl = slice(g * POOL_GROUP, (g + 1) * POOL_GROUP)
        cg = csum[..., sl]
        outs.append((cg[:, hi] - cg[:, lo]) / cnt - pf[..., sl])
    pooled = jnp.stack(outs, axis=2).astype(p.dtype)
    mixed = jnp.einsum('bsgc,gcd->bsgd', pooled, w_group).reshape(B, S, C)
    return mixed * scale


def memory_attention(q_x, mem_n, w_mem_kv, q_g, k_g):
    B, S, _ = q_x.shape
    M = mem_n.shape[1]
    q = rms_norm(q_x.reshape(B, S, XA_HEADS, XA_HEAD_DIM), q_g)
    kv = mem_n @ w_mem_kv
    k = rms_norm(kv[..., :XA_WIDTH].reshape(B, M, XA_HEADS, XA_HEAD_DIM), k_g)
    v = kv[..., XA_WIDTH:].reshape(B, M, XA_HEADS, XA_HEAD_DIM)
    s = jnp.einsum('bshd,bmhd->bhsm', q, k).astype(jnp.float32) * (XA_HEAD_DIM ** -0.5)
    p = jax.nn.softmax(s, axis=-1).astype(v.dtype)
    return jnp.einsum('bhsm,bmhd->bshd', p, v).reshape(B, S, XA_WIDTH)


def peer_ffn(hn, w_q, sub_keys, u, v):
    B, S, D = hn.shape
    nc = S // PEER_CHUNK
    hc = hn.reshape(B, nc, PEER_CHUNK, D).transpose(1, 0, 2, 3)

    def chunk(hb):
        T = hb.shape[1]
        q = (hb @ w_q).reshape(B, T, PEER_HEADS, 2, PEER_QDIM // 2)
        s = jnp.einsum('bthpd,hpnd->bthpn', q, sub_keys).astype(jnp.float32)
        s1, i1 = lax.top_k(s[..., 0, :], PEER_TOPK)
        s2, i2 = lax.top_k(s[..., 1, :], PEER_TOPK)
        cand = (s1[..., :, None] + s2[..., None, :]).reshape(B, T, PEER_HEADS, PEER_TOPK * PEER_TOPK)
        cidx = (i1[..., :, None] * PEER_KEYS + i2[..., None, :]).reshape(B, T, PEER_HEADS, PEER_TOPK * PEER_TOPK)
        top_s, pos = lax.top_k(cand, PEER_TOPK)
        eidx = jnp.take_along_axis(cidx, pos, axis=-1)
        g = jax.nn.softmax(top_s, axis=-1)
        u_sel = u[eidx]
        v_sel = v[eidx]
        a = jax.nn.gelu(jnp.einsum('btd,bthkd->bthk', hb, u_sel).astype(jnp.float32), approximate=False)
        return jnp.einsum('bthk,bthkd->btd', (g * a).astype(hb.dtype), v_sel)

    out = lax.map(chunk, hc)
    return out.transpose(1, 0, 2, 3).reshape(B, S, D)


def setup_inputs(seed: int = 0) -> dict:
    key = jax.random.key(seed)
    ks = jax.random.split(key, 24)
    f32 = jnp.float32
    L = DEPTH

    def nrm(k, shape, scale):
        return jax.random.normal(k, shape, f32) * scale

    def gain(k, shape):
        return 1.0 + 0.05 * jax.random.normal(k, shape, f32)

    return {
        'x': nrm(ks[0], (BATCH, SEQ, D_MODEL), 1.0),
        'mem': nrm(ks[1], (BATCH, MEM_LEN, D_MODEL), 1.0),
        'mix_norm_g': gain(ks[2], (L, D_MODEL)),
        'mem_norm_g': gain(ks[3], (L, D_MODEL)),
        'w_in': nrm(ks[4], (L, D_MODEL, IN_COLS), D_MODEL ** -0.5),
        'gate_b': nrm(ks[5], (L, N_BRANCH * D_MODEL), 0.1),
        'w_mem_kv': nrm(ks[6], (L, D_MODEL, 2 * XA_WIDTH), D_MODEL ** -0.5),
        'na_q_g': gain(ks[7], (L, NA_HEAD_DIM)),
        'na_k_g': gain(ks[8], (L, NA_HEAD_DIM)),
        'na_rpb': nrm(ks[9], (L, NA_HEADS, 2 * NA_WIN_ROWS - 1, 2 * NA_WIN_COLS - 1), 0.5),
        'pool_w': nrm(ks[10], (L, len(POOL_SIZES), POOL_GROUP, POOL_GROUP), POOL_GROUP ** -0.5),
        'pool_scale': gain(ks[11], (L, POOL_WIDTH)),
        'xa_q_g': gain(ks[12], (L, XA_HEAD_DIM)),
        'xa_k_g': gain(ks[13], (L, XA_HEAD_DIM)),
        'w_branch_na': nrm(ks[14], (L, NA_WIDTH, D_MODEL), NA_WIDTH ** -0.5),
        'w_branch_pool': nrm(ks[15], (L, POOL_WIDTH, D_MODEL), POOL_WIDTH ** -0.5),
        'w_branch_xa': nrm(ks[16], (L, XA_WIDTH, D_MODEL), XA_WIDTH ** -0.5),
        'w_out': nrm(ks[17], (L, D_MODEL, D_MODEL), D_MODEL ** -0.5),
        'ffn_norm_g': gain(ks[18], (L, D_MODEL)),
        'peer_w_q': nrm(ks[19], (L, D_MODEL, PEER_HEADS * PEER_QDIM), D_MODEL ** -0.5),
        'peer_sub_keys': nrm(ks[20], (L, PEER_HEADS, 2, PEER_KEYS, PEER_QDIM // 2), (PEER_QDIM // 2) ** -0.5),
        'peer_u': nrm(ks[21], (L, PEER_EXPERTS, D_MODEL), D_MODEL ** -0.5),
        'peer_v': nrm(ks[22], (L, PEER_EXPERTS, D_MODEL), 0.5),
    }


def reference(x, mem, mix_norm_g, mem_norm_g, w_in, gate_b, w_mem_kv, na_q_g, na_k_g, na_rpb,
              pool_w, pool_scale, xa_q_g, xa_k_g, w_branch_na, w_branch_pool, w_branch_xa, w_out,
              ffn_norm_g, peer_w_q, peer_sub_keys, peer_u, peer_v):
    B, S, D = x.shape
    c0 = 3 * NA_WIDTH
    c1 = c0 + POOL_WIDTH
    c2 = c1 + XA_WIDTH
    h = x
    for l in range(DEPTH):
        xn = rms_norm(h, mix_norm_g[l])
        proj = xn @ w_in[l]
        qkv = proj[..., :c0].reshape(B, S, 3, NA_HEADS, NA_HEAD_DIM)
        q_na = rms_norm(qkv[:, :, 0], na_q_g[l])
        k_na = rms_norm(qkv[:, :, 1], na_k_g[l])
        y_na = neighbourhood_attention(q_na, k_na, qkv[:, :, 2], na_rpb[l])
        y_pool = multiscale_pool(proj[..., c0:c1], pool_w[l], pool_scale[l])
        mem_n = rms_norm(mem, mem_norm_g[l])
        y_xa = memory_attention(proj[..., c1:c2], mem_n, w_mem_kv[l], xa_q_g[l], xa_k_g[l])
        gate = jax.nn.sigmoid((proj[..., c2:] + gate_b[l]).astype(jnp.float32))
        gate = gate.reshape(B, S, N_BRANCH, D).astype(h.dtype)
        merged = (gate[:, :, 0] * (y_na @ w_branch_na[l])
                  + gate[:, :, 1] * (y_pool @ w_branch_pool[l])
                  + gate[:, :, 2] * (y_xa @ w_branch_xa[l]))
        h = h + merged @ w_out[l]
        hn = rms_norm(h, ffn_norm_g[l])
        h = h + peer_ffn(hn, peer_w_q[l], peer_sub_keys[l], peer_u[l], peer_v[l])
    return h
```

```cpp
#include <hip/hip_runtime.h>
#include <cstdio>
#include <cstdint>
namespace nv {
constexpr int NB = 4, NS = 8192, ND = 1024, NT = NS  , NIN = 5632, NMEM = 256;
constexpr float EPSF = 1e-6f;

__device__ __forceinline__ float wsum(float v) {
#pragma unroll
    for (int o = 32; o > 0; o >>= 1) v += __shfl_xor(v, o);
    return v;
}
__device__ __forceinline__ float wmax(float v) {
#pragma unroll
    for (int o = 32; o > 0; o >>= 1) v = fmaxf(v, __shfl_xor(v, o));
    return v;
}
__global__ void k_rmsnorm(const float* __restrict__ x, const float* __restrict__ g, float* __restrict__ y, int nrow, int ncol) {
    const int lane = threadIdx.x & 63, w = (blockIdx.x * blockDim.x + threadIdx.x) >> 6;
    if (w >= nrow) return;
    const float* xr = x + (size_t)w * ncol; float s = 0.f;
    for (int c = lane; c < ncol; c += 64) { float v = xr[c]; s += v * v; }
    s = wsum(s);
    const float r = rsqrtf(s / (float)ncol + EPSF);
    float* yr = y + (size_t)w * ncol;
    for (int c = lane; c < ncol; c += 64) yr[c] = xr[c] * r * g[c];
}
__global__ void k_headnorm(float* buf, int ld, int off, int nh, int hd, const float* __restrict__ g, int nrow) {
    const int lane = threadIdx.x & 63, w = (blockIdx.x * blockDim.x + threadIdx.x) >> 6;
    if (w >= nrow * nh) return;
    const int row = w / nh, h = w % nh;
    float* p = buf + (size_t)row * ld + off + h * hd; float s = 0.f;
    for (int c = lane; c < hd; c += 64) { float v = p[c]; s += v * v; }
    s = wsum(s);
    const float r = rsqrtf(s / (float)hd + EPSF);
    for (int c = lane; c < hd; c += 64) p[c] = p[c] * r * g[c];
}
__global__ void __launch_bounds__(256) k_sgemm(const float* __restrict__ A, int lda, const float* __restrict__ Bm, int ldb, float* __restrict__ C, int ldc,
                                               const float* __restrict__ Add, int K) {
    __shared__ float As[16][64 + 4], Bs[16][64 + 4];
    const int tx = threadIdx.x & 15, ty = threadIdx.x >> 4, m0 = blockIdx.y * 64, n0 = blockIdx.x * 64;
    float acc[4][4];
#pragma unroll
    for (int i = 0; i < 4; ++i)
#pragma unroll
        for (int j = 0; j < 4; ++j) acc[i][j] = 0.f;
    for (int k0 = 0; k0 < K; k0 += 16) {
        {
            const int r = threadIdx.x >> 2, c4 = (threadIdx.x & 3) * 4;
            const float4 v = *(const float4*)(A + (size_t)(m0 + r) * lda + k0 + c4);
            As[c4 + 0][r] = v.x; As[c4 + 1][r] = v.y; As[c4 + 2][r] = v.z; As[c4 + 3][r] = v.w;
            const int kr = threadIdx.x >> 4, nc = (threadIdx.x & 15) * 4;
            const float4 b = *(const float4*)(Bm + (size_t)(k0 + kr) * ldb + n0 + nc);
            Bs[kr][nc + 0] = b.x; Bs[kr][nc + 1] = b.y; Bs[kr][nc + 2] = b.z; Bs[kr][nc + 3] = b.w;
        }
        __syncthreads();
#pragma unroll
        for (int kk = 0; kk < 16; ++kk) {
            float a[4], b[4];
#pragma unroll
            for (int i = 0; i < 4; ++i) { a[i] = As[kk][ty * 4 + i]; b[i] = Bs[kk][tx * 4 + i]; }
#pragma unroll
            for (int i = 0; i < 4; ++i)
#pragma unroll
                for (int j = 0; j < 4; ++j) acc[i][j] += a[i] * b[j];
        }
        __syncthreads();
    }
#pragma unroll
    for (int i = 0; i < 4; ++i) {
        const size_t o = (size_t)(m0 + ty * 4 + i) * ldc + n0 + tx * 4;
        float4 v = make_float4(acc[i][0], acc[i][1], acc[i][2], acc[i][3]);
        if (Add) { const float4 a = *(const float4*)(Add + o); v.x += a.x; v.y += a.y; v.z += a.z; v.w += a.w; }
        *(float4*)(C + o) = v;
    }
}
__global__ void k_na(const float* __restrict__ proj, const float* __restrict__ rpb, float* __restrict__ y) {
    const int lane = threadIdx.x & 63, w = (blockIdx.x * blockDim.x + threadIdx.x) >> 6;
    if (w >= NT * 8) return;
    const int tok = w >> 3, h = w & 7, b = tok / NS, t = tok % NS, r = t >> 6, c = t & 63;
    int rs = r - 4; rs = rs < 0 ? 0 : (rs > 120 ? 120 : rs);
    int cs = c - 8; cs = cs < 0 ? 0 : (cs > 48 ? 48 : cs);
    const float qd = proj[(size_t)tok * NIN + h * 64 + lane];
    float m = -3.0e38f, l = 0.f, acc = 0.f;
    for (int kr = 0; kr < 8; ++kr)
        for (int kc = 0; kc < 16; ++kc) {
            const int krow = rs + kr, kcol = cs + kc;
            const size_t kt = (size_t)b * NS + krow * 64 + kcol;
            const float kd = proj[kt * NIN + 512 + h * 64 + lane];
            float s = wsum(qd * kd) * 0.125f;
            int dc = kcol - c; dc = dc < -15 ? -15 : (dc > 15 ? 15 : dc);
            s += rpb[(h * 15 + (krow - r + 7)) * 31 + dc + 15];
            const float mn = fmaxf(m, s), f = __expf(m - mn), p = __expf(s - mn);
            const float vd = proj[kt * NIN + 1024 + h * 64 + lane];
            l = l * f + p; acc = acc * f + p * vd; m = mn;
        }
    y[(size_t)tok * 512 + h * 64 + lane] = acc / l;
}
__global__ void k_pool(const float* __restrict__ proj, float* __restrict__ pooled) {
    const size_t i = (size_t)blockIdx.x * blockDim.x + threadIdx.x;
    if (i >= (size_t)NT * 512) return;
    const int tok = (int)(i >> 9), ch = (int)(i & 511), g = ch >> 7, b = tok / NS, t = tok % NS;
    const int w = 2 << g, hw = w >> 1;
    int lo = t - hw; lo = lo < 0 ? 0 : lo; int hi = t + hw; hi = hi > NS ? NS : hi;
    float s = 0.f;
    for (int u = lo; u < hi; ++u) s += proj[((size_t)b * NS + u) * NIN + 1536 + ch];
    pooled[i] = s / (float)(hi - lo) - proj[(size_t)tok * NIN + 1536 + ch];
}
__global__ void k_poolmix(const float* __restrict__ pooled, const float* __restrict__ pw, const float* __restrict__ sc, float* __restrict__ y) {
    const size_t i = (size_t)blockIdx.x * blockDim.x + threadIdx.x;
    if (i >= (size_t)NT * 512) return;
    const int tok = (int)(i >> 9), ch = (int)(i & 511), g = ch >> 7, d = ch & 127;
    float s = 0.f;
    for (int c = 0; c < 128; ++c) s += pooled[(size_t)tok * 512 + g * 128 + c] * pw[(g * 128 + c) * 128 + d];
    y[i] = s * sc[ch];
}
__global__ void k_xa(const float* __restrict__ proj, const float* __restrict__ kv, float* __restrict__ y) {
    const int lane = threadIdx.x & 63, w = (blockIdx.x * blockDim.x + threadIdx.x) >> 6;
    if (w >= NT * 4) return;
    const int tok = w >> 2, h = w & 3, b = tok / NS;
    const float q0 = proj[(size_t)tok * NIN + 2048 + h * 128 + lane], q1 = proj[(size_t)tok * NIN + 2048 + h * 128 + 64 + lane];
    float m = -3.0e38f, l = 0.f, a0 = 0.f, a1 = 0.f;
    const float sc = 0.08838834764831845f;
    for (int j = 0; j < NMEM; ++j) {
        const float* kr = kv + (size_t)(b * NMEM + j) * 1024 + h * 128;
        const float s = wsum(q0 * kr[lane] + q1 * kr[64 + lane]) * sc;
        const float mn = fmaxf(m, s), f = __expf(m - mn), p = __expf(s - mn);
        l = l * f + p; a0 = a0 * f + p * kr[512 + lane]; a1 = a1 * f + p * kr[512 + 64 + lane]; m = mn;
    }
    y[(size_t)tok * 512 + h * 128 + lane] = a0 / l; y[(size_t)tok * 512 + h * 128 + 64 + lane] = a1 / l;
}
__global__ void k_merge(const float* __restrict__ proj, const float* __restrict__ gb, const float* __restrict__ b0, const float* __restrict__ b1, const float* __restrict__ b2,
                        float* __restrict__ merged) {
    const size_t i = (size_t)blockIdx.x * blockDim.x + threadIdx.x;
    if (i >= (size_t)NT * ND) return;
    const int tok = (int)(i >> 10), c = (int)(i & 1023);
    const float* pr = proj + (size_t)tok * NIN + 2560;
    const float g0 = 1.f / (1.f + __expf(-(pr[c] + gb[c]))), g1 = 1.f / (1.f + __expf(-(pr[1024 + c] + gb[1024 + c]))), g2 = 1.f / (1.f + __expf(-(pr[2048 + c] + gb[2048 + c])));
    merged[i] = g0 * b0[i] + g1 * b1[i] + g2 * b2[i];
}
__global__ void k_peer_top1(const float* __restrict__ q, const float* __restrict__ keys, float* __restrict__ sv, int* __restrict__ si) {
    const int lane = threadIdx.x & 63, w = (blockIdx.x * blockDim.x + threadIdx.x) >> 6;
    if (w >= NT * 16) return;
    const int tok = w >> 4, hp = w & 15;
    const float* qp = q + (size_t)tok * 2048 + hp * 128;
    const float* kp = keys + (size_t)hp * 128 * 128;
    float s0 = 0.f, s1 = 0.f;
    for (int d = 0; d < 128; ++d) { const float qd = qp[d]; s0 += qd * kp[lane * 128 + d]; s1 += qd * kp[(lane + 64) * 128 + d]; }
    for (int k = 0; k < 16; ++k) {
        const float mine = fmaxf(s0, s1), mx = wmax(mine);
        int cand = 1 << 30;
        if (s0 == mx) cand = lane; else if (s1 == mx) cand = lane + 64;
        int best = cand;
#pragma unroll
        for (int o = 32; o > 0; o >>= 1) { const int ot = __shfl_xor(best, o); best = ot < best ? ot : best; }
        if (lane == 0) { sv[(size_t)w * 16 + k] = mx; si[(size_t)w * 16 + k] = best; }
        if (best == lane) s0 = -3.0e38f;
        if (best == lane + 64) s1 = -3.0e38f;
    }
}
__global__ void k_peer_top2(const float* __restrict__ sv, const int* __restrict__ si, float* __restrict__ gw, int* __restrict__ ge) {
    const int lane = threadIdx.x & 63, w = (blockIdx.x * blockDim.x + threadIdx.x) >> 6;
    if (w >= NT * 8) return;
    const float* s1 = sv + (size_t)w * 32; const float* s2 = s1 + 16;
    const int* i1 = si + (size_t)w * 32; const int* i2 = i1 + 16;
    float c[4];
#pragma unroll
    for (int j = 0; j < 4; ++j) { const int pos = lane * 4 + j; c[j] = s1[pos >> 4] + s2[pos & 15]; }
    float tv = 0.f; int te = 0;
    for (int k = 0; k < 16; ++k) {
        const float mine = fmaxf(fmaxf(c[0], c[1]), fmaxf(c[2], c[3])), mx = wmax(mine);
        int cand = 1 << 30;
#pragma unroll
        for (int j = 3; j >= 0; --j) if (c[j] == mx) cand = lane * 4 + j;
        int best = cand;
#pragma unroll
        for (int o = 32; o > 0; o >>= 1) { const int ot = __shfl_xor(best, o); best = ot < best ? ot : best; }
        if (lane == k) { tv = mx; te = i1[best >> 4] * 128 + i2[best & 15]; }
#pragma unroll
        for (int j = 0; j < 4; ++j) if (best == lane * 4 + j) c[j] = -3.0e38f;
    }
    const float v = lane < 16 ? tv : -3.0e38f, mx = wmax(v), e = lane < 16 ? __expf(v - mx) : 0.f, sum = wsum(e);
    if (lane < 16) { gw[(size_t)w * 16 + lane] = e / sum; ge[(size_t)w * 16 + lane] = te; }
}
__global__ void __launch_bounds__(256) k_peer_out(const float* __restrict__ h, const float* __restrict__ hn, const float* __restrict__ u, const float* __restrict__ v,
                                                  const float* __restrict__ gw, const int* __restrict__ ge, float* __restrict__ out) {
    __shared__ float wk[128]; __shared__ int ek[128]; __shared__ float red[4];
    const int tok = blockIdx.x, tid = threadIdx.x, lane = tid & 63, wv = tid >> 6;
    const float4 hv = *(const float4*)(hn + (size_t)tok * ND + tid * 4);
    if (tid < 128) ek[tid] = ge[(size_t)tok * 128 + tid];
    __syncthreads();
    for (int k = 0; k < 128; ++k) {
        const float4 uv = *(const float4*)(u + (size_t)ek[k] * ND + tid * 4);
        float s = hv.x * uv.x + hv.y * uv.y + hv.z * uv.z + hv.w * uv.w;
        s = wsum(s);
        if (lane == 0) red[wv] = s;
        __syncthreads();
        if (tid == 0) { const float z = red[0] + red[1] + red[2] + red[3]; wk[k] = gw[(size_t)tok * 128 + k] * 0.5f * z * (1.f + erff(z * 0.70710678118654752f)); }
        __syncthreads();
    }
    float4 acc = *(const float4*)(h + (size_t)tok * ND + tid * 4);
    for (int k = 0; k < 128; ++k) {
        const float4 vv = *(const float4*)(v + (size_t)ek[k] * ND + tid * 4); const float wgt = wk[k];
        acc.x += wgt * vv.x; acc.y += wgt * vv.y; acc.z += wgt * vv.z; acc.w += wgt * vv.w;
    }
    *(float4*)(out + (size_t)tok * ND + tid * 4) = acc;
}


static void run(void* const* d_in, float* out, char* ws, hipStream_t st) {
    const float* x = (const float*)d_in[0]; const float* mem = (const float*)d_in[1]; const float* mix_g = (const float*)d_in[2]; const float* mem_g = (const float*)d_in[3];
    const float* w_in = (const float*)d_in[4]; const float* gate_b = (const float*)d_in[5]; const float* w_kv = (const float*)d_in[6]; const float* na_q_g = (const float*)d_in[7];
    const float* na_k_g = (const float*)d_in[8]; const float* rpb = (const float*)d_in[9]; const float* pool_w = (const float*)d_in[10]; const float* pool_sc = (const float*)d_in[11];
    const float* xa_q_g = (const float*)d_in[12]; const float* xa_k_g = (const float*)d_in[13]; const float* wb0 = (const float*)d_in[14]; const float* wb1 = (const float*)d_in[15];
    const float* wb2 = (const float*)d_in[16]; const float* w_out = (const float*)d_in[17]; const float* ffn_g = (const float*)d_in[18]; const float* w_q = (const float*)d_in[19];
    const float* keys = (const float*)d_in[20]; const float* pu = (const float*)d_in[21]; const float* pv = (const float*)d_in[22];
    size_t o = 0; auto take = [&](size_t nfl) { float* p = (float*)(ws + o); o += nfl * 4; return p; };
    float* proj = take((size_t)NT * NIN);
    float* xn = take((size_t)NT * ND);
    float* b1 = take((size_t)NT * ND); float* b2 = take((size_t)NT * ND);
    float* yna = take((size_t)NT * 512); float* pooled = take((size_t)NT * 512); float* ypool = take((size_t)NT * 512); float* yxa = take((size_t)NT * 512);
    float* merged = take((size_t)NT * ND);
    float* hbuf = take((size_t)NT * ND);
    float* memn = take((size_t)NMEM * ND); float* kv = take((size_t)NMEM * ND);
    float* b0 = xn; float* hn = merged; float* q = proj; float* sv = q + (size_t)NT * 2048; int* si = (int*)(sv + (size_t)NT * 256);
    float* gw = (float*)(si + (size_t)NT * 256); int* ge = (int*)(gw + (size_t)NT * 128);
    for (int b = 0; b < NB; ++b) {
        const float* xb = x + (size_t)b * NT * ND; float* ob = out + (size_t)b * NT * ND;
        k_rmsnorm<<<NT / 4, 256, 0, st>>>(xb, mix_g, xn, NT, ND);
        k_sgemm<<<dim3(NIN / 64, NT / 64), 256, 0, st>>>(xn, ND, w_in, NIN, proj, NIN, nullptr, ND);
        k_headnorm<<<NT * 8 / 4, 256, 0, st>>>(proj, NIN, 0, 8, 64, na_q_g, NT);
        k_headnorm<<<NT * 8 / 4, 256, 0, st>>>(proj, NIN, 512, 8, 64, na_k_g, NT);
        k_na<<<NT * 8 / 4, 256, 0, st>>>(proj, rpb, yna);
        k_pool<<<NT * 512 / 256, 256, 0, st>>>(proj, pooled);
        k_poolmix<<<NT * 512 / 256, 256, 0, st>>>(pooled, pool_w, pool_sc, ypool);
        k_rmsnorm<<<NMEM / 4, 256, 0, st>>>(mem + (size_t)b * NMEM * ND, mem_g, memn, NMEM, ND);
        k_sgemm<<<dim3(1024 / 64, NMEM / 64), 256, 0, st>>>(memn, ND, w_kv, 1024, kv, 1024, nullptr, ND);
        k_headnorm<<<NMEM * 4 / 4, 256, 0, st>>>(kv, 1024, 0, 4, 128, xa_k_g, NMEM);
        k_headnorm<<<NT * 4 / 4, 256, 0, st>>>(proj, NIN, 2048, 4, 128, xa_q_g, NT);
        k_xa<<<NT * 4 / 4, 256, 0, st>>>(proj, kv, yxa);
        k_sgemm<<<dim3(ND / 64, NT / 64), 256, 0, st>>>(yna, 512, wb0, ND, b0, ND, nullptr, 512);
        k_sgemm<<<dim3(ND / 64, NT / 64), 256, 0, st>>>(ypool, 512, wb1, ND, b1, ND, nullptr, 512);
        k_sgemm<<<dim3(ND / 64, NT / 64), 256, 0, st>>>(yxa, 512, wb2, ND, b2, ND, nullptr, 512);
        k_merge<<<NT * ND / 256, 256, 0, st>>>(proj, gate_b, b0, b1, b2, merged);
        k_sgemm<<<dim3(ND / 64, NT / 64), 256, 0, st>>>(merged, ND, w_out, ND, hbuf, ND, xb, ND);
        k_rmsnorm<<<NT / 4, 256, 0, st>>>(hbuf, ffn_g, hn, NT, ND);
        k_sgemm<<<dim3(2048 / 64, NT / 64), 256, 0, st>>>(hn, ND, w_q, 2048, q, 2048, nullptr, ND);
        k_peer_top1<<<NT * 16 / 4, 256, 0, st>>>(q, keys, sv, si);
        k_peer_top2<<<NT * 8 / 4, 256, 0, st>>>(sv, si, gw, ge);
        k_peer_out<<<NT, 256, 0, st>>>(hbuf, hn, pu, pv, gw, ge, ob);
    }
}
}

extern "C" void kernel_launch(void* const* d_in, const int* in_sizes, int n_in, void* d_out, int out_size, void* d_ws, size_t ws_size, hipStream_t stream) {
    if (ws_size < (size_t)440 * 1024 * 1024) { fprintf(stderr, "kernel_launch: ws too small: %zu\n", ws_size); return; }
    nv::run(d_in, (float*)d_out, (char*)d_ws, stream);
}
```

```cpp
#define MK_N_LAUNCHES 8
#include <hip/hip_runtime.h>
#include <cstdio>
#include <cstdint>

#ifndef MK_N_LAUNCHES
#define MK_N_LAUNCHES 1
#endif

namespace pg8 {
#define PG8_LAS __attribute__((address_space(3)))
typedef unsigned short bf16_t;
typedef short bf16x8 __attribute__((ext_vector_type(8)));
typedef float f32x4 __attribute__((ext_vector_type(4)));
typedef unsigned u32x4 __attribute__((ext_vector_type(4)));
typedef unsigned u32x2 __attribute__((ext_vector_type(2)));
constexpr int BM = 256, BK = 64, HALF = 128, HTB = HALF * BK * 2  , STAGE_BYTES = 8 * HTB, NXCD = 8, WGM = 8;

__host__ __device__ __forceinline__ int lds_byte(int r, int c) { const int st = (r >> 4) * 2 + (c >> 5), rr = r & 15, cc = c & 31, ob = rr * 64 + cc * 2; return st * 1024 + (ob ^ (((ob >> 9) & 1) << 5)); }
__host__ __device__ __forceinline__ void stage_rc(int b, int& R, int& C) { const int st = b / 1024, sb = b % 1024, swz = sb ^ (((sb >> 9) & 1) << 5); R = (st >> 1) * 16 + swz / 64; C = (st & 1) * 32 + (swz % 64) / 2; }
__host__ __device__ __forceinline__ int perm32(int rho) { const int n = rho >> 4, i = rho & 15; return 8 * (i >> 2) + 4 * n + (i & 3); }

struct Unit { int pm, pn, br; };

struct StaticOrder {
    int nM, nN, nwg, G, c;
    __host__ __device__ void init(int M, int N, int G_, int c_) { nM = M / BM; nN = N / BM; nwg = nM * nN; G = G_; c = c_; }
    __host__ __device__ bool next(int i, Unit& u) const {
        const long L = (long)i * G + c; if (L >= nwg) return false;
        int wgid = (int)L; { const int q = nwg / NXCD, r = nwg % NXCD, xcd = wgid % NXCD, off = wgid / NXCD; wgid = (xcd < r ? xcd * (q + 1) : r * (q + 1) + (xcd - r) * q) + off; }
        const int nig = WGM * nN, gid = wgid / nig, fm = gid * WGM, gsz = (nM - fm) < WGM ? (nM - fm) : WGM;
        u.pm = fm + ((wgid % nig) % gsz); u.pn = (wgid % nig) / gsz; return true;
    }
};
struct Sched1 {
    StaticOrder so; const char* A; const char* Bt; size_t tstep;
    __device__ __forceinline__ bool next(int i, Unit& u) const { u.br = 0; return so.next(i, u); }
    __device__ __forceinline__ const char* abase(const Unit& u) const { return A + (size_t)u.pm * tstep; }
    __device__ __forceinline__ const char* bbase(const Unit& u) const { return Bt + (size_t)u.pn * tstep; }
    __device__ __forceinline__ void a_ready(const Unit&) const {}
    __device__ __forceinline__ void done(const Unit&) const {}
};
struct Sched3 {
    StaticOrder so; const char* A; const char* Bt; size_t tstep, strideA, strideB;
    __device__ __forceinline__ bool next(int i, Unit& u) const { u.br = i % 3; return so.next(i / 3, u); }
    __device__ __forceinline__ const char* abase(const Unit& u) const { return A + (size_t)u.br * strideA + (size_t)u.pm * tstep; }
    __device__ __forceinline__ const char* bbase(const Unit& u) const { return Bt + (size_t)u.br * strideB + (size_t)u.pn * tstep; }
    __device__ __forceinline__ void a_ready(const Unit&) const {}
    __device__ __forceinline__ void done(const Unit&) const {}
};

typedef float f32x2_t __attribute__((ext_vector_type(2))); typedef __bf16 bf16x2v_t __attribute__((ext_vector_type(2)));
__device__ __forceinline__ unsigned cvt_pk_bf16(float lo, float hi) { const f32x2_t v = {lo, hi}; const bf16x2v_t b = __builtin_convertvector(v, bf16x2v_t); return __builtin_bit_cast(unsigned, b); }
__device__ __forceinline__ u32x4 pack8(const f32x4 a, const f32x4 b) { u32x4 w; w.x = cvt_pk_bf16(a[0], a[1]); w.y = cvt_pk_bf16(a[2], a[3]); w.z = cvt_pk_bf16(b[0], b[1]); w.w = cvt_pk_bf16(b[2], b[3]); return w; }
__device__ __forceinline__ float bflo(unsigned u) { return __builtin_bit_cast(float, u << 16); }
__device__ __forceinline__ float bfhi(unsigned u) { return __builtin_bit_cast(float, u & 0xffff0000u); }


constexpr float RMS_EPS = 1e-6f;

struct EpiProj {
    static constexpr bool PERM = true, AFTER_DRAIN = false;
    const float* rstd; bf16_t *qn, *kn, *pp, *xq, *gates; const float *qg, *kg, *gate_b;
    __device__ __forceinline__ void operator()(const f32x4 (&acc)[2][2][4][2], const Unit& u, int wr, int wc, int fr, int fq) const {
        const int pn = u.pn, row0 = u.pm * BM + wr * 64 + fr, lc0 = 64 * wc + 8 * fq;
        if (pn < 4) {
            const bool isq = pn < 2; bf16_t* O = isq ? qn : kn; const float* g = isq ? qg : kg; const float post = isq ? 0.125f : 1.0f;
            f32x4 gv[2][2];
#pragma unroll
            for (int bj = 0; bj < 2; ++bj)
#pragma unroll
                for (int n = 0; n < 2; ++n) gv[bj][n] = *(const f32x4*)(g + 32 * bj + 8 * fq + 4 * n);
            const int colbase = (pn & 1) * 256 + lc0;
#pragma unroll
            for (int ai = 0; ai < 2; ++ai)
#pragma unroll
                for (int m = 0; m < 4; ++m) {
                    const int row = row0 + ai * HALF + m * 16; const float rs = rstd[row];
                    f32x4 v[2][2]; float ss = 0.f;
#pragma unroll
                    for (int bj = 0; bj < 2; ++bj)
#pragma unroll
                        for (int n = 0; n < 2; ++n) { v[bj][n] = acc[ai][bj][m][n] * rs; ss += (v[bj][n][0] * v[bj][n][0] + v[bj][n][1] * v[bj][n][1]) + (v[bj][n][2] * v[bj][n][2] + v[bj][n][3] * v[bj][n][3]); }
                    ss += __shfl_xor(ss, 16); ss += __shfl_xor(ss, 32);
                    const float r = rsqrtf(ss * (1.0f / 64.0f) + RMS_EPS) * post;
#pragma unroll
                    for (int bj = 0; bj < 2; ++bj) *(u32x4*)(O + (size_t)row * 512 + colbase + 32 * bj) = pack8(v[bj][0] * r * gv[bj][0], v[bj][1] * r * gv[bj][1]);
                }
        } else if (pn < 8) {
            bf16_t* O = pn < 6 ? pp : xq; const int colbase = (pn & 1) * 256 + lc0;
#pragma unroll
            for (int ai = 0; ai < 2; ++ai)
#pragma unroll
                for (int m = 0; m < 4; ++m) {
                    const int row = row0 + ai * HALF + m * 16; const float rs = rstd[row];
#pragma unroll
                    for (int bj = 0; bj < 2; ++bj) *(u32x4*)(O + (size_t)row * 512 + colbase + 32 * bj) = pack8(acc[ai][bj][m][0] * rs, acc[ai][bj][m][1] * rs);
                }
        } else {
            const int gcol0 = (pn - 8) * 256 + lc0;
            f32x4 bv[2][2];
#pragma unroll
            for (int bj = 0; bj < 2; ++bj)
#pragma unroll
                for (int n = 0; n < 2; ++n) bv[bj][n] = *(const f32x4*)(gate_b + gcol0 + 32 * bj + 4 * n);
#pragma unroll
            for (int ai = 0; ai < 2; ++ai)
#pragma unroll
                for (int m = 0; m < 4; ++m) {
                    const int row = row0 + ai * HALF + m * 16; const float rs = rstd[row];
#pragma unroll
                    for (int bj = 0; bj < 2; ++bj) {
                        f32x4 o[2];
#pragma unroll
                        for (int n = 0; n < 2; ++n) { const f32x4 z = acc[ai][bj][m][n] * rs + bv[bj][n];
#pragma unroll
                            for (int i = 0; i < 4; ++i) o[n][i] = __builtin_amdgcn_rcpf(1.0f + __expf(-z[i])); }
                        *(u32x4*)(gates + (size_t)row * 3072 + gcol0 + 32 * bj) = pack8(o[0], o[1]);
                    }
                }
        }
    }
};
struct EpiVt {
    static constexpr bool PERM = true, AFTER_DRAIN = false;
    const float* rstd; bf16_t* Vt;
    __device__ __forceinline__ void operator()(const f32x4 (&acc)[2][2][4][2], const Unit& u, int wr, int wc, int fr, int fq) const {
        const int ch0 = u.pm * BM + wr * 64 + fr, tok0 = u.pn * BM + wc * 32 + 8 * fq, b = tok0 >> 13, t0 = tok0 & 8191;
        f32x4 rv[2][2];
#pragma unroll
        for (int bj = 0; bj < 2; ++bj)
#pragma unroll
            for (int n = 0; n < 2; ++n) rv[bj][n] = *(const f32x4*)(rstd + tok0 + bj * HALF + 4 * n);
#pragma unroll
        for (int ai = 0; ai < 2; ++ai)
#pragma unroll
            for (int m = 0; m < 4; ++m) { const int ch = ch0 + ai * HALF + m * 16; bf16_t* rowp = Vt + ((size_t)(b * 512 + ch) * 8192 + t0);
#pragma unroll
                for (int bj = 0; bj < 2; ++bj) *(u32x4*)(rowp + bj * HALF) = pack8(acc[ai][bj][m][0] * rv[bj][0], acc[ai][bj][m][1] * rv[bj][1]); }
    }
};
struct EpiMerge {
    static constexpr bool PERM = true, AFTER_DRAIN = false;
    const bf16_t* gates; bf16_t* pa; bf16_t* merged;
    __device__ __forceinline__ void operator()(const f32x4 (&acc)[2][2][4][2], const Unit& u, int wr, int wc, int fr, int fq) const {
        const int row0 = u.pm * BM + wr * 64 + fr, col0 = u.pn * BM + wc * 32 + 8 * fq, br = u.br;
        const bf16_t* src = br == 1 ? pa : merged; bf16_t* dst = br == 0 ? pa : merged;
#pragma unroll
        for (int ai = 0; ai < 2; ++ai)
#pragma unroll
            for (int m = 0; m < 4; ++m) { const int row = row0 + ai * HALF + m * 16;
#pragma unroll
                for (int bj = 0; bj < 2; ++bj) {
                    const u32x4 g8 = *(const u32x4*)(gates + (size_t)row * 3072 + br * 1024 + col0 + bj * HALF);
                    const size_t mo = (size_t)row * 1024 + col0 + bj * HALF;
                    f32x4 a = acc[ai][bj][m][0], b = acc[ai][bj][m][1];
                    a[0] *= bflo(g8.x); a[1] *= bfhi(g8.x); a[2] *= bflo(g8.y); a[3] *= bfhi(g8.y); b[0] *= bflo(g8.z); b[1] *= bfhi(g8.z); b[2] *= bflo(g8.w); b[3] *= bfhi(g8.w);
                    if (br > 0) { const u32x4 p8 = *(const u32x4*)(src + mo);
                        a[0] += bflo(p8.x); a[1] += bfhi(p8.x); a[2] += bflo(p8.y); a[3] += bfhi(p8.y); b[0] += bflo(p8.z); b[1] += bfhi(p8.z); b[2] += bflo(p8.w); b[3] += bfhi(p8.w); }
                    *(u32x4*)(dst + mo) = pack8(a, b);
                } }
    }
};
struct EpiH {
    static constexpr bool PERM = true, AFTER_DRAIN = false;
    const float* x; float* out; bf16_t* hb; float* rowsq;
    __device__ __forceinline__ void operator()(const f32x4 (&acc)[2][2][4][2], const Unit& u, int wr, int wc, int fr, int fq) const {
        const int row0 = u.pm * BM + wr * 64 + fr, col0 = u.pn * BM + wc * 32 + 8 * fq;
#pragma unroll
        for (int ai = 0; ai < 2; ++ai)
#pragma unroll
            for (int m = 0; m < 4; ++m) { const int row = row0 + ai * HALF + m * 16; float ss = 0.f;
#pragma unroll
                for (int bj = 0; bj < 2; ++bj) { const size_t o = (size_t)row * 1024 + col0 + bj * HALF;
                    const f32x4 h0 = *(const f32x4*)(x + o) + acc[ai][bj][m][0], h1 = *(const f32x4*)(x + o + 4) + acc[ai][bj][m][1];
                    *(f32x4*)(out + o) = h0; *(f32x4*)(out + o + 4) = h1; *(u32x4*)(hb + o) = pack8(h0, h1);
                    ss += (h0[0] * h0[0] + h0[1] * h0[1]) + (h0[2] * h0[2] + h0[3] * h0[3]) + (h1[0] * h1[0] + h1[1] * h1[1]) + (h1[2] * h1[2] + h1[3] * h1[3]); }
                ss += __shfl_xor(ss, 16); ss += __shfl_xor(ss, 32);
                if (fq == 0) atomicAdd(rowsq + row, ss); }
    }
};
struct EpiQ {
    static constexpr bool PERM = true, AFTER_DRAIN = false;
    const float* rowsq; bf16_t* qb;
    __device__ __forceinline__ void operator()(const f32x4 (&acc)[2][2][4][2], const Unit& u, int wr, int wc, int fr, int fq) const {
        const int row0 = u.pm * BM + wr * 64 + fr, col0 = u.pn * BM + wc * 32 + 8 * fq;
#pragma unroll
        for (int ai = 0; ai < 2; ++ai)
#pragma unroll
            for (int m = 0; m < 4; ++m) { const int row = row0 + ai * HALF + m * 16; const float r = rsqrtf(rowsq[row] * (1.0f / 1024.0f) + RMS_EPS);
#pragma unroll
                for (int bj = 0; bj < 2; ++bj) *(u32x4*)(qb + (size_t)row * 2048 + col0 + bj * HALF) = pack8(acc[ai][bj][m][0] * r, acc[ai][bj][m][1] * r); }
    }
};

template <class Epi, class Sched, bool ALIGN_EPI = false, bool SP2 = false>
__device__ __forceinline__ void gemm_phase(PG8_LAS unsigned char* lds, const int K, const Sched& S, const Epi& E) {
    const int tid = threadIdx.x, wid = __builtin_amdgcn_readfirstlane(tid >> 6), lane = tid & 63, wr = wid >> 2, wc = wid & 3, fr = lane & 15, fq = lane >> 4;
    const int nt = K / BK;
    unsigned voffA[2], voffB[2];
#pragma unroll
    for (int i = 0; i < 2; ++i) { int R, C; stage_rc(tid * 16 + i * 8192, R, C); const int Rb = Epi::PERM ? ((R & ~31) + perm32(R & 31)) : R;
        voffA[i] = (unsigned)(R * K + C) * 2u; voffB[i] = (unsigned)(Rb * K + C) * 2u; }
    const size_t kstep = (size_t)(BK * 2);
    const size_t hstep = (size_t)HALF * K * 2;
    const size_t tstep = 2 * hstep;
    const unsigned ldsw = (unsigned)wid * 1024u;
    const int aoff = lds_byte(wr * 64 + fr, fq * 8), boff = lds_byte(wc * 32 + fr, fq * 8);
#define PG8_SA(b, h) (((b) * 2 + (h)) * HTB)
#define PG8_SB(b, h) ((4 + (b) * 2 + (h)) * HTB)
#define PG8_STAGE(bufoff, gbase, voff) do { _Pragma("unroll") for (int _i = 0; _i < 2; ++_i) \
        __builtin_amdgcn_global_load_lds((const unsigned*)((const char*)(gbase) + (voff)[_i]), (PG8_LAS unsigned*)(lds + (bufoff) + ldsw + _i * 8192), 16, 0, 0); } while (0)
#define PG8_LDA(dst, b, h) do { _Pragma("unroll") for (int m = 0; m < 4; ++m) _Pragma("unroll") for (int k = 0; k < 2; ++k) dst[m][k] = *(const PG8_LAS bf16x8*)(lds + PG8_SA(b, h) + aoff + m * 2048 + k * 1024); } while (0)
#define PG8_LDB(dst, b, h) do { _Pragma("unroll") for (int n = 0; n < 2; ++n) _Pragma("unroll") for (int k = 0; k < 2; ++k) dst[n][k] = *(const PG8_LAS bf16x8*)(lds + PG8_SB(b, h) + boff + n * 2048 + k * 1024); } while (0)
#define PG8_MMA(ai, bj, At, Bt) do { __builtin_amdgcn_s_setprio(1); _Pragma("unroll") for (int m = 0; m < 4; ++m) _Pragma("unroll") for (int n = 0; n < 2; ++n) _Pragma("unroll") for (int k = 0; k < 2; ++k) \
        acc[ai][bj][m][n] = __builtin_amdgcn_mfma_f32_16x16x32_bf16(Bt[n][k], At[m][k], acc[ai][bj][m][n], 0, 0, 0); __builtin_amdgcn_s_setprio(0); } while (0)
#define PG8_WAIT_V(n) asm volatile("s_waitcnt vmcnt(" #n ")" ::: "memory")
#define PG8_WAIT_L(n) asm volatile("s_waitcnt lgkmcnt(" #n ")" ::: "memory")
#define PG8_BAR __builtin_amdgcn_s_barrier()
#define PG8_SCHED __builtin_amdgcn_sched_barrier(0)
    Unit cur, nxt; int ui = 0;
    if (!S.next(0, cur)) return;
    f32x4 acc[2][2][4][2];
#pragma unroll
    for (int a = 0; a < 2; ++a)
#pragma unroll
        for (int b = 0; b < 2; ++b)
#pragma unroll
            for (int m = 0; m < 4; ++m)
#pragma unroll
                for (int n = 0; n < 2; ++n) acc[a][b][m][n] = (f32x4){0.f, 0.f, 0.f, 0.f};
    bf16x8 At[4][2], B0[2][2], B1[2][2];
    const char* cA = S.abase(cur); const char* cB = S.bbase(cur);
    S.a_ready(cur);
    if constexpr (SP2) {
        PG8_STAGE(PG8_SB(0, 0), cB, voffB); PG8_STAGE(PG8_SB(0, 1), cB + hstep, voffB); PG8_STAGE(PG8_SA(0, 0), cA, voffA); PG8_STAGE(PG8_SA(0, 1), cA + hstep, voffA);
        if (wr == 1) PG8_BAR;
        PG8_WAIT_V(2); PG8_BAR;
        PG8_STAGE(PG8_SB(1, 0), cB + kstep, voffB); PG8_STAGE(PG8_SA(1, 0), cA + kstep, voffA); PG8_STAGE(PG8_SB(1, 1), cB + hstep + kstep, voffB);
        PG8_WAIT_V(6); PG8_BAR;
    } else {
        PG8_STAGE(PG8_SB(0, 0), cB, voffB); PG8_STAGE(PG8_SA(0, 0), cA, voffA); PG8_STAGE(PG8_SB(0, 1), cB + hstep, voffB); PG8_STAGE(PG8_SA(0, 1), cA + hstep, voffA);
        if (wr == 1) PG8_BAR;
        PG8_WAIT_V(4); PG8_BAR;
        PG8_STAGE(PG8_SB(1, 0), cB + kstep, voffB); PG8_STAGE(PG8_SA(1, 0), cA + kstep, voffA); PG8_STAGE(PG8_SB(1, 1), cB + hstep + kstep, voffB);
        PG8_WAIT_V(6); PG8_BAR;
    }
    for (;;) {
        const bool has_next = S.next(ui + 1, nxt);
        const char* nA = has_next ? S.abase(nxt) : cA; const char* nB = has_next ? S.bbase(nxt) : cB;
        for (int t = 0; t < nt; t += 2) {
            const bool last = (t == nt - 2);
            const char* a1 = cA + (size_t)(t + 1) * kstep;
            const char* a2 = last ? nA : cA + (size_t)(t + 2) * kstep; const char* b2 = last ? nB : cB + (size_t)(t + 2) * kstep;
            const char* a3 = a2 + kstep; const char* b3 = b2 + kstep;
            if (last && has_next) S.a_ready(nxt);
            if constexpr (SP2) {
            PG8_LDB(B0, 0, 0); PG8_LDB(B1, 0, 1); PG8_SCHED; PG8_LDA(At, 0, 0); PG8_STAGE(PG8_SA(1, 1), a1 + hstep, voffA);
            PG8_WAIT_V(8); PG8_WAIT_L(0); PG8_BAR; PG8_MMA(0, 0, At, B0); PG8_MMA(0, 1, At, B1); PG8_BAR; PG8_SCHED;
            PG8_LDA(At, 0, 1); PG8_STAGE(PG8_SB(0, 0), b2, voffB); PG8_STAGE(PG8_SB(0, 1), b2 + hstep, voffB); PG8_STAGE(PG8_SA(0, 0), a2, voffA);
            PG8_WAIT_V(8); PG8_WAIT_L(0); PG8_BAR; PG8_MMA(1, 0, At, B0); PG8_MMA(1, 1, At, B1); PG8_BAR; PG8_SCHED;
            PG8_LDB(B0, 1, 0); PG8_LDB(B1, 1, 1); PG8_SCHED; PG8_LDA(At, 1, 0); PG8_STAGE(PG8_SA(0, 1), a2 + hstep, voffA);
            PG8_WAIT_V(8); PG8_WAIT_L(0); PG8_BAR; PG8_MMA(0, 0, At, B0); PG8_MMA(0, 1, At, B1); PG8_BAR; PG8_SCHED;
            PG8_LDA(At, 1, 1); PG8_STAGE(PG8_SB(1, 0), b3, voffB); PG8_STAGE(PG8_SB(1, 1), b3 + hstep, voffB); PG8_STAGE(PG8_SA(1, 0), a3, voffA);
            PG8_WAIT_V(8); PG8_WAIT_L(0); PG8_BAR; PG8_MMA(1, 0, At, B0); PG8_MMA(1, 1, At, B1); PG8_BAR; PG8_SCHED;
            } else {
            PG8_LDB(B0, 0, 0); PG8_SCHED; PG8_LDA(At, 0, 0); PG8_STAGE(PG8_SA(1, 1), a1 + hstep, voffA);
            PG8_WAIT_L(8); PG8_BAR; PG8_WAIT_L(0); PG8_MMA(0, 0, At, B0); PG8_BAR; PG8_SCHED;
            PG8_LDB(B1, 0, 1); PG8_STAGE(PG8_SB(0, 0), b2, voffB);
            PG8_BAR; PG8_WAIT_L(0); PG8_MMA(0, 1, At, B1); PG8_BAR;
            PG8_LDA(At, 0, 1); PG8_STAGE(PG8_SA(0, 0), a2, voffA);
            PG8_BAR; PG8_WAIT_L(0); PG8_MMA(1, 0, At, B0); PG8_BAR; PG8_SCHED;
            PG8_STAGE(PG8_SB(0, 1), b2 + hstep, voffB);
            PG8_WAIT_V(6); PG8_BAR; PG8_MMA(1, 1, At, B1); PG8_BAR;
            PG8_LDB(B0, 1, 0); PG8_SCHED; PG8_LDA(At, 1, 0); PG8_STAGE(PG8_SA(0, 1), a2 + hstep, voffA);
            PG8_WAIT_L(8); PG8_BAR; PG8_WAIT_L(0); PG8_MMA(0, 0, At, B0); PG8_BAR; PG8_SCHED;
            PG8_LDB(B1, 1, 1); PG8_STAGE(PG8_SB(1, 0), b3, voffB);
            PG8_BAR; PG8_WAIT_L(0); PG8_MMA(0, 1, At, B1); PG8_BAR;
            PG8_LDA(At, 1, 1); PG8_STAGE(PG8_SA(1, 0), a3, voffA);
            PG8_BAR; PG8_WAIT_L(0); PG8_MMA(1, 0, At, B0); PG8_BAR; PG8_SCHED;
            PG8_STAGE(PG8_SB(1, 1), b3 + hstep, voffB);
            PG8_WAIT_V(6); PG8_BAR; PG8_MMA(1, 1, At, B1); PG8_BAR;
            }
        }
        if constexpr (ALIGN_EPI) { if (wr == 0) PG8_BAR; }
        if constexpr (!Epi::AFTER_DRAIN) { E(acc, cur, wr, wc, fr, fq); S.done(cur); }
        if (!has_next) break;
#pragma unroll
        for (int a = 0; a < 2; ++a)
#pragma unroll
            for (int b = 0; b < 2; ++b)
#pragma unroll
                for (int m = 0; m < 4; ++m)
#pragma unroll
                    for (int n = 0; n < 2; ++n) acc[a][b][m][n] = (f32x4){0.f, 0.f, 0.f, 0.f};
        cur = nxt; cA = nA; cB = nB; ++ui;
        if constexpr (ALIGN_EPI) { if (wr == 1) PG8_BAR; }
    }
    PG8_WAIT_V(0);
    if constexpr (!ALIGN_EPI) { if (wr == 0) PG8_BAR; }
    PG8_BAR;
    if constexpr (Epi::AFTER_DRAIN) { E.fused(acc, cur, wr, wc, fr, fq, lds, wid, lane); S.done(cur); }
#undef PG8_SA
#undef PG8_SB
#undef PG8_STAGE
#undef PG8_LDA
#undef PG8_LDB
#undef PG8_MMA
#undef PG8_WAIT_V
#undef PG8_WAIT_L
#undef PG8_BAR
#undef PG8_SCHED
}
}

constexpr int NWAVES = 8;
constexpr int N_LAUNCHES = MK_N_LAUNCHES;
constexpr int PER_PHASE = 8;
constexpr int NBATCH = 4, SEQ = 8192, D = 1024, T = NBATCH * SEQ, MEMLEN = 256, NMEMTOK = NBATCH * MEMLEN;
constexpr int IN_MAIN = 5120;
constexpr int NEXP = 16384;

constexpr size_t MiB = 1u << 20;
constexpr size_t WS_CTL = 0, CTL_ZERO_BYTES = 512 * 1024;
constexpr size_t WS_ROWSQ = 256 * 1024;
constexpr size_t WS_WIN = 1 * MiB, WS_WV = 11 * MiB, WS_WKV = 12 * MiB, WS_WBR = 14 * MiB, WS_WOUT = 17 * MiB, WS_WQ = 19 * MiB, WS_KEYS = 23 * MiB, WS_PWT = 23 * MiB + 512 * 1024;
constexpr size_t WS_MEMN = 24 * MiB, WS_KMEM = 26 * MiB, WS_VTMEM = 27 * MiB, WS_RSTDX = 28 * MiB, WS_U16 = 32 * MiB, WS_V16 = 64 * MiB;
constexpr size_t WS_QN = 96 * MiB, WS_KN = 128 * MiB, WS_VT = 160 * MiB, WS_PP = 192 * MiB, WS_XQ = 224 * MiB, WS_GATE = 256 * MiB, WS_END = 448 * MiB;
constexpr size_t WS_MERGED = WS_QN;
constexpr size_t WS_HB = WS_VT;
constexpr size_t WS_QB = WS_GATE;
constexpr size_t WS_TE = WS_GATE + 128 * MiB, WS_TW = WS_TE + 16 * MiB;
constexpr size_t OUT_XB = 0, OUT_YNA = 0, OUT_YPOOL = 32 * MiB, OUT_YXA = 64 * MiB;
constexpr int CW_TMO = 0, CW_BAR = 4096;

constexpr int RING_OFF = 0, RING_BYTES = 131072;
constexpr int LDSCTL_OFF = RING_BYTES, MISC_OFF = LDSCTL_OFF + 320;
constexpr int LDS_BYTES = 147456;

#define GAS __attribute__((address_space(1)))
#define LAS __attribute__((address_space(3)))
typedef unsigned short bf16;
typedef unsigned v4u __attribute__((ext_vector_type(4)));
typedef unsigned v2u __attribute__((ext_vector_type(2)));
typedef float f32x4 __attribute__((ext_vector_type(4)));
typedef short bf16x8 __attribute__((ext_vector_type(8)));
typedef __bf16 bf16x2_t __attribute__((ext_vector_type(2)));
typedef GAS unsigned gu32;
#define LDS_WAIT() asm volatile("s_waitcnt lgkmcnt(0)" ::: "memory")
#define VM_WAIT() asm volatile("s_waitcnt vmcnt(0)" ::: "memory")
__device__ __forceinline__ unsigned f2bf(float f) { unsigned u = __builtin_bit_cast(unsigned, f); return (u + 0x7fffu + ((u >> 16) & 1u)) >> 16; }
__device__ __forceinline__ unsigned pk2(float lo, float hi) { return f2bf(lo) | (f2bf(hi) << 16); }
__device__ __forceinline__ float bflo(unsigned u) { return __builtin_bit_cast(float, u << 16); }
__device__ __forceinline__ float bfhi(unsigned u) { return __builtin_bit_cast(float, u & 0xffff0000u); }
__device__ __forceinline__ float bf1(short s) { return __builtin_bit_cast(float, ((unsigned)(unsigned short)s) << 16); }
__device__ __forceinline__ f32x4 mfma16(bf16x8 a, bf16x8 b, f32x4 c) { return __builtin_amdgcn_mfma_f32_16x16x32_bf16(a, b, c, 0, 0, 0); }
__device__ __forceinline__ float wave_sum(float v) {
#pragma unroll
    for (int o = 1; o < 64; o <<= 1) v += __shfl_xor(v, o);
    return v;
}

#define XB_TMO      128
#define XB_XCNT(j)  (256  + 64 * (j))
#define XB_XSUB(j)  (1280 + 64 * (j))
#define XB_XGEN(j)  (2304 + 64 * (j))
#define XB_TOP      3328
#define XB_TOPGEN   3392
#define XCD_BAR_WORDS 3456
#define XB_SPIN_CAP (1u << 18)

__device__ __forceinline__ unsigned xb_ld(unsigned* p)              { return __hip_atomic_load(p, __ATOMIC_RELAXED, __HIP_MEMORY_SCOPE_AGENT); }
__device__ __forceinline__ unsigned xb_add(unsigned* p, unsigned v) { return __hip_atomic_fetch_add(p, v, __ATOMIC_RELAXED, __HIP_MEMORY_SCOPE_AGENT); }
__device__ __forceinline__ unsigned xb_xcc_id() { return (unsigned)__builtin_amdgcn_s_getreg((3 << 11) | 20) & 0xFu; }
#define XB_SPIN(cond, bar) do { unsigned _sp = 0; while (cond) { __builtin_amdgcn_s_sleep(1); \
    if ((++_sp & 255u) == 0u) { if (xb_ld(&(bar)[XB_TMO])) break; if (_sp > XB_SPIN_CAP) { atomicAdd(&(bar)[XB_TMO], 1u); break; } } } } while (0)

struct XcdBarrier {
    unsigned* bar; unsigned x;
    volatile LAS unsigned* st;
};

__device__ __forceinline__ XcdBarrier xcd_barrier_post(unsigned* bar, volatile LAS unsigned* st) {
    XcdBarrier b; b.bar = bar; b.x = xb_xcc_id(); b.st = st;
    if (threadIdx.x == 0) (void)xb_add(&bar[XB_XCNT(b.x)], 1u);
    return b;
}
__device__ __forceinline__ void xcd_barrier_complete(unsigned* bar, unsigned x, unsigned& nloc, unsigned& nx) {
    const unsigned G = gridDim.x * gridDim.y * gridDim.z;
    unsigned sum, cnt, mine, sp = 0u;
    for (;;) {
        sum = 0u; cnt = 0u; mine = 0u;
#pragma unroll
        for (unsigned j = 0; j < 16; ++j) { const unsigned c = xb_ld(&bar[XB_XCNT(j)]); sum += c; cnt += (c > 0u) ? 1u : 0u; mine = (j == x) ? c : mine; }
        if (sum == G) break;
        __builtin_amdgcn_s_sleep(1);
        if ((++sp & 255u) == 0u) { if (xb_ld(&bar[XB_TMO])) break; if (sp > XB_SPIN_CAP) { atomicAdd(&bar[XB_TMO], 1u); break; } }
    }
    nloc = mine > 0u ? mine : 1u; nx = cnt > 0u ? cnt : 1u;
}

__device__ __forceinline__ void xcd_barrier(const XcdBarrier& b) {
    asm volatile("s_waitcnt vmcnt(0)" ::: "memory");
    __syncthreads();
    if (threadIdx.x == 0) {
        unsigned* bar = b.bar;
        __builtin_amdgcn_s_waitcnt(0);
        unsigned nloc = b.st[0], nx = b.st[1];
        if (nloc == 0u) { xcd_barrier_complete(bar, b.x, nloc, nx); b.st[0] = nloc; b.st[1] = nx; }
        const unsigned old = xb_add(&bar[XB_XSUB(b.x)], 1u);
        const unsigned gen = old / nloc;
        if (old + 1u == (gen + 1u) * nloc) {
            __builtin_amdgcn_fence(__ATOMIC_RELEASE, "agent");
            asm volatile("s_waitcnt vmcnt(0)" ::: "memory");
            const unsigned og = xb_add(&bar[XB_TOP], 1u);
            const unsigned tg = og / nx;
            if (og + 1u == (tg + 1u) * nx) xb_add(&bar[XB_TOPGEN], 1u);
            else XB_SPIN(xb_ld(&bar[XB_TOPGEN]) == tg, bar);
            __builtin_amdgcn_fence(__ATOMIC_ACQUIRE, "agent");
            xb_add(&bar[XB_XGEN(b.x)], 1u);
            asm volatile("s_waitcnt vmcnt(0)" ::: "memory");
        } else {
            XB_SPIN(xb_ld(&bar[XB_XGEN(b.x)]) == gen, bar);
            __builtin_amdgcn_fence(__ATOMIC_ACQUIRE, "agent");
            asm volatile("s_waitcnt vmcnt(0)" ::: "memory");
        }
    }
    __syncthreads();
}

struct Frame {
    LAS unsigned char* lds;
    volatile LAS unsigned* MISC;
    gu32* ctl;
    int tid, lane, wave, vcu, G;
    float* out; unsigned char* ws;
};
struct Args { const float* in[23]; float* out; unsigned char* ws; int ph_lo, ph_hi; };
enum { I_X = 0, I_MEM, I_MIXG, I_MEMG, I_WIN, I_GATEB, I_WKV, I_NAQG, I_NAKG, I_RPB, I_POOLW, I_POOLSC, I_XAQG, I_XAKG, I_WB0, I_WB1, I_WB2, I_WOUT, I_FFNG, I_WQ, I_KEYS, I_PU, I_PV };

__device__ __forceinline__ void p0_transpose_item(const float* W, int K, int N, int k0, int n0, bf16* dst, const float* kscale, LAS float* scr, int lane) {
#pragma unroll 8
    for (int i = 0; i < 32; ++i) { const int kk = 2 * i + (lane >> 5); float v = W[(size_t)(k0 + kk) * N + n0 + (lane & 31)]; if (kscale) v *= kscale[k0 + kk]; scr[kk * 33 + (lane & 31)] = v; }
    LDS_WAIT(); asm volatile("" ::: "memory");
    const int c = lane & 7;
#pragma unroll
    for (int j = 0; j < 4; ++j) { const int n = (lane >> 3) + 8 * j; const LAS float* s = scr + (8 * c) * 33 + n;
        v4u o; o.x = pk2(s[0 * 33], s[1 * 33]); o.y = pk2(s[2 * 33], s[3 * 33]); o.z = pk2(s[4 * 33], s[5 * 33]); o.w = pk2(s[6 * 33], s[7 * 33]);
        *(GAS v4u*)(dst + (size_t)n * K + k0 + 8 * c) = o; }
    LDS_WAIT(); asm volatile("" ::: "memory");
}
__device__ __forceinline__ void cvt_row1024(const float* src, bf16* dst, const float* colscale, float rowscale, int lane) {
    const GAS f32x4* xr = (const GAS f32x4*)src + lane; GAS unsigned long long* o8 = (GAS unsigned long long*)dst + lane;
#pragma unroll
    for (int j = 0; j < 4; ++j) { f32x4 v = xr[64 * j] * rowscale; if (colscale) v = v * ((const GAS f32x4*)colscale)[lane + 64 * j];
        o8[64 * j] = (unsigned long long)pk2(v.x, v.y) | ((unsigned long long)pk2(v.z, v.w) << 32); }
}
__device__ __forceinline__ float row_rstd1024(const float* src, int lane) {
    const GAS f32x4* xr = (const GAS f32x4*)src + lane; float s = 0.f;
#pragma unroll
    for (int j = 0; j < 4; ++j) { const f32x4 v = xr[64 * j]; s += (v.x * v.x + v.y * v.y) + (v.z * v.z + v.w * v.w); }
    return rsqrtf(wave_sum(s) * (1.0f / 1024.0f) + 1e-6f);
}
__device__ __forceinline__ void p0_prologue(Frame& F, const Args& A) {
    LAS float* scr = (LAS float*)(F.lds + RING_OFF + F.wave * 16384);
    const int gw = F.vcu * NWAVES + F.wave, NGW = F.G * NWAVES, lane = F.lane;
    unsigned char* ws = F.ws;
    constexpr int I_IN = 16 * 176, I_KV = 16 * 32, I_BR = 8 * 32, I_OUT = 16 * 32, I_Q = 16 * 64;
    constexpr int NITEMS = I_IN + I_KV + 3 * I_BR + I_OUT + I_Q;
    for (int it = gw; it < NITEMS; it += NGW) {
        int r = it;
        if (r < I_IN) { const int kb = r / 176, nb = r % 176, n0 = 32 * nb; bf16* dst;
            if (n0 >= 1024 && n0 < 1536) dst = (bf16*)(ws + WS_WV) + (size_t)(n0 - 1024) * 1024;
            else { const int np = n0 < 1024 ? n0 : n0 - 512, t = np >> 8, w = np & 255, wc = w >> 6, bj = (w >> 5) & 1; dst = (bf16*)(ws + WS_WIN) + (size_t)(256 * t + 128 * bj + 32 * wc) * 1024; }
            p0_transpose_item(A.in[I_WIN], 1024, 5632, 64 * kb, n0, dst, A.in[I_MIXG], scr, lane); continue; }
        r -= I_IN;
        if (r < I_KV) { const int kb = r / 32, nb = r % 32; p0_transpose_item(A.in[I_WKV], 1024, 1024, 64 * kb, 32 * nb, (bf16*)(ws + WS_WKV) + (size_t)(32 * nb) * 1024, nullptr, scr, lane); continue; }
        r -= I_KV;
        if (r < 3 * I_BR) { const int br = r / I_BR, rr = r % I_BR, kb = rr / 32, nb = rr % 32; const float* W = br == 0 ? A.in[I_WB0] : (br == 1 ? A.in[I_WB1] : A.in[I_WB2]);
            p0_transpose_item(W, 512, 1024, 64 * kb, 32 * nb, (bf16*)(ws + WS_WBR) + (size_t)br * 1024 * 512 + (size_t)(32 * nb) * 512, nullptr, scr, lane); continue; }
        r -= 3 * I_BR;
        if (r < I_OUT) { const int kb = r / 32, nb = r % 32; p0_transpose_item(A.in[I_WOUT], 1024, 1024, 64 * kb, 32 * nb, (bf16*)(ws + WS_WOUT) + (size_t)(32 * nb) * 1024, nullptr, scr, lane); continue; }
        r -= I_OUT;
        { const int kb = r / 64, nb = r % 64; p0_transpose_item(A.in[I_WQ], 1024, 2048, 64 * kb, 32 * nb, (bf16*)(ws + WS_WQ) + (size_t)(32 * nb) * 1024, A.in[I_FFNG], scr, lane); }
    }
    { bf16* xb = (bf16*)((unsigned char*)F.out + OUT_XB); float* rstdx = (float*)(ws + WS_RSTDX);
      for (int m = gw; m < T; m += NGW) { const float* xr = A.in[I_X] + (size_t)m * D; const float rs = row_rstd1024(xr, lane); cvt_row1024(xr, xb + (size_t)m * D, nullptr, 1.0f, lane); if (lane == 0) rstdx[m] = rs; } }
    for (int m = gw; m < NMEMTOK; m += NGW) { const float* xr = A.in[I_MEM] + (size_t)m * D; const float rs = row_rstd1024(xr, lane); cvt_row1024(xr, (bf16*)(ws + WS_MEMN) + (size_t)m * D, A.in[I_MEMG], rs, lane); }
    for (int m = gw; m < 2 * NEXP; m += NGW) {
        if (m < NEXP) cvt_row1024(A.in[I_PU] + (size_t)m * D, (bf16*)(ws + WS_U16) + (size_t)m * D, A.in[I_FFNG], 1.0f, lane);
        else cvt_row1024(A.in[I_PV] + (size_t)(m - NEXP) * D, (bf16*)(ws + WS_V16) + (size_t)(m - NEXP) * D, nullptr, 1.0f, lane);
    }
    for (int m = gw * 64 + lane; m < T; m += NGW * 64) ((float*)(ws + WS_ROWSQ))[m] = 0.f;
    for (int m = gw; m < 256; m += NGW) cvt_row1024(A.in[I_KEYS] + (size_t)m * 1024, (bf16*)(ws + WS_KEYS) + (size_t)m * 1024, nullptr, 1.0f, lane);
    for (int m = gw; m < 1024; m += NGW) { const int gd = m >> 1, c = (m & 1) * 64 + lane, g = gd >> 7, d = gd & 127;
        const float v = A.in[I_POOLW][(size_t)(g * 128 + c) * 128 + d] * A.in[I_POOLSC][gd];
        ((bf16*)(ws + WS_PWT))[(size_t)gd * 128 + c] = (bf16)f2bf(v); }
}

__device__ __forceinline__ void memkv_tile(const bf16* memn, const bf16* wkvT, const float* kg, const float* qg, bf16* kmem, bf16* vtmem, int tile, int lane) {
    const int q = lane & 15, hi = lane >> 4, rg = tile >> 3, cg = tile & 7, r0 = rg * 16, c0 = cg * 128;
    f32x4 acc[8];
#pragma unroll
    for (int i = 0; i < 8; ++i) acc[i] = (f32x4){0.f, 0.f, 0.f, 0.f};
    const bf16* ap = memn + (size_t)(r0 + q) * 1024 + 8 * hi; const bf16* bp = wkvT + (size_t)(c0 + q) * 1024 + 8 * hi;
#pragma unroll 2
    for (int ks = 0; ks < 32; ++ks) { const bf16x8 a = *(const bf16x8*)(ap + 32 * ks);
#pragma unroll
        for (int nf = 0; nf < 8; ++nf) { const bf16x8 b = *(const bf16x8*)(bp + (size_t)(16 * nf) * 1024 + 32 * ks); acc[nf] = mfma16(a, b, acc[nf]); } }
    if (cg < 4) {
        float rr[4];
#pragma unroll
        for (int g = 0; g < 4; ++g) { float ss = 0.f;
#pragma unroll
            for (int nf = 0; nf < 8; ++nf) ss += acc[nf][g] * acc[nf][g];
            ss += __shfl_xor(ss, 1); ss += __shfl_xor(ss, 2); ss += __shfl_xor(ss, 4); ss += __shfl_xor(ss, 8);
            rr[g] = rsqrtf(ss * (1.0f / 128.0f) + 1e-6f); }
#pragma unroll
        for (int nf = 0; nf < 8; ++nf) { const int d = 16 * nf + q; const float gs = kg[d] * qg[d];
#pragma unroll
            for (int g = 0; g < 4; ++g) kmem[(size_t)(r0 + 4 * hi + g) * 512 + cg * 128 + d] = (bf16)f2bf(acc[nf][g] * rr[g] * gs); }
    } else {
        const int h = cg - 4, b = r0 >> 8, key0 = (r0 & 255) + 4 * hi;
#pragma unroll
        for (int nf = 0; nf < 8; ++nf) { const int d = 16 * nf + q; v2u w; w.x = pk2(acc[nf][0], acc[nf][1]); w.y = pk2(acc[nf][2], acc[nf][3]);
            *(v2u*)(vtmem + (size_t)(b * 512 + h * 128 + d) * 256 + key0) = w; }
    }
}

__device__ __forceinline__ void na_item(const bf16* __restrict__ qn, const bf16* __restrict__ kn, const bf16* __restrict__ vt, const float* __restrict__ rpb, bf16* __restrict__ yna,
                                        int b, int r, int jb, int h, int lane) {
    const int q = lane & 15, hi = lane >> 4;
    int rs = r - 4; rs = rs < 0 ? 0 : (rs > 120 ? 120 : rs);
    int kb0 = jb * 16 - 8; kb0 = kb0 < 0 ? 0 : (kb0 > 32 ? 32 : kb0);
    const int qcol = jb * 16 + q; int cs = qcol - 8; cs = cs < 0 ? 0 : (cs > 48 ? 48 : cs);
    const size_t tokq = (size_t)b * SEQ + r * 64 + qcol;
    const bf16* qp = qn + tokq * 512 + h * 64 + 8 * hi;
    const bf16x8 qf0 = *(const bf16x8*)qp, qf1 = *(const bf16x8*)(qp + 32);
    const bf16* kbase = kn + ((size_t)b * SEQ + rs * 64 + kb0 + q) * 512 + h * 64 + 8 * hi;
    f32x4 s[16];
#pragma unroll
    for (int f = 0; f < 16; ++f) {
        const bf16* kp = kbase + (size_t)((f >> 1) * 64 + (f & 1) * 16) * 512;
        const bf16x8 a0 = *(const bf16x8*)kp, a1 = *(const bf16x8*)(kp + 32);
        f32x4 z = (f32x4){0.f, 0.f, 0.f, 0.f}; z = mfma16(a0, qf0, z); s[f] = mfma16(a1, qf1, z);
    }
    const float* rp = rpb + h * 15 * 31;
    float mx = -3.0e38f;
#pragma unroll
    for (int f = 0; f < 16; ++f) {
        const int dr = rs + (f >> 1) - r + 7;
#pragma unroll
        for (int g = 0; g < 4; ++g) {
            const int kcol = kb0 + (f & 1) * 16 + 4 * hi + g;
            const bool ok = (kcol >= cs) && (kcol < cs + 16);
            int dc = kcol - qcol + 15; dc = dc < 0 ? 0 : (dc > 30 ? 30 : dc);
            const float v = ok ? s[f][g] + rp[dr * 31 + dc] : -1.0e30f;
            s[f][g] = v; mx = fmaxf(mx, v);
        }
    }
    mx = fmaxf(mx, __shfl_xor(mx, 16)); mx = fmaxf(mx, __shfl_xor(mx, 32));
    float sum = 0.f;
#pragma unroll
    for (int f = 0; f < 16; ++f)
#pragma unroll
        for (int g = 0; g < 4; ++g) { const float p = __expf(s[f][g] - mx); s[f][g] = p; sum += p; }
    sum += __shfl_xor(sum, 16); sum += __shfl_xor(sum, 32);
    const float inv = 1.0f / sum;
    f32x4 o[4];
#pragma unroll
    for (int i = 0; i < 4; ++i) o[i] = (f32x4){0.f, 0.f, 0.f, 0.f};
    const bf16* vbase = vt + ((size_t)(b * 512 + h * 64 + q) * SEQ + rs * 64 + kb0 + 4 * hi);
#pragma unroll
    for (int st = 0; st < 8; ++st) {
        const bf16x8 pb = __builtin_bit_cast(bf16x8, pg8::pack8(s[2 * st], s[2 * st + 1]));
#pragma unroll
        for (int mf = 0; mf < 4; ++mf) { const bf16* vp = vbase + (size_t)(16 * mf) * SEQ + st * 64; const v2u lo = *(const v2u*)vp, hh = *(const v2u*)(vp + 16);
            const bf16x8 av = __builtin_bit_cast(bf16x8, (v4u){lo.x, lo.y, hh.x, hh.y}); o[mf] = mfma16(av, pb, o[mf]); }
    }
    bf16* yp = yna + tokq * 512 + h * 64 + 4 * hi;
#pragma unroll
    for (int mf = 0; mf < 4; ++mf) { v2u w; w.x = pk2(o[mf][0] * inv, o[mf][1] * inv); w.y = pk2(o[mf][2] * inv, o[mf][3] * inv); *(v2u*)(yp + 16 * mf) = w; }
}
__device__ __forceinline__ void xa_item(const bf16* __restrict__ xq, const bf16* __restrict__ kmem, const bf16* __restrict__ vtmem, bf16* __restrict__ yxa, int tok0, int h, int lane) {
    const int q = lane & 15, hi = lane >> 4; const size_t tok = (size_t)tok0 + q; const int b = tok0 >> 13;
    const bf16* qp = xq + tok * 512 + h * 128 + 8 * hi;
    bf16x8 qf[4]; float ssq = 0.f;
#pragma unroll
    for (int ks = 0; ks < 4; ++ks) { qf[ks] = *(const bf16x8*)(qp + 32 * ks);
#pragma unroll
        for (int j = 0; j < 8; ++j) { const float v = bf1(qf[ks][j]); ssq += v * v; } }
    ssq += __shfl_xor(ssq, 16); ssq += __shfl_xor(ssq, 32);
    const float cexp = rsqrtf(ssq * (1.0f / 128.0f) + 1e-6f) * 0.08838834764831845f * 1.4426950408889634f;
    const bf16* kbase = kmem + ((size_t)b * 256 + q) * 512 + h * 128 + 8 * hi;
    f32x4 s[16];
#pragma unroll
    for (int f = 0; f < 16; ++f) { const bf16* kp = kbase + (size_t)(16 * f) * 512; f32x4 z = (f32x4){0.f, 0.f, 0.f, 0.f};
#pragma unroll
        for (int ks = 0; ks < 4; ++ks) z = mfma16(*(const bf16x8*)(kp + 32 * ks), qf[ks], z);
        s[f] = z; }
    float mx = -3.0e38f;
#pragma unroll
    for (int f = 0; f < 16; ++f)
#pragma unroll
        for (int g = 0; g < 4; ++g) mx = fmaxf(mx, s[f][g]);
    mx = fmaxf(mx, __shfl_xor(mx, 16)); mx = fmaxf(mx, __shfl_xor(mx, 32));
    float sum = 0.f;
#pragma unroll
    for (int f = 0; f < 16; ++f)
#pragma unroll
        for (int g = 0; g < 4; ++g) { const float p = __builtin_amdgcn_exp2f((s[f][g] - mx) * cexp); s[f][g] = p; sum += p; }
    sum += __shfl_xor(sum, 16); sum += __shfl_xor(sum, 32);
    const float inv = 1.0f / sum;
    f32x4 o[8];
#pragma unroll
    for (int i = 0; i < 8; ++i) o[i] = (f32x4){0.f, 0.f, 0.f, 0.f};
    const bf16* vbase = vtmem + (size_t)(b * 512 + h * 128 + q) * 256 + 4 * hi;
#pragma unroll
    for (int st = 0; st < 8; ++st) {
        const bf16x8 pb = __builtin_bit_cast(bf16x8, pg8::pack8(s[2 * st], s[2 * st + 1]));
#pragma unroll
        for (int mf = 0; mf < 8; ++mf) { const bf16* vp = vbase + (size_t)(16 * mf) * 256 + 32 * st; const v2u lo = *(const v2u*)vp, hh = *(const v2u*)(vp + 16);
            const bf16x8 av = __builtin_bit_cast(bf16x8, (v4u){lo.x, lo.y, hh.x, hh.y}); o[mf] = mfma16(av, pb, o[mf]); }
    }
    bf16* yp = yxa + tok * 512 + h * 128 + 4 * hi;
#pragma unroll
    for (int mf = 0; mf < 8; ++mf) { v2u w; w.x = pk2(o[mf][0] * inv, o[mf][1] * inv); w.y = pk2(o[mf][2] * inv, o[mf][3] * inv); *(v2u*)(yp + 16 * mf) = w; }
}
__device__ __forceinline__ void pool_item(const bf16* __restrict__ pp, const bf16* __restrict__ pwT, bf16* __restrict__ ypool, int tok0, int g, int lane) {
    const int q = lane & 15, hi = lane >> 4; const int tok = tok0 + q, b = tok >> 13, t = tok & 8191;
    const int hw = 1 << g;
    int lo = t - hw; lo = lo < 0 ? 0 : lo; int ht = t + hw; ht = ht > SEQ ? SEQ : ht;
    const float inv = 1.0f / (float)(ht - lo);
    const bf16* base = pp + (size_t)b * SEQ * 512 + g * 128 + 8 * hi;
    bf16x8 pb[4];
#pragma unroll
    for (int ks = 0; ks < 4; ++ks) {
        float a8[8];
#pragma unroll
        for (int j = 0; j < 8; ++j) a8[j] = 0.f;
        for (int d = -hw; d < hw; ++d) { const int u = t + d; const bool ok = (u >= 0) && (u < SEQ); const int uc = ok ? u : t;
            const bf16x8 v = *(const bf16x8*)(base + (size_t)uc * 512 + 32 * ks);
#pragma unroll
            for (int j = 0; j < 8; ++j) a8[j] += ok ? bf1(v[j]) : 0.f; }
        const bf16x8 sv = *(const bf16x8*)(base + (size_t)t * 512 + 32 * ks);
        f32x4 p0, p1;
#pragma unroll
        for (int j = 0; j < 4; ++j) { p0[j] = a8[j] * inv - bf1(sv[j]); p1[j] = a8[j + 4] * inv - bf1(sv[j + 4]); }
        pb[ks] = __builtin_bit_cast(bf16x8, pg8::pack8(p0, p1));
    }
    bf16* yp = ypool + (size_t)tok * 512 + g * 128 + 4 * hi;
    const bf16* wb = pwT + (size_t)(g * 128 + q) * 128 + 8 * hi;
#pragma unroll
    for (int mf = 0; mf < 8; ++mf) { f32x4 o = (f32x4){0.f, 0.f, 0.f, 0.f};
#pragma unroll
        for (int ks = 0; ks < 4; ++ks) o = mfma16(*(const bf16x8*)(wb + (size_t)(16 * mf) * 128 + 32 * ks), pb[ks], o);
        v2u w; w.x = pk2(o[0], o[1]); w.y = pk2(o[2], o[3]); *(v2u*)(yp + 16 * mf) = w; }
}

__device__ __forceinline__ int f2key(float s, int idx, int mask) { int b = __builtin_bit_cast(int, s); b = b >= 0 ? b : (b ^ 0x7fffffff); return (b & ~mask) | idx; }
__device__ __forceinline__ float key2f(int k) { k = k >= 0 ? k : (k ^ 0x7fffffff); return __builtin_bit_cast(float, k); }
#define INS16(L, x) do { int _x = (x); _Pragma("unroll") for (int _j = 0; _j < 16; ++_j) { const int _t = L[_j] > _x ? L[_j] : _x; _x = L[_j] > _x ? _x : L[_j]; L[_j] = _t; } } while (0)
__device__ __forceinline__ void topk_item(const bf16* __restrict__ qb, const bf16* __restrict__ keys, int* __restrict__ te, float* __restrict__ tw, LAS int* lscr, int tok0, int h, int lane) {
    const int q = lane & 15, hi = lane >> 4; const size_t tok = (size_t)tok0 + q;
    int L[2][16];
#pragma unroll
    for (int p = 0; p < 2; ++p) {
#pragma unroll
        for (int k = 0; k < 16; ++k) L[p][k] = (int)0x80000000;
        bf16x8 qf[4];
#pragma unroll
        for (int ks = 0; ks < 4; ++ks) qf[ks] = *(const bf16x8*)(qb + tok * 2048 + h * 256 + p * 128 + 32 * ks + 8 * hi);
        const bf16* kb = keys + (size_t)((h * 2 + p) * 128 + q) * 128 + 8 * hi;
#pragma unroll
        for (int mf = 0; mf < 8; ++mf) { f32x4 s = (f32x4){0.f, 0.f, 0.f, 0.f};
#pragma unroll
            for (int ks = 0; ks < 4; ++ks) s = mfma16(*(const bf16x8*)(kb + (size_t)(16 * mf) * 128 + 32 * ks), qf[ks], s);
#pragma unroll
            for (int g = 0; g < 4; ++g) INS16(L[p], f2key(s[g], 16 * mf + 4 * hi + g, 127)); }
#pragma unroll
        for (int step = 16; step <= 32; step <<= 1) { int tmp[16];
#pragma unroll
            for (int k = 0; k < 16; ++k) tmp[k] = L[p][k];
#pragma unroll
            for (int k = 0; k < 16; ++k) { const int o = __shfl_xor(tmp[k], step); INS16(L[p], o); } }
    }
    float v1[16], v2[16];
#pragma unroll
    for (int k = 0; k < 16; ++k) { v1[k] = key2f(L[0][k]); v2[k] = key2f(L[1][k]); }
    int Fk[16];
#pragma unroll
    for (int k = 0; k < 16; ++k) Fk[k] = (int)0x80000000;
#pragma unroll
    for (int i = 0; i < 16; ++i)
#pragma unroll
        for (int j = 0; j < 16; ++j) if ((i + 1) * (j + 1) <= 16) INS16(Fk, f2key(v1[i] + v2[j], (i << 4) | j, 255));
    LAS int* my = lscr + lane * 33;
#pragma unroll
    for (int k = 0; k < 16; ++k) { my[k] = L[0][k] & 127; my[16 + k] = L[1][k] & 127; }
    LDS_WAIT(); asm volatile("" ::: "memory");
    float e[16]; float sum = 0.f; const float mx = key2f(Fk[0]);
#pragma unroll
    for (int k = 0; k < 16; ++k) { e[k] = __expf(key2f(Fk[k]) - mx); sum += e[k]; }
    const float inv = 1.0f / sum;
    if (hi == 0) {
        int* tep = te + (tok * 8 + h) * 16; float* twp = tw + (tok * 8 + h) * 16;
#pragma unroll
        for (int k4 = 0; k4 < 4; ++k4) { int ev[4]; f32x4 wv;
#pragma unroll
            for (int k = 0; k < 4; ++k) { const int kk = 4 * k4 + k, i = (Fk[kk] >> 4) & 15, j = Fk[kk] & 15; ev[k] = my[i] * 128 + my[16 + j]; wv[k] = e[kk] * inv; }
            *(v4u*)(tep + 4 * k4) = (v4u){(unsigned)ev[0], (unsigned)ev[1], (unsigned)ev[2], (unsigned)ev[3]}; *(f32x4*)(twp + 4 * k4) = wv; }
    }
    LDS_WAIT(); asm volatile("" ::: "memory");
}

__device__ __forceinline__ float dot2bf(unsigned a, unsigned b, float c) { return __builtin_amdgcn_fdot2_f32_bf16(__builtin_bit_cast(bf16x2_t, a), __builtin_bit_cast(bf16x2_t, b), c, false); }
__device__ __forceinline__ void peer_token(const bf16* __restrict__ hb, const float* __restrict__ rowsq, const bf16* __restrict__ u16, const bf16* __restrict__ v16,
                                           const int* __restrict__ te, const float* __restrict__ tw, float* out, int tok, int lane) {
    const bf16* hp = hb + (size_t)tok * 1024 + 8 * lane;
    const v4u h0 = *(const v4u*)hp, h1 = *(const v4u*)(hp + 512);
    const float rstd = rsqrtf(rowsq[tok] * (1.0f / 1024.0f) + 1e-6f);
    float* op = out + (size_t)tok * 1024 + 8 * lane;
    f32x4 a0 = *(const f32x4*)op, a1 = *(const f32x4*)(op + 4), a2 = *(const f32x4*)(op + 512), a3 = *(const f32x4*)(op + 516);
    for (int hd = 0; hd < 8; ++hd) {
        const int my_e = te[(size_t)tok * 128 + hd * 16 + (lane & 15)];
        const float my_g = tw[(size_t)tok * 128 + hd * 16 + ((lane >> 2) & 15)];
        float p[16];
#pragma unroll
        for (int k = 0; k < 16; ++k) { const int e = __builtin_amdgcn_readlane(my_e, k); const bf16* ur = u16 + (size_t)e * 1024 + 8 * lane;
            const v4u u0 = *(const v4u*)ur, u1 = *(const v4u*)(ur + 512);
            float d = 0.f; d = dot2bf(h0.x, u0.x, d); d = dot2bf(h0.y, u0.y, d); d = dot2bf(h0.z, u0.z, d); d = dot2bf(h0.w, u0.w, d);
            d = dot2bf(h1.x, u1.x, d); d = dot2bf(h1.y, u1.y, d); d = dot2bf(h1.z, u1.z, d); d = dot2bf(h1.w, u1.w, d); p[k] = d; }
        float q8[8], q4[4], q2[2], q1;
#pragma unroll
        for (int i = 0; i < 8; ++i) { const bool up = (lane & 32) != 0; const float keep = up ? p[i + 8] : p[i], send = up ? p[i] : p[i + 8]; q8[i] = keep + __shfl_xor(send, 32); }
#pragma unroll
        for (int i = 0; i < 4; ++i) { const bool up = (lane & 16) != 0; const float keep = up ? q8[i + 4] : q8[i], send = up ? q8[i] : q8[i + 4]; q4[i] = keep + __shfl_xor(send, 16); }
#pragma unroll
        for (int i = 0; i < 2; ++i) { const bool up = (lane & 8) != 0; const float keep = up ? q4[i + 2] : q4[i], send = up ? q4[i] : q4[i + 2]; q2[i] = keep + __shfl_xor(send, 8); }
        { const bool up = (lane & 4) != 0; const float keep = up ? q2[1] : q2[0], send = up ? q2[0] : q2[1]; q1 = keep + __shfl_xor(send, 4); }
        q1 += __shfl_xor(q1, 2); q1 += __shfl_xor(q1, 1);
        const float z = q1 * rstd;
        const float wgt = my_g * 0.5f * z * (1.0f + erff(z * 0.70710678118654752f));
#pragma unroll
        for (int k = 0; k < 16; ++k) { const int e = __builtin_amdgcn_readlane(my_e, k); const float wk = __builtin_bit_cast(float, __builtin_amdgcn_readlane(__builtin_bit_cast(int, wgt), 4 * k));
            const bf16* vr = v16 + (size_t)e * 1024 + 8 * lane; const v4u v0 = *(const v4u*)vr, v1 = *(const v4u*)(vr + 512);
            a0[0] += wk * bflo(v0.x); a0[1] += wk * bfhi(v0.x); a0[2] += wk * bflo(v0.y); a0[3] += wk * bfhi(v0.y);
            a1[0] += wk * bflo(v0.z); a1[1] += wk * bfhi(v0.z); a1[2] += wk * bflo(v0.w); a1[3] += wk * bfhi(v0.w);
            a2[0] += wk * bflo(v1.x); a2[1] += wk * bfhi(v1.x); a2[2] += wk * bflo(v1.y); a2[3] += wk * bfhi(v1.y);
            a3[0] += wk * bflo(v1.z); a3[1] += wk * bfhi(v1.z); a3[2] += wk * bflo(v1.w); a3[3] += wk * bfhi(v1.w); }
    }
    *(f32x4*)op = a0; *(f32x4*)(op + 4) = a1; *(f32x4*)(op + 512) = a2; *(f32x4*)(op + 516) = a3;
}

__global__ void __launch_bounds__(NWAVES * 64, 2) mk_fwd(Args args) {
    extern __shared__ __attribute__((aligned(16))) unsigned char lds[];
    Frame F;
    F.lds = (LAS unsigned char*)lds;
    F.MISC = (volatile LAS unsigned*)(F.lds + MISC_OFF);
    F.tid = threadIdx.x; F.lane = F.tid & 63; F.wave = __builtin_amdgcn_readfirstlane(F.tid >> 6);
    F.G = gridDim.x; { const int bx = blockIdx.x; F.vcu = (F.G % 8 == 0) ? (bx % 8) * (F.G / 8) + bx / 8 : bx; }
    F.out = args.out; F.ws = args.ws;
    unsigned char* ws = args.ws;
    F.ctl = (gu32*)(ws + WS_CTL);
    for (int u = F.tid; u < (LDS_BYTES - LDSCTL_OFF) / 4; u += NWAVES * 64) ((LAS unsigned*)(F.lds + LDSCTL_OFF))[u] = 0u;
    __syncthreads();
    XcdBarrier bar; bar.bar = (unsigned*)(F.ctl + CW_BAR); bar.x = 0; bar.st = nullptr;
    if (N_LAUNCHES != PER_PHASE) bar = xcd_barrier_post((unsigned*)(F.ctl + CW_BAR), F.MISC + 8);
#define GRID_BAR() do { if (N_LAUNCHES != PER_PHASE) xcd_barrier(bar); } while (0)
    const int lo = args.ph_lo, hi = args.ph_hi;
#define IN(k) (lo <= (k) && (k) < hi)
#define BOTH(k) (IN(k) && IN((k) + 1))
    const int gw = F.vcu * NWAVES + F.wave, NGW = F.G * NWAVES;
    bf16* const WinT = (bf16*)(ws + WS_WIN); bf16* const WvT = (bf16*)(ws + WS_WV); bf16* const WkvT = (bf16*)(ws + WS_WKV); bf16* const WbrT = (bf16*)(ws + WS_WBR);
    bf16* const WoutT = (bf16*)(ws + WS_WOUT); bf16* const WqT = (bf16*)(ws + WS_WQ); bf16* const KEYS = (bf16*)(ws + WS_KEYS); bf16* const PWT = (bf16*)(ws + WS_PWT);
    bf16* const MEMN = (bf16*)(ws + WS_MEMN); bf16* const KMEM = (bf16*)(ws + WS_KMEM); bf16* const VTMEM = (bf16*)(ws + WS_VTMEM); float* const RSTDX = (float*)(ws + WS_RSTDX);
    bf16* const U16 = (bf16*)(ws + WS_U16); bf16* const V16 = (bf16*)(ws + WS_V16);
    bf16* const QN = (bf16*)(ws + WS_QN); bf16* const KN = (bf16*)(ws + WS_KN); bf16* const VT = (bf16*)(ws + WS_VT); bf16* const PP = (bf16*)(ws + WS_PP); bf16* const XQ = (bf16*)(ws + WS_XQ);
    bf16* const GATE = (bf16*)(ws + WS_GATE); bf16* const MERGED = (bf16*)(ws + WS_MERGED); bf16* const HB = (bf16*)(ws + WS_HB); bf16* const QB = (bf16*)(ws + WS_QB);
    int* const TE = (int*)(ws + WS_TE); float* const TW = (float*)(ws + WS_TW); float* const ROWSQ = (float*)(ws + WS_ROWSQ);
    bf16* const XB = (bf16*)((unsigned char*)args.out + OUT_XB); bf16* const YNA = (bf16*)((unsigned char*)args.out + OUT_YNA);
    bf16* const YPOOL = (bf16*)((unsigned char*)args.out + OUT_YPOOL); bf16* const YXA = (bf16*)((unsigned char*)args.out + OUT_YXA);

    if (IN(0)) { p0_prologue(F, args); if (BOTH(0)) GRID_BAR(); }

    if (IN(1)) {
        { pg8::Sched1 S; S.so.init(T, IN_MAIN, F.G, (int)blockIdx.x); S.A = (const char*)XB; S.Bt = (const char*)WinT; S.tstep = (size_t)256 * 1024 * 2;
          pg8::EpiProj E{RSTDX, QN, KN, PP, XQ, GATE, args.in[I_NAQG], args.in[I_NAKG], args.in[I_GATEB]};
          pg8::gemm_phase<pg8::EpiProj, pg8::Sched1, true, true>(F.lds + RING_OFF, 1024, S, E); }
        { pg8::Sched1 S; S.so.init(512, T, F.G, (int)blockIdx.x); S.A = (const char*)WvT; S.Bt = (const char*)XB; S.tstep = (size_t)256 * 1024 * 2;
          pg8::EpiVt E{RSTDX, VT};
          pg8::gemm_phase<pg8::EpiVt, pg8::Sched1, false, true>(F.lds + RING_OFF, 1024, S, E); }
        for (int t = gw; t < 512; t += NGW) memkv_tile(MEMN, WkvT, args.in[I_XAKG], args.in[I_XAQG], KMEM, VTMEM, t, F.lane);
        if (BOTH(1)) GRID_BAR();
    }

    if (IN(2)) {
        for (int i = F.vcu; i < 256; i += F.G)
            for (int k = 0; k < 8; ++k) { const int idx = i * 8 + k, b = idx >> 9, r = (idx >> 2) & 127, jb = idx & 3; na_item(QN, KN, VT, args.in[I_RPB], YNA, b, r, jb, F.wave, F.lane); }
        for (int it = gw; it < 8192; it += NGW) pool_item(PP, PWT, YPOOL, (it >> 2) * 16, it & 3, F.lane);
        for (int it = gw; it < 8192; it += NGW) xa_item(XQ, KMEM, VTMEM, YXA, (it >> 2) * 16, it & 3, F.lane);
        if (BOTH(2)) GRID_BAR();
    }

    if (IN(3)) {
        pg8::Sched3 S; S.so.init(T, D, F.G, (int)blockIdx.x); S.A = (const char*)YNA; S.Bt = (const char*)WbrT; S.tstep = (size_t)256 * 512 * 2; S.strideA = 32 * MiB; S.strideB = (size_t)1024 * 512 * 2;
        pg8::EpiMerge E{GATE, (bf16*)(ws + WS_VT)  , MERGED};
        pg8::gemm_phase<pg8::EpiMerge, pg8::Sched3, true, true>(F.lds + RING_OFF, 512, S, E);
        if (BOTH(3)) GRID_BAR();
    }

    if (IN(4)) {
        pg8::Sched1 S; S.so.init(T, D, F.G, (int)blockIdx.x); S.A = (const char*)MERGED; S.Bt = (const char*)WoutT; S.tstep = (size_t)256 * 1024 * 2;
        pg8::EpiH E{args.in[I_X], F.out, HB, ROWSQ};
        pg8::gemm_phase<pg8::EpiH, pg8::Sched1, true, true>(F.lds + RING_OFF, 1024, S, E);
        if (BOTH(4)) GRID_BAR();
    }

    if (IN(5)) {
        pg8::Sched1 S; S.so.init(T, 2048, F.G, (int)blockIdx.x); S.A = (const char*)HB; S.Bt = (const char*)WqT; S.tstep = (size_t)256 * 1024 * 2;
        pg8::EpiQ E{ROWSQ, QB};
        pg8::gemm_phase<pg8::EpiQ, pg8::Sched1, true, true>(F.lds + RING_OFF, 1024, S, E);
        if (BOTH(5)) GRID_BAR();
    }

    if (IN(6)) {
        LAS int* lscr = (LAS int*)(F.lds + RING_OFF + F.wave * 16384);
        for (int it = gw; it < 16384; it += NGW) topk_item(QB, KEYS, TE, TW, lscr, (it >> 3) * 16, it & 7, F.lane);
        if (BOTH(6)) GRID_BAR();
    }

    if (IN(7)) {
        for (int tok = gw; tok < T; tok += NGW) peer_token(HB, ROWSQ, U16, V16, TE, TW, F.out, tok, F.lane);
    }
#undef IN
#undef BOTH
#undef GRID_BAR
}

extern "C" void kernel_launch(void* const* d_in, const int* in_sizes, int n_in, void* d_out, int out_size, void* d_ws, size_t ws_size, hipStream_t stream) {
    static int grid = 0;
    if (grid == 0) {
        if (n_in != 23 || in_sizes[0] != T * D || out_size != T * D || ws_size < WS_END) { fprintf(stderr, "kernel_launch: unexpected shapes: n_in %d in0 %d out %d ws %zu\n", n_in, n_in > 0 ? in_sizes[0] : -1, out_size, ws_size); grid = -1; return; }
        int dev = 0, cus = 0, per_cu = 0;
        if (hipGetDevice(&dev) != hipSuccess || hipDeviceGetAttribute(&cus, hipDeviceAttributeMultiprocessorCount, dev) != hipSuccess) { fprintf(stderr, "kernel_launch: device query failed\n"); grid = -1; return; }
        if (hipFuncSetAttribute((const void*)mk_fwd, hipFuncAttributeMaxDynamicSharedMemorySize, LDS_BYTES) != hipSuccess) { fprintf(stderr, "kernel_launch: hipFuncSetAttribute failed\n"); grid = -1; return; }
        if (hipOccupancyMaxActiveBlocksPerMultiprocessor(&per_cu, (const void*)mk_fwd, NWAVES * 64, LDS_BYTES) != hipSuccess || per_cu < 1)
            fprintf(stderr, "kernel_launch: note: occupancy query reports %d workgroups per CU\n", per_cu);
        (void)hipGetLastError();
        grid = cus;
    }
    if (grid < 0) return;
    if (hipMemsetAsync((char*)d_ws + WS_CTL, 0, CTL_ZERO_BYTES, stream) != hipSuccess) { fprintf(stderr, "kernel_launch: memset failed\n"); return; }
    Args a{};
    for (int i = 0; i < 23; ++i) a.in[i] = (const float*)d_in[i];
    a.out = (float*)d_out; a.ws = (unsigned char*)d_ws;
    for (int li = 0; li < N_LAUNCHES; ++li) {
        a.ph_lo = (N_LAUNCHES == PER_PHASE) ? li : 0; a.ph_hi = (N_LAUNCHES == PER_PHASE) ? li + 1 : PER_PHASE;
        hipLaunchKernelGGL(mk_fwd, dim3(grid), dim3(NWAVES * 64), LDS_BYTES, stream, a);
        const hipError_t le = hipPeekAtLastError();
        if (le != hipSuccess) { fprintf(stderr, "kernel_launch: launch %d failed: %s\n", li, hipGetErrorName(le)); break; }
    }
}
```

```cpp
#define MK_N_LAUNCHES 1
#include <hip/hip_runtime.h>
#include <cstdio>
#include <cstdint>

#ifndef MK_N_LAUNCHES
#define MK_N_LAUNCHES 1
#endif

namespace pg8 {
#define PG8_LAS __attribute__((address_space(3)))
typedef unsigned short bf16_t;
typedef short bf16x8 __attribute__((ext_vector_type(8)));
typedef float f32x4 __attribute__((ext_vector_type(4)));
typedef unsigned u32x4 __attribute__((ext_vector_type(4)));
typedef unsigned u32x2 __attribute__((ext_vector_type(2)));
constexpr int BM = 256, BK = 64, HALF = 128, HTB = HALF * BK * 2  , STAGE_BYTES = 8 * HTB, NXCD = 8, WGM = 8;

__host__ __device__ __forceinline__ int lds_byte(int r, int c) { const int st = (r >> 4) * 2 + (c >> 5), rr = r & 15, cc = c & 31, ob = rr * 64 + cc * 2; return st * 1024 + (ob ^ (((ob >> 9) & 1) << 5)); }
__host__ __device__ __forceinline__ void stage_rc(int b, int& R, int& C) { const int st = b / 1024, sb = b % 1024, swz = sb ^ (((sb >> 9) & 1) << 5); R = (st >> 1) * 16 + swz / 64; C = (st & 1) * 32 + (swz % 64) / 2; }
__host__ __device__ __forceinline__ int perm32(int rho) { const int n = rho >> 4, i = rho & 15; return 8 * (i >> 2) + 4 * n + (i & 3); }

struct Unit { int pm, pn, br; };

struct StaticOrder {
    int nM, nN, nwg, G, c;
    __host__ __device__ void init(int M, int N, int G_, int c_) { nM = M / BM; nN = N / BM; nwg = nM * nN; G = G_; c = c_; }
    __host__ __device__ bool next(int i, Unit& u) const {
        const long L = (long)i * G + c; if (L >= nwg) return false;
        int wgid = (int)L; { const int q = nwg / NXCD, r = nwg % NXCD, xcd = wgid % NXCD, off = wgid / NXCD; wgid = (xcd < r ? xcd * (q + 1) : r * (q + 1) + (xcd - r) * q) + off; }
        const int nig = WGM * nN, gid = wgid / nig, fm = gid * WGM, gsz = (nM - fm) < WGM ? (nM - fm) : WGM;
        u.pm = fm + ((wgid % nig) % gsz); u.pn = (wgid % nig) / gsz; return true;
    }
};
struct Sched1 {
    StaticOrder so; const char* A; const char* Bt; size_t tstep;
    __device__ __forceinline__ bool next(int i, Unit& u) const { u.br = 0; return so.next(i, u); }
    __device__ __forceinline__ const char* abase(const Unit& u) const { return A + (size_t)u.pm * tstep; }
    __device__ __forceinline__ const char* bbase(const Unit& u) const { return Bt + (size_t)u.pn * tstep; }
    __device__ __forceinline__ void a_ready(const Unit&) const {}
    __device__ __forceinline__ void done(const Unit&) const {}
};
struct Sched3 {
    StaticOrder so; const char* A; const char* Bt; size_t tstep, strideA, strideB;
    __device__ __forceinline__ bool next(int i, Unit& u) const { u.br = i % 3; return so.next(i / 3, u); }
    __device__ __forceinline__ const char* abase(const Unit& u) const { return A + (size_t)u.br * strideA + (size_t)u.pm * tstep; }
    __device__ __forceinline__ const char* bbase(const Unit& u) const { return Bt + (size_t)u.br * strideB + (size_t)u.pn * tstep; }
    __device__ __forceinline__ void a_ready(const Unit&) const {}
    __device__ __forceinline__ void done(const Unit&) const {}
};

typedef float f32x2_t __attribute__((ext_vector_type(2))); typedef __bf16 bf16x2v_t __attribute__((ext_vector_type(2)));
__device__ __forceinline__ unsigned cvt_pk_bf16(float lo, float hi) { const f32x2_t v = {lo, hi}; const bf16x2v_t b = __builtin_convertvector(v, bf16x2v_t); return __builtin_bit_cast(unsigned, b); }
__device__ __forceinline__ u32x4 pack8(const f32x4 a, const f32x4 b) { u32x4 w; w.x = cvt_pk_bf16(a[0], a[1]); w.y = cvt_pk_bf16(a[2], a[3]); w.z = cvt_pk_bf16(b[0], b[1]); w.w = cvt_pk_bf16(b[2], b[3]); return w; }
__device__ __forceinline__ float bflo(unsigned u) { return __builtin_bit_cast(float, u << 16); }
__device__ __forceinline__ float bfhi(unsigned u) { return __builtin_bit_cast(float, u & 0xffff0000u); }


constexpr float RMS_EPS = 1e-6f;

struct EpiProj {
    static constexpr bool PERM = true, AFTER_DRAIN = false;
    const float* rstd; bf16_t *qn, *kn, *pp, *xq, *gates; const float *qg, *kg, *gate_b;
    __device__ __forceinline__ void operator()(const f32x4 (&acc)[2][2][4][2], const Unit& u, int wr, int wc, int fr, int fq) const {
        const int pn = u.pn, row0 = u.pm * BM + wr * 64 + fr, lc0 = 64 * wc + 8 * fq;
        if (pn < 4) {
            const bool isq = pn < 2; bf16_t* O = isq ? qn : kn; const float* g = isq ? qg : kg; const float post = isq ? 0.125f : 1.0f;
            f32x4 gv[2][2];
#pragma unroll
            for (int bj = 0; bj < 2; ++bj)
#pragma unroll
                for (int n = 0; n < 2; ++n) gv[bj][n] = *(const f32x4*)(g + 32 * bj + 8 * fq + 4 * n);
            const int colbase = (pn & 1) * 256 + lc0;
#pragma unroll
            for (int ai = 0; ai < 2; ++ai)
#pragma unroll
                for (int m = 0; m < 4; ++m) {
                    const int row = row0 + ai * HALF + m * 16; const float rs = rstd[row];
                    f32x4 v[2][2]; float ss = 0.f;
#pragma unroll
                    for (int bj = 0; bj < 2; ++bj)
#pragma unroll
                        for (int n = 0; n < 2; ++n) { v[bj][n] = acc[ai][bj][m][n] * rs; ss += (v[bj][n][0] * v[bj][n][0] + v[bj][n][1] * v[bj][n][1]) + (v[bj][n][2] * v[bj][n][2] + v[bj][n][3] * v[bj][n][3]); }
                    ss += __shfl_xor(ss, 16); ss += __shfl_xor(ss, 32);
                    const float r = rsqrtf(ss * (1.0f / 64.0f) + RMS_EPS) * post;
#pragma unroll
                    for (int bj = 0; bj < 2; ++bj) *(u32x4*)(O + (size_t)row * 512 + colbase + 32 * bj) = pack8(v[bj][0] * r * gv[bj][0], v[bj][1] * r * gv[bj][1]);
                }
        } else if (pn < 8) {
            bf16_t* O = pn < 6 ? pp : xq; const int colbase = (pn & 1) * 256 + lc0;
#pragma unroll
            for (int ai = 0; ai < 2; ++ai)
#pragma unroll
                for (int m = 0; m < 4; ++m) {
                    const int row = row0 + ai * HALF + m * 16; const float rs = rstd[row];
#pragma unroll
                    for (int bj = 0; bj < 2; ++bj) *(u32x4*)(O + (size_t)row * 512 + colbase + 32 * bj) = pack8(acc[ai][bj][m][0] * rs, acc[ai][bj][m][1] * rs);
                }
        } else {
            const int gcol0 = (pn - 8) * 256 + lc0;
            f32x4 bv[2][2];
#pragma unroll
            for (int bj = 0; bj < 2; ++bj)
#pragma unroll
                for (int n = 0; n < 2; ++n) bv[bj][n] = *(const f32x4*)(gate_b + gcol0 + 32 * bj + 4 * n);
#pragma unroll
            for (int ai = 0; ai < 2; ++ai)
#pragma unroll
                for (int m = 0; m < 4; ++m) {
                    const int row = row0 + ai * HALF + m * 16; const float rs = rstd[row];
#pragma unroll
                    for (int bj = 0; bj < 2; ++bj) {
                        f32x4 o[2];
#pragma unroll
                        for (int n = 0; n < 2; ++n) { const f32x4 z = acc[ai][bj][m][n] * rs + bv[bj][n];
#pragma unroll
                            for (int i = 0; i < 4; ++i) o[n][i] = __builtin_amdgcn_rcpf(1.0f + __expf(-z[i])); }
                        *(u32x4*)(gates + (size_t)row * 3072 + gcol0 + 32 * bj) = pack8(o[0], o[1]);
                    }
                }
        }
    }
};
struct EpiVt {
    static constexpr bool PERM = true, AFTER_DRAIN = false;
    const float* rstd; bf16_t* Vt;
    __device__ __forceinline__ void operator()(const f32x4 (&acc)[2][2][4][2], const Unit& u, int wr, int wc, int fr, int fq) const {
        const int ch0 = u.pm * BM + wr * 64 + fr, tok0 = u.pn * BM + wc * 32 + 8 * fq, b = tok0 >> 13, t0 = tok0 & 8191;
        f32x4 rv[2][2];
#pragma unroll
        for (int bj = 0; bj < 2; ++bj)
#pragma unroll
            for (int n = 0; n < 2; ++n) rv[bj][n] = *(const f32x4*)(rstd + tok0 + bj * HALF + 4 * n);
#pragma unroll
        for (int ai = 0; ai < 2; ++ai)
#pragma unroll
            for (int m = 0; m < 4; ++m) { const int ch = ch0 + ai * HALF + m * 16; bf16_t* rowp = Vt + ((size_t)(b * 512 + ch) * 8192 + t0);
#pragma unroll
                for (int bj = 0; bj < 2; ++bj) *(u32x4*)(rowp + bj * HALF) = pack8(acc[ai][bj][m][0] * rv[bj][0], acc[ai][bj][m][1] * rv[bj][1]); }
    }
};
struct EpiMerge {
    static constexpr bool PERM = true, AFTER_DRAIN = false;
    const bf16_t* gates; bf16_t* pa; bf16_t* merged;
    __device__ __forceinline__ void operator()(const f32x4 (&acc)[2][2][4][2], const Unit& u, int wr, int wc, int fr, int fq) const {
        const int row0 = u.pm * BM + wr * 64 + fr, col0 = u.pn * BM + wc * 32 + 8 * fq, br = u.br;
        const bf16_t* src = br == 1 ? pa : merged; bf16_t* dst = br == 0 ? pa : merged;
#pragma unroll
        for (int ai = 0; ai < 2; ++ai)
#pragma unroll
            for (int m = 0; m < 4; ++m) { const int row = row0 + ai * HALF + m * 16;
#pragma unroll
                for (int bj = 0; bj < 2; ++bj) {
                    const u32x4 g8 = *(const u32x4*)(gates + (size_t)row * 3072 + br * 1024 + col0 + bj * HALF);
                    const size_t mo = (size_t)row * 1024 + col0 + bj * HALF;
                    f32x4 a = acc[ai][bj][m][0], b = acc[ai][bj][m][1];
                    a[0] *= bflo(g8.x); a[1] *= bfhi(g8.x); a[2] *= bflo(g8.y); a[3] *= bfhi(g8.y); b[0] *= bflo(g8.z); b[1] *= bfhi(g8.z); b[2] *= bflo(g8.w); b[3] *= bfhi(g8.w);
                    if (br > 0) { const u32x4 p8 = *(const u32x4*)(src + mo);
                        a[0] += bflo(p8.x); a[1] += bfhi(p8.x); a[2] += bflo(p8.y); a[3] += bfhi(p8.y); b[0] += bflo(p8.z); b[1] += bfhi(p8.z); b[2] += bflo(p8.w); b[3] += bfhi(p8.w); }
                    *(u32x4*)(dst + mo) = pack8(a, b);
                } }
    }
};
struct EpiH {
    static constexpr bool PERM = true, AFTER_DRAIN = false;
    const float* x; float* out; bf16_t* hb; float* rowsq;
    __device__ __forceinline__ void operator()(const f32x4 (&acc)[2][2][4][2], const Unit& u, int wr, int wc, int fr, int fq) const {
        const int row0 = u.pm * BM + wr * 64 + fr, col0 = u.pn * BM + wc * 32 + 8 * fq;
#pragma unroll
        for (int ai = 0; ai < 2; ++ai)
#pragma unroll
            for (int m = 0; m < 4; ++m) { const int row = row0 + ai * HALF + m * 16; float ss = 0.f;
#pragma unroll
                for (int bj = 0; bj < 2; ++bj) { const size_t o = (size_t)row * 1024 + col0 + bj * HALF;
                    const f32x4 h0 = *(const f32x4*)(x + o) + acc[ai][bj][m][0], h1 = *(const f32x4*)(x + o + 4) + acc[ai][bj][m][1];
                    *(f32x4*)(out + o) = h0; *(f32x4*)(out + o + 4) = h1; *(u32x4*)(hb + o) = pack8(h0, h1);
                    ss += (h0[0] * h0[0] + h0[1] * h0[1]) + (h0[2] * h0[2] + h0[3] * h0[3]) + (h1[0] * h1[0] + h1[1] * h1[1]) + (h1[2] * h1[2] + h1[3] * h1[3]); }
                ss += __shfl_xor(ss, 16); ss += __shfl_xor(ss, 32);
                if (fq == 0) atomicAdd(rowsq + row, ss); }
    }
};
struct EpiQ {
    static constexpr bool PERM = true, AFTER_DRAIN = false;
    const float* rowsq; bf16_t* qb;
    __device__ __forceinline__ void operator()(const f32x4 (&acc)[2][2][4][2], const Unit& u, int wr, int wc, int fr, int fq) const {
        const int row0 = u.pm * BM + wr * 64 + fr, col0 = u.pn * BM + wc * 32 + 8 * fq;
#pragma unroll
        for (int ai = 0; ai < 2; ++ai)
#pragma unroll
            for (int m = 0; m < 4; ++m) { const int row = row0 + ai * HALF + m * 16; const float r = rsqrtf(rowsq[row] * (1.0f / 1024.0f) + RMS_EPS);
#pragma unroll
                for (int bj = 0; bj < 2; ++bj) *(u32x4*)(qb + (size_t)row * 2048 + col0 + bj * HALF) = pack8(acc[ai][bj][m][0] * r, acc[ai][bj][m][1] * r); }
    }
};

template <class Epi, class Sched, bool ALIGN_EPI = false, bool SP2 = false>
__device__ __forceinline__ void gemm_phase(PG8_LAS unsigned char* lds, const int K, const Sched& S, const Epi& E) {
    const int tid = threadIdx.x, wid = __builtin_amdgcn_readfirstlane(tid >> 6), lane = tid & 63, wr = wid >> 2, wc = wid & 3, fr = lane & 15, fq = lane >> 4;
    const int nt = K / BK;
    unsigned voffA[2], voffB[2];
#pragma unroll
    for (int i = 0; i < 2; ++i) { int R, C; stage_rc(tid * 16 + i * 8192, R, C); const int Rb = Epi::PERM ? ((R & ~31) + perm32(R & 31)) : R;
        voffA[i] = (unsigned)(R * K + C) * 2u; voffB[i] = (unsigned)(Rb * K + C) * 2u; }
    const size_t kstep = (size_t)(BK * 2);
    const size_t hstep = (size_t)HALF * K * 2;
    const size_t tstep = 2 * hstep;
    const unsigned ldsw = (unsigned)wid * 1024u;
    const int aoff = lds_byte(wr * 64 + fr, fq * 8), boff = lds_byte(wc * 32 + fr, fq * 8);
#define PG8_SA(b, h) (((b) * 2 + (h)) * HTB)
#define PG8_SB(b, h) ((4 + (b) * 2 + (h)) * HTB)
#define PG8_STAGE(bufoff, gbase, voff) do { _Pragma("unroll") for (int _i = 0; _i < 2; ++_i) \
        __builtin_amdgcn_global_load_lds((const unsigned*)((const char*)(gbase) + (voff)[_i]), (PG8_LAS unsigned*)(lds + (bufoff) + ldsw + _i * 8192), 16, 0, 0); } while (0)
#define PG8_LDA(dst, b, h) do { _Pragma("unroll") for (int m = 0; m < 4; ++m) _Pragma("unroll") for (int k = 0; k < 2; ++k) dst[m][k] = *(const PG8_LAS bf16x8*)(lds + PG8_SA(b, h) + aoff + m * 2048 + k * 1024); } while (0)
#define PG8_LDB(dst, b, h) do { _Pragma("unroll") for (int n = 0; n < 2; ++n) _Pragma("unroll") for (int k = 0; k < 2; ++k) dst[n][k] = *(const PG8_LAS bf16x8*)(lds + PG8_SB(b, h) + boff + n * 2048 + k * 1024); } while (0)
#define PG8_MMA(ai, bj, At, Bt) do { __builtin_amdgcn_s_setprio(1); _Pragma("unroll") for (int m = 0; m < 4; ++m) _Pragma("unroll") for (int n = 0; n < 2; ++n) _Pragma("unroll") for (int k = 0; k < 2; ++k) \
        acc[ai][bj][m][n] = __builtin_amdgcn_mfma_f32_16x16x32_bf16(Bt[n][k], At[m][k], acc[ai][bj][m][n], 0, 0, 0); __builtin_amdgcn_s_setprio(0); } while (0)
#define PG8_WAIT_V(n) asm volatile("s_waitcnt vmcnt(" #n ")" ::: "memory")
#define PG8_WAIT_L(n) asm volatile("s_waitcnt lgkmcnt(" #n ")" ::: "memory")
#define PG8_BAR __builtin_amdgcn_s_barrier()
#define PG8_SCHED __builtin_amdgcn_sched_barrier(0)
    Unit cur, nxt; int ui = 0;
    if (!S.next(0, cur)) return;
    f32x4 acc[2][2][4][2];
#pragma unroll
    for (int a = 0; a < 2; ++a)
#pragma unroll
        for (int b = 0; b < 2; ++b)
#pragma unroll
            for (int m = 0; m < 4; ++m)
#pragma unroll
                for (int n = 0; n < 2; ++n) acc[a][b][m][n] = (f32x4){0.f, 0.f, 0.f, 0.f};
    bf16x8 At[4][2], B0[2][2], B1[2][2];
    const char* cA = S.abase(cur); const char* cB = S.bbase(cur);
    S.a_ready(cur);
    if constexpr (SP2) {
        PG8_STAGE(PG8_SB(0, 0), cB, voffB); PG8_STAGE(PG8_SB(0, 1), cB + hstep, voffB); PG8_STAGE(PG8_SA(0, 0), cA, voffA); PG8_STAGE(PG8_SA(0, 1), cA + hstep, voffA);
        if (wr == 1) PG8_BAR;
        PG8_WAIT_V(2); PG8_BAR;
        PG8_STAGE(PG8_SB(1, 0), cB + kstep, voffB); PG8_STAGE(PG8_SA(1, 0), cA + kstep, voffA); PG8_STAGE(PG8_SB(1, 1), cB + hstep + kstep, voffB);
        PG8_WAIT_V(6); PG8_BAR;
    } else {
        PG8_STAGE(PG8_SB(0, 0), cB, voffB); PG8_STAGE(PG8_SA(0, 0), cA, voffA); PG8_STAGE(PG8_SB(0, 1), cB + hstep, voffB); PG8_STAGE(PG8_SA(0, 1), cA + hstep, voffA);
        if (wr == 1) PG8_BAR;
        PG8_WAIT_V(4); PG8_BAR;
        PG8_STAGE(PG8_SB(1, 0), cB + kstep, voffB); PG8_STAGE(PG8_SA(1, 0), cA + kstep, voffA); PG8_STAGE(PG8_SB(1, 1), cB + hstep + kstep, voffB);
        PG8_WAIT_V(6); PG8_BAR;
    }
    for (;;) {
        const bool has_next = S.next(ui + 1, nxt);
        const char* nA = has_next ? S.abase(nxt) : cA; const char* nB = has_next ? S.bbase(nxt) : cB;
        for (int t = 0; t < nt; t += 2) {
            const bool last = (t == nt - 2);
            const char* a1 = cA + (size_t)(t + 1) * kstep;
            const char* a2 = last ? nA : cA + (size_t)(t + 2) * kstep; const char* b2 = last ? nB : cB + (size_t)(t + 2) * kstep;
            const char* a3 = a2 + kstep; const char* b3 = b2 + kstep;
            if (last && has_next) S.a_ready(nxt);
            if constexpr (SP2) {
            PG8_LDB(B0, 0, 0); PG8_LDB(B1, 0, 1); PG8_SCHED; PG8_LDA(At, 0, 0); PG8_STAGE(PG8_SA(1, 1), a1 + hstep, voffA);
            PG8_WAIT_V(8); PG8_WAIT_L(0); PG8_BAR; PG8_MMA(0, 0, At, B0); PG8_MMA(0, 1, At, B1); PG8_BAR; PG8_SCHED;
            PG8_LDA(At, 0, 1); PG8_STAGE(PG8_SB(0, 0), b2, voffB); PG8_STAGE(PG8_SB(0, 1), b2 + hstep, voffB); PG8_STAGE(PG8_SA(0, 0), a2, voffA);
            PG8_WAIT_V(8); PG8_WAIT_L(0); PG8_BAR; PG8_MMA(1, 0, At, B0); PG8_MMA(1, 1, At, B1); PG8_BAR; PG8_SCHED;
            PG8_LDB(B0, 1, 0); PG8_LDB(B1, 1, 1); PG8_SCHED; PG8_LDA(At, 1, 0); PG8_STAGE(PG8_SA(0, 1), a2 + hstep, voffA);
            PG8_WAIT_V(8); PG8_WAIT_L(0); PG8_BAR; PG8_MMA(0, 0, At, B0); PG8_MMA(0, 1, At, B1); PG8_BAR; PG8_SCHED;
            PG8_LDA(At, 1, 1); PG8_STAGE(PG8_SB(1, 0), b3, voffB); PG8_STAGE(PG8_SB(1, 1), b3 + hstep, voffB); PG8_STAGE(PG8_SA(1, 0), a3, voffA);
            PG8_WAIT_V(8); PG8_WAIT_L(0); PG8_BAR; PG8_MMA(1, 0, At, B0); PG8_MMA(1, 1, At, B1); PG8_BAR; PG8_SCHED;
            } else {
            PG8_LDB(B0, 0, 0); PG8_SCHED; PG8_LDA(At, 0, 0); PG8_STAGE(PG8_SA(1, 1), a1 + hstep, voffA);
            PG8_WAIT_L(8); PG8_BAR; PG8_WAIT_L(0); PG8_MMA(0, 0, At, B0); PG8_BAR; PG8_SCHED;
            PG8_LDB(B1, 0, 1); PG8_STAGE(PG8_SB(0, 0), b2, voffB);
            PG8_BAR; PG8_WAIT_L(0); PG8_MMA(0, 1, At, B1); PG8_BAR;
            PG8_LDA(At, 0, 1); PG8_STAGE(PG8_SA(0, 0), a2, voffA);
            PG8_BAR; PG8_WAIT_L(0); PG8_MMA(1, 0, At, B0); PG8_BAR; PG8_SCHED;
            PG8_STAGE(PG8_SB(0, 1), b2 + hstep, voffB);
            PG8_WAIT_V(6); PG8_BAR; PG8_MMA(1, 1, At, B1); PG8_BAR;
            PG8_LDB(B0, 1, 0); PG8_SCHED; PG8_LDA(At, 1, 0); PG8_STAGE(PG8_SA(0, 1), a2 + hstep, voffA);
            PG8_WAIT_L(8); PG8_BAR; PG8_WAIT_L(0); PG8_MMA(0, 0, At, B0); PG8_BAR; PG8_SCHED;
            PG8_LDB(B1, 1, 1); PG8_STAGE(PG8_SB(1, 0), b3, voffB);
            PG8_BAR; PG8_WAIT_L(0); PG8_MMA(0, 1, At, B1); PG8_BAR;
            PG8_LDA(At, 1, 1); PG8_STAGE(PG8_SA(1, 0), a3, voffA);
            PG8_BAR; PG8_WAIT_L(0); PG8_MMA(1, 0, At, B0); PG8_BAR; PG8_SCHED;
            PG8_STAGE(PG8_SB(1, 1), b3 + hstep, voffB);
            PG8_WAIT_V(6); PG8_BAR; PG8_MMA(1, 1, At, B1); PG8_BAR;
            }
        }
        if constexpr (ALIGN_EPI) { if (wr == 0) PG8_BAR; }
        if constexpr (!Epi::AFTER_DRAIN) { E(acc, cur, wr, wc, fr, fq); S.done(cur); }
        if (!has_next) break;
#pragma unroll
        for (int a = 0; a < 2; ++a)
#pragma unroll
            for (int b = 0; b < 2; ++b)
#pragma unroll
                for (int m = 0; m < 4; ++m)
#pragma unroll
                    for (int n = 0; n < 2; ++n) acc[a][b][m][n] = (f32x4){0.f, 0.f, 0.f, 0.f};
        cur = nxt; cA = nA; cB = nB; ++ui;
        if constexpr (ALIGN_EPI) { if (wr == 1) PG8_BAR; }
    }
    PG8_WAIT_V(0);
    if constexpr (!ALIGN_EPI) { if (wr == 0) PG8_BAR; }
    PG8_BAR;
    if constexpr (Epi::AFTER_DRAIN) { E.fused(acc, cur, wr, wc, fr, fq, lds, wid, lane); S.done(cur); }
#undef PG8_SA
#undef PG8_SB
#undef PG8_STAGE
#undef PG8_LDA
#undef PG8_LDB
#undef PG8_MMA
#undef PG8_WAIT_V
#undef PG8_WAIT_L
#undef PG8_BAR
#undef PG8_SCHED
}
}

constexpr int NWAVES = 8;
constexpr int N_LAUNCHES = MK_N_LAUNCHES;
constexpr int PER_PHASE = 8;
constexpr int NBATCH = 4, SEQ = 8192, D = 1024, T = NBATCH * SEQ, MEMLEN = 256, NMEMTOK = NBATCH * MEMLEN;
constexpr int IN_MAIN = 5120;
constexpr int NEXP = 16384;

constexpr size_t MiB = 1u << 20;
constexpr size_t WS_CTL = 0, CTL_ZERO_BYTES = 512 * 1024;
constexpr size_t WS_ROWSQ = 256 * 1024;
constexpr size_t WS_WIN = 1 * MiB, WS_WV = 11 * MiB, WS_WKV = 12 * MiB, WS_WBR = 14 * MiB, WS_WOUT = 17 * MiB, WS_WQ = 19 * MiB, WS_KEYS = 23 * MiB, WS_PWT = 23 * MiB + 512 * 1024;
constexpr size_t WS_MEMN = 24 * MiB, WS_KMEM = 26 * MiB, WS_VTMEM = 27 * MiB, WS_RSTDX = 28 * MiB, WS_U16 = 32 * MiB, WS_V16 = 64 * MiB;
constexpr size_t WS_QN = 96 * MiB, WS_KN = 128 * MiB, WS_VT = 160 * MiB, WS_PP = 192 * MiB, WS_XQ = 224 * MiB, WS_GATE = 256 * MiB, WS_END = 448 * MiB;
constexpr size_t WS_MERGED = WS_QN;
constexpr size_t WS_HB = WS_VT;
constexpr size_t WS_QB = WS_GATE;
constexpr size_t WS_TE = WS_GATE + 128 * MiB, WS_TW = WS_TE + 16 * MiB;
constexpr size_t OUT_XB = 0, OUT_YNA = 0, OUT_YPOOL = 32 * MiB, OUT_YXA = 64 * MiB;
constexpr int CW_TMO = 0, CW_BAR = 4096;

constexpr int RING_OFF = 0, RING_BYTES = 131072;
constexpr int LDSCTL_OFF = RING_BYTES, MISC_OFF = LDSCTL_OFF + 320;
constexpr int LDS_BYTES = 147456;

#define GAS __attribute__((address_space(1)))
#define LAS __attribute__((address_space(3)))
typedef unsigned short bf16;
typedef unsigned v4u __attribute__((ext_vector_type(4)));
typedef unsigned v2u __attribute__((ext_vector_type(2)));
typedef float f32x4 __attribute__((ext_vector_type(4)));
typedef short bf16x8 __attribute__((ext_vector_type(8)));
typedef __bf16 bf16x2_t __attribute__((ext_vector_type(2)));
typedef GAS unsigned gu32;
#define LDS_WAIT() asm volatile("s_waitcnt lgkmcnt(0)" ::: "memory")
#define VM_WAIT() asm volatile("s_waitcnt vmcnt(0)" ::: "memory")
__device__ __forceinline__ unsigned f2bf(float f) { unsigned u = __builtin_bit_cast(unsigned, f); return (u + 0x7fffu + ((u >> 16) & 1u)) >> 16; }
__device__ __forceinline__ unsigned pk2(float lo, float hi) { return f2bf(lo) | (f2bf(hi) << 16); }
__device__ __forceinline__ float bflo(unsigned u) { return __builtin_bit_cast(float, u << 16); }
__device__ __forceinline__ float bfhi(unsigned u) { return __builtin_bit_cast(float, u & 0xffff0000u); }
__device__ __forceinline__ float bf1(short s) { return __builtin_bit_cast(float, ((unsigned)(unsigned short)s) << 16); }
__device__ __forceinline__ f32x4 mfma16(bf16x8 a, bf16x8 b, f32x4 c) { return __builtin_amdgcn_mfma_f32_16x16x32_bf16(a, b, c, 0, 0, 0); }
__device__ __forceinline__ float wave_sum(float v) {
#pragma unroll
    for (int o = 1; o < 64; o <<= 1) v += __shfl_xor(v, o);
    return v;
}

#define XB_TMO      128
#define XB_XCNT(j)  (256  + 64 * (j))
#define XB_XSUB(j)  (1280 + 64 * (j))
#define XB_XGEN(j)  (2304 + 64 * (j))
#define XB_TOP      3328
#define XB_TOPGEN   3392
#define XCD_BAR_WORDS 3456
#define XB_SPIN_CAP (1u << 18)

__device__ __forceinline__ unsigned xb_ld(unsigned* p)              { return __hip_atomic_load(p, __ATOMIC_RELAXED, __HIP_MEMORY_SCOPE_AGENT); }
__device__ __forceinline__ unsigned xb_add(unsigned* p, unsigned v) { return __hip_atomic_fetch_add(p, v, __ATOMIC_RELAXED, __HIP_MEMORY_SCOPE_AGENT); }
__device__ __forceinline__ unsigned xb_xcc_id() { return (unsigned)__builtin_amdgcn_s_getreg((3 << 11) | 20) & 0xFu; }
#define XB_SPIN(cond, bar) do { unsigned _sp = 0; while (cond) { __builtin_amdgcn_s_sleep(1); \
    if ((++_sp & 255u) == 0u) { if (xb_ld(&(bar)[XB_TMO])) break; if (_sp > XB_SPIN_CAP) { atomicAdd(&(bar)[XB_TMO], 1u); break; } } } } while (0)

struct XcdBarrier {
    unsigned* bar; unsigned x;
    volatile LAS unsigned* st;
};

__device__ __forceinline__ XcdBarrier xcd_barrier_post(unsigned* bar, volatile LAS unsigned* st) {
    XcdBarrier b; b.bar = bar; b.x = xb_xcc_id(); b.st = st;
    if (threadIdx.x == 0) (void)xb_add(&bar[XB_XCNT(b.x)], 1u);
    return b;
}
__device__ __forceinline__ void xcd_barrier_complete(unsigned* bar, unsigned x, unsigned& nloc, unsigned& nx) {
    const unsigned G = gridDim.x * gridDim.y * gridDim.z;
    unsigned sum, cnt, mine, sp = 0u;
    for (;;) {
        sum = 0u; cnt = 0u; mine = 0u;
#pragma unroll
        for (unsigned j = 0; j < 16; ++j) { const unsigned c = xb_ld(&bar[XB_XCNT(j)]); sum += c; cnt += (c > 0u) ? 1u : 0u; mine = (j == x) ? c : mine; }
        if (sum == G) break;
        __builtin_amdgcn_s_sleep(1);
        if ((++sp & 255u) == 0u) { if (xb_ld(&bar[XB_TMO])) break; if (sp > XB_SPIN_CAP) { atomicAdd(&bar[XB_TMO], 1u); break; } }
    }
    nloc = mine > 0u ? mine : 1u; nx = cnt > 0u ? cnt : 1u;
}

__device__ __forceinline__ void xcd_barrier(const XcdBarrier& b) {
    asm volatile("s_waitcnt vmcnt(0)" ::: "memory");
    __syncthreads();
    if (threadIdx.x == 0) {
        unsigned* bar = b.bar;
        __builtin_amdgcn_s_waitcnt(0);
        unsigned nloc = b.st[0], nx = b.st[1];
        if (nloc == 0u) { xcd_barrier_complete(bar, b.x, nloc, nx); b.st[0] = nloc; b.st[1] = nx; }
        const unsigned old = xb_add(&bar[XB_XSUB(b.x)], 1u);
        const unsigned gen = old / nloc;
        if (old + 1u == (gen + 1u) * nloc) {
            __builtin_amdgcn_fence(__ATOMIC_RELEASE, "agent");
            asm volatile("s_waitcnt vmcnt(0)" ::: "memory");
            const unsigned og = xb_add(&bar[XB_TOP], 1u);
            const unsigned tg = og / nx;
            if (og + 1u == (tg + 1u) * nx) xb_add(&bar[XB_TOPGEN], 1u);
            else XB_SPIN(xb_ld(&bar[XB_TOPGEN]) == tg, bar);
            __builtin_amdgcn_fence(__ATOMIC_ACQUIRE, "agent");
            xb_add(&bar[XB_XGEN(b.x)], 1u);
            asm volatile("s_waitcnt vmcnt(0)" ::: "memory");
        } else {
            XB_SPIN(xb_ld(&bar[XB_XGEN(b.x)]) == gen, bar);
            __builtin_amdgcn_fence(__ATOMIC_ACQUIRE, "agent");
            asm volatile("s_waitcnt vmcnt(0)" ::: "memory");
        }
    }
    __syncthreads();
}

struct Frame {
    LAS unsigned char* lds;
    volatile LAS unsigned* MISC;
    gu32* ctl;
    int tid, lane, wave, vcu, G;
    float* out; unsigned char* ws;
};
struct Args { const float* in[23]; float* out; unsigned char* ws; int ph_lo, ph_hi; };
enum { I_X = 0, I_MEM, I_MIXG, I_MEMG, I_WIN, I_GATEB, I_WKV, I_NAQG, I_NAKG, I_RPB, I_POOLW, I_POOLSC, I_XAQG, I_XAKG, I_WB0, I_WB1, I_WB2, I_WOUT, I_FFNG, I_WQ, I_KEYS, I_PU, I_PV };

__device__ __forceinline__ void p0_transpose_item(const float* W, int K, int N, int k0, int n0, bf16* dst, const float* kscale, LAS float* scr, int lane) {
#pragma unroll 8
    for (int i = 0; i < 32; ++i) { const int kk = 2 * i + (lane >> 5); float v = W[(size_t)(k0 + kk) * N + n0 + (lane & 31)]; if (kscale) v *= kscale[k0 + kk]; scr[kk * 33 + (lane & 31)] = v; }
    LDS_WAIT(); asm volatile("" ::: "memory");
    const int c = lane & 7;
#pragma unroll
    for (int j = 0; j < 4; ++j) { const int n = (lane >> 3) + 8 * j; const LAS float* s = scr + (8 * c) * 33 + n;
        v4u o; o.x = pk2(s[0 * 33], s[1 * 33]); o.y = pk2(s[2 * 33], s[3 * 33]); o.z = pk2(s[4 * 33], s[5 * 33]); o.w = pk2(s[6 * 33], s[7 * 33]);
        *(GAS v4u*)(dst + (size_t)n * K + k0 + 8 * c) = o; }
    LDS_WAIT(); asm volatile("" ::: "memory");
}
__device__ __forceinline__ void cvt_row1024(const float* src, bf16* dst, const float* colscale, float rowscale, int lane) {
    const GAS f32x4* xr = (const GAS f32x4*)src + lane; GAS unsigned long long* o8 = (GAS unsigned long long*)dst + lane;
#pragma unroll
    for (int j = 0; j < 4; ++j) { f32x4 v = xr[64 * j] * rowscale; if (colscale) v = v * ((const GAS f32x4*)colscale)[lane + 64 * j];
        o8[64 * j] = (unsigned long long)pk2(v.x, v.y) | ((unsigned long long)pk2(v.z, v.w) << 32); }
}
__device__ __forceinline__ float row_rstd1024(const float* src, int lane) {
    const GAS f32x4* xr = (const GAS f32x4*)src + lane; float s = 0.f;
#pragma unroll
    for (int j = 0; j < 4; ++j) { const f32x4 v = xr[64 * j]; s += (v.x * v.x + v.y * v.y) + (v.z * v.z + v.w * v.w); }
    return rsqrtf(wave_sum(s) * (1.0f / 1024.0f) + 1e-6f);
}
__device__ __forceinline__ void p0_prologue(Frame& F, const Args& A) {
    LAS float* scr = (LAS float*)(F.lds + RING_OFF + F.wave * 16384);
    const int gw = F.vcu * NWAVES + F.wave, NGW = F.G * NWAVES, lane = F.lane;
    unsigned char* ws = F.ws;
    constexpr int I_IN = 16 * 176, I_KV = 16 * 32, I_BR = 8 * 32, I_OUT = 16 * 32, I_Q = 16 * 64;
    constexpr int NITEMS = I_IN + I_KV + 3 * I_BR + I_OUT + I_Q;
    for (int it = gw; it < NITEMS; it += NGW) {
        int r = it;
        if (r < I_IN) { const int kb = r / 176, nb = r % 176, n0 = 32 * nb; bf16* dst;
            if (n0 >= 1024 && n0 < 1536) dst = (bf16*)(ws + WS_WV) + (size_t)(n0 - 1024) * 1024;
            else { const int np = n0 < 1024 ? n0 : n0 - 512, t = np >> 8, w = np & 255, wc = w >> 6, bj = (w >> 5) & 1; dst = (bf16*)(ws + WS_WIN) + (size_t)(256 * t + 128 * bj + 32 * wc) * 1024; }
            p0_transpose_item(A.in[I_WIN], 1024, 5632, 64 * kb, n0, dst, A.in[I_MIXG], scr, lane); continue; }
        r -= I_IN;
        if (r < I_KV) { const int kb = r / 32, nb = r % 32; p0_transpose_item(A.in[I_WKV], 1024, 1024, 64 * kb, 32 * nb, (bf16*)(ws + WS_WKV) + (size_t)(32 * nb) * 1024, nullptr, scr, lane); continue; }
        r -= I_KV;
        if (r < 3 * I_BR) { const int br = r / I_BR, rr = r % I_BR, kb = rr / 32, nb = rr % 32; const float* W = br == 0 ? A.in[I_WB0] : (br == 1 ? A.in[I_WB1] : A.in[I_WB2]);
            p0_transpose_item(W, 512, 1024, 64 * kb, 32 * nb, (bf16*)(ws + WS_WBR) + (size_t)br * 1024 * 512 + (size_t)(32 * nb) * 512, nullptr, scr, lane); continue; }
        r -= 3 * I_BR;
        if (r < I_OUT) { const int kb = r / 32, nb = r % 32; p0_transpose_item(A.in[I_WOUT], 1024, 1024, 64 * kb, 32 * nb, (bf16*)(ws + WS_WOUT) + (size_t)(32 * nb) * 1024, nullptr, scr, lane); continue; }
        r -= I_OUT;
        { const int kb = r / 64, nb = r % 64; p0_transpose_item(A.in[I_WQ], 1024, 2048, 64 * kb, 32 * nb, (bf16*)(ws + WS_WQ) + (size_t)(32 * nb) * 1024, A.in[I_FFNG], scr, lane); }
    }
    { bf16* xb = (bf16*)((unsigned char*)F.out + OUT_XB); float* rstdx = (float*)(ws + WS_RSTDX);
      for (int m = gw; m < T; m += NGW) { const float* xr = A.in[I_X] + (size_t)m * D; const float rs = row_rstd1024(xr, lane); cvt_row1024(xr, xb + (size_t)m * D, nullptr, 1.0f, lane); if (lane == 0) rstdx[m] = rs; } }
    for (int m = gw; m < NMEMTOK; m += NGW) { const float* xr = A.in[I_MEM] + (size_t)m * D; const float rs = row_rstd1024(xr, lane); cvt_row1024(xr, (bf16*)(ws + WS_MEMN) + (size_t)m * D, A.in[I_MEMG], rs, lane); }
    for (int m = gw; m < 2 * NEXP; m += NGW) {
        if (m < NEXP) cvt_row1024(A.in[I_PU] + (size_t)m * D, (bf16*)(ws + WS_U16) + (size_t)m * D, A.in[I_FFNG], 1.0f, lane);
        else cvt_row1024(A.in[I_PV] + (size_t)(m - NEXP) * D, (bf16*)(ws + WS_V16) + (size_t)(m - NEXP) * D, nullptr, 1.0f, lane);
    }
    for (int m = gw * 64 + lane; m < T; m += NGW * 64) ((float*)(ws + WS_ROWSQ))[m] = 0.f;
    for (int m = gw; m < 256; m += NGW) cvt_row1024(A.in[I_KEYS] + (size_t)m * 1024, (bf16*)(ws + WS_KEYS) + (size_t)m * 1024, nullptr, 1.0f, lane);
    for (int m = gw; m < 1024; m += NGW) { const int gd = m >> 1, c = (m & 1) * 64 + lane, g = gd >> 7, d = gd & 127;
        const float v = A.in[I_POOLW][(size_t)(g * 128 + c) * 128 + d] * A.in[I_POOLSC][gd];
        ((bf16*)(ws + WS_PWT))[(size_t)gd * 128 + c] = (bf16)f2bf(v); }
}

__device__ __forceinline__ void memkv_tile(const bf16* memn, const bf16* wkvT, const float* kg, const float* qg, bf16* kmem, bf16* vtmem, int tile, int lane) {
    const int q = lane & 15, hi = lane >> 4, rg = tile >> 3, cg = tile & 7, r0 = rg * 16, c0 = cg * 128;
    f32x4 acc[8];
#pragma unroll
    for (int i = 0; i < 8; ++i) acc[i] = (f32x4){0.f, 0.f, 0.f, 0.f};
    const bf16* ap = memn + (size_t)(r0 + q) * 1024 + 8 * hi; const bf16* bp = wkvT + (size_t)(c0 + q) * 1024 + 8 * hi;
#pragma unroll 2
    for (int ks = 0; ks < 32; ++ks) { const bf16x8 a = *(const bf16x8*)(ap + 32 * ks);
#pragma unroll
        for (int nf = 0; nf < 8; ++nf) { const bf16x8 b = *(const bf16x8*)(bp + (size_t)(16 * nf) * 1024 + 32 * ks); acc[nf] = mfma16(a, b, acc[nf]); } }
    if (cg < 4) {
        float rr[4];
#pragma unroll
        for (int g = 0; g < 4; ++g) { float ss = 0.f;
#pragma unroll
            for (int nf = 0; nf < 8; ++nf) ss += acc[nf][g] * acc[nf][g];
            ss += __shfl_xor(ss, 1); ss += __shfl_xor(ss, 2); ss += __shfl_xor(ss, 4); ss += __shfl_xor(ss, 8);
            rr[g] = rsqrtf(ss * (1.0f / 128.0f) + 1e-6f); }
#pragma unroll
        for (int nf = 0; nf < 8; ++nf) { const int d = 16 * nf + q; const float gs = kg[d] * qg[d];
#pragma unroll
            for (int g = 0; g < 4; ++g) kmem[(size_t)(r0 + 4 * hi + g) * 512 + cg * 128 + d] = (bf16)f2bf(acc[nf][g] * rr[g] * gs); }
    } else {
        const int h = cg - 4, b = r0 >> 8, key0 = (r0 & 255) + 4 * hi;
#pragma unroll
        for (int nf = 0; nf < 8; ++nf) { const int d = 16 * nf + q; v2u w; w.x = pk2(acc[nf][0], acc[nf][1]); w.y = pk2(acc[nf][2], acc[nf][3]);
            *(v2u*)(vtmem + (size_t)(b * 512 + h * 128 + d) * 256 + key0) = w; }
    }
}

__device__ __forceinline__ void na_item(const bf16* __restrict__ qn, const bf16* __restrict__ kn, const bf16* __restrict__ vt, const float* __restrict__ rpb, bf16* __restrict__ yna,
                                        int b, int r, int jb, int h, int lane) {
    const int q = lane & 15, hi = lane >> 4;
    int rs = r - 4; rs = rs < 0 ? 0 : (rs > 120 ? 120 : rs);
    int kb0 = jb * 16 - 8; kb0 = kb0 < 0 ? 0 : (kb0 > 32 ? 32 : kb0);
    const int qcol = jb * 16 + q; int cs = qcol - 8; cs = cs < 0 ? 0 : (cs > 48 ? 48 : cs);
    const size_t tokq = (size_t)b * SEQ + r * 64 + qcol;
    const bf16* qp = qn + tokq * 512 + h * 64 + 8 * hi;
    const bf16x8 qf0 = *(const bf16x8*)qp, qf1 = *(const bf16x8*)(qp + 32);
    const bf16* kbase = kn + ((size_t)b * SEQ + rs * 64 + kb0 + q) * 512 + h * 64 + 8 * hi;
    f32x4 s[16];
#pragma unroll
    for (int f = 0; f < 16; ++f) {
        const bf16* kp = kbase + (size_t)((f >> 1) * 64 + (f & 1) * 16) * 512;
        const bf16x8 a0 = *(const bf16x8*)kp, a1 = *(const bf16x8*)(kp + 32);
        f32x4 z = (f32x4){0.f, 0.f, 0.f, 0.f}; z = mfma16(a0, qf0, z); s[f] = mfma16(a1, qf1, z);
    }
    const float* rp = rpb + h * 15 * 31;
    float mx = -3.0e38f;
#pragma unroll
    for (int f = 0; f < 16; ++f) {
        const int dr = rs + (f >> 1) - r + 7;
#pragma unroll
        for (int g = 0; g < 4; ++g) {
            const int kcol = kb0 + (f & 1) * 16 + 4 * hi + g;
            const bool ok = (kcol >= cs) && (kcol < cs + 16);
            int dc = kcol - qcol + 15; dc = dc < 0 ? 0 : (dc > 30 ? 30 : dc);
            const float v = ok ? s[f][g] + rp[dr * 31 + dc] : -1.0e30f;
            s[f][g] = v; mx = fmaxf(mx, v);
        }
    }
    mx = fmaxf(mx, __shfl_xor(mx, 16)); mx = fmaxf(mx, __shfl_xor(mx, 32));
    float sum = 0.f;
#pragma unroll
    for (int f = 0; f < 16; ++f)
#pragma unroll
        for (int g = 0; g < 4; ++g) { const float p = __expf(s[f][g] - mx); s[f][g] = p; sum += p; }
    sum += __shfl_xor(sum, 16); sum += __shfl_xor(sum, 32);
    const float inv = 1.0f / sum;
    f32x4 o[4];
#pragma unroll
    for (int i = 0; i < 4; ++i) o[i] = (f32x4){0.f, 0.f, 0.f, 0.f};
    const bf16* vbase = vt + ((size_t)(b * 512 + h * 64 + q) * SEQ + rs * 64 + kb0 + 4 * hi);
#pragma unroll
    for (int st = 0; st < 8; ++st) {
        const bf16x8 pb = __builtin_bit_cast(bf16x8, pg8::pack8(s[2 * st], s[2 * st + 1]));
#pragma unroll
        for (int mf = 0; mf < 4; ++mf) { const bf16* vp = vbase + (size_t)(16 * mf) * SEQ + st * 64; const v2u lo = *(const v2u*)vp, hh = *(const v2u*)(vp + 16);
            const bf16x8 av = __builtin_bit_cast(bf16x8, (v4u){lo.x, lo.y, hh.x, hh.y}); o[mf] = mfma16(av, pb, o[mf]); }
    }
    bf16* yp = yna + tokq * 512 + h * 64 + 4 * hi;
#pragma unroll
    for (int mf = 0; mf < 4; ++mf) { v2u w; w.x = pk2(o[mf][0] * inv, o[mf][1] * inv); w.y = pk2(o[mf][2] * inv, o[mf][3] * inv); *(v2u*)(yp + 16 * mf) = w; }
}
__device__ __forceinline__ void xa_item(const bf16* __restrict__ xq, const bf16* __restrict__ kmem, const bf16* __restrict__ vtmem, bf16* __restrict__ yxa, int tok0, int h, int lane) {
    const int q = lane & 15, hi = lane >> 4; const size_t tok = (size_t)tok0 + q; const int b = tok0 >> 13;
    const bf16* qp = xq + tok * 512 + h * 128 + 8 * hi;
    bf16x8 qf[4]; float ssq = 0.f;
#pragma unroll
    for (int ks = 0; ks < 4; ++ks) { qf[ks] = *(const bf16x8*)(qp + 32 * ks);
#pragma unroll
        for (int j = 0; j < 8; ++j) { const float v = bf1(qf[ks][j]); ssq += v * v; } }
    ssq += __shfl_xor(ssq, 16); ssq += __shfl_xor(ssq, 32);
    const float cexp = rsqrtf(ssq * (1.0f / 128.0f) + 1e-6f) * 0.08838834764831845f * 1.4426950408889634f;
    const bf16* kbase = kmem + ((size_t)b * 256 + q) * 512 + h * 128 + 8 * hi;
    f32x4 s[16];
#pragma unroll
    for (int f = 0; f < 16; ++f) { const bf16* kp = kbase + (size_t)(16 * f) * 512; f32x4 z = (f32x4){0.f, 0.f, 0.f, 0.f};
#pragma unroll
        for (int ks = 0; ks < 4; ++ks) z = mfma16(*(const bf16x8*)(kp + 32 * ks), qf[ks], z);
        s[f] = z; }
    float mx = -3.0e38f;
#pragma unroll
    for (int f = 0; f < 16; ++f)
#pragma unroll
        for (int g = 0; g < 4; ++g) mx = fmaxf(mx, s[f][g]);
    mx = fmaxf(mx, __shfl_xor(mx, 16)); mx = fmaxf(mx, __shfl_xor(mx, 32));
    float sum = 0.f;
#pragma unroll
    for (int f = 0; f < 16; ++f)
#pragma unroll
        for (int g = 0; g < 4; ++g) { const float p = __builtin_amdgcn_exp2f((s[f][g] - mx) * cexp); s[f][g] = p; sum += p; }
    sum += __shfl_xor(sum, 16); sum += __shfl_xor(sum, 32);
    const float inv = 1.0f / sum;
    f32x4 o[8];
#pragma unroll
    for (int i = 0; i < 8; ++i) o[i] = (f32x4){0.f, 0.f, 0.f, 0.f};
    const bf16* vbase = vtmem + (size_t)(b * 512 + h * 128 + q) * 256 + 4 * hi;
#pragma unroll
    for (int st = 0; st < 8; ++st) {
        const bf16x8 pb = __builtin_bit_cast(bf16x8, pg8::pack8(s[2 * st], s[2 * st + 1]));
#pragma unroll
        for (int mf = 0; mf < 8; ++mf) { const bf16* vp = vbase + (size_t)(16 * mf) * 256 + 32 * st; const v2u lo = *(const v2u*)vp, hh = *(const v2u*)(vp + 16);
            const bf16x8 av = __builtin_bit_cast(bf16x8, (v4u){lo.x, lo.y, hh.x, hh.y}); o[mf] = mfma16(av, pb, o[mf]); }
    }
    bf16* yp = yxa + tok * 512 + h * 128 + 4 * hi;
#pragma unroll
    for (int mf = 0; mf < 8; ++mf) { v2u w; w.x = pk2(o[mf][0] * inv, o[mf][1] * inv); w.y = pk2(o[mf][2] * inv, o[mf][3] * inv); *(v2u*)(yp + 16 * mf) = w; }
}
__device__ __forceinline__ void pool_item(const bf16* __restrict__ pp, const bf16* __restrict__ pwT, bf16* __restrict__ ypool, int tok0, int g, int lane) {
    const int q = lane & 15, hi = lane >> 4; const int tok = tok0 + q, b = tok >> 13, t = tok & 8191;
    const int hw = 1 << g;
    int lo = t - hw; lo = lo < 0 ? 0 : lo; int ht = t + hw; ht = ht > SEQ ? SEQ : ht;
    const float inv = 1.0f / (float)(ht - lo);
    const bf16* base = pp + (size_t)b * SEQ * 512 + g * 128 + 8 * hi;
    bf16x8 pb[4];
#pragma unroll
    for (int ks = 0; ks < 4; ++ks) {
        float a8[8];
#pragma unroll
        for (int j = 0; j < 8; ++j) a8[j] = 0.f;
        for (int d = -hw; d < hw; ++d) { const int u = t + d; const bool ok = (u >= 0) && (u < SEQ); const int uc = ok ? u : t;
            const bf16x8 v = *(const bf16x8*)(base + (size_t)uc * 512 + 32 * ks);
#pragma unroll
            for (int j = 0; j < 8; ++j) a8[j] += ok ? bf1(v[j]) : 0.f; }
        const bf16x8 sv = *(const bf16x8*)(base + (size_t)t * 512 + 32 * ks);
        f32x4 p0, p1;
#pragma unroll
        for (int j = 0; j < 4; ++j) { p0[j] = a8[j] * inv - bf1(sv[j]); p1[j] = a8[j + 4] * inv - bf1(sv[j + 4]); }
        pb[ks] = __builtin_bit_cast(bf16x8, pg8::pack8(p0, p1));
    }
    bf16* yp = ypool + (size_t)tok * 512 + g * 128 + 4 * hi;
    const bf16* wb = pwT + (size_t)(g * 128 + q) * 128 + 8 * hi;
#pragma unroll
    for (int mf = 0; mf < 8; ++mf) { f32x4 o = (f32x4){0.f, 0.f, 0.f, 0.f};
#pragma unroll
        for (int ks = 0; ks < 4; ++ks) o = mfma16(*(const bf16x8*)(wb + (size_t)(16 * mf) * 128 + 32 * ks), pb[ks], o);
        v2u w; w.x = pk2(o[0], o[1]); w.y = pk2(o[2], o[3]); *(v2u*)(yp + 16 * mf) = w; }
}

__device__ __forceinline__ int f2key(float s, int idx, int mask) { int b = __builtin_bit_cast(int, s); b = b >= 0 ? b : (b ^ 0x7fffffff); return (b & ~mask) | idx; }
__device__ __forceinline__ float key2f(int k) { k = k >= 0 ? k : (k ^ 0x7fffffff); return __builtin_bit_cast(float, k); }
#define INS16(L, x) do { int _x = (x); _Pragma("unroll") for (int _j = 0; _j < 16; ++_j) { const int _t = L[_j] > _x ? L[_j] : _x; _x = L[_j] > _x ? _x : L[_j]; L[_j] = _t; } } while (0)
__device__ __forceinline__ void topk_item(const bf16* __restrict__ qb, const bf16* __restrict__ keys, int* __restrict__ te, float* __restrict__ tw, LAS int* lscr, int tok0, int h, int lane) {
    const int q = lane & 15, hi = lane >> 4; const size_t tok = (size_t)tok0 + q;
    int L[2][16];
#pragma unroll
    for (int p = 0; p < 2; ++p) {
#pragma unroll
        for (int k = 0; k < 16; ++k) L[p][k] = (int)0x80000000;
        bf16x8 qf[4];
#pragma unroll
        for (int ks = 0; ks < 4; ++ks) qf[ks] = *(const bf16x8*)(qb + tok * 2048 + h * 256 + p * 128 + 32 * ks + 8 * hi);
        const bf16* kb = keys + (size_t)((h * 2 + p) * 128 + q) * 128 + 8 * hi;
#pragma unroll
        for (int mf = 0; mf < 8; ++mf) { f32x4 s = (f32x4){0.f, 0.f, 0.f, 0.f};
#pragma unroll
            for (int ks = 0; ks < 4; ++ks) s = mfma16(*(const bf16x8*)(kb + (size_t)(16 * mf) * 128 + 32 * ks), qf[ks], s);
#pragma unroll
            for (int g = 0; g < 4; ++g) INS16(L[p], f2key(s[g], 16 * mf + 4 * hi + g, 127)); }
#pragma unroll
        for (int step = 16; step <= 32; step <<= 1) { int tmp[16];
#pragma unroll
            for (int k = 0; k < 16; ++k) tmp[k] = L[p][k];
#pragma unroll
            for (int k = 0; k < 16; ++k) { const int o = __shfl_xor(tmp[k], step); INS16(L[p], o); } }
    }
    float v1[16], v2[16];
#pragma unroll
    for (int k = 0; k < 16; ++k) { v1[k] = key2f(L[0][k]); v2[k] = key2f(L[1][k]); }
    int Fk[16];
#pragma unroll
    for (int k = 0; k < 16; ++k) Fk[k] = (int)0x80000000;
#pragma unroll
    for (int i = 0; i < 16; ++i)
#pragma unroll
        for (int j = 0; j < 16; ++j) if ((i + 1) * (j + 1) <= 16) INS16(Fk, f2key(v1[i] + v2[j], (i << 4) | j, 255));
    LAS int* my = lscr + lane * 33;
#pragma unroll
    for (int k = 0; k < 16; ++k) { my[k] = L[0][k] & 127; my[16 + k] = L[1][k] & 127; }
    LDS_WAIT(); asm volatile("" ::: "memory");
    float e[16]; float sum = 0.f; const float mx = key2f(Fk[0]);
#pragma unroll
    for (int k = 0; k < 16; ++k) { e[k] = __expf(key2f(Fk[k]) - mx); sum += e[k]; }
    const float inv = 1.0f / sum;
    if (hi == 0) {
        int* tep = te + (tok * 8 + h) * 16; float* twp = tw + (tok * 8 + h) * 16;
#pragma unroll
        for (int k4 = 0; k4 < 4; ++k4) { int ev[4]; f32x4 wv;
#pragma unroll
            for (int k = 0; k < 4; ++k) { const int kk = 4 * k4 + k, i = (Fk[kk] >> 4) & 15, j = Fk[kk] & 15; ev[k] = my[i] * 128 + my[16 + j]; wv[k] = e[kk] * inv; }
            *(v4u*)(tep + 4 * k4) = (v4u){(unsigned)ev[0], (unsigned)ev[1], (unsigned)ev[2], (unsigned)ev[3]}; *(f32x4*)(twp + 4 * k4) = wv; }
    }
    LDS_WAIT(); asm volatile("" ::: "memory");
}

__device__ __forceinline__ float dot2bf(unsigned a, unsigned b, float c) { return __builtin_amdgcn_fdot2_f32_bf16(__builtin_bit_cast(bf16x2_t, a), __builtin_bit_cast(bf16x2_t, b), c, false); }
__device__ __forceinline__ void peer_token(const bf16* __restrict__ hb, const float* __restrict__ rowsq, const bf16* __restrict__ u16, const bf16* __restrict__ v16,
                                           const int* __restrict__ te, const float* __restrict__ tw, float* out, int tok, int lane) {
    const bf16* hp = hb + (size_t)tok * 1024 + 8 * lane;
    const v4u h0 = *(const v4u*)hp, h1 = *(const v4u*)(hp + 512);
    const float rstd = rsqrtf(rowsq[tok] * (1.0f / 1024.0f) + 1e-6f);
    float* op = out + (size_t)tok * 1024 + 8 * lane;
    f32x4 a0 = *(const f32x4*)op, a1 = *(const f32x4*)(op + 4), a2 = *(const f32x4*)(op + 512), a3 = *(const f32x4*)(op + 516);
    for (int hd = 0; hd < 8; ++hd) {
        const int my_e = te[(size_t)tok * 128 + hd * 16 + (lane & 15)];
        const float my_g = tw[(size_t)tok * 128 + hd * 16 + ((lane >> 2) & 15)];
        float p[16];
#pragma unroll
        for (int k = 0; k < 16; ++k) { const int e = __builtin_amdgcn_readlane(my_e, k); const bf16* ur = u16 + (size_t)e * 1024 + 8 * lane;
            const v4u u0 = *(const v4u*)ur, u1 = *(const v4u*)(ur + 512);
            float d = 0.f; d = dot2bf(h0.x, u0.x, d); d = dot2bf(h0.y, u0.y, d); d = dot2bf(h0.z, u0.z, d); d = dot2bf(h0.w, u0.w, d);
            d = dot2bf(h1.x, u1.x, d); d = dot2bf(h1.y, u1.y, d); d = dot2bf(h1.z, u1.z, d); d = dot2bf(h1.w, u1.w, d); p[k] = d; }
        float q8[8], q4[4], q2[2], q1;
#pragma unroll
        for (int i = 0; i < 8; ++i) { const bool up = (lane & 32) != 0; const float keep = up ? p[i + 8] : p[i], send = up ? p[i] : p[i + 8]; q8[i] = keep + __shfl_xor(send, 32); }
#pragma unroll
        for (int i = 0; i < 4; ++i) { const bool up = (lane & 16) != 0; const float keep = up ? q8[i + 4] : q8[i], send = up ? q8[i] : q8[i + 4]; q4[i] = keep + __shfl_xor(send, 16); }
#pragma unroll
        for (int i = 0; i < 2; ++i) { const bool up = (lane & 8) != 0; const float keep = up ? q4[i + 2] : q4[i], send = up ? q4[i] : q4[i + 2]; q2[i] = keep + __shfl_xor(send, 8); }
        { const bool up = (lane & 4) != 0; const float keep = up ? q2[1] : q2[0], send = up ? q2[0] : q2[1]; q1 = keep + __shfl_xor(send, 4); }
        q1 += __shfl_xor(q1, 2); q1 += __shfl_xor(q1, 1);
        const float z = q1 * rstd;
        const float wgt = my_g * 0.5f * z * (1.0f + erff(z * 0.70710678118654752f));
#pragma unroll
        for (int k = 0; k < 16; ++k) { const int e = __builtin_amdgcn_readlane(my_e, k); const float wk = __builtin_bit_cast(float, __builtin_amdgcn_readlane(__builtin_bit_cast(int, wgt), 4 * k));
            const bf16* vr = v16 + (size_t)e * 1024 + 8 * lane; const v4u v0 = *(const v4u*)vr, v1 = *(const v4u*)(vr + 512);
            a0[0] += wk * bflo(v0.x); a0[1] += wk * bfhi(v0.x); a0[2] += wk * bflo(v0.y); a0[3] += wk * bfhi(v0.y);
            a1[0] += wk * bflo(v0.z); a1[1] += wk * bfhi(v0.z); a1[2] += wk * bflo(v0.w); a1[3] += wk * bfhi(v0.w);
            a2[0] += wk * bflo(v1.x); a2[1] += wk * bfhi(v1.x); a2[2] += wk * bflo(v1.y); a2[3] += wk * bfhi(v1.y);
            a3[0] += wk * bflo(v1.z); a3[1] += wk * bfhi(v1.z); a3[2] += wk * bflo(v1.w); a3[3] += wk * bfhi(v1.w); }
    }
    *(f32x4*)op = a0; *(f32x4*)(op + 4) = a1; *(f32x4*)(op + 512) = a2; *(f32x4*)(op + 516) = a3;
}

__global__ void __launch_bounds__(NWAVES * 64, 2) mk_fwd(Args args) {
    extern __shared__ __attribute__((aligned(16))) unsigned char lds[];
    Frame F;
    F.lds = (LAS unsigned char*)lds;
    F.MISC = (volatile LAS unsigned*)(F.lds + MISC_OFF);
    F.tid = threadIdx.x; F.lane = F.tid & 63; F.wave = __builtin_amdgcn_readfirstlane(F.tid >> 6);
    F.G = gridDim.x; { const int bx = blockIdx.x; F.vcu = (F.G % 8 == 0) ? (bx % 8) * (F.G / 8) + bx / 8 : bx; }
    F.out = args.out; F.ws = args.ws;
    unsigned char* ws = args.ws;
    F.ctl = (gu32*)(ws + WS_CTL);
    for (int u = F.tid; u < (LDS_BYTES - LDSCTL_OFF) / 4; u += NWAVES * 64) ((LAS unsigned*)(F.lds + LDSCTL_OFF))[u] = 0u;
    __syncthreads();
    XcdBarrier bar; bar.bar = (unsigned*)(F.ctl + CW_BAR); bar.x = 0; bar.st = nullptr;
    if (N_LAUNCHES != PER_PHASE) bar = xcd_barrier_post((unsigned*)(F.ctl + CW_BAR), F.MISC + 8);
#define GRID_BAR() do { if (N_LAUNCHES != PER_PHASE) xcd_barrier(bar); } while (0)
    const int lo = args.ph_lo, hi = args.ph_hi;
#define IN(k) (lo <= (k) && (k) < hi)
#define BOTH(k) (IN(k) && IN((k) + 1))
    const int gw = F.vcu * NWAVES + F.wave, NGW = F.G * NWAVES;
    bf16* const WinT = (bf16*)(ws + WS_WIN); bf16* const WvT = (bf16*)(ws + WS_WV); bf16* const WkvT = (bf16*)(ws + WS_WKV); bf16* const WbrT = (bf16*)(ws + WS_WBR);
    bf16* const WoutT = (bf16*)(ws + WS_WOUT); bf16* const WqT = (bf16*)(ws + WS_WQ); bf16* const KEYS = (bf16*)(ws + WS_KEYS); bf16* const PWT = (bf16*)(ws + WS_PWT);
    bf16* const MEMN = (bf16*)(ws + WS_MEMN); bf16* const KMEM = (bf16*)(ws + WS_KMEM); bf16* const VTMEM = (bf16*)(ws + WS_VTMEM); float* const RSTDX = (float*)(ws + WS_RSTDX);
    bf16* const U16 = (bf16*)(ws + WS_U16); bf16* const V16 = (bf16*)(ws + WS_V16);
    bf16* const QN = (bf16*)(ws + WS_QN); bf16* const KN = (bf16*)(ws + WS_KN); bf16* const VT = (bf16*)(ws + WS_VT); bf16* const PP = (bf16*)(ws + WS_PP); bf16* const XQ = (bf16*)(ws + WS_XQ);
    bf16* const GATE = (bf16*)(ws + WS_GATE); bf16* const MERGED = (bf16*)(ws + WS_MERGED); bf16* const HB = (bf16*)(ws + WS_HB); bf16* const QB = (bf16*)(ws + WS_QB);
    int* const TE = (int*)(ws + WS_TE); float* const TW = (float*)(ws + WS_TW); float* const ROWSQ = (float*)(ws + WS_ROWSQ);
    bf16* const XB = (bf16*)((unsigned char*)args.out + OUT_XB); bf16* const YNA = (bf16*)((unsigned char*)args.out + OUT_YNA);
    bf16* const YPOOL = (bf16*)((unsigned char*)args.out + OUT_YPOOL); bf16* const YXA = (bf16*)((unsigned char*)args.out + OUT_YXA);

    if (IN(0)) { p0_prologue(F, args); if (BOTH(0)) GRID_BAR(); }

    if (IN(1)) {
        { pg8::Sched1 S; S.so.init(T, IN_MAIN, F.G, (int)blockIdx.x); S.A = (const char*)XB; S.Bt = (const char*)WinT; S.tstep = (size_t)256 * 1024 * 2;
          pg8::EpiProj E{RSTDX, QN, KN, PP, XQ, GATE, args.in[I_NAQG], args.in[I_NAKG], args.in[I_GATEB]};
          pg8::gemm_phase<pg8::EpiProj, pg8::Sched1, true, true>(F.lds + RING_OFF, 1024, S, E); }
        { pg8::Sched1 S; S.so.init(512, T, F.G, (int)blockIdx.x); S.A = (const char*)WvT; S.Bt = (const char*)XB; S.tstep = (size_t)256 * 1024 * 2;
          pg8::EpiVt E{RSTDX, VT};
          pg8::gemm_phase<pg8::EpiVt, pg8::Sched1, false, true>(F.lds + RING_OFF, 1024, S, E); }
        for (int t = gw; t < 512; t += NGW) memkv_tile(MEMN, WkvT, args.in[I_XAKG], args.in[I_XAQG], KMEM, VTMEM, t, F.lane);
        if (BOTH(1)) GRID_BAR();
    }

    if (IN(2)) {
        for (int i = F.vcu; i < 256; i += F.G)
            for (int k = 0; k < 8; ++k) { const int idx = i * 8 + k, b = idx >> 9, r = (idx >> 2) & 127, jb = idx & 3; na_item(QN, KN, VT, args.in[I_RPB], YNA, b, r, jb, F.wave, F.lane); }
        for (int it = gw; it < 8192; it += NGW) pool_item(PP, PWT, YPOOL, (it >> 2) * 16, it & 3, F.lane);
        for (int it = gw; it < 8192; it += NGW) xa_item(XQ, KMEM, VTMEM, YXA, (it >> 2) * 16, it & 3, F.lane);
        if (BOTH(2)) GRID_BAR();
    }

    if (IN(3)) {
        pg8::Sched3 S; S.so.init(T, D, F.G, (int)blockIdx.x); S.A = (const char*)YNA; S.Bt = (const char*)WbrT; S.tstep = (size_t)256 * 512 * 2; S.strideA = 32 * MiB; S.strideB = (size_t)1024 * 512 * 2;
        pg8::EpiMerge E{GATE, (bf16*)(ws + WS_VT)  , MERGED};
        pg8::gemm_phase<pg8::EpiMerge, pg8::Sched3, true, true>(F.lds + RING_OFF, 512, S, E);
        if (BOTH(3)) GRID_BAR();
    }

    if (IN(4)) {
        pg8::Sched1 S; S.so.init(T, D, F.G, (int)blockIdx.x); S.A = (const char*)MERGED; S.Bt = (const char*)WoutT; S.tstep = (size_t)256 * 1024 * 2;
        pg8::EpiH E{args.in[I_X], F.out, HB, ROWSQ};
        pg8::gemm_phase<pg8::EpiH, pg8::Sched1, true, true>(F.lds + RING_OFF, 1024, S, E);
        if (BOTH(4)) GRID_BAR();
    }

    if (IN(5)) {
        pg8::Sched1 S; S.so.init(T, 2048, F.G, (int)blockIdx.x); S.A = (const char*)HB; S.Bt = (const char*)WqT; S.tstep = (size_t)256 * 1024 * 2;
        pg8::EpiQ E{ROWSQ, QB};
        pg8::gemm_phase<pg8::EpiQ, pg8::Sched1, true, true>(F.lds + RING_OFF, 1024, S, E);
        if (BOTH(5)) GRID_BAR();
    }

    if (IN(6)) {
        LAS int* lscr = (LAS int*)(F.lds + RING_OFF + F.wave * 16384);
        for (int it = gw; it < 16384; it += NGW) topk_item(QB, KEYS, TE, TW, lscr, (it >> 3) * 16, it & 7, F.lane);
        if (BOTH(6)) GRID_BAR();
    }

    if (IN(7)) {
        for (int tok = gw; tok < T; tok += NGW) peer_token(HB, ROWSQ, U16, V16, TE, TW, F.out, tok, F.lane);
    }
#undef IN
#undef BOTH
#undef GRID_BAR
}

extern "C" void kernel_launch(void* const* d_in, const int* in_sizes, int n_in, void* d_out, int out_size, void* d_ws, size_t ws_size, hipStream_t stream) {
    static int grid = 0;
    if (grid == 0) {
        if (n_in != 23 || in_sizes[0] != T * D || out_size != T * D || ws_size < WS_END) { fprintf(stderr, "kernel_launch: unexpected shapes: n_in %d in0 %d out %d ws %zu\n", n_in, n_in > 0 ? in_sizes[0] : -1, out_size, ws_size); grid = -1; return; }
        int dev = 0, cus = 0, per_cu = 0;
        if (hipGetDevice(&dev) != hipSuccess || hipDeviceGetAttribute(&cus, hipDeviceAttributeMultiprocessorCount, dev) != hipSuccess) { fprintf(stderr, "kernel_launch: device query failed\n"); grid = -1; return; }
        if (hipFuncSetAttribute((const void*)mk_fwd, hipFuncAttributeMaxDynamicSharedMemorySize, LDS_BYTES) != hipSuccess) { fprintf(stderr, "kernel_launch: hipFuncSetAttribute failed\n"); grid = -1; return; }
        if (hipOccupancyMaxActiveBlocksPerMultiprocessor(&per_cu, (const void*)mk_fwd, NWAVES * 64, LDS_BYTES) != hipSuccess || per_cu < 1)
            fprintf(stderr, "kernel_launch: note: occupancy query reports %d workgroups per CU\n", per_cu);
        (void)hipGetLastError();
        grid = cus;
    }
    if (grid < 0) return;
    if (hipMemsetAsync((char*)d_ws + WS_CTL, 0, CTL_ZERO_BYTES, stream) != hipSuccess) { fprintf(stderr, "kernel_launch: memset failed\n"); return; }
    Args a{};
    for (int i = 0; i < 23; ++i) a.in[i] = (const float*)d_in[i];
    a.out = (float*)d_out; a.ws = (unsigned char*)d_ws;
    for (int li = 0; li < N_LAUNCHES; ++li) {
        a.ph_lo = (N_LAUNCHES == PER_PHASE) ? li : 0; a.ph_hi = (N_LAUNCHES == PER_PHASE) ? li + 1 : PER_PHASE;
        hipLaunchKernelGGL(mk_fwd, dim3(grid), dim3(NWAVES * 64), LDS_BYTES, stream, a);
        const hipError_t le = hipPeekAtLastError();
        if (le != hipSuccess) { fprintf(stderr, "kernel_launch: launch %d failed: %s\n", li, hipGetErrorName(le)); break; }
    }
}
```

```cpp
#define MK_N_LAUNCHES 1
#include <hip/hip_runtime.h>
#include <cstdio>
#include <cstdint>

#ifndef MK_N_LAUNCHES
#define MK_N_LAUNCHES 1
#endif

namespace pg8 {
#define PG8_LAS __attribute__((address_space(3)))
typedef unsigned short bf16_t;
typedef short bf16x8 __attribute__((ext_vector_type(8)));
typedef float f32x4 __attribute__((ext_vector_type(4)));
typedef unsigned u32x4 __attribute__((ext_vector_type(4)));
typedef unsigned u32x2 __attribute__((ext_vector_type(2)));
constexpr int BM = 256, BK = 64, HALF = 128, HTB = HALF * BK * 2  , STAGE_BYTES = 8 * HTB, NXCD = 8, WGM = 8;

__host__ __device__ __forceinline__ int lds_byte(int r, int c) { const int st = (r >> 4) * 2 + (c >> 5), rr = r & 15, cc = c & 31, ob = rr * 64 + cc * 2; return st * 1024 + (ob ^ (((ob >> 9) & 1) << 5)); }
__host__ __device__ __forceinline__ void stage_rc(int b, int& R, int& C) { const int st = b / 1024, sb = b % 1024, swz = sb ^ (((sb >> 9) & 1) << 5); R = (st >> 1) * 16 + swz / 64; C = (st & 1) * 32 + (swz % 64) / 2; }
__host__ __device__ __forceinline__ int perm32(int rho) { const int n = rho >> 4, i = rho & 15; return 8 * (i >> 2) + 4 * n + (i & 3); }

struct Unit { int pm, pn, br; };

struct StaticOrder {
    int nM, nN, nwg, G, c;
    __host__ __device__ void init(int M, int N, int G_, int c_) { nM = M / BM; nN = N / BM; nwg = nM * nN; G = G_; c = c_; }
    __host__ __device__ bool next(int i, Unit& u) const {
        const long L = (long)i * G + c; if (L >= nwg) return false;
        int wgid = (int)L; { const int q = nwg / NXCD, r = nwg % NXCD, xcd = wgid % NXCD, off = wgid / NXCD; wgid = (xcd < r ? xcd * (q + 1) : r * (q + 1) + (xcd - r) * q) + off; }
        const int nig = WGM * nN, gid = wgid / nig, fm = gid * WGM, gsz = (nM - fm) < WGM ? (nM - fm) : WGM;
        u.pm = fm + ((wgid % nig) % gsz); u.pn = (wgid % nig) / gsz; return true;
    }
};
struct Sched1 {
    StaticOrder so; const char* A; const char* Bt; size_t tstep;
    __device__ __forceinline__ bool next(int i, Unit& u) const { u.br = 0; return so.next(i, u); }
    __device__ __forceinline__ const char* abase(const Unit& u) const { return A + (size_t)u.pm * tstep; }
    __device__ __forceinline__ const char* bbase(const Unit& u) const { return Bt + (size_t)u.pn * tstep; }
    __device__ __forceinline__ void a_ready(const Unit&) const {}
    __device__ __forceinline__ void done(const Unit&) const {}
};
struct Sched3 {
    StaticOrder so; const char* A; const char* Bt; size_t tstep, strideA, strideB;
    __device__ __forceinline__ bool next(int i, Unit& u) const { u.br = i % 3; return so.next(i / 3, u); }
    __device__ __forceinline__ const char* abase(const Unit& u) const { return A + (size_t)u.br * strideA + (size_t)u.pm * tstep; }
    __device__ __forceinline__ const char* bbase(const Unit& u) const { return Bt + (size_t)u.br * strideB + (size_t)u.pn * tstep; }
    __device__ __forceinline__ void a_ready(const Unit&) const {}
    __device__ __forceinline__ void done(const Unit&) const {}
};

typedef float f32x2_t __attribute__((ext_vector_type(2))); typedef __bf16 bf16x2v_t __attribute__((ext_vector_type(2)));
__device__ __forceinline__ unsigned cvt_pk_bf16(float lo, float hi) { const f32x2_t v = {lo, hi}; const bf16x2v_t b = __builtin_convertvector(v, bf16x2v_t); return __builtin_bit_cast(unsigned, b); }
__device__ __forceinline__ u32x4 pack8(const f32x4 a, const f32x4 b) { u32x4 w; w.x = cvt_pk_bf16(a[0], a[1]); w.y = cvt_pk_bf16(a[2], a[3]); w.z = cvt_pk_bf16(b[0], b[1]); w.w = cvt_pk_bf16(b[2], b[3]); return w; }
__device__ __forceinline__ float bflo(unsigned u) { return __builtin_bit_cast(float, u << 16); }
__device__ __forceinline__ float bfhi(unsigned u) { return __builtin_bit_cast(float, u & 0xffff0000u); }


constexpr float RMS_EPS = 1e-6f;

struct EpiProj {
    static constexpr bool PERM = true, AFTER_DRAIN = false;
    const float* rstd; bf16_t *qn, *kn, *pp, *xq, *gates; const float *qg, *kg, *gate_b;
    __device__ __forceinline__ void operator()(const f32x4 (&acc)[2][2][4][2], const Unit& u, int wr, int wc, int fr, int fq) const {
        const int pn = u.pn, row0 = u.pm * BM + wr * 64 + fr, lc0 = 64 * wc + 8 * fq;
        if (pn < 4) {
            const bool isq = pn < 2; bf16_t* O = isq ? qn : kn; const float* g = isq ? qg : kg; const float post = isq ? 0.125f : 1.0f;
            f32x4 gv[2][2];
#pragma unroll
            for (int bj = 0; bj < 2; ++bj)
#pragma unroll
                for (int n = 0; n < 2; ++n) gv[bj][n] = *(const f32x4*)(g + 32 * bj + 8 * fq + 4 * n);
            const int colbase = (pn & 1) * 256 + lc0;
#pragma unroll
            for (int ai = 0; ai < 2; ++ai)
#pragma unroll
                for (int m = 0; m < 4; ++m) {
                    const int row = row0 + ai * HALF + m * 16; const float rs = rstd[row];
                    f32x4 v[2][2]; float ss = 0.f;
#pragma unroll
                    for (int bj = 0; bj < 2; ++bj)
#pragma unroll
                        for (int n = 0; n < 2; ++n) { v[bj][n] = acc[ai][bj][m][n] * rs; ss += (v[bj][n][0] * v[bj][n][0] + v[bj][n][1] * v[bj][n][1]) + (v[bj][n][2] * v[bj][n][2] + v[bj][n][3] * v[bj][n][3]); }
                    ss += __shfl_xor(ss, 16); ss += __shfl_xor(ss, 32);
                    const float r = rsqrtf(ss * (1.0f / 64.0f) + RMS_EPS) * post;
#pragma unroll
                    for (int bj = 0; bj < 2; ++bj) *(u32x4*)(O + (size_t)row * 512 + colbase + 32 * bj) = pack8(v[bj][0] * r * gv[bj][0], v[bj][1] * r * gv[bj][1]);
                }
        } else if (pn < 8) {
            bf16_t* O = pn < 6 ? pp : xq; const int colbase = (pn & 1) * 256 + lc0;
#pragma unroll
            for (int ai = 0; ai < 2; ++ai)
#pragma unroll
                for (int m = 0; m < 4; ++m) {
                    const int row = row0 + ai * HALF + m * 16; const float rs = rstd[row];
#pragma unroll
                    for (int bj = 0; bj < 2; ++bj) *(u32x4*)(O + (size_t)row * 512 + colbase + 32 * bj) = pack8(acc[ai][bj][m][0] * rs, acc[ai][bj][m][1] * rs);
                }
        } else {
            const int gcol0 = (pn - 8) * 256 + lc0;
            f32x4 bv[2][2];
#pragma unroll
            for (int bj = 0; bj < 2; ++bj)
#pragma unroll
                for (int n = 0; n < 2; ++n) bv[bj][n] = *(const f32x4*)(gate_b + gcol0 + 32 * bj + 4 * n);
#pragma unroll
            for (int ai = 0; ai < 2; ++ai)
#pragma unroll
                for (int m = 0; m < 4; ++m) {
                    const int row = row0 + ai * HALF + m * 16; const float rs = rstd[row];
#pragma unroll
                    for (int bj = 0; bj < 2; ++bj) {
                        f32x4 o[2];
#pragma unroll
                        for (int n = 0; n < 2; ++n) { const f32x4 z = acc[ai][bj][m][n] * rs + bv[bj][n];
#pragma unroll
                            for (int i = 0; i < 4; ++i) o[n][i] = __builtin_amdgcn_rcpf(1.0f + __expf(-z[i])); }
                        *(u32x4*)(gates + (size_t)row * 3072 + gcol0 + 32 * bj) = pack8(o[0], o[1]);
                    }
                }
        }
    }
};
struct EpiVt {
    static constexpr bool PERM = true, AFTER_DRAIN = false;
    const float* rstd; bf16_t* Vt;
    __device__ __forceinline__ void operator()(const f32x4 (&acc)[2][2][4][2], const Unit& u, int wr, int wc, int fr, int fq) const {
        const int ch0 = u.pm * BM + wr * 64 + fr, tok0 = u.pn * BM + wc * 32 + 8 * fq, b = tok0 >> 13, t0 = tok0 & 8191;
        f32x4 rv[2][2];
#pragma unroll
        for (int bj = 0; bj < 2; ++bj)
#pragma unroll
            for (int n = 0; n < 2; ++n) rv[bj][n] = *(const f32x4*)(rstd + tok0 + bj * HALF + 4 * n);
#pragma unroll
        for (int ai = 0; ai < 2; ++ai)
#pragma unroll
            for (int m = 0; m < 4; ++m) { const int ch = ch0 + ai * HALF + m * 16; bf16_t* rowp = Vt + ((size_t)(b * 512 + ch) * 8192 + t0);
#pragma unroll
                for (int bj = 0; bj < 2; ++bj) *(u32x4*)(rowp + bj * HALF) = pack8(acc[ai][bj][m][0] * rv[bj][0], acc[ai][bj][m][1] * rv[bj][1]); }
    }
};
struct EpiMerge {
    static constexpr bool PERM = true, AFTER_DRAIN = false;
    const bf16_t* gates; bf16_t* pa; bf16_t* merged;
    __device__ __forceinline__ void operator()(const f32x4 (&acc)[2][2][4][2], const Unit& u, int wr, int wc, int fr, int fq) const {
        const int row0 = u.pm * BM + wr * 64 + fr, col0 = u.pn * BM + wc * 32 + 8 * fq, br = u.br;
        const bf16_t* src = br == 1 ? pa : merged; bf16_t* dst = br == 0 ? pa : merged;
#pragma unroll
        for (int ai = 0; ai < 2; ++ai)
#pragma unroll
            for (int m = 0; m < 4; ++m) { const int row = row0 + ai * HALF + m * 16;
#pragma unroll
                for (int bj = 0; bj < 2; ++bj) {
                    const u32x4 g8 = *(const u32x4*)(gates + (size_t)row * 3072 + br * 1024 + col0 + bj * HALF);
                    const size_t mo = (size_t)row * 1024 + col0 + bj * HALF;
                    f32x4 a = acc[ai][bj][m][0], b = acc[ai][bj][m][1];
                    a[0] *= bflo(g8.x); a[1] *= bfhi(g8.x); a[2] *= bflo(g8.y); a[3] *= bfhi(g8.y); b[0] *= bflo(g8.z); b[1] *= bfhi(g8.z); b[2] *= bflo(g8.w); b[3] *= bfhi(g8.w);
                    if (br > 0) { const u32x4 p8 = *(const u32x4*)(src + mo);
                        a[0] += bflo(p8.x); a[1] += bfhi(p8.x); a[2] += bflo(p8.y); a[3] += bfhi(p8.y); b[0] += bflo(p8.z); b[1] += bfhi(p8.z); b[2] += bflo(p8.w); b[3] += bfhi(p8.w); }
                    *(u32x4*)(dst + mo) = pack8(a, b);
                } }
    }
};
struct EpiH {
    static constexpr bool PERM = true, AFTER_DRAIN = false;
    const float* x; float* out; bf16_t* hb; float* rowsq;
    __device__ __forceinline__ void operator()(const f32x4 (&acc)[2][2][4][2], const Unit& u, int wr, int wc, int fr, int fq) const {
        const int row0 = u.pm * BM + wr * 64 + fr, col0 = u.pn * BM + wc * 32 + 8 * fq;
#pragma unroll
        for (int ai = 0; ai < 2; ++ai)
#pragma unroll
            for (int m = 0; m < 4; ++m) { const int row = row0 + ai * HALF + m * 16; float ss = 0.f;
#pragma unroll
                for (int bj = 0; bj < 2; ++bj) { const size_t o = (size_t)row * 1024 + col0 + bj * HALF;
                    const f32x4 h0 = *(const f32x4*)(x + o) + acc[ai][bj][m][0], h1 = *(const f32x4*)(x + o + 4) + acc[ai][bj][m][1];
                    *(f32x4*)(out + o) = h0; *(f32x4*)(out + o + 4) = h1; *(u32x4*)(hb + o) = pack8(h0, h1);
                    ss += (h0[0] * h0[0] + h0[1] * h0[1]) + (h0[2] * h0[2] + h0[3] * h0[3]) + (h1[0] * h1[0] + h1[1] * h1[1]) + (h1[2] * h1[2] + h1[3] * h1[3]); }
                ss += __shfl_xor(ss, 16); ss += __shfl_xor(ss, 32);
                if (fq == 0) atomicAdd(rowsq + row, ss); }
    }
};
struct EpiQ {
    static constexpr bool PERM = true, AFTER_DRAIN = false;
    const float* rowsq; bf16_t* qb;
    __device__ __forceinline__ void operator()(const f32x4 (&acc)[2][2][4][2], const Unit& u, int wr, int wc, int fr, int fq) const {
        const int row0 = u.pm * BM + wr * 64 + fr, col0 = u.pn * BM + wc * 32 + 8 * fq;
#pragma unroll
        for (int ai = 0; ai < 2; ++ai)
#pragma unroll
            for (int m = 0; m < 4; ++m) { const int row = row0 + ai * HALF + m * 16; const float r = rsqrtf(rowsq[row] * (1.0f / 1024.0f) + RMS_EPS);
#pragma unroll
                for (int bj = 0; bj < 2; ++bj) *(u32x4*)(qb + (size_t)row * 2048 + col0 + bj * HALF) = pack8(acc[ai][bj][m][0] * r, acc[ai][bj][m][1] * r); }
    }
};

template <class Epi, class Sched, bool ALIGN_EPI = false, bool SP2 = false>
__device__ __forceinline__ void gemm_phase(PG8_LAS unsigned char* lds, const int K, const Sched& S, const Epi& E) {
    const int tid = threadIdx.x, wid = __builtin_amdgcn_readfirstlane(tid >> 6), lane = tid & 63, wr = wid >> 2, wc = wid & 3, fr = lane & 15, fq = lane >> 4;
    const int nt = K / BK;
    unsigned voffA[2], voffB[2];
#pragma unroll
    for (int i = 0; i < 2; ++i) { int R, C; stage_rc(tid * 16 + i * 8192, R, C); const int Rb = Epi::PERM ? ((R & ~31) + perm32(R & 31)) : R;
        voffA[i] = (unsigned)(R * K + C) * 2u; voffB[i] = (unsigned)(Rb * K + C) * 2u; }
    const size_t kstep = (size_t)(BK * 2);
    const size_t hstep = (size_t)HALF * K * 2;
    const size_t tstep = 2 * hstep;
    const unsigned ldsw = (unsigned)wid * 1024u;
    const int aoff = lds_byte(wr * 64 + fr, fq * 8), boff = lds_byte(wc * 32 + fr, fq * 8);
#define PG8_SA(b, h) (((b) * 2 + (h)) * HTB)
#define PG8_SB(b, h) ((4 + (b) * 2 + (h)) * HTB)
#define PG8_STAGE(bufoff, gbase, voff) do { _Pragma("unroll") for (int _i = 0; _i < 2; ++_i) \
        __builtin_amdgcn_global_load_lds((const unsigned*)((const char*)(gbase) + (voff)[_i]), (PG8_LAS unsigned*)(lds + (bufoff) + ldsw + _i * 8192), 16, 0, 0); } while (0)
#define PG8_LDA(dst, b, h) do { _Pragma("unroll") for (int m = 0; m < 4; ++m) _Pragma("unroll") for (int k = 0; k < 2; ++k) dst[m][k] = *(const PG8_LAS bf16x8*)(lds + PG8_SA(b, h) + aoff + m * 2048 + k * 1024); } while (0)
#define PG8_LDB(dst, b, h) do { _Pragma("unroll") for (int n = 0; n < 2; ++n) _Pragma("unroll") for (int k = 0; k < 2; ++k) dst[n][k] = *(const PG8_LAS bf16x8*)(lds + PG8_SB(b, h) + boff + n * 2048 + k * 1024); } while (0)
#define PG8_MMA(ai, bj, At, Bt) do { __builtin_amdgcn_s_setprio(1); _Pragma("unroll") for (int m = 0; m < 4; ++m) _Pragma("unroll") for (int n = 0; n < 2; ++n) _Pragma("unroll") for (int k = 0; k < 2; ++k) \
        acc[ai][bj][m][n] = __builtin_amdgcn_mfma_f32_16x16x32_bf16(Bt[n][k], At[m][k], acc[ai][bj][m][n], 0, 0, 0); __builtin_amdgcn_s_setprio(0); } while (0)
#define PG8_WAIT_V(n) asm volatile("s_waitcnt vmcnt(" #n ")" ::: "memory")
#define PG8_WAIT_L(n) asm volatile("s_waitcnt lgkmcnt(" #n ")" ::: "memory")
#define PG8_BAR __builtin_amdgcn_s_barrier()
#define PG8_SCHED __builtin_amdgcn_sched_barrier(0)
    Unit cur, nxt; int ui = 0;
    if (!S.next(0, cur)) return;
    f32x4 acc[2][2][4][2];
#pragma unroll
    for (int a = 0; a < 2; ++a)
#pragma unroll
        for (int b = 0; b < 2; ++b)
#pragma unroll
            for (int m = 0; m < 4; ++m)
#pragma unroll
                for (int n = 0; n < 2; ++n) acc[a][b][m][n] = (f32x4){0.f, 0.f, 0.f, 0.f};
    bf16x8 At[4][2], B0[2][2], B1[2][2];
    const char* cA = S.abase(cur); const char* cB = S.bbase(cur);
    S.a_ready(cur);
    if constexpr (SP2) {
        PG8_STAGE(PG8_SB(0, 0), cB, voffB); PG8_STAGE(PG8_SB(0, 1), cB + hstep, voffB); PG8_STAGE(PG8_SA(0, 0), cA, voffA); PG8_STAGE(PG8_SA(0, 1), cA + hstep, voffA);
        if (wr == 1) PG8_BAR;
        PG8_WAIT_V(2); PG8_BAR;
        PG8_STAGE(PG8_SB(1, 0), cB + kstep, voffB); PG8_STAGE(PG8_SA(1, 0), cA + kstep, voffA); PG8_STAGE(PG8_SB(1, 1), cB + hstep + kstep, voffB);
        PG8_WAIT_V(6); PG8_BAR;
    } else {
        PG8_STAGE(PG8_SB(0, 0), cB, voffB); PG8_STAGE(PG8_SA(0, 0), cA, voffA); PG8_STAGE(PG8_SB(0, 1), cB + hstep, voffB); PG8_STAGE(PG8_SA(0, 1), cA + hstep, voffA);
        if (wr == 1) PG8_BAR;
        PG8_WAIT_V(4); PG8_BAR;
        PG8_STAGE(PG8_SB(1, 0), cB + kstep, voffB); PG8_STAGE(PG8_SA(1, 0), cA + kstep, voffA); PG8_STAGE(PG8_SB(1, 1), cB + hstep + kstep, voffB);
        PG8_WAIT_V(6); PG8_BAR;
    }
    for (;;) {
        const bool has_next = S.next(ui + 1, nxt);
        const char* nA = has_next ? S.abase(nxt) : cA; const char* nB = has_next ? S.bbase(nxt) : cB;
        for (int t = 0; t < nt; t += 2) {
            const bool last = (t == nt - 2);
            const char* a1 = cA + (size_t)(t + 1) * kstep;
            const char* a2 = last ? nA : cA + (size_t)(t + 2) * kstep; const char* b2 = last ? nB : cB + (size_t)(t + 2) * kstep;
            const char* a3 = a2 + kstep; const char* b3 = b2 + kstep;
            if (last && has_next) S.a_ready(nxt);
            if constexpr (SP2) {
            PG8_LDB(B0, 0, 0); PG8_LDB(B1, 0, 1); PG8_SCHED; PG8_LDA(At, 0, 0); PG8_STAGE(PG8_SA(1, 1), a1 + hstep, voffA);
            PG8_WAIT_V(8); PG8_WAIT_L(0); PG8_BAR; PG8_MMA(0, 0, At, B0); PG8_MMA(0, 1, At, B1); PG8_BAR; PG8_SCHED;
            PG8_LDA(At, 0, 1); PG8_STAGE(PG8_SB(0, 0), b2, voffB); PG8_STAGE(PG8_SB(0, 1), b2 + hstep, voffB); PG8_STAGE(PG8_SA(0, 0), a2, voffA);
            PG8_WAIT_V(8); PG8_WAIT_L(0); PG8_BAR; PG8_MMA(1, 0, At, B0); PG8_MMA(1, 1, At, B1); PG8_BAR; PG8_SCHED;
            PG8_LDB(B0, 1, 0); PG8_LDB(B1, 1, 1); PG8_SCHED; PG8_LDA(At, 1, 0); PG8_STAGE(PG8_SA(0, 1), a2 + hstep, voffA);
            PG8_WAIT_V(8); PG8_WAIT_L(0); PG8_BAR; PG8_MMA(0, 0, At, B0); PG8_MMA(0, 1, At, B1); PG8_BAR; PG8_SCHED;
            PG8_LDA(At, 1, 1); PG8_STAGE(PG8_SB(1, 0), b3, voffB); PG8_STAGE(PG8_SB(1, 1), b3 + hstep, voffB); PG8_STAGE(PG8_SA(1, 0), a3, voffA);
            PG8_WAIT_V(8); PG8_WAIT_L(0); PG8_BAR; PG8_MMA(1, 0, At, B0); PG8_MMA(1, 1, At, B1); PG8_BAR; PG8_SCHED;
            } else {
            PG8_LDB(B0, 0, 0); PG8_SCHED; PG8_LDA(At, 0, 0); PG8_STAGE(PG8_SA(1, 1), a1 + hstep, voffA);
            PG8_WAIT_L(8); PG8_BAR; PG8_WAIT_L(0); PG8_MMA(0, 0, At, B0); PG8_BAR; PG8_SCHED;
            PG8_LDB(B1, 0, 1); PG8_STAGE(PG8_SB(0, 0), b2, voffB);
            PG8_BAR; PG8_WAIT_L(0); PG8_MMA(0, 1, At, B1); PG8_BAR;
            PG8_LDA(At, 0, 1); PG8_STAGE(PG8_SA(0, 0), a2, voffA);
            PG8_BAR; PG8_WAIT_L(0); PG8_MMA(1, 0, At, B0); PG8_BAR; PG8_SCHED;
            PG8_STAGE(PG8_SB(0, 1), b2 + hstep, voffB);
            PG8_WAIT_V(6); PG8_BAR; PG8_MMA(1, 1, At, B1); PG8_BAR;
            PG8_LDB(B0, 1, 0); PG8_SCHED; PG8_LDA(At, 1, 0); PG8_STAGE(PG8_SA(0, 1), a2 + hstep, voffA);
            PG8_WAIT_L(8); PG8_BAR; PG8_WAIT_L(0); PG8_MMA(0, 0, At, B0); PG8_BAR; PG8_SCHED;
            PG8_LDB(B1, 1, 1); PG8_STAGE(PG8_SB(1, 0), b3, voffB);
            PG8_BAR; PG8_WAIT_L(0); PG8_MMA(0, 1, At, B1); PG8_BAR;
            PG8_LDA(At, 1, 1); PG8_STAGE(PG8_SA(1, 0), a3, voffA);
            PG8_BAR; PG8_WAIT_L(0); PG8_MMA(1, 0, At, B0); PG8_BAR; PG8_SCHED;
            PG8_STAGE(PG8_SB(1, 1), b3 + hstep, voffB);
            PG8_WAIT_V(6); PG8_BAR; PG8_MMA(1, 1, At, B1); PG8_BAR;
            }
        }
        if constexpr (ALIGN_EPI) { if (wr == 0) PG8_BAR; }
        if constexpr (!Epi::AFTER_DRAIN) { E(acc, cur, wr, wc, fr, fq); S.done(cur); }
        if (!has_next) break;
#pragma unroll
        for (int a = 0; a < 2; ++a)
#pragma unroll
            for (int b = 0; b < 2; ++b)
#pragma unroll
                for (int m = 0; m < 4; ++m)
#pragma unroll
                    for (int n = 0; n < 2; ++n) acc[a][b][m][n] = (f32x4){0.f, 0.f, 0.f, 0.f};
        cur = nxt; cA = nA; cB = nB; ++ui;
        if constexpr (ALIGN_EPI) { if (wr == 1) PG8_BAR; }
    }
    PG8_WAIT_V(0);
    if constexpr (!ALIGN_EPI) { if (wr == 0) PG8_BAR; }
    PG8_BAR;
    if constexpr (Epi::AFTER_DRAIN) { E.fused(acc, cur, wr, wc, fr, fq, lds, wid, lane); S.done(cur); }
#undef PG8_SA
#undef PG8_SB
#undef PG8_STAGE
#undef PG8_LDA
#undef PG8_LDB
#undef PG8_MMA
#undef PG8_WAIT_V
#undef PG8_WAIT_L
#undef PG8_BAR
#undef PG8_SCHED
}
}

constexpr int NWAVES = 8;
constexpr int N_LAUNCHES = MK_N_LAUNCHES;
constexpr int PER_PHASE = 8;
constexpr int NBATCH = 4, SEQ = 8192, D = 1024, T = NBATCH * SEQ, MEMLEN = 256, NMEMTOK = NBATCH * MEMLEN;
constexpr int IN_MAIN = 5120;
constexpr int NEXP = 16384;

constexpr size_t MiB = 1u << 20;
constexpr size_t WS_CTL = 0, CTL_ZERO_BYTES = 512 * 1024;
constexpr size_t WS_ROWSQ = 256 * 1024;
constexpr size_t WS_WIN = 1 * MiB, WS_WV = 11 * MiB, WS_WKV = 12 * MiB, WS_WBR = 14 * MiB, WS_WOUT = 17 * MiB, WS_WQ = 19 * MiB, WS_KEYS = 23 * MiB, WS_PWT = 23 * MiB + 512 * 1024;
constexpr size_t WS_MEMN = 24 * MiB, WS_KMEM = 26 * MiB, WS_VTMEM = 27 * MiB, WS_RSTDX = 28 * MiB, WS_SU = 28 * MiB + 256 * 1024, WS_SV = 28 * MiB + 512 * 1024;
constexpr size_t WS_U8 = 32 * MiB, WS_V8 = 48 * MiB;
constexpr size_t WS_QN = 96 * MiB, WS_KN = 128 * MiB, WS_VT = 160 * MiB, WS_PP = 192 * MiB, WS_XQ = 224 * MiB, WS_GATE = 256 * MiB, WS_END = 448 * MiB;
constexpr size_t WS_MERGED = WS_QN;
constexpr size_t WS_HB = WS_VT;
constexpr size_t WS_QB = WS_GATE;
constexpr size_t WS_TE = WS_GATE + 128 * MiB, WS_TW = WS_TE + 16 * MiB;
constexpr size_t OUT_XB = 0, OUT_YNA = 0, OUT_YPOOL = 32 * MiB, OUT_YXA = 64 * MiB;
constexpr int CW_TMO = 0, CW_BAR = 4096;

constexpr int RING_OFF = 0, RING_BYTES = 131072;
constexpr int LDSCTL_OFF = RING_BYTES, MISC_OFF = LDSCTL_OFF + 320;
constexpr int LDS_BYTES = 147456;

#define GAS __attribute__((address_space(1)))
#define LAS __attribute__((address_space(3)))
typedef unsigned short bf16;
typedef unsigned v4u __attribute__((ext_vector_type(4)));
typedef unsigned v2u __attribute__((ext_vector_type(2)));
typedef float f32x4 __attribute__((ext_vector_type(4)));
typedef short bf16x8 __attribute__((ext_vector_type(8)));
typedef __bf16 bf16x2_t __attribute__((ext_vector_type(2)));
typedef GAS unsigned gu32;
#define LDS_WAIT() asm volatile("s_waitcnt lgkmcnt(0)" ::: "memory")
#define VM_WAIT() asm volatile("s_waitcnt vmcnt(0)" ::: "memory")
__device__ __forceinline__ unsigned f2bf(float f) { unsigned u = __builtin_bit_cast(unsigned, f); return (u + 0x7fffu + ((u >> 16) & 1u)) >> 16; }
__device__ __forceinline__ unsigned pk2(float lo, float hi) { return f2bf(lo) | (f2bf(hi) << 16); }
__device__ __forceinline__ float bflo(unsigned u) { return __builtin_bit_cast(float, u << 16); }
__device__ __forceinline__ float bfhi(unsigned u) { return __builtin_bit_cast(float, u & 0xffff0000u); }
__device__ __forceinline__ float bf1(short s) { return __builtin_bit_cast(float, ((unsigned)(unsigned short)s) << 16); }
__device__ __forceinline__ f32x4 mfma16(bf16x8 a, bf16x8 b, f32x4 c) { return __builtin_amdgcn_mfma_f32_16x16x32_bf16(a, b, c, 0, 0, 0); }
__device__ __forceinline__ float wave_sum(float v) {
#pragma unroll
    for (int o = 1; o < 64; o <<= 1) v += __shfl_xor(v, o);
    return v;
}

#define XB_TMO      128
#define XB_XCNT(j)  (256  + 64 * (j))
#define XB_XSUB(j)  (1280 + 64 * (j))
#define XB_XGEN(j)  (2304 + 64 * (j))
#define XB_TOP      3328
#define XB_TOPGEN   3392
#define XCD_BAR_WORDS 3456
#define XB_SPIN_CAP (1u << 18)

__device__ __forceinline__ unsigned xb_ld(unsigned* p)              { return __hip_atomic_load(p, __ATOMIC_RELAXED, __HIP_MEMORY_SCOPE_AGENT); }
__device__ __forceinline__ unsigned xb_add(unsigned* p, unsigned v) { return __hip_atomic_fetch_add(p, v, __ATOMIC_RELAXED, __HIP_MEMORY_SCOPE_AGENT); }
__device__ __forceinline__ unsigned xb_xcc_id() { return (unsigned)__builtin_amdgcn_s_getreg((3 << 11) | 20) & 0xFu; }
#define XB_SPIN(cond, bar) do { unsigned _sp = 0; while (cond) { __builtin_amdgcn_s_sleep(1); \
    if ((++_sp & 255u) == 0u) { if (xb_ld(&(bar)[XB_TMO])) break; if (_sp > XB_SPIN_CAP) { atomicAdd(&(bar)[XB_TMO], 1u); break; } } } } while (0)

struct XcdBarrier {
    unsigned* bar; unsigned x;
    volatile LAS unsigned* st;
};

__device__ __forceinline__ XcdBarrier xcd_barrier_post(unsigned* bar, volatile LAS unsigned* st) {
    XcdBarrier b; b.bar = bar; b.x = xb_xcc_id(); b.st = st;
    if (threadIdx.x == 0) (void)xb_add(&bar[XB_XCNT(b.x)], 1u);
    return b;
}
__device__ __forceinline__ void xcd_barrier_complete(unsigned* bar, unsigned x, unsigned& nloc, unsigned& nx) {
    const unsigned G = gridDim.x * gridDim.y * gridDim.z;
    unsigned sum, cnt, mine, sp = 0u;
    for (;;) {
        sum = 0u; cnt = 0u; mine = 0u;
#pragma unroll
        for (unsigned j = 0; j < 16; ++j) { const unsigned c = xb_ld(&bar[XB_XCNT(j)]); sum += c; cnt += (c > 0u) ? 1u : 0u; mine = (j == x) ? c : mine; }
        if (sum == G) break;
        __builtin_amdgcn_s_sleep(1);
        if ((++sp & 255u) == 0u) { if (xb_ld(&bar[XB_TMO])) break; if (sp > XB_SPIN_CAP) { atomicAdd(&bar[XB_TMO], 1u); break; } }
    }
    nloc = mine > 0u ? mine : 1u; nx = cnt > 0u ? cnt : 1u;
}

__device__ __forceinline__ void xcd_barrier(const XcdBarrier& b) {
    asm volatile("s_waitcnt vmcnt(0)" ::: "memory");
    __syncthreads();
    if (threadIdx.x == 0) {
        unsigned* bar = b.bar;
        __builtin_amdgcn_s_waitcnt(0);
        unsigned nloc = b.st[0], nx = b.st[1];
        if (nloc == 0u) { xcd_barrier_complete(bar, b.x, nloc, nx); b.st[0] = nloc; b.st[1] = nx; }
        const unsigned old = xb_add(&bar[XB_XSUB(b.x)], 1u);
        const unsigned gen = old / nloc;
        if (old + 1u == (gen + 1u) * nloc) {
            __builtin_amdgcn_fence(__ATOMIC_RELEASE, "agent");
            asm volatile("s_waitcnt vmcnt(0)" ::: "memory");
            const unsigned og = xb_add(&bar[XB_TOP], 1u);
            const unsigned tg = og / nx;
            if (og + 1u == (tg + 1u) * nx) xb_add(&bar[XB_TOPGEN], 1u);
            else XB_SPIN(xb_ld(&bar[XB_TOPGEN]) == tg, bar);
            __builtin_amdgcn_fence(__ATOMIC_ACQUIRE, "agent");
            xb_add(&bar[XB_XGEN(b.x)], 1u);
            asm volatile("s_waitcnt vmcnt(0)" ::: "memory");
        } else {
            XB_SPIN(xb_ld(&bar[XB_XGEN(b.x)]) == gen, bar);
            __builtin_amdgcn_fence(__ATOMIC_ACQUIRE, "agent");
            asm volatile("s_waitcnt vmcnt(0)" ::: "memory");
        }
    }
    __syncthreads();
}

struct Frame {
    LAS unsigned char* lds;
    volatile LAS unsigned* MISC;
    gu32* ctl;
    int tid, lane, wave, vcu, G;
    float* out; unsigned char* ws;
};
struct Args { const float* in[23]; float* out; unsigned char* ws; int ph_lo, ph_hi; };
enum { I_X = 0, I_MEM, I_MIXG, I_MEMG, I_WIN, I_GATEB, I_WKV, I_NAQG, I_NAKG, I_RPB, I_POOLW, I_POOLSC, I_XAQG, I_XAKG, I_WB0, I_WB1, I_WB2, I_WOUT, I_FFNG, I_WQ, I_KEYS, I_PU, I_PV };

__device__ __forceinline__ void p0_transpose_item(const float* W, int K, int N, int k0, int n0, bf16* dst, const float* kscale, LAS float* scr, int lane) {
#pragma unroll 8
    for (int i = 0; i < 32; ++i) { const int kk = 2 * i + (lane >> 5); float v = W[(size_t)(k0 + kk) * N + n0 + (lane & 31)]; if (kscale) v *= kscale[k0 + kk]; scr[kk * 33 + (lane & 31)] = v; }
    LDS_WAIT(); asm volatile("" ::: "memory");
    const int c = lane & 7;
#pragma unroll
    for (int j = 0; j < 4; ++j) { const int n = (lane >> 3) + 8 * j; const LAS float* s = scr + (8 * c) * 33 + n;
        v4u o; o.x = pk2(s[0 * 33], s[1 * 33]); o.y = pk2(s[2 * 33], s[3 * 33]); o.z = pk2(s[4 * 33], s[5 * 33]); o.w = pk2(s[6 * 33], s[7 * 33]);
        *(GAS v4u*)(dst + (size_t)n * K + k0 + 8 * c) = o; }
    LDS_WAIT(); asm volatile("" ::: "memory");
}
__device__ __forceinline__ void cvt_row1024(const float* src, bf16* dst, const float* colscale, float rowscale, int lane) {
    const GAS f32x4* xr = (const GAS f32x4*)src + lane; GAS unsigned long long* o8 = (GAS unsigned long long*)dst + lane;
#pragma unroll
    for (int j = 0; j < 4; ++j) { f32x4 v = xr[64 * j] * rowscale; if (colscale) v = v * ((const GAS f32x4*)colscale)[lane + 64 * j];
        o8[64 * j] = (unsigned long long)pk2(v.x, v.y) | ((unsigned long long)pk2(v.z, v.w) << 32); }
}
__device__ __forceinline__ float row_rstd1024(const float* src, int lane) {
    const GAS f32x4* xr = (const GAS f32x4*)src + lane; float s = 0.f;
#pragma unroll
    for (int j = 0; j < 4; ++j) { const f32x4 v = xr[64 * j]; s += (v.x * v.x + v.y * v.y) + (v.z * v.z + v.w * v.w); }
    return rsqrtf(wave_sum(s) * (1.0f / 1024.0f) + 1e-6f);
}
__device__ __forceinline__ void p0_prologue(Frame& F, const Args& A) {
    LAS float* scr = (LAS float*)(F.lds + RING_OFF + F.wave * 16384);
    const int gw = F.vcu * NWAVES + F.wave, NGW = F.G * NWAVES, lane = F.lane;
    unsigned char* ws = F.ws;
    constexpr int I_IN = 16 * 176, I_KV = 16 * 32, I_BR = 8 * 32, I_OUT = 16 * 32, I_Q = 16 * 64;
    constexpr int NITEMS = I_IN + I_KV + 3 * I_BR + I_OUT + I_Q;
    for (int it = gw; it < NITEMS; it += NGW) {
        int r = it;
        if (r < I_IN) { const int kb = r / 176, nb = r % 176, n0 = 32 * nb; bf16* dst;
            if (n0 >= 1024 && n0 < 1536) dst = (bf16*)(ws + WS_WV) + (size_t)(n0 - 1024) * 1024;
            else { const int np = n0 < 1024 ? n0 : n0 - 512, t = np >> 8, w = np & 255, wc = w >> 6, bj = (w >> 5) & 1; dst = (bf16*)(ws + WS_WIN) + (size_t)(256 * t + 128 * bj + 32 * wc) * 1024; }
            p0_transpose_item(A.in[I_WIN], 1024, 5632, 64 * kb, n0, dst, A.in[I_MIXG], scr, lane); continue; }
        r -= I_IN;
        if (r < I_KV) { const int kb = r / 32, nb = r % 32; p0_transpose_item(A.in[I_WKV], 1024, 1024, 64 * kb, 32 * nb, (bf16*)(ws + WS_WKV) + (size_t)(32 * nb) * 1024, nullptr, scr, lane); continue; }
        r -= I_KV;
        if (r < 3 * I_BR) { const int br = r / I_BR, rr = r % I_BR, kb = rr / 32, nb = rr % 32; const float* W = br == 0 ? A.in[I_WB0] : (br == 1 ? A.in[I_WB1] : A.in[I_WB2]);
            p0_transpose_item(W, 512, 1024, 64 * kb, 32 * nb, (bf16*)(ws + WS_WBR) + (size_t)br * 1024 * 512 + (size_t)(32 * nb) * 512, nullptr, scr, lane); continue; }
        r -= 3 * I_BR;
        if (r < I_OUT) { const int kb = r / 32, nb = r % 32; p0_transpose_item(A.in[I_WOUT], 1024, 1024, 64 * kb, 32 * nb, (bf16*)(ws + WS_WOUT) + (size_t)(32 * nb) * 1024, nullptr, scr, lane); continue; }
        r -= I_OUT;
        { const int kb = r / 64, nb = r % 64; p0_transpose_item(A.in[I_WQ], 1024, 2048, 64 * kb, 32 * nb, (bf16*)(ws + WS_WQ) + (size_t)(32 * nb) * 1024, A.in[I_FFNG], scr, lane); }
    }
    { bf16* xb = (bf16*)((unsigned char*)F.out + OUT_XB); float* rstdx = (float*)(ws + WS_RSTDX);
      for (int m = gw; m < T; m += NGW) { const float* xr = A.in[I_X] + (size_t)m * D; const float rs = row_rstd1024(xr, lane); cvt_row1024(xr, xb + (size_t)m * D, nullptr, 1.0f, lane); if (lane == 0) rstdx[m] = rs; } }
    for (int m = gw; m < NMEMTOK; m += NGW) { const float* xr = A.in[I_MEM] + (size_t)m * D; const float rs = row_rstd1024(xr, lane); cvt_row1024(xr, (bf16*)(ws + WS_MEMN) + (size_t)m * D, A.in[I_MEMG], rs, lane); }
    for (int m = gw; m < 2 * NEXP; m += NGW) {
        const bool isu = m < NEXP; const int e = isu ? m : m - NEXP;
        const GAS f32x4* src = (const GAS f32x4*)((isu ? A.in[I_PU] : A.in[I_PV]) + (size_t)e * D) + 4 * lane;
        f32x4 v[4]; float mx = 0.f;
#pragma unroll
        for (int d = 0; d < 4; ++d) { v[d] = src[d]; if (isu) v[d] = v[d] * ((const GAS f32x4*)A.in[I_FFNG])[4 * lane + d];
            mx = fmaxf(mx, fmaxf(fmaxf(fabsf(v[d].x), fabsf(v[d].y)), fmaxf(fabsf(v[d].z), fabsf(v[d].w)))); }
#pragma unroll
        for (int o = 1; o < 64; o <<= 1) mx = fmaxf(mx, __shfl_xor(mx, o));
        const float inv = mx > 0.f ? 127.0f / mx : 0.f; const int off = isu ? 0 : 128;
        v4u w;
#pragma unroll
        for (int d = 0; d < 4; ++d) { const unsigned b0 = (unsigned)((int)rintf(v[d].x * inv) + off) & 0xffu, b1 = (unsigned)((int)rintf(v[d].y * inv) + off) & 0xffu,
                                                     b2 = (unsigned)((int)rintf(v[d].z * inv) + off) & 0xffu, b3 = (unsigned)((int)rintf(v[d].w * inv) + off) & 0xffu;
            w[d] = b0 | (b1 << 8) | (b2 << 16) | (b3 << 24); }
        ((GAS v4u*)(ws + (isu ? WS_U8 : WS_V8)))[(size_t)e * 64 + lane] = w;
        if (lane == 0) ((float*)(ws + (isu ? WS_SU : WS_SV)))[e] = mx * (1.0f / 127.0f);
    }
    for (int m = gw * 64 + lane; m < T; m += NGW * 64) ((float*)(ws + WS_ROWSQ))[m] = 0.f;
    for (int m = gw; m < 256; m += NGW) cvt_row1024(A.in[I_KEYS] + (size_t)m * 1024, (bf16*)(ws + WS_KEYS) + (size_t)m * 1024, nullptr, 1.0f, lane);
    for (int m = gw; m < 1024; m += NGW) { const int gd = m >> 1, c = (m & 1) * 64 + lane, g = gd >> 7, d = gd & 127;
        const float v = A.in[I_POOLW][(size_t)(g * 128 + c) * 128 + d] * A.in[I_POOLSC][gd];
        ((bf16*)(ws + WS_PWT))[(size_t)gd * 128 + c] = (bf16)f2bf(v); }
}

__device__ __forceinline__ void memkv_tile(const bf16* memn, const bf16* wkvT, const float* kg, const float* qg, bf16* kmem, bf16* vtmem, int tile, int lane) {
    const int q = lane & 15, hi = lane >> 4, rg = tile >> 3, cg = tile & 7, r0 = rg * 16, c0 = cg * 128;
    f32x4 acc[8];
#pragma unroll
    for (int i = 0; i < 8; ++i) acc[i] = (f32x4){0.f, 0.f, 0.f, 0.f};
    const bf16* ap = memn + (size_t)(r0 + q) * 1024 + 8 * hi; const bf16* bp = wkvT + (size_t)(c0 + q) * 1024 + 8 * hi;
#pragma unroll 2
    for (int ks = 0; ks < 32; ++ks) { const bf16x8 a = *(const bf16x8*)(ap + 32 * ks);
#pragma unroll
        for (int nf = 0; nf < 8; ++nf) { const bf16x8 b = *(const bf16x8*)(bp + (size_t)(16 * nf) * 1024 + 32 * ks); acc[nf] = mfma16(a, b, acc[nf]); } }
    if (cg < 4) {
        float rr[4];
#pragma unroll
        for (int g = 0; g < 4; ++g) { float ss = 0.f;
#pragma unroll
            for (int nf = 0; nf < 8; ++nf) ss += acc[nf][g] * acc[nf][g];
            ss += __shfl_xor(ss, 1); ss += __shfl_xor(ss, 2); ss += __shfl_xor(ss, 4); ss += __shfl_xor(ss, 8);
            rr[g] = rsqrtf(ss * (1.0f / 128.0f) + 1e-6f); }
#pragma unroll
        for (int nf = 0; nf < 8; ++nf) { const int d = 16 * nf + q; const float gs = kg[d] * qg[d];
#pragma unroll
            for (int g = 0; g < 4; ++g) kmem[(size_t)(r0 + 4 * hi + g) * 512 + cg * 128 + d] = (bf16)f2bf(acc[nf][g] * rr[g] * gs); }
    } else {
        const int h = cg - 4, b = r0 >> 8, key0 = (r0 & 255) + 4 * hi;
#pragma unroll
        for (int nf = 0; nf < 8; ++nf) { const int d = 16 * nf + q; v2u w; w.x = pk2(acc[nf][0], acc[nf][1]); w.y = pk2(acc[nf][2], acc[nf][3]);
            *(v2u*)(vtmem + (size_t)(b * 512 + h * 128 + d) * 256 + key0) = w; }
    }
}

__device__ __forceinline__ void na_item(const bf16* __restrict__ qn, const bf16* __restrict__ kn, const bf16* __restrict__ vt, const float* __restrict__ rpb, bf16* __restrict__ yna,
                                        int b, int r, int jb, int h, int lane) {
    const int q = lane & 15, hi = lane >> 4;
    int rs = r - 4; rs = rs < 0 ? 0 : (rs > 120 ? 120 : rs);
    int kb0 = jb * 16 - 8; kb0 = kb0 < 0 ? 0 : (kb0 > 32 ? 32 : kb0);
    const int qcol = jb * 16 + q; int cs = qcol - 8; cs = cs < 0 ? 0 : (cs > 48 ? 48 : cs);
    const size_t tokq = (size_t)b * SEQ + r * 64 + qcol;
    const bf16* qp = qn + tokq * 512 + h * 64 + 8 * hi;
    const bf16x8 qf0 = *(const bf16x8*)qp, qf1 = *(const bf16x8*)(qp + 32);
    const bf16* kbase = kn + ((size_t)b * SEQ + rs * 64 + kb0 + q) * 512 + h * 64 + 8 * hi;
    f32x4 s[16];
#pragma unroll
    for (int f = 0; f < 16; ++f) {
        const bf16* kp = kbase + (size_t)((f >> 1) * 64 + (f & 1) * 16) * 512;
        const bf16x8 a0 = *(const bf16x8*)kp, a1 = *(const bf16x8*)(kp + 32);
        f32x4 z = (f32x4){0.f, 0.f, 0.f, 0.f}; z = mfma16(a0, qf0, z); s[f] = mfma16(a1, qf1, z);
    }
    const float* rp = rpb + h * 15 * 31;
    float mx = -3.0e38f;
#pragma unroll
    for (int f = 0; f < 16; ++f) {
        const int dr = rs + (f >> 1) - r + 7;
#pragma unroll
        for (int g = 0; g < 4; ++g) {
            const int kcol = kb0 + (f & 1) * 16 + 4 * hi + g;
            const bool ok = (kcol >= cs) && (kcol < cs + 16);
            int dc = kcol - qcol + 15; dc = dc < 0 ? 0 : (dc > 30 ? 30 : dc);
            const float v = ok ? s[f][g] + rp[dr * 31 + dc] : -1.0e30f;
            s[f][g] = v; mx = fmaxf(mx, v);
        }
    }
    mx = fmaxf(mx, __shfl_xor(mx, 16)); mx = fmaxf(mx, __shfl_xor(mx, 32));
    float sum = 0.f;
#pragma unroll
    for (int f = 0; f < 16; ++f)
#pragma unroll
        for (int g = 0; g < 4; ++g) { const float p = __expf(s[f][g] - mx); s[f][g] = p; sum += p; }
    sum += __shfl_xor(sum, 16); sum += __shfl_xor(sum, 32);
    const float inv = 1.0f / sum;
    f32x4 o[4];
#pragma unroll
    for (int i = 0; i < 4; ++i) o[i] = (f32x4){0.f, 0.f, 0.f, 0.f};
    const bf16* vbase = vt + ((size_t)(b * 512 + h * 64 + q) * SEQ + rs * 64 + kb0 + 4 * hi);
#pragma unroll
    for (int st = 0; st < 8; ++st) {
        const bf16x8 pb = __builtin_bit_cast(bf16x8, pg8::pack8(s[2 * st], s[2 * st + 1]));
#pragma unroll
        for (int mf = 0; mf < 4; ++mf) { const bf16* vp = vbase + (size_t)(16 * mf) * SEQ + st * 64; const v2u lo = *(const v2u*)vp, hh = *(const v2u*)(vp + 16);
            const bf16x8 av = __builtin_bit_cast(bf16x8, (v4u){lo.x, lo.y, hh.x, hh.y}); o[mf] = mfma16(av, pb, o[mf]); }
    }
    bf16* yp = yna + tokq * 512 + h * 64 + 4 * hi;
#pragma unroll
    for (int mf = 0; mf < 4; ++mf) { v2u w; w.x = pk2(o[mf][0] * inv, o[mf][1] * inv); w.y = pk2(o[mf][2] * inv, o[mf][3] * inv); *(v2u*)(yp + 16 * mf) = w; }
}
__device__ __forceinline__ void xa_item(const bf16* __restrict__ xq, const bf16* __restrict__ kmem, const bf16* __restrict__ vtmem, bf16* __restrict__ yxa, int tok0, int h, int lane) {
    const int q = lane & 15, hi = lane >> 4; const size_t tok = (size_t)tok0 + q; const int b = tok0 >> 13;
    const bf16* qp = xq + tok * 512 + h * 128 + 8 * hi;
    bf16x8 qf[4]; float ssq = 0.f;
#pragma unroll
    for (int ks = 0; ks < 4; ++ks) { qf[ks] = *(const bf16x8*)(qp + 32 * ks);
#pragma unroll
        for (int j = 0; j < 8; ++j) { const float v = bf1(qf[ks][j]); ssq += v * v; } }
    ssq += __shfl_xor(ssq, 16); ssq += __shfl_xor(ssq, 32);
    const float cexp = rsqrtf(ssq * (1.0f / 128.0f) + 1e-6f) * 0.08838834764831845f * 1.4426950408889634f;
    const bf16* kbase = kmem + ((size_t)b * 256 + q) * 512 + h * 128 + 8 * hi;
    f32x4 s[16];
#pragma unroll
    for (int f = 0; f < 16; ++f) { const bf16* kp = kbase + (size_t)(16 * f) * 512; f32x4 z = (f32x4){0.f, 0.f, 0.f, 0.f};
#pragma unroll
        for (int ks = 0; ks < 4; ++ks) z = mfma16(*(const bf16x8*)(kp + 32 * ks), qf[ks], z);
        s[f] = z; }
    float mx = -3.0e38f;
#pragma unroll
    for (int f = 0; f < 16; ++f)
#pragma unroll
        for (int g = 0; g < 4; ++g) mx = fmaxf(mx, s[f][g]);
    mx = fmaxf(mx, __shfl_xor(mx, 16)); mx = fmaxf(mx, __shfl_xor(mx, 32));
    float sum = 0.f;
#pragma unroll
    for (int f = 0; f < 16; ++f)
#pragma unroll
        for (int g = 0; g < 4; ++g) { const float p = __builtin_amdgcn_exp2f((s[f][g] - mx) * cexp); s[f][g] = p; sum += p; }
    sum += __shfl_xor(sum, 16); sum += __shfl_xor(sum, 32);
    const float inv = 1.0f / sum;
    f32x4 o[8];
#pragma unroll
    for (int i = 0; i < 8; ++i) o[i] = (f32x4){0.f, 0.f, 0.f, 0.f};
    const bf16* vbase = vtmem + (size_t)(b * 512 + h * 128 + q) * 256 + 4 * hi;
#pragma unroll
    for (int st = 0; st < 8; ++st) {
        const bf16x8 pb = __builtin_bit_cast(bf16x8, pg8::pack8(s[2 * st], s[2 * st + 1]));
#pragma unroll
        for (int mf = 0; mf < 8; ++mf) { const bf16* vp = vbase + (size_t)(16 * mf) * 256 + 32 * st; const v2u lo = *(const v2u*)vp, hh = *(const v2u*)(vp + 16);
            const bf16x8 av = __builtin_bit_cast(bf16x8, (v4u){lo.x, lo.y, hh.x, hh.y}); o[mf] = mfma16(av, pb, o[mf]); }
    }
    bf16* yp = yxa + tok * 512 + h * 128 + 4 * hi;
#pragma unroll
    for (int mf = 0; mf < 8; ++mf) { v2u w; w.x = pk2(o[mf][0] * inv, o[mf][1] * inv); w.y = pk2(o[mf][2] * inv, o[mf][3] * inv); *(v2u*)(yp + 16 * mf) = w; }
}
__device__ __forceinline__ void pool_item(const bf16* __restrict__ pp, const bf16* __restrict__ pwT, bf16* __restrict__ ypool, int tok0, int g, int lane) {
    const int q = lane & 15, hi = lane >> 4; const int tok = tok0 + q, b = tok >> 13, t = tok & 8191;
    const int hw = 1 << g;
    int lo = t - hw; lo = lo < 0 ? 0 : lo; int ht = t + hw; ht = ht > SEQ ? SEQ : ht;
    const float inv = 1.0f / (float)(ht - lo);
    const bf16* base = pp + (size_t)b * SEQ * 512 + g * 128 + 8 * hi;
    bf16x8 pb[4];
#pragma unroll
    for (int ks = 0; ks < 4; ++ks) {
        float a8[8];
#pragma unroll
        for (int j = 0; j < 8; ++j) a8[j] = 0.f;
        for (int d = -hw; d < hw; ++d) { const int u = t + d; const bool ok = (u >= 0) && (u < SEQ); const int uc = ok ? u : t;
            const bf16x8 v = *(const bf16x8*)(base + (size_t)uc * 512 + 32 * ks);
#pragma unroll
            for (int j = 0; j < 8; ++j) a8[j] += ok ? bf1(v[j]) : 0.f; }
        const bf16x8 sv = *(const bf16x8*)(base + (size_t)t * 512 + 32 * ks);
        f32x4 p0, p1;
#pragma unroll
        for (int j = 0; j < 4; ++j) { p0[j] = a8[j] * inv - bf1(sv[j]); p1[j] = a8[j + 4] * inv - bf1(sv[j + 4]); }
        pb[ks] = __builtin_bit_cast(bf16x8, pg8::pack8(p0, p1));
    }
    bf16* yp = ypool + (size_t)tok * 512 + g * 128 + 4 * hi;
    const bf16* wb = pwT + (size_t)(g * 128 + q) * 128 + 8 * hi;
#pragma unroll
    for (int mf = 0; mf < 8; ++mf) { f32x4 o = (f32x4){0.f, 0.f, 0.f, 0.f};
#pragma unroll
        for (int ks = 0; ks < 4; ++ks) o = mfma16(*(const bf16x8*)(wb + (size_t)(16 * mf) * 128 + 32 * ks), pb[ks], o);
        v2u w; w.x = pk2(o[0], o[1]); w.y = pk2(o[2], o[3]); *(v2u*)(yp + 16 * mf) = w; }
}

__device__ __forceinline__ int f2key(float s, int idx, int mask) { int b = __builtin_bit_cast(int, s); b = b >= 0 ? b : (b ^ 0x7fffffff); return (b & ~mask) | idx; }
__device__ __forceinline__ float key2f(int k) { k = k >= 0 ? k : (k ^ 0x7fffffff); return __builtin_bit_cast(float, k); }
#define INS16(L, x) do { int _x = (x); _Pragma("unroll") for (int _j = 0; _j < 16; ++_j) { const int _t = L[_j] > _x ? L[_j] : _x; _x = L[_j] > _x ? _x : L[_j]; L[_j] = _t; } } while (0)
__device__ __forceinline__ void topk_item(const bf16* __restrict__ qb, const bf16* __restrict__ keys, int* __restrict__ te, float* __restrict__ tw, LAS int* lscr, int tok0, int h, int lane) {
    const int q = lane & 15, hi = lane >> 4; const size_t tok = (size_t)tok0 + q;
    int L[2][16];
#pragma unroll
    for (int p = 0; p < 2; ++p) {
#pragma unroll
        for (int k = 0; k < 16; ++k) L[p][k] = (int)0x80000000;
        bf16x8 qf[4];
#pragma unroll
        for (int ks = 0; ks < 4; ++ks) qf[ks] = *(const bf16x8*)(qb + tok * 2048 + h * 256 + p * 128 + 32 * ks + 8 * hi);
        const bf16* kb = keys + (size_t)((h * 2 + p) * 128 + q) * 128 + 8 * hi;
#pragma unroll
        for (int mf = 0; mf < 8; ++mf) { f32x4 s = (f32x4){0.f, 0.f, 0.f, 0.f};
#pragma unroll
            for (int ks = 0; ks < 4; ++ks) s = mfma16(*(const bf16x8*)(kb + (size_t)(16 * mf) * 128 + 32 * ks), qf[ks], s);
#pragma unroll
            for (int g = 0; g < 4; ++g) INS16(L[p], f2key(s[g], 16 * mf + 4 * hi + g, 127)); }
#pragma unroll
        for (int step = 16; step <= 32; step <<= 1) { int tmp[16];
#pragma unroll
            for (int k = 0; k < 16; ++k) tmp[k] = L[p][k];
#pragma unroll
            for (int k = 0; k < 16; ++k) { const int o = __shfl_xor(tmp[k], step); INS16(L[p], o); } }
    }
    float v1[16], v2[16];
#pragma unroll
    for (int k = 0; k < 16; ++k) { v1[k] = key2f(L[0][k]); v2[k] = key2f(L[1][k]); }
    int Fk[16];
#pragma unroll
    for (int k = 0; k < 16; ++k) Fk[k] = (int)0x80000000;
#pragma unroll
    for (int i = 0; i < 16; ++i)
#pragma unroll
        for (int j = 0; j < 16; ++j) if ((i + 1) * (j + 1) <= 16) INS16(Fk, f2key(v1[i] + v2[j], (i << 4) | j, 255));
    LAS int* my = lscr + lane * 33;
#pragma unroll
    for (int k = 0; k < 16; ++k) { my[k] = L[0][k] & 127; my[16 + k] = L[1][k] & 127; }
    LDS_WAIT(); asm volatile("" ::: "memory");
    float e[16]; float sum = 0.f; const float mx = key2f(Fk[0]);
#pragma unroll
    for (int k = 0; k < 16; ++k) { e[k] = __expf(key2f(Fk[k]) - mx); sum += e[k]; }
    const float inv = 1.0f / sum;
    if (hi == 0) {
        int* tep = te + (tok * 8 + h) * 16; float* twp = tw + (tok * 8 + h) * 16;
#pragma unroll
        for (int k4 = 0; k4 < 4; ++k4) { int ev[4]; f32x4 wv;
#pragma unroll
            for (int k = 0; k < 4; ++k) { const int kk = 4 * k4 + k, i = (Fk[kk] >> 4) & 15, j = Fk[kk] & 15; ev[k] = my[i] * 128 + my[16 + j]; wv[k] = e[kk] * inv; }
            *(v4u*)(tep + 4 * k4) = (v4u){(unsigned)ev[0], (unsigned)ev[1], (unsigned)ev[2], (unsigned)ev[3]}; *(f32x4*)(twp + 4 * k4) = wv; }
    }
    LDS_WAIT(); asm volatile("" ::: "memory");
}

__device__ __forceinline__ float ub2f(unsigned v, int b) { return (float)((v >> (8 * b)) & 0xffu); }
__device__ __forceinline__ void peer_token(const bf16* __restrict__ hb, const float* __restrict__ rowsq, const unsigned char* __restrict__ u8, const unsigned char* __restrict__ v8,
                                           const float* __restrict__ su, const float* __restrict__ sv, const int* __restrict__ te, const float* __restrict__ tw,
                                           const float* hsrc, float* out, int tok, int lane) {
    const bf16* hp = hb + (size_t)tok * 1024 + 16 * lane;
    const v4u hA = *(const v4u*)hp, hB = *(const v4u*)(hp + 8);
    float hf[16];
#pragma unroll
    for (int d = 0; d < 4; ++d) { hf[2 * d] = bflo(hA[d]); hf[2 * d + 1] = bfhi(hA[d]); hf[8 + 2 * d] = bflo(hB[d]); hf[8 + 2 * d + 1] = bfhi(hB[d]); }
    float amax = 0.f;
#pragma unroll
    for (int j = 0; j < 16; ++j) amax = fmaxf(amax, fabsf(hf[j]));
#pragma unroll
    for (int o = 1; o < 64; o <<= 1) amax = fmaxf(amax, __shfl_xor(amax, o));
    const float hinv = amax > 0.f ? 127.0f / amax : 0.f;
    int hq[4];
#pragma unroll
    for (int d = 0; d < 4; ++d) { const unsigned b0 = (unsigned)(int)rintf(hf[4 * d] * hinv) & 0xffu, b1 = (unsigned)(int)rintf(hf[4 * d + 1] * hinv) & 0xffu,
                                                 b2 = (unsigned)(int)rintf(hf[4 * d + 2] * hinv) & 0xffu, b3 = (unsigned)(int)rintf(hf[4 * d + 3] * hinv) & 0xffu;
        hq[d] = (int)(b0 | (b1 << 8) | (b2 << 16) | (b3 << 24)); }
    const float zscale = rsqrtf(rowsq[tok] * (1.0f / 1024.0f) + 1e-6f) * amax * (1.0f / 127.0f);
    const int e0 = te[(size_t)tok * 128 + lane], e1 = te[(size_t)tok * 128 + 64 + lane];
    const float* ip = hsrc + (size_t)tok * 1024 + 16 * lane; float* op = out + (size_t)tok * 1024 + 16 * lane;
    f32x4 acc[4];
#pragma unroll
    for (int d = 0; d < 4; ++d) acc[d] = *(const f32x4*)(ip + 4 * d);
    float wsum = 0.f;
#pragma unroll 1
    for (int hd = 0; hd < 8; ++hd) {
        const int esel = hd < 4 ? e0 : e1, lbase = (hd & 3) * 16;
        v4u ur[16], vr[16];
#pragma unroll
        for (int k = 0; k < 16; ++k) { const int e = __builtin_amdgcn_readlane(esel, lbase + k);
            ur[k] = *(const v4u*)(u8 + (size_t)e * 1024 + 16 * lane); vr[k] = *(const v4u*)(v8 + (size_t)e * 1024 + 16 * lane); }
        const int el = __shfl(esel, lbase + (lane >> 2));
        const float su_l = su[el], sv_l = sv[el], g_l = tw[(size_t)tok * 128 + hd * 16 + (lane >> 2)];
        int p[16];
#pragma unroll
        for (int k = 0; k < 16; ++k) { int d = __builtin_amdgcn_sdot4((int)ur[k].x, hq[0], 0, false); d = __builtin_amdgcn_sdot4((int)ur[k].y, hq[1], d, false);
            d = __builtin_amdgcn_sdot4((int)ur[k].z, hq[2], d, false); p[k] = __builtin_amdgcn_sdot4((int)ur[k].w, hq[3], d, false); }
        int q8[8], q4[4], q2[2], q1;
#pragma unroll
        for (int i = 0; i < 8; ++i) { const bool up = (lane & 32) != 0; const int keep = up ? p[i + 8] : p[i], send = up ? p[i] : p[i + 8]; q8[i] = keep + __shfl_xor(send, 32); }
#pragma unroll
        for (int i = 0; i < 4; ++i) { const bool up = (lane & 16) != 0; const int keep = up ? q8[i + 4] : q8[i], send = up ? q8[i] : q8[i + 4]; q4[i] = keep + __shfl_xor(send, 16); }
#pragma unroll
        for (int i = 0; i < 2; ++i) { const bool up = (lane & 8) != 0; const int keep = up ? q4[i + 2] : q4[i], send = up ? q4[i] : q4[i + 2]; q2[i] = keep + __shfl_xor(send, 8); }
        { const bool up = (lane & 4) != 0; const int keep = up ? q2[1] : q2[0], send = up ? q2[0] : q2[1]; q1 = keep + __shfl_xor(send, 4); }
        q1 += __shfl_xor(q1, 2); q1 += __shfl_xor(q1, 1);
        const float z = (float)q1 * zscale * su_l;
        const float wgt = g_l * 0.5f * z * (1.0f + erff(z * 0.70710678118654752f)) * sv_l;
#pragma unroll
        for (int k = 0; k < 16; ++k) { const float wk = __builtin_bit_cast(float, __builtin_amdgcn_readlane(__builtin_bit_cast(int, wgt), 4 * k)); wsum += wk;
#pragma unroll
            for (int d = 0; d < 4; ++d) { acc[d][0] += wk * ub2f(vr[k][d], 0); acc[d][1] += wk * ub2f(vr[k][d], 1); acc[d][2] += wk * ub2f(vr[k][d], 2); acc[d][3] += wk * ub2f(vr[k][d], 3); } }
    }
    const float corr = 128.0f * wsum;
#pragma unroll
    for (int d = 0; d < 4; ++d) *(f32x4*)(op + 4 * d) = acc[d] - corr;
}

__global__ void __launch_bounds__(NWAVES * 64, 2) mk_fwd(Args args) {
    extern __shared__ __attribute__((aligned(16))) unsigned char lds[];
    Frame F;
    F.lds = (LAS unsigned char*)lds;
    F.MISC = (volatile LAS unsigned*)(F.lds + MISC_OFF);
    F.tid = threadIdx.x; F.lane = F.tid & 63; F.wave = __builtin_amdgcn_readfirstlane(F.tid >> 6);
    F.G = gridDim.x; { const int bx = blockIdx.x; F.vcu = (F.G % 8 == 0) ? (bx % 8) * (F.G / 8) + bx / 8 : bx; }
    F.out = args.out; F.ws = args.ws;
    unsigned char* ws = args.ws;
    F.ctl = (gu32*)(ws + WS_CTL);
    for (int u = F.tid; u < (LDS_BYTES - LDSCTL_OFF) / 4; u += NWAVES * 64) ((LAS unsigned*)(F.lds + LDSCTL_OFF))[u] = 0u;
    __syncthreads();
    XcdBarrier bar; bar.bar = (unsigned*)(F.ctl + CW_BAR); bar.x = 0; bar.st = nullptr;
    if (N_LAUNCHES != PER_PHASE) bar = xcd_barrier_post((unsigned*)(F.ctl + CW_BAR), F.MISC + 8);
#define GRID_BAR() do { if (N_LAUNCHES != PER_PHASE) xcd_barrier(bar); } while (0)
    const int lo = args.ph_lo, hi = args.ph_hi;
#define IN(k) (lo <= (k) && (k) < hi)
#define BOTH(k) (IN(k) && IN((k) + 1))
#ifndef DUP_PHASE
#define DUP_PHASE (-1)
#endif
#define NREP(k) ((DUP_PHASE == (k)) ? 2 : 1)
    const int gw = F.vcu * NWAVES + F.wave, NGW = F.G * NWAVES;
    bf16* const WinT = (bf16*)(ws + WS_WIN); bf16* const WvT = (bf16*)(ws + WS_WV); bf16* const WkvT = (bf16*)(ws + WS_WKV); bf16* const WbrT = (bf16*)(ws + WS_WBR);
    bf16* const WoutT = (bf16*)(ws + WS_WOUT); bf16* const WqT = (bf16*)(ws + WS_WQ); bf16* const KEYS = (bf16*)(ws + WS_KEYS); bf16* const PWT = (bf16*)(ws + WS_PWT);
    bf16* const MEMN = (bf16*)(ws + WS_MEMN); bf16* const KMEM = (bf16*)(ws + WS_KMEM); bf16* const VTMEM = (bf16*)(ws + WS_VTMEM); float* const RSTDX = (float*)(ws + WS_RSTDX);
    const unsigned char* const U8 = ws + WS_U8; const unsigned char* const V8 = ws + WS_V8; const float* const SU = (const float*)(ws + WS_SU); const float* const SV = (const float*)(ws + WS_SV);
    bf16* const QN = (bf16*)(ws + WS_QN); bf16* const KN = (bf16*)(ws + WS_KN); bf16* const VT = (bf16*)(ws + WS_VT); bf16* const PP = (bf16*)(ws + WS_PP); bf16* const XQ = (bf16*)(ws + WS_XQ);
    bf16* const GATE = (bf16*)(ws + WS_GATE); bf16* const MERGED = (bf16*)(ws + WS_MERGED); bf16* const HB = (bf16*)(ws + WS_HB); bf16* const QB = (bf16*)(ws + WS_QB);
    int* const TE = (int*)(ws + WS_TE); float* const TW = (float*)(ws + WS_TW); float* const ROWSQ = (float*)(ws + WS_ROWSQ);
    bf16* const XB = (bf16*)((unsigned char*)args.out + OUT_XB); bf16* const YNA = (bf16*)((unsigned char*)args.out + OUT_YNA);
    bf16* const YPOOL = (bf16*)((unsigned char*)args.out + OUT_YPOOL); bf16* const YXA = (bf16*)((unsigned char*)args.out + OUT_YXA);

    if (IN(0)) { for (int rep = 0; rep < NREP(0); ++rep) { p0_prologue(F, args); if (rep + 1 < NREP(0)) GRID_BAR(); } if (BOTH(0)) GRID_BAR(); }

    if (IN(1)) {
      for (int rep = 0; rep < NREP(1); ++rep) {
        { pg8::Sched1 S; S.so.init(T, IN_MAIN, F.G, (int)blockIdx.x); S.A = (const char*)XB; S.Bt = (const char*)WinT; S.tstep = (size_t)256 * 1024 * 2;
          pg8::EpiProj E{RSTDX, QN, KN, PP, XQ, GATE, args.in[I_NAQG], args.in[I_NAKG], args.in[I_GATEB]};
          pg8::gemm_phase<pg8::EpiProj, pg8::Sched1, true, true>(F.lds + RING_OFF, 1024, S, E); }
        { pg8::Sched1 S; S.so.init(512, T, F.G, (int)blockIdx.x); S.A = (const char*)WvT; S.Bt = (const char*)XB; S.tstep = (size_t)256 * 1024 * 2;
          pg8::EpiVt E{RSTDX, VT};
          pg8::gemm_phase<pg8::EpiVt, pg8::Sched1, false, true>(F.lds + RING_OFF, 1024, S, E); }
        for (int t = gw; t < 512; t += NGW) memkv_tile(MEMN, WkvT, args.in[I_XAKG], args.in[I_XAQG], KMEM, VTMEM, t, F.lane);
        if (rep + 1 < NREP(1)) GRID_BAR();
      }
        if (BOTH(1)) GRID_BAR();
    }

    if (IN(2)) {
      for (int rep = 0; rep < NREP(2); ++rep) {
        for (int i = F.vcu; i < 256; i += F.G)
            for (int k = 0; k < 8; ++k) { const int idx = i * 8 + k, b = idx >> 9, r = (idx >> 2) & 127, jb = idx & 3; na_item(QN, KN, VT, args.in[I_RPB], YNA, b, r, jb, F.wave, F.lane); }
        for (int it = gw; it < 8192; it += NGW) pool_item(PP, PWT, YPOOL, (it >> 2) * 16, it & 3, F.lane);
        for (int it = gw; it < 8192; it += NGW) xa_item(XQ, KMEM, VTMEM, YXA, (it >> 2) * 16, it & 3, F.lane);
        if (rep + 1 < NREP(2)) GRID_BAR();
      }
        if (BOTH(2)) GRID_BAR();
    }

    if (IN(3)) {
      for (int rep = 0; rep < NREP(3); ++rep) {
        pg8::Sched3 S; S.so.init(T, D, F.G, (int)blockIdx.x); S.A = (const char*)YNA; S.Bt = (const char*)WbrT; S.tstep = (size_t)256 * 512 * 2; S.strideA = 32 * MiB; S.strideB = (size_t)1024 * 512 * 2;
        pg8::EpiMerge E{GATE, (bf16*)(ws + WS_VT)  , MERGED};
        pg8::gemm_phase<pg8::EpiMerge, pg8::Sched3, true, true>(F.lds + RING_OFF, 512, S, E);
        if (rep + 1 < NREP(3)) GRID_BAR();
      }
        if (BOTH(3)) GRID_BAR();
    }

    if (IN(4)) {
      for (int rep = 0; rep < NREP(4); ++rep) {
        pg8::Sched1 S; S.so.init(T, D, F.G, (int)blockIdx.x); S.A = (const char*)MERGED; S.Bt = (const char*)WoutT; S.tstep = (size_t)256 * 1024 * 2;
        pg8::EpiH E{args.in[I_X], F.out, HB, ROWSQ};
        pg8::gemm_phase<pg8::EpiH, pg8::Sched1, true, true>(F.lds + RING_OFF, 1024, S, E);
        if (rep + 1 < NREP(4)) { GRID_BAR(); for (int m = gw * 64 + F.lane; m < T; m += NGW * 64) ROWSQ[m] = 0.f; GRID_BAR(); }
      }
        if (BOTH(4)) GRID_BAR();
    }

    if (IN(5)) {
      for (int rep = 0; rep < NREP(5); ++rep) {
        pg8::Sched1 S; S.so.init(T, 2048, F.G, (int)blockIdx.x); S.A = (const char*)HB; S.Bt = (const char*)WqT; S.tstep = (size_t)256 * 1024 * 2;
        pg8::EpiQ E{ROWSQ, QB};
        pg8::gemm_phase<pg8::EpiQ, pg8::Sched1, true, true>(F.lds + RING_OFF, 1024, S, E);
        if (rep + 1 < NREP(5)) GRID_BAR();
      }
        if (BOTH(5)) GRID_BAR();
    }

    if (IN(6)) {
        LAS int* lscr = (LAS int*)(F.lds + RING_OFF + F.wave * 16384);
        for (int rep = 0; rep < NREP(6); ++rep) { for (int it = gw; it < 16384; it += NGW) topk_item(QB, KEYS, TE, TW, lscr, (it >> 3) * 16, it & 7, F.lane); if (rep + 1 < NREP(6)) GRID_BAR(); }
        if (BOTH(6)) GRID_BAR();
    }

    if (IN(7)) {
        for (int rep = 0; rep < NREP(7); ++rep) { float* dst = (rep + 1 < NREP(7)) ? (float*)QB : F.out;
            for (int tok = gw; tok < T; tok += NGW) peer_token(HB, ROWSQ, U8, V8, SU, SV, TE, TW, F.out, dst, tok, F.lane);
            if (rep + 1 < NREP(7)) GRID_BAR(); }
    }
#undef IN
#undef BOTH
#undef GRID_BAR
}

extern "C" void kernel_launch(void* const* d_in, const int* in_sizes, int n_in, void* d_out, int out_size, void* d_ws, size_t ws_size, hipStream_t stream) {
    static int grid = 0;
    if (grid == 0) {
        if (n_in != 23 || in_sizes[0] != T * D || out_size != T * D || ws_size < WS_END) { fprintf(stderr, "kernel_launch: unexpected shapes: n_in %d in0 %d out %d ws %zu\n", n_in, n_in > 0 ? in_sizes[0] : -1, out_size, ws_size); grid = -1; return; }
        int dev = 0, cus = 0, per_cu = 0;
        if (hipGetDevice(&dev) != hipSuccess || hipDeviceGetAttribute(&cus, hipDeviceAttributeMultiprocessorCount, dev) != hipSuccess) { fprintf(stderr, "kernel_launch: device query failed\n"); grid = -1; return; }
        if (hipFuncSetAttribute((const void*)mk_fwd, hipFuncAttributeMaxDynamicSharedMemorySize, LDS_BYTES) != hipSuccess) { fprintf(stderr, "kernel_launch: hipFuncSetAttribute failed\n"); grid = -1; return; }
        if (hipOccupancyMaxActiveBlocksPerMultiprocessor(&per_cu, (const void*)mk_fwd, NWAVES * 64, LDS_BYTES) != hipSuccess || per_cu < 1)
            fprintf(stderr, "kernel_launch: note: occupancy query reports %d workgroups per CU\n", per_cu);
        (void)hipGetLastError();
        grid = cus;
    }
    if (grid < 0) return;
    if (hipMemsetAsync((char*)d_ws + WS_CTL, 0, CTL_ZERO_BYTES, stream) != hipSuccess) { fprintf(stderr, "kernel_launch: memset failed\n"); return; }
    Args a{};
    for (int i = 0; i < 23; ++i) a.in[i] = (const float*)d_in[i];
    a.out = (float*)d_out; a.ws = (unsigned char*)d_ws;
    for (int li = 0; li < N_LAUNCHES; ++li) {
        a.ph_lo = (N_LAUNCHES == PER_PHASE) ? li : 0; a.ph_hi = (N_LAUNCHES == PER_PHASE) ? li + 1 : PER_PHASE;
        hipLaunchKernelGGL(mk_fwd, dim3(grid), dim3(NWAVES * 64), LDS_BYTES, stream, a);
#ifdef HOST_DUP_PHASE
        if (N_LAUNCHES == PER_PHASE && li == HOST_DUP_PHASE) { if (li == 4) (void)hipMemsetAsync((char*)d_ws + WS_ROWSQ, 0, (size_t)T * 4, stream); hipLaunchKernelGGL(mk_fwd, dim3(grid), dim3(NWAVES * 64), LDS_BYTES, stream, a); }
#endif
        const hipError_t le = hipPeekAtLastError();
        if (le != hipSuccess) { fprintf(stderr, "kernel_launch: launch %d failed: %s\n", li, hipGetErrorName(le)); break; }
    }
}
```

```cpp
#define MK_N_LAUNCHES 1
#include <hip/hip_runtime.h>
#include <cstdio>
#include <cstdint>

#ifndef MK_N_LAUNCHES
#define MK_N_LAUNCHES 1
#endif

namespace pg8 {
#define PG8_LAS __attribute__((address_space(3)))
typedef unsigned short bf16_t;
typedef short bf16x8 __attribute__((ext_vector_type(8)));
typedef float f32x4 __attribute__((ext_vector_type(4)));
typedef unsigned u32x4 __attribute__((ext_vector_type(4)));
typedef unsigned u32x2 __attribute__((ext_vector_type(2)));
constexpr int BM = 256, BK = 64, HALF = 128, HTB = HALF * BK * 2  , STAGE_BYTES = 8 * HTB, NXCD = 8, WGM = 8;

__host__ __device__ __forceinline__ int lds_byte(int r, int c) { const int st = (r >> 4) * 2 + (c >> 5), rr = r & 15, cc = c & 31, ob = rr * 64 + cc * 2; return st * 1024 + (ob ^ (((ob >> 9) & 1) << 5)); }
__host__ __device__ __forceinline__ void stage_rc(int b, int& R, int& C) { const int st = b / 1024, sb = b % 1024, swz = sb ^ (((sb >> 9) & 1) << 5); R = (st >> 1) * 16 + swz / 64; C = (st & 1) * 32 + (swz % 64) / 2; }
__host__ __device__ __forceinline__ int perm32(int rho) { const int n = rho >> 4, i = rho & 15; return 8 * (i >> 2) + 4 * n + (i & 3); }

struct Unit { int pm, pn, br; };

struct StaticOrder {
    int nM, nN, nwg, G, c;
    __host__ __device__ void init(int M, int N, int G_, int c_) { nM = M / BM; nN = N / BM; nwg = nM * nN; G = G_; c = c_; }
    __host__ __device__ bool next(int i, Unit& u) const {
        const long L = (long)i * G + c; if (L >= nwg) return false;
        int wgid = (int)L; { const int q = nwg / NXCD, r = nwg % NXCD, xcd = wgid % NXCD, off = wgid / NXCD; wgid = (xcd < r ? xcd * (q + 1) : r * (q + 1) + (xcd - r) * q) + off; }
        const int nig = WGM * nN, gid = wgid / nig, fm = gid * WGM, gsz = (nM - fm) < WGM ? (nM - fm) : WGM;
        u.pm = fm + ((wgid % nig) % gsz); u.pn = (wgid % nig) / gsz; return true;
    }
};
struct Sched1 {
    StaticOrder so; const char* A; const char* Bt; size_t tstep;
    __device__ __forceinline__ bool next(int i, Unit& u) const { u.br = 0; return so.next(i, u); }
    __device__ __forceinline__ const char* abase(const Unit& u) const { return A + (size_t)u.pm * tstep; }
    __device__ __forceinline__ const char* bbase(const Unit& u) const { return Bt + (size_t)u.pn * tstep; }
    __device__ __forceinline__ void a_ready(const Unit&) const {}
    __device__ __forceinline__ void done(const Unit&) const {}
};
struct Sched3 {
    StaticOrder so; const char* A; const char* Bt; size_t tstep, strideA, strideB;
    __device__ __forceinline__ bool next(int i, Unit& u) const { u.br = i % 3; return so.next(i / 3, u); }
    __device__ __forceinline__ const char* abase(const Unit& u) const { return A + (size_t)u.br * strideA + (size_t)u.pm * tstep; }
    __device__ __forceinline__ const char* bbase(const Unit& u) const { return Bt + (size_t)u.br * strideB + (size_t)u.pn * tstep; }
    __device__ __forceinline__ void a_ready(const Unit&) const {}
    __device__ __forceinline__ void done(const Unit&) const {}
};

typedef float f32x2_t __attribute__((ext_vector_type(2))); typedef __bf16 bf16x2v_t __attribute__((ext_vector_type(2)));
__device__ __forceinline__ unsigned cvt_pk_bf16(float lo, float hi) { const f32x2_t v = {lo, hi}; const bf16x2v_t b = __builtin_convertvector(v, bf16x2v_t); return __builtin_bit_cast(unsigned, b); }
__device__ __forceinline__ u32x4 pack8(const f32x4 a, const f32x4 b) { u32x4 w; w.x = cvt_pk_bf16(a[0], a[1]); w.y = cvt_pk_bf16(a[2], a[3]); w.z = cvt_pk_bf16(b[0], b[1]); w.w = cvt_pk_bf16(b[2], b[3]); return w; }
__device__ __forceinline__ float bflo(unsigned u) { return __builtin_bit_cast(float, u << 16); }
__device__ __forceinline__ float bfhi(unsigned u) { return __builtin_bit_cast(float, u & 0xffff0000u); }


constexpr float RMS_EPS = 1e-6f;

struct EpiProj {
    static constexpr bool PERM = true, AFTER_DRAIN = false;
    const float* rstd; bf16_t *qn, *kn, *pp, *xq, *gates; const float *qg, *kg, *gate_b;
    __device__ __forceinline__ void operator()(const f32x4 (&acc)[2][2][4][2], const Unit& u, int wr, int wc, int fr, int fq) const {
        const int pn = u.pn, row0 = u.pm * BM + wr * 64 + fr, lc0 = 64 * wc + 8 * fq;
        if (pn < 4) {
            const bool isq = pn < 2; bf16_t* O = isq ? qn : kn; const float* g = isq ? qg : kg; const float post = isq ? 0.125f : 1.0f;
            f32x4 gv[2][2];
#pragma unroll
            for (int bj = 0; bj < 2; ++bj)
#pragma unroll
                for (int n = 0; n < 2; ++n) gv[bj][n] = *(const f32x4*)(g + 32 * bj + 8 * fq + 4 * n);
            const int colbase = (pn & 1) * 256 + lc0;
#pragma unroll
            for (int ai = 0; ai < 2; ++ai)
#pragma unroll
                for (int m = 0; m < 4; ++m) {
                    const int row = row0 + ai * HALF + m * 16; const float rs = rstd[row];
                    f32x4 v[2][2]; float ss = 0.f;
#pragma unroll
                    for (int bj = 0; bj < 2; ++bj)
#pragma unroll
                        for (int n = 0; n < 2; ++n) { v[bj][n] = acc[ai][bj][m][n] * rs; ss += (v[bj][n][0] * v[bj][n][0] + v[bj][n][1] * v[bj][n][1]) + (v[bj][n][2] * v[bj][n][2] + v[bj][n][3] * v[bj][n][3]); }
                    ss += __shfl_xor(ss, 16); ss += __shfl_xor(ss, 32);
                    const float r = rsqrtf(ss * (1.0f / 64.0f) + RMS_EPS) * post;
#pragma unroll
                    for (int bj = 0; bj < 2; ++bj) *(u32x4*)(O + (size_t)row * 512 + colbase + 32 * bj) = pack8(v[bj][0] * r * gv[bj][0], v[bj][1] * r * gv[bj][1]);
                }
        } else if (pn < 8) {
            bf16_t* O = pn < 6 ? pp : xq; const int colbase = (pn & 1) * 256 + lc0;
#pragma unroll
            for (int ai = 0; ai < 2; ++ai)
#pragma unroll
                for (int m = 0; m < 4; ++m) {
                    const int row = row0 + ai * HALF + m * 16; const float rs = rstd[row];
#pragma unroll
                    for (int bj = 0; bj < 2; ++bj) *(u32x4*)(O + (size_t)row * 512 + colbase + 32 * bj) = pack8(acc[ai][bj][m][0] * rs, acc[ai][bj][m][1] * rs);
                }
        } else {
            const int gcol0 = (pn - 8) * 256 + lc0;
            f32x4 bv[2][2];
#pragma unroll
            for (int bj = 0; bj < 2; ++bj)
#pragma unroll
                for (int n = 0; n < 2; ++n) bv[bj][n] = *(const f32x4*)(gate_b + gcol0 + 32 * bj + 4 * n);
#pragma unroll
            for (int ai = 0; ai < 2; ++ai)
#pragma unroll
                for (int m = 0; m < 4; ++m) {
                    const int row = row0 + ai * HALF + m * 16; const float rs = rstd[row];
#pragma unroll
                    for (int bj = 0; bj < 2; ++bj) {
                        f32x4 o[2];
#pragma unroll
                        for (int n = 0; n < 2; ++n) { const f32x4 z = acc[ai][bj][m][n] * rs + bv[bj][n];
#pragma unroll
                            for (int i = 0; i < 4; ++i) o[n][i] = __builtin_amdgcn_rcpf(1.0f + __expf(-z[i])); }
                        *(u32x4*)(gates + (size_t)row * 3072 + gcol0 + 32 * bj) = pack8(o[0], o[1]);
                    }
                }
        }
    }
};
struct EpiVt {
    static constexpr bool PERM = true, AFTER_DRAIN = false;
    const float* rstd; bf16_t* Vt;
    __device__ __forceinline__ void operator()(const f32x4 (&acc)[2][2][4][2], const Unit& u, int wr, int wc, int fr, int fq) const {
        const int ch0 = u.pm * BM + wr * 64 + fr, tok0 = u.pn * BM + wc * 32 + 8 * fq, b = tok0 >> 13, t0 = tok0 & 8191;
        f32x4 rv[2][2];
#pragma unroll
        for (int bj = 0; bj < 2; ++bj)
#pragma unroll
            for (int n = 0; n < 2; ++n) rv[bj][n] = *(const f32x4*)(rstd + tok0 + bj * HALF + 4 * n);
#pragma unroll
        for (int ai = 0; ai < 2; ++ai)
#pragma unroll
            for (int m = 0; m < 4; ++m) { const int ch = ch0 + ai * HALF + m * 16; bf16_t* rowp = Vt + ((size_t)(b * 512 + ch) * 8192 + t0);
#pragma unroll
                for (int bj = 0; bj < 2; ++bj) *(u32x4*)(rowp + bj * HALF) = pack8(acc[ai][bj][m][0] * rv[bj][0], acc[ai][bj][m][1] * rv[bj][1]); }
    }
};
struct EpiMerge {
    static constexpr bool PERM = true, AFTER_DRAIN = false;
    const bf16_t* gates; bf16_t* pa; bf16_t* merged;
    __device__ __forceinline__ void operator()(const f32x4 (&acc)[2][2][4][2], const Unit& u, int wr, int wc, int fr, int fq) const {
        const int row0 = u.pm * BM + wr * 64 + fr, col0 = u.pn * BM + wc * 32 + 8 * fq, br = u.br;
        const bf16_t* src = br == 1 ? pa : merged; bf16_t* dst = br == 0 ? pa : merged;
#pragma unroll
        for (int ai = 0; ai < 2; ++ai)
#pragma unroll
            for (int m = 0; m < 4; ++m) { const int row = row0 + ai * HALF + m * 16;
#pragma unroll
                for (int bj = 0; bj < 2; ++bj) {
                    const u32x4 g8 = *(const u32x4*)(gates + (size_t)row * 3072 + br * 1024 + col0 + bj * HALF);
                    const size_t mo = (size_t)row * 1024 + col0 + bj * HALF;
                    f32x4 a = acc[ai][bj][m][0], b = acc[ai][bj][m][1];
                    a[0] *= bflo(g8.x); a[1] *= bfhi(g8.x); a[2] *= bflo(g8.y); a[3] *= bfhi(g8.y); b[0] *= bflo(g8.z); b[1] *= bfhi(g8.z); b[2] *= bflo(g8.w); b[3] *= bfhi(g8.w);
                    if (br > 0) { const u32x4 p8 = *(const u32x4*)(src + mo);
                        a[0] += bflo(p8.x); a[1] += bfhi(p8.x); a[2] += bflo(p8.y); a[3] += bfhi(p8.y); b[0] += bflo(p8.z); b[1] += bfhi(p8.z); b[2] += bflo(p8.w); b[3] += bfhi(p8.w); }
                    *(u32x4*)(dst + mo) = pack8(a, b);
                } }
    }
};
struct EpiH {
    static constexpr bool PERM = true, AFTER_DRAIN = false;
    const float* x; float* out; bf16_t* hb; float* rowsq;
    __device__ __forceinline__ void operator()(const f32x4 (&acc)[2][2][4][2], const Unit& u, int wr, int wc, int fr, int fq) const {
        const int row0 = u.pm * BM + wr * 64 + fr, col0 = u.pn * BM + wc * 32 + 8 * fq;
#pragma unroll
        for (int ai = 0; ai < 2; ++ai)
#pragma unroll
            for (int m = 0; m < 4; ++m) { const int row = row0 + ai * HALF + m * 16; float ss = 0.f;
#pragma unroll
                for (int bj = 0; bj < 2; ++bj) { const size_t o = (size_t)row * 1024 + col0 + bj * HALF;
                    const f32x4 h0 = *(const f32x4*)(x + o) + acc[ai][bj][m][0], h1 = *(const f32x4*)(x + o + 4) + acc[ai][bj][m][1];
                    *(f32x4*)(out + o) = h0; *(f32x4*)(out + o + 4) = h1; *(u32x4*)(hb + o) = pack8(h0, h1);
                    ss += (h0[0] * h0[0] + h0[1] * h0[1]) + (h0[2] * h0[2] + h0[3] * h0[3]) + (h1[0] * h1[0] + h1[1] * h1[1]) + (h1[2] * h1[2] + h1[3] * h1[3]); }
                ss += __shfl_xor(ss, 16); ss += __shfl_xor(ss, 32);
                if (fq == 0) atomicAdd(rowsq + row, ss); }
    }
};
struct EpiQ {
    static constexpr bool PERM = true, AFTER_DRAIN = false;
    const float* rowsq; bf16_t* qb;
    __device__ __forceinline__ void operator()(const f32x4 (&acc)[2][2][4][2], const Unit& u, int wr, int wc, int fr, int fq) const {
        const int row0 = u.pm * BM + wr * 64 + fr, col0 = u.pn * BM + wc * 32 + 8 * fq;
#pragma unroll
        for (int ai = 0; ai < 2; ++ai)
#pragma unroll
            for (int m = 0; m < 4; ++m) { const int row = row0 + ai * HALF + m * 16; const float r = rsqrtf(rowsq[row] * (1.0f / 1024.0f) + RMS_EPS);
#pragma unroll
                for (int bj = 0; bj < 2; ++bj) *(u32x4*)(qb + (size_t)row * 2048 + col0 + bj * HALF) = pack8(acc[ai][bj][m][0] * r, acc[ai][bj][m][1] * r); }
    }
};

template <class Epi, class Sched, bool ALIGN_EPI = false, bool SP2 = false>
__device__ __forceinline__ void gemm_phase(PG8_LAS unsigned char* lds, const int K, const Sched& S, const Epi& E) {
    const int tid = threadIdx.x, wid = __builtin_amdgcn_readfirstlane(tid >> 6), lane = tid & 63, wr = wid >> 2, wc = wid & 3, fr = lane & 15, fq = lane >> 4;
    const int nt = K / BK;
    unsigned voffA[2], voffB[2];
#pragma unroll
    for (int i = 0; i < 2; ++i) { int R, C; stage_rc(tid * 16 + i * 8192, R, C); const int Rb = Epi::PERM ? ((R & ~31) + perm32(R & 31)) : R;
        voffA[i] = (unsigned)(R * K + C) * 2u; voffB[i] = (unsigned)(Rb * K + C) * 2u; }
    const size_t kstep = (size_t)(BK * 2);
    const size_t hstep = (size_t)HALF * K * 2;
    const size_t tstep = 2 * hstep;
    const unsigned ldsw = (unsigned)wid * 1024u;
    const int aoff = lds_byte(wr * 64 + fr, fq * 8), boff = lds_byte(wc * 32 + fr, fq * 8);
#define PG8_SA(b, h) (((b) * 2 + (h)) * HTB)
#define PG8_SB(b, h) ((4 + (b) * 2 + (h)) * HTB)
#define PG8_STAGE(bufoff, gbase, voff) do { _Pragma("unroll") for (int _i = 0; _i < 2; ++_i) \
        __builtin_amdgcn_global_load_lds((const unsigned*)((const char*)(gbase) + (voff)[_i]), (PG8_LAS unsigned*)(lds + (bufoff) + ldsw + _i * 8192), 16, 0, 0); } while (0)
#define PG8_LDA(dst, b, h) do { _Pragma("unroll") for (int m = 0; m < 4; ++m) _Pragma("unroll") for (int k = 0; k < 2; ++k) dst[m][k] = *(const PG8_LAS bf16x8*)(lds + PG8_SA(b, h) + aoff + m * 2048 + k * 1024); } while (0)
#define PG8_LDB(dst, b, h) do { _Pragma("unroll") for (int n = 0; n < 2; ++n) _Pragma("unroll") for (int k = 0; k < 2; ++k) dst[n][k] = *(const PG8_LAS bf16x8*)(lds + PG8_SB(b, h) + boff + n * 2048 + k * 1024); } while (0)
#define PG8_MMA(ai, bj, At, Bt) do { __builtin_amdgcn_s_setprio(1); _Pragma("unroll") for (int m = 0; m < 4; ++m) _Pragma("unroll") for (int n = 0; n < 2; ++n) _Pragma("unroll") for (int k = 0; k < 2; ++k) \
        acc[ai][bj][m][n] = __builtin_amdgcn_mfma_f32_16x16x32_bf16(Bt[n][k], At[m][k], acc[ai][bj][m][n], 0, 0, 0); __builtin_amdgcn_s_setprio(0); } while (0)
#define PG8_WAIT_V(n) asm volatile("s_waitcnt vmcnt(" #n ")" ::: "memory")
#define PG8_WAIT_L(n) asm volatile("s_waitcnt lgkmcnt(" #n ")" ::: "memory")
#define PG8_BAR __builtin_amdgcn_s_barrier()
#define PG8_SCHED __builtin_amdgcn_sched_barrier(0)
    Unit cur, nxt; int ui = 0;
    if (!S.next(0, cur)) return;
    f32x4 acc[2][2][4][2];
#pragma unroll
    for (int a = 0; a < 2; ++a)
#pragma unroll
        for (int b = 0; b < 2; ++b)
#pragma unroll
            for (int m = 0; m < 4; ++m)
#pragma unroll
                for (int n = 0; n < 2; ++n) acc[a][b][m][n] = (f32x4){0.f, 0.f, 0.f, 0.f};
    bf16x8 At[4][2], B0[2][2], B1[2][2];
    const char* cA = S.abase(cur); const char* cB = S.bbase(cur);
    S.a_ready(cur);
    if constexpr (SP2) {
        PG8_STAGE(PG8_SB(0, 0), cB, voffB); PG8_STAGE(PG8_SB(0, 1), cB + hstep, voffB); PG8_STAGE(PG8_SA(0, 0), cA, voffA); PG8_STAGE(PG8_SA(0, 1), cA + hstep, voffA);
        if (wr == 1) PG8_BAR;
        PG8_WAIT_V(2); PG8_BAR;
        PG8_STAGE(PG8_SB(1, 0), cB + kstep, voffB); PG8_STAGE(PG8_SA(1, 0), cA + kstep, voffA); PG8_STAGE(PG8_SB(1, 1), cB + hstep + kstep, voffB);
        PG8_WAIT_V(6); PG8_BAR;
    } else {
        PG8_STAGE(PG8_SB(0, 0), cB, voffB); PG8_STAGE(PG8_SA(0, 0), cA, voffA); PG8_STAGE(PG8_SB(0, 1), cB + hstep, voffB); PG8_STAGE(PG8_SA(0, 1), cA + hstep, voffA);
        if (wr == 1) PG8_BAR;
        PG8_WAIT_V(4); PG8_BAR;
        PG8_STAGE(PG8_SB(1, 0), cB + kstep, voffB); PG8_STAGE(PG8_SA(1, 0), cA + kstep, voffA); PG8_STAGE(PG8_SB(1, 1), cB + hstep + kstep, voffB);
        PG8_WAIT_V(6); PG8_BAR;
    }
    for (;;) {
        const bool has_next = S.next(ui + 1, nxt);
        const char* nA = has_next ? S.abase(nxt) : cA; const char* nB = has_next ? S.bbase(nxt) : cB;
        for (int t = 0; t < nt; t += 2) {
            const bool last = (t == nt - 2);
            const char* a1 = cA + (size_t)(t + 1) * kstep;
            const char* a2 = last ? nA : cA + (size_t)(t + 2) * kstep; const char* b2 = last ? nB : cB + (size_t)(t + 2) * kstep;
            const char* a3 = a2 + kstep; const char* b3 = b2 + kstep;
            if (last && has_next) S.a_ready(nxt);
            if constexpr (SP2) {
            PG8_LDB(B0, 0, 0); PG8_LDB(B1, 0, 1); PG8_SCHED; PG8_LDA(At, 0, 0); PG8_STAGE(PG8_SA(1, 1), a1 + hstep, voffA);
            PG8_WAIT_V(8); PG8_WAIT_L(0); PG8_BAR; PG8_MMA(0, 0, At, B0); PG8_MMA(0, 1, At, B1); PG8_BAR; PG8_SCHED;
            PG8_LDA(At, 0, 1); PG8_STAGE(PG8_SB(0, 0), b2, voffB); PG8_STAGE(PG8_SB(0, 1), b2 + hstep, voffB); PG8_STAGE(PG8_SA(0, 0), a2, voffA);
            PG8_WAIT_V(8); PG8_WAIT_L(0); PG8_BAR; PG8_MMA(1, 0, At, B0); PG8_MMA(1, 1, At, B1); PG8_BAR; PG8_SCHED;
            PG8_LDB(B0, 1, 0); PG8_LDB(B1, 1, 1); PG8_SCHED; PG8_LDA(At, 1, 0); PG8_STAGE(PG8_SA(0, 1), a2 + hstep, voffA);
            PG8_WAIT_V(8); PG8_WAIT_L(0); PG8_BAR; PG8_MMA(0, 0, At, B0); PG8_MMA(0, 1, At, B1); PG8_BAR; PG8_SCHED;
            PG8_LDA(At, 1, 1); PG8_STAGE(PG8_SB(1, 0), b3, voffB); PG8_STAGE(PG8_SB(1, 1), b3 + hstep, voffB); PG8_STAGE(PG8_SA(1, 0), a3, voffA);
            PG8_WAIT_V(8); PG8_WAIT_L(0); PG8_BAR; PG8_MMA(1, 0, At, B0); PG8_MMA(1, 1, At, B1); PG8_BAR; PG8_SCHED;
            } else {
            PG8_LDB(B0, 0, 0); PG8_SCHED; PG8_LDA(At, 0, 0); PG8_STAGE(PG8_SA(1, 1), a1 + hstep, voffA);
            PG8_WAIT_L(8); PG8_BAR; PG8_WAIT_L(0); PG8_MMA(0, 0, At, B0); PG8_BAR; PG8_SCHED;
            PG8_LDB(B1, 0, 1); PG8_STAGE(PG8_SB(0, 0), b2, voffB);
            PG8_BAR; PG8_WAIT_L(0); PG8_MMA(0, 1, At, B1); PG8_BAR;
            PG8_LDA(At, 0, 1); PG8_STAGE(PG8_SA(0, 0), a2, voffA);
            PG8_BAR; PG8_WAIT_L(0); PG8_MMA(1, 0, At, B0); PG8_BAR; PG8_SCHED;
            PG8_STAGE(PG8_SB(0, 1), b2 + hstep, voffB);
            PG8_WAIT_V(6); PG8_BAR; PG8_MMA(1, 1, At, B1); PG8_BAR;
            PG8_LDB(B0, 1, 0); PG8_SCHED; PG8_LDA(At, 1, 0); PG8_STAGE(PG8_SA(0, 1), a2 + hstep, voffA);
            PG8_WAIT_L(8); PG8_BAR; PG8_WAIT_L(0); PG8_MMA(0, 0, At, B0); PG8_BAR; PG8_SCHED;
            PG8_LDB(B1, 1, 1); PG8_STAGE(PG8_SB(1, 0), b3, voffB);
            PG8_BAR; PG8_WAIT_L(0); PG8_MMA(0, 1, At, B1); PG8_BAR;
            PG8_LDA(At, 1, 1); PG8_STAGE(PG8_SA(1, 0), a3, voffA);
            PG8_BAR; PG8_WAIT_L(0); PG8_MMA(1, 0, At, B0); PG8_BAR; PG8_SCHED;
            PG8_STAGE(PG8_SB(1, 1), b3 + hstep, voffB);
            PG8_WAIT_V(6); PG8_BAR; PG8_MMA(1, 1, At, B1); PG8_BAR;
            }
        }
        if constexpr (ALIGN_EPI) { if (wr == 0) PG8_BAR; }
        if constexpr (!Epi::AFTER_DRAIN) { E(acc, cur, wr, wc, fr, fq); S.done(cur); }
        if (!has_next) break;
#pragma unroll
        for (int a = 0; a < 2; ++a)
#pragma unroll
            for (int b = 0; b < 2; ++b)
#pragma unroll
                for (int m = 0; m < 4; ++m)
#pragma unroll
                    for (int n = 0; n < 2; ++n) acc[a][b][m][n] = (f32x4){0.f, 0.f, 0.f, 0.f};
        cur = nxt; cA = nA; cB = nB; ++ui;
        if constexpr (ALIGN_EPI) { if (wr == 1) PG8_BAR; }
    }
    PG8_WAIT_V(0);
    if constexpr (!ALIGN_EPI) { if (wr == 0) PG8_BAR; }
    PG8_BAR;
    if constexpr (Epi::AFTER_DRAIN) { E.fused(acc, cur, wr, wc, fr, fq, lds, wid, lane); S.done(cur); }
#undef PG8_SA
#undef PG8_SB
#undef PG8_STAGE
#undef PG8_LDA
#undef PG8_LDB
#undef PG8_MMA
#undef PG8_WAIT_V
#undef PG8_WAIT_L
#undef PG8_BAR
#undef PG8_SCHED
}
}

constexpr int NWAVES = 8;
constexpr int N_LAUNCHES = MK_N_LAUNCHES;
constexpr int PER_PHASE = 8;
constexpr int NBATCH = 4, SEQ = 8192, D = 1024, T = NBATCH * SEQ, MEMLEN = 256, NMEMTOK = NBATCH * MEMLEN;
constexpr int IN_MAIN = 5120;
constexpr int NEXP = 16384;

constexpr size_t MiB = 1u << 20;
constexpr size_t WS_CTL = 0, CTL_ZERO_BYTES = 512 * 1024;
constexpr size_t WS_ROWSQ = 256 * 1024;
constexpr size_t WS_WIN = 1 * MiB, WS_WV = 11 * MiB, WS_WKV = 12 * MiB, WS_WBR = 14 * MiB, WS_WOUT = 17 * MiB, WS_WQ = 19 * MiB, WS_KEYS = 23 * MiB, WS_PWT = 23 * MiB + 512 * 1024;
constexpr size_t WS_MEMN = 24 * MiB, WS_KMEM = 26 * MiB, WS_VTMEM = 27 * MiB, WS_RSTDX = 28 * MiB, WS_SU = 28 * MiB + 256 * 1024, WS_SV = 28 * MiB + 512 * 1024;
constexpr size_t WS_U8 = 32 * MiB, WS_V8 = 48 * MiB;
constexpr size_t WS_QN = 96 * MiB, WS_KN = 128 * MiB, WS_VT = 160 * MiB, WS_PP = 192 * MiB, WS_XQ = 224 * MiB, WS_GATE = 256 * MiB, WS_END = 448 * MiB;
constexpr size_t WS_MERGED = WS_QN;
constexpr size_t WS_HB = WS_VT;
constexpr size_t WS_QB = WS_GATE;
constexpr size_t WS_TE = WS_GATE + 128 * MiB, WS_TW = WS_TE + 16 * MiB;
constexpr size_t OUT_XB = 0, OUT_YNA = 0, OUT_YPOOL = 32 * MiB, OUT_YXA = 64 * MiB;
constexpr int CW_TMO = 0, CW_BAR = 4096;

constexpr int RING_OFF = 0, RING_BYTES = 131072;
constexpr int LDSCTL_OFF = RING_BYTES, MISC_OFF = LDSCTL_OFF + 320;
constexpr int LDS_BYTES = 147456;

#define GAS __attribute__((address_space(1)))
#define LAS __attribute__((address_space(3)))
typedef unsigned short bf16;
typedef unsigned v4u __attribute__((ext_vector_type(4)));
typedef unsigned v2u __attribute__((ext_vector_type(2)));
typedef float f32x4 __attribute__((ext_vector_type(4)));
typedef short bf16x8 __attribute__((ext_vector_type(8)));
typedef __bf16 bf16x2_t __attribute__((ext_vector_type(2)));
typedef GAS unsigned gu32;
#define LDS_WAIT() asm volatile("s_waitcnt lgkmcnt(0)" ::: "memory")
#define VM_WAIT() asm volatile("s_waitcnt vmcnt(0)" ::: "memory")
__device__ __forceinline__ unsigned f2bf(float f) { unsigned u = __builtin_bit_cast(unsigned, f); return (u + 0x7fffu + ((u >> 16) & 1u)) >> 16; }
__device__ __forceinline__ unsigned pk2(float lo, float hi) { return f2bf(lo) | (f2bf(hi) << 16); }
__device__ __forceinline__ float bflo(unsigned u) { return __builtin_bit_cast(float, u << 16); }
__device__ __forceinline__ float bfhi(unsigned u) { return __builtin_bit_cast(float, u & 0xffff0000u); }
__device__ __forceinline__ float bf1(short s) { return __builtin_bit_cast(float, ((unsigned)(unsigned short)s) << 16); }
__device__ __forceinline__ f32x4 mfma16(bf16x8 a, bf16x8 b, f32x4 c) { return __builtin_amdgcn_mfma_f32_16x16x32_bf16(a, b, c, 0, 0, 0); }
__device__ __forceinline__ float wave_sum(float v) {
#pragma unroll
    for (int o = 1; o < 64; o <<= 1) v += __shfl_xor(v, o);
    return v;
}

#define XB_TMO      128
#define XB_XCNT(j)  (256  + 64 * (j))
#define XB_XSUB(j)  (1280 + 64 * (j))
#define XB_XGEN(j)  (2304 + 64 * (j))
#define XB_TOP      3328
#define XB_TOPGEN   3392
#define XCD_BAR_WORDS 3456
#define XB_SPIN_CAP (1u << 18)

__device__ __forceinline__ unsigned xb_ld(unsigned* p)              { return __hip_atomic_load(p, __ATOMIC_RELAXED, __HIP_MEMORY_SCOPE_AGENT); }
__device__ __forceinline__ unsigned xb_add(unsigned* p, unsigned v) { return __hip_atomic_fetch_add(p, v, __ATOMIC_RELAXED, __HIP_MEMORY_SCOPE_AGENT); }
__device__ __forceinline__ unsigned xb_xcc_id() { return (unsigned)__builtin_amdgcn_s_getreg((3 << 11) | 20) & 0xFu; }
#define XB_SPIN(cond, bar) do { unsigned _sp = 0; while (cond) { __builtin_amdgcn_s_sleep(1); \
    if ((++_sp & 255u) == 0u) { if (xb_ld(&(bar)[XB_TMO])) break; if (_sp > XB_SPIN_CAP) { atomicAdd(&(bar)[XB_TMO], 1u); break; } } } } while (0)

struct XcdBarrier {
    unsigned* bar; unsigned x;
    volatile LAS unsigned* st;
};

__device__ __forceinline__ XcdBarrier xcd_barrier_post(unsigned* bar, volatile LAS unsigned* st) {
    XcdBarrier b; b.bar = bar; b.x = xb_xcc_id(); b.st = st;
    if (threadIdx.x == 0) (void)xb_add(&bar[XB_XCNT(b.x)], 1u);
    return b;
}
__device__ __forceinline__ void xcd_barrier_complete(unsigned* bar, unsigned x, unsigned& nloc, unsigned& nx) {
    const unsigned G = gridDim.x * gridDim.y * gridDim.z;
    unsigned sum, cnt, mine, sp = 0u;
    for (;;) {
        sum = 0u; cnt = 0u; mine = 0u;
#pragma unroll
        for (unsigned j = 0; j < 16; ++j) { const unsigned c = xb_ld(&bar[XB_XCNT(j)]); sum += c; cnt += (c > 0u) ? 1u : 0u; mine = (j == x) ? c : mine; }
        if (sum == G) break;
        __builtin_amdgcn_s_sleep(1);
        if ((++sp & 255u) == 0u) { if (xb_ld(&bar[XB_TMO])) break; if (sp > XB_SPIN_CAP) { atomicAdd(&bar[XB_TMO], 1u); break; } }
    }
    nloc = mine > 0u ? mine : 1u; nx = cnt > 0u ? cnt : 1u;
}

__device__ __forceinline__ void xcd_barrier(const XcdBarrier& b) {
    asm volatile("s_waitcnt vmcnt(0)" ::: "memory");
    __syncthreads();
    if (threadIdx.x == 0) {
        unsigned* bar = b.bar;
        __builtin_amdgcn_s_waitcnt(0);
        unsigned nloc = b.st[0], nx = b.st[1];
        if (nloc == 0u) { xcd_barrier_complete(bar, b.x, nloc, nx); b.st[0] = nloc; b.st[1] = nx; }
        const unsigned old = xb_add(&bar[XB_XSUB(b.x)], 1u);
        const unsigned gen = old / nloc;
        if (old + 1u == (gen + 1u) * nloc) {
            __builtin_amdgcn_fence(__ATOMIC_RELEASE, "agent");
            asm volatile("s_waitcnt vmcnt(0)" ::: "memory");
            const unsigned og = xb_add(&bar[XB_TOP], 1u);
            const unsigned tg = og / nx;
            if (og + 1u == (tg + 1u) * nx) xb_add(&bar[XB_TOPGEN], 1u);
            else XB_SPIN(xb_ld(&bar[XB_TOPGEN]) == tg, bar);
            __builtin_amdgcn_fence(__ATOMIC_ACQUIRE, "agent");
            xb_add(&bar[XB_XGEN(b.x)], 1u);
            asm volatile("s_waitcnt vmcnt(0)" ::: "memory");
        } else {
            XB_SPIN(xb_ld(&bar[XB_XGEN(b.x)]) == gen, bar);
            __builtin_amdgcn_fence(__ATOMIC_ACQUIRE, "agent");
            asm volatile("s_waitcnt vmcnt(0)" ::: "memory");
        }
    }
    __syncthreads();
}

struct Frame {
    LAS unsigned char* lds;
    volatile LAS unsigned* MISC;
    gu32* ctl;
    int tid, lane, wave, vcu, G;
    float* out; unsigned char* ws;
};
struct Args { const float* in[23]; float* out; unsigned char* ws; int ph_lo, ph_hi; };
enum { I_X = 0, I_MEM, I_MIXG, I_MEMG, I_WIN, I_GATEB, I_WKV, I_NAQG, I_NAKG, I_RPB, I_POOLW, I_POOLSC, I_XAQG, I_XAKG, I_WB0, I_WB1, I_WB2, I_WOUT, I_FFNG, I_WQ, I_KEYS, I_PU, I_PV };

__device__ __forceinline__ void p0_transpose_item(const float* W, int K, int N, int k0, int n0, bf16* dst, const float* kscale, LAS float* scr, int lane) {
#pragma unroll 8
    for (int i = 0; i < 32; ++i) { const int kk = 2 * i + (lane >> 5); float v = W[(size_t)(k0 + kk) * N + n0 + (lane & 31)]; if (kscale) v *= kscale[k0 + kk]; scr[kk * 33 + (lane & 31)] = v; }
    LDS_WAIT(); asm volatile("" ::: "memory");
    const int c = lane & 7;
#pragma unroll
    for (int j = 0; j < 4; ++j) { const int n = (lane >> 3) + 8 * j; const LAS float* s = scr + (8 * c) * 33 + n;
        v4u o; o.x = pk2(s[0 * 33], s[1 * 33]); o.y = pk2(s[2 * 33], s[3 * 33]); o.z = pk2(s[4 * 33], s[5 * 33]); o.w = pk2(s[6 * 33], s[7 * 33]);
        *(GAS v4u*)(dst + (size_t)n * K + k0 + 8 * c) = o; }
    LDS_WAIT(); asm volatile("" ::: "memory");
}
__device__ __forceinline__ void cvt_row1024(const float* src, bf16* dst, const float* colscale, float rowscale, int lane) {
    const GAS f32x4* xr = (const GAS f32x4*)src + lane; GAS unsigned long long* o8 = (GAS unsigned long long*)dst + lane;
#pragma unroll
    for (int j = 0; j < 4; ++j) { f32x4 v = xr[64 * j] * rowscale; if (colscale) v = v * ((const GAS f32x4*)colscale)[lane + 64 * j];
        o8[64 * j] = (unsigned long long)pk2(v.x, v.y) | ((unsigned long long)pk2(v.z, v.w) << 32); }
}
__device__ __forceinline__ float row_rstd1024(const float* src, int lane) {
    const GAS f32x4* xr = (const GAS f32x4*)src + lane; float s = 0.f;
#pragma unroll
    for (int j = 0; j < 4; ++j) { const f32x4 v = xr[64 * j]; s += (v.x * v.x + v.y * v.y) + (v.z * v.z + v.w * v.w); }
    return rsqrtf(wave_sum(s) * (1.0f / 1024.0f) + 1e-6f);
}
__device__ __forceinline__ void p0_prologue(Frame& F, const Args& A) {
    LAS float* scr = (LAS float*)(F.lds + RING_OFF + F.wave * 16384);
    const int gw = F.vcu * NWAVES + F.wave, NGW = F.G * NWAVES, lane = F.lane;
    unsigned char* ws = F.ws;
    constexpr int I_IN = 16 * 176, I_KV = 16 * 32, I_BR = 8 * 32, I_OUT = 16 * 32, I_Q = 16 * 64;
    constexpr int NITEMS = I_IN + I_KV + 3 * I_BR + I_OUT + I_Q;
    for (int it = gw; it < NITEMS; it += NGW) {
        int r = it;
        if (r < I_IN) { const int kb = r / 176, nb = r % 176, n0 = 32 * nb; bf16* dst;
            if (n0 >= 1024 && n0 < 1536) dst = (bf16*)(ws + WS_WV) + (size_t)(n0 - 1024) * 1024;
            else { const int np = n0 < 1024 ? n0 : n0 - 512, t = np >> 8, w = np & 255, wc = w >> 6, bj = (w >> 5) & 1; dst = (bf16*)(ws + WS_WIN) + (size_t)(256 * t + 128 * bj + 32 * wc) * 1024; }
            p0_transpose_item(A.in[I_WIN], 1024, 5632, 64 * kb, n0, dst, A.in[I_MIXG], scr, lane); continue; }
        r -= I_IN;
        if (r < I_KV) { const int kb = r / 32, nb = r % 32; p0_transpose_item(A.in[I_WKV], 1024, 1024, 64 * kb, 32 * nb, (bf16*)(ws + WS_WKV) + (size_t)(32 * nb) * 1024, nullptr, scr, lane); continue; }
        r -= I_KV;
        if (r < 3 * I_BR) { const int br = r / I_BR, rr = r % I_BR, kb = rr / 32, nb = rr % 32; const float* W = br == 0 ? A.in[I_WB0] : (br == 1 ? A.in[I_WB1] : A.in[I_WB2]);
            p0_transpose_item(W, 512, 1024, 64 * kb, 32 * nb, (bf16*)(ws + WS_WBR) + (size_t)br * 1024 * 512 + (size_t)(32 * nb) * 512, nullptr, scr, lane); continue; }
        r -= 3 * I_BR;
        if (r < I_OUT) { const int kb = r / 32, nb = r % 32; p0_transpose_item(A.in[I_WOUT], 1024, 1024, 64 * kb, 32 * nb, (bf16*)(ws + WS_WOUT) + (size_t)(32 * nb) * 1024, nullptr, scr, lane); continue; }
        r -= I_OUT;
        { const int kb = r / 64, nb = r % 64; p0_transpose_item(A.in[I_WQ], 1024, 2048, 64 * kb, 32 * nb, (bf16*)(ws + WS_WQ) + (size_t)(32 * nb) * 1024, A.in[I_FFNG], scr, lane); }
    }
    { bf16* xb = (bf16*)((unsigned char*)F.out + OUT_XB); float* rstdx = (float*)(ws + WS_RSTDX);
      for (int m = gw; m < T; m += NGW) { const float* xr = A.in[I_X] + (size_t)m * D; const float rs = row_rstd1024(xr, lane); cvt_row1024(xr, xb + (size_t)m * D, nullptr, 1.0f, lane); if (lane == 0) rstdx[m] = rs; } }
    for (int m = gw; m < NMEMTOK; m += NGW) { const float* xr = A.in[I_MEM] + (size_t)m * D; const float rs = row_rstd1024(xr, lane); cvt_row1024(xr, (bf16*)(ws + WS_MEMN) + (size_t)m * D, A.in[I_MEMG], rs, lane); }
    for (int m = gw; m < 2 * NEXP; m += NGW) {
        const bool isu = m < NEXP; const int e = isu ? m : m - NEXP;
        const GAS f32x4* src = (const GAS f32x4*)((isu ? A.in[I_PU] : A.in[I_PV]) + (size_t)e * D) + 4 * lane;
        f32x4 v[4]; float mx = 0.f;
#pragma unroll
        for (int d = 0; d < 4; ++d) { v[d] = src[d]; if (isu) v[d] = v[d] * ((const GAS f32x4*)A.in[I_FFNG])[4 * lane + d];
            mx = fmaxf(mx, fmaxf(fmaxf(fabsf(v[d].x), fabsf(v[d].y)), fmaxf(fabsf(v[d].z), fabsf(v[d].w)))); }
#pragma unroll
        for (int o = 1; o < 64; o <<= 1) mx = fmaxf(mx, __shfl_xor(mx, o));
        const float inv = mx > 0.f ? 127.0f / mx : 0.f; const int off = isu ? 0 : 128;
        v4u w;
#pragma unroll
        for (int d = 0; d < 4; ++d) { const unsigned b0 = (unsigned)((int)rintf(v[d].x * inv) + off) & 0xffu, b1 = (unsigned)((int)rintf(v[d].y * inv) + off) & 0xffu,
                                                     b2 = (unsigned)((int)rintf(v[d].z * inv) + off) & 0xffu, b3 = (unsigned)((int)rintf(v[d].w * inv) + off) & 0xffu;
            w[d] = b0 | (b1 << 8) | (b2 << 16) | (b3 << 24); }
        ((GAS v4u*)(ws + (isu ? WS_U8 : WS_V8)))[(size_t)e * 64 + lane] = w;
        if (lane == 0) ((float*)(ws + (isu ? WS_SU : WS_SV)))[e] = mx * (1.0f / 127.0f);
    }
    for (int m = gw * 64 + lane; m < T; m += NGW * 64) ((float*)(ws + WS_ROWSQ))[m] = 0.f;
    for (int m = gw; m < 256; m += NGW) cvt_row1024(A.in[I_KEYS] + (size_t)m * 1024, (bf16*)(ws + WS_KEYS) + (size_t)m * 1024, nullptr, 1.0f, lane);
    for (int m = gw; m < 1024; m += NGW) { const int gd = m >> 1, c = (m & 1) * 64 + lane, g = gd >> 7, d = gd & 127;
        const float v = A.in[I_POOLW][(size_t)(g * 128 + c) * 128 + d] * A.in[I_POOLSC][gd];
        ((bf16*)(ws + WS_PWT))[(size_t)gd * 128 + c] = (bf16)f2bf(v); }
}

__device__ __forceinline__ void memkv_tile(const bf16* memn, const bf16* wkvT, const float* kg, const float* qg, bf16* kmem, bf16* vtmem, int tile, int lane) {
    const int q = lane & 15, hi = lane >> 4, rg = tile >> 3, cg = tile & 7, r0 = rg * 16, c0 = cg * 128;
    f32x4 acc[8];
#pragma unroll
    for (int i = 0; i < 8; ++i) acc[i] = (f32x4){0.f, 0.f, 0.f, 0.f};
    const bf16* ap = memn + (size_t)(r0 + q) * 1024 + 8 * hi; const bf16* bp = wkvT + (size_t)(c0 + q) * 1024 + 8 * hi;
#pragma unroll 2
    for (int ks = 0; ks < 32; ++ks) { const bf16x8 a = *(const bf16x8*)(ap + 32 * ks);
#pragma unroll
        for (int nf = 0; nf < 8; ++nf) { const bf16x8 b = *(const bf16x8*)(bp + (size_t)(16 * nf) * 1024 + 32 * ks); acc[nf] = mfma16(a, b, acc[nf]); } }
    if (cg < 4) {
        float rr[4];
#pragma unroll
        for (int g = 0; g < 4; ++g) { float ss = 0.f;
#pragma unroll
            for (int nf = 0; nf < 8; ++nf) ss += acc[nf][g] * acc[nf][g];
            ss += __shfl_xor(ss, 1); ss += __shfl_xor(ss, 2); ss += __shfl_xor(ss, 4); ss += __shfl_xor(ss, 8);
            rr[g] = rsqrtf(ss * (1.0f / 128.0f) + 1e-6f); }
#pragma unroll
        for (int nf = 0; nf < 8; ++nf) { const int d = 16 * nf + q; const float gs = kg[d] * qg[d];
#pragma unroll
            for (int g = 0; g < 4; ++g) kmem[(size_t)(r0 + 4 * hi + g) * 512 + cg * 128 + d] = (bf16)f2bf(acc[nf][g] * rr[g] * gs); }
    } else {
        const int h = cg - 4, b = r0 >> 8, key0 = (r0 & 255) + 4 * hi;
#pragma unroll
        for (int nf = 0; nf < 8; ++nf) { const int d = 16 * nf + q; v2u w; w.x = pk2(acc[nf][0], acc[nf][1]); w.y = pk2(acc[nf][2], acc[nf][3]);
            *(v2u*)(vtmem + (size_t)(b * 512 + h * 128 + d) * 256 + key0) = w; }
    }
}

__device__ __forceinline__ void na_item(const bf16* __restrict__ qn, const bf16* __restrict__ kn, const bf16* __restrict__ vt, const LAS float* rpl, bf16* __restrict__ yna,
                                        int b, int r, int jb, int h, int lane) {
    const int q = lane & 15, hi = lane >> 4;
    int rs = r - 4; rs = rs < 0 ? 0 : (rs > 120 ? 120 : rs);
    int kb0 = jb * 16 - 8; kb0 = kb0 < 0 ? 0 : (kb0 > 32 ? 32 : kb0);
    const int qcol = jb * 16 + q; int cs = qcol - 8; cs = cs < 0 ? 0 : (cs > 48 ? 48 : cs);
    const size_t tokq = (size_t)b * SEQ + r * 64 + qcol;
    const bf16* qp = qn + tokq * 512 + h * 64 + 8 * hi;
    const bf16x8 qf0 = *(const bf16x8*)qp, qf1 = *(const bf16x8*)(qp + 32);
    const int kq = 8 * (q >> 2) + (q & 3);
    const bf16* kbase = kn + ((size_t)b * SEQ + rs * 64 + kb0 + kq) * 512 + h * 64 + 8 * hi;
    f32x4 s[16];
#pragma unroll
    for (int f = 0; f < 16; ++f) {
        const bf16* kp = kbase + (size_t)((f >> 1) * 64 + (f & 1) * 4) * 512;
        const bf16x8 a0 = *(const bf16x8*)kp, a1 = *(const bf16x8*)(kp + 32);
        f32x4 z = (f32x4){0.f, 0.f, 0.f, 0.f}; z = mfma16(a0, qf0, z); s[f] = mfma16(a1, qf1, z);
    }
    float mx = -3.0e38f;
#pragma unroll
    for (int f = 0; f < 16; ++f) {
        const int dr = rs + (f >> 1) - r + 7;
#pragma unroll
        for (int g = 0; g < 4; ++g) {
            const int kcol = kb0 + 8 * hi + 4 * (f & 1) + g;
            const bool ok = (kcol >= cs) && (kcol < cs + 16);
            int dc = kcol - qcol + 15; dc = dc < 0 ? 0 : (dc > 30 ? 30 : dc);
            const float v = ok ? s[f][g] + rpl[dr * 31 + dc] : -1.0e30f;
            s[f][g] = v; mx = fmaxf(mx, v);
        }
    }
    mx = fmaxf(mx, __shfl_xor(mx, 16)); mx = fmaxf(mx, __shfl_xor(mx, 32));
    float sum = 0.f;
#pragma unroll
    for (int f = 0; f < 16; ++f)
#pragma unroll
        for (int g = 0; g < 4; ++g) { const float p = __expf(s[f][g] - mx); s[f][g] = p; sum += p; }
    sum += __shfl_xor(sum, 16); sum += __shfl_xor(sum, 32);
    const float inv = 1.0f / sum;
    f32x4 o[4];
#pragma unroll
    for (int i = 0; i < 4; ++i) o[i] = (f32x4){0.f, 0.f, 0.f, 0.f};
    const bf16* vbase = vt + ((size_t)(b * 512 + h * 64 + q) * SEQ + rs * 64 + kb0 + 8 * hi);
#pragma unroll
    for (int st = 0; st < 8; ++st) {
        const bf16x8 pb = __builtin_bit_cast(bf16x8, pg8::pack8(s[2 * st], s[2 * st + 1]));
#pragma unroll
        for (int mf = 0; mf < 4; ++mf) o[mf] = mfma16(*(const bf16x8*)(vbase + (size_t)(16 * mf) * SEQ + st * 64), pb, o[mf]);
    }
    bf16* yp = yna + tokq * 512 + h * 64 + 4 * hi;
#pragma unroll
    for (int mf = 0; mf < 4; ++mf) { v2u w; w.x = pk2(o[mf][0] * inv, o[mf][1] * inv); w.y = pk2(o[mf][2] * inv, o[mf][3] * inv); *(v2u*)(yp + 16 * mf) = w; }
}
__device__ __forceinline__ void xa_item(const bf16* __restrict__ xq, const bf16* __restrict__ kmem, const bf16* __restrict__ vtmem, bf16* __restrict__ yxa, int tok0, int h, int lane) {
    const int q = lane & 15, hi = lane >> 4; const size_t tok = (size_t)tok0 + q; const int b = tok0 >> 13;
    const bf16* qp = xq + tok * 512 + h * 128 + 8 * hi;
    bf16x8 qf[4]; float ssq = 0.f;
#pragma unroll
    for (int ks = 0; ks < 4; ++ks) { qf[ks] = *(const bf16x8*)(qp + 32 * ks);
#pragma unroll
        for (int j = 0; j < 8; ++j) { const float v = bf1(qf[ks][j]); ssq += v * v; } }
    ssq += __shfl_xor(ssq, 16); ssq += __shfl_xor(ssq, 32);
    const float cexp = rsqrtf(ssq * (1.0f / 128.0f) + 1e-6f) * 0.08838834764831845f * 1.4426950408889634f;
    const int kq = 8 * (q >> 2) + (q & 3);
    const bf16* kbase = kmem + ((size_t)b * 256 + kq) * 512 + h * 128 + 8 * hi;
    f32x4 s[16];
#pragma unroll
    for (int f = 0; f < 16; ++f) { const bf16* kp = kbase + (size_t)(32 * (f >> 1) + 4 * (f & 1)) * 512; f32x4 z = (f32x4){0.f, 0.f, 0.f, 0.f};
#pragma unroll
        for (int ks = 0; ks < 4; ++ks) z = mfma16(*(const bf16x8*)(kp + 32 * ks), qf[ks], z);
        s[f] = z; }
    float mx = -3.0e38f;
#pragma unroll
    for (int f = 0; f < 16; ++f)
#pragma unroll
        for (int g = 0; g < 4; ++g) mx = fmaxf(mx, s[f][g]);
    mx = fmaxf(mx, __shfl_xor(mx, 16)); mx = fmaxf(mx, __shfl_xor(mx, 32));
    float sum = 0.f;
#pragma unroll
    for (int f = 0; f < 16; ++f)
#pragma unroll
        for (int g = 0; g < 4; ++g) { const float p = __builtin_amdgcn_exp2f((s[f][g] - mx) * cexp); s[f][g] = p; sum += p; }
    sum += __shfl_xor(sum, 16); sum += __shfl_xor(sum, 32);
    const float inv = 1.0f / sum;
    f32x4 o[8];
#pragma unroll
    for (int i = 0; i < 8; ++i) o[i] = (f32x4){0.f, 0.f, 0.f, 0.f};
    const bf16* vbase = vtmem + (size_t)(b * 512 + h * 128 + q) * 256 + 8 * hi;
#pragma unroll
    for (int st = 0; st < 8; ++st) {
        const bf16x8 pb = __builtin_bit_cast(bf16x8, pg8::pack8(s[2 * st], s[2 * st + 1]));
#pragma unroll
        for (int mf = 0; mf < 8; ++mf) o[mf] = mfma16(*(const bf16x8*)(vbase + (size_t)(16 * mf) * 256 + 32 * st), pb, o[mf]);
    }
    bf16* yp = yxa + tok * 512 + h * 128 + 4 * hi;
#pragma unroll
    for (int mf = 0; mf < 8; ++mf) { v2u w; w.x = pk2(o[mf][0] * inv, o[mf][1] * inv); w.y = pk2(o[mf][2] * inv, o[mf][3] * inv); *(v2u*)(yp + 16 * mf) = w; }
}
__device__ __forceinline__ void pool_wg(const bf16* __restrict__ pp, const bf16* __restrict__ pwT, bf16* __restrict__ ypool, LAS unsigned char* lds, int tokbase, int wave, int lane) {
    const int q = lane & 15, hi = lane >> 4;
    __syncthreads();
    {
        const int hw = 1 << hi, tw0 = tokbase + 16 * wave, b = tw0 >> 13, t0 = tw0 & 8191;
        const bf16* base = pp + (size_t)b * SEQ * 512 + 8 * lane;
        float s[8];
#pragma unroll
        for (int j = 0; j < 8; ++j) s[j] = 0.f;
#pragma unroll 4
        for (int d = -8; d < 8; ++d) { const int u = t0 + d; const bool ok = (d >= -hw) && (d < hw) && (u >= 0) && (u < SEQ);
            const bf16x8 v = *(const bf16x8*)(base + (size_t)(ok ? u : t0) * 512);
#pragma unroll
            for (int j = 0; j < 8; ++j) s[j] += ok ? bf1(v[j]) : 0.f; }
        LAS unsigned char* tile = lds + wave * 16384;
#pragma unroll 2
        for (int i = 0; i < 16; ++i) { const int t = t0 + i;
            int lo = t - hw; lo = lo < 0 ? 0 : lo; int ht = t + hw; ht = ht > SEQ ? SEQ : ht;
            const float inv = 1.0f / (float)(ht - lo);
            const bool oka = (t + hw) < SEQ, oks = (t - hw) >= 0;
            const bf16x8 sv = *(const bf16x8*)(base + (size_t)t * 512), av = *(const bf16x8*)(base + (size_t)(oka ? t + hw : t) * 512), bv = *(const bf16x8*)(base + (size_t)(oks ? t - hw : t) * 512);
            f32x4 p0, p1;
#pragma unroll
            for (int j = 0; j < 4; ++j) { p0[j] = s[j] * inv - bf1(sv[j]); p1[j] = s[j + 4] * inv - bf1(sv[j + 4]); }
            *(LAS v4u*)(tile + i * 1024 + ((lane ^ (i & 15)) << 4)) = pg8::pack8(p0, p1);
#pragma unroll
            for (int j = 0; j < 8; ++j) s[j] += (oka ? bf1(av[j]) : 0.f) - (oks ? bf1(bv[j]) : 0.f);
        }
    }
    __syncthreads();
#pragma unroll 1
    for (int k = 0; k < 4; ++k) {
        const int pair = wave * 4 + k, g = pair >> 3, mf = pair & 7;
        const bf16* wb = pwT + (size_t)(g * 128 + 16 * mf + q) * 128 + 8 * hi;
        bf16x8 a[4];
#pragma unroll
        for (int ks = 0; ks < 4; ++ks) a[ks] = *(const bf16x8*)(wb + 32 * ks);
#pragma unroll 2
        for (int tg = 0; tg < 8; ++tg) {
            const LAS unsigned char* trow = lds + tg * 16384 + q * 1024; f32x4 o = (f32x4){0.f, 0.f, 0.f, 0.f};
#pragma unroll
            for (int ks = 0; ks < 4; ++ks) { const int c = g * 16 + 4 * ks + hi; o = mfma16(a[ks], *(const LAS bf16x8*)(trow + ((c ^ q) << 4)), o); }
            v2u w; w.x = pk2(o[0], o[1]); w.y = pk2(o[2], o[3]);
            *(v2u*)(ypool + (size_t)(tokbase + 16 * tg + q) * 512 + g * 128 + 16 * mf + 4 * hi) = w;
        }
    }
    __syncthreads();
}

__device__ __forceinline__ int f2key(float s, int idx, int mask) { int b = __builtin_bit_cast(int, s); b = b >= 0 ? b : (b ^ 0x7fffffff); return (b & ~mask) | idx; }
__device__ __forceinline__ float key2f(int k) { k = k >= 0 ? k : (k ^ 0x7fffffff); return __builtin_bit_cast(float, k); }
#define INS16(L, x) do { int _x = (x); _Pragma("unroll") for (int _j = 0; _j < 16; ++_j) { const int _t = L[_j] > _x ? L[_j] : _x; _x = L[_j] > _x ? _x : L[_j]; L[_j] = _t; } } while (0)
__device__ __forceinline__ void topk_item(const bf16* __restrict__ qb, const bf16* __restrict__ keys, int* __restrict__ te, float* __restrict__ tw, LAS int* lscr, int tok0, int h, int lane) {
    const int q = lane & 15, hi = lane >> 4; const size_t tok = (size_t)tok0 + q;
    int L[2][16];
#pragma unroll
    for (int p = 0; p < 2; ++p) {
#pragma unroll
        for (int k = 0; k < 16; ++k) L[p][k] = (int)0x80000000;
        bf16x8 qf[4];
#pragma unroll
        for (int ks = 0; ks < 4; ++ks) qf[ks] = *(const bf16x8*)(qb + tok * 2048 + h * 256 + p * 128 + 32 * ks + 8 * hi);
        const bf16* kb = keys + (size_t)((h * 2 + p) * 128 + q) * 128 + 8 * hi;
#pragma unroll
        for (int mf = 0; mf < 8; ++mf) { f32x4 s = (f32x4){0.f, 0.f, 0.f, 0.f};
#pragma unroll
            for (int ks = 0; ks < 4; ++ks) s = mfma16(*(const bf16x8*)(kb + (size_t)(16 * mf) * 128 + 32 * ks), qf[ks], s);
#pragma unroll
            for (int g = 0; g < 4; ++g) INS16(L[p], f2key(s[g], 16 * mf + 4 * hi + g, 127)); }
#pragma unroll
        for (int step = 16; step <= 32; step <<= 1) { int tmp[16];
#pragma unroll
            for (int k = 0; k < 16; ++k) tmp[k] = L[p][k];
#pragma unroll
            for (int k = 0; k < 16; ++k) { const int o = __shfl_xor(tmp[k], step); INS16(L[p], o); } }
    }
    float v1[16], v2[16];
#pragma unroll
    for (int k = 0; k < 16; ++k) { v1[k] = key2f(L[0][k]); v2[k] = key2f(L[1][k]); }
    int Fk[16];
#pragma unroll
    for (int k = 0; k < 16; ++k) Fk[k] = (int)0x80000000;
#pragma unroll
    for (int i = 0; i < 16; ++i)
#pragma unroll
        for (int j = 0; j < 16; ++j) if ((i + 1) * (j + 1) <= 16) INS16(Fk, f2key(v1[i] + v2[j], (i << 4) | j, 255));
    LAS int* my = lscr + lane * 33;
#pragma unroll
    for (int k = 0; k < 16; ++k) { my[k] = L[0][k] & 127; my[16 + k] = L[1][k] & 127; }
    LDS_WAIT(); asm volatile("" ::: "memory");
    float e[16]; float sum = 0.f; const float mx = key2f(Fk[0]);
#pragma unroll
    for (int k = 0; k < 16; ++k) { e[k] = __expf(key2f(Fk[k]) - mx); sum += e[k]; }
    const float inv = 1.0f / sum;
    if (hi == 0) {
        int* tep = te + (tok * 8 + h) * 16; float* twp = tw + (tok * 8 + h) * 16;
#pragma unroll
        for (int k4 = 0; k4 < 4; ++k4) { int ev[4]; f32x4 wv;
#pragma unroll
            for (int k = 0; k < 4; ++k) { const int kk = 4 * k4 + k, i = (Fk[kk] >> 4) & 15, j = Fk[kk] & 15; ev[k] = my[i] * 128 + my[16 + j]; wv[k] = e[kk] * inv; }
            *(v4u*)(tep + 4 * k4) = (v4u){(unsigned)ev[0], (unsigned)ev[1], (unsigned)ev[2], (unsigned)ev[3]}; *(f32x4*)(twp + 4 * k4) = wv; }
    }
    LDS_WAIT(); asm volatile("" ::: "memory");
}

__device__ __forceinline__ float ub2f(unsigned v, int b) { return (float)((v >> (8 * b)) & 0xffu); }
__device__ __forceinline__ void peer_token(const bf16* __restrict__ hb, const float* __restrict__ rowsq, const unsigned char* __restrict__ u8, const unsigned char* __restrict__ v8,
                                           const float* __restrict__ su, const float* __restrict__ sv, const int* __restrict__ te, const float* __restrict__ tw,
                                           const float* hsrc, float* out, int tok, int lane) {
    const bf16* hp = hb + (size_t)tok * 1024 + 16 * lane;
    const v4u hA = *(const v4u*)hp, hB = *(const v4u*)(hp + 8);
    float hf[16];
#pragma unroll
    for (int d = 0; d < 4; ++d) { hf[2 * d] = bflo(hA[d]); hf[2 * d + 1] = bfhi(hA[d]); hf[8 + 2 * d] = bflo(hB[d]); hf[8 + 2 * d + 1] = bfhi(hB[d]); }
    float amax = 0.f;
#pragma unroll
    for (int j = 0; j < 16; ++j) amax = fmaxf(amax, fabsf(hf[j]));
#pragma unroll
    for (int o = 1; o < 64; o <<= 1) amax = fmaxf(amax, __shfl_xor(amax, o));
    const float hinv = amax > 0.f ? 127.0f / amax : 0.f;
    int hq[4];
#pragma unroll
    for (int d = 0; d < 4; ++d) { const unsigned b0 = (unsigned)(int)rintf(hf[4 * d] * hinv) & 0xffu, b1 = (unsigned)(int)rintf(hf[4 * d + 1] * hinv) & 0xffu,
                                                 b2 = (unsigned)(int)rintf(hf[4 * d + 2] * hinv) & 0xffu, b3 = (unsigned)(int)rintf(hf[4 * d + 3] * hinv) & 0xffu;
        hq[d] = (int)(b0 | (b1 << 8) | (b2 << 16) | (b3 << 24)); }
    const float zscale = rsqrtf(rowsq[tok] * (1.0f / 1024.0f) + 1e-6f) * amax * (1.0f / 127.0f);
    const int e0 = te[(size_t)tok * 128 + lane], e1 = te[(size_t)tok * 128 + 64 + lane];
    const float* ip = hsrc + (size_t)tok * 1024 + 16 * lane; float* op = out + (size_t)tok * 1024 + 16 * lane;
    f32x4 acc[4];
#pragma unroll
    for (int d = 0; d < 4; ++d) acc[d] = *(const f32x4*)(ip + 4 * d);
    float wsum = 0.f;
#pragma unroll 1
    for (int hd = 0; hd < 8; ++hd) {
        const int esel = hd < 4 ? e0 : e1, lbase = (hd & 3) * 16;
        v4u ur[16], vr[16];
#pragma unroll
        for (int k = 0; k < 16; ++k) { const int e = __builtin_amdgcn_readlane(esel, lbase + k);
            ur[k] = *(const v4u*)(u8 + (size_t)e * 1024 + 16 * lane); vr[k] = *(const v4u*)(v8 + (size_t)e * 1024 + 16 * lane); }
        const int el = __shfl(esel, lbase + (lane >> 2));
        const float su_l = su[el], sv_l = sv[el], g_l = tw[(size_t)tok * 128 + hd * 16 + (lane >> 2)];
        int p[16];
#pragma unroll
        for (int k = 0; k < 16; ++k) { int d = __builtin_amdgcn_sdot4((int)ur[k].x, hq[0], 0, false); d = __builtin_amdgcn_sdot4((int)ur[k].y, hq[1], d, false);
            d = __builtin_amdgcn_sdot4((int)ur[k].z, hq[2], d, false); p[k] = __builtin_amdgcn_sdot4((int)ur[k].w, hq[3], d, false); }
        int q8[8], q4[4], q2[2], q1;
#pragma unroll
        for (int i = 0; i < 8; ++i) { const bool up = (lane & 32) != 0; const int keep = up ? p[i + 8] : p[i], send = up ? p[i] : p[i + 8]; q8[i] = keep + __shfl_xor(send, 32); }
#pragma unroll
        for (int i = 0; i < 4; ++i) { const bool up = (lane & 16) != 0; const int keep = up ? q8[i + 4] : q8[i], send = up ? q8[i] : q8[i + 4]; q4[i] = keep + __shfl_xor(send, 16); }
#pragma unroll
        for (int i = 0; i < 2; ++i) { const bool up = (lane & 8) != 0; const int keep = up ? q4[i + 2] : q4[i], send = up ? q4[i] : q4[i + 2]; q2[i] = keep + __shfl_xor(send, 8); }
        { const bool up = (lane & 4) != 0; const int keep = up ? q2[1] : q2[0], send = up ? q2[0] : q2[1]; q1 = keep + __shfl_xor(send, 4); }
        q1 += __shfl_xor(q1, 2); q1 += __shfl_xor(q1, 1);
        const float z = (float)q1 * zscale * su_l;
        const float wgt = g_l * 0.5f * z * (1.0f + erff(z * 0.70710678118654752f)) * sv_l;
#pragma unroll
        for (int k = 0; k < 16; ++k) { const float wk = __builtin_bit_cast(float, __builtin_amdgcn_readlane(__builtin_bit_cast(int, wgt), 4 * k)); wsum += wk;
#pragma unroll
            for (int d = 0; d < 4; ++d) { acc[d][0] += wk * ub2f(vr[k][d], 0); acc[d][1] += wk * ub2f(vr[k][d], 1); acc[d][2] += wk * ub2f(vr[k][d], 2); acc[d][3] += wk * ub2f(vr[k][d], 3); } }
    }
    const float corr = 128.0f * wsum;
#pragma unroll
    for (int d = 0; d < 4; ++d) *(f32x4*)(op + 4 * d) = acc[d] - corr;
}

__global__ void __launch_bounds__(NWAVES * 64, 2) mk_fwd(Args args) {
    extern __shared__ __attribute__((aligned(16))) unsigned char lds[];
    Frame F;
    F.lds = (LAS unsigned char*)lds;
    F.MISC = (volatile LAS unsigned*)(F.lds + MISC_OFF);
    F.tid = threadIdx.x; F.lane = F.tid & 63; F.wave = __builtin_amdgcn_readfirstlane(F.tid >> 6);
    F.G = gridDim.x; { const int bx = blockIdx.x; F.vcu = (F.G % 8 == 0) ? (bx % 8) * (F.G / 8) + bx / 8 : bx; }
    F.out = args.out; F.ws = args.ws;
    unsigned char* ws = args.ws;
    F.ctl = (gu32*)(ws + WS_CTL);
    for (int u = F.tid; u < (LDS_BYTES - LDSCTL_OFF) / 4; u += NWAVES * 64) ((LAS unsigned*)(F.lds + LDSCTL_OFF))[u] = 0u;
    __syncthreads();
    XcdBarrier bar; bar.bar = (unsigned*)(F.ctl + CW_BAR); bar.x = 0; bar.st = nullptr;
    if (N_LAUNCHES != PER_PHASE) bar = xcd_barrier_post((unsigned*)(F.ctl + CW_BAR), F.MISC + 8);
#define GRID_BAR() do { if (N_LAUNCHES != PER_PHASE) xcd_barrier(bar); } while (0)
    const int lo = args.ph_lo, hi = args.ph_hi;
#define IN(k) (lo <= (k) && (k) < hi)
#define BOTH(k) (IN(k) && IN((k) + 1))
#ifndef DUP_PHASE
#define DUP_PHASE (-1)
#endif
#define NREP(k) ((DUP_PHASE == (k)) ? 2 : 1)
    const int gw = F.vcu * NWAVES + F.wave, NGW = F.G * NWAVES;
    bf16* const WinT = (bf16*)(ws + WS_WIN); bf16* const WvT = (bf16*)(ws + WS_WV); bf16* const WkvT = (bf16*)(ws + WS_WKV); bf16* const WbrT = (bf16*)(ws + WS_WBR);
    bf16* const WoutT = (bf16*)(ws + WS_WOUT); bf16* const WqT = (bf16*)(ws + WS_WQ); bf16* const KEYS = (bf16*)(ws + WS_KEYS); bf16* const PWT = (bf16*)(ws + WS_PWT);
    bf16* const MEMN = (bf16*)(ws + WS_MEMN); bf16* const KMEM = (bf16*)(ws + WS_KMEM); bf16* const VTMEM = (bf16*)(ws + WS_VTMEM); float* const RSTDX = (float*)(ws + WS_RSTDX);
    const unsigned char* const U8 = ws + WS_U8; const unsigned char* const V8 = ws + WS_V8; const float* const SU = (const float*)(ws + WS_SU); const float* const SV = (const float*)(ws + WS_SV);
    bf16* const QN = (bf16*)(ws + WS_QN); bf16* const KN = (bf16*)(ws + WS_KN); bf16* const VT = (bf16*)(ws + WS_VT); bf16* const PP = (bf16*)(ws + WS_PP); bf16* const XQ = (bf16*)(ws + WS_XQ);
    bf16* const GATE = (bf16*)(ws + WS_GATE); bf16* const MERGED = (bf16*)(ws + WS_MERGED); bf16* const HB = (bf16*)(ws + WS_HB); bf16* const QB = (bf16*)(ws + WS_QB);
    int* const TE = (int*)(ws + WS_TE); float* const TW = (float*)(ws + WS_TW); float* const ROWSQ = (float*)(ws + WS_ROWSQ);
    bf16* const XB = (bf16*)((unsigned char*)args.out + OUT_XB); bf16* const YNA = (bf16*)((unsigned char*)args.out + OUT_YNA);
    bf16* const YPOOL = (bf16*)((unsigned char*)args.out + OUT_YPOOL); bf16* const YXA = (bf16*)((unsigned char*)args.out + OUT_YXA);

    if (IN(0)) { for (int rep = 0; rep < NREP(0); ++rep) { p0_prologue(F, args); if (rep + 1 < NREP(0)) GRID_BAR(); } if (BOTH(0)) GRID_BAR(); }

    if (IN(1)) {
      for (int rep = 0; rep < NREP(1); ++rep) {
        { pg8::Sched1 S; S.so.init(T, IN_MAIN, F.G, (int)blockIdx.x); S.A = (const char*)XB; S.Bt = (const char*)WinT; S.tstep = (size_t)256 * 1024 * 2;
          pg8::EpiProj E{RSTDX, QN, KN, PP, XQ, GATE, args.in[I_NAQG], args.in[I_NAKG], args.in[I_GATEB]};
          pg8::gemm_phase<pg8::EpiProj, pg8::Sched1, true, true>(F.lds + RING_OFF, 1024, S, E); }
        { pg8::Sched1 S; S.so.init(512, T, F.G, (int)blockIdx.x); S.A = (const char*)WvT; S.Bt = (const char*)XB; S.tstep = (size_t)256 * 1024 * 2;
          pg8::EpiVt E{RSTDX, VT};
          pg8::gemm_phase<pg8::EpiVt, pg8::Sched1, false, true>(F.lds + RING_OFF, 1024, S, E); }
        for (int t = gw; t < 512; t += NGW) memkv_tile(MEMN, WkvT, args.in[I_XAKG], args.in[I_XAQG], KMEM, VTMEM, t, F.lane);
        if (rep + 1 < NREP(1)) GRID_BAR();
      }
        if (BOTH(1)) GRID_BAR();
    }

    if (IN(2)) {
      for (int rep = 0; rep < NREP(2); ++rep) {
        LAS float* rpl = (LAS float*)(F.lds + RING_OFF + F.wave * 16384);
        for (int i = F.lane; i < 15 * 31; i += 64) rpl[i] = args.in[I_RPB][F.wave * 15 * 31 + i];
        LDS_WAIT(); asm volatile("" ::: "memory");
        for (int i = F.vcu; i < 256; i += F.G)
            for (int k = 0; k < 8; ++k) { const int idx = i * 8 + k, b = idx >> 9, r = (idx >> 2) & 127, jb = idx & 3; na_item(QN, KN, VT, rpl, YNA, b, r, jb, F.wave, F.lane); }
        for (int i = F.vcu; i < 256; i += F.G) pool_wg(PP, PWT, YPOOL, F.lds + RING_OFF, i * 128, F.wave, F.lane);
        for (int it = gw; it < 8192; it += NGW) xa_item(XQ, KMEM, VTMEM, YXA, (it >> 2) * 16, it & 3, F.lane);
        if (rep + 1 < NREP(2)) GRID_BAR();
      }
        if (BOTH(2)) GRID_BAR();
    }

    if (IN(3)) {
      for (int rep = 0; rep < NREP(3); ++rep) {
        pg8::Sched3 S; S.so.init(T, D, F.G, (int)blockIdx.x); S.A = (const char*)YNA; S.Bt = (const char*)WbrT; S.tstep = (size_t)256 * 512 * 2; S.strideA = 32 * MiB; S.strideB = (size_t)1024 * 512 * 2;
        pg8::EpiMerge E{GATE, (bf16*)(ws + WS_VT)  , MERGED};
        pg8::gemm_phase<pg8::EpiMerge, pg8::Sched3, true, true>(F.lds + RING_OFF, 512, S, E);
        if (rep + 1 < NREP(3)) GRID_BAR();
      }
        if (BOTH(3)) GRID_BAR();
    }

    if (IN(4)) {
      for (int rep = 0; rep < NREP(4); ++rep) {
        pg8::Sched1 S; S.so.init(T, D, F.G, (int)blockIdx.x); S.A = (const char*)MERGED; S.Bt = (const char*)WoutT; S.tstep = (size_t)256 * 1024 * 2;
        pg8::EpiH E{args.in[I_X], F.out, HB, ROWSQ};
        pg8::gemm_phase<pg8::EpiH, pg8::Sched1, true, true>(F.lds + RING_OFF, 1024, S, E);
        if (rep + 1 < NREP(4)) { GRID_BAR(); for (int m = gw * 64 + F.lane; m < T; m += NGW * 64) ROWSQ[m] = 0.f; GRID_BAR(); }
      }
        if (BOTH(4)) GRID_BAR();
    }

    if (IN(5)) {
      for (int rep = 0; rep < NREP(5); ++rep) {
        pg8::Sched1 S; S.so.init(T, 2048, F.G, (int)blockIdx.x); S.A = (const char*)HB; S.Bt = (const char*)WqT; S.tstep = (size_t)256 * 1024 * 2;
        pg8::EpiQ E{ROWSQ, QB};
        pg8::gemm_phase<pg8::EpiQ, pg8::Sched1, true, true>(F.lds + RING_OFF, 1024, S, E);
        if (rep + 1 < NREP(5)) GRID_BAR();
      }
        if (BOTH(5)) GRID_BAR();
    }

    if (IN(6)) {
        LAS int* lscr = (LAS int*)(F.lds + RING_OFF + F.wave * 16384);
        for (int rep = 0; rep < NREP(6); ++rep) { for (int it = gw; it < 16384; it += NGW) topk_item(QB, KEYS, TE, TW, lscr, (it >> 3) * 16, it & 7, F.lane); if (rep + 1 < NREP(6)) GRID_BAR(); }
        if (BOTH(6)) GRID_BAR();
    }

    if (IN(7)) {
        for (int rep = 0; rep < NREP(7); ++rep) { float* dst = (rep + 1 < NREP(7)) ? (float*)QB : F.out;
            for (int tok = gw; tok < T; tok += NGW) peer_token(HB, ROWSQ, U8, V8, SU, SV, TE, TW, F.out, dst, tok, F.lane);
            if (rep + 1 < NREP(7)) GRID_BAR(); }
    }
#undef IN
#undef BOTH
#undef GRID_BAR
}

extern "C" void kernel_launch(void* const* d_in, const int* in_sizes, int n_in, void* d_out, int out_size, void* d_ws, size_t ws_size, hipStream_t stream) {
    static int grid = 0;
    if (grid == 0) {
        if (n_in != 23 || in_sizes[0] != T * D || out_size != T * D || ws_size < WS_END) { fprintf(stderr, "kernel_launch: unexpected shapes: n_in %d in0 %d out %d ws %zu\n", n_in, n_in > 0 ? in_sizes[0] : -1, out_size, ws_size); grid = -1; return; }
        int dev = 0, cus = 0, per_cu = 0;
        if (hipGetDevice(&dev) != hipSuccess || hipDeviceGetAttribute(&cus, hipDeviceAttributeMultiprocessorCount, dev) != hipSuccess) { fprintf(stderr, "kernel_launch: device query failed\n"); grid = -1; return; }
        if (hipFuncSetAttribute((const void*)mk_fwd, hipFuncAttributeMaxDynamicSharedMemorySize, LDS_BYTES) != hipSuccess) { fprintf(stderr, "kernel_launch: hipFuncSetAttribute failed\n"); grid = -1; return; }
        if (hipOccupancyMaxActiveBlocksPerMultiprocessor(&per_cu, (const void*)mk_fwd, NWAVES * 64, LDS_BYTES) != hipSuccess || per_cu < 1)
            fprintf(stderr, "kernel_launch: note: occupancy query reports %d workgroups per CU\n", per_cu);
        (void)hipGetLastError();
        grid = cus;
    }
    if (grid < 0) return;
    if (hipMemsetAsync((char*)d_ws + WS_CTL, 0, CTL_ZERO_BYTES, stream) != hipSuccess) { fprintf(stderr, "kernel_launch: memset failed\n"); return; }
    Args a{};
    for (int i = 0; i < 23; ++i) a.in[i] = (const float*)d_in[i];
    a.out = (float*)d_out; a.ws = (unsigned char*)d_ws;
    for (int li = 0; li < N_LAUNCHES; ++li) {
        a.ph_lo = (N_LAUNCHES == PER_PHASE) ? li : 0; a.ph_hi = (N_LAUNCHES == PER_PHASE) ? li + 1 : PER_PHASE;
        hipLaunchKernelGGL(mk_fwd, dim3(grid), dim3(NWAVES * 64), LDS_BYTES, stream, a);
#ifdef HOST_DUP_PHASE
        if (N_LAUNCHES == PER_PHASE && li == HOST_DUP_PHASE) { if (li == 4) (void)hipMemsetAsync((char*)d_ws + WS_ROWSQ, 0, (size_t)T * 4, stream); hipLaunchKernelGGL(mk_fwd, dim3(grid), dim3(NWAVES * 64), LDS_BYTES, stream, a); }
#endif
        const hipError_t le = hipPeekAtLastError();
        if (le != hipSuccess) { fprintf(stderr, "kernel_launch: launch %d failed: %s\n", li, hipGetErrorName(le)); break; }
    }
}
```

```cpp
#define MK_N_LAUNCHES 1
#include <hip/hip_runtime.h>
#include <cstdio>
#include <cstdint>

#ifndef MK_N_LAUNCHES
#define MK_N_LAUNCHES 1
#endif

namespace pg8 {
#define PG8_LAS __attribute__((address_space(3)))
typedef unsigned short bf16_t;
typedef short bf16x8 __attribute__((ext_vector_type(8)));
typedef float f32x4 __attribute__((ext_vector_type(4)));
typedef unsigned u32x4 __attribute__((ext_vector_type(4)));
typedef unsigned u32x2 __attribute__((ext_vector_type(2)));
constexpr int BM = 256, BK = 64, HALF = 128, HTB = HALF * BK * 2  , STAGE_BYTES = 8 * HTB, NXCD = 8, WGM = 8;

__host__ __device__ __forceinline__ int lds_byte(int r, int c) { const int st = (r >> 4) * 2 + (c >> 5), rr = r & 15, cc = c & 31, ob = rr * 64 + cc * 2; return st * 1024 + (ob ^ (((ob >> 9) & 1) << 5)); }
__host__ __device__ __forceinline__ void stage_rc(int b, int& R, int& C) { const int st = b / 1024, sb = b % 1024, swz = sb ^ (((sb >> 9) & 1) << 5); R = (st >> 1) * 16 + swz / 64; C = (st & 1) * 32 + (swz % 64) / 2; }
__host__ __device__ __forceinline__ int perm32(int rho) { const int n = rho >> 4, i = rho & 15; return 8 * (i >> 2) + 4 * n + (i & 3); }

struct Unit { int pm, pn, br; };

struct StaticOrder {
    int nM, nN, nwg, G, c;
    __host__ __device__ void init(int M, int N, int G_, int c_) { nM = M / BM; nN = N / BM; nwg = nM * nN; G = G_; c = c_; }
    __host__ __device__ bool next(int i, Unit& u) const {
        const long L = (long)i * G + c; if (L >= nwg) return false;
        int wgid = (int)L; { const int q = nwg / NXCD, r = nwg % NXCD, xcd = wgid % NXCD, off = wgid / NXCD; wgid = (xcd < r ? xcd * (q + 1) : r * (q + 1) + (xcd - r) * q) + off; }
        const int nig = WGM * nN, gid = wgid / nig, fm = gid * WGM, gsz = (nM - fm) < WGM ? (nM - fm) : WGM;
        u.pm = fm + ((wgid % nig) % gsz); u.pn = (wgid % nig) / gsz; return true;
    }
};
struct Sched1 {
    StaticOrder so; const char* A; const char* Bt; size_t tstep;
    __device__ __forceinline__ bool next(int i, Unit& u) const { u.br = 0; return so.next(i, u); }
    __device__ __forceinline__ const char* abase(const Unit& u) const { return A + (size_t)u.pm * tstep; }
    __device__ __forceinline__ const char* bbase(const Unit& u) const { return Bt + (size_t)u.pn * tstep; }
    __device__ __forceinline__ void a_ready(const Unit&) const {}
    __device__ __forceinline__ void done(const Unit&) const {}
};
struct Sched3 {
    StaticOrder so; const char* A; const char* Bt; size_t tstep, strideA, strideB;
    __device__ __forceinline__ bool next(int i, Unit& u) const { u.br = i % 3; return so.next(i / 3, u); }
    __device__ __forceinline__ const char* abase(const Unit& u) const { return A + (size_t)u.br * strideA + (size_t)u.pm * tstep; }
    __device__ __forceinline__ const char* bbase(const Unit& u) const { return Bt + (size_t)u.br * strideB + (size_t)u.pn * tstep; }
    __device__ __forceinline__ void a_ready(const Unit&) const {}
    __device__ __forceinline__ void done(const Unit&) const {}
};

typedef float f32x2_t __attribute__((ext_vector_type(2))); typedef __bf16 bf16x2v_t __attribute__((ext_vector_type(2)));
__device__ __forceinline__ unsigned cvt_pk_bf16(float lo, float hi) { const f32x2_t v = {lo, hi}; const bf16x2v_t b = __builtin_convertvector(v, bf16x2v_t); return __builtin_bit_cast(unsigned, b); }
__device__ __forceinline__ u32x4 pack8(const f32x4 a, const f32x4 b) { u32x4 w; w.x = cvt_pk_bf16(a[0], a[1]); w.y = cvt_pk_bf16(a[2], a[3]); w.z = cvt_pk_bf16(b[0], b[1]); w.w = cvt_pk_bf16(b[2], b[3]); return w; }
__device__ __forceinline__ float bflo(unsigned u) { return __builtin_bit_cast(float, u << 16); }
__device__ __forceinline__ float bfhi(unsigned u) { return __builtin_bit_cast(float, u & 0xffff0000u); }


constexpr float RMS_EPS = 1e-6f;

struct EpiProj {
    static constexpr bool PERM = true, AFTER_DRAIN = false;
    const float* rstd; bf16_t *qn, *kn, *pp, *xq, *gates; const float *qg, *kg, *gate_b;
    __device__ __forceinline__ void operator()(const f32x4 (&acc)[2][2][4][2], const Unit& u, int wr, int wc, int fr, int fq) const {
        const int pn = u.pn, row0 = u.pm * BM + wr * 64 + fr, lc0 = 64 * wc + 8 * fq;
        if (pn < 4) {
            const bool isq = pn < 2; bf16_t* O = isq ? qn : kn; const float* g = isq ? qg : kg; const float post = isq ? 0.125f : 1.0f;
            f32x4 gv[2][2];
#pragma unroll
            for (int bj = 0; bj < 2; ++bj)
#pragma unroll
                for (int n = 0; n < 2; ++n) gv[bj][n] = *(const f32x4*)(g + 32 * bj + 8 * fq + 4 * n);
            const int colbase = (pn & 1) * 256 + lc0;
#pragma unroll
            for (int ai = 0; ai < 2; ++ai)
#pragma unroll
                for (int m = 0; m < 4; ++m) {
                    const int row = row0 + ai * HALF + m * 16; const float rs = rstd[row];
                    f32x4 v[2][2]; float ss = 0.f;
#pragma unroll
                    for (int bj = 0; bj < 2; ++bj)
#pragma unroll
                        for (int n = 0; n < 2; ++n) { v[bj][n] = acc[ai][bj][m][n] * rs; ss += (v[bj][n][0] * v[bj][n][0] + v[bj][n][1] * v[bj][n][1]) + (v[bj][n][2] * v[bj][n][2] + v[bj][n][3] * v[bj][n][3]); }
                    ss += __shfl_xor(ss, 16); ss += __shfl_xor(ss, 32);
                    const float r = rsqrtf(ss * (1.0f / 64.0f) + RMS_EPS) * post;
#pragma unroll
                    for (int bj = 0; bj < 2; ++bj) *(u32x4*)(O + (size_t)row * 512 + colbase + 32 * bj) = pack8(v[bj][0] * r * gv[bj][0], v[bj][1] * r * gv[bj][1]);
                }
        } else if (pn < 8) {
            bf16_t* O = pn < 6 ? pp : xq; const int colbase = (pn & 1) * 256 + lc0;
#pragma unroll
            for (int ai = 0; ai < 2; ++ai)
#pragma unroll
                for (int m = 0; m < 4; ++m) {
                    const int row = row0 + ai * HALF + m * 16; const float rs = rstd[row];
#pragma unroll
                    for (int bj = 0; bj < 2; ++bj) *(u32x4*)(O + (size_t)row * 512 + colbase + 32 * bj) = pack8(acc[ai][bj][m][0] * rs, acc[ai][bj][m][1] * rs);
                }
        } else {
            const int gcol0 = (pn - 8) * 256 + lc0;
            f32x4 bv[2][2];
#pragma unroll
            for (int bj = 0; bj < 2; ++bj)
#pragma unroll
                for (int n = 0; n < 2; ++n) bv[bj][n] = *(const f32x4*)(gate_b + gcol0 + 32 * bj + 4 * n);
#pragma unroll
            for (int ai = 0; ai < 2; ++ai)
#pragma unroll
                for (int m = 0; m < 4; ++m) {
                    const int row = row0 + ai * HALF + m * 16; const float rs = rstd[row];
#pragma unroll
                    for (int bj = 0; bj < 2; ++bj) {
                        f32x4 o[2];
#pragma unroll
                        for (int n = 0; n < 2; ++n) { const f32x4 z = acc[ai][bj][m][n] * rs + bv[bj][n];
#pragma unroll
                            for (int i = 0; i < 4; ++i) o[n][i] = __builtin_amdgcn_rcpf(1.0f + __expf(-z[i])); }
                        *(u32x4*)(gates + (size_t)row * 3072 + gcol0 + 32 * bj) = pack8(o[0], o[1]);
                    }
                }
        }
    }
};
struct EpiVt {
    static constexpr bool PERM = true, AFTER_DRAIN = false;
    const float* rstd; bf16_t* Vt;
    __device__ __forceinline__ void operator()(const f32x4 (&acc)[2][2][4][2], const Unit& u, int wr, int wc, int fr, int fq) const {
        const int ch0 = u.pm * BM + wr * 64 + fr, tok0 = u.pn * BM + wc * 32 + 8 * fq, b = tok0 >> 13, t0 = tok0 & 8191;
        f32x4 rv[2][2];
#pragma unroll
        for (int bj = 0; bj < 2; ++bj)
#pragma unroll
            for (int n = 0; n < 2; ++n) rv[bj][n] = *(const f32x4*)(rstd + tok0 + bj * HALF + 4 * n);
#pragma unroll
        for (int ai = 0; ai < 2; ++ai)
#pragma unroll
            for (int m = 0; m < 4; ++m) { const int ch = ch0 + ai * HALF + m * 16; bf16_t* rowp = Vt + ((size_t)(b * 512 + ch) * 8192 + t0);
#pragma unroll
                for (int bj = 0; bj < 2; ++bj) *(u32x4*)(rowp + bj * HALF) = pack8(acc[ai][bj][m][0] * rv[bj][0], acc[ai][bj][m][1] * rv[bj][1]); }
    }
};
struct EpiMerge {
    static constexpr bool PERM = true, AFTER_DRAIN = false;
    const bf16_t* gates; bf16_t* pa; bf16_t* merged;
    __device__ __forceinline__ void operator()(const f32x4 (&acc)[2][2][4][2], const Unit& u, int wr, int wc, int fr, int fq) const {
        const int row0 = u.pm * BM + wr * 64 + fr, col0 = u.pn * BM + wc * 32 + 8 * fq, br = u.br;
        const bf16_t* src = br == 1 ? pa : merged; bf16_t* dst = br == 0 ? pa : merged;
#pragma unroll
        for (int ai = 0; ai < 2; ++ai)
#pragma unroll
            for (int m = 0; m < 4; ++m) { const int row = row0 + ai * HALF + m * 16;
#pragma unroll
                for (int bj = 0; bj < 2; ++bj) {
                    const u32x4 g8 = *(const u32x4*)(gates + (size_t)row * 3072 + br * 1024 + col0 + bj * HALF);
                    const size_t mo = (size_t)row * 1024 + col0 + bj * HALF;
                    f32x4 a = acc[ai][bj][m][0], b = acc[ai][bj][m][1];
                    a[0] *= bflo(g8.x); a[1] *= bfhi(g8.x); a[2] *= bflo(g8.y); a[3] *= bfhi(g8.y); b[0] *= bflo(g8.z); b[1] *= bfhi(g8.z); b[2] *= bflo(g8.w); b[3] *= bfhi(g8.w);
                    if (br > 0) { const u32x4 p8 = *(const u32x4*)(src + mo);
                        a[0] += bflo(p8.x); a[1] += bfhi(p8.x); a[2] += bflo(p8.y); a[3] += bfhi(p8.y); b[0] += bflo(p8.z); b[1] += bfhi(p8.z); b[2] += bflo(p8.w); b[3] += bfhi(p8.w); }
                    *(u32x4*)(dst + mo) = pack8(a, b);
                } }
    }
};
struct EpiH {
    static constexpr bool PERM = true, AFTER_DRAIN = false;
    const float* x; float* out; bf16_t* hb; float* rowsq;
    __device__ __forceinline__ void operator()(const f32x4 (&acc)[2][2][4][2], const Unit& u, int wr, int wc, int fr, int fq) const {
        const int row0 = u.pm * BM + wr * 64 + fr, col0 = u.pn * BM + wc * 32 + 8 * fq;
#pragma unroll
        for (int ai = 0; ai < 2; ++ai)
#pragma unroll
            for (int m = 0; m < 4; ++m) { const int row = row0 + ai * HALF + m * 16; float ss = 0.f;
#pragma unroll
                for (int bj = 0; bj < 2; ++bj) { const size_t o = (size_t)row * 1024 + col0 + bj * HALF;
                    const f32x4 h0 = *(const f32x4*)(x + o) + acc[ai][bj][m][0], h1 = *(const f32x4*)(x + o + 4) + acc[ai][bj][m][1];
                    *(f32x4*)(out + o) = h0; *(f32x4*)(out + o + 4) = h1; *(u32x4*)(hb + o) = pack8(h0, h1);
                    ss += (h0[0] * h0[0] + h0[1] * h0[1]) + (h0[2] * h0[2] + h0[3] * h0[3]) + (h1[0] * h1[0] + h1[1] * h1[1]) + (h1[2] * h1[2] + h1[3] * h1[3]); }
                ss += __shfl_xor(ss, 16); ss += __shfl_xor(ss, 32);
                if (fq == 0) atomicAdd(rowsq + row, ss); }
    }
};
struct EpiQ {
    static constexpr bool PERM = true, AFTER_DRAIN = false;
    const float* rowsq; bf16_t* qb;
    __device__ __forceinline__ void operator()(const f32x4 (&acc)[2][2][4][2], const Unit& u, int wr, int wc, int fr, int fq) const {
        const int row0 = u.pm * BM + wr * 64 + fr, col0 = u.pn * BM + wc * 32 + 8 * fq;
#pragma unroll
        for (int ai = 0; ai < 2; ++ai)
#pragma unroll
            for (int m = 0; m < 4; ++m) { const int row = row0 + ai * HALF + m * 16; const float r = rsqrtf(rowsq[row] * (1.0f / 1024.0f) + RMS_EPS);
#pragma unroll
                for (int bj = 0; bj < 2; ++bj) *(u32x4*)(qb + (size_t)row * 2048 + col0 + bj * HALF) = pack8(acc[ai][bj][m][0] * r, acc[ai][bj][m][1] * r); }
    }
};

template <class Epi, class Sched, bool ALIGN_EPI = false, bool SP2 = false>
__device__ __forceinline__ void gemm_phase(PG8_LAS unsigned char* lds, const int K, const Sched& S, const Epi& E) {
    const int tid = threadIdx.x, wid = __builtin_amdgcn_readfirstlane(tid >> 6), lane = tid & 63, wr = wid >> 2, wc = wid & 3, fr = lane & 15, fq = lane >> 4;
    const int nt = K / BK;
    unsigned voffA[2], voffB[2];
#pragma unroll
    for (int i = 0; i < 2; ++i) { int R, C; stage_rc(tid * 16 + i * 8192, R, C); const int Rb = Epi::PERM ? ((R & ~31) + perm32(R & 31)) : R;
        voffA[i] = (unsigned)(R * K + C) * 2u; voffB[i] = (unsigned)(Rb * K + C) * 2u; }
    const size_t kstep = (size_t)(BK * 2);
    const size_t hstep = (size_t)HALF * K * 2;
    const size_t tstep = 2 * hstep;
    const unsigned ldsw = (unsigned)wid * 1024u;
    const int aoff = lds_byte(wr * 64 + fr, fq * 8), boff = lds_byte(wc * 32 + fr, fq * 8);
#define PG8_SA(b, h) (((b) * 2 + (h)) * HTB)
#define PG8_SB(b, h) ((4 + (b) * 2 + (h)) * HTB)
#define PG8_STAGE(bufoff, gbase, voff) do { _Pragma("unroll") for (int _i = 0; _i < 2; ++_i) \
        __builtin_amdgcn_global_load_lds((const unsigned*)((const char*)(gbase) + (voff)[_i]), (PG8_LAS unsigned*)(lds + (bufoff) + ldsw + _i * 8192), 16, 0, 0); } while (0)
#define PG8_LDA(dst, b, h) do { _Pragma("unroll") for (int m = 0; m < 4; ++m) _Pragma("unroll") for (int k = 0; k < 2; ++k) dst[m][k] = *(const PG8_LAS bf16x8*)(lds + PG8_SA(b, h) + aoff + m * 2048 + k * 1024); } while (0)
#define PG8_LDB(dst, b, h) do { _Pragma("unroll") for (int n = 0; n < 2; ++n) _Pragma("unroll") for (int k = 0; k < 2; ++k) dst[n][k] = *(const PG8_LAS bf16x8*)(lds + PG8_SB(b, h) + boff + n * 2048 + k * 1024); } while (0)
#define PG8_MMA(ai, bj, At, Bt) do { __builtin_amdgcn_s_setprio(1); _Pragma("unroll") for (int m = 0; m < 4; ++m) _Pragma("unroll") for (int n = 0; n < 2; ++n) _Pragma("unroll") for (int k = 0; k < 2; ++k) \
        acc[ai][bj][m][n] = __builtin_amdgcn_mfma_f32_16x16x32_bf16(Bt[n][k], At[m][k], acc[ai][bj][m][n], 0, 0, 0); __builtin_amdgcn_s_setprio(0); } while (0)
#define PG8_WAIT_V(n) asm volatile("s_waitcnt vmcnt(" #n ")" ::: "memory")
#define PG8_WAIT_L(n) asm volatile("s_waitcnt lgkmcnt(" #n ")" ::: "memory")
#define PG8_BAR __builtin_amdgcn_s_barrier()
#define PG8_SCHED __builtin_amdgcn_sched_barrier(0)
    Unit cur, nxt; int ui = 0;
    if (!S.next(0, cur)) return;
    f32x4 acc[2][2][4][2];
#pragma unroll
    for (int a = 0; a < 2; ++a)
#pragma unroll
        for (int b = 0; b < 2; ++b)
#pragma unroll
            for (int m = 0; m < 4; ++m)
#pragma unroll
                for (int n = 0; n < 2; ++n) acc[a][b][m][n] = (f32x4){0.f, 0.f, 0.f, 0.f};
    bf16x8 At[4][2], B0[2][2], B1[2][2];
    const char* cA = S.abase(cur); const char* cB = S.bbase(cur);
    S.a_ready(cur);
    if constexpr (SP2) {
        PG8_STAGE(PG8_SB(0, 0), cB, voffB); PG8_STAGE(PG8_SB(0, 1), cB + hstep, voffB); PG8_STAGE(PG8_SA(0, 0), cA, voffA); PG8_STAGE(PG8_SA(0, 1), cA + hstep, voffA);
        if (wr == 1) PG8_BAR;
        PG8_WAIT_V(2); PG8_BAR;
        PG8_STAGE(PG8_SB(1, 0), cB + kstep, voffB); PG8_STAGE(PG8_SA(1, 0), cA + kstep, voffA); PG8_STAGE(PG8_SB(1, 1), cB + hstep + kstep, voffB);
        PG8_WAIT_V(6); PG8_BAR;
    } else {
        PG8_STAGE(PG8_SB(0, 0), cB, voffB); PG8_STAGE(PG8_SA(0, 0), cA, voffA); PG8_STAGE(PG8_SB(0, 1), cB + hstep, voffB); PG8_STAGE(PG8_SA(0, 1), cA + hstep, voffA);
        if (wr == 1) PG8_BAR;
        PG8_WAIT_V(4); PG8_BAR;
        PG8_STAGE(PG8_SB(1, 0), cB + kstep, voffB); PG8_STAGE(PG8_SA(1, 0), cA + kstep, voffA); PG8_STAGE(PG8_SB(1, 1), cB + hstep + kstep, voffB);
        PG8_WAIT_V(6); PG8_BAR;
    }
    for (;;) {
        const bool has_next = S.next(ui + 1, nxt);
        const char* nA = has_next ? S.abase(nxt) : cA; const char* nB = has_next ? S.bbase(nxt) : cB;
        for (int t = 0; t < nt; t += 2) {
            const bool last = (t == nt - 2);
            const char* a1 = cA + (size_t)(t + 1) * kstep;
            const char* a2 = last ? nA : cA + (size_t)(t + 2) * kstep; const char* b2 = last ? nB : cB + (size_t)(t + 2) * kstep;
            const char* a3 = a2 + kstep; const char* b3 = b2 + kstep;
            if (last && has_next) S.a_ready(nxt);
            if constexpr (SP2) {
            PG8_LDB(B0, 0, 0); PG8_LDB(B1, 0, 1); PG8_SCHED; PG8_LDA(At, 0, 0); PG8_STAGE(PG8_SA(1, 1), a1 + hstep, voffA);
            PG8_WAIT_V(8); PG8_WAIT_L(0); PG8_BAR; PG8_MMA(0, 0, At, B0); PG8_MMA(0, 1, At, B1); PG8_BAR; PG8_SCHED;
            PG8_LDA(At, 0, 1); PG8_STAGE(PG8_SB(0, 0), b2, voffB); PG8_STAGE(PG8_SB(0, 1), b2 + hstep, voffB); PG8_STAGE(PG8_SA(0, 0), a2, voffA);
            PG8_WAIT_V(8); PG8_WAIT_L(0); PG8_BAR; PG8_MMA(1, 0, At, B0); PG8_MMA(1, 1, At, B1); PG8_BAR; PG8_SCHED;
            PG8_LDB(B0, 1, 0); PG8_LDB(B1, 1, 1); PG8_SCHED; PG8_LDA(At, 1, 0); PG8_STAGE(PG8_SA(0, 1), a2 + hstep, voffA);
            PG8_WAIT_V(8); PG8_WAIT_L(0); PG8_BAR; PG8_MMA(0, 0, At, B0); PG8_MMA(0, 1, At, B1); PG8_BAR; PG8_SCHED;
            PG8_LDA(At, 1, 1); PG8_STAGE(PG8_SB(1, 0), b3, voffB); PG8_STAGE(PG8_SB(1, 1), b3 + hstep, voffB); PG8_STAGE(PG8_SA(1, 0), a3, voffA);
            PG8_WAIT_V(8); PG8_WAIT_L(0); PG8_BAR; PG8_MMA(1, 0, At, B0); PG8_MMA(1, 1, At, B1); PG8_BAR; PG8_SCHED;
            } else {
            PG8_LDB(B0, 0, 0); PG8_SCHED; PG8_LDA(At, 0, 0); PG8_STAGE(PG8_SA(1, 1), a1 + hstep, voffA);
            PG8_WAIT_L(8); PG8_BAR; PG8_WAIT_L(0); PG8_MMA(0, 0, At, B0); PG8_BAR; PG8_SCHED;
            PG8_LDB(B1, 0, 1); PG8_STAGE(PG8_SB(0, 0), b2, voffB);
            PG8_BAR; PG8_WAIT_L(0); PG8_MMA(0, 1, At, B1); PG8_BAR;
            PG8_LDA(At, 0, 1); PG8_STAGE(PG8_SA(0, 0), a2, voffA);
            PG8_BAR; PG8_WAIT_L(0); PG8_MMA(1, 0, At, B0); PG8_BAR; PG8_SCHED;
            PG8_STAGE(PG8_SB(0, 1), b2 + hstep, voffB);
            PG8_WAIT_V(6); PG8_BAR; PG8_MMA(1, 1, At, B1); PG8_BAR;
            PG8_LDB(B0, 1, 0); PG8_SCHED; PG8_LDA(At, 1, 0); PG8_STAGE(PG8_SA(0, 1), a2 + hstep, voffA);
            PG8_WAIT_L(8); PG8_BAR; PG8_WAIT_L(0); PG8_MMA(0, 0, At, B0); PG8_BAR; PG8_SCHED;
            PG8_LDB(B1, 1, 1); PG8_STAGE(PG8_SB(1, 0), b3, voffB);
            PG8_BAR; PG8_WAIT_L(0); PG8_MMA(0, 1, At, B1); PG8_BAR;
            PG8_LDA(At, 1, 1); PG8_STAGE(PG8_SA(1, 0), a3, voffA);
            PG8_BAR; PG8_WAIT_L(0); PG8_MMA(1, 0, At, B0); PG8_BAR; PG8_SCHED;
            PG8_STAGE(PG8_SB(1, 1), b3 + hstep, voffB);
            PG8_WAIT_V(6); PG8_BAR; PG8_MMA(1, 1, At, B1); PG8_BAR;
            }
        }
        if constexpr (ALIGN_EPI) { if (wr == 0) PG8_BAR; }
        if constexpr (!Epi::AFTER_DRAIN) { E(acc, cur, wr, wc, fr, fq); S.done(cur); }
        if (!has_next) break;
#pragma unroll
        for (int a = 0; a < 2; ++a)
#pragma unroll
            for (int b = 0; b < 2; ++b)
#pragma unroll
                for (int m = 0; m < 4; ++m)
#pragma unroll
                    for (int n = 0; n < 2; ++n) acc[a][b][m][n] = (f32x4){0.f, 0.f, 0.f, 0.f};
        cur = nxt; cA = nA; cB = nB; ++ui;
        if constexpr (ALIGN_EPI) { if (wr == 1) PG8_BAR; }
    }
    PG8_WAIT_V(0);
    if constexpr (!ALIGN_EPI) { if (wr == 0) PG8_BAR; }
    PG8_BAR;
    if constexpr (Epi::AFTER_DRAIN) { E.fused(acc, cur, wr, wc, fr, fq, lds, wid, lane); S.done(cur); }
#undef PG8_SA
#undef PG8_SB
#undef PG8_STAGE
#undef PG8_LDA
#undef PG8_LDB
#undef PG8_MMA
#undef PG8_WAIT_V
#undef PG8_WAIT_L
#undef PG8_BAR
#undef PG8_SCHED
}
}

constexpr int NWAVES = 8;
constexpr int N_LAUNCHES = MK_N_LAUNCHES;
constexpr int PER_PHASE = 8;
constexpr int NBATCH = 4, SEQ = 8192, D = 1024, T = NBATCH * SEQ, MEMLEN = 256, NMEMTOK = NBATCH * MEMLEN;
constexpr int IN_MAIN = 5120;
constexpr int NEXP = 16384;

constexpr size_t MiB = 1u << 20;
constexpr size_t WS_CTL = 0, CTL_ZERO_BYTES = 512 * 1024;
constexpr size_t WS_ROWSQ = 256 * 1024;
constexpr size_t WS_WIN = 1 * MiB, WS_WV = 11 * MiB, WS_WKV = 12 * MiB, WS_WBR = 14 * MiB, WS_WOUT = 17 * MiB, WS_WQ = 19 * MiB, WS_KEYS = 23 * MiB, WS_PWT = 23 * MiB + 512 * 1024;
constexpr size_t WS_MEMN = 24 * MiB, WS_KMEM = 26 * MiB, WS_VTMEM = 27 * MiB, WS_RSTDX = 28 * MiB, WS_SU = 28 * MiB + 256 * 1024, WS_SV = 28 * MiB + 512 * 1024;
constexpr size_t WS_U8 = 32 * MiB, WS_V8 = 48 * MiB;
constexpr size_t WS_QN = 96 * MiB, WS_KN = 128 * MiB, WS_VT = 160 * MiB, WS_PP = 192 * MiB, WS_XQ = 224 * MiB, WS_GATE = 256 * MiB, WS_END = 448 * MiB;
constexpr size_t WS_MERGED = WS_QN;
constexpr size_t WS_HB = WS_VT;
constexpr size_t WS_QB = WS_GATE;
constexpr size_t WS_TE = WS_GATE + 128 * MiB, WS_TW = WS_TE + 16 * MiB;
constexpr size_t OUT_XB = 0, OUT_YNA = 0, OUT_YPOOL = 32 * MiB, OUT_YXA = 64 * MiB;
constexpr int CW_TMO = 0, CW_BAR = 4096;

constexpr int RING_OFF = 0, RING_BYTES = 131072;
constexpr int LDSCTL_OFF = RING_BYTES, MISC_OFF = LDSCTL_OFF + 320;
constexpr int LDS_BYTES = 147456;

#define GAS __attribute__((address_space(1)))
#define LAS __attribute__((address_space(3)))
typedef unsigned short bf16;
typedef unsigned v4u __attribute__((ext_vector_type(4)));
typedef unsigned v2u __attribute__((ext_vector_type(2)));
typedef float f32x4 __attribute__((ext_vector_type(4)));
typedef short bf16x8 __attribute__((ext_vector_type(8)));
typedef __bf16 bf16x2_t __attribute__((ext_vector_type(2)));
typedef GAS unsigned gu32;
#define LDS_WAIT() asm volatile("s_waitcnt lgkmcnt(0)" ::: "memory")
#define VM_WAIT() asm volatile("s_waitcnt vmcnt(0)" ::: "memory")
__device__ __forceinline__ unsigned f2bf(float f) { unsigned u = __builtin_bit_cast(unsigned, f); return (u + 0x7fffu + ((u >> 16) & 1u)) >> 16; }
__device__ __forceinline__ unsigned pk2(float lo, float hi) { return f2bf(lo) | (f2bf(hi) << 16); }
__device__ __forceinline__ float bflo(unsigned u) { return __builtin_bit_cast(float, u << 16); }
__device__ __forceinline__ float bfhi(unsigned u) { return __builtin_bit_cast(float, u & 0xffff0000u); }
__device__ __forceinline__ float bf1(short s) { return __builtin_bit_cast(float, ((unsigned)(unsigned short)s) << 16); }
__device__ __forceinline__ f32x4 mfma16(bf16x8 a, bf16x8 b, f32x4 c) { return __builtin_amdgcn_mfma_f32_16x16x32_bf16(a, b, c, 0, 0, 0); }
__device__ __forceinline__ float wave_sum(float v) {
#pragma unroll
    for (int o = 1; o < 64; o <<= 1) v += __shfl_xor(v, o);
    return v;
}

#define XB_TMO      128
#define XB_XCNT(j)  (256  + 64 * (j))
#define XB_XSUB(j)  (1280 + 64 * (j))
#define XB_XGEN(j)  (2304 + 64 * (j))
#define XB_TOP      3328
#define XB_TOPGEN   3392
#define XCD_BAR_WORDS 3456
#define XB_SPIN_CAP (1u << 18)

__device__ __forceinline__ unsigned xb_ld(unsigned* p)              { return __hip_atomic_load(p, __ATOMIC_RELAXED, __HIP_MEMORY_SCOPE_AGENT); }
__device__ __forceinline__ unsigned xb_add(unsigned* p, unsigned v) { return __hip_atomic_fetch_add(p, v, __ATOMIC_RELAXED, __HIP_MEMORY_SCOPE_AGENT); }
__device__ __forceinline__ unsigned xb_xcc_id() { return (unsigned)__builtin_amdgcn_s_getreg((3 << 11) | 20) & 0xFu; }
#define XB_SPIN(cond, bar) do { unsigned _sp = 0; while (cond) { __builtin_amdgcn_s_sleep(1); \
    if ((++_sp & 255u) == 0u) { if (xb_ld(&(bar)[XB_TMO])) break; if (_sp > XB_SPIN_CAP) { atomicAdd(&(bar)[XB_TMO], 1u); break; } } } } while (0)

struct XcdBarrier {
    unsigned* bar; unsigned x;
    volatile LAS unsigned* st;
};

__device__ __forceinline__ XcdBarrier xcd_barrier_post(unsigned* bar, volatile LAS unsigned* st) {
    XcdBarrier b; b.bar = bar; b.x = xb_xcc_id(); b.st = st;
    if (threadIdx.x == 0) (void)xb_add(&bar[XB_XCNT(b.x)], 1u);
    return b;
}
__device__ __forceinline__ void xcd_barrier_complete(unsigned* bar, unsigned x, unsigned& nloc, unsigned& nx) {
    const unsigned G = gridDim.x * gridDim.y * gridDim.z;
    unsigned sum, cnt, mine, sp = 0u;
    for (;;) {
        sum = 0u; cnt = 0u; mine = 0u;
#pragma unroll
        for (unsigned j = 0; j < 16; ++j) { const unsigned c = xb_ld(&bar[XB_XCNT(j)]); sum += c; cnt += (c > 0u) ? 1u : 0u; mine = (j == x) ? c : mine; }
        if (sum == G) break;
        __builtin_amdgcn_s_sleep(1);
        if ((++sp & 255u) == 0u) { if (xb_ld(&bar[XB_TMO])) break; if (sp > XB_SPIN_CAP) { atomicAdd(&bar[XB_TMO], 1u); break; } }
    }
    nloc = mine > 0u ? mine : 1u; nx = cnt > 0u ? cnt : 1u;
}

__device__ __forceinline__ void xcd_barrier(const XcdBarrier& b) {
    asm volatile("s_waitcnt vmcnt(0)" ::: "memory");
    __syncthreads();
    if (threadIdx.x == 0) {
        unsigned* bar = b.bar;
        __builtin_amdgcn_s_waitcnt(0);
        unsigned nloc = b.st[0], nx = b.st[1];
        if (nloc == 0u) { xcd_barrier_complete(bar, b.x, nloc, nx); b.st[0] = nloc; b.st[1] = nx; }
        const unsigned old = xb_add(&bar[XB_XSUB(b.x)], 1u);
        const unsigned gen = old / nloc;
        if (old + 1u == (gen + 1u) * nloc) {
            __builtin_amdgcn_fence(__ATOMIC_RELEASE, "agent");
            asm volatile("s_waitcnt vmcnt(0)" ::: "memory");
            const unsigned og = xb_add(&bar[XB_TOP], 1u);
            const unsigned tg = og / nx;
            if (og + 1u == (tg + 1u) * nx) xb_add(&bar[XB_TOPGEN], 1u);
            else XB_SPIN(xb_ld(&bar[XB_TOPGEN]) == tg, bar);
            __builtin_amdgcn_fence(__ATOMIC_ACQUIRE, "agent");
            xb_add(&bar[XB_XGEN(b.x)], 1u);
            asm volatile("s_waitcnt vmcnt(0)" ::: "memory");
        } else {
            XB_SPIN(xb_ld(&bar[XB_XGEN(b.x)]) == gen, bar);
            __builtin_amdgcn_fence(__ATOMIC_ACQUIRE, "agent");
            asm volatile("s_waitcnt vmcnt(0)" ::: "memory");
        }
    }
    __syncthreads();
}

struct Frame {
    LAS unsigned char* lds;
    volatile LAS unsigned* MISC;
    gu32* ctl;
    int tid, lane, wave, vcu, G;
    float* out; unsigned char* ws;
};
struct Args { const float* in[23]; float* out; unsigned char* ws; int ph_lo, ph_hi; };
enum { I_X = 0, I_MEM, I_MIXG, I_MEMG, I_WIN, I_GATEB, I_WKV, I_NAQG, I_NAKG, I_RPB, I_POOLW, I_POOLSC, I_XAQG, I_XAKG, I_WB0, I_WB1, I_WB2, I_WOUT, I_FFNG, I_WQ, I_KEYS, I_PU, I_PV };

__device__ __forceinline__ void p0_transpose_item(const float* W, int K, int N, int k0, int n0, bf16* dst, const float* kscale, LAS float* scr, int lane) {
#pragma unroll 8
    for (int i = 0; i < 32; ++i) { const int kk = 2 * i + (lane >> 5); float v = W[(size_t)(k0 + kk) * N + n0 + (lane & 31)]; if (kscale) v *= kscale[k0 + kk]; scr[kk * 33 + (lane & 31)] = v; }
    LDS_WAIT(); asm volatile("" ::: "memory");
    const int c = lane & 7;
#pragma unroll
    for (int j = 0; j < 4; ++j) { const int n = (lane >> 3) + 8 * j; const LAS float* s = scr + (8 * c) * 33 + n;
        v4u o; o.x = pk2(s[0 * 33], s[1 * 33]); o.y = pk2(s[2 * 33], s[3 * 33]); o.z = pk2(s[4 * 33], s[5 * 33]); o.w = pk2(s[6 * 33], s[7 * 33]);
        *(GAS v4u*)(dst + (size_t)n * K + k0 + 8 * c) = o; }
    LDS_WAIT(); asm volatile("" ::: "memory");
}
__device__ __forceinline__ void cvt_row1024(const float* src, bf16* dst, const float* colscale, float rowscale, int lane) {
    const GAS f32x4* xr = (const GAS f32x4*)src + lane; GAS unsigned long long* o8 = (GAS unsigned long long*)dst + lane;
#pragma unroll
    for (int j = 0; j < 4; ++j) { f32x4 v = xr[64 * j] * rowscale; if (colscale) v = v * ((const GAS f32x4*)colscale)[lane + 64 * j];
        o8[64 * j] = (unsigned long long)pk2(v.x, v.y) | ((unsigned long long)pk2(v.z, v.w) << 32); }
}
__device__ __forceinline__ float row_rstd1024(const float* src, int lane) {
    const GAS f32x4* xr = (const GAS f32x4*)src + lane; float s = 0.f;
#pragma unroll
    for (int j = 0; j < 4; ++j) { const f32x4 v = xr[64 * j]; s += (v.x * v.x + v.y * v.y) + (v.z * v.z + v.w * v.w); }
    return rsqrtf(wave_sum(s) * (1.0f / 1024.0f) + 1e-6f);
}
__device__ __forceinline__ void p0_prologue(Frame& F, const Args& A) {
    LAS float* scr = (LAS float*)(F.lds + RING_OFF + F.wave * 16384);
    const int gw = F.vcu * NWAVES + F.wave, NGW = F.G * NWAVES, lane = F.lane;
    unsigned char* ws = F.ws;
    constexpr int I_IN = 16 * 176, I_KV = 16 * 32, I_BR = 8 * 32, I_OUT = 16 * 32, I_Q = 16 * 64;
    constexpr int NITEMS = I_IN + I_KV + 3 * I_BR + I_OUT + I_Q;
    for (int it = gw; it < NITEMS; it += NGW) {
        int r = it;
        if (r < I_IN) { const int kb = r / 176, nb = r % 176, n0 = 32 * nb; bf16* dst;
            if (n0 >= 1024 && n0 < 1536) dst = (bf16*)(ws + WS_WV) + (size_t)(n0 - 1024) * 1024;
            else { const int np = n0 < 1024 ? n0 : n0 - 512, t = np >> 8, w = np & 255, wc = w >> 6, bj = (w >> 5) & 1; dst = (bf16*)(ws + WS_WIN) + (size_t)(256 * t + 128 * bj + 32 * wc) * 1024; }
            p0_transpose_item(A.in[I_WIN], 1024, 5632, 64 * kb, n0, dst, A.in[I_MIXG], scr, lane); continue; }
        r -= I_IN;
        if (r < I_KV) { const int kb = r / 32, nb = r % 32; p0_transpose_item(A.in[I_WKV], 1024, 1024, 64 * kb, 32 * nb, (bf16*)(ws + WS_WKV) + (size_t)(32 * nb) * 1024, nullptr, scr, lane); continue; }
        r -= I_KV;
        if (r < 3 * I_BR) { const int br = r / I_BR, rr = r % I_BR, kb = rr / 32, nb = rr % 32; const float* W = br == 0 ? A.in[I_WB0] : (br == 1 ? A.in[I_WB1] : A.in[I_WB2]);
            p0_transpose_item(W, 512, 1024, 64 * kb, 32 * nb, (bf16*)(ws + WS_WBR) + (size_t)br * 1024 * 512 + (size_t)(32 * nb) * 512, nullptr, scr, lane); continue; }
        r -= 3 * I_BR;
        if (r < I_OUT) { const int kb = r / 32, nb = r % 32; p0_transpose_item(A.in[I_WOUT], 1024, 1024, 64 * kb, 32 * nb, (bf16*)(ws + WS_WOUT) + (size_t)(32 * nb) * 1024, nullptr, scr, lane); continue; }
        r -= I_OUT;
        { const int kb = r / 64, nb = r % 64; p0_transpose_item(A.in[I_WQ], 1024, 2048, 64 * kb, 32 * nb, (bf16*)(ws + WS_WQ) + (size_t)(32 * nb) * 1024, A.in[I_FFNG], scr, lane); }
    }
    { bf16* xb = (bf16*)((unsigned char*)F.out + OUT_XB); float* rstdx = (float*)(ws + WS_RSTDX);
      for (int m = gw; m < T; m += NGW) { const float* xr = A.in[I_X] + (size_t)m * D; const float rs = row_rstd1024(xr, lane); cvt_row1024(xr, xb + (size_t)m * D, nullptr, 1.0f, lane); if (lane == 0) rstdx[m] = rs; } }
    for (int m = gw; m < NMEMTOK; m += NGW) { const float* xr = A.in[I_MEM] + (size_t)m * D; const float rs = row_rstd1024(xr, lane); cvt_row1024(xr, (bf16*)(ws + WS_MEMN) + (size_t)m * D, A.in[I_MEMG], rs, lane); }
    for (int m = gw; m < 2 * NEXP; m += NGW) {
        const bool isu = m < NEXP; const int e = isu ? m : m - NEXP;
        const GAS f32x4* src = (const GAS f32x4*)((isu ? A.in[I_PU] : A.in[I_PV]) + (size_t)e * D) + 4 * lane;
        f32x4 v[4]; float mx = 0.f;
#pragma unroll
        for (int d = 0; d < 4; ++d) { v[d] = src[d]; if (isu) v[d] = v[d] * ((const GAS f32x4*)A.in[I_FFNG])[4 * lane + d];
            mx = fmaxf(mx, fmaxf(fmaxf(fabsf(v[d].x), fabsf(v[d].y)), fmaxf(fabsf(v[d].z), fabsf(v[d].w)))); }
#pragma unroll
        for (int o = 1; o < 64; o <<= 1) mx = fmaxf(mx, __shfl_xor(mx, o));
        const float inv = mx > 0.f ? 127.0f / mx : 0.f; const int off = isu ? 0 : 128;
        v4u w;
#pragma unroll
        for (int d = 0; d < 4; ++d) { const unsigned b0 = (unsigned)((int)rintf(v[d].x * inv) + off) & 0xffu, b1 = (unsigned)((int)rintf(v[d].y * inv) + off) & 0xffu,
                                                     b2 = (unsigned)((int)rintf(v[d].z * inv) + off) & 0xffu, b3 = (unsigned)((int)rintf(v[d].w * inv) + off) & 0xffu;
            w[d] = b0 | (b1 << 8) | (b2 << 16) | (b3 << 24); }
        ((GAS v4u*)(ws + (isu ? WS_U8 : WS_V8)))[(size_t)e * 64 + lane] = w;
        if (lane == 0) ((float*)(ws + (isu ? WS_SU : WS_SV)))[e] = mx * (1.0f / 127.0f);
    }
    for (int m = gw * 64 + lane; m < T; m += NGW * 64) ((float*)(ws + WS_ROWSQ))[m] = 0.f;
    for (int m = gw; m < 256; m += NGW) cvt_row1024(A.in[I_KEYS] + (size_t)m * 1024, (bf16*)(ws + WS_KEYS) + (size_t)m * 1024, nullptr, 1.0f, lane);
    for (int m = gw; m < 1024; m += NGW) { const int gd = m >> 1, c = (m & 1) * 64 + lane, g = gd >> 7, d = gd & 127;
        const float v = A.in[I_POOLW][(size_t)(g * 128 + c) * 128 + d] * A.in[I_POOLSC][gd];
        ((bf16*)(ws + WS_PWT))[(size_t)gd * 128 + c] = (bf16)f2bf(v); }
}

__device__ __forceinline__ void memkv_tile(const bf16* memn, const bf16* wkvT, const float* kg, const float* qg, bf16* kmem, bf16* vtmem, int tile, int lane) {
    const int q = lane & 15, hi = lane >> 4, rg = tile >> 3, cg = tile & 7, r0 = rg * 16, c0 = cg * 128;
    f32x4 acc[8];
#pragma unroll
    for (int i = 0; i < 8; ++i) acc[i] = (f32x4){0.f, 0.f, 0.f, 0.f};
    const bf16* ap = memn + (size_t)(r0 + q) * 1024 + 8 * hi; const bf16* bp = wkvT + (size_t)(c0 + q) * 1024 + 8 * hi;
#pragma unroll 1
    for (int kb = 0; kb < 8; ++kb) {
        bf16x8 a[4], b[4][8];
#pragma unroll
        for (int k4 = 0; k4 < 4; ++k4) { a[k4] = *(const bf16x8*)(ap + 32 * (4 * kb + k4));
#pragma unroll
            for (int nf = 0; nf < 8; ++nf) b[k4][nf] = *(const bf16x8*)(bp + (size_t)(16 * nf) * 1024 + 32 * (4 * kb + k4)); }
        __builtin_amdgcn_sched_barrier(0);
#pragma unroll
        for (int k4 = 0; k4 < 4; ++k4)
#pragma unroll
            for (int nf = 0; nf < 8; ++nf) acc[nf] = mfma16(a[k4], b[k4][nf], acc[nf]);
        __builtin_amdgcn_sched_barrier(0);
    }
    if (cg < 4) {
        float rr[4];
#pragma unroll
        for (int g = 0; g < 4; ++g) { float ss = 0.f;
#pragma unroll
            for (int nf = 0; nf < 8; ++nf) ss += acc[nf][g] * acc[nf][g];
            ss += __shfl_xor(ss, 1); ss += __shfl_xor(ss, 2); ss += __shfl_xor(ss, 4); ss += __shfl_xor(ss, 8);
            rr[g] = rsqrtf(ss * (1.0f / 128.0f) + 1e-6f); }
#pragma unroll
        for (int nf = 0; nf < 8; ++nf) { const int d = 16 * nf + q; const float gs = kg[d] * qg[d];
#pragma unroll
            for (int g = 0; g < 4; ++g) kmem[(size_t)(r0 + 4 * hi + g) * 512 + cg * 128 + d] = (bf16)f2bf(acc[nf][g] * rr[g] * gs); }
    } else {
        const int h = cg - 4, b = r0 >> 8, key0 = (r0 & 255) + 4 * hi;
#pragma unroll
        for (int nf = 0; nf < 8; ++nf) { const int d = 16 * nf + q; v2u w; w.x = pk2(acc[nf][0], acc[nf][1]); w.y = pk2(acc[nf][2], acc[nf][3]);
            *(v2u*)(vtmem + (size_t)(b * 512 + h * 128 + d) * 256 + key0) = w; }
    }
}

__device__ __forceinline__ void na_item(const bf16* __restrict__ qn, const bf16* __restrict__ kn, const bf16* __restrict__ vt, const LAS float* rpl, bf16* __restrict__ yna,
                                        int b, int r, int jb, int h, int lane) {
    const int q = lane & 15, hi = lane >> 4;
    int rs = r - 4; rs = rs < 0 ? 0 : (rs > 120 ? 120 : rs);
    int kb0 = jb * 16 - 8; kb0 = kb0 < 0 ? 0 : (kb0 > 32 ? 32 : kb0);
    const int qcol = jb * 16 + q; int cs = qcol - 8; cs = cs < 0 ? 0 : (cs > 48 ? 48 : cs);
    const size_t tokq = (size_t)b * SEQ + r * 64 + qcol;
    const bf16* qp = qn + tokq * 512 + h * 64 + 8 * hi;
    const bf16x8 qf0 = *(const bf16x8*)qp, qf1 = *(const bf16x8*)(qp + 32);
    const int kq = 8 * (q >> 2) + (q & 3);
    const bf16* kbase = kn + ((size_t)b * SEQ + rs * 64 + kb0 + kq) * 512 + h * 64 + 8 * hi;
    f32x4 s[16];
    {
        bf16x8 ka[16][2];
#pragma unroll
        for (int f = 0; f < 16; ++f) { const bf16* kp = kbase + (size_t)((f >> 1) * 64 + (f & 1) * 4) * 512; ka[f][0] = *(const bf16x8*)kp; ka[f][1] = *(const bf16x8*)(kp + 32); }
        __builtin_amdgcn_sched_barrier(0);
#pragma unroll
        for (int f = 0; f < 16; ++f) { f32x4 z = (f32x4){0.f, 0.f, 0.f, 0.f}; z = mfma16(ka[f][0], qf0, z); s[f] = mfma16(ka[f][1], qf1, z); }
    }
    const bf16* vbase = vt + ((size_t)(b * 512 + h * 64 + q) * SEQ + rs * 64 + kb0 + 8 * hi);
    bf16x8 va[8][4];
#pragma unroll
    for (int st = 0; st < 8; ++st)
#pragma unroll
        for (int mf = 0; mf < 4; ++mf) va[st][mf] = *(const bf16x8*)(vbase + (size_t)(16 * mf) * SEQ + st * 64);
    __builtin_amdgcn_sched_barrier(0);
    float mx = -3.0e38f;
#pragma unroll
    for (int f = 0; f < 16; ++f) {
        const int dr = rs + (f >> 1) - r + 7;
#pragma unroll
        for (int g = 0; g < 4; ++g) {
            const int kcol = kb0 + 8 * hi + 4 * (f & 1) + g;
            const bool ok = (kcol >= cs) && (kcol < cs + 16);
            int dc = kcol - qcol + 15; dc = dc < 0 ? 0 : (dc > 30 ? 30 : dc);
            const float v = ok ? s[f][g] + rpl[dr * 31 + dc] : -1.0e30f;
            s[f][g] = v; mx = fmaxf(mx, v);
        }
    }
    mx = fmaxf(mx, __shfl_xor(mx, 16)); mx = fmaxf(mx, __shfl_xor(mx, 32));
    float sum = 0.f;
#pragma unroll
    for (int f = 0; f < 16; ++f)
#pragma unroll
        for (int g = 0; g < 4; ++g) { const float p = __expf(s[f][g] - mx); s[f][g] = p; sum += p; }
    sum += __shfl_xor(sum, 16); sum += __shfl_xor(sum, 32);
    const float inv = 1.0f / sum;
    f32x4 o[4];
#pragma unroll
    for (int i = 0; i < 4; ++i) o[i] = (f32x4){0.f, 0.f, 0.f, 0.f};
#pragma unroll
    for (int st = 0; st < 8; ++st) {
        const bf16x8 pb = __builtin_bit_cast(bf16x8, pg8::pack8(s[2 * st], s[2 * st + 1]));
#pragma unroll
        for (int mf = 0; mf < 4; ++mf) o[mf] = mfma16(va[st][mf], pb, o[mf]);
    }
    bf16* yp = yna + tokq * 512 + h * 64 + 4 * hi;
#pragma unroll
    for (int mf = 0; mf < 4; ++mf) { v2u w; w.x = pk2(o[mf][0] * inv, o[mf][1] * inv); w.y = pk2(o[mf][2] * inv, o[mf][3] * inv); *(v2u*)(yp + 16 * mf) = w; }
}
__device__ __forceinline__ void xa_fill_lds(const bf16* __restrict__ kmem, const bf16* __restrict__ vtmem, LAS unsigned char* lds, int b, int h, int tid) {
#pragma unroll
    for (int ps = 0; ps < 8; ++ps) { const int id = tid + 512 * ps, key = id >> 4, c = id & 15;
        *(LAS v4u*)(lds + key * 256 + ((c ^ (key & 15)) << 4)) = *(const v4u*)(kmem + ((size_t)b * 256 + key) * 512 + h * 128 + 8 * c); }
#pragma unroll
    for (int ps = 0; ps < 8; ++ps) { const int id = tid + 512 * ps, dim = id >> 5, c = id & 31;
        *(LAS v4u*)(lds + 65536 + dim * 512 + ((c ^ (dim & 15)) << 4)) = *(const v4u*)(vtmem + (size_t)(b * 512 + h * 128 + dim) * 256 + 8 * c); }
}
__device__ __forceinline__ void xa_item(const bf16* __restrict__ xq, const LAS unsigned char* lds, bf16* __restrict__ yxa, int tok0, int h, int lane) {
    const int q = lane & 15, hi = lane >> 4; const size_t tok = (size_t)tok0 + q;
    const bf16* qp = xq + tok * 512 + h * 128 + 8 * hi;
    bf16x8 qf[4]; float ssq = 0.f;
#pragma unroll
    for (int ks = 0; ks < 4; ++ks) qf[ks] = *(const bf16x8*)(qp + 32 * ks);
    __builtin_amdgcn_sched_barrier(0);
#pragma unroll
    for (int ks = 0; ks < 4; ++ks)
#pragma unroll
        for (int j = 0; j < 8; ++j) { const float v = bf1(qf[ks][j]); ssq += v * v; }
    ssq += __shfl_xor(ssq, 16); ssq += __shfl_xor(ssq, 32);
    const float cexp = rsqrtf(ssq * (1.0f / 128.0f) + 1e-6f) * 0.08838834764831845f * 1.4426950408889634f;
    const int kq = 8 * (q >> 2) + (q & 3);
    f32x4 s[16];
#pragma unroll
    for (int f = 0; f < 16; ++f) { const int key = 32 * (f >> 1) + 4 * (f & 1) + kq; const LAS unsigned char* kr = lds + key * 256; f32x4 z = (f32x4){0.f, 0.f, 0.f, 0.f};
#pragma unroll
        for (int ks = 0; ks < 4; ++ks) z = mfma16(*(const LAS bf16x8*)(kr + (((4 * ks + hi) ^ (key & 15)) << 4)), qf[ks], z);
        s[f] = z; }
    float mx = -3.0e38f;
#pragma unroll
    for (int f = 0; f < 16; ++f)
#pragma unroll
        for (int g = 0; g < 4; ++g) mx = fmaxf(mx, s[f][g]);
    mx = fmaxf(mx, __shfl_xor(mx, 16)); mx = fmaxf(mx, __shfl_xor(mx, 32));
    float sum = 0.f;
#pragma unroll
    for (int f = 0; f < 16; ++f)
#pragma unroll
        for (int g = 0; g < 4; ++g) { const float p = __builtin_amdgcn_exp2f((s[f][g] - mx) * cexp); s[f][g] = p; sum += p; }
    sum += __shfl_xor(sum, 16); sum += __shfl_xor(sum, 32);
    const float inv = 1.0f / sum;
    f32x4 o[8];
#pragma unroll
    for (int i = 0; i < 8; ++i) o[i] = (f32x4){0.f, 0.f, 0.f, 0.f};
#pragma unroll
    for (int st = 0; st < 8; ++st) {
        const bf16x8 pb = __builtin_bit_cast(bf16x8, pg8::pack8(s[2 * st], s[2 * st + 1]));
#pragma unroll
        for (int mf = 0; mf < 8; ++mf) { const int dim = 16 * mf + q; o[mf] = mfma16(*(const LAS bf16x8*)(lds + 65536 + dim * 512 + (((4 * st + hi) ^ (dim & 15)) << 4)), pb, o[mf]); }
    }
    bf16* yp = yxa + tok * 512 + h * 128 + 4 * hi;
#pragma unroll
    for (int mf = 0; mf < 8; ++mf) { v2u w; w.x = pk2(o[mf][0] * inv, o[mf][1] * inv); w.y = pk2(o[mf][2] * inv, o[mf][3] * inv); *(v2u*)(yp + 16 * mf) = w; }
}
__device__ __forceinline__ void pool_wg(const bf16* __restrict__ pp, const bf16* __restrict__ pwT, bf16* __restrict__ ypool, LAS unsigned char* lds, int tokbase, int wave, int lane) {
    const int q = lane & 15, hi = lane >> 4;
    __syncthreads();
    {
        const int hw = 1 << hi, tw0 = tokbase + 16 * wave, b = tw0 >> 13, t0 = tw0 & 8191;
        const bf16* base = pp + (size_t)b * SEQ * 512 + 8 * lane;
        float s[8];
#pragma unroll
        for (int j = 0; j < 8; ++j) s[j] = 0.f;
#pragma unroll 4
        for (int d = -8; d < 8; ++d) { const int u = t0 + d; const bool ok = (d >= -hw) && (d < hw) && (u >= 0) && (u < SEQ);
            const bf16x8 v = *(const bf16x8*)(base + (size_t)(ok ? u : t0) * 512);
#pragma unroll
            for (int j = 0; j < 8; ++j) s[j] += ok ? bf1(v[j]) : 0.f; }
        LAS unsigned char* tile = lds + wave * 16384;
#pragma unroll 2
        for (int i = 0; i < 16; ++i) { const int t = t0 + i;
            int lo = t - hw; lo = lo < 0 ? 0 : lo; int ht = t + hw; ht = ht > SEQ ? SEQ : ht;
            const float inv = 1.0f / (float)(ht - lo);
            const bool oka = (t + hw) < SEQ, oks = (t - hw) >= 0;
            const bf16x8 sv = *(const bf16x8*)(base + (size_t)t * 512), av = *(const bf16x8*)(base + (size_t)(oka ? t + hw : t) * 512), bv = *(const bf16x8*)(base + (size_t)(oks ? t - hw : t) * 512);
            f32x4 p0, p1;
#pragma unroll
            for (int j = 0; j < 4; ++j) { p0[j] = s[j] * inv - bf1(sv[j]); p1[j] = s[j + 4] * inv - bf1(sv[j + 4]); }
            *(LAS v4u*)(tile + i * 1024 + ((lane ^ (i & 15)) << 4)) = pg8::pack8(p0, p1);
#pragma unroll
            for (int j = 0; j < 8; ++j) s[j] += (oka ? bf1(av[j]) : 0.f) - (oks ? bf1(bv[j]) : 0.f);
        }
    }
    __syncthreads();
#pragma unroll 1
    for (int k = 0; k < 4; ++k) {
        const int pair = wave * 4 + k, g = pair >> 3, mf = pair & 7;
        const bf16* wb = pwT + (size_t)(g * 128 + 16 * mf + q) * 128 + 8 * hi;
        bf16x8 a[4];
#pragma unroll
        for (int ks = 0; ks < 4; ++ks) a[ks] = *(const bf16x8*)(wb + 32 * ks);
#pragma unroll 2
        for (int tg = 0; tg < 8; ++tg) {
            const LAS unsigned char* trow = lds + tg * 16384 + q * 1024; f32x4 o = (f32x4){0.f, 0.f, 0.f, 0.f};
#pragma unroll
            for (int ks = 0; ks < 4; ++ks) { const int c = g * 16 + 4 * ks + hi; o = mfma16(a[ks], *(const LAS bf16x8*)(trow + ((c ^ q) << 4)), o); }
            v2u w; w.x = pk2(o[0], o[1]); w.y = pk2(o[2], o[3]);
            *(v2u*)(ypool + (size_t)(tokbase + 16 * tg + q) * 512 + g * 128 + 16 * mf + 4 * hi) = w;
        }
    }
    __syncthreads();
}

__device__ __forceinline__ int f2key(float s, int idx, int mask) { int b = __builtin_bit_cast(int, s); b = b >= 0 ? b : (b ^ 0x7fffffff); return (b & ~mask) | idx; }
__device__ __forceinline__ float key2f(int k) { k = k >= 0 ? k : (k ^ 0x7fffffff); return __builtin_bit_cast(float, k); }
#define CE_DESC(x, y) do { const int _h = (x) > (y) ? (x) : (y), _l = (x) > (y) ? (y) : (x); (x) = _h; (y) = _l; } while (0)
__device__ __forceinline__ void sort16(int (&a)[16]) {
#pragma unroll
    for (int ks = 1; ks <= 4; ++ks)
#pragma unroll
        for (int js = ks - 1; js >= 0; --js)
#pragma unroll
            for (int i = 0; i < 16; ++i) { const int k = 1 << ks, j = 1 << js, l = i ^ j;
                if (l > i) { if ((i & k) == 0) CE_DESC(a[i], a[l]); else CE_DESC(a[l], a[i]); } }
}
__device__ __forceinline__ void merge16(int (&a)[16], const int (&b)[16]) {
#pragma unroll
    for (int i = 0; i < 16; ++i) a[i] = a[i] > b[15 - i] ? a[i] : b[15 - i];
#pragma unroll
    for (int js = 3; js >= 0; --js)
#pragma unroll
        for (int i = 0; i < 16; ++i) { const int j = 1 << js, l = i ^ j; if (l > i) CE_DESC(a[i], a[l]); }
}
__device__ __forceinline__ void merge16_lanes(int (&a)[16], int step) { int o[16];
#pragma unroll
    for (int k = 0; k < 16; ++k) o[k] = __shfl_xor(a[k], step);
    merge16(a, o); }
__device__ constexpr int cand_i(int hi, int m) {
    return hi == 0 ? 0
         : hi == 1 ? (m < 8 ? 1 : (m < 13 ? 2 : -1))
         : hi == 2 ? (m < 4 ? 3 : (m < 7 ? 4 : (m < 9 ? 5 : (m < 11 ? 6 : -1))))
         :           (m < 2 ? 7 : (m < 10 ? 8 + (m - 2) : -1));
}
__device__ constexpr int cand_j(int hi, int m) {
    return hi == 0 ? m
         : hi == 1 ? (m < 8 ? m : (m < 13 ? m - 8 : -1))
         : hi == 2 ? (m < 4 ? m : (m < 7 ? m - 4 : (m < 9 ? m - 7 : (m < 11 ? m - 9 : -1))))
         :           (m < 2 ? m : (m < 10 ? 0 : -1));
}
__device__ __forceinline__ void topk_fill_lds(const bf16* __restrict__ keys, LAS unsigned char* lds, int h, int tid) {
#pragma unroll
    for (int ps = 0; ps < 8; ++ps) { const int id = tid + 512 * ps, row = id >> 4, c = id & 15;
        *(LAS v4u*)(lds + row * 256 + ((c ^ (row & 15)) << 4)) = *(const v4u*)(keys + ((size_t)h * 256 + row) * 128 + 8 * c); }
}
__device__ __forceinline__ void topk_item(const bf16* __restrict__ qb, const LAS unsigned char* klds, int* __restrict__ te, float* __restrict__ tw, LAS int* lscr, int tok0, int h, int lane) {
    const int q = lane & 15, hi = lane >> 4; const size_t tok = (size_t)tok0 + q;
    int L[2][16];
    bf16x8 qfa[2][4];
#pragma unroll
    for (int p = 0; p < 2; ++p)
#pragma unroll
        for (int ks = 0; ks < 4; ++ks) qfa[p][ks] = *(const bf16x8*)(qb + tok * 2048 + h * 256 + p * 128 + 32 * ks + 8 * hi);
    __builtin_amdgcn_sched_barrier(0);
#pragma unroll
    for (int p = 0; p < 2; ++p) {
        int B[16];
#pragma unroll
        for (int mf = 0; mf < 8; ++mf) { f32x4 s = (f32x4){0.f, 0.f, 0.f, 0.f}; const int row = p * 128 + 16 * mf + q;
#pragma unroll
            for (int ks = 0; ks < 4; ++ks) s = mfma16(*(const LAS bf16x8*)(klds + row * 256 + (((4 * ks + hi) ^ (row & 15)) << 4)), qfa[p][ks], s);
#pragma unroll
            for (int g = 0; g < 4; ++g) { const int key = f2key(s[g], 16 * mf + 4 * hi + g, 127); if (mf < 4) L[p][4 * mf + g] = key; else B[4 * (mf - 4) + g] = key; } }
        sort16(L[p]); sort16(B); merge16(L[p], B);
        merge16_lanes(L[p], 16); merge16_lanes(L[p], 32);
    }
    float v1[16], v2[16];
#pragma unroll
    for (int k = 0; k < 16; ++k) { v1[k] = key2f(L[0][k]); v2[k] = key2f(L[1][k]); }
    int Fk[16];
#pragma unroll
    for (int m = 0; m < 16; ++m) {
        float sm = v1[0] + v2[m]; int id = 255 - m;
        if (cand_i(1, m) >= 0) { if (hi == 1) { sm = v1[cand_i(1, m) < 0 ? 0 : cand_i(1, m)] + v2[cand_j(1, m) < 0 ? 0 : cand_j(1, m)]; id = 255 - ((cand_i(1, m) << 4) | cand_j(1, m)); } }
        if (cand_i(2, m) >= 0) { if (hi == 2) { sm = v1[cand_i(2, m) < 0 ? 0 : cand_i(2, m)] + v2[cand_j(2, m) < 0 ? 0 : cand_j(2, m)]; id = 255 - ((cand_i(2, m) << 4) | cand_j(2, m)); } }
        if (cand_i(3, m) >= 0) { if (hi == 3) { sm = v1[cand_i(3, m) < 0 ? 0 : cand_i(3, m)] + v2[cand_j(3, m) < 0 ? 0 : cand_j(3, m)]; id = 255 - ((cand_i(3, m) << 4) | cand_j(3, m)); } }
        int key = f2key(sm, id, 255);
        if ((hi == 1 && cand_i(1, m) < 0) || (hi == 2 && cand_i(2, m) < 0) || (hi == 3 && cand_i(3, m) < 0)) key = (int)0x80000000;
        Fk[m] = key;
    }
    sort16(Fk); merge16_lanes(Fk, 16); merge16_lanes(Fk, 32);
    LAS int* my = lscr + lane * 32;
#pragma unroll
    for (int k = 0; k < 16; ++k) { my[k] = L[0][k] & 127; my[16 + k] = L[1][k] & 127; }
    LDS_WAIT(); asm volatile("" ::: "memory");
    float e[16]; float sum = 0.f; const float mx = key2f(Fk[0]);
#pragma unroll
    for (int k = 0; k < 16; ++k) { e[k] = __expf(key2f(Fk[k]) - mx); sum += e[k]; }
    const float inv = 1.0f / sum;
    if (hi == 0) {
        int* tep = te + (tok * 8 + h) * 16; float* twp = tw + (tok * 8 + h) * 16;
#pragma unroll
        for (int k4 = 0; k4 < 4; ++k4) { int ev[4]; f32x4 wv;
#pragma unroll
            for (int k = 0; k < 4; ++k) { const int kk = 4 * k4 + k, ij = 255 - (Fk[kk] & 255), i = ij >> 4, j = ij & 15; ev[k] = my[i] * 128 + my[16 + j]; wv[k] = e[kk] * inv; }
            *(v4u*)(tep + 4 * k4) = (v4u){(unsigned)ev[0], (unsigned)ev[1], (unsigned)ev[2], (unsigned)ev[3]}; *(f32x4*)(twp + 4 * k4) = wv; }
    }
    LDS_WAIT(); asm volatile("" ::: "memory");
}

__device__ __forceinline__ float ub2f(unsigned v, int b) { return (float)((v >> (8 * b)) & 0xffu); }
__device__ __forceinline__ void peer_token(const bf16* __restrict__ hb, const float* __restrict__ rowsq, const unsigned char* __restrict__ u8, const unsigned char* __restrict__ v8,
                                           const float* __restrict__ su, const float* __restrict__ sv, const int* __restrict__ te, const float* __restrict__ tw,
                                           const float* hsrc, float* out, int tok, int lane) {
    const bf16* hp = hb + (size_t)tok * 1024 + 16 * lane;
    const v4u hA = *(const v4u*)hp, hB = *(const v4u*)(hp + 8);
    float hf[16];
#pragma unroll
    for (int d = 0; d < 4; ++d) { hf[2 * d] = bflo(hA[d]); hf[2 * d + 1] = bfhi(hA[d]); hf[8 + 2 * d] = bflo(hB[d]); hf[8 + 2 * d + 1] = bfhi(hB[d]); }
    float amax = 0.f;
#pragma unroll
    for (int j = 0; j < 16; ++j) amax = fmaxf(amax, fabsf(hf[j]));
#pragma unroll
    for (int o = 1; o < 64; o <<= 1) amax = fmaxf(amax, __shfl_xor(amax, o));
    const float hinv = amax > 0.f ? 127.0f / amax : 0.f;
    int hq[4];
#pragma unroll
    for (int d = 0; d < 4; ++d) { const unsigned b0 = (unsigned)(int)rintf(hf[4 * d] * hinv) & 0xffu, b1 = (unsigned)(int)rintf(hf[4 * d + 1] * hinv) & 0xffu,
                                                 b2 = (unsigned)(int)rintf(hf[4 * d + 2] * hinv) & 0xffu, b3 = (unsigned)(int)rintf(hf[4 * d + 3] * hinv) & 0xffu;
        hq[d] = (int)(b0 | (b1 << 8) | (b2 << 16) | (b3 << 24)); }
    const float zscale = rsqrtf(rowsq[tok] * (1.0f / 1024.0f) + 1e-6f) * amax * (1.0f / 127.0f);
    const int e0 = te[(size_t)tok * 128 + lane], e1 = te[(size_t)tok * 128 + 64 + lane];
    const float* ip = hsrc + (size_t)tok * 1024 + 16 * lane; float* op = out + (size_t)tok * 1024 + 16 * lane;
    f32x4 acc[4];
#pragma unroll
    for (int d = 0; d < 4; ++d) acc[d] = *(const f32x4*)(ip + 4 * d);
    float wsum = 0.f;
#pragma unroll 1
    for (int hd = 0; hd < 8; ++hd) {
        const int esel = hd < 4 ? e0 : e1, lbase = (hd & 3) * 16;
        v4u ur[16], vr[16];
#pragma unroll
        for (int k = 0; k < 16; ++k) { const int e = __builtin_amdgcn_readlane(esel, lbase + k);
            ur[k] = *(const v4u*)(u8 + (size_t)e * 1024 + 16 * lane); vr[k] = *(const v4u*)(v8 + (size_t)e * 1024 + 16 * lane); }
        const int el = __shfl(esel, lbase + (lane >> 2));
        const float su_l = su[el], sv_l = sv[el], g_l = tw[(size_t)tok * 128 + hd * 16 + (lane >> 2)];
        int p[16];
#pragma unroll
        for (int k = 0; k < 16; ++k) { int d = __builtin_amdgcn_sdot4((int)ur[k].x, hq[0], 0, false); d = __builtin_amdgcn_sdot4((int)ur[k].y, hq[1], d, false);
            d = __builtin_amdgcn_sdot4((int)ur[k].z, hq[2], d, false); p[k] = __builtin_amdgcn_sdot4((int)ur[k].w, hq[3], d, false); }
        int q8[8], q4[4], q2[2], q1;
#pragma unroll
        for (int i = 0; i < 8; ++i) { const bool up = (lane & 32) != 0; const int keep = up ? p[i + 8] : p[i], send = up ? p[i] : p[i + 8]; q8[i] = keep + __shfl_xor(send, 32); }
#pragma unroll
        for (int i = 0; i < 4; ++i) { const bool up = (lane & 16) != 0; const int keep = up ? q8[i + 4] : q8[i], send = up ? q8[i] : q8[i + 4]; q4[i] = keep + __shfl_xor(send, 16); }
#pragma unroll
        for (int i = 0; i < 2; ++i) { const bool up = (lane & 8) != 0; const int keep = up ? q4[i + 2] : q4[i], send = up ? q4[i] : q4[i + 2]; q2[i] = keep + __shfl_xor(send, 8); }
        { const bool up = (lane & 4) != 0; const int keep = up ? q2[1] : q2[0], send = up ? q2[0] : q2[1]; q1 = keep + __shfl_xor(send, 4); }
        q1 += __shfl_xor(q1, 2); q1 += __shfl_xor(q1, 1);
        const float z = (float)q1 * zscale * su_l;
        const float wgt = g_l * 0.5f * z * (1.0f + erff(z * 0.70710678118654752f)) * sv_l;
#pragma unroll
        for (int k = 0; k < 16; ++k) { const float wk = __builtin_bit_cast(float, __builtin_amdgcn_readlane(__builtin_bit_cast(int, wgt), 4 * k)); wsum += wk;
#pragma unroll
            for (int d = 0; d < 4; ++d) { acc[d][0] += wk * ub2f(vr[k][d], 0); acc[d][1] += wk * ub2f(vr[k][d], 1); acc[d][2] += wk * ub2f(vr[k][d], 2); acc[d][3] += wk * ub2f(vr[k][d], 3); } }
    }
    const float corr = 128.0f * wsum;
#pragma unroll
    for (int d = 0; d < 4; ++d) *(f32x4*)(op + 4 * d) = acc[d] - corr;
}

__global__ void __launch_bounds__(NWAVES * 64, 2) mk_fwd(Args args) {
    extern __shared__ __attribute__((aligned(16))) unsigned char lds[];
    Frame F;
    F.lds = (LAS unsigned char*)lds;
    F.MISC = (volatile LAS unsigned*)(F.lds + MISC_OFF);
    F.tid = threadIdx.x; F.lane = F.tid & 63; F.wave = __builtin_amdgcn_readfirstlane(F.tid >> 6);
    F.G = gridDim.x; { const int bx = blockIdx.x; F.vcu = (F.G % 8 == 0) ? (bx % 8) * (F.G / 8) + bx / 8 : bx; }
    F.out = args.out; F.ws = args.ws;
    unsigned char* ws = args.ws;
    F.ctl = (gu32*)(ws + WS_CTL);
    for (int u = F.tid; u < (LDS_BYTES - LDSCTL_OFF) / 4; u += NWAVES * 64) ((LAS unsigned*)(F.lds + LDSCTL_OFF))[u] = 0u;
    __syncthreads();
    XcdBarrier bar; bar.bar = (unsigned*)(F.ctl + CW_BAR); bar.x = 0; bar.st = nullptr;
    if (N_LAUNCHES != PER_PHASE) bar = xcd_barrier_post((unsigned*)(F.ctl + CW_BAR), F.MISC + 8);
#define GRID_BAR() do { if (N_LAUNCHES != PER_PHASE) xcd_barrier(bar); } while (0)
    const int lo = args.ph_lo, hi = args.ph_hi;
#define IN(k) (lo <= (k) && (k) < hi)
#define BOTH(k) (IN(k) && IN((k) + 1))
#ifndef DUP_PHASE
#define DUP_PHASE (-1)
#endif
#define NREP(k) ((DUP_PHASE == (k)) ? 2 : 1)
    const int gw = F.vcu * NWAVES + F.wave, NGW = F.G * NWAVES;
    bf16* const WinT = (bf16*)(ws + WS_WIN); bf16* const WvT = (bf16*)(ws + WS_WV); bf16* const WkvT = (bf16*)(ws + WS_WKV); bf16* const WbrT = (bf16*)(ws + WS_WBR);
    bf16* const WoutT = (bf16*)(ws + WS_WOUT); bf16* const WqT = (bf16*)(ws + WS_WQ); bf16* const KEYS = (bf16*)(ws + WS_KEYS); bf16* const PWT = (bf16*)(ws + WS_PWT);
    bf16* const MEMN = (bf16*)(ws + WS_MEMN); bf16* const KMEM = (bf16*)(ws + WS_KMEM); bf16* const VTMEM = (bf16*)(ws + WS_VTMEM); float* const RSTDX = (float*)(ws + WS_RSTDX);
    const unsigned char* const U8 = ws + WS_U8; const unsigned char* const V8 = ws + WS_V8; const float* const SU = (const float*)(ws + WS_SU); const float* const SV = (const float*)(ws + WS_SV);
    bf16* const QN = (bf16*)(ws + WS_QN); bf16* const KN = (bf16*)(ws + WS_KN); bf16* const VT = (bf16*)(ws + WS_VT); bf16* const PP = (bf16*)(ws + WS_PP); bf16* const XQ = (bf16*)(ws + WS_XQ);
    bf16* const GATE = (bf16*)(ws + WS_GATE); bf16* const MERGED = (bf16*)(ws + WS_MERGED); bf16* const HB = (bf16*)(ws + WS_HB); bf16* const QB = (bf16*)(ws + WS_QB);
    int* const TE = (int*)(ws + WS_TE); float* const TW = (float*)(ws + WS_TW); float* const ROWSQ = (float*)(ws + WS_ROWSQ);
    bf16* const XB = (bf16*)((unsigned char*)args.out + OUT_XB); bf16* const YNA = (bf16*)((unsigned char*)args.out + OUT_YNA);
    bf16* const YPOOL = (bf16*)((unsigned char*)args.out + OUT_YPOOL); bf16* const YXA = (bf16*)((unsigned char*)args.out + OUT_YXA);

    if (IN(0)) { for (int rep = 0; rep < NREP(0); ++rep) { p0_prologue(F, args); if (rep + 1 < NREP(0)) GRID_BAR(); } if (BOTH(0)) GRID_BAR(); }

    if (IN(1)) {
      for (int rep = 0; rep < NREP(1); ++rep) {
        { pg8::Sched1 S; S.so.init(T, IN_MAIN, F.G, (int)blockIdx.x); S.A = (const char*)XB; S.Bt = (const char*)WinT; S.tstep = (size_t)256 * 1024 * 2;
          pg8::EpiProj E{RSTDX, QN, KN, PP, XQ, GATE, args.in[I_NAQG], args.in[I_NAKG], args.in[I_GATEB]};
          pg8::gemm_phase<pg8::EpiProj, pg8::Sched1, true, true>(F.lds + RING_OFF, 1024, S, E); }
        { pg8::Sched1 S; S.so.init(512, T, F.G, (int)blockIdx.x); S.A = (const char*)WvT; S.Bt = (const char*)XB; S.tstep = (size_t)256 * 1024 * 2;
          pg8::EpiVt E{RSTDX, VT};
          pg8::gemm_phase<pg8::EpiVt, pg8::Sched1, false, true>(F.lds + RING_OFF, 1024, S, E); }
        for (int t = gw; t < 512; t += NGW) memkv_tile(MEMN, WkvT, args.in[I_XAKG], args.in[I_XAQG], KMEM, VTMEM, t, F.lane);
        if (rep + 1 < NREP(1)) GRID_BAR();
      }
        if (BOTH(1)) GRID_BAR();
    }

    if (IN(2)) {
      for (int rep = 0; rep < NREP(2); ++rep) {
        LAS float* rpl = (LAS float*)(F.lds + RING_OFF + F.wave * 16384);
        for (int i = F.lane; i < 15 * 31; i += 64) rpl[i] = args.in[I_RPB][F.wave * 15 * 31 + i];
        LDS_WAIT(); asm volatile("" ::: "memory");
        for (int i = F.vcu; i < 256; i += F.G)
            for (int k = 0; k < 8; ++k) { const int idx = i * 8 + k, b = idx >> 9, r = (idx >> 2) & 127, jb = idx & 3; na_item(QN, KN, VT, rpl, YNA, b, r, jb, F.wave, F.lane); }
        for (int i = F.vcu; i < 256; i += F.G) pool_wg(PP, PWT, YPOOL, F.lds + RING_OFF, i * 128, F.wave, F.lane);
        { const int pair = F.vcu & 15, xb = pair >> 2, xh = pair & 3, slot = F.vcu >> 4, nslot = F.G >> 4;
          __syncthreads(); xa_fill_lds(KMEM, VTMEM, F.lds + RING_OFF, xb, xh, F.tid); __syncthreads();
          if (slot < nslot) for (int n = slot * NWAVES + F.wave; n < 512; n += nslot * NWAVES) xa_item(XQ, F.lds + RING_OFF, YXA, (xb * 512 + n) * 16, xh, F.lane);
          __syncthreads(); }
        if (rep + 1 < NREP(2)) GRID_BAR();
      }
        if (BOTH(2)) GRID_BAR();
    }

    if (IN(3)) {
      for (int rep = 0; rep < NREP(3); ++rep) {
        pg8::Sched3 S; S.so.init(T, D, F.G, (int)blockIdx.x); S.A = (const char*)YNA; S.Bt = (const char*)WbrT; S.tstep = (size_t)256 * 512 * 2; S.strideA = 32 * MiB; S.strideB = (size_t)1024 * 512 * 2;
        pg8::EpiMerge E{GATE, (bf16*)(ws + WS_VT)  , MERGED};
        pg8::gemm_phase<pg8::EpiMerge, pg8::Sched3, true, true>(F.lds + RING_OFF, 512, S, E);
        if (rep + 1 < NREP(3)) GRID_BAR();
      }
        if (BOTH(3)) GRID_BAR();
    }

    if (IN(4)) {
      for (int rep = 0; rep < NREP(4); ++rep) {
        pg8::Sched1 S; S.so.init(T, D, F.G, (int)blockIdx.x); S.A = (const char*)MERGED; S.Bt = (const char*)WoutT; S.tstep = (size_t)256 * 1024 * 2;
        pg8::EpiH E{args.in[I_X], F.out, HB, ROWSQ};
        pg8::gemm_phase<pg8::EpiH, pg8::Sched1, true, true>(F.lds + RING_OFF, 1024, S, E);
        if (rep + 1 < NREP(4)) { GRID_BAR(); for (int m = gw * 64 + F.lane; m < T; m += NGW * 64) ROWSQ[m] = 0.f; GRID_BAR(); }
      }
        if (BOTH(4)) GRID_BAR();
    }

    if (IN(5)) {
      for (int rep = 0; rep < NREP(5); ++rep) {
        pg8::Sched1 S; S.so.init(T, 2048, F.G, (int)blockIdx.x); S.A = (const char*)HB; S.Bt = (const char*)WqT; S.tstep = (size_t)256 * 1024 * 2;
        pg8::EpiQ E{ROWSQ, QB};
        pg8::gemm_phase<pg8::EpiQ, pg8::Sched1, true, true>(F.lds + RING_OFF, 1024, S, E);
        if (rep + 1 < NREP(5)) GRID_BAR();
      }
        if (BOTH(5)) GRID_BAR();
    }

    if (IN(6)) {
        LAS int* lscr = (LAS int*)(F.lds + RING_OFF + 65536 + F.wave * 8192);
        { const int th = F.vcu & 7, slot = F.vcu >> 3, nslot = F.G >> 3;
          __syncthreads(); topk_fill_lds(KEYS, F.lds + RING_OFF, th, F.tid); __syncthreads();
          for (int rep = 0; rep < NREP(6); ++rep) { for (int n = slot * NWAVES + F.wave; n < 2048; n += nslot * NWAVES) topk_item(QB, F.lds + RING_OFF, TE, TW, lscr, n * 16, th, F.lane); if (rep + 1 < NREP(6)) GRID_BAR(); }
          __syncthreads(); }
        if (BOTH(6)) GRID_BAR();
    }

    if (IN(7)) {
        for (int rep = 0; rep < NREP(7); ++rep) { float* dst = (rep + 1 < NREP(7)) ? (float*)QB : F.out;
            for (int tok = gw; tok < T; tok += NGW) peer_token(HB, ROWSQ, U8, V8, SU, SV, TE, TW, F.out, dst, tok, F.lane);
            if (rep + 1 < NREP(7)) GRID_BAR(); }
    }
#undef IN
#undef BOTH
#undef GRID_BAR
}

extern "C" void kernel_launch(void* const* d_in, const int* in_sizes, int n_in, void* d_out, int out_size, void* d_ws, size_t ws_size, hipStream_t stream) {
    static int grid = 0;
    if (grid == 0) {
        if (n_in != 23 || in_sizes[0] != T * D || out_size != T * D || ws_size < WS_END) { fprintf(stderr, "kernel_launch: unexpected shapes: n_in %d in0 %d out %d ws %zu\n", n_in, n_in > 0 ? in_sizes[0] : -1, out_size, ws_size); grid = -1; return; }
        int dev = 0, cus = 0, per_cu = 0;
        if (hipGetDevice(&dev) != hipSuccess || hipDeviceGetAttribute(&cus, hipDeviceAttributeMultiprocessorCount, dev) != hipSuccess) { fprintf(stderr, "kernel_launch: device query failed\n"); grid = -1; return; }
        if (hipFuncSetAttribute((const void*)mk_fwd, hipFuncAttributeMaxDynamicSharedMemorySize, LDS_BYTES) != hipSuccess) { fprintf(stderr, "kernel_launch: hipFuncSetAttribute failed\n"); grid = -1; return; }
        if (hipOccupancyMaxActiveBlocksPerMultiprocessor(&per_cu, (const void*)mk_fwd, NWAVES * 64, LDS_BYTES) != hipSuccess || per_cu < 1)
            fprintf(stderr, "kernel_launch: note: occupancy query reports %d workgroups per CU\n", per_cu);
        (void)hipGetLastError();
        grid = cus;
    }
    if (grid < 0) return;
    if (hipMemsetAsync((char*)d_ws + WS_CTL, 0, CTL_ZERO_BYTES, stream) != hipSuccess) { fprintf(stderr, "kernel_launch: memset failed\n"); return; }
    Args a{};
    for (int i = 0; i < 23; ++i) a.in[i] = (const float*)d_in[i];
    a.out = (float*)d_out; a.ws = (unsigned char*)d_ws;
    for (int li = 0; li < N_LAUNCHES; ++li) {
        a.ph_lo = (N_LAUNCHES == PER_PHASE) ? li : 0; a.ph_hi = (N_LAUNCHES == PER_PHASE) ? li + 1 : PER_PHASE;
        hipLaunchKernelGGL(mk_fwd, dim3(grid), dim3(NWAVES * 64), LDS_BYTES, stream, a);
#ifdef HOST_DUP_PHASE
        if (N_LAUNCHES == PER_PHASE && li == HOST_DUP_PHASE) { if (li == 4) (void)hipMemsetAsync((char*)d_ws + WS_ROWSQ, 0, (size_t)T * 4, stream); hipLaunchKernelGGL(mk_fwd, dim3(grid), dim3(NWAVES * 64), LDS_BYTES, stream, a); }
#endif
        const hipError_t le = hipPeekAtLastError();
        if (le != hipSuccess) { fprintf(stderr, "kernel_launch: launch %d failed: %s\n", li, hipGetErrorName(le)); break; }
    }
}
```

```cpp
#define MK_N_LAUNCHES 1
#include <hip/hip_runtime.h>
#include <cstdio>
#include <cstdint>

#ifndef MK_N_LAUNCHES
#define MK_N_LAUNCHES 1
#endif

namespace pg8 {
#define PG8_LAS __attribute__((address_space(3)))
typedef unsigned short bf16_t;
typedef short bf16x8 __attribute__((ext_vector_type(8)));
typedef float f32x4 __attribute__((ext_vector_type(4)));
typedef unsigned u32x4 __attribute__((ext_vector_type(4)));
typedef unsigned u32x2 __attribute__((ext_vector_type(2)));
constexpr int BM = 256, BK = 64, HALF = 128, HTB = HALF * BK * 2  , STAGE_BYTES = 8 * HTB, NXCD = 8, WGM = 8;

__host__ __device__ __forceinline__ int lds_byte(int r, int c) { const int st = (r >> 4) * 2 + (c >> 5), rr = r & 15, cc = c & 31, ob = rr * 64 + cc * 2; return st * 1024 + (ob ^ (((ob >> 9) & 1) << 5)); }
__host__ __device__ __forceinline__ void stage_rc(int b, int& R, int& C) { const int st = b / 1024, sb = b % 1024, swz = sb ^ (((sb >> 9) & 1) << 5); R = (st >> 1) * 16 + swz / 64; C = (st & 1) * 32 + (swz % 64) / 2; }
__host__ __device__ __forceinline__ int perm32(int rho) { const int n = rho >> 4, i = rho & 15; return 8 * (i >> 2) + 4 * n + (i & 3); }

struct Unit { int pm, pn, br; };

struct StaticOrder {
    int nM, nN, nwg, G, c;
    __host__ __device__ void init(int M, int N, int G_, int c_) { nM = M / BM; nN = N / BM; nwg = nM * nN; G = G_; c = c_; }
    __host__ __device__ bool next(int i, Unit& u) const {
        const long L = (long)i * G + c; if (L >= nwg) return false;
        int wgid = (int)L; { const int q = nwg / NXCD, r = nwg % NXCD, xcd = wgid % NXCD, off = wgid / NXCD; wgid = (xcd < r ? xcd * (q + 1) : r * (q + 1) + (xcd - r) * q) + off; }
        const int nig = WGM * nN, gid = wgid / nig, fm = gid * WGM, gsz = (nM - fm) < WGM ? (nM - fm) : WGM;
        u.pm = fm + ((wgid % nig) % gsz); u.pn = (wgid % nig) / gsz; return true;
    }
};
struct Sched1 {
    StaticOrder so; const char* A; const char* Bt; size_t tstep;
    __device__ __forceinline__ bool next(int i, Unit& u) const { u.br = 0; return so.next(i, u); }
    __device__ __forceinline__ const char* abase(const Unit& u) const { return A + (size_t)u.pm * tstep; }
    __device__ __forceinline__ const char* bbase(const Unit& u) const { return Bt + (size_t)u.pn * tstep; }
    __device__ __forceinline__ void a_ready(const Unit&) const {}
    __device__ __forceinline__ void done(const Unit&) const {}
};
struct Sched3 {
    StaticOrder so; const char* A; const char* Bt; size_t tstep, strideA, strideB;
    __device__ __forceinline__ bool next(int i, Unit& u) const { u.br = i % 3; return so.next(i / 3, u); }
    __device__ __forceinline__ const char* abase(const Unit& u) const { return A + (size_t)u.br * strideA + (size_t)u.pm * tstep; }
    __device__ __forceinline__ const char* bbase(const Unit& u) const { return Bt + (size_t)u.br * strideB + (size_t)u.pn * tstep; }
    __device__ __forceinline__ void a_ready(const Unit&) const {}
    __device__ __forceinline__ void done(const Unit&) const {}
};

typedef float f32x2_t __attribute__((ext_vector_type(2))); typedef __bf16 bf16x2v_t __attribute__((ext_vector_type(2)));
__device__ __forceinline__ unsigned cvt_pk_bf16(float lo, float hi) { const f32x2_t v = {lo, hi}; const bf16x2v_t b = __builtin_convertvector(v, bf16x2v_t); return __builtin_bit_cast(unsigned, b); }
__device__ __forceinline__ u32x4 pack8(const f32x4 a, const f32x4 b) { u32x4 w; w.x = cvt_pk_bf16(a[0], a[1]); w.y = cvt_pk_bf16(a[2], a[3]); w.z = cvt_pk_bf16(b[0], b[1]); w.w = cvt_pk_bf16(b[2], b[3]); return w; }
__device__ __forceinline__ float bflo(unsigned u) { return __builtin_bit_cast(float, u << 16); }
__device__ __forceinline__ float bfhi(unsigned u) { return __builtin_bit_cast(float, u & 0xffff0000u); }


constexpr float RMS_EPS = 1e-6f;

struct EpiProj {
    static constexpr bool PERM = true, AFTER_DRAIN = false;
    const float* rstd; bf16_t *qn, *kn, *pp, *xq, *gates; const float *qg, *kg, *gate_b;
    __device__ __forceinline__ void operator()(const f32x4 (&acc)[2][2][4][2], const Unit& u, int wr, int wc, int fr, int fq) const {
        const int pn = u.pn, row0 = u.pm * BM + wr * 64 + fr, lc0 = 64 * wc + 8 * fq;
        if (pn < 4) {
            const bool isq = pn < 2; bf16_t* O = isq ? qn : kn; const float* g = isq ? qg : kg; const float post = isq ? 0.125f : 1.0f;
            f32x4 gv[2][2];
#pragma unroll
            for (int bj = 0; bj < 2; ++bj)
#pragma unroll
                for (int n = 0; n < 2; ++n) gv[bj][n] = *(const f32x4*)(g + 32 * bj + 8 * fq + 4 * n);
            const int colbase = (pn & 1) * 256 + lc0;
#pragma unroll
            for (int ai = 0; ai < 2; ++ai)
#pragma unroll
                for (int m = 0; m < 4; ++m) {
                    const int row = row0 + ai * HALF + m * 16; const float rs = rstd[row];
                    f32x4 v[2][2]; float ss = 0.f;
#pragma unroll
                    for (int bj = 0; bj < 2; ++bj)
#pragma unroll
                        for (int n = 0; n < 2; ++n) { v[bj][n] = acc[ai][bj][m][n] * rs; ss += (v[bj][n][0] * v[bj][n][0] + v[bj][n][1] * v[bj][n][1]) + (v[bj][n][2] * v[bj][n][2] + v[bj][n][3] * v[bj][n][3]); }
                    ss += __shfl_xor(ss, 16); ss += __shfl_xor(ss, 32);
                    const float r = rsqrtf(ss * (1.0f / 64.0f) + RMS_EPS) * post;
#pragma unroll
                    for (int bj = 0; bj < 2; ++bj) *(u32x4*)(O + (size_t)row * 512 + colbase + 32 * bj) = pack8(v[bj][0] * r * gv[bj][0], v[bj][1] * r * gv[bj][1]);
                }
        } else if (pn < 8) {
            bf16_t* O = pn < 6 ? pp : xq; const int colbase = (pn & 1) * 256 + lc0;
#pragma unroll
            for (int ai = 0; ai < 2; ++ai)
#pragma unroll
                for (int m = 0; m < 4; ++m) {
                    const int row = row0 + ai * HALF + m * 16; const float rs = rstd[row];
#pragma unroll
                    for (int bj = 0; bj < 2; ++bj) *(u32x4*)(O + (size_t)row * 512 + colbase + 32 * bj) = pack8(acc[ai][bj][m][0] * rs, acc[ai][bj][m][1] * rs);
                }
        } else {
            const int gcol0 = (pn - 8) * 256 + lc0;
            f32x4 bv[2][2];
#pragma unroll
            for (int bj = 0; bj < 2; ++bj)
#pragma unroll
                for (int n = 0; n < 2; ++n) bv[bj][n] = *(const f32x4*)(gate_b + gcol0 + 32 * bj + 4 * n);
#pragma unroll
            for (int ai = 0; ai < 2; ++ai)
#pragma unroll
                for (int m = 0; m < 4; ++m) {
                    const int row = row0 + ai * HALF + m * 16; const float rs = rstd[row];
#pragma unroll
                    for (int bj = 0; bj < 2; ++bj) {
                        f32x4 o[2];
#pragma unroll
                        for (int n = 0; n < 2; ++n) { const f32x4 z = acc[ai][bj][m][n] * rs + bv[bj][n];
#pragma unroll
                            for (int i = 0; i < 4; ++i) o[n][i] = __builtin_amdgcn_rcpf(1.0f + __expf(-z[i])); }
                        *(u32x4*)(gates + (size_t)row * 3072 + gcol0 + 32 * bj) = pack8(o[0], o[1]);
                    }
                }
        }
    }
};
struct EpiVt {
    static constexpr bool PERM = true, AFTER_DRAIN = false;
    const float* rstd; bf16_t* Vt;
    __device__ __forceinline__ void operator()(const f32x4 (&acc)[2][2][4][2], const Unit& u, int wr, int wc, int fr, int fq) const {
        const int ch0 = u.pm * BM + wr * 64 + fr, tok0 = u.pn * BM + wc * 32 + 8 * fq, b = tok0 >> 13, t0 = tok0 & 8191;
        f32x4 rv[2][2];
#pragma unroll
        for (int bj = 0; bj < 2; ++bj)
#pragma unroll
            for (int n = 0; n < 2; ++n) rv[bj][n] = *(const f32x4*)(rstd + tok0 + bj * HALF + 4 * n);
#pragma unroll
        for (int ai = 0; ai < 2; ++ai)
#pragma unroll
            for (int m = 0; m < 4; ++m) { const int ch = ch0 + ai * HALF + m * 16; bf16_t* rowp = Vt + ((size_t)(b * 512 + ch) * 8192 + t0);
#pragma unroll
                for (int bj = 0; bj < 2; ++bj) *(u32x4*)(rowp + bj * HALF) = pack8(acc[ai][bj][m][0] * rv[bj][0], acc[ai][bj][m][1] * rv[bj][1]); }
    }
};
struct EpiMerge {
    static constexpr bool PERM = true, AFTER_DRAIN = false;
    const bf16_t* gates; bf16_t* pa; bf16_t* merged;
    __device__ __forceinline__ void operator()(const f32x4 (&acc)[2][2][4][2], const Unit& u, int wr, int wc, int fr, int fq) const {
        const int row0 = u.pm * BM + wr * 64 + fr, col0 = u.pn * BM + wc * 32 + 8 * fq, br = u.br;
        const bf16_t* src = br == 1 ? pa : merged; bf16_t* dst = br == 0 ? pa : merged;
#pragma unroll
        for (int ai = 0; ai < 2; ++ai)
#pragma unroll
            for (int m = 0; m < 4; ++m) { const int row = row0 + ai * HALF + m * 16;
#pragma unroll
                for (int bj = 0; bj < 2; ++bj) {
                    const u32x4 g8 = *(const u32x4*)(gates + (size_t)row * 3072 + br * 1024 + col0 + bj * HALF);
                    const size_t mo = (size_t)row * 1024 + col0 + bj * HALF;
                    f32x4 a = acc[ai][bj][m][0], b = acc[ai][bj][m][1];
                    a[0] *= bflo(g8.x); a[1] *= bfhi(g8.x); a[2] *= bflo(g8.y); a[3] *= bfhi(g8.y); b[0] *= bflo(g8.z); b[1] *= bfhi(g8.z); b[2] *= bflo(g8.w); b[3] *= bfhi(g8.w);
                    if (br > 0) { const u32x4 p8 = *(const u32x4*)(src + mo);
                        a[0] += bflo(p8.x); a[1] += bfhi(p8.x); a[2] += bflo(p8.y); a[3] += bfhi(p8.y); b[0] += bflo(p8.z); b[1] += bfhi(p8.z); b[2] += bflo(p8.w); b[3] += bfhi(p8.w); }
                    *(u32x4*)(dst + mo) = pack8(a, b);
                } }
    }
};
struct EpiH {
    static constexpr bool PERM = true, AFTER_DRAIN = false;
    const float* x; float* out; bf16_t* hb; float* rowsq;
    __device__ __forceinline__ void operator()(const f32x4 (&acc)[2][2][4][2], const Unit& u, int wr, int wc, int fr, int fq) const {
        const int row0 = u.pm * BM + wr * 64 + fr, col0 = u.pn * BM + wc * 32 + 8 * fq;
#pragma unroll
        for (int ai = 0; ai < 2; ++ai)
#pragma unroll
            for (int m = 0; m < 4; ++m) { const int row = row0 + ai * HALF + m * 16; float ss = 0.f;
#pragma unroll
                for (int bj = 0; bj < 2; ++bj) { const size_t o = (size_t)row * 1024 + col0 + bj * HALF;
                    const f32x4 h0 = *(const f32x4*)(x + o) + acc[ai][bj][m][0], h1 = *(const f32x4*)(x + o + 4) + acc[ai][bj][m][1];
                    *(f32x4*)(out + o) = h0; *(f32x4*)(out + o + 4) = h1; *(u32x4*)(hb + o) = pack8(h0, h1);
                    ss += (h0[0] * h0[0] + h0[1] * h0[1]) + (h0[2] * h0[2] + h0[3] * h0[3]) + (h1[0] * h1[0] + h1[1] * h1[1]) + (h1[2] * h1[2] + h1[3] * h1[3]); }
                ss += __shfl_xor(ss, 16); ss += __shfl_xor(ss, 32);
                if (fq == 0) atomicAdd(rowsq + row, ss); }
    }
};
struct EpiQ {
    static constexpr bool PERM = true, AFTER_DRAIN = false;
    const float* rowsq; bf16_t* qb;
    __device__ __forceinline__ void operator()(const f32x4 (&acc)[2][2][4][2], const Unit& u, int wr, int wc, int fr, int fq) const {
        const int row0 = u.pm * BM + wr * 64 + fr, col0 = u.pn * BM + wc * 32 + 8 * fq;
#pragma unroll
        for (int ai = 0; ai < 2; ++ai)
#pragma unroll
            for (int m = 0; m < 4; ++m) { const int row = row0 + ai * HALF + m * 16; const float r = rsqrtf(rowsq[row] * (1.0f / 1024.0f) + RMS_EPS);
#pragma unroll
                for (int bj = 0; bj < 2; ++bj) *(u32x4*)(qb + (size_t)row * 2048 + col0 + bj * HALF) = pack8(acc[ai][bj][m][0] * r, acc[ai][bj][m][1] * r); }
    }
};

template <class Epi, class Sched, bool ALIGN_EPI = false, bool SP2 = false>
__device__ __forceinline__ void gemm_phase(PG8_LAS unsigned char* lds, const int K, const Sched& S, const Epi& E) {
    const int tid = threadIdx.x, wid = __builtin_amdgcn_readfirstlane(tid >> 6), lane = tid & 63, wr = wid >> 2, wc = wid & 3, fr = lane & 15, fq = lane >> 4;
    const int nt = K / BK;
    unsigned voffA[2], voffB[2];
#pragma unroll
    for (int i = 0; i < 2; ++i) { int R, C; stage_rc(tid * 16 + i * 8192, R, C); const int Rb = Epi::PERM ? ((R & ~31) + perm32(R & 31)) : R;
        voffA[i] = (unsigned)(R * K + C) * 2u; voffB[i] = (unsigned)(Rb * K + C) * 2u; }
    const size_t kstep = (size_t)(BK * 2);
    const size_t hstep = (size_t)HALF * K * 2;
    const size_t tstep = 2 * hstep;
    const unsigned ldsw = (unsigned)wid * 1024u;
    const int aoff = lds_byte(wr * 64 + fr, fq * 8), boff = lds_byte(wc * 32 + fr, fq * 8);
#define PG8_SA(b, h) (((b) * 2 + (h)) * HTB)
#define PG8_SB(b, h) ((4 + (b) * 2 + (h)) * HTB)
#define PG8_STAGE(bufoff, gbase, voff) do { _Pragma("unroll") for (int _i = 0; _i < 2; ++_i) \
        __builtin_amdgcn_global_load_lds((const unsigned*)((const char*)(gbase) + (voff)[_i]), (PG8_LAS unsigned*)(lds + (bufoff) + ldsw + _i * 8192), 16, 0, 0); } while (0)
#define PG8_LDA(dst, b, h) do { _Pragma("unroll") for (int m = 0; m < 4; ++m) _Pragma("unroll") for (int k = 0; k < 2; ++k) dst[m][k] = *(const PG8_LAS bf16x8*)(lds + PG8_SA(b, h) + aoff + m * 2048 + k * 1024); } while (0)
#define PG8_LDB(dst, b, h) do { _Pragma("unroll") for (int n = 0; n < 2; ++n) _Pragma("unroll") for (int k = 0; k < 2; ++k) dst[n][k] = *(const PG8_LAS bf16x8*)(lds + PG8_SB(b, h) + boff + n * 2048 + k * 1024); } while (0)
#define PG8_MMA(ai, bj, At, Bt) do { __builtin_amdgcn_s_setprio(1); _Pragma("unroll") for (int m = 0; m < 4; ++m) _Pragma("unroll") for (int n = 0; n < 2; ++n) _Pragma("unroll") for (int k = 0; k < 2; ++k) \
        acc[ai][bj][m][n] = __builtin_amdgcn_mfma_f32_16x16x32_bf16(Bt[n][k], At[m][k], acc[ai][bj][m][n], 0, 0, 0); __builtin_amdgcn_s_setprio(0); } while (0)
#define PG8_WAIT_V(n) asm volatile("s_waitcnt vmcnt(" #n ")" ::: "memory")
#define PG8_WAIT_L(n) asm volatile("s_waitcnt lgkmcnt(" #n ")" ::: "memory")
#define PG8_BAR __builtin_amdgcn_s_barrier()
#define PG8_SCHED __builtin_amdgcn_sched_barrier(0)
    Unit cur, nxt; int ui = 0;
    if (!S.next(0, cur)) return;
    f32x4 acc[2][2][4][2];
#pragma unroll
    for (int a = 0; a < 2; ++a)
#pragma unroll
        for (int b = 0; b < 2; ++b)
#pragma unroll
            for (int m = 0; m < 4; ++m)
#pragma unroll
                for (int n = 0; n < 2; ++n) acc[a][b][m][n] = (f32x4){0.f, 0.f, 0.f, 0.f};
    bf16x8 At[4][2], B0[2][2], B1[2][2];
    const char* cA = S.abase(cur); const char* cB = S.bbase(cur);
    S.a_ready(cur);
    if constexpr (SP2) {
        PG8_STAGE(PG8_SB(0, 0), cB, voffB); PG8_STAGE(PG8_SB(0, 1), cB + hstep, voffB); PG8_STAGE(PG8_SA(0, 0), cA, voffA); PG8_STAGE(PG8_SA(0, 1), cA + hstep, voffA);
        if (wr == 1) PG8_BAR;
        PG8_WAIT_V(2); PG8_BAR;
        PG8_STAGE(PG8_SB(1, 0), cB + kstep, voffB); PG8_STAGE(PG8_SA(1, 0), cA + kstep, voffA); PG8_STAGE(PG8_SB(1, 1), cB + hstep + kstep, voffB);
        PG8_WAIT_V(6); PG8_BAR;
    } else {
        PG8_STAGE(PG8_SB(0, 0), cB, voffB); PG8_STAGE(PG8_SA(0, 0), cA, voffA); PG8_STAGE(PG8_SB(0, 1), cB + hstep, voffB); PG8_STAGE(PG8_SA(0, 1), cA + hstep, voffA);
        if (wr == 1) PG8_BAR;
        PG8_WAIT_V(4); PG8_BAR;
        PG8_STAGE(PG8_SB(1, 0), cB + kstep, voffB); PG8_STAGE(PG8_SA(1, 0), cA + kstep, voffA); PG8_STAGE(PG8_SB(1, 1), cB + hstep + kstep, voffB);
        PG8_WAIT_V(6); PG8_BAR;
    }
    for (;;) {
        const bool has_next = S.next(ui + 1, nxt);
        const char* nA = has_next ? S.abase(nxt) : cA; const char* nB = has_next ? S.bbase(nxt) : cB;
        for (int t = 0; t < nt; t += 2) {
            const bool last = (t == nt - 2);
            const char* a1 = cA + (size_t)(t + 1) * kstep;
            const char* a2 = last ? nA : cA + (size_t)(t + 2) * kstep; const char* b2 = last ? nB : cB + (size_t)(t + 2) * kstep;
            const char* a3 = a2 + kstep; const char* b3 = b2 + kstep;
            if (last && has_next) S.a_ready(nxt);
            if constexpr (SP2) {
            PG8_LDB(B0, 0, 0); PG8_LDB(B1, 0, 1); PG8_SCHED; PG8_LDA(At, 0, 0); PG8_STAGE(PG8_SA(1, 1), a1 + hstep, voffA);
            PG8_WAIT_V(8); PG8_WAIT_L(0); PG8_BAR; PG8_MMA(0, 0, At, B0); PG8_MMA(0, 1, At, B1); PG8_BAR; PG8_SCHED;
            PG8_LDA(At, 0, 1); PG8_STAGE(PG8_SB(0, 0), b2, voffB); PG8_STAGE(PG8_SB(0, 1), b2 + hstep, voffB); PG8_STAGE(PG8_SA(0, 0), a2, voffA);
            PG8_WAIT_V(8); PG8_WAIT_L(0); PG8_BAR; PG8_MMA(1, 0, At, B0); PG8_MMA(1, 1, At, B1); PG8_BAR; PG8_SCHED;
            PG8_LDB(B0, 1, 0); PG8_LDB(B1, 1, 1); PG8_SCHED; PG8_LDA(At, 1, 0); PG8_STAGE(PG8_SA(0, 1), a2 + hstep, voffA);
            PG8_WAIT_V(8); PG8_WAIT_L(0); PG8_BAR; PG8_MMA(0, 0, At, B0); PG8_MMA(0, 1, At, B1); PG8_BAR; PG8_SCHED;
            PG8_LDA(At, 1, 1); PG8_STAGE(PG8_SB(1, 0), b3, voffB); PG8_STAGE(PG8_SB(1, 1), b3 + hstep, voffB); PG8_STAGE(PG8_SA(1, 0), a3, voffA);
            PG8_WAIT_V(8); PG8_WAIT_L(0); PG8_BAR; PG8_MMA(1, 0, At, B0); PG8_MMA(1, 1, At, B1); PG8_BAR; PG8_SCHED;
            } else {
            PG8_LDB(B0, 0, 0); PG8_SCHED; PG8_LDA(At, 0, 0); PG8_STAGE(PG8_SA(1, 1), a1 + hstep, voffA);
            PG8_WAIT_L(8); PG8_BAR; PG8_WAIT_L(0); PG8_MMA(0, 0, At, B0); PG8_BAR; PG8_SCHED;
            PG8_LDB(B1, 0, 1); PG8_STAGE(PG8_SB(0, 0), b2, voffB);
            PG8_BAR; PG8_WAIT_L(0); PG8_MMA(0, 1, At, B1); PG8_BAR;
            PG8_LDA(At, 0, 1); PG8_STAGE(PG8_SA(0, 0), a2, voffA);
            PG8_BAR; PG8_WAIT_L(0); PG8_MMA(1, 0, At, B0); PG8_BAR; PG8_SCHED;
            PG8_STAGE(PG8_SB(0, 1), b2 + hstep, voffB);
            PG8_WAIT_V(6); PG8_BAR; PG8_MMA(1, 1, At, B1); PG8_BAR;
            PG8_LDB(B0, 1, 0); PG8_SCHED; PG8_LDA(At, 1, 0); PG8_STAGE(PG8_SA(0, 1), a2 + hstep, voffA);
            PG8_WAIT_L(8); PG8_BAR; PG8_WAIT_L(0); PG8_MMA(0, 0, At, B0); PG8_BAR; PG8_SCHED;
            PG8_LDB(B1, 1, 1); PG8_STAGE(PG8_SB(1, 0), b3, voffB);
            PG8_BAR; PG8_WAIT_L(0); PG8_MMA(0, 1, At, B1); PG8_BAR;
            PG8_LDA(At, 1, 1); PG8_STAGE(PG8_SA(1, 0), a3, voffA);
            PG8_BAR; PG8_WAIT_L(0); PG8_MMA(1, 0, At, B0); PG8_BAR; PG8_SCHED;
            PG8_STAGE(PG8_SB(1, 1), b3 + hstep, voffB);
            PG8_WAIT_V(6); PG8_BAR; PG8_MMA(1, 1, At, B1); PG8_BAR;
            }
        }
        if constexpr (ALIGN_EPI) { if (wr == 0) PG8_BAR; }
        if constexpr (!Epi::AFTER_DRAIN) { E(acc, cur, wr, wc, fr, fq); S.done(cur); }
        if (!has_next) break;
#pragma unroll
        for (int a = 0; a < 2; ++a)
#pragma unroll
            for (int b = 0; b < 2; ++b)
#pragma unroll
                for (int m = 0; m < 4; ++m)
#pragma unroll
                    for (int n = 0; n < 2; ++n) acc[a][b][m][n] = (f32x4){0.f, 0.f, 0.f, 0.f};
        cur = nxt; cA = nA; cB = nB; ++ui;
        if constexpr (ALIGN_EPI) { if (wr == 1) PG8_BAR; }
    }
    PG8_WAIT_V(0);
    if constexpr (!ALIGN_EPI) { if (wr == 0) PG8_BAR; }
    PG8_BAR;
    if constexpr (Epi::AFTER_DRAIN) { E.fused(acc, cur, wr, wc, fr, fq, lds, wid, lane); S.done(cur); }
#undef PG8_SA
#undef PG8_SB
#undef PG8_STAGE
#undef PG8_LDA
#undef PG8_LDB
#undef PG8_MMA
#undef PG8_WAIT_V
#undef PG8_WAIT_L
#undef PG8_BAR
#undef PG8_SCHED
}
}

constexpr int NWAVES = 8;
constexpr int N_LAUNCHES = MK_N_LAUNCHES;
constexpr int PER_PHASE = 9;
constexpr int NBATCH = 4, SEQ = 8192, D = 1024, T = NBATCH * SEQ, MEMLEN = 256, NMEMTOK = NBATCH * MEMLEN;
constexpr int IN_MAIN = 5120;
constexpr int NEXP = 16384;

constexpr size_t MiB = 1u << 20;
constexpr size_t WS_CTL = 0, CTL_ZERO_BYTES = 512 * 1024;
constexpr size_t WS_ROWSQ = 256 * 1024;
constexpr size_t WS_WIN = 1 * MiB, WS_WV = 11 * MiB, WS_WKV = 12 * MiB, WS_WBR = 14 * MiB, WS_WOUT = 17 * MiB, WS_WQ = 19 * MiB, WS_KEYS = 23 * MiB, WS_PWT = 23 * MiB + 512 * 1024;
constexpr size_t WS_MEMN = 24 * MiB, WS_KMEM = 26 * MiB, WS_VTMEM = 27 * MiB, WS_RSTDX = 28 * MiB, WS_SU = 28 * MiB + 256 * 1024, WS_SV = 28 * MiB + 512 * 1024;
constexpr size_t WS_U8 = 32 * MiB, WS_V8 = 48 * MiB;
constexpr size_t WS_QN = 96 * MiB, WS_KN = 128 * MiB, WS_VT = 160 * MiB, WS_PP = 192 * MiB, WS_XQ = 224 * MiB, WS_GATE = 256 * MiB, WS_END = 448 * MiB;
constexpr size_t WS_MERGED = WS_QN;
constexpr size_t WS_HB = WS_VT;
constexpr size_t WS_QB = WS_GATE;
constexpr size_t WS_TE = WS_GATE + 128 * MiB, WS_TW = WS_TE + 16 * MiB;
constexpr size_t WS_HQ = WS_TW + 16 * MiB;
constexpr size_t WS_HS = 28 * MiB + 768 * 1024;
constexpr size_t OUT_XB = 0, OUT_YNA = 0, OUT_YPOOL = 32 * MiB, OUT_YXA = 64 * MiB;
constexpr int CW_TMO = 0, CW_BAR = 4096;

constexpr int RING_OFF = 0, RING_BYTES = 131072;
constexpr int LDSCTL_OFF = RING_BYTES, MISC_OFF = LDSCTL_OFF + 320;
constexpr int LDS_BYTES = 147456;

#define GAS __attribute__((address_space(1)))
#define LAS __attribute__((address_space(3)))
typedef unsigned short bf16;
typedef unsigned v4u __attribute__((ext_vector_type(4)));
typedef unsigned v2u __attribute__((ext_vector_type(2)));
typedef float f32x4 __attribute__((ext_vector_type(4)));
typedef short bf16x8 __attribute__((ext_vector_type(8)));
typedef __bf16 bf16x2_t __attribute__((ext_vector_type(2)));
typedef GAS unsigned gu32;
#define LDS_WAIT() asm volatile("s_waitcnt lgkmcnt(0)" ::: "memory")
#define VM_WAIT() asm volatile("s_waitcnt vmcnt(0)" ::: "memory")
__device__ __forceinline__ unsigned f2bf(float f) { unsigned u = __builtin_bit_cast(unsigned, f); return (u + 0x7fffu + ((u >> 16) & 1u)) >> 16; }
__device__ __forceinline__ unsigned pk2(float lo, float hi) { return f2bf(lo) | (f2bf(hi) << 16); }
__device__ __forceinline__ float bflo(unsigned u) { return __builtin_bit_cast(float, u << 16); }
__device__ __forceinline__ float bfhi(unsigned u) { return __builtin_bit_cast(float, u & 0xffff0000u); }
__device__ __forceinline__ float bf1(short s) { return __builtin_bit_cast(float, ((unsigned)(unsigned short)s) << 16); }
__device__ __forceinline__ f32x4 mfma16(bf16x8 a, bf16x8 b, f32x4 c) { return __builtin_amdgcn_mfma_f32_16x16x32_bf16(a, b, c, 0, 0, 0); }
__device__ __forceinline__ float wave_sum(float v) {
#pragma unroll
    for (int o = 1; o < 64; o <<= 1) v += __shfl_xor(v, o);
    return v;
}

#define XB_TMO      128
#define XB_XCNT(j)  (256  + 64 * (j))
#define XB_XSUB(j)  (1280 + 64 * (j))
#define XB_XGEN(j)  (2304 + 64 * (j))
#define XB_TOP      3328
#define XB_TOPGEN   3392
#define XCD_BAR_WORDS 3456
#define XB_SPIN_CAP (1u << 18)

__device__ __forceinline__ unsigned xb_ld(unsigned* p)              { return __hip_atomic_load(p, __ATOMIC_RELAXED, __HIP_MEMORY_SCOPE_AGENT); }
__device__ __forceinline__ unsigned xb_add(unsigned* p, unsigned v) { return __hip_atomic_fetch_add(p, v, __ATOMIC_RELAXED, __HIP_MEMORY_SCOPE_AGENT); }
__device__ __forceinline__ unsigned xb_xcc_id() { return (unsigned)__builtin_amdgcn_s_getreg((3 << 11) | 20) & 0xFu; }
#define XB_SPIN(cond, bar) do { unsigned _sp = 0; while (cond) { __builtin_amdgcn_s_sleep(1); \
    if ((++_sp & 255u) == 0u) { if (xb_ld(&(bar)[XB_TMO])) break; if (_sp > XB_SPIN_CAP) { atomicAdd(&(bar)[XB_TMO], 1u); break; } } } } while (0)

struct XcdBarrier {
    unsigned* bar; unsigned x;
    volatile LAS unsigned* st;
};

__device__ __forceinline__ XcdBarrier xcd_barrier_post(unsigned* bar, volatile LAS unsigned* st) {
    XcdBarrier b; b.bar = bar; b.x = xb_xcc_id(); b.st = st;
    if (threadIdx.x == 0) (void)xb_add(&bar[XB_XCNT(b.x)], 1u);
    return b;
}
__device__ __forceinline__ void xcd_barrier_complete(unsigned* bar, unsigned x, unsigned& nloc, unsigned& nx) {
    const unsigned G = gridDim.x * gridDim.y * gridDim.z;
    unsigned sum, cnt, mine, sp = 0u;
    for (;;) {
        sum = 0u; cnt = 0u; mine = 0u;
#pragma unroll
        for (unsigned j = 0; j < 16; ++j) { const unsigned c = xb_ld(&bar[XB_XCNT(j)]); sum += c; cnt += (c > 0u) ? 1u : 0u; mine = (j == x) ? c : mine; }
        if (sum == G) break;
        __builtin_amdgcn_s_sleep(1);
        if ((++sp & 255u) == 0u) { if (xb_ld(&bar[XB_TMO])) break; if (sp > XB_SPIN_CAP) { atomicAdd(&bar[XB_TMO], 1u); break; } }
    }
    nloc = mine > 0u ? mine : 1u; nx = cnt > 0u ? cnt : 1u;
}

__device__ __forceinline__ void xcd_barrier(const XcdBarrier& b) {
    asm volatile("s_waitcnt vmcnt(0)" ::: "memory");
    __syncthreads();
    if (threadIdx.x == 0) {
        unsigned* bar = b.bar;
        __builtin_amdgcn_s_waitcnt(0);
        unsigned nloc = b.st[0], nx = b.st[1];
        if (nloc == 0u) { xcd_barrier_complete(bar, b.x, nloc, nx); b.st[0] = nloc; b.st[1] = nx; }
        const unsigned old = xb_add(&bar[XB_XSUB(b.x)], 1u);
        const unsigned gen = old / nloc;
        if (old + 1u == (gen + 1u) * nloc) {
            __builtin_amdgcn_fence(__ATOMIC_RELEASE, "agent");
            asm volatile("s_waitcnt vmcnt(0)" ::: "memory");
            const unsigned og = xb_add(&bar[XB_TOP], 1u);
            const unsigned tg = og / nx;
            if (og + 1u == (tg + 1u) * nx) xb_add(&bar[XB_TOPGEN], 1u);
            else XB_SPIN(xb_ld(&bar[XB_TOPGEN]) == tg, bar);
            __builtin_amdgcn_fence(__ATOMIC_ACQUIRE, "agent");
            xb_add(&bar[XB_XGEN(b.x)], 1u);
            asm volatile("s_waitcnt vmcnt(0)" ::: "memory");
        } else {
            XB_SPIN(xb_ld(&bar[XB_XGEN(b.x)]) == gen, bar);
            __builtin_amdgcn_fence(__ATOMIC_ACQUIRE, "agent");
            asm volatile("s_waitcnt vmcnt(0)" ::: "memory");
        }
    }
    __syncthreads();
}

struct Frame {
    LAS unsigned char* lds;
    volatile LAS unsigned* MISC;
    gu32* ctl;
    int tid, lane, wave, vcu, G;
    float* out; unsigned char* ws;
};
struct Args { const float* in[23]; float* out; unsigned char* ws; int ph_lo, ph_hi; };
enum { I_X = 0, I_MEM, I_MIXG, I_MEMG, I_WIN, I_GATEB, I_WKV, I_NAQG, I_NAKG, I_RPB, I_POOLW, I_POOLSC, I_XAQG, I_XAKG, I_WB0, I_WB1, I_WB2, I_WOUT, I_FFNG, I_WQ, I_KEYS, I_PU, I_PV };

__device__ __forceinline__ void p0_transpose_item(const float* W, int K, int N, int k0, int n0, bf16* dst, const float* kscale, LAS float* scr, int lane) {
#pragma unroll 8
    for (int i = 0; i < 32; ++i) { const int kk = 2 * i + (lane >> 5); float v = W[(size_t)(k0 + kk) * N + n0 + (lane & 31)]; if (kscale) v *= kscale[k0 + kk]; scr[kk * 33 + (lane & 31)] = v; }
    LDS_WAIT(); asm volatile("" ::: "memory");
    const int c = lane & 7;
#pragma unroll
    for (int j = 0; j < 4; ++j) { const int n = (lane >> 3) + 8 * j; const LAS float* s = scr + (8 * c) * 33 + n;
        v4u o; o.x = pk2(s[0 * 33], s[1 * 33]); o.y = pk2(s[2 * 33], s[3 * 33]); o.z = pk2(s[4 * 33], s[5 * 33]); o.w = pk2(s[6 * 33], s[7 * 33]);
        *(GAS v4u*)(dst + (size_t)n * K + k0 + 8 * c) = o; }
    LDS_WAIT(); asm volatile("" ::: "memory");
}
__device__ __forceinline__ void cvt_row1024(const float* src, bf16* dst, const float* colscale, float rowscale, int lane) {
    const GAS f32x4* xr = (const GAS f32x4*)src + lane; GAS unsigned long long* o8 = (GAS unsigned long long*)dst + lane;
#pragma unroll
    for (int j = 0; j < 4; ++j) { f32x4 v = xr[64 * j] * rowscale; if (colscale) v = v * ((const GAS f32x4*)colscale)[lane + 64 * j];
        o8[64 * j] = (unsigned long long)pk2(v.x, v.y) | ((unsigned long long)pk2(v.z, v.w) << 32); }
}
__device__ __forceinline__ float row_rstd1024(const float* src, int lane) {
    const GAS f32x4* xr = (const GAS f32x4*)src + lane; float s = 0.f;
#pragma unroll
    for (int j = 0; j < 4; ++j) { const f32x4 v = xr[64 * j]; s += (v.x * v.x + v.y * v.y) + (v.z * v.z + v.w * v.w); }
    return rsqrtf(wave_sum(s) * (1.0f / 1024.0f) + 1e-6f);
}
__device__ __forceinline__ void p0_prologue(Frame& F, const Args& A) {
    LAS float* scr = (LAS float*)(F.lds + RING_OFF + F.wave * 16384);
    const int gw = F.vcu * NWAVES + F.wave, NGW = F.G * NWAVES, lane = F.lane;
    unsigned char* ws = F.ws;
    constexpr int I_IN = 16 * 176, I_KV = 16 * 32, I_BR = 8 * 32, I_OUT = 16 * 32, I_Q = 16 * 64;
    constexpr int NITEMS = I_IN + I_KV + 3 * I_BR + I_OUT + I_Q;
    for (int it = gw; it < NITEMS; it += NGW) {
        int r = it;
        if (r < I_IN) { const int kb = r / 176, nb = r % 176, n0 = 32 * nb; bf16* dst;
            if (n0 >= 1024 && n0 < 1536) dst = (bf16*)(ws + WS_WV) + (size_t)(n0 - 1024) * 1024;
            else { const int np = n0 < 1024 ? n0 : n0 - 512, t = np >> 8, w = np & 255, wc = w >> 6, bj = (w >> 5) & 1; dst = (bf16*)(ws + WS_WIN) + (size_t)(256 * t + 128 * bj + 32 * wc) * 1024; }
            p0_transpose_item(A.in[I_WIN], 1024, 5632, 64 * kb, n0, dst, A.in[I_MIXG], scr, lane); continue; }
        r -= I_IN;
        if (r < I_KV) { const int kb = r / 32, nb = r % 32; p0_transpose_item(A.in[I_WKV], 1024, 1024, 64 * kb, 32 * nb, (bf16*)(ws + WS_WKV) + (size_t)(32 * nb) * 1024, nullptr, scr, lane); continue; }
        r -= I_KV;
        if (r < 3 * I_BR) { const int br = r / I_BR, rr = r % I_BR, kb = rr / 32, nb = rr % 32; const float* W = br == 0 ? A.in[I_WB0] : (br == 1 ? A.in[I_WB1] : A.in[I_WB2]);
            p0_transpose_item(W, 512, 1024, 64 * kb, 32 * nb, (bf16*)(ws + WS_WBR) + (size_t)br * 1024 * 512 + (size_t)(32 * nb) * 512, nullptr, scr, lane); continue; }
        r -= 3 * I_BR;
        if (r < I_OUT) { const int kb = r / 32, nb = r % 32; p0_transpose_item(A.in[I_WOUT], 1024, 1024, 64 * kb, 32 * nb, (bf16*)(ws + WS_WOUT) + (size_t)(32 * nb) * 1024, nullptr, scr, lane); continue; }
        r -= I_OUT;
        { const int kb = r / 64, nb = r % 64; p0_transpose_item(A.in[I_WQ], 1024, 2048, 64 * kb, 32 * nb, (bf16*)(ws + WS_WQ) + (size_t)(32 * nb) * 1024, A.in[I_FFNG], scr, lane); }
    }
    { bf16* xb = (bf16*)((unsigned char*)F.out + OUT_XB); float* rstdx = (float*)(ws + WS_RSTDX);
      for (int m = gw; m < T; m += NGW) { const float* xr = A.in[I_X] + (size_t)m * D; const float rs = row_rstd1024(xr, lane); cvt_row1024(xr, xb + (size_t)m * D, nullptr, 1.0f, lane); if (lane == 0) rstdx[m] = rs; } }
    for (int m = gw; m < NMEMTOK; m += NGW) { const float* xr = A.in[I_MEM] + (size_t)m * D; const float rs = row_rstd1024(xr, lane); cvt_row1024(xr, (bf16*)(ws + WS_MEMN) + (size_t)m * D, A.in[I_MEMG], rs, lane); }
    for (int m = gw; m < 2 * NEXP; m += NGW) {
        const bool isu = m < NEXP; const int e = isu ? m : m - NEXP;
        const GAS f32x4* src = (const GAS f32x4*)((isu ? A.in[I_PU] : A.in[I_PV]) + (size_t)e * D) + 4 * lane;
        f32x4 v[4]; float mx = 0.f;
#pragma unroll
        for (int d = 0; d < 4; ++d) { v[d] = src[d]; if (isu) v[d] = v[d] * ((const GAS f32x4*)A.in[I_FFNG])[4 * lane + d];
            mx = fmaxf(mx, fmaxf(fmaxf(fabsf(v[d].x), fabsf(v[d].y)), fmaxf(fabsf(v[d].z), fabsf(v[d].w)))); }
#pragma unroll
        for (int o = 1; o < 64; o <<= 1) mx = fmaxf(mx, __shfl_xor(mx, o));
        const float inv = mx > 0.f ? 127.0f / mx : 0.f; const int off = isu ? 0 : 128;
        v4u w;
#pragma unroll
        for (int d = 0; d < 4; ++d) { const unsigned b0 = (unsigned)((int)rintf(v[d].x * inv) + off) & 0xffu, b1 = (unsigned)((int)rintf(v[d].y * inv) + off) & 0xffu,
                                                     b2 = (unsigned)((int)rintf(v[d].z * inv) + off) & 0xffu, b3 = (unsigned)((int)rintf(v[d].w * inv) + off) & 0xffu;
            w[d] = b0 | (b1 << 8) | (b2 << 16) | (b3 << 24); }
        if (isu) ((GAS v4u*)(ws + WS_U8))[(size_t)e * 64 + lane] = w;
        else *(GAS v4u*)(ws + WS_V8 + (size_t)(lane >> 3) * (2 * MiB) + (size_t)e * 128 + (lane & 7) * 16) = w;
        if (lane == 0) ((float*)(ws + (isu ? WS_SU : WS_SV)))[e] = mx * (1.0f / 127.0f);
    }
    for (int m = gw * 64 + lane; m < T; m += NGW * 64) ((float*)(ws + WS_ROWSQ))[m] = 0.f;
    for (int m = gw; m < 256; m += NGW) cvt_row1024(A.in[I_KEYS] + (size_t)m * 1024, (bf16*)(ws + WS_KEYS) + (size_t)m * 1024, nullptr, 1.0f, lane);
    for (int m = gw; m < 1024; m += NGW) { const int gd = m >> 1, c = (m & 1) * 64 + lane, g = gd >> 7, d = gd & 127;
        const float v = A.in[I_POOLW][(size_t)(g * 128 + c) * 128 + d] * A.in[I_POOLSC][gd];
        ((bf16*)(ws + WS_PWT))[(size_t)gd * 128 + c] = (bf16)f2bf(v); }
}

__device__ __forceinline__ void memkv_tile(const bf16* memn, const bf16* wkvT, const float* kg, const float* qg, bf16* kmem, bf16* vtmem, int tile, int lane) {
    const int q = lane & 15, hi = lane >> 4, rg = tile >> 3, cg = tile & 7, r0 = rg * 16, c0 = cg * 128;
    f32x4 acc[8];
#pragma unroll
    for (int i = 0; i < 8; ++i) acc[i] = (f32x4){0.f, 0.f, 0.f, 0.f};
    const bf16* ap = memn + (size_t)(r0 + q) * 1024 + 8 * hi; const bf16* bp = wkvT + (size_t)(c0 + q) * 1024 + 8 * hi;
#pragma unroll 1
    for (int kb = 0; kb < 8; ++kb) {
        bf16x8 a[4], b[4][8];
#pragma unroll
        for (int k4 = 0; k4 < 4; ++k4) { a[k4] = *(const bf16x8*)(ap + 32 * (4 * kb + k4));
#pragma unroll
            for (int nf = 0; nf < 8; ++nf) b[k4][nf] = *(const bf16x8*)(bp + (size_t)(16 * nf) * 1024 + 32 * (4 * kb + k4)); }
        __builtin_amdgcn_sched_barrier(0);
#pragma unroll
        for (int k4 = 0; k4 < 4; ++k4)
#pragma unroll
            for (int nf = 0; nf < 8; ++nf) acc[nf] = mfma16(a[k4], b[k4][nf], acc[nf]);
        __builtin_amdgcn_sched_barrier(0);
    }
    if (cg < 4) {
        float rr[4];
#pragma unroll
        for (int g = 0; g < 4; ++g) { float ss = 0.f;
#pragma unroll
            for (int nf = 0; nf < 8; ++nf) ss += acc[nf][g] * acc[nf][g];
            ss += __shfl_xor(ss, 1); ss += __shfl_xor(ss, 2); ss += __shfl_xor(ss, 4); ss += __shfl_xor(ss, 8);
            rr[g] = rsqrtf(ss * (1.0f / 128.0f) + 1e-6f); }
#pragma unroll
        for (int nf = 0; nf < 8; ++nf) { const int d = 16 * nf + q; const float gs = kg[d] * qg[d];
#pragma unroll
            for (int g = 0; g < 4; ++g) kmem[(size_t)(r0 + 4 * hi + g) * 512 + cg * 128 + d] = (bf16)f2bf(acc[nf][g] * rr[g] * gs); }
    } else {
        const int h = cg - 4, b = r0 >> 8, key0 = (r0 & 255) + 4 * hi;
#pragma unroll
        for (int nf = 0; nf < 8; ++nf) { const int d = 16 * nf + q; v2u w; w.x = pk2(acc[nf][0], acc[nf][1]); w.y = pk2(acc[nf][2], acc[nf][3]);
            *(v2u*)(vtmem + (size_t)(b * 512 + h * 128 + d) * 256 + key0) = w; }
    }
}

__device__ __forceinline__ void na_item(const bf16* __restrict__ qn, const bf16* __restrict__ kn, const bf16* __restrict__ vt, const LAS float* rpl, bf16* __restrict__ yna,
                                        int b, int r, int jb, int h, int lane) {
    const int q = lane & 15, hi = lane >> 4;
    int rs = r - 4; rs = rs < 0 ? 0 : (rs > 120 ? 120 : rs);
    int kb0 = jb * 16 - 8; kb0 = kb0 < 0 ? 0 : (kb0 > 32 ? 32 : kb0);
    const int qcol = jb * 16 + q; int cs = qcol - 8; cs = cs < 0 ? 0 : (cs > 48 ? 48 : cs);
    const size_t tokq = (size_t)b * SEQ + r * 64 + qcol;
    const bf16* qp = qn + tokq * 512 + h * 64 + 8 * hi;
    const bf16x8 qf0 = *(const bf16x8*)qp, qf1 = *(const bf16x8*)(qp + 32);
    const int kq = 8 * (q >> 2) + (q & 3);
    const bf16* kbase = kn + ((size_t)b * SEQ + rs * 64 + kb0 + kq) * 512 + h * 64 + 8 * hi;
    f32x4 s[16];
    {
        bf16x8 ka[16][2];
#pragma unroll
        for (int f = 0; f < 16; ++f) { const bf16* kp = kbase + (size_t)((f >> 1) * 64 + (f & 1) * 4) * 512; ka[f][0] = *(const bf16x8*)kp; ka[f][1] = *(const bf16x8*)(kp + 32); }
        __builtin_amdgcn_sched_barrier(0);
#pragma unroll
        for (int f = 0; f < 16; ++f) { f32x4 z = (f32x4){0.f, 0.f, 0.f, 0.f}; z = mfma16(ka[f][0], qf0, z); s[f] = mfma16(ka[f][1], qf1, z); }
    }
    const bf16* vbase = vt + ((size_t)(b * 512 + h * 64 + q) * SEQ + rs * 64 + kb0 + 8 * hi);
    bf16x8 va[8][4];
#pragma unroll
    for (int st = 0; st < 8; ++st)
#pragma unroll
        for (int mf = 0; mf < 4; ++mf) va[st][mf] = *(const bf16x8*)(vbase + (size_t)(16 * mf) * SEQ + st * 64);
    __builtin_amdgcn_sched_barrier(0);
    float mx = -3.0e38f;
#pragma unroll
    for (int f = 0; f < 16; ++f) {
        const int dr = rs + (f >> 1) - r + 7;
#pragma unroll
        for (int g = 0; g < 4; ++g) {
            const int kcol = kb0 + 8 * hi + 4 * (f & 1) + g;
            const bool ok = (kcol >= cs) && (kcol < cs + 16);
            int dc = kcol - qcol + 15; dc = dc < 0 ? 0 : (dc > 30 ? 30 : dc);
            const float v = ok ? s[f][g] + rpl[dr * 31 + dc] : -1.0e30f;
            s[f][g] = v; mx = fmaxf(mx, v);
        }
    }
    mx = fmaxf(mx, __shfl_xor(mx, 16)); mx = fmaxf(mx, __shfl_xor(mx, 32));
    float sum = 0.f;
#pragma unroll
    for (int f = 0; f < 16; ++f)
#pragma unroll
        for (int g = 0; g < 4; ++g) { const float p = __expf(s[f][g] - mx); s[f][g] = p; sum += p; }
    sum += __shfl_xor(sum, 16); sum += __shfl_xor(sum, 32);
    const float inv = 1.0f / sum;
    f32x4 o[4];
#pragma unroll
    for (int i = 0; i < 4; ++i) o[i] = (f32x4){0.f, 0.f, 0.f, 0.f};
#pragma unroll
    for (int st = 0; st < 8; ++st) {
        const bf16x8 pb = __builtin_bit_cast(bf16x8, pg8::pack8(s[2 * st], s[2 * st + 1]));
#pragma unroll
        for (int mf = 0; mf < 4; ++mf) o[mf] = mfma16(va[st][mf], pb, o[mf]);
    }
    bf16* yp = yna + tokq * 512 + h * 64 + 4 * hi;
#pragma unroll
    for (int mf = 0; mf < 4; ++mf) { v2u w; w.x = pk2(o[mf][0] * inv, o[mf][1] * inv); w.y = pk2(o[mf][2] * inv, o[mf][3] * inv); *(v2u*)(yp + 16 * mf) = w; }
}
__device__ __forceinline__ void xa_fill_lds(const bf16* __restrict__ kmem, const bf16* __restrict__ vtmem, LAS unsigned char* lds, int b, int h, int tid) {
#pragma unroll
    for (int ps = 0; ps < 8; ++ps) { const int id = tid + 512 * ps, key = id >> 4, c = id & 15;
        *(LAS v4u*)(lds + key * 256 + ((c ^ (key & 15)) << 4)) = *(const v4u*)(kmem + ((size_t)b * 256 + key) * 512 + h * 128 + 8 * c); }
#pragma unroll
    for (int ps = 0; ps < 8; ++ps) { const int id = tid + 512 * ps, dim = id >> 5, c = id & 31;
        *(LAS v4u*)(lds + 65536 + dim * 512 + ((c ^ (dim & 15)) << 4)) = *(const v4u*)(vtmem + (size_t)(b * 512 + h * 128 + dim) * 256 + 8 * c); }
}
__device__ __forceinline__ void xa_item(const bf16* __restrict__ xq, const LAS unsigned char* lds, bf16* __restrict__ yxa, int tok0, int h, int lane) {
    const int q = lane & 15, hi = lane >> 4; const size_t tok = (size_t)tok0 + q;
    const bf16* qp = xq + tok * 512 + h * 128 + 8 * hi;
    bf16x8 qf[4]; float ssq = 0.f;
#pragma unroll
    for (int ks = 0; ks < 4; ++ks) qf[ks] = *(const bf16x8*)(qp + 32 * ks);
    __builtin_amdgcn_sched_barrier(0);
#pragma unroll
    for (int ks = 0; ks < 4; ++ks)
#pragma unroll
        for (int j = 0; j < 8; ++j) { const float v = bf1(qf[ks][j]); ssq += v * v; }
    ssq += __shfl_xor(ssq, 16); ssq += __shfl_xor(ssq, 32);
    const float cexp = rsqrtf(ssq * (1.0f / 128.0f) + 1e-6f) * 0.08838834764831845f * 1.4426950408889634f;
    const int kq = 8 * (q >> 2) + (q & 3);
    f32x4 s[16];
#pragma unroll
    for (int f = 0; f < 16; ++f) { const int key = 32 * (f >> 1) + 4 * (f & 1) + kq; const LAS unsigned char* kr = lds + key * 256; f32x4 z = (f32x4){0.f, 0.f, 0.f, 0.f};
#pragma unroll
        for (int ks = 0; ks < 4; ++ks) z = mfma16(*(const LAS bf16x8*)(kr + (((4 * ks + hi) ^ (key & 15)) << 4)), qf[ks], z);
        s[f] = z; }
    float mx = -3.0e38f;
#pragma unroll
    for (int f = 0; f < 16; ++f)
#pragma unroll
        for (int g = 0; g < 4; ++g) mx = fmaxf(mx, s[f][g]);
    mx = fmaxf(mx, __shfl_xor(mx, 16)); mx = fmaxf(mx, __shfl_xor(mx, 32));
    float sum = 0.f;
#pragma unroll
    for (int f = 0; f < 16; ++f)
#pragma unroll
        for (int g = 0; g < 4; ++g) { const float p = __builtin_amdgcn_exp2f((s[f][g] - mx) * cexp); s[f][g] = p; sum += p; }
    sum += __shfl_xor(sum, 16); sum += __shfl_xor(sum, 32);
    const float inv = 1.0f / sum;
    f32x4 o[8];
#pragma unroll
    for (int i = 0; i < 8; ++i) o[i] = (f32x4){0.f, 0.f, 0.f, 0.f};
#pragma unroll
    for (int st = 0; st < 8; ++st) {
        const bf16x8 pb = __builtin_bit_cast(bf16x8, pg8::pack8(s[2 * st], s[2 * st + 1]));
#pragma unroll
        for (int mf = 0; mf < 8; ++mf) { const int dim = 16 * mf + q; o[mf] = mfma16(*(const LAS bf16x8*)(lds + 65536 + dim * 512 + (((4 * st + hi) ^ (dim & 15)) << 4)), pb, o[mf]); }
    }
    bf16* yp = yxa + tok * 512 + h * 128 + 4 * hi;
#pragma unroll
    for (int mf = 0; mf < 8; ++mf) { v2u w; w.x = pk2(o[mf][0] * inv, o[mf][1] * inv); w.y = pk2(o[mf][2] * inv, o[mf][3] * inv); *(v2u*)(yp + 16 * mf) = w; }
}
__device__ __forceinline__ void pool_wg(const bf16* __restrict__ pp, const bf16* __restrict__ pwT, bf16* __restrict__ ypool, LAS unsigned char* lds, int tokbase, int wave, int lane) {
    const int q = lane & 15, hi = lane >> 4;
    __syncthreads();
    {
        const int hw = 1 << hi, tw0 = tokbase + 16 * wave, b = tw0 >> 13, t0 = tw0 & 8191;
        const bf16* base = pp + (size_t)b * SEQ * 512 + 8 * lane;
        float s[8];
#pragma unroll
        for (int j = 0; j < 8; ++j) s[j] = 0.f;
#pragma unroll 4
        for (int d = -8; d < 8; ++d) { const int u = t0 + d; const bool ok = (d >= -hw) && (d < hw) && (u >= 0) && (u < SEQ);
            const bf16x8 v = *(const bf16x8*)(base + (size_t)(ok ? u : t0) * 512);
#pragma unroll
            for (int j = 0; j < 8; ++j) s[j] += ok ? bf1(v[j]) : 0.f; }
        LAS unsigned char* tile = lds + wave * 16384;
#pragma unroll 2
        for (int i = 0; i < 16; ++i) { const int t = t0 + i;
            int lo = t - hw; lo = lo < 0 ? 0 : lo; int ht = t + hw; ht = ht > SEQ ? SEQ : ht;
            const float inv = 1.0f / (float)(ht - lo);
            const bool oka = (t + hw) < SEQ, oks = (t - hw) >= 0;
            const bf16x8 sv = *(const bf16x8*)(base + (size_t)t * 512), av = *(const bf16x8*)(base + (size_t)(oka ? t + hw : t) * 512), bv = *(const bf16x8*)(base + (size_t)(oks ? t - hw : t) * 512);
            f32x4 p0, p1;
#pragma unroll
            for (int j = 0; j < 4; ++j) { p0[j] = s[j] * inv - bf1(sv[j]); p1[j] = s[j + 4] * inv - bf1(sv[j + 4]); }
            *(LAS v4u*)(tile + i * 1024 + ((lane ^ (i & 15)) << 4)) = pg8::pack8(p0, p1);
#pragma unroll
            for (int j = 0; j < 8; ++j) s[j] += (oka ? bf1(av[j]) : 0.f) - (oks ? bf1(bv[j]) : 0.f);
        }
    }
    __syncthreads();
#pragma unroll 1
    for (int k = 0; k < 4; ++k) {
        const int pair = wave * 4 + k, g = pair >> 3, mf = pair & 7;
        const bf16* wb = pwT + (size_t)(g * 128 + 16 * mf + q) * 128 + 8 * hi;
        bf16x8 a[4];
#pragma unroll
        for (int ks = 0; ks < 4; ++ks) a[ks] = *(const bf16x8*)(wb + 32 * ks);
#pragma unroll 2
        for (int tg = 0; tg < 8; ++tg) {
            const LAS unsigned char* trow = lds + tg * 16384 + q * 1024; f32x4 o = (f32x4){0.f, 0.f, 0.f, 0.f};
#pragma unroll
            for (int ks = 0; ks < 4; ++ks) { const int c = g * 16 + 4 * ks + hi; o = mfma16(a[ks], *(const LAS bf16x8*)(trow + ((c ^ q) << 4)), o); }
            v2u w; w.x = pk2(o[0], o[1]); w.y = pk2(o[2], o[3]);
            *(v2u*)(ypool + (size_t)(tokbase + 16 * tg + q) * 512 + g * 128 + 16 * mf + 4 * hi) = w;
        }
    }
    __syncthreads();
}

__device__ __forceinline__ int f2key(float s, int idx, int mask) { int b = __builtin_bit_cast(int, s); b = b >= 0 ? b : (b ^ 0x7fffffff); return (b & ~mask) | idx; }
__device__ __forceinline__ float key2f(int k) { k = k >= 0 ? k : (k ^ 0x7fffffff); return __builtin_bit_cast(float, k); }
#define CE_DESC(x, y) do { const int _h = (x) > (y) ? (x) : (y), _l = (x) > (y) ? (y) : (x); (x) = _h; (y) = _l; } while (0)
__device__ __forceinline__ void sort16(int (&a)[16]) {
#pragma unroll
    for (int ks = 1; ks <= 4; ++ks)
#pragma unroll
        for (int js = ks - 1; js >= 0; --js)
#pragma unroll
            for (int i = 0; i < 16; ++i) { const int k = 1 << ks, j = 1 << js, l = i ^ j;
                if (l > i) { if ((i & k) == 0) CE_DESC(a[i], a[l]); else CE_DESC(a[l], a[i]); } }
}
__device__ __forceinline__ void merge16(int (&a)[16], const int (&b)[16]) {
#pragma unroll
    for (int i = 0; i < 16; ++i) a[i] = a[i] > b[15 - i] ? a[i] : b[15 - i];
#pragma unroll
    for (int js = 3; js >= 0; --js)
#pragma unroll
        for (int i = 0; i < 16; ++i) { const int j = 1 << js, l = i ^ j; if (l > i) CE_DESC(a[i], a[l]); }
}
__device__ __forceinline__ void merge16_lanes(int (&a)[16], int step) { int o[16];
#pragma unroll
    for (int k = 0; k < 16; ++k) o[k] = __shfl_xor(a[k], step);
    merge16(a, o); }
__device__ constexpr int cand_i(int hi, int m) {
    return hi == 0 ? 0
         : hi == 1 ? (m < 8 ? 1 : (m < 13 ? 2 : -1))
         : hi == 2 ? (m < 4 ? 3 : (m < 7 ? 4 : (m < 9 ? 5 : (m < 11 ? 6 : -1))))
         :           (m < 2 ? 7 : (m < 10 ? 8 + (m - 2) : -1));
}
__device__ constexpr int cand_j(int hi, int m) {
    return hi == 0 ? m
         : hi == 1 ? (m < 8 ? m : (m < 13 ? m - 8 : -1))
         : hi == 2 ? (m < 4 ? m : (m < 7 ? m - 4 : (m < 9 ? m - 7 : (m < 11 ? m - 9 : -1))))
         :           (m < 2 ? m : (m < 10 ? 0 : -1));
}
__device__ __forceinline__ void topk_fill_lds(const bf16* __restrict__ keys, LAS unsigned char* lds, int h, int tid) {
#pragma unroll
    for (int ps = 0; ps < 8; ++ps) { const int id = tid + 512 * ps, row = id >> 4, c = id & 15;
        *(LAS v4u*)(lds + row * 256 + ((c ^ (row & 15)) << 4)) = *(const v4u*)(keys + ((size_t)h * 256 + row) * 128 + 8 * c); }
}
__device__ __forceinline__ void topk_item(const bf16* __restrict__ qb, const LAS unsigned char* klds, int* __restrict__ te, float* __restrict__ tw, LAS int* lscr, int tok0, int h, int lane) {
    const int q = lane & 15, hi = lane >> 4; const size_t tok = (size_t)tok0 + q;
    int L[2][16];
    bf16x8 qfa[2][4];
#pragma unroll
    for (int p = 0; p < 2; ++p)
#pragma unroll
        for (int ks = 0; ks < 4; ++ks) qfa[p][ks] = *(const bf16x8*)(qb + tok * 2048 + h * 256 + p * 128 + 32 * ks + 8 * hi);
    __builtin_amdgcn_sched_barrier(0);
#pragma unroll
    for (int p = 0; p < 2; ++p) {
        int B[16];
#pragma unroll
        for (int mf = 0; mf < 8; ++mf) { f32x4 s = (f32x4){0.f, 0.f, 0.f, 0.f}; const int row = p * 128 + 16 * mf + q;
#pragma unroll
            for (int ks = 0; ks < 4; ++ks) s = mfma16(*(const LAS bf16x8*)(klds + row * 256 + (((4 * ks + hi) ^ (row & 15)) << 4)), qfa[p][ks], s);
#pragma unroll
            for (int g = 0; g < 4; ++g) { const int key = f2key(s[g], 16 * mf + 4 * hi + g, 127); if (mf < 4) L[p][4 * mf + g] = key; else B[4 * (mf - 4) + g] = key; } }
        sort16(L[p]); sort16(B); merge16(L[p], B);
        merge16_lanes(L[p], 16); merge16_lanes(L[p], 32);
    }
    float v1[16], v2[16];
#pragma unroll
    for (int k = 0; k < 16; ++k) { v1[k] = key2f(L[0][k]); v2[k] = key2f(L[1][k]); }
    int Fk[16];
#pragma unroll
    for (int m = 0; m < 16; ++m) {
        float sm = v1[0] + v2[m]; int id = 255 - m;
        if (cand_i(1, m) >= 0) { if (hi == 1) { sm = v1[cand_i(1, m) < 0 ? 0 : cand_i(1, m)] + v2[cand_j(1, m) < 0 ? 0 : cand_j(1, m)]; id = 255 - ((cand_i(1, m) << 4) | cand_j(1, m)); } }
        if (cand_i(2, m) >= 0) { if (hi == 2) { sm = v1[cand_i(2, m) < 0 ? 0 : cand_i(2, m)] + v2[cand_j(2, m) < 0 ? 0 : cand_j(2, m)]; id = 255 - ((cand_i(2, m) << 4) | cand_j(2, m)); } }
        if (cand_i(3, m) >= 0) { if (hi == 3) { sm = v1[cand_i(3, m) < 0 ? 0 : cand_i(3, m)] + v2[cand_j(3, m) < 0 ? 0 : cand_j(3, m)]; id = 255 - ((cand_i(3, m) << 4) | cand_j(3, m)); } }
        int key = f2key(sm, id, 255);
        if ((hi == 1 && cand_i(1, m) < 0) || (hi == 2 && cand_i(2, m) < 0) || (hi == 3 && cand_i(3, m) < 0)) key = (int)0x80000000;
        Fk[m] = key;
    }
    sort16(Fk); merge16_lanes(Fk, 16); merge16_lanes(Fk, 32);
    LAS int* my = lscr + lane * 32;
#pragma unroll
    for (int k = 0; k < 16; ++k) { my[k] = L[0][k] & 127; my[16 + k] = L[1][k] & 127; }
    LDS_WAIT(); asm volatile("" ::: "memory");
    float e[16]; float sum = 0.f; const float mx = key2f(Fk[0]);
#pragma unroll
    for (int k = 0; k < 16; ++k) { e[k] = __expf(key2f(Fk[k]) - mx); sum += e[k]; }
    const float inv = 1.0f / sum;
    if (hi == 0) {
        int* tep = te + (tok * 8 + h) * 16; float* twp = tw + (tok * 8 + h) * 16;
#pragma unroll
        for (int k4 = 0; k4 < 4; ++k4) { int ev[4]; f32x4 wv;
#pragma unroll
            for (int k = 0; k < 4; ++k) { const int kk = 4 * k4 + k, ij = 255 - (Fk[kk] & 255), i = ij >> 4, j = ij & 15; ev[k] = my[i] * 128 + my[16 + j]; wv[k] = e[kk] * inv; }
            *(v4u*)(tep + 4 * k4) = (v4u){(unsigned)ev[0], (unsigned)ev[1], (unsigned)ev[2], (unsigned)ev[3]}; *(f32x4*)(twp + 4 * k4) = wv; }
    }
    LDS_WAIT(); asm volatile("" ::: "memory");
}

__device__ __forceinline__ float ub2f(unsigned v, int b) { return (float)((v >> (8 * b)) & 0xffu); }
__device__ __forceinline__ void hq_token(const bf16* __restrict__ hb, const float* __restrict__ rowsq, unsigned char* __restrict__ hq, float* __restrict__ hs, int tok, int lane) {
    const bf16* hp = hb + (size_t)tok * 1024 + 16 * lane;
    const v4u hA = *(const v4u*)hp, hB = *(const v4u*)(hp + 8);
    float hf[16];
#pragma unroll
    for (int d = 0; d < 4; ++d) { hf[2 * d] = bflo(hA[d]); hf[2 * d + 1] = bfhi(hA[d]); hf[8 + 2 * d] = bflo(hB[d]); hf[8 + 2 * d + 1] = bfhi(hB[d]); }
    float amax = 0.f;
#pragma unroll
    for (int j = 0; j < 16; ++j) amax = fmaxf(amax, fabsf(hf[j]));
#pragma unroll
    for (int o = 1; o < 64; o <<= 1) amax = fmaxf(amax, __shfl_xor(amax, o));
    const float hinv = amax > 0.f ? 127.0f / amax : 0.f;
    v4u w;
#pragma unroll
    for (int d = 0; d < 4; ++d) { const unsigned b0 = (unsigned)(int)rintf(hf[4 * d] * hinv) & 0xffu, b1 = (unsigned)(int)rintf(hf[4 * d + 1] * hinv) & 0xffu,
                                                 b2 = (unsigned)(int)rintf(hf[4 * d + 2] * hinv) & 0xffu, b3 = (unsigned)(int)rintf(hf[4 * d + 3] * hinv) & 0xffu;
        w[d] = b0 | (b1 << 8) | (b2 << 16) | (b3 << 24); }
    *(v4u*)(hq + (size_t)tok * 1024 + 16 * lane) = w;
    if (lane == 0) hs[tok] = rsqrtf(rowsq[tok] * (1.0f / 1024.0f) + 1e-6f) * amax * (1.0f / 127.0f);
}
__device__ __forceinline__ void peer_a_item(const unsigned char* __restrict__ hq, const float* __restrict__ hs, const unsigned char* __restrict__ u8, const float* __restrict__ su,
                                            const float* __restrict__ sv, const int* __restrict__ te, float* tw, LAS int* lst, int tok, int x, int lane) {
    const int e0 = te[(size_t)tok * 128 + lane], e1 = te[(size_t)tok * 128 + 64 + lane];
    const bool m0 = (e0 >> 11) == x, m1 = (e1 >> 11) == x;
    const unsigned long long b0 = __ballot(m0), b1 = __ballot(m1), lt = (1ull << lane) - 1ull;
    const int c0 = __popcll(b0), cnt = c0 + __popcll(b1);
    if (m0) { const int r = __popcll(b0 & lt); lst[2 * r] = e0; lst[2 * r + 1] = lane; }
    if (m1) { const int r = c0 + __popcll(b1 & lt); lst[2 * r] = e1; lst[2 * r + 1] = 64 + lane; }
    LDS_WAIT(); asm volatile("" ::: "memory");
    const v4u hv = *(const v4u*)(hq + (size_t)tok * 1024 + 16 * lane); const float hsc = hs[tok];
    for (int base = 0; base < cnt; base += 16) {
        v4u ur[16];
#pragma unroll
        for (int k = 0; k < 16; ++k) { ur[k] = (v4u){0u, 0u, 0u, 0u};
            if (base + k < cnt) { const int e = __builtin_amdgcn_readfirstlane(lst[2 * (base + k)]); ur[k] = *(const v4u*)(u8 + (size_t)e * 1024 + 16 * lane); } }
        int p[16];
#pragma unroll
        for (int k = 0; k < 16; ++k) { int d = __builtin_amdgcn_sdot4((int)ur[k].x, (int)hv.x, 0, false); d = __builtin_amdgcn_sdot4((int)ur[k].y, (int)hv.y, d, false);
            d = __builtin_amdgcn_sdot4((int)ur[k].z, (int)hv.z, d, false); p[k] = __builtin_amdgcn_sdot4((int)ur[k].w, (int)hv.w, d, false); }
        int q8[8], q4[4], q2[2], q1;
#pragma unroll
        for (int i = 0; i < 8; ++i) { const bool up = (lane & 32) != 0; const int keep = up ? p[i + 8] : p[i], send = up ? p[i] : p[i + 8]; q8[i] = keep + __shfl_xor(send, 32); }
#pragma unroll
        for (int i = 0; i < 4; ++i) { const bool up = (lane & 16) != 0; const int keep = up ? q8[i + 4] : q8[i], send = up ? q8[i] : q8[i + 4]; q4[i] = keep + __shfl_xor(send, 16); }
#pragma unroll
        for (int i = 0; i < 2; ++i) { const bool up = (lane & 8) != 0; const int keep = up ? q4[i + 2] : q4[i], send = up ? q4[i] : q4[i + 2]; q2[i] = keep + __shfl_xor(send, 8); }
        { const bool up = (lane & 4) != 0; const int keep = up ? q2[1] : q2[0], send = up ? q2[0] : q2[1]; q1 = keep + __shfl_xor(send, 4); }
        q1 += __shfl_xor(q1, 2); q1 += __shfl_xor(q1, 1);
        const int sl = base + (lane >> 2);
        if (sl < cnt && (lane & 3) == 0) { const int e = lst[2 * sl], pos = lst[2 * sl + 1];
            const float z = (float)q1 * hsc * su[e]; float* gp = tw + (size_t)tok * 128 + pos;
            *gp = *gp * 0.5f * z * (1.0f + erff(z * 0.70710678118654752f)) * sv[e]; }
    }
    LDS_WAIT(); asm volatile("" ::: "memory");
}
__device__ __forceinline__ void peer_b_item(const unsigned char* __restrict__ v8x, const int* __restrict__ te, const float* __restrict__ aw, float* out, int tok, int x, int lane) {
    const int i = lane >> 3, c = lane & 7;
    const int e0 = te[(size_t)tok * 128 + lane], e1 = te[(size_t)tok * 128 + 64 + lane];
    const float w0 = aw[(size_t)tok * 128 + lane], w1 = aw[(size_t)tok * 128 + 64 + lane];
    v4u vr[16]; float wk[16];
#pragma unroll
    for (int m = 0; m < 16; ++m) { const int src = (8 * m + i) & 63; const int e = __shfl(m < 8 ? e0 : e1, src); wk[m] = __shfl(m < 8 ? w0 : w1, src);
        vr[m] = *(const v4u*)(v8x + (size_t)e * 128 + 16 * c); }
    float acc[16]; float ws = 0.f;
#pragma unroll
    for (int j = 0; j < 16; ++j) acc[j] = 0.f;
#pragma unroll
    for (int m = 0; m < 16; ++m) { ws += wk[m];
#pragma unroll
        for (int d = 0; d < 4; ++d) { acc[4 * d] += wk[m] * ub2f(vr[m][d], 0); acc[4 * d + 1] += wk[m] * ub2f(vr[m][d], 1); acc[4 * d + 2] += wk[m] * ub2f(vr[m][d], 2); acc[4 * d + 3] += wk[m] * ub2f(vr[m][d], 3); } }
    const float corr = 128.0f * ws;
#pragma unroll
    for (int j = 0; j < 16; ++j) acc[j] -= corr;
    float r8[8], r4[4], r2[2];
#pragma unroll
    for (int j = 0; j < 8; ++j) { const bool up = (lane & 8) != 0; const float keep = up ? acc[j + 8] : acc[j], send = up ? acc[j] : acc[j + 8]; r8[j] = keep + __shfl_xor(send, 8); }
#pragma unroll
    for (int j = 0; j < 4; ++j) { const bool up = (lane & 16) != 0; const float keep = up ? r8[j + 4] : r8[j], send = up ? r8[j] : r8[j + 4]; r4[j] = keep + __shfl_xor(send, 16); }
#pragma unroll
    for (int j = 0; j < 2; ++j) { const bool up = (lane & 32) != 0; const float keep = up ? r4[j + 2] : r4[j], send = up ? r4[j] : r4[j + 2]; r2[j] = keep + __shfl_xor(send, 32); }
    const int col = 16 * c + 8 * ((lane >> 3) & 1) + 4 * ((lane >> 4) & 1) + 2 * ((lane >> 5) & 1);
    float* op = out + (size_t)tok * 1024 + 128 * x + col;
    typedef float f32x2v __attribute__((ext_vector_type(2)));
    f32x2v h2 = *(const f32x2v*)op; h2.x += r2[0]; h2.y += r2[1]; *(f32x2v*)op = h2;
}

__global__ void __launch_bounds__(NWAVES * 64, 2) mk_fwd(Args args) {
    extern __shared__ __attribute__((aligned(16))) unsigned char lds[];
    Frame F;
    F.lds = (LAS unsigned char*)lds;
    F.MISC = (volatile LAS unsigned*)(F.lds + MISC_OFF);
    F.tid = threadIdx.x; F.lane = F.tid & 63; F.wave = __builtin_amdgcn_readfirstlane(F.tid >> 6);
    F.G = gridDim.x; { const int bx = blockIdx.x; F.vcu = (F.G % 8 == 0) ? (bx % 8) * (F.G / 8) + bx / 8 : bx; }
    F.out = args.out; F.ws = args.ws;
    unsigned char* ws = args.ws;
    F.ctl = (gu32*)(ws + WS_CTL);
    for (int u = F.tid; u < (LDS_BYTES - LDSCTL_OFF) / 4; u += NWAVES * 64) ((LAS unsigned*)(F.lds + LDSCTL_OFF))[u] = 0u;
    __syncthreads();
    XcdBarrier bar; bar.bar = (unsigned*)(F.ctl + CW_BAR); bar.x = 0; bar.st = nullptr;
    if (N_LAUNCHES != PER_PHASE) bar = xcd_barrier_post((unsigned*)(F.ctl + CW_BAR), F.MISC + 8);
#define GRID_BAR() do { if (N_LAUNCHES != PER_PHASE) xcd_barrier(bar); } while (0)
    const int lo = args.ph_lo, hi = args.ph_hi;
#define IN(k) (lo <= (k) && (k) < hi)
#define BOTH(k) (IN(k) && IN((k) + 1))
#ifndef DUP_PHASE
#define DUP_PHASE (-1)
#endif
#define NREP(k) ((DUP_PHASE == (k)) ? 2 : 1)
    const int gw = F.vcu * NWAVES + F.wave, NGW = F.G * NWAVES;
    bf16* const WinT = (bf16*)(ws + WS_WIN); bf16* const WvT = (bf16*)(ws + WS_WV); bf16* const WkvT = (bf16*)(ws + WS_WKV); bf16* const WbrT = (bf16*)(ws + WS_WBR);
    bf16* const WoutT = (bf16*)(ws + WS_WOUT); bf16* const WqT = (bf16*)(ws + WS_WQ); bf16* const KEYS = (bf16*)(ws + WS_KEYS); bf16* const PWT = (bf16*)(ws + WS_PWT);
    bf16* const MEMN = (bf16*)(ws + WS_MEMN); bf16* const KMEM = (bf16*)(ws + WS_KMEM); bf16* const VTMEM = (bf16*)(ws + WS_VTMEM); float* const RSTDX = (float*)(ws + WS_RSTDX);
    const unsigned char* const U8 = ws + WS_U8; const unsigned char* const V8 = ws + WS_V8; const float* const SU = (const float*)(ws + WS_SU); const float* const SV = (const float*)(ws + WS_SV);
    bf16* const QN = (bf16*)(ws + WS_QN); bf16* const KN = (bf16*)(ws + WS_KN); bf16* const VT = (bf16*)(ws + WS_VT); bf16* const PP = (bf16*)(ws + WS_PP); bf16* const XQ = (bf16*)(ws + WS_XQ);
    bf16* const GATE = (bf16*)(ws + WS_GATE); bf16* const MERGED = (bf16*)(ws + WS_MERGED); bf16* const HB = (bf16*)(ws + WS_HB); bf16* const QB = (bf16*)(ws + WS_QB);
    int* const TE = (int*)(ws + WS_TE); float* const TW = (float*)(ws + WS_TW); float* const ROWSQ = (float*)(ws + WS_ROWSQ);
    bf16* const XB = (bf16*)((unsigned char*)args.out + OUT_XB); bf16* const YNA = (bf16*)((unsigned char*)args.out + OUT_YNA);
    bf16* const YPOOL = (bf16*)((unsigned char*)args.out + OUT_YPOOL); bf16* const YXA = (bf16*)((unsigned char*)args.out + OUT_YXA);

    if (IN(0)) { for (int rep = 0; rep < NREP(0); ++rep) { p0_prologue(F, args); if (rep + 1 < NREP(0)) GRID_BAR(); } if (BOTH(0)) GRID_BAR(); }

    if (IN(1)) {
      for (int rep = 0; rep < NREP(1); ++rep) {
        { pg8::Sched1 S; S.so.init(T, IN_MAIN, F.G, (int)blockIdx.x); S.A = (const char*)XB; S.Bt = (const char*)WinT; S.tstep = (size_t)256 * 1024 * 2;
          pg8::EpiProj E{RSTDX, QN, KN, PP, XQ, GATE, args.in[I_NAQG], args.in[I_NAKG], args.in[I_GATEB]};
          pg8::gemm_phase<pg8::EpiProj, pg8::Sched1, true, true>(F.lds + RING_OFF, 1024, S, E); }
        { pg8::Sched1 S; S.so.init(512, T, F.G, (int)blockIdx.x); S.A = (const char*)WvT; S.Bt = (const char*)XB; S.tstep = (size_t)256 * 1024 * 2;
          pg8::EpiVt E{RSTDX, VT};
          pg8::gemm_phase<pg8::EpiVt, pg8::Sched1, false, true>(F.lds + RING_OFF, 1024, S, E); }
        for (int t = gw; t < 512; t += NGW) memkv_tile(MEMN, WkvT, args.in[I_XAKG], args.in[I_XAQG], KMEM, VTMEM, t, F.lane);
        if (rep + 1 < NREP(1)) GRID_BAR();
      }
        if (BOTH(1)) GRID_BAR();
    }

    if (IN(2)) {
      for (int rep = 0; rep < NREP(2); ++rep) {
        LAS float* rpl = (LAS float*)(F.lds + RING_OFF + F.wave * 16384);
        for (int i = F.lane; i < 15 * 31; i += 64) rpl[i] = args.in[I_RPB][F.wave * 15 * 31 + i];
        LDS_WAIT(); asm volatile("" ::: "memory");
        for (int i = F.vcu; i < 256; i += F.G)
            for (int k = 0; k < 8; ++k) { const int idx = i * 8 + k, b = idx >> 9, r = (idx >> 2) & 127, jb = idx & 3; na_item(QN, KN, VT, rpl, YNA, b, r, jb, F.wave, F.lane); }
        for (int i = F.vcu; i < 256; i += F.G) pool_wg(PP, PWT, YPOOL, F.lds + RING_OFF, i * 128, F.wave, F.lane);
        { const int pair = F.vcu & 15, xb = pair >> 2, xh = pair & 3, slot = F.vcu >> 4, nslot = F.G >> 4;
          __syncthreads(); xa_fill_lds(KMEM, VTMEM, F.lds + RING_OFF, xb, xh, F.tid); __syncthreads();
          if (slot < nslot) for (int n = slot * NWAVES + F.wave; n < 512; n += nslot * NWAVES) xa_item(XQ, F.lds + RING_OFF, YXA, (xb * 512 + n) * 16, xh, F.lane);
          __syncthreads(); }
        if (rep + 1 < NREP(2)) GRID_BAR();
      }
        if (BOTH(2)) GRID_BAR();
    }

    if (IN(3)) {
      for (int rep = 0; rep < NREP(3); ++rep) {
        pg8::Sched3 S; S.so.init(T, D, F.G, (int)blockIdx.x); S.A = (const char*)YNA; S.Bt = (const char*)WbrT; S.tstep = (size_t)256 * 512 * 2; S.strideA = 32 * MiB; S.strideB = (size_t)1024 * 512 * 2;
        pg8::EpiMerge E{GATE, (bf16*)(ws + WS_VT)  , MERGED};
        pg8::gemm_phase<pg8::EpiMerge, pg8::Sched3, true, true>(F.lds + RING_OFF, 512, S, E);
        if (rep + 1 < NREP(3)) GRID_BAR();
      }
        if (BOTH(3)) GRID_BAR();
    }

    if (IN(4)) {
      for (int rep = 0; rep < NREP(4); ++rep) {
        pg8::Sched1 S; S.so.init(T, D, F.G, (int)blockIdx.x); S.A = (const char*)MERGED; S.Bt = (const char*)WoutT; S.tstep = (size_t)256 * 1024 * 2;
        pg8::EpiH E{args.in[I_X], F.out, HB, ROWSQ};
        pg8::gemm_phase<pg8::EpiH, pg8::Sched1, true, true>(F.lds + RING_OFF, 1024, S, E);
        if (rep + 1 < NREP(4)) { GRID_BAR(); for (int m = gw * 64 + F.lane; m < T; m += NGW * 64) ROWSQ[m] = 0.f; GRID_BAR(); }
      }
        if (BOTH(4)) GRID_BAR();
    }

    if (IN(5)) {
      for (int rep = 0; rep < NREP(5); ++rep) {
        pg8::Sched1 S; S.so.init(T, 2048, F.G, (int)blockIdx.x); S.A = (const char*)HB; S.Bt = (const char*)WqT; S.tstep = (size_t)256 * 1024 * 2;
        pg8::EpiQ E{ROWSQ, QB};
        pg8::gemm_phase<pg8::EpiQ, pg8::Sched1, true, true>(F.lds + RING_OFF, 1024, S, E);
        if (rep + 1 < NREP(5)) GRID_BAR();
      }
        if (BOTH(5)) GRID_BAR();
    }

    if (IN(6)) {
        LAS int* lscr = (LAS int*)(F.lds + RING_OFF + 65536 + F.wave * 8192);
        for (int tok = gw; tok < T; tok += NGW) hq_token(HB, ROWSQ, ws + WS_HQ, (float*)(ws + WS_HS), tok, F.lane);
        { const int th = F.vcu & 7, slot = F.vcu >> 3, nslot = F.G >> 3;
          __syncthreads(); topk_fill_lds(KEYS, F.lds + RING_OFF, th, F.tid); __syncthreads();
          for (int rep = 0; rep < NREP(6); ++rep) { for (int n = slot * NWAVES + F.wave; n < 2048; n += nslot * NWAVES) topk_item(QB, F.lds + RING_OFF, TE, TW, lscr, n * 16, th, F.lane); if (rep + 1 < NREP(6)) GRID_BAR(); }
          __syncthreads(); }
        if (BOTH(6)) GRID_BAR();
    }

    if (IN(7)) {
        const bool sliced = (F.G & 7) == 0;
        const int x0 = sliced ? ((int)blockIdx.x & 7) : 0, nxs = sliced ? 1 : 8, wrank = (sliced ? ((int)blockIdx.x >> 3) : (int)blockIdx.x) * NWAVES + F.wave, wstep = (sliced ? (F.G >> 3) : F.G) * NWAVES;
        LAS int* lst = (LAS int*)(F.lds + RING_OFF + F.wave * 16384);
        for (int xs = 0; xs < nxs; ++xs) { const int x = x0 + xs;
            for (int tok = wrank; tok < T; tok += wstep) peer_a_item(ws + WS_HQ, (const float*)(ws + WS_HS), U8, SU, SV, TE, TW, lst, tok, x, F.lane); }
        if (N_LAUNCHES != PER_PHASE) xcd_barrier(bar);
    }
    if (IN(8)) {
        const bool sliced = (F.G & 7) == 0;
        const int x0 = sliced ? ((int)blockIdx.x & 7) : 0, nxs = sliced ? 1 : 8, wrank = (sliced ? ((int)blockIdx.x >> 3) : (int)blockIdx.x) * NWAVES + F.wave, wstep = (sliced ? (F.G >> 3) : F.G) * NWAVES;
        for (int xs = 0; xs < nxs; ++xs) { const int x = x0 + xs;
            for (int tok = wrank; tok < T; tok += wstep) peer_b_item(V8 + (size_t)x * (2 * MiB), TE, TW, F.out, tok, x, F.lane); }
    }
#undef IN
#undef BOTH
#undef GRID_BAR
}

extern "C" void kernel_launch(void* const* d_in, const int* in_sizes, int n_in, void* d_out, int out_size, void* d_ws, size_t ws_size, hipStream_t stream) {
    static int grid = 0;
    if (grid == 0) {
        if (n_in != 23 || in_sizes[0] != T * D || out_size != T * D || ws_size < WS_END) { fprintf(stderr, "kernel_launch: unexpected shapes: n_in %d in0 %d out %d ws %zu\n", n_in, n_in > 0 ? in_sizes[0] : -1, out_size, ws_size); grid = -1; return; }
        int dev = 0, cus = 0, per_cu = 0;
        if (hipGetDevice(&dev) != hipSuccess || hipDeviceGetAttribute(&cus, hipDeviceAttributeMultiprocessorCount, dev) != hipSuccess) { fprintf(stderr, "kernel_launch: device query failed\n"); grid = -1; return; }
        if (hipFuncSetAttribute((const void*)mk_fwd, hipFuncAttributeMaxDynamicSharedMemorySize, LDS_BYTES) != hipSuccess) { fprintf(stderr, "kernel_launch: hipFuncSetAttribute failed\n"); grid = -1; return; }
        if (hipOccupancyMaxActiveBlocksPerMultiprocessor(&per_cu, (const void*)mk_fwd, NWAVES * 64, LDS_BYTES) != hipSuccess || per_cu < 1)
            fprintf(stderr, "kernel_launch: note: occupancy query reports %d workgroups per CU\n", per_cu);
        (void)hipGetLastError();
        grid = cus;
    }
    if (grid < 0) return;
    if (hipMemsetAsync((char*)d_ws + WS_CTL, 0, CTL_ZERO_BYTES, stream) != hipSuccess) { fprintf(stderr, "kernel_launch: memset failed\n"); return; }
    Args a{};
    for (int i = 0; i < 23; ++i) a.in[i] = (const float*)d_in[i];
    a.out = (float*)d_out; a.ws = (unsigned char*)d_ws;
    for (int li = 0; li < N_LAUNCHES; ++li) {
        a.ph_lo = (N_LAUNCHES == PER_PHASE) ? li : 0; a.ph_hi = (N_LAUNCHES == PER_PHASE) ? li + 1 : PER_PHASE;
        hipLaunchKernelGGL(mk_fwd, dim3(grid), dim3(NWAVES * 64), LDS_BYTES, stream, a);
#ifdef HOST_DUP_PHASE
        if (N_LAUNCHES == PER_PHASE && li == HOST_DUP_PHASE) { if (li == 4) (void)hipMemsetAsync((char*)d_ws + WS_ROWSQ, 0, (size_t)T * 4, stream); hipLaunchKernelGGL(mk_fwd, dim3(grid), dim3(NWAVES * 64), LDS_BYTES, stream, a); }
#endif
        const hipError_t le = hipPeekAtLastError();
        if (le != hipSuccess) { fprintf(stderr, "kernel_launch: launch %d failed: %s\n", li, hipGetErrorName(le)); break; }
    }
}
```

```cpp
#define MK_N_LAUNCHES 1
#include <hip/hip_runtime.h>
#include <cstdio>
#include <cstdint>

#ifndef MK_N_LAUNCHES
#define MK_N_LAUNCHES 1
#endif

namespace pg8 {
#define PG8_LAS __attribute__((address_space(3)))
typedef unsigned short bf16_t;
typedef short bf16x8 __attribute__((ext_vector_type(8)));
typedef float f32x4 __attribute__((ext_vector_type(4)));
typedef unsigned u32x4 __attribute__((ext_vector_type(4)));
typedef unsigned u32x2 __attribute__((ext_vector_type(2)));
constexpr int BM = 256, BK = 64, HALF = 128, HTB = HALF * BK * 2  , STAGE_BYTES = 8 * HTB, NXCD = 8, WGM = 8;

__host__ __device__ __forceinline__ int lds_byte(int r, int c) { const int st = (r >> 4) * 2 + (c >> 5), rr = r & 15, cc = c & 31, ob = rr * 64 + cc * 2; return st * 1024 + (ob ^ (((ob >> 9) & 1) << 5)); }
__host__ __device__ __forceinline__ void stage_rc(int b, int& R, int& C) { const int st = b / 1024, sb = b % 1024, swz = sb ^ (((sb >> 9) & 1) << 5); R = (st >> 1) * 16 + swz / 64; C = (st & 1) * 32 + (swz % 64) / 2; }
__host__ __device__ __forceinline__ int perm32(int rho) { const int n = rho >> 4, i = rho & 15; return 8 * (i >> 2) + 4 * n + (i & 3); }

struct Unit { int pm, pn, br; };

struct StaticOrder {
    int nM, nN, nwg, G, c;
    __host__ __device__ void init(int M, int N, int G_, int c_) { nM = M / BM; nN = N / BM; nwg = nM * nN; G = G_; c = c_; }
    __host__ __device__ bool next(int i, Unit& u) const {
        const long L = (long)i * G + c; if (L >= nwg) return false;
        int wgid = (int)L; { const int q = nwg / NXCD, r = nwg % NXCD, xcd = wgid % NXCD, off = wgid / NXCD; wgid = (xcd < r ? xcd * (q + 1) : r * (q + 1) + (xcd - r) * q) + off; }
        const int nig = WGM * nN, gid = wgid / nig, fm = gid * WGM, gsz = (nM - fm) < WGM ? (nM - fm) : WGM;
        u.pm = fm + ((wgid % nig) % gsz); u.pn = (wgid % nig) / gsz; return true;
    }
};
struct Sched1 {
    StaticOrder so; const char* A; const char* Bt; size_t tstep;
    __device__ __forceinline__ bool next(int i, Unit& u) const { u.br = 0; return so.next(i, u); }
    __device__ __forceinline__ const char* abase(const Unit& u) const { return A + (size_t)u.pm * tstep; }
    __device__ __forceinline__ const char* bbase(const Unit& u) const { return Bt + (size_t)u.pn * tstep; }
    __device__ __forceinline__ void a_ready(const Unit&) const {}
    __device__ __forceinline__ void done(const Unit&) const {}
};
struct Sched3 {
    StaticOrder so; const char* A; const char* Bt; size_t tstep, strideA, strideB;
    __device__ __forceinline__ bool next(int i, Unit& u) const { u.br = i % 3; return so.next(i / 3, u); }
    __device__ __forceinline__ const char* abase(const Unit& u) const { return A + (size_t)u.br * strideA + (size_t)u.pm * tstep; }
    __device__ __forceinline__ const char* bbase(const Unit& u) const { return Bt + (size_t)u.br * strideB + (size_t)u.pn * tstep; }
    __device__ __forceinline__ void a_ready(const Unit&) const {}
    __device__ __forceinline__ void done(const Unit&) const {}
};

typedef float f32x2_t __attribute__((ext_vector_type(2))); typedef __bf16 bf16x2v_t __attribute__((ext_vector_type(2)));
__device__ __forceinline__ unsigned cvt_pk_bf16(float lo, float hi) { const f32x2_t v = {lo, hi}; const bf16x2v_t b = __builtin_convertvector(v, bf16x2v_t); return __builtin_bit_cast(unsigned, b); }
__device__ __forceinline__ u32x4 pack8(const f32x4 a, const f32x4 b) { u32x4 w; w.x = cvt_pk_bf16(a[0], a[1]); w.y = cvt_pk_bf16(a[2], a[3]); w.z = cvt_pk_bf16(b[0], b[1]); w.w = cvt_pk_bf16(b[2], b[3]); return w; }
__device__ __forceinline__ float bflo(unsigned u) { return __builtin_bit_cast(float, u << 16); }
__device__ __forceinline__ float bfhi(unsigned u) { return __builtin_bit_cast(float, u & 0xffff0000u); }


constexpr float RMS_EPS = 1e-6f;

struct EpiProj {
    static constexpr bool PERM = true, AFTER_DRAIN = false;
    const float* rstd; bf16_t *qn, *kn, *pp, *xq, *gates; const float *qg, *kg, *gate_b;
    __device__ __forceinline__ void operator()(const f32x4 (&acc)[2][2][4][2], const Unit& u, int wr, int wc, int fr, int fq) const {
        const int pn = u.pn, row0 = u.pm * BM + wr * 64 + fr, lc0 = 64 * wc + 8 * fq;
        if (pn < 4) {
            const bool isq = pn < 2; bf16_t* O = isq ? qn : kn; const float* g = isq ? qg : kg; const float post = isq ? 0.125f : 1.0f;
            f32x4 gv[2][2];
#pragma unroll
            for (int bj = 0; bj < 2; ++bj)
#pragma unroll
                for (int n = 0; n < 2; ++n) gv[bj][n] = *(const f32x4*)(g + 32 * bj + 8 * fq + 4 * n);
            const int colbase = (pn & 1) * 256 + lc0;
#pragma unroll
            for (int ai = 0; ai < 2; ++ai)
#pragma unroll
                for (int m = 0; m < 4; ++m) {
                    const int row = row0 + ai * HALF + m * 16; const float rs = rstd[row];
                    f32x4 v[2][2]; float ss = 0.f;
#pragma unroll
                    for (int bj = 0; bj < 2; ++bj)
#pragma unroll
                        for (int n = 0; n < 2; ++n) { v[bj][n] = acc[ai][bj][m][n] * rs; ss += (v[bj][n][0] * v[bj][n][0] + v[bj][n][1] * v[bj][n][1]) + (v[bj][n][2] * v[bj][n][2] + v[bj][n][3] * v[bj][n][3]); }
                    ss += __shfl_xor(ss, 16); ss += __shfl_xor(ss, 32);
                    const float r = rsqrtf(ss * (1.0f / 64.0f) + RMS_EPS) * post;
#pragma unroll
                    for (int bj = 0; bj < 2; ++bj) *(u32x4*)(O + (size_t)row * 512 + colbase + 32 * bj) = pack8(v[bj][0] * r * gv[bj][0], v[bj][1] * r * gv[bj][1]);
                }
        } else if (pn < 8) {
            bf16_t* O = pn < 6 ? pp : xq; const int colbase = (pn & 1) * 256 + lc0;
#pragma unroll
            for (int ai = 0; ai < 2; ++ai)
#pragma unroll
                for (int m = 0; m < 4; ++m) {
                    const int row = row0 + ai * HALF + m * 16; const float rs = rstd[row];
#pragma unroll
                    for (int bj = 0; bj < 2; ++bj) *(u32x4*)(O + (size_t)row * 512 + colbase + 32 * bj) = pack8(acc[ai][bj][m][0] * rs, acc[ai][bj][m][1] * rs);
                }
        } else {
            const int gcol0 = (pn - 8) * 256 + lc0;
            f32x4 bv[2][2];
#pragma unroll
            for (int bj = 0; bj < 2; ++bj)
#pragma unroll
                for (int n = 0; n < 2; ++n) bv[bj][n] = *(const f32x4*)(gate_b + gcol0 + 32 * bj + 4 * n);
#pragma unroll
            for (int ai = 0; ai < 2; ++ai)
#pragma unroll
                for (int m = 0; m < 4; ++m) {
                    const int row = row0 + ai * HALF + m * 16; const float rs = rstd[row];
#pragma unroll
                    for (int bj = 0; bj < 2; ++bj) {
                        f32x4 o[2];
#pragma unroll
                        for (int n = 0; n < 2; ++n) { const f32x4 z = acc[ai][bj][m][n] * rs + bv[bj][n];
#pragma unroll
                            for (int i = 0; i < 4; ++i) o[n][i] = __builtin_amdgcn_rcpf(1.0f + __expf(-z[i])); }
                        *(u32x4*)(gates + (size_t)row * 3072 + gcol0 + 32 * bj) = pack8(o[0], o[1]);
                    }
                }
        }
    }
};
struct EpiVt {
    static constexpr bool PERM = true, AFTER_DRAIN = false;
    const float* rstd; bf16_t* Vt;
    __device__ __forceinline__ void operator()(const f32x4 (&acc)[2][2][4][2], const Unit& u, int wr, int wc, int fr, int fq) const {
        const int ch0 = u.pm * BM + wr * 64 + fr, tok0 = u.pn * BM + wc * 32 + 8 * fq, b = tok0 >> 13, t0 = tok0 & 8191;
        f32x4 rv[2][2];
#pragma unroll
        for (int bj = 0; bj < 2; ++bj)
#pragma unroll
            for (int n = 0; n < 2; ++n) rv[bj][n] = *(const f32x4*)(rstd + tok0 + bj * HALF + 4 * n);
#pragma unroll
        for (int ai = 0; ai < 2; ++ai)
#pragma unroll
            for (int m = 0; m < 4; ++m) { const int ch = ch0 + ai * HALF + m * 16; bf16_t* rowp = Vt + ((size_t)(b * 512 + ch) * 8192 + t0);
#pragma unroll
                for (int bj = 0; bj < 2; ++bj) *(u32x4*)(rowp + bj * HALF) = pack8(acc[ai][bj][m][0] * rv[bj][0], acc[ai][bj][m][1] * rv[bj][1]); }
    }
};
struct EpiMerge {
    static constexpr bool PERM = true, AFTER_DRAIN = false;
    const bf16_t* gates; bf16_t* pa; bf16_t* merged;
    __device__ __forceinline__ void operator()(const f32x4 (&acc)[2][2][4][2], const Unit& u, int wr, int wc, int fr, int fq) const {
        const int row0 = u.pm * BM + wr * 64 + fr, col0 = u.pn * BM + wc * 32 + 8 * fq, br = u.br;
        const bf16_t* src = br == 1 ? pa : merged; bf16_t* dst = br == 0 ? pa : merged;
#pragma unroll
        for (int ai = 0; ai < 2; ++ai)
#pragma unroll
            for (int m = 0; m < 4; ++m) { const int row = row0 + ai * HALF + m * 16;
#pragma unroll
                for (int bj = 0; bj < 2; ++bj) {
                    const u32x4 g8 = *(const u32x4*)(gates + (size_t)row * 3072 + br * 1024 + col0 + bj * HALF);
                    const size_t mo = (size_t)row * 1024 + col0 + bj * HALF;
                    f32x4 a = acc[ai][bj][m][0], b = acc[ai][bj][m][1];
                    a[0] *= bflo(g8.x); a[1] *= bfhi(g8.x); a[2] *= bflo(g8.y); a[3] *= bfhi(g8.y); b[0] *= bflo(g8.z); b[1] *= bfhi(g8.z); b[2] *= bflo(g8.w); b[3] *= bfhi(g8.w);
                    if (br > 0) { const u32x4 p8 = *(const u32x4*)(src + mo);
                        a[0] += bflo(p8.x); a[1] += bfhi(p8.x); a[2] += bflo(p8.y); a[3] += bfhi(p8.y); b[0] += bflo(p8.z); b[1] += bfhi(p8.z); b[2] += bflo(p8.w); b[3] += bfhi(p8.w); }
                    *(u32x4*)(dst + mo) = pack8(a, b);
                } }
    }
};
struct EpiH {
    static constexpr bool PERM = true, AFTER_DRAIN = false;
    const float* x; float* out; bf16_t* hb; float* rowsq;
    __device__ __forceinline__ void operator()(const f32x4 (&acc)[2][2][4][2], const Unit& u, int wr, int wc, int fr, int fq) const {
        const int row0 = u.pm * BM + wr * 64 + fr, col0 = u.pn * BM + wc * 32 + 8 * fq;
#pragma unroll
        for (int ai = 0; ai < 2; ++ai)
#pragma unroll
            for (int m = 0; m < 4; ++m) { const int row = row0 + ai * HALF + m * 16; float ss = 0.f;
#pragma unroll
                for (int bj = 0; bj < 2; ++bj) { const size_t o = (size_t)row * 1024 + col0 + bj * HALF;
                    const f32x4 h0 = *(const f32x4*)(x + o) + acc[ai][bj][m][0], h1 = *(const f32x4*)(x + o + 4) + acc[ai][bj][m][1];
                    *(f32x4*)(out + o) = h0; *(f32x4*)(out + o + 4) = h1; *(u32x4*)(hb + o) = pack8(h0, h1);
                    ss += (h0[0] * h0[0] + h0[1] * h0[1]) + (h0[2] * h0[2] + h0[3] * h0[3]) + (h1[0] * h1[0] + h1[1] * h1[1]) + (h1[2] * h1[2] + h1[3] * h1[3]); }
                ss += __shfl_xor(ss, 16); ss += __shfl_xor(ss, 32);
                if (fq == 0) atomicAdd(rowsq + row, ss); }
    }
};
struct EpiQ {
    static constexpr bool PERM = true, AFTER_DRAIN = false;
    const float* rowsq; bf16_t* qb;
    __device__ __forceinline__ void operator()(const f32x4 (&acc)[2][2][4][2], const Unit& u, int wr, int wc, int fr, int fq) const {
        const int row0 = u.pm * BM + wr * 64 + fr, col0 = u.pn * BM + wc * 32 + 8 * fq;
#pragma unroll
        for (int ai = 0; ai < 2; ++ai)
#pragma unroll
            for (int m = 0; m < 4; ++m) { const int row = row0 + ai * HALF + m * 16; const float r = rsqrtf(rowsq[row] * (1.0f / 1024.0f) + RMS_EPS);
#pragma unroll
                for (int bj = 0; bj < 2; ++bj) *(u32x4*)(qb + (size_t)row * 2048 + col0 + bj * HALF) = pack8(acc[ai][bj][m][0] * r, acc[ai][bj][m][1] * r); }
    }
};

template <class Epi, class Sched, bool ALIGN_EPI = false, bool SP2 = false>
__device__ __forceinline__ void gemm_phase(PG8_LAS unsigned char* lds, const int K, const Sched& S, const Epi& E) {
    const int tid = threadIdx.x, wid = __builtin_amdgcn_readfirstlane(tid >> 6), lane = tid & 63, wr = wid >> 2, wc = wid & 3, fr = lane & 15, fq = lane >> 4;
    const int nt = K / BK;
    unsigned voffA[2], voffB[2];
#pragma unroll
    for (int i = 0; i < 2; ++i) { int R, C; stage_rc(tid * 16 + i * 8192, R, C); const int Rb = Epi::PERM ? ((R & ~31) + perm32(R & 31)) : R;
        voffA[i] = (unsigned)(R * K + C) * 2u; voffB[i] = (unsigned)(Rb * K + C) * 2u; }
    const size_t kstep = (size_t)(BK * 2);
    const size_t hstep = (size_t)HALF * K * 2;
    const size_t tstep = 2 * hstep;
    const unsigned ldsw = (unsigned)wid * 1024u;
    const int aoff = lds_byte(wr * 64 + fr, fq * 8), boff = lds_byte(wc * 32 + fr, fq * 8);
#define PG8_SA(b, h) (((b) * 2 + (h)) * HTB)
#define PG8_SB(b, h) ((4 + (b) * 2 + (h)) * HTB)
#define PG8_STAGE(bufoff, gbase, voff) do { _Pragma("unroll") for (int _i = 0; _i < 2; ++_i) \
        __builtin_amdgcn_global_load_lds((const unsigned*)((const char*)(gbase) + (voff)[_i]), (PG8_LAS unsigned*)(lds + (bufoff) + ldsw + _i * 8192), 16, 0, 0); } while (0)
#define PG8_LDA(dst, b, h) do { _Pragma("unroll") for (int m = 0; m < 4; ++m) _Pragma("unroll") for (int k = 0; k < 2; ++k) dst[m][k] = *(const PG8_LAS bf16x8*)(lds + PG8_SA(b, h) + aoff + m * 2048 + k * 1024); } while (0)
#define PG8_LDB(dst, b, h) do { _Pragma("unroll") for (int n = 0; n < 2; ++n) _Pragma("unroll") for (int k = 0; k < 2; ++k) dst[n][k] = *(const PG8_LAS bf16x8*)(lds + PG8_SB(b, h) + boff + n * 2048 + k * 1024); } while (0)
#define PG8_MMA(ai, bj, At, Bt) do { __builtin_amdgcn_s_setprio(1); _Pragma("unroll") for (int m = 0; m < 4; ++m) _Pragma("unroll") for (int n = 0; n < 2; ++n) _Pragma("unroll") for (int k = 0; k < 2; ++k) \
        acc[ai][bj][m][n] = __builtin_amdgcn_mfma_f32_16x16x32_bf16(Bt[n][k], At[m][k], acc[ai][bj][m][n], 0, 0, 0); __builtin_amdgcn_s_setprio(0); } while (0)
#define PG8_WAIT_V(n) asm volatile("s_waitcnt vmcnt(" #n ")" ::: "memory")
#define PG8_WAIT_L(n) asm volatile("s_waitcnt lgkmcnt(" #n ")" ::: "memory")
#define PG8_BAR __builtin_amdgcn_s_barrier()
#define PG8_SCHED __builtin_amdgcn_sched_barrier(0)
    Unit cur, nxt; int ui = 0;
    if (!S.next(0, cur)) return;
    f32x4 acc[2][2][4][2];
#pragma unroll
    for (int a = 0; a < 2; ++a)
#pragma unroll
        for (int b = 0; b < 2; ++b)
#pragma unroll
            for (int m = 0; m < 4; ++m)
#pragma unroll
                for (int n = 0; n < 2; ++n) acc[a][b][m][n] = (f32x4){0.f, 0.f, 0.f, 0.f};
    bf16x8 At[4][2], B0[2][2], B1[2][2];
    const char* cA = S.abase(cur); const char* cB = S.bbase(cur);
    S.a_ready(cur);
    if constexpr (SP2) {
        PG8_STAGE(PG8_SB(0, 0), cB, voffB); PG8_STAGE(PG8_SB(0, 1), cB + hstep, voffB); PG8_STAGE(PG8_SA(0, 0), cA, voffA); PG8_STAGE(PG8_SA(0, 1), cA + hstep, voffA);
        if (wr == 1) PG8_BAR;
        PG8_WAIT_V(2); PG8_BAR;
        PG8_STAGE(PG8_SB(1, 0), cB + kstep, voffB); PG8_STAGE(PG8_SA(1, 0), cA + kstep, voffA); PG8_STAGE(PG8_SB(1, 1), cB + hstep + kstep, voffB);
        PG8_WAIT_V(6); PG8_BAR;
    } else {
        PG8_STAGE(PG8_SB(0, 0), cB, voffB); PG8_STAGE(PG8_SA(0, 0), cA, voffA); PG8_STAGE(PG8_SB(0, 1), cB + hstep, voffB); PG8_STAGE(PG8_SA(0, 1), cA + hstep, voffA);
        if (wr == 1) PG8_BAR;
        PG8_WAIT_V(4); PG8_BAR;
        PG8_STAGE(PG8_SB(1, 0), cB + kstep, voffB); PG8_STAGE(PG8_SA(1, 0), cA + kstep, voffA); PG8_STAGE(PG8_SB(1, 1), cB + hstep + kstep, voffB);
        PG8_WAIT_V(6); PG8_BAR;
    }
    for (;;) {
        const bool has_next = S.next(ui + 1, nxt);
        const char* nA = has_next ? S.abase(nxt) : cA; const char* nB = has_next ? S.bbase(nxt) : cB;
        for (int t = 0; t < nt; t += 2) {
            const bool last = (t == nt - 2);
            const char* a1 = cA + (size_t)(t + 1) * kstep;
            const char* a2 = last ? nA : cA + (size_t)(t + 2) * kstep; const char* b2 = last ? nB : cB + (size_t)(t + 2) * kstep;
            const char* a3 = a2 + kstep; const char* b3 = b2 + kstep;
            if (last && has_next) S.a_ready(nxt);
            if constexpr (SP2) {
            PG8_LDB(B0, 0, 0); PG8_LDB(B1, 0, 1); PG8_SCHED; PG8_LDA(At, 0, 0); PG8_STAGE(PG8_SA(1, 1), a1 + hstep, voffA);
            PG8_WAIT_V(8); PG8_WAIT_L(0); PG8_BAR; PG8_MMA(0, 0, At, B0); PG8_MMA(0, 1, At, B1); PG8_BAR; PG8_SCHED;
            PG8_LDA(At, 0, 1); PG8_STAGE(PG8_SB(0, 0), b2, voffB); PG8_STAGE(PG8_SB(0, 1), b2 + hstep, voffB); PG8_STAGE(PG8_SA(0, 0), a2, voffA);
            PG8_WAIT_V(8); PG8_WAIT_L(0); PG8_BAR; PG8_MMA(1, 0, At, B0); PG8_MMA(1, 1, At, B1); PG8_BAR; PG8_SCHED;
            PG8_LDB(B0, 1, 0); PG8_LDB(B1, 1, 1); PG8_SCHED; PG8_LDA(At, 1, 0); PG8_STAGE(PG8_SA(0, 1), a2 + hstep, voffA);
            PG8_WAIT_V(8); PG8_WAIT_L(0); PG8_BAR; PG8_MMA(0, 0, At, B0); PG8_MMA(0, 1, At, B1); PG8_BAR; PG8_SCHED;
            PG8_LDA(At, 1, 1); PG8_STAGE(PG8_SB(1, 0), b3, voffB); PG8_STAGE(PG8_SB(1, 1), b3 + hstep, voffB); PG8_STAGE(PG8_SA(1, 0), a3, voffA);
            PG8_WAIT_V(8); PG8_WAIT_L(0); PG8_BAR; PG8_MMA(1, 0, At, B0); PG8_MMA(1, 1, At, B1); PG8_BAR; PG8_SCHED;
            } else {
            PG8_LDB(B0, 0, 0); PG8_SCHED; PG8_LDA(At, 0, 0); PG8_STAGE(PG8_SA(1, 1), a1 + hstep, voffA);
            PG8_WAIT_L(8); PG8_BAR; PG8_WAIT_L(0); PG8_MMA(0, 0, At, B0); PG8_BAR; PG8_SCHED;
            PG8_LDB(B1, 0, 1); PG8_STAGE(PG8_SB(0, 0), b2, voffB);
            PG8_BAR; PG8_WAIT_L(0); PG8_MMA(0, 1, At, B1); PG8_BAR;
            PG8_LDA(At, 0, 1); PG8_STAGE(PG8_SA(0, 0), a2, voffA);
            PG8_BAR; PG8_WAIT_L(0); PG8_MMA(1, 0, At, B0); PG8_BAR; PG8_SCHED;
            PG8_STAGE(PG8_SB(0, 1), b2 + hstep, voffB);
            PG8_WAIT_V(6); PG8_BAR; PG8_MMA(1, 1, At, B1); PG8_BAR;
            PG8_LDB(B0, 1, 0); PG8_SCHED; PG8_LDA(At, 1, 0); PG8_STAGE(PG8_SA(0, 1), a2 + hstep, voffA);
            PG8_WAIT_L(8); PG8_BAR; PG8_WAIT_L(0); PG8_MMA(0, 0, At, B0); PG8_BAR; PG8_SCHED;
            PG8_LDB(B1, 1, 1); PG8_STAGE(PG8_SB(1, 0), b3, voffB);
            PG8_BAR; PG8_WAIT_L(0); PG8_MMA(0, 1, At, B1); PG8_BAR;
            PG8_LDA(At, 1, 1); PG8_STAGE(PG8_SA(1, 0), a3, voffA);
            PG8_BAR; PG8_WAIT_L(0); PG8_MMA(1, 0, At, B0); PG8_BAR; PG8_SCHED;
            PG8_STAGE(PG8_SB(1, 1), b3 + hstep, voffB);
            PG8_WAIT_V(6); PG8_BAR; PG8_MMA(1, 1, At, B1); PG8_BAR;
            }
        }
        if constexpr (ALIGN_EPI) { if (wr == 0) PG8_BAR; }
        if constexpr (!Epi::AFTER_DRAIN) { E(acc, cur, wr, wc, fr, fq); S.done(cur); }
        if (!has_next) break;
#pragma unroll
        for (int a = 0; a < 2; ++a)
#pragma unroll
            for (int b = 0; b < 2; ++b)
#pragma unroll
                for (int m = 0; m < 4; ++m)
#pragma unroll
                    for (int n = 0; n < 2; ++n) acc[a][b][m][n] = (f32x4){0.f, 0.f, 0.f, 0.f};
        cur = nxt; cA = nA; cB = nB; ++ui;
        if constexpr (ALIGN_EPI) { if (wr == 1) PG8_BAR; }
    }
    PG8_WAIT_V(0);
    if constexpr (!ALIGN_EPI) { if (wr == 0) PG8_BAR; }
    PG8_BAR;
    if constexpr (Epi::AFTER_DRAIN) { E.fused(acc, cur, wr, wc, fr, fq, lds, wid, lane); S.done(cur); }
#undef PG8_SA
#undef PG8_SB
#undef PG8_STAGE
#undef PG8_LDA
#undef PG8_LDB
#undef PG8_MMA
#undef PG8_WAIT_V
#undef PG8_WAIT_L
#undef PG8_BAR
#undef PG8_SCHED
}
}

constexpr int NWAVES = 8;
constexpr int N_LAUNCHES = MK_N_LAUNCHES;
constexpr int PER_PHASE = 9;
constexpr int NBATCH = 4, SEQ = 8192, D = 1024, T = NBATCH * SEQ, MEMLEN = 256, NMEMTOK = NBATCH * MEMLEN;
constexpr int IN_MAIN = 5120;
constexpr int NEXP = 16384;

constexpr size_t MiB = 1u << 20;
constexpr size_t WS_CTL = 0, CTL_ZERO_BYTES = 512 * 1024;
constexpr size_t WS_ROWSQ = 256 * 1024;
constexpr size_t WS_WIN = 1 * MiB, WS_WV = 11 * MiB, WS_WKV = 12 * MiB, WS_WBR = 14 * MiB, WS_WOUT = 17 * MiB, WS_WQ = 19 * MiB, WS_KEYS = 23 * MiB, WS_PWT = 23 * MiB + 512 * 1024;
constexpr size_t WS_MEMN = 24 * MiB, WS_KMEM = 26 * MiB, WS_VTMEM = 27 * MiB, WS_RSTDX = 28 * MiB, WS_SU = 28 * MiB + 256 * 1024  , WS_SV = 28 * MiB + 512 * 1024  ;
constexpr size_t WS_U8 = 32 * MiB, WS_V8 = 48 * MiB;
constexpr size_t WS_QN = 96 * MiB, WS_KN = 128 * MiB, WS_VT = 160 * MiB, WS_PP = 192 * MiB, WS_XQ = 224 * MiB, WS_GATE = 256 * MiB, WS_END = 448 * MiB;
constexpr size_t WS_MERGED = WS_QN;
constexpr size_t WS_HB = WS_VT;
constexpr size_t WS_QB = WS_GATE;
constexpr size_t WS_TE = WS_GATE + 128 * MiB, WS_TW = WS_TE + 16 * MiB;
constexpr size_t WS_HQ = WS_TW + 16 * MiB;
constexpr size_t WS_HS = 28 * MiB + 768 * 1024;
constexpr size_t WS_AW = WS_MERGED;
constexpr size_t OUT_XB = 0, OUT_YNA = 0, OUT_YPOOL = 32 * MiB, OUT_YXA = 64 * MiB;
constexpr int CW_TMO = 0, CW_BAR = 4096, CW_TICKET = 8192;

constexpr int RING_OFF = 0, RING_BYTES = 131072;
constexpr int LDSCTL_OFF = RING_BYTES, MISC_OFF = LDSCTL_OFF + 320;
constexpr int LDS_BYTES = 147456;

#define GAS __attribute__((address_space(1)))
#define LAS __attribute__((address_space(3)))
typedef unsigned short bf16;
typedef unsigned v4u __attribute__((ext_vector_type(4)));
typedef unsigned v2u __attribute__((ext_vector_type(2)));
typedef float f32x4 __attribute__((ext_vector_type(4)));
typedef short bf16x8 __attribute__((ext_vector_type(8)));
typedef __bf16 bf16x2_t __attribute__((ext_vector_type(2)));
typedef GAS unsigned gu32;
#define LDS_WAIT() asm volatile("s_waitcnt lgkmcnt(0)" ::: "memory")
#define VM_WAIT() asm volatile("s_waitcnt vmcnt(0)" ::: "memory")
__device__ __forceinline__ unsigned f2bf(float f) { unsigned u = __builtin_bit_cast(unsigned, f); return (u + 0x7fffu + ((u >> 16) & 1u)) >> 16; }
__device__ __forceinline__ unsigned pk2(float lo, float hi) { return f2bf(lo) | (f2bf(hi) << 16); }
__device__ __forceinline__ float bflo(unsigned u) { return __builtin_bit_cast(float, u << 16); }
__device__ __forceinline__ float bfhi(unsigned u) { return __builtin_bit_cast(float, u & 0xffff0000u); }
__device__ __forceinline__ float bf1(short s) { return __builtin_bit_cast(float, ((unsigned)(unsigned short)s) << 16); }
__device__ __forceinline__ f32x4 mfma16(bf16x8 a, bf16x8 b, f32x4 c) { return __builtin_amdgcn_mfma_f32_16x16x32_bf16(a, b, c, 0, 0, 0); }
__device__ __forceinline__ float wave_sum(float v) {
#pragma unroll
    for (int o = 1; o < 64; o <<= 1) v += __shfl_xor(v, o);
    return v;
}

#define XB_TMO      128
#define XB_XCNT(j)  (256  + 64 * (j))
#define XB_XSUB(j)  (1280 + 64 * (j))
#define XB_XGEN(j)  (2304 + 64 * (j))
#define XB_TOP      3328
#define XB_TOPGEN   3392
#define XCD_BAR_WORDS 3456
#define XB_SPIN_CAP (1u << 18)

__device__ __forceinline__ unsigned xb_ld(unsigned* p)              { return __hip_atomic_load(p, __ATOMIC_RELAXED, __HIP_MEMORY_SCOPE_AGENT); }
__device__ __forceinline__ unsigned xb_add(unsigned* p, unsigned v) { return __hip_atomic_fetch_add(p, v, __ATOMIC_RELAXED, __HIP_MEMORY_SCOPE_AGENT); }
__device__ __forceinline__ unsigned xb_xcc_id() { return (unsigned)__builtin_amdgcn_s_getreg((3 << 11) | 20) & 0xFu; }
#define XB_SPIN(cond, bar) do { unsigned _sp = 0; while (cond) { __builtin_amdgcn_s_sleep(1); \
    if ((++_sp & 255u) == 0u) { if (xb_ld(&(bar)[XB_TMO])) break; if (_sp > XB_SPIN_CAP) { atomicAdd(&(bar)[XB_TMO], 1u); break; } } } } while (0)

struct XcdBarrier {
    unsigned* bar; unsigned x;
    volatile LAS unsigned* st;
};

__device__ __forceinline__ XcdBarrier xcd_barrier_post(unsigned* bar, volatile LAS unsigned* st) {
    XcdBarrier b; b.bar = bar; b.x = xb_xcc_id(); b.st = st;
    if (threadIdx.x == 0) (void)xb_add(&bar[XB_XCNT(b.x)], 1u);
    return b;
}
__device__ __forceinline__ void xcd_barrier_complete(unsigned* bar, unsigned x, unsigned& nloc, unsigned& nx) {
    const unsigned G = gridDim.x * gridDim.y * gridDim.z;
    unsigned sum, cnt, mine, sp = 0u;
    for (;;) {
        sum = 0u; cnt = 0u; mine = 0u;
#pragma unroll
        for (unsigned j = 0; j < 16; ++j) { const unsigned c = xb_ld(&bar[XB_XCNT(j)]); sum += c; cnt += (c > 0u) ? 1u : 0u; mine = (j == x) ? c : mine; }
        if (sum == G) break;
        __builtin_amdgcn_s_sleep(1);
        if ((++sp & 255u) == 0u) { if (xb_ld(&bar[XB_TMO])) break; if (sp > XB_SPIN_CAP) { atomicAdd(&bar[XB_TMO], 1u); break; } }
    }
    nloc = mine > 0u ? mine : 1u; nx = cnt > 0u ? cnt : 1u;
}

__device__ __forceinline__ void xcd_barrier(const XcdBarrier& b) {
    asm volatile("s_waitcnt vmcnt(0)" ::: "memory");
    __syncthreads();
    if (threadIdx.x == 0) {
        unsigned* bar = b.bar;
        __builtin_amdgcn_s_waitcnt(0);
        unsigned nloc = b.st[0], nx = b.st[1];
        if (nloc == 0u) { xcd_barrier_complete(bar, b.x, nloc, nx); b.st[0] = nloc; b.st[1] = nx; }
        const unsigned old = xb_add(&bar[XB_XSUB(b.x)], 1u);
        const unsigned gen = old / nloc;
        if (old + 1u == (gen + 1u) * nloc) {
            __builtin_amdgcn_fence(__ATOMIC_RELEASE, "agent");
            asm volatile("s_waitcnt vmcnt(0)" ::: "memory");
            const unsigned og = xb_add(&bar[XB_TOP], 1u);
            const unsigned tg = og / nx;
            if (og + 1u == (tg + 1u) * nx) xb_add(&bar[XB_TOPGEN], 1u);
            else XB_SPIN(xb_ld(&bar[XB_TOPGEN]) == tg, bar);
            __builtin_amdgcn_fence(__ATOMIC_ACQUIRE, "agent");
            xb_add(&bar[XB_XGEN(b.x)], 1u);
            asm volatile("s_waitcnt vmcnt(0)" ::: "memory");
        } else {
            XB_SPIN(xb_ld(&bar[XB_XGEN(b.x)]) == gen, bar);
            __builtin_amdgcn_fence(__ATOMIC_ACQUIRE, "agent");
            asm volatile("s_waitcnt vmcnt(0)" ::: "memory");
        }
    }
    __syncthreads();
}

struct Frame {
    LAS unsigned char* lds;
    volatile LAS unsigned* MISC;
    gu32* ctl;
    int tid, lane, wave, vcu, G;
    float* out; unsigned char* ws;
};
struct Args { const float* in[23]; float* out; unsigned char* ws; int ph_lo, ph_hi, probe, pad; };
enum { I_X = 0, I_MEM, I_MIXG, I_MEMG, I_WIN, I_GATEB, I_WKV, I_NAQG, I_NAKG, I_RPB, I_POOLW, I_POOLSC, I_XAQG, I_XAKG, I_WB0, I_WB1, I_WB2, I_WOUT, I_FFNG, I_WQ, I_KEYS, I_PU, I_PV };

__device__ __forceinline__ void p0_transpose_item(const float* W, int K, int N, int k0, int n0, bf16* dst, const float* kscale, LAS float* scr, int lane) {
#pragma unroll 8
    for (int i = 0; i < 32; ++i) { const int kk = 2 * i + (lane >> 5); float v = W[(size_t)(k0 + kk) * N + n0 + (lane & 31)]; if (kscale) v *= kscale[k0 + kk]; scr[kk * 33 + (lane & 31)] = v; }
    LDS_WAIT(); asm volatile("" ::: "memory");
    const int c = lane & 7;
#pragma unroll
    for (int j = 0; j < 4; ++j) { const int n = (lane >> 3) + 8 * j; const LAS float* s = scr + (8 * c) * 33 + n;
        v4u o; o.x = pk2(s[0 * 33], s[1 * 33]); o.y = pk2(s[2 * 33], s[3 * 33]); o.z = pk2(s[4 * 33], s[5 * 33]); o.w = pk2(s[6 * 33], s[7 * 33]);
        *(GAS v4u*)(dst + (size_t)n * K + k0 + 8 * c) = o; }
    LDS_WAIT(); asm volatile("" ::: "memory");
}
__device__ __forceinline__ void cvt_row1024(const float* src, bf16* dst, const float* colscale, float rowscale, int lane) {
    const GAS f32x4* xr = (const GAS f32x4*)src + lane; GAS unsigned long long* o8 = (GAS unsigned long long*)dst + lane;
#pragma unroll
    for (int j = 0; j < 4; ++j) { f32x4 v = xr[64 * j] * rowscale; if (colscale) v = v * ((const GAS f32x4*)colscale)[lane + 64 * j];
        o8[64 * j] = (unsigned long long)pk2(v.x, v.y) | ((unsigned long long)pk2(v.z, v.w) << 32); }
}
__device__ __forceinline__ float row_rstd1024(const float* src, int lane) {
    const GAS f32x4* xr = (const GAS f32x4*)src + lane; float s = 0.f;
#pragma unroll
    for (int j = 0; j < 4; ++j) { const f32x4 v = xr[64 * j]; s += (v.x * v.x + v.y * v.y) + (v.z * v.z + v.w * v.w); }
    return rsqrtf(wave_sum(s) * (1.0f / 1024.0f) + 1e-6f);
}
__device__ __forceinline__ void p0_prologue(Frame& F, const Args& A) {
    LAS float* scr = (LAS float*)(F.lds + RING_OFF + F.wave * 16384);
    const int gw = F.vcu * NWAVES + F.wave, NGW = F.G * NWAVES, lane = F.lane;
    unsigned char* ws = F.ws;
    constexpr int I_IN = 16 * 176, I_KV = 16 * 32, I_BR = 8 * 32, I_OUT = 16 * 32, I_Q = 16 * 64;
    constexpr int NITEMS = I_IN + I_KV + 3 * I_BR + I_OUT + I_Q;
    for (int it = gw; it < NITEMS; it += NGW) {
        int r = it;
        if (r < I_IN) { const int kb = r / 176, nb = r % 176, n0 = 32 * nb; bf16* dst;
            if (n0 >= 1024 && n0 < 1536) dst = (bf16*)(ws + WS_WV) + (size_t)(n0 - 1024) * 1024;
            else { const int np = n0 < 1024 ? n0 : n0 - 512, t = np >> 8, w = np & 255, wc = w >> 6, bj = (w >> 5) & 1; dst = (bf16*)(ws + WS_WIN) + (size_t)(256 * t + 128 * bj + 32 * wc) * 1024; }
            p0_transpose_item(A.in[I_WIN], 1024, 5632, 64 * kb, n0, dst, A.in[I_MIXG], scr, lane); continue; }
        r -= I_IN;
        if (r < I_KV) { const int kb = r / 32, nb = r % 32; p0_transpose_item(A.in[I_WKV], 1024, 1024, 64 * kb, 32 * nb, (bf16*)(ws + WS_WKV) + (size_t)(32 * nb) * 1024, nullptr, scr, lane); continue; }
        r -= I_KV;
        if (r < 3 * I_BR) { const int br = r / I_BR, rr = r % I_BR, kb = rr / 32, nb = rr % 32; const float* W = br == 0 ? A.in[I_WB0] : (br == 1 ? A.in[I_WB1] : A.in[I_WB2]);
            p0_transpose_item(W, 512, 1024, 64 * kb, 32 * nb, (bf16*)(ws + WS_WBR) + (size_t)br * 1024 * 512 + (size_t)(32 * nb) * 512, nullptr, scr, lane); continue; }
        r -= 3 * I_BR;
        if (r < I_OUT) { const int kb = r / 32, nb = r % 32; p0_transpose_item(A.in[I_WOUT], 1024, 1024, 64 * kb, 32 * nb, (bf16*)(ws + WS_WOUT) + (size_t)(32 * nb) * 1024, nullptr, scr, lane); continue; }
        r -= I_OUT;
        { const int kb = r / 64, nb = r % 64; p0_transpose_item(A.in[I_WQ], 1024, 2048, 64 * kb, 32 * nb, (bf16*)(ws + WS_WQ) + (size_t)(32 * nb) * 1024, A.in[I_FFNG], scr, lane); }
    }
    { bf16* xb = (bf16*)((unsigned char*)F.out + OUT_XB); float* rstdx = (float*)(ws + WS_RSTDX);
      for (int m = gw; m < T; m += NGW) { const float* xr = A.in[I_X] + (size_t)m * D; const float rs = row_rstd1024(xr, lane); cvt_row1024(xr, xb + (size_t)m * D, nullptr, 1.0f, lane); if (lane == 0) rstdx[m] = rs; } }
    for (int m = gw; m < NMEMTOK; m += NGW) { const float* xr = A.in[I_MEM] + (size_t)m * D; const float rs = row_rstd1024(xr, lane); cvt_row1024(xr, (bf16*)(ws + WS_MEMN) + (size_t)m * D, A.in[I_MEMG], rs, lane); }
    for (int m = gw; m < 2 * NEXP; m += NGW) {
        const bool isu = m < NEXP; const int e = isu ? m : m - NEXP;
        const GAS f32x4* src = (const GAS f32x4*)((isu ? A.in[I_PU] : A.in[I_PV]) + (size_t)e * D) + 4 * lane;
        f32x4 v[4]; float mx = 0.f;
#pragma unroll
        for (int d = 0; d < 4; ++d) { v[d] = src[d]; if (isu) v[d] = v[d] * ((const GAS f32x4*)A.in[I_FFNG])[4 * lane + d];
            mx = fmaxf(mx, fmaxf(fmaxf(fabsf(v[d].x), fabsf(v[d].y)), fmaxf(fabsf(v[d].z), fabsf(v[d].w)))); }
#pragma unroll
        for (int o = 1; o < 64; o <<= 1) mx = fmaxf(mx, __shfl_xor(mx, o));
        const float inv = mx > 0.f ? 127.0f / mx : 0.f; const int off = 0;
        v4u w;
#pragma unroll
        for (int d = 0; d < 4; ++d) { const unsigned b0 = (unsigned)((int)rintf(v[d].x * inv) + off) & 0xffu, b1 = (unsigned)((int)rintf(v[d].y * inv) + off) & 0xffu,
                                                     b2 = (unsigned)((int)rintf(v[d].z * inv) + off) & 0xffu, b3 = (unsigned)((int)rintf(v[d].w * inv) + off) & 0xffu;
            w[d] = b0 | (b1 << 8) | (b2 << 16) | (b3 << 24); }
        if (isu) ((GAS v4u*)(ws + WS_U8))[(size_t)e * 64 + lane] = w;
        else *(GAS v4u*)(ws + WS_V8 + (size_t)(lane >> 3) * (2 * MiB) + (size_t)e * 128 + (lane & 7) * 16) = w;
        if (lane == 0) ((float*)(ws + WS_SU))[2 * e + (isu ? 0 : 1)] = mx * (1.0f / 127.0f);
    }
    for (int m = gw * 64 + lane; m < T; m += NGW * 64) ((float*)(ws + WS_ROWSQ))[m] = 0.f;
    for (int m = gw; m < 256; m += NGW) cvt_row1024(A.in[I_KEYS] + (size_t)m * 1024, (bf16*)(ws + WS_KEYS) + (size_t)m * 1024, nullptr, 1.0f, lane);
    for (int m = gw; m < 1024; m += NGW) { const int gd = m >> 1, c = (m & 1) * 64 + lane, g = gd >> 7, d = gd & 127;
        const float v = A.in[I_POOLW][(size_t)(g * 128 + c) * 128 + d] * A.in[I_POOLSC][gd];
        ((bf16*)(ws + WS_PWT))[(size_t)gd * 128 + c] = (bf16)f2bf(v); }
}

__device__ __forceinline__ void memkv_tile(const bf16* memn, const bf16* wkvT, const float* kg, const float* qg, bf16* kmem, bf16* vtmem, int tile, int lane) {
    const int q = lane & 15, hi = lane >> 4, rg = tile >> 3, cg = tile & 7, r0 = rg * 16, c0 = cg * 128;
    f32x4 acc[8];
#pragma unroll
    for (int i = 0; i < 8; ++i) acc[i] = (f32x4){0.f, 0.f, 0.f, 0.f};
    const bf16* ap = memn + (size_t)(r0 + q) * 1024 + 8 * hi; const bf16* bp = wkvT + (size_t)(c0 + q) * 1024 + 8 * hi;
#pragma unroll 1
    for (int kb = 0; kb < 8; ++kb) {
        bf16x8 a[4], b[4][8];
#pragma unroll
        for (int k4 = 0; k4 < 4; ++k4) { a[k4] = *(const bf16x8*)(ap + 32 * (4 * kb + k4));
#pragma unroll
            for (int nf = 0; nf < 8; ++nf) b[k4][nf] = *(const bf16x8*)(bp + (size_t)(16 * nf) * 1024 + 32 * (4 * kb + k4)); }
        __builtin_amdgcn_sched_barrier(0);
#pragma unroll
        for (int k4 = 0; k4 < 4; ++k4)
#pragma unroll
            for (int nf = 0; nf < 8; ++nf) acc[nf] = mfma16(a[k4], b[k4][nf], acc[nf]);
        __builtin_amdgcn_sched_barrier(0);
    }
    if (cg < 4) {
        float rr[4];
#pragma unroll
        for (int g = 0; g < 4; ++g) { float ss = 0.f;
#pragma unroll
            for (int nf = 0; nf < 8; ++nf) ss += acc[nf][g] * acc[nf][g];
            ss += __shfl_xor(ss, 1); ss += __shfl_xor(ss, 2); ss += __shfl_xor(ss, 4); ss += __shfl_xor(ss, 8);
            rr[g] = rsqrtf(ss * (1.0f / 128.0f) + 1e-6f); }
#pragma unroll
        for (int nf = 0; nf < 8; ++nf) { const int d = 16 * nf + q; const float gs = kg[d] * qg[d];
#pragma unroll
            for (int g = 0; g < 4; ++g) kmem[(size_t)(r0 + 4 * hi + g) * 512 + cg * 128 + d] = (bf16)f2bf(acc[nf][g] * rr[g] * gs); }
    } else {
        const int h = cg - 4, b = r0 >> 8, key0 = (r0 & 255) + 4 * hi;
#pragma unroll
        for (int nf = 0; nf < 8; ++nf) { const int d = 16 * nf + q; v2u w; w.x = pk2(acc[nf][0], acc[nf][1]); w.y = pk2(acc[nf][2], acc[nf][3]);
            *(v2u*)(vtmem + (size_t)(b * 512 + h * 128 + d) * 256 + key0) = w; }
    }
}

__device__ __forceinline__ void na_item(const bf16* __restrict__ qn, const bf16* __restrict__ kn, const bf16* __restrict__ vt, const LAS float* rpl, bf16* __restrict__ yna,
                                        int b, int r, int jb, int h, int lane) {
    const int q = lane & 15, hi = lane >> 4;
    int rs = r - 4; rs = rs < 0 ? 0 : (rs > 120 ? 120 : rs);
    int kb0 = jb * 16 - 8; kb0 = kb0 < 0 ? 0 : (kb0 > 32 ? 32 : kb0);
    const int qcol = jb * 16 + q; int cs = qcol - 8; cs = cs < 0 ? 0 : (cs > 48 ? 48 : cs);
    const size_t tokq = (size_t)b * SEQ + r * 64 + qcol;
    const bf16* qp = qn + tokq * 512 + h * 64 + 8 * hi;
    const bf16x8 qf0 = *(const bf16x8*)qp, qf1 = *(const bf16x8*)(qp + 32);
    const int kq = 8 * (q >> 2) + (q & 3);
    const bf16* kbase = kn + ((size_t)b * SEQ + rs * 64 + kb0 + kq) * 512 + h * 64 + 8 * hi;
    f32x4 s[16];
    {
        bf16x8 ka[16][2];
#pragma unroll
        for (int f = 0; f < 16; ++f) { const bf16* kp = kbase + (size_t)((f >> 1) * 64 + (f & 1) * 4) * 512; ka[f][0] = *(const bf16x8*)kp; ka[f][1] = *(const bf16x8*)(kp + 32); }
        __builtin_amdgcn_sched_barrier(0);
#pragma unroll
        for (int f = 0; f < 16; ++f) { f32x4 z = (f32x4){0.f, 0.f, 0.f, 0.f}; z = mfma16(ka[f][0], qf0, z); s[f] = mfma16(ka[f][1], qf1, z); }
    }
    const bf16* vbase = vt + ((size_t)(b * 512 + h * 64 + q) * SEQ + rs * 64 + kb0 + 8 * hi);
    bf16x8 va[8][4];
#pragma unroll
    for (int st = 0; st < 8; ++st)
#pragma unroll
        for (int mf = 0; mf < 4; ++mf) va[st][mf] = *(const bf16x8*)(vbase + (size_t)(16 * mf) * SEQ + st * 64);
    __builtin_amdgcn_sched_barrier(0);
    float mx = -3.0e38f;
#pragma unroll
    for (int f = 0; f < 16; ++f) {
        const int dr = rs + (f >> 1) - r + 7;
#pragma unroll
        for (int g = 0; g < 4; ++g) {
            const int kcol = kb0 + 8 * hi + 4 * (f & 1) + g;
            const bool ok = (kcol >= cs) && (kcol < cs + 16);
            int dc = kcol - qcol + 15; dc = dc < 0 ? 0 : (dc > 30 ? 30 : dc);
            const float v = ok ? s[f][g] + rpl[dr * 31 + dc] : -1.0e30f;
            s[f][g] = v; mx = fmaxf(mx, v);
        }
    }
    mx = fmaxf(mx, __shfl_xor(mx, 16)); mx = fmaxf(mx, __shfl_xor(mx, 32));
    float sum = 0.f;
#pragma unroll
    for (int f = 0; f < 16; ++f)
#pragma unroll
        for (int g = 0; g < 4; ++g) { const float p = __expf(s[f][g] - mx); s[f][g] = p; sum += p; }
    sum += __shfl_xor(sum, 16); sum += __shfl_xor(sum, 32);
    const float inv = 1.0f / sum;
    f32x4 o[4];
#pragma unroll
    for (int i = 0; i < 4; ++i) o[i] = (f32x4){0.f, 0.f, 0.f, 0.f};
#pragma unroll
    for (int st = 0; st < 8; ++st) {
        const bf16x8 pb = __builtin_bit_cast(bf16x8, pg8::pack8(s[2 * st], s[2 * st + 1]));
#pragma unroll
        for (int mf = 0; mf < 4; ++mf) o[mf] = mfma16(va[st][mf], pb, o[mf]);
    }
    bf16* yp = yna + tokq * 512 + h * 64 + 4 * hi;
#pragma unroll
    for (int mf = 0; mf < 4; ++mf) { v2u w; w.x = pk2(o[mf][0] * inv, o[mf][1] * inv); w.y = pk2(o[mf][2] * inv, o[mf][3] * inv); *(v2u*)(yp + 16 * mf) = w; }
}
__device__ __forceinline__ void xa_fill_lds(const bf16* __restrict__ kmem, const bf16* __restrict__ vtmem, LAS unsigned char* lds, int b, int h, int tid) {
#pragma unroll
    for (int ps = 0; ps < 8; ++ps) { const int id = tid + 512 * ps, key = id >> 4, c = id & 15;
        *(LAS v4u*)(lds + key * 256 + ((c ^ (key & 15)) << 4)) = *(const v4u*)(kmem + ((size_t)b * 256 + key) * 512 + h * 128 + 8 * c); }
#pragma unroll
    for (int ps = 0; ps < 8; ++ps) { const int id = tid + 512 * ps, dim = id >> 5, c = id & 31;
        *(LAS v4u*)(lds + 65536 + dim * 512 + ((c ^ (dim & 15)) << 4)) = *(const v4u*)(vtmem + (size_t)(b * 512 + h * 128 + dim) * 256 + 8 * c); }
}
__device__ __forceinline__ void xa_item(const bf16* __restrict__ xq, const LAS unsigned char* lds, bf16* __restrict__ yxa, int tok0, int h, int lane) {
    const int q = lane & 15, hi = lane >> 4; const size_t tok = (size_t)tok0 + q;
    const bf16* qp = xq + tok * 512 + h * 128 + 8 * hi;
    bf16x8 qf[4]; float ssq = 0.f;
#pragma unroll
    for (int ks = 0; ks < 4; ++ks) qf[ks] = *(const bf16x8*)(qp + 32 * ks);
    __builtin_amdgcn_sched_barrier(0);
#pragma unroll
    for (int ks = 0; ks < 4; ++ks)
#pragma unroll
        for (int j = 0; j < 8; ++j) { const float v = bf1(qf[ks][j]); ssq += v * v; }
    ssq += __shfl_xor(ssq, 16); ssq += __shfl_xor(ssq, 32);
    const float cexp = rsqrtf(ssq * (1.0f / 128.0f) + 1e-6f) * 0.08838834764831845f * 1.4426950408889634f;
    const int kq = 8 * (q >> 2) + (q & 3);
    f32x4 s[16];
#pragma unroll
    for (int f = 0; f < 16; ++f) { const int key = 32 * (f >> 1) + 4 * (f & 1) + kq; const LAS unsigned char* kr = lds + key * 256; f32x4 z = (f32x4){0.f, 0.f, 0.f, 0.f};
#pragma unroll
        for (int ks = 0; ks < 4; ++ks) z = mfma16(*(const LAS bf16x8*)(kr + (((4 * ks + hi) ^ (key & 15)) << 4)), qf[ks], z);
        s[f] = z; }
    float mx = -3.0e38f;
#pragma unroll
    for (int f = 0; f < 16; ++f)
#pragma unroll
        for (int g = 0; g < 4; ++g) mx = fmaxf(mx, s[f][g]);
    mx = fmaxf(mx, __shfl_xor(mx, 16)); mx = fmaxf(mx, __shfl_xor(mx, 32));
    float sum = 0.f;
#pragma unroll
    for (int f = 0; f < 16; ++f)
#pragma unroll
        for (int g = 0; g < 4; ++g) { const float p = __builtin_amdgcn_exp2f((s[f][g] - mx) * cexp); s[f][g] = p; sum += p; }
    sum += __shfl_xor(sum, 16); sum += __shfl_xor(sum, 32);
    const float inv = 1.0f / sum;
    f32x4 o[8];
#pragma unroll
    for (int i = 0; i < 8; ++i) o[i] = (f32x4){0.f, 0.f, 0.f, 0.f};
#pragma unroll
    for (int st = 0; st < 8; ++st) {
        const bf16x8 pb = __builtin_bit_cast(bf16x8, pg8::pack8(s[2 * st], s[2 * st + 1]));
#pragma unroll
        for (int mf = 0; mf < 8; ++mf) { const int dim = 16 * mf + q; o[mf] = mfma16(*(const LAS bf16x8*)(lds + 65536 + dim * 512 + (((4 * st + hi) ^ (dim & 15)) << 4)), pb, o[mf]); }
    }
    bf16* yp = yxa + tok * 512 + h * 128 + 4 * hi;
#pragma unroll
    for (int mf = 0; mf < 8; ++mf) { v2u w; w.x = pk2(o[mf][0] * inv, o[mf][1] * inv); w.y = pk2(o[mf][2] * inv, o[mf][3] * inv); *(v2u*)(yp + 16 * mf) = w; }
}
__device__ __forceinline__ void pool_wg(const bf16* __restrict__ pp, const bf16* __restrict__ pwT, bf16* __restrict__ ypool, LAS unsigned char* lds, int tokbase, int wave, int lane) {
    const int q = lane & 15, hi = lane >> 4;
    __syncthreads();
    {
        const int hw = 1 << hi, tw0 = tokbase + 16 * wave, b = tw0 >> 13, t0 = tw0 & 8191;
        const bf16* base = pp + (size_t)b * SEQ * 512 + 8 * lane;
        float s[8];
#pragma unroll
        for (int j = 0; j < 8; ++j) s[j] = 0.f;
#pragma unroll 4
        for (int d = -8; d < 8; ++d) { const int u = t0 + d; const bool ok = (d >= -hw) && (d < hw) && (u >= 0) && (u < SEQ);
            const bf16x8 v = *(const bf16x8*)(base + (size_t)(ok ? u : t0) * 512);
#pragma unroll
            for (int j = 0; j < 8; ++j) s[j] += ok ? bf1(v[j]) : 0.f; }
        LAS unsigned char* tile = lds + wave * 16384;
#pragma unroll 2
        for (int i = 0; i < 16; ++i) { const int t = t0 + i;
            int lo = t - hw; lo = lo < 0 ? 0 : lo; int ht = t + hw; ht = ht > SEQ ? SEQ : ht;
            const float inv = 1.0f / (float)(ht - lo);
            const bool oka = (t + hw) < SEQ, oks = (t - hw) >= 0;
            const bf16x8 sv = *(const bf16x8*)(base + (size_t)t * 512), av = *(const bf16x8*)(base + (size_t)(oka ? t + hw : t) * 512), bv = *(const bf16x8*)(base + (size_t)(oks ? t - hw : t) * 512);
            f32x4 p0, p1;
#pragma unroll
            for (int j = 0; j < 4; ++j) { p0[j] = s[j] * inv - bf1(sv[j]); p1[j] = s[j + 4] * inv - bf1(sv[j + 4]); }
            *(LAS v4u*)(tile + i * 1024 + ((lane ^ (i & 15)) << 4)) = pg8::pack8(p0, p1);
#pragma unroll
            for (int j = 0; j < 8; ++j) s[j] += (oka ? bf1(av[j]) : 0.f) - (oks ? bf1(bv[j]) : 0.f);
        }
    }
    __syncthreads();
#pragma unroll 1
    for (int k = 0; k < 4; ++k) {
        const int pair = wave * 4 + k, g = pair >> 3, mf = pair & 7;
        const bf16* wb = pwT + (size_t)(g * 128 + 16 * mf + q) * 128 + 8 * hi;
        bf16x8 a[4];
#pragma unroll
        for (int ks = 0; ks < 4; ++ks) a[ks] = *(const bf16x8*)(wb + 32 * ks);
#pragma unroll 2
        for (int tg = 0; tg < 8; ++tg) {
            const LAS unsigned char* trow = lds + tg * 16384 + q * 1024; f32x4 o = (f32x4){0.f, 0.f, 0.f, 0.f};
#pragma unroll
            for (int ks = 0; ks < 4; ++ks) { const int c = g * 16 + 4 * ks + hi; o = mfma16(a[ks], *(const LAS bf16x8*)(trow + ((c ^ q) << 4)), o); }
            v2u w; w.x = pk2(o[0], o[1]); w.y = pk2(o[2], o[3]);
            *(v2u*)(ypool + (size_t)(tokbase + 16 * tg + q) * 512 + g * 128 + 16 * mf + 4 * hi) = w;
        }
    }
    __syncthreads();
}

__device__ __forceinline__ int f2key(float s, int idx, int mask) { int b = __builtin_bit_cast(int, s); b = b >= 0 ? b : (b ^ 0x7fffffff); return (b & ~mask) | idx; }
__device__ __forceinline__ float key2f(int k) { k = k >= 0 ? k : (k ^ 0x7fffffff); return __builtin_bit_cast(float, k); }
#define CE_DESC(x, y) do { const int _h = (x) > (y) ? (x) : (y), _l = (x) > (y) ? (y) : (x); (x) = _h; (y) = _l; } while (0)
__device__ __forceinline__ void sort16(int (&a)[16]) {
#pragma unroll
    for (int ks = 1; ks <= 4; ++ks)
#pragma unroll
        for (int js = ks - 1; js >= 0; --js)
#pragma unroll
            for (int i = 0; i < 16; ++i) { const int k = 1 << ks, j = 1 << js, l = i ^ j;
                if (l > i) { if ((i & k) == 0) CE_DESC(a[i], a[l]); else CE_DESC(a[l], a[i]); } }
}
__device__ __forceinline__ void merge16(int (&a)[16], const int (&b)[16]) {
#pragma unroll
    for (int i = 0; i < 16; ++i) a[i] = a[i] > b[15 - i] ? a[i] : b[15 - i];
#pragma unroll
    for (int js = 3; js >= 0; --js)
#pragma unroll
        for (int i = 0; i < 16; ++i) { const int j = 1 << js, l = i ^ j; if (l > i) CE_DESC(a[i], a[l]); }
}
__device__ __forceinline__ void merge16_lanes(int (&a)[16], int step) { int o[16];
#pragma unroll
    for (int k = 0; k < 16; ++k) o[k] = __shfl_xor(a[k], step);
    merge16(a, o); }
__device__ constexpr int cand_i(int hi, int m) {
    return hi == 0 ? 0
         : hi == 1 ? (m < 8 ? 1 : (m < 13 ? 2 : -1))
         : hi == 2 ? (m < 4 ? 3 : (m < 7 ? 4 : (m < 9 ? 5 : (m < 11 ? 6 : -1))))
         :           (m < 2 ? 7 : (m < 10 ? 8 + (m - 2) : -1));
}
__device__ constexpr int cand_j(int hi, int m) {
    return hi == 0 ? m
         : hi == 1 ? (m < 8 ? m : (m < 13 ? m - 8 : -1))
         : hi == 2 ? (m < 4 ? m : (m < 7 ? m - 4 : (m < 9 ? m - 7 : (m < 11 ? m - 9 : -1))))
         :           (m < 2 ? m : (m < 10 ? 0 : -1));
}
__device__ __forceinline__ void topk_fill_lds(const bf16* __restrict__ keys, LAS unsigned char* lds, int h, int tid) {
#pragma unroll
    for (int ps = 0; ps < 8; ++ps) { const int id = tid + 512 * ps, row = id >> 4, c = id & 15;
        *(LAS v4u*)(lds + row * 256 + ((c ^ (row & 15)) << 4)) = *(const v4u*)(keys + ((size_t)h * 256 + row) * 128 + 8 * c); }
}
__device__ __forceinline__ void topk_item(const bf16* __restrict__ qb, const LAS unsigned char* klds, int* __restrict__ te, float* __restrict__ tw, LAS int* lscr, int tok0, int h, int lane) {
    const int q = lane & 15, hi = lane >> 4; const size_t tok = (size_t)tok0 + q;
    int L[2][16];
    bf16x8 qfa[2][4];
#pragma unroll
    for (int p = 0; p < 2; ++p)
#pragma unroll
        for (int ks = 0; ks < 4; ++ks) qfa[p][ks] = *(const bf16x8*)(qb + tok * 2048 + h * 256 + p * 128 + 32 * ks + 8 * hi);
    __builtin_amdgcn_sched_barrier(0);
#pragma unroll
    for (int p = 0; p < 2; ++p) {
        int B[16];
#pragma unroll
        for (int mf = 0; mf < 8; ++mf) { f32x4 s = (f32x4){0.f, 0.f, 0.f, 0.f}; const int row = p * 128 + 16 * mf + q;
#pragma unroll
            for (int ks = 0; ks < 4; ++ks) s = mfma16(*(const LAS bf16x8*)(klds + row * 256 + (((4 * ks + hi) ^ (row & 15)) << 4)), qfa[p][ks], s);
#pragma unroll
            for (int g = 0; g < 4; ++g) { const int key = f2key(s[g], 16 * mf + 4 * hi + g, 127); if (mf < 4) L[p][4 * mf + g] = key; else B[4 * (mf - 4) + g] = key; } }
        sort16(L[p]); sort16(B); merge16(L[p], B);
        merge16_lanes(L[p], 16); merge16_lanes(L[p], 32);
    }
    float v1[16], v2[16];
#pragma unroll
    for (int k = 0; k < 16; ++k) { v1[k] = key2f(L[0][k]); v2[k] = key2f(L[1][k]); }
    int Fk[16];
#pragma unroll
    for (int m = 0; m < 16; ++m) {
        float sm = v1[0] + v2[m]; int id = 255 - m;
        if (cand_i(1, m) >= 0) { if (hi == 1) { sm = v1[cand_i(1, m) < 0 ? 0 : cand_i(1, m)] + v2[cand_j(1, m) < 0 ? 0 : cand_j(1, m)]; id = 255 - ((cand_i(1, m) << 4) | cand_j(1, m)); } }
        if (cand_i(2, m) >= 0) { if (hi == 2) { sm = v1[cand_i(2, m) < 0 ? 0 : cand_i(2, m)] + v2[cand_j(2, m) < 0 ? 0 : cand_j(2, m)]; id = 255 - ((cand_i(2, m) << 4) | cand_j(2, m)); } }
        if (cand_i(3, m) >= 0) { if (hi == 3) { sm = v1[cand_i(3, m) < 0 ? 0 : cand_i(3, m)] + v2[cand_j(3, m) < 0 ? 0 : cand_j(3, m)]; id = 255 - ((cand_i(3, m) << 4) | cand_j(3, m)); } }
        int key = f2key(sm, id, 255);
        if ((hi == 1 && cand_i(1, m) < 0) || (hi == 2 && cand_i(2, m) < 0) || (hi == 3 && cand_i(3, m) < 0)) key = (int)0x80000000;
        Fk[m] = key;
    }
    sort16(Fk); merge16_lanes(Fk, 16); merge16_lanes(Fk, 32);
    LAS int* my = lscr + lane * 32;
#pragma unroll
    for (int k = 0; k < 16; ++k) { my[k] = L[0][k] & 127; my[16 + k] = L[1][k] & 127; }
    LDS_WAIT(); asm volatile("" ::: "memory");
    float e[16]; float sum = 0.f; const float mx = key2f(Fk[0]);
#pragma unroll
    for (int k = 0; k < 16; ++k) { e[k] = __expf(key2f(Fk[k]) - mx); sum += e[k]; }
    const float inv = 1.0f / sum;
    if (hi == 0) {
        int* tep = te + tok * 128; float* twp = tw + tok * 128;
#pragma unroll
        for (int kk = 0; kk < 16; ++kk) { const int ij = 255 - (Fk[kk] & 255), i = ij >> 4, j = ij & 15, slot = (kk & 7) * 16 + 2 * h + (kk >> 3);
            tep[slot] = my[i] * 128 + my[16 + j]; twp[slot] = e[kk] * inv; }
    }
    LDS_WAIT(); asm volatile("" ::: "memory");
}

__device__ __forceinline__ float ub2f(unsigned v, int b) { return (float)((v >> (8 * b)) & 0xffu); }
__device__ __forceinline__ void hq_token(const bf16* __restrict__ hb, const float* __restrict__ rowsq, unsigned char* __restrict__ hq, float* __restrict__ hs, int tok, int lane) {
    const bf16* hp = hb + (size_t)tok * 1024 + 16 * lane;
    const v4u hA = *(const v4u*)hp, hB = *(const v4u*)(hp + 8);
    float hf[16];
#pragma unroll
    for (int d = 0; d < 4; ++d) { hf[2 * d] = bflo(hA[d]); hf[2 * d + 1] = bfhi(hA[d]); hf[8 + 2 * d] = bflo(hB[d]); hf[8 + 2 * d + 1] = bfhi(hB[d]); }
    float amax = 0.f;
#pragma unroll
    for (int j = 0; j < 16; ++j) amax = fmaxf(amax, fabsf(hf[j]));
#pragma unroll
    for (int o = 1; o < 64; o <<= 1) amax = fmaxf(amax, __shfl_xor(amax, o));
    const float hinv = amax > 0.f ? 127.0f / amax : 0.f;
    v4u w;
#pragma unroll
    for (int d = 0; d < 4; ++d) { const unsigned b0 = (unsigned)(int)rintf(hf[4 * d] * hinv) & 0xffu, b1 = (unsigned)(int)rintf(hf[4 * d + 1] * hinv) & 0xffu,
                                                 b2 = (unsigned)(int)rintf(hf[4 * d + 2] * hinv) & 0xffu, b3 = (unsigned)(int)rintf(hf[4 * d + 3] * hinv) & 0xffu;
        w[d] = b0 | (b1 << 8) | (b2 << 16) | (b3 << 24); }
    *(v4u*)(hq + (size_t)tok * 1024 + 16 * lane) = w;
    if (lane == 0) hs[tok] = rsqrtf(rowsq[tok] * (1.0f / 1024.0f) + 1e-6f) * amax * (1.0f / 127.0f);
}
struct PeerA1 { int e; float g; };
constexpr int PA_SLOTS = 12;
struct PeerA2 { v4u ur[PA_SLOTS]; v4u hv; float hsc, su, sv; int cnt, rk; bool m; unsigned long long rem; };
__device__ __forceinline__ void pa_s1(PeerA1& a, const int* __restrict__ te, const float* __restrict__ tw, int tok, int half, int lane) {
    a.e = te[(size_t)tok * 128 + 64 * half + lane]; a.g = tw[(size_t)tok * 128 + 64 * half + lane]; }
__device__ __forceinline__ void pa_s2(PeerA2& b, const PeerA1& a, const unsigned char* __restrict__ hq, const float* __restrict__ hs, const unsigned char* __restrict__ u8,
                                      const float* __restrict__ su, const float* __restrict__ sv, int tok, int x, int lane, int hot) {
    b.m = (a.e >> 11) == x;
    unsigned long long mask = __ballot(b.m); const unsigned long long lt = (1ull << lane) - 1ull;
    b.cnt = __popcll(mask); b.rk = __popcll(mask & lt);
    { typedef float f32x2s __attribute__((ext_vector_type(2))); f32x2s s2 = (f32x2s){0.f, 0.f}; if (b.m) s2 = ((const f32x2s*)su)[a.e]; b.su = s2.x; b.sv = s2.y; }
    b.hv = *(const v4u*)(hq + (size_t)tok * 1024 + 16 * lane); b.hsc = hs[tok];
#pragma unroll
    for (int k = 0; k < PA_SLOTS; ++k) { const bool has = mask != 0ull; const int idx = has ? __builtin_ctzll(mask) : 0; mask &= mask - 1ull;
        int e = has ? __builtin_amdgcn_readlane(a.e, idx) : (x << 11); if (hot) e = (x << 11) | (e & 255); b.ur[k] = *(const v4u*)(u8 + (size_t)e * 1024 + 16 * lane); }
    b.rem = mask;
}
__device__ __forceinline__ int dot16(const v4u u, const v4u h) { int d = __builtin_amdgcn_sdot4((int)u.x, (int)h.x, 0, false); d = __builtin_amdgcn_sdot4((int)u.y, (int)h.y, d, false);
    d = __builtin_amdgcn_sdot4((int)u.z, (int)h.z, d, false); return __builtin_amdgcn_sdot4((int)u.w, (int)h.w, d, false); }
template <int CTRL, int RM> __device__ __forceinline__ int dpp_i(int x) { return __builtin_amdgcn_update_dpp(0, x, CTRL, RM, 0xf, false); }
__device__ __forceinline__ int wave_sum_to63(int x) { x += dpp_i<0xb1, 0xf>(x); x += dpp_i<0x4e, 0xf>(x); x += dpp_i<0x124, 0xf>(x); x += dpp_i<0x128, 0xf>(x); x += dpp_i<0x142, 0xa>(x); x += dpp_i<0x143, 0xc>(x); return x; }
__device__ __forceinline__ float gelu_erf(float v) {
    const float av = fabsf(v), t = __builtin_amdgcn_rcpf(av * 0.2316418882f + 1.0f);
    float q = t * 0.5307027145f + (-0.7265760135f); q = q * t + 0.7107068705f; q = q * t + (-0.142248368f); q = q * t + 0.127414796f; q = q * t;
    const float e = __builtin_amdgcn_exp2f((v * v) * (-0.72134752044f)), m = v * (q * e);
    return v < 0.f ? m : v - m; }
__device__ __forceinline__ void pa_s3(const PeerA2& b, const PeerA1& a, const unsigned char* __restrict__ u8, float* __restrict__ aw, int tok, int half, int lane) {
    int mine = 0;
#pragma unroll
    for (int k = 0; k < PA_SLOTS; ++k) { const int s = __builtin_amdgcn_readlane(wave_sum_to63(dot16(b.ur[k], b.hv)), 63); mine = (b.rk == k) ? s : mine; }
    float* awp = aw + (size_t)tok * 128 + 64 * half + lane;
    if (b.m && b.rk < PA_SLOTS) *awp = a.g * gelu_erf((float)mine * b.hsc * b.su) * b.sv;
    if (b.cnt > PA_SLOTS) {
        unsigned long long rem = b.rem;
        while (rem != 0ull) { const int idx = __builtin_ctzll(rem); rem &= rem - 1ull; const int e = __builtin_amdgcn_readlane(a.e, idx);
            const int d = __builtin_amdgcn_readlane(wave_sum_to63(dot16(*(const v4u*)(u8 + (size_t)e * 1024 + 16 * lane), b.hv)), 63);
            if (lane == idx) *awp = a.g * gelu_erf((float)d * b.hsc * b.su) * b.sv; }
    }
}
__device__ __forceinline__ void peer_a_run(const unsigned char* __restrict__ hq, const float* __restrict__ hs, const unsigned char* __restrict__ u8, const float* __restrict__ su,
                                           const float* __restrict__ sv, const int* __restrict__ te, const float* __restrict__ tw, float* __restrict__ aw, int wrank, int wstep, int x, int lane, int hot = 0) {
    const int ntok = wrank < T ? (T - wrank + wstep - 1) / wstep : 0, N = 2 * ntok;
#define PA_TOK(n) (wrank + ((n) >> 1) * wstep)
    if (N == 0) return;
    PeerA1 a0, a1, a2; PeerA2 bA, bB;
    pa_s1(a0, te, tw, PA_TOK(0), 0, lane); pa_s1(a1, te, tw, PA_TOK(1), 1, lane);
    pa_s2(bA, a0, hq, hs, u8, su, sv, PA_TOK(0), x, lane, hot);
#define PA_STEP(n, Bcur, Bnext, Acur, Anext, Anew) do { \
        if ((n) + 1 < N) pa_s2(Bnext, Anext, hq, hs, u8, su, sv, PA_TOK((n) + 1), x, lane, hot); \
        if ((n) + 2 < N) pa_s1(Anew, te, tw, PA_TOK((n) + 2), ((n) + 2) & 1, lane); \
        pa_s3(Bcur, Acur, u8, aw, PA_TOK(n), (n) & 1, lane); } while (0)
    for (int n = 0; n < N; n += 6) {
        PA_STEP(n, bA, bB, a0, a1, a2);
        if (n + 1 < N) PA_STEP(n + 1, bB, bA, a1, a2, a0);
        if (n + 2 < N) PA_STEP(n + 2, bA, bB, a2, a0, a1);
        if (n + 3 < N) PA_STEP(n + 3, bB, bA, a0, a1, a2);
        if (n + 4 < N) PA_STEP(n + 4, bA, bB, a1, a2, a0);
        if (n + 5 < N) PA_STEP(n + 5, bB, bA, a2, a0, a1);
    }
#undef PA_STEP
#undef PA_TOK
}
struct PeerB1 { v4u e[4]; f32x4 w[4]; };
struct PeerB2 { v4u vr[8]; };
struct PeerBAcc { int acc[16]; int wq[4]; float wsc, h0, h1; };
typedef float f32x2v __attribute__((ext_vector_type(2)));
__device__ __forceinline__ void pb_s1(PeerB1& a, const int* __restrict__ te, const float* __restrict__ aw, int tok, int lane) {
    const v4u* ep = (const v4u*)(te + (size_t)tok * 128 + 16 * (lane >> 3)); const f32x4* wp = (const f32x4*)(aw + (size_t)tok * 128 + 16 * (lane >> 3));
#pragma unroll
    for (int j = 0; j < 4; ++j) { a.e[j] = ep[j]; a.w[j] = wp[j]; } }
__device__ __forceinline__ int pb_col(int lane) { return 16 * (lane & 7) + 8 * ((lane >> 5) & 1) + 4 * ((lane >> 4) & 1) + 2 * ((lane >> 3) & 1); }
template <int CTRL, int RM> __device__ __forceinline__ float dpp_f(float x) { return __builtin_bit_cast(float, __builtin_amdgcn_update_dpp(0, __builtin_bit_cast(int, x), CTRL, RM, 0xf, false)); }
__device__ __forceinline__ void pb_quant(PeerBAcc& A, const PeerB1& a) {
    float mx = 0.f;
#pragma unroll
    for (int j = 0; j < 4; ++j) mx = fmaxf(mx, fmaxf(fmaxf(fabsf(a.w[j][0]), fabsf(a.w[j][1])), fmaxf(fabsf(a.w[j][2]), fabsf(a.w[j][3]))));
    mx = fmaxf(mx, dpp_f<0xb1, 0xf>(mx)); mx = fmaxf(mx, dpp_f<0x4e, 0xf>(mx)); mx = fmaxf(mx, dpp_f<0x124, 0xf>(mx)); mx = fmaxf(mx, dpp_f<0x128, 0xf>(mx));
    mx = fmaxf(mx, dpp_f<0x142, 0xa>(mx)); mx = fmaxf(mx, dpp_f<0x143, 0xc>(mx));
    mx = __builtin_bit_cast(float, __builtin_amdgcn_readlane(__builtin_bit_cast(int, mx), 63));
    const float inv = mx > 0.f ? 127.0f / mx : 0.f; A.wsc = mx * (1.0f / 127.0f);
#pragma unroll
    for (int j = 0; j < 4; ++j) A.wq[j] = (int)(((unsigned)(int)rintf(a.w[j][0] * inv) & 0xffu) | (((unsigned)(int)rintf(a.w[j][1] * inv) & 0xffu) << 8) |
                                               (((unsigned)(int)rintf(a.w[j][2] * inv) & 0xffu) << 16) | (((unsigned)(int)rintf(a.w[j][3] * inv) & 0xffu) << 24));
}
template <int HF> __device__ __forceinline__ void pb_s2(PeerB2& b, const PeerB1& a, const unsigned char* __restrict__ v8x, int lane, int hot = 0) {
    const int c = lane & 7;
#pragma unroll
    for (int m = 0; m < 8; ++m) { unsigned e = a.e[2 * HF + (m >> 2)][m & 3]; if (hot) e &= 255u; b.vr[m] = *(const v4u*)(v8x + (size_t)e * 128 + 16 * c); }
}
__device__ __forceinline__ float swap32_add(float lo, float hi) { const auto r = __builtin_amdgcn_permlane32_swap(__builtin_bit_cast(unsigned, lo), __builtin_bit_cast(unsigned, hi), false, false);
    return __builtin_bit_cast(float, r[0]) + __builtin_bit_cast(float, r[1]); }
__device__ __forceinline__ float swap16_add(float lo, float hi) { const auto r = __builtin_amdgcn_permlane16_swap(__builtin_bit_cast(unsigned, lo), __builtin_bit_cast(unsigned, hi), false, false);
    return __builtin_bit_cast(float, r[0]) + __builtin_bit_cast(float, r[1]); }
template <int HF> __device__ __forceinline__ void pb_s3(PeerBAcc& A, const PeerB2& b, const PeerB1& a, float* out, int tok, int x, int lane) {
    if (HF == 0) {
#pragma unroll
        for (int j = 0; j < 16; ++j) A.acc[j] = 0;
    }
#pragma unroll
    for (int gg = 0; gg < 2; ++gg)
#pragma unroll
        for (int d = 0; d < 4; ++d) { const unsigned ra = b.vr[4 * gg][d], rb = b.vr[4 * gg + 1][d], rc = b.vr[4 * gg + 2][d], rd = b.vr[4 * gg + 3][d];
            const unsigned t0 = __builtin_amdgcn_perm(rb, ra, 0x05010400u), t1 = __builtin_amdgcn_perm(rb, ra, 0x07030602u), t2 = __builtin_amdgcn_perm(rd, rc, 0x05010400u), t3 = __builtin_amdgcn_perm(rd, rc, 0x07030602u);
            const unsigned c0 = __builtin_amdgcn_perm(t2, t0, 0x05040100u), c1 = __builtin_amdgcn_perm(t2, t0, 0x07060302u), c2 = __builtin_amdgcn_perm(t3, t1, 0x05040100u), c3 = __builtin_amdgcn_perm(t3, t1, 0x07060302u);
            const int w4 = A.wq[2 * HF + gg];
            A.acc[4 * d] = __builtin_amdgcn_sdot4((int)c0, w4, A.acc[4 * d], false); A.acc[4 * d + 1] = __builtin_amdgcn_sdot4((int)c1, w4, A.acc[4 * d + 1], false);
            A.acc[4 * d + 2] = __builtin_amdgcn_sdot4((int)c2, w4, A.acc[4 * d + 2], false); A.acc[4 * d + 3] = __builtin_amdgcn_sdot4((int)c3, w4, A.acc[4 * d + 3], false); }
    if (HF == 1) {
        int r8[8], r4[4], r2[2];
#pragma unroll
        for (int j = 0; j < 8; ++j) { const bool up = (lane & 32) != 0; const int keep = up ? A.acc[j + 8] : A.acc[j], send = up ? A.acc[j] : A.acc[j + 8]; r8[j] = keep + __shfl_xor(send, 32); }
#pragma unroll
        for (int j = 0; j < 4; ++j) { const bool up = (lane & 16) != 0; const int keep = up ? r8[j + 4] : r8[j], send = up ? r8[j] : r8[j + 4]; r4[j] = keep + __shfl_xor(send, 16); }
#pragma unroll
        for (int j = 0; j < 2; ++j) { const bool up = (lane & 8) != 0; const int keep = up ? r4[j + 2] : r4[j], send = up ? r4[j] : r4[j + 2];
            r2[j] = keep + __builtin_amdgcn_update_dpp(0, send, 0x128, 0xf, 0xf, false); }
        f32x2v h2; h2.x = A.h0 + A.wsc * (float)r2[0]; h2.y = A.h1 + A.wsc * (float)r2[1];
        *(f32x2v*)(out + (size_t)tok * 1024 + 128 * x + pb_col(lane)) = h2;
    }
}
__device__ __forceinline__ void peer_b_run(const unsigned char* __restrict__ v8x, const int* __restrict__ te, const float* __restrict__ aw, float* out, int wrank, int wstep, int x, int lane, int hot = 0) {
    const int N = wrank < T ? (T - wrank + wstep - 1) / wstep : 0;
#define PB_TOK(n) (wrank + (n) * wstep)
#define PB_LOADH(n) do { const f32x2v h2_ = *(const f32x2v*)(out + (size_t)PB_TOK(n) * 1024 + 128 * x + pb_col(lane)); A.h0 = h2_.x; A.h1 = h2_.y; } while (0)
    if (N == 0) return;
    PeerB1 s0, s1; PeerB2 bA, bB; PeerBAcc A;
    pb_s1(s0, te, aw, PB_TOK(0), lane); if (N > 1) pb_s1(s1, te, aw, PB_TOK(1), lane);
    pb_s2<0>(bA, s0, v8x, lane, hot);
    for (int n = 0; n < N; n += 2) {
        pb_s2<1>(bB, s0, v8x, lane, hot); PB_LOADH(n); pb_quant(A, s0);
        pb_s3<0>(A, bA, s0, out, PB_TOK(n), x, lane);
        if (n + 1 < N) pb_s2<0>(bA, s1, v8x, lane, hot);
        pb_s3<1>(A, bB, s0, out, PB_TOK(n), x, lane);
        if (n + 2 < N) pb_s1(s0, te, aw, PB_TOK(n + 2), lane);
        if (n + 1 < N) {
            pb_s2<1>(bB, s1, v8x, lane, hot); PB_LOADH(n + 1); pb_quant(A, s1);
            pb_s3<0>(A, bA, s1, out, PB_TOK(n + 1), x, lane);
            if (n + 2 < N) pb_s2<0>(bA, s0, v8x, lane, hot);
            pb_s3<1>(A, bB, s1, out, PB_TOK(n + 1), x, lane);
            if (n + 3 < N) pb_s1(s1, te, aw, PB_TOK(n + 3), lane);
        }
    }
#undef PB_LOADH
#undef PB_TOK
}

__global__ void __launch_bounds__(NWAVES * 64, 2) mk_fwd(Args args) {
    extern __shared__ __attribute__((aligned(16))) unsigned char lds[];
    Frame F;
    F.lds = (LAS unsigned char*)lds;
    F.MISC = (volatile LAS unsigned*)(F.lds + MISC_OFF);
    F.tid = threadIdx.x; F.lane = F.tid & 63; F.wave = __builtin_amdgcn_readfirstlane(F.tid >> 6);
    F.G = gridDim.x; { const int bx = blockIdx.x; F.vcu = (F.G % 8 == 0) ? (bx % 8) * (F.G / 8) + bx / 8 : bx; }
    F.out = args.out; F.ws = args.ws;
    unsigned char* ws = args.ws;
    F.ctl = (gu32*)(ws + WS_CTL);
    for (int u = F.tid; u < (LDS_BYTES - LDSCTL_OFF) / 4; u += NWAVES * 64) ((LAS unsigned*)(F.lds + LDSCTL_OFF))[u] = 0u;
    __syncthreads();
    XcdBarrier bar; bar.bar = (unsigned*)(F.ctl + CW_BAR); bar.x = 0; bar.st = nullptr;
    if (N_LAUNCHES != PER_PHASE) bar = xcd_barrier_post((unsigned*)(F.ctl + CW_BAR), F.MISC + 8);
    if (N_LAUNCHES != PER_PHASE) { if (F.tid == 0) { const unsigned xid = xb_xcc_id(); F.MISC[12] = xid; F.MISC[13] = xb_add((unsigned*)(F.ctl + CW_TICKET) + 64 * xid, 1u); } __syncthreads(); }
#define GRID_BAR() do { if (N_LAUNCHES != PER_PHASE) xcd_barrier(bar); } while (0)
    const int lo = args.ph_lo, hi = args.ph_hi;
#define IN(k) (lo <= (k) && (k) < hi)
#define BOTH(k) (IN(k) && IN((k) + 1))
#ifndef DUP_PHASE
#define DUP_PHASE (-1)
#endif
#define NREP(k) ((DUP_PHASE == (k)) ? 2 : 1)
    const int gw = F.vcu * NWAVES + F.wave, NGW = F.G * NWAVES;
    bf16* const WinT = (bf16*)(ws + WS_WIN); bf16* const WvT = (bf16*)(ws + WS_WV); bf16* const WkvT = (bf16*)(ws + WS_WKV); bf16* const WbrT = (bf16*)(ws + WS_WBR);
    bf16* const WoutT = (bf16*)(ws + WS_WOUT); bf16* const WqT = (bf16*)(ws + WS_WQ); bf16* const KEYS = (bf16*)(ws + WS_KEYS); bf16* const PWT = (bf16*)(ws + WS_PWT);
    bf16* const MEMN = (bf16*)(ws + WS_MEMN); bf16* const KMEM = (bf16*)(ws + WS_KMEM); bf16* const VTMEM = (bf16*)(ws + WS_VTMEM); float* const RSTDX = (float*)(ws + WS_RSTDX);
    const unsigned char* const U8 = ws + WS_U8; const unsigned char* const V8 = ws + WS_V8; const float* const SU = (const float*)(ws + WS_SU); const float* const SV = (const float*)(ws + WS_SV);
    bf16* const QN = (bf16*)(ws + WS_QN); bf16* const KN = (bf16*)(ws + WS_KN); bf16* const VT = (bf16*)(ws + WS_VT); bf16* const PP = (bf16*)(ws + WS_PP); bf16* const XQ = (bf16*)(ws + WS_XQ);
    bf16* const GATE = (bf16*)(ws + WS_GATE); bf16* const MERGED = (bf16*)(ws + WS_MERGED); bf16* const HB = (bf16*)(ws + WS_HB); bf16* const QB = (bf16*)(ws + WS_QB);
    int* const TE = (int*)(ws + WS_TE); float* const TW = (float*)(ws + WS_TW); float* const AW = (float*)(ws + WS_AW); float* const ROWSQ = (float*)(ws + WS_ROWSQ);
    bf16* const XB = (bf16*)((unsigned char*)args.out + OUT_XB); bf16* const YNA = (bf16*)((unsigned char*)args.out + OUT_YNA);
    bf16* const YPOOL = (bf16*)((unsigned char*)args.out + OUT_YPOOL); bf16* const YXA = (bf16*)((unsigned char*)args.out + OUT_YXA);

    if (IN(0)) { for (int rep = 0; rep < NREP(0); ++rep) { p0_prologue(F, args); if (rep + 1 < NREP(0)) GRID_BAR(); } if (BOTH(0)) GRID_BAR(); }

    if (IN(1)) {
      for (int rep = 0; rep < NREP(1); ++rep) {
        { pg8::Sched1 S; S.so.init(T, IN_MAIN, F.G, (int)blockIdx.x); S.A = (const char*)XB; S.Bt = (const char*)WinT; S.tstep = (size_t)256 * 1024 * 2;
          pg8::EpiProj E{RSTDX, QN, KN, PP, XQ, GATE, args.in[I_NAQG], args.in[I_NAKG], args.in[I_GATEB]};
          pg8::gemm_phase<pg8::EpiProj, pg8::Sched1, true, true>(F.lds + RING_OFF, 1024, S, E); }
        { pg8::Sched1 S; S.so.init(512, T, F.G, (int)blockIdx.x); S.A = (const char*)WvT; S.Bt = (const char*)XB; S.tstep = (size_t)256 * 1024 * 2;
          pg8::EpiVt E{RSTDX, VT};
          pg8::gemm_phase<pg8::EpiVt, pg8::Sched1, false, true>(F.lds + RING_OFF, 1024, S, E); }
        for (int t = gw; t < 512; t += NGW) memkv_tile(MEMN, WkvT, args.in[I_XAKG], args.in[I_XAQG], KMEM, VTMEM, t, F.lane);
        if (rep + 1 < NREP(1)) GRID_BAR();
      }
        if (BOTH(1)) GRID_BAR();
    }

    if (IN(2)) {
      for (int rep = 0; rep < NREP(2); ++rep) {
        LAS float* rpl = (LAS float*)(F.lds + RING_OFF + F.wave * 16384);
        for (int i = F.lane; i < 15 * 31; i += 64) rpl[i] = args.in[I_RPB][F.wave * 15 * 31 + i];
        LDS_WAIT(); asm volatile("" ::: "memory");
        for (int i = F.vcu; i < 256; i += F.G)
            for (int k = 0; k < 8; ++k) { const int idx = i * 8 + k, b = idx >> 9, r = (idx >> 2) & 127, jb = idx & 3; na_item(QN, KN, VT, rpl, YNA, b, r, jb, F.wave, F.lane); }
        for (int i = F.vcu; i < 256; i += F.G) pool_wg(PP, PWT, YPOOL, F.lds + RING_OFF, i * 128, F.wave, F.lane);
        { const int pair = F.vcu & 15, xb = pair >> 2, xh = pair & 3, slot = F.vcu >> 4, nslot = F.G >> 4;
          __syncthreads(); xa_fill_lds(KMEM, VTMEM, F.lds + RING_OFF, xb, xh, F.tid); __syncthreads();
          if (slot < nslot) for (int n = slot * NWAVES + F.wave; n < 512; n += nslot * NWAVES) xa_item(XQ, F.lds + RING_OFF, YXA, (xb * 512 + n) * 16, xh, F.lane);
          __syncthreads(); }
        if (rep + 1 < NREP(2)) GRID_BAR();
      }
        if (BOTH(2)) GRID_BAR();
    }

    if (IN(3)) {
      for (int rep = 0; rep < NREP(3); ++rep) {
        pg8::Sched3 S; S.so.init(T, D, F.G, (int)blockIdx.x); S.A = (const char*)YNA; S.Bt = (const char*)WbrT; S.tstep = (size_t)256 * 512 * 2; S.strideA = 32 * MiB; S.strideB = (size_t)1024 * 512 * 2;
        pg8::EpiMerge E{GATE, (bf16*)(ws + WS_VT)  , MERGED};
        pg8::gemm_phase<pg8::EpiMerge, pg8::Sched3, true, true>(F.lds + RING_OFF, 512, S, E);
        if (rep + 1 < NREP(3)) GRID_BAR();
      }
        if (BOTH(3)) GRID_BAR();
    }

    if (IN(4)) {
      for (int rep = 0; rep < NREP(4); ++rep) {
        pg8::Sched1 S; S.so.init(T, D, F.G, (int)blockIdx.x); S.A = (const char*)MERGED; S.Bt = (const char*)WoutT; S.tstep = (size_t)256 * 1024 * 2;
        pg8::EpiH E{args.in[I_X], F.out, HB, ROWSQ};
        pg8::gemm_phase<pg8::EpiH, pg8::Sched1, true, true>(F.lds + RING_OFF, 1024, S, E);
        if (rep + 1 < NREP(4)) { GRID_BAR(); for (int m = gw * 64 + F.lane; m < T; m += NGW * 64) ROWSQ[m] = 0.f; GRID_BAR(); }
      }
        if (BOTH(4)) GRID_BAR();
    }

    if (IN(5)) {
      for (int rep = 0; rep < NREP(5); ++rep) {
        pg8::Sched1 S; S.so.init(T, 2048, F.G, (int)blockIdx.x); S.A = (const char*)HB; S.Bt = (const char*)WqT; S.tstep = (size_t)256 * 1024 * 2;
        pg8::EpiQ E{ROWSQ, QB};
        pg8::gemm_phase<pg8::EpiQ, pg8::Sched1, true, true>(F.lds + RING_OFF, 1024, S, E);
        if (rep + 1 < NREP(5)) GRID_BAR();
      }
        if (BOTH(5)) GRID_BAR();
    }

    if (IN(6)) {
        LAS int* lscr = (LAS int*)(F.lds + RING_OFF + 65536 + F.wave * 8192);
        for (int tok = gw; tok < T; tok += NGW) hq_token(HB, ROWSQ, ws + WS_HQ, (float*)(ws + WS_HS), tok, F.lane);
        { const int th = F.vcu & 7, slot = F.vcu >> 3, nslot = F.G >> 3;
          __syncthreads(); topk_fill_lds(KEYS, F.lds + RING_OFF, th, F.tid); __syncthreads();
          for (int rep = 0; rep < NREP(6); ++rep) { for (int n = slot * NWAVES + F.wave; n < 2048; n += nslot * NWAVES) topk_item(QB, F.lds + RING_OFF, TE, TW, lscr, n * 16, th, F.lane); if (rep + 1 < NREP(6)) GRID_BAR(); }
          __syncthreads(); }
        if (BOTH(6)) GRID_BAR();
    }

    if (IN(7)) {
        int x0 = 0, nxs = 8, wrank = (int)blockIdx.x * NWAVES + F.wave, wstep = F.G * NWAVES;
        if (N_LAUNCHES != PER_PHASE) { const unsigned xid = F.MISC[12], rk = F.MISC[13]; unsigned nx = 0, below = 0, mine = 0;
            for (unsigned j = 0; j < 16; ++j) { const unsigned c = xb_ld((unsigned*)(F.ctl + CW_BAR) + XB_XCNT(j)); nx += c > 0u; below += (c > 0u && j < xid); mine = (j == xid) ? c : mine; }
            if (nx == 8 && mine > 0 && rk < mine) { x0 = (int)below; nxs = 1; wrank = (int)rk * NWAVES + F.wave; wstep = (int)mine * NWAVES; } }
        else if ((F.G & 7) == 0) { x0 = (int)blockIdx.x & 7; nxs = 1; wrank = ((int)blockIdx.x >> 3) * NWAVES + F.wave; wstep = (F.G >> 3) * NWAVES; }
        for (int xs = 0; xs < nxs; ++xs) peer_a_run(ws + WS_HQ, (const float*)(ws + WS_HS), U8, SU, SV, TE, TW, args.probe ? (float*)QB : AW, wrank, wstep, x0 + xs, F.lane, args.probe == 2);
        if (N_LAUNCHES != PER_PHASE) xcd_barrier(bar);
    }
    if (IN(8)) {
        int x0 = 0, nxs = 8, wrank = (int)blockIdx.x * NWAVES + F.wave, wstep = F.G * NWAVES;
        if (N_LAUNCHES != PER_PHASE) { const unsigned xid = F.MISC[12], rk = F.MISC[13]; unsigned nx = 0, below = 0, mine = 0;
            for (unsigned j = 0; j < 16; ++j) { const unsigned c = xb_ld((unsigned*)(F.ctl + CW_BAR) + XB_XCNT(j)); nx += c > 0u; below += (c > 0u && j < xid); mine = (j == xid) ? c : mine; }
            if (nx == 8 && mine > 0 && rk < mine) { x0 = (int)below; nxs = 1; wrank = (int)rk * NWAVES + F.wave; wstep = (int)mine * NWAVES; } }
        else if ((F.G & 7) == 0) { x0 = (int)blockIdx.x & 7; nxs = 1; wrank = ((int)blockIdx.x >> 3) * NWAVES + F.wave; wstep = (F.G >> 3) * NWAVES; }
        for (int xs = 0; xs < nxs; ++xs) peer_b_run(V8 + (size_t)(x0 + xs) * (2 * MiB), TE, AW, args.probe ? (float*)QB : F.out, wrank, wstep, x0 + xs, F.lane, args.probe == 2);
    }
#undef IN
#undef BOTH
#undef GRID_BAR
}

extern "C" void kernel_launch(void* const* d_in, const int* in_sizes, int n_in, void* d_out, int out_size, void* d_ws, size_t ws_size, hipStream_t stream) {
    static int grid = 0;
    if (grid == 0) {
        if (n_in != 23 || in_sizes[0] != T * D || out_size != T * D || ws_size < WS_END) { fprintf(stderr, "kernel_launch: unexpected shapes: n_in %d in0 %d out %d ws %zu\n", n_in, n_in > 0 ? in_sizes[0] : -1, out_size, ws_size); grid = -1; return; }
        int dev = 0, cus = 0, per_cu = 0;
        if (hipGetDevice(&dev) != hipSuccess || hipDeviceGetAttribute(&cus, hipDeviceAttributeMultiprocessorCount, dev) != hipSuccess) { fprintf(stderr, "kernel_launch: device query failed\n"); grid = -1; return; }
        if (hipFuncSetAttribute((const void*)mk_fwd, hipFuncAttributeMaxDynamicSharedMemorySize, LDS_BYTES) != hipSuccess) { fprintf(stderr, "kernel_launch: hipFuncSetAttribute failed\n"); grid = -1; return; }
        if (hipOccupancyMaxActiveBlocksPerMultiprocessor(&per_cu, (const void*)mk_fwd, NWAVES * 64, LDS_BYTES) != hipSuccess || per_cu < 1)
            fprintf(stderr, "kernel_launch: note: occupancy query reports %d workgroups per CU\n", per_cu);
        (void)hipGetLastError();
        grid = cus;
    }
    if (grid < 0) return;
    if (hipMemsetAsync((char*)d_ws + WS_CTL, 0, CTL_ZERO_BYTES, stream) != hipSuccess) { fprintf(stderr, "kernel_launch: memset failed\n"); return; }
    Args a{};
    for (int i = 0; i < 23; ++i) a.in[i] = (const float*)d_in[i];
    a.out = (float*)d_out; a.ws = (unsigned char*)d_ws;
    for (int li = 0; li < N_LAUNCHES; ++li) {
        a.ph_lo = (N_LAUNCHES == PER_PHASE) ? li : 0; a.ph_hi = (N_LAUNCHES == PER_PHASE) ? li + 1 : PER_PHASE;
        hipLaunchKernelGGL(mk_fwd, dim3(grid), dim3(NWAVES * 64), LDS_BYTES, stream, a);
#ifdef HOST_DUP_PHASE
        if (N_LAUNCHES == PER_PHASE && li == HOST_DUP_PHASE) { if (li == 4) (void)hipMemsetAsync((char*)d_ws + WS_ROWSQ, 0, (size_t)T * 4, stream);
#ifdef PROBE_MODE
            a.probe = PROBE_MODE;
#endif
            hipLaunchKernelGGL(mk_fwd, dim3(grid), dim3(NWAVES * 64), LDS_BYTES, stream, a); a.probe = 0; }
#endif
        const hipError_t le = hipPeekAtLastError();
        if (le != hipSuccess) { fprintf(stderr, "kernel_launch: launch %d failed: %s\n", li, hipGetErrorName(le)); break; }
    }
}
```

```cpp
#define MK_N_LAUNCHES 1
#include <hip/hip_runtime.h>
#include <cstdio>
#include <cstdint>

#ifndef MK_N_LAUNCHES
#define MK_N_LAUNCHES 1
#endif

namespace pg8 {
#define PG8_LAS __attribute__((address_space(3)))
typedef unsigned short bf16_t;
typedef short bf16x8 __attribute__((ext_vector_type(8)));
typedef float f32x4 __attribute__((ext_vector_type(4)));
typedef unsigned u32x4 __attribute__((ext_vector_type(4)));
typedef unsigned u32x2 __attribute__((ext_vector_type(2)));
constexpr int BM = 256, BK = 64, HALF = 128, HTB = HALF * BK * 2  , STAGE_BYTES = 8 * HTB, NXCD = 8, WGM = 8;

__host__ __device__ __forceinline__ int lds_byte(int r, int c) { const int st = (r >> 4) * 2 + (c >> 5), rr = r & 15, cc = c & 31, ob = rr * 64 + cc * 2; return st * 1024 + (ob ^ (((ob >> 9) & 1) << 5)); }
__host__ __device__ __forceinline__ void stage_rc(int b, int& R, int& C) { const int st = b / 1024, sb = b % 1024, swz = sb ^ (((sb >> 9) & 1) << 5); R = (st >> 1) * 16 + swz / 64; C = (st & 1) * 32 + (swz % 64) / 2; }
__host__ __device__ __forceinline__ int perm32(int rho) { const int n = rho >> 4, i = rho & 15; return 8 * (i >> 2) + 4 * n + (i & 3); }

struct Unit { int pm, pn, br; };

struct StaticOrder {
    int nM, nN, nwg, G, c;
    __host__ __device__ void init(int M, int N, int G_, int c_) { nM = M / BM; nN = N / BM; nwg = nM * nN; G = G_; c = c_; }
    __host__ __device__ bool next(int i, Unit& u) const {
        const long L = (long)i * G + c; if (L >= nwg) return false;
        int wgid = (int)L; { const int q = nwg / NXCD, r = nwg % NXCD, xcd = wgid % NXCD, off = wgid / NXCD; wgid = (xcd < r ? xcd * (q + 1) : r * (q + 1) + (xcd - r) * q) + off; }
        const int nig = WGM * nN, gid = wgid / nig, fm = gid * WGM, gsz = (nM - fm) < WGM ? (nM - fm) : WGM;
        u.pm = fm + ((wgid % nig) % gsz); u.pn = (wgid % nig) / gsz; return true;
    }
};
struct Sched1 {
    StaticOrder so; const char* A; const char* Bt; size_t tstep;
    __device__ __forceinline__ bool next(int i, Unit& u) const { u.br = 0; return so.next(i, u); }
    __device__ __forceinline__ const char* abase(const Unit& u) const { return A + (size_t)u.pm * tstep; }
    __device__ __forceinline__ const char* bbase(const Unit& u) const { return Bt + (size_t)u.pn * tstep; }
    __device__ __forceinline__ void a_ready(const Unit&) const {}
    __device__ __forceinline__ void done(const Unit&) const {}
};
struct Sched3 {
    StaticOrder so; const char* A; const char* Bt; size_t tstep, strideA, strideB;
    __device__ __forceinline__ bool next(int i, Unit& u) const { u.br = i % 3; return so.next(i / 3, u); }
    __device__ __forceinline__ const char* abase(const Unit& u) const { return A + (size_t)u.br * strideA + (size_t)u.pm * tstep; }
    __device__ __forceinline__ const char* bbase(const Unit& u) const { return Bt + (size_t)u.br * strideB + (size_t)u.pn * tstep; }
    __device__ __forceinline__ void a_ready(const Unit&) const {}
    __device__ __forceinline__ void done(const Unit&) const {}
};

typedef float f32x2_t __attribute__((ext_vector_type(2))); typedef __bf16 bf16x2v_t __attribute__((ext_vector_type(2)));
__device__ __forceinline__ unsigned cvt_pk_bf16(float lo, float hi) { const f32x2_t v = {lo, hi}; const bf16x2v_t b = __builtin_convertvector(v, bf16x2v_t); return __builtin_bit_cast(unsigned, b); }
__device__ __forceinline__ u32x4 pack8(const f32x4 a, const f32x4 b) { u32x4 w; w.x = cvt_pk_bf16(a[0], a[1]); w.y = cvt_pk_bf16(a[2], a[3]); w.z = cvt_pk_bf16(b[0], b[1]); w.w = cvt_pk_bf16(b[2], b[3]); return w; }
__device__ __forceinline__ float bflo(unsigned u) { return __builtin_bit_cast(float, u << 16); }
__device__ __forceinline__ float bfhi(unsigned u) { return __builtin_bit_cast(float, u & 0xffff0000u); }


constexpr float RMS_EPS = 1e-6f;

struct EpiProj {
    static constexpr bool PERM = true, AFTER_DRAIN = false;
    const float* rstd; bf16_t *qn, *kn, *pp, *xq, *gates; const float *qg, *kg, *gate_b;
    __device__ __forceinline__ void operator()(const f32x4 (&acc)[2][2][4][2], const Unit& u, int wr, int wc, int fr, int fq) const {
        const int pn = u.pn, row0 = u.pm * BM + wr * 64 + fr, lc0 = 64 * wc + 8 * fq;
        float rsv[2][4];
#pragma unroll
        for (int ai = 0; ai < 2; ++ai)
#pragma unroll
            for (int m = 0; m < 4; ++m) rsv[ai][m] = rstd[row0 + ai * HALF + m * 16];
        if (pn < 4) {
            const bool isq = pn < 2; bf16_t* O = isq ? qn : kn; const float* g = isq ? qg : kg; const float post = isq ? 0.125f : 1.0f;
            f32x4 gv[2][2];
#pragma unroll
            for (int bj = 0; bj < 2; ++bj)
#pragma unroll
                for (int n = 0; n < 2; ++n) gv[bj][n] = *(const f32x4*)(g + 32 * bj + 8 * fq + 4 * n);
            const int colbase = (pn & 1) * 256 + lc0;
#pragma unroll
            for (int ai = 0; ai < 2; ++ai)
#pragma unroll
                for (int m = 0; m < 4; ++m) {
                    const int row = row0 + ai * HALF + m * 16; const float rs = rsv[ai][m];
                    f32x4 v[2][2]; float ss = 0.f;
#pragma unroll
                    for (int bj = 0; bj < 2; ++bj)
#pragma unroll
                        for (int n = 0; n < 2; ++n) { v[bj][n] = acc[ai][bj][m][n] * rs; ss += (v[bj][n][0] * v[bj][n][0] + v[bj][n][1] * v[bj][n][1]) + (v[bj][n][2] * v[bj][n][2] + v[bj][n][3] * v[bj][n][3]); }
                    ss += __shfl_xor(ss, 16); ss += __shfl_xor(ss, 32);
                    const float r = rsqrtf(ss * (1.0f / 64.0f) + RMS_EPS) * post;
#pragma unroll
                    for (int bj = 0; bj < 2; ++bj) *(u32x4*)(O + (size_t)row * 512 + colbase + 32 * bj) = pack8(v[bj][0] * r * gv[bj][0], v[bj][1] * r * gv[bj][1]);
                }
        } else if (pn < 8) {
            bf16_t* O = pn < 6 ? pp : xq; const int colbase = (pn & 1) * 256 + lc0;
#pragma unroll
            for (int ai = 0; ai < 2; ++ai)
#pragma unroll
                for (int m = 0; m < 4; ++m) {
                    const int row = row0 + ai * HALF + m * 16; const float rs = rsv[ai][m];
#pragma unroll
                    for (int bj = 0; bj < 2; ++bj) *(u32x4*)(O + (size_t)row * 512 + colbase + 32 * bj) = pack8(acc[ai][bj][m][0] * rs, acc[ai][bj][m][1] * rs);
                }
        } else {
            const int gcol0 = (pn - 8) * 256 + lc0;
            f32x4 bv[2][2];
#pragma unroll
            for (int bj = 0; bj < 2; ++bj)
#pragma unroll
                for (int n = 0; n < 2; ++n) bv[bj][n] = *(const f32x4*)(gate_b + gcol0 + 32 * bj + 4 * n);
#pragma unroll
            for (int ai = 0; ai < 2; ++ai)
#pragma unroll
                for (int m = 0; m < 4; ++m) {
                    const int row = row0 + ai * HALF + m * 16; const float rs = rsv[ai][m];
#pragma unroll
                    for (int bj = 0; bj < 2; ++bj) {
                        f32x4 o[2];
#pragma unroll
                        for (int n = 0; n < 2; ++n) { const f32x4 z = acc[ai][bj][m][n] * rs + bv[bj][n];
#pragma unroll
                            for (int i = 0; i < 4; ++i) o[n][i] = __builtin_amdgcn_rcpf(1.0f + __expf(-z[i])); }
                        *(u32x4*)(gates + (size_t)row * 3072 + gcol0 + 32 * bj) = pack8(o[0], o[1]);
                    }
                }
        }
    }
};
struct EpiVt {
    static constexpr bool PERM = true, AFTER_DRAIN = false;
    const float* rstd; bf16_t* Vt;
    __device__ __forceinline__ void operator()(const f32x4 (&acc)[2][2][4][2], const Unit& u, int wr, int wc, int fr, int fq) const {
        const int ch0 = u.pm * BM + wr * 64 + fr, tok0 = u.pn * BM + wc * 32 + 8 * fq, b = tok0 >> 13, t0 = tok0 & 8191;
        f32x4 rv[2][2];
#pragma unroll
        for (int bj = 0; bj < 2; ++bj)
#pragma unroll
            for (int n = 0; n < 2; ++n) rv[bj][n] = *(const f32x4*)(rstd + tok0 + bj * HALF + 4 * n);
#pragma unroll
        for (int ai = 0; ai < 2; ++ai)
#pragma unroll
            for (int m = 0; m < 4; ++m) { const int ch = ch0 + ai * HALF + m * 16; bf16_t* rowp = Vt + ((size_t)(b * 512 + ch) * 8192 + t0);
#pragma unroll
                for (int bj = 0; bj < 2; ++bj) *(u32x4*)(rowp + bj * HALF) = pack8(acc[ai][bj][m][0] * rv[bj][0], acc[ai][bj][m][1] * rv[bj][1]); }
    }
};
struct EpiMerge {
    static constexpr bool PERM = true, AFTER_DRAIN = false;
    const bf16_t* gates; bf16_t* pa; bf16_t* merged;
    __device__ __forceinline__ void operator()(const f32x4 (&acc)[2][2][4][2], const Unit& u, int wr, int wc, int fr, int fq) const {
        const int row0 = u.pm * BM + wr * 64 + fr, col0 = u.pn * BM + wc * 32 + 8 * fq, br = u.br;
        const bf16_t* src = br == 1 ? pa : merged; bf16_t* dst = br == 0 ? pa : merged;
#pragma unroll
        for (int ai = 0; ai < 2; ++ai) {
            u32x4 g8[4][2], p8[4][2];
#pragma unroll
            for (int m = 0; m < 4; ++m)
#pragma unroll
                for (int bj = 0; bj < 2; ++bj) { const int row = row0 + ai * HALF + m * 16;
                    g8[m][bj] = *(const u32x4*)(gates + (size_t)row * 3072 + br * 1024 + col0 + bj * HALF);
                    p8[m][bj] = (u32x4){0u, 0u, 0u, 0u}; if (br > 0) p8[m][bj] = *(const u32x4*)(src + (size_t)row * 1024 + col0 + bj * HALF); }
            __builtin_amdgcn_sched_barrier(0);
#pragma unroll
            for (int m = 0; m < 4; ++m)
#pragma unroll
                for (int bj = 0; bj < 2; ++bj) { const int row = row0 + ai * HALF + m * 16; const u32x4 g = g8[m][bj], q = p8[m][bj];
                    f32x4 a = acc[ai][bj][m][0], b = acc[ai][bj][m][1];
                    a[0] = a[0] * bflo(g.x) + bflo(q.x); a[1] = a[1] * bfhi(g.x) + bfhi(q.x); a[2] = a[2] * bflo(g.y) + bflo(q.y); a[3] = a[3] * bfhi(g.y) + bfhi(q.y);
                    b[0] = b[0] * bflo(g.z) + bflo(q.z); b[1] = b[1] * bfhi(g.z) + bfhi(q.z); b[2] = b[2] * bflo(g.w) + bflo(q.w); b[3] = b[3] * bfhi(g.w) + bfhi(q.w);
                    *(u32x4*)(dst + (size_t)row * 1024 + col0 + bj * HALF) = pack8(a, b); }
            __builtin_amdgcn_sched_barrier(0);
        }
    }
};
struct EpiH {
    static constexpr bool PERM = true, AFTER_DRAIN = false;
    const float* x; float* out; bf16_t* hb; float* rowsq;
    __device__ __forceinline__ void operator()(const f32x4 (&acc)[2][2][4][2], const Unit& u, int wr, int wc, int fr, int fq) const {
        const int row0 = u.pm * BM + wr * 64 + fr, col0 = u.pn * BM + wc * 32 + 8 * fq;
#pragma unroll
        for (int ai = 0; ai < 2; ++ai) {
            f32x4 xv[4][2][2];
#pragma unroll
            for (int m = 0; m < 4; ++m)
#pragma unroll
                for (int bj = 0; bj < 2; ++bj) { const size_t o = (size_t)(row0 + ai * HALF + m * 16) * 1024 + col0 + bj * HALF; xv[m][bj][0] = *(const f32x4*)(x + o); xv[m][bj][1] = *(const f32x4*)(x + o + 4); }
            __builtin_amdgcn_sched_barrier(0);
#pragma unroll
            for (int m = 0; m < 4; ++m) { const int row = row0 + ai * HALF + m * 16; float ss = 0.f;
#pragma unroll
                for (int bj = 0; bj < 2; ++bj) { const size_t o = (size_t)row * 1024 + col0 + bj * HALF;
                    const f32x4 h0 = xv[m][bj][0] + acc[ai][bj][m][0], h1 = xv[m][bj][1] + acc[ai][bj][m][1];
                    *(f32x4*)(out + o) = h0; *(f32x4*)(out + o + 4) = h1; *(u32x4*)(hb + o) = pack8(h0, h1);
                    ss += (h0[0] * h0[0] + h0[1] * h0[1]) + (h0[2] * h0[2] + h0[3] * h0[3]) + (h1[0] * h1[0] + h1[1] * h1[1]) + (h1[2] * h1[2] + h1[3] * h1[3]); }
                ss += __shfl_xor(ss, 16); ss += __shfl_xor(ss, 32);
                if (fq == 0) atomicAdd(rowsq + row, ss); }
            __builtin_amdgcn_sched_barrier(0);
        }
    }
};
struct EpiQ {
    static constexpr bool PERM = true, AFTER_DRAIN = false;
    const float* rowsq; bf16_t* qb;
    __device__ __forceinline__ void operator()(const f32x4 (&acc)[2][2][4][2], const Unit& u, int wr, int wc, int fr, int fq) const {
        const int row0 = u.pm * BM + wr * 64 + fr, col0 = u.pn * BM + wc * 32 + 8 * fq;
        float rq[2][4];
#pragma unroll
        for (int ai = 0; ai < 2; ++ai)
#pragma unroll
            for (int m = 0; m < 4; ++m) rq[ai][m] = rowsq[row0 + ai * HALF + m * 16];
#pragma unroll
        for (int ai = 0; ai < 2; ++ai)
#pragma unroll
            for (int m = 0; m < 4; ++m) { const int row = row0 + ai * HALF + m * 16; const float r = rsqrtf(rq[ai][m] * (1.0f / 1024.0f) + RMS_EPS);
#pragma unroll
                for (int bj = 0; bj < 2; ++bj) *(u32x4*)(qb + (size_t)row * 2048 + col0 + bj * HALF) = pack8(acc[ai][bj][m][0] * r, acc[ai][bj][m][1] * r); }
    }
};

template <class Epi, class Sched, bool ALIGN_EPI = false, bool SP2 = false>
__device__ __forceinline__ void gemm_phase(PG8_LAS unsigned char* lds, const int K, const Sched& S, const Epi& E) {
    const int tid = threadIdx.x, wid = __builtin_amdgcn_readfirstlane(tid >> 6), lane = tid & 63, wr = wid >> 2, wc = wid & 3, fr = lane & 15, fq = lane >> 4;
    const int nt = K / BK;
    unsigned voffA[2], voffB[2];
#pragma unroll
    for (int i = 0; i < 2; ++i) { int R, C; stage_rc(tid * 16 + i * 8192, R, C); const int Rb = Epi::PERM ? ((R & ~31) + perm32(R & 31)) : R;
        voffA[i] = (unsigned)(R * K + C) * 2u; voffB[i] = (unsigned)(Rb * K + C) * 2u; }
    const size_t kstep = (size_t)(BK * 2);
    const size_t hstep = (size_t)HALF * K * 2;
    const size_t tstep = 2 * hstep;
    const unsigned ldsw = (unsigned)wid * 1024u;
    const int aoff = lds_byte(wr * 64 + fr, fq * 8), boff = lds_byte(wc * 32 + fr, fq * 8);
#define PG8_SA(b, h) (((b) * 2 + (h)) * HTB)
#define PG8_SB(b, h) ((4 + (b) * 2 + (h)) * HTB)
#define PG8_STAGE(bufoff, gbase, voff) do { _Pragma("unroll") for (int _i = 0; _i < 2; ++_i) \
        __builtin_amdgcn_global_load_lds((const unsigned*)((const char*)(gbase) + (voff)[_i]), (PG8_LAS unsigned*)(lds + (bufoff) + ldsw + _i * 8192), 16, 0, 0); } while (0)
#define PG8_LDA(dst, b, h) do { _Pragma("unroll") for (int m = 0; m < 4; ++m) _Pragma("unroll") for (int k = 0; k < 2; ++k) dst[m][k] = *(const PG8_LAS bf16x8*)(lds + PG8_SA(b, h) + aoff + m * 2048 + k * 1024); } while (0)
#define PG8_LDB(dst, b, h) do { _Pragma("unroll") for (int n = 0; n < 2; ++n) _Pragma("unroll") for (int k = 0; k < 2; ++k) dst[n][k] = *(const PG8_LAS bf16x8*)(lds + PG8_SB(b, h) + boff + n * 2048 + k * 1024); } while (0)
#define PG8_MMA(ai, bj, At, Bt) do { __builtin_amdgcn_s_setprio(1); _Pragma("unroll") for (int m = 0; m < 4; ++m) _Pragma("unroll") for (int n = 0; n < 2; ++n) _Pragma("unroll") for (int k = 0; k < 2; ++k) \
        acc[ai][bj][m][n] = __builtin_amdgcn_mfma_f32_16x16x32_bf16(Bt[n][k], At[m][k], acc[ai][bj][m][n], 0, 0, 0); __builtin_amdgcn_s_setprio(0); } while (0)
#define PG8_WAIT_V(n) asm volatile("s_waitcnt vmcnt(" #n ")" ::: "memory")
#define PG8_WAIT_L(n) asm volatile("s_waitcnt lgkmcnt(" #n ")" ::: "memory")
#define PG8_BAR __builtin_amdgcn_s_barrier()
#define PG8_SCHED __builtin_amdgcn_sched_barrier(0)
    Unit cur, nxt; int ui = 0;
    if (!S.next(0, cur)) return;
    f32x4 acc[2][2][4][2];
#pragma unroll
    for (int a = 0; a < 2; ++a)
#pragma unroll
        for (int b = 0; b < 2; ++b)
#pragma unroll
            for (int m = 0; m < 4; ++m)
#pragma unroll
                for (int n = 0; n < 2; ++n) acc[a][b][m][n] = (f32x4){0.f, 0.f, 0.f, 0.f};
    bf16x8 At[4][2], B0[2][2], B1[2][2];
    const char* cA = S.abase(cur); const char* cB = S.bbase(cur);
    S.a_ready(cur);
    if constexpr (SP2) {
        PG8_STAGE(PG8_SB(0, 0), cB, voffB); PG8_STAGE(PG8_SB(0, 1), cB + hstep, voffB); PG8_STAGE(PG8_SA(0, 0), cA, voffA); PG8_STAGE(PG8_SA(0, 1), cA + hstep, voffA);
        if (wr == 1) PG8_BAR;
        PG8_WAIT_V(2); PG8_BAR;
        PG8_STAGE(PG8_SB(1, 0), cB + kstep, voffB); PG8_STAGE(PG8_SA(1, 0), cA + kstep, voffA); PG8_STAGE(PG8_SB(1, 1), cB + hstep + kstep, voffB);
        PG8_WAIT_V(6); PG8_BAR;
    } else {
        PG8_STAGE(PG8_SB(0, 0), cB, voffB); PG8_STAGE(PG8_SA(0, 0), cA, voffA); PG8_STAGE(PG8_SB(0, 1), cB + hstep, voffB); PG8_STAGE(PG8_SA(0, 1), cA + hstep, voffA);
        if (wr == 1) PG8_BAR;
        PG8_WAIT_V(4); PG8_BAR;
        PG8_STAGE(PG8_SB(1, 0), cB + kstep, voffB); PG8_STAGE(PG8_SA(1, 0), cA + kstep, voffA); PG8_STAGE(PG8_SB(1, 1), cB + hstep + kstep, voffB);
        PG8_WAIT_V(6); PG8_BAR;
    }
    for (;;) {
        const bool has_next = S.next(ui + 1, nxt);
        const char* nA = has_next ? S.abase(nxt) : cA; const char* nB = has_next ? S.bbase(nxt) : cB;
        for (int t = 0; t < nt; t += 2) {
            const bool last = (t == nt - 2);
            const char* a1 = cA + (size_t)(t + 1) * kstep;
            const char* a2 = last ? nA : cA + (size_t)(t + 2) * kstep; const char* b2 = last ? nB : cB + (size_t)(t + 2) * kstep;
            const char* a3 = a2 + kstep; const char* b3 = b2 + kstep;
            if (last && has_next) S.a_ready(nxt);
            if constexpr (SP2) {
            PG8_LDB(B0, 0, 0); PG8_LDB(B1, 0, 1); PG8_SCHED; PG8_LDA(At, 0, 0); PG8_STAGE(PG8_SA(1, 1), a1 + hstep, voffA);
            PG8_WAIT_V(8); PG8_WAIT_L(0); PG8_BAR; PG8_MMA(0, 0, At, B0); PG8_MMA(0, 1, At, B1); PG8_BAR; PG8_SCHED;
            PG8_LDA(At, 0, 1); PG8_STAGE(PG8_SB(0, 0), b2, voffB); PG8_STAGE(PG8_SB(0, 1), b2 + hstep, voffB); PG8_STAGE(PG8_SA(0, 0), a2, voffA);
            PG8_WAIT_V(8); PG8_WAIT_L(0); PG8_BAR; PG8_MMA(1, 0, At, B0); PG8_MMA(1, 1, At, B1); PG8_BAR; PG8_SCHED;
            PG8_LDB(B0, 1, 0); PG8_LDB(B1, 1, 1); PG8_SCHED; PG8_LDA(At, 1, 0); PG8_STAGE(PG8_SA(0, 1), a2 + hstep, voffA);
            PG8_WAIT_V(8); PG8_WAIT_L(0); PG8_BAR; PG8_MMA(0, 0, At, B0); PG8_MMA(0, 1, At, B1); PG8_BAR; PG8_SCHED;
            PG8_LDA(At, 1, 1); PG8_STAGE(PG8_SB(1, 0), b3, voffB); PG8_STAGE(PG8_SB(1, 1), b3 + hstep, voffB); PG8_STAGE(PG8_SA(1, 0), a3, voffA);
            PG8_WAIT_V(8); PG8_WAIT_L(0); PG8_BAR; PG8_MMA(1, 0, At, B0); PG8_MMA(1, 1, At, B1); PG8_BAR; PG8_SCHED;
            } else {
            PG8_LDB(B0, 0, 0); PG8_SCHED; PG8_LDA(At, 0, 0); PG8_STAGE(PG8_SA(1, 1), a1 + hstep, voffA);
            PG8_WAIT_L(8); PG8_BAR; PG8_WAIT_L(0); PG8_MMA(0, 0, At, B0); PG8_BAR; PG8_SCHED;
            PG8_LDB(B1, 0, 1); PG8_STAGE(PG8_SB(0, 0), b2, voffB);
            PG8_BAR; PG8_WAIT_L(0); PG8_MMA(0, 1, At, B1); PG8_BAR;
            PG8_LDA(At, 0, 1); PG8_STAGE(PG8_SA(0, 0), a2, voffA);
            PG8_BAR; PG8_WAIT_L(0); PG8_MMA(1, 0, At, B0); PG8_BAR; PG8_SCHED;
            PG8_STAGE(PG8_SB(0, 1), b2 + hstep, voffB);
            PG8_WAIT_V(6); PG8_BAR; PG8_MMA(1, 1, At, B1); PG8_BAR;
            PG8_LDB(B0, 1, 0); PG8_SCHED; PG8_LDA(At, 1, 0); PG8_STAGE(PG8_SA(0, 1), a2 + hstep, voffA);
            PG8_WAIT_L(8); PG8_BAR; PG8_WAIT_L(0); PG8_MMA(0, 0, At, B0); PG8_BAR; PG8_SCHED;
            PG8_LDB(B1, 1, 1); PG8_STAGE(PG8_SB(1, 0), b3, voffB);
            PG8_BAR; PG8_WAIT_L(0); PG8_MMA(0, 1, At, B1); PG8_BAR;
            PG8_LDA(At, 1, 1); PG8_STAGE(PG8_SA(1, 0), a3, voffA);
            PG8_BAR; PG8_WAIT_L(0); PG8_MMA(1, 0, At, B0); PG8_BAR; PG8_SCHED;
            PG8_STAGE(PG8_SB(1, 1), b3 + hstep, voffB);
            PG8_WAIT_V(6); PG8_BAR; PG8_MMA(1, 1, At, B1); PG8_BAR;
            }
        }
        if constexpr (ALIGN_EPI) { if (wr == 0) PG8_BAR; }
        if constexpr (!Epi::AFTER_DRAIN) { E(acc, cur, wr, wc, fr, fq); S.done(cur); }
        if (!has_next) break;
#pragma unroll
        for (int a = 0; a < 2; ++a)
#pragma unroll
            for (int b = 0; b < 2; ++b)
#pragma unroll
                for (int m = 0; m < 4; ++m)
#pragma unroll
                    for (int n = 0; n < 2; ++n) acc[a][b][m][n] = (f32x4){0.f, 0.f, 0.f, 0.f};
        cur = nxt; cA = nA; cB = nB; ++ui;
        if constexpr (ALIGN_EPI) { if (wr == 1) PG8_BAR; }
    }
    PG8_WAIT_V(0);
    if constexpr (!ALIGN_EPI) { if (wr == 0) PG8_BAR; }
    PG8_BAR;
    if constexpr (Epi::AFTER_DRAIN) { E.fused(acc, cur, wr, wc, fr, fq, lds, wid, lane); S.done(cur); }
#undef PG8_SA
#undef PG8_SB
#undef PG8_STAGE
#undef PG8_LDA
#undef PG8_LDB
#undef PG8_MMA
#undef PG8_WAIT_V
#undef PG8_WAIT_L
#undef PG8_BAR
#undef PG8_SCHED
}
}

constexpr int NWAVES = 8;
constexpr int N_LAUNCHES = MK_N_LAUNCHES;
constexpr int PER_PHASE = 9;
constexpr int NBATCH = 4, SEQ = 8192, D = 1024, T = NBATCH * SEQ, MEMLEN = 256, NMEMTOK = NBATCH * MEMLEN;
constexpr int IN_MAIN = 5120;
constexpr int NEXP = 16384;

constexpr size_t MiB = 1u << 20;
constexpr size_t WS_CTL = 0, CTL_ZERO_BYTES = 512 * 1024;
constexpr size_t WS_ROWSQ = 256 * 1024;
constexpr size_t WS_WIN = 1 * MiB, WS_WV = 11 * MiB, WS_WKV = 12 * MiB, WS_WBR = 14 * MiB, WS_WOUT = 17 * MiB, WS_WQ = 19 * MiB, WS_KEYS = 23 * MiB, WS_PWT = 23 * MiB + 512 * 1024;
constexpr size_t WS_MEMN = 24 * MiB, WS_KMEM = 26 * MiB, WS_VTMEM = 27 * MiB, WS_RSTDX = 28 * MiB, WS_SU = 28 * MiB + 256 * 1024  , WS_SV = 28 * MiB + 512 * 1024  ;
constexpr size_t WS_U8 = 32 * MiB, WS_V8 = 48 * MiB;
constexpr size_t WS_QN = 96 * MiB, WS_KN = 128 * MiB, WS_VT = 160 * MiB, WS_PP = 192 * MiB, WS_XQ = 224 * MiB, WS_GATE = 256 * MiB, WS_END = 448 * MiB;
constexpr size_t WS_MERGED = WS_QN;
constexpr size_t WS_HB = WS_VT;
constexpr size_t WS_QB = WS_GATE;
constexpr size_t WS_TE = WS_GATE + 128 * MiB, WS_TW = WS_TE + 16 * MiB;
constexpr size_t WS_HQ = WS_TW + 16 * MiB;
constexpr size_t WS_HS = 28 * MiB + 768 * 1024;
constexpr size_t WS_AW = WS_MERGED;
constexpr size_t OUT_XB = 0, OUT_YNA = 0, OUT_YPOOL = 32 * MiB, OUT_YXA = 64 * MiB;
constexpr int CW_TMO = 0, CW_BAR = 4096, CW_TICKET = 8192;

constexpr int RING_OFF = 0, RING_BYTES = 131072;
constexpr int LDSCTL_OFF = RING_BYTES, MISC_OFF = LDSCTL_OFF + 320;
constexpr int LDS_BYTES = 147456;

#define GAS __attribute__((address_space(1)))
#define LAS __attribute__((address_space(3)))
typedef unsigned short bf16;
typedef unsigned v4u __attribute__((ext_vector_type(4)));
typedef unsigned v2u __attribute__((ext_vector_type(2)));
typedef float f32x4 __attribute__((ext_vector_type(4)));
typedef short bf16x8 __attribute__((ext_vector_type(8)));
typedef __bf16 bf16x2_t __attribute__((ext_vector_type(2)));
typedef GAS unsigned gu32;
#define LDS_WAIT() asm volatile("s_waitcnt lgkmcnt(0)" ::: "memory")
#define VM_WAIT() asm volatile("s_waitcnt vmcnt(0)" ::: "memory")
__device__ __forceinline__ unsigned f2bf(float f) { unsigned u = __builtin_bit_cast(unsigned, f); return (u + 0x7fffu + ((u >> 16) & 1u)) >> 16; }
__device__ __forceinline__ unsigned pk2(float lo, float hi) { return f2bf(lo) | (f2bf(hi) << 16); }
__device__ __forceinline__ float bflo(unsigned u) { return __builtin_bit_cast(float, u << 16); }
__device__ __forceinline__ float bfhi(unsigned u) { return __builtin_bit_cast(float, u & 0xffff0000u); }
__device__ __forceinline__ float bf1(short s) { return __builtin_bit_cast(float, ((unsigned)(unsigned short)s) << 16); }
__device__ __forceinline__ f32x4 mfma16(bf16x8 a, bf16x8 b, f32x4 c) { return __builtin_amdgcn_mfma_f32_16x16x32_bf16(a, b, c, 0, 0, 0); }
__device__ __forceinline__ float wave_sum(float v) {
#pragma unroll
    for (int o = 1; o < 64; o <<= 1) v += __shfl_xor(v, o);
    return v;
}

#define XB_TMO      128
#define XB_XCNT(j)  (256  + 64 * (j))
#define XB_XSUB(j)  (1280 + 64 * (j))
#define XB_XGEN(j)  (2304 + 64 * (j))
#define XB_TOP      3328
#define XB_TOPGEN   3392
#define XCD_BAR_WORDS 3456
#define XB_SPIN_CAP (1u << 18)

__device__ __forceinline__ unsigned xb_ld(unsigned* p)              { return __hip_atomic_load(p, __ATOMIC_RELAXED, __HIP_MEMORY_SCOPE_AGENT); }
__device__ __forceinline__ unsigned xb_add(unsigned* p, unsigned v) { return __hip_atomic_fetch_add(p, v, __ATOMIC_RELAXED, __HIP_MEMORY_SCOPE_AGENT); }
__device__ __forceinline__ unsigned xb_xcc_id() { return (unsigned)__builtin_amdgcn_s_getreg((3 << 11) | 20) & 0xFu; }
#define XB_SPIN(cond, bar) do { unsigned _sp = 0; while (cond) { __builtin_amdgcn_s_sleep(1); \
    if ((++_sp & 255u) == 0u) { if (xb_ld(&(bar)[XB_TMO])) break; if (_sp > XB_SPIN_CAP) { atomicAdd(&(bar)[XB_TMO], 1u); break; } } } } while (0)

struct XcdBarrier {
    unsigned* bar; unsigned x;
    volatile LAS unsigned* st;
};

__device__ __forceinline__ XcdBarrier xcd_barrier_post(unsigned* bar, volatile LAS unsigned* st) {
    XcdBarrier b; b.bar = bar; b.x = xb_xcc_id(); b.st = st;
    if (threadIdx.x == 0) (void)xb_add(&bar[XB_XCNT(b.x)], 1u);
    return b;
}
__device__ __forceinline__ void xcd_barrier_complete(unsigned* bar, unsigned x, unsigned& nloc, unsigned& nx) {
    const unsigned G = gridDim.x * gridDim.y * gridDim.z;
    unsigned sum, cnt, mine, sp = 0u;
    for (;;) {
        sum = 0u; cnt = 0u; mine = 0u;
#pragma unroll
        for (unsigned j = 0; j < 16; ++j) { const unsigned c = xb_ld(&bar[XB_XCNT(j)]); sum += c; cnt += (c > 0u) ? 1u : 0u; mine = (j == x) ? c : mine; }
        if (sum == G) break;
        __builtin_amdgcn_s_sleep(1);
        if ((++sp & 255u) == 0u) { if (xb_ld(&bar[XB_TMO])) break; if (sp > XB_SPIN_CAP) { atomicAdd(&bar[XB_TMO], 1u); break; } }
    }
    nloc = mine > 0u ? mine : 1u; nx = cnt > 0u ? cnt : 1u;
}

__device__ __forceinline__ void xcd_barrier(const XcdBarrier& b) {
    asm volatile("s_waitcnt vmcnt(0)" ::: "memory");
    __syncthreads();
    if (threadIdx.x == 0) {
        unsigned* bar = b.bar;
        __builtin_amdgcn_s_waitcnt(0);
        unsigned nloc = b.st[0], nx = b.st[1];
        if (nloc == 0u) { xcd_barrier_complete(bar, b.x, nloc, nx); b.st[0] = nloc; b.st[1] = nx; }
        const unsigned old = xb_add(&bar[XB_XSUB(b.x)], 1u);
        const unsigned gen = old / nloc;
        if (old + 1u == (gen + 1u) * nloc) {
            __builtin_amdgcn_fence(__ATOMIC_RELEASE, "agent");
            asm volatile("s_waitcnt vmcnt(0)" ::: "memory");
            const unsigned og = xb_add(&bar[XB_TOP], 1u);
            const unsigned tg = og / nx;
            if (og + 1u == (tg + 1u) * nx) xb_add(&bar[XB_TOPGEN], 1u);
            else XB_SPIN(xb_ld(&bar[XB_TOPGEN]) == tg, bar);
            __builtin_amdgcn_fence(__ATOMIC_ACQUIRE, "agent");
            xb_add(&bar[XB_XGEN(b.x)], 1u);
            asm volatile("s_waitcnt vmcnt(0)" ::: "memory");
        } else {
            XB_SPIN(xb_ld(&bar[XB_XGEN(b.x)]) == gen, bar);
            __builtin_amdgcn_fence(__ATOMIC_ACQUIRE, "agent");
            asm volatile("s_waitcnt vmcnt(0)" ::: "memory");
        }
    }
    __syncthreads();
}

struct Frame {
    LAS unsigned char* lds;
    volatile LAS unsigned* MISC;
    gu32* ctl;
    int tid, lane, wave, vcu, G;
    float* out; unsigned char* ws;
};
struct Args { const float* in[23]; float* out; unsigned char* ws; int ph_lo, ph_hi, probe, pad; };
enum { I_X = 0, I_MEM, I_MIXG, I_MEMG, I_WIN, I_GATEB, I_WKV, I_NAQG, I_NAKG, I_RPB, I_POOLW, I_POOLSC, I_XAQG, I_XAKG, I_WB0, I_WB1, I_WB2, I_WOUT, I_FFNG, I_WQ, I_KEYS, I_PU, I_PV };

__device__ __forceinline__ void p0_transpose_item(const float* W, int K, int N, int k0, int n0, bf16* dst, const float* kscale, LAS float* scr, int lane) {
#pragma unroll 8
    for (int i = 0; i < 32; ++i) { const int kk = 2 * i + (lane >> 5); float v = W[(size_t)(k0 + kk) * N + n0 + (lane & 31)]; if (kscale) v *= kscale[k0 + kk]; scr[kk * 33 + (lane & 31)] = v; }
    LDS_WAIT(); asm volatile("" ::: "memory");
    const int c = lane & 7;
#pragma unroll
    for (int j = 0; j < 4; ++j) { const int n = (lane >> 3) + 8 * j; const LAS float* s = scr + (8 * c) * 33 + n;
        v4u o; o.x = pk2(s[0 * 33], s[1 * 33]); o.y = pk2(s[2 * 33], s[3 * 33]); o.z = pk2(s[4 * 33], s[5 * 33]); o.w = pk2(s[6 * 33], s[7 * 33]);
        *(GAS v4u*)(dst + (size_t)n * K + k0 + 8 * c) = o; }
    LDS_WAIT(); asm volatile("" ::: "memory");
}
__device__ __forceinline__ void cvt_row1024(const float* src, bf16* dst, const float* colscale, float rowscale, int lane) {
    const GAS f32x4* xr = (const GAS f32x4*)src + lane; GAS unsigned long long* o8 = (GAS unsigned long long*)dst + lane;
#pragma unroll
    for (int j = 0; j < 4; ++j) { f32x4 v = xr[64 * j] * rowscale; if (colscale) v = v * ((const GAS f32x4*)colscale)[lane + 64 * j];
        o8[64 * j] = (unsigned long long)pk2(v.x, v.y) | ((unsigned long long)pk2(v.z, v.w) << 32); }
}
__device__ __forceinline__ float row_rstd1024(const float* src, int lane) {
    const GAS f32x4* xr = (const GAS f32x4*)src + lane; float s = 0.f;
#pragma unroll
    for (int j = 0; j < 4; ++j) { const f32x4 v = xr[64 * j]; s += (v.x * v.x + v.y * v.y) + (v.z * v.z + v.w * v.w); }
    return rsqrtf(wave_sum(s) * (1.0f / 1024.0f) + 1e-6f);
}
__device__ __forceinline__ void p0_prologue(Frame& F, const Args& A) {
    LAS float* scr = (LAS float*)(F.lds + RING_OFF + F.wave * 16384);
    const int gw = F.vcu * NWAVES + F.wave, NGW = F.G * NWAVES, lane = F.lane;
    unsigned char* ws = F.ws;
    constexpr int I_IN = 16 * 176, I_KV = 16 * 32, I_BR = 8 * 32, I_OUT = 16 * 32, I_Q = 16 * 64;
    constexpr int NITEMS = I_IN + I_KV + 3 * I_BR + I_OUT + I_Q;
    for (int it = gw; it < NITEMS; it += NGW) {
        int r = it;
        if (r < I_IN) { const int kb = r / 176, nb = r % 176, n0 = 32 * nb; bf16* dst;
            if (n0 >= 1024 && n0 < 1536) dst = (bf16*)(ws + WS_WV) + (size_t)(n0 - 1024) * 1024;
            else { const int np = n0 < 1024 ? n0 : n0 - 512, t = np >> 8, w = np & 255, wc = w >> 6, bj = (w >> 5) & 1; dst = (bf16*)(ws + WS_WIN) + (size_t)(256 * t + 128 * bj + 32 * wc) * 1024; }
            p0_transpose_item(A.in[I_WIN], 1024, 5632, 64 * kb, n0, dst, A.in[I_MIXG], scr, lane); continue; }
        r -= I_IN;
        if (r < I_KV) { const int kb = r / 32, nb = r % 32; p0_transpose_item(A.in[I_WKV], 1024, 1024, 64 * kb, 32 * nb, (bf16*)(ws + WS_WKV) + (size_t)(32 * nb) * 1024, nullptr, scr, lane); continue; }
        r -= I_KV;
        if (r < 3 * I_BR) { const int br = r / I_BR, rr = r % I_BR, kb = rr / 32, nb = rr % 32; const float* W = br == 0 ? A.in[I_WB0] : (br == 1 ? A.in[I_WB1] : A.in[I_WB2]);
            p0_transpose_item(W, 512, 1024, 64 * kb, 32 * nb, (bf16*)(ws + WS_WBR) + (size_t)br * 1024 * 512 + (size_t)(32 * nb) * 512, nullptr, scr, lane); continue; }
        r -= 3 * I_BR;
        if (r < I_OUT) { const int kb = r / 32, nb = r % 32; p0_transpose_item(A.in[I_WOUT], 1024, 1024, 64 * kb, 32 * nb, (bf16*)(ws + WS_WOUT) + (size_t)(32 * nb) * 1024, nullptr, scr, lane); continue; }
        r -= I_OUT;
        { const int kb = r / 64, nb = r % 64; p0_transpose_item(A.in[I_WQ], 1024, 2048, 64 * kb, 32 * nb, (bf16*)(ws + WS_WQ) + (size_t)(32 * nb) * 1024, A.in[I_FFNG], scr, lane); }
    }
    { bf16* xb = (bf16*)((unsigned char*)F.out + OUT_XB); float* rstdx = (float*)(ws + WS_RSTDX);
      for (int m = gw; m < T; m += NGW) { const float* xr = A.in[I_X] + (size_t)m * D; const float rs = row_rstd1024(xr, lane); cvt_row1024(xr, xb + (size_t)m * D, nullptr, 1.0f, lane); if (lane == 0) rstdx[m] = rs; } }
    for (int m = gw; m < NMEMTOK; m += NGW) { const float* xr = A.in[I_MEM] + (size_t)m * D; const float rs = row_rstd1024(xr, lane); cvt_row1024(xr, (bf16*)(ws + WS_MEMN) + (size_t)m * D, A.in[I_MEMG], rs, lane); }
    for (int m = gw; m < 2 * NEXP; m += NGW) {
        const bool isu = m < NEXP; const int e = isu ? m : m - NEXP;
        const GAS f32x4* src = (const GAS f32x4*)((isu ? A.in[I_PU] : A.in[I_PV]) + (size_t)e * D) + 4 * lane;
        f32x4 v[4]; float mx = 0.f;
#pragma unroll
        for (int d = 0; d < 4; ++d) { v[d] = src[d]; if (isu) v[d] = v[d] * ((const GAS f32x4*)A.in[I_FFNG])[4 * lane + d];
            mx = fmaxf(mx, fmaxf(fmaxf(fabsf(v[d].x), fabsf(v[d].y)), fmaxf(fabsf(v[d].z), fabsf(v[d].w)))); }
#pragma unroll
        for (int o = 1; o < 64; o <<= 1) mx = fmaxf(mx, __shfl_xor(mx, o));
        const float inv = mx > 0.f ? 127.0f / mx : 0.f; const int off = 0;
        v4u w;
#pragma unroll
        for (int d = 0; d < 4; ++d) { const unsigned b0 = (unsigned)((int)rintf(v[d].x * inv) + off) & 0xffu, b1 = (unsigned)((int)rintf(v[d].y * inv) + off) & 0xffu,
                                                     b2 = (unsigned)((int)rintf(v[d].z * inv) + off) & 0xffu, b3 = (unsigned)((int)rintf(v[d].w * inv) + off) & 0xffu;
            w[d] = b0 | (b1 << 8) | (b2 << 16) | (b3 << 24); }
        if (isu) ((GAS v4u*)(ws + WS_U8))[(size_t)e * 64 + lane] = w;
        else *(GAS v4u*)(ws + WS_V8 + (size_t)(lane >> 3) * (2 * MiB) + (size_t)e * 128 + (lane & 7) * 16) = w;
        if (lane == 0) ((float*)(ws + WS_SU))[2 * e + (isu ? 0 : 1)] = mx * (1.0f / 127.0f);
    }
    for (int m = gw * 64 + lane; m < T; m += NGW * 64) ((float*)(ws + WS_ROWSQ))[m] = 0.f;
    for (int m = gw; m < 256; m += NGW) cvt_row1024(A.in[I_KEYS] + (size_t)m * 1024, (bf16*)(ws + WS_KEYS) + (size_t)m * 1024, nullptr, 1.0f, lane);
    for (int m = gw; m < 1024; m += NGW) { const int gd = m >> 1, c = (m & 1) * 64 + lane, g = gd >> 7, d = gd & 127;
        const float v = A.in[I_POOLW][(size_t)(g * 128 + c) * 128 + d] * A.in[I_POOLSC][gd];
        ((bf16*)(ws + WS_PWT))[(size_t)gd * 128 + c] = (bf16)f2bf(v); }
}

__device__ __forceinline__ void memkv_tile(const bf16* memn, const bf16* wkvT, const float* kg, const float* qg, bf16* kmem, bf16* vtmem, int tile, int lane) {
    const int q = lane & 15, hi = lane >> 4, rg = tile >> 3, cg = tile & 7, r0 = rg * 16, c0 = cg * 128;
    f32x4 acc[8];
#pragma unroll
    for (int i = 0; i < 8; ++i) acc[i] = (f32x4){0.f, 0.f, 0.f, 0.f};
    const bf16* ap = memn + (size_t)(r0 + q) * 1024 + 8 * hi; const bf16* bp = wkvT + (size_t)(c0 + q) * 1024 + 8 * hi;
#pragma unroll 1
    for (int kb = 0; kb < 8; ++kb) {
        bf16x8 a[4], b[4][8];
#pragma unroll
        for (int k4 = 0; k4 < 4; ++k4) { a[k4] = *(const bf16x8*)(ap + 32 * (4 * kb + k4));
#pragma unroll
            for (int nf = 0; nf < 8; ++nf) b[k4][nf] = *(const bf16x8*)(bp + (size_t)(16 * nf) * 1024 + 32 * (4 * kb + k4)); }
        __builtin_amdgcn_sched_barrier(0);
#pragma unroll
        for (int k4 = 0; k4 < 4; ++k4)
#pragma unroll
            for (int nf = 0; nf < 8; ++nf) acc[nf] = mfma16(a[k4], b[k4][nf], acc[nf]);
        __builtin_amdgcn_sched_barrier(0);
    }
    if (cg < 4) {
        float rr[4];
#pragma unroll
        for (int g = 0; g < 4; ++g) { float ss = 0.f;
#pragma unroll
            for (int nf = 0; nf < 8; ++nf) ss += acc[nf][g] * acc[nf][g];
            ss += __shfl_xor(ss, 1); ss += __shfl_xor(ss, 2); ss += __shfl_xor(ss, 4); ss += __shfl_xor(ss, 8);
            rr[g] = rsqrtf(ss * (1.0f / 128.0f) + 1e-6f); }
#pragma unroll
        for (int nf = 0; nf < 8; ++nf) { const int d = 16 * nf + q; const float gs = kg[d] * qg[d];
#pragma unroll
            for (int g = 0; g < 4; ++g) kmem[(size_t)(r0 + 4 * hi + g) * 512 + cg * 128 + d] = (bf16)f2bf(acc[nf][g] * rr[g] * gs); }
    } else {
        const int h = cg - 4, b = r0 >> 8, key0 = (r0 & 255) + 4 * hi;
#pragma unroll
        for (int nf = 0; nf < 8; ++nf) { const int d = 16 * nf + q; v2u w; w.x = pk2(acc[nf][0], acc[nf][1]); w.y = pk2(acc[nf][2], acc[nf][3]);
            *(v2u*)(vtmem + (size_t)(b * 512 + h * 128 + d) * 256 + key0) = w; }
    }
}

__device__ __forceinline__ void na_item(const bf16* __restrict__ qn, const bf16* __restrict__ kn, const bf16* __restrict__ vt, const LAS float* rpl, bf16* __restrict__ yna,
                                        int b, int r, int jb, int h, int lane) {
    const int q = lane & 15, hi = lane >> 4;
    int rs = r - 4; rs = rs < 0 ? 0 : (rs > 120 ? 120 : rs);
    int kb0 = jb * 16 - 8; kb0 = kb0 < 0 ? 0 : (kb0 > 32 ? 32 : kb0);
    const int qcol = jb * 16 + q; int cs = qcol - 8; cs = cs < 0 ? 0 : (cs > 48 ? 48 : cs);
    const size_t tokq = (size_t)b * SEQ + r * 64 + qcol;
    const bf16* qp = qn + tokq * 512 + h * 64 + 8 * hi;
    const bf16x8 qf0 = *(const bf16x8*)qp, qf1 = *(const bf16x8*)(qp + 32);
    const int kq = 8 * (q >> 2) + (q & 3);
    const bf16* kbase = kn + ((size_t)b * SEQ + rs * 64 + kb0 + kq) * 512 + h * 64 + 8 * hi;
    f32x4 s[16];
    {
        bf16x8 ka[16][2];
#pragma unroll
        for (int f = 0; f < 16; ++f) { const bf16* kp = kbase + (size_t)((f >> 1) * 64 + (f & 1) * 4) * 512; ka[f][0] = *(const bf16x8*)kp; ka[f][1] = *(const bf16x8*)(kp + 32); }
        __builtin_amdgcn_sched_barrier(0);
#pragma unroll
        for (int f = 0; f < 16; ++f) { f32x4 z = (f32x4){0.f, 0.f, 0.f, 0.f}; z = mfma16(ka[f][0], qf0, z); s[f] = mfma16(ka[f][1], qf1, z); }
    }
    const bf16* vbase = vt + ((size_t)(b * 512 + h * 64 + q) * SEQ + rs * 64 + kb0 + 8 * hi);
    bf16x8 va[8][4];
#pragma unroll
    for (int st = 0; st < 8; ++st)
#pragma unroll
        for (int mf = 0; mf < 4; ++mf) va[st][mf] = *(const bf16x8*)(vbase + (size_t)(16 * mf) * SEQ + st * 64);
    __builtin_amdgcn_sched_barrier(0);
    float mx = -3.0e38f;
#pragma unroll
    for (int f = 0; f < 16; ++f) {
        const int dr = rs + (f >> 1) - r + 7;
#pragma unroll
        for (int g = 0; g < 4; ++g) {
            const int kcol = kb0 + 8 * hi + 4 * (f & 1) + g;
            const bool ok = (kcol >= cs) && (kcol < cs + 16);
            int dc = kcol - qcol + 15; dc = dc < 0 ? 0 : (dc > 30 ? 30 : dc);
            const float v = ok ? s[f][g] + rpl[dr * 31 + dc] : -1.0e30f;
            s[f][g] = v; mx = fmaxf(mx, v);
        }
    }
    mx = fmaxf(mx, __shfl_xor(mx, 16)); mx = fmaxf(mx, __shfl_xor(mx, 32));
    float sum = 0.f;
#pragma unroll
    for (int f = 0; f < 16; ++f)
#pragma unroll
        for (int g = 0; g < 4; ++g) { const float p = __expf(s[f][g] - mx); s[f][g] = p; sum += p; }
    sum += __shfl_xor(sum, 16); sum += __shfl_xor(sum, 32);
    const float inv = 1.0f / sum;
    f32x4 o[4];
#pragma unroll
    for (int i = 0; i < 4; ++i) o[i] = (f32x4){0.f, 0.f, 0.f, 0.f};
#pragma unroll
    for (int st = 0; st < 8; ++st) {
        const bf16x8 pb = __builtin_bit_cast(bf16x8, pg8::pack8(s[2 * st], s[2 * st + 1]));
#pragma unroll
        for (int mf = 0; mf < 4; ++mf) o[mf] = mfma16(va[st][mf], pb, o[mf]);
    }
    bf16* yp = yna + tokq * 512 + h * 64 + 4 * hi;
#pragma unroll
    for (int mf = 0; mf < 4; ++mf) { v2u w; w.x = pk2(o[mf][0] * inv, o[mf][1] * inv); w.y = pk2(o[mf][2] * inv, o[mf][3] * inv); *(v2u*)(yp + 16 * mf) = w; }
}
__device__ __forceinline__ void xa_fill_lds(const bf16* __restrict__ kmem, const bf16* __restrict__ vtmem, LAS unsigned char* lds, int b, int h, int tid) {
#pragma unroll
    for (int ps = 0; ps < 8; ++ps) { const int id = tid + 512 * ps, key = id >> 4, c = id & 15;
        *(LAS v4u*)(lds + key * 256 + ((c ^ (key & 15)) << 4)) = *(const v4u*)(kmem + ((size_t)b * 256 + key) * 512 + h * 128 + 8 * c); }
#pragma unroll
    for (int ps = 0; ps < 8; ++ps) { const int id = tid + 512 * ps, dim = id >> 5, c = id & 31;
        *(LAS v4u*)(lds + 65536 + dim * 512 + ((c ^ (dim & 15)) << 4)) = *(const v4u*)(vtmem + (size_t)(b * 512 + h * 128 + dim) * 256 + 8 * c); }
}
__device__ __forceinline__ void xa_item(const bf16* __restrict__ xq, const LAS unsigned char* lds, bf16* __restrict__ yxa, int tok0, int h, int lane) {
    const int q = lane & 15, hi = lane >> 4; const size_t tok = (size_t)tok0 + q;
    const bf16* qp = xq + tok * 512 + h * 128 + 8 * hi;
    bf16x8 qf[4]; float ssq = 0.f;
#pragma unroll
    for (int ks = 0; ks < 4; ++ks) qf[ks] = *(const bf16x8*)(qp + 32 * ks);
    __builtin_amdgcn_sched_barrier(0);
#pragma unroll
    for (int ks = 0; ks < 4; ++ks)
#pragma unroll
        for (int j = 0; j < 8; ++j) { const float v = bf1(qf[ks][j]); ssq += v * v; }
    ssq += __shfl_xor(ssq, 16); ssq += __shfl_xor(ssq, 32);
    const float cexp = rsqrtf(ssq * (1.0f / 128.0f) + 1e-6f) * 0.08838834764831845f * 1.4426950408889634f;
    const int kq = 8 * (q >> 2) + (q & 3);
    f32x4 s[16];
#pragma unroll
    for (int f = 0; f < 16; ++f) { const int key = 32 * (f >> 1) + 4 * (f & 1) + kq; const LAS unsigned char* kr = lds + key * 256; f32x4 z = (f32x4){0.f, 0.f, 0.f, 0.f};
#pragma unroll
        for (int ks = 0; ks < 4; ++ks) z = mfma16(*(const LAS bf16x8*)(kr + (((4 * ks + hi) ^ (key & 15)) << 4)), qf[ks], z);
        s[f] = z; }
    float mx = -3.0e38f;
#pragma unroll
    for (int f = 0; f < 16; ++f)
#pragma unroll
        for (int g = 0; g < 4; ++g) mx = fmaxf(mx, s[f][g]);
    mx = fmaxf(mx, __shfl_xor(mx, 16)); mx = fmaxf(mx, __shfl_xor(mx, 32));
    float sum = 0.f;
#pragma unroll
    for (int f = 0; f < 16; ++f)
#pragma unroll
        for (int g = 0; g < 4; ++g) { const float p = __builtin_amdgcn_exp2f((s[f][g] - mx) * cexp); s[f][g] = p; sum += p; }
    sum += __shfl_xor(sum, 16); sum += __shfl_xor(sum, 32);
    const float inv = 1.0f / sum;
    f32x4 o[8];
#pragma unroll
    for (int i = 0; i < 8; ++i) o[i] = (f32x4){0.f, 0.f, 0.f, 0.f};
#pragma unroll
    for (int st = 0; st < 8; ++st) {
        const bf16x8 pb = __builtin_bit_cast(bf16x8, pg8::pack8(s[2 * st], s[2 * st + 1]));
#pragma unroll
        for (int mf = 0; mf < 8; ++mf) { const int dim = 16 * mf + q; o[mf] = mfma16(*(const LAS bf16x8*)(lds + 65536 + dim * 512 + (((4 * st + hi) ^ (dim & 15)) << 4)), pb, o[mf]); }
    }
    bf16* yp = yxa + tok * 512 + h * 128 + 4 * hi;
#pragma unroll
    for (int mf = 0; mf < 8; ++mf) { v2u w; w.x = pk2(o[mf][0] * inv, o[mf][1] * inv); w.y = pk2(o[mf][2] * inv, o[mf][3] * inv); *(v2u*)(yp + 16 * mf) = w; }
}
__device__ __forceinline__ void pool_wg(const bf16* __restrict__ pp, const bf16* __restrict__ pwT, bf16* __restrict__ ypool, LAS unsigned char* lds, int tokbase, int wave, int lane) {
    const int q = lane & 15, hi = lane >> 4;
    __syncthreads();
    {
        const int hw = 1 << hi, tw0 = tokbase + 16 * wave, b = tw0 >> 13, t0 = tw0 & 8191;
        const bf16* base = pp + (size_t)b * SEQ * 512 + 8 * lane;
        float s[8];
#pragma unroll
        for (int j = 0; j < 8; ++j) s[j] = 0.f;
#pragma unroll 4
        for (int d = -8; d < 8; ++d) { const int u = t0 + d; const bool ok = (d >= -hw) && (d < hw) && (u >= 0) && (u < SEQ);
            const bf16x8 v = *(const bf16x8*)(base + (size_t)(ok ? u : t0) * 512);
#pragma unroll
            for (int j = 0; j < 8; ++j) s[j] += ok ? bf1(v[j]) : 0.f; }
        LAS unsigned char* tile = lds + wave * 16384;
#pragma unroll 2
        for (int i = 0; i < 16; ++i) { const int t = t0 + i;
            int lo = t - hw; lo = lo < 0 ? 0 : lo; int ht = t + hw; ht = ht > SEQ ? SEQ : ht;
            const float inv = 1.0f / (float)(ht - lo);
            const bool oka = (t + hw) < SEQ, oks = (t - hw) >= 0;
            const bf16x8 sv = *(const bf16x8*)(base + (size_t)t * 512), av = *(const bf16x8*)(base + (size_t)(oka ? t + hw : t) * 512), bv = *(const bf16x8*)(base + (size_t)(oks ? t - hw : t) * 512);
            f32x4 p0, p1;
#pragma unroll
            for (int j = 0; j < 4; ++j) { p0[j] = s[j] * inv - bf1(sv[j]); p1[j] = s[j + 4] * inv - bf1(sv[j + 4]); }
            *(LAS v4u*)(tile + i * 1024 + ((lane ^ (i & 15)) << 4)) = pg8::pack8(p0, p1);
#pragma unroll
            for (int j = 0; j < 8; ++j) s[j] += (oka ? bf1(av[j]) : 0.f) - (oks ? bf1(bv[j]) : 0.f);
        }
    }
    __syncthreads();
#pragma unroll 1
    for (int k = 0; k < 4; ++k) {
        const int pair = wave * 4 + k, g = pair >> 3, mf = pair & 7;
        const bf16* wb = pwT + (size_t)(g * 128 + 16 * mf + q) * 128 + 8 * hi;
        bf16x8 a[4];
#pragma unroll
        for (int ks = 0; ks < 4; ++ks) a[ks] = *(const bf16x8*)(wb + 32 * ks);
#pragma unroll 2
        for (int tg = 0; tg < 8; ++tg) {
            const LAS unsigned char* trow = lds + tg * 16384 + q * 1024; f32x4 o = (f32x4){0.f, 0.f, 0.f, 0.f};
#pragma unroll
            for (int ks = 0; ks < 4; ++ks) { const int c = g * 16 + 4 * ks + hi; o = mfma16(a[ks], *(const LAS bf16x8*)(trow + ((c ^ q) << 4)), o); }
            v2u w; w.x = pk2(o[0], o[1]); w.y = pk2(o[2], o[3]);
            *(v2u*)(ypool + (size_t)(tokbase + 16 * tg + q) * 512 + g * 128 + 16 * mf + 4 * hi) = w;
        }
    }
    __syncthreads();
}

__device__ __forceinline__ int f2key(float s, int idx, int mask) { int b = __builtin_bit_cast(int, s); b = b >= 0 ? b : (b ^ 0x7fffffff); return (b & ~mask) | idx; }
__device__ __forceinline__ float key2f(int k) { k = k >= 0 ? k : (k ^ 0x7fffffff); return __builtin_bit_cast(float, k); }
#define CE_DESC(x, y) do { const int _h = (x) > (y) ? (x) : (y), _l = (x) > (y) ? (y) : (x); (x) = _h; (y) = _l; } while (0)
__device__ __forceinline__ void sort16(int (&a)[16]) {
#pragma unroll
    for (int ks = 1; ks <= 4; ++ks)
#pragma unroll
        for (int js = ks - 1; js >= 0; --js)
#pragma unroll
            for (int i = 0; i < 16; ++i) { const int k = 1 << ks, j = 1 << js, l = i ^ j;
                if (l > i) { if ((i & k) == 0) CE_DESC(a[i], a[l]); else CE_DESC(a[l], a[i]); } }
}
__device__ __forceinline__ void merge16(int (&a)[16], const int (&b)[16]) {
#pragma unroll
    for (int i = 0; i < 16; ++i) a[i] = a[i] > b[15 - i] ? a[i] : b[15 - i];
#pragma unroll
    for (int js = 3; js >= 0; --js)
#pragma unroll
        for (int i = 0; i < 16; ++i) { const int j = 1 << js, l = i ^ j; if (l > i) CE_DESC(a[i], a[l]); }
}
__device__ __forceinline__ void merge16_lanes(int (&a)[16], int step) { int o[16];
#pragma unroll
    for (int k = 0; k < 16; ++k) o[k] = __shfl_xor(a[k], step);
    merge16(a, o); }
__device__ constexpr int cand_i(int hi, int m) {
    return hi == 0 ? 0
         : hi == 1 ? (m < 8 ? 1 : (m < 13 ? 2 : -1))
         : hi == 2 ? (m < 4 ? 3 : (m < 7 ? 4 : (m < 9 ? 5 : (m < 11 ? 6 : -1))))
         :           (m < 2 ? 7 : (m < 10 ? 8 + (m - 2) : -1));
}
__device__ constexpr int cand_j(int hi, int m) {
    return hi == 0 ? m
         : hi == 1 ? (m < 8 ? m : (m < 13 ? m - 8 : -1))
         : hi == 2 ? (m < 4 ? m : (m < 7 ? m - 4 : (m < 9 ? m - 7 : (m < 11 ? m - 9 : -1))))
         :           (m < 2 ? m : (m < 10 ? 0 : -1));
}
__device__ __forceinline__ void topk_fill_lds(const bf16* __restrict__ keys, LAS unsigned char* lds, int h, int tid) {
#pragma unroll
    for (int ps = 0; ps < 8; ++ps) { const int id = tid + 512 * ps, row = id >> 4, c = id & 15;
        *(LAS v4u*)(lds + row * 256 + ((c ^ (row & 15)) << 4)) = *(const v4u*)(keys + ((size_t)h * 256 + row) * 128 + 8 * c); }
}
__device__ __forceinline__ void topk_item(const bf16* __restrict__ qb, const LAS unsigned char* klds, int* __restrict__ te, float* __restrict__ tw, LAS int* lscr, int tok0, int h, int lane) {
    const int q = lane & 15, hi = lane >> 4; const size_t tok = (size_t)tok0 + q;
    int L[2][16];
    bf16x8 qfa[2][4];
#pragma unroll
    for (int p = 0; p < 2; ++p)
#pragma unroll
        for (int ks = 0; ks < 4; ++ks) qfa[p][ks] = *(const bf16x8*)(qb + tok * 2048 + h * 256 + p * 128 + 32 * ks + 8 * hi);
    __builtin_amdgcn_sched_barrier(0);
#pragma unroll
    for (int p = 0; p < 2; ++p) {
        int B[16];
#pragma unroll
        for (int mf = 0; mf < 8; ++mf) { f32x4 s = (f32x4){0.f, 0.f, 0.f, 0.f}; const int row = p * 128 + 16 * mf + q;
#pragma unroll
            for (int ks = 0; ks < 4; ++ks) s = mfma16(*(const LAS bf16x8*)(klds + row * 256 + (((4 * ks + hi) ^ (row & 15)) << 4)), qfa[p][ks], s);
#pragma unroll
            for (int g = 0; g < 4; ++g) { const int key = f2key(s[g], 16 * mf + 4 * hi + g, 127); if (mf < 4) L[p][4 * mf + g] = key; else B[4 * (mf - 4) + g] = key; } }
        sort16(L[p]); sort16(B); merge16(L[p], B);
        merge16_lanes(L[p], 16); merge16_lanes(L[p], 32);
    }
    float v1[16], v2[16];
#pragma unroll
    for (int k = 0; k < 16; ++k) { v1[k] = key2f(L[0][k]); v2[k] = key2f(L[1][k]); }
    int Fk[16];
#pragma unroll
    for (int m = 0; m < 16; ++m) {
        float sm = v1[0] + v2[m]; int id = 255 - m;
        if (cand_i(1, m) >= 0) { if (hi == 1) { sm = v1[cand_i(1, m) < 0 ? 0 : cand_i(1, m)] + v2[cand_j(1, m) < 0 ? 0 : cand_j(1, m)]; id = 255 - ((cand_i(1, m) << 4) | cand_j(1, m)); } }
        if (cand_i(2, m) >= 0) { if (hi == 2) { sm = v1[cand_i(2, m) < 0 ? 0 : cand_i(2, m)] + v2[cand_j(2, m) < 0 ? 0 : cand_j(2, m)]; id = 255 - ((cand_i(2, m) << 4) | cand_j(2, m)); } }
        if (cand_i(3, m) >= 0) { if (hi == 3) { sm = v1[cand_i(3, m) < 0 ? 0 : cand_i(3, m)] + v2[cand_j(3, m) < 0 ? 0 : cand_j(3, m)]; id = 255 - ((cand_i(3, m) << 4) | cand_j(3, m)); } }
        int key = f2key(sm, id, 255);
        if ((hi == 1 && cand_i(1, m) < 0) || (hi == 2 && cand_i(2, m) < 0) || (hi == 3 && cand_i(3, m) < 0)) key = (int)0x80000000;
        Fk[m] = key;
    }
    sort16(Fk); merge16_lanes(Fk, 16); merge16_lanes(Fk, 32);
    LAS int* my = lscr + lane * 32;
#pragma unroll
    for (int k = 0; k < 16; ++k) { my[k] = L[0][k] & 127; my[16 + k] = L[1][k] & 127; }
    LDS_WAIT(); asm volatile("" ::: "memory");
    float e[16]; float sum = 0.f; const float mx = key2f(Fk[0]);
#pragma unroll
    for (int k = 0; k < 16; ++k) { e[k] = __expf(key2f(Fk[k]) - mx); sum += e[k]; }
    const float inv = 1.0f / sum;
    if (hi == 0) {
        int* tep = te + tok * 128; float* twp = tw + tok * 128;
#pragma unroll
        for (int kk = 0; kk < 16; ++kk) { const int ij = 255 - (Fk[kk] & 255), i = ij >> 4, j = ij & 15, slot = (kk & 7) * 16 + 2 * h + (kk >> 3);
            tep[slot] = my[i] * 128 + my[16 + j]; twp[slot] = e[kk] * inv; }
    }
    LDS_WAIT(); asm volatile("" ::: "memory");
}

__device__ __forceinline__ float ub2f(unsigned v, int b) { return (float)((v >> (8 * b)) & 0xffu); }
__device__ __forceinline__ void hq_token(const bf16* __restrict__ hb, const float* __restrict__ rowsq, unsigned char* __restrict__ hq, float* __restrict__ hs, int tok, int lane) {
    const bf16* hp = hb + (size_t)tok * 1024 + 16 * lane;
    const v4u hA = *(const v4u*)hp, hB = *(const v4u*)(hp + 8);
    float hf[16];
#pragma unroll
    for (int d = 0; d < 4; ++d) { hf[2 * d] = bflo(hA[d]); hf[2 * d + 1] = bfhi(hA[d]); hf[8 + 2 * d] = bflo(hB[d]); hf[8 + 2 * d + 1] = bfhi(hB[d]); }
    float amax = 0.f;
#pragma unroll
    for (int j = 0; j < 16; ++j) amax = fmaxf(amax, fabsf(hf[j]));
#pragma unroll
    for (int o = 1; o < 64; o <<= 1) amax = fmaxf(amax, __shfl_xor(amax, o));
    const float hinv = amax > 0.f ? 127.0f / amax : 0.f;
    v4u w;
#pragma unroll
    for (int d = 0; d < 4; ++d) { const unsigned b0 = (unsigned)(int)rintf(hf[4 * d] * hinv) & 0xffu, b1 = (unsigned)(int)rintf(hf[4 * d + 1] * hinv) & 0xffu,
                                                 b2 = (unsigned)(int)rintf(hf[4 * d + 2] * hinv) & 0xffu, b3 = (unsigned)(int)rintf(hf[4 * d + 3] * hinv) & 0xffu;
        w[d] = b0 | (b1 << 8) | (b2 << 16) | (b3 << 24); }
    *(v4u*)(hq + (size_t)tok * 1024 + 16 * lane) = w;
    if (lane == 0) hs[tok] = rsqrtf(rowsq[tok] * (1.0f / 1024.0f) + 1e-6f) * amax * (1.0f / 127.0f);
}
constexpr int PA_SLOTS = 12;
struct PeerA1 { int e; float g; };
struct PeerA2 { v4u ur[3][4]; v4u hv[4]; float hsc, su, sv; int cnt, rk; bool m; unsigned long long rem; };
__device__ __forceinline__ void pa_s1(PeerA1& a, const int* __restrict__ te, const float* __restrict__ tw, int tok, int half, int lane) {
    a.e = te[(size_t)tok * 128 + 64 * half + lane]; a.g = tw[(size_t)tok * 128 + 64 * half + lane]; }
__device__ __forceinline__ void pa_s2(PeerA2& b, const PeerA1& a, const unsigned char* __restrict__ hq, const float* __restrict__ hs, const unsigned char* __restrict__ u8,
                                      const float* __restrict__ su, const float* __restrict__ sv, LAS int* lst, int tok, int x, int lane, int hot) {
    b.m = (a.e >> 11) == x;
    const unsigned long long mask = __ballot(b.m), lt = (1ull << lane) - 1ull;
    b.cnt = __popcll(mask); b.rk = __popcll(mask & lt);
    if (b.m && b.rk < PA_SLOTS) lst[b.rk] = a.e;
    { unsigned long long r = mask; for (int k = 0; k < PA_SLOTS && r != 0ull; ++k) r &= r - 1ull; b.rem = b.cnt > PA_SLOTS ? r : 0ull; }
    { typedef float f32x2s __attribute__((ext_vector_type(2))); f32x2s s2 = (f32x2s){0.f, 0.f}; if (b.m) s2 = ((const f32x2s*)su)[a.e]; b.su = s2.x; b.sv = s2.y; }
    const int r = lane >> 4, t = lane & 15;
#pragma unroll
    for (int i = 0; i < 4; ++i) b.hv[i] = *(const v4u*)(hq + (size_t)tok * 1024 + 16 * t + 256 * i);
    b.hsc = hs[tok];
    LDS_WAIT(); asm volatile("" ::: "memory");
    const int lim = b.cnt < PA_SLOTS ? b.cnt : PA_SLOTS;
#pragma unroll
    for (int q = 0; q < 3; ++q) { const int slot = 4 * q + r;
#pragma unroll
        for (int i = 0; i < 4; ++i) b.ur[q][i] = (v4u){0u, 0u, 0u, 0u};
        if (slot < lim) { int e = lst[slot]; if (hot) e = (x << 11) | (e & 255); const unsigned char* rp = u8 + (size_t)e * 1024 + 16 * t;
#pragma unroll
            for (int i = 0; i < 4; ++i) b.ur[q][i] = *(const v4u*)(rp + 256 * i); } }
    (void)sv;
}
__device__ __forceinline__ int dot16(const v4u u, const v4u h) { int d = __builtin_amdgcn_sdot4((int)u.x, (int)h.x, 0, false); d = __builtin_amdgcn_sdot4((int)u.y, (int)h.y, d, false);
    d = __builtin_amdgcn_sdot4((int)u.z, (int)h.z, d, false); return __builtin_amdgcn_sdot4((int)u.w, (int)h.w, d, false); }
template <int CTRL, int RM> __device__ __forceinline__ int dpp_i(int x) { return __builtin_amdgcn_update_dpp(0, x, CTRL, RM, 0xf, false); }
__device__ __forceinline__ int wave_sum_to63(int x) { x += dpp_i<0xb1, 0xf>(x); x += dpp_i<0x4e, 0xf>(x); x += dpp_i<0x124, 0xf>(x); x += dpp_i<0x128, 0xf>(x); x += dpp_i<0x142, 0xa>(x); x += dpp_i<0x143, 0xc>(x); return x; }
__device__ __forceinline__ int row_sum16(int x) { x += dpp_i<0xb1, 0xf>(x); x += dpp_i<0x4e, 0xf>(x); x += dpp_i<0x124, 0xf>(x); x += dpp_i<0x128, 0xf>(x); return x; }
__device__ __forceinline__ float gelu_erf(float v) {
    const float av = fabsf(v), t = __builtin_amdgcn_rcpf(av * 0.2316418882f + 1.0f);
    float q = t * 0.5307027145f + (-0.7265760135f); q = q * t + 0.7107068705f; q = q * t + (-0.142248368f); q = q * t + 0.127414796f; q = q * t;
    const float e = __builtin_amdgcn_exp2f((v * v) * (-0.72134752044f)), m = v * (q * e);
    return v < 0.f ? m : v - m; }
__device__ __forceinline__ void pa_s3(const PeerA2& b, const PeerA1& a, const unsigned char* __restrict__ u8, const unsigned char* __restrict__ hq, float* __restrict__ aw, int tok, int half, int lane) {
    int mine = 0;
#pragma unroll
    for (int q = 0; q < 3; ++q) { int d = dot16(b.ur[q][0], b.hv[0]); d += dot16(b.ur[q][1], b.hv[1]); d += dot16(b.ur[q][2], b.hv[2]); d += dot16(b.ur[q][3], b.hv[3]);
        d = row_sum16(d);
#pragma unroll
        for (int r = 0; r < 4; ++r) { const int s = __builtin_amdgcn_readlane(d, 16 * r); mine = (b.rk == 4 * q + r) ? s : mine; } }
    float* awp = aw + (size_t)tok * 128 + 64 * half + lane;
    if (b.m && b.rk < PA_SLOTS) *awp = a.g * gelu_erf((float)mine * b.hsc * b.su) * b.sv;
    if (b.cnt > PA_SLOTS) {
        unsigned long long rem = b.rem; const v4u hw = *(const v4u*)(hq + (size_t)tok * 1024 + 16 * lane);
        while (rem != 0ull) { const int idx = __builtin_ctzll(rem); rem &= rem - 1ull; const int e = __builtin_amdgcn_readlane(a.e, idx);
            const int d = __builtin_amdgcn_readlane(wave_sum_to63(dot16(*(const v4u*)(u8 + (size_t)e * 1024 + 16 * lane), hw)), 63);
            if (lane == idx) *awp = a.g * gelu_erf((float)d * b.hsc * b.su) * b.sv; }
    }
}
__device__ __forceinline__ void peer_a_run(const unsigned char* __restrict__ hq, const float* __restrict__ hs, const unsigned char* __restrict__ u8, const float* __restrict__ su,
                                           const float* __restrict__ sv, const int* __restrict__ te, const float* __restrict__ tw, float* __restrict__ aw, LAS int* lst, int wrank, int wstep, int x, int lane, int hot = 0) {
    const int ntok = wrank < T ? (T - wrank + wstep - 1) / wstep : 0, N = 2 * ntok;
#define PA_TOK(n) (wrank + ((n) >> 1) * wstep)
    if (N == 0) return;
    PeerA1 a0, a1, a2; PeerA2 bA, bB;
    pa_s1(a0, te, tw, PA_TOK(0), 0, lane); pa_s1(a1, te, tw, PA_TOK(1), 1, lane);
    pa_s2(bA, a0, hq, hs, u8, su, sv, lst, PA_TOK(0), x, lane, hot);
#define PA_STEP(n, Bcur, Bnext, Acur, Anext, Anew) do { \
        if ((n) + 1 < N) pa_s2(Bnext, Anext, hq, hs, u8, su, sv, lst, PA_TOK((n) + 1), x, lane, hot); \
        if ((n) + 2 < N) pa_s1(Anew, te, tw, PA_TOK((n) + 2), ((n) + 2) & 1, lane); \
        pa_s3(Bcur, Acur, u8, hq, aw, PA_TOK(n), (n) & 1, lane); } while (0)
    for (int n = 0; n < N; n += 6) {
        PA_STEP(n, bA, bB, a0, a1, a2);
        if (n + 1 < N) PA_STEP(n + 1, bB, bA, a1, a2, a0);
        if (n + 2 < N) PA_STEP(n + 2, bA, bB, a2, a0, a1);
        if (n + 3 < N) PA_STEP(n + 3, bB, bA, a0, a1, a2);
        if (n + 4 < N) PA_STEP(n + 4, bA, bB, a1, a2, a0);
        if (n + 5 < N) PA_STEP(n + 5, bB, bA, a2, a0, a1);
    }
#undef PA_STEP
#undef PA_TOK
}
struct PeerB1 { v4u e[4]; f32x4 w[4]; };
struct PeerB2 { v4u vr[8]; };
struct PeerBAcc { int acc[16]; int wq[4]; float wsc, h0, h1; };
typedef float f32x2v __attribute__((ext_vector_type(2)));
__device__ __forceinline__ void pb_s1(PeerB1& a, const int* __restrict__ te, const float* __restrict__ aw, int tok, int lane) {
    const v4u* ep = (const v4u*)(te + (size_t)tok * 128 + 16 * (lane >> 3)); const f32x4* wp = (const f32x4*)(aw + (size_t)tok * 128 + 16 * (lane >> 3));
#pragma unroll
    for (int j = 0; j < 4; ++j) { a.e[j] = ep[j]; a.w[j] = wp[j]; } }
__device__ __forceinline__ int pb_col(int lane) { return 16 * (lane & 7) + 8 * ((lane >> 5) & 1) + 4 * ((lane >> 4) & 1) + 2 * ((lane >> 3) & 1); }
template <int CTRL, int RM> __device__ __forceinline__ float dpp_f(float x) { return __builtin_bit_cast(float, __builtin_amdgcn_update_dpp(0, __builtin_bit_cast(int, x), CTRL, RM, 0xf, false)); }
__device__ __forceinline__ void pb_quant(PeerBAcc& A, const PeerB1& a) {
    float mx = 0.f;
#pragma unroll
    for (int j = 0; j < 4; ++j) mx = fmaxf(mx, fmaxf(fmaxf(fabsf(a.w[j][0]), fabsf(a.w[j][1])), fmaxf(fabsf(a.w[j][2]), fabsf(a.w[j][3]))));
    mx = fmaxf(mx, dpp_f<0xb1, 0xf>(mx)); mx = fmaxf(mx, dpp_f<0x4e, 0xf>(mx)); mx = fmaxf(mx, dpp_f<0x124, 0xf>(mx)); mx = fmaxf(mx, dpp_f<0x128, 0xf>(mx));
    mx = fmaxf(mx, dpp_f<0x142, 0xa>(mx)); mx = fmaxf(mx, dpp_f<0x143, 0xc>(mx));
    mx = __builtin_bit_cast(float, __builtin_amdgcn_readlane(__builtin_bit_cast(int, mx), 63));
    const float inv = mx > 0.f ? 127.0f / mx : 0.f; A.wsc = mx * (1.0f / 127.0f);
#pragma unroll
    for (int j = 0; j < 4; ++j) A.wq[j] = (int)(((unsigned)(int)rintf(a.w[j][0] * inv) & 0xffu) | (((unsigned)(int)rintf(a.w[j][1] * inv) & 0xffu) << 8) |
                                               (((unsigned)(int)rintf(a.w[j][2] * inv) & 0xffu) << 16) | (((unsigned)(int)rintf(a.w[j][3] * inv) & 0xffu) << 24));
}
template <int HF> __device__ __forceinline__ void pb_s2(PeerB2& b, const PeerB1& a, const unsigned char* __restrict__ v8x, int lane, int hot = 0) {
    const int c = lane & 7;
#pragma unroll
    for (int m = 0; m < 8; ++m) { unsigned e = a.e[2 * HF + (m >> 2)][m & 3]; if (hot) e &= 255u; b.vr[m] = *(const v4u*)(v8x + (size_t)e * 128 + 16 * c); }
}
__device__ __forceinline__ float swap32_add(float lo, float hi) { const auto r = __builtin_amdgcn_permlane32_swap(__builtin_bit_cast(unsigned, lo), __builtin_bit_cast(unsigned, hi), false, false);
    return __builtin_bit_cast(float, r[0]) + __builtin_bit_cast(float, r[1]); }
__device__ __forceinline__ float swap16_add(float lo, float hi) { const auto r = __builtin_amdgcn_permlane16_swap(__builtin_bit_cast(unsigned, lo), __builtin_bit_cast(unsigned, hi), false, false);
    return __builtin_bit_cast(float, r[0]) + __builtin_bit_cast(float, r[1]); }
template <int HF> __device__ __forceinline__ void pb_s3(PeerBAcc& A, const PeerB2& b, const PeerB1& a, float* out, int tok, int x, int lane) {
    if (HF == 0) {
#pragma unroll
        for (int j = 0; j < 16; ++j) A.acc[j] = 0;
    }
#pragma unroll
    for (int gg = 0; gg < 2; ++gg)
#pragma unroll
        for (int d = 0; d < 4; ++d) { const unsigned ra = b.vr[4 * gg][d], rb = b.vr[4 * gg + 1][d], rc = b.vr[4 * gg + 2][d], rd = b.vr[4 * gg + 3][d];
            const unsigned t0 = __builtin_amdgcn_perm(rb, ra, 0x05010400u), t1 = __builtin_amdgcn_perm(rb, ra, 0x07030602u), t2 = __builtin_amdgcn_perm(rd, rc, 0x05010400u), t3 = __builtin_amdgcn_perm(rd, rc, 0x07030602u);
            const unsigned c0 = __builtin_amdgcn_perm(t2, t0, 0x05040100u), c1 = __builtin_amdgcn_perm(t2, t0, 0x07060302u), c2 = __builtin_amdgcn_perm(t3, t1, 0x05040100u), c3 = __builtin_amdgcn_perm(t3, t1, 0x07060302u);
            const int w4 = A.wq[2 * HF + gg];
            A.acc[4 * d] = __builtin_amdgcn_sdot4((int)c0, w4, A.acc[4 * d], false); A.acc[4 * d + 1] = __builtin_amdgcn_sdot4((int)c1, w4, A.acc[4 * d + 1], false);
            A.acc[4 * d + 2] = __builtin_amdgcn_sdot4((int)c2, w4, A.acc[4 * d + 2], false); A.acc[4 * d + 3] = __builtin_amdgcn_sdot4((int)c3, w4, A.acc[4 * d + 3], false); }
    if (HF == 1) {
        int r8[8], r4[4], r2[2];
#pragma unroll
        for (int j = 0; j < 8; ++j) { const bool up = (lane & 32) != 0; const int keep = up ? A.acc[j + 8] : A.acc[j], send = up ? A.acc[j] : A.acc[j + 8]; r8[j] = keep + __shfl_xor(send, 32); }
#pragma unroll
        for (int j = 0; j < 4; ++j) { const bool up = (lane & 16) != 0; const int keep = up ? r8[j + 4] : r8[j], send = up ? r8[j] : r8[j + 4]; r4[j] = keep + __shfl_xor(send, 16); }
#pragma unroll
        for (int j = 0; j < 2; ++j) { const bool up = (lane & 8) != 0; const int keep = up ? r4[j + 2] : r4[j], send = up ? r4[j] : r4[j + 2];
            r2[j] = keep + __builtin_amdgcn_update_dpp(0, send, 0x128, 0xf, 0xf, false); }
        f32x2v h2; h2.x = A.h0 + A.wsc * (float)r2[0]; h2.y = A.h1 + A.wsc * (float)r2[1];
        *(f32x2v*)(out + (size_t)tok * 1024 + 128 * x + pb_col(lane)) = h2;
    }
}
__device__ __forceinline__ void peer_b_run(const unsigned char* __restrict__ v8x, const int* __restrict__ te, const float* __restrict__ aw, float* out, int wrank, int wstep, int x, int lane, int hot = 0) {
    const int N = wrank < T ? (T - wrank + wstep - 1) / wstep : 0;
#define PB_TOK(n) (wrank + (n) * wstep)
#define PB_LOADH(n) do { const f32x2v h2_ = *(const f32x2v*)(out + (size_t)PB_TOK(n) * 1024 + 128 * x + pb_col(lane)); A.h0 = h2_.x; A.h1 = h2_.y; } while (0)
    if (N == 0) return;
    PeerB1 s0, s1; PeerB2 bA, bB; PeerBAcc A;
    pb_s1(s0, te, aw, PB_TOK(0), lane); if (N > 1) pb_s1(s1, te, aw, PB_TOK(1), lane);
    pb_s2<0>(bA, s0, v8x, lane, hot);
    for (int n = 0; n < N; n += 2) {
        pb_s2<1>(bB, s0, v8x, lane, hot); PB_LOADH(n); pb_quant(A, s0);
        pb_s3<0>(A, bA, s0, out, PB_TOK(n), x, lane);
        if (n + 1 < N) pb_s2<0>(bA, s1, v8x, lane, hot);
        pb_s3<1>(A, bB, s0, out, PB_TOK(n), x, lane);
        if (n + 2 < N) pb_s1(s0, te, aw, PB_TOK(n + 2), lane);
        if (n + 1 < N) {
            pb_s2<1>(bB, s1, v8x, lane, hot); PB_LOADH(n + 1); pb_quant(A, s1);
            pb_s3<0>(A, bA, s1, out, PB_TOK(n + 1), x, lane);
            if (n + 2 < N) pb_s2<0>(bA, s0, v8x, lane, hot);
            pb_s3<1>(A, bB, s1, out, PB_TOK(n + 1), x, lane);
            if (n + 3 < N) pb_s1(s1, te, aw, PB_TOK(n + 3), lane);
        }
    }
#undef PB_LOADH
#undef PB_TOK
}

__global__ void __launch_bounds__(NWAVES * 64, 2) mk_fwd(Args args) {
    extern __shared__ __attribute__((aligned(16))) unsigned char lds[];
    Frame F;
    F.lds = (LAS unsigned char*)lds;
    F.MISC = (volatile LAS unsigned*)(F.lds + MISC_OFF);
    F.tid = threadIdx.x; F.lane = F.tid & 63; F.wave = __builtin_amdgcn_readfirstlane(F.tid >> 6);
    F.G = gridDim.x; { const int bx = blockIdx.x; F.vcu = (F.G % 8 == 0) ? (bx % 8) * (F.G / 8) + bx / 8 : bx; }
    F.out = args.out; F.ws = args.ws;
    unsigned char* ws = args.ws;
    F.ctl = (gu32*)(ws + WS_CTL);
    for (int u = F.tid; u < (LDS_BYTES - LDSCTL_OFF) / 4; u += NWAVES * 64) ((LAS unsigned*)(F.lds + LDSCTL_OFF))[u] = 0u;
    __syncthreads();
    XcdBarrier bar; bar.bar = (unsigned*)(F.ctl + CW_BAR); bar.x = 0; bar.st = nullptr;
    if (N_LAUNCHES != PER_PHASE) bar = xcd_barrier_post((unsigned*)(F.ctl + CW_BAR), F.MISC + 8);
    if (N_LAUNCHES != PER_PHASE) { if (F.tid == 0) { const unsigned xid = xb_xcc_id(); F.MISC[12] = xid; F.MISC[13] = xb_add((unsigned*)(F.ctl + CW_TICKET) + 64 * xid, 1u); } __syncthreads(); }
#define GRID_BAR() do { if (N_LAUNCHES != PER_PHASE) xcd_barrier(bar); } while (0)
    const int lo = args.ph_lo, hi = args.ph_hi;
#define IN(k) (lo <= (k) && (k) < hi)
#define BOTH(k) (IN(k) && IN((k) + 1))
#ifndef DUP_PHASE
#define DUP_PHASE (-1)
#endif
#define NREP(k) ((DUP_PHASE == (k)) ? 2 : 1)
    const int gw = F.vcu * NWAVES + F.wave, NGW = F.G * NWAVES;
    bf16* const WinT = (bf16*)(ws + WS_WIN); bf16* const WvT = (bf16*)(ws + WS_WV); bf16* const WkvT = (bf16*)(ws + WS_WKV); bf16* const WbrT = (bf16*)(ws + WS_WBR);
    bf16* const WoutT = (bf16*)(ws + WS_WOUT); bf16* const WqT = (bf16*)(ws + WS_WQ); bf16* const KEYS = (bf16*)(ws + WS_KEYS); bf16* const PWT = (bf16*)(ws + WS_PWT);
    bf16* const MEMN = (bf16*)(ws + WS_MEMN); bf16* const KMEM = (bf16*)(ws + WS_KMEM); bf16* const VTMEM = (bf16*)(ws + WS_VTMEM); float* const RSTDX = (float*)(ws + WS_RSTDX);
    const unsigned char* const U8 = ws + WS_U8; const unsigned char* const V8 = ws + WS_V8; const float* const SU = (const float*)(ws + WS_SU); const float* const SV = (const float*)(ws + WS_SV);
    bf16* const QN = (bf16*)(ws + WS_QN); bf16* const KN = (bf16*)(ws + WS_KN); bf16* const VT = (bf16*)(ws + WS_VT); bf16* const PP = (bf16*)(ws + WS_PP); bf16* const XQ = (bf16*)(ws + WS_XQ);
    bf16* const GATE = (bf16*)(ws + WS_GATE); bf16* const MERGED = (bf16*)(ws + WS_MERGED); bf16* const HB = (bf16*)(ws + WS_HB); bf16* const QB = (bf16*)(ws + WS_QB);
    int* const TE = (int*)(ws + WS_TE); float* const TW = (float*)(ws + WS_TW); float* const AW = (float*)(ws + WS_AW); float* const ROWSQ = (float*)(ws + WS_ROWSQ);
    bf16* const XB = (bf16*)((unsigned char*)args.out + OUT_XB); bf16* const YNA = (bf16*)((unsigned char*)args.out + OUT_YNA);
    bf16* const YPOOL = (bf16*)((unsigned char*)args.out + OUT_YPOOL); bf16* const YXA = (bf16*)((unsigned char*)args.out + OUT_YXA);

    if (IN(0)) { for (int rep = 0; rep < NREP(0); ++rep) { p0_prologue(F, args); if (rep + 1 < NREP(0)) GRID_BAR(); } if (BOTH(0)) GRID_BAR(); }

    if (IN(1)) {
      for (int rep = 0; rep < NREP(1); ++rep) {
        { pg8::Sched1 S; S.so.init(T, IN_MAIN, F.G, (int)blockIdx.x); S.A = (const char*)XB; S.Bt = (const char*)WinT; S.tstep = (size_t)256 * 1024 * 2;
          pg8::EpiProj E{RSTDX, QN, KN, PP, XQ, GATE, args.in[I_NAQG], args.in[I_NAKG], args.in[I_GATEB]};
          pg8::gemm_phase<pg8::EpiProj, pg8::Sched1, true, true>(F.lds + RING_OFF, 1024, S, E); }
        { pg8::Sched1 S; S.so.init(512, T, F.G, (int)blockIdx.x); S.A = (const char*)WvT; S.Bt = (const char*)XB; S.tstep = (size_t)256 * 1024 * 2;
          pg8::EpiVt E{RSTDX, VT};
          pg8::gemm_phase<pg8::EpiVt, pg8::Sched1, false, true>(F.lds + RING_OFF, 1024, S, E); }
        for (int t = gw; t < 512; t += NGW) memkv_tile(MEMN, WkvT, args.in[I_XAKG], args.in[I_XAQG], KMEM, VTMEM, t, F.lane);
        if (rep + 1 < NREP(1)) GRID_BAR();
      }
        if (BOTH(1)) GRID_BAR();
    }

    if (IN(2)) {
      for (int rep = 0; rep < NREP(2); ++rep) {
        LAS float* rpl = (LAS float*)(F.lds + RING_OFF + F.wave * 16384);
        for (int i = F.lane; i < 15 * 31; i += 64) rpl[i] = args.in[I_RPB][F.wave * 15 * 31 + i];
        LDS_WAIT(); asm volatile("" ::: "memory");
        for (int i = F.vcu; i < 256; i += F.G)
            for (int k = 0; k < 8; ++k) { const int idx = i * 8 + k, b = idx >> 9, r = (idx >> 2) & 127, jb = idx & 3; na_item(QN, KN, VT, rpl, YNA, b, r, jb, F.wave, F.lane); }
        for (int i = F.vcu; i < 256; i += F.G) pool_wg(PP, PWT, YPOOL, F.lds + RING_OFF, i * 128, F.wave, F.lane);
        { const int pair = F.vcu & 15, xb = pair >> 2, xh = pair & 3, slot = F.vcu >> 4, nslot = F.G >> 4;
          __syncthreads(); xa_fill_lds(KMEM, VTMEM, F.lds + RING_OFF, xb, xh, F.tid); __syncthreads();
          if (slot < nslot) for (int n = slot * NWAVES + F.wave; n < 512; n += nslot * NWAVES) xa_item(XQ, F.lds + RING_OFF, YXA, (xb * 512 + n) * 16, xh, F.lane);
          __syncthreads(); }
        if (rep + 1 < NREP(2)) GRID_BAR();
      }
        if (BOTH(2)) GRID_BAR();
    }

    if (IN(3)) {
      for (int rep = 0; rep < NREP(3); ++rep) {
        pg8::Sched3 S; S.so.init(T, D, F.G, (int)blockIdx.x); S.A = (const char*)YNA; S.Bt = (const char*)WbrT; S.tstep = (size_t)256 * 512 * 2; S.strideA = 32 * MiB; S.strideB = (size_t)1024 * 512 * 2;
        pg8::EpiMerge E{GATE, (bf16*)(ws + WS_VT)  , MERGED};
        pg8::gemm_phase<pg8::EpiMerge, pg8::Sched3, true, true>(F.lds + RING_OFF, 512, S, E);
        if (rep + 1 < NREP(3)) GRID_BAR();
      }
        if (BOTH(3)) GRID_BAR();
    }

    if (IN(4)) {
      for (int rep = 0; rep < NREP(4); ++rep) {
        pg8::Sched1 S; S.so.init(T, D, F.G, (int)blockIdx.x); S.A = (const char*)MERGED; S.Bt = (const char*)WoutT; S.tstep = (size_t)256 * 1024 * 2;
        pg8::EpiH E{args.in[I_X], F.out, HB, ROWSQ};
        pg8::gemm_phase<pg8::EpiH, pg8::Sched1, true, true>(F.lds + RING_OFF, 1024, S, E);
        if (rep + 1 < NREP(4)) { GRID_BAR(); for (int m = gw * 64 + F.lane; m < T; m += NGW * 64) ROWSQ[m] = 0.f; GRID_BAR(); }
      }
        if (BOTH(4)) GRID_BAR();
    }

    if (IN(5)) {
      for (int rep = 0; rep < NREP(5); ++rep) {
        pg8::Sched1 S; S.so.init(T, 2048, F.G, (int)blockIdx.x); S.A = (const char*)HB; S.Bt = (const char*)WqT; S.tstep = (size_t)256 * 1024 * 2;
        pg8::EpiQ E{ROWSQ, QB};
        pg8::gemm_phase<pg8::EpiQ, pg8::Sched1, true, true>(F.lds + RING_OFF, 1024, S, E);
        if (rep + 1 < NREP(5)) GRID_BAR();
      }
        if (BOTH(5)) GRID_BAR();
    }

    if (IN(6)) {
        LAS int* lscr = (LAS int*)(F.lds + RING_OFF + 65536 + F.wave * 8192);
        for (int tok = gw; tok < T; tok += NGW) hq_token(HB, ROWSQ, ws + WS_HQ, (float*)(ws + WS_HS), tok, F.lane);
        { const int th = F.vcu & 7, slot = F.vcu >> 3, nslot = F.G >> 3;
          __syncthreads(); topk_fill_lds(KEYS, F.lds + RING_OFF, th, F.tid); __syncthreads();
          for (int rep = 0; rep < NREP(6); ++rep) { for (int n = slot * NWAVES + F.wave; n < 2048; n += nslot * NWAVES) topk_item(QB, F.lds + RING_OFF, TE, TW, lscr, n * 16, th, F.lane); if (rep + 1 < NREP(6)) GRID_BAR(); }
          __syncthreads(); }
        if (BOTH(6)) GRID_BAR();
    }

    if (IN(7)) {
        int x0 = 0, nxs = 8, wrank = (int)blockIdx.x * NWAVES + F.wave, wstep = F.G * NWAVES;
        if (N_LAUNCHES != PER_PHASE) { const unsigned xid = F.MISC[12], rk = F.MISC[13]; unsigned nx = 0, below = 0, mine = 0;
            for (unsigned j = 0; j < 16; ++j) { const unsigned c = xb_ld((unsigned*)(F.ctl + CW_BAR) + XB_XCNT(j)); nx += c > 0u; below += (c > 0u && j < xid); mine = (j == xid) ? c : mine; }
            if (nx == 8 && mine > 0 && rk < mine) { x0 = (int)below; nxs = 1; wrank = (int)rk * NWAVES + F.wave; wstep = (int)mine * NWAVES; } }
        else if ((F.G & 7) == 0) { x0 = (int)blockIdx.x & 7; nxs = 1; wrank = ((int)blockIdx.x >> 3) * NWAVES + F.wave; wstep = (F.G >> 3) * NWAVES; }
        for (int xs = 0; xs < nxs; ++xs) peer_a_run(ws + WS_HQ, (const float*)(ws + WS_HS), U8, SU, SV, TE, TW, args.probe ? (float*)QB : AW, (LAS int*)(F.lds + RING_OFF + F.wave * 16384), wrank, wstep, x0 + xs, F.lane, args.probe == 2);
        if (N_LAUNCHES != PER_PHASE) xcd_barrier(bar);
    }
    if (IN(8)) {
        int x0 = 0, nxs = 8, wrank = (int)blockIdx.x * NWAVES + F.wave, wstep = F.G * NWAVES;
        if (N_LAUNCHES != PER_PHASE) { const unsigned xid = F.MISC[12], rk = F.MISC[13]; unsigned nx = 0, below = 0, mine = 0;
            for (unsigned j = 0; j < 16; ++j) { const unsigned c = xb_ld((unsigned*)(F.ctl + CW_BAR) + XB_XCNT(j)); nx += c > 0u; below += (c > 0u && j < xid); mine = (j == xid) ? c : mine; }
            if (nx == 8 && mine > 0 && rk < mine) { x0 = (int)below; nxs = 1; wrank = (int)rk * NWAVES + F.wave; wstep = (int)mine * NWAVES; } }
        else if ((F.G & 7) == 0) { x0 = (int)blockIdx.x & 7; nxs = 1; wrank = ((int)blockIdx.x >> 3) * NWAVES + F.wave; wstep = (F.G >> 3) * NWAVES; }
        for (int xs = 0; xs < nxs; ++xs) peer_b_run(V8 + (size_t)(x0 + xs) * (2 * MiB), TE, AW, args.probe ? (float*)QB : F.out, wrank, wstep, x0 + xs, F.lane, args.probe == 2);
    }
#undef IN
#undef BOTH
#undef GRID_BAR
}

extern "C" void kernel_launch(void* const* d_in, const int* in_sizes, int n_in, void* d_out, int out_size, void* d_ws, size_t ws_size, hipStream_t stream) {
    static int grid = 0;
    if (grid == 0) {
        if (n_in != 23 || in_sizes[0] != T * D || out_size != T * D || ws_size < WS_END) { fprintf(stderr, "kernel_launch: unexpected shapes: n_in %d in0 %d out %d ws %zu\n", n_in, n_in > 0 ? in_sizes[0] : -1, out_size, ws_size); grid = -1; return; }
        int dev = 0, cus = 0, per_cu = 0;
        if (hipGetDevice(&dev) != hipSuccess || hipDeviceGetAttribute(&cus, hipDeviceAttributeMultiprocessorCount, dev) != hipSuccess) { fprintf(stderr, "kernel_launch: device query failed\n"); grid = -1; return; }
        if (hipFuncSetAttribute((const void*)mk_fwd, hipFuncAttributeMaxDynamicSharedMemorySize, LDS_BYTES) != hipSuccess) { fprintf(stderr, "kernel_launch: hipFuncSetAttribute failed\n"); grid = -1; return; }
        if (hipOccupancyMaxActiveBlocksPerMultiprocessor(&per_cu, (const void*)mk_fwd, NWAVES * 64, LDS_BYTES) != hipSuccess || per_cu < 1)
            fprintf(stderr, "kernel_launch: note: occupancy query reports %d workgroups per CU\n", per_cu);
        (void)hipGetLastError();
        grid = cus;
    }
    if (grid < 0) return;
    if (hipMemsetAsync((char*)d_ws + WS_CTL, 0, CTL_ZERO_BYTES, stream) != hipSuccess) { fprintf(stderr, "kernel_launch: memset failed\n"); return; }
    Args a{};
    for (int i = 0; i < 23; ++i) a.in[i] = (const float*)d_in[i];
    a.out = (float*)d_out; a.ws = (unsigned char*)d_ws;
    for (int li = 0; li < N_LAUNCHES; ++li) {
        a.ph_lo = (N_LAUNCHES == PER_PHASE) ? li : 0; a.ph_hi = (N_LAUNCHES == PER_PHASE) ? li + 1 : PER_PHASE;
        hipLaunchKernelGGL(mk_fwd, dim3(grid), dim3(NWAVES * 64), LDS_BYTES, stream, a);
#ifdef HOST_DUP_PHASE
        if (N_LAUNCHES == PER_PHASE && li == HOST_DUP_PHASE) { if (li == 4) (void)hipMemsetAsync((char*)d_ws + WS_ROWSQ, 0, (size_t)T * 4, stream);
#ifdef PROBE_MODE
            a.probe = PROBE_MODE;
#endif
            hipLaunchKernelGGL(mk_fwd, dim3(grid), dim3(NWAVES * 64), LDS_BYTES, stream, a); a.probe = 0; }
#endif
        const hipError_t le = hipPeekAtLastError();
        if (le != hipSuccess) { fprintf(stderr, "kernel_launch: launch %d failed: %s\n", li, hipGetErrorName(le)); break; }
    }
}
```

```cpp
#define MK_N_LAUNCHES 1
#include <hip/hip_runtime.h>
#include <cstdio>
#include <cstdint>

#ifndef MK_N_LAUNCHES
#define MK_N_LAUNCHES 1
#endif

namespace pg8 {
#define PG8_LAS __attribute__((address_space(3)))
typedef unsigned short bf16_t;
typedef short bf16x8 __attribute__((ext_vector_type(8)));
typedef float f32x4 __attribute__((ext_vector_type(4)));
typedef unsigned u32x4 __attribute__((ext_vector_type(4)));
typedef unsigned u32x2 __attribute__((ext_vector_type(2)));
constexpr int BM = 256, BK = 64, HALF = 128, HTB = HALF * BK * 2  , STAGE_BYTES = 8 * HTB, NXCD = 8, WGM = 8;

__host__ __device__ __forceinline__ int lds_byte(int r, int c) { const int st = (r >> 4) * 2 + (c >> 5), rr = r & 15, cc = c & 31, ob = rr * 64 + cc * 2; return st * 1024 + (ob ^ (((ob >> 9) & 1) << 5)); }
__host__ __device__ __forceinline__ void stage_rc(int b, int& R, int& C) { const int st = b / 1024, sb = b % 1024, swz = sb ^ (((sb >> 9) & 1) << 5); R = (st >> 1) * 16 + swz / 64; C = (st & 1) * 32 + (swz % 64) / 2; }
__host__ __device__ __forceinline__ int perm32(int rho) { const int n = rho >> 4, i = rho & 15; return 8 * (i >> 2) + 4 * n + (i & 3); }

struct Unit { int pm, pn, br; };

struct StaticOrder {
    int nM, nN, nwg, G, c;
    __host__ __device__ void init(int M, int N, int G_, int c_) { nM = M / BM; nN = N / BM; nwg = nM * nN; G = G_; c = c_; }
    __host__ __device__ bool next(int i, Unit& u) const {
        const long L = (long)i * G + c; if (L >= nwg) return false;
        int wgid = (int)L; { const int q = nwg / NXCD, r = nwg % NXCD, xcd = wgid % NXCD, off = wgid / NXCD; wgid = (xcd < r ? xcd * (q + 1) : r * (q + 1) + (xcd - r) * q) + off; }
        const int nig = WGM * nN, gid = wgid / nig, fm = gid * WGM, gsz = (nM - fm) < WGM ? (nM - fm) : WGM;
        u.pm = fm + ((wgid % nig) % gsz); u.pn = (wgid % nig) / gsz; return true;
    }
};
struct Sched1 {
    StaticOrder so; const char* A; const char* Bt; size_t tstep;
    __device__ __forceinline__ bool next(int i, Unit& u) const { u.br = 0; return so.next(i, u); }
    __device__ __forceinline__ const char* abase(const Unit& u) const { return A + (size_t)u.pm * tstep; }
    __device__ __forceinline__ const char* bbase(const Unit& u) const { return Bt + (size_t)u.pn * tstep; }
    __device__ __forceinline__ void a_ready(const Unit&) const {}
    __device__ __forceinline__ void done(const Unit&) const {}
};
struct Sched3 {
    StaticOrder so; const char* A; const char* Bt; size_t tstep, strideA, strideB;
    __device__ __forceinline__ bool next(int i, Unit& u) const { u.br = i % 3; return so.next(i / 3, u); }
    __device__ __forceinline__ const char* abase(const Unit& u) const { return A + (size_t)u.br * strideA + (size_t)u.pm * tstep; }
    __device__ __forceinline__ const char* bbase(const Unit& u) const { return Bt + (size_t)u.br * strideB + (size_t)u.pn * tstep; }
    __device__ __forceinline__ void a_ready(const Unit&) const {}
    __device__ __forceinline__ void done(const Unit&) const {}
};

typedef float f32x2_t __attribute__((ext_vector_type(2))); typedef __bf16 bf16x2v_t __attribute__((ext_vector_type(2)));
__device__ __forceinline__ unsigned cvt_pk_bf16(float lo, float hi) { const f32x2_t v = {lo, hi}; const bf16x2v_t b = __builtin_convertvector(v, bf16x2v_t); return __builtin_bit_cast(unsigned, b); }
__device__ __forceinline__ u32x4 pack8(const f32x4 a, const f32x4 b) { u32x4 w; w.x = cvt_pk_bf16(a[0], a[1]); w.y = cvt_pk_bf16(a[2], a[3]); w.z = cvt_pk_bf16(b[0], b[1]); w.w = cvt_pk_bf16(b[2], b[3]); return w; }
__device__ __forceinline__ float bflo(unsigned u) { return __builtin_bit_cast(float, u << 16); }
__device__ __forceinline__ float bfhi(unsigned u) { return __builtin_bit_cast(float, u & 0xffff0000u); }


constexpr float RMS_EPS = 1e-6f;

struct EpiProj {
    static constexpr bool PERM = true, AFTER_DRAIN = false;
    const float* rstd; bf16_t *qn, *kn, *pp, *xq, *gates; const float *qg, *kg, *gate_b;
    __device__ __forceinline__ void operator()(const f32x4 (&acc)[2][2][4][2], const Unit& u, int wr, int wc, int fr, int fq) const {
        const int pn = u.pn, row0 = u.pm * BM + wr * 64 + fr, lc0 = 64 * wc + 8 * fq;
        float rsv[2][4];
#pragma unroll
        for (int ai = 0; ai < 2; ++ai)
#pragma unroll
            for (int m = 0; m < 4; ++m) rsv[ai][m] = rstd[row0 + ai * HALF + m * 16];
        if (pn < 4) {
            const bool isq = pn < 2; bf16_t* O = isq ? qn : kn; const float* g = isq ? qg : kg; const float post = isq ? 0.125f : 1.0f;
            f32x4 gv[2][2];
#pragma unroll
            for (int bj = 0; bj < 2; ++bj)
#pragma unroll
                for (int n = 0; n < 2; ++n) gv[bj][n] = *(const f32x4*)(g + 32 * bj + 8 * fq + 4 * n);
            const int colbase = (pn & 1) * 256 + lc0;
#pragma unroll
            for (int ai = 0; ai < 2; ++ai)
#pragma unroll
                for (int m = 0; m < 4; ++m) {
                    const int row = row0 + ai * HALF + m * 16; const float rs = rsv[ai][m];
                    f32x4 v[2][2]; float ss = 0.f;
#pragma unroll
                    for (int bj = 0; bj < 2; ++bj)
#pragma unroll
                        for (int n = 0; n < 2; ++n) { v[bj][n] = acc[ai][bj][m][n] * rs; ss += (v[bj][n][0] * v[bj][n][0] + v[bj][n][1] * v[bj][n][1]) + (v[bj][n][2] * v[bj][n][2] + v[bj][n][3] * v[bj][n][3]); }
                    ss += __shfl_xor(ss, 16); ss += __shfl_xor(ss, 32);
                    const float r = rsqrtf(ss * (1.0f / 64.0f) + RMS_EPS) * post;
#pragma unroll
                    for (int bj = 0; bj < 2; ++bj) *(u32x4*)(O + (size_t)row * 512 + colbase + 32 * bj) = pack8(v[bj][0] * r * gv[bj][0], v[bj][1] * r * gv[bj][1]);
                }
        } else if (pn < 8) {
            bf16_t* O = pn < 6 ? pp : xq; const int colbase = (pn & 1) * 256 + lc0;
#pragma unroll
            for (int ai = 0; ai < 2; ++ai)
#pragma unroll
                for (int m = 0; m < 4; ++m) {
                    const int row = row0 + ai * HALF + m * 16; const float rs = rsv[ai][m];
#pragma unroll
                    for (int bj = 0; bj < 2; ++bj) *(u32x4*)(O + (size_t)row * 512 + colbase + 32 * bj) = pack8(acc[ai][bj][m][0] * rs, acc[ai][bj][m][1] * rs);
                }
        } else {
            const int gcol0 = (pn - 8) * 256 + lc0;
            f32x4 bv[2][2];
#pragma unroll
            for (int bj = 0; bj < 2; ++bj)
#pragma unroll
                for (int n = 0; n < 2; ++n) bv[bj][n] = *(const f32x4*)(gate_b + gcol0 + 32 * bj + 4 * n);
#pragma unroll
            for (int ai = 0; ai < 2; ++ai)
#pragma unroll
                for (int m = 0; m < 4; ++m) {
                    const int row = row0 + ai * HALF + m * 16; const float rs = rsv[ai][m];
#pragma unroll
                    for (int bj = 0; bj < 2; ++bj) {
                        f32x4 o[2];
#pragma unroll
                        for (int n = 0; n < 2; ++n) { const f32x4 z = acc[ai][bj][m][n] * rs + bv[bj][n];
#pragma unroll
                            for (int i = 0; i < 4; ++i) o[n][i] = __builtin_amdgcn_rcpf(1.0f + __expf(-z[i])); }
                        *(u32x4*)(gates + (size_t)row * 3072 + gcol0 + 32 * bj) = pack8(o[0], o[1]);
                    }
                }
        }
    }
};
struct EpiVt {
    static constexpr bool PERM = true, AFTER_DRAIN = false;
    const float* rstd; bf16_t* Vt;
    __device__ __forceinline__ void operator()(const f32x4 (&acc)[2][2][4][2], const Unit& u, int wr, int wc, int fr, int fq) const {
        const int ch0 = u.pm * BM + wr * 64 + fr, tok0 = u.pn * BM + wc * 32 + 8 * fq, b = tok0 >> 13, t0 = tok0 & 8191;
        f32x4 rv[2][2];
#pragma unroll
        for (int bj = 0; bj < 2; ++bj)
#pragma unroll
            for (int n = 0; n < 2; ++n) rv[bj][n] = *(const f32x4*)(rstd + tok0 + bj * HALF + 4 * n);
#pragma unroll
        for (int ai = 0; ai < 2; ++ai)
#pragma unroll
            for (int m = 0; m < 4; ++m) { const int ch = ch0 + ai * HALF + m * 16; bf16_t* rowp = Vt + ((size_t)(b * 512 + ch) * 8192 + t0);
#pragma unroll
                for (int bj = 0; bj < 2; ++bj) *(u32x4*)(rowp + bj * HALF) = pack8(acc[ai][bj][m][0] * rv[bj][0], acc[ai][bj][m][1] * rv[bj][1]); }
    }
};
struct EpiMerge {
    static constexpr bool PERM = true, AFTER_DRAIN = false;
    const bf16_t* gates; bf16_t* pa; bf16_t* merged;
    __device__ __forceinline__ void operator()(const f32x4 (&acc)[2][2][4][2], const Unit& u, int wr, int wc, int fr, int fq) const {
        const int row0 = u.pm * BM + wr * 64 + fr, col0 = u.pn * BM + wc * 32 + 8 * fq, br = u.br;
        const bf16_t* src = br == 1 ? pa : merged; bf16_t* dst = br == 0 ? pa : merged;
#pragma unroll
        for (int ai = 0; ai < 2; ++ai) {
            u32x4 g8[4][2], p8[4][2];
#pragma unroll
            for (int m = 0; m < 4; ++m)
#pragma unroll
                for (int bj = 0; bj < 2; ++bj) { const int row = row0 + ai * HALF + m * 16;
                    g8[m][bj] = *(const u32x4*)(gates + (size_t)row * 3072 + br * 1024 + col0 + bj * HALF);
                    p8[m][bj] = (u32x4){0u, 0u, 0u, 0u}; if (br > 0) p8[m][bj] = *(const u32x4*)(src + (size_t)row * 1024 + col0 + bj * HALF); }
            __builtin_amdgcn_sched_barrier(0);
#pragma unroll
            for (int m = 0; m < 4; ++m)
#pragma unroll
                for (int bj = 0; bj < 2; ++bj) { const int row = row0 + ai * HALF + m * 16; const u32x4 g = g8[m][bj], q = p8[m][bj];
                    f32x4 a = acc[ai][bj][m][0], b = acc[ai][bj][m][1];
                    a[0] = a[0] * bflo(g.x) + bflo(q.x); a[1] = a[1] * bfhi(g.x) + bfhi(q.x); a[2] = a[2] * bflo(g.y) + bflo(q.y); a[3] = a[3] * bfhi(g.y) + bfhi(q.y);
                    b[0] = b[0] * bflo(g.z) + bflo(q.z); b[1] = b[1] * bfhi(g.z) + bfhi(q.z); b[2] = b[2] * bflo(g.w) + bflo(q.w); b[3] = b[3] * bfhi(g.w) + bfhi(q.w);
                    *(u32x4*)(dst + (size_t)row * 1024 + col0 + bj * HALF) = pack8(a, b); }
            __builtin_amdgcn_sched_barrier(0);
        }
    }
};
struct EpiH {
    static constexpr bool PERM = true, AFTER_DRAIN = false;
    const float* x; float* out; bf16_t* hb; float* rowsq; int noatomic;
    __device__ __forceinline__ void operator()(const f32x4 (&acc)[2][2][4][2], const Unit& u, int wr, int wc, int fr, int fq) const {
        const int row0 = u.pm * BM + wr * 64 + fr, col0 = u.pn * BM + wc * 32 + 8 * fq;
#pragma unroll
        for (int ai = 0; ai < 2; ++ai) {
            f32x4 xv[4][2][2];
#pragma unroll
            for (int m = 0; m < 4; ++m)
#pragma unroll
                for (int bj = 0; bj < 2; ++bj) { const size_t o = (size_t)(row0 + ai * HALF + m * 16) * 1024 + col0 + bj * HALF; xv[m][bj][0] = *(const f32x4*)(x + o); xv[m][bj][1] = *(const f32x4*)(x + o + 4); }
            __builtin_amdgcn_sched_barrier(0);
#pragma unroll
            for (int m = 0; m < 4; ++m) { const int row = row0 + ai * HALF + m * 16; float ss = 0.f;
#pragma unroll
                for (int bj = 0; bj < 2; ++bj) { const size_t o = (size_t)row * 1024 + col0 + bj * HALF;
                    const f32x4 h0 = xv[m][bj][0] + acc[ai][bj][m][0], h1 = xv[m][bj][1] + acc[ai][bj][m][1];
                    *(u32x4*)(hb + o) = pack8(h0, h1);
                    ss += (h0[0] * h0[0] + h0[1] * h0[1]) + (h0[2] * h0[2] + h0[3] * h0[3]) + (h1[0] * h1[0] + h1[1] * h1[1]) + (h1[2] * h1[2] + h1[3] * h1[3]); }
                ss += __shfl_xor(ss, 16); ss += __shfl_xor(ss, 32);
                if (fq == 0 && !noatomic) atomicAdd(rowsq + row, ss); }
            __builtin_amdgcn_sched_barrier(0);
        }
    }
};
struct EpiQ {
    static constexpr bool PERM = true, AFTER_DRAIN = false;
    const float* rowsq; bf16_t* qb;
    __device__ __forceinline__ void operator()(const f32x4 (&acc)[2][2][4][2], const Unit& u, int wr, int wc, int fr, int fq) const {
        const int row0 = u.pm * BM + wr * 64 + fr, col0 = u.pn * BM + wc * 32 + 8 * fq;
        float rq[2][4];
#pragma unroll
        for (int ai = 0; ai < 2; ++ai)
#pragma unroll
            for (int m = 0; m < 4; ++m) rq[ai][m] = rowsq[row0 + ai * HALF + m * 16];
#pragma unroll
        for (int ai = 0; ai < 2; ++ai)
#pragma unroll
            for (int m = 0; m < 4; ++m) { const int row = row0 + ai * HALF + m * 16; const float r = rsqrtf(rq[ai][m] * (1.0f / 1024.0f) + RMS_EPS);
#pragma unroll
                for (int bj = 0; bj < 2; ++bj) *(u32x4*)(qb + (size_t)row * 2048 + col0 + bj * HALF) = pack8(acc[ai][bj][m][0] * r, acc[ai][bj][m][1] * r); }
    }
};

template <class Epi, class Sched, bool ALIGN_EPI = false, bool SP2 = false>
__device__ __forceinline__ void gemm_phase(PG8_LAS unsigned char* lds, const int K, const Sched& S, const Epi& E) {
    const int tid = threadIdx.x, wid = __builtin_amdgcn_readfirstlane(tid >> 6), lane = tid & 63, wr = wid >> 2, wc = wid & 3, fr = lane & 15, fq = lane >> 4;
    const int nt = K / BK;
    unsigned voffA[2], voffB[2];
#pragma unroll
    for (int i = 0; i < 2; ++i) { int R, C; stage_rc(tid * 16 + i * 8192, R, C); const int Rb = Epi::PERM ? ((R & ~31) + perm32(R & 31)) : R;
        voffA[i] = (unsigned)(R * K + C) * 2u; voffB[i] = (unsigned)(Rb * K + C) * 2u; }
    const size_t kstep = (size_t)(BK * 2);
    const size_t hstep = (size_t)HALF * K * 2;
    const size_t tstep = 2 * hstep;
    const unsigned ldsw = (unsigned)wid * 1024u;
    const int aoff = lds_byte(wr * 64 + fr, fq * 8), boff = lds_byte(wc * 32 + fr, fq * 8);
#define PG8_SA(b, h) (((b) * 2 + (h)) * HTB)
#define PG8_SB(b, h) ((4 + (b) * 2 + (h)) * HTB)
#define PG8_STAGE(bufoff, gbase, voff) do { _Pragma("unroll") for (int _i = 0; _i < 2; ++_i) \
        __builtin_amdgcn_global_load_lds((const unsigned*)((const char*)(gbase) + (voff)[_i]), (PG8_LAS unsigned*)(lds + (bufoff) + ldsw + _i * 8192), 16, 0, 0); } while (0)
#define PG8_LDA(dst, b, h) do { _Pragma("unroll") for (int m = 0; m < 4; ++m) _Pragma("unroll") for (int k = 0; k < 2; ++k) dst[m][k] = *(const PG8_LAS bf16x8*)(lds + PG8_SA(b, h) + aoff + m * 2048 + k * 1024); } while (0)
#define PG8_LDB(dst, b, h) do { _Pragma("unroll") for (int n = 0; n < 2; ++n) _Pragma("unroll") for (int k = 0; k < 2; ++k) dst[n][k] = *(const PG8_LAS bf16x8*)(lds + PG8_SB(b, h) + boff + n * 2048 + k * 1024); } while (0)
#define PG8_MMA(ai, bj, At, Bt) do { __builtin_amdgcn_s_setprio(1); _Pragma("unroll") for (int m = 0; m < 4; ++m) _Pragma("unroll") for (int n = 0; n < 2; ++n) _Pragma("unroll") for (int k = 0; k < 2; ++k) \
        acc[ai][bj][m][n] = __builtin_amdgcn_mfma_f32_16x16x32_bf16(Bt[n][k], At[m][k], acc[ai][bj][m][n], 0, 0, 0); __builtin_amdgcn_s_setprio(0); } while (0)
#define PG8_WAIT_V(n) asm volatile("s_waitcnt vmcnt(" #n ")" ::: "memory")
#define PG8_WAIT_L(n) asm volatile("s_waitcnt lgkmcnt(" #n ")" ::: "memory")
#define PG8_BAR __builtin_amdgcn_s_barrier()
#define PG8_SCHED __builtin_amdgcn_sched_barrier(0)
    Unit cur, nxt; int ui = 0;
    if (!S.next(0, cur)) return;
    f32x4 acc[2][2][4][2];
#pragma unroll
    for (int a = 0; a < 2; ++a)
#pragma unroll
        for (int b = 0; b < 2; ++b)
#pragma unroll
            for (int m = 0; m < 4; ++m)
#pragma unroll
                for (int n = 0; n < 2; ++n) acc[a][b][m][n] = (f32x4){0.f, 0.f, 0.f, 0.f};
    bf16x8 At[4][2], B0[2][2], B1[2][2];
    const char* cA = S.abase(cur); const char* cB = S.bbase(cur);
    S.a_ready(cur);
    if constexpr (SP2) {
        PG8_STAGE(PG8_SB(0, 0), cB, voffB); PG8_STAGE(PG8_SB(0, 1), cB + hstep, voffB); PG8_STAGE(PG8_SA(0, 0), cA, voffA); PG8_STAGE(PG8_SA(0, 1), cA + hstep, voffA);
        if (wr == 1) PG8_BAR;
        PG8_WAIT_V(2); PG8_BAR;
        PG8_STAGE(PG8_SB(1, 0), cB + kstep, voffB); PG8_STAGE(PG8_SA(1, 0), cA + kstep, voffA); PG8_STAGE(PG8_SB(1, 1), cB + hstep + kstep, voffB);
        PG8_WAIT_V(6); PG8_BAR;
    } else {
        PG8_STAGE(PG8_SB(0, 0), cB, voffB); PG8_STAGE(PG8_SA(0, 0), cA, voffA); PG8_STAGE(PG8_SB(0, 1), cB + hstep, voffB); PG8_STAGE(PG8_SA(0, 1), cA + hstep, voffA);
        if (wr == 1) PG8_BAR;
        PG8_WAIT_V(4); PG8_BAR;
        PG8_STAGE(PG8_SB(1, 0), cB + kstep, voffB); PG8_STAGE(PG8_SA(1, 0), cA + kstep, voffA); PG8_STAGE(PG8_SB(1, 1), cB + hstep + kstep, voffB);
        PG8_WAIT_V(6); PG8_BAR;
    }
    for (;;) {
        const bool has_next = S.next(ui + 1, nxt);
        const char* nA = has_next ? S.abase(nxt) : cA; const char* nB = has_next ? S.bbase(nxt) : cB;
        for (int t = 0; t < nt; t += 2) {
            const bool last = (t == nt - 2);
            const char* a1 = cA + (size_t)(t + 1) * kstep;
            const char* a2 = last ? nA : cA + (size_t)(t + 2) * kstep; const char* b2 = last ? nB : cB + (size_t)(t + 2) * kstep;
            const char* a3 = a2 + kstep; const char* b3 = b2 + kstep;
            if (last && has_next) S.a_ready(nxt);
            if constexpr (SP2) {
            PG8_LDB(B0, 0, 0); PG8_LDB(B1, 0, 1); PG8_SCHED; PG8_LDA(At, 0, 0); PG8_STAGE(PG8_SA(1, 1), a1 + hstep, voffA);
            PG8_WAIT_V(8); PG8_WAIT_L(0); PG8_BAR; PG8_MMA(0, 0, At, B0); PG8_MMA(0, 1, At, B1); PG8_BAR; PG8_SCHED;
            PG8_LDA(At, 0, 1); PG8_STAGE(PG8_SB(0, 0), b2, voffB); PG8_STAGE(PG8_SB(0, 1), b2 + hstep, voffB); PG8_STAGE(PG8_SA(0, 0), a2, voffA);
            PG8_WAIT_V(8); PG8_WAIT_L(0); PG8_BAR; PG8_MMA(1, 0, At, B0); PG8_MMA(1, 1, At, B1); PG8_BAR; PG8_SCHED;
            PG8_LDB(B0, 1, 0); PG8_LDB(B1, 1, 1); PG8_SCHED; PG8_LDA(At, 1, 0); PG8_STAGE(PG8_SA(0, 1), a2 + hstep, voffA);
            PG8_WAIT_V(8); PG8_WAIT_L(0); PG8_BAR; PG8_MMA(0, 0, At, B0); PG8_MMA(0, 1, At, B1); PG8_BAR; PG8_SCHED;
            PG8_LDA(At, 1, 1); PG8_STAGE(PG8_SB(1, 0), b3, voffB); PG8_STAGE(PG8_SB(1, 1), b3 + hstep, voffB); PG8_STAGE(PG8_SA(1, 0), a3, voffA);
            PG8_WAIT_V(8); PG8_WAIT_L(0); PG8_BAR; PG8_MMA(1, 0, At, B0); PG8_MMA(1, 1, At, B1); PG8_BAR; PG8_SCHED;
            } else {
            PG8_LDB(B0, 0, 0); PG8_SCHED; PG8_LDA(At, 0, 0); PG8_STAGE(PG8_SA(1, 1), a1 + hstep, voffA);
            PG8_WAIT_L(8); PG8_BAR; PG8_WAIT_L(0); PG8_MMA(0, 0, At, B0); PG8_BAR; PG8_SCHED;
            PG8_LDB(B1, 0, 1); PG8_STAGE(PG8_SB(0, 0), b2, voffB);
            PG8_BAR; PG8_WAIT_L(0); PG8_MMA(0, 1, At, B1); PG8_BAR;
            PG8_LDA(At, 0, 1); PG8_STAGE(PG8_SA(0, 0), a2, voffA);
            PG8_BAR; PG8_WAIT_L(0); PG8_MMA(1, 0, At, B0); PG8_BAR; PG8_SCHED;
            PG8_STAGE(PG8_SB(0, 1), b2 + hstep, voffB);
            PG8_WAIT_V(6); PG8_BAR; PG8_MMA(1, 1, At, B1); PG8_BAR;
            PG8_LDB(B0, 1, 0); PG8_SCHED; PG8_LDA(At, 1, 0); PG8_STAGE(PG8_SA(0, 1), a2 + hstep, voffA);
            PG8_WAIT_L(8); PG8_BAR; PG8_WAIT_L(0); PG8_MMA(0, 0, At, B0); PG8_BAR; PG8_SCHED;
            PG8_LDB(B1, 1, 1); PG8_STAGE(PG8_SB(1, 0), b3, voffB);
            PG8_BAR; PG8_WAIT_L(0); PG8_MMA(0, 1, At, B1); PG8_BAR;
            PG8_LDA(At, 1, 1); PG8_STAGE(PG8_SA(1, 0), a3, voffA);
            PG8_BAR; PG8_WAIT_L(0); PG8_MMA(1, 0, At, B0); PG8_BAR; PG8_SCHED;
            PG8_STAGE(PG8_SB(1, 1), b3 + hstep, voffB);
            PG8_WAIT_V(6); PG8_BAR; PG8_MMA(1, 1, At, B1); PG8_BAR;
            }
        }
        if constexpr (ALIGN_EPI) { if (wr == 0) PG8_BAR; }
        if constexpr (!Epi::AFTER_DRAIN) { E(acc, cur, wr, wc, fr, fq); S.done(cur); }
        if (!has_next) break;
#pragma unroll
        for (int a = 0; a < 2; ++a)
#pragma unroll
            for (int b = 0; b < 2; ++b)
#pragma unroll
                for (int m = 0; m < 4; ++m)
#pragma unroll
                    for (int n = 0; n < 2; ++n) acc[a][b][m][n] = (f32x4){0.f, 0.f, 0.f, 0.f};
        cur = nxt; cA = nA; cB = nB; ++ui;
        if constexpr (ALIGN_EPI) { if (wr == 1) PG8_BAR; }
    }
    PG8_WAIT_V(0);
    if constexpr (!ALIGN_EPI) { if (wr == 0) PG8_BAR; }
    PG8_BAR;
    if constexpr (Epi::AFTER_DRAIN) { E.fused(acc, cur, wr, wc, fr, fq, lds, wid, lane); S.done(cur); }
#undef PG8_SA
#undef PG8_SB
#undef PG8_STAGE
#undef PG8_LDA
#undef PG8_LDB
#undef PG8_MMA
#undef PG8_WAIT_V
#undef PG8_WAIT_L
#undef PG8_BAR
#undef PG8_SCHED
}
}

constexpr int NWAVES = 8;
constexpr int N_LAUNCHES = MK_N_LAUNCHES;
constexpr int PER_PHASE = 9;
constexpr int NBATCH = 4, SEQ = 8192, D = 1024, T = NBATCH * SEQ, MEMLEN = 256, NMEMTOK = NBATCH * MEMLEN;
constexpr int IN_MAIN = 5120;
constexpr int NEXP = 16384;

constexpr size_t MiB = 1u << 20;
constexpr size_t WS_CTL = 0, CTL_ZERO_BYTES = 512 * 1024;
constexpr size_t WS_ROWSQ = 256 * 1024;
constexpr size_t WS_WIN = 1 * MiB, WS_WV = 11 * MiB, WS_WKV = 12 * MiB, WS_WBR = 14 * MiB, WS_WOUT = 17 * MiB, WS_WQ = 19 * MiB, WS_KEYS = 23 * MiB, WS_PWT = 23 * MiB + 512 * 1024;
constexpr size_t WS_MEMN = 24 * MiB, WS_KMEM = 26 * MiB, WS_VTMEM = 27 * MiB, WS_RSTDX = 28 * MiB, WS_SU = 28 * MiB + 256 * 1024  , WS_SV = 28 * MiB + 512 * 1024  ;
constexpr size_t WS_U8 = 32 * MiB, WS_V8 = 48 * MiB;
constexpr size_t WS_QN = 96 * MiB, WS_KN = 128 * MiB, WS_VT = 160 * MiB, WS_PP = 192 * MiB, WS_XQ = 224 * MiB, WS_GATE = 256 * MiB, WS_END = 448 * MiB;
constexpr size_t WS_MERGED = WS_QN;
constexpr size_t WS_HB = WS_VT;
constexpr size_t WS_QB = WS_GATE;
constexpr size_t WS_TE = WS_GATE + 128 * MiB, WS_TW = WS_TE + 16 * MiB;
constexpr size_t WS_HQ = WS_TW + 16 * MiB;
constexpr size_t WS_HS = 28 * MiB + 768 * 1024;
constexpr size_t WS_AW = WS_MERGED;
constexpr size_t OUT_XB = 0, OUT_YNA = 0, OUT_YPOOL = 32 * MiB, OUT_YXA = 64 * MiB;
constexpr int CW_TMO = 0, CW_BAR = 4096, CW_TICKET = 8192;

constexpr int RING_OFF = 0, RING_BYTES = 131072;
constexpr int LDSCTL_OFF = RING_BYTES, MISC_OFF = LDSCTL_OFF + 320;
constexpr int LDS_BYTES = 147456;

#define GAS __attribute__((address_space(1)))
#define LAS __attribute__((address_space(3)))
typedef unsigned short bf16;
typedef unsigned v4u __attribute__((ext_vector_type(4)));
typedef unsigned v2u __attribute__((ext_vector_type(2)));
typedef float f32x4 __attribute__((ext_vector_type(4)));
typedef short bf16x8 __attribute__((ext_vector_type(8)));
typedef __bf16 bf16x2_t __attribute__((ext_vector_type(2)));
typedef GAS unsigned gu32;
#define LDS_WAIT() asm volatile("s_waitcnt lgkmcnt(0)" ::: "memory")
#define VM_WAIT() asm volatile("s_waitcnt vmcnt(0)" ::: "memory")
__device__ __forceinline__ unsigned f2bf(float f) { unsigned u = __builtin_bit_cast(unsigned, f); return (u + 0x7fffu + ((u >> 16) & 1u)) >> 16; }
__device__ __forceinline__ unsigned pk2(float lo, float hi) { return f2bf(lo) | (f2bf(hi) << 16); }
__device__ __forceinline__ float bflo(unsigned u) { return __builtin_bit_cast(float, u << 16); }
__device__ __forceinline__ float bfhi(unsigned u) { return __builtin_bit_cast(float, u & 0xffff0000u); }
__device__ __forceinline__ float bf1(short s) { return __builtin_bit_cast(float, ((unsigned)(unsigned short)s) << 16); }
__device__ __forceinline__ f32x4 mfma16(bf16x8 a, bf16x8 b, f32x4 c) { return __builtin_amdgcn_mfma_f32_16x16x32_bf16(a, b, c, 0, 0, 0); }
__device__ __forceinline__ float wave_sum(float v) {
#pragma unroll
    for (int o = 1; o < 64; o <<= 1) v += __shfl_xor(v, o);
    return v;
}

#define XB_TMO      128
#define XB_XCNT(j)  (256  + 64 * (j))
#define XB_XSUB(j)  (1280 + 64 * (j))
#define XB_XGEN(j)  (2304 + 64 * (j))
#define XB_TOP      3328
#define XB_TOPGEN   3392
#define XCD_BAR_WORDS 3456
#define XB_SPIN_CAP (1u << 18)

__device__ __forceinline__ unsigned xb_ld(unsigned* p)              { return __hip_atomic_load(p, __ATOMIC_RELAXED, __HIP_MEMORY_SCOPE_AGENT); }
__device__ __forceinline__ unsigned xb_add(unsigned* p, unsigned v) { return __hip_atomic_fetch_add(p, v, __ATOMIC_RELAXED, __HIP_MEMORY_SCOPE_AGENT); }
__device__ __forceinline__ unsigned xb_xcc_id() { return (unsigned)__builtin_amdgcn_s_getreg((3 << 11) | 20) & 0xFu; }
#define XB_SPIN(cond, bar) do { unsigned _sp = 0; while (cond) { __builtin_amdgcn_s_sleep(1); \
    if ((++_sp & 255u) == 0u) { if (xb_ld(&(bar)[XB_TMO])) break; if (_sp > XB_SPIN_CAP) { atomicAdd(&(bar)[XB_TMO], 1u); break; } } } } while (0)

struct XcdBarrier {
    unsigned* bar; unsigned x;
    volatile LAS unsigned* st;
};

__device__ __forceinline__ XcdBarrier xcd_barrier_post(unsigned* bar, volatile LAS unsigned* st) {
    XcdBarrier b; b.bar = bar; b.x = xb_xcc_id(); b.st = st;
    if (threadIdx.x == 0) (void)xb_add(&bar[XB_XCNT(b.x)], 1u);
    return b;
}
__device__ __forceinline__ void xcd_barrier_complete(unsigned* bar, unsigned x, unsigned& nloc, unsigned& nx) {
    const unsigned G = gridDim.x * gridDim.y * gridDim.z;
    unsigned sum, cnt, mine, sp = 0u;
    for (;;) {
        sum = 0u; cnt = 0u; mine = 0u;
#pragma unroll
        for (unsigned j = 0; j < 16; ++j) { const unsigned c = xb_ld(&bar[XB_XCNT(j)]); sum += c; cnt += (c > 0u) ? 1u : 0u; mine = (j == x) ? c : mine; }
        if (sum == G) break;
        __builtin_amdgcn_s_sleep(1);
        if ((++sp & 255u) == 0u) { if (xb_ld(&bar[XB_TMO])) break; if (sp > XB_SPIN_CAP) { atomicAdd(&bar[XB_TMO], 1u); break; } }
    }
    nloc = mine > 0u ? mine : 1u; nx = cnt > 0u ? cnt : 1u;
}

__device__ __forceinline__ void xcd_barrier(const XcdBarrier& b) {
    asm volatile("s_waitcnt vmcnt(0)" ::: "memory");
    __syncthreads();
    if (threadIdx.x == 0) {
        unsigned* bar = b.bar;
        __builtin_amdgcn_s_waitcnt(0);
        unsigned nloc = b.st[0], nx = b.st[1];
        if (nloc == 0u) { xcd_barrier_complete(bar, b.x, nloc, nx); b.st[0] = nloc; b.st[1] = nx; }
        const unsigned old = xb_add(&bar[XB_XSUB(b.x)], 1u);
        const unsigned gen = old / nloc;
        if (old + 1u == (gen + 1u) * nloc) {
            __builtin_amdgcn_fence(__ATOMIC_RELEASE, "agent");
            asm volatile("s_waitcnt vmcnt(0)" ::: "memory");
            const unsigned og = xb_add(&bar[XB_TOP], 1u);
            const unsigned tg = og / nx;
            if (og + 1u == (tg + 1u) * nx) xb_add(&bar[XB_TOPGEN], 1u);
            else XB_SPIN(xb_ld(&bar[XB_TOPGEN]) == tg, bar);
            __builtin_amdgcn_fence(__ATOMIC_ACQUIRE, "agent");
            xb_add(&bar[XB_XGEN(b.x)], 1u);
            asm volatile("s_waitcnt vmcnt(0)" ::: "memory");
        } else {
            XB_SPIN(xb_ld(&bar[XB_XGEN(b.x)]) == gen, bar);
            __builtin_amdgcn_fence(__ATOMIC_ACQUIRE, "agent");
            asm volatile("s_waitcnt vmcnt(0)" ::: "memory");
        }
    }
    __syncthreads();
}

struct Frame {
    LAS unsigned char* lds;
    volatile LAS unsigned* MISC;
    gu32* ctl;
    int tid, lane, wave, vcu, G;
    float* out; unsigned char* ws;
};
struct Args { const float* in[23]; float* out; unsigned char* ws; int ph_lo, ph_hi, probe, pad; };
enum { I_X = 0, I_MEM, I_MIXG, I_MEMG, I_WIN, I_GATEB, I_WKV, I_NAQG, I_NAKG, I_RPB, I_POOLW, I_POOLSC, I_XAQG, I_XAKG, I_WB0, I_WB1, I_WB2, I_WOUT, I_FFNG, I_WQ, I_KEYS, I_PU, I_PV };

__device__ __forceinline__ void p0_transpose_item(const float* W, int K, int N, int k0, int n0, bf16* dst, const float* kscale, LAS float* scr, int lane) {
#pragma unroll 8
    for (int i = 0; i < 32; ++i) { const int kk = 2 * i + (lane >> 5); float v = W[(size_t)(k0 + kk) * N + n0 + (lane & 31)]; if (kscale) v *= kscale[k0 + kk]; scr[kk * 33 + (lane & 31)] = v; }
    LDS_WAIT(); asm volatile("" ::: "memory");
    const int c = lane & 7;
#pragma unroll
    for (int j = 0; j < 4; ++j) { const int n = (lane >> 3) + 8 * j; const LAS float* s = scr + (8 * c) * 33 + n;
        v4u o; o.x = pk2(s[0 * 33], s[1 * 33]); o.y = pk2(s[2 * 33], s[3 * 33]); o.z = pk2(s[4 * 33], s[5 * 33]); o.w = pk2(s[6 * 33], s[7 * 33]);
        *(GAS v4u*)(dst + (size_t)n * K + k0 + 8 * c) = o; }
    LDS_WAIT(); asm volatile("" ::: "memory");
}
__device__ __forceinline__ void cvt_row1024(const float* src, bf16* dst, const float* colscale, float rowscale, int lane) {
    const GAS f32x4* xr = (const GAS f32x4*)src + lane; GAS unsigned long long* o8 = (GAS unsigned long long*)dst + lane;
#pragma unroll
    for (int j = 0; j < 4; ++j) { f32x4 v = xr[64 * j] * rowscale; if (colscale) v = v * ((const GAS f32x4*)colscale)[lane + 64 * j];
        o8[64 * j] = (unsigned long long)pk2(v.x, v.y) | ((unsigned long long)pk2(v.z, v.w) << 32); }
}
__device__ __forceinline__ float row_rstd1024(const float* src, int lane) {
    const GAS f32x4* xr = (const GAS f32x4*)src + lane; float s = 0.f;
#pragma unroll
    for (int j = 0; j < 4; ++j) { const f32x4 v = xr[64 * j]; s += (v.x * v.x + v.y * v.y) + (v.z * v.z + v.w * v.w); }
    return rsqrtf(wave_sum(s) * (1.0f / 1024.0f) + 1e-6f);
}
__device__ __forceinline__ void p0_prologue(Frame& F, const Args& A) {
    LAS float* scr = (LAS float*)(F.lds + RING_OFF + F.wave * 16384);
    const int gw = F.vcu * NWAVES + F.wave, NGW = F.G * NWAVES, lane = F.lane;
    unsigned char* ws = F.ws;
    constexpr int I_IN = 16 * 176, I_KV = 16 * 32, I_BR = 8 * 32, I_OUT = 16 * 32, I_Q = 16 * 64;
    constexpr int NITEMS = I_IN + I_KV + 3 * I_BR + I_OUT + I_Q;
    for (int it = gw; it < NITEMS; it += NGW) {
        int r = it;
        if (r < I_IN) { const int kb = r / 176, nb = r % 176, n0 = 32 * nb; bf16* dst;
            if (n0 >= 1024 && n0 < 1536) dst = (bf16*)(ws + WS_WV) + (size_t)(n0 - 1024) * 1024;
            else { const int np = n0 < 1024 ? n0 : n0 - 512, t = np >> 8, w = np & 255, wc = w >> 6, bj = (w >> 5) & 1; dst = (bf16*)(ws + WS_WIN) + (size_t)(256 * t + 128 * bj + 32 * wc) * 1024; }
            p0_transpose_item(A.in[I_WIN], 1024, 5632, 64 * kb, n0, dst, A.in[I_MIXG], scr, lane); continue; }
        r -= I_IN;
        if (r < I_KV) { const int kb = r / 32, nb = r % 32; p0_transpose_item(A.in[I_WKV], 1024, 1024, 64 * kb, 32 * nb, (bf16*)(ws + WS_WKV) + (size_t)(32 * nb) * 1024, nullptr, scr, lane); continue; }
        r -= I_KV;
        if (r < 3 * I_BR) { const int br = r / I_BR, rr = r % I_BR, kb = rr / 32, nb = rr % 32; const float* W = br == 0 ? A.in[I_WB0] : (br == 1 ? A.in[I_WB1] : A.in[I_WB2]);
            p0_transpose_item(W, 512, 1024, 64 * kb, 32 * nb, (bf16*)(ws + WS_WBR) + (size_t)br * 1024 * 512 + (size_t)(32 * nb) * 512, nullptr, scr, lane); continue; }
        r -= 3 * I_BR;
        if (r < I_OUT) { const int kb = r / 32, nb = r % 32; p0_transpose_item(A.in[I_WOUT], 1024, 1024, 64 * kb, 32 * nb, (bf16*)(ws + WS_WOUT) + (size_t)(32 * nb) * 1024, nullptr, scr, lane); continue; }
        r -= I_OUT;
        { const int kb = r / 64, nb = r % 64; p0_transpose_item(A.in[I_WQ], 1024, 2048, 64 * kb, 32 * nb, (bf16*)(ws + WS_WQ) + (size_t)(32 * nb) * 1024, A.in[I_FFNG], scr, lane); }
    }
    { bf16* xb = (bf16*)((unsigned char*)F.out + OUT_XB); float* rstdx = (float*)(ws + WS_RSTDX);
      for (int m0 = 4 * gw; m0 < T; m0 += 4 * NGW) {
          f32x4 v[4][4];
#pragma unroll
          for (int r = 0; r < 4; ++r)
#pragma unroll
              for (int j = 0; j < 4; ++j) v[r][j] = ((const GAS f32x4*)(A.in[I_X] + (size_t)(m0 + r) * D))[lane + 64 * j];
#pragma unroll
          for (int r = 0; r < 4; ++r) { float s = 0.f;
#pragma unroll
              for (int j = 0; j < 4; ++j) s += (v[r][j].x * v[r][j].x + v[r][j].y * v[r][j].y) + (v[r][j].z * v[r][j].z + v[r][j].w * v[r][j].w);
              const float rs = rsqrtf(wave_sum(s) * (1.0f / 1024.0f) + 1e-6f);
              GAS unsigned long long* o8 = (GAS unsigned long long*)(xb + (size_t)(m0 + r) * D) + lane;
#pragma unroll
              for (int j = 0; j < 4; ++j) o8[64 * j] = (unsigned long long)pk2(v[r][j].x, v[r][j].y) | ((unsigned long long)pk2(v[r][j].z, v[r][j].w) << 32);
              if (lane == 0) rstdx[m0 + r] = rs; } } }
    for (int m = gw; m < NMEMTOK; m += NGW) { const float* xr = A.in[I_MEM] + (size_t)m * D; const float rs = row_rstd1024(xr, lane); cvt_row1024(xr, (bf16*)(ws + WS_MEMN) + (size_t)m * D, A.in[I_MEMG], rs, lane); }
    for (int mb = 4 * gw; mb < 2 * NEXP; mb += 4 * NGW) {
        const bool isu = mb < NEXP; const int e0 = isu ? mb : mb - NEXP;
        f32x4 v[4][4];
#pragma unroll
        for (int r = 0; r < 4; ++r) { const GAS f32x4* src = (const GAS f32x4*)((isu ? A.in[I_PU] : A.in[I_PV]) + (size_t)(e0 + r) * D) + 4 * lane;
#pragma unroll
            for (int d = 0; d < 4; ++d) v[r][d] = src[d]; }
        f32x4 gv[4];
#pragma unroll
        for (int d = 0; d < 4; ++d) gv[d] = isu ? ((const GAS f32x4*)A.in[I_FFNG])[4 * lane + d] : (f32x4){1.f, 1.f, 1.f, 1.f};
#pragma unroll
        for (int r = 0; r < 4; ++r) { const int e = e0 + r; float mx = 0.f;
#pragma unroll
            for (int d = 0; d < 4; ++d) { v[r][d] = v[r][d] * gv[d]; mx = fmaxf(mx, fmaxf(fmaxf(fabsf(v[r][d].x), fabsf(v[r][d].y)), fmaxf(fabsf(v[r][d].z), fabsf(v[r][d].w)))); }
#pragma unroll
            for (int o = 1; o < 64; o <<= 1) mx = fmaxf(mx, __shfl_xor(mx, o));
            const float inv = mx > 0.f ? 127.0f / mx : 0.f;
            v4u w;
#pragma unroll
            for (int d = 0; d < 4; ++d) { const unsigned b0 = (unsigned)(int)rintf(v[r][d].x * inv) & 0xffu, b1 = (unsigned)(int)rintf(v[r][d].y * inv) & 0xffu,
                                                         b2 = (unsigned)(int)rintf(v[r][d].z * inv) & 0xffu, b3 = (unsigned)(int)rintf(v[r][d].w * inv) & 0xffu;
                w[d] = b0 | (b1 << 8) | (b2 << 16) | (b3 << 24); }
            if (isu) ((GAS v4u*)(ws + WS_U8))[(size_t)e * 64 + lane] = w;
            else *(GAS v4u*)(ws + WS_V8 + (size_t)(lane >> 3) * (2 * MiB) + (size_t)e * 128 + (lane & 7) * 16) = w;
            if (lane == 0) ((float*)(ws + WS_SU))[2 * e + (isu ? 0 : 1)] = mx * (1.0f / 127.0f); }
    }
    for (int m = gw * 64 + lane; m < T; m += NGW * 64) ((float*)(ws + WS_ROWSQ))[m] = 0.f;
    for (int m = gw; m < 256; m += NGW) cvt_row1024(A.in[I_KEYS] + (size_t)m * 1024, (bf16*)(ws + WS_KEYS) + (size_t)m * 1024, nullptr, 1.0f, lane);
    for (int m = gw; m < 1024; m += NGW) { const int gd = m >> 1, c = (m & 1) * 64 + lane, g = gd >> 7, d = gd & 127;
        const float v = A.in[I_POOLW][(size_t)(g * 128 + c) * 128 + d] * A.in[I_POOLSC][gd];
        ((bf16*)(ws + WS_PWT))[(size_t)gd * 128 + c] = (bf16)f2bf(v); }
}

__device__ __forceinline__ void memkv_tile(const bf16* memn, const bf16* wkvT, const float* kg, const float* qg, bf16* kmem, bf16* vtmem, int tile, int lane) {
    const int q = lane & 15, hi = lane >> 4, rg = tile >> 3, cg = tile & 7, r0 = rg * 16, c0 = cg * 128;
    f32x4 acc[8];
#pragma unroll
    for (int i = 0; i < 8; ++i) acc[i] = (f32x4){0.f, 0.f, 0.f, 0.f};
    const bf16* ap = memn + (size_t)(r0 + q) * 1024 + 8 * hi; const bf16* bp = wkvT + (size_t)(c0 + q) * 1024 + 8 * hi;
#pragma unroll 1
    for (int kb = 0; kb < 8; ++kb) {
        bf16x8 a[4], b[4][8];
#pragma unroll
        for (int k4 = 0; k4 < 4; ++k4) { a[k4] = *(const bf16x8*)(ap + 32 * (4 * kb + k4));
#pragma unroll
            for (int nf = 0; nf < 8; ++nf) b[k4][nf] = *(const bf16x8*)(bp + (size_t)(16 * nf) * 1024 + 32 * (4 * kb + k4)); }
        __builtin_amdgcn_sched_barrier(0);
#pragma unroll
        for (int k4 = 0; k4 < 4; ++k4)
#pragma unroll
            for (int nf = 0; nf < 8; ++nf) acc[nf] = mfma16(a[k4], b[k4][nf], acc[nf]);
        __builtin_amdgcn_sched_barrier(0);
    }
    if (cg < 4) {
        float rr[4];
#pragma unroll
        for (int g = 0; g < 4; ++g) { float ss = 0.f;
#pragma unroll
            for (int nf = 0; nf < 8; ++nf) ss += acc[nf][g] * acc[nf][g];
            ss += __shfl_xor(ss, 1); ss += __shfl_xor(ss, 2); ss += __shfl_xor(ss, 4); ss += __shfl_xor(ss, 8);
            rr[g] = rsqrtf(ss * (1.0f / 128.0f) + 1e-6f); }
#pragma unroll
        for (int nf = 0; nf < 8; ++nf) { const int d = 16 * nf + q; const float gs = kg[d] * qg[d];
#pragma unroll
            for (int g = 0; g < 4; ++g) kmem[(size_t)(r0 + 4 * hi + g) * 512 + cg * 128 + d] = (bf16)f2bf(acc[nf][g] * rr[g] * gs); }
    } else {
        const int h = cg - 4, b = r0 >> 8, key0 = (r0 & 255) + 4 * hi;
#pragma unroll
        for (int nf = 0; nf < 8; ++nf) { const int d = 16 * nf + q; v2u w; w.x = pk2(acc[nf][0], acc[nf][1]); w.y = pk2(acc[nf][2], acc[nf][3]);
            *(v2u*)(vtmem + (size_t)(b * 512 + h * 128 + d) * 256 + key0) = w; }
    }
}

__device__ __forceinline__ void na_item(const bf16* __restrict__ qn, const bf16* __restrict__ kn, const bf16* __restrict__ vt, const LAS float* rpl, bf16* __restrict__ yna,
                                        int b, int r, int jb, int h, int lane) {
    const int q = lane & 15, hi = lane >> 4;
    int rs = r - 4; rs = rs < 0 ? 0 : (rs > 120 ? 120 : rs);
    int kb0 = jb * 16 - 8; kb0 = kb0 < 0 ? 0 : (kb0 > 32 ? 32 : kb0);
    const int qcol = jb * 16 + q; int cs = qcol - 8; cs = cs < 0 ? 0 : (cs > 48 ? 48 : cs);
    const size_t tokq = (size_t)b * SEQ + r * 64 + qcol;
    const bf16* qp = qn + tokq * 512 + h * 64 + 8 * hi;
    const bf16x8 qf0 = *(const bf16x8*)qp, qf1 = *(const bf16x8*)(qp + 32);
    const int kq = 8 * (q >> 2) + (q & 3);
    const bf16* kbase = kn + ((size_t)b * SEQ + rs * 64 + kb0 + kq) * 512 + h * 64 + 8 * hi;
    f32x4 s[16];
    {
        bf16x8 ka[16][2];
#pragma unroll
        for (int f = 0; f < 16; ++f) { const bf16* kp = kbase + (size_t)((f >> 1) * 64 + (f & 1) * 4) * 512; ka[f][0] = *(const bf16x8*)kp; ka[f][1] = *(const bf16x8*)(kp + 32); }
        __builtin_amdgcn_sched_barrier(0);
#pragma unroll
        for (int f = 0; f < 16; ++f) { f32x4 z = (f32x4){0.f, 0.f, 0.f, 0.f}; z = mfma16(ka[f][0], qf0, z); s[f] = mfma16(ka[f][1], qf1, z); }
    }
    const bf16* vbase = vt + ((size_t)(b * 512 + h * 64 + q) * SEQ + rs * 64 + kb0 + 8 * hi);
    bf16x8 va[8][4];
#pragma unroll
    for (int st = 0; st < 8; ++st)
#pragma unroll
        for (int mf = 0; mf < 4; ++mf) va[st][mf] = *(const bf16x8*)(vbase + (size_t)(16 * mf) * SEQ + st * 64);
    __builtin_amdgcn_sched_barrier(0);
    float mx = -3.0e38f;
#pragma unroll
    for (int f = 0; f < 16; ++f) {
        const int dr = rs + (f >> 1) - r + 7;
#pragma unroll
        for (int g = 0; g < 4; ++g) {
            const int kcol = kb0 + 8 * hi + 4 * (f & 1) + g;
            const bool ok = (kcol >= cs) && (kcol < cs + 16);
            int dc = kcol - qcol + 15; dc = dc < 0 ? 0 : (dc > 30 ? 30 : dc);
            const float v = ok ? s[f][g] + rpl[dr * 31 + dc] : -1.0e30f;
            s[f][g] = v; mx = fmaxf(mx, v);
        }
    }
    mx = fmaxf(mx, __shfl_xor(mx, 16)); mx = fmaxf(mx, __shfl_xor(mx, 32));
    float sum = 0.f;
#pragma unroll
    for (int f = 0; f < 16; ++f)
#pragma unroll
        for (int g = 0; g < 4; ++g) { const float p = __expf(s[f][g] - mx); s[f][g] = p; sum += p; }
    sum += __shfl_xor(sum, 16); sum += __shfl_xor(sum, 32);
    const float inv = 1.0f / sum;
    f32x4 o[4];
#pragma unroll
    for (int i = 0; i < 4; ++i) o[i] = (f32x4){0.f, 0.f, 0.f, 0.f};
#pragma unroll
    for (int st = 0; st < 8; ++st) {
        const bf16x8 pb = __builtin_bit_cast(bf16x8, pg8::pack8(s[2 * st], s[2 * st + 1]));
#pragma unroll
        for (int mf = 0; mf < 4; ++mf) o[mf] = mfma16(va[st][mf], pb, o[mf]);
    }
    bf16* yp = yna + tokq * 512 + h * 64 + 4 * hi;
#pragma unroll
    for (int mf = 0; mf < 4; ++mf) { v2u w; w.x = pk2(o[mf][0] * inv, o[mf][1] * inv); w.y = pk2(o[mf][2] * inv, o[mf][3] * inv); *(v2u*)(yp + 16 * mf) = w; }
}
__device__ __forceinline__ void xa_fill_lds(const bf16* __restrict__ kmem, const bf16* __restrict__ vtmem, LAS unsigned char* lds, int b, int h, int tid) {
#pragma unroll
    for (int ps = 0; ps < 8; ++ps) { const int id = tid + 512 * ps, key = id >> 4, c = id & 15;
        *(LAS v4u*)(lds + key * 256 + ((c ^ (key & 15)) << 4)) = *(const v4u*)(kmem + ((size_t)b * 256 + key) * 512 + h * 128 + 8 * c); }
#pragma unroll
    for (int ps = 0; ps < 8; ++ps) { const int id = tid + 512 * ps, dim = id >> 5, c = id & 31;
        *(LAS v4u*)(lds + 65536 + dim * 512 + ((c ^ (dim & 15)) << 4)) = *(const v4u*)(vtmem + (size_t)(b * 512 + h * 128 + dim) * 256 + 8 * c); }
}
__device__ __forceinline__ void xa_item(const bf16* __restrict__ xq, const LAS unsigned char* lds, bf16* __restrict__ yxa, int tok0, int h, int lane) {
    const int q = lane & 15, hi = lane >> 4; const size_t tok = (size_t)tok0 + q;
    const bf16* qp = xq + tok * 512 + h * 128 + 8 * hi;
    bf16x8 qf[4]; float ssq = 0.f;
#pragma unroll
    for (int ks = 0; ks < 4; ++ks) qf[ks] = *(const bf16x8*)(qp + 32 * ks);
    __builtin_amdgcn_sched_barrier(0);
#pragma unroll
    for (int ks = 0; ks < 4; ++ks)
#pragma unroll
        for (int j = 0; j < 8; ++j) { const float v = bf1(qf[ks][j]); ssq += v * v; }
    ssq += __shfl_xor(ssq, 16); ssq += __shfl_xor(ssq, 32);
    const float cexp = rsqrtf(ssq * (1.0f / 128.0f) + 1e-6f) * 0.08838834764831845f * 1.4426950408889634f;
    const int kq = 8 * (q >> 2) + (q & 3);
    f32x4 s[16];
#pragma unroll
    for (int f = 0; f < 16; ++f) { const int key = 32 * (f >> 1) + 4 * (f & 1) + kq; const LAS unsigned char* kr = lds + key * 256; f32x4 z = (f32x4){0.f, 0.f, 0.f, 0.f};
#pragma unroll
        for (int ks = 0; ks < 4; ++ks) z = mfma16(*(const LAS bf16x8*)(kr + (((4 * ks + hi) ^ (key & 15)) << 4)), qf[ks], z);
        s[f] = z; }
    float mx = -3.0e38f;
#pragma unroll
    for (int f = 0; f < 16; ++f)
#pragma unroll
        for (int g = 0; g < 4; ++g) mx = fmaxf(mx, s[f][g]);
    mx = fmaxf(mx, __shfl_xor(mx, 16)); mx = fmaxf(mx, __shfl_xor(mx, 32));
    float sum = 0.f;
#pragma unroll
    for (int f = 0; f < 16; ++f)
#pragma unroll
        for (int g = 0; g < 4; ++g) { const float p = __builtin_amdgcn_exp2f((s[f][g] - mx) * cexp); s[f][g] = p; sum += p; }
    sum += __shfl_xor(sum, 16); sum += __shfl_xor(sum, 32);
    const float inv = 1.0f / sum;
    f32x4 o[8];
#pragma unroll
    for (int i = 0; i < 8; ++i) o[i] = (f32x4){0.f, 0.f, 0.f, 0.f};
#pragma unroll
    for (int st = 0; st < 8; ++st) {
        const bf16x8 pb = __builtin_bit_cast(bf16x8, pg8::pack8(s[2 * st], s[2 * st + 1]));
#pragma unroll
        for (int mf = 0; mf < 8; ++mf) { const int dim = 16 * mf + q; o[mf] = mfma16(*(const LAS bf16x8*)(lds + 65536 + dim * 512 + (((4 * st + hi) ^ (dim & 15)) << 4)), pb, o[mf]); }
    }
    bf16* yp = yxa + tok * 512 + h * 128 + 4 * hi;
#pragma unroll
    for (int mf = 0; mf < 8; ++mf) { v2u w; w.x = pk2(o[mf][0] * inv, o[mf][1] * inv); w.y = pk2(o[mf][2] * inv, o[mf][3] * inv); *(v2u*)(yp + 16 * mf) = w; }
}
__device__ __forceinline__ void pool_wg(const bf16* __restrict__ pp, const bf16* __restrict__ pwT, bf16* __restrict__ ypool, LAS unsigned char* lds, int tokbase, int wave, int lane) {
    const int q = lane & 15, hi = lane >> 4;
    __syncthreads();
    {
        const int hw = 1 << hi, tw0 = tokbase + 16 * wave, b = tw0 >> 13, t0 = tw0 & 8191;
        const bf16* base = pp + (size_t)b * SEQ * 512 + 8 * lane;
        float s[8];
#pragma unroll
        for (int j = 0; j < 8; ++j) s[j] = 0.f;
#pragma unroll 4
        for (int d = -8; d < 8; ++d) { const int u = t0 + d; const bool ok = (d >= -hw) && (d < hw) && (u >= 0) && (u < SEQ);
            const bf16x8 v = *(const bf16x8*)(base + (size_t)(ok ? u : t0) * 512);
#pragma unroll
            for (int j = 0; j < 8; ++j) s[j] += ok ? bf1(v[j]) : 0.f; }
        LAS unsigned char* tile = lds + wave * 16384;
#pragma unroll 4
        for (int i = 0; i < 16; ++i) { const int t = t0 + i;
            int lo = t - hw; lo = lo < 0 ? 0 : lo; int ht = t + hw; ht = ht > SEQ ? SEQ : ht;
            const float inv = 1.0f / (float)(ht - lo);
            const bool oka = (t + hw) < SEQ, oks = (t - hw) >= 0;
            const bf16x8 sv = *(const bf16x8*)(base + (size_t)t * 512), av = *(const bf16x8*)(base + (size_t)(oka ? t + hw : t) * 512), bv = *(const bf16x8*)(base + (size_t)(oks ? t - hw : t) * 512);
            f32x4 p0, p1;
#pragma unroll
            for (int j = 0; j < 4; ++j) { p0[j] = s[j] * inv - bf1(sv[j]); p1[j] = s[j + 4] * inv - bf1(sv[j + 4]); }
            *(LAS v4u*)(tile + i * 1024 + ((lane ^ (i & 15)) << 4)) = pg8::pack8(p0, p1);
#pragma unroll
            for (int j = 0; j < 8; ++j) s[j] += (oka ? bf1(av[j]) : 0.f) - (oks ? bf1(bv[j]) : 0.f);
        }
    }
    __syncthreads();
#pragma unroll 1
    for (int k = 0; k < 4; ++k) {
        const int pair = wave * 4 + k, g = pair >> 3, mf = pair & 7;
        const bf16* wb = pwT + (size_t)(g * 128 + 16 * mf + q) * 128 + 8 * hi;
        bf16x8 a[4];
#pragma unroll
        for (int ks = 0; ks < 4; ++ks) a[ks] = *(const bf16x8*)(wb + 32 * ks);
#pragma unroll 2
        for (int tg = 0; tg < 8; ++tg) {
            const LAS unsigned char* trow = lds + tg * 16384 + q * 1024; f32x4 o = (f32x4){0.f, 0.f, 0.f, 0.f};
#pragma unroll
            for (int ks = 0; ks < 4; ++ks) { const int c = g * 16 + 4 * ks + hi; o = mfma16(a[ks], *(const LAS bf16x8*)(trow + ((c ^ q) << 4)), o); }
            v2u w; w.x = pk2(o[0], o[1]); w.y = pk2(o[2], o[3]);
            *(v2u*)(ypool + (size_t)(tokbase + 16 * tg + q) * 512 + g * 128 + 16 * mf + 4 * hi) = w;
        }
    }
    __syncthreads();
}

__device__ __forceinline__ int f2key(float s, int idx, int mask) { int b = __builtin_bit_cast(int, s); b = b >= 0 ? b : (b ^ 0x7fffffff); return (b & ~mask) | idx; }
__device__ __forceinline__ float key2f(int k) { k = k >= 0 ? k : (k ^ 0x7fffffff); return __builtin_bit_cast(float, k); }
#define CE_DESC(x, y) do { const int _h = (x) > (y) ? (x) : (y), _l = (x) > (y) ? (y) : (x); (x) = _h; (y) = _l; } while (0)
__device__ __forceinline__ void sort16(int (&a)[16]) {
#pragma unroll
    for (int ks = 1; ks <= 4; ++ks)
#pragma unroll
        for (int js = ks - 1; js >= 0; --js)
#pragma unroll
            for (int i = 0; i < 16; ++i) { const int k = 1 << ks, j = 1 << js, l = i ^ j;
                if (l > i) { if ((i & k) == 0) CE_DESC(a[i], a[l]); else CE_DESC(a[l], a[i]); } }
}
__device__ __forceinline__ void merge16(int (&a)[16], const int (&b)[16]) {
#pragma unroll
    for (int i = 0; i < 16; ++i) a[i] = a[i] > b[15 - i] ? a[i] : b[15 - i];
#pragma unroll
    for (int js = 3; js >= 0; --js)
#pragma unroll
        for (int i = 0; i < 16; ++i) { const int j = 1 << js, l = i ^ j; if (l > i) CE_DESC(a[i], a[l]); }
}
__device__ __forceinline__ void merge16_lanes(int (&a)[16], int step) { int o[16];
#pragma unroll
    for (int k = 0; k < 16; ++k) o[k] = __shfl_xor(a[k], step);
    merge16(a, o); }
__device__ constexpr int cand_i(int hi, int m) {
    return hi == 0 ? 0
         : hi == 1 ? (m < 8 ? 1 : (m < 13 ? 2 : -1))
         : hi == 2 ? (m < 4 ? 3 : (m < 7 ? 4 : (m < 9 ? 5 : (m < 11 ? 6 : -1))))
         :           (m < 2 ? 7 : (m < 10 ? 8 + (m - 2) : -1));
}
__device__ constexpr int cand_j(int hi, int m) {
    return hi == 0 ? m
         : hi == 1 ? (m < 8 ? m : (m < 13 ? m - 8 : -1))
         : hi == 2 ? (m < 4 ? m : (m < 7 ? m - 4 : (m < 9 ? m - 7 : (m < 11 ? m - 9 : -1))))
         :           (m < 2 ? m : (m < 10 ? 0 : -1));
}
__device__ __forceinline__ void topk_fill_lds(const bf16* __restrict__ keys, LAS unsigned char* lds, int h, int tid) {
#pragma unroll
    for (int ps = 0; ps < 8; ++ps) { const int id = tid + 512 * ps, row = id >> 4, c = id & 15;
        *(LAS v4u*)(lds + row * 256 + ((c ^ (row & 15)) << 4)) = *(const v4u*)(keys + ((size_t)h * 256 + row) * 128 + 8 * c); }
}
__device__ __forceinline__ void topk_item(const bf16* __restrict__ qb, const LAS unsigned char* klds, int* __restrict__ te, float* __restrict__ tw, LAS int* lscr, int tok0, int h, int lane) {
    const int q = lane & 15, hi = lane >> 4; const size_t tok = (size_t)tok0 + q;
    int L[2][16];
    bf16x8 qfa[2][4];
#pragma unroll
    for (int p = 0; p < 2; ++p)
#pragma unroll
        for (int ks = 0; ks < 4; ++ks) qfa[p][ks] = *(const bf16x8*)(qb + tok * 2048 + h * 256 + p * 128 + 32 * ks + 8 * hi);
    __builtin_amdgcn_sched_barrier(0);
#pragma unroll
    for (int p = 0; p < 2; ++p) {
        int B[16];
#pragma unroll
        for (int mf = 0; mf < 8; ++mf) { f32x4 s = (f32x4){0.f, 0.f, 0.f, 0.f}; const int row = p * 128 + 16 * mf + q;
#pragma unroll
            for (int ks = 0; ks < 4; ++ks) s = mfma16(*(const LAS bf16x8*)(klds + row * 256 + (((4 * ks + hi) ^ (row & 15)) << 4)), qfa[p][ks], s);
#pragma unroll
            for (int g = 0; g < 4; ++g) { const int key = f2key(s[g], 16 * mf + 4 * hi + g, 127); if (mf < 4) L[p][4 * mf + g] = key; else B[4 * (mf - 4) + g] = key; } }
        sort16(L[p]); sort16(B); merge16(L[p], B);
        merge16_lanes(L[p], 16); merge16_lanes(L[p], 32);
    }
    float v1[16], v2[16];
#pragma unroll
    for (int k = 0; k < 16; ++k) { v1[k] = key2f(L[0][k]); v2[k] = key2f(L[1][k]); }
    int Fk[16];
#pragma unroll
    for (int m = 0; m < 16; ++m) {
        float sm = v1[0] + v2[m]; int id = 255 - m;
        if (cand_i(1, m) >= 0) { if (hi == 1) { sm = v1[cand_i(1, m) < 0 ? 0 : cand_i(1, m)] + v2[cand_j(1, m) < 0 ? 0 : cand_j(1, m)]; id = 255 - ((cand_i(1, m) << 4) | cand_j(1, m)); } }
        if (cand_i(2, m) >= 0) { if (hi == 2) { sm = v1[cand_i(2, m) < 0 ? 0 : cand_i(2, m)] + v2[cand_j(2, m) < 0 ? 0 : cand_j(2, m)]; id = 255 - ((cand_i(2, m) << 4) | cand_j(2, m)); } }
        if (cand_i(3, m) >= 0) { if (hi == 3) { sm = v1[cand_i(3, m) < 0 ? 0 : cand_i(3, m)] + v2[cand_j(3, m) < 0 ? 0 : cand_j(3, m)]; id = 255 - ((cand_i(3, m) << 4) | cand_j(3, m)); } }
        int key = f2key(sm, id, 255);
        if ((hi == 1 && cand_i(1, m) < 0) || (hi == 2 && cand_i(2, m) < 0) || (hi == 3 && cand_i(3, m) < 0)) key = (int)0x80000000;
        Fk[m] = key;
    }
    sort16(Fk); merge16_lanes(Fk, 16); merge16_lanes(Fk, 32);
    LAS int* my = lscr + lane * 32;
#pragma unroll
    for (int k = 0; k < 16; ++k) { my[k] = L[0][k] & 127; my[16 + k] = L[1][k] & 127; }
    LDS_WAIT(); asm volatile("" ::: "memory");
    float e[16]; float sum = 0.f; const float mx = key2f(Fk[0]);
#pragma unroll
    for (int k = 0; k < 16; ++k) { e[k] = __expf(key2f(Fk[k]) - mx); sum += e[k]; }
    const float inv = 1.0f / sum;
    if (hi == 0) {
        int* tep = te + tok * 128; float* twp = tw + tok * 128;
#pragma unroll
        for (int kk = 0; kk < 16; ++kk) { const int ij = 255 - (Fk[kk] & 255), i = ij >> 4, j = ij & 15, slot = (kk & 7) * 16 + 2 * h + (kk >> 3);
            tep[slot] = my[i] * 128 + my[16 + j]; twp[slot] = e[kk] * inv; }
    }
    LDS_WAIT(); asm volatile("" ::: "memory");
}

__device__ __forceinline__ float ub2f(unsigned v, int b) { return (float)((v >> (8 * b)) & 0xffu); }
__device__ __forceinline__ void hq_token(const bf16* __restrict__ hb, const float* __restrict__ rowsq, unsigned char* __restrict__ hq, float* __restrict__ hs, int tok, int lane) {
    const bf16* hp = hb + (size_t)tok * 1024 + 16 * lane;
    const v4u hA = *(const v4u*)hp, hB = *(const v4u*)(hp + 8);
    float hf[16];
#pragma unroll
    for (int d = 0; d < 4; ++d) { hf[2 * d] = bflo(hA[d]); hf[2 * d + 1] = bfhi(hA[d]); hf[8 + 2 * d] = bflo(hB[d]); hf[8 + 2 * d + 1] = bfhi(hB[d]); }
    float amax = 0.f;
#pragma unroll
    for (int j = 0; j < 16; ++j) amax = fmaxf(amax, fabsf(hf[j]));
#pragma unroll
    for (int o = 1; o < 64; o <<= 1) amax = fmaxf(amax, __shfl_xor(amax, o));
    const float hinv = amax > 0.f ? 127.0f / amax : 0.f;
    v4u w;
#pragma unroll
    for (int d = 0; d < 4; ++d) { const unsigned b0 = (unsigned)(int)rintf(hf[4 * d] * hinv) & 0xffu, b1 = (unsigned)(int)rintf(hf[4 * d + 1] * hinv) & 0xffu,
                                                 b2 = (unsigned)(int)rintf(hf[4 * d + 2] * hinv) & 0xffu, b3 = (unsigned)(int)rintf(hf[4 * d + 3] * hinv) & 0xffu;
        w[d] = b0 | (b1 << 8) | (b2 << 16) | (b3 << 24); }
    *(v4u*)(hq + (size_t)tok * 1024 + 16 * lane) = w;
    if (lane == 0) hs[tok] = rsqrtf(rowsq[tok] * (1.0f / 1024.0f) + 1e-6f) * amax * (1.0f / 127.0f);
}
constexpr int PA_SLOTS = 12;
struct PeerA1 { int e; float g; };
struct PeerA2 { v4u ur[3][4]; v4u hv[4]; float hsc, su, sv; int cnt, rk; bool m; unsigned long long rem; };
__device__ __forceinline__ void pa_s1(PeerA1& a, const int* __restrict__ te, const float* __restrict__ tw, int tok, int half, int lane) {
    a.e = te[(size_t)tok * 128 + 64 * half + lane]; a.g = tw[(size_t)tok * 128 + 64 * half + lane]; }
__device__ __forceinline__ void pa_s2(PeerA2& b, const PeerA1& a, const unsigned char* __restrict__ hq, const float* __restrict__ hs, const unsigned char* __restrict__ u8,
                                      const float* __restrict__ su, const float* __restrict__ sv, LAS int* lst, int tok, int x, int lane, int hot) {
    b.m = (a.e >> 11) == x;
    const unsigned long long mask = __ballot(b.m), lt = (1ull << lane) - 1ull;
    b.cnt = __popcll(mask); b.rk = __popcll(mask & lt);
    if (b.m && b.rk < PA_SLOTS) lst[b.rk] = a.e;
    { unsigned long long r = mask; for (int k = 0; k < PA_SLOTS && r != 0ull; ++k) r &= r - 1ull; b.rem = b.cnt > PA_SLOTS ? r : 0ull; }
    { typedef float f32x2s __attribute__((ext_vector_type(2))); f32x2s s2 = (f32x2s){0.f, 0.f}; if (b.m) s2 = ((const f32x2s*)su)[a.e]; b.su = s2.x; b.sv = s2.y; }
    const int r = lane >> 4, t = lane & 15;
#pragma unroll
    for (int i = 0; i < 4; ++i) b.hv[i] = *(const v4u*)(hq + (size_t)tok * 1024 + 16 * t + 256 * i);
    b.hsc = hs[tok];
    LDS_WAIT(); asm volatile("" ::: "memory");
    const int lim = b.cnt < PA_SLOTS ? b.cnt : PA_SLOTS;
#pragma unroll
    for (int q = 0; q < 3; ++q) { const int slot = 4 * q + r;
#pragma unroll
        for (int i = 0; i < 4; ++i) b.ur[q][i] = (v4u){0u, 0u, 0u, 0u};
        if (slot < lim) { int e = lst[slot]; if (hot) e = (x << 11) | (e & 255); const unsigned char* rp = u8 + (size_t)e * 1024 + 16 * t;
#pragma unroll
            for (int i = 0; i < 4; ++i) b.ur[q][i] = *(const v4u*)(rp + 256 * i); } }
    (void)sv;
}
__device__ __forceinline__ int dot16(const v4u u, const v4u h) { int d = __builtin_amdgcn_sdot4((int)u.x, (int)h.x, 0, false); d = __builtin_amdgcn_sdot4((int)u.y, (int)h.y, d, false);
    d = __builtin_amdgcn_sdot4((int)u.z, (int)h.z, d, false); return __builtin_amdgcn_sdot4((int)u.w, (int)h.w, d, false); }
template <int CTRL, int RM> __device__ __forceinline__ int dpp_i(int x) { return __builtin_amdgcn_update_dpp(0, x, CTRL, RM, 0xf, false); }
__device__ __forceinline__ int wave_sum_to63(int x) { x += dpp_i<0xb1, 0xf>(x); x += dpp_i<0x4e, 0xf>(x); x += dpp_i<0x124, 0xf>(x); x += dpp_i<0x128, 0xf>(x); x += dpp_i<0x142, 0xa>(x); x += dpp_i<0x143, 0xc>(x); return x; }
__device__ __forceinline__ int row_sum16(int x) { x += dpp_i<0xb1, 0xf>(x); x += dpp_i<0x4e, 0xf>(x); x += dpp_i<0x124, 0xf>(x); x += dpp_i<0x128, 0xf>(x); return x; }
__device__ __forceinline__ float gelu_erf(float v) {
    const float av = fabsf(v), t = __builtin_amdgcn_rcpf(av * 0.2316418882f + 1.0f);
    float q = t * 0.5307027145f + (-0.7265760135f); q = q * t + 0.7107068705f; q = q * t + (-0.142248368f); q = q * t + 0.127414796f; q = q * t;
    const float e = __builtin_amdgcn_exp2f((v * v) * (-0.72134752044f)), m = v * (q * e);
    return v < 0.f ? m : v - m; }
__device__ __forceinline__ void pa_s3(const PeerA2& b, const PeerA1& a, const unsigned char* __restrict__ u8, const unsigned char* __restrict__ hq, float* __restrict__ aw, int tok, int half, int lane) {
    int mine = 0;
#pragma unroll
    for (int q = 0; q < 3; ++q) { int d = dot16(b.ur[q][0], b.hv[0]); d += dot16(b.ur[q][1], b.hv[1]); d += dot16(b.ur[q][2], b.hv[2]); d += dot16(b.ur[q][3], b.hv[3]);
        d = row_sum16(d);
#pragma unroll
        for (int r = 0; r < 4; ++r) { const int s = __builtin_amdgcn_readlane(d, 16 * r); mine = (b.rk == 4 * q + r) ? s : mine; } }
    float* awp = aw + (size_t)tok * 128 + 64 * half + lane;
    if (b.m && b.rk < PA_SLOTS) *awp = a.g * gelu_erf((float)mine * b.hsc * b.su) * b.sv;
    if (b.cnt > PA_SLOTS) {
        unsigned long long rem = b.rem; const v4u hw = *(const v4u*)(hq + (size_t)tok * 1024 + 16 * lane);
        while (rem != 0ull) { const int idx = __builtin_ctzll(rem); rem &= rem - 1ull; const int e = __builtin_amdgcn_readlane(a.e, idx);
            const int d = __builtin_amdgcn_readlane(wave_sum_to63(dot16(*(const v4u*)(u8 + (size_t)e * 1024 + 16 * lane), hw)), 63);
            if (lane == idx) *awp = a.g * gelu_erf((float)d * b.hsc * b.su) * b.sv; }
    }
}
__device__ __forceinline__ void peer_a_run(const unsigned char* __restrict__ hq, const float* __restrict__ hs, const unsigned char* __restrict__ u8, const float* __restrict__ su,
                                           const float* __restrict__ sv, const int* __restrict__ te, const float* __restrict__ tw, float* __restrict__ aw, LAS int* lst, int wrank, int wstep, int x, int lane, int hot = 0) {
    const int ntok = wrank < T ? (T - wrank + wstep - 1) / wstep : 0, N = 2 * ntok;
#define PA_TOK(n) (wrank + ((n) >> 1) * wstep)
    if (N == 0) return;
    PeerA1 a0, a1, a2; PeerA2 bA, bB;
    pa_s1(a0, te, tw, PA_TOK(0), 0, lane); pa_s1(a1, te, tw, PA_TOK(1), 1, lane);
    pa_s2(bA, a0, hq, hs, u8, su, sv, lst, PA_TOK(0), x, lane, hot);
#define PA_STEP(n, Bcur, Bnext, Acur, Anext, Anew) do { \
        if ((n) + 1 < N) pa_s2(Bnext, Anext, hq, hs, u8, su, sv, lst, PA_TOK((n) + 1), x, lane, hot); \
        if ((n) + 2 < N) pa_s1(Anew, te, tw, PA_TOK((n) + 2), ((n) + 2) & 1, lane); \
        pa_s3(Bcur, Acur, u8, hq, aw, PA_TOK(n), (n) & 1, lane); } while (0)
    for (int n = 0; n < N; n += 6) {
        PA_STEP(n, bA, bB, a0, a1, a2);
        if (n + 1 < N) PA_STEP(n + 1, bB, bA, a1, a2, a0);
        if (n + 2 < N) PA_STEP(n + 2, bA, bB, a2, a0, a1);
        if (n + 3 < N) PA_STEP(n + 3, bB, bA, a0, a1, a2);
        if (n + 4 < N) PA_STEP(n + 4, bA, bB, a1, a2, a0);
        if (n + 5 < N) PA_STEP(n + 5, bB, bA, a2, a0, a1);
    }
#undef PA_STEP
#undef PA_TOK
}
struct PeerB1 { v4u e[4]; f32x4 w[4]; };
struct PeerB2 { v4u vr[8]; };
struct PeerBAcc { int acc[16]; int wq[4]; float wsc, h0, h1; };
typedef float f32x2v __attribute__((ext_vector_type(2)));
__device__ __forceinline__ void pb_s1(PeerB1& a, const int* __restrict__ te, const float* __restrict__ aw, int tok, int lane) {
    const v4u* ep = (const v4u*)(te + (size_t)tok * 128 + 16 * (lane >> 3)); const f32x4* wp = (const f32x4*)(aw + (size_t)tok * 128 + 16 * (lane >> 3));
#pragma unroll
    for (int j = 0; j < 4; ++j) { a.e[j] = ep[j]; a.w[j] = wp[j]; } }
__device__ __forceinline__ int pb_col(int lane) { return 16 * (lane & 7) + 8 * ((lane >> 5) & 1) + 4 * ((lane >> 4) & 1) + 2 * ((lane >> 3) & 1); }
template <int CTRL, int RM> __device__ __forceinline__ float dpp_f(float x) { return __builtin_bit_cast(float, __builtin_amdgcn_update_dpp(0, __builtin_bit_cast(int, x), CTRL, RM, 0xf, false)); }
__device__ __forceinline__ void pb_quant(PeerBAcc& A, const PeerB1& a) {
    float mx = 0.f;
#pragma unroll
    for (int j = 0; j < 4; ++j) mx = fmaxf(mx, fmaxf(fmaxf(fabsf(a.w[j][0]), fabsf(a.w[j][1])), fmaxf(fabsf(a.w[j][2]), fabsf(a.w[j][3]))));
    mx = fmaxf(mx, dpp_f<0xb1, 0xf>(mx)); mx = fmaxf(mx, dpp_f<0x4e, 0xf>(mx)); mx = fmaxf(mx, dpp_f<0x124, 0xf>(mx)); mx = fmaxf(mx, dpp_f<0x128, 0xf>(mx));
    mx = fmaxf(mx, dpp_f<0x142, 0xa>(mx)); mx = fmaxf(mx, dpp_f<0x143, 0xc>(mx));
    mx = __builtin_bit_cast(float, __builtin_amdgcn_readlane(__builtin_bit_cast(int, mx), 63));
    const float inv = mx > 0.f ? 127.0f / mx : 0.f; A.wsc = mx * (1.0f / 127.0f);
#pragma unroll
    for (int j = 0; j < 4; ++j) A.wq[j] = (int)(((unsigned)(int)rintf(a.w[j][0] * inv) & 0xffu) | (((unsigned)(int)rintf(a.w[j][1] * inv) & 0xffu) << 8) |
                                               (((unsigned)(int)rintf(a.w[j][2] * inv) & 0xffu) << 16) | (((unsigned)(int)rintf(a.w[j][3] * inv) & 0xffu) << 24));
}
template <int HF> __device__ __forceinline__ void pb_s2(PeerB2& b, const PeerB1& a, const unsigned char* __restrict__ v8x, int lane, int hot = 0) {
    const int c = lane & 7;
#pragma unroll
    for (int m = 0; m < 8; ++m) { unsigned e = a.e[2 * HF + (m >> 2)][m & 3]; if (hot) e &= 255u; b.vr[m] = *(const v4u*)(v8x + (size_t)e * 128 + 16 * c); }
}
__device__ __forceinline__ float swap32_add(float lo, float hi) { const auto r = __builtin_amdgcn_permlane32_swap(__builtin_bit_cast(unsigned, lo), __builtin_bit_cast(unsigned, hi), false, false);
    return __builtin_bit_cast(float, r[0]) + __builtin_bit_cast(float, r[1]); }
__device__ __forceinline__ float swap16_add(float lo, float hi) { const auto r = __builtin_amdgcn_permlane16_swap(__builtin_bit_cast(unsigned, lo), __builtin_bit_cast(unsigned, hi), false, false);
    return __builtin_bit_cast(float, r[0]) + __builtin_bit_cast(float, r[1]); }
template <int HF> __device__ __forceinline__ void pb_s3(PeerBAcc& A, const PeerB2& b, const PeerB1& a, float* out, int tok, int x, int lane) {
    if (HF == 0) {
#pragma unroll
        for (int j = 0; j < 16; ++j) A.acc[j] = 0;
    }
#pragma unroll
    for (int gg = 0; gg < 2; ++gg)
#pragma unroll
        for (int d = 0; d < 4; ++d) { const unsigned ra = b.vr[4 * gg][d], rb = b.vr[4 * gg + 1][d], rc = b.vr[4 * gg + 2][d], rd = b.vr[4 * gg + 3][d];
            const unsigned t0 = __builtin_amdgcn_perm(rb, ra, 0x05010400u), t1 = __builtin_amdgcn_perm(rb, ra, 0x07030602u), t2 = __builtin_amdgcn_perm(rd, rc, 0x05010400u), t3 = __builtin_amdgcn_perm(rd, rc, 0x07030602u);
            const unsigned c0 = __builtin_amdgcn_perm(t2, t0, 0x05040100u), c1 = __builtin_amdgcn_perm(t2, t0, 0x07060302u), c2 = __builtin_amdgcn_perm(t3, t1, 0x05040100u), c3 = __builtin_amdgcn_perm(t3, t1, 0x07060302u);
            const int w4 = A.wq[2 * HF + gg];
            A.acc[4 * d] = __builtin_amdgcn_sdot4((int)c0, w4, A.acc[4 * d], false); A.acc[4 * d + 1] = __builtin_amdgcn_sdot4((int)c1, w4, A.acc[4 * d + 1], false);
            A.acc[4 * d + 2] = __builtin_amdgcn_sdot4((int)c2, w4, A.acc[4 * d + 2], false); A.acc[4 * d + 3] = __builtin_amdgcn_sdot4((int)c3, w4, A.acc[4 * d + 3], false); }
    if (HF == 1) {
        int r8[8], r4[4], r2[2];
#pragma unroll
        for (int j = 0; j < 8; ++j) { const bool up = (lane & 32) != 0; const int keep = up ? A.acc[j + 8] : A.acc[j], send = up ? A.acc[j] : A.acc[j + 8]; r8[j] = keep + __shfl_xor(send, 32); }
#pragma unroll
        for (int j = 0; j < 4; ++j) { const bool up = (lane & 16) != 0; const int keep = up ? r8[j + 4] : r8[j], send = up ? r8[j] : r8[j + 4]; r4[j] = keep + __shfl_xor(send, 16); }
#pragma unroll
        for (int j = 0; j < 2; ++j) { const bool up = (lane & 8) != 0; const int keep = up ? r4[j + 2] : r4[j], send = up ? r4[j] : r4[j + 2];
            r2[j] = keep + __builtin_amdgcn_update_dpp(0, send, 0x128, 0xf, 0xf, false); }
        f32x2v h2; h2.x = A.h0 + A.wsc * (float)r2[0]; h2.y = A.h1 + A.wsc * (float)r2[1];
        *(f32x2v*)(out + (size_t)tok * 1024 + 128 * x + pb_col(lane)) = h2;
    }
}
__device__ __forceinline__ void peer_b_run(const unsigned char* __restrict__ v8x, const int* __restrict__ te, const float* __restrict__ aw, const bf16* __restrict__ hb, float* out, int wrank, int wstep, int x, int lane, int hot = 0) {
    const int N = wrank < T ? (T - wrank + wstep - 1) / wstep : 0;
#define PB_TOK(n) (wrank + (n) * wstep)
#define PB_LOADH(n) do { const unsigned h2_ = *(const unsigned*)(hb + (size_t)PB_TOK(n) * 1024 + 128 * x + pb_col(lane)); A.h0 = bflo(h2_); A.h1 = bfhi(h2_); } while (0)
    if (N == 0) return;
    PeerB1 s0, s1; PeerB2 bA, bB; PeerBAcc A;
    pb_s1(s0, te, aw, PB_TOK(0), lane); if (N > 1) pb_s1(s1, te, aw, PB_TOK(1), lane);
    pb_s2<0>(bA, s0, v8x, lane, hot);
    for (int n = 0; n < N; n += 2) {
        pb_s2<1>(bB, s0, v8x, lane, hot); PB_LOADH(n); pb_quant(A, s0);
        pb_s3<0>(A, bA, s0, out, PB_TOK(n), x, lane);
        if (n + 1 < N) pb_s2<0>(bA, s1, v8x, lane, hot);
        pb_s3<1>(A, bB, s0, out, PB_TOK(n), x, lane);
        if (n + 2 < N) pb_s1(s0, te, aw, PB_TOK(n + 2), lane);
        if (n + 1 < N) {
            pb_s2<1>(bB, s1, v8x, lane, hot); PB_LOADH(n + 1); pb_quant(A, s1);
            pb_s3<0>(A, bA, s1, out, PB_TOK(n + 1), x, lane);
            if (n + 2 < N) pb_s2<0>(bA, s0, v8x, lane, hot);
            pb_s3<1>(A, bB, s1, out, PB_TOK(n + 1), x, lane);
            if (n + 3 < N) pb_s1(s1, te, aw, PB_TOK(n + 3), lane);
        }
    }
#undef PB_LOADH
#undef PB_TOK
}

__global__ void __launch_bounds__(NWAVES * 64, 2) mk_fwd(Args args) {
    extern __shared__ __attribute__((aligned(16))) unsigned char lds[];
    Frame F;
    F.lds = (LAS unsigned char*)lds;
    F.MISC = (volatile LAS unsigned*)(F.lds + MISC_OFF);
    F.tid = threadIdx.x; F.lane = F.tid & 63; F.wave = __builtin_amdgcn_readfirstlane(F.tid >> 6);
    F.G = gridDim.x; { const int bx = blockIdx.x; F.vcu = (F.G % 8 == 0) ? (bx % 8) * (F.G / 8) + bx / 8 : bx; }
    F.out = args.out; F.ws = args.ws;
    unsigned char* ws = args.ws;
    F.ctl = (gu32*)(ws + WS_CTL);
    for (int u = F.tid; u < (LDS_BYTES - LDSCTL_OFF) / 4; u += NWAVES * 64) ((LAS unsigned*)(F.lds + LDSCTL_OFF))[u] = 0u;
    __syncthreads();
    XcdBarrier bar; bar.bar = (unsigned*)(F.ctl + CW_BAR); bar.x = 0; bar.st = nullptr;
    if (N_LAUNCHES != PER_PHASE) bar = xcd_barrier_post((unsigned*)(F.ctl + CW_BAR), F.MISC + 8);
    if (N_LAUNCHES != PER_PHASE) { if (F.tid == 0) { const unsigned xid = xb_xcc_id(); F.MISC[12] = xid; F.MISC[13] = xb_add((unsigned*)(F.ctl + CW_TICKET) + 64 * xid, 1u); } __syncthreads(); }
#define GRID_BAR() do { if (N_LAUNCHES != PER_PHASE) xcd_barrier(bar); } while (0)
    const int lo = args.ph_lo, hi = args.ph_hi;
#define IN(k) (lo <= (k) && (k) < hi)
#define BOTH(k) (IN(k) && IN((k) + 1))
#ifndef DUP_PHASE
#define DUP_PHASE (-1)
#endif
#define NREP(k) ((DUP_PHASE == (k)) ? 2 : 1)
    const int gw = F.vcu * NWAVES + F.wave, NGW = F.G * NWAVES;
    bf16* const WinT = (bf16*)(ws + WS_WIN); bf16* const WvT = (bf16*)(ws + WS_WV); bf16* const WkvT = (bf16*)(ws + WS_WKV); bf16* const WbrT = (bf16*)(ws + WS_WBR);
    bf16* const WoutT = (bf16*)(ws + WS_WOUT); bf16* const WqT = (bf16*)(ws + WS_WQ); bf16* const KEYS = (bf16*)(ws + WS_KEYS); bf16* const PWT = (bf16*)(ws + WS_PWT);
    bf16* const MEMN = (bf16*)(ws + WS_MEMN); bf16* const KMEM = (bf16*)(ws + WS_KMEM); bf16* const VTMEM = (bf16*)(ws + WS_VTMEM); float* const RSTDX = (float*)(ws + WS_RSTDX);
    const unsigned char* const U8 = ws + WS_U8; const unsigned char* const V8 = ws + WS_V8; const float* const SU = (const float*)(ws + WS_SU); const float* const SV = (const float*)(ws + WS_SV);
    bf16* const QN = (bf16*)(ws + WS_QN); bf16* const KN = (bf16*)(ws + WS_KN); bf16* const VT = (bf16*)(ws + WS_VT); bf16* const PP = (bf16*)(ws + WS_PP); bf16* const XQ = (bf16*)(ws + WS_XQ);
    bf16* const GATE = (bf16*)(ws + WS_GATE); bf16* const MERGED = (bf16*)(ws + WS_MERGED); bf16* const HB = (bf16*)(ws + WS_HB); bf16* const QB = (bf16*)(ws + WS_QB);
    int* const TE = (int*)(ws + WS_TE); float* const TW = (float*)(ws + WS_TW); float* const AW = (float*)(ws + WS_AW); float* const ROWSQ = (float*)(ws + WS_ROWSQ);
    bf16* const XB = (bf16*)((unsigned char*)args.out + OUT_XB); bf16* const YNA = (bf16*)((unsigned char*)args.out + OUT_YNA);
    bf16* const YPOOL = (bf16*)((unsigned char*)args.out + OUT_YPOOL); bf16* const YXA = (bf16*)((unsigned char*)args.out + OUT_YXA);

    if (IN(0)) { for (int rep = 0; rep < NREP(0); ++rep) { p0_prologue(F, args); if (rep + 1 < NREP(0)) GRID_BAR(); } if (BOTH(0)) GRID_BAR(); }

    if (IN(1)) {
      for (int rep = 0; rep < NREP(1); ++rep) {
        { pg8::Sched1 S; S.so.init(T, IN_MAIN, F.G, (int)blockIdx.x); S.A = (const char*)XB; S.Bt = (const char*)WinT; S.tstep = (size_t)256 * 1024 * 2;
          pg8::EpiProj E{RSTDX, QN, KN, PP, XQ, GATE, args.in[I_NAQG], args.in[I_NAKG], args.in[I_GATEB]};
          pg8::gemm_phase<pg8::EpiProj, pg8::Sched1, true, true>(F.lds + RING_OFF, 1024, S, E); }
        { pg8::Sched1 S; S.so.init(512, T, F.G, (int)blockIdx.x); S.A = (const char*)WvT; S.Bt = (const char*)XB; S.tstep = (size_t)256 * 1024 * 2;
          pg8::EpiVt E{RSTDX, VT};
          pg8::gemm_phase<pg8::EpiVt, pg8::Sched1, false, true>(F.lds + RING_OFF, 1024, S, E); }
        for (int t = gw; t < 512; t += NGW) memkv_tile(MEMN, WkvT, args.in[I_XAKG], args.in[I_XAQG], KMEM, VTMEM, t, F.lane);
        if (rep + 1 < NREP(1)) GRID_BAR();
      }
        if (BOTH(1)) GRID_BAR();
    }

    if (IN(2)) {
      for (int rep = 0; rep < NREP(2); ++rep) {
        LAS float* rpl = (LAS float*)(F.lds + RING_OFF + F.wave * 16384);
        for (int i = F.lane; i < 15 * 31; i += 64) rpl[i] = args.in[I_RPB][F.wave * 15 * 31 + i];
        LDS_WAIT(); asm volatile("" ::: "memory");
        for (int i = F.vcu; i < 256; i += F.G)
            for (int k = 0; k < 8; ++k) { const int idx = i * 8 + k, b = idx >> 9, r = (idx >> 2) & 127, jb = idx & 3; na_item(QN, KN, VT, rpl, YNA, b, r, jb, F.wave, F.lane); }
        for (int i = F.vcu; i < 256; i += F.G) pool_wg(PP, PWT, YPOOL, F.lds + RING_OFF, i * 128, F.wave, F.lane);
        { const int pair = F.vcu & 15, xb = pair >> 2, xh = pair & 3, slot = F.vcu >> 4, nslot = F.G >> 4;
          __syncthreads(); xa_fill_lds(KMEM, VTMEM, F.lds + RING_OFF, xb, xh, F.tid); __syncthreads();
          if (slot < nslot) for (int n = slot * NWAVES + F.wave; n < 512; n += nslot * NWAVES) xa_item(XQ, F.lds + RING_OFF, YXA, (xb * 512 + n) * 16, xh, F.lane);
          __syncthreads(); }
        if (rep + 1 < NREP(2)) GRID_BAR();
      }
        if (BOTH(2)) GRID_BAR();
    }

    if (IN(3)) {
      for (int rep = 0; rep < NREP(3); ++rep) {
        pg8::Sched3 S; S.so.init(T, D, F.G, (int)blockIdx.x); S.A = (const char*)YNA; S.Bt = (const char*)WbrT; S.tstep = (size_t)256 * 512 * 2; S.strideA = 32 * MiB; S.strideB = (size_t)1024 * 512 * 2;
        pg8::EpiMerge E{GATE, (bf16*)(ws + WS_VT)  , MERGED};
        pg8::gemm_phase<pg8::EpiMerge, pg8::Sched3, true, true>(F.lds + RING_OFF, 512, S, E);
        if (rep + 1 < NREP(3)) GRID_BAR();
      }
        if (BOTH(3)) GRID_BAR();
    }

    if (IN(4)) {
      for (int rep = 0; rep < NREP(4); ++rep) {
        pg8::Sched1 S; S.so.init(T, D, F.G, (int)blockIdx.x); S.A = (const char*)MERGED; S.Bt = (const char*)WoutT; S.tstep = (size_t)256 * 1024 * 2;
        pg8::EpiH E{args.in[I_X], F.out, HB, ROWSQ, args.probe};
        pg8::gemm_phase<pg8::EpiH, pg8::Sched1, true, true>(F.lds + RING_OFF, 1024, S, E);
        if (rep + 1 < NREP(4)) { GRID_BAR(); for (int m = gw * 64 + F.lane; m < T; m += NGW * 64) ROWSQ[m] = 0.f; GRID_BAR(); }
      }
        if (BOTH(4)) GRID_BAR();
    }

    if (IN(5)) {
      for (int rep = 0; rep < NREP(5); ++rep) {
        pg8::Sched1 S; S.so.init(T, 2048, F.G, (int)blockIdx.x); S.A = (const char*)HB; S.Bt = (const char*)WqT; S.tstep = (size_t)256 * 1024 * 2;
        pg8::EpiQ E{ROWSQ, QB};
        pg8::gemm_phase<pg8::EpiQ, pg8::Sched1, true, true>(F.lds + RING_OFF, 1024, S, E);
        if (rep + 1 < NREP(5)) GRID_BAR();
      }
        if (BOTH(5)) GRID_BAR();
    }

    if (IN(6)) {
        LAS int* lscr = (LAS int*)(F.lds + RING_OFF + 65536 + F.wave * 8192);
        for (int tok = gw; tok < T; tok += NGW) hq_token(HB, ROWSQ, ws + WS_HQ, (float*)(ws + WS_HS), tok, F.lane);
        { const int th = F.vcu & 7, slot = F.vcu >> 3, nslot = F.G >> 3;
          __syncthreads(); topk_fill_lds(KEYS, F.lds + RING_OFF, th, F.tid); __syncthreads();
          for (int rep = 0; rep < NREP(6); ++rep) { for (int n = slot * NWAVES + F.wave; n < 2048; n += nslot * NWAVES) topk_item(QB, F.lds + RING_OFF, TE, TW, lscr, n * 16, th, F.lane); if (rep + 1 < NREP(6)) GRID_BAR(); }
          __syncthreads(); }
        if (BOTH(6)) GRID_BAR();
    }

    if (IN(7)) {
        int x0 = 0, nxs = 8, wrank = (int)blockIdx.x * NWAVES + F.wave, wstep = F.G * NWAVES;
        if (N_LAUNCHES != PER_PHASE) { const unsigned xid = F.MISC[12], rk = F.MISC[13]; unsigned nx = 0, below = 0, mine = 0;
            for (unsigned j = 0; j < 16; ++j) { const unsigned c = xb_ld((unsigned*)(F.ctl + CW_BAR) + XB_XCNT(j)); nx += c > 0u; below += (c > 0u && j < xid); mine = (j == xid) ? c : mine; }
            if (nx == 8 && mine > 0 && rk < mine) { x0 = (int)below; nxs = 1; wrank = (int)rk * NWAVES + F.wave; wstep = (int)mine * NWAVES; } }
        else if ((F.G & 7) == 0) { x0 = (int)blockIdx.x & 7; nxs = 1; wrank = ((int)blockIdx.x >> 3) * NWAVES + F.wave; wstep = (F.G >> 3) * NWAVES; }
        for (int xs = 0; xs < nxs; ++xs) peer_a_run(ws + WS_HQ, (const float*)(ws + WS_HS), U8, SU, SV, TE, TW, args.probe ? (float*)QB : AW, (LAS int*)(F.lds + RING_OFF + F.wave * 16384), wrank, wstep, x0 + xs, F.lane, args.probe == 2);
        if (N_LAUNCHES != PER_PHASE) xcd_barrier(bar);
    }
    if (IN(8)) {
        int x0 = 0, nxs = 8, wrank = (int)blockIdx.x * NWAVES + F.wave, wstep = F.G * NWAVES;
        if (N_LAUNCHES != PER_PHASE) { const unsigned xid = F.MISC[12], rk = F.MISC[13]; unsigned nx = 0, below = 0, mine = 0;
            for (unsigned j = 0; j < 16; ++j) { const unsigned c = xb_ld((unsigned*)(F.ctl + CW_BAR) + XB_XCNT(j)); nx += c > 0u; below += (c > 0u && j < xid); mine = (j == xid) ? c : mine; }
            if (nx == 8 && mine > 0 && rk < mine) { x0 = (int)below; nxs = 1; wrank = (int)rk * NWAVES + F.wave; wstep = (int)mine * NWAVES; } }
        else if ((F.G & 7) == 0) { x0 = (int)blockIdx.x & 7; nxs = 1; wrank = ((int)blockIdx.x >> 3) * NWAVES + F.wave; wstep = (F.G >> 3) * NWAVES; }
        for (int xs = 0; xs < nxs; ++xs) peer_b_run(V8 + (size_t)(x0 + xs) * (2 * MiB), TE, AW, HB, args.probe ? (float*)QB : F.out, wrank, wstep, x0 + xs, F.lane, args.probe == 2);
    }
#undef IN
#undef BOTH
#undef GRID_BAR
}

extern "C" void kernel_launch(void* const* d_in, const int* in_sizes, int n_in, void* d_out, int out_size, void* d_ws, size_t ws_size, hipStream_t stream) {
    static int grid = 0;
    if (grid == 0) {
        if (n_in != 23 || in_sizes[0] != T * D || out_size != T * D || ws_size < WS_END) { fprintf(stderr, "kernel_launch: unexpected shapes: n_in %d in0 %d out %d ws %zu\n", n_in, n_in > 0 ? in_sizes[0] : -1, out_size, ws_size); grid = -1; return; }
        int dev = 0, cus = 0, per_cu = 0;
        if (hipGetDevice(&dev) != hipSuccess || hipDeviceGetAttribute(&cus, hipDeviceAttributeMultiprocessorCount, dev) != hipSuccess) { fprintf(stderr, "kernel_launch: device query failed\n"); grid = -1; return; }
        if (hipFuncSetAttribute((const void*)mk_fwd, hipFuncAttributeMaxDynamicSharedMemorySize, LDS_BYTES) != hipSuccess) { fprintf(stderr, "kernel_launch: hipFuncSetAttribute failed\n"); grid = -1; return; }
        if (hipOccupancyMaxActiveBlocksPerMultiprocessor(&per_cu, (const void*)mk_fwd, NWAVES * 64, LDS_BYTES) != hipSuccess || per_cu < 1)
            fprintf(stderr, "kernel_launch: note: occupancy query reports %d workgroups per CU\n", per_cu);
        (void)hipGetLastError();
        grid = cus;
    }
    if (grid < 0) return;
    if (hipMemsetAsync((char*)d_ws + WS_CTL, 0, CTL_ZERO_BYTES, stream) != hipSuccess) { fprintf(stderr, "kernel_launch: memset failed\n"); return; }
    Args a{};
    for (int i = 0; i < 23; ++i) a.in[i] = (const float*)d_in[i];
    a.out = (float*)d_out; a.ws = (unsigned char*)d_ws;
    for (int li = 0; li < N_LAUNCHES; ++li) {
        a.ph_lo = (N_LAUNCHES == PER_PHASE) ? li : 0; a.ph_hi = (N_LAUNCHES == PER_PHASE) ? li + 1 : PER_PHASE;
        hipLaunchKernelGGL(mk_fwd, dim3(grid), dim3(NWAVES * 64), LDS_BYTES, stream, a);
#ifdef HOST_DUP_PHASE
        if (N_LAUNCHES == PER_PHASE && li == HOST_DUP_PHASE) {
#ifndef PROBE_MODE
            if (li == 4) (void)hipMemsetAsync((char*)d_ws + WS_ROWSQ, 0, (size_t)T * 4, stream);
#endif
#ifdef PROBE_MODE
            a.probe = PROBE_MODE;
#endif
            hipLaunchKernelGGL(mk_fwd, dim3(grid), dim3(NWAVES * 64), LDS_BYTES, stream, a); a.probe = 0; }
#endif
        const hipError_t le = hipPeekAtLastError();
        if (le != hipSuccess) { fprintf(stderr, "kernel_launch: launch %d failed: %s\n", li, hipGetErrorName(le)); break; }
    }
}
```

```cpp
#define MK_N_LAUNCHES 1
#include <hip/hip_runtime.h>
#include <cstdio>
#include <cstdint>

#ifndef MK_N_LAUNCHES
#define MK_N_LAUNCHES 1
#endif

namespace pg8 {
#define PG8_LAS __attribute__((address_space(3)))
typedef unsigned short bf16_t;
typedef short bf16x8 __attribute__((ext_vector_type(8)));
typedef float f32x4 __attribute__((ext_vector_type(4)));
typedef unsigned u32x4 __attribute__((ext_vector_type(4)));
typedef unsigned u32x2 __attribute__((ext_vector_type(2)));
constexpr int BM = 256, BK = 64, HALF = 128, HTB = HALF * BK * 2  , STAGE_BYTES = 8 * HTB, NXCD = 8, WGM = 8;

__host__ __device__ __forceinline__ int lds_byte(int r, int c) { const int st = (r >> 4) * 2 + (c >> 5), rr = r & 15, cc = c & 31, ob = rr * 64 + cc * 2; return st * 1024 + (ob ^ (((ob >> 9) & 1) << 5)); }
__host__ __device__ __forceinline__ void stage_rc(int b, int& R, int& C) { const int st = b / 1024, sb = b % 1024, swz = sb ^ (((sb >> 9) & 1) << 5); R = (st >> 1) * 16 + swz / 64; C = (st & 1) * 32 + (swz % 64) / 2; }
__host__ __device__ __forceinline__ int perm32(int rho) { const int n = rho >> 4, i = rho & 15; return 8 * (i >> 2) + 4 * n + (i & 3); }

struct Unit { int pm, pn, br; };

struct StaticOrder {
    int nM, nN, nwg, G, c;
    __host__ __device__ void init(int M, int N, int G_, int c_) { nM = M / BM; nN = N / BM; nwg = nM * nN; G = G_; c = c_; }
    __host__ __device__ bool next(int i, Unit& u) const {
        const long L = (long)i * G + c; if (L >= nwg) return false;
        int wgid = (int)L; { const int q = nwg / NXCD, r = nwg % NXCD, xcd = wgid % NXCD, off = wgid / NXCD; wgid = (xcd < r ? xcd * (q + 1) : r * (q + 1) + (xcd - r) * q) + off; }
        const int nig = WGM * nN, gid = wgid / nig, fm = gid * WGM, gsz = (nM - fm) < WGM ? (nM - fm) : WGM;
        u.pm = fm + ((wgid % nig) % gsz); u.pn = (wgid % nig) / gsz; return true;
    }
};
struct Sched1 {
    StaticOrder so; const char* A; const char* Bt; size_t tstep;
    __device__ __forceinline__ bool next(int i, Unit& u) const { u.br = 0; return so.next(i, u); }
    __device__ __forceinline__ const char* abase(const Unit& u) const { return A + (size_t)u.pm * tstep; }
    __device__ __forceinline__ const char* bbase(const Unit& u) const { return Bt + (size_t)u.pn * tstep; }
    __device__ __forceinline__ void a_ready(const Unit&) const {}
    __device__ __forceinline__ void done(const Unit&) const {}
};
struct Sched3 {
    StaticOrder so; const char* A; const char* Bt; size_t tstep, strideA, strideB;
    __device__ __forceinline__ bool next(int i, Unit& u) const { u.br = i % 3; return so.next(i / 3, u); }
    __device__ __forceinline__ const char* abase(const Unit& u) const { return A + (size_t)u.br * strideA + (size_t)u.pm * tstep; }
    __device__ __forceinline__ const char* bbase(const Unit& u) const { return Bt + (size_t)u.br * strideB + (size_t)u.pn * tstep; }
    __device__ __forceinline__ void a_ready(const Unit&) const {}
    __device__ __forceinline__ void done(const Unit&) const {}
};

typedef float f32x2_t __attribute__((ext_vector_type(2))); typedef __bf16 bf16x2v_t __attribute__((ext_vector_type(2)));
__device__ __forceinline__ unsigned cvt_pk_bf16(float lo, float hi) { const f32x2_t v = {lo, hi}; const bf16x2v_t b = __builtin_convertvector(v, bf16x2v_t); return __builtin_bit_cast(unsigned, b); }
__device__ __forceinline__ u32x4 pack8(const f32x4 a, const f32x4 b) { u32x4 w; w.x = cvt_pk_bf16(a[0], a[1]); w.y = cvt_pk_bf16(a[2], a[3]); w.z = cvt_pk_bf16(b[0], b[1]); w.w = cvt_pk_bf16(b[2], b[3]); return w; }
__device__ __forceinline__ float bflo(unsigned u) { return __builtin_bit_cast(float, u << 16); }
__device__ __forceinline__ float bfhi(unsigned u) { return __builtin_bit_cast(float, u & 0xffff0000u); }


constexpr float RMS_EPS = 1e-6f;

struct EpiProj {
    static constexpr bool PERM = true, AFTER_DRAIN = false, HAS_MID = false;
    const float* rstd; bf16_t *qn, *kn, *pp, *xq, *gates; const float *qg, *kg, *gate_b;
    __device__ __forceinline__ void operator()(const f32x4 (&acc)[2][2][4][2], const Unit& u, int wr, int wc, int fr, int fq) const {
        const int pn = u.pn, row0 = u.pm * BM + wr * 64 + fr, lc0 = 64 * wc + 8 * fq;
        float rsv[2][4];
#pragma unroll
        for (int ai = 0; ai < 2; ++ai)
#pragma unroll
            for (int m = 0; m < 4; ++m) rsv[ai][m] = rstd[row0 + ai * HALF + m * 16];
        if (pn < 4) {
            const bool isq = pn < 2; bf16_t* O = isq ? qn : kn; const float* g = isq ? qg : kg; const float post = isq ? 0.125f : 1.0f;
            f32x4 gv[2][2];
#pragma unroll
            for (int bj = 0; bj < 2; ++bj)
#pragma unroll
                for (int n = 0; n < 2; ++n) gv[bj][n] = *(const f32x4*)(g + 32 * bj + 8 * fq + 4 * n);
            const int colbase = (pn & 1) * 256 + lc0;
#pragma unroll
            for (int ai = 0; ai < 2; ++ai)
#pragma unroll
                for (int m = 0; m < 4; ++m) {
                    const int row = row0 + ai * HALF + m * 16; const float rs = rsv[ai][m];
                    f32x4 v[2][2]; float ss = 0.f;
#pragma unroll
                    for (int bj = 0; bj < 2; ++bj)
#pragma unroll
                        for (int n = 0; n < 2; ++n) { v[bj][n] = acc[ai][bj][m][n] * rs; ss += (v[bj][n][0] * v[bj][n][0] + v[bj][n][1] * v[bj][n][1]) + (v[bj][n][2] * v[bj][n][2] + v[bj][n][3] * v[bj][n][3]); }
                    ss += __shfl_xor(ss, 16); ss += __shfl_xor(ss, 32);
                    const float r = rsqrtf(ss * (1.0f / 64.0f) + RMS_EPS) * post;
#pragma unroll
                    for (int bj = 0; bj < 2; ++bj) *(u32x4*)(O + (size_t)row * 512 + colbase + 32 * bj) = pack8(v[bj][0] * r * gv[bj][0], v[bj][1] * r * gv[bj][1]);
                }
        } else if (pn < 8) {
            bf16_t* O = pn < 6 ? pp : xq; const int colbase = (pn & 1) * 256 + lc0;
#pragma unroll
            for (int ai = 0; ai < 2; ++ai)
#pragma unroll
                for (int m = 0; m < 4; ++m) {
                    const int row = row0 + ai * HALF + m * 16; const float rs = rsv[ai][m];
#pragma unroll
                    for (int bj = 0; bj < 2; ++bj) *(u32x4*)(O + (size_t)row * 512 + colbase + 32 * bj) = pack8(acc[ai][bj][m][0] * rs, acc[ai][bj][m][1] * rs);
                }
        } else {
            const int gcol0 = (pn - 8) * 256 + lc0;
            f32x4 bv[2][2];
#pragma unroll
            for (int bj = 0; bj < 2; ++bj)
#pragma unroll
                for (int n = 0; n < 2; ++n) bv[bj][n] = *(const f32x4*)(gate_b + gcol0 + 32 * bj + 4 * n);
#pragma unroll
            for (int ai = 0; ai < 2; ++ai)
#pragma unroll
                for (int m = 0; m < 4; ++m) {
                    const int row = row0 + ai * HALF + m * 16; const float rs = rsv[ai][m];
#pragma unroll
                    for (int bj = 0; bj < 2; ++bj) {
                        f32x4 o[2];
#pragma unroll
                        for (int n = 0; n < 2; ++n) { const f32x4 z = acc[ai][bj][m][n] * rs + bv[bj][n];
#pragma unroll
                            for (int i = 0; i < 4; ++i) o[n][i] = __builtin_amdgcn_rcpf(1.0f + __expf(-z[i])); }
                        *(u32x4*)(gates + (size_t)row * 3072 + gcol0 + 32 * bj) = pack8(o[0], o[1]);
                    }
                }
        }
    }
};
struct EpiVt {
    static constexpr bool PERM = true, AFTER_DRAIN = false, HAS_MID = false;
    const float* rstd; bf16_t* Vt;
    __device__ __forceinline__ void operator()(const f32x4 (&acc)[2][2][4][2], const Unit& u, int wr, int wc, int fr, int fq) const {
        const int ch0 = u.pm * BM + wr * 64 + fr, tok0 = u.pn * BM + wc * 32 + 8 * fq, b = tok0 >> 13, t0 = tok0 & 8191;
        f32x4 rv[2][2];
#pragma unroll
        for (int bj = 0; bj < 2; ++bj)
#pragma unroll
            for (int n = 0; n < 2; ++n) rv[bj][n] = *(const f32x4*)(rstd + tok0 + bj * HALF + 4 * n);
#pragma unroll
        for (int ai = 0; ai < 2; ++ai)
#pragma unroll
            for (int m = 0; m < 4; ++m) { const int ch = ch0 + ai * HALF + m * 16; bf16_t* rowp = Vt + ((size_t)(b * 512 + ch) * 8192 + t0);
#pragma unroll
                for (int bj = 0; bj < 2; ++bj) *(u32x4*)(rowp + bj * HALF) = pack8(acc[ai][bj][m][0] * rv[bj][0], acc[ai][bj][m][1] * rv[bj][1]); }
    }
};
struct EpiMergeCat {
    static constexpr bool PERM = true, AFTER_DRAIN = false, HAS_MID = true;
    const bf16_t* gates; bf16_t* merged;
    __device__ __forceinline__ void mid(f32x4 (&acc)[2][2][4][2], const Unit& u, int nb  , int wr, int wc, int fr, int fq) const {
        const int row0 = u.pm * BM + wr * 64 + fr, col0 = u.pn * BM + wc * 32 + 8 * fq;
#pragma unroll
        for (int ai = 0; ai < 2; ++ai) {
            u32x4 ga[4][2], gb[4][2];
#pragma unroll
            for (int m = 0; m < 4; ++m)
#pragma unroll
                for (int bj = 0; bj < 2; ++bj) { const bf16_t* gp = gates + (size_t)(row0 + ai * HALF + m * 16) * 3072 + (nb - 1) * 1024 + col0 + bj * HALF;
                    ga[m][bj] = *(const u32x4*)gp; gb[m][bj] = *(const u32x4*)(gp + 1024); }
            __builtin_amdgcn_sched_barrier(0);
#pragma unroll
            for (int m = 0; m < 4; ++m)
#pragma unroll
                for (int bj = 0; bj < 2; ++bj) { const u32x4 a = ga[m][bj], b = gb[m][bj]; f32x4& x0 = acc[ai][bj][m][0]; f32x4& x1 = acc[ai][bj][m][1];
                    x0[0] *= bflo(a.x) * __builtin_amdgcn_rcpf(bflo(b.x)); x0[1] *= bfhi(a.x) * __builtin_amdgcn_rcpf(bfhi(b.x)); x0[2] *= bflo(a.y) * __builtin_amdgcn_rcpf(bflo(b.y)); x0[3] *= bfhi(a.y) * __builtin_amdgcn_rcpf(bfhi(b.y));
                    x1[0] *= bflo(a.z) * __builtin_amdgcn_rcpf(bflo(b.z)); x1[1] *= bfhi(a.z) * __builtin_amdgcn_rcpf(bfhi(b.z)); x1[2] *= bflo(a.w) * __builtin_amdgcn_rcpf(bflo(b.w)); x1[3] *= bfhi(a.w) * __builtin_amdgcn_rcpf(bfhi(b.w)); }
            __builtin_amdgcn_sched_barrier(0);
        }
    }
    __device__ __forceinline__ void operator()(const f32x4 (&acc)[2][2][4][2], const Unit& u, int wr, int wc, int fr, int fq) const {
        const int row0 = u.pm * BM + wr * 64 + fr, col0 = u.pn * BM + wc * 32 + 8 * fq;
#pragma unroll
        for (int ai = 0; ai < 2; ++ai) {
            u32x4 g8[4][2];
#pragma unroll
            for (int m = 0; m < 4; ++m)
#pragma unroll
                for (int bj = 0; bj < 2; ++bj) g8[m][bj] = *(const u32x4*)(gates + (size_t)(row0 + ai * HALF + m * 16) * 3072 + 2048 + col0 + bj * HALF);
            __builtin_amdgcn_sched_barrier(0);
#pragma unroll
            for (int m = 0; m < 4; ++m)
#pragma unroll
                for (int bj = 0; bj < 2; ++bj) { const u32x4 g = g8[m][bj]; f32x4 a = acc[ai][bj][m][0], b = acc[ai][bj][m][1];
                    a[0] *= bflo(g.x); a[1] *= bfhi(g.x); a[2] *= bflo(g.y); a[3] *= bfhi(g.y); b[0] *= bflo(g.z); b[1] *= bfhi(g.z); b[2] *= bflo(g.w); b[3] *= bfhi(g.w);
                    *(u32x4*)(merged + (size_t)(row0 + ai * HALF + m * 16) * 1024 + col0 + bj * HALF) = pack8(a, b); }
            __builtin_amdgcn_sched_barrier(0);
        }
    }
};
struct EpiH {
    static constexpr bool PERM = true, AFTER_DRAIN = false, HAS_MID = false;
    const float* x; float* out; bf16_t* hb; float* rowsq; int noatomic;
    __device__ __forceinline__ void operator()(const f32x4 (&acc)[2][2][4][2], const Unit& u, int wr, int wc, int fr, int fq) const {
        const int row0 = u.pm * BM + wr * 64 + fr, col0 = u.pn * BM + wc * 32 + 8 * fq;
#pragma unroll
        for (int ai = 0; ai < 2; ++ai) {
            f32x4 xv[4][2][2];
#pragma unroll
            for (int m = 0; m < 4; ++m)
#pragma unroll
                for (int bj = 0; bj < 2; ++bj) { const size_t o = (size_t)(row0 + ai * HALF + m * 16) * 1024 + col0 + bj * HALF; xv[m][bj][0] = *(const f32x4*)(x + o); xv[m][bj][1] = *(const f32x4*)(x + o + 4); }
            __builtin_amdgcn_sched_barrier(0);
#pragma unroll
            for (int m = 0; m < 4; ++m) { const int row = row0 + ai * HALF + m * 16; float ss = 0.f;
#pragma unroll
                for (int bj = 0; bj < 2; ++bj) { const size_t o = (size_t)row * 1024 + col0 + bj * HALF;
                    const f32x4 h0 = xv[m][bj][0] + acc[ai][bj][m][0], h1 = xv[m][bj][1] + acc[ai][bj][m][1];
                    *(u32x4*)(hb + o) = pack8(h0, h1);
                    ss += (h0[0] * h0[0] + h0[1] * h0[1]) + (h0[2] * h0[2] + h0[3] * h0[3]) + (h1[0] * h1[0] + h1[1] * h1[1]) + (h1[2] * h1[2] + h1[3] * h1[3]); }
                ss += __shfl_xor(ss, 16); ss += __shfl_xor(ss, 32);
                if (fq == 0 && !noatomic) atomicAdd(rowsq + row, ss); }
            __builtin_amdgcn_sched_barrier(0);
        }
    }
};
struct EpiQ {
    static constexpr bool PERM = true, AFTER_DRAIN = false, HAS_MID = false;
    const float* rowsq; bf16_t* qb;
    __device__ __forceinline__ void operator()(const f32x4 (&acc)[2][2][4][2], const Unit& u, int wr, int wc, int fr, int fq) const {
        const int row0 = u.pm * BM + wr * 64 + fr, col0 = u.pn * BM + wc * 32 + 8 * fq;
        float rq[2][4];
#pragma unroll
        for (int ai = 0; ai < 2; ++ai)
#pragma unroll
            for (int m = 0; m < 4; ++m) rq[ai][m] = rowsq[row0 + ai * HALF + m * 16];
#pragma unroll
        for (int ai = 0; ai < 2; ++ai)
#pragma unroll
            for (int m = 0; m < 4; ++m) { const int row = row0 + ai * HALF + m * 16; const float r = rsqrtf(rq[ai][m] * (1.0f / 1024.0f) + RMS_EPS);
#pragma unroll
                for (int bj = 0; bj < 2; ++bj) *(u32x4*)(qb + (size_t)row * 2048 + col0 + bj * HALF) = pack8(acc[ai][bj][m][0] * r, acc[ai][bj][m][1] * r); }
    }
};

template <class Epi, class Sched, bool ALIGN_EPI = false, bool SP2 = false>
__device__ __forceinline__ void gemm_phase(PG8_LAS unsigned char* lds, const int K, const Sched& S, const Epi& E) {
    const int tid = threadIdx.x, wid = __builtin_amdgcn_readfirstlane(tid >> 6), lane = tid & 63, wr = wid >> 2, wc = wid & 3, fr = lane & 15, fq = lane >> 4;
    const int nt = K / BK;
    unsigned voffA[2], voffB[2];
#pragma unroll
    for (int i = 0; i < 2; ++i) { int R, C; stage_rc(tid * 16 + i * 8192, R, C); const int Rb = Epi::PERM ? ((R & ~31) + perm32(R & 31)) : R;
        voffA[i] = (unsigned)(R * K + C) * 2u; voffB[i] = (unsigned)(Rb * K + C) * 2u; }
    const size_t kstep = (size_t)(BK * 2);
    const size_t hstep = (size_t)HALF * K * 2;
    const size_t tstep = 2 * hstep;
    const unsigned ldsw = (unsigned)wid * 1024u;
    const int aoff = lds_byte(wr * 64 + fr, fq * 8), boff = lds_byte(wc * 32 + fr, fq * 8);
#define PG8_SA(b, h) (((b) * 2 + (h)) * HTB)
#define PG8_SB(b, h) ((4 + (b) * 2 + (h)) * HTB)
#define PG8_STAGE(bufoff, gbase, voff) do { _Pragma("unroll") for (int _i = 0; _i < 2; ++_i) \
        __builtin_amdgcn_global_load_lds((const unsigned*)((const char*)(gbase) + (voff)[_i]), (PG8_LAS unsigned*)(lds + (bufoff) + ldsw + _i * 8192), 16, 0, 0); } while (0)
#define PG8_LDA(dst, b, h) do { _Pragma("unroll") for (int m = 0; m < 4; ++m) _Pragma("unroll") for (int k = 0; k < 2; ++k) dst[m][k] = *(const PG8_LAS bf16x8*)(lds + PG8_SA(b, h) + aoff + m * 2048 + k * 1024); } while (0)
#define PG8_LDB(dst, b, h) do { _Pragma("unroll") for (int n = 0; n < 2; ++n) _Pragma("unroll") for (int k = 0; k < 2; ++k) dst[n][k] = *(const PG8_LAS bf16x8*)(lds + PG8_SB(b, h) + boff + n * 2048 + k * 1024); } while (0)
#define PG8_MMA(ai, bj, At, Bt) do { __builtin_amdgcn_s_setprio(1); _Pragma("unroll") for (int m = 0; m < 4; ++m) _Pragma("unroll") for (int n = 0; n < 2; ++n) _Pragma("unroll") for (int k = 0; k < 2; ++k) \
        acc[ai][bj][m][n] = __builtin_amdgcn_mfma_f32_16x16x32_bf16(Bt[n][k], At[m][k], acc[ai][bj][m][n], 0, 0, 0); __builtin_amdgcn_s_setprio(0); } while (0)
#define PG8_WAIT_V(n) asm volatile("s_waitcnt vmcnt(" #n ")" ::: "memory")
#define PG8_WAIT_L(n) asm volatile("s_waitcnt lgkmcnt(" #n ")" ::: "memory")
#define PG8_BAR __builtin_amdgcn_s_barrier()
#define PG8_SCHED __builtin_amdgcn_sched_barrier(0)
    Unit cur, nxt; int ui = 0;
    if (!S.next(0, cur)) return;
    f32x4 acc[2][2][4][2];
#pragma unroll
    for (int a = 0; a < 2; ++a)
#pragma unroll
        for (int b = 0; b < 2; ++b)
#pragma unroll
            for (int m = 0; m < 4; ++m)
#pragma unroll
                for (int n = 0; n < 2; ++n) acc[a][b][m][n] = (f32x4){0.f, 0.f, 0.f, 0.f};
    bf16x8 At[4][2], B0[2][2], B1[2][2];
    const char* cA = S.abase(cur); const char* cB = S.bbase(cur);
    S.a_ready(cur);
    if constexpr (SP2) {
        PG8_STAGE(PG8_SB(0, 0), cB, voffB); PG8_STAGE(PG8_SB(0, 1), cB + hstep, voffB); PG8_STAGE(PG8_SA(0, 0), cA, voffA); PG8_STAGE(PG8_SA(0, 1), cA + hstep, voffA);
        if (wr == 1) PG8_BAR;
        PG8_WAIT_V(2); PG8_BAR;
        PG8_STAGE(PG8_SB(1, 0), cB + kstep, voffB); PG8_STAGE(PG8_SA(1, 0), cA + kstep, voffA); PG8_STAGE(PG8_SB(1, 1), cB + hstep + kstep, voffB);
        PG8_WAIT_V(6); PG8_BAR;
    } else {
        PG8_STAGE(PG8_SB(0, 0), cB, voffB); PG8_STAGE(PG8_SA(0, 0), cA, voffA); PG8_STAGE(PG8_SB(0, 1), cB + hstep, voffB); PG8_STAGE(PG8_SA(0, 1), cA + hstep, voffA);
        if (wr == 1) PG8_BAR;
        PG8_WAIT_V(4); PG8_BAR;
        PG8_STAGE(PG8_SB(1, 0), cB + kstep, voffB); PG8_STAGE(PG8_SA(1, 0), cA + kstep, voffA); PG8_STAGE(PG8_SB(1, 1), cB + hstep + kstep, voffB);
        PG8_WAIT_V(6); PG8_BAR;
    }
    for (;;) {
        const bool has_next = S.next(ui + 1, nxt);
        const char* nA = has_next ? S.abase(nxt) : cA; const char* nB = has_next ? S.bbase(nxt) : cB;
        for (int t = 0; t < nt; t += 2) {
            if constexpr (Epi::HAS_MID) { if (t == 8 || t == 16) E.mid(acc, cur, t >> 3, wr, wc, fr, fq); }
            const bool last = (t == nt - 2);
            const char* a1 = cA + (size_t)(t + 1) * kstep;
            const char* a2 = last ? nA : cA + (size_t)(t + 2) * kstep; const char* b2 = last ? nB : cB + (size_t)(t + 2) * kstep;
            const char* a3 = a2 + kstep; const char* b3 = b2 + kstep;
            if (last && has_next) S.a_ready(nxt);
            if constexpr (SP2) {
            PG8_LDB(B0, 0, 0); PG8_LDB(B1, 0, 1); PG8_SCHED; PG8_LDA(At, 0, 0); PG8_STAGE(PG8_SA(1, 1), a1 + hstep, voffA);
            PG8_WAIT_V(8); PG8_WAIT_L(0); PG8_BAR; PG8_MMA(0, 0, At, B0); PG8_MMA(0, 1, At, B1); PG8_BAR; PG8_SCHED;
            PG8_LDA(At, 0, 1); PG8_STAGE(PG8_SB(0, 0), b2, voffB); PG8_STAGE(PG8_SB(0, 1), b2 + hstep, voffB); PG8_STAGE(PG8_SA(0, 0), a2, voffA);
            PG8_WAIT_V(8); PG8_WAIT_L(0); PG8_BAR; PG8_MMA(1, 0, At, B0); PG8_MMA(1, 1, At, B1); PG8_BAR; PG8_SCHED;
            PG8_LDB(B0, 1, 0); PG8_LDB(B1, 1, 1); PG8_SCHED; PG8_LDA(At, 1, 0); PG8_STAGE(PG8_SA(0, 1), a2 + hstep, voffA);
            PG8_WAIT_V(8); PG8_WAIT_L(0); PG8_BAR; PG8_MMA(0, 0, At, B0); PG8_MMA(0, 1, At, B1); PG8_BAR; PG8_SCHED;
            PG8_LDA(At, 1, 1); PG8_STAGE(PG8_SB(1, 0), b3, voffB); PG8_STAGE(PG8_SB(1, 1), b3 + hstep, voffB); PG8_STAGE(PG8_SA(1, 0), a3, voffA);
            PG8_WAIT_V(8); PG8_WAIT_L(0); PG8_BAR; PG8_MMA(1, 0, At, B0); PG8_MMA(1, 1, At, B1); PG8_BAR; PG8_SCHED;
            } else {
            PG8_LDB(B0, 0, 0); PG8_SCHED; PG8_LDA(At, 0, 0); PG8_STAGE(PG8_SA(1, 1), a1 + hstep, voffA);
            PG8_WAIT_L(8); PG8_BAR; PG8_WAIT_L(0); PG8_MMA(0, 0, At, B0); PG8_BAR; PG8_SCHED;
            PG8_LDB(B1, 0, 1); PG8_STAGE(PG8_SB(0, 0), b2, voffB);
            PG8_BAR; PG8_WAIT_L(0); PG8_MMA(0, 1, At, B1); PG8_BAR;
            PG8_LDA(At, 0, 1); PG8_STAGE(PG8_SA(0, 0), a2, voffA);
            PG8_BAR; PG8_WAIT_L(0); PG8_MMA(1, 0, At, B0); PG8_BAR; PG8_SCHED;
            PG8_STAGE(PG8_SB(0, 1), b2 + hstep, voffB);
            PG8_WAIT_V(6); PG8_BAR; PG8_MMA(1, 1, At, B1); PG8_BAR;
            PG8_LDB(B0, 1, 0); PG8_SCHED; PG8_LDA(At, 1, 0); PG8_STAGE(PG8_SA(0, 1), a2 + hstep, voffA);
            PG8_WAIT_L(8); PG8_BAR; PG8_WAIT_L(0); PG8_MMA(0, 0, At, B0); PG8_BAR; PG8_SCHED;
            PG8_LDB(B1, 1, 1); PG8_STAGE(PG8_SB(1, 0), b3, voffB);
            PG8_BAR; PG8_WAIT_L(0); PG8_MMA(0, 1, At, B1); PG8_BAR;
            PG8_LDA(At, 1, 1); PG8_STAGE(PG8_SA(1, 0), a3, voffA);
            PG8_BAR; PG8_WAIT_L(0); PG8_MMA(1, 0, At, B0); PG8_BAR; PG8_SCHED;
            PG8_STAGE(PG8_SB(1, 1), b3 + hstep, voffB);
            PG8_WAIT_V(6); PG8_BAR; PG8_MMA(1, 1, At, B1); PG8_BAR;
            }
        }
        if constexpr (ALIGN_EPI) { if (wr == 0) PG8_BAR; }
        if constexpr (!Epi::AFTER_DRAIN) { E(acc, cur, wr, wc, fr, fq); S.done(cur); }
        if (!has_next) break;
#pragma unroll
        for (int a = 0; a < 2; ++a)
#pragma unroll
            for (int b = 0; b < 2; ++b)
#pragma unroll
                for (int m = 0; m < 4; ++m)
#pragma unroll
                    for (int n = 0; n < 2; ++n) acc[a][b][m][n] = (f32x4){0.f, 0.f, 0.f, 0.f};
        cur = nxt; cA = nA; cB = nB; ++ui;
        if constexpr (ALIGN_EPI) { if (wr == 1) PG8_BAR; }
    }
    PG8_WAIT_V(0);
    if constexpr (!ALIGN_EPI) { if (wr == 0) PG8_BAR; }
    PG8_BAR;
    if constexpr (Epi::AFTER_DRAIN) { E.fused(acc, cur, wr, wc, fr, fq, lds, wid, lane); S.done(cur); }
#undef PG8_SA
#undef PG8_SB
#undef PG8_STAGE
#undef PG8_LDA
#undef PG8_LDB
#undef PG8_MMA
#undef PG8_WAIT_V
#undef PG8_WAIT_L
#undef PG8_BAR
#undef PG8_SCHED
}
}

constexpr int NWAVES = 8;
constexpr int N_LAUNCHES = MK_N_LAUNCHES;
constexpr int PER_PHASE = 9;
constexpr int NBATCH = 4, SEQ = 8192, D = 1024, T = NBATCH * SEQ, MEMLEN = 256, NMEMTOK = NBATCH * MEMLEN;
constexpr int IN_MAIN = 5120;
constexpr int NEXP = 16384;

constexpr size_t MiB = 1u << 20;
constexpr size_t WS_CTL = 0, CTL_ZERO_BYTES = 512 * 1024;
constexpr size_t WS_ROWSQ = 256 * 1024;
constexpr size_t WS_WIN = 1 * MiB, WS_WV = 11 * MiB, WS_WKV = 12 * MiB, WS_WBR = 14 * MiB, WS_WOUT = 17 * MiB, WS_WQ = 19 * MiB, WS_KEYS = 23 * MiB, WS_PWT = 23 * MiB + 512 * 1024;
constexpr size_t WS_MEMN = 24 * MiB, WS_KMEM = 26 * MiB, WS_VTMEM = 27 * MiB, WS_RSTDX = 28 * MiB, WS_SU = 28 * MiB + 256 * 1024  , WS_SV = 28 * MiB + 512 * 1024  ;
constexpr size_t WS_U8 = 32 * MiB, WS_V8 = 48 * MiB;
constexpr size_t WS_QN = 96 * MiB, WS_KN = 128 * MiB, WS_VT = 160 * MiB, WS_PP = 192 * MiB, WS_XQ = 224 * MiB, WS_GATE = 256 * MiB, WS_END = 448 * MiB;
constexpr size_t WS_MERGED = WS_QN;
constexpr size_t WS_HB = WS_VT;
constexpr size_t WS_QB = WS_GATE;
constexpr size_t WS_TE = WS_GATE + 128 * MiB, WS_TW = WS_TE + 16 * MiB;
constexpr size_t WS_HQ = WS_TW + 16 * MiB;
constexpr size_t WS_HS = 28 * MiB + 768 * 1024;
constexpr size_t WS_AW = WS_MERGED;
constexpr size_t OUT_XB = 0, OUT_YNA = 0, OUT_YPOOL = 512 * 2, OUT_YXA = 1024 * 2;
constexpr int CW_TMO = 0, CW_BAR = 4096, CW_TICKET = 8192;

constexpr int RING_OFF = 0, RING_BYTES = 131072;
constexpr int LDSCTL_OFF = RING_BYTES, MISC_OFF = LDSCTL_OFF + 320;
constexpr int LDS_BYTES = 147456;

#define GAS __attribute__((address_space(1)))
#define LAS __attribute__((address_space(3)))
typedef unsigned short bf16;
typedef unsigned v4u __attribute__((ext_vector_type(4)));
typedef unsigned v2u __attribute__((ext_vector_type(2)));
typedef float f32x4 __attribute__((ext_vector_type(4)));
typedef short bf16x8 __attribute__((ext_vector_type(8)));
typedef __bf16 bf16x2_t __attribute__((ext_vector_type(2)));
typedef GAS unsigned gu32;
#define LDS_WAIT() asm volatile("s_waitcnt lgkmcnt(0)" ::: "memory")
#define VM_WAIT() asm volatile("s_waitcnt vmcnt(0)" ::: "memory")
__device__ __forceinline__ unsigned f2bf(float f) { unsigned u = __builtin_bit_cast(unsigned, f); return (u + 0x7fffu + ((u >> 16) & 1u)) >> 16; }
__device__ __forceinline__ unsigned pk2(float lo, float hi) { return f2bf(lo) | (f2bf(hi) << 16); }
__device__ __forceinline__ float bflo(unsigned u) { return __builtin_bit_cast(float, u << 16); }
__device__ __forceinline__ float bfhi(unsigned u) { return __builtin_bit_cast(float, u & 0xffff0000u); }
__device__ __forceinline__ float bf1(short s) { return __builtin_bit_cast(float, ((unsigned)(unsigned short)s) << 16); }
__device__ __forceinline__ f32x4 mfma16(bf16x8 a, bf16x8 b, f32x4 c) { return __builtin_amdgcn_mfma_f32_16x16x32_bf16(a, b, c, 0, 0, 0); }
__device__ __forceinline__ float wave_sum(float v) {
#pragma unroll
    for (int o = 1; o < 64; o <<= 1) v += __shfl_xor(v, o);
    return v;
}

#define XB_TMO      128
#define XB_XCNT(j)  (256  + 64 * (j))
#define XB_XSUB(j)  (1280 + 64 * (j))
#define XB_XGEN(j)  (2304 + 64 * (j))
#define XB_TOP      3328
#define XB_TOPGEN   3392
#define XCD_BAR_WORDS 3456
#define XB_SPIN_CAP (1u << 18)

__device__ __forceinline__ unsigned xb_ld(unsigned* p)              { return __hip_atomic_load(p, __ATOMIC_RELAXED, __HIP_MEMORY_SCOPE_AGENT); }
__device__ __forceinline__ unsigned xb_add(unsigned* p, unsigned v) { return __hip_atomic_fetch_add(p, v, __ATOMIC_RELAXED, __HIP_MEMORY_SCOPE_AGENT); }
__device__ __forceinline__ unsigned xb_xcc_id() { return (unsigned)__builtin_amdgcn_s_getreg((3 << 11) | 20) & 0xFu; }
#define XB_SPIN(cond, bar) do { unsigned _sp = 0; while (cond) { __builtin_amdgcn_s_sleep(1); \
    if ((++_sp & 255u) == 0u) { if (xb_ld(&(bar)[XB_TMO])) break; if (_sp > XB_SPIN_CAP) { atomicAdd(&(bar)[XB_TMO], 1u); break; } } } } while (0)

struct XcdBarrier {
    unsigned* bar; unsigned x;
    volatile LAS unsigned* st;
};

__device__ __forceinline__ XcdBarrier xcd_barrier_post(unsigned* bar, volatile LAS unsigned* st) {
    XcdBarrier b; b.bar = bar; b.x = xb_xcc_id(); b.st = st;
    if (threadIdx.x == 0) (void)xb_add(&bar[XB_XCNT(b.x)], 1u);
    return b;
}
__device__ __forceinline__ void xcd_barrier_complete(unsigned* bar, unsigned x, unsigned& nloc, unsigned& nx) {
    const unsigned G = gridDim.x * gridDim.y * gridDim.z;
    unsigned sum, cnt, mine, sp = 0u;
    for (;;) {
        sum = 0u; cnt = 0u; mine = 0u;
#pragma unroll
        for (unsigned j = 0; j < 16; ++j) { const unsigned c = xb_ld(&bar[XB_XCNT(j)]); sum += c; cnt += (c > 0u) ? 1u : 0u; mine = (j == x) ? c : mine; }
        if (sum == G) break;
        __builtin_amdgcn_s_sleep(1);
        if ((++sp & 255u) == 0u) { if (xb_ld(&bar[XB_TMO])) break; if (sp > XB_SPIN_CAP) { atomicAdd(&bar[XB_TMO], 1u); break; } }
    }
    nloc = mine > 0u ? mine : 1u; nx = cnt > 0u ? cnt : 1u;
}

__device__ __forceinline__ void xcd_barrier(const XcdBarrier& b) {
    asm volatile("s_waitcnt vmcnt(0)" ::: "memory");
    __syncthreads();
    if (threadIdx.x == 0) {
        unsigned* bar = b.bar;
        __builtin_amdgcn_s_waitcnt(0);
        unsigned nloc = b.st[0], nx = b.st[1];
        if (nloc == 0u) { xcd_barrier_complete(bar, b.x, nloc, nx); b.st[0] = nloc; b.st[1] = nx; }
        const unsigned old = xb_add(&bar[XB_XSUB(b.x)], 1u);
        const unsigned gen = old / nloc;
        if (old + 1u == (gen + 1u) * nloc) {
            __builtin_amdgcn_fence(__ATOMIC_RELEASE, "agent");
            asm volatile("s_waitcnt vmcnt(0)" ::: "memory");
            const unsigned og = xb_add(&bar[XB_TOP], 1u);
            const unsigned tg = og / nx;
            if (og + 1u == (tg + 1u) * nx) xb_add(&bar[XB_TOPGEN], 1u);
            else XB_SPIN(xb_ld(&bar[XB_TOPGEN]) == tg, bar);
            __builtin_amdgcn_fence(__ATOMIC_ACQUIRE, "agent");
            xb_add(&bar[XB_XGEN(b.x)], 1u);
            asm volatile("s_waitcnt vmcnt(0)" ::: "memory");
        } else {
            XB_SPIN(xb_ld(&bar[XB_XGEN(b.x)]) == gen, bar);
            __builtin_amdgcn_fence(__ATOMIC_ACQUIRE, "agent");
            asm volatile("s_waitcnt vmcnt(0)" ::: "memory");
        }
    }
    __syncthreads();
}

struct Frame {
    LAS unsigned char* lds;
    volatile LAS unsigned* MISC;
    gu32* ctl;
    int tid, lane, wave, vcu, G;
    float* out; unsigned char* ws;
};
struct Args { const float* in[23]; float* out; unsigned char* ws; int ph_lo, ph_hi, probe, pad; };
enum { I_X = 0, I_MEM, I_MIXG, I_MEMG, I_WIN, I_GATEB, I_WKV, I_NAQG, I_NAKG, I_RPB, I_POOLW, I_POOLSC, I_XAQG, I_XAKG, I_WB0, I_WB1, I_WB2, I_WOUT, I_FFNG, I_WQ, I_KEYS, I_PU, I_PV };

__device__ __forceinline__ void p0_transpose_item(const float* W, int K, int N, int k0, int n0, bf16* dst, const float* kscale, LAS float* scr, int lane, int dpitch = 0) {
    if (dpitch == 0) dpitch = K;
#pragma unroll 8
    for (int i = 0; i < 32; ++i) { const int kk = 2 * i + (lane >> 5); float v = W[(size_t)(k0 + kk) * N + n0 + (lane & 31)]; if (kscale) v *= kscale[k0 + kk]; scr[kk * 33 + (lane & 31)] = v; }
    LDS_WAIT(); asm volatile("" ::: "memory");
    const int c = lane & 7;
#pragma unroll
    for (int j = 0; j < 4; ++j) { const int n = (lane >> 3) + 8 * j; const LAS float* s = scr + (8 * c) * 33 + n;
        v4u o; o.x = pk2(s[0 * 33], s[1 * 33]); o.y = pk2(s[2 * 33], s[3 * 33]); o.z = pk2(s[4 * 33], s[5 * 33]); o.w = pk2(s[6 * 33], s[7 * 33]);
        *(GAS v4u*)(dst + (size_t)n * dpitch + k0 + 8 * c) = o; }
    LDS_WAIT(); asm volatile("" ::: "memory");
}
__device__ __forceinline__ void cvt_row1024(const float* src, bf16* dst, const float* colscale, float rowscale, int lane) {
    const GAS f32x4* xr = (const GAS f32x4*)src + lane; GAS unsigned long long* o8 = (GAS unsigned long long*)dst + lane;
#pragma unroll
    for (int j = 0; j < 4; ++j) { f32x4 v = xr[64 * j] * rowscale; if (colscale) v = v * ((const GAS f32x4*)colscale)[lane + 64 * j];
        o8[64 * j] = (unsigned long long)pk2(v.x, v.y) | ((unsigned long long)pk2(v.z, v.w) << 32); }
}
__device__ __forceinline__ float row_rstd1024(const float* src, int lane) {
    const GAS f32x4* xr = (const GAS f32x4*)src + lane; float s = 0.f;
#pragma unroll
    for (int j = 0; j < 4; ++j) { const f32x4 v = xr[64 * j]; s += (v.x * v.x + v.y * v.y) + (v.z * v.z + v.w * v.w); }
    return rsqrtf(wave_sum(s) * (1.0f / 1024.0f) + 1e-6f);
}
__device__ __forceinline__ void p0_prologue(Frame& F, const Args& A) {
    LAS float* scr = (LAS float*)(F.lds + RING_OFF + F.wave * 16384);
    const int gw = F.vcu * NWAVES + F.wave, NGW = F.G * NWAVES, lane = F.lane;
    unsigned char* ws = F.ws;
    constexpr int I_IN = 16 * 176, I_KV = 16 * 32, I_BR = 8 * 32, I_OUT = 16 * 32, I_Q = 16 * 64;
    constexpr int NITEMS = I_IN + I_KV + 3 * I_BR + I_OUT + I_Q;
    for (int it = gw; it < NITEMS; it += NGW) {
        int r = it;
        if (r < I_IN) { const int kb = r / 176, nb = r % 176, n0 = 32 * nb; bf16* dst;
            if (n0 >= 1024 && n0 < 1536) dst = (bf16*)(ws + WS_WV) + (size_t)(n0 - 1024) * 1024;
            else { const int np = n0 < 1024 ? n0 : n0 - 512, t = np >> 8, w = np & 255, wc = w >> 6, bj = (w >> 5) & 1; dst = (bf16*)(ws + WS_WIN) + (size_t)(256 * t + 128 * bj + 32 * wc) * 1024; }
            p0_transpose_item(A.in[I_WIN], 1024, 5632, 64 * kb, n0, dst, A.in[I_MIXG], scr, lane); continue; }
        r -= I_IN;
        if (r < I_KV) { const int kb = r / 32, nb = r % 32; p0_transpose_item(A.in[I_WKV], 1024, 1024, 64 * kb, 32 * nb, (bf16*)(ws + WS_WKV) + (size_t)(32 * nb) * 1024, nullptr, scr, lane); continue; }
        r -= I_KV;
        if (r < 3 * I_BR) { const int br = r / I_BR, rr = r % I_BR, kb = rr / 32, nb = rr % 32; const float* W = br == 0 ? A.in[I_WB0] : (br == 1 ? A.in[I_WB1] : A.in[I_WB2]);
            p0_transpose_item(W, 512, 1024, 64 * kb, 32 * nb, (bf16*)(ws + WS_WBR) + (size_t)(32 * nb) * 1536 + br * 512, nullptr, scr, lane, 1536); continue; }
        r -= 3 * I_BR;
        if (r < I_OUT) { const int kb = r / 32, nb = r % 32; p0_transpose_item(A.in[I_WOUT], 1024, 1024, 64 * kb, 32 * nb, (bf16*)(ws + WS_WOUT) + (size_t)(32 * nb) * 1024, nullptr, scr, lane); continue; }
        r -= I_OUT;
        { const int kb = r / 64, nb = r % 64; p0_transpose_item(A.in[I_WQ], 1024, 2048, 64 * kb, 32 * nb, (bf16*)(ws + WS_WQ) + (size_t)(32 * nb) * 1024, A.in[I_FFNG], scr, lane); }
    }
    { bf16* xb = (bf16*)((unsigned char*)F.out + OUT_XB); float* rstdx = (float*)(ws + WS_RSTDX);
      for (int m0 = 4 * gw; m0 < T; m0 += 4 * NGW) {
          f32x4 v[4][4];
#pragma unroll
          for (int r = 0; r < 4; ++r)
#pragma unroll
              for (int j = 0; j < 4; ++j) v[r][j] = ((const GAS f32x4*)(A.in[I_X] + (size_t)(m0 + r) * D))[lane + 64 * j];
#pragma unroll
          for (int r = 0; r < 4; ++r) { float s = 0.f;
#pragma unroll
              for (int j = 0; j < 4; ++j) s += (v[r][j].x * v[r][j].x + v[r][j].y * v[r][j].y) + (v[r][j].z * v[r][j].z + v[r][j].w * v[r][j].w);
              const float rs = rsqrtf(wave_sum(s) * (1.0f / 1024.0f) + 1e-6f);
              GAS unsigned long long* o8 = (GAS unsigned long long*)(xb + (size_t)(m0 + r) * D) + lane;
#pragma unroll
              for (int j = 0; j < 4; ++j) o8[64 * j] = (unsigned long long)pk2(v[r][j].x, v[r][j].y) | ((unsigned long long)pk2(v[r][j].z, v[r][j].w) << 32);
              if (lane == 0) rstdx[m0 + r] = rs; } } }
    for (int m = gw; m < NMEMTOK; m += NGW) { const float* xr = A.in[I_MEM] + (size_t)m * D; const float rs = row_rstd1024(xr, lane); cvt_row1024(xr, (bf16*)(ws + WS_MEMN) + (size_t)m * D, A.in[I_MEMG], rs, lane); }
    for (int mb = 4 * gw; mb < 2 * NEXP; mb += 4 * NGW) {
        const bool isu = mb < NEXP; const int e0 = isu ? mb : mb - NEXP;
        f32x4 v[4][4];
#pragma unroll
        for (int r = 0; r < 4; ++r) { const GAS f32x4* src = (const GAS f32x4*)((isu ? A.in[I_PU] : A.in[I_PV]) + (size_t)(e0 + r) * D) + 4 * lane;
#pragma unroll
            for (int d = 0; d < 4; ++d) v[r][d] = src[d]; }
        f32x4 gv[4];
#pragma unroll
        for (int d = 0; d < 4; ++d) gv[d] = isu ? ((const GAS f32x4*)A.in[I_FFNG])[4 * lane + d] : (f32x4){1.f, 1.f, 1.f, 1.f};
#pragma unroll
        for (int r = 0; r < 4; ++r) { const int e = e0 + r; float mx = 0.f;
#pragma unroll
            for (int d = 0; d < 4; ++d) { v[r][d] = v[r][d] * gv[d]; mx = fmaxf(mx, fmaxf(fmaxf(fabsf(v[r][d].x), fabsf(v[r][d].y)), fmaxf(fabsf(v[r][d].z), fabsf(v[r][d].w)))); }
#pragma unroll
            for (int o = 1; o < 64; o <<= 1) mx = fmaxf(mx, __shfl_xor(mx, o));
            const float inv = mx > 0.f ? 127.0f / mx : 0.f;
            v4u w;
#pragma unroll
            for (int d = 0; d < 4; ++d) { const unsigned b0 = (unsigned)(int)rintf(v[r][d].x * inv) & 0xffu, b1 = (unsigned)(int)rintf(v[r][d].y * inv) & 0xffu,
                                                         b2 = (unsigned)(int)rintf(v[r][d].z * inv) & 0xffu, b3 = (unsigned)(int)rintf(v[r][d].w * inv) & 0xffu;
                w[d] = b0 | (b1 << 8) | (b2 << 16) | (b3 << 24); }
            if (isu) ((GAS v4u*)(ws + WS_U8))[(size_t)e * 64 + lane] = w;
            else *(GAS v4u*)(ws + WS_V8 + (size_t)(lane >> 3) * (2 * MiB) + (size_t)e * 128 + (lane & 7) * 16) = w;
            if (lane == 0) ((float*)(ws + WS_SU))[2 * e + (isu ? 0 : 1)] = mx * (1.0f / 127.0f); }
    }
    for (int m = gw * 64 + lane; m < T; m += NGW * 64) ((float*)(ws + WS_ROWSQ))[m] = 0.f;
    for (int m = gw; m < 256; m += NGW) cvt_row1024(A.in[I_KEYS] + (size_t)m * 1024, (bf16*)(ws + WS_KEYS) + (size_t)m * 1024, nullptr, 1.0f, lane);
    for (int m = gw; m < 1024; m += NGW) { const int gd = m >> 1, c = (m & 1) * 64 + lane, g = gd >> 7, d = gd & 127;
        const float v = A.in[I_POOLW][(size_t)(g * 128 + c) * 128 + d] * A.in[I_POOLSC][gd];
        ((bf16*)(ws + WS_PWT))[(size_t)gd * 128 + c] = (bf16)f2bf(v); }
}

__device__ __forceinline__ void memkv_tile(const bf16* memn, const bf16* wkvT, const float* kg, const float* qg, bf16* kmem, bf16* vtmem, int tile, int lane) {
    const int q = lane & 15, hi = lane >> 4, rg = tile >> 3, cg = tile & 7, r0 = rg * 16, c0 = cg * 128;
    f32x4 acc[8];
#pragma unroll
    for (int i = 0; i < 8; ++i) acc[i] = (f32x4){0.f, 0.f, 0.f, 0.f};
    const bf16* ap = memn + (size_t)(r0 + q) * 1024 + 8 * hi; const bf16* bp = wkvT + (size_t)(c0 + q) * 1024 + 8 * hi;
#pragma unroll 1
    for (int kb = 0; kb < 8; ++kb) {
        bf16x8 a[4], b[4][8];
#pragma unroll
        for (int k4 = 0; k4 < 4; ++k4) { a[k4] = *(const bf16x8*)(ap + 32 * (4 * kb + k4));
#pragma unroll
            for (int nf = 0; nf < 8; ++nf) b[k4][nf] = *(const bf16x8*)(bp + (size_t)(16 * nf) * 1024 + 32 * (4 * kb + k4)); }
        __builtin_amdgcn_sched_barrier(0);
#pragma unroll
        for (int k4 = 0; k4 < 4; ++k4)
#pragma unroll
            for (int nf = 0; nf < 8; ++nf) acc[nf] = mfma16(a[k4], b[k4][nf], acc[nf]);
        __builtin_amdgcn_sched_barrier(0);
    }
    if (cg < 4) {
        float rr[4];
#pragma unroll
        for (int g = 0; g < 4; ++g) { float ss = 0.f;
#pragma unroll
            for (int nf = 0; nf < 8; ++nf) ss += acc[nf][g] * acc[nf][g];
            ss += __shfl_xor(ss, 1); ss += __shfl_xor(ss, 2); ss += __shfl_xor(ss, 4); ss += __shfl_xor(ss, 8);
            rr[g] = rsqrtf(ss * (1.0f / 128.0f) + 1e-6f); }
#pragma unroll
        for (int nf = 0; nf < 8; ++nf) { const int d = 16 * nf + q; const float gs = kg[d] * qg[d];
#pragma unroll
            for (int g = 0; g < 4; ++g) kmem[(size_t)(r0 + 4 * hi + g) * 512 + cg * 128 + d] = (bf16)f2bf(acc[nf][g] * rr[g] * gs); }
    } else {
        const int h = cg - 4, b = r0 >> 8, key0 = (r0 & 255) + 4 * hi;
#pragma unroll
        for (int nf = 0; nf < 8; ++nf) { const int d = 16 * nf + q; v2u w; w.x = pk2(acc[nf][0], acc[nf][1]); w.y = pk2(acc[nf][2], acc[nf][3]);
            *(v2u*)(vtmem + (size_t)(b * 512 + h * 128 + d) * 256 + key0) = w; }
    }
}

__device__ __forceinline__ void na_item(const bf16* __restrict__ qn, const bf16* __restrict__ kn, const bf16* __restrict__ vt, const LAS float* rpl, bf16* __restrict__ yna,
                                        int b, int r, int jb, int h, int lane) {
    const int q = lane & 15, hi = lane >> 4;
    int rs = r - 4; rs = rs < 0 ? 0 : (rs > 120 ? 120 : rs);
    int kb0 = jb * 16 - 8; kb0 = kb0 < 0 ? 0 : (kb0 > 32 ? 32 : kb0);
    const int qcol = jb * 16 + q; int cs = qcol - 8; cs = cs < 0 ? 0 : (cs > 48 ? 48 : cs);
    const size_t tokq = (size_t)b * SEQ + r * 64 + qcol;
    const bf16* qp = qn + tokq * 512 + h * 64 + 8 * hi;
    const bf16x8 qf0 = *(const bf16x8*)qp, qf1 = *(const bf16x8*)(qp + 32);
    const int kq = 8 * (q >> 2) + (q & 3);
    const bf16* kbase = kn + ((size_t)b * SEQ + rs * 64 + kb0 + kq) * 512 + h * 64 + 8 * hi;
    f32x4 s[16];
    {
        bf16x8 ka[16][2];
#pragma unroll
        for (int f = 0; f < 16; ++f) { const bf16* kp = kbase + (size_t)((f >> 1) * 64 + (f & 1) * 4) * 512; ka[f][0] = *(const bf16x8*)kp; ka[f][1] = *(const bf16x8*)(kp + 32); }
        __builtin_amdgcn_sched_barrier(0);
#pragma unroll
        for (int f = 0; f < 16; ++f) { f32x4 z = (f32x4){0.f, 0.f, 0.f, 0.f}; z = mfma16(ka[f][0], qf0, z); s[f] = mfma16(ka[f][1], qf1, z); }
    }
    const bf16* vbase = vt + ((size_t)(b * 512 + h * 64 + q) * SEQ + rs * 64 + kb0 + 8 * hi);
    bf16x8 va[8][4];
#pragma unroll
    for (int st = 0; st < 8; ++st)
#pragma unroll
        for (int mf = 0; mf < 4; ++mf) va[st][mf] = *(const bf16x8*)(vbase + (size_t)(16 * mf) * SEQ + st * 64);
    __builtin_amdgcn_sched_barrier(0);
    float mx = -3.0e38f;
#pragma unroll
    for (int f = 0; f < 16; ++f) {
        const int dr = rs + (f >> 1) - r + 7;
#pragma unroll
        for (int g = 0; g < 4; ++g) {
            const int kcol = kb0 + 8 * hi + 4 * (f & 1) + g;
            const bool ok = (kcol >= cs) && (kcol < cs + 16);
            int dc = kcol - qcol + 15; dc = dc < 0 ? 0 : (dc > 30 ? 30 : dc);
            const float v = ok ? s[f][g] + rpl[dr * 31 + dc] : -1.0e30f;
            s[f][g] = v; mx = fmaxf(mx, v);
        }
    }
    mx = fmaxf(mx, __shfl_xor(mx, 16)); mx = fmaxf(mx, __shfl_xor(mx, 32));
    float sum = 0.f;
#pragma unroll
    for (int f = 0; f < 16; ++f)
#pragma unroll
        for (int g = 0; g < 4; ++g) { const float p = __expf(s[f][g] - mx); s[f][g] = p; sum += p; }
    sum += __shfl_xor(sum, 16); sum += __shfl_xor(sum, 32);
    const float inv = 1.0f / sum;
    f32x4 o[4];
#pragma unroll
    for (int i = 0; i < 4; ++i) o[i] = (f32x4){0.f, 0.f, 0.f, 0.f};
#pragma unroll
    for (int st = 0; st < 8; ++st) {
        const bf16x8 pb = __builtin_bit_cast(bf16x8, pg8::pack8(s[2 * st], s[2 * st + 1]));
#pragma unroll
        for (int mf = 0; mf < 4; ++mf) o[mf] = mfma16(va[st][mf], pb, o[mf]);
    }
    bf16* yp = yna + tokq * 1536 + h * 64 + 4 * hi;
#pragma unroll
    for (int mf = 0; mf < 4; ++mf) { v2u w; w.x = pk2(o[mf][0] * inv, o[mf][1] * inv); w.y = pk2(o[mf][2] * inv, o[mf][3] * inv); *(v2u*)(yp + 16 * mf) = w; }
}
__device__ __forceinline__ void xa_fill_lds(const bf16* __restrict__ kmem, const bf16* __restrict__ vtmem, LAS unsigned char* lds, int b, int h, int tid) {
#pragma unroll
    for (int ps = 0; ps < 8; ++ps) { const int id = tid + 512 * ps, key = id >> 4, c = id & 15;
        *(LAS v4u*)(lds + key * 256 + ((c ^ (key & 15)) << 4)) = *(const v4u*)(kmem + ((size_t)b * 256 + key) * 512 + h * 128 + 8 * c); }
#pragma unroll
    for (int ps = 0; ps < 8; ++ps) { const int id = tid + 512 * ps, dim = id >> 5, c = id & 31;
        *(LAS v4u*)(lds + 65536 + dim * 512 + ((c ^ (dim & 15)) << 4)) = *(const v4u*)(vtmem + (size_t)(b * 512 + h * 128 + dim) * 256 + 8 * c); }
}
__device__ __forceinline__ void xa_item(const bf16* __restrict__ xq, const LAS unsigned char* lds, bf16* __restrict__ yxa, int tok0, int h, int lane) {
    const int q = lane & 15, hi = lane >> 4; const size_t tok = (size_t)tok0 + q;
    const bf16* qp = xq + tok * 512 + h * 128 + 8 * hi;
    bf16x8 qf[4]; float ssq = 0.f;
#pragma unroll
    for (int ks = 0; ks < 4; ++ks) qf[ks] = *(const bf16x8*)(qp + 32 * ks);
    __builtin_amdgcn_sched_barrier(0);
#pragma unroll
    for (int ks = 0; ks < 4; ++ks)
#pragma unroll
        for (int j = 0; j < 8; ++j) { const float v = bf1(qf[ks][j]); ssq += v * v; }
    ssq += __shfl_xor(ssq, 16); ssq += __shfl_xor(ssq, 32);
    const float cexp = rsqrtf(ssq * (1.0f / 128.0f) + 1e-6f) * 0.08838834764831845f * 1.4426950408889634f;
    const int kq = 8 * (q >> 2) + (q & 3);
    f32x4 s[16];
#pragma unroll
    for (int f = 0; f < 16; ++f) { const int key = 32 * (f >> 1) + 4 * (f & 1) + kq; const LAS unsigned char* kr = lds + key * 256; f32x4 z = (f32x4){0.f, 0.f, 0.f, 0.f};
#pragma unroll
        for (int ks = 0; ks < 4; ++ks) z = mfma16(*(const LAS bf16x8*)(kr + (((4 * ks + hi) ^ (key & 15)) << 4)), qf[ks], z);
        s[f] = z; }
    float mx = -3.0e38f;
#pragma unroll
    for (int f = 0; f < 16; ++f)
#pragma unroll
        for (int g = 0; g < 4; ++g) mx = fmaxf(mx, s[f][g]);
    mx = fmaxf(mx, __shfl_xor(mx, 16)); mx = fmaxf(mx, __shfl_xor(mx, 32));
    float sum = 0.f;
#pragma unroll
    for (int f = 0; f < 16; ++f)
#pragma unroll
        for (int g = 0; g < 4; ++g) { const float p = __builtin_amdgcn_exp2f((s[f][g] - mx) * cexp); s[f][g] = p; sum += p; }
    sum += __shfl_xor(sum, 16); sum += __shfl_xor(sum, 32);
    const float inv = 1.0f / sum;
    f32x4 o[8];
#pragma unroll
    for (int i = 0; i < 8; ++i) o[i] = (f32x4){0.f, 0.f, 0.f, 0.f};
#pragma unroll
    for (int st = 0; st < 8; ++st) {
        const bf16x8 pb = __builtin_bit_cast(bf16x8, pg8::pack8(s[2 * st], s[2 * st + 1]));
#pragma unroll
        for (int mf = 0; mf < 8; ++mf) { const int dim = 16 * mf + q; o[mf] = mfma16(*(const LAS bf16x8*)(lds + 65536 + dim * 512 + (((4 * st + hi) ^ (dim & 15)) << 4)), pb, o[mf]); }
    }
    bf16* yp = yxa + tok * 1536 + h * 128 + 4 * hi;
#pragma unroll
    for (int mf = 0; mf < 8; ++mf) { v2u w; w.x = pk2(o[mf][0] * inv, o[mf][1] * inv); w.y = pk2(o[mf][2] * inv, o[mf][3] * inv); *(v2u*)(yp + 16 * mf) = w; }
}
__device__ __forceinline__ void pool_wg(const bf16* __restrict__ pp, const bf16* __restrict__ pwT, bf16* __restrict__ ypool, LAS unsigned char* lds, int tokbase, int wave, int lane) {
    const int q = lane & 15, hi = lane >> 4;
    __syncthreads();
    {
        const int hw = 1 << hi, tw0 = tokbase + 16 * wave, b = tw0 >> 13, t0 = tw0 & 8191;
        const bf16* base = pp + (size_t)b * SEQ * 512 + 8 * lane;
        float s[8];
#pragma unroll
        for (int j = 0; j < 8; ++j) s[j] = 0.f;
#pragma unroll 4
        for (int d = -8; d < 8; ++d) { const int u = t0 + d; const bool ok = (d >= -hw) && (d < hw) && (u >= 0) && (u < SEQ);
            const bf16x8 v = *(const bf16x8*)(base + (size_t)(ok ? u : t0) * 512);
#pragma unroll
            for (int j = 0; j < 8; ++j) s[j] += ok ? bf1(v[j]) : 0.f; }
        LAS unsigned char* tile = lds + wave * 16384;
#pragma unroll 4
        for (int i = 0; i < 16; ++i) { const int t = t0 + i;
            int lo = t - hw; lo = lo < 0 ? 0 : lo; int ht = t + hw; ht = ht > SEQ ? SEQ : ht;
            const float inv = 1.0f / (float)(ht - lo);
            const bool oka = (t + hw) < SEQ, oks = (t - hw) >= 0;
            const bf16x8 sv = *(const bf16x8*)(base + (size_t)t * 512), av = *(const bf16x8*)(base + (size_t)(oka ? t + hw : t) * 512), bv = *(const bf16x8*)(base + (size_t)(oks ? t - hw : t) * 512);
            f32x4 p0, p1;
#pragma unroll
            for (int j = 0; j < 4; ++j) { p0[j] = s[j] * inv - bf1(sv[j]); p1[j] = s[j + 4] * inv - bf1(sv[j + 4]); }
            *(LAS v4u*)(tile + i * 1024 + ((lane ^ (i & 15)) << 4)) = pg8::pack8(p0, p1);
#pragma unroll
            for (int j = 0; j < 8; ++j) s[j] += (oka ? bf1(av[j]) : 0.f) - (oks ? bf1(bv[j]) : 0.f);
        }
    }
    __syncthreads();
#pragma unroll 1
    for (int k = 0; k < 4; ++k) {
        const int pair = wave * 4 + k, g = pair >> 3, mf = pair & 7;
        const bf16* wb = pwT + (size_t)(g * 128 + 16 * mf + q) * 128 + 8 * hi;
        bf16x8 a[4];
#pragma unroll
        for (int ks = 0; ks < 4; ++ks) a[ks] = *(const bf16x8*)(wb + 32 * ks);
#pragma unroll 2
        for (int tg = 0; tg < 8; ++tg) {
            const LAS unsigned char* trow = lds + tg * 16384 + q * 1024; f32x4 o = (f32x4){0.f, 0.f, 0.f, 0.f};
#pragma unroll
            for (int ks = 0; ks < 4; ++ks) { const int c = g * 16 + 4 * ks + hi; o = mfma16(a[ks], *(const LAS bf16x8*)(trow + ((c ^ q) << 4)), o); }
            v2u w; w.x = pk2(o[0], o[1]); w.y = pk2(o[2], o[3]);
            *(v2u*)(ypool + (size_t)(tokbase + 16 * tg + q) * 1536 + g * 128 + 16 * mf + 4 * hi) = w;
        }
    }
    __syncthreads();
}

__device__ __forceinline__ int f2key(float s, int idx, int mask) { int b = __builtin_bit_cast(int, s); b = b >= 0 ? b : (b ^ 0x7fffffff); return (b & ~mask) | idx; }
__device__ __forceinline__ float key2f(int k) { k = k >= 0 ? k : (k ^ 0x7fffffff); return __builtin_bit_cast(float, k); }
#define CE_DESC(x, y) do { const int _h = (x) > (y) ? (x) : (y), _l = (x) > (y) ? (y) : (x); (x) = _h; (y) = _l; } while (0)
__device__ __forceinline__ void sort16(int (&a)[16]) {
#pragma unroll
    for (int ks = 1; ks <= 4; ++ks)
#pragma unroll
        for (int js = ks - 1; js >= 0; --js)
#pragma unroll
            for (int i = 0; i < 16; ++i) { const int k = 1 << ks, j = 1 << js, l = i ^ j;
                if (l > i) { if ((i & k) == 0) CE_DESC(a[i], a[l]); else CE_DESC(a[l], a[i]); } }
}
__device__ __forceinline__ void merge16(int (&a)[16], const int (&b)[16]) {
#pragma unroll
    for (int i = 0; i < 16; ++i) a[i] = a[i] > b[15 - i] ? a[i] : b[15 - i];
#pragma unroll
    for (int js = 3; js >= 0; --js)
#pragma unroll
        for (int i = 0; i < 16; ++i) { const int j = 1 << js, l = i ^ j; if (l > i) CE_DESC(a[i], a[l]); }
}
__device__ __forceinline__ void merge16_lanes(int (&a)[16], int step) { int o[16];
#pragma unroll
    for (int k = 0; k < 16; ++k) o[k] = __shfl_xor(a[k], step);
    merge16(a, o); }
__device__ constexpr int cand_i(int hi, int m) {
    return hi == 0 ? 0
         : hi == 1 ? (m < 8 ? 1 : (m < 13 ? 2 : -1))
         : hi == 2 ? (m < 4 ? 3 : (m < 7 ? 4 : (m < 9 ? 5 : (m < 11 ? 6 : -1))))
         :           (m < 2 ? 7 : (m < 10 ? 8 + (m - 2) : -1));
}
__device__ constexpr int cand_j(int hi, int m) {
    return hi == 0 ? m
         : hi == 1 ? (m < 8 ? m : (m < 13 ? m - 8 : -1))
         : hi == 2 ? (m < 4 ? m : (m < 7 ? m - 4 : (m < 9 ? m - 7 : (m < 11 ? m - 9 : -1))))
         :           (m < 2 ? m : (m < 10 ? 0 : -1));
}
__device__ __forceinline__ void topk_fill_lds(const bf16* __restrict__ keys, LAS unsigned char* lds, int h, int tid) {
#pragma unroll
    for (int ps = 0; ps < 8; ++ps) { const int id = tid + 512 * ps, row = id >> 4, c = id & 15;
        *(LAS v4u*)(lds + row * 256 + ((c ^ (row & 15)) << 4)) = *(const v4u*)(keys + ((size_t)h * 256 + row) * 128 + 8 * c); }
}
__device__ __forceinline__ void topk_item(const bf16* __restrict__ qb, const LAS unsigned char* klds, int* __restrict__ te, float* __restrict__ tw, LAS int* lscr, int tok0, int h, int lane) {
    const int q = lane & 15, hi = lane >> 4; const size_t tok = (size_t)tok0 + q;
    int L[2][16];
    bf16x8 qfa[2][4];
#pragma unroll
    for (int p = 0; p < 2; ++p)
#pragma unroll
        for (int ks = 0; ks < 4; ++ks) qfa[p][ks] = *(const bf16x8*)(qb + tok * 2048 + h * 256 + p * 128 + 32 * ks + 8 * hi);
    __builtin_amdgcn_sched_barrier(0);
#pragma unroll
    for (int p = 0; p < 2; ++p) {
        int B[16];
#pragma unroll
        for (int mf = 0; mf < 8; ++mf) { f32x4 s = (f32x4){0.f, 0.f, 0.f, 0.f}; const int row = p * 128 + 16 * mf + q;
#pragma unroll
            for (int ks = 0; ks < 4; ++ks) s = mfma16(*(const LAS bf16x8*)(klds + row * 256 + (((4 * ks + hi) ^ (row & 15)) << 4)), qfa[p][ks], s);
#pragma unroll
            for (int g = 0; g < 4; ++g) { const int key = f2key(s[g], 16 * mf + 4 * hi + g, 127); if (mf < 4) L[p][4 * mf + g] = key; else B[4 * (mf - 4) + g] = key; } }
        sort16(L[p]); sort16(B); merge16(L[p], B);
        merge16_lanes(L[p], 16); merge16_lanes(L[p], 32);
    }
    float v1[16], v2[16];
#pragma unroll
    for (int k = 0; k < 16; ++k) { v1[k] = key2f(L[0][k]); v2[k] = key2f(L[1][k]); }
    int Fk[16];
#pragma unroll
    for (int m = 0; m < 16; ++m) {
        float sm = v1[0] + v2[m]; int id = 255 - m;
        if (cand_i(1, m) >= 0) { if (hi == 1) { sm = v1[cand_i(1, m) < 0 ? 0 : cand_i(1, m)] + v2[cand_j(1, m) < 0 ? 0 : cand_j(1, m)]; id = 255 - ((cand_i(1, m) << 4) | cand_j(1, m)); } }
        if (cand_i(2, m) >= 0) { if (hi == 2) { sm = v1[cand_i(2, m) < 0 ? 0 : cand_i(2, m)] + v2[cand_j(2, m) < 0 ? 0 : cand_j(2, m)]; id = 255 - ((cand_i(2, m) << 4) | cand_j(2, m)); } }
        if (cand_i(3, m) >= 0) { if (hi == 3) { sm = v1[cand_i(3, m) < 0 ? 0 : cand_i(3, m)] + v2[cand_j(3, m) < 0 ? 0 : cand_j(3, m)]; id = 255 - ((cand_i(3, m) << 4) | cand_j(3, m)); } }
        int key = f2key(sm, id, 255);
        if ((hi == 1 && cand_i(1, m) < 0) || (hi == 2 && cand_i(2, m) < 0) || (hi == 3 && cand_i(3, m) < 0)) key = (int)0x80000000;
        Fk[m] = key;
    }
    sort16(Fk); merge16_lanes(Fk, 16); merge16_lanes(Fk, 32);
    LAS int* my = lscr + lane * 32;
#pragma unroll
    for (int k = 0; k < 16; ++k) { my[k] = L[0][k] & 127; my[16 + k] = L[1][k] & 127; }
    LDS_WAIT(); asm volatile("" ::: "memory");
    float e[16]; float sum = 0.f; const float mx = key2f(Fk[0]);
#pragma unroll
    for (int k = 0; k < 16; ++k) { e[k] = __expf(key2f(Fk[k]) - mx); sum += e[k]; }
    const float inv = 1.0f / sum;
    if (hi == 0) {
        int* tep = te + tok * 128; float* twp = tw + tok * 128;
#pragma unroll
        for (int kk = 0; kk < 16; ++kk) { const int ij = 255 - (Fk[kk] & 255), i = ij >> 4, j = ij & 15, slot = (kk & 7) * 16 + 2 * h + (kk >> 3);
            tep[slot] = my[i] * 128 + my[16 + j]; twp[slot] = e[kk] * inv; }
    }
    LDS_WAIT(); asm volatile("" ::: "memory");
}

__device__ __forceinline__ float ub2f(unsigned v, int b) { return (float)((v >> (8 * b)) & 0xffu); }
__device__ __forceinline__ void hq_token(const bf16* __restrict__ hb, const float* __restrict__ rowsq, unsigned char* __restrict__ hq, float* __restrict__ hs, int tok, int lane) {
    const bf16* hp = hb + (size_t)tok * 1024 + 16 * lane;
    const v4u hA = *(const v4u*)hp, hB = *(const v4u*)(hp + 8);
    float hf[16];
#pragma unroll
    for (int d = 0; d < 4; ++d) { hf[2 * d] = bflo(hA[d]); hf[2 * d + 1] = bfhi(hA[d]); hf[8 + 2 * d] = bflo(hB[d]); hf[8 + 2 * d + 1] = bfhi(hB[d]); }
    float amax = 0.f;
#pragma unroll
    for (int j = 0; j < 16; ++j) amax = fmaxf(amax, fabsf(hf[j]));
#pragma unroll
    for (int o = 1; o < 64; o <<= 1) amax = fmaxf(amax, __shfl_xor(amax, o));
    const float hinv = amax > 0.f ? 127.0f / amax : 0.f;
    v4u w;
#pragma unroll
    for (int d = 0; d < 4; ++d) { const unsigned b0 = (unsigned)(int)rintf(hf[4 * d] * hinv) & 0xffu, b1 = (unsigned)(int)rintf(hf[4 * d + 1] * hinv) & 0xffu,
                                                 b2 = (unsigned)(int)rintf(hf[4 * d + 2] * hinv) & 0xffu, b3 = (unsigned)(int)rintf(hf[4 * d + 3] * hinv) & 0xffu;
        w[d] = b0 | (b1 << 8) | (b2 << 16) | (b3 << 24); }
    *(v4u*)(hq + (size_t)tok * 1024 + 16 * lane) = w;
    if (lane == 0) hs[tok] = rsqrtf(rowsq[tok] * (1.0f / 1024.0f) + 1e-6f) * amax * (1.0f / 127.0f);
}
constexpr int PA_SLOTS = 12;
struct PeerA1 { int e; float g; };
struct PeerA2 { v4u ur[3][4]; v4u hv[4]; float hsc, su, sv; int cnt, rk; bool m; unsigned long long rem; };
__device__ __forceinline__ void pa_s1(PeerA1& a, const int* __restrict__ te, const float* __restrict__ tw, int tok, int half, int lane) {
    a.e = te[(size_t)tok * 128 + 64 * half + lane]; a.g = tw[(size_t)tok * 128 + 64 * half + lane]; }
__device__ __forceinline__ void pa_s2(PeerA2& b, const PeerA1& a, const unsigned char* __restrict__ hq, const float* __restrict__ hs, const unsigned char* __restrict__ u8,
                                      const float* __restrict__ su, const float* __restrict__ sv, LAS int* lst, int tok, int x, int lane, int hot) {
    b.m = (a.e >> 11) == x;
    const unsigned long long mask = __ballot(b.m), lt = (1ull << lane) - 1ull;
    b.cnt = __popcll(mask); b.rk = __popcll(mask & lt);
    if (b.m && b.rk < PA_SLOTS) lst[b.rk] = a.e;
    { unsigned long long r = mask; for (int k = 0; k < PA_SLOTS && r != 0ull; ++k) r &= r - 1ull; b.rem = b.cnt > PA_SLOTS ? r : 0ull; }
    { typedef float f32x2s __attribute__((ext_vector_type(2))); f32x2s s2 = (f32x2s){0.f, 0.f}; if (b.m) s2 = ((const f32x2s*)su)[a.e]; b.su = s2.x; b.sv = s2.y; }
    const int r = lane >> 4, t = lane & 15;
#pragma unroll
    for (int i = 0; i < 4; ++i) b.hv[i] = *(const v4u*)(hq + (size_t)tok * 1024 + 16 * t + 256 * i);
    b.hsc = hs[tok];
    LDS_WAIT(); asm volatile("" ::: "memory");
    const int lim = b.cnt < PA_SLOTS ? b.cnt : PA_SLOTS;
#pragma unroll
    for (int q = 0; q < 3; ++q) { const int slot = 4 * q + r;
#pragma unroll
        for (int i = 0; i < 4; ++i) b.ur[q][i] = (v4u){0u, 0u, 0u, 0u};
        if (slot < lim) { int e = lst[slot]; if (hot) e = (x << 11) | (e & 255); const unsigned char* rp = u8 + (size_t)e * 1024 + 16 * t;
#pragma unroll
            for (int i = 0; i < 4; ++i) b.ur[q][i] = *(const v4u*)(rp + 256 * i); } }
    (void)sv;
}
__device__ __forceinline__ int dot16(const v4u u, const v4u h) { int d = __builtin_amdgcn_sdot4((int)u.x, (int)h.x, 0, false); d = __builtin_amdgcn_sdot4((int)u.y, (int)h.y, d, false);
    d = __builtin_amdgcn_sdot4((int)u.z, (int)h.z, d, false); return __builtin_amdgcn_sdot4((int)u.w, (int)h.w, d, false); }
template <int CTRL, int RM> __device__ __forceinline__ int dpp_i(int x) { return __builtin_amdgcn_update_dpp(0, x, CTRL, RM, 0xf, false); }
__device__ __forceinline__ int wave_sum_to63(int x) { x += dpp_i<0xb1, 0xf>(x); x += dpp_i<0x4e, 0xf>(x); x += dpp_i<0x124, 0xf>(x); x += dpp_i<0x128, 0xf>(x); x += dpp_i<0x142, 0xa>(x); x += dpp_i<0x143, 0xc>(x); return x; }
__device__ __forceinline__ int row_sum16(int x) { x += dpp_i<0xb1, 0xf>(x); x += dpp_i<0x4e, 0xf>(x); x += dpp_i<0x124, 0xf>(x); x += dpp_i<0x128, 0xf>(x); return x; }
__device__ __forceinline__ float gelu_erf(float v) {
    const float av = fabsf(v), t = __builtin_amdgcn_rcpf(av * 0.2316418882f + 1.0f);
    float q = t * 0.5307027145f + (-0.7265760135f); q = q * t + 0.7107068705f; q = q * t + (-0.142248368f); q = q * t + 0.127414796f; q = q * t;
    const float e = __builtin_amdgcn_exp2f((v * v) * (-0.72134752044f)), m = v * (q * e);
    return v < 0.f ? m : v - m; }
__device__ __forceinline__ void pa_s3(const PeerA2& b, const PeerA1& a, const unsigned char* __restrict__ u8, const unsigned char* __restrict__ hq, float* __restrict__ aw, int tok, int half, int lane) {
    int mine = 0;
#pragma unroll
    for (int q = 0; q < 3; ++q) { int d = dot16(b.ur[q][0], b.hv[0]); d += dot16(b.ur[q][1], b.hv[1]); d += dot16(b.ur[q][2], b.hv[2]); d += dot16(b.ur[q][3], b.hv[3]);
        d = row_sum16(d);
#pragma unroll
        for (int r = 0; r < 4; ++r) { const int s = __builtin_amdgcn_readlane(d, 16 * r); mine = (b.rk == 4 * q + r) ? s : mine; } }
    float* awp = aw + (size_t)tok * 128 + 64 * half + lane;
    if (b.m && b.rk < PA_SLOTS) *awp = a.g * gelu_erf((float)mine * b.hsc * b.su) * b.sv;
    if (b.cnt > PA_SLOTS) {
        unsigned long long rem = b.rem; const v4u hw = *(const v4u*)(hq + (size_t)tok * 1024 + 16 * lane);
        while (rem != 0ull) { const int idx = __builtin_ctzll(rem); rem &= rem - 1ull; const int e = __builtin_amdgcn_readlane(a.e, idx);
            const int d = __builtin_amdgcn_readlane(wave_sum_to63(dot16(*(const v4u*)(u8 + (size_t)e * 1024 + 16 * lane), hw)), 63);
            if (lane == idx) *awp = a.g * gelu_erf((float)d * b.hsc * b.su) * b.sv; }
    }
}
__device__ __forceinline__ void peer_a_run(const unsigned char* __restrict__ hq, const float* __restrict__ hs, const unsigned char* __restrict__ u8, const float* __restrict__ su,
                                           const float* __restrict__ sv, const int* __restrict__ te, const float* __restrict__ tw, float* __restrict__ aw, LAS int* lst, int wrank, int wstep, int x, int lane, int hot = 0) {
    const int ntok = wrank < T ? (T - wrank + wstep - 1) / wstep : 0, N = 2 * ntok;
#define PA_TOK(n) (wrank + ((n) >> 1) * wstep)
    if (N == 0) return;
    PeerA1 a0, a1, a2; PeerA2 bA, bB;
    pa_s1(a0, te, tw, PA_TOK(0), 0, lane); pa_s1(a1, te, tw, PA_TOK(1), 1, lane);
    pa_s2(bA, a0, hq, hs, u8, su, sv, lst, PA_TOK(0), x, lane, hot);
#define PA_STEP(n, Bcur, Bnext, Acur, Anext, Anew) do { \
        if ((n) + 1 < N) pa_s2(Bnext, Anext, hq, hs, u8, su, sv, lst, PA_TOK((n) + 1), x, lane, hot); \
        if ((n) + 2 < N) pa_s1(Anew, te, tw, PA_TOK((n) + 2), ((n) + 2) & 1, lane); \
        pa_s3(Bcur, Acur, u8, hq, aw, PA_TOK(n), (n) & 1, lane); } while (0)
    for (int n = 0; n < N; n += 6) {
        PA_STEP(n, bA, bB, a0, a1, a2);
        if (n + 1 < N) PA_STEP(n + 1, bB, bA, a1, a2, a0);
        if (n + 2 < N) PA_STEP(n + 2, bA, bB, a2, a0, a1);
        if (n + 3 < N) PA_STEP(n + 3, bB, bA, a0, a1, a2);
        if (n + 4 < N) PA_STEP(n + 4, bA, bB, a1, a2, a0);
        if (n + 5 < N) PA_STEP(n + 5, bB, bA, a2, a0, a1);
    }
#undef PA_STEP
#undef PA_TOK
}
struct PeerB1 { v4u e[4]; f32x4 w[4]; };
struct PeerB2 { v4u vr[8]; };
struct PeerBAcc { int acc[16]; int wq[4]; float wsc, h0, h1; };
typedef float f32x2v __attribute__((ext_vector_type(2)));
__device__ __forceinline__ void pb_s1(PeerB1& a, const int* __restrict__ te, const float* __restrict__ aw, int tok, int lane) {
    const v4u* ep = (const v4u*)(te + (size_t)tok * 128 + 16 * (lane >> 3)); const f32x4* wp = (const f32x4*)(aw + (size_t)tok * 128 + 16 * (lane >> 3));
#pragma unroll
    for (int j = 0; j < 4; ++j) { a.e[j] = ep[j]; a.w[j] = wp[j]; } }
__device__ __forceinline__ int pb_col(int lane) { return 16 * (lane & 7) + 8 * ((lane >> 5) & 1) + 4 * ((lane >> 4) & 1) + 2 * ((lane >> 3) & 1); }
template <int CTRL, int RM> __device__ __forceinline__ float dpp_f(float x) { return __builtin_bit_cast(float, __builtin_amdgcn_update_dpp(0, __builtin_bit_cast(int, x), CTRL, RM, 0xf, false)); }
__device__ __forceinline__ void pb_quant(PeerBAcc& A, const PeerB1& a) {
    float mx = 0.f;
#pragma unroll
    for (int j = 0; j < 4; ++j) mx = fmaxf(mx, fmaxf(fmaxf(fabsf(a.w[j][0]), fabsf(a.w[j][1])), fmaxf(fabsf(a.w[j][2]), fabsf(a.w[j][3]))));
    mx = fmaxf(mx, dpp_f<0xb1, 0xf>(mx)); mx = fmaxf(mx, dpp_f<0x4e, 0xf>(mx)); mx = fmaxf(mx, dpp_f<0x124, 0xf>(mx)); mx = fmaxf(mx, dpp_f<0x128, 0xf>(mx));
    mx = fmaxf(mx, dpp_f<0x142, 0xa>(mx)); mx = fmaxf(mx, dpp_f<0x143, 0xc>(mx));
    mx = __builtin_bit_cast(float, __builtin_amdgcn_readlane(__builtin_bit_cast(int, mx), 63));
    const float inv = mx > 0.f ? 127.0f / mx : 0.f; A.wsc = mx * (1.0f / 127.0f);
#pragma unroll
    for (int j = 0; j < 4; ++j) A.wq[j] = (int)(((unsigned)(int)rintf(a.w[j][0] * inv) & 0xffu) | (((unsigned)(int)rintf(a.w[j][1] * inv) & 0xffu) << 8) |
                                               (((unsigned)(int)rintf(a.w[j][2] * inv) & 0xffu) << 16) | (((unsigned)(int)rintf(a.w[j][3] * inv) & 0xffu) << 24));
}
template <int HF> __device__ __forceinline__ void pb_s2(PeerB2& b, const PeerB1& a, const unsigned char* __restrict__ v8x, int lane, int hot = 0) {
    const int c = lane & 7;
#pragma unroll
    for (int m = 0; m < 8; ++m) { unsigned e = a.e[2 * HF + (m >> 2)][m & 3]; if (hot) e &= 255u; b.vr[m] = *(const v4u*)(v8x + (size_t)e * 128 + 16 * c); }
}
__device__ __forceinline__ float swap32_add(float lo, float hi) { const auto r = __builtin_amdgcn_permlane32_swap(__builtin_bit_cast(unsigned, lo), __builtin_bit_cast(unsigned, hi), false, false);
    return __builtin_bit_cast(float, r[0]) + __builtin_bit_cast(float, r[1]); }
__device__ __forceinline__ float swap16_add(float lo, float hi) { const auto r = __builtin_amdgcn_permlane16_swap(__builtin_bit_cast(unsigned, lo), __builtin_bit_cast(unsigned, hi), false, false);
    return __builtin_bit_cast(float, r[0]) + __builtin_bit_cast(float, r[1]); }
template <int HF> __device__ __forceinline__ void pb_s3(PeerBAcc& A, const PeerB2& b, const PeerB1& a, float* out, int tok, int x, int lane) {
    if (HF == 0) {
#pragma unroll
        for (int j = 0; j < 16; ++j) A.acc[j] = 0;
    }
#pragma unroll
    for (int gg = 0; gg < 2; ++gg)
#pragma unroll
        for (int d = 0; d < 4; ++d) { const unsigned ra = b.vr[4 * gg][d], rb = b.vr[4 * gg + 1][d], rc = b.vr[4 * gg + 2][d], rd = b.vr[4 * gg + 3][d];
            const unsigned t0 = __builtin_amdgcn_perm(rb, ra, 0x05010400u), t1 = __builtin_amdgcn_perm(rb, ra, 0x07030602u), t2 = __builtin_amdgcn_perm(rd, rc, 0x05010400u), t3 = __builtin_amdgcn_perm(rd, rc, 0x07030602u);
            const unsigned c0 = __builtin_amdgcn_perm(t2, t0, 0x05040100u), c1 = __builtin_amdgcn_perm(t2, t0, 0x07060302u), c2 = __builtin_amdgcn_perm(t3, t1, 0x05040100u), c3 = __builtin_amdgcn_perm(t3, t1, 0x07060302u);
            const int w4 = A.wq[2 * HF + gg];
            A.acc[4 * d] = __builtin_amdgcn_sdot4((int)c0, w4, A.acc[4 * d], false); A.acc[4 * d + 1] = __builtin_amdgcn_sdot4((int)c1, w4, A.acc[4 * d + 1], false);
            A.acc[4 * d + 2] = __builtin_amdgcn_sdot4((int)c2, w4, A.acc[4 * d + 2], false); A.acc[4 * d + 3] = __builtin_amdgcn_sdot4((int)c3, w4, A.acc[4 * d + 3], false); }
    if (HF == 1) {
        int r8[8], r4[4], r2[2];
#pragma unroll
        for (int j = 0; j < 8; ++j) { const bool up = (lane & 32) != 0; const int keep = up ? A.acc[j + 8] : A.acc[j], send = up ? A.acc[j] : A.acc[j + 8]; r8[j] = keep + __shfl_xor(send, 32); }
#pragma unroll
        for (int j = 0; j < 4; ++j) { const bool up = (lane & 16) != 0; const int keep = up ? r8[j + 4] : r8[j], send = up ? r8[j] : r8[j + 4]; r4[j] = keep + __shfl_xor(send, 16); }
#pragma unroll
        for (int j = 0; j < 2; ++j) { const bool up = (lane & 8) != 0; const int keep = up ? r4[j + 2] : r4[j], send = up ? r4[j] : r4[j + 2];
            r2[j] = keep + __builtin_amdgcn_update_dpp(0, send, 0x128, 0xf, 0xf, false); }
        f32x2v h2; h2.x = A.h0 + A.wsc * (float)r2[0]; h2.y = A.h1 + A.wsc * (float)r2[1];
        *(f32x2v*)(out + (size_t)tok * 1024 + 128 * x + pb_col(lane)) = h2;
    }
}
__device__ __forceinline__ void peer_b_run(const unsigned char* __restrict__ v8x, const int* __restrict__ te, const float* __restrict__ aw, const bf16* __restrict__ hb, float* out, int wrank, int wstep, int x, int lane, int hot = 0) {
    const int N = wrank < T ? (T - wrank + wstep - 1) / wstep : 0;
#define PB_TOK(n) (wrank + (n) * wstep)
#define PB_LOADH(n) do { const unsigned h2_ = *(const unsigned*)(hb + (size_t)PB_TOK(n) * 1024 + 128 * x + pb_col(lane)); A.h0 = bflo(h2_); A.h1 = bfhi(h2_); } while (0)
    if (N == 0) return;
    PeerB1 s0, s1; PeerB2 bA, bB; PeerBAcc A;
    pb_s1(s0, te, aw, PB_TOK(0), lane); if (N > 1) pb_s1(s1, te, aw, PB_TOK(1), lane);
    pb_s2<0>(bA, s0, v8x, lane, hot);
    for (int n = 0; n < N; n += 2) {
        pb_s2<1>(bB, s0, v8x, lane, hot); PB_LOADH(n); pb_quant(A, s0);
        pb_s3<0>(A, bA, s0, out, PB_TOK(n), x, lane);
        if (n + 1 < N) pb_s2<0>(bA, s1, v8x, lane, hot);
        pb_s3<1>(A, bB, s0, out, PB_TOK(n), x, lane);
        if (n + 2 < N) pb_s1(s0, te, aw, PB_TOK(n + 2), lane);
        if (n + 1 < N) {
            pb_s2<1>(bB, s1, v8x, lane, hot); PB_LOADH(n + 1); pb_quant(A, s1);
            pb_s3<0>(A, bA, s1, out, PB_TOK(n + 1), x, lane);
            if (n + 2 < N) pb_s2<0>(bA, s0, v8x, lane, hot);
            pb_s3<1>(A, bB, s1, out, PB_TOK(n + 1), x, lane);
            if (n + 3 < N) pb_s1(s1, te, aw, PB_TOK(n + 3), lane);
        }
    }
#undef PB_LOADH
#undef PB_TOK
}

__global__ void __launch_bounds__(NWAVES * 64, 2) mk_fwd(Args args) {
    extern __shared__ __attribute__((aligned(16))) unsigned char lds[];
    Frame F;
    F.lds = (LAS unsigned char*)lds;
    F.MISC = (volatile LAS unsigned*)(F.lds + MISC_OFF);
    F.tid = threadIdx.x; F.lane = F.tid & 63; F.wave = __builtin_amdgcn_readfirstlane(F.tid >> 6);
    F.G = gridDim.x; { const int bx = blockIdx.x; F.vcu = (F.G % 8 == 0) ? (bx % 8) * (F.G / 8) + bx / 8 : bx; }
    F.out = args.out; F.ws = args.ws;
    unsigned char* ws = args.ws;
    F.ctl = (gu32*)(ws + WS_CTL);
    for (int u = F.tid; u < (LDS_BYTES - LDSCTL_OFF) / 4; u += NWAVES * 64) ((LAS unsigned*)(F.lds + LDSCTL_OFF))[u] = 0u;
    __syncthreads();
    XcdBarrier bar; bar.bar = (unsigned*)(F.ctl + CW_BAR); bar.x = 0; bar.st = nullptr;
    if (N_LAUNCHES != PER_PHASE) bar = xcd_barrier_post((unsigned*)(F.ctl + CW_BAR), F.MISC + 8);
    if (N_LAUNCHES != PER_PHASE) { if (F.tid == 0) { const unsigned xid = xb_xcc_id(); F.MISC[12] = xid; F.MISC[13] = xb_add((unsigned*)(F.ctl + CW_TICKET) + 64 * xid, 1u); } __syncthreads(); }
#define GRID_BAR() do { if (N_LAUNCHES != PER_PHASE) xcd_barrier(bar); } while (0)
    const int lo = args.ph_lo, hi = args.ph_hi;
#define IN(k) (lo <= (k) && (k) < hi)
#define BOTH(k) (IN(k) && IN((k) + 1))
#ifndef DUP_PHASE
#define DUP_PHASE (-1)
#endif
#define NREP(k) ((DUP_PHASE == (k)) ? 2 : 1)
    const int gw = F.vcu * NWAVES + F.wave, NGW = F.G * NWAVES;
    bf16* const WinT = (bf16*)(ws + WS_WIN); bf16* const WvT = (bf16*)(ws + WS_WV); bf16* const WkvT = (bf16*)(ws + WS_WKV); bf16* const WbrT = (bf16*)(ws + WS_WBR);
    bf16* const WoutT = (bf16*)(ws + WS_WOUT); bf16* const WqT = (bf16*)(ws + WS_WQ); bf16* const KEYS = (bf16*)(ws + WS_KEYS); bf16* const PWT = (bf16*)(ws + WS_PWT);
    bf16* const MEMN = (bf16*)(ws + WS_MEMN); bf16* const KMEM = (bf16*)(ws + WS_KMEM); bf16* const VTMEM = (bf16*)(ws + WS_VTMEM); float* const RSTDX = (float*)(ws + WS_RSTDX);
    const unsigned char* const U8 = ws + WS_U8; const unsigned char* const V8 = ws + WS_V8; const float* const SU = (const float*)(ws + WS_SU); const float* const SV = (const float*)(ws + WS_SV);
    bf16* const QN = (bf16*)(ws + WS_QN); bf16* const KN = (bf16*)(ws + WS_KN); bf16* const VT = (bf16*)(ws + WS_VT); bf16* const PP = (bf16*)(ws + WS_PP); bf16* const XQ = (bf16*)(ws + WS_XQ);
    bf16* const GATE = (bf16*)(ws + WS_GATE); bf16* const MERGED = (bf16*)(ws + WS_MERGED); bf16* const HB = (bf16*)(ws + WS_HB); bf16* const QB = (bf16*)(ws + WS_QB);
    int* const TE = (int*)(ws + WS_TE); float* const TW = (float*)(ws + WS_TW); float* const AW = (float*)(ws + WS_AW); float* const ROWSQ = (float*)(ws + WS_ROWSQ);
    bf16* const XB = (bf16*)((unsigned char*)args.out + OUT_XB); bf16* const YNA = (bf16*)((unsigned char*)args.out + OUT_YNA);
    bf16* const YPOOL = (bf16*)((unsigned char*)args.out + OUT_YPOOL); bf16* const YXA = (bf16*)((unsigned char*)args.out + OUT_YXA);

    if (IN(0)) { for (int rep = 0; rep < NREP(0); ++rep) { p0_prologue(F, args); if (rep + 1 < NREP(0)) GRID_BAR(); } if (BOTH(0)) GRID_BAR(); }

    if (IN(1)) {
      for (int rep = 0; rep < NREP(1); ++rep) {
        { pg8::Sched1 S; S.so.init(T, IN_MAIN, F.G, (int)blockIdx.x); S.A = (const char*)XB; S.Bt = (const char*)WinT; S.tstep = (size_t)256 * 1024 * 2;
          pg8::EpiProj E{RSTDX, QN, KN, PP, XQ, GATE, args.in[I_NAQG], args.in[I_NAKG], args.in[I_GATEB]};
          pg8::gemm_phase<pg8::EpiProj, pg8::Sched1, true, true>(F.lds + RING_OFF, 1024, S, E); }
        { pg8::Sched1 S; S.so.init(512, T, F.G, (int)blockIdx.x); S.A = (const char*)WvT; S.Bt = (const char*)XB; S.tstep = (size_t)256 * 1024 * 2;
          pg8::EpiVt E{RSTDX, VT};
          pg8::gemm_phase<pg8::EpiVt, pg8::Sched1, false, true>(F.lds + RING_OFF, 1024, S, E); }
        for (int t = gw; t < 512; t += NGW) memkv_tile(MEMN, WkvT, args.in[I_XAKG], args.in[I_XAQG], KMEM, VTMEM, t, F.lane);
        if (rep + 1 < NREP(1)) GRID_BAR();
      }
        if (BOTH(1)) GRID_BAR();
    }

    if (IN(2)) {
      for (int rep = 0; rep < NREP(2); ++rep) {
        LAS float* rpl = (LAS float*)(F.lds + RING_OFF + F.wave * 16384);
        for (int i = F.lane; i < 15 * 31; i += 64) rpl[i] = args.in[I_RPB][F.wave * 15 * 31 + i];
        LDS_WAIT(); asm volatile("" ::: "memory");
        for (int i = F.vcu; i < 256; i += F.G)
            for (int k = 0; k < 8; ++k) { const int idx = i * 8 + k, b = idx >> 9, r = (idx >> 2) & 127, jb = idx & 3; na_item(QN, KN, VT, rpl, YNA, b, r, jb, F.wave, F.lane); }
        for (int i = F.vcu; i < 256; i += F.G) pool_wg(PP, PWT, YPOOL, F.lds + RING_OFF, i * 128, F.wave, F.lane);
        { const int pair = F.vcu & 15, xb = pair >> 2, xh = pair & 3, slot = F.vcu >> 4, nslot = F.G >> 4;
          __syncthreads(); xa_fill_lds(KMEM, VTMEM, F.lds + RING_OFF, xb, xh, F.tid); __syncthreads();
          if (slot < nslot) for (int n = slot * NWAVES + F.wave; n < 512; n += nslot * NWAVES) xa_item(XQ, F.lds + RING_OFF, YXA, (xb * 512 + n) * 16, xh, F.lane);
          __syncthreads(); }
        if (rep + 1 < NREP(2)) GRID_BAR();
      }
        if (BOTH(2)) GRID_BAR();
    }

    if (IN(3)) {
      for (int rep = 0; rep < NREP(3); ++rep) {
        pg8::Sched1 S; S.so.init(T, D, F.G, (int)blockIdx.x); S.A = (const char*)YNA; S.Bt = (const char*)WbrT; S.tstep = (size_t)256 * 1536 * 2;
        pg8::EpiMergeCat E{GATE, MERGED};
        pg8::gemm_phase<pg8::EpiMergeCat, pg8::Sched1, true, true>(F.lds + RING_OFF, 1536, S, E);
        if (rep + 1 < NREP(3)) GRID_BAR();
      }
        if (BOTH(3)) GRID_BAR();
    }

    if (IN(4)) {
      for (int rep = 0; rep < NREP(4); ++rep) {
        pg8::Sched1 S; S.so.init(T, D, F.G, (int)blockIdx.x); S.A = (const char*)MERGED; S.Bt = (const char*)WoutT; S.tstep = (size_t)256 * 1024 * 2;
        pg8::EpiH E{args.in[I_X], F.out, HB, ROWSQ, args.probe};
        pg8::gemm_phase<pg8::EpiH, pg8::Sched1, true, true>(F.lds + RING_OFF, 1024, S, E);
        if (rep + 1 < NREP(4)) { GRID_BAR(); for (int m = gw * 64 + F.lane; m < T; m += NGW * 64) ROWSQ[m] = 0.f; GRID_BAR(); }
      }
        if (BOTH(4)) GRID_BAR();
    }

    if (IN(5)) {
      for (int rep = 0; rep < NREP(5); ++rep) {
        pg8::Sched1 S; S.so.init(T, 2048, F.G, (int)blockIdx.x); S.A = (const char*)HB; S.Bt = (const char*)WqT; S.tstep = (size_t)256 * 1024 * 2;
        pg8::EpiQ E{ROWSQ, QB};
        pg8::gemm_phase<pg8::EpiQ, pg8::Sched1, true, true>(F.lds + RING_OFF, 1024, S, E);
        if (rep + 1 < NREP(5)) GRID_BAR();
      }
        if (BOTH(5)) GRID_BAR();
    }

    if (IN(6)) {
        LAS int* lscr = (LAS int*)(F.lds + RING_OFF + 65536 + F.wave * 8192);
        for (int tok = gw; tok < T; tok += NGW) hq_token(HB, ROWSQ, ws + WS_HQ, (float*)(ws + WS_HS), tok, F.lane);
        { const int th = F.vcu & 7, slot = F.vcu >> 3, nslot = F.G >> 3;
          __syncthreads(); topk_fill_lds(KEYS, F.lds + RING_OFF, th, F.tid); __syncthreads();
          for (int rep = 0; rep < NREP(6); ++rep) { for (int n = slot * NWAVES + F.wave; n < 2048; n += nslot * NWAVES) topk_item(QB, F.lds + RING_OFF, TE, TW, lscr, n * 16, th, F.lane); if (rep + 1 < NREP(6)) GRID_BAR(); }
          __syncthreads(); }
        if (BOTH(6)) GRID_BAR();
    }

    if (IN(7)) {
        int x0 = 0, nxs = 8, wrank = (int)blockIdx.x * NWAVES + F.wave, wstep = F.G * NWAVES;
        if (N_LAUNCHES != PER_PHASE) { const unsigned xid = F.MISC[12], rk = F.MISC[13]; unsigned nx = 0, below = 0, mine = 0;
            for (unsigned j = 0; j < 16; ++j) { const unsigned c = xb_ld((unsigned*)(F.ctl + CW_BAR) + XB_XCNT(j)); nx += c > 0u; below += (c > 0u && j < xid); mine = (j == xid) ? c : mine; }
            if (nx == 8 && mine > 0 && rk < mine) { x0 = (int)below; nxs = 1; wrank = (int)rk * NWAVES + F.wave; wstep = (int)mine * NWAVES; } }
        else if ((F.G & 7) == 0) { x0 = (int)blockIdx.x & 7; nxs = 1; wrank = ((int)blockIdx.x >> 3) * NWAVES + F.wave; wstep = (F.G >> 3) * NWAVES; }
        for (int xs = 0; xs < nxs; ++xs) peer_a_run(ws + WS_HQ, (const float*)(ws + WS_HS), U8, SU, SV, TE, TW, args.probe ? (float*)QB : AW, (LAS int*)(F.lds + RING_OFF + F.wave * 16384), wrank, wstep, x0 + xs, F.lane, args.probe == 2);
        if (N_LAUNCHES != PER_PHASE) xcd_barrier(bar);
    }
    if (IN(8)) {
        int x0 = 0, nxs = 8, wrank = (int)blockIdx.x * NWAVES + F.wave, wstep = F.G * NWAVES;
        if (N_LAUNCHES != PER_PHASE) { const unsigned xid = F.MISC[12], rk = F.MISC[13]; unsigned nx = 0, below = 0, mine = 0;
            for (unsigned j = 0; j < 16; ++j) { const unsigned c = xb_ld((unsigned*)(F.ctl + CW_BAR) + XB_XCNT(j)); nx += c > 0u; below += (c > 0u && j < xid); mine = (j == xid) ? c : mine; }
            if (nx == 8 && mine > 0 && rk < mine) { x0 = (int)below; nxs = 1; wrank = (int)rk * NWAVES + F.wave; wstep = (int)mine * NWAVES; } }
        else if ((F.G & 7) == 0) { x0 = (int)blockIdx.x & 7; nxs = 1; wrank = ((int)blockIdx.x >> 3) * NWAVES + F.wave; wstep = (F.G >> 3) * NWAVES; }
        for (int xs = 0; xs < nxs; ++xs) peer_b_run(V8 + (size_t)(x0 + xs) * (2 * MiB), TE, AW, HB, args.probe ? (float*)QB : F.out, wrank, wstep, x0 + xs, F.lane, args.probe == 2);
    }
#undef IN
#undef BOTH
#undef GRID_BAR
}

extern "C" void kernel_launch(void* const* d_in, const int* in_sizes, int n_in, void* d_out, int out_size, void* d_ws, size_t ws_size, hipStream_t stream) {
    static int grid = 0;
    if (grid == 0) {
        if (n_in != 23 || in_sizes[0] != T * D || out_size != T * D || ws_size < WS_END) { fprintf(stderr, "kernel_launch: unexpected shapes: n_in %d in0 %d out %d ws %zu\n", n_in, n_in > 0 ? in_sizes[0] : -1, out_size, ws_size); grid = -1; return; }
        int dev = 0, cus = 0, per_cu = 0;
        if (hipGetDevice(&dev) != hipSuccess || hipDeviceGetAttribute(&cus, hipDeviceAttributeMultiprocessorCount, dev) != hipSuccess) { fprintf(stderr, "kernel_launch: device query failed\n"); grid = -1; return; }
        if (hipFuncSetAttribute((const void*)mk_fwd, hipFuncAttributeMaxDynamicSharedMemorySize, LDS_BYTES) != hipSuccess) { fprintf(stderr, "kernel_launch: hipFuncSetAttribute failed\n"); grid = -1; return; }
        if (hipOccupancyMaxActiveBlocksPerMultiprocessor(&per_cu, (const void*)mk_fwd, NWAVES * 64, LDS_BYTES) != hipSuccess || per_cu < 1)
            fprintf(stderr, "kernel_launch: note: occupancy query reports %d workgroups per CU\n", per_cu);
        (void)hipGetLastError();
        grid = cus;
    }
    if (grid < 0) return;
    if (hipMemsetAsync((char*)d_ws + WS_CTL, 0, CTL_ZERO_BYTES, stream) != hipSuccess) { fprintf(stderr, "kernel_launch: memset failed\n"); return; }
    Args a{};
    for (int i = 0; i < 23; ++i) a.in[i] = (const float*)d_in[i];
    a.out = (float*)d_out; a.ws = (unsigned char*)d_ws;
    for (int li = 0; li < N_LAUNCHES; ++li) {
        a.ph_lo = (N_LAUNCHES == PER_PHASE) ? li : 0; a.ph_hi = (N_LAUNCHES == PER_PHASE) ? li + 1 : PER_PHASE;
        hipLaunchKernelGGL(mk_fwd, dim3(grid), dim3(NWAVES * 64), LDS_BYTES, stream, a);
#ifdef HOST_DUP_PHASE
        if (N_LAUNCHES == PER_PHASE && li == HOST_DUP_PHASE) {
#ifndef PROBE_MODE
            if (li == 4) (void)hipMemsetAsync((char*)d_ws + WS_ROWSQ, 0, (size_t)T * 4, stream);
#endif
#ifdef PROBE_MODE
            a.probe = PROBE_MODE;
#endif
            hipLaunchKernelGGL(mk_fwd, dim3(grid), dim3(NWAVES * 64), LDS_BYTES, stream, a); a.probe = 0; }
#endif
        const hipError_t le = hipPeekAtLastError();
        if (le != hipSuccess) { fprintf(stderr, "kernel_launch: launch %d failed: %s\n", li, hipGetErrorName(le)); break; }
    }
}
```

```cpp
#define MK_N_LAUNCHES 1
#include <hip/hip_runtime.h>
#include <cstdio>
#include <cstdint>

#ifndef MK_N_LAUNCHES
#define MK_N_LAUNCHES 1
#endif

namespace pg8 {
#define PG8_LAS __attribute__((address_space(3)))
typedef unsigned short bf16_t;
typedef short bf16x8 __attribute__((ext_vector_type(8)));
typedef float f32x4 __attribute__((ext_vector_type(4)));
typedef unsigned u32x4 __attribute__((ext_vector_type(4)));
typedef unsigned u32x2 __attribute__((ext_vector_type(2)));
constexpr int BM = 256, BK = 64, HALF = 128, HTB = HALF * BK * 2  , STAGE_BYTES = 8 * HTB, NXCD = 8, WGM = 8;

__host__ __device__ __forceinline__ int lds_byte(int r, int c) { const int st = (r >> 4) * 2 + (c >> 5), rr = r & 15, cc = c & 31, ob = rr * 64 + cc * 2; return st * 1024 + (ob ^ (((ob >> 9) & 1) << 5)); }
__host__ __device__ __forceinline__ void stage_rc(int b, int& R, int& C) { const int st = b / 1024, sb = b % 1024, swz = sb ^ (((sb >> 9) & 1) << 5); R = (st >> 1) * 16 + swz / 64; C = (st & 1) * 32 + (swz % 64) / 2; }
__host__ __device__ __forceinline__ int perm32(int rho) { const int n = rho >> 4, i = rho & 15; return 8 * (i >> 2) + 4 * n + (i & 3); }

struct Unit { int pm, pn, br; };

struct StaticOrder {
    int nM, nN, nwg, G, c;
    __host__ __device__ void init(int M, int N, int G_, int c_) { nM = M / BM; nN = N / BM; nwg = nM * nN; G = G_; c = c_; }
    __host__ __device__ bool next(int i, Unit& u) const {
        const long L = (long)i * G + c; if (L >= nwg) return false;
        int wgid = (int)L; { const int q = nwg / NXCD, r = nwg % NXCD, xcd = wgid % NXCD, off = wgid / NXCD; wgid = (xcd < r ? xcd * (q + 1) : r * (q + 1) + (xcd - r) * q) + off; }
        const int nig = WGM * nN, gid = wgid / nig, fm = gid * WGM, gsz = (nM - fm) < WGM ? (nM - fm) : WGM;
        u.pm = fm + ((wgid % nig) % gsz); u.pn = (wgid % nig) / gsz; return true;
    }
};
struct Sched1 {
    StaticOrder so; const char* A; const char* Bt; size_t tstep;
    __device__ __forceinline__ bool next(int i, Unit& u) const { u.br = 0; return so.next(i, u); }
    __device__ __forceinline__ const char* abase(const Unit& u) const { return A + (size_t)u.pm * tstep; }
    __device__ __forceinline__ const char* bbase(const Unit& u) const { return Bt + (size_t)u.pn * tstep; }
    __device__ __forceinline__ void a_ready(const Unit&) const {}
    __device__ __forceinline__ void done(const Unit&) const {}
};
struct Sched3 {
    StaticOrder so; const char* A; const char* Bt; size_t tstep, strideA, strideB;
    __device__ __forceinline__ bool next(int i, Unit& u) const { u.br = i % 3; return so.next(i / 3, u); }
    __device__ __forceinline__ const char* abase(const Unit& u) const { return A + (size_t)u.br * strideA + (size_t)u.pm * tstep; }
    __device__ __forceinline__ const char* bbase(const Unit& u) const { return Bt + (size_t)u.br * strideB + (size_t)u.pn * tstep; }
    __device__ __forceinline__ void a_ready(const Unit&) const {}
    __device__ __forceinline__ void done(const Unit&) const {}
};

typedef float f32x2_t __attribute__((ext_vector_type(2))); typedef __bf16 bf16x2v_t __attribute__((ext_vector_type(2)));
__device__ __forceinline__ unsigned cvt_pk_bf16(float lo, float hi) { const f32x2_t v = {lo, hi}; const bf16x2v_t b = __builtin_convertvector(v, bf16x2v_t); return __builtin_bit_cast(unsigned, b); }
__device__ __forceinline__ u32x4 pack8(const f32x4 a, const f32x4 b) { u32x4 w; w.x = cvt_pk_bf16(a[0], a[1]); w.y = cvt_pk_bf16(a[2], a[3]); w.z = cvt_pk_bf16(b[0], b[1]); w.w = cvt_pk_bf16(b[2], b[3]); return w; }
__device__ __forceinline__ float bflo(unsigned u) { return __builtin_bit_cast(float, u << 16); }
__device__ __forceinline__ float bfhi(unsigned u) { return __builtin_bit_cast(float, u & 0xffff0000u); }


constexpr float RMS_EPS = 1e-6f;

struct EpiProj {
    static constexpr bool PERM = true, AFTER_DRAIN = false, HAS_MID = false;
    const float* rstd; bf16_t *qn, *kn, *pp, *xq, *gates; const float *qg, *kg, *gate_b;
    __device__ __forceinline__ void operator()(const f32x4 (&acc)[2][2][4][2], const Unit& u, int wr, int wc, int fr, int fq) const {
        const int pn = u.pn, row0 = u.pm * BM + wr * 64 + fr, lc0 = 64 * wc + 8 * fq;
        float rsv[2][4];
#pragma unroll
        for (int ai = 0; ai < 2; ++ai)
#pragma unroll
            for (int m = 0; m < 4; ++m) rsv[ai][m] = rstd[row0 + ai * HALF + m * 16];
        if (pn < 4) {
            const bool isq = pn < 2; bf16_t* O = isq ? qn : kn; const float* g = isq ? qg : kg; const float post = isq ? 0.125f : 1.0f;
            f32x4 gv[2][2];
#pragma unroll
            for (int bj = 0; bj < 2; ++bj)
#pragma unroll
                for (int n = 0; n < 2; ++n) gv[bj][n] = *(const f32x4*)(g + 32 * bj + 8 * fq + 4 * n);
            const int colbase = (pn & 1) * 256 + lc0;
#pragma unroll
            for (int ai = 0; ai < 2; ++ai)
#pragma unroll
                for (int m = 0; m < 4; ++m) {
                    const int row = row0 + ai * HALF + m * 16; const float rs = rsv[ai][m];
                    f32x4 v[2][2]; float ss = 0.f;
#pragma unroll
                    for (int bj = 0; bj < 2; ++bj)
#pragma unroll
                        for (int n = 0; n < 2; ++n) { v[bj][n] = acc[ai][bj][m][n] * rs; ss += (v[bj][n][0] * v[bj][n][0] + v[bj][n][1] * v[bj][n][1]) + (v[bj][n][2] * v[bj][n][2] + v[bj][n][3] * v[bj][n][3]); }
                    ss += __shfl_xor(ss, 16); ss += __shfl_xor(ss, 32);
                    const float r = rsqrtf(ss * (1.0f / 64.0f) + RMS_EPS) * post;
#pragma unroll
                    for (int bj = 0; bj < 2; ++bj) *(u32x4*)(O + (size_t)row * 512 + colbase + 32 * bj) = pack8(v[bj][0] * r * gv[bj][0], v[bj][1] * r * gv[bj][1]);
                }
        } else if (pn < 8) {
            bf16_t* O = pn < 6 ? pp : xq; const int colbase = (pn & 1) * 256 + lc0;
#pragma unroll
            for (int ai = 0; ai < 2; ++ai)
#pragma unroll
                for (int m = 0; m < 4; ++m) {
                    const int row = row0 + ai * HALF + m * 16; const float rs = rsv[ai][m];
#pragma unroll
                    for (int bj = 0; bj < 2; ++bj) *(u32x4*)(O + (size_t)row * 512 + colbase + 32 * bj) = pack8(acc[ai][bj][m][0] * rs, acc[ai][bj][m][1] * rs);
                }
        } else {
            const int gcol0 = (pn - 8) * 256 + lc0;
            f32x4 bv[2][2];
#pragma unroll
            for (int bj = 0; bj < 2; ++bj)
#pragma unroll
                for (int n = 0; n < 2; ++n) bv[bj][n] = *(const f32x4*)(gate_b + gcol0 + 32 * bj + 4 * n);
#pragma unroll
            for (int ai = 0; ai < 2; ++ai)
#pragma unroll
                for (int m = 0; m < 4; ++m) {
                    const int row = row0 + ai * HALF + m * 16; const float rs = rsv[ai][m];
#pragma unroll
                    for (int bj = 0; bj < 2; ++bj) {
                        f32x4 o[2];
#pragma unroll
                        for (int n = 0; n < 2; ++n) { const f32x4 z = acc[ai][bj][m][n] * rs + bv[bj][n];
#pragma unroll
                            for (int i = 0; i < 4; ++i) o[n][i] = __builtin_amdgcn_rcpf(1.0f + __expf(-z[i])); }
                        *(u32x4*)(gates + (size_t)row * 3072 + gcol0 + 32 * bj) = pack8(o[0], o[1]);
                    }
                }
        }
    }
};
struct EpiVt {
    static constexpr bool PERM = true, AFTER_DRAIN = false, HAS_MID = false;
    const float* rstd; bf16_t* Vt;
    __device__ __forceinline__ void operator()(const f32x4 (&acc)[2][2][4][2], const Unit& u, int wr, int wc, int fr, int fq) const {
        const int ch0 = u.pm * BM + wr * 64 + fr, tok0 = u.pn * BM + wc * 32 + 8 * fq, b = tok0 >> 13, t0 = tok0 & 8191;
        f32x4 rv[2][2];
#pragma unroll
        for (int bj = 0; bj < 2; ++bj)
#pragma unroll
            for (int n = 0; n < 2; ++n) rv[bj][n] = *(const f32x4*)(rstd + tok0 + bj * HALF + 4 * n);
#pragma unroll
        for (int ai = 0; ai < 2; ++ai)
#pragma unroll
            for (int m = 0; m < 4; ++m) { const int ch = ch0 + ai * HALF + m * 16; bf16_t* rowp = Vt + ((size_t)(b * 512 + ch) * 8192 + t0);
#pragma unroll
                for (int bj = 0; bj < 2; ++bj) *(u32x4*)(rowp + bj * HALF) = pack8(acc[ai][bj][m][0] * rv[bj][0], acc[ai][bj][m][1] * rv[bj][1]); }
    }
};
struct EpiMergeCat {
    static constexpr bool PERM = true, AFTER_DRAIN = false, HAS_MID = true;
    const bf16_t* gates; bf16_t* merged;
    __device__ __forceinline__ void mid(f32x4 (&acc)[2][2][4][2], const Unit& u, int nb  , int wr, int wc, int fr, int fq) const {
        const int row0 = u.pm * BM + wr * 64 + fr, col0 = u.pn * BM + wc * 32 + 8 * fq;
#pragma unroll
        for (int ai = 0; ai < 2; ++ai) {
            u32x4 ga[4][2], gb[4][2];
#pragma unroll
            for (int m = 0; m < 4; ++m)
#pragma unroll
                for (int bj = 0; bj < 2; ++bj) { const bf16_t* gp = gates + (size_t)(row0 + ai * HALF + m * 16) * 3072 + (nb - 1) * 1024 + col0 + bj * HALF;
                    ga[m][bj] = *(const u32x4*)gp; gb[m][bj] = *(const u32x4*)(gp + 1024); }
            __builtin_amdgcn_sched_barrier(0);
#pragma unroll
            for (int m = 0; m < 4; ++m)
#pragma unroll
                for (int bj = 0; bj < 2; ++bj) { const u32x4 a = ga[m][bj], b = gb[m][bj]; f32x4& x0 = acc[ai][bj][m][0]; f32x4& x1 = acc[ai][bj][m][1];
                    x0[0] *= bflo(a.x) * __builtin_amdgcn_rcpf(bflo(b.x)); x0[1] *= bfhi(a.x) * __builtin_amdgcn_rcpf(bfhi(b.x)); x0[2] *= bflo(a.y) * __builtin_amdgcn_rcpf(bflo(b.y)); x0[3] *= bfhi(a.y) * __builtin_amdgcn_rcpf(bfhi(b.y));
                    x1[0] *= bflo(a.z) * __builtin_amdgcn_rcpf(bflo(b.z)); x1[1] *= bfhi(a.z) * __builtin_amdgcn_rcpf(bfhi(b.z)); x1[2] *= bflo(a.w) * __builtin_amdgcn_rcpf(bflo(b.w)); x1[3] *= bfhi(a.w) * __builtin_amdgcn_rcpf(bfhi(b.w)); }
            __builtin_amdgcn_sched_barrier(0);
        }
    }
    __device__ __forceinline__ void operator()(const f32x4 (&acc)[2][2][4][2], const Unit& u, int wr, int wc, int fr, int fq) const {
        const int row0 = u.pm * BM + wr * 64 + fr, col0 = u.pn * BM + wc * 32 + 8 * fq;
#pragma unroll
        for (int ai = 0; ai < 2; ++ai) {
            u32x4 g8[4][2];
#pragma unroll
            for (int m = 0; m < 4; ++m)
#pragma unroll
                for (int bj = 0; bj < 2; ++bj) g8[m][bj] = *(const u32x4*)(gates + (size_t)(row0 + ai * HALF + m * 16) * 3072 + 2048 + col0 + bj * HALF);
            __builtin_amdgcn_sched_barrier(0);
#pragma unroll
            for (int m = 0; m < 4; ++m)
#pragma unroll
                for (int bj = 0; bj < 2; ++bj) { const u32x4 g = g8[m][bj]; f32x4 a = acc[ai][bj][m][0], b = acc[ai][bj][m][1];
                    a[0] *= bflo(g.x); a[1] *= bfhi(g.x); a[2] *= bflo(g.y); a[3] *= bfhi(g.y); b[0] *= bflo(g.z); b[1] *= bfhi(g.z); b[2] *= bflo(g.w); b[3] *= bfhi(g.w);
                    *(u32x4*)(merged + (size_t)(row0 + ai * HALF + m * 16) * 1024 + col0 + bj * HALF) = pack8(a, b); }
            __builtin_amdgcn_sched_barrier(0);
        }
    }
};
struct EpiH {
    static constexpr bool PERM = true, AFTER_DRAIN = false, HAS_MID = false;
    const float* x; float* out; bf16_t* hb; float* rowsq; int noatomic;
    __device__ __forceinline__ void operator()(const f32x4 (&acc)[2][2][4][2], const Unit& u, int wr, int wc, int fr, int fq) const {
        const int row0 = u.pm * BM + wr * 64 + fr, col0 = u.pn * BM + wc * 32 + 8 * fq;
#pragma unroll
        for (int ai = 0; ai < 2; ++ai) {
            f32x4 xv[4][2][2];
#pragma unroll
            for (int m = 0; m < 4; ++m)
#pragma unroll
                for (int bj = 0; bj < 2; ++bj) { const size_t o = (size_t)(row0 + ai * HALF + m * 16) * 1024 + col0 + bj * HALF; xv[m][bj][0] = *(const f32x4*)(x + o); xv[m][bj][1] = *(const f32x4*)(x + o + 4); }
            __builtin_amdgcn_sched_barrier(0);
#pragma unroll
            for (int m = 0; m < 4; ++m) { const int row = row0 + ai * HALF + m * 16; float ss = 0.f;
#pragma unroll
                for (int bj = 0; bj < 2; ++bj) { const size_t o = (size_t)row * 1024 + col0 + bj * HALF;
                    const f32x4 h0 = xv[m][bj][0] + acc[ai][bj][m][0], h1 = xv[m][bj][1] + acc[ai][bj][m][1];
                    *(u32x4*)(hb + o) = pack8(h0, h1);
                    ss += (h0[0] * h0[0] + h0[1] * h0[1]) + (h0[2] * h0[2] + h0[3] * h0[3]) + (h1[0] * h1[0] + h1[1] * h1[1]) + (h1[2] * h1[2] + h1[3] * h1[3]); }
                ss += __shfl_xor(ss, 16); ss += __shfl_xor(ss, 32);
                if (fq == 0 && !noatomic) atomicAdd(rowsq + row, ss); }
            __builtin_amdgcn_sched_barrier(0);
        }
    }
};
struct EpiQ {
    static constexpr bool PERM = true, AFTER_DRAIN = false, HAS_MID = false;
    const float* rowsq; bf16_t* qb;
    __device__ __forceinline__ void operator()(const f32x4 (&acc)[2][2][4][2], const Unit& u, int wr, int wc, int fr, int fq) const {
        const int row0 = u.pm * BM + wr * 64 + fr, col0 = u.pn * BM + wc * 32 + 8 * fq;
        float rq[2][4];
#pragma unroll
        for (int ai = 0; ai < 2; ++ai)
#pragma unroll
            for (int m = 0; m < 4; ++m) rq[ai][m] = rowsq[row0 + ai * HALF + m * 16];
#pragma unroll
        for (int ai = 0; ai < 2; ++ai)
#pragma unroll
            for (int m = 0; m < 4; ++m) { const int row = row0 + ai * HALF + m * 16; const float r = rsqrtf(rq[ai][m] * (1.0f / 1024.0f) + RMS_EPS);
#pragma unroll
                for (int bj = 0; bj < 2; ++bj) *(u32x4*)(qb + (size_t)row * 2048 + col0 + bj * HALF) = pack8(acc[ai][bj][m][0] * r, acc[ai][bj][m][1] * r); }
    }
};

template <class Epi, class Sched, bool ALIGN_EPI = false, bool SP2 = false>
__device__ __forceinline__ void gemm_phase(PG8_LAS unsigned char* lds, const int K, const Sched& S, const Epi& E) {
    const int tid = threadIdx.x, wid = __builtin_amdgcn_readfirstlane(tid >> 6), lane = tid & 63, wr = wid >> 2, wc = wid & 3, fr = lane & 15, fq = lane >> 4;
    const int nt = K / BK;
    unsigned voffA[2], voffB[2];
#pragma unroll
    for (int i = 0; i < 2; ++i) { int R, C; stage_rc(tid * 16 + i * 8192, R, C); const int Rb = Epi::PERM ? ((R & ~31) + perm32(R & 31)) : R;
        voffA[i] = (unsigned)(R * K + C) * 2u; voffB[i] = (unsigned)(Rb * K + C) * 2u; }
    const size_t kstep = (size_t)(BK * 2);
    const size_t hstep = (size_t)HALF * K * 2;
    const size_t tstep = 2 * hstep;
    const unsigned ldsw = (unsigned)wid * 1024u;
    const int aoff = lds_byte(wr * 64 + fr, fq * 8), boff = lds_byte(wc * 32 + fr, fq * 8);
#define PG8_SA(b, h) (((b) * 2 + (h)) * HTB)
#define PG8_SB(b, h) ((4 + (b) * 2 + (h)) * HTB)
#define PG8_STAGE(bufoff, gbase, voff) do { _Pragma("unroll") for (int _i = 0; _i < 2; ++_i) \
        __builtin_amdgcn_global_load_lds((const unsigned*)((const char*)(gbase) + (voff)[_i]), (PG8_LAS unsigned*)(lds + (bufoff) + ldsw + _i * 8192), 16, 0, 0); } while (0)
#define PG8_LDA(dst, b, h) do { _Pragma("unroll") for (int m = 0; m < 4; ++m) _Pragma("unroll") for (int k = 0; k < 2; ++k) dst[m][k] = *(const PG8_LAS bf16x8*)(lds + PG8_SA(b, h) + aoff + m * 2048 + k * 1024); } while (0)
#define PG8_LDB(dst, b, h) do { _Pragma("unroll") for (int n = 0; n < 2; ++n) _Pragma("unroll") for (int k = 0; k < 2; ++k) dst[n][k] = *(const PG8_LAS bf16x8*)(lds + PG8_SB(b, h) + boff + n * 2048 + k * 1024); } while (0)
#define PG8_MMA(ai, bj, At, Bt) do { __builtin_amdgcn_s_setprio(1); _Pragma("unroll") for (int m = 0; m < 4; ++m) _Pragma("unroll") for (int n = 0; n < 2; ++n) _Pragma("unroll") for (int k = 0; k < 2; ++k) \
        acc[ai][bj][m][n] = __builtin_amdgcn_mfma_f32_16x16x32_bf16(Bt[n][k], At[m][k], acc[ai][bj][m][n], 0, 0, 0); __builtin_amdgcn_s_setprio(0); } while (0)
#define PG8_WAIT_V(n) asm volatile("s_waitcnt vmcnt(" #n ")" ::: "memory")
#define PG8_WAIT_L(n) asm volatile("s_waitcnt lgkmcnt(" #n ")" ::: "memory")
#define PG8_BAR __builtin_amdgcn_s_barrier()
#define PG8_SCHED __builtin_amdgcn_sched_barrier(0)
    Unit cur, nxt; int ui = 0;
    if (!S.next(0, cur)) return;
    f32x4 acc[2][2][4][2];
#pragma unroll
    for (int a = 0; a < 2; ++a)
#pragma unroll
        for (int b = 0; b < 2; ++b)
#pragma unroll
            for (int m = 0; m < 4; ++m)
#pragma unroll
                for (int n = 0; n < 2; ++n) acc[a][b][m][n] = (f32x4){0.f, 0.f, 0.f, 0.f};
    bf16x8 At[4][2], B0[2][2], B1[2][2];
    const char* cA = S.abase(cur); const char* cB = S.bbase(cur);
    S.a_ready(cur);
    if constexpr (SP2) {
        PG8_STAGE(PG8_SB(0, 0), cB, voffB); PG8_STAGE(PG8_SB(0, 1), cB + hstep, voffB); PG8_STAGE(PG8_SA(0, 0), cA, voffA); PG8_STAGE(PG8_SA(0, 1), cA + hstep, voffA);
        if (wr == 1) PG8_BAR;
        PG8_WAIT_V(2); PG8_BAR;
        PG8_STAGE(PG8_SB(1, 0), cB + kstep, voffB); PG8_STAGE(PG8_SA(1, 0), cA + kstep, voffA); PG8_STAGE(PG8_SB(1, 1), cB + hstep + kstep, voffB);
        PG8_WAIT_V(6); PG8_BAR;
    } else {
        PG8_STAGE(PG8_SB(0, 0), cB, voffB); PG8_STAGE(PG8_SA(0, 0), cA, voffA); PG8_STAGE(PG8_SB(0, 1), cB + hstep, voffB); PG8_STAGE(PG8_SA(0, 1), cA + hstep, voffA);
        if (wr == 1) PG8_BAR;
        PG8_WAIT_V(4); PG8_BAR;
        PG8_STAGE(PG8_SB(1, 0), cB + kstep, voffB); PG8_STAGE(PG8_SA(1, 0), cA + kstep, voffA); PG8_STAGE(PG8_SB(1, 1), cB + hstep + kstep, voffB);
        PG8_WAIT_V(6); PG8_BAR;
    }
    for (;;) {
        const bool has_next = S.next(ui + 1, nxt);
        const char* nA = has_next ? S.abase(nxt) : cA; const char* nB = has_next ? S.bbase(nxt) : cB;
        for (int t = 0; t < nt; t += 2) {
            if constexpr (Epi::HAS_MID) { if (t == 8 || t == 16) E.mid(acc, cur, t >> 3, wr, wc, fr, fq); }
            const bool last = (t == nt - 2);
            const char* a1 = cA + (size_t)(t + 1) * kstep;
            const char* a2 = last ? nA : cA + (size_t)(t + 2) * kstep; const char* b2 = last ? nB : cB + (size_t)(t + 2) * kstep;
            const char* a3 = a2 + kstep; const char* b3 = b2 + kstep;
            if (last && has_next) S.a_ready(nxt);
            if constexpr (SP2) {
            PG8_LDB(B0, 0, 0); PG8_LDB(B1, 0, 1); PG8_SCHED; PG8_LDA(At, 0, 0); PG8_STAGE(PG8_SA(1, 1), a1 + hstep, voffA);
            PG8_WAIT_V(8); PG8_WAIT_L(0); PG8_BAR; PG8_MMA(0, 0, At, B0); PG8_MMA(0, 1, At, B1); PG8_BAR; PG8_SCHED;
            PG8_LDA(At, 0, 1); PG8_STAGE(PG8_SB(0, 0), b2, voffB); PG8_STAGE(PG8_SB(0, 1), b2 + hstep, voffB); PG8_STAGE(PG8_SA(0, 0), a2, voffA);
            PG8_WAIT_V(8); PG8_WAIT_L(0); PG8_BAR; PG8_MMA(1, 0, At, B0); PG8_MMA(1, 1, At, B1); PG8_BAR; PG8_SCHED;
            PG8_LDB(B0, 1, 0); PG8_LDB(B1, 1, 1); PG8_SCHED; PG8_LDA(At, 1, 0); PG8_STAGE(PG8_SA(0, 1), a2 + hstep, voffA);
            PG8_WAIT_V(8); PG8_WAIT_L(0); PG8_BAR; PG8_MMA(0, 0, At, B0); PG8_MMA(0, 1, At, B1); PG8_BAR; PG8_SCHED;
            PG8_LDA(At, 1, 1); PG8_STAGE(PG8_SB(1, 0), b3, voffB); PG8_STAGE(PG8_SB(1, 1), b3 + hstep, voffB); PG8_STAGE(PG8_SA(1, 0), a3, voffA);
            PG8_WAIT_V(8); PG8_WAIT_L(0); PG8_BAR; PG8_MMA(1, 0, At, B0); PG8_MMA(1, 1, At, B1); PG8_BAR; PG8_SCHED;
            } else {
            PG8_LDB(B0, 0, 0); PG8_SCHED; PG8_LDA(At, 0, 0); PG8_STAGE(PG8_SA(1, 1), a1 + hstep, voffA);
            PG8_WAIT_L(8); PG8_BAR; PG8_WAIT_L(0); PG8_MMA(0, 0, At, B0); PG8_BAR; PG8_SCHED;
            PG8_LDB(B1, 0, 1); PG8_STAGE(PG8_SB(0, 0), b2, voffB);
            PG8_BAR; PG8_WAIT_L(0); PG8_MMA(0, 1, At, B1); PG8_BAR;
            PG8_LDA(At, 0, 1); PG8_STAGE(PG8_SA(0, 0), a2, voffA);
            PG8_BAR; PG8_WAIT_L(0); PG8_MMA(1, 0, At, B0); PG8_BAR; PG8_SCHED;
            PG8_STAGE(PG8_SB(0, 1), b2 + hstep, voffB);
            PG8_WAIT_V(6); PG8_BAR; PG8_MMA(1, 1, At, B1); PG8_BAR;
            PG8_LDB(B0, 1, 0); PG8_SCHED; PG8_LDA(At, 1, 0); PG8_STAGE(PG8_SA(0, 1), a2 + hstep, voffA);
            PG8_WAIT_L(8); PG8_BAR; PG8_WAIT_L(0); PG8_MMA(0, 0, At, B0); PG8_BAR; PG8_SCHED;
            PG8_LDB(B1, 1, 1); PG8_STAGE(PG8_SB(1, 0), b3, voffB);
            PG8_BAR; PG8_WAIT_L(0); PG8_MMA(0, 1, At, B1); PG8_BAR;
            PG8_LDA(At, 1, 1); PG8_STAGE(PG8_SA(1, 0), a3, voffA);
            PG8_BAR; PG8_WAIT_L(0); PG8_MMA(1, 0, At, B0); PG8_BAR; PG8_SCHED;
            PG8_STAGE(PG8_SB(1, 1), b3 + hstep, voffB);
            PG8_WAIT_V(6); PG8_BAR; PG8_MMA(1, 1, At, B1); PG8_BAR;
            }
        }
        if constexpr (ALIGN_EPI) { if (wr == 0) PG8_BAR; }
        if constexpr (!Epi::AFTER_DRAIN) { E(acc, cur, wr, wc, fr, fq); S.done(cur); }
        if (!has_next) break;
#pragma unroll
        for (int a = 0; a < 2; ++a)
#pragma unroll
            for (int b = 0; b < 2; ++b)
#pragma unroll
                for (int m = 0; m < 4; ++m)
#pragma unroll
                    for (int n = 0; n < 2; ++n) acc[a][b][m][n] = (f32x4){0.f, 0.f, 0.f, 0.f};
        cur = nxt; cA = nA; cB = nB; ++ui;
        if constexpr (ALIGN_EPI) { if (wr == 1) PG8_BAR; }
    }
    PG8_WAIT_V(0);
    if constexpr (!ALIGN_EPI) { if (wr == 0) PG8_BAR; }
    PG8_BAR;
    if constexpr (Epi::AFTER_DRAIN) { E.fused(acc, cur, wr, wc, fr, fq, lds, wid, lane); S.done(cur); }
#undef PG8_SA
#undef PG8_SB
#undef PG8_STAGE
#undef PG8_LDA
#undef PG8_LDB
#undef PG8_MMA
#undef PG8_WAIT_V
#undef PG8_WAIT_L
#undef PG8_BAR
#undef PG8_SCHED
}
}

constexpr int NWAVES = 8;
constexpr int N_LAUNCHES = MK_N_LAUNCHES;
constexpr int PER_PHASE = 9;
constexpr int NBATCH = 4, SEQ = 8192, D = 1024, T = NBATCH * SEQ, MEMLEN = 256, NMEMTOK = NBATCH * MEMLEN;
constexpr int IN_MAIN = 5120;
constexpr int NEXP = 16384;

constexpr size_t MiB = 1u << 20;
constexpr size_t WS_CTL = 0, CTL_ZERO_BYTES = 512 * 1024;
constexpr size_t WS_ROWSQ = 256 * 1024;
constexpr size_t WS_WIN = 1 * MiB, WS_WV = 11 * MiB, WS_WKV = 12 * MiB, WS_WBR = 14 * MiB, WS_WOUT = 17 * MiB, WS_WQ = 19 * MiB, WS_KEYS = 23 * MiB, WS_PWT = 23 * MiB + 512 * 1024;
constexpr size_t WS_MEMN = 24 * MiB, WS_KMEM = 26 * MiB, WS_VTMEM = 27 * MiB, WS_RSTDX = 28 * MiB, WS_SU = 28 * MiB + 256 * 1024  , WS_SV = 28 * MiB + 512 * 1024  ;
constexpr size_t WS_U8 = 32 * MiB, WS_V8 = 48 * MiB;
constexpr size_t WS_QN = 96 * MiB, WS_KN = 128 * MiB, WS_VT = 160 * MiB, WS_PP = 192 * MiB, WS_XQ = 224 * MiB, WS_GATE = 256 * MiB, WS_END = 448 * MiB;
constexpr size_t WS_MERGED = WS_QN;
constexpr size_t WS_HB = WS_VT;
constexpr size_t WS_QB = WS_GATE;
constexpr size_t WS_TE = WS_GATE + 128 * MiB, WS_TW = WS_TE + 16 * MiB;
constexpr size_t WS_HQ = WS_TW + 16 * MiB;
constexpr size_t WS_HS = 28 * MiB + 768 * 1024;
constexpr size_t WS_AW = WS_MERGED;
constexpr size_t OUT_XB = 0, OUT_YNA = 0, OUT_YPOOL = 512 * 2, OUT_YXA = 1024 * 2;
constexpr int CW_TMO = 0, CW_BAR = 4096, CW_TICKET = 8192;

constexpr int RING_OFF = 0, RING_BYTES = 131072;
constexpr int LDSCTL_OFF = RING_BYTES, MISC_OFF = LDSCTL_OFF + 320;
constexpr int LDS_BYTES = 147456;

#define GAS __attribute__((address_space(1)))
#define LAS __attribute__((address_space(3)))
typedef unsigned short bf16;
typedef unsigned v4u __attribute__((ext_vector_type(4)));
typedef unsigned v2u __attribute__((ext_vector_type(2)));
typedef float f32x4 __attribute__((ext_vector_type(4)));
typedef short bf16x8 __attribute__((ext_vector_type(8)));
typedef __bf16 bf16x2_t __attribute__((ext_vector_type(2)));
typedef GAS unsigned gu32;
#define LDS_WAIT() asm volatile("s_waitcnt lgkmcnt(0)" ::: "memory")
#define VM_WAIT() asm volatile("s_waitcnt vmcnt(0)" ::: "memory")
__device__ __forceinline__ unsigned f2bf(float f) { unsigned u = __builtin_bit_cast(unsigned, f); return (u + 0x7fffu + ((u >> 16) & 1u)) >> 16; }
__device__ __forceinline__ unsigned pk2(float lo, float hi) { return f2bf(lo) | (f2bf(hi) << 16); }
__device__ __forceinline__ float bflo(unsigned u) { return __builtin_bit_cast(float, u << 16); }
__device__ __forceinline__ float bfhi(unsigned u) { return __builtin_bit_cast(float, u & 0xffff0000u); }
__device__ __forceinline__ float bf1(short s) { return __builtin_bit_cast(float, ((unsigned)(unsigned short)s) << 16); }
__device__ __forceinline__ f32x4 mfma16(bf16x8 a, bf16x8 b, f32x4 c) { return __builtin_amdgcn_mfma_f32_16x16x32_bf16(a, b, c, 0, 0, 0); }
__device__ __forceinline__ float wave_sum(float v) {
#pragma unroll
    for (int o = 1; o < 64; o <<= 1) v += __shfl_xor(v, o);
    return v;
}

#define XB_TMO      128
#define XB_XCNT(j)  (256  + 64 * (j))
#define XB_XSUB(j)  (1280 + 64 * (j))
#define XB_XGEN(j)  (2304 + 64 * (j))
#define XB_TOP      3328
#define XB_TOPGEN   3392
#define XCD_BAR_WORDS 3456
#define XB_SPIN_CAP (1u << 18)

__device__ __forceinline__ unsigned xb_ld(unsigned* p)              { return __hip_atomic_load(p, __ATOMIC_RELAXED, __HIP_MEMORY_SCOPE_AGENT); }
__device__ __forceinline__ unsigned xb_add(unsigned* p, unsigned v) { return __hip_atomic_fetch_add(p, v, __ATOMIC_RELAXED, __HIP_MEMORY_SCOPE_AGENT); }
__device__ __forceinline__ unsigned xb_xcc_id() { return (unsigned)__builtin_amdgcn_s_getreg((3 << 11) | 20) & 0xFu; }
#define XB_SPIN(cond, bar) do { unsigned _sp = 0; while (cond) { __builtin_amdgcn_s_sleep(1); \
    if ((++_sp & 255u) == 0u) { if (xb_ld(&(bar)[XB_TMO])) break; if (_sp > XB_SPIN_CAP) { atomicAdd(&(bar)[XB_TMO], 1u); break; } } } } while (0)

struct XcdBarrier {
    unsigned* bar; unsigned x;
    volatile LAS unsigned* st;
};

__device__ __forceinline__ XcdBarrier xcd_barrier_post(unsigned* bar, volatile LAS unsigned* st) {
    XcdBarrier b; b.bar = bar; b.x = xb_xcc_id(); b.st = st;
    if (threadIdx.x == 0) (void)xb_add(&bar[XB_XCNT(b.x)], 1u);
    return b;
}
__device__ __forceinline__ void xcd_barrier_complete(unsigned* bar, unsigned x, unsigned& nloc, unsigned& nx) {
    const unsigned G = gridDim.x * gridDim.y * gridDim.z;
    unsigned sum, cnt, mine, sp = 0u;
    for (;;) {
        sum = 0u; cnt = 0u; mine = 0u;
#pragma unroll
        for (unsigned j = 0; j < 16; ++j) { const unsigned c = xb_ld(&bar[XB_XCNT(j)]); sum += c; cnt += (c > 0u) ? 1u : 0u; mine = (j == x) ? c : mine; }
        if (sum == G) break;
        __builtin_amdgcn_s_sleep(1);
        if ((++sp & 255u) == 0u) { if (xb_ld(&bar[XB_TMO])) break; if (sp > XB_SPIN_CAP) { atomicAdd(&bar[XB_TMO], 1u); break; } }
    }
    nloc = mine > 0u ? mine : 1u; nx = cnt > 0u ? cnt : 1u;
}

__device__ __forceinline__ void xcd_barrier(const XcdBarrier& b) {
    asm volatile("s_waitcnt vmcnt(0)" ::: "memory");
    __syncthreads();
    if (threadIdx.x == 0) {
        unsigned* bar = b.bar;
        __builtin_amdgcn_s_waitcnt(0);
        unsigned nloc = b.st[0], nx = b.st[1];
        if (nloc == 0u) { xcd_barrier_complete(bar, b.x, nloc, nx); b.st[0] = nloc; b.st[1] = nx; }
        const unsigned old = xb_add(&bar[XB_XSUB(b.x)], 1u);
        const unsigned gen = old / nloc;
        if (old + 1u == (gen + 1u) * nloc) {
            __builtin_amdgcn_fence(__ATOMIC_RELEASE, "agent");
            asm volatile("s_waitcnt vmcnt(0)" ::: "memory");
            const unsigned og = xb_add(&bar[XB_TOP], 1u);
            const unsigned tg = og / nx;
            if (og + 1u == (tg + 1u) * nx) xb_add(&bar[XB_TOPGEN], 1u);
            else XB_SPIN(xb_ld(&bar[XB_TOPGEN]) == tg, bar);
            __builtin_amdgcn_fence(__ATOMIC_ACQUIRE, "agent");
            xb_add(&bar[XB_XGEN(b.x)], 1u);
            asm volatile("s_waitcnt vmcnt(0)" ::: "memory");
        } else {
            XB_SPIN(xb_ld(&bar[XB_XGEN(b.x)]) == gen, bar);
            __builtin_amdgcn_fence(__ATOMIC_ACQUIRE, "agent");
            asm volatile("s_waitcnt vmcnt(0)" ::: "memory");
        }
    }
    __syncthreads();
}

struct Frame {
    LAS unsigned char* lds;
    volatile LAS unsigned* MISC;
    gu32* ctl;
    int tid, lane, wave, vcu, G;
    float* out; unsigned char* ws;
};
struct Args { const float* in[23]; float* out; unsigned char* ws; int ph_lo, ph_hi, probe, pad; };
enum { I_X = 0, I_MEM, I_MIXG, I_MEMG, I_WIN, I_GATEB, I_WKV, I_NAQG, I_NAKG, I_RPB, I_POOLW, I_POOLSC, I_XAQG, I_XAKG, I_WB0, I_WB1, I_WB2, I_WOUT, I_FFNG, I_WQ, I_KEYS, I_PU, I_PV };

__device__ __forceinline__ void p0_transpose_item(const float* W, int K, int N, int k0, int n0, bf16* dst, const float* kscale, LAS float* scr, int lane, int dpitch = 0) {
    if (dpitch == 0) dpitch = K;
#pragma unroll 8
    for (int i = 0; i < 32; ++i) { const int kk = 2 * i + (lane >> 5); float v = W[(size_t)(k0 + kk) * N + n0 + (lane & 31)]; if (kscale) v *= kscale[k0 + kk]; scr[kk * 33 + (lane & 31)] = v; }
    LDS_WAIT(); asm volatile("" ::: "memory");
    const int c = lane & 7;
#pragma unroll
    for (int j = 0; j < 4; ++j) { const int n = (lane >> 3) + 8 * j; const LAS float* s = scr + (8 * c) * 33 + n;
        v4u o; o.x = pk2(s[0 * 33], s[1 * 33]); o.y = pk2(s[2 * 33], s[3 * 33]); o.z = pk2(s[4 * 33], s[5 * 33]); o.w = pk2(s[6 * 33], s[7 * 33]);
        *(GAS v4u*)(dst + (size_t)n * dpitch + k0 + 8 * c) = o; }
    LDS_WAIT(); asm volatile("" ::: "memory");
}
__device__ __forceinline__ void cvt_row1024(const float* src, bf16* dst, const float* colscale, float rowscale, int lane) {
    const GAS f32x4* xr = (const GAS f32x4*)src + lane; GAS unsigned long long* o8 = (GAS unsigned long long*)dst + lane;
#pragma unroll
    for (int j = 0; j < 4; ++j) { f32x4 v = xr[64 * j] * rowscale; if (colscale) v = v * ((const GAS f32x4*)colscale)[lane + 64 * j];
        o8[64 * j] = (unsigned long long)pk2(v.x, v.y) | ((unsigned long long)pk2(v.z, v.w) << 32); }
}
__device__ __forceinline__ float row_rstd1024(const float* src, int lane) {
    const GAS f32x4* xr = (const GAS f32x4*)src + lane; float s = 0.f;
#pragma unroll
    for (int j = 0; j < 4; ++j) { const f32x4 v = xr[64 * j]; s += (v.x * v.x + v.y * v.y) + (v.z * v.z + v.w * v.w); }
    return rsqrtf(wave_sum(s) * (1.0f / 1024.0f) + 1e-6f);
}
__device__ __forceinline__ void p0_prologue(Frame& F, const Args& A) {
    LAS float* scr = (LAS float*)(F.lds + RING_OFF + F.wave * 16384);
    const int gw = F.vcu * NWAVES + F.wave, NGW = F.G * NWAVES, lane = F.lane;
    unsigned char* ws = F.ws;
    constexpr int I_IN = 16 * 176, I_KV = 16 * 32, I_BR = 8 * 32, I_OUT = 16 * 32, I_Q = 16 * 64;
    constexpr int NITEMS = I_IN + I_KV + 3 * I_BR + I_OUT + I_Q;
    for (int it = gw; it < NITEMS; it += NGW) {
        int r = it;
        if (r < I_IN) { const int kb = r / 176, nb = r % 176, n0 = 32 * nb; bf16* dst;
            if (n0 >= 1024 && n0 < 1536) dst = (bf16*)(ws + WS_WV) + (size_t)(n0 - 1024) * 1024;
            else { const int np = n0 < 1024 ? n0 : n0 - 512, t = np >> 8, w = np & 255, wc = w >> 6, bj = (w >> 5) & 1; dst = (bf16*)(ws + WS_WIN) + (size_t)(256 * t + 128 * bj + 32 * wc) * 1024; }
            p0_transpose_item(A.in[I_WIN], 1024, 5632, 64 * kb, n0, dst, A.in[I_MIXG], scr, lane); continue; }
        r -= I_IN;
        if (r < I_KV) { const int kb = r / 32, nb = r % 32; p0_transpose_item(A.in[I_WKV], 1024, 1024, 64 * kb, 32 * nb, (bf16*)(ws + WS_WKV) + (size_t)(32 * nb) * 1024, nullptr, scr, lane); continue; }
        r -= I_KV;
        if (r < 3 * I_BR) { const int br = r / I_BR, rr = r % I_BR, kb = rr / 32, nb = rr % 32; const float* W = br == 0 ? A.in[I_WB0] : (br == 1 ? A.in[I_WB1] : A.in[I_WB2]);
            p0_transpose_item(W, 512, 1024, 64 * kb, 32 * nb, (bf16*)(ws + WS_WBR) + (size_t)(32 * nb) * 1536 + br * 512, nullptr, scr, lane, 1536); continue; }
        r -= 3 * I_BR;
        if (r < I_OUT) { const int kb = r / 32, nb = r % 32; p0_transpose_item(A.in[I_WOUT], 1024, 1024, 64 * kb, 32 * nb, (bf16*)(ws + WS_WOUT) + (size_t)(32 * nb) * 1024, nullptr, scr, lane); continue; }
        r -= I_OUT;
        { const int kb = r / 64, nb = r % 64; p0_transpose_item(A.in[I_WQ], 1024, 2048, 64 * kb, 32 * nb, (bf16*)(ws + WS_WQ) + (size_t)(32 * nb) * 1024, A.in[I_FFNG], scr, lane); }
    }
    { bf16* xb = (bf16*)((unsigned char*)F.out + OUT_XB); float* rstdx = (float*)(ws + WS_RSTDX);
      for (int m0 = 4 * gw; m0 < T; m0 += 4 * NGW) {
          f32x4 v[4][4];
#pragma unroll
          for (int r = 0; r < 4; ++r)
#pragma unroll
              for (int j = 0; j < 4; ++j) v[r][j] = ((const GAS f32x4*)(A.in[I_X] + (size_t)(m0 + r) * D))[lane + 64 * j];
#pragma unroll
          for (int r = 0; r < 4; ++r) { float s = 0.f;
#pragma unroll
              for (int j = 0; j < 4; ++j) s += (v[r][j].x * v[r][j].x + v[r][j].y * v[r][j].y) + (v[r][j].z * v[r][j].z + v[r][j].w * v[r][j].w);
              const float rs = rsqrtf(wave_sum(s) * (1.0f / 1024.0f) + 1e-6f);
              GAS unsigned long long* o8 = (GAS unsigned long long*)(xb + (size_t)(m0 + r) * D) + lane;
#pragma unroll
              for (int j = 0; j < 4; ++j) o8[64 * j] = (unsigned long long)pk2(v[r][j].x, v[r][j].y) | ((unsigned long long)pk2(v[r][j].z, v[r][j].w) << 32);
              if (lane == 0) rstdx[m0 + r] = rs; } } }
    for (int m = gw; m < NMEMTOK; m += NGW) { const float* xr = A.in[I_MEM] + (size_t)m * D; const float rs = row_rstd1024(xr, lane); cvt_row1024(xr, (bf16*)(ws + WS_MEMN) + (size_t)m * D, A.in[I_MEMG], rs, lane); }
    for (int mb = 4 * gw; mb < 2 * NEXP; mb += 4 * NGW) {
        const bool isu = mb < NEXP; const int e0 = isu ? mb : mb - NEXP;
        f32x4 v[4][4];
#pragma unroll
        for (int r = 0; r < 4; ++r) { const GAS f32x4* src = (const GAS f32x4*)((isu ? A.in[I_PU] : A.in[I_PV]) + (size_t)(e0 + r) * D) + 4 * lane;
#pragma unroll
            for (int d = 0; d < 4; ++d) v[r][d] = src[d]; }
        f32x4 gv[4];
#pragma unroll
        for (int d = 0; d < 4; ++d) gv[d] = isu ? ((const GAS f32x4*)A.in[I_FFNG])[4 * lane + d] : (f32x4){1.f, 1.f, 1.f, 1.f};
#pragma unroll
        for (int r = 0; r < 4; ++r) { const int e = e0 + r; float mx = 0.f;
#pragma unroll
            for (int d = 0; d < 4; ++d) { v[r][d] = v[r][d] * gv[d]; mx = fmaxf(mx, fmaxf(fmaxf(fabsf(v[r][d].x), fabsf(v[r][d].y)), fmaxf(fabsf(v[r][d].z), fabsf(v[r][d].w)))); }
#pragma unroll
            for (int o = 1; o < 64; o <<= 1) mx = fmaxf(mx, __shfl_xor(mx, o));
            const float inv = mx > 0.f ? 127.0f / mx : 0.f;
            v4u w;
#pragma unroll
            for (int d = 0; d < 4; ++d) { const unsigned b0 = (unsigned)(int)rintf(v[r][d].x * inv) & 0xffu, b1 = (unsigned)(int)rintf(v[r][d].y * inv) & 0xffu,
                                                         b2 = (unsigned)(int)rintf(v[r][d].z * inv) & 0xffu, b3 = (unsigned)(int)rintf(v[r][d].w * inv) & 0xffu;
                w[d] = b0 | (b1 << 8) | (b2 << 16) | (b3 << 24); }
            if (isu) ((GAS v4u*)(ws + WS_U8))[(size_t)e * 64 + lane] = w;
            else *(GAS v4u*)(ws + WS_V8 + (size_t)(lane >> 3) * (2 * MiB) + (size_t)e * 128 + (lane & 7) * 16) = w;
            if (lane == 0) ((float*)(ws + WS_SU))[2 * e + (isu ? 0 : 1)] = mx * (1.0f / 127.0f); }
    }
    for (int m = gw * 64 + lane; m < T; m += NGW * 64) ((float*)(ws + WS_ROWSQ))[m] = 0.f;
    for (int m = gw; m < 256; m += NGW) cvt_row1024(A.in[I_KEYS] + (size_t)m * 1024, (bf16*)(ws + WS_KEYS) + (size_t)m * 1024, nullptr, 1.0f, lane);
    for (int m = gw; m < 1024; m += NGW) { const int gd = m >> 1, c = (m & 1) * 64 + lane, g = gd >> 7, d = gd & 127;
        const float v = A.in[I_POOLW][(size_t)(g * 128 + c) * 128 + d] * A.in[I_POOLSC][gd];
        ((bf16*)(ws + WS_PWT))[(size_t)gd * 128 + c] = (bf16)f2bf(v); }
}

__device__ __forceinline__ void memkv_tile(const bf16* memn, const bf16* wkvT, const float* kg, const float* qg, bf16* kmem, bf16* vtmem, int tile, int lane) {
    const int q = lane & 15, hi = lane >> 4, rg = tile >> 3, cg = tile & 7, r0 = rg * 16, c0 = cg * 128;
    f32x4 acc[8];
#pragma unroll
    for (int i = 0; i < 8; ++i) acc[i] = (f32x4){0.f, 0.f, 0.f, 0.f};
    const bf16* ap = memn + (size_t)(r0 + q) * 1024 + 8 * hi; const bf16* bp = wkvT + (size_t)(c0 + q) * 1024 + 8 * hi;
#pragma unroll 1
    for (int kb = 0; kb < 8; ++kb) {
        bf16x8 a[4], b[4][8];
#pragma unroll
        for (int k4 = 0; k4 < 4; ++k4) { a[k4] = *(const bf16x8*)(ap + 32 * (4 * kb + k4));
#pragma unroll
            for (int nf = 0; nf < 8; ++nf) b[k4][nf] = *(const bf16x8*)(bp + (size_t)(16 * nf) * 1024 + 32 * (4 * kb + k4)); }
        __builtin_amdgcn_sched_barrier(0);
#pragma unroll
        for (int k4 = 0; k4 < 4; ++k4)
#pragma unroll
            for (int nf = 0; nf < 8; ++nf) acc[nf] = mfma16(a[k4], b[k4][nf], acc[nf]);
        __builtin_amdgcn_sched_barrier(0);
    }
    if (cg < 4) {
        float rr[4];
#pragma unroll
        for (int g = 0; g < 4; ++g) { float ss = 0.f;
#pragma unroll
            for (int nf = 0; nf < 8; ++nf) ss += acc[nf][g] * acc[nf][g];
            ss += __shfl_xor(ss, 1); ss += __shfl_xor(ss, 2); ss += __shfl_xor(ss, 4); ss += __shfl_xor(ss, 8);
            rr[g] = rsqrtf(ss * (1.0f / 128.0f) + 1e-6f); }
#pragma unroll
        for (int nf = 0; nf < 8; ++nf) { const int d = 16 * nf + q; const float gs = kg[d] * qg[d];
#pragma unroll
            for (int g = 0; g < 4; ++g) kmem[(size_t)(r0 + 4 * hi + g) * 512 + cg * 128 + d] = (bf16)f2bf(acc[nf][g] * rr[g] * gs); }
    } else {
        const int h = cg - 4, b = r0 >> 8, key0 = (r0 & 255) + 4 * hi;
#pragma unroll
        for (int nf = 0; nf < 8; ++nf) { const int d = 16 * nf + q; v2u w; w.x = pk2(acc[nf][0], acc[nf][1]); w.y = pk2(acc[nf][2], acc[nf][3]);
            *(v2u*)(vtmem + (size_t)(b * 512 + h * 128 + d) * 256 + key0) = w; }
    }
}

__device__ __forceinline__ void na_item(const bf16* __restrict__ qn, const bf16* __restrict__ kn, const bf16* __restrict__ vt, const LAS float* rpl, bf16* __restrict__ yna,
                                        int b, int r, int jb, int h, int lane) {
    const int q = lane & 15, hi = lane >> 4;
    int rs = r - 4; rs = rs < 0 ? 0 : (rs > 120 ? 120 : rs);
    int kb0 = jb * 16 - 8; kb0 = kb0 < 0 ? 0 : (kb0 > 32 ? 32 : kb0);
    const int qcol = jb * 16 + q; int cs = qcol - 8; cs = cs < 0 ? 0 : (cs > 48 ? 48 : cs);
    const size_t tokq = (size_t)b * SEQ + r * 64 + qcol;
    const bf16* qp = qn + tokq * 512 + h * 64 + 8 * hi;
    const bf16x8 qf0 = *(const bf16x8*)qp, qf1 = *(const bf16x8*)(qp + 32);
    const int kq = 8 * (q >> 2) + (q & 3);
    const bf16* kbase = kn + ((size_t)b * SEQ + rs * 64 + kb0 + kq) * 512 + h * 64 + 8 * hi;
    f32x4 s[16];
    {
        bf16x8 ka[16][2];
#pragma unroll
        for (int f = 0; f < 16; ++f) { const bf16* kp = kbase + (size_t)((f >> 1) * 64 + (f & 1) * 4) * 512; ka[f][0] = *(const bf16x8*)kp; ka[f][1] = *(const bf16x8*)(kp + 32); }
        __builtin_amdgcn_sched_barrier(0);
#pragma unroll
        for (int f = 0; f < 16; ++f) { f32x4 z = (f32x4){0.f, 0.f, 0.f, 0.f}; z = mfma16(ka[f][0], qf0, z); s[f] = mfma16(ka[f][1], qf1, z); }
    }
    const bf16* vbase = vt + ((size_t)(b * 512 + h * 64 + q) * SEQ + rs * 64 + kb0 + 8 * hi);
    bf16x8 va[8][4];
#pragma unroll
    for (int st = 0; st < 8; ++st)
#pragma unroll
        for (int mf = 0; mf < 4; ++mf) va[st][mf] = *(const bf16x8*)(vbase + (size_t)(16 * mf) * SEQ + st * 64);
    __builtin_amdgcn_sched_barrier(0);
    float mx = -3.0e38f;
#pragma unroll
    for (int f = 0; f < 16; ++f) {
        const int dr = rs + (f >> 1) - r + 7;
#pragma unroll
        for (int g = 0; g < 4; ++g) {
            const int kcol = kb0 + 8 * hi + 4 * (f & 1) + g;
            const bool ok = (kcol >= cs) && (kcol < cs + 16);
            int dc = kcol - qcol + 15; dc = dc < 0 ? 0 : (dc > 30 ? 30 : dc);
            const float v = ok ? s[f][g] + rpl[dr * 31 + dc] : -1.0e30f;
            s[f][g] = v; mx = fmaxf(mx, v);
        }
    }
    mx = fmaxf(mx, __shfl_xor(mx, 16)); mx = fmaxf(mx, __shfl_xor(mx, 32));
    float sum = 0.f;
#pragma unroll
    for (int f = 0; f < 16; ++f)
#pragma unroll
        for (int g = 0; g < 4; ++g) { const float p = __expf(s[f][g] - mx); s[f][g] = p; sum += p; }
    sum += __shfl_xor(sum, 16); sum += __shfl_xor(sum, 32);
    const float inv = 1.0f / sum;
    f32x4 o[4];
#pragma unroll
    for (int i = 0; i < 4; ++i) o[i] = (f32x4){0.f, 0.f, 0.f, 0.f};
#pragma unroll
    for (int st = 0; st < 8; ++st) {
        const bf16x8 pb = __builtin_bit_cast(bf16x8, pg8::pack8(s[2 * st], s[2 * st + 1]));
#pragma unroll
        for (int mf = 0; mf < 4; ++mf) o[mf] = mfma16(va[st][mf], pb, o[mf]);
    }
    bf16* yp = yna + tokq * 1536 + h * 64 + 4 * hi;
#pragma unroll
    for (int mf = 0; mf < 4; ++mf) { v2u w; w.x = pk2(o[mf][0] * inv, o[mf][1] * inv); w.y = pk2(o[mf][2] * inv, o[mf][3] * inv); *(v2u*)(yp + 16 * mf) = w; }
}
__device__ __forceinline__ void xa_fill_lds(const bf16* __restrict__ kmem, const bf16* __restrict__ vtmem, LAS unsigned char* lds, int b, int h, int tid) {
#pragma unroll
    for (int ps = 0; ps < 8; ++ps) { const int id = tid + 512 * ps, key = id >> 4, c = id & 15;
        *(LAS v4u*)(lds + key * 256 + ((c ^ (key & 15)) << 4)) = *(const v4u*)(kmem + ((size_t)b * 256 + key) * 512 + h * 128 + 8 * c); }
#pragma unroll
    for (int ps = 0; ps < 8; ++ps) { const int id = tid + 512 * ps, dim = id >> 5, c = id & 31;
        *(LAS v4u*)(lds + 65536 + dim * 512 + ((c ^ (dim & 15)) << 4)) = *(const v4u*)(vtmem + (size_t)(b * 512 + h * 128 + dim) * 256 + 8 * c); }
}
__device__ __forceinline__ void xa_item(const bf16* __restrict__ xq, const LAS unsigned char* lds, bf16* __restrict__ yxa, int tok0, int h, int lane) {
    const int q = lane & 15, hi = lane >> 4; const size_t tok = (size_t)tok0 + q;
    const bf16* qp = xq + tok * 512 + h * 128 + 8 * hi;
    bf16x8 qf[4]; float ssq = 0.f;
#pragma unroll
    for (int ks = 0; ks < 4; ++ks) qf[ks] = *(const bf16x8*)(qp + 32 * ks);
    __builtin_amdgcn_sched_barrier(0);
#pragma unroll
    for (int ks = 0; ks < 4; ++ks)
#pragma unroll
        for (int j = 0; j < 8; ++j) { const float v = bf1(qf[ks][j]); ssq += v * v; }
    ssq += __shfl_xor(ssq, 16); ssq += __shfl_xor(ssq, 32);
    const float cexp = rsqrtf(ssq * (1.0f / 128.0f) + 1e-6f) * 0.08838834764831845f * 1.4426950408889634f;
    const int kq = 8 * (q >> 2) + (q & 3);
    f32x4 s[16];
#pragma unroll
    for (int f = 0; f < 16; ++f) { const int key = 32 * (f >> 1) + 4 * (f & 1) + kq; const LAS unsigned char* kr = lds + key * 256; f32x4 z = (f32x4){0.f, 0.f, 0.f, 0.f};
#pragma unroll
        for (int ks = 0; ks < 4; ++ks) z = mfma16(*(const LAS bf16x8*)(kr + (((4 * ks + hi) ^ (key & 15)) << 4)), qf[ks], z);
        s[f] = z; }
    float mx = -3.0e38f;
#pragma unroll
    for (int f = 0; f < 16; ++f)
#pragma unroll
        for (int g = 0; g < 4; ++g) mx = fmaxf(mx, s[f][g]);
    mx = fmaxf(mx, __shfl_xor(mx, 16)); mx = fmaxf(mx, __shfl_xor(mx, 32));
    float sum = 0.f;
#pragma unroll
    for (int f = 0; f < 16; ++f)
#pragma unroll
        for (int g = 0; g < 4; ++g) { const float p = __builtin_amdgcn_exp2f((s[f][g] - mx) * cexp); s[f][g] = p; sum += p; }
    sum += __shfl_xor(sum, 16); sum += __shfl_xor(sum, 32);
    const float inv = 1.0f / sum;
    f32x4 o[8];
#pragma unroll
    for (int i = 0; i < 8; ++i) o[i] = (f32x4){0.f, 0.f, 0.f, 0.f};
#pragma unroll
    for (int st = 0; st < 8; ++st) {
        const bf16x8 pb = __builtin_bit_cast(bf16x8, pg8::pack8(s[2 * st], s[2 * st + 1]));
#pragma unroll
        for (int mf = 0; mf < 8; ++mf) { const int dim = 16 * mf + q; o[mf] = mfma16(*(const LAS bf16x8*)(lds + 65536 + dim * 512 + (((4 * st + hi) ^ (dim & 15)) << 4)), pb, o[mf]); }
    }
    bf16* yp = yxa + tok * 1536 + h * 128 + 4 * hi;
#pragma unroll
    for (int mf = 0; mf < 8; ++mf) { v2u w; w.x = pk2(o[mf][0] * inv, o[mf][1] * inv); w.y = pk2(o[mf][2] * inv, o[mf][3] * inv); *(v2u*)(yp + 16 * mf) = w; }
}
__device__ __forceinline__ void pool_wg(const bf16* __restrict__ pp, const bf16* __restrict__ pwT, bf16* __restrict__ ypool, LAS unsigned char* lds, int tokbase, int wave, int lane) {
    const int q = lane & 15, hi = lane >> 4;
    __syncthreads();
    {
        const int hw = 1 << hi, tw0 = tokbase + 16 * wave, b = tw0 >> 13, t0 = tw0 & 8191;
        const bf16* base = pp + (size_t)b * SEQ * 512 + 8 * lane;
        float s[8];
#pragma unroll
        for (int j = 0; j < 8; ++j) s[j] = 0.f;
#pragma unroll 4
        for (int d = -8; d < 8; ++d) { const int u = t0 + d; const bool ok = (d >= -hw) && (d < hw) && (u >= 0) && (u < SEQ);
            const bf16x8 v = *(const bf16x8*)(base + (size_t)(ok ? u : t0) * 512);
#pragma unroll
            for (int j = 0; j < 8; ++j) s[j] += ok ? bf1(v[j]) : 0.f; }
        LAS unsigned char* tile = lds + wave * 16384;
#pragma unroll 4
        for (int i = 0; i < 16; ++i) { const int t = t0 + i;
            int lo = t - hw; lo = lo < 0 ? 0 : lo; int ht = t + hw; ht = ht > SEQ ? SEQ : ht;
            const float inv = 1.0f / (float)(ht - lo);
            const bool oka = (t + hw) < SEQ, oks = (t - hw) >= 0;
            const bf16x8 sv = *(const bf16x8*)(base + (size_t)t * 512), av = *(const bf16x8*)(base + (size_t)(oka ? t + hw : t) * 512), bv = *(const bf16x8*)(base + (size_t)(oks ? t - hw : t) * 512);
            f32x4 p0, p1;
#pragma unroll
            for (int j = 0; j < 4; ++j) { p0[j] = s[j] * inv - bf1(sv[j]); p1[j] = s[j + 4] * inv - bf1(sv[j + 4]); }
            *(LAS v4u*)(tile + i * 1024 + ((lane ^ (i & 15)) << 4)) = pg8::pack8(p0, p1);
#pragma unroll
            for (int j = 0; j < 8; ++j) s[j] += (oka ? bf1(av[j]) : 0.f) - (oks ? bf1(bv[j]) : 0.f);
        }
    }
    __syncthreads();
#pragma unroll 1
    for (int k = 0; k < 4; ++k) {
        const int pair = wave * 4 + k, g = pair >> 3, mf = pair & 7;
        const bf16* wb = pwT + (size_t)(g * 128 + 16 * mf + q) * 128 + 8 * hi;
        bf16x8 a[4];
#pragma unroll
        for (int ks = 0; ks < 4; ++ks) a[ks] = *(const bf16x8*)(wb + 32 * ks);
#pragma unroll 2
        for (int tg = 0; tg < 8; ++tg) {
            const LAS unsigned char* trow = lds + tg * 16384 + q * 1024; f32x4 o = (f32x4){0.f, 0.f, 0.f, 0.f};
#pragma unroll
            for (int ks = 0; ks < 4; ++ks) { const int c = g * 16 + 4 * ks + hi; o = mfma16(a[ks], *(const LAS bf16x8*)(trow + ((c ^ q) << 4)), o); }
            v2u w; w.x = pk2(o[0], o[1]); w.y = pk2(o[2], o[3]);
            *(v2u*)(ypool + (size_t)(tokbase + 16 * tg + q) * 1536 + g * 128 + 16 * mf + 4 * hi) = w;
        }
    }
    __syncthreads();
}

__device__ __forceinline__ int f2key(float s, int idx, int mask) { int b = __builtin_bit_cast(int, s); b = b >= 0 ? b : (b ^ 0x7fffffff); return (b & ~mask) | idx; }
__device__ __forceinline__ float key2f(int k) { k = k >= 0 ? k : (k ^ 0x7fffffff); return __builtin_bit_cast(float, k); }
#define CE_DESC(x, y) do { const int _h = (x) > (y) ? (x) : (y), _l = (x) > (y) ? (y) : (x); (x) = _h; (y) = _l; } while (0)
__device__ __forceinline__ void sort16(int (&a)[16]) {
#pragma unroll
    for (int ks = 1; ks <= 4; ++ks)
#pragma unroll
        for (int js = ks - 1; js >= 0; --js)
#pragma unroll
            for (int i = 0; i < 16; ++i) { const int k = 1 << ks, j = 1 << js, l = i ^ j;
                if (l > i) { if ((i & k) == 0) CE_DESC(a[i], a[l]); else CE_DESC(a[l], a[i]); } }
}
__device__ __forceinline__ void merge16(int (&a)[16], const int (&b)[16]) {
#pragma unroll
    for (int i = 0; i < 16; ++i) a[i] = a[i] > b[15 - i] ? a[i] : b[15 - i];
#pragma unroll
    for (int js = 3; js >= 0; --js)
#pragma unroll
        for (int i = 0; i < 16; ++i) { const int j = 1 << js, l = i ^ j; if (l > i) CE_DESC(a[i], a[l]); }
}
__device__ __forceinline__ void merge16_lanes(int (&a)[16], int step) { int o[16];
#pragma unroll
    for (int k = 0; k < 16; ++k) o[k] = __shfl_xor(a[k], step);
    merge16(a, o); }
__device__ constexpr int cand_i(int hi, int m) {
    return hi == 0 ? 0
         : hi == 1 ? (m < 8 ? 1 : (m < 13 ? 2 : -1))
         : hi == 2 ? (m < 4 ? 3 : (m < 7 ? 4 : (m < 9 ? 5 : (m < 11 ? 6 : -1))))
         :           (m < 2 ? 7 : (m < 10 ? 8 + (m - 2) : -1));
}
__device__ constexpr int cand_j(int hi, int m) {
    return hi == 0 ? m
         : hi == 1 ? (m < 8 ? m : (m < 13 ? m - 8 : -1))
         : hi == 2 ? (m < 4 ? m : (m < 7 ? m - 4 : (m < 9 ? m - 7 : (m < 11 ? m - 9 : -1))))
         :           (m < 2 ? m : (m < 10 ? 0 : -1));
}
__device__ __forceinline__ void topk_fill_lds(const bf16* __restrict__ keys, LAS unsigned char* lds, int h, int tid) {
#pragma unroll
    for (int ps = 0; ps < 8; ++ps) { const int id = tid + 512 * ps, row = id >> 4, c = id & 15;
        *(LAS v4u*)(lds + row * 256 + ((c ^ (row & 15)) << 4)) = *(const v4u*)(keys + ((size_t)h * 256 + row) * 128 + 8 * c); }
}
struct TopkQ { bf16x8 q[2][4]; };
__device__ __forceinline__ void topk_loadq(TopkQ& Q, const bf16* __restrict__ qb, int tok0, int h, int lane) {
    const size_t tok = (size_t)tok0 + (lane & 15); const int hi = lane >> 4;
#pragma unroll
    for (int p = 0; p < 2; ++p)
#pragma unroll
        for (int ks = 0; ks < 4; ++ks) Q.q[p][ks] = *(const bf16x8*)(qb + tok * 2048 + h * 256 + p * 128 + 32 * ks + 8 * hi);
}
__device__ __forceinline__ void topk_item(const TopkQ& Q, const LAS unsigned char* klds, int* __restrict__ te, float* __restrict__ tw, LAS int* lscr, int tok0, int h, int lane) {
    const int q = lane & 15, hi = lane >> 4; const size_t tok = (size_t)tok0 + q;
    int L[2][16];
#pragma unroll
    for (int p = 0; p < 2; ++p) {
        int B[16];
#pragma unroll
        for (int mf = 0; mf < 8; ++mf) { f32x4 s = (f32x4){0.f, 0.f, 0.f, 0.f}; const int row = p * 128 + 16 * mf + q;
#pragma unroll
            for (int ks = 0; ks < 4; ++ks) s = mfma16(*(const LAS bf16x8*)(klds + row * 256 + (((4 * ks + hi) ^ (row & 15)) << 4)), Q.q[p][ks], s);
#pragma unroll
            for (int g = 0; g < 4; ++g) { const int key = f2key(s[g], 16 * mf + 4 * hi + g, 127); if (mf < 4) L[p][4 * mf + g] = key; else B[4 * (mf - 4) + g] = key; } }
        sort16(L[p]); sort16(B); merge16(L[p], B);
        merge16_lanes(L[p], 16); merge16_lanes(L[p], 32);
    }
    float v1[16], v2[16];
#pragma unroll
    for (int k = 0; k < 16; ++k) { v1[k] = key2f(L[0][k]); v2[k] = key2f(L[1][k]); }
    int Fk[16];
#pragma unroll
    for (int m = 0; m < 16; ++m) {
        float sm = v1[0] + v2[m]; int id = 255 - m;
        if (cand_i(1, m) >= 0) { if (hi == 1) { sm = v1[cand_i(1, m) < 0 ? 0 : cand_i(1, m)] + v2[cand_j(1, m) < 0 ? 0 : cand_j(1, m)]; id = 255 - ((cand_i(1, m) << 4) | cand_j(1, m)); } }
        if (cand_i(2, m) >= 0) { if (hi == 2) { sm = v1[cand_i(2, m) < 0 ? 0 : cand_i(2, m)] + v2[cand_j(2, m) < 0 ? 0 : cand_j(2, m)]; id = 255 - ((cand_i(2, m) << 4) | cand_j(2, m)); } }
        if (cand_i(3, m) >= 0) { if (hi == 3) { sm = v1[cand_i(3, m) < 0 ? 0 : cand_i(3, m)] + v2[cand_j(3, m) < 0 ? 0 : cand_j(3, m)]; id = 255 - ((cand_i(3, m) << 4) | cand_j(3, m)); } }
        int key = f2key(sm, id, 255);
        if ((hi == 1 && cand_i(1, m) < 0) || (hi == 2 && cand_i(2, m) < 0) || (hi == 3 && cand_i(3, m) < 0)) key = (int)0x80000000;
        Fk[m] = key;
    }
    sort16(Fk); merge16_lanes(Fk, 16); merge16_lanes(Fk, 32);
    LAS int* my = lscr + lane * 32;
#pragma unroll
    for (int k = 0; k < 16; ++k) { my[k] = L[0][k] & 127; my[16 + k] = L[1][k] & 127; }
    LDS_WAIT(); asm volatile("" ::: "memory");
    float e[16]; float sum = 0.f; const float mx = key2f(Fk[0]);
#pragma unroll
    for (int k = 0; k < 16; ++k) { e[k] = __expf(key2f(Fk[k]) - mx); sum += e[k]; }
    const float inv = 1.0f / sum;
    if (hi == 0) {
        int* tep = te + tok * 128; float* twp = tw + tok * 128;
#pragma unroll
        for (int kk = 0; kk < 16; ++kk) { const int ij = 255 - (Fk[kk] & 255), i = ij >> 4, j = ij & 15, slot = (kk & 7) * 16 + 2 * h + (kk >> 3);
            tep[slot] = my[i] * 128 + my[16 + j]; twp[slot] = e[kk] * inv; }
    }
    LDS_WAIT(); asm volatile("" ::: "memory");
}

__device__ __forceinline__ float ub2f(unsigned v, int b) { return (float)((v >> (8 * b)) & 0xffu); }
__device__ __forceinline__ void hq_token(const bf16* __restrict__ hb, const float* __restrict__ rowsq, unsigned char* __restrict__ hq, float* __restrict__ hs, int tok, int lane) {
    const bf16* hp = hb + (size_t)tok * 1024 + 16 * lane;
    const v4u hA = *(const v4u*)hp, hB = *(const v4u*)(hp + 8);
    float hf[16];
#pragma unroll
    for (int d = 0; d < 4; ++d) { hf[2 * d] = bflo(hA[d]); hf[2 * d + 1] = bfhi(hA[d]); hf[8 + 2 * d] = bflo(hB[d]); hf[8 + 2 * d + 1] = bfhi(hB[d]); }
    float amax = 0.f;
#pragma unroll
    for (int j = 0; j < 16; ++j) amax = fmaxf(amax, fabsf(hf[j]));
#pragma unroll
    for (int o = 1; o < 64; o <<= 1) amax = fmaxf(amax, __shfl_xor(amax, o));
    const float hinv = amax > 0.f ? 127.0f / amax : 0.f;
    v4u w;
#pragma unroll
    for (int d = 0; d < 4; ++d) { const unsigned b0 = (unsigned)(int)rintf(hf[4 * d] * hinv) & 0xffu, b1 = (unsigned)(int)rintf(hf[4 * d + 1] * hinv) & 0xffu,
                                                 b2 = (unsigned)(int)rintf(hf[4 * d + 2] * hinv) & 0xffu, b3 = (unsigned)(int)rintf(hf[4 * d + 3] * hinv) & 0xffu;
        w[d] = b0 | (b1 << 8) | (b2 << 16) | (b3 << 24); }
    *(v4u*)(hq + (size_t)tok * 1024 + 16 * lane) = w;
    if (lane == 0) hs[tok] = rsqrtf(rowsq[tok] * (1.0f / 1024.0f) + 1e-6f) * amax * (1.0f / 127.0f);
}
constexpr int PA_SLOTS = 12;
struct PeerA1 { int e; float g; };
struct PeerA2 { v4u ur[3][4]; v4u hv[4]; float hsc, su, sv; int cnt, rk; bool m; unsigned long long rem; };
__device__ __forceinline__ void pa_s1(PeerA1& a, const int* __restrict__ te, const float* __restrict__ tw, int tok, int half, int lane) {
    a.e = te[(size_t)tok * 128 + 64 * half + lane]; a.g = tw[(size_t)tok * 128 + 64 * half + lane]; }
__device__ __forceinline__ void pa_s2(PeerA2& b, const PeerA1& a, const unsigned char* __restrict__ hq, const float* __restrict__ hs, const unsigned char* __restrict__ u8,
                                      const float* __restrict__ su, const float* __restrict__ sv, LAS int* lst, int tok, int x, int lane, int hot) {
    b.m = (a.e >> 11) == x;
    const unsigned long long mask = __ballot(b.m), lt = (1ull << lane) - 1ull;
    b.cnt = __popcll(mask); b.rk = __popcll(mask & lt);
    if (b.m && b.rk < PA_SLOTS) lst[b.rk] = a.e;
    { unsigned long long r = mask; for (int k = 0; k < PA_SLOTS && r != 0ull; ++k) r &= r - 1ull; b.rem = b.cnt > PA_SLOTS ? r : 0ull; }
    { typedef float f32x2s __attribute__((ext_vector_type(2))); f32x2s s2 = (f32x2s){0.f, 0.f}; if (b.m) s2 = ((const f32x2s*)su)[a.e]; b.su = s2.x; b.sv = s2.y; }
    const int r = lane >> 4, t = lane & 15;
#pragma unroll
    for (int i = 0; i < 4; ++i) b.hv[i] = *(const v4u*)(hq + (size_t)tok * 1024 + 16 * t + 256 * i);
    b.hsc = hs[tok];
    LDS_WAIT(); asm volatile("" ::: "memory");
    const int lim = b.cnt < PA_SLOTS ? b.cnt : PA_SLOTS;
#pragma unroll
    for (int q = 0; q < 3; ++q) { const int slot = 4 * q + r;
#pragma unroll
        for (int i = 0; i < 4; ++i) b.ur[q][i] = (v4u){0u, 0u, 0u, 0u};
        if (slot < lim) { int e = lst[slot]; if (hot) e = (x << 11) | (e & 255); const unsigned char* rp = u8 + (size_t)e * 1024 + 16 * t;
#pragma unroll
            for (int i = 0; i < 4; ++i) b.ur[q][i] = *(const v4u*)(rp + 256 * i); } }
    (void)sv;
}
__device__ __forceinline__ int dot16(const v4u u, const v4u h) { int d = __builtin_amdgcn_sdot4((int)u.x, (int)h.x, 0, false); d = __builtin_amdgcn_sdot4((int)u.y, (int)h.y, d, false);
    d = __builtin_amdgcn_sdot4((int)u.z, (int)h.z, d, false); return __builtin_amdgcn_sdot4((int)u.w, (int)h.w, d, false); }
template <int CTRL, int RM> __device__ __forceinline__ int dpp_i(int x) { return __builtin_amdgcn_update_dpp(0, x, CTRL, RM, 0xf, false); }
__device__ __forceinline__ int wave_sum_to63(int x) { x += dpp_i<0xb1, 0xf>(x); x += dpp_i<0x4e, 0xf>(x); x += dpp_i<0x124, 0xf>(x); x += dpp_i<0x128, 0xf>(x); x += dpp_i<0x142, 0xa>(x); x += dpp_i<0x143, 0xc>(x); return x; }
__device__ __forceinline__ int row_sum16(int x) { x += dpp_i<0xb1, 0xf>(x); x += dpp_i<0x4e, 0xf>(x); x += dpp_i<0x124, 0xf>(x); x += dpp_i<0x128, 0xf>(x); return x; }
__device__ __forceinline__ float gelu_erf(float v) {
    const float av = fabsf(v), t = __builtin_amdgcn_rcpf(av * 0.2316418882f + 1.0f);
    float q = t * 0.5307027145f + (-0.7265760135f); q = q * t + 0.7107068705f; q = q * t + (-0.142248368f); q = q * t + 0.127414796f; q = q * t;
    const float e = __builtin_amdgcn_exp2f((v * v) * (-0.72134752044f)), m = v * (q * e);
    return v < 0.f ? m : v - m; }
__device__ __forceinline__ void pa_s3(const PeerA2& b, const PeerA1& a, const unsigned char* __restrict__ u8, const unsigned char* __restrict__ hq, float* __restrict__ aw, int tok, int half, int lane) {
    int mine = 0;
#pragma unroll
    for (int q = 0; q < 3; ++q) { int d = dot16(b.ur[q][0], b.hv[0]); d += dot16(b.ur[q][1], b.hv[1]); d += dot16(b.ur[q][2], b.hv[2]); d += dot16(b.ur[q][3], b.hv[3]);
        d = row_sum16(d);
#pragma unroll
        for (int r = 0; r < 4; ++r) { const int s = __builtin_amdgcn_readlane(d, 16 * r); mine = (b.rk == 4 * q + r) ? s : mine; } }
    float* awp = aw + (size_t)tok * 128 + 64 * half + lane;
    if (b.m && b.rk < PA_SLOTS) *awp = a.g * gelu_erf((float)mine * b.hsc * b.su) * b.sv;
    if (b.cnt > PA_SLOTS) {
        unsigned long long rem = b.rem; const v4u hw = *(const v4u*)(hq + (size_t)tok * 1024 + 16 * lane);
        while (rem != 0ull) { const int idx = __builtin_ctzll(rem); rem &= rem - 1ull; const int e = __builtin_amdgcn_readlane(a.e, idx);
            const int d = __builtin_amdgcn_readlane(wave_sum_to63(dot16(*(const v4u*)(u8 + (size_t)e * 1024 + 16 * lane), hw)), 63);
            if (lane == idx) *awp = a.g * gelu_erf((float)d * b.hsc * b.su) * b.sv; }
    }
}
__device__ __forceinline__ void peer_a_run(const unsigned char* __restrict__ hq, const float* __restrict__ hs, const unsigned char* __restrict__ u8, const float* __restrict__ su,
                                           const float* __restrict__ sv, const int* __restrict__ te, const float* __restrict__ tw, float* __restrict__ aw, LAS int* lst, int wrank, int wstep, int x, int lane, int hot = 0) {
    const int ntok = wrank < T ? (T - wrank + wstep - 1) / wstep : 0, N = 2 * ntok;
#define PA_TOK(n) (wrank + ((n) >> 1) * wstep)
    if (N == 0) return;
    PeerA1 a0, a1, a2; PeerA2 bA, bB;
    pa_s1(a0, te, tw, PA_TOK(0), 0, lane); pa_s1(a1, te, tw, PA_TOK(1), 1, lane);
    pa_s2(bA, a0, hq, hs, u8, su, sv, lst, PA_TOK(0), x, lane, hot);
#define PA_STEP(n, Bcur, Bnext, Acur, Anext, Anew) do { \
        if ((n) + 1 < N) pa_s2(Bnext, Anext, hq, hs, u8, su, sv, lst, PA_TOK((n) + 1), x, lane, hot); \
        if ((n) + 2 < N) pa_s1(Anew, te, tw, PA_TOK((n) + 2), ((n) + 2) & 1, lane); \
        pa_s3(Bcur, Acur, u8, hq, aw, PA_TOK(n), (n) & 1, lane); } while (0)
    for (int n = 0; n < N; n += 6) {
        PA_STEP(n, bA, bB, a0, a1, a2);
        if (n + 1 < N) PA_STEP(n + 1, bB, bA, a1, a2, a0);
        if (n + 2 < N) PA_STEP(n + 2, bA, bB, a2, a0, a1);
        if (n + 3 < N) PA_STEP(n + 3, bB, bA, a0, a1, a2);
        if (n + 4 < N) PA_STEP(n + 4, bA, bB, a1, a2, a0);
        if (n + 5 < N) PA_STEP(n + 5, bB, bA, a2, a0, a1);
    }
#undef PA_STEP
#undef PA_TOK
}
struct PeerB1 { v4u e[4]; f32x4 w[4]; };
struct PeerB2 { v4u vr[8]; };
struct PeerBAcc { int acc[16]; int wq[4]; float wsc, h0, h1; };
typedef float f32x2v __attribute__((ext_vector_type(2)));
__device__ __forceinline__ void pb_s1(PeerB1& a, const int* __restrict__ te, const float* __restrict__ aw, int tok, int lane) {
    const v4u* ep = (const v4u*)(te + (size_t)tok * 128 + 16 * (lane >> 3)); const f32x4* wp = (const f32x4*)(aw + (size_t)tok * 128 + 16 * (lane >> 3));
#pragma unroll
    for (int j = 0; j < 4; ++j) { a.e[j] = ep[j]; a.w[j] = wp[j]; } }
__device__ __forceinline__ int pb_col(int lane) { return 16 * (lane & 7) + 8 * ((lane >> 5) & 1) + 4 * ((lane >> 4) & 1) + 2 * ((lane >> 3) & 1); }
template <int CTRL, int RM> __device__ __forceinline__ float dpp_f(float x) { return __builtin_bit_cast(float, __builtin_amdgcn_update_dpp(0, __builtin_bit_cast(int, x), CTRL, RM, 0xf, false)); }
__device__ __forceinline__ void pb_quant(PeerBAcc& A, const PeerB1& a) {
    float mx = 0.f;
#pragma unroll
    for (int j = 0; j < 4; ++j) mx = fmaxf(mx, fmaxf(fmaxf(fabsf(a.w[j][0]), fabsf(a.w[j][1])), fmaxf(fabsf(a.w[j][2]), fabsf(a.w[j][3]))));
    mx = fmaxf(mx, dpp_f<0xb1, 0xf>(mx)); mx = fmaxf(mx, dpp_f<0x4e, 0xf>(mx)); mx = fmaxf(mx, dpp_f<0x124, 0xf>(mx)); mx = fmaxf(mx, dpp_f<0x128, 0xf>(mx));
    mx = fmaxf(mx, dpp_f<0x142, 0xa>(mx)); mx = fmaxf(mx, dpp_f<0x143, 0xc>(mx));
    mx = __builtin_bit_cast(float, __builtin_amdgcn_readlane(__builtin_bit_cast(int, mx), 63));
    const float inv = mx > 0.f ? 127.0f / mx : 0.f; A.wsc = mx * (1.0f / 127.0f);
#pragma unroll
    for (int j = 0; j < 4; ++j) A.wq[j] = (int)(((unsigned)(int)rintf(a.w[j][0] * inv) & 0xffu) | (((unsigned)(int)rintf(a.w[j][1] * inv) & 0xffu) << 8) |
                                               (((unsigned)(int)rintf(a.w[j][2] * inv) & 0xffu) << 16) | (((unsigned)(int)rintf(a.w[j][3] * inv) & 0xffu) << 24));
}
template <int HF> __device__ __forceinline__ void pb_s2(PeerB2& b, const PeerB1& a, const unsigned char* __restrict__ v8x, int lane, int hot = 0) {
    const int c = lane & 7;
#pragma unroll
    for (int m = 0; m < 8; ++m) { unsigned e = a.e[2 * HF + (m >> 2)][m & 3]; if (hot) e &= 255u; b.vr[m] = *(const v4u*)(v8x + (size_t)e * 128 + 16 * c); }
}
__device__ __forceinline__ float swap32_add(float lo, float hi) { const auto r = __builtin_amdgcn_permlane32_swap(__builtin_bit_cast(unsigned, lo), __builtin_bit_cast(unsigned, hi), false, false);
    return __builtin_bit_cast(float, r[0]) + __builtin_bit_cast(float, r[1]); }
__device__ __forceinline__ float swap16_add(float lo, float hi) { const auto r = __builtin_amdgcn_permlane16_swap(__builtin_bit_cast(unsigned, lo), __builtin_bit_cast(unsigned, hi), false, false);
    return __builtin_bit_cast(float, r[0]) + __builtin_bit_cast(float, r[1]); }
template <int HF> __device__ __forceinline__ void pb_s3(PeerBAcc& A, const PeerB2& b, const PeerB1& a, float* out, int tok, int x, int lane) {
    if (HF == 0) {
#pragma unroll
        for (int j = 0; j < 16; ++j) A.acc[j] = 0;
    }
#pragma unroll
    for (int gg = 0; gg < 2; ++gg)
#pragma unroll
        for (int d = 0; d < 4; ++d) { const unsigned ra = b.vr[4 * gg][d], rb = b.vr[4 * gg + 1][d], rc = b.vr[4 * gg + 2][d], rd = b.vr[4 * gg + 3][d];
            const unsigned t0 = __builtin_amdgcn_perm(rb, ra, 0x05010400u), t1 = __builtin_amdgcn_perm(rb, ra, 0x07030602u), t2 = __builtin_amdgcn_perm(rd, rc, 0x05010400u), t3 = __builtin_amdgcn_perm(rd, rc, 0x07030602u);
            const unsigned c0 = __builtin_amdgcn_perm(t2, t0, 0x05040100u), c1 = __builtin_amdgcn_perm(t2, t0, 0x07060302u), c2 = __builtin_amdgcn_perm(t3, t1, 0x05040100u), c3 = __builtin_amdgcn_perm(t3, t1, 0x07060302u);
            const int w4 = A.wq[2 * HF + gg];
            A.acc[4 * d] = __builtin_amdgcn_sdot4((int)c0, w4, A.acc[4 * d], false); A.acc[4 * d + 1] = __builtin_amdgcn_sdot4((int)c1, w4, A.acc[4 * d + 1], false);
            A.acc[4 * d + 2] = __builtin_amdgcn_sdot4((int)c2, w4, A.acc[4 * d + 2], false); A.acc[4 * d + 3] = __builtin_amdgcn_sdot4((int)c3, w4, A.acc[4 * d + 3], false); }
    if (HF == 1) {
        int r8[8], r4[4], r2[2];
#pragma unroll
        for (int j = 0; j < 8; ++j) { const bool up = (lane & 32) != 0; const int keep = up ? A.acc[j + 8] : A.acc[j], send = up ? A.acc[j] : A.acc[j + 8]; r8[j] = keep + __shfl_xor(send, 32); }
#pragma unroll
        for (int j = 0; j < 4; ++j) { const bool up = (lane & 16) != 0; const int keep = up ? r8[j + 4] : r8[j], send = up ? r8[j] : r8[j + 4]; r4[j] = keep + __shfl_xor(send, 16); }
#pragma unroll
        for (int j = 0; j < 2; ++j) { const bool up = (lane & 8) != 0; const int keep = up ? r4[j + 2] : r4[j], send = up ? r4[j] : r4[j + 2];
            r2[j] = keep + __builtin_amdgcn_update_dpp(0, send, 0x128, 0xf, 0xf, false); }
        f32x2v h2; h2.x = A.h0 + A.wsc * (float)r2[0]; h2.y = A.h1 + A.wsc * (float)r2[1];
        *(f32x2v*)(out + (size_t)tok * 1024 + 128 * x + pb_col(lane)) = h2;
    }
}
__device__ __forceinline__ void peer_b_run(const unsigned char* __restrict__ v8x, const int* __restrict__ te, const float* __restrict__ aw, const bf16* __restrict__ hb, float* out, int wrank, int wstep, int x, int lane, int hot = 0) {
    const int N = wrank < T ? (T - wrank + wstep - 1) / wstep : 0;
#define PB_TOK(n) (wrank + (n) * wstep)
#define PB_LOADH(n) do { const unsigned h2_ = *(const unsigned*)(hb + (size_t)PB_TOK(n) * 1024 + 128 * x + pb_col(lane)); A.h0 = bflo(h2_); A.h1 = bfhi(h2_); } while (0)
    if (N == 0) return;
    PeerB1 s0, s1; PeerB2 bA, bB; PeerBAcc A;
    pb_s1(s0, te, aw, PB_TOK(0), lane); if (N > 1) pb_s1(s1, te, aw, PB_TOK(1), lane);
    pb_s2<0>(bA, s0, v8x, lane, hot);
    for (int n = 0; n < N; n += 2) {
        pb_s2<1>(bB, s0, v8x, lane, hot); PB_LOADH(n); pb_quant(A, s0);
        pb_s3<0>(A, bA, s0, out, PB_TOK(n), x, lane);
        if (n + 1 < N) pb_s2<0>(bA, s1, v8x, lane, hot);
        pb_s3<1>(A, bB, s0, out, PB_TOK(n), x, lane);
        if (n + 2 < N) pb_s1(s0, te, aw, PB_TOK(n + 2), lane);
        if (n + 1 < N) {
            pb_s2<1>(bB, s1, v8x, lane, hot); PB_LOADH(n + 1); pb_quant(A, s1);
            pb_s3<0>(A, bA, s1, out, PB_TOK(n + 1), x, lane);
            if (n + 2 < N) pb_s2<0>(bA, s0, v8x, lane, hot);
            pb_s3<1>(A, bB, s1, out, PB_TOK(n + 1), x, lane);
            if (n + 3 < N) pb_s1(s1, te, aw, PB_TOK(n + 3), lane);
        }
    }
#undef PB_LOADH
#undef PB_TOK
}

__global__ void __launch_bounds__(NWAVES * 64, 2) mk_fwd(Args args) {
    extern __shared__ __attribute__((aligned(16))) unsigned char lds[];
    Frame F;
    F.lds = (LAS unsigned char*)lds;
    F.MISC = (volatile LAS unsigned*)(F.lds + MISC_OFF);
    F.tid = threadIdx.x; F.lane = F.tid & 63; F.wave = __builtin_amdgcn_readfirstlane(F.tid >> 6);
    F.G = gridDim.x; { const int bx = blockIdx.x; F.vcu = (F.G % 8 == 0) ? (bx % 8) * (F.G / 8) + bx / 8 : bx; }
    F.out = args.out; F.ws = args.ws;
    unsigned char* ws = args.ws;
    F.ctl = (gu32*)(ws + WS_CTL);
    for (int u = F.tid; u < (LDS_BYTES - LDSCTL_OFF) / 4; u += NWAVES * 64) ((LAS unsigned*)(F.lds + LDSCTL_OFF))[u] = 0u;
    __syncthreads();
    XcdBarrier bar; bar.bar = (unsigned*)(F.ctl + CW_BAR); bar.x = 0; bar.st = nullptr;
    if (N_LAUNCHES != PER_PHASE) bar = xcd_barrier_post((unsigned*)(F.ctl + CW_BAR), F.MISC + 8);
    if (N_LAUNCHES != PER_PHASE) { if (F.tid == 0) { const unsigned xid = xb_xcc_id(); F.MISC[12] = xid; F.MISC[13] = xb_add((unsigned*)(F.ctl + CW_TICKET) + 64 * xid, 1u); } __syncthreads(); }
#define GRID_BAR() do { if (N_LAUNCHES != PER_PHASE) xcd_barrier(bar); } while (0)
    const int lo = args.ph_lo, hi = args.ph_hi;
#define IN(k) (lo <= (k) && (k) < hi)
#define BOTH(k) (IN(k) && IN((k) + 1))
#ifndef DUP_PHASE
#define DUP_PHASE (-1)
#endif
#define NREP(k) ((DUP_PHASE == (k)) ? 2 : 1)
    const int gw = F.vcu * NWAVES + F.wave, NGW = F.G * NWAVES;
    bf16* const WinT = (bf16*)(ws + WS_WIN); bf16* const WvT = (bf16*)(ws + WS_WV); bf16* const WkvT = (bf16*)(ws + WS_WKV); bf16* const WbrT = (bf16*)(ws + WS_WBR);
    bf16* const WoutT = (bf16*)(ws + WS_WOUT); bf16* const WqT = (bf16*)(ws + WS_WQ); bf16* const KEYS = (bf16*)(ws + WS_KEYS); bf16* const PWT = (bf16*)(ws + WS_PWT);
    bf16* const MEMN = (bf16*)(ws + WS_MEMN); bf16* const KMEM = (bf16*)(ws + WS_KMEM); bf16* const VTMEM = (bf16*)(ws + WS_VTMEM); float* const RSTDX = (float*)(ws + WS_RSTDX);
    const unsigned char* const U8 = ws + WS_U8; const unsigned char* const V8 = ws + WS_V8; const float* const SU = (const float*)(ws + WS_SU); const float* const SV = (const float*)(ws + WS_SV);
    bf16* const QN = (bf16*)(ws + WS_QN); bf16* const KN = (bf16*)(ws + WS_KN); bf16* const VT = (bf16*)(ws + WS_VT); bf16* const PP = (bf16*)(ws + WS_PP); bf16* const XQ = (bf16*)(ws + WS_XQ);
    bf16* const GATE = (bf16*)(ws + WS_GATE); bf16* const MERGED = (bf16*)(ws + WS_MERGED); bf16* const HB = (bf16*)(ws + WS_HB); bf16* const QB = (bf16*)(ws + WS_QB);
    int* const TE = (int*)(ws + WS_TE); float* const TW = (float*)(ws + WS_TW); float* const AW = (float*)(ws + WS_AW); float* const ROWSQ = (float*)(ws + WS_ROWSQ);
    bf16* const XB = (bf16*)((unsigned char*)args.out + OUT_XB); bf16* const YNA = (bf16*)((unsigned char*)args.out + OUT_YNA);
    bf16* const YPOOL = (bf16*)((unsigned char*)args.out + OUT_YPOOL); bf16* const YXA = (bf16*)((unsigned char*)args.out + OUT_YXA);

    if (IN(0)) { for (int rep = 0; rep < NREP(0); ++rep) { p0_prologue(F, args); if (rep + 1 < NREP(0)) GRID_BAR(); } if (BOTH(0)) GRID_BAR(); }

    if (IN(1)) {
      for (int rep = 0; rep < NREP(1); ++rep) {
        { pg8::Sched1 S; S.so.init(T, IN_MAIN, F.G, (int)blockIdx.x); S.A = (const char*)XB; S.Bt = (const char*)WinT; S.tstep = (size_t)256 * 1024 * 2;
          pg8::EpiProj E{RSTDX, QN, KN, PP, XQ, GATE, args.in[I_NAQG], args.in[I_NAKG], args.in[I_GATEB]};
          pg8::gemm_phase<pg8::EpiProj, pg8::Sched1, true, true>(F.lds + RING_OFF, 1024, S, E); }
        { pg8::Sched1 S; S.so.init(512, T, F.G, (int)blockIdx.x); S.A = (const char*)WvT; S.Bt = (const char*)XB; S.tstep = (size_t)256 * 1024 * 2;
          pg8::EpiVt E{RSTDX, VT};
          pg8::gemm_phase<pg8::EpiVt, pg8::Sched1, false, true>(F.lds + RING_OFF, 1024, S, E); }
        for (int t = gw; t < 512; t += NGW) memkv_tile(MEMN, WkvT, args.in[I_XAKG], args.in[I_XAQG], KMEM, VTMEM, t, F.lane);
        if (rep + 1 < NREP(1)) GRID_BAR();
      }
        if (BOTH(1)) GRID_BAR();
    }

    if (IN(2)) {
      for (int rep = 0; rep < NREP(2); ++rep) {
        LAS float* rpl = (LAS float*)(F.lds + RING_OFF + F.wave * 16384);
        for (int i = F.lane; i < 15 * 31; i += 64) rpl[i] = args.in[I_RPB][F.wave * 15 * 31 + i];
        LDS_WAIT(); asm volatile("" ::: "memory");
        for (int i = F.vcu; i < 256; i += F.G)
            for (int k = 0; k < 8; ++k) { const int idx = i * 8 + k, b = idx >> 9, r = (idx >> 2) & 127, jb = idx & 3; na_item(QN, KN, VT, rpl, YNA, b, r, jb, F.wave, F.lane); }
        for (int i = F.vcu; i < 256; i += F.G) pool_wg(PP, PWT, YPOOL, F.lds + RING_OFF, i * 128, F.wave, F.lane);
        { const int pair = F.vcu & 15, xb = pair >> 2, xh = pair & 3, slot = F.vcu >> 4, nslot = F.G >> 4;
          __syncthreads(); xa_fill_lds(KMEM, VTMEM, F.lds + RING_OFF, xb, xh, F.tid); __syncthreads();
          if (slot < nslot) for (int n = slot * NWAVES + F.wave; n < 512; n += nslot * NWAVES) xa_item(XQ, F.lds + RING_OFF, YXA, (xb * 512 + n) * 16, xh, F.lane);
          __syncthreads(); }
        if (rep + 1 < NREP(2)) GRID_BAR();
      }
        if (BOTH(2)) GRID_BAR();
    }

    if (IN(3)) {
      for (int rep = 0; rep < NREP(3); ++rep) {
        pg8::Sched1 S; S.so.init(T, D, F.G, (int)blockIdx.x); S.A = (const char*)YNA; S.Bt = (const char*)WbrT; S.tstep = (size_t)256 * 1536 * 2;
        pg8::EpiMergeCat E{GATE, MERGED};
        pg8::gemm_phase<pg8::EpiMergeCat, pg8::Sched1, true, true>(F.lds + RING_OFF, 1536, S, E);
        if (rep + 1 < NREP(3)) GRID_BAR();
      }
        if (BOTH(3)) GRID_BAR();
    }

    if (IN(4)) {
      for (int rep = 0; rep < NREP(4); ++rep) {
        pg8::Sched1 S; S.so.init(T, D, F.G, (int)blockIdx.x); S.A = (const char*)MERGED; S.Bt = (const char*)WoutT; S.tstep = (size_t)256 * 1024 * 2;
        pg8::EpiH E{args.in[I_X], F.out, HB, ROWSQ, args.probe};
        pg8::gemm_phase<pg8::EpiH, pg8::Sched1, true, true>(F.lds + RING_OFF, 1024, S, E);
        if (rep + 1 < NREP(4)) { GRID_BAR(); for (int m = gw * 64 + F.lane; m < T; m += NGW * 64) ROWSQ[m] = 0.f; GRID_BAR(); }
      }
        if (BOTH(4)) GRID_BAR();
    }

    if (IN(5)) {
      for (int rep = 0; rep < NREP(5); ++rep) {
        pg8::Sched1 S; S.so.init(T, 2048, F.G, (int)blockIdx.x); S.A = (const char*)HB; S.Bt = (const char*)WqT; S.tstep = (size_t)256 * 1024 * 2;
        pg8::EpiQ E{ROWSQ, QB};
        pg8::gemm_phase<pg8::EpiQ, pg8::Sched1, true, true>(F.lds + RING_OFF, 1024, S, E);
        if (rep + 1 < NREP(5)) GRID_BAR();
      }
        if (BOTH(5)) GRID_BAR();
    }

    if (IN(6)) {
        LAS int* lscr = (LAS int*)(F.lds + RING_OFF + 65536 + F.wave * 8192);
        for (int tok = gw; tok < T; tok += NGW) hq_token(HB, ROWSQ, ws + WS_HQ, (float*)(ws + WS_HS), tok, F.lane);
        { const int th = F.vcu & 7, slot = F.vcu >> 3, nslot = F.G >> 3;
          __syncthreads(); topk_fill_lds(KEYS, F.lds + RING_OFF, th, F.tid); __syncthreads();
          for (int rep = 0; rep < NREP(6); ++rep) { { const int n0 = slot * NWAVES + F.wave, ns = nslot * NWAVES; TopkQ qA, qB;
              if (n0 < 2048) topk_loadq(qA, QB, n0 * 16, th, F.lane);
              for (int n = n0; n < 2048; n += 2 * ns) {
                  if (n + ns < 2048) topk_loadq(qB, QB, (n + ns) * 16, th, F.lane);
                  topk_item(qA, F.lds + RING_OFF, TE, TW, lscr, n * 16, th, F.lane);
                  if (n + ns < 2048) { if (n + 2 * ns < 2048) topk_loadq(qA, QB, (n + 2 * ns) * 16, th, F.lane);
                      topk_item(qB, F.lds + RING_OFF, TE, TW, lscr, (n + ns) * 16, th, F.lane); } } } if (rep + 1 < NREP(6)) GRID_BAR(); }
          __syncthreads(); }
        if (BOTH(6)) GRID_BAR();
    }

    if (IN(7)) {
        int x0 = 0, nxs = 8, wrank = (int)blockIdx.x * NWAVES + F.wave, wstep = F.G * NWAVES;
        if (N_LAUNCHES != PER_PHASE) { const unsigned xid = F.MISC[12], rk = F.MISC[13]; unsigned nx = 0, below = 0, mine = 0;
            for (unsigned j = 0; j < 16; ++j) { const unsigned c = xb_ld((unsigned*)(F.ctl + CW_BAR) + XB_XCNT(j)); nx += c > 0u; below += (c > 0u && j < xid); mine = (j == xid) ? c : mine; }
            if (nx == 8 && mine > 0 && rk < mine) { x0 = (int)below; nxs = 1; wrank = (int)rk * NWAVES + F.wave; wstep = (int)mine * NWAVES; } }
        else if ((F.G & 7) == 0) { x0 = (int)blockIdx.x & 7; nxs = 1; wrank = ((int)blockIdx.x >> 3) * NWAVES + F.wave; wstep = (F.G >> 3) * NWAVES; }
        for (int xs = 0; xs < nxs; ++xs) peer_a_run(ws + WS_HQ, (const float*)(ws + WS_HS), U8, SU, SV, TE, TW, args.probe ? (float*)QB : AW, (LAS int*)(F.lds + RING_OFF + F.wave * 16384), wrank, wstep, x0 + xs, F.lane, args.probe == 2);
        if (N_LAUNCHES != PER_PHASE) xcd_barrier(bar);
    }
    if (IN(8)) {
        int x0 = 0, nxs = 8, wrank = (int)blockIdx.x * NWAVES + F.wave, wstep = F.G * NWAVES;
        if (N_LAUNCHES != PER_PHASE) { const unsigned xid = F.MISC[12], rk = F.MISC[13]; unsigned nx = 0, below = 0, mine = 0;
            for (unsigned j = 0; j < 16; ++j) { const unsigned c = xb_ld((unsigned*)(F.ctl + CW_BAR) + XB_XCNT(j)); nx += c > 0u; below += (c > 0u && j < xid); mine = (j == xid) ? c : mine; }
            if (nx == 8 && mine > 0 && rk < mine) { x0 = (int)below; nxs = 1; wrank = (int)rk * NWAVES + F.wave; wstep = (int)mine * NWAVES; } }
        else if ((F.G & 7) == 0) { x0 = (int)blockIdx.x & 7; nxs = 1; wrank = ((int)blockIdx.x >> 3) * NWAVES + F.wave; wstep = (F.G >> 3) * NWAVES; }
        for (int xs = 0; xs < nxs; ++xs) peer_b_run(V8 + (size_t)(x0 + xs) * (2 * MiB), TE, AW, HB, args.probe ? (float*)QB : F.out, wrank, wstep, x0 + xs, F.lane, args.probe == 2);
    }
#undef IN
#undef BOTH
#undef GRID_BAR
}

extern "C" void kernel_launch(void* const* d_in, const int* in_sizes, int n_in, void* d_out, int out_size, void* d_ws, size_t ws_size, hipStream_t stream) {
    static int grid = 0;
    if (grid == 0) {
        if (n_in != 23 || in_sizes[0] != T * D || out_size != T * D || ws_size < WS_END) { fprintf(stderr, "kernel_launch: unexpected shapes: n_in %d in0 %d out %d ws %zu\n", n_in, n_in > 0 ? in_sizes[0] : -1, out_size, ws_size); grid = -1; return; }
        int dev = 0, cus = 0, per_cu = 0;
        if (hipGetDevice(&dev) != hipSuccess || hipDeviceGetAttribute(&cus, hipDeviceAttributeMultiprocessorCount, dev) != hipSuccess) { fprintf(stderr, "kernel_launch: device query failed\n"); grid = -1; return; }
        if (hipFuncSetAttribute((const void*)mk_fwd, hipFuncAttributeMaxDynamicSharedMemorySize, LDS_BYTES) != hipSuccess) { fprintf(stderr, "kernel_launch: hipFuncSetAttribute failed\n"); grid = -1; return; }
        if (hipOccupancyMaxActiveBlocksPerMultiprocessor(&per_cu, (const void*)mk_fwd, NWAVES * 64, LDS_BYTES) != hipSuccess || per_cu < 1)
            fprintf(stderr, "kernel_launch: note: occupancy query reports %d workgroups per CU\n", per_cu);
        (void)hipGetLastError();
        grid = cus;
    }
    if (grid < 0) return;
    if (hipMemsetAsync((char*)d_ws + WS_CTL, 0, CTL_ZERO_BYTES, stream) != hipSuccess) { fprintf(stderr, "kernel_launch: memset failed\n"); return; }
    Args a{};
    for (int i = 0; i < 23; ++i) a.in[i] = (const float*)d_in[i];
    a.out = (float*)d_out; a.ws = (unsigned char*)d_ws;
    for (int li = 0; li < N_LAUNCHES; ++li) {
        a.ph_lo = (N_LAUNCHES == PER_PHASE) ? li : 0; a.ph_hi = (N_LAUNCHES == PER_PHASE) ? li + 1 : PER_PHASE;
        hipLaunchKernelGGL(mk_fwd, dim3(grid), dim3(NWAVES * 64), LDS_BYTES, stream, a);
#ifdef HOST_DUP_PHASE
        if (N_LAUNCHES == PER_PHASE && li == HOST_DUP_PHASE) {
#ifndef PROBE_MODE
            if (li == 4) (void)hipMemsetAsync((char*)d_ws + WS_ROWSQ, 0, (size_t)T * 4, stream);
#endif
#ifdef PROBE_MODE
            a.probe = PROBE_MODE;
#endif
            hipLaunchKernelGGL(mk_fwd, dim3(grid), dim3(NWAVES * 64), LDS_BYTES, stream, a); a.probe = 0; }
#endif
        const hipError_t le = hipPeekAtLastError();
        if (le != hipSuccess) { fprintf(stderr, "kernel_launch: launch %d failed: %s\n", li, hipGetErrorName(le)); break; }
    }
}
```

```cpp
#include <hip/hip_runtime.h>
#include <cstdio>
#include <cstdint>

#ifndef MK_N_LAUNCHES
#define MK_N_LAUNCHES 1
#endif

namespace pg8 {
#define PG8_LAS __attribute__((address_space(3)))
typedef unsigned short bf16_t;
typedef short bf16x8 __attribute__((ext_vector_type(8)));
typedef float f32x4 __attribute__((ext_vector_type(4)));
typedef unsigned u32x4 __attribute__((ext_vector_type(4)));
typedef unsigned u32x2 __attribute__((ext_vector_type(2)));
constexpr int BM = 256, BK = 64, HALF = 128, HTB = HALF * BK * 2  , STAGE_BYTES = 8 * HTB, NXCD = 8, WGM = 8;

__host__ __device__ __forceinline__ int lds_byte(int r, int c) { const int st = (r >> 4) * 2 + (c >> 5), rr = r & 15, cc = c & 31, ob = rr * 64 + cc * 2; return st * 1024 + (ob ^ (((ob >> 9) & 1) << 5)); }
__host__ __device__ __forceinline__ void stage_rc(int b, int& R, int& C) { const int st = b / 1024, sb = b % 1024, swz = sb ^ (((sb >> 9) & 1) << 5); R = (st >> 1) * 16 + swz / 64; C = (st & 1) * 32 + (swz % 64) / 2; }
__host__ __device__ __forceinline__ int perm32(int rho) { const int n = rho >> 4, i = rho & 15; return 8 * (i >> 2) + 4 * n + (i & 3); }

struct Unit { int pm, pn, br; };

struct StaticOrder {
    int nM, nN, nwg, G, c;
    __host__ __device__ void init(int M, int N, int G_, int c_) { nM = M / BM; nN = N / BM; nwg = nM * nN; G = G_; c = c_; }
    __host__ __device__ bool next(int i, Unit& u) const {
        const long L = (long)i * G + c; if (L >= nwg) return false;
        int wgid = (int)L; { const int q = nwg / NXCD, r = nwg % NXCD, xcd = wgid % NXCD, off = wgid / NXCD; wgid = (xcd < r ? xcd * (q + 1) : r * (q + 1) + (xcd - r) * q) + off; }
        const int nig = WGM * nN, gid = wgid / nig, fm = gid * WGM, gsz = (nM - fm) < WGM ? (nM - fm) : WGM;
        u.pm = fm + ((wgid % nig) % gsz); u.pn = (wgid % nig) / gsz; return true;
    }
};
struct Sched1 {
    StaticOrder so; const char* A; const char* Bt; size_t tstep;
    __device__ __forceinline__ bool next(int i, Unit& u) const { u.br = 0; return so.next(i, u); }
    __device__ __forceinline__ const char* abase(const Unit& u) const { return A + (size_t)u.pm * tstep; }
    __device__ __forceinline__ const char* bbase(const Unit& u) const { return Bt + (size_t)u.pn * tstep; }
    __device__ __forceinline__ void a_ready(const Unit&) const {}
    __device__ __forceinline__ void done(const Unit&) const {}
};
struct Sched3 {
    StaticOrder so; const char* A; const char* Bt; size_t tstep, strideA, strideB;
    __device__ __forceinline__ bool next(int i, Unit& u) const { u.br = i % 3; return so.next(i / 3, u); }
    __device__ __forceinline__ const char* abase(const Unit& u) const { return A + (size_t)u.br * strideA + (size_t)u.pm * tstep; }
    __device__ __forceinline__ const char* bbase(const Unit& u) const { return Bt + (size_t)u.br * strideB + (size_t)u.pn * tstep; }
    __device__ __forceinline__ void a_ready(const Unit&) const {}
    __device__ __forceinline__ void done(const Unit&) const {}
};

typedef float f32x2_t __attribute__((ext_vector_type(2))); typedef __bf16 bf16x2v_t __attribute__((ext_vector_type(2)));
__device__ __forceinline__ unsigned cvt_pk_bf16(float lo, float hi) { const f32x2_t v = {lo, hi}; const bf16x2v_t b = __builtin_convertvector(v, bf16x2v_t); return __builtin_bit_cast(unsigned, b); }
__device__ __forceinline__ u32x4 pack8(const f32x4 a, const f32x4 b) { u32x4 w; w.x = cvt_pk_bf16(a[0], a[1]); w.y = cvt_pk_bf16(a[2], a[3]); w.z = cvt_pk_bf16(b[0], b[1]); w.w = cvt_pk_bf16(b[2], b[3]); return w; }
__device__ __forceinline__ float bflo(unsigned u) { return __builtin_bit_cast(float, u << 16); }
__device__ __forceinline__ float bfhi(unsigned u) { return __builtin_bit_cast(float, u & 0xffff0000u); }


constexpr float RMS_EPS = 1e-6f;

struct EpiProj {
    static constexpr bool PERM = true, AFTER_DRAIN = false, HAS_MID = false;
    const float* rstd; bf16_t *qn, *kn, *pp, *xq, *gates; const float *qg, *kg, *gate_b;
    __device__ __forceinline__ void operator()(const f32x4 (&acc)[2][2][4][2], const Unit& u, int wr, int wc, int fr, int fq) const {
        const int pn = u.pn, row0 = u.pm * BM + wr * 64 + fr, lc0 = 64 * wc + 8 * fq;
        float rsv[2][4];
#pragma unroll
        for (int ai = 0; ai < 2; ++ai)
#pragma unroll
            for (int m = 0; m < 4; ++m) rsv[ai][m] = rstd[row0 + ai * HALF + m * 16];
        if (pn < 4) {
            const bool isq = pn < 2; bf16_t* O = isq ? qn : kn; const float* g = isq ? qg : kg; const float post = isq ? 0.125f : 1.0f;
            f32x4 gv[2][2];
#pragma unroll
            for (int bj = 0; bj < 2; ++bj)
#pragma unroll
                for (int n = 0; n < 2; ++n) gv[bj][n] = *(const f32x4*)(g + 32 * bj + 8 * fq + 4 * n);
            const int colbase = (pn & 1) * 256 + lc0;
#pragma unroll
            for (int ai = 0; ai < 2; ++ai)
#pragma unroll
                for (int m = 0; m < 4; ++m) {
                    const int row = row0 + ai * HALF + m * 16; const float rs = rsv[ai][m];
                    f32x4 v[2][2]; float ss = 0.f;
#pragma unroll
                    for (int bj = 0; bj < 2; ++bj)
#pragma unroll
                        for (int n = 0; n < 2; ++n) { v[bj][n] = acc[ai][bj][m][n] * rs; ss += (v[bj][n][0] * v[bj][n][0] + v[bj][n][1] * v[bj][n][1]) + (v[bj][n][2] * v[bj][n][2] + v[bj][n][3] * v[bj][n][3]); }
                    ss += __shfl_xor(ss, 16); ss += __shfl_xor(ss, 32);
                    const float r = rsqrtf(ss * (1.0f / 64.0f) + RMS_EPS) * post;
#pragma unroll
                    for (int bj = 0; bj < 2; ++bj) *(u32x4*)(O + (size_t)row * 512 + colbase + 32 * bj) = pack8(v[bj][0] * r * gv[bj][0], v[bj][1] * r * gv[bj][1]);
                }
        } else if (pn < 8) {
            bf16_t* O = pn < 6 ? pp : xq; const int colbase = (pn & 1) * 256 + lc0;
#pragma unroll
            for (int ai = 0; ai < 2; ++ai)
#pragma unroll
                for (int m = 0; m < 4; ++m) {
                    const int row = row0 + ai * HALF + m * 16; const float rs = rsv[ai][m];
#pragma unroll
                    for (int bj = 0; bj < 2; ++bj) *(u32x4*)(O + (size_t)row * 512 + colbase + 32 * bj) = pack8(acc[ai][bj][m][0] * rs, acc[ai][bj][m][1] * rs);
                }
        } else {
            const int gcol0 = (pn - 8) * 256 + lc0;
            f32x4 bv[2][2];
#pragma unroll
            for (int bj = 0; bj < 2; ++bj)
#pragma unroll
                for (int n = 0; n < 2; ++n) bv[bj][n] = *(const f32x4*)(gate_b + gcol0 + 32 * bj + 4 * n);
#pragma unroll
            for (int ai = 0; ai < 2; ++ai)
#pragma unroll
                for (int m = 0; m < 4; ++m) {
                    const int row = row0 + ai * HALF + m * 16; const float rs = rsv[ai][m];
#pragma unroll
                    for (int bj = 0; bj < 2; ++bj) {
                        f32x4 o[2];
#pragma unroll
                        for (int n = 0; n < 2; ++n) { const f32x4 z = acc[ai][bj][m][n] * rs + bv[bj][n];
#pragma unroll
                            for (int i = 0; i < 4; ++i) o[n][i] = __builtin_amdgcn_rcpf(1.0f + __expf(-z[i])); }
                        *(u32x4*)(gates + (size_t)row * 3072 + gcol0 + 32 * bj) = pack8(o[0], o[1]);
                    }
                }
        }
    }
};
struct EpiVt {
    static constexpr bool PERM = true, AFTER_DRAIN = false, HAS_MID = false;
    const float* rstd; bf16_t* Vt;
    __device__ __forceinline__ void operator()(const f32x4 (&acc)[2][2][4][2], const Unit& u, int wr, int wc, int fr, int fq) const {
        const int ch0 = u.pm * BM + wr * 64 + fr, tok0 = u.pn * BM + wc * 32 + 8 * fq, b = tok0 >> 13, t0 = tok0 & 8191;
        f32x4 rv[2][2];
#pragma unroll
        for (int bj = 0; bj < 2; ++bj)
#pragma unroll
            for (int n = 0; n < 2; ++n) rv[bj][n] = *(const f32x4*)(rstd + tok0 + bj * HALF + 4 * n);
#pragma unroll
        for (int ai = 0; ai < 2; ++ai)
#pragma unroll
            for (int m = 0; m < 4; ++m) { const int ch = ch0 + ai * HALF + m * 16; bf16_t* rowp = Vt + ((size_t)(b * 512 + ch) * 8192 + t0);
#pragma unroll
                for (int bj = 0; bj < 2; ++bj) *(u32x4*)(rowp + bj * HALF) = pack8(acc[ai][bj][m][0] * rv[bj][0], acc[ai][bj][m][1] * rv[bj][1]); }
    }
};
struct EpiMergeCat {
    static constexpr bool PERM = true, AFTER_DRAIN = false, HAS_MID = true;
    const bf16_t* gates; bf16_t* merged;
    __device__ __forceinline__ void mid(f32x4 (&acc)[2][2][4][2], const Unit& u, int nb  , int wr, int wc, int fr, int fq) const {
        const int row0 = u.pm * BM + wr * 64 + fr, col0 = u.pn * BM + wc * 32 + 8 * fq;
#pragma unroll
        for (int ai = 0; ai < 2; ++ai) {
            u32x4 ga[4][2], gb[4][2];
#pragma unroll
            for (int m = 0; m < 4; ++m)
#pragma unroll
                for (int bj = 0; bj < 2; ++bj) { const bf16_t* gp = gates + (size_t)(row0 + ai * HALF + m * 16) * 3072 + (nb - 1) * 1024 + col0 + bj * HALF;
                    ga[m][bj] = *(const u32x4*)gp; gb[m][bj] = *(const u32x4*)(gp + 1024); }
            __builtin_amdgcn_sched_barrier(0);
#pragma unroll
            for (int m = 0; m < 4; ++m)
#pragma unroll
                for (int bj = 0; bj < 2; ++bj) { const u32x4 a = ga[m][bj], b = gb[m][bj]; f32x4& x0 = acc[ai][bj][m][0]; f32x4& x1 = acc[ai][bj][m][1];
                    x0[0] *= bflo(a.x) * __builtin_amdgcn_rcpf(bflo(b.x)); x0[1] *= bfhi(a.x) * __builtin_amdgcn_rcpf(bfhi(b.x)); x0[2] *= bflo(a.y) * __builtin_amdgcn_rcpf(bflo(b.y)); x0[3] *= bfhi(a.y) * __builtin_amdgcn_rcpf(bfhi(b.y));
                    x1[0] *= bflo(a.z) * __builtin_amdgcn_rcpf(bflo(b.z)); x1[1] *= bfhi(a.z) * __builtin_amdgcn_rcpf(bfhi(b.z)); x1[2] *= bflo(a.w) * __builtin_amdgcn_rcpf(bflo(b.w)); x1[3] *= bfhi(a.w) * __builtin_amdgcn_rcpf(bfhi(b.w)); }
            __builtin_amdgcn_sched_barrier(0);
        }
    }
    __device__ __forceinline__ void operator()(const f32x4 (&acc)[2][2][4][2], const Unit& u, int wr, int wc, int fr, int fq) const {
        const int row0 = u.pm * BM + wr * 64 + fr, col0 = u.pn * BM + wc * 32 + 8 * fq;
#pragma unroll
        for (int ai = 0; ai < 2; ++ai) {
            u32x4 g8[4][2];
#pragma unroll
            for (int m = 0; m < 4; ++m)
#pragma unroll
                for (int bj = 0; bj < 2; ++bj) g8[m][bj] = *(const u32x4*)(gates + (size_t)(row0 + ai * HALF + m * 16) * 3072 + 2048 + col0 + bj * HALF);
            __builtin_amdgcn_sched_barrier(0);
#pragma unroll
            for (int m = 0; m < 4; ++m)
#pragma unroll
                for (int bj = 0; bj < 2; ++bj) { const u32x4 g = g8[m][bj]; f32x4 a = acc[ai][bj][m][0], b = acc[ai][bj][m][1];
                    a[0] *= bflo(g.x); a[1] *= bfhi(g.x); a[2] *= bflo(g.y); a[3] *= bfhi(g.y); b[0] *= bflo(g.z); b[1] *= bfhi(g.z); b[2] *= bflo(g.w); b[3] *= bfhi(g.w);
                    *(u32x4*)(merged + (size_t)(row0 + ai * HALF + m * 16) * 1024 + col0 + bj * HALF) = pack8(a, b); }
            __builtin_amdgcn_sched_barrier(0);
        }
    }
};
struct EpiH {
    static constexpr bool PERM = true, AFTER_DRAIN = false, HAS_MID = false;
    const float* x; float* out; bf16_t* hb; float* rowsq; int noatomic;
    __device__ __forceinline__ void operator()(const f32x4 (&acc)[2][2][4][2], const Unit& u, int wr, int wc, int fr, int fq) const {
        const int row0 = u.pm * BM + wr * 64 + fr, col0 = u.pn * BM + wc * 32 + 8 * fq;
#pragma unroll
        for (int ai = 0; ai < 2; ++ai) {
            f32x4 xv[4][2][2];
#pragma unroll
            for (int m = 0; m < 4; ++m)
#pragma unroll
                for (int bj = 0; bj < 2; ++bj) { const size_t o = (size_t)(row0 + ai * HALF + m * 16) * 1024 + col0 + bj * HALF; xv[m][bj][0] = *(const f32x4*)(x + o); xv[m][bj][1] = *(const f32x4*)(x + o + 4); }
            __builtin_amdgcn_sched_barrier(0);
#pragma unroll
            for (int m = 0; m < 4; ++m) { const int row = row0 + ai * HALF + m * 16; float ss = 0.f;
#pragma unroll
                for (int bj = 0; bj < 2; ++bj) { const size_t o = (size_t)row * 1024 + col0 + bj * HALF;
                    const f32x4 h0 = xv[m][bj][0] + acc[ai][bj][m][0], h1 = xv[m][bj][1] + acc[ai][bj][m][1];
                    *(u32x4*)(hb + o) = pack8(h0, h1);
                    ss += (h0[0] * h0[0] + h0[1] * h0[1]) + (h0[2] * h0[2] + h0[3] * h0[3]) + (h1[0] * h1[0] + h1[1] * h1[1]) + (h1[2] * h1[2] + h1[3] * h1[3]); }
                ss += __shfl_xor(ss, 16); ss += __shfl_xor(ss, 32);
                if (fq == 0 && !noatomic) atomicAdd(rowsq + row, ss); }
            __builtin_amdgcn_sched_barrier(0);
        }
    }
};
struct EpiQ {
    static constexpr bool PERM = true, AFTER_DRAIN = false, HAS_MID = false;
    const float* rowsq; bf16_t* qb;
    __device__ __forceinline__ void operator()(const f32x4 (&acc)[2][2][4][2], const Unit& u, int wr, int wc, int fr, int fq) const {
        const int row0 = u.pm * BM + wr * 64 + fr, col0 = u.pn * BM + wc * 32 + 8 * fq;
        float rq[2][4];
#pragma unroll
        for (int ai = 0; ai < 2; ++ai)
#pragma unroll
            for (int m = 0; m < 4; ++m) rq[ai][m] = rowsq[row0 + ai * HALF + m * 16];
#pragma unroll
        for (int ai = 0; ai < 2; ++ai)
#pragma unroll
            for (int m = 0; m < 4; ++m) { const int row = row0 + ai * HALF + m * 16; const float r = rsqrtf(rq[ai][m] * (1.0f / 1024.0f) + RMS_EPS);
#pragma unroll
                for (int bj = 0; bj < 2; ++bj) *(u32x4*)(qb + (size_t)row * 2048 + col0 + bj * HALF) = pack8(acc[ai][bj][m][0] * r, acc[ai][bj][m][1] * r); }
    }
};

template <class Epi, class Sched, bool ALIGN_EPI = false, bool SP2 = false>
__device__ __forceinline__ void gemm_phase(PG8_LAS unsigned char* lds, const int K, const Sched& S, const Epi& E) {
    const int tid = threadIdx.x, wid = __builtin_amdgcn_readfirstlane(tid >> 6), lane = tid & 63, wr = wid >> 2, wc = wid & 3, fr = lane & 15, fq = lane >> 4;
    const int nt = K / BK;
    unsigned voffA[2], voffB[2];
#pragma unroll
    for (int i = 0; i < 2; ++i) { int R, C; stage_rc(tid * 16 + i * 8192, R, C); const int Rb = Epi::PERM ? ((R & ~31) + perm32(R & 31)) : R;
        voffA[i] = (unsigned)(R * K + C) * 2u; voffB[i] = (unsigned)(Rb * K + C) * 2u; }
    const size_t kstep = (size_t)(BK * 2);
    const size_t hstep = (size_t)HALF * K * 2;
    const size_t tstep = 2 * hstep;
    const unsigned ldsw = (unsigned)wid * 1024u;
    const int aoff = lds_byte(wr * 64 + fr, fq * 8), boff = lds_byte(wc * 32 + fr, fq * 8);
#define PG8_SA(b, h) (((b) * 2 + (h)) * HTB)
#define PG8_SB(b, h) ((4 + (b) * 2 + (h)) * HTB)
#define PG8_STAGE(bufoff, gbase, voff) do { _Pragma("unroll") for (int _i = 0; _i < 2; ++_i) \
        __builtin_amdgcn_global_load_lds((const unsigned*)((const char*)(gbase) + (voff)[_i]), (PG8_LAS unsigned*)(lds + (bufoff) + ldsw + _i * 8192), 16, 0, 0); } while (0)
#define PG8_LDA(dst, b, h) do { _Pragma("unroll") for (int m = 0; m < 4; ++m) _Pragma("unroll") for (int k = 0; k < 2; ++k) dst[m][k] = *(const PG8_LAS bf16x8*)(lds + PG8_SA(b, h) + aoff + m * 2048 + k * 1024); } while (0)
#define PG8_LDB(dst, b, h) do { _Pragma("unroll") for (int n = 0; n < 2; ++n) _Pragma("unroll") for (int k = 0; k < 2; ++k) dst[n][k] = *(const PG8_LAS bf16x8*)(lds + PG8_SB(b, h) + boff + n * 2048 + k * 1024); } while (0)
#define PG8_MMA(ai, bj, At, Bt) do { __builtin_amdgcn_s_setprio(1); _Pragma("unroll") for (int m = 0; m < 4; ++m) _Pragma("unroll") for (int n = 0; n < 2; ++n) _Pragma("unroll") for (int k = 0; k < 2; ++k) \
        acc[ai][bj][m][n] = __builtin_amdgcn_mfma_f32_16x16x32_bf16(Bt[n][k], At[m][k], acc[ai][bj][m][n], 0, 0, 0); __builtin_amdgcn_s_setprio(0); } while (0)
#define PG8_WAIT_V(n) asm volatile("s_waitcnt vmcnt(" #n ")" ::: "memory")
#define PG8_WAIT_L(n) asm volatile("s_waitcnt lgkmcnt(" #n ")" ::: "memory")
#define PG8_BAR __builtin_amdgcn_s_barrier()
#define PG8_SCHED __builtin_amdgcn_sched_barrier(0)
    Unit cur, nxt; int ui = 0;
    if (!S.next(0, cur)) return;
    f32x4 acc[2][2][4][2];
#pragma unroll
    for (int a = 0; a < 2; ++a)
#pragma unroll
        for (int b = 0; b < 2; ++b)
#pragma unroll
            for (int m = 0; m < 4; ++m)
#pragma unroll
                for (int n = 0; n < 2; ++n) acc[a][b][m][n] = (f32x4){0.f, 0.f, 0.f, 0.f};
    bf16x8 At[4][2], B0[2][2], B1[2][2];
    const char* cA = S.abase(cur); const char* cB = S.bbase(cur);
    S.a_ready(cur);
    if constexpr (SP2) {
        PG8_STAGE(PG8_SB(0, 0), cB, voffB); PG8_STAGE(PG8_SB(0, 1), cB + hstep, voffB); PG8_STAGE(PG8_SA(0, 0), cA, voffA); PG8_STAGE(PG8_SA(0, 1), cA + hstep, voffA);
        if (wr == 1) PG8_BAR;
        PG8_WAIT_V(2); PG8_BAR;
        PG8_STAGE(PG8_SB(1, 0), cB + kstep, voffB); PG8_STAGE(PG8_SA(1, 0), cA + kstep, voffA); PG8_STAGE(PG8_SB(1, 1), cB + hstep + kstep, voffB);
        PG8_WAIT_V(6); PG8_BAR;
    } else {
        PG8_STAGE(PG8_SB(0, 0), cB, voffB); PG8_STAGE(PG8_SA(0, 0), cA, voffA); PG8_STAGE(PG8_SB(0, 1), cB + hstep, voffB); PG8_STAGE(PG8_SA(0, 1), cA + hstep, voffA);
        if (wr == 1) PG8_BAR;
        PG8_WAIT_V(4); PG8_BAR;
        PG8_STAGE(PG8_SB(1, 0), cB + kstep, voffB); PG8_STAGE(PG8_SA(1, 0), cA + kstep, voffA); PG8_STAGE(PG8_SB(1, 1), cB + hstep + kstep, voffB);
        PG8_WAIT_V(6); PG8_BAR;
    }
    for (;;) {
        const bool has_next = S.next(ui + 1, nxt);
        const char* nA = has_next ? S.abase(nxt) : cA; const char* nB = has_next ? S.bbase(nxt) : cB;
        for (int t = 0; t < nt; t += 2) {
            if constexpr (Epi::HAS_MID) { if (t == 8 || t == 16) E.mid(acc, cur, t >> 3, wr, wc, fr, fq); }
            const bool last = (t == nt - 2);
            const char* a1 = cA + (size_t)(t + 1) * kstep;
            const char* a2 = last ? nA : cA + (size_t)(t + 2) * kstep; const char* b2 = last ? nB : cB + (size_t)(t + 2) * kstep;
            const char* a3 = a2 + kstep; const char* b3 = b2 + kstep;
            if (last && has_next) S.a_ready(nxt);
            if constexpr (SP2) {
            PG8_LDB(B0, 0, 0); PG8_LDB(B1, 0, 1); PG8_SCHED; PG8_LDA(At, 0, 0); PG8_STAGE(PG8_SA(1, 1), a1 + hstep, voffA);
            PG8_WAIT_V(8); PG8_WAIT_L(0); PG8_BAR; PG8_MMA(0, 0, At, B0); PG8_MMA(0, 1, At, B1); PG8_BAR; PG8_SCHED;
            PG8_LDA(At, 0, 1); PG8_STAGE(PG8_SB(0, 0), b2, voffB); PG8_STAGE(PG8_SB(0, 1), b2 + hstep, voffB); PG8_STAGE(PG8_SA(0, 0), a2, voffA);
            PG8_WAIT_V(8); PG8_WAIT_L(0); PG8_BAR; PG8_MMA(1, 0, At, B0); PG8_MMA(1, 1, At, B1); PG8_BAR; PG8_SCHED;
            PG8_LDB(B0, 1, 0); PG8_LDB(B1, 1, 1); PG8_SCHED; PG8_LDA(At, 1, 0); PG8_STAGE(PG8_SA(0, 1), a2 + hstep, voffA);
            PG8_WAIT_V(8); PG8_WAIT_L(0); PG8_BAR; PG8_MMA(0, 0, At, B0); PG8_MMA(0, 1, At, B1); PG8_BAR; PG8_SCHED;
            PG8_LDA(At, 1, 1); PG8_STAGE(PG8_SB(1, 0), b3, voffB); PG8_STAGE(PG8_SB(1, 1), b3 + hstep, voffB); PG8_STAGE(PG8_SA(1, 0), a3, voffA);
            PG8_WAIT_V(8); PG8_WAIT_L(0); PG8_BAR; PG8_MMA(1, 0, At, B0); PG8_MMA(1, 1, At, B1); PG8_BAR; PG8_SCHED;
            } else {
            PG8_LDB(B0, 0, 0); PG8_SCHED; PG8_LDA(At, 0, 0); PG8_STAGE(PG8_SA(1, 1), a1 + hstep, voffA);
            PG8_WAIT_L(8); PG8_BAR; PG8_WAIT_L(0); PG8_MMA(0, 0, At, B0); PG8_BAR; PG8_SCHED;
            PG8_LDB(B1, 0, 1); PG8_STAGE(PG8_SB(0, 0), b2, voffB);
            PG8_BAR; PG8_WAIT_L(0); PG8_MMA(0, 1, At, B1); PG8_BAR;
            PG8_LDA(At, 0, 1); PG8_STAGE(PG8_SA(0, 0), a2, voffA);
            PG8_BAR; PG8_WAIT_L(0); PG8_MMA(1, 0, At, B0); PG8_BAR; PG8_SCHED;
            PG8_STAGE(PG8_SB(0, 1), b2 + hstep, voffB);
            PG8_WAIT_V(6); PG8_BAR; PG8_MMA(1, 1, At, B1); PG8_BAR;
            PG8_LDB(B0, 1, 0); PG8_SCHED; PG8_LDA(At, 1, 0); PG8_STAGE(PG8_SA(0, 1), a2 + hstep, voffA);
            PG8_WAIT_L(8); PG8_BAR; PG8_WAIT_L(0); PG8_MMA(0, 0, At, B0); PG8_BAR; PG8_SCHED;
            PG8_LDB(B1, 1, 1); PG8_STAGE(PG8_SB(1, 0), b3, voffB);
            PG8_BAR; PG8_WAIT_L(0); PG8_MMA(0, 1, At, B1); PG8_BAR;
            PG8_LDA(At, 1, 1); PG8_STAGE(PG8_SA(1, 0), a3, voffA);
            PG8_BAR; PG8_WAIT_L(0); PG8_MMA(1, 0, At, B0); PG8_BAR; PG8_SCHED;
            PG8_STAGE(PG8_SB(1, 1), b3 + hstep, voffB);
            PG8_WAIT_V(6); PG8_BAR; PG8_MMA(1, 1, At, B1); PG8_BAR;
            }
        }
        if constexpr (ALIGN_EPI) { if (wr == 0) PG8_BAR; }
        if constexpr (!Epi::AFTER_DRAIN) { E(acc, cur, wr, wc, fr, fq); S.done(cur); }
        if (!has_next) break;
#pragma unroll
        for (int a = 0; a < 2; ++a)
#pragma unroll
            for (int b = 0; b < 2; ++b)
#pragma unroll
                for (int m = 0; m < 4; ++m)
#pragma unroll
                    for (int n = 0; n < 2; ++n) acc[a][b][m][n] = (f32x4){0.f, 0.f, 0.f, 0.f};
        cur = nxt; cA = nA; cB = nB; ++ui;
        if constexpr (ALIGN_EPI) { if (wr == 1) PG8_BAR; }
    }
    PG8_WAIT_V(0);
    if constexpr (!ALIGN_EPI) { if (wr == 0) PG8_BAR; }
    PG8_BAR;
    if constexpr (Epi::AFTER_DRAIN) { E.fused(acc, cur, wr, wc, fr, fq, lds, wid, lane); S.done(cur); }
#undef PG8_SA
#undef PG8_SB
#undef PG8_STAGE
#undef PG8_LDA
#undef PG8_LDB
#undef PG8_MMA
#undef PG8_WAIT_V
#undef PG8_WAIT_L
#undef PG8_BAR
#undef PG8_SCHED
}
}

constexpr int NWAVES = 8;
constexpr int N_LAUNCHES = MK_N_LAUNCHES;
constexpr int PER_PHASE = 9;
constexpr int NBATCH = 4, SEQ = 8192, D = 1024, T = NBATCH * SEQ, MEMLEN = 256, NMEMTOK = NBATCH * MEMLEN;
constexpr int IN_MAIN = 5120;
constexpr int NEXP = 16384;

constexpr size_t MiB = 1u << 20;
constexpr size_t WS_CTL = 0, CTL_ZERO_BYTES = 512 * 1024;
constexpr size_t WS_ROWSQ = 256 * 1024;
constexpr size_t WS_WIN = 1 * MiB, WS_WV = 11 * MiB, WS_WKV = 12 * MiB, WS_WBR = 14 * MiB, WS_WOUT = 17 * MiB, WS_WQ = 19 * MiB, WS_KEYS = 23 * MiB, WS_PWT = 23 * MiB + 512 * 1024;
constexpr size_t WS_MEMN = 24 * MiB, WS_KMEM = 26 * MiB, WS_VTMEM = 27 * MiB, WS_RSTDX = 28 * MiB, WS_SU = 28 * MiB + 256 * 1024  , WS_SV = 28 * MiB + 512 * 1024  ;
constexpr size_t WS_U8 = 32 * MiB, WS_V8 = 48 * MiB;
constexpr size_t WS_QN = 96 * MiB, WS_KN = 128 * MiB, WS_VT = 160 * MiB, WS_PP = 192 * MiB, WS_XQ = 224 * MiB, WS_GATE = 256 * MiB, WS_END = 448 * MiB;
constexpr size_t WS_MERGED = WS_QN;
constexpr size_t WS_HB = WS_VT;
constexpr size_t WS_QB = WS_GATE;
constexpr size_t WS_TE = WS_GATE + 128 * MiB, WS_TW = WS_TE + 16 * MiB;
constexpr size_t WS_HQ = WS_TW + 16 * MiB;
constexpr size_t WS_HS = 28 * MiB + 768 * 1024;
constexpr size_t WS_AW = WS_MERGED;
constexpr size_t OUT_XB = 0, OUT_YNA = 0, OUT_YPOOL = 512 * 2, OUT_YXA = 1024 * 2;
constexpr int CW_TMO = 0, CW_BAR = 4096, CW_TICKET = 8192;

constexpr int RING_OFF = 0, RING_BYTES = 131072;
constexpr int LDSCTL_OFF = RING_BYTES, MISC_OFF = LDSCTL_OFF + 320;
constexpr int LDS_BYTES = 147456;

#define GAS __attribute__((address_space(1)))
#define LAS __attribute__((address_space(3)))
typedef unsigned short bf16;
typedef unsigned v4u __attribute__((ext_vector_type(4)));
typedef unsigned v2u __attribute__((ext_vector_type(2)));
typedef float f32x4 __attribute__((ext_vector_type(4)));
typedef short bf16x8 __attribute__((ext_vector_type(8)));
typedef __bf16 bf16x2_t __attribute__((ext_vector_type(2)));
typedef GAS unsigned gu32;
#define LDS_WAIT() asm volatile("s_waitcnt lgkmcnt(0)" ::: "memory")
#define VM_WAIT() asm volatile("s_waitcnt vmcnt(0)" ::: "memory")
__device__ __forceinline__ unsigned f2bf(float f) { unsigned u = __builtin_bit_cast(unsigned, f); return (u + 0x7fffu + ((u >> 16) & 1u)) >> 16; }
__device__ __forceinline__ unsigned pk2(float lo, float hi) { return f2bf(lo) | (f2bf(hi) << 16); }
__device__ __forceinline__ float bflo(unsigned u) { return __builtin_bit_cast(float, u << 16); }
__device__ __forceinline__ float bfhi(unsigned u) { return __builtin_bit_cast(float, u & 0xffff0000u); }
__device__ __forceinline__ float bf1(short s) { return __builtin_bit_cast(float, ((unsigned)(unsigned short)s) << 16); }
__device__ __forceinline__ f32x4 mfma16(bf16x8 a, bf16x8 b, f32x4 c) { return __builtin_amdgcn_mfma_f32_16x16x32_bf16(a, b, c, 0, 0, 0); }
__device__ __forceinline__ float wave_sum(float v) {
#pragma unroll
    for (int o = 1; o < 64; o <<= 1) v += __shfl_xor(v, o);
    return v;
}

#define XB_TMO      128
#define XB_XCNT(j)  (256  + 64 * (j))
#define XB_XSUB(j)  (1280 + 64 * (j))
#define XB_XGEN(j)  (2304 + 64 * (j))
#define XB_TOP      3328
#define XB_TOPGEN   3392
#define XCD_BAR_WORDS 3456
#define XB_SPIN_CAP (1u << 18)

__device__ __forceinline__ unsigned xb_ld(unsigned* p)              { return __hip_atomic_load(p, __ATOMIC_RELAXED, __HIP_MEMORY_SCOPE_AGENT); }
__device__ __forceinline__ unsigned xb_add(unsigned* p, unsigned v) { return __hip_atomic_fetch_add(p, v, __ATOMIC_RELAXED, __HIP_MEMORY_SCOPE_AGENT); }
__device__ __forceinline__ unsigned xb_xcc_id() { return (unsigned)__builtin_amdgcn_s_getreg((3 << 11) | 20) & 0xFu; }
#define XB_SPIN(cond, bar) do { unsigned _sp = 0; while (cond) { __builtin_amdgcn_s_sleep(1); \
    if ((++_sp & 255u) == 0u) { if (xb_ld(&(bar)[XB_TMO])) break; if (_sp > XB_SPIN_CAP) { atomicAdd(&(bar)[XB_TMO], 1u); break; } } } } while (0)

struct XcdBarrier {
    unsigned* bar; unsigned x;
    volatile LAS unsigned* st;
};

__device__ __forceinline__ XcdBarrier xcd_barrier_post(unsigned* bar, volatile LAS unsigned* st) {
    XcdBarrier b; b.bar = bar; b.x = xb_xcc_id(); b.st = st;
    if (threadIdx.x == 0) (void)xb_add(&bar[XB_XCNT(b.x)], 1u);
    return b;
}
__device__ __forceinline__ void xcd_barrier_complete(unsigned* bar, unsigned x, unsigned& nloc, unsigned& nx) {
    const unsigned G = gridDim.x * gridDim.y * gridDim.z;
    unsigned sum, cnt, mine, sp = 0u;
    for (;;) {
        sum = 0u; cnt = 0u; mine = 0u;
#pragma unroll
        for (unsigned j = 0; j < 16; ++j) { const unsigned c = xb_ld(&bar[XB_XCNT(j)]); sum += c; cnt += (c > 0u) ? 1u : 0u; mine = (j == x) ? c : mine; }
        if (sum == G) break;
        __builtin_amdgcn_s_sleep(1);
        if ((++sp & 255u) == 0u) { if (xb_ld(&bar[XB_TMO])) break; if (sp > XB_SPIN_CAP) { atomicAdd(&bar[XB_TMO], 1u); break; } }
    }
    nloc = mine > 0u ? mine : 1u; nx = cnt > 0u ? cnt : 1u;
}

__device__ __forceinline__ void xcd_barrier(const XcdBarrier& b) {
    asm volatile("s_waitcnt vmcnt(0)" ::: "memory");
    __syncthreads();
    if (threadIdx.x == 0) {
        unsigned* bar = b.bar;
        __builtin_amdgcn_s_waitcnt(0);
        unsigned nloc = b.st[0], nx = b.st[1];
        if (nloc == 0u) { xcd_barrier_complete(bar, b.x, nloc, nx); b.st[0] = nloc; b.st[1] = nx; }
        const unsigned old = xb_add(&bar[XB_XSUB(b.x)], 1u);
        const unsigned gen = old / nloc;
        if (old + 1u == (gen + 1u) * nloc) {
            __builtin_amdgcn_fence(__ATOMIC_RELEASE, "agent");
            asm volatile("s_waitcnt vmcnt(0)" ::: "memory");
            const unsigned og = xb_add(&bar[XB_TOP], 1u);
            const unsigned tg = og / nx;
            if (og + 1u == (tg + 1u) * nx) xb_add(&bar[XB_TOPGEN], 1u);
            else XB_SPIN(xb_ld(&bar[XB_TOPGEN]) == tg, bar);
            __builtin_amdgcn_fence(__ATOMIC_ACQUIRE, "agent");
            xb_add(&bar[XB_XGEN(b.x)], 1u);
            asm volatile("s_waitcnt vmcnt(0)" ::: "memory");
        } else {
            XB_SPIN(xb_ld(&bar[XB_XGEN(b.x)]) == gen, bar);
            __builtin_amdgcn_fence(__ATOMIC_ACQUIRE, "agent");
            asm volatile("s_waitcnt vmcnt(0)" ::: "memory");
        }
    }
    __syncthreads();
}

struct Frame {
    LAS unsigned char* lds;
    volatile LAS unsigned* MISC;
    gu32* ctl;
    int tid, lane, wave, vcu, G;
    float* out; unsigned char* ws;
};
struct Args { const float* in[23]; float* out; unsigned char* ws; int ph_lo, ph_hi, probe, pad; };
enum { I_X = 0, I_MEM, I_MIXG, I_MEMG, I_WIN, I_GATEB, I_WKV, I_NAQG, I_NAKG, I_RPB, I_POOLW, I_POOLSC, I_XAQG, I_XAKG, I_WB0, I_WB1, I_WB2, I_WOUT, I_FFNG, I_WQ, I_KEYS, I_PU, I_PV };

__device__ __forceinline__ void p0_transpose_item(const float* W, int K, int N, int k0, int n0, bf16* dst, const float* kscale, LAS float* scr, int lane, int dpitch = 0) {
    if (dpitch == 0) dpitch = K;
#pragma unroll 8
    for (int i = 0; i < 32; ++i) { const int kk = 2 * i + (lane >> 5); float v = W[(size_t)(k0 + kk) * N + n0 + (lane & 31)]; if (kscale) v *= kscale[k0 + kk]; scr[kk * 33 + (lane & 31)] = v; }
    LDS_WAIT(); asm volatile("" ::: "memory");
    const int c = lane & 7;
#pragma unroll
    for (int j = 0; j < 4; ++j) { const int n = (lane >> 3) + 8 * j; const LAS float* s = scr + (8 * c) * 33 + n;
        v4u o; o.x = pk2(s[0 * 33], s[1 * 33]); o.y = pk2(s[2 * 33], s[3 * 33]); o.z = pk2(s[4 * 33], s[5 * 33]); o.w = pk2(s[6 * 33], s[7 * 33]);
        *(GAS v4u*)(dst + (size_t)n * dpitch + k0 + 8 * c) = o; }
    LDS_WAIT(); asm volatile("" ::: "memory");
}
__device__ __forceinline__ void cvt_row1024(const float* src, bf16* dst, const float* colscale, float rowscale, int lane) {
    const GAS f32x4* xr = (const GAS f32x4*)src + lane; GAS unsigned long long* o8 = (GAS unsigned long long*)dst + lane;
#pragma unroll
    for (int j = 0; j < 4; ++j) { f32x4 v = xr[64 * j] * rowscale; if (colscale) v = v * ((const GAS f32x4*)colscale)[lane + 64 * j];
        o8[64 * j] = (unsigned long long)pk2(v.x, v.y) | ((unsigned long long)pk2(v.z, v.w) << 32); }
}
__device__ __forceinline__ float row_rstd1024(const float* src, int lane) {
    const GAS f32x4* xr = (const GAS f32x4*)src + lane; float s = 0.f;
#pragma unroll
    for (int j = 0; j < 4; ++j) { const f32x4 v = xr[64 * j]; s += (v.x * v.x + v.y * v.y) + (v.z * v.z + v.w * v.w); }
    return rsqrtf(wave_sum(s) * (1.0f / 1024.0f) + 1e-6f);
}
__device__ __forceinline__ void p0_prologue(Frame& F, const Args& A) {
    LAS float* scr = (LAS float*)(F.lds + RING_OFF + F.wave * 16384);
    const int gw = F.vcu * NWAVES + F.wave, NGW = F.G * NWAVES, lane = F.lane;
    unsigned char* ws = F.ws;
    constexpr int I_IN = 16 * 176, I_KV = 16 * 32, I_BR = 8 * 32, I_OUT = 16 * 32, I_Q = 16 * 64;
    constexpr int NITEMS = I_IN + I_KV + 3 * I_BR + I_OUT + I_Q;
    for (int it = gw; it < NITEMS; it += NGW) {
        int r = it;
        if (r < I_IN) { const int kb = r / 176, nb = r % 176, n0 = 32 * nb; bf16* dst;
            if (n0 >= 1024 && n0 < 1536) dst = (bf16*)(ws + WS_WV) + (size_t)(n0 - 1024) * 1024;
            else { const int np = n0 < 1024 ? n0 : n0 - 512, t = np >> 8, w = np & 255, wc = w >> 6, bj = (w >> 5) & 1; dst = (bf16*)(ws + WS_WIN) + (size_t)(256 * t + 128 * bj + 32 * wc) * 1024; }
            p0_transpose_item(A.in[I_WIN], 1024, 5632, 64 * kb, n0, dst, A.in[I_MIXG], scr, lane); continue; }
        r -= I_IN;
        if (r < I_KV) { const int kb = r / 32, nb = r % 32; p0_transpose_item(A.in[I_WKV], 1024, 1024, 64 * kb, 32 * nb, (bf16*)(ws + WS_WKV) + (size_t)(32 * nb) * 1024, nullptr, scr, lane); continue; }
        r -= I_KV;
        if (r < 3 * I_BR) { const int br = r / I_BR, rr = r % I_BR, kb = rr / 32, nb = rr % 32; const float* W = br == 0 ? A.in[I_WB0] : (br == 1 ? A.in[I_WB1] : A.in[I_WB2]);
            p0_transpose_item(W, 512, 1024, 64 * kb, 32 * nb, (bf16*)(ws + WS_WBR) + (size_t)(32 * nb) * 1536 + br * 512, nullptr, scr, lane, 1536); continue; }
        r -= 3 * I_BR;
        if (r < I_OUT) { const int kb = r / 32, nb = r % 32; p0_transpose_item(A.in[I_WOUT], 1024, 1024, 64 * kb, 32 * nb, (bf16*)(ws + WS_WOUT) + (size_t)(32 * nb) * 1024, nullptr, scr, lane); continue; }
        r -= I_OUT;
        { const int kb = r / 64, nb = r % 64; p0_transpose_item(A.in[I_WQ], 1024, 2048, 64 * kb, 32 * nb, (bf16*)(ws + WS_WQ) + (size_t)(32 * nb) * 1024, A.in[I_FFNG], scr, lane); }
    }
    { bf16* xb = (bf16*)((unsigned char*)F.out + OUT_XB); float* rstdx = (float*)(ws + WS_RSTDX);
      for (int m0 = 4 * gw; m0 < T; m0 += 4 * NGW) {
          f32x4 v[4][4];
#pragma unroll
          for (int r = 0; r < 4; ++r)
#pragma unroll
              for (int j = 0; j < 4; ++j) v[r][j] = ((const GAS f32x4*)(A.in[I_X] + (size_t)(m0 + r) * D))[lane + 64 * j];
#pragma unroll
          for (int r = 0; r < 4; ++r) { float s = 0.f;
#pragma unroll
              for (int j = 0; j < 4; ++j) s += (v[r][j].x * v[r][j].x + v[r][j].y * v[r][j].y) + (v[r][j].z * v[r][j].z + v[r][j].w * v[r][j].w);
              const float rs = rsqrtf(wave_sum(s) * (1.0f / 1024.0f) + 1e-6f);
              GAS unsigned long long* o8 = (GAS unsigned long long*)(xb + (size_t)(m0 + r) * D) + lane;
#pragma unroll
              for (int j = 0; j < 4; ++j) o8[64 * j] = (unsigned long long)pk2(v[r][j].x, v[r][j].y) | ((unsigned long long)pk2(v[r][j].z, v[r][j].w) << 32);
              if (lane == 0) rstdx[m0 + r] = rs; } } }
    for (int m = gw; m < NMEMTOK; m += NGW) { const float* xr = A.in[I_MEM] + (size_t)m * D; const float rs = row_rstd1024(xr, lane); cvt_row1024(xr, (bf16*)(ws + WS_MEMN) + (size_t)m * D, A.in[I_MEMG], rs, lane); }
    for (int mb = 4 * gw; mb < 2 * NEXP; mb += 4 * NGW) {
        const bool isu = mb < NEXP; const int e0 = isu ? mb : mb - NEXP;
        f32x4 v[4][4];
#pragma unroll
        for (int r = 0; r < 4; ++r) { const GAS f32x4* src = (const GAS f32x4*)((isu ? A.in[I_PU] : A.in[I_PV]) + (size_t)(e0 + r) * D) + 4 * lane;
#pragma unroll
            for (int d = 0; d < 4; ++d) v[r][d] = src[d]; }
        f32x4 gv[4];
#pragma unroll
        for (int d = 0; d < 4; ++d) gv[d] = isu ? ((const GAS f32x4*)A.in[I_FFNG])[4 * lane + d] : (f32x4){1.f, 1.f, 1.f, 1.f};
#pragma unroll
        for (int r = 0; r < 4; ++r) { const int e = e0 + r; float mx = 0.f;
#pragma unroll
            for (int d = 0; d < 4; ++d) { v[r][d] = v[r][d] * gv[d]; mx = fmaxf(mx, fmaxf(fmaxf(fabsf(v[r][d].x), fabsf(v[r][d].y)), fmaxf(fabsf(v[r][d].z), fabsf(v[r][d].w)))); }
#pragma unroll
            for (int o = 1; o < 64; o <<= 1) mx = fmaxf(mx, __shfl_xor(mx, o));
            const float inv = mx > 0.f ? 127.0f / mx : 0.f;
            v4u w;
#pragma unroll
            for (int d = 0; d < 4; ++d) { const unsigned b0 = (unsigned)(int)rintf(v[r][d].x * inv) & 0xffu, b1 = (unsigned)(int)rintf(v[r][d].y * inv) & 0xffu,
                                                         b2 = (unsigned)(int)rintf(v[r][d].z * inv) & 0xffu, b3 = (unsigned)(int)rintf(v[r][d].w * inv) & 0xffu;
                w[d] = b0 | (b1 << 8) | (b2 << 16) | (b3 << 24); }
            if (isu) ((GAS v4u*)(ws + WS_U8))[(size_t)e * 64 + lane] = w;
            else *(GAS v4u*)(ws + WS_V8 + (size_t)(lane >> 3) * (2 * MiB) + (size_t)e * 128 + (lane & 7) * 16) = w;
            if (lane == 0) ((float*)(ws + WS_SU))[2 * e + (isu ? 0 : 1)] = mx * (1.0f / 127.0f); }
    }
    for (int m = gw * 64 + lane; m < T; m += NGW * 64) ((float*)(ws + WS_ROWSQ))[m] = 0.f;
    for (int m = gw; m < 256; m += NGW) cvt_row1024(A.in[I_KEYS] + (size_t)m * 1024, (bf16*)(ws + WS_KEYS) + (size_t)m * 1024, nullptr, 1.0f, lane);
    for (int m = gw; m < 1024; m += NGW) { const int gd = m >> 1, c = (m & 1) * 64 + lane, g = gd >> 7, d = gd & 127;
        const float v = A.in[I_POOLW][(size_t)(g * 128 + c) * 128 + d] * A.in[I_POOLSC][gd];
        ((bf16*)(ws + WS_PWT))[(size_t)gd * 128 + c] = (bf16)f2bf(v); }
}

__device__ __forceinline__ void memkv_tile(const bf16* memn, const bf16* wkvT, const float* kg, const float* qg, bf16* kmem, bf16* vtmem, int tile, int lane) {
    const int q = lane & 15, hi = lane >> 4, rg = tile >> 3, cg = tile & 7, r0 = rg * 16, c0 = cg * 128;
    f32x4 acc[8];
#pragma unroll
    for (int i = 0; i < 8; ++i) acc[i] = (f32x4){0.f, 0.f, 0.f, 0.f};
    const bf16* ap = memn + (size_t)(r0 + q) * 1024 + 8 * hi; const bf16* bp = wkvT + (size_t)(c0 + q) * 1024 + 8 * hi;
#pragma unroll 1
    for (int kb = 0; kb < 8; ++kb) {
        bf16x8 a[4], b[4][8];
#pragma unroll
        for (int k4 = 0; k4 < 4; ++k4) { a[k4] = *(const bf16x8*)(ap + 32 * (4 * kb + k4));
#pragma unroll
            for (int nf = 0; nf < 8; ++nf) b[k4][nf] = *(const bf16x8*)(bp + (size_t)(16 * nf) * 1024 + 32 * (4 * kb + k4)); }
        __builtin_amdgcn_sched_barrier(0);
#pragma unroll
        for (int k4 = 0; k4 < 4; ++k4)
#pragma unroll
            for (int nf = 0; nf < 8; ++nf) acc[nf] = mfma16(a[k4], b[k4][nf], acc[nf]);
        __builtin_amdgcn_sched_barrier(0);
    }
    if (cg < 4) {
        float rr[4];
#pragma unroll
        for (int g = 0; g < 4; ++g) { float ss = 0.f;
#pragma unroll
            for (int nf = 0; nf < 8; ++nf) ss += acc[nf][g] * acc[nf][g];
            ss += __shfl_xor(ss, 1); ss += __shfl_xor(ss, 2); ss += __shfl_xor(ss, 4); ss += __shfl_xor(ss, 8);
            rr[g] = rsqrtf(ss * (1.0f / 128.0f) + 1e-6f); }
#pragma unroll
        for (int nf = 0; nf < 8; ++nf) { const int d = 16 * nf + q; const float gs = kg[d] * qg[d];
#pragma unroll
            for (int g = 0; g < 4; ++g) kmem[(size_t)(r0 + 4 * hi + g) * 512 + cg * 128 + d] = (bf16)f2bf(acc[nf][g] * rr[g] * gs); }
    } else {
        const int h = cg - 4, b = r0 >> 8, key0 = (r0 & 255) + 4 * hi;
#pragma unroll
        for (int nf = 0; nf < 8; ++nf) { const int d = 16 * nf + q; v2u w; w.x = pk2(acc[nf][0], acc[nf][1]); w.y = pk2(acc[nf][2], acc[nf][3]);
            *(v2u*)(vtmem + (size_t)(b * 512 + h * 128 + d) * 256 + key0) = w; }
    }
}

__device__ __forceinline__ void na_item(const bf16* __restrict__ qn, const bf16* __restrict__ kn, const bf16* __restrict__ vt, const LAS float* rpl, bf16* __restrict__ yna,
                                        int b, int r, int jb, int h, int lane) {
    const int q = lane & 15, hi = lane >> 4;
    int rs = r - 4; rs = rs < 0 ? 0 : (rs > 120 ? 120 : rs);
    int kb0 = jb * 16 - 8; kb0 = kb0 < 0 ? 0 : (kb0 > 32 ? 32 : kb0);
    const int qcol = jb * 16 + q; int cs = qcol - 8; cs = cs < 0 ? 0 : (cs > 48 ? 48 : cs);
    const size_t tokq = (size_t)b * SEQ + r * 64 + qcol;
    const bf16* qp = qn + tokq * 512 + h * 64 + 8 * hi;
    const bf16x8 qf0 = *(const bf16x8*)qp, qf1 = *(const bf16x8*)(qp + 32);
    const int kq = 8 * (q >> 2) + (q & 3);
    const bf16* kbase = kn + ((size_t)b * SEQ + rs * 64 + kb0 + kq) * 512 + h * 64 + 8 * hi;
    f32x4 s[16];
    {
        bf16x8 ka[16][2];
#pragma unroll
        for (int f = 0; f < 16; ++f) { const bf16* kp = kbase + (size_t)((f >> 1) * 64 + (f & 1) * 4) * 512; ka[f][0] = *(const bf16x8*)kp; ka[f][1] = *(const bf16x8*)(kp + 32); }
        __builtin_amdgcn_sched_barrier(0);
#pragma unroll
        for (int f = 0; f < 16; ++f) { f32x4 z = (f32x4){0.f, 0.f, 0.f, 0.f}; z = mfma16(ka[f][0], qf0, z); s[f] = mfma16(ka[f][1], qf1, z); }
    }
    const bf16* vbase = vt + ((size_t)(b * 512 + h * 64 + q) * SEQ + rs * 64 + kb0 + 8 * hi);
    bf16x8 va[8][4];
#pragma unroll
    for (int st = 0; st < 8; ++st)
#pragma unroll
        for (int mf = 0; mf < 4; ++mf) va[st][mf] = *(const bf16x8*)(vbase + (size_t)(16 * mf) * SEQ + st * 64);
    __builtin_amdgcn_sched_barrier(0);
    float mx = -3.0e38f;
#pragma unroll
    for (int f = 0; f < 16; ++f) {
        const int dr = rs + (f >> 1) - r + 7;
#pragma unroll
        for (int g = 0; g < 4; ++g) {
            const int kcol = kb0 + 8 * hi + 4 * (f & 1) + g;
            const bool ok = (kcol >= cs) && (kcol < cs + 16);
            int dc = kcol - qcol + 15; dc = dc < 0 ? 0 : (dc > 30 ? 30 : dc);
            const float v = ok ? s[f][g] + rpl[dr * 31 + dc] : -1.0e30f;
            s[f][g] = v; mx = fmaxf(mx, v);
        }
    }
    mx = fmaxf(mx, __shfl_xor(mx, 16)); mx = fmaxf(mx, __shfl_xor(mx, 32));
    float sum = 0.f;
#pragma unroll
    for (int f = 0; f < 16; ++f)
#pragma unroll
        for (int g = 0; g < 4; ++g) { const float p = __expf(s[f][g] - mx); s[f][g] = p; sum += p; }
    sum += __shfl_xor(sum, 16); sum += __shfl_xor(sum, 32);
    const float inv = 1.0f / sum;
    f32x4 o[4];
#pragma unroll
    for (int i = 0; i < 4; ++i) o[i] = (f32x4){0.f, 0.f, 0.f, 0.f};
#pragma unroll
    for (int st = 0; st < 8; ++st) {
        const bf16x8 pb = __builtin_bit_cast(bf16x8, pg8::pack8(s[2 * st], s[2 * st + 1]));
#pragma unroll
        for (int mf = 0; mf < 4; ++mf) o[mf] = mfma16(va[st][mf], pb, o[mf]);
    }
    bf16* yp = yna + tokq * 1536 + h * 64 + 4 * hi;
#pragma unroll
    for (int mf = 0; mf < 4; ++mf) { v2u w; w.x = pk2(o[mf][0] * inv, o[mf][1] * inv); w.y = pk2(o[mf][2] * inv, o[mf][3] * inv); *(v2u*)(yp + 16 * mf) = w; }
}
__device__ __forceinline__ void xa_fill_lds(const bf16* __restrict__ kmem, const bf16* __restrict__ vtmem, LAS unsigned char* lds, int b, int h, int tid) {
#pragma unroll
    for (int ps = 0; ps < 8; ++ps) { const int id = tid + 512 * ps, key = id >> 4, c = id & 15;
        *(LAS v4u*)(lds + key * 256 + ((c ^ (key & 15)) << 4)) = *(const v4u*)(kmem + ((size_t)b * 256 + key) * 512 + h * 128 + 8 * c); }
#pragma unroll
    for (int ps = 0; ps < 8; ++ps) { const int id = tid + 512 * ps, dim = id >> 5, c = id & 31;
        *(LAS v4u*)(lds + 65536 + dim * 512 + ((c ^ (dim & 15)) << 4)) = *(const v4u*)(vtmem + (size_t)(b * 512 + h * 128 + dim) * 256 + 8 * c); }
}
__device__ __forceinline__ void xa_item(const bf16* __restrict__ xq, const LAS unsigned char* lds, bf16* __restrict__ yxa, int tok0, int h, int lane) {
    const int q = lane & 15, hi = lane >> 4; const size_t tok = (size_t)tok0 + q;
    const bf16* qp = xq + tok * 512 + h * 128 + 8 * hi;
    bf16x8 qf[4]; float ssq = 0.f;
#pragma unroll
    for (int ks = 0; ks < 4; ++ks) qf[ks] = *(const bf16x8*)(qp + 32 * ks);
    __builtin_amdgcn_sched_barrier(0);
#pragma unroll
    for (int ks = 0; ks < 4; ++ks)
#pragma unroll
        for (int j = 0; j < 8; ++j) { const float v = bf1(qf[ks][j]); ssq += v * v; }
    ssq += __shfl_xor(ssq, 16); ssq += __shfl_xor(ssq, 32);
    const float cexp = rsqrtf(ssq * (1.0f / 128.0f) + 1e-6f) * 0.08838834764831845f * 1.4426950408889634f;
    const int kq = 8 * (q >> 2) + (q & 3);
    f32x4 s[16];
#pragma unroll
    for (int f = 0; f < 16; ++f) { const int key = 32 * (f >> 1) + 4 * (f & 1) + kq; const LAS unsigned char* kr = lds + key * 256; f32x4 z = (f32x4){0.f, 0.f, 0.f, 0.f};
#pragma unroll
        for (int ks = 0; ks < 4; ++ks) z = mfma16(*(const LAS bf16x8*)(kr + (((4 * ks + hi) ^ (key & 15)) << 4)), qf[ks], z);
        s[f] = z; }
    float mx = -3.0e38f;
#pragma unroll
    for (int f = 0; f < 16; ++f)
#pragma unroll
        for (int g = 0; g < 4; ++g) mx = fmaxf(mx, s[f][g]);
    mx = fmaxf(mx, __shfl_xor(mx, 16)); mx = fmaxf(mx, __shfl_xor(mx, 32));
    float sum = 0.f;
#pragma unroll
    for (int f = 0; f < 16; ++f)
#pragma unroll
        for (int g = 0; g < 4; ++g) { const float p = __builtin_amdgcn_exp2f((s[f][g] - mx) * cexp); s[f][g] = p; sum += p; }
    sum += __shfl_xor(sum, 16); sum += __shfl_xor(sum, 32);
    const float inv = 1.0f / sum;
    f32x4 o[8];
#pragma unroll
    for (int i = 0; i < 8; ++i) o[i] = (f32x4){0.f, 0.f, 0.f, 0.f};
#pragma unroll
    for (int st = 0; st < 8; ++st) {
        const bf16x8 pb = __builtin_bit_cast(bf16x8, pg8::pack8(s[2 * st], s[2 * st + 1]));
#pragma unroll
        for (int mf = 0; mf < 8; ++mf) { const int dim = 16 * mf + q; o[mf] = mfma16(*(const LAS bf16x8*)(lds + 65536 + dim * 512 + (((4 * st + hi) ^ (dim & 15)) << 4)), pb, o[mf]); }
    }
    bf16* yp = yxa + tok * 1536 + h * 128 + 4 * hi;
#pragma unroll
    for (int mf = 0; mf < 8; ++mf) { v2u w; w.x = pk2(o[mf][0] * inv, o[mf][1] * inv); w.y = pk2(o[mf][2] * inv, o[mf][3] * inv); *(v2u*)(yp + 16 * mf) = w; }
}
__device__ __forceinline__ void pool_wg(const bf16* __restrict__ pp, const bf16* __restrict__ pwT, bf16* __restrict__ ypool, LAS unsigned char* lds, int tokbase, int wave, int lane) {
    const int q = lane & 15, hi = lane >> 4;
    __syncthreads();
    {
        const int hw = 1 << hi, tw0 = tokbase + 16 * wave, b = tw0 >> 13, t0 = tw0 & 8191;
        const bf16* base = pp + (size_t)b * SEQ * 512 + 8 * lane;
        float s[8];
#pragma unroll
        for (int j = 0; j < 8; ++j) s[j] = 0.f;
#pragma unroll 4
        for (int d = -8; d < 8; ++d) { const int u = t0 + d; const bool ok = (d >= -hw) && (d < hw) && (u >= 0) && (u < SEQ);
            const bf16x8 v = *(const bf16x8*)(base + (size_t)(ok ? u : t0) * 512);
#pragma unroll
            for (int j = 0; j < 8; ++j) s[j] += ok ? bf1(v[j]) : 0.f; }
        LAS unsigned char* tile = lds + wave * 16384;
#pragma unroll 4
        for (int i = 0; i < 16; ++i) { const int t = t0 + i;
            int lo = t - hw; lo = lo < 0 ? 0 : lo; int ht = t + hw; ht = ht > SEQ ? SEQ : ht;
            const float inv = 1.0f / (float)(ht - lo);
            const bool oka = (t + hw) < SEQ, oks = (t - hw) >= 0;
            const bf16x8 sv = *(const bf16x8*)(base + (size_t)t * 512), av = *(const bf16x8*)(base + (size_t)(oka ? t + hw : t) * 512), bv = *(const bf16x8*)(base + (size_t)(oks ? t - hw : t) * 512);
            f32x4 p0, p1;
#pragma unroll
            for (int j = 0; j < 4; ++j) { p0[j] = s[j] * inv - bf1(sv[j]); p1[j] = s[j + 4] * inv - bf1(sv[j + 4]); }
            *(LAS v4u*)(tile + i * 1024 + ((lane ^ (i & 15)) << 4)) = pg8::pack8(p0, p1);
#pragma unroll
            for (int j = 0; j < 8; ++j) s[j] += (oka ? bf1(av[j]) : 0.f) - (oks ? bf1(bv[j]) : 0.f);
        }
    }
    __syncthreads();
#pragma unroll 1
    for (int k = 0; k < 4; ++k) {
        const int pair = wave * 4 + k, g = pair >> 3, mf = pair & 7;
        const bf16* wb = pwT + (size_t)(g * 128 + 16 * mf + q) * 128 + 8 * hi;
        bf16x8 a[4];
#pragma unroll
        for (int ks = 0; ks < 4; ++ks) a[ks] = *(const bf16x8*)(wb + 32 * ks);
#pragma unroll 2
        for (int tg = 0; tg < 8; ++tg) {
            const LAS unsigned char* trow = lds + tg * 16384 + q * 1024; f32x4 o = (f32x4){0.f, 0.f, 0.f, 0.f};
#pragma unroll
            for (int ks = 0; ks < 4; ++ks) { const int c = g * 16 + 4 * ks + hi; o = mfma16(a[ks], *(const LAS bf16x8*)(trow + ((c ^ q) << 4)), o); }
            v2u w; w.x = pk2(o[0], o[1]); w.y = pk2(o[2], o[3]);
            *(v2u*)(ypool + (size_t)(tokbase + 16 * tg + q) * 1536 + g * 128 + 16 * mf + 4 * hi) = w;
        }
    }
    __syncthreads();
}

__device__ __forceinline__ int f2key(float s, int idx, int mask) { int b = __builtin_bit_cast(int, s); b = b >= 0 ? b : (b ^ 0x7fffffff); return (b & ~mask) | idx; }
__device__ __forceinline__ float key2f(int k) { k = k >= 0 ? k : (k ^ 0x7fffffff); return __builtin_bit_cast(float, k); }
#define CE_DESC(x, y) do { const int _h = (x) > (y) ? (x) : (y), _l = (x) > (y) ? (y) : (x); (x) = _h; (y) = _l; } while (0)
__device__ __forceinline__ void sort16(int (&a)[16]) {
#pragma unroll
    for (int ks = 1; ks <= 4; ++ks)
#pragma unroll
        for (int js = ks - 1; js >= 0; --js)
#pragma unroll
            for (int i = 0; i < 16; ++i) { const int k = 1 << ks, j = 1 << js, l = i ^ j;
                if (l > i) { if ((i & k) == 0) CE_DESC(a[i], a[l]); else CE_DESC(a[l], a[i]); } }
}
__device__ __forceinline__ void merge16(int (&a)[16], const int (&b)[16]) {
#pragma unroll
    for (int i = 0; i < 16; ++i) a[i] = a[i] > b[15 - i] ? a[i] : b[15 - i];
#pragma unroll
    for (int js = 3; js >= 0; --js)
#pragma unroll
        for (int i = 0; i < 16; ++i) { const int j = 1 << js, l = i ^ j; if (l > i) CE_DESC(a[i], a[l]); }
}
__device__ __forceinline__ void merge16_lanes(int (&a)[16], int step) { int o[16];
#pragma unroll
    for (int k = 0; k < 16; ++k) o[k] = __shfl_xor(a[k], step);
    merge16(a, o); }
__device__ constexpr int cand_i(int hi, int m) {
    return hi == 0 ? 0
         : hi == 1 ? (m < 8 ? 1 : (m < 13 ? 2 : -1))
         : hi == 2 ? (m < 4 ? 3 : (m < 7 ? 4 : (m < 9 ? 5 : (m < 11 ? 6 : -1))))
         :           (m < 2 ? 7 : (m < 10 ? 8 + (m - 2) : -1));
}
__device__ constexpr int cand_j(int hi, int m) {
    return hi == 0 ? m
         : hi == 1 ? (m < 8 ? m : (m < 13 ? m - 8 : -1))
         : hi == 2 ? (m < 4 ? m : (m < 7 ? m - 4 : (m < 9 ? m - 7 : (m < 11 ? m - 9 : -1))))
         :           (m < 2 ? m : (m < 10 ? 0 : -1));
}
__device__ __forceinline__ void topk_fill_lds(const bf16* __restrict__ keys, LAS unsigned char* lds, int h, int tid) {
#pragma unroll
    for (int ps = 0; ps < 8; ++ps) { const int id = tid + 512 * ps, row = id >> 4, c = id & 15;
        *(LAS v4u*)(lds + row * 256 + ((c ^ (row & 15)) << 4)) = *(const v4u*)(keys + ((size_t)h * 256 + row) * 128 + 8 * c); }
}
struct TopkQ { bf16x8 q[2][4]; };
__device__ __forceinline__ void topk_loadq(TopkQ& Q, const bf16* __restrict__ qb, int tok0, int h, int lane) {
    const size_t tok = (size_t)tok0 + (lane & 15); const int hi = lane >> 4;
#pragma unroll
    for (int p = 0; p < 2; ++p)
#pragma unroll
        for (int ks = 0; ks < 4; ++ks) Q.q[p][ks] = *(const bf16x8*)(qb + tok * 2048 + h * 256 + p * 128 + 32 * ks + 8 * hi);
}
__device__ __forceinline__ void topk_item(const TopkQ& Q, const LAS unsigned char* klds, int* __restrict__ te, float* __restrict__ tw, LAS int* lscr, int tok0, int h, int lane) {
    const int q = lane & 15, hi = lane >> 4; const size_t tok = (size_t)tok0 + q;
    int L[2][16];
#pragma unroll
    for (int p = 0; p < 2; ++p) {
        int B[16];
#pragma unroll
        for (int mf = 0; mf < 8; ++mf) { f32x4 s = (f32x4){0.f, 0.f, 0.f, 0.f}; const int row = p * 128 + 16 * mf + q;
#pragma unroll
            for (int ks = 0; ks < 4; ++ks) s = mfma16(*(const LAS bf16x8*)(klds + row * 256 + (((4 * ks + hi) ^ (row & 15)) << 4)), Q.q[p][ks], s);
#pragma unroll
            for (int g = 0; g < 4; ++g) { const int key = f2key(s[g], 16 * mf + 4 * hi + g, 127); if (mf < 4) L[p][4 * mf + g] = key; else B[4 * (mf - 4) + g] = key; } }
        sort16(L[p]); sort16(B); merge16(L[p], B);
        merge16_lanes(L[p], 16); merge16_lanes(L[p], 32);
    }
    float v1[16], v2[16];
#pragma unroll
    for (int k = 0; k < 16; ++k) { v1[k] = key2f(L[0][k]); v2[k] = key2f(L[1][k]); }
    int Fk[16];
#pragma unroll
    for (int m = 0; m < 16; ++m) {
        float sm = v1[0] + v2[m]; int id = 255 - m;
        if (cand_i(1, m) >= 0) { if (hi == 1) { sm = v1[cand_i(1, m) < 0 ? 0 : cand_i(1, m)] + v2[cand_j(1, m) < 0 ? 0 : cand_j(1, m)]; id = 255 - ((cand_i(1, m) << 4) | cand_j(1, m)); } }
        if (cand_i(2, m) >= 0) { if (hi == 2) { sm = v1[cand_i(2, m) < 0 ? 0 : cand_i(2, m)] + v2[cand_j(2, m) < 0 ? 0 : cand_j(2, m)]; id = 255 - ((cand_i(2, m) << 4) | cand_j(2, m)); } }
        if (cand_i(3, m) >= 0) { if (hi == 3) { sm = v1[cand_i(3, m) < 0 ? 0 : cand_i(3, m)] + v2[cand_j(3, m) < 0 ? 0 : cand_j(3, m)]; id = 255 - ((cand_i(3, m) << 4) | cand_j(3, m)); } }
        int key = f2key(sm, id, 255);
        if ((hi == 1 && cand_i(1, m) < 0) || (hi == 2 && cand_i(2, m) < 0) || (hi == 3 && cand_i(3, m) < 0)) key = (int)0x80000000;
        Fk[m] = key;
    }
    sort16(Fk); merge16_lanes(Fk, 16); merge16_lanes(Fk, 32);
    LAS int* my = lscr + lane * 32;
#pragma unroll
    for (int k = 0; k < 16; ++k) { my[k] = L[0][k] & 127; my[16 + k] = L[1][k] & 127; }
    LDS_WAIT(); asm volatile("" ::: "memory");
    float e[16]; float sum = 0.f; const float mx = key2f(Fk[0]);
#pragma unroll
    for (int k = 0; k < 16; ++k) { e[k] = __expf(key2f(Fk[k]) - mx); sum += e[k]; }
    const float inv = 1.0f / sum;
    if (hi == 0) {
        int* tep = te + tok * 128; float* twp = tw + tok * 128;
#pragma unroll
        for (int kk = 0; kk < 16; ++kk) { const int ij = 255 - (Fk[kk] & 255), i = ij >> 4, j = ij & 15, slot = (kk & 7) * 16 + 2 * h + (kk >> 3);
            tep[slot] = my[i] * 128 + my[16 + j]; twp[slot] = e[kk] * inv; }
    }
    LDS_WAIT(); asm volatile("" ::: "memory");
}

__device__ __forceinline__ float ub2f(unsigned v, int b) { return (float)((v >> (8 * b)) & 0xffu); }
struct HqIn { v4u hA, hB; float rsq; };
__device__ __forceinline__ void hq_load(HqIn& in, const bf16* __restrict__ hb, const float* __restrict__ rowsq, int tok, int lane) {
    const bf16* hp = hb + (size_t)tok * 1024 + 16 * lane; in.hA = *(const v4u*)hp; in.hB = *(const v4u*)(hp + 8); in.rsq = rowsq[tok]; }
__device__ __forceinline__ void hq_token(const HqIn& in, unsigned char* __restrict__ hq, float* __restrict__ hs, int tok, int lane) {
    const v4u hA = in.hA, hB = in.hB;
    float hf[16];
#pragma unroll
    for (int d = 0; d < 4; ++d) { hf[2 * d] = bflo(hA[d]); hf[2 * d + 1] = bfhi(hA[d]); hf[8 + 2 * d] = bflo(hB[d]); hf[8 + 2 * d + 1] = bfhi(hB[d]); }
    float amax = 0.f;
#pragma unroll
    for (int j = 0; j < 16; ++j) amax = fmaxf(amax, fabsf(hf[j]));
#pragma unroll
    for (int o = 1; o < 64; o <<= 1) amax = fmaxf(amax, __shfl_xor(amax, o));
    const float hinv = amax > 0.f ? 127.0f / amax : 0.f;
    v4u w;
#pragma unroll
    for (int d = 0; d < 4; ++d) { const unsigned b0 = (unsigned)(int)rintf(hf[4 * d] * hinv) & 0xffu, b1 = (unsigned)(int)rintf(hf[4 * d + 1] * hinv) & 0xffu,
                                                 b2 = (unsigned)(int)rintf(hf[4 * d + 2] * hinv) & 0xffu, b3 = (unsigned)(int)rintf(hf[4 * d + 3] * hinv) & 0xffu;
        w[d] = b0 | (b1 << 8) | (b2 << 16) | (b3 << 24); }
    *(v4u*)(hq + (size_t)tok * 1024 + 16 * lane) = w;
    if (lane == 0) hs[tok] = rsqrtf(in.rsq * (1.0f / 1024.0f) + 1e-6f) * amax * (1.0f / 127.0f);
}
constexpr int PA_SLOTS = 12;
struct PeerA1 { int e; float g; };
struct PeerA2 { v4u ur[3][4]; v4u hv[4]; float hsc, su, sv; int cnt, rk; bool m; unsigned long long rem; };
__device__ __forceinline__ void pa_s1(PeerA1& a, const int* __restrict__ te, const float* __restrict__ tw, int tok, int half, int lane) {
    a.e = te[(size_t)tok * 128 + 64 * half + lane]; a.g = tw[(size_t)tok * 128 + 64 * half + lane]; }
__device__ __forceinline__ void pa_s2(PeerA2& b, const PeerA1& a, const unsigned char* __restrict__ hq, const float* __restrict__ hs, const unsigned char* __restrict__ u8,
                                      const float* __restrict__ su, const float* __restrict__ sv, LAS int* lst, int tok, int x, int lane, int hot) {
    b.m = (a.e >> 11) == x;
    const unsigned long long mask = __ballot(b.m), lt = (1ull << lane) - 1ull;
    b.cnt = __popcll(mask); b.rk = __popcll(mask & lt);
    if (b.m && b.rk < PA_SLOTS) lst[b.rk] = a.e;
    { unsigned long long r = mask; for (int k = 0; k < PA_SLOTS && r != 0ull; ++k) r &= r - 1ull; b.rem = b.cnt > PA_SLOTS ? r : 0ull; }
    { typedef float f32x2s __attribute__((ext_vector_type(2))); f32x2s s2 = (f32x2s){0.f, 0.f}; if (b.m) s2 = ((const f32x2s*)su)[a.e]; b.su = s2.x; b.sv = s2.y; }
    const int r = lane >> 4, t = lane & 15;
#pragma unroll
    for (int i = 0; i < 4; ++i) b.hv[i] = *(const v4u*)(hq + (size_t)tok * 1024 + 16 * t + 256 * i);
    b.hsc = hs[tok];
    LDS_WAIT(); asm volatile("" ::: "memory");
    const int lim = b.cnt < PA_SLOTS ? b.cnt : PA_SLOTS;
#pragma unroll
    for (int q = 0; q < 3; ++q) { const int slot = 4 * q + r;
#pragma unroll
        for (int i = 0; i < 4; ++i) b.ur[q][i] = (v4u){0u, 0u, 0u, 0u};
        if (slot < lim) { int e = lst[slot]; if (hot) e = (x << 11) | (e & 255); const unsigned char* rp = u8 + (size_t)e * 1024 + 16 * t;
#pragma unroll
            for (int i = 0; i < 4; ++i) b.ur[q][i] = *(const v4u*)(rp + 256 * i); } }
    (void)sv;
}
__device__ __forceinline__ int dot16(const v4u u, const v4u h) { int d = __builtin_amdgcn_sdot4((int)u.x, (int)h.x, 0, false); d = __builtin_amdgcn_sdot4((int)u.y, (int)h.y, d, false);
    d = __builtin_amdgcn_sdot4((int)u.z, (int)h.z, d, false); return __builtin_amdgcn_sdot4((int)u.w, (int)h.w, d, false); }
template <int CTRL, int RM> __device__ __forceinline__ int dpp_i(int x) { return __builtin_amdgcn_update_dpp(0, x, CTRL, RM, 0xf, false); }
__device__ __forceinline__ int wave_sum_to63(int x) { x += dpp_i<0xb1, 0xf>(x); x += dpp_i<0x4e, 0xf>(x); x += dpp_i<0x124, 0xf>(x); x += dpp_i<0x128, 0xf>(x); x += dpp_i<0x142, 0xa>(x); x += dpp_i<0x143, 0xc>(x); return x; }
__device__ __forceinline__ int row_sum16(int x) { x += dpp_i<0xb1, 0xf>(x); x += dpp_i<0x4e, 0xf>(x); x += dpp_i<0x124, 0xf>(x); x += dpp_i<0x128, 0xf>(x); return x; }
__device__ __forceinline__ float gelu_erf(float v) {
    const float av = fabsf(v), t = __builtin_amdgcn_rcpf(av * 0.2316418882f + 1.0f);
    float q = t * 0.5307027145f + (-0.7265760135f); q = q * t + 0.7107068705f; q = q * t + (-0.142248368f); q = q * t + 0.127414796f; q = q * t;
    const float e = __builtin_amdgcn_exp2f((v * v) * (-0.72134752044f)), m = v * (q * e);
    return v < 0.f ? m : v - m; }
__device__ __forceinline__ void pa_s3(const PeerA2& b, const PeerA1& a, const unsigned char* __restrict__ u8, const unsigned char* __restrict__ hq, float* __restrict__ aw, int tok, int half, int lane) {
    int mine = 0;
#pragma unroll
    for (int q = 0; q < 3; ++q) { int d = dot16(b.ur[q][0], b.hv[0]); d += dot16(b.ur[q][1], b.hv[1]); d += dot16(b.ur[q][2], b.hv[2]); d += dot16(b.ur[q][3], b.hv[3]);
        d = row_sum16(d);
#pragma unroll
        for (int r = 0; r < 4; ++r) { const int s = __builtin_amdgcn_readlane(d, 16 * r); mine = (b.rk == 4 * q + r) ? s : mine; } }
    float* awp = aw + (size_t)tok * 128 + 64 * half + lane;
    if (b.m && b.rk < PA_SLOTS) *awp = a.g * gelu_erf((float)mine * b.hsc * b.su) * b.sv;
    if (b.cnt > PA_SLOTS) {
        unsigned long long rem = b.rem; const v4u hw = *(const v4u*)(hq + (size_t)tok * 1024 + 16 * lane);
        while (rem != 0ull) { const int idx = __builtin_ctzll(rem); rem &= rem - 1ull; const int e = __builtin_amdgcn_readlane(a.e, idx);
            const int d = __builtin_amdgcn_readlane(wave_sum_to63(dot16(*(const v4u*)(u8 + (size_t)e * 1024 + 16 * lane), hw)), 63);
            if (lane == idx) *awp = a.g * gelu_erf((float)d * b.hsc * b.su) * b.sv; }
    }
}
__device__ __forceinline__ void peer_a_run(const unsigned char* __restrict__ hq, const float* __restrict__ hs, const unsigned char* __restrict__ u8, const float* __restrict__ su,
                                           const float* __restrict__ sv, const int* __restrict__ te, const float* __restrict__ tw, float* __restrict__ aw, LAS int* lst, int wrank, int wstep, int x, int lane, int hot = 0) {
    const int ntok = wrank < T ? (T - wrank + wstep - 1) / wstep : 0, N = 2 * ntok;
#define PA_TOK(n) (wrank + ((n) >> 1) * wstep)
    if (N == 0) return;
    PeerA1 a0, a1, a2; PeerA2 bA, bB;
    pa_s1(a0, te, tw, PA_TOK(0), 0, lane); pa_s1(a1, te, tw, PA_TOK(1), 1, lane);
    pa_s2(bA, a0, hq, hs, u8, su, sv, lst, PA_TOK(0), x, lane, hot);
#define PA_STEP(n, Bcur, Bnext, Acur, Anext, Anew) do { \
        if ((n) + 1 < N) pa_s2(Bnext, Anext, hq, hs, u8, su, sv, lst, PA_TOK((n) + 1), x, lane, hot); \
        if ((n) + 2 < N) pa_s1(Anew, te, tw, PA_TOK((n) + 2), ((n) + 2) & 1, lane); \
        pa_s3(Bcur, Acur, u8, hq, aw, PA_TOK(n), (n) & 1, lane); } while (0)
    for (int n = 0; n < N; n += 6) {
        PA_STEP(n, bA, bB, a0, a1, a2);
        if (n + 1 < N) PA_STEP(n + 1, bB, bA, a1, a2, a0);
        if (n + 2 < N) PA_STEP(n + 2, bA, bB, a2, a0, a1);
        if (n + 3 < N) PA_STEP(n + 3, bB, bA, a0, a1, a2);
        if (n + 4 < N) PA_STEP(n + 4, bA, bB, a1, a2, a0);
        if (n + 5 < N) PA_STEP(n + 5, bB, bA, a2, a0, a1);
    }
#undef PA_STEP
#undef PA_TOK
}
struct PeerB1 { v4u e[4]; f32x4 w[4]; };
struct PeerB2 { v4u vr[8]; };
struct PeerBAcc { int acc[16]; int wq[4]; float wsc, h0, h1; };
typedef float f32x2v __attribute__((ext_vector_type(2)));
__device__ __forceinline__ void pb_s1(PeerB1& a, const int* __restrict__ te, const float* __restrict__ aw, int tok, int lane) {
    const v4u* ep = (const v4u*)(te + (size_t)tok * 128 + 16 * (lane >> 3)); const f32x4* wp = (const f32x4*)(aw + (size_t)tok * 128 + 16 * (lane >> 3));
#pragma unroll
    for (int j = 0; j < 4; ++j) { a.e[j] = ep[j]; a.w[j] = wp[j]; } }
__device__ __forceinline__ int pb_col(int lane) { return 16 * (lane & 7) + 8 * ((lane >> 5) & 1) + 4 * ((lane >> 4) & 1) + 2 * ((lane >> 3) & 1); }
template <int CTRL, int RM> __device__ __forceinline__ float dpp_f(float x) { return __builtin_bit_cast(float, __builtin_amdgcn_update_dpp(0, __builtin_bit_cast(int, x), CTRL, RM, 0xf, false)); }
__device__ __forceinline__ void pb_quant(PeerBAcc& A, const PeerB1& a) {
    float mx = 0.f;
#pragma unroll
    for (int j = 0; j < 4; ++j) mx = fmaxf(mx, fmaxf(fmaxf(fabsf(a.w[j][0]), fabsf(a.w[j][1])), fmaxf(fabsf(a.w[j][2]), fabsf(a.w[j][3]))));
    mx = fmaxf(mx, dpp_f<0xb1, 0xf>(mx)); mx = fmaxf(mx, dpp_f<0x4e, 0xf>(mx)); mx = fmaxf(mx, dpp_f<0x124, 0xf>(mx)); mx = fmaxf(mx, dpp_f<0x128, 0xf>(mx));
    mx = fmaxf(mx, dpp_f<0x142, 0xa>(mx)); mx = fmaxf(mx, dpp_f<0x143, 0xc>(mx));
    mx = __builtin_bit_cast(float, __builtin_amdgcn_readlane(__builtin_bit_cast(int, mx), 63));
    const float inv = mx > 0.f ? 127.0f / mx : 0.f; A.wsc = mx * (1.0f / 127.0f);
#pragma unroll
    for (int j = 0; j < 4; ++j) A.wq[j] = (int)(((unsigned)(int)rintf(a.w[j][0] * inv) & 0xffu) | (((unsigned)(int)rintf(a.w[j][1] * inv) & 0xffu) << 8) |
                                               (((unsigned)(int)rintf(a.w[j][2] * inv) & 0xffu) << 16) | (((unsigned)(int)rintf(a.w[j][3] * inv) & 0xffu) << 24));
}
template <int HF> __device__ __forceinline__ void pb_s2(PeerB2& b, const PeerB1& a, const unsigned char* __restrict__ v8x, int lane, int hot = 0) {
    const int c = lane & 7;
#pragma unroll
    for (int m = 0; m < 8; ++m) { unsigned e = a.e[2 * HF + (m >> 2)][m & 3]; if (hot) e &= 255u; b.vr[m] = *(const v4u*)(v8x + (size_t)e * 128 + 16 * c); }
}
__device__ __forceinline__ float swap32_add(float lo, float hi) { const auto r = __builtin_amdgcn_permlane32_swap(__builtin_bit_cast(unsigned, lo), __builtin_bit_cast(unsigned, hi), false, false);
    return __builtin_bit_cast(float, r[0]) + __builtin_bit_cast(float, r[1]); }
__device__ __forceinline__ float swap16_add(float lo, float hi) { const auto r = __builtin_amdgcn_permlane16_swap(__builtin_bit_cast(unsigned, lo), __builtin_bit_cast(unsigned, hi), false, false);
    return __builtin_bit_cast(float, r[0]) + __builtin_bit_cast(float, r[1]); }
template <int HF> __device__ __forceinline__ void pb_s3(PeerBAcc& A, const PeerB2& b, const PeerB1& a, float* out, int tok, int x, int lane) {
    if (HF == 0) {
#pragma unroll
        for (int j = 0; j < 16; ++j) A.acc[j] = 0;
    }
#pragma unroll
    for (int gg = 0; gg < 2; ++gg)
#pragma unroll
        for (int d = 0; d < 4; ++d) { const unsigned ra = b.vr[4 * gg][d], rb = b.vr[4 * gg + 1][d], rc = b.vr[4 * gg + 2][d], rd = b.vr[4 * gg + 3][d];
            const unsigned t0 = __builtin_amdgcn_perm(rb, ra, 0x05010400u), t1 = __builtin_amdgcn_perm(rb, ra, 0x07030602u), t2 = __builtin_amdgcn_perm(rd, rc, 0x05010400u), t3 = __builtin_amdgcn_perm(rd, rc, 0x07030602u);
            const unsigned c0 = __builtin_amdgcn_perm(t2, t0, 0x05040100u), c1 = __builtin_amdgcn_perm(t2, t0, 0x07060302u), c2 = __builtin_amdgcn_perm(t3, t1, 0x05040100u), c3 = __builtin_amdgcn_perm(t3, t1, 0x07060302u);
            const int w4 = A.wq[2 * HF + gg];
            A.acc[4 * d] = __builtin_amdgcn_sdot4((int)c0, w4, A.acc[4 * d], false); A.acc[4 * d + 1] = __builtin_amdgcn_sdot4((int)c1, w4, A.acc[4 * d + 1], false);
            A.acc[4 * d + 2] = __builtin_amdgcn_sdot4((int)c2, w4, A.acc[4 * d + 2], false); A.acc[4 * d + 3] = __builtin_amdgcn_sdot4((int)c3, w4, A.acc[4 * d + 3], false); }
    if (HF == 1) {
        int r8[8], r4[4], r2[2];
#pragma unroll
        for (int j = 0; j < 8; ++j) { const bool up = (lane & 32) != 0; const int keep = up ? A.acc[j + 8] : A.acc[j], send = up ? A.acc[j] : A.acc[j + 8]; r8[j] = keep + __shfl_xor(send, 32); }
#pragma unroll
        for (int j = 0; j < 4; ++j) { const bool up = (lane & 16) != 0; const int keep = up ? r8[j + 4] : r8[j], send = up ? r8[j] : r8[j + 4]; r4[j] = keep + __shfl_xor(send, 16); }
#pragma unroll
        for (int j = 0; j < 2; ++j) { const bool up = (lane & 8) != 0; const int keep = up ? r4[j + 2] : r4[j], send = up ? r4[j] : r4[j + 2];
            r2[j] = keep + __builtin_amdgcn_update_dpp(0, send, 0x128, 0xf, 0xf, false); }
        f32x2v h2; h2.x = A.h0 + A.wsc * (float)r2[0]; h2.y = A.h1 + A.wsc * (float)r2[1];
        *(f32x2v*)(out + (size_t)tok * 1024 + 128 * x + pb_col(lane)) = h2;
    }
}
__device__ __forceinline__ void peer_b_run(const unsigned char* __restrict__ v8x, const int* __restrict__ te, const float* __restrict__ aw, const bf16* __restrict__ hb, float* out, int wrank, int wstep, int x, int lane, int hot = 0) {
    const int N = wrank < T ? (T - wrank + wstep - 1) / wstep : 0;
#define PB_TOK(n) (wrank + (n) * wstep)
#define PB_LOADH(n) do { const unsigned h2_ = *(const unsigned*)(hb + (size_t)PB_TOK(n) * 1024 + 128 * x + pb_col(lane)); A.h0 = bflo(h2_); A.h1 = bfhi(h2_); } while (0)
    if (N == 0) return;
    PeerB1 s0, s1; PeerB2 bA, bB; PeerBAcc A;
    pb_s1(s0, te, aw, PB_TOK(0), lane); if (N > 1) pb_s1(s1, te, aw, PB_TOK(1), lane);
    pb_s2<0>(bA, s0, v8x, lane, hot);
    for (int n = 0; n < N; n += 2) {
        pb_s2<1>(bB, s0, v8x, lane, hot); PB_LOADH(n); pb_quant(A, s0);
        pb_s3<0>(A, bA, s0, out, PB_TOK(n), x, lane);
        if (n + 1 < N) pb_s2<0>(bA, s1, v8x, lane, hot);
        pb_s3<1>(A, bB, s0, out, PB_TOK(n), x, lane);
        if (n + 2 < N) pb_s1(s0, te, aw, PB_TOK(n + 2), lane);
        if (n + 1 < N) {
            pb_s2<1>(bB, s1, v8x, lane, hot); PB_LOADH(n + 1); pb_quant(A, s1);
            pb_s3<0>(A, bA, s1, out, PB_TOK(n + 1), x, lane);
            if (n + 2 < N) pb_s2<0>(bA, s0, v8x, lane, hot);
            pb_s3<1>(A, bB, s1, out, PB_TOK(n + 1), x, lane);
            if (n + 3 < N) pb_s1(s1, te, aw, PB_TOK(n + 3), lane);
        }
    }
#undef PB_LOADH
#undef PB_TOK
}

__global__ void __launch_bounds__(NWAVES * 64, 2) mk_fwd(Args args) {
    extern __shared__ __attribute__((aligned(16))) unsigned char lds[];
    Frame F;
    F.lds = (LAS unsigned char*)lds;
    F.MISC = (volatile LAS unsigned*)(F.lds + MISC_OFF);
    F.tid = threadIdx.x; F.lane = F.tid & 63; F.wave = __builtin_amdgcn_readfirstlane(F.tid >> 6);
    F.G = gridDim.x; { const int bx = blockIdx.x; F.vcu = (F.G % 8 == 0) ? (bx % 8) * (F.G / 8) + bx / 8 : bx; }
    F.out = args.out; F.ws = args.ws;
    unsigned char* ws = args.ws;
    F.ctl = (gu32*)(ws + WS_CTL);
    for (int u = F.tid; u < (LDS_BYTES - LDSCTL_OFF) / 4; u += NWAVES * 64) ((LAS unsigned*)(F.lds + LDSCTL_OFF))[u] = 0u;
    __syncthreads();
    XcdBarrier bar; bar.bar = (unsigned*)(F.ctl + CW_BAR); bar.x = 0; bar.st = nullptr;
    if (N_LAUNCHES != PER_PHASE) bar = xcd_barrier_post((unsigned*)(F.ctl + CW_BAR), F.MISC + 8);
    if (N_LAUNCHES != PER_PHASE) { if (F.tid == 0) { const unsigned xid = xb_xcc_id(); F.MISC[12] = xid; F.MISC[13] = xb_add((unsigned*)(F.ctl + CW_TICKET) + 64 * xid, 1u); } __syncthreads(); }
#define GRID_BAR() do { if (N_LAUNCHES != PER_PHASE) xcd_barrier(bar); } while (0)
    const int lo = args.ph_lo, hi = args.ph_hi;
#define IN(k) (lo <= (k) && (k) < hi)
#define BOTH(k) (IN(k) && IN((k) + 1))
#ifndef DUP_PHASE
#define DUP_PHASE (-1)
#endif
#define NREP(k) ((DUP_PHASE == (k)) ? 2 : 1)
    const int gw = F.vcu * NWAVES + F.wave, NGW = F.G * NWAVES;
    bf16* const WinT = (bf16*)(ws + WS_WIN); bf16* const WvT = (bf16*)(ws + WS_WV); bf16* const WkvT = (bf16*)(ws + WS_WKV); bf16* const WbrT = (bf16*)(ws + WS_WBR);
    bf16* const WoutT = (bf16*)(ws + WS_WOUT); bf16* const WqT = (bf16*)(ws + WS_WQ); bf16* const KEYS = (bf16*)(ws + WS_KEYS); bf16* const PWT = (bf16*)(ws + WS_PWT);
    bf16* const MEMN = (bf16*)(ws + WS_MEMN); bf16* const KMEM = (bf16*)(ws + WS_KMEM); bf16* const VTMEM = (bf16*)(ws + WS_VTMEM); float* const RSTDX = (float*)(ws + WS_RSTDX);
    const unsigned char* const U8 = ws + WS_U8; const unsigned char* const V8 = ws + WS_V8; const float* const SU = (const float*)(ws + WS_SU); const float* const SV = (const float*)(ws + WS_SV);
    bf16* const QN = (bf16*)(ws + WS_QN); bf16* const KN = (bf16*)(ws + WS_KN); bf16* const VT = (bf16*)(ws + WS_VT); bf16* const PP = (bf16*)(ws + WS_PP); bf16* const XQ = (bf16*)(ws + WS_XQ);
    bf16* const GATE = (bf16*)(ws + WS_GATE); bf16* const MERGED = (bf16*)(ws + WS_MERGED); bf16* const HB = (bf16*)(ws + WS_HB); bf16* const QB = (bf16*)(ws + WS_QB);
    int* const TE = (int*)(ws + WS_TE); float* const TW = (float*)(ws + WS_TW); float* const AW = (float*)(ws + WS_AW); float* const ROWSQ = (float*)(ws + WS_ROWSQ);
    bf16* const XB = (bf16*)((unsigned char*)args.out + OUT_XB); bf16* const YNA = (bf16*)((unsigned char*)args.out + OUT_YNA);
    bf16* const YPOOL = (bf16*)((unsigned char*)args.out + OUT_YPOOL); bf16* const YXA = (bf16*)((unsigned char*)args.out + OUT_YXA);

    if (IN(0)) { for (int rep = 0; rep < NREP(0); ++rep) { p0_prologue(F, args); if (rep + 1 < NREP(0)) GRID_BAR(); } if (BOTH(0)) GRID_BAR(); }

    if (IN(1)) {
      for (int rep = 0; rep < NREP(1); ++rep) {
        { pg8::Sched1 S; S.so.init(T, IN_MAIN, F.G, (int)blockIdx.x); S.A = (const char*)XB; S.Bt = (const char*)WinT; S.tstep = (size_t)256 * 1024 * 2;
          pg8::EpiProj E{RSTDX, QN, KN, PP, XQ, GATE, args.in[I_NAQG], args.in[I_NAKG], args.in[I_GATEB]};
          pg8::gemm_phase<pg8::EpiProj, pg8::Sched1, true, true>(F.lds + RING_OFF, 1024, S, E); }
        { pg8::Sched1 S; S.so.init(512, T, F.G, (int)blockIdx.x); S.A = (const char*)WvT; S.Bt = (const char*)XB; S.tstep = (size_t)256 * 1024 * 2;
          pg8::EpiVt E{RSTDX, VT};
          pg8::gemm_phase<pg8::EpiVt, pg8::Sched1, false, true>(F.lds + RING_OFF, 1024, S, E); }
        for (int t = gw; t < 512; t += NGW) memkv_tile(MEMN, WkvT, args.in[I_XAKG], args.in[I_XAQG], KMEM, VTMEM, t, F.lane);
        if (rep + 1 < NREP(1)) GRID_BAR();
      }
        if (BOTH(1)) GRID_BAR();
    }

    if (IN(2)) {
      for (int rep = 0; rep < NREP(2); ++rep) {
        LAS float* rpl = (LAS float*)(F.lds + RING_OFF + F.wave * 16384);
        for (int i = F.lane; i < 15 * 31; i += 64) rpl[i] = args.in[I_RPB][F.wave * 15 * 31 + i];
        LDS_WAIT(); asm volatile("" ::: "memory");
        for (int i = F.vcu; i < 256; i += F.G)
            for (int k = 0; k < 8; ++k) { const int idx = i * 8 + k, b = idx >> 9, r = (idx >> 2) & 127, jb = idx & 3; na_item(QN, KN, VT, rpl, YNA, b, r, jb, F.wave, F.lane); }
        for (int i = F.vcu; i < 256; i += F.G) pool_wg(PP, PWT, YPOOL, F.lds + RING_OFF, i * 128, F.wave, F.lane);
        { const int pair = F.vcu & 15, xb = pair >> 2, xh = pair & 3, slot = F.vcu >> 4, nslot = F.G >> 4;
          __syncthreads(); xa_fill_lds(KMEM, VTMEM, F.lds + RING_OFF, xb, xh, F.tid); __syncthreads();
          if (slot < nslot) for (int n = slot * NWAVES + F.wave; n < 512; n += nslot * NWAVES) xa_item(XQ, F.lds + RING_OFF, YXA, (xb * 512 + n) * 16, xh, F.lane);
          __syncthreads(); }
        if (rep + 1 < NREP(2)) GRID_BAR();
      }
        if (BOTH(2)) GRID_BAR();
    }

    if (IN(3)) {
      for (int rep = 0; rep < NREP(3); ++rep) {
        pg8::Sched1 S; S.so.init(T, D, F.G, (int)blockIdx.x); S.A = (const char*)YNA; S.Bt = (const char*)WbrT; S.tstep = (size_t)256 * 1536 * 2;
        pg8::EpiMergeCat E{GATE, MERGED};
        pg8::gemm_phase<pg8::EpiMergeCat, pg8::Sched1, true, true>(F.lds + RING_OFF, 1536, S, E);
        if (rep + 1 < NREP(3)) GRID_BAR();
      }
        if (BOTH(3)) GRID_BAR();
    }

    if (IN(4)) {
      for (int rep = 0; rep < NREP(4); ++rep) {
        pg8::Sched1 S; S.so.init(T, D, F.G, (int)blockIdx.x); S.A = (const char*)MERGED; S.Bt = (const char*)WoutT; S.tstep = (size_t)256 * 1024 * 2;
        pg8::EpiH E{args.in[I_X], F.out, HB, ROWSQ, args.probe};
        pg8::gemm_phase<pg8::EpiH, pg8::Sched1, true, true>(F.lds + RING_OFF, 1024, S, E);
        if (rep + 1 < NREP(4)) { GRID_BAR(); for (int m = gw * 64 + F.lane; m < T; m += NGW * 64) ROWSQ[m] = 0.f; GRID_BAR(); }
      }
        if (BOTH(4)) GRID_BAR();
    }

    if (IN(5)) {
      for (int rep = 0; rep < NREP(5); ++rep) {
        pg8::Sched1 S; S.so.init(T, 2048, F.G, (int)blockIdx.x); S.A = (const char*)HB; S.Bt = (const char*)WqT; S.tstep = (size_t)256 * 1024 * 2;
        pg8::EpiQ E{ROWSQ, QB};
        pg8::gemm_phase<pg8::EpiQ, pg8::Sched1, true, true>(F.lds + RING_OFF, 1024, S, E);
        if (rep + 1 < NREP(5)) GRID_BAR();
      }
        if (BOTH(5)) GRID_BAR();
    }

    if (IN(6)) {
        LAS int* lscr = (LAS int*)(F.lds + RING_OFF + 65536 + F.wave * 8192);
        for (int tok = 4 * gw; tok < T; tok += 4 * NGW) {
            HqIn hin[4];
#pragma unroll
            for (int r = 0; r < 4; ++r) hq_load(hin[r], HB, ROWSQ, tok + r, F.lane);
#pragma unroll
            for (int r = 0; r < 4; ++r) hq_token(hin[r], ws + WS_HQ, (float*)(ws + WS_HS), tok + r, F.lane); }
        { const int th = F.vcu & 7, slot = F.vcu >> 3, nslot = F.G >> 3;
          __syncthreads(); topk_fill_lds(KEYS, F.lds + RING_OFF, th, F.tid); __syncthreads();
          for (int rep = 0; rep < NREP(6); ++rep) { { const int n0 = slot * NWAVES + F.wave, ns = nslot * NWAVES; TopkQ qA, qB;
              if (n0 < 2048) topk_loadq(qA, QB, n0 * 16, th, F.lane);
              for (int n = n0; n < 2048; n += 2 * ns) {
                  if (n + ns < 2048) topk_loadq(qB, QB, (n + ns) * 16, th, F.lane);
                  topk_item(qA, F.lds + RING_OFF, TE, TW, lscr, n * 16, th, F.lane);
                  if (n + ns < 2048) { if (n + 2 * ns < 2048) topk_loadq(qA, QB, (n + 2 * ns) * 16, th, F.lane);
                      topk_item(qB, F.lds + RING_OFF, TE, TW, lscr, (n + ns) * 16, th, F.lane); } } } if (rep + 1 < NREP(6)) GRID_BAR(); }
          __syncthreads(); }
        if (BOTH(6)) GRID_BAR();
    }

    if (IN(7)) {
        int x0 = 0, nxs = 8, wrank = (int)blockIdx.x * NWAVES + F.wave, wstep = F.G * NWAVES;
        if (N_LAUNCHES != PER_PHASE) { const unsigned xid = F.MISC[12], rk = F.MISC[13]; unsigned nx = 0, below = 0, mine = 0;
            for (unsigned j = 0; j < 16; ++j) { const unsigned c = xb_ld((unsigned*)(F.ctl + CW_BAR) + XB_XCNT(j)); nx += c > 0u; below += (c > 0u && j < xid); mine = (j == xid) ? c : mine; }
            if (nx == 8 && mine > 0 && rk < mine) { x0 = (int)below; nxs = 1; wrank = (int)rk * NWAVES + F.wave; wstep = (int)mine * NWAVES; } }
        else if ((F.G & 7) == 0) { x0 = (int)blockIdx.x & 7; nxs = 1; wrank = ((int)blockIdx.x >> 3) * NWAVES + F.wave; wstep = (F.G >> 3) * NWAVES; }
        for (int xs = 0; xs < nxs; ++xs) peer_a_run(ws + WS_HQ, (const float*)(ws + WS_HS), U8, SU, SV, TE, TW, args.probe ? (float*)QB : AW, (LAS int*)(F.lds + RING_OFF + F.wave * 16384), wrank, wstep, x0 + xs, F.lane, args.probe == 2);
        if (N_LAUNCHES != PER_PHASE) xcd_barrier(bar);
    }
    if (IN(8)) {
        int x0 = 0, nxs = 8, wrank = (int)blockIdx.x * NWAVES + F.wave, wstep = F.G * NWAVES;
        if (N_LAUNCHES != PER_PHASE) { const unsigned xid = F.MISC[12], rk = F.MISC[13]; unsigned nx = 0, below = 0, mine = 0;
            for (unsigned j = 0; j < 16; ++j) { const unsigned c = xb_ld((unsigned*)(F.ctl + CW_BAR) + XB_XCNT(j)); nx += c > 0u; below += (c > 0u && j < xid); mine = (j == xid) ? c : mine; }
            if (nx == 8 && mine > 0 && rk < mine) { x0 = (int)below; nxs = 1; wrank = (int)rk * NWAVES + F.wave; wstep = (int)mine * NWAVES; } }
        else if ((F.G & 7) == 0) { x0 = (int)blockIdx.x & 7; nxs = 1; wrank = ((int)blockIdx.x >> 3) * NWAVES + F.wave; wstep = (F.G >> 3) * NWAVES; }
        for (int xs = 0; xs < nxs; ++xs) peer_b_run(V8 + (size_t)(x0 + xs) * (2 * MiB), TE, AW, HB, args.probe ? (float*)QB : F.out, wrank, wstep, x0 + xs, F.lane, args.probe == 2);
    }
#undef IN
#undef BOTH
#undef GRID_BAR
}

extern "C" void kernel_launch(void* const* d_in, const int* in_sizes, int n_in, void* d_out, int out_size, void* d_ws, size_t ws_size, hipStream_t stream) {
    static int grid = 0;
    if (grid == 0) {
        if (n_in != 23 || in_sizes[0] != T * D || out_size != T * D || ws_size < WS_END) { fprintf(stderr, "kernel_launch: unexpected shapes: n_in %d in0 %d out %d ws %zu\n", n_in, n_in > 0 ? in_sizes[0] : -1, out_size, ws_size); grid = -1; return; }
        int dev = 0, cus = 0, per_cu = 0;
        if (hipGetDevice(&dev) != hipSuccess || hipDeviceGetAttribute(&cus, hipDeviceAttributeMultiprocessorCount, dev) != hipSuccess) { fprintf(stderr, "kernel_launch: device query failed\n"); grid = -1; return; }
        if (hipFuncSetAttribute((const void*)mk_fwd, hipFuncAttributeMaxDynamicSharedMemorySize, LDS_BYTES) != hipSuccess) { fprintf(stderr, "kernel_launch: hipFuncSetAttribute failed\n"); grid = -1; return; }
        if (hipOccupancyMaxActiveBlocksPerMultiprocessor(&per_cu, (const void*)mk_fwd, NWAVES * 64, LDS_BYTES) != hipSuccess || per_cu < 1)
            fprintf(stderr, "kernel_launch: note: occupancy query reports %d workgroups per CU\n", per_cu);
        (void)hipGetLastError();
        grid = cus;
    }
    if (grid < 0) return;
    if (hipMemsetAsync((char*)d_ws + WS_CTL, 0, CTL_ZERO_BYTES, stream) != hipSuccess) { fprintf(stderr, "kernel_launch: memset failed\n"); return; }
    Args a{};
    for (int i = 0; i < 23; ++i) a.in[i] = (const float*)d_in[i];
    a.out = (float*)d_out; a.ws = (unsigned char*)d_ws;
    for (int li = 0; li < N_LAUNCHES; ++li) {
        a.ph_lo = (N_LAUNCHES == PER_PHASE) ? li : 0; a.ph_hi = (N_LAUNCHES == PER_PHASE) ? li + 1 : PER_PHASE;
        hipLaunchKernelGGL(mk_fwd, dim3(grid), dim3(NWAVES * 64), LDS_BYTES, stream, a);
#ifdef HOST_DUP_PHASE
        if (N_LAUNCHES == PER_PHASE && li == HOST_DUP_PHASE) {
#ifndef PROBE_MODE
            if (li == 4) (void)hipMemsetAsync((char*)d_ws + WS_ROWSQ, 0, (size_t)T * 4, stream);
#endif
#ifdef PROBE_MODE
            a.probe = PROBE_MODE;
#endif
            hipLaunchKernelGGL(mk_fwd, dim3(grid), dim3(NWAVES * 64), LDS_BYTES, stream, a); a.probe = 0; }
#endif
        const hipError_t le = hipPeekAtLastError();
        if (le != hipSuccess) { fprintf(stderr, "kernel_launch: launch %d failed: %s\n", li, hipGetErrorName(le)); break; }
    }
}
```

```cpp
#include <hip/hip_runtime.h>
#include <cstdio>
#include <cstdint>

#ifndef MK_N_LAUNCHES
#define MK_N_LAUNCHES 1
#endif

namespace pg8 {
#define PG8_LAS __attribute__((address_space(3)))
typedef unsigned short bf16_t;
typedef short bf16x8 __attribute__((ext_vector_type(8)));
typedef float f32x4 __attribute__((ext_vector_type(4)));
typedef unsigned u32x4 __attribute__((ext_vector_type(4)));
typedef unsigned u32x2 __attribute__((ext_vector_type(2)));
constexpr int BM = 256, BK = 64, HALF = 128, HTB = HALF * BK * 2  , STAGE_BYTES = 8 * HTB, NXCD = 8, WGM = 8;

__host__ __device__ __forceinline__ int lds_byte(int r, int c) { const int st = (r >> 4) * 2 + (c >> 5), rr = r & 15, cc = c & 31, ob = rr * 64 + cc * 2; return st * 1024 + (ob ^ (((ob >> 9) & 1) << 5)); }
__host__ __device__ __forceinline__ void stage_rc(int b, int& R, int& C) { const int st = b / 1024, sb = b % 1024, swz = sb ^ (((sb >> 9) & 1) << 5); R = (st >> 1) * 16 + swz / 64; C = (st & 1) * 32 + (swz % 64) / 2; }
__host__ __device__ __forceinline__ int perm32(int rho) { const int n = rho >> 4, i = rho & 15; return 8 * (i >> 2) + 4 * n + (i & 3); }

struct Unit { int pm, pn, br; };

struct StaticOrder {
    int nM, nN, nwg, G, c;
    __host__ __device__ void init(int M, int N, int G_, int c_) { nM = M / BM; nN = N / BM; nwg = nM * nN; G = G_; c = c_; }
    __host__ __device__ bool next(int i, Unit& u) const {
        const long L = (long)i * G + c; if (L >= nwg) return false;
        int wgid = (int)L; { const int q = nwg / NXCD, r = nwg % NXCD, xcd = wgid % NXCD, off = wgid / NXCD; wgid = (xcd < r ? xcd * (q + 1) : r * (q + 1) + (xcd - r) * q) + off; }
        const int nig = WGM * nN, gid = wgid / nig, fm = gid * WGM, gsz = (nM - fm) < WGM ? (nM - fm) : WGM;
        u.pm = fm + ((wgid % nig) % gsz); u.pn = (wgid % nig) / gsz; return true;
    }
};
struct Sched1 {
    StaticOrder so; const char* A; const char* Bt; size_t tstep;
    __device__ __forceinline__ bool next(int i, Unit& u) const { u.br = 0; return so.next(i, u); }
    __device__ __forceinline__ const char* abase(const Unit& u) const { return A + (size_t)u.pm * tstep; }
    __device__ __forceinline__ const char* bbase(const Unit& u) const { return Bt + (size_t)u.pn * tstep; }
    __device__ __forceinline__ void a_ready(const Unit&) const {}
    __device__ __forceinline__ void done(const Unit&) const {}
};
struct Sched3 {
    StaticOrder so; const char* A; const char* Bt; size_t tstep, strideA, strideB;
    __device__ __forceinline__ bool next(int i, Unit& u) const { u.br = i % 3; return so.next(i / 3, u); }
    __device__ __forceinline__ const char* abase(const Unit& u) const { return A + (size_t)u.br * strideA + (size_t)u.pm * tstep; }
    __device__ __forceinline__ const char* bbase(const Unit& u) const { return Bt + (size_t)u.br * strideB + (size_t)u.pn * tstep; }
    __device__ __forceinline__ void a_ready(const Unit&) const {}
    __device__ __forceinline__ void done(const Unit&) const {}
};

typedef float f32x2_t __attribute__((ext_vector_type(2))); typedef __bf16 bf16x2v_t __attribute__((ext_vector_type(2)));
__device__ __forceinline__ unsigned cvt_pk_bf16(float lo, float hi) { const f32x2_t v = {lo, hi}; const bf16x2v_t b = __builtin_convertvector(v, bf16x2v_t); return __builtin_bit_cast(unsigned, b); }
__device__ __forceinline__ u32x4 pack8(const f32x4 a, const f32x4 b) { u32x4 w; w.x = cvt_pk_bf16(a[0], a[1]); w.y = cvt_pk_bf16(a[2], a[3]); w.z = cvt_pk_bf16(b[0], b[1]); w.w = cvt_pk_bf16(b[2], b[3]); return w; }
__device__ __forceinline__ float bflo(unsigned u) { return __builtin_bit_cast(float, u << 16); }
__device__ __forceinline__ float bfhi(unsigned u) { return __builtin_bit_cast(float, u & 0xffff0000u); }


constexpr float RMS_EPS = 1e-6f;

struct EpiProj {
    static constexpr bool PERM = true, AFTER_DRAIN = false, HAS_MID = false;
    const float* rstd; bf16_t *qn, *kn, *pp, *xq, *gates; const float *qg, *kg, *gate_b;
    __device__ __forceinline__ void operator()(const f32x4 (&acc)[2][2][4][2], const Unit& u, int wr, int wc, int fr, int fq) const {
        const int pn = u.pn, row0 = u.pm * BM + wr * 64 + fr, lc0 = 64 * wc + 8 * fq;
        float rsv[2][4];
#pragma unroll
        for (int ai = 0; ai < 2; ++ai)
#pragma unroll
            for (int m = 0; m < 4; ++m) rsv[ai][m] = rstd[row0 + ai * HALF + m * 16];
        if (pn < 4) {
            const bool isq = pn < 2; bf16_t* O = isq ? qn : kn; const float* g = isq ? qg : kg; const float post = isq ? 0.125f : 1.0f;
            f32x4 gv[2][2];
#pragma unroll
            for (int bj = 0; bj < 2; ++bj)
#pragma unroll
                for (int n = 0; n < 2; ++n) gv[bj][n] = *(const f32x4*)(g + 32 * bj + 8 * fq + 4 * n);
            const int colbase = (pn & 1) * 256 + lc0;
#pragma unroll
            for (int ai = 0; ai < 2; ++ai)
#pragma unroll
                for (int m = 0; m < 4; ++m) {
                    const int row = row0 + ai * HALF + m * 16; const float rs = rsv[ai][m];
                    f32x4 v[2][2]; float ss = 0.f;
#pragma unroll
                    for (int bj = 0; bj < 2; ++bj)
#pragma unroll
                        for (int n = 0; n < 2; ++n) { v[bj][n] = acc[ai][bj][m][n] * rs; ss += (v[bj][n][0] * v[bj][n][0] + v[bj][n][1] * v[bj][n][1]) + (v[bj][n][2] * v[bj][n][2] + v[bj][n][3] * v[bj][n][3]); }
                    ss += __shfl_xor(ss, 16); ss += __shfl_xor(ss, 32);
                    const float r = rsqrtf(ss * (1.0f / 64.0f) + RMS_EPS) * post;
#pragma unroll
                    for (int bj = 0; bj < 2; ++bj) *(u32x4*)(O + (size_t)row * 512 + colbase + 32 * bj) = pack8(v[bj][0] * r * gv[bj][0], v[bj][1] * r * gv[bj][1]);
                }
        } else if (pn < 8) {
            bf16_t* O = pn < 6 ? pp : xq; const int colbase = (pn & 1) * 256 + lc0;
#pragma unroll
            for (int ai = 0; ai < 2; ++ai)
#pragma unroll
                for (int m = 0; m < 4; ++m) {
                    const int row = row0 + ai * HALF + m * 16; const float rs = rsv[ai][m];
#pragma unroll
                    for (int bj = 0; bj < 2; ++bj) *(u32x4*)(O + (size_t)row * 512 + colbase + 32 * bj) = pack8(acc[ai][bj][m][0] * rs, acc[ai][bj][m][1] * rs);
                }
        } else {
            const int gcol0 = (pn - 8) * 256 + lc0;
            f32x4 bv[2][2];
#pragma unroll
            for (int bj = 0; bj < 2; ++bj)
#pragma unroll
                for (int n = 0; n < 2; ++n) bv[bj][n] = *(const f32x4*)(gate_b + gcol0 + 32 * bj + 4 * n);
#pragma unroll
            for (int ai = 0; ai < 2; ++ai)
#pragma unroll
                for (int m = 0; m < 4; ++m) {
                    const int row = row0 + ai * HALF + m * 16; const float rs = rsv[ai][m];
#pragma unroll
                    for (int bj = 0; bj < 2; ++bj) {
                        f32x4 o[2];
#pragma unroll
                        for (int n = 0; n < 2; ++n) { const f32x4 z = acc[ai][bj][m][n] * rs + bv[bj][n];
#pragma unroll
                            for (int i = 0; i < 4; ++i) o[n][i] = __builtin_amdgcn_rcpf(1.0f + __expf(-z[i])); }
                        *(u32x4*)(gates + (size_t)row * 3072 + gcol0 + 32 * bj) = pack8(o[0], o[1]);
                    }
                }
        }
    }
};
struct EpiVt {
    static constexpr bool PERM = true, AFTER_DRAIN = false, HAS_MID = false;
    const float* rstd; bf16_t* Vt;
    __device__ __forceinline__ void operator()(const f32x4 (&acc)[2][2][4][2], const Unit& u, int wr, int wc, int fr, int fq) const {
        const int ch0 = u.pm * BM + wr * 64 + fr, tok0 = u.pn * BM + wc * 32 + 8 * fq, b = tok0 >> 13, t0 = tok0 & 8191;
        f32x4 rv[2][2];
#pragma unroll
        for (int bj = 0; bj < 2; ++bj)
#pragma unroll
            for (int n = 0; n < 2; ++n) rv[bj][n] = *(const f32x4*)(rstd + tok0 + bj * HALF + 4 * n);
#pragma unroll
        for (int ai = 0; ai < 2; ++ai)
#pragma unroll
            for (int m = 0; m < 4; ++m) { const int ch = ch0 + ai * HALF + m * 16; bf16_t* rowp = Vt + ((size_t)(b * 512 + ch) * 8192 + t0);
#pragma unroll
                for (int bj = 0; bj < 2; ++bj) *(u32x4*)(rowp + bj * HALF) = pack8(acc[ai][bj][m][0] * rv[bj][0], acc[ai][bj][m][1] * rv[bj][1]); }
    }
};
struct EpiMergeCat {
    static constexpr bool PERM = true, AFTER_DRAIN = false, HAS_MID = true;
    const bf16_t* gates; bf16_t* merged;
    __device__ __forceinline__ void mid(f32x4 (&acc)[2][2][4][2], const Unit& u, int nb  , int wr, int wc, int fr, int fq) const {
        const int row0 = u.pm * BM + wr * 64 + fr, col0 = u.pn * BM + wc * 32 + 8 * fq;
#pragma unroll
        for (int ai = 0; ai < 2; ++ai) {
            u32x4 ga[4][2], gb[4][2];
#pragma unroll
            for (int m = 0; m < 4; ++m)
#pragma unroll
                for (int bj = 0; bj < 2; ++bj) { const bf16_t* gp = gates + (size_t)(row0 + ai * HALF + m * 16) * 3072 + (nb - 1) * 1024 + col0 + bj * HALF;
                    ga[m][bj] = *(const u32x4*)gp; gb[m][bj] = *(const u32x4*)(gp + 1024); }
            __builtin_amdgcn_sched_barrier(0);
#pragma unroll
            for (int m = 0; m < 4; ++m)
#pragma unroll
                for (int bj = 0; bj < 2; ++bj) { const u32x4 a = ga[m][bj], b = gb[m][bj]; f32x4& x0 = acc[ai][bj][m][0]; f32x4& x1 = acc[ai][bj][m][1];
                    x0[0] *= bflo(a.x) * __builtin_amdgcn_rcpf(bflo(b.x)); x0[1] *= bfhi(a.x) * __builtin_amdgcn_rcpf(bfhi(b.x)); x0[2] *= bflo(a.y) * __builtin_amdgcn_rcpf(bflo(b.y)); x0[3] *= bfhi(a.y) * __builtin_amdgcn_rcpf(bfhi(b.y));
                    x1[0] *= bflo(a.z) * __builtin_amdgcn_rcpf(bflo(b.z)); x1[1] *= bfhi(a.z) * __builtin_amdgcn_rcpf(bfhi(b.z)); x1[2] *= bflo(a.w) * __builtin_amdgcn_rcpf(bflo(b.w)); x1[3] *= bfhi(a.w) * __builtin_amdgcn_rcpf(bfhi(b.w)); }
            __builtin_amdgcn_sched_barrier(0);
        }
    }
    __device__ __forceinline__ void operator()(const f32x4 (&acc)[2][2][4][2], const Unit& u, int wr, int wc, int fr, int fq) const {
        const int row0 = u.pm * BM + wr * 64 + fr, col0 = u.pn * BM + wc * 32 + 8 * fq;
#pragma unroll
        for (int ai = 0; ai < 2; ++ai) {
            u32x4 g8[4][2];
#pragma unroll
            for (int m = 0; m < 4; ++m)
#pragma unroll
                for (int bj = 0; bj < 2; ++bj) g8[m][bj] = *(const u32x4*)(gates + (size_t)(row0 + ai * HALF + m * 16) * 3072 + 2048 + col0 + bj * HALF);
            __builtin_amdgcn_sched_barrier(0);
#pragma unroll
            for (int m = 0; m < 4; ++m)
#pragma unroll
                for (int bj = 0; bj < 2; ++bj) { const u32x4 g = g8[m][bj]; f32x4 a = acc[ai][bj][m][0], b = acc[ai][bj][m][1];
                    a[0] *= bflo(g.x); a[1] *= bfhi(g.x); a[2] *= bflo(g.y); a[3] *= bfhi(g.y); b[0] *= bflo(g.z); b[1] *= bfhi(g.z); b[2] *= bflo(g.w); b[3] *= bfhi(g.w);
                    *(u32x4*)(merged + (size_t)(row0 + ai * HALF + m * 16) * 1024 + col0 + bj * HALF) = pack8(a, b); }
            __builtin_amdgcn_sched_barrier(0);
        }
    }
};
struct EpiH {
    static constexpr bool PERM = true, AFTER_DRAIN = false, HAS_MID = false;
    const float* x; float* out; bf16_t* hb; float* rowsq; int noatomic;
    __device__ __forceinline__ void operator()(const f32x4 (&acc)[2][2][4][2], const Unit& u, int wr, int wc, int fr, int fq) const {
        const int row0 = u.pm * BM + wr * 64 + fr, col0 = u.pn * BM + wc * 32 + 8 * fq;
#pragma unroll
        for (int ai = 0; ai < 2; ++ai) {
            f32x4 xv[4][2][2];
#pragma unroll
            for (int m = 0; m < 4; ++m)
#pragma unroll
                for (int bj = 0; bj < 2; ++bj) { const size_t o = (size_t)(row0 + ai * HALF + m * 16) * 1024 + col0 + bj * HALF; xv[m][bj][0] = *(const f32x4*)(x + o); xv[m][bj][1] = *(const f32x4*)(x + o + 4); }
            __builtin_amdgcn_sched_barrier(0);
#pragma unroll
            for (int m = 0; m < 4; ++m) { const int row = row0 + ai * HALF + m * 16; float ss = 0.f;
#pragma unroll
                for (int bj = 0; bj < 2; ++bj) { const size_t o = (size_t)row * 1024 + col0 + bj * HALF;
                    const f32x4 h0 = xv[m][bj][0] + acc[ai][bj][m][0], h1 = xv[m][bj][1] + acc[ai][bj][m][1];
                    *(u32x4*)(hb + o) = pack8(h0, h1);
                    ss += (h0[0] * h0[0] + h0[1] * h0[1]) + (h0[2] * h0[2] + h0[3] * h0[3]) + (h1[0] * h1[0] + h1[1] * h1[1]) + (h1[2] * h1[2] + h1[3] * h1[3]); }
                ss += __shfl_xor(ss, 16); ss += __shfl_xor(ss, 32);
                if (fq == 0 && !noatomic) atomicAdd(rowsq + row, ss); }
            __builtin_amdgcn_sched_barrier(0);
        }
    }
};
struct EpiQ {
    static constexpr bool PERM = true, AFTER_DRAIN = false, HAS_MID = false;
    const float* rowsq; bf16_t* qb;
    __device__ __forceinline__ void operator()(const f32x4 (&acc)[2][2][4][2], const Unit& u, int wr, int wc, int fr, int fq) const {
        const int row0 = u.pm * BM + wr * 64 + fr, col0 = u.pn * BM + wc * 32 + 8 * fq;
        float rq[2][4];
#pragma unroll
        for (int ai = 0; ai < 2; ++ai)
#pragma unroll
            for (int m = 0; m < 4; ++m) rq[ai][m] = rowsq[row0 + ai * HALF + m * 16];
#pragma unroll
        for (int ai = 0; ai < 2; ++ai)
#pragma unroll
            for (int m = 0; m < 4; ++m) { const int row = row0 + ai * HALF + m * 16; const float r = rsqrtf(rq[ai][m] * (1.0f / 1024.0f) + RMS_EPS);
#pragma unroll
                for (int bj = 0; bj < 2; ++bj) *(u32x4*)(qb + (size_t)row * 2048 + col0 + bj * HALF) = pack8(acc[ai][bj][m][0] * r, acc[ai][bj][m][1] * r); }
    }
};

template <class Epi, class Sched, bool ALIGN_EPI = false, bool SP2 = false>
__device__ __forceinline__ void gemm_phase(PG8_LAS unsigned char* lds, const int K, const Sched& S, const Epi& E) {
    const int tid = threadIdx.x, wid = __builtin_amdgcn_readfirstlane(tid >> 6), lane = tid & 63, wr = wid >> 2, wc = wid & 3, fr = lane & 15, fq = lane >> 4;
    const int nt = K / BK;
    unsigned voffA[2], voffB[2];
#pragma unroll
    for (int i = 0; i < 2; ++i) { int R, C; stage_rc(tid * 16 + i * 8192, R, C); const int Rb = Epi::PERM ? ((R & ~31) + perm32(R & 31)) : R;
        voffA[i] = (unsigned)(R * K + C) * 2u; voffB[i] = (unsigned)(Rb * K + C) * 2u; }
    const size_t kstep = (size_t)(BK * 2);
    const size_t hstep = (size_t)HALF * K * 2;
    const size_t tstep = 2 * hstep;
    const unsigned ldsw = (unsigned)wid * 1024u;
    const int aoff = lds_byte(wr * 64 + fr, fq * 8), boff = lds_byte(wc * 32 + fr, fq * 8);
#define PG8_SA(b, h) (((b) * 2 + (h)) * HTB)
#define PG8_SB(b, h) ((4 + (b) * 2 + (h)) * HTB)
#define PG8_STAGE(bufoff, gbase, voff) do { _Pragma("unroll") for (int _i = 0; _i < 2; ++_i) \
        __builtin_amdgcn_global_load_lds((const unsigned*)((const char*)(gbase) + (voff)[_i]), (PG8_LAS unsigned*)(lds + (bufoff) + ldsw + _i * 8192), 16, 0, 0); } while (0)
#define PG8_LDA(dst, b, h) do { _Pragma("unroll") for (int m = 0; m < 4; ++m) _Pragma("unroll") for (int k = 0; k < 2; ++k) dst[m][k] = *(const PG8_LAS bf16x8*)(lds + PG8_SA(b, h) + aoff + m * 2048 + k * 1024); } while (0)
#define PG8_LDB(dst, b, h) do { _Pragma("unroll") for (int n = 0; n < 2; ++n) _Pragma("unroll") for (int k = 0; k < 2; ++k) dst[n][k] = *(const PG8_LAS bf16x8*)(lds + PG8_SB(b, h) + boff + n * 2048 + k * 1024); } while (0)
#define PG8_MMA(ai, bj, At, Bt) do { __builtin_amdgcn_s_setprio(1); _Pragma("unroll") for (int m = 0; m < 4; ++m) _Pragma("unroll") for (int n = 0; n < 2; ++n) _Pragma("unroll") for (int k = 0; k < 2; ++k) \
        acc[ai][bj][m][n] = __builtin_amdgcn_mfma_f32_16x16x32_bf16(Bt[n][k], At[m][k], acc[ai][bj][m][n], 0, 0, 0); __builtin_amdgcn_s_setprio(0); } while (0)
#define PG8_WAIT_V(n) asm volatile("s_waitcnt vmcnt(" #n ")" ::: "memory")
#define PG8_WAIT_L(n) asm volatile("s_waitcnt lgkmcnt(" #n ")" ::: "memory")
#define PG8_BAR __builtin_amdgcn_s_barrier()
#define PG8_SCHED __builtin_amdgcn_sched_barrier(0)
    Unit cur, nxt; int ui = 0;
    if (!S.next(0, cur)) return;
    f32x4 acc[2][2][4][2];
#pragma unroll
    for (int a = 0; a < 2; ++a)
#pragma unroll
        for (int b = 0; b < 2; ++b)
#pragma unroll
            for (int m = 0; m < 4; ++m)
#pragma unroll
                for (int n = 0; n < 2; ++n) acc[a][b][m][n] = (f32x4){0.f, 0.f, 0.f, 0.f};
    bf16x8 At[4][2], B0[2][2], B1[2][2];
    const char* cA = S.abase(cur); const char* cB = S.bbase(cur);
    S.a_ready(cur);
    if constexpr (SP2) {
        PG8_STAGE(PG8_SB(0, 0), cB, voffB); PG8_STAGE(PG8_SB(0, 1), cB + hstep, voffB); PG8_STAGE(PG8_SA(0, 0), cA, voffA); PG8_STAGE(PG8_SA(0, 1), cA + hstep, voffA);
        if (wr == 1) PG8_BAR;
        PG8_WAIT_V(2); PG8_BAR;
        PG8_STAGE(PG8_SB(1, 0), cB + kstep, voffB); PG8_STAGE(PG8_SA(1, 0), cA + kstep, voffA); PG8_STAGE(PG8_SB(1, 1), cB + hstep + kstep, voffB);
        PG8_WAIT_V(6); PG8_BAR;
    } else {
        PG8_STAGE(PG8_SB(0, 0), cB, voffB); PG8_STAGE(PG8_SA(0, 0), cA, voffA); PG8_STAGE(PG8_SB(0, 1), cB + hstep, voffB); PG8_STAGE(PG8_SA(0, 1), cA + hstep, voffA);
        if (wr == 1) PG8_BAR;
        PG8_WAIT_V(4); PG8_BAR;
        PG8_STAGE(PG8_SB(1, 0), cB + kstep, voffB); PG8_STAGE(PG8_SA(1, 0), cA + kstep, voffA); PG8_STAGE(PG8_SB(1, 1), cB + hstep + kstep, voffB);
        PG8_WAIT_V(6); PG8_BAR;
    }
    for (;;) {
        const bool has_next = S.next(ui + 1, nxt);
        const char* nA = has_next ? S.abase(nxt) : cA; const char* nB = has_next ? S.bbase(nxt) : cB;
        for (int t = 0; t < nt; t += 2) {
            if constexpr (Epi::HAS_MID) { if (t == 8 || t == 16) E.mid(acc, cur, t >> 3, wr, wc, fr, fq); }
            const bool last = (t == nt - 2);
            const char* a1 = cA + (size_t)(t + 1) * kstep;
            const char* a2 = last ? nA : cA + (size_t)(t + 2) * kstep; const char* b2 = last ? nB : cB + (size_t)(t + 2) * kstep;
            const char* a3 = a2 + kstep; const char* b3 = b2 + kstep;
            if (last && has_next) S.a_ready(nxt);
            if constexpr (SP2) {
            PG8_LDB(B0, 0, 0); PG8_LDB(B1, 0, 1); PG8_SCHED; PG8_LDA(At, 0, 0); PG8_STAGE(PG8_SA(1, 1), a1 + hstep, voffA);
            PG8_WAIT_V(8); PG8_WAIT_L(0); PG8_BAR; PG8_MMA(0, 0, At, B0); PG8_MMA(0, 1, At, B1); PG8_BAR; PG8_SCHED;
            PG8_LDA(At, 0, 1); PG8_STAGE(PG8_SB(0, 0), b2, voffB); PG8_STAGE(PG8_SB(0, 1), b2 + hstep, voffB); PG8_STAGE(PG8_SA(0, 0), a2, voffA);
            PG8_WAIT_V(8); PG8_WAIT_L(0); PG8_BAR; PG8_MMA(1, 0, At, B0); PG8_MMA(1, 1, At, B1); PG8_BAR; PG8_SCHED;
            PG8_LDB(B0, 1, 0); PG8_LDB(B1, 1, 1); PG8_SCHED; PG8_LDA(At, 1, 0); PG8_STAGE(PG8_SA(0, 1), a2 + hstep, voffA);
            PG8_WAIT_V(8); PG8_WAIT_L(0); PG8_BAR; PG8_MMA(0, 0, At, B0); PG8_MMA(0, 1, At, B1); PG8_BAR; PG8_SCHED;
            PG8_LDA(At, 1, 1); PG8_STAGE(PG8_SB(1, 0), b3, voffB); PG8_STAGE(PG8_SB(1, 1), b3 + hstep, voffB); PG8_STAGE(PG8_SA(1, 0), a3, voffA);
            PG8_WAIT_V(8); PG8_WAIT_L(0); PG8_BAR; PG8_MMA(1, 0, At, B0); PG8_MMA(1, 1, At, B1); PG8_BAR; PG8_SCHED;
            } else {
            PG8_LDB(B0, 0, 0); PG8_SCHED; PG8_LDA(At, 0, 0); PG8_STAGE(PG8_SA(1, 1), a1 + hstep, voffA);
            PG8_WAIT_L(8); PG8_BAR; PG8_WAIT_L(0); PG8_MMA(0, 0, At, B0); PG8_BAR; PG8_SCHED;
            PG8_LDB(B1, 0, 1); PG8_STAGE(PG8_SB(0, 0), b2, voffB);
            PG8_BAR; PG8_WAIT_L(0); PG8_MMA(0, 1, At, B1); PG8_BAR;
            PG8_LDA(At, 0, 1); PG8_STAGE(PG8_SA(0, 0), a2, voffA);
            PG8_BAR; PG8_WAIT_L(0); PG8_MMA(1, 0, At, B0); PG8_BAR; PG8_SCHED;
            PG8_STAGE(PG8_SB(0, 1), b2 + hstep, voffB);
            PG8_WAIT_V(6); PG8_BAR; PG8_MMA(1, 1, At, B1); PG8_BAR;
            PG8_LDB(B0, 1, 0); PG8_SCHED; PG8_LDA(At, 1, 0); PG8_STAGE(PG8_SA(0, 1), a2 + hstep, voffA);
            PG8_WAIT_L(8); PG8_BAR; PG8_WAIT_L(0); PG8_MMA(0, 0, At, B0); PG8_BAR; PG8_SCHED;
            PG8_LDB(B1, 1, 1); PG8_STAGE(PG8_SB(1, 0), b3, voffB);
            PG8_BAR; PG8_WAIT_L(0); PG8_MMA(0, 1, At, B1); PG8_BAR;
            PG8_LDA(At, 1, 1); PG8_STAGE(PG8_SA(1, 0), a3, voffA);
            PG8_BAR; PG8_WAIT_L(0); PG8_MMA(1, 0, At, B0); PG8_BAR; PG8_SCHED;
            PG8_STAGE(PG8_SB(1, 1), b3 + hstep, voffB);
            PG8_WAIT_V(6); PG8_BAR; PG8_MMA(1, 1, At, B1); PG8_BAR;
            }
        }
        if constexpr (ALIGN_EPI) { if (wr == 0) PG8_BAR; }
        if constexpr (!Epi::AFTER_DRAIN) { E(acc, cur, wr, wc, fr, fq); S.done(cur); }
        if (!has_next) break;
#pragma unroll
        for (int a = 0; a < 2; ++a)
#pragma unroll
            for (int b = 0; b < 2; ++b)
#pragma unroll
                for (int m = 0; m < 4; ++m)
#pragma unroll
                    for (int n = 0; n < 2; ++n) acc[a][b][m][n] = (f32x4){0.f, 0.f, 0.f, 0.f};
        cur = nxt; cA = nA; cB = nB; ++ui;
        if constexpr (ALIGN_EPI) { if (wr == 1) PG8_BAR; }
    }
    PG8_WAIT_V(0);
    if constexpr (!ALIGN_EPI) { if (wr == 0) PG8_BAR; }
    PG8_BAR;
    if constexpr (Epi::AFTER_DRAIN) { E.fused(acc, cur, wr, wc, fr, fq, lds, wid, lane); S.done(cur); }
#undef PG8_SA
#undef PG8_SB
#undef PG8_STAGE
#undef PG8_LDA
#undef PG8_LDB
#undef PG8_MMA
#undef PG8_WAIT_V
#undef PG8_WAIT_L
#undef PG8_BAR
#undef PG8_SCHED
}
}

constexpr int NWAVES = 8;
constexpr int N_LAUNCHES = MK_N_LAUNCHES;
constexpr int PER_PHASE = 9;
constexpr int NBATCH = 4, SEQ = 8192, D = 1024, T = NBATCH * SEQ, MEMLEN = 256, NMEMTOK = NBATCH * MEMLEN;
constexpr int IN_MAIN = 5120;
constexpr int NEXP = 16384;

constexpr size_t MiB = 1u << 20;
constexpr size_t WS_CTL = 0, CTL_ZERO_BYTES = 512 * 1024;
constexpr size_t WS_ROWSQ = 256 * 1024;
constexpr size_t WS_WIN = 1 * MiB, WS_WV = 11 * MiB, WS_WKV = 12 * MiB, WS_WBR = 14 * MiB, WS_WOUT = 17 * MiB, WS_WQ = 19 * MiB, WS_KEYS = 23 * MiB, WS_PWT = 23 * MiB + 512 * 1024;
constexpr size_t WS_MEMN = 24 * MiB, WS_KMEM = 26 * MiB, WS_VTMEM = 27 * MiB, WS_RSTDX = 28 * MiB, WS_SU = 28 * MiB + 256 * 1024  , WS_SV = 28 * MiB + 512 * 1024  ;
constexpr size_t WS_U8 = 32 * MiB, WS_V8 = 48 * MiB;
constexpr size_t WS_QN = 96 * MiB, WS_KN = 128 * MiB, WS_VT = 160 * MiB, WS_PP = 192 * MiB, WS_XQ = 224 * MiB, WS_GATE = 256 * MiB, WS_END = 448 * MiB;
constexpr size_t WS_MERGED = WS_QN;
constexpr size_t WS_HB = WS_VT;
constexpr size_t WS_QB = WS_GATE;
constexpr size_t WS_TE = WS_GATE + 128 * MiB, WS_TW = WS_TE + 16 * MiB;
constexpr size_t WS_HQ = WS_TW + 16 * MiB;
constexpr size_t WS_HS = 28 * MiB + 768 * 1024;
constexpr size_t WS_AW = WS_MERGED;
constexpr size_t OUT_XB = 0, OUT_YNA = 0, OUT_YPOOL = 512 * 2, OUT_YXA = 1024 * 2;
constexpr int CW_TMO = 0, CW_BAR = 4096, CW_TICKET = 8192;

constexpr int RING_OFF = 0, RING_BYTES = 131072;
constexpr int LDSCTL_OFF = RING_BYTES, MISC_OFF = LDSCTL_OFF + 320;
constexpr int LDS_BYTES = 147456;

#define GAS __attribute__((address_space(1)))
#define LAS __attribute__((address_space(3)))
typedef unsigned short bf16;
typedef unsigned v4u __attribute__((ext_vector_type(4)));
typedef unsigned v2u __attribute__((ext_vector_type(2)));
typedef float f32x4 __attribute__((ext_vector_type(4)));
typedef short bf16x8 __attribute__((ext_vector_type(8)));
typedef __bf16 bf16x2_t __attribute__((ext_vector_type(2)));
typedef GAS unsigned gu32;
#define LDS_WAIT() asm volatile("s_waitcnt lgkmcnt(0)" ::: "memory")
#define VM_WAIT() asm volatile("s_waitcnt vmcnt(0)" ::: "memory")
__device__ __forceinline__ unsigned f2bf(float f) { unsigned u = __builtin_bit_cast(unsigned, f); return (u + 0x7fffu + ((u >> 16) & 1u)) >> 16; }
__device__ __forceinline__ unsigned pk2(float lo, float hi) { return f2bf(lo) | (f2bf(hi) << 16); }
__device__ __forceinline__ float bflo(unsigned u) { return __builtin_bit_cast(float, u << 16); }
__device__ __forceinline__ float bfhi(unsigned u) { return __builtin_bit_cast(float, u & 0xffff0000u); }
__device__ __forceinline__ float bf1(short s) { return __builtin_bit_cast(float, ((unsigned)(unsigned short)s) << 16); }
__device__ __forceinline__ f32x4 mfma16(bf16x8 a, bf16x8 b, f32x4 c) { return __builtin_amdgcn_mfma_f32_16x16x32_bf16(a, b, c, 0, 0, 0); }
__device__ __forceinline__ float wave_sum(float v) {
#pragma unroll
    for (int o = 1; o < 64; o <<= 1) v += __shfl_xor(v, o);
    return v;
}

#define XB_TMO      128
#define XB_XCNT(j)  (256  + 64 * (j))
#define XB_XSUB(j)  (1280 + 64 * (j))
#define XB_XGEN(j)  (2304 + 64 * (j))
#define XB_TOP      3328
#define XB_TOPGEN   3392
#define XCD_BAR_WORDS 3456
#define XB_SPIN_CAP (1u << 18)

__device__ __forceinline__ unsigned xb_ld(unsigned* p)              { return __hip_atomic_load(p, __ATOMIC_RELAXED, __HIP_MEMORY_SCOPE_AGENT); }
__device__ __forceinline__ unsigned xb_add(unsigned* p, unsigned v) { return __hip_atomic_fetch_add(p, v, __ATOMIC_RELAXED, __HIP_MEMORY_SCOPE_AGENT); }
__device__ __forceinline__ unsigned xb_xcc_id() { return (unsigned)__builtin_amdgcn_s_getreg((3 << 11) | 20) & 0xFu; }
#define XB_SPIN(cond, bar) do { unsigned _sp = 0; while (cond) { __builtin_amdgcn_s_sleep(1); \
    if ((++_sp & 255u) == 0u) { if (xb_ld(&(bar)[XB_TMO])) break; if (_sp > XB_SPIN_CAP) { atomicAdd(&(bar)[XB_TMO], 1u); break; } } } } while (0)

struct XcdBarrier {
    unsigned* bar; unsigned x;
    volatile LAS unsigned* st;
};

__device__ __forceinline__ XcdBarrier xcd_barrier_post(unsigned* bar, volatile LAS unsigned* st) {
    XcdBarrier b; b.bar = bar; b.x = xb_xcc_id(); b.st = st;
    if (threadIdx.x == 0) (void)xb_add(&bar[XB_XCNT(b.x)], 1u);
    return b;
}
__device__ __forceinline__ void xcd_barrier_complete(unsigned* bar, unsigned x, unsigned& nloc, unsigned& nx) {
    const unsigned G = gridDim.x * gridDim.y * gridDim.z;
    unsigned sum, cnt, mine, sp = 0u;
    for (;;) {
        sum = 0u; cnt = 0u; mine = 0u;
#pragma unroll
        for (unsigned j = 0; j < 16; ++j) { const unsigned c = xb_ld(&bar[XB_XCNT(j)]); sum += c; cnt += (c > 0u) ? 1u : 0u; mine = (j == x) ? c : mine; }
        if (sum == G) break;
        __builtin_amdgcn_s_sleep(1);
        if ((++sp & 255u) == 0u) { if (xb_ld(&bar[XB_TMO])) break; if (sp > XB_SPIN_CAP) { atomicAdd(&bar[XB_TMO], 1u); break; } }
    }
    nloc = mine > 0u ? mine : 1u; nx = cnt > 0u ? cnt : 1u;
}

__device__ __forceinline__ void xcd_barrier(const XcdBarrier& b) {
    asm volatile("s_waitcnt vmcnt(0)" ::: "memory");
    __syncthreads();
    if (threadIdx.x == 0) {
        unsigned* bar = b.bar;
        __builtin_amdgcn_s_waitcnt(0);
        unsigned nloc = b.st[0], nx = b.st[1];
        if (nloc == 0u) { xcd_barrier_complete(bar, b.x, nloc, nx); b.st[0] = nloc; b.st[1] = nx; }
        const unsigned old = xb_add(&bar[XB_XSUB(b.x)], 1u);
        const unsigned gen = old / nloc;
        if (old + 1u == (gen + 1u) * nloc) {
            __builtin_amdgcn_fence(__ATOMIC_RELEASE, "agent");
            asm volatile("s_waitcnt vmcnt(0)" ::: "memory");
            const unsigned og = xb_add(&bar[XB_TOP], 1u);
            const unsigned tg = og / nx;
            if (og + 1u == (tg + 1u) * nx) xb_add(&bar[XB_TOPGEN], 1u);
            else XB_SPIN(xb_ld(&bar[XB_TOPGEN]) == tg, bar);
            __builtin_amdgcn_fence(__ATOMIC_ACQUIRE, "agent");
            xb_add(&bar[XB_XGEN(b.x)], 1u);
            asm volatile("s_waitcnt vmcnt(0)" ::: "memory");
        } else {
            XB_SPIN(xb_ld(&bar[XB_XGEN(b.x)]) == gen, bar);
            __builtin_amdgcn_fence(__ATOMIC_ACQUIRE, "agent");
            asm volatile("s_waitcnt vmcnt(0)" ::: "memory");
        }
    }
    __syncthreads();
}

struct Frame {
    LAS unsigned char* lds;
    volatile LAS unsigned* MISC;
    gu32* ctl;
    int tid, lane, wave, vcu, G;
    float* out; unsigned char* ws;
};
struct Args { const float* in[23]; float* out; unsigned char* ws; int ph_lo, ph_hi, probe, pad; };
enum { I_X = 0, I_MEM, I_MIXG, I_MEMG, I_WIN, I_GATEB, I_WKV, I_NAQG, I_NAKG, I_RPB, I_POOLW, I_POOLSC, I_XAQG, I_XAKG, I_WB0, I_WB1, I_WB2, I_WOUT, I_FFNG, I_WQ, I_KEYS, I_PU, I_PV };

__device__ __forceinline__ void p0_transpose_item(const float* W, int K, int N, int k0, int n0, bf16* dst, const float* kscale, LAS float* scr, int lane, int dpitch = 0) {
    if (dpitch == 0) dpitch = K;
#pragma unroll 8
    for (int i = 0; i < 32; ++i) { const int kk = 2 * i + (lane >> 5); float v = W[(size_t)(k0 + kk) * N + n0 + (lane & 31)]; if (kscale) v *= kscale[k0 + kk]; scr[kk * 33 + (lane & 31)] = v; }
    LDS_WAIT(); asm volatile("" ::: "memory");
    const int c = lane & 7;
#pragma unroll
    for (int j = 0; j < 4; ++j) { const int n = (lane >> 3) + 8 * j; const LAS float* s = scr + (8 * c) * 33 + n;
        v4u o; o.x = pk2(s[0 * 33], s[1 * 33]); o.y = pk2(s[2 * 33], s[3 * 33]); o.z = pk2(s[4 * 33], s[5 * 33]); o.w = pk2(s[6 * 33], s[7 * 33]);
        *(GAS v4u*)(dst + (size_t)n * dpitch + k0 + 8 * c) = o; }
    LDS_WAIT(); asm volatile("" ::: "memory");
}
__device__ __forceinline__ void cvt_row1024(const float* src, bf16* dst, const float* colscale, float rowscale, int lane) {
    const GAS f32x4* xr = (const GAS f32x4*)src + lane; GAS unsigned long long* o8 = (GAS unsigned long long*)dst + lane;
#pragma unroll
    for (int j = 0; j < 4; ++j) { f32x4 v = xr[64 * j] * rowscale; if (colscale) v = v * ((const GAS f32x4*)colscale)[lane + 64 * j];
        o8[64 * j] = (unsigned long long)pk2(v.x, v.y) | ((unsigned long long)pk2(v.z, v.w) << 32); }
}
__device__ __forceinline__ float row_rstd1024(const float* src, int lane) {
    const GAS f32x4* xr = (const GAS f32x4*)src + lane; float s = 0.f;
#pragma unroll
    for (int j = 0; j < 4; ++j) { const f32x4 v = xr[64 * j]; s += (v.x * v.x + v.y * v.y) + (v.z * v.z + v.w * v.w); }
    return rsqrtf(wave_sum(s) * (1.0f / 1024.0f) + 1e-6f);
}
__device__ __forceinline__ void p0_prologue(Frame& F, const Args& A) {
    LAS float* scr = (LAS float*)(F.lds + RING_OFF + F.wave * 16384);
    const int gw = F.vcu * NWAVES + F.wave, NGW = F.G * NWAVES, lane = F.lane;
    unsigned char* ws = F.ws;
    constexpr int I_IN = 16 * 176, I_KV = 16 * 32, I_BR = 8 * 32, I_OUT = 16 * 32, I_Q = 16 * 64;
    constexpr int NITEMS = I_IN + I_KV + 3 * I_BR + I_OUT + I_Q;
    for (int it = gw; it < NITEMS; it += NGW) {
        int r = it;
        if (r < I_IN) { const int kb = r / 176, nb = r % 176, n0 = 32 * nb; bf16* dst;
            if (n0 >= 1024 && n0 < 1536) dst = (bf16*)(ws + WS_WV) + (size_t)(n0 - 1024) * 1024;
            else { const int np = n0 < 1024 ? n0 : n0 - 512, t = np >> 8, w = np & 255, wc = w >> 6, bj = (w >> 5) & 1; dst = (bf16*)(ws + WS_WIN) + (size_t)(256 * t + 128 * bj + 32 * wc) * 1024; }
            p0_transpose_item(A.in[I_WIN], 1024, 5632, 64 * kb, n0, dst, A.in[I_MIXG], scr, lane); continue; }
        r -= I_IN;
        if (r < I_KV) { const int kb = r / 32, nb = r % 32; p0_transpose_item(A.in[I_WKV], 1024, 1024, 64 * kb, 32 * nb, (bf16*)(ws + WS_WKV) + (size_t)(32 * nb) * 1024, nullptr, scr, lane); continue; }
        r -= I_KV;
        if (r < 3 * I_BR) { const int br = r / I_BR, rr = r % I_BR, kb = rr / 32, nb = rr % 32; const float* W = br == 0 ? A.in[I_WB0] : (br == 1 ? A.in[I_WB1] : A.in[I_WB2]);
            p0_transpose_item(W, 512, 1024, 64 * kb, 32 * nb, (bf16*)(ws + WS_WBR) + (size_t)(32 * nb) * 1536 + br * 512, nullptr, scr, lane, 1536); continue; }
        r -= 3 * I_BR;
        if (r < I_OUT) { const int kb = r / 32, nb = r % 32; p0_transpose_item(A.in[I_WOUT], 1024, 1024, 64 * kb, 32 * nb, (bf16*)(ws + WS_WOUT) + (size_t)(32 * nb) * 1024, nullptr, scr, lane); continue; }
        r -= I_OUT;
        { const int kb = r / 64, nb = r % 64; p0_transpose_item(A.in[I_WQ], 1024, 2048, 64 * kb, 32 * nb, (bf16*)(ws + WS_WQ) + (size_t)(32 * nb) * 1024, A.in[I_FFNG], scr, lane); }
    }
    { bf16* xb = (bf16*)((unsigned char*)F.out + OUT_XB); float* rstdx = (float*)(ws + WS_RSTDX);
      for (int m0 = 4 * gw; m0 < T; m0 += 4 * NGW) {
          f32x4 v[4][4];
#pragma unroll
          for (int r = 0; r < 4; ++r)
#pragma unroll
              for (int j = 0; j < 4; ++j) v[r][j] = ((const GAS f32x4*)(A.in[I_X] + (size_t)(m0 + r) * D))[lane + 64 * j];
#pragma unroll
          for (int r = 0; r < 4; ++r) { float s = 0.f;
#pragma unroll
              for (int j = 0; j < 4; ++j) s += (v[r][j].x * v[r][j].x + v[r][j].y * v[r][j].y) + (v[r][j].z * v[r][j].z + v[r][j].w * v[r][j].w);
              const float rs = rsqrtf(wave_sum(s) * (1.0f / 1024.0f) + 1e-6f);
              GAS unsigned long long* o8 = (GAS unsigned long long*)(xb + (size_t)(m0 + r) * D) + lane;
#pragma unroll
              for (int j = 0; j < 4; ++j) o8[64 * j] = (unsigned long long)pk2(v[r][j].x, v[r][j].y) | ((unsigned long long)pk2(v[r][j].z, v[r][j].w) << 32);
              if (lane == 0) rstdx[m0 + r] = rs; } } }
    for (int m = gw; m < NMEMTOK; m += NGW) { const float* xr = A.in[I_MEM] + (size_t)m * D; const float rs = row_rstd1024(xr, lane); cvt_row1024(xr, (bf16*)(ws + WS_MEMN) + (size_t)m * D, A.in[I_MEMG], rs, lane); }
    for (int mb = 4 * gw; mb < 2 * NEXP; mb += 4 * NGW) {
        const bool isu = mb < NEXP; const int e0 = isu ? mb : mb - NEXP;
        f32x4 v[4][4];
#pragma unroll
        for (int r = 0; r < 4; ++r) { const GAS f32x4* src = (const GAS f32x4*)((isu ? A.in[I_PU] : A.in[I_PV]) + (size_t)(e0 + r) * D) + 4 * lane;
#pragma unroll
            for (int d = 0; d < 4; ++d) v[r][d] = src[d]; }
        f32x4 gv[4];
#pragma unroll
        for (int d = 0; d < 4; ++d) gv[d] = isu ? ((const GAS f32x4*)A.in[I_FFNG])[4 * lane + d] : (f32x4){1.f, 1.f, 1.f, 1.f};
#pragma unroll
        for (int r = 0; r < 4; ++r) { const int e = e0 + r; float mx = 0.f;
#pragma unroll
            for (int d = 0; d < 4; ++d) { v[r][d] = v[r][d] * gv[d]; mx = fmaxf(mx, fmaxf(fmaxf(fabsf(v[r][d].x), fabsf(v[r][d].y)), fmaxf(fabsf(v[r][d].z), fabsf(v[r][d].w)))); }
#pragma unroll
            for (int o = 1; o < 64; o <<= 1) mx = fmaxf(mx, __shfl_xor(mx, o));
            const float inv = mx > 0.f ? 127.0f / mx : 0.f;
            v4u w;
#pragma unroll
            for (int d = 0; d < 4; ++d) { const unsigned b0 = (unsigned)(int)rintf(v[r][d].x * inv) & 0xffu, b1 = (unsigned)(int)rintf(v[r][d].y * inv) & 0xffu,
                                                         b2 = (unsigned)(int)rintf(v[r][d].z * inv) & 0xffu, b3 = (unsigned)(int)rintf(v[r][d].w * inv) & 0xffu;
                w[d] = b0 | (b1 << 8) | (b2 << 16) | (b3 << 24); }
            if (isu) ((GAS v4u*)(ws + WS_U8))[(size_t)e * 64 + lane] = w;
            else *(GAS v4u*)(ws + WS_V8 + (size_t)(lane >> 3) * (2 * MiB) + (size_t)e * 128 + (lane & 7) * 16) = w;
            if (lane == 0) ((float*)(ws + WS_SU))[2 * e + (isu ? 0 : 1)] = mx * (1.0f / 127.0f); }
    }
    for (int m = gw * 64 + lane; m < T; m += NGW * 64) ((float*)(ws + WS_ROWSQ))[m] = 0.f;
    for (int m = gw; m < 256; m += NGW) cvt_row1024(A.in[I_KEYS] + (size_t)m * 1024, (bf16*)(ws + WS_KEYS) + (size_t)m * 1024, nullptr, 1.0f, lane);
    for (int m = gw; m < 1024; m += NGW) { const int gd = m >> 1, c = (m & 1) * 64 + lane, g = gd >> 7, d = gd & 127;
        const float v = A.in[I_POOLW][(size_t)(g * 128 + c) * 128 + d] * A.in[I_POOLSC][gd];
        ((bf16*)(ws + WS_PWT))[(size_t)gd * 128 + c] = (bf16)f2bf(v); }
}

__device__ __forceinline__ void memkv_tile(const bf16* memn, const bf16* wkvT, const float* kg, const float* qg, bf16* kmem, bf16* vtmem, int tile, int lane) {
    const int q = lane & 15, hi = lane >> 4, rg = tile >> 3, cg = tile & 7, r0 = rg * 16, c0 = cg * 128;
    f32x4 acc[8];
#pragma unroll
    for (int i = 0; i < 8; ++i) acc[i] = (f32x4){0.f, 0.f, 0.f, 0.f};
    const bf16* ap = memn + (size_t)(r0 + q) * 1024 + 8 * hi; const bf16* bp = wkvT + (size_t)(c0 + q) * 1024 + 8 * hi;
#pragma unroll 1
    for (int kb = 0; kb < 8; ++kb) {
        bf16x8 a[4], b[4][8];
#pragma unroll
        for (int k4 = 0; k4 < 4; ++k4) { a[k4] = *(const bf16x8*)(ap + 32 * (4 * kb + k4));
#pragma unroll
            for (int nf = 0; nf < 8; ++nf) b[k4][nf] = *(const bf16x8*)(bp + (size_t)(16 * nf) * 1024 + 32 * (4 * kb + k4)); }
        __builtin_amdgcn_sched_barrier(0);
#pragma unroll
        for (int k4 = 0; k4 < 4; ++k4)
#pragma unroll
            for (int nf = 0; nf < 8; ++nf) acc[nf] = mfma16(a[k4], b[k4][nf], acc[nf]);
        __builtin_amdgcn_sched_barrier(0);
    }
    if (cg < 4) {
        float rr[4];
#pragma unroll
        for (int g = 0; g < 4; ++g) { float ss = 0.f;
#pragma unroll
            for (int nf = 0; nf < 8; ++nf) ss += acc[nf][g] * acc[nf][g];
            ss += __shfl_xor(ss, 1); ss += __shfl_xor(ss, 2); ss += __shfl_xor(ss, 4); ss += __shfl_xor(ss, 8);
            rr[g] = rsqrtf(ss * (1.0f / 128.0f) + 1e-6f); }
#pragma unroll
        for (int nf = 0; nf < 8; ++nf) { const int d = 16 * nf + q; const float gs = kg[d] * qg[d];
#pragma unroll
            for (int g = 0; g < 4; ++g) kmem[(size_t)(r0 + 4 * hi + g) * 512 + cg * 128 + d] = (bf16)f2bf(acc[nf][g] * rr[g] * gs); }
    } else {
        const int h = cg - 4, b = r0 >> 8, key0 = (r0 & 255) + 4 * hi;
#pragma unroll
        for (int nf = 0; nf < 8; ++nf) { const int d = 16 * nf + q; v2u w; w.x = pk2(acc[nf][0], acc[nf][1]); w.y = pk2(acc[nf][2], acc[nf][3]);
            *(v2u*)(vtmem + (size_t)(b * 512 + h * 128 + d) * 256 + key0) = w; }
    }
}

__device__ __forceinline__ void na_item(const bf16* __restrict__ qn, const bf16* __restrict__ kn, const bf16* __restrict__ vt, const LAS float* rpl, bf16* __restrict__ yna,
                                        int b, int r, int jb, int h, int lane) {
    const int q = lane & 15, hi = lane >> 4;
    int rs = r - 4; rs = rs < 0 ? 0 : (rs > 120 ? 120 : rs);
    int kb0 = jb * 16 - 8; kb0 = kb0 < 0 ? 0 : (kb0 > 32 ? 32 : kb0);
    const int qcol = jb * 16 + q; int cs = qcol - 8; cs = cs < 0 ? 0 : (cs > 48 ? 48 : cs);
    const size_t tokq = (size_t)b * SEQ + r * 64 + qcol;
    const bf16* qp = qn + tokq * 512 + h * 64 + 8 * hi;
    const bf16x8 qf0 = *(const bf16x8*)qp, qf1 = *(const bf16x8*)(qp + 32);
    const int kq = 8 * (q >> 2) + (q & 3);
    const bf16* kbase = kn + ((size_t)b * SEQ + rs * 64 + kb0 + kq) * 512 + h * 64 + 8 * hi;
    f32x4 s[16];
    {
        bf16x8 ka[16][2];
#pragma unroll
        for (int f = 0; f < 16; ++f) { const bf16* kp = kbase + (size_t)((f >> 1) * 64 + (f & 1) * 4) * 512; ka[f][0] = *(const bf16x8*)kp; ka[f][1] = *(const bf16x8*)(kp + 32); }
        __builtin_amdgcn_sched_barrier(0);
#pragma unroll
        for (int f = 0; f < 16; ++f) { f32x4 z = (f32x4){0.f, 0.f, 0.f, 0.f}; z = mfma16(ka[f][0], qf0, z); s[f] = mfma16(ka[f][1], qf1, z); }
    }
    const bf16* vbase = vt + ((size_t)(b * 512 + h * 64 + q) * SEQ + rs * 64 + kb0 + 8 * hi);
    bf16x8 va[8][4];
#pragma unroll
    for (int st = 0; st < 8; ++st)
#pragma unroll
        for (int mf = 0; mf < 4; ++mf) va[st][mf] = *(const bf16x8*)(vbase + (size_t)(16 * mf) * SEQ + st * 64);
    __builtin_amdgcn_sched_barrier(0);
    float mx = -3.0e38f;
#pragma unroll
    for (int f = 0; f < 16; ++f) {
        const int dr = rs + (f >> 1) - r + 7;
#pragma unroll
        for (int g = 0; g < 4; ++g) {
            const int kcol = kb0 + 8 * hi + 4 * (f & 1) + g;
            const bool ok = (kcol >= cs) && (kcol < cs + 16);
            int dc = kcol - qcol + 15; dc = dc < 0 ? 0 : (dc > 30 ? 30 : dc);
            const float v = ok ? s[f][g] + rpl[dr * 31 + dc] : -1.0e30f;
            s[f][g] = v; mx = fmaxf(mx, v);
        }
    }
    mx = fmaxf(mx, __shfl_xor(mx, 16)); mx = fmaxf(mx, __shfl_xor(mx, 32));
    float sum = 0.f;
#pragma unroll
    for (int f = 0; f < 16; ++f)
#pragma unroll
        for (int g = 0; g < 4; ++g) { const float p = __expf(s[f][g] - mx); s[f][g] = p; sum += p; }
    sum += __shfl_xor(sum, 16); sum += __shfl_xor(sum, 32);
    const float inv = 1.0f / sum;
    f32x4 o[4];
#pragma unroll
    for (int i = 0; i < 4; ++i) o[i] = (f32x4){0.f, 0.f, 0.f, 0.f};
#pragma unroll
    for (int st = 0; st < 8; ++st) {
        const bf16x8 pb = __builtin_bit_cast(bf16x8, pg8::pack8(s[2 * st], s[2 * st + 1]));
#pragma unroll
        for (int mf = 0; mf < 4; ++mf) o[mf] = mfma16(va[st][mf], pb, o[mf]);
    }
    bf16* yp = yna + tokq * 1536 + h * 64 + 4 * hi;
#pragma unroll
    for (int mf = 0; mf < 4; ++mf) { v2u w; w.x = pk2(o[mf][0] * inv, o[mf][1] * inv); w.y = pk2(o[mf][2] * inv, o[mf][3] * inv); *(v2u*)(yp + 16 * mf) = w; }
}
__device__ __forceinline__ void xa_fill_lds(const bf16* __restrict__ kmem, const bf16* __restrict__ vtmem, LAS unsigned char* lds, int b, int h, int tid) {
#pragma unroll
    for (int ps = 0; ps < 8; ++ps) { const int id = tid + 512 * ps, key = id >> 4, c = id & 15;
        *(LAS v4u*)(lds + key * 256 + ((c ^ (key & 15)) << 4)) = *(const v4u*)(kmem + ((size_t)b * 256 + key) * 512 + h * 128 + 8 * c); }
#pragma unroll
    for (int ps = 0; ps < 8; ++ps) { const int id = tid + 512 * ps, dim = id >> 5, c = id & 31;
        *(LAS v4u*)(lds + 65536 + dim * 512 + ((c ^ (dim & 15)) << 4)) = *(const v4u*)(vtmem + (size_t)(b * 512 + h * 128 + dim) * 256 + 8 * c); }
}
__device__ __forceinline__ void xa_item(const bf16* __restrict__ xq, const LAS unsigned char* lds, bf16* __restrict__ yxa, int tok0, int h, int lane) {
    const int q = lane & 15, hi = lane >> 4; const size_t tok = (size_t)tok0 + q;
    const bf16* qp = xq + tok * 512 + h * 128 + 8 * hi;
    bf16x8 qf[4]; float ssq = 0.f;
#pragma unroll
    for (int ks = 0; ks < 4; ++ks) qf[ks] = *(const bf16x8*)(qp + 32 * ks);
    __builtin_amdgcn_sched_barrier(0);
#pragma unroll
    for (int ks = 0; ks < 4; ++ks)
#pragma unroll
        for (int j = 0; j < 8; ++j) { const float v = bf1(qf[ks][j]); ssq += v * v; }
    ssq += __shfl_xor(ssq, 16); ssq += __shfl_xor(ssq, 32);
    const float cexp = rsqrtf(ssq * (1.0f / 128.0f) + 1e-6f) * 0.08838834764831845f * 1.4426950408889634f;
    const int kq = 8 * (q >> 2) + (q & 3);
    f32x4 s[16];
#pragma unroll
    for (int f = 0; f < 16; ++f) { const int key = 32 * (f >> 1) + 4 * (f & 1) + kq; const LAS unsigned char* kr = lds + key * 256; f32x4 z = (f32x4){0.f, 0.f, 0.f, 0.f};
#pragma unroll
        for (int ks = 0; ks < 4; ++ks) z = mfma16(*(const LAS bf16x8*)(kr + (((4 * ks + hi) ^ (key & 15)) << 4)), qf[ks], z);
        s[f] = z; }
    float mx = -3.0e38f;
#pragma unroll
    for (int f = 0; f < 16; ++f)
#pragma unroll
        for (int g = 0; g < 4; ++g) mx = fmaxf(mx, s[f][g]);
    mx = fmaxf(mx, __shfl_xor(mx, 16)); mx = fmaxf(mx, __shfl_xor(mx, 32));
    float sum = 0.f;
#pragma unroll
    for (int f = 0; f < 16; ++f)
#pragma unroll
        for (int g = 0; g < 4; ++g) { const float p = __builtin_amdgcn_exp2f((s[f][g] - mx) * cexp); s[f][g] = p; sum += p; }
    sum += __shfl_xor(sum, 16); sum += __shfl_xor(sum, 32);
    const float inv = 1.0f / sum;
    f32x4 o[8];
#pragma unroll
    for (int i = 0; i < 8; ++i) o[i] = (f32x4){0.f, 0.f, 0.f, 0.f};
#pragma unroll
    for (int st = 0; st < 8; ++st) {
        const bf16x8 pb = __builtin_bit_cast(bf16x8, pg8::pack8(s[2 * st], s[2 * st + 1]));
#pragma unroll
        for (int mf = 0; mf < 8; ++mf) { const int dim = 16 * mf + q; o[mf] = mfma16(*(const LAS bf16x8*)(lds + 65536 + dim * 512 + (((4 * st + hi) ^ (dim & 15)) << 4)), pb, o[mf]); }
    }
    bf16* yp = yxa + tok * 1536 + h * 128 + 4 * hi;
#pragma unroll
    for (int mf = 0; mf < 8; ++mf) { v2u w; w.x = pk2(o[mf][0] * inv, o[mf][1] * inv); w.y = pk2(o[mf][2] * inv, o[mf][3] * inv); *(v2u*)(yp + 16 * mf) = w; }
}
__device__ __forceinline__ void pool_wg(const bf16* __restrict__ pp, const bf16* __restrict__ pwT, bf16* __restrict__ ypool, LAS unsigned char* lds, int tokbase, int wave, int lane) {
    const int q = lane & 15, hi = lane >> 4;
    __syncthreads();
    {
        const int hw = 1 << hi, tw0 = tokbase + 16 * wave, b = tw0 >> 13, t0 = tw0 & 8191;
        const bf16* base = pp + (size_t)b * SEQ * 512 + 8 * lane;
        float s[8];
#pragma unroll
        for (int j = 0; j < 8; ++j) s[j] = 0.f;
#pragma unroll 4
        for (int d = -8; d < 8; ++d) { const int u = t0 + d; const bool ok = (d >= -hw) && (d < hw) && (u >= 0) && (u < SEQ);
            const bf16x8 v = *(const bf16x8*)(base + (size_t)(ok ? u : t0) * 512);
#pragma unroll
            for (int j = 0; j < 8; ++j) s[j] += ok ? bf1(v[j]) : 0.f; }
        LAS unsigned char* tile = lds + wave * 16384;
#pragma unroll 4
        for (int i = 0; i < 16; ++i) { const int t = t0 + i;
            int lo = t - hw; lo = lo < 0 ? 0 : lo; int ht = t + hw; ht = ht > SEQ ? SEQ : ht;
            const float inv = 1.0f / (float)(ht - lo);
            const bool oka = (t + hw) < SEQ, oks = (t - hw) >= 0;
            const bf16x8 sv = *(const bf16x8*)(base + (size_t)t * 512), av = *(const bf16x8*)(base + (size_t)(oka ? t + hw : t) * 512), bv = *(const bf16x8*)(base + (size_t)(oks ? t - hw : t) * 512);
            f32x4 p0, p1;
#pragma unroll
            for (int j = 0; j < 4; ++j) { p0[j] = s[j] * inv - bf1(sv[j]); p1[j] = s[j + 4] * inv - bf1(sv[j + 4]); }
            *(LAS v4u*)(tile + i * 1024 + ((lane ^ (i & 15)) << 4)) = pg8::pack8(p0, p1);
#pragma unroll
            for (int j = 0; j < 8; ++j) s[j] += (oka ? bf1(av[j]) : 0.f) - (oks ? bf1(bv[j]) : 0.f);
        }
    }
    __syncthreads();
#pragma unroll 1
    for (int k = 0; k < 4; ++k) {
        const int pair = wave * 4 + k, g = pair >> 3, mf = pair & 7;
        const bf16* wb = pwT + (size_t)(g * 128 + 16 * mf + q) * 128 + 8 * hi;
        bf16x8 a[4];
#pragma unroll
        for (int ks = 0; ks < 4; ++ks) a[ks] = *(const bf16x8*)(wb + 32 * ks);
#pragma unroll 2
        for (int tg = 0; tg < 8; ++tg) {
            const LAS unsigned char* trow = lds + tg * 16384 + q * 1024; f32x4 o = (f32x4){0.f, 0.f, 0.f, 0.f};
#pragma unroll
            for (int ks = 0; ks < 4; ++ks) { const int c = g * 16 + 4 * ks + hi; o = mfma16(a[ks], *(const LAS bf16x8*)(trow + ((c ^ q) << 4)), o); }
            v2u w; w.x = pk2(o[0], o[1]); w.y = pk2(o[2], o[3]);
            *(v2u*)(ypool + (size_t)(tokbase + 16 * tg + q) * 1536 + g * 128 + 16 * mf + 4 * hi) = w;
        }
    }
    __syncthreads();
}

__device__ __forceinline__ int f2key(float s, int idx, int mask) { int b = __builtin_bit_cast(int, s); b = b >= 0 ? b : (b ^ 0x7fffffff); return (b & ~mask) | idx; }
__device__ __forceinline__ float key2f(int k) { k = k >= 0 ? k : (k ^ 0x7fffffff); return __builtin_bit_cast(float, k); }
#define CE_DESC(x, y) do { const int _h = (x) > (y) ? (x) : (y), _l = (x) > (y) ? (y) : (x); (x) = _h; (y) = _l; } while (0)
__device__ __forceinline__ void sort16(int (&a)[16]) {
#pragma unroll
    for (int ks = 1; ks <= 4; ++ks)
#pragma unroll
        for (int js = ks - 1; js >= 0; --js)
#pragma unroll
            for (int i = 0; i < 16; ++i) { const int k = 1 << ks, j = 1 << js, l = i ^ j;
                if (l > i) { if ((i & k) == 0) CE_DESC(a[i], a[l]); else CE_DESC(a[l], a[i]); } }
}
__device__ __forceinline__ void merge16(int (&a)[16], const int (&b)[16]) {
#pragma unroll
    for (int i = 0; i < 16; ++i) a[i] = a[i] > b[15 - i] ? a[i] : b[15 - i];
#pragma unroll
    for (int js = 3; js >= 0; --js)
#pragma unroll
        for (int i = 0; i < 16; ++i) { const int j = 1 << js, l = i ^ j; if (l > i) CE_DESC(a[i], a[l]); }
}
__device__ __forceinline__ void merge16_lanes(int (&a)[16], int step) { int o[16];
#pragma unroll
    for (int k = 0; k < 16; ++k) o[k] = __shfl_xor(a[k], step);
    merge16(a, o); }
__device__ constexpr int cand_i(int hi, int m) {
    return hi == 0 ? 0
         : hi == 1 ? (m < 8 ? 1 : (m < 13 ? 2 : -1))
         : hi == 2 ? (m < 4 ? 3 : (m < 7 ? 4 : (m < 9 ? 5 : (m < 11 ? 6 : -1))))
         :           (m < 2 ? 7 : (m < 10 ? 8 + (m - 2) : -1));
}
__device__ constexpr int cand_j(int hi, int m) {
    return hi == 0 ? m
         : hi == 1 ? (m < 8 ? m : (m < 13 ? m - 8 : -1))
         : hi == 2 ? (m < 4 ? m : (m < 7 ? m - 4 : (m < 9 ? m - 7 : (m < 11 ? m - 9 : -1))))
         :           (m < 2 ? m : (m < 10 ? 0 : -1));
}
__device__ __forceinline__ void topk_fill_lds(const bf16* __restrict__ keys, LAS unsigned char* lds, int h, int tid) {
#pragma unroll
    for (int ps = 0; ps < 8; ++ps) { const int id = tid + 512 * ps, row = id >> 4, c = id & 15;
        *(LAS v4u*)(lds + row * 256 + ((c ^ (row & 15)) << 4)) = *(const v4u*)(keys + ((size_t)h * 256 + row) * 128 + 8 * c); }
}
struct TopkQ { bf16x8 q[2][4]; };
__device__ __forceinline__ void topk_loadq(TopkQ& Q, const bf16* __restrict__ qb, int tok0, int h, int lane) {
    const size_t tok = (size_t)tok0 + (lane & 15); const int hi = lane >> 4;
#pragma unroll
    for (int p = 0; p < 2; ++p)
#pragma unroll
        for (int ks = 0; ks < 4; ++ks) Q.q[p][ks] = *(const bf16x8*)(qb + tok * 2048 + h * 256 + p * 128 + 32 * ks + 8 * hi);
}
__device__ __forceinline__ void topk_item(const TopkQ& Q, const LAS unsigned char* klds, int* __restrict__ te, float* __restrict__ tw, LAS int* lscr, int tok0, int h, int lane) {
    const int q = lane & 15, hi = lane >> 4; const size_t tok = (size_t)tok0 + q;
    int L[2][16];
#pragma unroll
    for (int p = 0; p < 2; ++p) {
        int B[16];
#pragma unroll
        for (int mf = 0; mf < 8; ++mf) { f32x4 s = (f32x4){0.f, 0.f, 0.f, 0.f}; const int row = p * 128 + 16 * mf + q;
#pragma unroll
            for (int ks = 0; ks < 4; ++ks) s = mfma16(*(const LAS bf16x8*)(klds + row * 256 + (((4 * ks + hi) ^ (row & 15)) << 4)), Q.q[p][ks], s);
#pragma unroll
            for (int g = 0; g < 4; ++g) { const int key = f2key(s[g], 16 * mf + 4 * hi + g, 127); if (mf < 4) L[p][4 * mf + g] = key; else B[4 * (mf - 4) + g] = key; } }
        sort16(L[p]); sort16(B); merge16(L[p], B);
        merge16_lanes(L[p], 16); merge16_lanes(L[p], 32);
    }
    float v1[16], v2[16];
#pragma unroll
    for (int k = 0; k < 16; ++k) { v1[k] = key2f(L[0][k]); v2[k] = key2f(L[1][k]); }
    int Fk[16];
#pragma unroll
    for (int m = 0; m < 16; ++m) {
        float sm = v1[0] + v2[m]; int id = 255 - m;
        if (cand_i(1, m) >= 0) { if (hi == 1) { sm = v1[cand_i(1, m) < 0 ? 0 : cand_i(1, m)] + v2[cand_j(1, m) < 0 ? 0 : cand_j(1, m)]; id = 255 - ((cand_i(1, m) << 4) | cand_j(1, m)); } }
        if (cand_i(2, m) >= 0) { if (hi == 2) { sm = v1[cand_i(2, m) < 0 ? 0 : cand_i(2, m)] + v2[cand_j(2, m) < 0 ? 0 : cand_j(2, m)]; id = 255 - ((cand_i(2, m) << 4) | cand_j(2, m)); } }
        if (cand_i(3, m) >= 0) { if (hi == 3) { sm = v1[cand_i(3, m) < 0 ? 0 : cand_i(3, m)] + v2[cand_j(3, m) < 0 ? 0 : cand_j(3, m)]; id = 255 - ((cand_i(3, m) << 4) | cand_j(3, m)); } }
        int key = f2key(sm, id, 255);
        if ((hi == 1 && cand_i(1, m) < 0) || (hi == 2 && cand_i(2, m) < 0) || (hi == 3 && cand_i(3, m) < 0)) key = (int)0x80000000;
        Fk[m] = key;
    }
    sort16(Fk); merge16_lanes(Fk, 16); merge16_lanes(Fk, 32);
    LAS int* my = lscr + lane * 32;
#pragma unroll
    for (int k = 0; k < 16; ++k) { my[k] = L[0][k] & 127; my[16 + k] = L[1][k] & 127; }
    LDS_WAIT(); asm volatile("" ::: "memory");
    float e[16]; float sum = 0.f; const float mx = key2f(Fk[0]);
#pragma unroll
    for (int k = 0; k < 16; ++k) { e[k] = __expf(key2f(Fk[k]) - mx); sum += e[k]; }
    const float inv = 1.0f / sum;
    if (hi == 0) {
        int* tep = te + tok * 128; float* twp = tw + tok * 128;
#pragma unroll
        for (int kk = 0; kk < 16; ++kk) { const int ij = 255 - (Fk[kk] & 255), i = ij >> 4, j = ij & 15, slot = (kk & 7) * 16 + 2 * h + (kk >> 3);
            tep[slot] = my[i] * 128 + my[16 + j]; twp[slot] = e[kk] * inv; }
    }
    LDS_WAIT(); asm volatile("" ::: "memory");
}

__device__ __forceinline__ float ub2f(unsigned v, int b) { return (float)((v >> (8 * b)) & 0xffu); }
struct HqIn { v4u hA, hB; float rsq; };
__device__ __forceinline__ void hq_load(HqIn& in, const bf16* __restrict__ hb, const float* __restrict__ rowsq, int tok, int lane) {
    const bf16* hp = hb + (size_t)tok * 1024 + 16 * lane; in.hA = *(const v4u*)hp; in.hB = *(const v4u*)(hp + 8); in.rsq = rowsq[tok]; }
__device__ __forceinline__ void hq_token(const HqIn& in, unsigned char* __restrict__ hq, float* __restrict__ hs, int tok, int lane) {
    const v4u hA = in.hA, hB = in.hB;
    float hf[16];
#pragma unroll
    for (int d = 0; d < 4; ++d) { hf[2 * d] = bflo(hA[d]); hf[2 * d + 1] = bfhi(hA[d]); hf[8 + 2 * d] = bflo(hB[d]); hf[8 + 2 * d + 1] = bfhi(hB[d]); }
    float amax = 0.f;
#pragma unroll
    for (int j = 0; j < 16; ++j) amax = fmaxf(amax, fabsf(hf[j]));
#pragma unroll
    for (int o = 1; o < 64; o <<= 1) amax = fmaxf(amax, __shfl_xor(amax, o));
    const float hinv = amax > 0.f ? 127.0f / amax : 0.f;
    v4u w;
#pragma unroll
    for (int d = 0; d < 4; ++d) { const unsigned b0 = (unsigned)(int)rintf(hf[4 * d] * hinv) & 0xffu, b1 = (unsigned)(int)rintf(hf[4 * d + 1] * hinv) & 0xffu,
                                                 b2 = (unsigned)(int)rintf(hf[4 * d + 2] * hinv) & 0xffu, b3 = (unsigned)(int)rintf(hf[4 * d + 3] * hinv) & 0xffu;
        w[d] = b0 | (b1 << 8) | (b2 << 16) | (b3 << 24); }
    *(v4u*)(hq + (size_t)tok * 1024 + 16 * lane) = w;
    if (lane == 0) hs[tok] = rsqrtf(in.rsq * (1.0f / 1024.0f) + 1e-6f) * amax * (1.0f / 127.0f);
}
constexpr int PA_SLOTS = 12;
struct PeerA1 { int e; float g; };
struct PeerA2 { v4u ur[3][4]; v4u hv[4]; float hsc, su, sv; int cnt, rk; bool m; unsigned long long rem; };
__device__ __forceinline__ void pa_s1(PeerA1& a, const int* __restrict__ te, const float* __restrict__ tw, int tok, int half, int lane) {
    a.e = te[(size_t)tok * 128 + 64 * half + lane]; a.g = tw[(size_t)tok * 128 + 64 * half + lane]; }
__device__ __forceinline__ void pa_s2(PeerA2& b, const PeerA1& a, const unsigned char* __restrict__ hq, const float* __restrict__ hs, const unsigned char* __restrict__ u8,
                                      const float* __restrict__ su, const float* __restrict__ sv, LAS int* lst, int tok, int x, int lane, int hot) {
    b.m = (a.e >> 11) == x;
    const unsigned long long mask = __ballot(b.m), lt = (1ull << lane) - 1ull;
    b.cnt = __popcll(mask); b.rk = __popcll(mask & lt);
    if (b.m && b.rk < PA_SLOTS) lst[b.rk] = a.e;
    b.rem = 0ull; if (b.cnt > PA_SLOTS) { unsigned long long r = mask;
#pragma unroll
        for (int k = 0; k < PA_SLOTS; ++k) r &= r - 1ull;
        b.rem = r; }
    { typedef float f32x2s __attribute__((ext_vector_type(2))); f32x2s s2 = (f32x2s){0.f, 0.f}; if (b.m) s2 = ((const f32x2s*)su)[a.e]; b.su = s2.x; b.sv = s2.y; }
    const int r = lane >> 4, t = lane & 15;
#pragma unroll
    for (int i = 0; i < 4; ++i) b.hv[i] = *(const v4u*)(hq + (size_t)tok * 1024 + 16 * t + 256 * i);
    b.hsc = hs[tok];
    LDS_WAIT(); asm volatile("" ::: "memory");
    const int lim = b.cnt < PA_SLOTS ? b.cnt : PA_SLOTS;
#pragma unroll
    for (int q = 0; q < 3; ++q) { const int slot = 4 * q + r;
#pragma unroll
        for (int i = 0; i < 4; ++i) b.ur[q][i] = (v4u){0u, 0u, 0u, 0u};
        if (slot < lim) { int e = lst[slot]; if (hot) e = (x << 11) | (e & 255); const unsigned char* rp = u8 + (size_t)e * 1024 + 16 * t;
#pragma unroll
            for (int i = 0; i < 4; ++i) b.ur[q][i] = *(const v4u*)(rp + 256 * i); } }
    (void)sv;
}
__device__ __forceinline__ int dot16(const v4u u, const v4u h) { int d = __builtin_amdgcn_sdot4((int)u.x, (int)h.x, 0, false); d = __builtin_amdgcn_sdot4((int)u.y, (int)h.y, d, false);
    d = __builtin_amdgcn_sdot4((int)u.z, (int)h.z, d, false); return __builtin_amdgcn_sdot4((int)u.w, (int)h.w, d, false); }
template <int CTRL, int RM> __device__ __forceinline__ int dpp_i(int x) { return __builtin_amdgcn_update_dpp(0, x, CTRL, RM, 0xf, false); }
__device__ __forceinline__ int wave_sum_to63(int x) { x += dpp_i<0xb1, 0xf>(x); x += dpp_i<0x4e, 0xf>(x); x += dpp_i<0x124, 0xf>(x); x += dpp_i<0x128, 0xf>(x); x += dpp_i<0x142, 0xa>(x); x += dpp_i<0x143, 0xc>(x); return x; }
__device__ __forceinline__ int row_sum16(int x) { x += dpp_i<0xb1, 0xf>(x); x += dpp_i<0x4e, 0xf>(x); x += dpp_i<0x124, 0xf>(x); x += dpp_i<0x128, 0xf>(x); return x; }
__device__ __forceinline__ float gelu_erf(float v) {
    const float av = fabsf(v), t = __builtin_amdgcn_rcpf(av * 0.2316418882f + 1.0f);
    float q = t * 0.5307027145f + (-0.7265760135f); q = q * t + 0.7107068705f; q = q * t + (-0.142248368f); q = q * t + 0.127414796f; q = q * t;
    const float e = __builtin_amdgcn_exp2f((v * v) * (-0.72134752044f)), m = v * (q * e);
    return v < 0.f ? m : v - m; }
__device__ __forceinline__ void pa_s3(const PeerA2& b, const PeerA1& a, const unsigned char* __restrict__ u8, const unsigned char* __restrict__ hq, float* __restrict__ aw, int tok, int half, int lane) {
    int mine = 0;
#pragma unroll
    for (int q = 0; q < 3; ++q) { int d = dot16(b.ur[q][0], b.hv[0]); d += dot16(b.ur[q][1], b.hv[1]); d += dot16(b.ur[q][2], b.hv[2]); d += dot16(b.ur[q][3], b.hv[3]);
        d = row_sum16(d);
#pragma unroll
        for (int r = 0; r < 4; ++r) { const int s = __builtin_amdgcn_readlane(d, 16 * r); mine = (b.rk == 4 * q + r) ? s : mine; } }
    float* awp = aw + (size_t)tok * 128 + 64 * half + lane;
    if (b.m && b.rk < PA_SLOTS) *awp = a.g * gelu_erf((float)mine * b.hsc * b.su) * b.sv;
    if (b.cnt > PA_SLOTS) {
        unsigned long long rem = b.rem; const v4u hw = *(const v4u*)(hq + (size_t)tok * 1024 + 16 * lane);
        while (rem != 0ull) { const int idx = __builtin_ctzll(rem); rem &= rem - 1ull; const int e = __builtin_amdgcn_readlane(a.e, idx);
            const int d = __builtin_amdgcn_readlane(wave_sum_to63(dot16(*(const v4u*)(u8 + (size_t)e * 1024 + 16 * lane), hw)), 63);
            if (lane == idx) *awp = a.g * gelu_erf((float)d * b.hsc * b.su) * b.sv; }
    }
}
__device__ __forceinline__ void peer_a_run(const unsigned char* __restrict__ hq, const float* __restrict__ hs, const unsigned char* __restrict__ u8, const float* __restrict__ su,
                                           const float* __restrict__ sv, const int* __restrict__ te, const float* __restrict__ tw, float* __restrict__ aw, LAS int* lst, int wrank, int wstep, int x, int lane, int hot = 0) {
    const int ntok = wrank < T ? (T - wrank + wstep - 1) / wstep : 0, N = 2 * ntok;
#define PA_TOK(n) (wrank + ((n) >> 1) * wstep)
    if (N == 0) return;
    PeerA1 a0, a1, a2; PeerA2 bA, bB;
    pa_s1(a0, te, tw, PA_TOK(0), 0, lane); pa_s1(a1, te, tw, PA_TOK(1), 1, lane);
    pa_s2(bA, a0, hq, hs, u8, su, sv, lst, PA_TOK(0), x, lane, hot);
#define PA_STEP(n, Bcur, Bnext, Acur, Anext, Anew) do { \
        if ((n) + 1 < N) pa_s2(Bnext, Anext, hq, hs, u8, su, sv, lst, PA_TOK((n) + 1), x, lane, hot); \
        if ((n) + 2 < N) pa_s1(Anew, te, tw, PA_TOK((n) + 2), ((n) + 2) & 1, lane); \
        pa_s3(Bcur, Acur, u8, hq, aw, PA_TOK(n), (n) & 1, lane); } while (0)
    for (int n = 0; n < N; n += 6) {
        PA_STEP(n, bA, bB, a0, a1, a2);
        if (n + 1 < N) PA_STEP(n + 1, bB, bA, a1, a2, a0);
        if (n + 2 < N) PA_STEP(n + 2, bA, bB, a2, a0, a1);
        if (n + 3 < N) PA_STEP(n + 3, bB, bA, a0, a1, a2);
        if (n + 4 < N) PA_STEP(n + 4, bA, bB, a1, a2, a0);
        if (n + 5 < N) PA_STEP(n + 5, bB, bA, a2, a0, a1);
    }
#undef PA_STEP
#undef PA_TOK
}
struct PeerB1 { v4u e[4]; f32x4 w[4]; };
struct PeerB2 { v4u vr[8]; };
struct PeerBAcc { int acc[16]; int wq[4]; float wsc, h0, h1; };
typedef float f32x2v __attribute__((ext_vector_type(2)));
__device__ __forceinline__ void pb_s1(PeerB1& a, const int* __restrict__ te, const float* __restrict__ aw, int tok, int lane) {
    const v4u* ep = (const v4u*)(te + (size_t)tok * 128 + 16 * (lane >> 3)); const f32x4* wp = (const f32x4*)(aw + (size_t)tok * 128 + 16 * (lane >> 3));
#pragma unroll
    for (int j = 0; j < 4; ++j) { a.e[j] = ep[j]; a.w[j] = wp[j]; } }
__device__ __forceinline__ int pb_col(int lane) { return 16 * (lane & 7) + 8 * ((lane >> 5) & 1) + 4 * ((lane >> 4) & 1) + 2 * ((lane >> 3) & 1); }
template <int CTRL, int RM> __device__ __forceinline__ float dpp_f(float x) { return __builtin_bit_cast(float, __builtin_amdgcn_update_dpp(0, __builtin_bit_cast(int, x), CTRL, RM, 0xf, false)); }
__device__ __forceinline__ void pb_quant(PeerBAcc& A, const PeerB1& a) {
    float mx = 0.f;
#pragma unroll
    for (int j = 0; j < 4; ++j) mx = fmaxf(mx, fmaxf(fmaxf(fabsf(a.w[j][0]), fabsf(a.w[j][1])), fmaxf(fabsf(a.w[j][2]), fabsf(a.w[j][3]))));
    mx = fmaxf(mx, dpp_f<0xb1, 0xf>(mx)); mx = fmaxf(mx, dpp_f<0x4e, 0xf>(mx)); mx = fmaxf(mx, dpp_f<0x124, 0xf>(mx)); mx = fmaxf(mx, dpp_f<0x128, 0xf>(mx));
    mx = fmaxf(mx, dpp_f<0x142, 0xa>(mx)); mx = fmaxf(mx, dpp_f<0x143, 0xc>(mx));
    mx = __builtin_bit_cast(float, __builtin_amdgcn_readlane(__builtin_bit_cast(int, mx), 63));
    const float inv = mx > 0.f ? 127.0f / mx : 0.f; A.wsc = mx * (1.0f / 127.0f);
#pragma unroll
    for (int j = 0; j < 4; ++j) A.wq[j] = (int)(((unsigned)(int)rintf(a.w[j][0] * inv) & 0xffu) | (((unsigned)(int)rintf(a.w[j][1] * inv) & 0xffu) << 8) |
                                               (((unsigned)(int)rintf(a.w[j][2] * inv) & 0xffu) << 16) | (((unsigned)(int)rintf(a.w[j][3] * inv) & 0xffu) << 24));
}
template <int HF> __device__ __forceinline__ void pb_s2(PeerB2& b, const PeerB1& a, const unsigned char* __restrict__ v8x, int lane, int hot = 0) {
    const int c = lane & 7;
#pragma unroll
    for (int m = 0; m < 8; ++m) { unsigned e = a.e[2 * HF + (m >> 2)][m & 3]; if (hot) e &= 255u; b.vr[m] = *(const v4u*)(v8x + (size_t)e * 128 + 16 * c); }
}
__device__ __forceinline__ float swap32_add(float lo, float hi) { const auto r = __builtin_amdgcn_permlane32_swap(__builtin_bit_cast(unsigned, lo), __builtin_bit_cast(unsigned, hi), false, false);
    return __builtin_bit_cast(float, r[0]) + __builtin_bit_cast(float, r[1]); }
__device__ __forceinline__ float swap16_add(float lo, float hi) { const auto r = __builtin_amdgcn_permlane16_swap(__builtin_bit_cast(unsigned, lo), __builtin_bit_cast(unsigned, hi), false, false);
    return __builtin_bit_cast(float, r[0]) + __builtin_bit_cast(float, r[1]); }
template <int HF> __device__ __forceinline__ void pb_s3(PeerBAcc& A, const PeerB2& b, const PeerB1& a, float* out, int tok, int x, int lane) {
    if (HF == 0) {
#pragma unroll
        for (int j = 0; j < 16; ++j) A.acc[j] = 0;
    }
#pragma unroll
    for (int gg = 0; gg < 2; ++gg)
#pragma unroll
        for (int d = 0; d < 4; ++d) { const unsigned ra = b.vr[4 * gg][d], rb = b.vr[4 * gg + 1][d], rc = b.vr[4 * gg + 2][d], rd = b.vr[4 * gg + 3][d];
            const unsigned t0 = __builtin_amdgcn_perm(rb, ra, 0x05010400u), t1 = __builtin_amdgcn_perm(rb, ra, 0x07030602u), t2 = __builtin_amdgcn_perm(rd, rc, 0x05010400u), t3 = __builtin_amdgcn_perm(rd, rc, 0x07030602u);
            const unsigned c0 = __builtin_amdgcn_perm(t2, t0, 0x05040100u), c1 = __builtin_amdgcn_perm(t2, t0, 0x07060302u), c2 = __builtin_amdgcn_perm(t3, t1, 0x05040100u), c3 = __builtin_amdgcn_perm(t3, t1, 0x07060302u);
            const int w4 = A.wq[2 * HF + gg];
            A.acc[4 * d] = __builtin_amdgcn_sdot4((int)c0, w4, A.acc[4 * d], false); A.acc[4 * d + 1] = __builtin_amdgcn_sdot4((int)c1, w4, A.acc[4 * d + 1], false);
            A.acc[4 * d + 2] = __builtin_amdgcn_sdot4((int)c2, w4, A.acc[4 * d + 2], false); A.acc[4 * d + 3] = __builtin_amdgcn_sdot4((int)c3, w4, A.acc[4 * d + 3], false); }
    if (HF == 1) {
        int r8[8], r4[4], r2[2];
#pragma unroll
        for (int j = 0; j < 8; ++j) { const bool up = (lane & 32) != 0; const int keep = up ? A.acc[j + 8] : A.acc[j], send = up ? A.acc[j] : A.acc[j + 8]; r8[j] = keep + __shfl_xor(send, 32); }
#pragma unroll
        for (int j = 0; j < 4; ++j) { const bool up = (lane & 16) != 0; const int keep = up ? r8[j + 4] : r8[j], send = up ? r8[j] : r8[j + 4]; r4[j] = keep + __shfl_xor(send, 16); }
#pragma unroll
        for (int j = 0; j < 2; ++j) { const bool up = (lane & 8) != 0; const int keep = up ? r4[j + 2] : r4[j], send = up ? r4[j] : r4[j + 2];
            r2[j] = keep + __builtin_amdgcn_update_dpp(0, send, 0x128, 0xf, 0xf, false); }
        f32x2v h2; h2.x = A.h0 + A.wsc * (float)r2[0]; h2.y = A.h1 + A.wsc * (float)r2[1];
        *(f32x2v*)(out + (size_t)tok * 1024 + 128 * x + pb_col(lane)) = h2;
    }
}
__device__ __forceinline__ void peer_b_run(const unsigned char* __restrict__ v8x, const int* __restrict__ te, const float* __restrict__ aw, const bf16* __restrict__ hb, float* out, int wrank, int wstep, int x, int lane, int hot = 0) {
    const int N = wrank < T ? (T - wrank + wstep - 1) / wstep : 0;
#define PB_TOK(n) (wrank + (n) * wstep)
#define PB_LOADH(n) do { const unsigned h2_ = *(const unsigned*)(hb + (size_t)PB_TOK(n) * 1024 + 128 * x + pb_col(lane)); A.h0 = bflo(h2_); A.h1 = bfhi(h2_); } while (0)
    if (N == 0) return;
    PeerB1 s0, s1; PeerB2 bA, bB; PeerBAcc A;
    pb_s1(s0, te, aw, PB_TOK(0), lane); if (N > 1) pb_s1(s1, te, aw, PB_TOK(1), lane);
    pb_s2<0>(bA, s0, v8x, lane, hot);
    for (int n = 0; n < N; n += 2) {
        pb_s2<1>(bB, s0, v8x, lane, hot); PB_LOADH(n); pb_quant(A, s0);
        pb_s3<0>(A, bA, s0, out, PB_TOK(n), x, lane);
        if (n + 1 < N) pb_s2<0>(bA, s1, v8x, lane, hot);
        pb_s3<1>(A, bB, s0, out, PB_TOK(n), x, lane);
        if (n + 2 < N) pb_s1(s0, te, aw, PB_TOK(n + 2), lane);
        if (n + 1 < N) {
            pb_s2<1>(bB, s1, v8x, lane, hot); PB_LOADH(n + 1); pb_quant(A, s1);
            pb_s3<0>(A, bA, s1, out, PB_TOK(n + 1), x, lane);
            if (n + 2 < N) pb_s2<0>(bA, s0, v8x, lane, hot);
            pb_s3<1>(A, bB, s1, out, PB_TOK(n + 1), x, lane);
            if (n + 3 < N) pb_s1(s1, te, aw, PB_TOK(n + 3), lane);
        }
    }
#undef PB_LOADH
#undef PB_TOK
}

__global__ void __launch_bounds__(NWAVES * 64, 2) mk_fwd(Args args) {
    extern __shared__ __attribute__((aligned(16))) unsigned char lds[];
    Frame F;
    F.lds = (LAS unsigned char*)lds;
    F.MISC = (volatile LAS unsigned*)(F.lds + MISC_OFF);
    F.tid = threadIdx.x; F.lane = F.tid & 63; F.wave = __builtin_amdgcn_readfirstlane(F.tid >> 6);
    F.G = gridDim.x; { const int bx = blockIdx.x; F.vcu = (F.G % 8 == 0) ? (bx % 8) * (F.G / 8) + bx / 8 : bx; }
    F.out = args.out; F.ws = args.ws;
    unsigned char* ws = args.ws;
    F.ctl = (gu32*)(ws + WS_CTL);
    for (int u = F.tid; u < (LDS_BYTES - LDSCTL_OFF) / 4; u += NWAVES * 64) ((LAS unsigned*)(F.lds + LDSCTL_OFF))[u] = 0u;
    __syncthreads();
    XcdBarrier bar; bar.bar = (unsigned*)(F.ctl + CW_BAR); bar.x = 0; bar.st = nullptr;
    if (N_LAUNCHES != PER_PHASE) bar = xcd_barrier_post((unsigned*)(F.ctl + CW_BAR), F.MISC + 8);
    if (N_LAUNCHES != PER_PHASE) { if (F.tid == 0) { const unsigned xid = xb_xcc_id(); F.MISC[12] = xid; F.MISC[13] = xb_add((unsigned*)(F.ctl + CW_TICKET) + 64 * xid, 1u); } __syncthreads(); }
#define GRID_BAR() do { if (N_LAUNCHES != PER_PHASE) xcd_barrier(bar); } while (0)
    const int lo = args.ph_lo, hi = args.ph_hi;
#define IN(k) (lo <= (k) && (k) < hi)
#define BOTH(k) (IN(k) && IN((k) + 1))
#ifndef DUP_PHASE
#define DUP_PHASE (-1)
#endif
#define NREP(k) ((DUP_PHASE == (k)) ? 2 : 1)
    const int gw = F.vcu * NWAVES + F.wave, NGW = F.G * NWAVES;
    bf16* const WinT = (bf16*)(ws + WS_WIN); bf16* const WvT = (bf16*)(ws + WS_WV); bf16* const WkvT = (bf16*)(ws + WS_WKV); bf16* const WbrT = (bf16*)(ws + WS_WBR);
    bf16* const WoutT = (bf16*)(ws + WS_WOUT); bf16* const WqT = (bf16*)(ws + WS_WQ); bf16* const KEYS = (bf16*)(ws + WS_KEYS); bf16* const PWT = (bf16*)(ws + WS_PWT);
    bf16* const MEMN = (bf16*)(ws + WS_MEMN); bf16* const KMEM = (bf16*)(ws + WS_KMEM); bf16* const VTMEM = (bf16*)(ws + WS_VTMEM); float* const RSTDX = (float*)(ws + WS_RSTDX);
    const unsigned char* const U8 = ws + WS_U8; const unsigned char* const V8 = ws + WS_V8; const float* const SU = (const float*)(ws + WS_SU); const float* const SV = (const float*)(ws + WS_SV);
    bf16* const QN = (bf16*)(ws + WS_QN); bf16* const KN = (bf16*)(ws + WS_KN); bf16* const VT = (bf16*)(ws + WS_VT); bf16* const PP = (bf16*)(ws + WS_PP); bf16* const XQ = (bf16*)(ws + WS_XQ);
    bf16* const GATE = (bf16*)(ws + WS_GATE); bf16* const MERGED = (bf16*)(ws + WS_MERGED); bf16* const HB = (bf16*)(ws + WS_HB); bf16* const QB = (bf16*)(ws + WS_QB);
    int* const TE = (int*)(ws + WS_TE); float* const TW = (float*)(ws + WS_TW); float* const AW = (float*)(ws + WS_AW); float* const ROWSQ = (float*)(ws + WS_ROWSQ);
    bf16* const XB = (bf16*)((unsigned char*)args.out + OUT_XB); bf16* const YNA = (bf16*)((unsigned char*)args.out + OUT_YNA);
    bf16* const YPOOL = (bf16*)((unsigned char*)args.out + OUT_YPOOL); bf16* const YXA = (bf16*)((unsigned char*)args.out + OUT_YXA);

    if (IN(0)) { for (int rep = 0; rep < NREP(0); ++rep) { p0_prologue(F, args); if (rep + 1 < NREP(0)) GRID_BAR(); } if (BOTH(0)) GRID_BAR(); }

    if (IN(1)) {
      for (int rep = 0; rep < NREP(1); ++rep) {
        { pg8::Sched1 S; S.so.init(T, IN_MAIN, F.G, (int)blockIdx.x); S.A = (const char*)XB; S.Bt = (const char*)WinT; S.tstep = (size_t)256 * 1024 * 2;
          pg8::EpiProj E{RSTDX, QN, KN, PP, XQ, GATE, args.in[I_NAQG], args.in[I_NAKG], args.in[I_GATEB]};
          pg8::gemm_phase<pg8::EpiProj, pg8::Sched1, true, true>(F.lds + RING_OFF, 1024, S, E); }
        { pg8::Sched1 S; S.so.init(512, T, F.G, (int)blockIdx.x); S.A = (const char*)WvT; S.Bt = (const char*)XB; S.tstep = (size_t)256 * 1024 * 2;
          pg8::EpiVt E{RSTDX, VT};
          pg8::gemm_phase<pg8::EpiVt, pg8::Sched1, false, true>(F.lds + RING_OFF, 1024, S, E); }
        for (int t = gw; t < 512; t += NGW) memkv_tile(MEMN, WkvT, args.in[I_XAKG], args.in[I_XAQG], KMEM, VTMEM, t, F.lane);
        if (rep + 1 < NREP(1)) GRID_BAR();
      }
        if (BOTH(1)) GRID_BAR();
    }

    if (IN(2)) {
      for (int rep = 0; rep < NREP(2); ++rep) {
        LAS float* rpl = (LAS float*)(F.lds + RING_OFF + F.wave * 16384);
        for (int i = F.lane; i < 15 * 31; i += 64) rpl[i] = args.in[I_RPB][F.wave * 15 * 31 + i];
        LDS_WAIT(); asm volatile("" ::: "memory");
        for (int i = F.vcu; i < 256; i += F.G)
            for (int k = 0; k < 8; ++k) { const int idx = i * 8 + k, b = idx >> 9, r = (idx >> 2) & 127, jb = idx & 3; na_item(QN, KN, VT, rpl, YNA, b, r, jb, F.wave, F.lane); }
        for (int i = F.vcu; i < 256; i += F.G) pool_wg(PP, PWT, YPOOL, F.lds + RING_OFF, i * 128, F.wave, F.lane);
        { const int pair = F.vcu & 15, xb = pair >> 2, xh = pair & 3, slot = F.vcu >> 4, nslot = F.G >> 4;
          __syncthreads(); xa_fill_lds(KMEM, VTMEM, F.lds + RING_OFF, xb, xh, F.tid); __syncthreads();
          if (slot < nslot) for (int n = slot * NWAVES + F.wave; n < 512; n += nslot * NWAVES) xa_item(XQ, F.lds + RING_OFF, YXA, (xb * 512 + n) * 16, xh, F.lane);
          __syncthreads(); }
        if (rep + 1 < NREP(2)) GRID_BAR();
      }
        if (BOTH(2)) GRID_BAR();
    }

    if (IN(3)) {
      for (int rep = 0; rep < NREP(3); ++rep) {
        pg8::Sched1 S; S.so.init(T, D, F.G, (int)blockIdx.x); S.A = (const char*)YNA; S.Bt = (const char*)WbrT; S.tstep = (size_t)256 * 1536 * 2;
        pg8::EpiMergeCat E{GATE, MERGED};
        pg8::gemm_phase<pg8::EpiMergeCat, pg8::Sched1, true, true>(F.lds + RING_OFF, 1536, S, E);
        if (rep + 1 < NREP(3)) GRID_BAR();
      }
        if (BOTH(3)) GRID_BAR();
    }

    if (IN(4)) {
      for (int rep = 0; rep < NREP(4); ++rep) {
        pg8::Sched1 S; S.so.init(T, D, F.G, (int)blockIdx.x); S.A = (const char*)MERGED; S.Bt = (const char*)WoutT; S.tstep = (size_t)256 * 1024 * 2;
        pg8::EpiH E{args.in[I_X], F.out, HB, ROWSQ, args.probe};
        pg8::gemm_phase<pg8::EpiH, pg8::Sched1, true, true>(F.lds + RING_OFF, 1024, S, E);
        if (rep + 1 < NREP(4)) { GRID_BAR(); for (int m = gw * 64 + F.lane; m < T; m += NGW * 64) ROWSQ[m] = 0.f; GRID_BAR(); }
      }
        if (BOTH(4)) GRID_BAR();
    }

    if (IN(5)) {
      for (int rep = 0; rep < NREP(5); ++rep) {
        pg8::Sched1 S; S.so.init(T, 2048, F.G, (int)blockIdx.x); S.A = (const char*)HB; S.Bt = (const char*)WqT; S.tstep = (size_t)256 * 1024 * 2;
        pg8::EpiQ E{ROWSQ, QB};
        pg8::gemm_phase<pg8::EpiQ, pg8::Sched1, true, true>(F.lds + RING_OFF, 1024, S, E);
        if (rep + 1 < NREP(5)) GRID_BAR();
      }
        if (BOTH(5)) GRID_BAR();
    }

    if (IN(6)) {
        LAS int* lscr = (LAS int*)(F.lds + RING_OFF + 65536 + F.wave * 8192);
        for (int tok = 4 * gw; tok < T; tok += 4 * NGW) {
            HqIn hin[4];
#pragma unroll
            for (int r = 0; r < 4; ++r) hq_load(hin[r], HB, ROWSQ, tok + r, F.lane);
#pragma unroll
            for (int r = 0; r < 4; ++r) hq_token(hin[r], ws + WS_HQ, (float*)(ws + WS_HS), tok + r, F.lane); }
        { const int th = F.vcu & 7, slot = F.vcu >> 3, nslot = F.G >> 3;
          __syncthreads(); topk_fill_lds(KEYS, F.lds + RING_OFF, th, F.tid); __syncthreads();
          for (int rep = 0; rep < NREP(6); ++rep) { { const int n0 = slot * NWAVES + F.wave, ns = nslot * NWAVES; TopkQ qA, qB;
              if (n0 < 2048) topk_loadq(qA, QB, n0 * 16, th, F.lane);
              for (int n = n0; n < 2048; n += 2 * ns) {
                  if (n + ns < 2048) topk_loadq(qB, QB, (n + ns) * 16, th, F.lane);
                  topk_item(qA, F.lds + RING_OFF, TE, TW, lscr, n * 16, th, F.lane);
                  if (n + ns < 2048) { if (n + 2 * ns < 2048) topk_loadq(qA, QB, (n + 2 * ns) * 16, th, F.lane);
                      topk_item(qB, F.lds + RING_OFF, TE, TW, lscr, (n + ns) * 16, th, F.lane); } } } if (rep + 1 < NREP(6)) GRID_BAR(); }
          __syncthreads(); }
        if (BOTH(6)) GRID_BAR();
    }

    if (IN(7)) {
        int x0 = 0, nxs = 8, wrank = (int)blockIdx.x * NWAVES + F.wave, wstep = F.G * NWAVES;
        if (N_LAUNCHES != PER_PHASE) { const unsigned xid = F.MISC[12], rk = F.MISC[13]; unsigned nx = 0, below = 0, mine = 0;
            for (unsigned j = 0; j < 16; ++j) { const unsigned c = xb_ld((unsigned*)(F.ctl + CW_BAR) + XB_XCNT(j)); nx += c > 0u; below += (c > 0u && j < xid); mine = (j == xid) ? c : mine; }
            if (nx == 8 && mine > 0 && rk < mine) { x0 = (int)below; nxs = 1; wrank = (int)rk * NWAVES + F.wave; wstep = (int)mine * NWAVES; } }
        else if ((F.G & 7) == 0) { x0 = (int)blockIdx.x & 7; nxs = 1; wrank = ((int)blockIdx.x >> 3) * NWAVES + F.wave; wstep = (F.G >> 3) * NWAVES; }
        for (int xs = 0; xs < nxs; ++xs) peer_a_run(ws + WS_HQ, (const float*)(ws + WS_HS), U8, SU, SV, TE, TW, args.probe ? (float*)QB : AW, (LAS int*)(F.lds + RING_OFF + F.wave * 16384), wrank, wstep, x0 + xs, F.lane, args.probe == 2);
        if (N_LAUNCHES != PER_PHASE) xcd_barrier(bar);
    }
    if (IN(8)) {
        int x0 = 0, nxs = 8, wrank = (int)blockIdx.x * NWAVES + F.wave, wstep = F.G * NWAVES;
        if (N_LAUNCHES != PER_PHASE) { const unsigned xid = F.MISC[12], rk = F.MISC[13]; unsigned nx = 0, below = 0, mine = 0;
            for (unsigned j = 0; j < 16; ++j) { const unsigned c = xb_ld((unsigned*)(F.ctl + CW_BAR) + XB_XCNT(j)); nx += c > 0u; below += (c > 0u && j < xid); mine = (j == xid) ? c : mine; }
            if (nx == 8 && mine > 0 && rk < mine) { x0 = (int)below; nxs = 1; wrank = (int)rk * NWAVES + F.wave; wstep = (int)mine * NWAVES; } }
        else if ((F.G & 7) == 0) { x0 = (int)blockIdx.x & 7; nxs = 1; wrank = ((int)blockIdx.x >> 3) * NWAVES + F.wave; wstep = (F.G >> 3) * NWAVES; }
        for (int xs = 0; xs < nxs; ++xs) peer_b_run(V8 + (size_t)(x0 + xs) * (2 * MiB), TE, AW, HB, args.probe ? (float*)QB : F.out, wrank, wstep, x0 + xs, F.lane, args.probe == 2);
    }
#undef IN
#undef BOTH
#undef GRID_BAR
}

extern "C" void kernel_launch(void* const* d_in, const int* in_sizes, int n_in, void* d_out, int out_size, void* d_ws, size_t ws_size, hipStream_t stream) {
    static int grid = 0;
    if (grid == 0) {
        if (n_in != 23 || in_sizes[0] != T * D || out_size != T * D || ws_size < WS_END) { fprintf(stderr, "kernel_launch: unexpected shapes: n_in %d in0 %d out %d ws %zu\n", n_in, n_in > 0 ? in_sizes[0] : -1, out_size, ws_size); grid = -1; return; }
        int dev = 0, cus = 0, per_cu = 0;
        if (hipGetDevice(&dev) != hipSuccess || hipDeviceGetAttribute(&cus, hipDeviceAttributeMultiprocessorCount, dev) != hipSuccess) { fprintf(stderr, "kernel_launch: device query failed\n"); grid = -1; return; }
        if (hipFuncSetAttribute((const void*)mk_fwd, hipFuncAttributeMaxDynamicSharedMemorySize, LDS_BYTES) != hipSuccess) { fprintf(stderr, "kernel_launch: hipFuncSetAttribute failed\n"); grid = -1; return; }
        if (hipOccupancyMaxActiveBlocksPerMultiprocessor(&per_cu, (const void*)mk_fwd, NWAVES * 64, LDS_BYTES) != hipSuccess || per_cu < 1)
            fprintf(stderr, "kernel_launch: note: occupancy query reports %d workgroups per CU\n", per_cu);
        (void)hipGetLastError();
        grid = cus;
    }
    if (grid < 0) return;
    if (hipMemsetAsync((char*)d_ws + WS_CTL, 0, CTL_ZERO_BYTES, stream) != hipSuccess) { fprintf(stderr, "kernel_launch: memset failed\n"); return; }
    Args a{};
    for (int i = 0; i < 23; ++i) a.in[i] = (const float*)d_in[i];
    a.out = (float*)d_out; a.ws = (unsigned char*)d_ws;
    for (int li = 0; li < N_LAUNCHES; ++li) {
        a.ph_lo = (N_LAUNCHES == PER_PHASE) ? li : 0; a.ph_hi = (N_LAUNCHES == PER_PHASE) ? li + 1 : PER_PHASE;
        hipLaunchKernelGGL(mk_fwd, dim3(grid), dim3(NWAVES * 64), LDS_BYTES, stream, a);
#ifdef HOST_DUP_PHASE
        if (N_LAUNCHES == PER_PHASE && li == HOST_DUP_PHASE) {
#ifndef PROBE_MODE
            if (li == 4) (void)hipMemsetAsync((char*)d_ws + WS_ROWSQ, 0, (size_t)T * 4, stream);
#endif
#ifdef PROBE_MODE
            a.probe = PROBE_MODE;
#endif
            hipLaunchKernelGGL(mk_fwd, dim3(grid), dim3(NWAVES * 64), LDS_BYTES, stream, a); a.probe = 0; }
#endif
        const hipError_t le = hipPeekAtLastError();
        if (le != hipSuccess) { fprintf(stderr, "kernel_launch: launch %d failed: %s\n", li, hipGetErrorName(le)); break; }
    }
}
```

```cpp
#include <hip/hip_runtime.h>
#include <cstdio>
#include <cstdint>

#ifndef MK_N_LAUNCHES
#define MK_N_LAUNCHES 1
#endif

namespace pg8 {
#define PG8_LAS __attribute__((address_space(3)))
typedef unsigned short bf16_t;
typedef short bf16x8 __attribute__((ext_vector_type(8)));
typedef float f32x4 __attribute__((ext_vector_type(4)));
typedef unsigned u32x4 __attribute__((ext_vector_type(4)));
typedef unsigned u32x2 __attribute__((ext_vector_type(2)));
constexpr int BM = 256, BK = 64, HALF = 128, HTB = HALF * BK * 2  , STAGE_BYTES = 8 * HTB, NXCD = 8, WGM = 8;

__host__ __device__ __forceinline__ int lds_byte(int r, int c) { const int st = (r >> 4) * 2 + (c >> 5), rr = r & 15, cc = c & 31, ob = rr * 64 + cc * 2; return st * 1024 + (ob ^ (((ob >> 9) & 1) << 5)); }
__host__ __device__ __forceinline__ void stage_rc(int b, int& R, int& C) { const int st = b / 1024, sb = b % 1024, swz = sb ^ (((sb >> 9) & 1) << 5); R = (st >> 1) * 16 + swz / 64; C = (st & 1) * 32 + (swz % 64) / 2; }
__host__ __device__ __forceinline__ int perm32(int rho) { const int n = rho >> 4, i = rho & 15; return 8 * (i >> 2) + 4 * n + (i & 3); }

struct Unit { int pm, pn, br; };

struct StaticOrder {
    int nM, nN, nwg, G, c;
    __host__ __device__ void init(int M, int N, int G_, int c_) { nM = M / BM; nN = N / BM; nwg = nM * nN; G = G_; c = c_; }
    __host__ __device__ bool next(int i, Unit& u) const {
        const long L = (long)i * G + c; if (L >= nwg) return false;
        int wgid = (int)L; { const int q = nwg / NXCD, r = nwg % NXCD, xcd = wgid % NXCD, off = wgid / NXCD; wgid = (xcd < r ? xcd * (q + 1) : r * (q + 1) + (xcd - r) * q) + off; }
        const int nig = WGM * nN, gid = wgid / nig, fm = gid * WGM, gsz = (nM - fm) < WGM ? (nM - fm) : WGM;
        u.pm = fm + ((wgid % nig) % gsz); u.pn = (wgid % nig) / gsz; return true;
    }
};
struct Sched1 {
    StaticOrder so; const char* A; const char* Bt; size_t tstep;
    __device__ __forceinline__ bool next(int i, Unit& u) const { u.br = 0; return so.next(i, u); }
    __device__ __forceinline__ const char* abase(const Unit& u) const { return A + (size_t)u.pm * tstep; }
    __device__ __forceinline__ const char* bbase(const Unit& u) const { return Bt + (size_t)u.pn * tstep; }
    __device__ __forceinline__ void a_ready(const Unit&) const {}
    __device__ __forceinline__ void done(const Unit&) const {}
};
struct Sched3 {
    StaticOrder so; const char* A; const char* Bt; size_t tstep, strideA, strideB;
    __device__ __forceinline__ bool next(int i, Unit& u) const { u.br = i % 3; return so.next(i / 3, u); }
    __device__ __forceinline__ const char* abase(const Unit& u) const { return A + (size_t)u.br * strideA + (size_t)u.pm * tstep; }
    __device__ __forceinline__ const char* bbase(const Unit& u) const { return Bt + (size_t)u.br * strideB + (size_t)u.pn * tstep; }
    __device__ __forceinline__ void a_ready(const Unit&) const {}
    __device__ __forceinline__ void done(const Unit&) const {}
};

typedef float f32x2_t __attribute__((ext_vector_type(2))); typedef __bf16 bf16x2v_t __attribute__((ext_vector_type(2)));
__device__ __forceinline__ unsigned cvt_pk_bf16(float lo, float hi) { const f32x2_t v = {lo, hi}; const bf16x2v_t b = __builtin_convertvector(v, bf16x2v_t); return __builtin_bit_cast(unsigned, b); }
__device__ __forceinline__ u32x4 pack8(const f32x4 a, const f32x4 b) { u32x4 w; w.x = cvt_pk_bf16(a[0], a[1]); w.y = cvt_pk_bf16(a[2], a[3]); w.z = cvt_pk_bf16(b[0], b[1]); w.w = cvt_pk_bf16(b[2], b[3]); return w; }
__device__ __forceinline__ float bflo(unsigned u) { return __builtin_bit_cast(float, u << 16); }
__device__ __forceinline__ float bfhi(unsigned u) { return __builtin_bit_cast(float, u & 0xffff0000u); }


constexpr float RMS_EPS = 1e-6f;

struct EpiProj {
    static constexpr bool PERM = true, AFTER_DRAIN = false, HAS_MID = false;
    const float* rstd; bf16_t *qn, *kn, *pp, *xq, *gates; const float *qg, *kg, *gate_b;
    __device__ __forceinline__ void operator()(const f32x4 (&acc)[2][2][4][2], const Unit& u, int wr, int wc, int fr, int fq) const {
        const int pn = u.pn, row0 = u.pm * BM + wr * 64 + fr, lc0 = 64 * wc + 8 * fq;
        float rsv[2][4];
#pragma unroll
        for (int ai = 0; ai < 2; ++ai)
#pragma unroll
            for (int m = 0; m < 4; ++m) rsv[ai][m] = rstd[row0 + ai * HALF + m * 16];
        if (pn < 4) {
            const bool isq = pn < 2; bf16_t* O = isq ? qn : kn; const float* g = isq ? qg : kg; const float post = isq ? 0.125f : 1.0f;
            f32x4 gv[2][2];
#pragma unroll
            for (int bj = 0; bj < 2; ++bj)
#pragma unroll
                for (int n = 0; n < 2; ++n) gv[bj][n] = *(const f32x4*)(g + 32 * bj + 8 * fq + 4 * n);
            const int colbase = (pn & 1) * 256 + lc0;
#pragma unroll
            for (int ai = 0; ai < 2; ++ai)
#pragma unroll
                for (int m = 0; m < 4; ++m) {
                    const int row = row0 + ai * HALF + m * 16; const float rs = rsv[ai][m];
                    f32x4 v[2][2]; float ss = 0.f;
#pragma unroll
                    for (int bj = 0; bj < 2; ++bj)
#pragma unroll
                        for (int n = 0; n < 2; ++n) { v[bj][n] = acc[ai][bj][m][n] * rs; ss += (v[bj][n][0] * v[bj][n][0] + v[bj][n][1] * v[bj][n][1]) + (v[bj][n][2] * v[bj][n][2] + v[bj][n][3] * v[bj][n][3]); }
                    ss += __shfl_xor(ss, 16); ss += __shfl_xor(ss, 32);
                    const float r = rsqrtf(ss * (1.0f / 64.0f) + RMS_EPS) * post;
#pragma unroll
                    for (int bj = 0; bj < 2; ++bj) *(u32x4*)(O + (size_t)row * 512 + colbase + 32 * bj) = pack8(v[bj][0] * r * gv[bj][0], v[bj][1] * r * gv[bj][1]);
                }
        } else if (pn < 8) {
            bf16_t* O = pn < 6 ? pp : xq; const int colbase = (pn & 1) * 256 + lc0;
#pragma unroll
            for (int ai = 0; ai < 2; ++ai)
#pragma unroll
                for (int m = 0; m < 4; ++m) {
                    const int row = row0 + ai * HALF + m * 16; const float rs = rsv[ai][m];
#pragma unroll
                    for (int bj = 0; bj < 2; ++bj) *(u32x4*)(O + (size_t)row * 512 + colbase + 32 * bj) = pack8(acc[ai][bj][m][0] * rs, acc[ai][bj][m][1] * rs);
                }
        } else {
            const int gcol0 = (pn - 8) * 256 + lc0;
            f32x4 bv[2][2];
#pragma unroll
            for (int bj = 0; bj < 2; ++bj)
#pragma unroll
                for (int n = 0; n < 2; ++n) bv[bj][n] = *(const f32x4*)(gate_b + gcol0 + 32 * bj + 4 * n);
#pragma unroll
            for (int ai = 0; ai < 2; ++ai)
#pragma unroll
                for (int m = 0; m < 4; ++m) {
                    const int row = row0 + ai * HALF + m * 16; const float rs = rsv[ai][m];
#pragma unroll
                    for (int bj = 0; bj < 2; ++bj) {
                        f32x4 o[2];
#pragma unroll
                        for (int n = 0; n < 2; ++n) { const f32x4 z = acc[ai][bj][m][n] * rs + bv[bj][n];
#pragma unroll
                            for (int i = 0; i < 4; ++i) o[n][i] = __builtin_amdgcn_rcpf(1.0f + __expf(-z[i])); }
                        *(u32x4*)(gates + (size_t)row * 3072 + gcol0 + 32 * bj) = pack8(o[0], o[1]);
                    }
                }
        }
    }
};
struct EpiVt {
    static constexpr bool PERM = true, AFTER_DRAIN = false, HAS_MID = false;
    const float* rstd; bf16_t* Vt;
    __device__ __forceinline__ void operator()(const f32x4 (&acc)[2][2][4][2], const Unit& u, int wr, int wc, int fr, int fq) const {
        const int ch0 = u.pm * BM + wr * 64 + fr, tok0 = u.pn * BM + wc * 32 + 8 * fq, b = tok0 >> 13, t0 = tok0 & 8191;
        f32x4 rv[2][2];
#pragma unroll
        for (int bj = 0; bj < 2; ++bj)
#pragma unroll
            for (int n = 0; n < 2; ++n) rv[bj][n] = *(const f32x4*)(rstd + tok0 + bj * HALF + 4 * n);
#pragma unroll
        for (int ai = 0; ai < 2; ++ai)
#pragma unroll
            for (int m = 0; m < 4; ++m) { const int ch = ch0 + ai * HALF + m * 16; bf16_t* rowp = Vt + ((size_t)(b * 512 + ch) * 8192 + t0);
#pragma unroll
                for (int bj = 0; bj < 2; ++bj) *(u32x4*)(rowp + bj * HALF) = pack8(acc[ai][bj][m][0] * rv[bj][0], acc[ai][bj][m][1] * rv[bj][1]); }
    }
};
struct EpiMergeCat {
    static constexpr bool PERM = true, AFTER_DRAIN = false, HAS_MID = true;
    const bf16_t* gates; bf16_t* merged;
    __device__ __forceinline__ void mid(f32x4 (&acc)[2][2][4][2], const Unit& u, int nb  , int wr, int wc, int fr, int fq) const {
        const int row0 = u.pm * BM + wr * 64 + fr, col0 = u.pn * BM + wc * 32 + 8 * fq;
#pragma unroll
        for (int ai = 0; ai < 2; ++ai) {
            u32x4 ga[4][2], gb[4][2];
#pragma unroll
            for (int m = 0; m < 4; ++m)
#pragma unroll
                for (int bj = 0; bj < 2; ++bj) { const bf16_t* gp = gates + (size_t)(row0 + ai * HALF + m * 16) * 3072 + (nb - 1) * 1024 + col0 + bj * HALF;
                    ga[m][bj] = *(const u32x4*)gp; gb[m][bj] = *(const u32x4*)(gp + 1024); }
            __builtin_amdgcn_sched_barrier(0);
#pragma unroll
            for (int m = 0; m < 4; ++m)
#pragma unroll
                for (int bj = 0; bj < 2; ++bj) { const u32x4 a = ga[m][bj], b = gb[m][bj]; f32x4& x0 = acc[ai][bj][m][0]; f32x4& x1 = acc[ai][bj][m][1];
                    x0[0] *= bflo(a.x) * __builtin_amdgcn_rcpf(bflo(b.x)); x0[1] *= bfhi(a.x) * __builtin_amdgcn_rcpf(bfhi(b.x)); x0[2] *= bflo(a.y) * __builtin_amdgcn_rcpf(bflo(b.y)); x0[3] *= bfhi(a.y) * __builtin_amdgcn_rcpf(bfhi(b.y));
                    x1[0] *= bflo(a.z) * __builtin_amdgcn_rcpf(bflo(b.z)); x1[1] *= bfhi(a.z) * __builtin_amdgcn_rcpf(bfhi(b.z)); x1[2] *= bflo(a.w) * __builtin_amdgcn_rcpf(bflo(b.w)); x1[3] *= bfhi(a.w) * __builtin_amdgcn_rcpf(bfhi(b.w)); }
            __builtin_amdgcn_sched_barrier(0);
        }
    }
    __device__ __forceinline__ void operator()(const f32x4 (&acc)[2][2][4][2], const Unit& u, int wr, int wc, int fr, int fq) const {
        const int row0 = u.pm * BM + wr * 64 + fr, col0 = u.pn * BM + wc * 32 + 8 * fq;
#pragma unroll
        for (int ai = 0; ai < 2; ++ai) {
            u32x4 g8[4][2];
#pragma unroll
            for (int m = 0; m < 4; ++m)
#pragma unroll
                for (int bj = 0; bj < 2; ++bj) g8[m][bj] = *(const u32x4*)(gates + (size_t)(row0 + ai * HALF + m * 16) * 3072 + 2048 + col0 + bj * HALF);
            __builtin_amdgcn_sched_barrier(0);
#pragma unroll
            for (int m = 0; m < 4; ++m)
#pragma unroll
                for (int bj = 0; bj < 2; ++bj) { const u32x4 g = g8[m][bj]; f32x4 a = acc[ai][bj][m][0], b = acc[ai][bj][m][1];
                    a[0] *= bflo(g.x); a[1] *= bfhi(g.x); a[2] *= bflo(g.y); a[3] *= bfhi(g.y); b[0] *= bflo(g.z); b[1] *= bfhi(g.z); b[2] *= bflo(g.w); b[3] *= bfhi(g.w);
                    *(u32x4*)(merged + (size_t)(row0 + ai * HALF + m * 16) * 1024 + col0 + bj * HALF) = pack8(a, b); }
            __builtin_amdgcn_sched_barrier(0);
        }
    }
};
struct EpiH {
    static constexpr bool PERM = true, AFTER_DRAIN = false, HAS_MID = false;
    const float* x; float* out; bf16_t* hb; float* rowsq; int noatomic;
    __device__ __forceinline__ void operator()(const f32x4 (&acc)[2][2][4][2], const Unit& u, int wr, int wc, int fr, int fq) const {
        const int row0 = u.pm * BM + wr * 64 + fr, col0 = u.pn * BM + wc * 32 + 8 * fq;
#pragma unroll
        for (int ai = 0; ai < 2; ++ai) {
            f32x4 xv[4][2][2];
#pragma unroll
            for (int m = 0; m < 4; ++m)
#pragma unroll
                for (int bj = 0; bj < 2; ++bj) { const size_t o = (size_t)(row0 + ai * HALF + m * 16) * 1024 + col0 + bj * HALF; xv[m][bj][0] = *(const f32x4*)(x + o); xv[m][bj][1] = *(const f32x4*)(x + o + 4); }
            __builtin_amdgcn_sched_barrier(0);
#pragma unroll
            for (int m = 0; m < 4; ++m) { const int row = row0 + ai * HALF + m * 16; float ss = 0.f;
#pragma unroll
                for (int bj = 0; bj < 2; ++bj) { const size_t o = (size_t)row * 1024 + col0 + bj * HALF;
                    const f32x4 h0 = xv[m][bj][0] + acc[ai][bj][m][0], h1 = xv[m][bj][1] + acc[ai][bj][m][1];
                    *(u32x4*)(hb + o) = pack8(h0, h1);
                    ss += (h0[0] * h0[0] + h0[1] * h0[1]) + (h0[2] * h0[2] + h0[3] * h0[3]) + (h1[0] * h1[0] + h1[1] * h1[1]) + (h1[2] * h1[2] + h1[3] * h1[3]); }
                ss += __shfl_xor(ss, 16); ss += __shfl_xor(ss, 32);
                if (fq == 0 && !noatomic) atomicAdd(rowsq + row, ss); }
            __builtin_amdgcn_sched_barrier(0);
        }
    }
};
struct EpiQ {
    static constexpr bool PERM = true, AFTER_DRAIN = false, HAS_MID = false;
    const float* rowsq; bf16_t* qb;
    __device__ __forceinline__ void operator()(const f32x4 (&acc)[2][2][4][2], const Unit& u, int wr, int wc, int fr, int fq) const {
        const int row0 = u.pm * BM + wr * 64 + fr, col0 = u.pn * BM + wc * 32 + 8 * fq;
        float rq[2][4];
#pragma unroll
        for (int ai = 0; ai < 2; ++ai)
#pragma unroll
            for (int m = 0; m < 4; ++m) rq[ai][m] = rowsq[row0 + ai * HALF + m * 16];
#pragma unroll
        for (int ai = 0; ai < 2; ++ai)
#pragma unroll
            for (int m = 0; m < 4; ++m) { const int row = row0 + ai * HALF + m * 16; const float r = rsqrtf(rq[ai][m] * (1.0f / 1024.0f) + RMS_EPS);
#pragma unroll
                for (int bj = 0; bj < 2; ++bj) *(u32x4*)(qb + (size_t)row * 2048 + col0 + bj * HALF) = pack8(acc[ai][bj][m][0] * r, acc[ai][bj][m][1] * r); }
    }
};

template <class Epi, class Sched, bool ALIGN_EPI = false, bool SP2 = false>
__device__ __forceinline__ void gemm_phase(PG8_LAS unsigned char* lds, const int K, const Sched& S, const Epi& E) {
    const int tid = threadIdx.x, wid = __builtin_amdgcn_readfirstlane(tid >> 6), lane = tid & 63, wr = wid >> 2, wc = wid & 3, fr = lane & 15, fq = lane >> 4;
    const int nt = K / BK;
    unsigned voffA[2], voffB[2];
#pragma unroll
    for (int i = 0; i < 2; ++i) { int R, C; stage_rc(tid * 16 + i * 8192, R, C); const int Rb = Epi::PERM ? ((R & ~31) + perm32(R & 31)) : R;
        voffA[i] = (unsigned)(R * K + C) * 2u; voffB[i] = (unsigned)(Rb * K + C) * 2u; }
    const size_t kstep = (size_t)(BK * 2);
    const size_t hstep = (size_t)HALF * K * 2;
    const size_t tstep = 2 * hstep;
    const unsigned ldsw = (unsigned)wid * 1024u;
    const int aoff = lds_byte(wr * 64 + fr, fq * 8), boff = lds_byte(wc * 32 + fr, fq * 8);
#define PG8_SA(b, h) (((b) * 2 + (h)) * HTB)
#define PG8_SB(b, h) ((4 + (b) * 2 + (h)) * HTB)
#define PG8_STAGE(bufoff, gbase, voff) do { _Pragma("unroll") for (int _i = 0; _i < 2; ++_i) \
        __builtin_amdgcn_global_load_lds((const unsigned*)((const char*)(gbase) + (voff)[_i]), (PG8_LAS unsigned*)(lds + (bufoff) + ldsw + _i * 8192), 16, 0, 0); } while (0)
#define PG8_LDA(dst, b, h) do { _Pragma("unroll") for (int m = 0; m < 4; ++m) _Pragma("unroll") for (int k = 0; k < 2; ++k) dst[m][k] = *(const PG8_LAS bf16x8*)(lds + PG8_SA(b, h) + aoff + m * 2048 + k * 1024); } while (0)
#define PG8_LDB(dst, b, h) do { _Pragma("unroll") for (int n = 0; n < 2; ++n) _Pragma("unroll") for (int k = 0; k < 2; ++k) dst[n][k] = *(const PG8_LAS bf16x8*)(lds + PG8_SB(b, h) + boff + n * 2048 + k * 1024); } while (0)
#define PG8_MMA(ai, bj, At, Bt) do { __builtin_amdgcn_s_setprio(1); _Pragma("unroll") for (int m = 0; m < 4; ++m) _Pragma("unroll") for (int n = 0; n < 2; ++n) _Pragma("unroll") for (int k = 0; k < 2; ++k) \
        acc[ai][bj][m][n] = __builtin_amdgcn_mfma_f32_16x16x32_bf16(Bt[n][k], At[m][k], acc[ai][bj][m][n], 0, 0, 0); __builtin_amdgcn_s_setprio(0); } while (0)
#define PG8_WAIT_V(n) asm volatile("s_waitcnt vmcnt(" #n ")" ::: "memory")
#define PG8_WAIT_L(n) asm volatile("s_waitcnt lgkmcnt(" #n ")" ::: "memory")
#define PG8_BAR __builtin_amdgcn_s_barrier()
#define PG8_SCHED __builtin_amdgcn_sched_barrier(0)
    Unit cur, nxt; int ui = 0;
    if (!S.next(0, cur)) return;
    f32x4 acc[2][2][4][2];
#pragma unroll
    for (int a = 0; a < 2; ++a)
#pragma unroll
        for (int b = 0; b < 2; ++b)
#pragma unroll
            for (int m = 0; m < 4; ++m)
#pragma unroll
                for (int n = 0; n < 2; ++n) acc[a][b][m][n] = (f32x4){0.f, 0.f, 0.f, 0.f};
    bf16x8 At[4][2], B0[2][2], B1[2][2];
    const char* cA = S.abase(cur); const char* cB = S.bbase(cur);
    S.a_ready(cur);
    if constexpr (SP2) {
        PG8_STAGE(PG8_SB(0, 0), cB, voffB); PG8_STAGE(PG8_SB(0, 1), cB + hstep, voffB); PG8_STAGE(PG8_SA(0, 0), cA, voffA); PG8_STAGE(PG8_SA(0, 1), cA + hstep, voffA);
        if (wr == 1) PG8_BAR;
        PG8_WAIT_V(2); PG8_BAR;
        PG8_STAGE(PG8_SB(1, 0), cB + kstep, voffB); PG8_STAGE(PG8_SA(1, 0), cA + kstep, voffA); PG8_STAGE(PG8_SB(1, 1), cB + hstep + kstep, voffB);
        PG8_WAIT_V(6); PG8_BAR;
    } else {
        PG8_STAGE(PG8_SB(0, 0), cB, voffB); PG8_STAGE(PG8_SA(0, 0), cA, voffA); PG8_STAGE(PG8_SB(0, 1), cB + hstep, voffB); PG8_STAGE(PG8_SA(0, 1), cA + hstep, voffA);
        if (wr == 1) PG8_BAR;
        PG8_WAIT_V(4); PG8_BAR;
        PG8_STAGE(PG8_SB(1, 0), cB + kstep, voffB); PG8_STAGE(PG8_SA(1, 0), cA + kstep, voffA); PG8_STAGE(PG8_SB(1, 1), cB + hstep + kstep, voffB);
        PG8_WAIT_V(6); PG8_BAR;
    }
    for (;;) {
        const bool has_next = S.next(ui + 1, nxt);
        const char* nA = has_next ? S.abase(nxt) : cA; const char* nB = has_next ? S.bbase(nxt) : cB;
        for (int t = 0; t < nt; t += 2) {
            if constexpr (Epi::HAS_MID) { if (t == 8 || t == 16) E.mid(acc, cur, t >> 3, wr, wc, fr, fq); }
            const bool last = (t == nt - 2);
            const char* a1 = cA + (size_t)(t + 1) * kstep;
            const char* a2 = last ? nA : cA + (size_t)(t + 2) * kstep; const char* b2 = last ? nB : cB + (size_t)(t + 2) * kstep;
            const char* a3 = a2 + kstep; const char* b3 = b2 + kstep;
            if (last && has_next) S.a_ready(nxt);
            if constexpr (SP2) {
            PG8_LDB(B0, 0, 0); PG8_LDB(B1, 0, 1); PG8_SCHED; PG8_LDA(At, 0, 0); PG8_STAGE(PG8_SA(1, 1), a1 + hstep, voffA);
            PG8_WAIT_V(8); PG8_WAIT_L(0); PG8_BAR; PG8_MMA(0, 0, At, B0); PG8_MMA(0, 1, At, B1); PG8_BAR; PG8_SCHED;
            PG8_LDA(At, 0, 1); PG8_STAGE(PG8_SB(0, 0), b2, voffB); PG8_STAGE(PG8_SB(0, 1), b2 + hstep, voffB); PG8_STAGE(PG8_SA(0, 0), a2, voffA);
            PG8_WAIT_V(8); PG8_WAIT_L(0); PG8_BAR; PG8_MMA(1, 0, At, B0); PG8_MMA(1, 1, At, B1); PG8_BAR; PG8_SCHED;
            PG8_LDB(B0, 1, 0); PG8_LDB(B1, 1, 1); PG8_SCHED; PG8_LDA(At, 1, 0); PG8_STAGE(PG8_SA(0, 1), a2 + hstep, voffA);
            PG8_WAIT_V(8); PG8_WAIT_L(0); PG8_BAR; PG8_MMA(0, 0, At, B0); PG8_MMA(0, 1, At, B1); PG8_BAR; PG8_SCHED;
            PG8_LDA(At, 1, 1); PG8_STAGE(PG8_SB(1, 0), b3, voffB); PG8_STAGE(PG8_SB(1, 1), b3 + hstep, voffB); PG8_STAGE(PG8_SA(1, 0), a3, voffA);
            PG8_WAIT_V(8); PG8_WAIT_L(0); PG8_BAR; PG8_MMA(1, 0, At, B0); PG8_MMA(1, 1, At, B1); PG8_BAR; PG8_SCHED;
            } else {
            PG8_LDB(B0, 0, 0); PG8_SCHED; PG8_LDA(At, 0, 0); PG8_STAGE(PG8_SA(1, 1), a1 + hstep, voffA);
            PG8_WAIT_L(8); PG8_BAR; PG8_WAIT_L(0); PG8_MMA(0, 0, At, B0); PG8_BAR; PG8_SCHED;
            PG8_LDB(B1, 0, 1); PG8_STAGE(PG8_SB(0, 0), b2, voffB);
            PG8_BAR; PG8_WAIT_L(0); PG8_MMA(0, 1, At, B1); PG8_BAR;
            PG8_LDA(At, 0, 1); PG8_STAGE(PG8_SA(0, 0), a2, voffA);
            PG8_BAR; PG8_WAIT_L(0); PG8_MMA(1, 0, At, B0); PG8_BAR; PG8_SCHED;
            PG8_STAGE(PG8_SB(0, 1), b2 + hstep, voffB);
            PG8_WAIT_V(6); PG8_BAR; PG8_MMA(1, 1, At, B1); PG8_BAR;
            PG8_LDB(B0, 1, 0); PG8_SCHED; PG8_LDA(At, 1, 0); PG8_STAGE(PG8_SA(0, 1), a2 + hstep, voffA);
            PG8_WAIT_L(8); PG8_BAR; PG8_WAIT_L(0); PG8_MMA(0, 0, At, B0); PG8_BAR; PG8_SCHED;
            PG8_LDB(B1, 1, 1); PG8_STAGE(PG8_SB(1, 0), b3, voffB);
            PG8_BAR; PG8_WAIT_L(0); PG8_MMA(0, 1, At, B1); PG8_BAR;
            PG8_LDA(At, 1, 1); PG8_STAGE(PG8_SA(1, 0), a3, voffA);
            PG8_BAR; PG8_WAIT_L(0); PG8_MMA(1, 0, At, B0); PG8_BAR; PG8_SCHED;
            PG8_STAGE(PG8_SB(1, 1), b3 + hstep, voffB);
            PG8_WAIT_V(6); PG8_BAR; PG8_MMA(1, 1, At, B1); PG8_BAR;
            }
        }
        if constexpr (ALIGN_EPI) { if (wr == 0) PG8_BAR; }
        if constexpr (!Epi::AFTER_DRAIN) { E(acc, cur, wr, wc, fr, fq); S.done(cur); }
        if (!has_next) break;
#pragma unroll
        for (int a = 0; a < 2; ++a)
#pragma unroll
            for (int b = 0; b < 2; ++b)
#pragma unroll
                for (int m = 0; m < 4; ++m)
#pragma unroll
                    for (int n = 0; n < 2; ++n) acc[a][b][m][n] = (f32x4){0.f, 0.f, 0.f, 0.f};
        cur = nxt; cA = nA; cB = nB; ++ui;
        if constexpr (ALIGN_EPI) { if (wr == 1) PG8_BAR; }
    }
    PG8_WAIT_V(0);
    if constexpr (!ALIGN_EPI) { if (wr == 0) PG8_BAR; }
    PG8_BAR;
    if constexpr (Epi::AFTER_DRAIN) { E.fused(acc, cur, wr, wc, fr, fq, lds, wid, lane); S.done(cur); }
#undef PG8_SA
#undef PG8_SB
#undef PG8_STAGE
#undef PG8_LDA
#undef PG8_LDB
#undef PG8_MMA
#undef PG8_WAIT_V
#undef PG8_WAIT_L
#undef PG8_BAR
#undef PG8_SCHED
}
}

constexpr int NWAVES = 8;
constexpr int N_LAUNCHES = MK_N_LAUNCHES;
constexpr int PER_PHASE = 9;
constexpr int NBATCH = 4, SEQ = 8192, D = 1024, T = NBATCH * SEQ, MEMLEN = 256, NMEMTOK = NBATCH * MEMLEN;
constexpr int IN_MAIN = 5120;
constexpr int NEXP = 16384;

constexpr size_t MiB = 1u << 20;
constexpr size_t WS_CTL = 0, CTL_ZERO_BYTES = 512 * 1024;
constexpr size_t WS_ROWSQ = 256 * 1024;
constexpr size_t WS_WIN = 1 * MiB, WS_WV = 11 * MiB, WS_WKV = 12 * MiB, WS_WBR = 14 * MiB, WS_WOUT = 17 * MiB, WS_WQ = 19 * MiB, WS_KEYS = 23 * MiB, WS_PWT = 23 * MiB + 512 * 1024;
constexpr size_t WS_MEMN = 24 * MiB, WS_KMEM = 26 * MiB, WS_VTMEM = 27 * MiB, WS_RSTDX = 28 * MiB, WS_SU = 28 * MiB + 256 * 1024  , WS_SV = 28 * MiB + 512 * 1024  ;
constexpr size_t WS_U8 = 32 * MiB, WS_V8 = 48 * MiB;
constexpr size_t WS_QN = 96 * MiB, WS_KN = 128 * MiB, WS_VT = 160 * MiB, WS_PP = 192 * MiB, WS_XQ = 224 * MiB, WS_GATE = 256 * MiB, WS_END = 448 * MiB;
constexpr size_t WS_MERGED = WS_QN;
constexpr size_t WS_HB = WS_VT;
constexpr size_t WS_QB = WS_GATE;
constexpr size_t WS_TE = WS_GATE + 128 * MiB, WS_TW = WS_TE + 16 * MiB;
constexpr size_t WS_HQ = WS_TW + 16 * MiB;
constexpr size_t WS_HS = 28 * MiB + 768 * 1024;
constexpr size_t WS_AW = WS_MERGED;
constexpr size_t OUT_XB = 0, OUT_YNA = 0, OUT_YPOOL = 512 * 2, OUT_YXA = 1024 * 2;
constexpr int CW_TMO = 0, CW_BAR = 4096, CW_TICKET = 8192;

constexpr int RING_OFF = 0, RING_BYTES = 131072;
constexpr int LDSCTL_OFF = RING_BYTES, MISC_OFF = LDSCTL_OFF + 320;
constexpr int LDS_BYTES = 147456;

#define GAS __attribute__((address_space(1)))
#define LAS __attribute__((address_space(3)))
typedef unsigned short bf16;
typedef unsigned v4u __attribute__((ext_vector_type(4)));
typedef unsigned v2u __attribute__((ext_vector_type(2)));
typedef float f32x4 __attribute__((ext_vector_type(4)));
typedef short bf16x8 __attribute__((ext_vector_type(8)));
typedef __bf16 bf16x2_t __attribute__((ext_vector_type(2)));
typedef GAS unsigned gu32;
#define LDS_WAIT() asm volatile("s_waitcnt lgkmcnt(0)" ::: "memory")
#define VM_WAIT() asm volatile("s_waitcnt vmcnt(0)" ::: "memory")
__device__ __forceinline__ unsigned f2bf(float f) { unsigned u = __builtin_bit_cast(unsigned, f); return (u + 0x7fffu + ((u >> 16) & 1u)) >> 16; }
__device__ __forceinline__ unsigned pk2(float lo, float hi) { return f2bf(lo) | (f2bf(hi) << 16); }
__device__ __forceinline__ float bflo(unsigned u) { return __builtin_bit_cast(float, u << 16); }
__device__ __forceinline__ float bfhi(unsigned u) { return __builtin_bit_cast(float, u & 0xffff0000u); }
__device__ __forceinline__ float bf1(short s) { return __builtin_bit_cast(float, ((unsigned)(unsigned short)s) << 16); }
__device__ __forceinline__ f32x4 mfma16(bf16x8 a, bf16x8 b, f32x4 c) { return __builtin_amdgcn_mfma_f32_16x16x32_bf16(a, b, c, 0, 0, 0); }
__device__ __forceinline__ float wave_sum(float v) {
#pragma unroll
    for (int o = 1; o < 64; o <<= 1) v += __shfl_xor(v, o);
    return v;
}

#define XB_TMO      128
#define XB_XCNT(j)  (256  + 64 * (j))
#define XB_XSUB(j)  (1280 + 64 * (j))
#define XB_XGEN(j)  (2304 + 64 * (j))
#define XB_TOP      3328
#define XB_TOPGEN   3392
#define XCD_BAR_WORDS 3456
#define XB_SPIN_CAP (1u << 18)

__device__ __forceinline__ unsigned xb_ld(unsigned* p)              { return __hip_atomic_load(p, __ATOMIC_RELAXED, __HIP_MEMORY_SCOPE_AGENT); }
__device__ __forceinline__ unsigned xb_add(unsigned* p, unsigned v) { return __hip_atomic_fetch_add(p, v, __ATOMIC_RELAXED, __HIP_MEMORY_SCOPE_AGENT); }
__device__ __forceinline__ unsigned xb_xcc_id() { return (unsigned)__builtin_amdgcn_s_getreg((3 << 11) | 20) & 0xFu; }
#define XB_SPIN(cond, bar) do { unsigned _sp = 0; while (cond) { __builtin_amdgcn_s_sleep(1); \
    if ((++_sp & 255u) == 0u) { if (xb_ld(&(bar)[XB_TMO])) break; if (_sp > XB_SPIN_CAP) { atomicAdd(&(bar)[XB_TMO], 1u); break; } } } } while (0)

struct XcdBarrier {
    unsigned* bar; unsigned x;
    volatile LAS unsigned* st;
};

__device__ __forceinline__ XcdBarrier xcd_barrier_post(unsigned* bar, volatile LAS unsigned* st) {
    XcdBarrier b; b.bar = bar; b.x = xb_xcc_id(); b.st = st;
    if (threadIdx.x == 0) (void)xb_add(&bar[XB_XCNT(b.x)], 1u);
    return b;
}
__device__ __forceinline__ void xcd_barrier_complete(unsigned* bar, unsigned x, unsigned& nloc, unsigned& nx) {
    const unsigned G = gridDim.x * gridDim.y * gridDim.z;
    unsigned sum, cnt, mine, sp = 0u;
    for (;;) {
        sum = 0u; cnt = 0u; mine = 0u;
#pragma unroll
        for (unsigned j = 0; j < 16; ++j) { const unsigned c = xb_ld(&bar[XB_XCNT(j)]); sum += c; cnt += (c > 0u) ? 1u : 0u; mine = (j == x) ? c : mine; }
        if (sum == G) break;
        __builtin_amdgcn_s_sleep(1);
        if ((++sp & 255u) == 0u) { if (xb_ld(&bar[XB_TMO])) break; if (sp > XB_SPIN_CAP) { atomicAdd(&bar[XB_TMO], 1u); break; } }
    }
    nloc = mine > 0u ? mine : 1u; nx = cnt > 0u ? cnt : 1u;
}

__device__ __forceinline__ void xcd_barrier(const XcdBarrier& b) {
    asm volatile("s_waitcnt vmcnt(0)" ::: "memory");
    __syncthreads();
    if (threadIdx.x == 0) {
        unsigned* bar = b.bar;
        __builtin_amdgcn_s_waitcnt(0);
        unsigned nloc = b.st[0], nx = b.st[1];
        if (nloc == 0u) { xcd_barrier_complete(bar, b.x, nloc, nx); b.st[0] = nloc; b.st[1] = nx; }
        const unsigned old = xb_add(&bar[XB_XSUB(b.x)], 1u);
        const unsigned gen = old / nloc;
        if (old + 1u == (gen + 1u) * nloc) {
            __builtin_amdgcn_fence(__ATOMIC_RELEASE, "agent");
            asm volatile("s_waitcnt vmcnt(0)" ::: "memory");
            const unsigned og = xb_add(&bar[XB_TOP], 1u);
            const unsigned tg = og / nx;
            if (og + 1u == (tg + 1u) * nx) xb_add(&bar[XB_TOPGEN], 1u);
            else XB_SPIN(xb_ld(&bar[XB_TOPGEN]) == tg, bar);
            __builtin_amdgcn_fence(__ATOMIC_ACQUIRE, "agent");
            xb_add(&bar[XB_XGEN(b.x)], 1u);
            asm volatile("s_waitcnt vmcnt(0)" ::: "memory");
        } else {
            XB_SPIN(xb_ld(&bar[XB_XGEN(b.x)]) == gen, bar);
            __builtin_amdgcn_fence(__ATOMIC_ACQUIRE, "agent");
            asm volatile("s_waitcnt vmcnt(0)" ::: "memory");
        }
    }
    __syncthreads();
}

struct Frame {
    LAS unsigned char* lds;
    volatile LAS unsigned* MISC;
    gu32* ctl;
    int tid, lane, wave, vcu, G;
    float* out; unsigned char* ws;
};
struct Args { const float* in[23]; float* out; unsigned char* ws; int ph_lo, ph_hi, probe, pad; };
enum { I_X = 0, I_MEM, I_MIXG, I_MEMG, I_WIN, I_GATEB, I_WKV, I_NAQG, I_NAKG, I_RPB, I_POOLW, I_POOLSC, I_XAQG, I_XAKG, I_WB0, I_WB1, I_WB2, I_WOUT, I_FFNG, I_WQ, I_KEYS, I_PU, I_PV };

__device__ __forceinline__ void p0_transpose_item(const float* W, int K, int N, int k0, int n0, bf16* dst, const float* kscale, LAS float* scr, int lane, int dpitch = 0) {
    if (dpitch == 0) dpitch = K;
#pragma unroll 8
    for (int i = 0; i < 32; ++i) { const int kk = 2 * i + (lane >> 5); float v = W[(size_t)(k0 + kk) * N + n0 + (lane & 31)]; if (kscale) v *= kscale[k0 + kk]; scr[kk * 33 + (lane & 31)] = v; }
    LDS_WAIT(); asm volatile("" ::: "memory");
    const int c = lane & 7;
#pragma unroll
    for (int j = 0; j < 4; ++j) { const int n = (lane >> 3) + 8 * j; const LAS float* s = scr + (8 * c) * 33 + n;
        v4u o; o.x = pk2(s[0 * 33], s[1 * 33]); o.y = pk2(s[2 * 33], s[3 * 33]); o.z = pk2(s[4 * 33], s[5 * 33]); o.w = pk2(s[6 * 33], s[7 * 33]);
        *(GAS v4u*)(dst + (size_t)n * dpitch + k0 + 8 * c) = o; }
    LDS_WAIT(); asm volatile("" ::: "memory");
}
__device__ __forceinline__ void cvt_row1024(const float* src, bf16* dst, const float* colscale, float rowscale, int lane) {
    const GAS f32x4* xr = (const GAS f32x4*)src + lane; GAS unsigned long long* o8 = (GAS unsigned long long*)dst + lane;
#pragma unroll
    for (int j = 0; j < 4; ++j) { f32x4 v = xr[64 * j] * rowscale; if (colscale) v = v * ((const GAS f32x4*)colscale)[lane + 64 * j];
        o8[64 * j] = (unsigned long long)pk2(v.x, v.y) | ((unsigned long long)pk2(v.z, v.w) << 32); }
}
__device__ __forceinline__ float row_rstd1024(const float* src, int lane) {
    const GAS f32x4* xr = (const GAS f32x4*)src + lane; float s = 0.f;
#pragma unroll
    for (int j = 0; j < 4; ++j) { const f32x4 v = xr[64 * j]; s += (v.x * v.x + v.y * v.y) + (v.z * v.z + v.w * v.w); }
    return rsqrtf(wave_sum(s) * (1.0f / 1024.0f) + 1e-6f);
}
__device__ __forceinline__ void p0_prologue(Frame& F, const Args& A) {
    LAS float* scr = (LAS float*)(F.lds + RING_OFF + F.wave * 16384);
    const int gw = F.vcu * NWAVES + F.wave, NGW = F.G * NWAVES, lane = F.lane;
    unsigned char* ws = F.ws;
    constexpr int I_IN = 16 * 176, I_KV = 16 * 32, I_BR = 8 * 32, I_OUT = 16 * 32, I_Q = 16 * 64;
    constexpr int NITEMS = I_IN + I_KV + 3 * I_BR + I_OUT + I_Q;
    for (int it = gw; it < NITEMS; it += NGW) {
        int r = it;
        if (r < I_IN) { const int kb = r / 176, nb = r % 176, n0 = 32 * nb; bf16* dst;
            if (n0 >= 1024 && n0 < 1536) dst = (bf16*)(ws + WS_WV) + (size_t)(n0 - 1024) * 1024;
            else { const int np = n0 < 1024 ? n0 : n0 - 512, t = np >> 8, w = np & 255, wc = w >> 6, bj = (w >> 5) & 1; dst = (bf16*)(ws + WS_WIN) + (size_t)(256 * t + 128 * bj + 32 * wc) * 1024; }
            p0_transpose_item(A.in[I_WIN], 1024, 5632, 64 * kb, n0, dst, A.in[I_MIXG], scr, lane); continue; }
        r -= I_IN;
        if (r < I_KV) { const int kb = r / 32, nb = r % 32; p0_transpose_item(A.in[I_WKV], 1024, 1024, 64 * kb, 32 * nb, (bf16*)(ws + WS_WKV) + (size_t)(32 * nb) * 1024, nullptr, scr, lane); continue; }
        r -= I_KV;
        if (r < 3 * I_BR) { const int br = r / I_BR, rr = r % I_BR, kb = rr / 32, nb = rr % 32; const float* W = br == 0 ? A.in[I_WB0] : (br == 1 ? A.in[I_WB1] : A.in[I_WB2]);
            p0_transpose_item(W, 512, 1024, 64 * kb, 32 * nb, (bf16*)(ws + WS_WBR) + (size_t)(32 * nb) * 1536 + br * 512, nullptr, scr, lane, 1536); continue; }
        r -= 3 * I_BR;
        if (r < I_OUT) { const int kb = r / 32, nb = r % 32; p0_transpose_item(A.in[I_WOUT], 1024, 1024, 64 * kb, 32 * nb, (bf16*)(ws + WS_WOUT) + (size_t)(32 * nb) * 1024, nullptr, scr, lane); continue; }
        r -= I_OUT;
        { const int kb = r / 64, nb = r % 64; p0_transpose_item(A.in[I_WQ], 1024, 2048, 64 * kb, 32 * nb, (bf16*)(ws + WS_WQ) + (size_t)(32 * nb) * 1024, A.in[I_FFNG], scr, lane); }
    }
    { bf16* xb = (bf16*)((unsigned char*)F.out + OUT_XB); float* rstdx = (float*)(ws + WS_RSTDX);
      for (int m0 = 4 * gw; m0 < T; m0 += 4 * NGW) {
          f32x4 v[4][4];
#pragma unroll
          for (int r = 0; r < 4; ++r)
#pragma unroll
              for (int j = 0; j < 4; ++j) v[r][j] = ((const GAS f32x4*)(A.in[I_X] + (size_t)(m0 + r) * D))[lane + 64 * j];
#pragma unroll
          for (int r = 0; r < 4; ++r) { float s = 0.f;
#pragma unroll
              for (int j = 0; j < 4; ++j) s += (v[r][j].x * v[r][j].x + v[r][j].y * v[r][j].y) + (v[r][j].z * v[r][j].z + v[r][j].w * v[r][j].w);
              const float rs = rsqrtf(wave_sum(s) * (1.0f / 1024.0f) + 1e-6f);
              GAS unsigned long long* o8 = (GAS unsigned long long*)(xb + (size_t)(m0 + r) * D) + lane;
#pragma unroll
              for (int j = 0; j < 4; ++j) o8[64 * j] = (unsigned long long)pk2(v[r][j].x, v[r][j].y) | ((unsigned long long)pk2(v[r][j].z, v[r][j].w) << 32);
              if (lane == 0) rstdx[m0 + r] = rs; } } }
    for (int m = gw; m < NMEMTOK; m += NGW) { const float* xr = A.in[I_MEM] + (size_t)m * D; const float rs = row_rstd1024(xr, lane); cvt_row1024(xr, (bf16*)(ws + WS_MEMN) + (size_t)m * D, A.in[I_MEMG], rs, lane); }
    for (int mb = 4 * gw; mb < 2 * NEXP; mb += 4 * NGW) {
        const bool isu = mb < NEXP; const int e0 = isu ? mb : mb - NEXP;
        f32x4 v[4][4];
#pragma unroll
        for (int r = 0; r < 4; ++r) { const GAS f32x4* src = (const GAS f32x4*)((isu ? A.in[I_PU] : A.in[I_PV]) + (size_t)(e0 + r) * D) + 4 * lane;
#pragma unroll
            for (int d = 0; d < 4; ++d) v[r][d] = src[d]; }
        f32x4 gv[4];
#pragma unroll
        for (int d = 0; d < 4; ++d) gv[d] = isu ? ((const GAS f32x4*)A.in[I_FFNG])[4 * lane + d] : (f32x4){1.f, 1.f, 1.f, 1.f};
#pragma unroll
        for (int r = 0; r < 4; ++r) { const int e = e0 + r; float mx = 0.f;
#pragma unroll
            for (int d = 0; d < 4; ++d) { v[r][d] = v[r][d] * gv[d]; mx = fmaxf(mx, fmaxf(fmaxf(fabsf(v[r][d].x), fabsf(v[r][d].y)), fmaxf(fabsf(v[r][d].z), fabsf(v[r][d].w)))); }
#pragma unroll
            for (int o = 1; o < 64; o <<= 1) mx = fmaxf(mx, __shfl_xor(mx, o));
            const float inv = mx > 0.f ? 127.0f / mx : 0.f;
            v4u w;
#pragma unroll
            for (int d = 0; d < 4; ++d) { const unsigned b0 = (unsigned)(int)rintf(v[r][d].x * inv) & 0xffu, b1 = (unsigned)(int)rintf(v[r][d].y * inv) & 0xffu,
                                                         b2 = (unsigned)(int)rintf(v[r][d].z * inv) & 0xffu, b3 = (unsigned)(int)rintf(v[r][d].w * inv) & 0xffu;
                w[d] = b0 | (b1 << 8) | (b2 << 16) | (b3 << 24); }
            if (isu) ((GAS v4u*)(ws + WS_U8))[(size_t)e * 64 + lane] = w;
            else *(GAS v4u*)(ws + WS_V8 + (size_t)(lane >> 3) * (2 * MiB) + (size_t)e * 128 + (lane & 7) * 16) = w;
            if (lane == 0) ((float*)(ws + WS_SU))[2 * e + (isu ? 0 : 1)] = mx * (1.0f / 127.0f); }
    }
    for (int m = gw * 64 + lane; m < T; m += NGW * 64) ((float*)(ws + WS_ROWSQ))[m] = 0.f;
    for (int m = gw; m < 256; m += NGW) cvt_row1024(A.in[I_KEYS] + (size_t)m * 1024, (bf16*)(ws + WS_KEYS) + (size_t)m * 1024, nullptr, 1.0f, lane);
    for (int m = gw; m < 1024; m += NGW) { const int gd = m >> 1, c = (m & 1) * 64 + lane, g = gd >> 7, d = gd & 127;
        const float v = A.in[I_POOLW][(size_t)(g * 128 + c) * 128 + d] * A.in[I_POOLSC][gd];
        ((bf16*)(ws + WS_PWT))[(size_t)gd * 128 + c] = (bf16)f2bf(v); }
}

__device__ __forceinline__ void memkv_tile(const bf16* memn, const bf16* wkvT, const float* kg, const float* qg, bf16* kmem, bf16* vtmem, int tile, int lane) {
    const int q = lane & 15, hi = lane >> 4, rg = tile >> 3, cg = tile & 7, r0 = rg * 16, c0 = cg * 128;
    f32x4 acc[8];
#pragma unroll
    for (int i = 0; i < 8; ++i) acc[i] = (f32x4){0.f, 0.f, 0.f, 0.f};
    const bf16* ap = memn + (size_t)(r0 + q) * 1024 + 8 * hi; const bf16* bp = wkvT + (size_t)(c0 + q) * 1024 + 8 * hi;
#pragma unroll 1
    for (int kb = 0; kb < 8; ++kb) {
        bf16x8 a[4], b[4][8];
#pragma unroll
        for (int k4 = 0; k4 < 4; ++k4) { a[k4] = *(const bf16x8*)(ap + 32 * (4 * kb + k4));
#pragma unroll
            for (int nf = 0; nf < 8; ++nf) b[k4][nf] = *(const bf16x8*)(bp + (size_t)(16 * nf) * 1024 + 32 * (4 * kb + k4)); }
        __builtin_amdgcn_sched_barrier(0);
#pragma unroll
        for (int k4 = 0; k4 < 4; ++k4)
#pragma unroll
            for (int nf = 0; nf < 8; ++nf) acc[nf] = mfma16(a[k4], b[k4][nf], acc[nf]);
        __builtin_amdgcn_sched_barrier(0);
    }
    if (cg < 4) {
        float rr[4];
#pragma unroll
        for (int g = 0; g < 4; ++g) { float ss = 0.f;
#pragma unroll
            for (int nf = 0; nf < 8; ++nf) ss += acc[nf][g] * acc[nf][g];
            ss += __shfl_xor(ss, 1); ss += __shfl_xor(ss, 2); ss += __shfl_xor(ss, 4); ss += __shfl_xor(ss, 8);
            rr[g] = rsqrtf(ss * (1.0f / 128.0f) + 1e-6f); }
#pragma unroll
        for (int nf = 0; nf < 8; ++nf) { const int d = 16 * nf + q; const float gs = kg[d] * qg[d];
#pragma unroll
            for (int g = 0; g < 4; ++g) kmem[(size_t)(r0 + 4 * hi + g) * 512 + cg * 128 + d] = (bf16)f2bf(acc[nf][g] * rr[g] * gs); }
    } else {
        const int h = cg - 4, b = r0 >> 8, key0 = (r0 & 255) + 4 * hi;
#pragma unroll
        for (int nf = 0; nf < 8; ++nf) { const int d = 16 * nf + q; v2u w; w.x = pk2(acc[nf][0], acc[nf][1]); w.y = pk2(acc[nf][2], acc[nf][3]);
            *(v2u*)(vtmem + (size_t)(b * 512 + h * 128 + d) * 256 + key0) = w; }
    }
}

__device__ __forceinline__ void na_item(const bf16* __restrict__ qn, const bf16* __restrict__ kn, const bf16* __restrict__ vt, const LAS float* rpl, bf16* __restrict__ yna,
                                        int b, int r, int jb, int h, int lane) {
    const int q = lane & 15, hi = lane >> 4;
    int rs = r - 4; rs = rs < 0 ? 0 : (rs > 120 ? 120 : rs);
    int kb0 = jb * 16 - 8; kb0 = kb0 < 0 ? 0 : (kb0 > 32 ? 32 : kb0);
    const int qcol = jb * 16 + q; int cs = qcol - 8; cs = cs < 0 ? 0 : (cs > 48 ? 48 : cs);
    const size_t tokq = (size_t)b * SEQ + r * 64 + qcol;
    const bf16* qp = qn + tokq * 512 + h * 64 + 8 * hi;
    const bf16x8 qf0 = *(const bf16x8*)qp, qf1 = *(const bf16x8*)(qp + 32);
    const int kq = 8 * (q >> 2) + (q & 3);
    const bf16* kbase = kn + ((size_t)b * SEQ + rs * 64 + kb0 + kq) * 512 + h * 64 + 8 * hi;
    f32x4 s[16];
    {
        bf16x8 ka[16][2];
#pragma unroll
        for (int f = 0; f < 16; ++f) { const bf16* kp = kbase + (size_t)((f >> 1) * 64 + (f & 1) * 4) * 512; ka[f][0] = *(const bf16x8*)kp; ka[f][1] = *(const bf16x8*)(kp + 32); }
        __builtin_amdgcn_sched_barrier(0);
#pragma unroll
        for (int f = 0; f < 16; ++f) { f32x4 z = (f32x4){0.f, 0.f, 0.f, 0.f}; z = mfma16(ka[f][0], qf0, z); s[f] = mfma16(ka[f][1], qf1, z); }
    }
    const bf16* vbase = vt + ((size_t)(b * 512 + h * 64 + q) * SEQ + rs * 64 + kb0 + 8 * hi);
    bf16x8 va[8][4];
#pragma unroll
    for (int st = 0; st < 8; ++st)
#pragma unroll
        for (int mf = 0; mf < 4; ++mf) va[st][mf] = *(const bf16x8*)(vbase + (size_t)(16 * mf) * SEQ + st * 64);
    __builtin_amdgcn_sched_barrier(0);
    float mx = -3.0e38f;
#pragma unroll
    for (int f = 0; f < 16; ++f) {
        const int dr = rs + (f >> 1) - r + 7;
#pragma unroll
        for (int g = 0; g < 4; ++g) {
            const int kcol = kb0 + 8 * hi + 4 * (f & 1) + g;
            const bool ok = (kcol >= cs) && (kcol < cs + 16);
            int dc = kcol - qcol + 15; dc = dc < 0 ? 0 : (dc > 30 ? 30 : dc);
            const float v = ok ? s[f][g] + rpl[dr * 31 + dc] : -1.0e30f;
            s[f][g] = v; mx = fmaxf(mx, v);
        }
    }
    mx = fmaxf(mx, __shfl_xor(mx, 16)); mx = fmaxf(mx, __shfl_xor(mx, 32));
    float sum = 0.f;
#pragma unroll
    for (int f = 0; f < 16; ++f)
#pragma unroll
        for (int g = 0; g < 4; ++g) { const float p = __expf(s[f][g] - mx); s[f][g] = p; sum += p; }
    sum += __shfl_xor(sum, 16); sum += __shfl_xor(sum, 32);
    const float inv = 1.0f / sum;
    f32x4 o[4];
#pragma unroll
    for (int i = 0; i < 4; ++i) o[i] = (f32x4){0.f, 0.f, 0.f, 0.f};
#pragma unroll
    for (int st = 0; st < 8; ++st) {
        const bf16x8 pb = __builtin_bit_cast(bf16x8, pg8::pack8(s[2 * st], s[2 * st + 1]));
#pragma unroll
        for (int mf = 0; mf < 4; ++mf) o[mf] = mfma16(va[st][mf], pb, o[mf]);
    }
    bf16* yp = yna + tokq * 1536 + h * 64 + 4 * hi;
#pragma unroll
    for (int mf = 0; mf < 4; ++mf) { v2u w; w.x = pk2(o[mf][0] * inv, o[mf][1] * inv); w.y = pk2(o[mf][2] * inv, o[mf][3] * inv); *(v2u*)(yp + 16 * mf) = w; }
}
__device__ __forceinline__ void xa_fill_lds(const bf16* __restrict__ kmem, const bf16* __restrict__ vtmem, LAS unsigned char* lds, int b, int h, int tid) {
#pragma unroll
    for (int ps = 0; ps < 8; ++ps) { const int id = tid + 512 * ps, key = id >> 4, c = id & 15;
        *(LAS v4u*)(lds + key * 256 + ((c ^ (key & 15)) << 4)) = *(const v4u*)(kmem + ((size_t)b * 256 + key) * 512 + h * 128 + 8 * c); }
#pragma unroll
    for (int ps = 0; ps < 8; ++ps) { const int id = tid + 512 * ps, dim = id >> 5, c = id & 31;
        *(LAS v4u*)(lds + 65536 + dim * 512 + ((c ^ (dim & 15)) << 4)) = *(const v4u*)(vtmem + (size_t)(b * 512 + h * 128 + dim) * 256 + 8 * c); }
}
__device__ __forceinline__ void xa_item(const bf16* __restrict__ xq, const LAS unsigned char* lds, bf16* __restrict__ yxa, int tok0, int h, int lane) {
    const int q = lane & 15, hi = lane >> 4; const size_t tok = (size_t)tok0 + q;
    const bf16* qp = xq + tok * 512 + h * 128 + 8 * hi;
    bf16x8 qf[4]; float ssq = 0.f;
#pragma unroll
    for (int ks = 0; ks < 4; ++ks) qf[ks] = *(const bf16x8*)(qp + 32 * ks);
    __builtin_amdgcn_sched_barrier(0);
#pragma unroll
    for (int ks = 0; ks < 4; ++ks)
#pragma unroll
        for (int j = 0; j < 8; ++j) { const float v = bf1(qf[ks][j]); ssq += v * v; }
    ssq += __shfl_xor(ssq, 16); ssq += __shfl_xor(ssq, 32);
    const float cexp = rsqrtf(ssq * (1.0f / 128.0f) + 1e-6f) * 0.08838834764831845f * 1.4426950408889634f;
    const int kq = 8 * (q >> 2) + (q & 3);
    f32x4 s[16];
#pragma unroll
    for (int f = 0; f < 16; ++f) { const int key = 32 * (f >> 1) + 4 * (f & 1) + kq; const LAS unsigned char* kr = lds + key * 256; f32x4 z = (f32x4){0.f, 0.f, 0.f, 0.f};
#pragma unroll
        for (int ks = 0; ks < 4; ++ks) z = mfma16(*(const LAS bf16x8*)(kr + (((4 * ks + hi) ^ (key & 15)) << 4)), qf[ks], z);
        s[f] = z; }
    float mx = -3.0e38f;
#pragma unroll
    for (int f = 0; f < 16; ++f)
#pragma unroll
        for (int g = 0; g < 4; ++g) mx = fmaxf(mx, s[f][g]);
    mx = fmaxf(mx, __shfl_xor(mx, 16)); mx = fmaxf(mx, __shfl_xor(mx, 32));
    float sum = 0.f;
#pragma unroll
    for (int f = 0; f < 16; ++f)
#pragma unroll
        for (int g = 0; g < 4; ++g) { const float p = __builtin_amdgcn_exp2f((s[f][g] - mx) * cexp); s[f][g] = p; sum += p; }
    sum += __shfl_xor(sum, 16); sum += __shfl_xor(sum, 32);
    const float inv = 1.0f / sum;
    f32x4 o[8];
#pragma unroll
    for (int i = 0; i < 8; ++i) o[i] = (f32x4){0.f, 0.f, 0.f, 0.f};
#pragma unroll
    for (int st = 0; st < 8; ++st) {
        const bf16x8 pb = __builtin_bit_cast(bf16x8, pg8::pack8(s[2 * st], s[2 * st + 1]));
#pragma unroll
        for (int mf = 0; mf < 8; ++mf) { const int dim = 16 * mf + q; o[mf] = mfma16(*(const LAS bf16x8*)(lds + 65536 + dim * 512 + (((4 * st + hi) ^ (dim & 15)) << 4)), pb, o[mf]); }
    }
    bf16* yp = yxa + tok * 1536 + h * 128 + 4 * hi;
#pragma unroll
    for (int mf = 0; mf < 8; ++mf) { v2u w; w.x = pk2(o[mf][0] * inv, o[mf][1] * inv); w.y = pk2(o[mf][2] * inv, o[mf][3] * inv); *(v2u*)(yp + 16 * mf) = w; }
}
__device__ __forceinline__ void pool_wg(const bf16* __restrict__ pp, const bf16* __restrict__ pwT, bf16* __restrict__ ypool, LAS unsigned char* lds, int tokbase, int wave, int lane) {
    const int q = lane & 15, hi = lane >> 4;
    __syncthreads();
    {
        const int hw = 1 << hi, tw0 = tokbase + 16 * wave, b = tw0 >> 13, t0 = tw0 & 8191;
        const bf16* base = pp + (size_t)b * SEQ * 512 + 8 * lane;
        float s[8];
#pragma unroll
        for (int j = 0; j < 8; ++j) s[j] = 0.f;
#pragma unroll 4
        for (int d = -8; d < 8; ++d) { const int u = t0 + d; const bool ok = (d >= -hw) && (d < hw) && (u >= 0) && (u < SEQ);
            const bf16x8 v = *(const bf16x8*)(base + (size_t)(ok ? u : t0) * 512);
#pragma unroll
            for (int j = 0; j < 8; ++j) s[j] += ok ? bf1(v[j]) : 0.f; }
        LAS unsigned char* tile = lds + wave * 16384;
#pragma unroll 4
        for (int i = 0; i < 16; ++i) { const int t = t0 + i;
            int lo = t - hw; lo = lo < 0 ? 0 : lo; int ht = t + hw; ht = ht > SEQ ? SEQ : ht;
            const float inv = 1.0f / (float)(ht - lo);
            const bool oka = (t + hw) < SEQ, oks = (t - hw) >= 0;
            const bf16x8 sv = *(const bf16x8*)(base + (size_t)t * 512), av = *(const bf16x8*)(base + (size_t)(oka ? t + hw : t) * 512), bv = *(const bf16x8*)(base + (size_t)(oks ? t - hw : t) * 512);
            f32x4 p0, p1;
#pragma unroll
            for (int j = 0; j < 4; ++j) { p0[j] = s[j] * inv - bf1(sv[j]); p1[j] = s[j + 4] * inv - bf1(sv[j + 4]); }
            *(LAS v4u*)(tile + i * 1024 + ((lane ^ (i & 15)) << 4)) = pg8::pack8(p0, p1);
#pragma unroll
            for (int j = 0; j < 8; ++j) s[j] += (oka ? bf1(av[j]) : 0.f) - (oks ? bf1(bv[j]) : 0.f);
        }
    }
    __syncthreads();
#pragma unroll 1
    for (int k = 0; k < 4; ++k) {
        const int pair = wave * 4 + k, g = pair >> 3, mf = pair & 7;
        const bf16* wb = pwT + (size_t)(g * 128 + 16 * mf + q) * 128 + 8 * hi;
        bf16x8 a[4];
#pragma unroll
        for (int ks = 0; ks < 4; ++ks) a[ks] = *(const bf16x8*)(wb + 32 * ks);
#pragma unroll 2
        for (int tg = 0; tg < 8; ++tg) {
            const LAS unsigned char* trow = lds + tg * 16384 + q * 1024; f32x4 o = (f32x4){0.f, 0.f, 0.f, 0.f};
#pragma unroll
            for (int ks = 0; ks < 4; ++ks) { const int c = g * 16 + 4 * ks + hi; o = mfma16(a[ks], *(const LAS bf16x8*)(trow + ((c ^ q) << 4)), o); }
            v2u w; w.x = pk2(o[0], o[1]); w.y = pk2(o[2], o[3]);
            *(v2u*)(ypool + (size_t)(tokbase + 16 * tg + q) * 1536 + g * 128 + 16 * mf + 4 * hi) = w;
        }
    }
    __syncthreads();
}

__device__ __forceinline__ int f2key(float s, int idx, int mask) { int b = __builtin_bit_cast(int, s); b = b >= 0 ? b : (b ^ 0x7fffffff); return (b & ~mask) | idx; }
__device__ __forceinline__ float key2f(int k) { k = k >= 0 ? k : (k ^ 0x7fffffff); return __builtin_bit_cast(float, k); }
#define CE_DESC(x, y) do { const int _h = (x) > (y) ? (x) : (y), _l = (x) > (y) ? (y) : (x); (x) = _h; (y) = _l; } while (0)
__device__ __forceinline__ void sort16(int (&a)[16]) {
#pragma unroll
    for (int ks = 1; ks <= 4; ++ks)
#pragma unroll
        for (int js = ks - 1; js >= 0; --js)
#pragma unroll
            for (int i = 0; i < 16; ++i) { const int k = 1 << ks, j = 1 << js, l = i ^ j;
                if (l > i) { if ((i & k) == 0) CE_DESC(a[i], a[l]); else CE_DESC(a[l], a[i]); } }
}
__device__ __forceinline__ void merge16(int (&a)[16], const int (&b)[16]) {
#pragma unroll
    for (int i = 0; i < 16; ++i) a[i] = a[i] > b[15 - i] ? a[i] : b[15 - i];
#pragma unroll
    for (int js = 3; js >= 0; --js)
#pragma unroll
        for (int i = 0; i < 16; ++i) { const int j = 1 << js, l = i ^ j; if (l > i) CE_DESC(a[i], a[l]); }
}
__device__ __forceinline__ void merge16_lanes(int (&a)[16], int step) { int o[16];
#pragma unroll
    for (int k = 0; k < 16; ++k) o[k] = __shfl_xor(a[k], step);
    merge16(a, o); }
__device__ constexpr int cand_i(int hi, int m) {
    return hi == 0 ? 0
         : hi == 1 ? (m < 8 ? 1 : (m < 13 ? 2 : -1))
         : hi == 2 ? (m < 4 ? 3 : (m < 7 ? 4 : (m < 9 ? 5 : (m < 11 ? 6 : -1))))
         :           (m < 2 ? 7 : (m < 10 ? 8 + (m - 2) : -1));
}
__device__ constexpr int cand_j(int hi, int m) {
    return hi == 0 ? m
         : hi == 1 ? (m < 8 ? m : (m < 13 ? m - 8 : -1))
         : hi == 2 ? (m < 4 ? m : (m < 7 ? m - 4 : (m < 9 ? m - 7 : (m < 11 ? m - 9 : -1))))
         :           (m < 2 ? m : (m < 10 ? 0 : -1));
}
__device__ __forceinline__ void topk_fill_lds(const bf16* __restrict__ keys, LAS unsigned char* lds, int h, int tid) {
#pragma unroll
    for (int ps = 0; ps < 8; ++ps) { const int id = tid + 512 * ps, row = id >> 4, c = id & 15;
        *(LAS v4u*)(lds + row * 256 + ((c ^ (row & 15)) << 4)) = *(const v4u*)(keys + ((size_t)h * 256 + row) * 128 + 8 * c); }
}
struct TopkQ { bf16x8 q[2][4]; };
__device__ __forceinline__ void topk_loadq(TopkQ& Q, const bf16* __restrict__ qb, int tok0, int h, int lane) {
    const size_t tok = (size_t)tok0 + (lane & 15); const int hi = lane >> 4;
#pragma unroll
    for (int p = 0; p < 2; ++p)
#pragma unroll
        for (int ks = 0; ks < 4; ++ks) Q.q[p][ks] = *(const bf16x8*)(qb + tok * 2048 + h * 256 + p * 128 + 32 * ks + 8 * hi);
}
__device__ __forceinline__ void topk_item(const TopkQ& Q, const LAS unsigned char* klds, int* __restrict__ te, float* __restrict__ tw, LAS int* lscr, int tok0, int h, int lane) {
    const int q = lane & 15, hi = lane >> 4; const size_t tok = (size_t)tok0 + q;
    int L[2][16];
#pragma unroll
    for (int p = 0; p < 2; ++p) {
        int B[16];
#pragma unroll
        for (int mf = 0; mf < 8; ++mf) { f32x4 s = (f32x4){0.f, 0.f, 0.f, 0.f}; const int row = p * 128 + 16 * mf + q;
#pragma unroll
            for (int ks = 0; ks < 4; ++ks) s = mfma16(*(const LAS bf16x8*)(klds + row * 256 + (((4 * ks + hi) ^ (row & 15)) << 4)), Q.q[p][ks], s);
#pragma unroll
            for (int g = 0; g < 4; ++g) { const int key = f2key(s[g], 16 * mf + 4 * hi + g, 127); if (mf < 4) L[p][4 * mf + g] = key; else B[4 * (mf - 4) + g] = key; } }
        sort16(L[p]); sort16(B); merge16(L[p], B);
        merge16_lanes(L[p], 16); merge16_lanes(L[p], 32);
    }
    float v1[16], v2[16];
#pragma unroll
    for (int k = 0; k < 16; ++k) { v1[k] = key2f(L[0][k]); v2[k] = key2f(L[1][k]); }
    int Fk[16];
#pragma unroll
    for (int m = 0; m < 16; ++m) {
        float sm = v1[0] + v2[m]; int id = 255 - m;
        if (cand_i(1, m) >= 0) { if (hi == 1) { sm = v1[cand_i(1, m) < 0 ? 0 : cand_i(1, m)] + v2[cand_j(1, m) < 0 ? 0 : cand_j(1, m)]; id = 255 - ((cand_i(1, m) << 4) | cand_j(1, m)); } }
        if (cand_i(2, m) >= 0) { if (hi == 2) { sm = v1[cand_i(2, m) < 0 ? 0 : cand_i(2, m)] + v2[cand_j(2, m) < 0 ? 0 : cand_j(2, m)]; id = 255 - ((cand_i(2, m) << 4) | cand_j(2, m)); } }
        if (cand_i(3, m) >= 0) { if (hi == 3) { sm = v1[cand_i(3, m) < 0 ? 0 : cand_i(3, m)] + v2[cand_j(3, m) < 0 ? 0 : cand_j(3, m)]; id = 255 - ((cand_i(3, m) << 4) | cand_j(3, m)); } }
        int key = f2key(sm, id, 255);
        if ((hi == 1 && cand_i(1, m) < 0) || (hi == 2 && cand_i(2, m) < 0) || (hi == 3 && cand_i(3, m) < 0)) key = (int)0x80000000;
        Fk[m] = key;
    }
    sort16(Fk); merge16_lanes(Fk, 16); merge16_lanes(Fk, 32);
    LAS int* my = lscr + lane * 32;
#pragma unroll
    for (int k = 0; k < 16; ++k) { my[k] = L[0][k] & 127; my[16 + k] = L[1][k] & 127; }
    LDS_WAIT(); asm volatile("" ::: "memory");
    float e[16]; float sum = 0.f; const float mx = key2f(Fk[0]);
#pragma unroll
    for (int k = 0; k < 16; ++k) { e[k] = __expf(key2f(Fk[k]) - mx); sum += e[k]; }
    const float inv = 1.0f / sum;
    if (hi == 0) {
        int* tep = te + tok * 128; float* twp = tw + tok * 128;
#pragma unroll
        for (int kk = 0; kk < 16; ++kk) { const int ij = 255 - (Fk[kk] & 255), i = ij >> 4, j = ij & 15, slot = (kk & 7) * 16 + 2 * h + (kk >> 3);
            tep[slot] = my[i] * 128 + my[16 + j]; twp[slot] = e[kk] * inv; }
    }
    LDS_WAIT(); asm volatile("" ::: "memory");
}

__device__ __forceinline__ float ub2f(unsigned v, int b) { return (float)((v >> (8 * b)) & 0xffu); }
struct HqIn { v4u hA, hB; float rsq; };
__device__ __forceinline__ void hq_load(HqIn& in, const bf16* __restrict__ hb, const float* __restrict__ rowsq, int tok, int lane) {
    const bf16* hp = hb + (size_t)tok * 1024 + 16 * lane; in.hA = *(const v4u*)hp; in.hB = *(const v4u*)(hp + 8); in.rsq = rowsq[tok]; }
__device__ __forceinline__ void hq_token(const HqIn& in, unsigned char* __restrict__ hq, float* __restrict__ hs, int tok, int lane) {
    const v4u hA = in.hA, hB = in.hB;
    float hf[16];
#pragma unroll
    for (int d = 0; d < 4; ++d) { hf[2 * d] = bflo(hA[d]); hf[2 * d + 1] = bfhi(hA[d]); hf[8 + 2 * d] = bflo(hB[d]); hf[8 + 2 * d + 1] = bfhi(hB[d]); }
    float amax = 0.f;
#pragma unroll
    for (int j = 0; j < 16; ++j) amax = fmaxf(amax, fabsf(hf[j]));
#pragma unroll
    for (int o = 1; o < 64; o <<= 1) amax = fmaxf(amax, __shfl_xor(amax, o));
    const float hinv = amax > 0.f ? 127.0f / amax : 0.f;
    v4u w;
#pragma unroll
    for (int d = 0; d < 4; ++d) { const unsigned b0 = (unsigned)(int)rintf(hf[4 * d] * hinv) & 0xffu, b1 = (unsigned)(int)rintf(hf[4 * d + 1] * hinv) & 0xffu,
                                                 b2 = (unsigned)(int)rintf(hf[4 * d + 2] * hinv) & 0xffu, b3 = (unsigned)(int)rintf(hf[4 * d + 3] * hinv) & 0xffu;
        w[d] = b0 | (b1 << 8) | (b2 << 16) | (b3 << 24); }
    *(v4u*)(hq + (size_t)tok * 1024 + 16 * lane) = w;
    if (lane == 0) hs[tok] = rsqrtf(in.rsq * (1.0f / 1024.0f) + 1e-6f) * amax * (1.0f / 127.0f);
}
constexpr int PA_SLOTS = 12;
struct PeerA1 { int e; float g; };
struct PeerA2 { v4u ur[3][4]; v4u hv[4]; float hsc, su, sv; int cnt, rk; bool m; unsigned long long rem; };
__device__ __forceinline__ void pa_s1(PeerA1& a, const int* __restrict__ te, const float* __restrict__ tw, int tok, int half, int lane) {
    a.e = te[(size_t)tok * 128 + 64 * half + lane]; a.g = tw[(size_t)tok * 128 + 64 * half + lane]; }
__device__ __forceinline__ void pa_s2(PeerA2& b, const PeerA1& a, const unsigned char* __restrict__ hq, const float* __restrict__ hs, const unsigned char* __restrict__ u8,
                                      const float* __restrict__ su, const float* __restrict__ sv, LAS int* lst, int tok, int x, int lane, int hot) {
    b.m = (a.e >> 11) == x;
    const unsigned long long mask = __ballot(b.m);
    b.cnt = __popcll(mask); b.rk = (int)__builtin_amdgcn_mbcnt_hi((unsigned)(mask >> 32), __builtin_amdgcn_mbcnt_lo((unsigned)mask, 0u));
    if (b.m && b.rk < PA_SLOTS) lst[b.rk] = a.e;
    b.rem = 0ull; if (b.cnt > PA_SLOTS) { unsigned long long r = mask;
#pragma unroll
        for (int k = 0; k < PA_SLOTS; ++k) r &= r - 1ull;
        b.rem = r; }
    { typedef float f32x2s __attribute__((ext_vector_type(2))); f32x2s s2 = (f32x2s){0.f, 0.f}; if (b.m) s2 = ((const f32x2s*)su)[a.e]; b.su = s2.x; b.sv = s2.y; }
    const int r = lane >> 4, t = lane & 15;
#pragma unroll
    for (int i = 0; i < 4; ++i) b.hv[i] = *(const v4u*)(hq + (size_t)tok * 1024 + 16 * t + 256 * i);
    b.hsc = hs[tok];
    LDS_WAIT(); asm volatile("" ::: "memory");
    const int lim = b.cnt < PA_SLOTS ? b.cnt : PA_SLOTS;
#pragma unroll
    for (int q = 0; q < 3; ++q) { const int slot = 4 * q + r;
#pragma unroll
        for (int i = 0; i < 4; ++i) b.ur[q][i] = (v4u){0u, 0u, 0u, 0u};
        if (slot < lim) { int e = lst[slot]; if (hot) e = (x << 11) | (e & 255); const unsigned char* rp = u8 + (size_t)e * 1024 + 16 * t;
#pragma unroll
            for (int i = 0; i < 4; ++i) b.ur[q][i] = *(const v4u*)(rp + 256 * i); } }
    (void)sv;
}
__device__ __forceinline__ int dot16(const v4u u, const v4u h) { int d = __builtin_amdgcn_sdot4((int)u.x, (int)h.x, 0, false); d = __builtin_amdgcn_sdot4((int)u.y, (int)h.y, d, false);
    d = __builtin_amdgcn_sdot4((int)u.z, (int)h.z, d, false); return __builtin_amdgcn_sdot4((int)u.w, (int)h.w, d, false); }
template <int CTRL, int RM> __device__ __forceinline__ int dpp_i(int x) { return __builtin_amdgcn_update_dpp(0, x, CTRL, RM, 0xf, false); }
__device__ __forceinline__ int wave_sum_to63(int x) { x += dpp_i<0xb1, 0xf>(x); x += dpp_i<0x4e, 0xf>(x); x += dpp_i<0x124, 0xf>(x); x += dpp_i<0x128, 0xf>(x); x += dpp_i<0x142, 0xa>(x); x += dpp_i<0x143, 0xc>(x); return x; }
__device__ __forceinline__ int row_sum16(int x) { x += dpp_i<0xb1, 0xf>(x); x += dpp_i<0x4e, 0xf>(x); x += dpp_i<0x124, 0xf>(x); x += dpp_i<0x128, 0xf>(x); return x; }
__device__ __forceinline__ float gelu_erf(float v) {
    const float av = fabsf(v), t = __builtin_amdgcn_rcpf(av * 0.2316418882f + 1.0f);
    float q = t * 0.5307027145f + (-0.7265760135f); q = q * t + 0.7107068705f; q = q * t + (-0.142248368f); q = q * t + 0.127414796f; q = q * t;
    const float e = __builtin_amdgcn_exp2f((v * v) * (-0.72134752044f)), m = v * (q * e);
    return v < 0.f ? m : v - m; }
__device__ __forceinline__ void pa_s3(const PeerA2& b, const PeerA1& a, const unsigned char* __restrict__ u8, const unsigned char* __restrict__ hq, float* __restrict__ aw, int tok, int half, int lane) {
    int mine = 0;
#pragma unroll
    for (int q = 0; q < 3; ++q) { int d = dot16(b.ur[q][0], b.hv[0]); d += dot16(b.ur[q][1], b.hv[1]); d += dot16(b.ur[q][2], b.hv[2]); d += dot16(b.ur[q][3], b.hv[3]);
        d = row_sum16(d);
#pragma unroll
        for (int r = 0; r < 4; ++r) { const int s = __builtin_amdgcn_readlane(d, 16 * r); mine = (b.rk == 4 * q + r) ? s : mine; } }
    float* awp = aw + (size_t)tok * 128 + 64 * half + lane;
    if (b.m && b.rk < PA_SLOTS) *awp = a.g * gelu_erf((float)mine * b.hsc * b.su) * b.sv;
    if (b.cnt > PA_SLOTS) {
        unsigned long long rem = b.rem; const v4u hw = *(const v4u*)(hq + (size_t)tok * 1024 + 16 * lane);
        while (rem != 0ull) { const int idx = __builtin_ctzll(rem); rem &= rem - 1ull; const int e = __builtin_amdgcn_readlane(a.e, idx);
            const int d = __builtin_amdgcn_readlane(wave_sum_to63(dot16(*(const v4u*)(u8 + (size_t)e * 1024 + 16 * lane), hw)), 63);
            if (lane == idx) *awp = a.g * gelu_erf((float)d * b.hsc * b.su) * b.sv; }
    }
}
__device__ __forceinline__ void peer_a_run(const unsigned char* __restrict__ hq, const float* __restrict__ hs, const unsigned char* __restrict__ u8, const float* __restrict__ su,
                                           const float* __restrict__ sv, const int* __restrict__ te, const float* __restrict__ tw, float* __restrict__ aw, LAS int* lst, int wrank, int wstep, int x, int lane, int hot = 0) {
    const int ntok = wrank < T ? (T - wrank + wstep - 1) / wstep : 0, N = 2 * ntok;
#define PA_TOK(n) (wrank + ((n) >> 1) * wstep)
    if (N == 0) return;
    PeerA1 a0, a1, a2; PeerA2 bA, bB;
    pa_s1(a0, te, tw, PA_TOK(0), 0, lane); pa_s1(a1, te, tw, PA_TOK(1), 1, lane);
    pa_s2(bA, a0, hq, hs, u8, su, sv, lst, PA_TOK(0), x, lane, hot);
#define PA_STEP(n, Bcur, Bnext, Acur, Anext, Anew) do { \
        if ((n) + 1 < N) pa_s2(Bnext, Anext, hq, hs, u8, su, sv, lst, PA_TOK((n) + 1), x, lane, hot); \
        if ((n) + 2 < N) pa_s1(Anew, te, tw, PA_TOK((n) + 2), ((n) + 2) & 1, lane); \
        pa_s3(Bcur, Acur, u8, hq, aw, PA_TOK(n), (n) & 1, lane); } while (0)
    for (int n = 0; n < N; n += 6) {
        PA_STEP(n, bA, bB, a0, a1, a2);
        if (n + 1 < N) PA_STEP(n + 1, bB, bA, a1, a2, a0);
        if (n + 2 < N) PA_STEP(n + 2, bA, bB, a2, a0, a1);
        if (n + 3 < N) PA_STEP(n + 3, bB, bA, a0, a1, a2);
        if (n + 4 < N) PA_STEP(n + 4, bA, bB, a1, a2, a0);
        if (n + 5 < N) PA_STEP(n + 5, bB, bA, a2, a0, a1);
    }
#undef PA_STEP
#undef PA_TOK
}
struct PeerB1 { v4u e[4]; f32x4 w[4]; };
struct PeerB2 { v4u vr[8]; };
struct PeerBAcc { int acc[16]; int wq[4]; float wsc, h0, h1; };
typedef float f32x2v __attribute__((ext_vector_type(2)));
__device__ __forceinline__ void pb_s1(PeerB1& a, const int* __restrict__ te, const float* __restrict__ aw, int tok, int lane) {
    const v4u* ep = (const v4u*)(te + (size_t)tok * 128 + 16 * (lane >> 3)); const f32x4* wp = (const f32x4*)(aw + (size_t)tok * 128 + 16 * (lane >> 3));
#pragma unroll
    for (int j = 0; j < 4; ++j) { a.e[j] = ep[j]; a.w[j] = wp[j]; } }
__device__ __forceinline__ int pb_col(int lane) { return 16 * (lane & 7) + 8 * ((lane >> 5) & 1) + 4 * ((lane >> 4) & 1) + 2 * ((lane >> 3) & 1); }
template <int CTRL, int RM> __device__ __forceinline__ float dpp_f(float x) { return __builtin_bit_cast(float, __builtin_amdgcn_update_dpp(0, __builtin_bit_cast(int, x), CTRL, RM, 0xf, false)); }
__device__ __forceinline__ void pb_quant(PeerBAcc& A, const PeerB1& a) {
    float mx = 0.f;
#pragma unroll
    for (int j = 0; j < 4; ++j) mx = fmaxf(mx, fmaxf(fmaxf(fabsf(a.w[j][0]), fabsf(a.w[j][1])), fmaxf(fabsf(a.w[j][2]), fabsf(a.w[j][3]))));
    mx = fmaxf(mx, dpp_f<0xb1, 0xf>(mx)); mx = fmaxf(mx, dpp_f<0x4e, 0xf>(mx)); mx = fmaxf(mx, dpp_f<0x124, 0xf>(mx)); mx = fmaxf(mx, dpp_f<0x128, 0xf>(mx));
    mx = fmaxf(mx, dpp_f<0x142, 0xa>(mx)); mx = fmaxf(mx, dpp_f<0x143, 0xc>(mx));
    mx = __builtin_bit_cast(float, __builtin_amdgcn_readlane(__builtin_bit_cast(int, mx), 63));
    const float inv = mx > 0.f ? 127.0f / mx : 0.f; A.wsc = mx * (1.0f / 127.0f);
#pragma unroll
    for (int j = 0; j < 4; ++j) A.wq[j] = (int)(((unsigned)(int)rintf(a.w[j][0] * inv) & 0xffu) | (((unsigned)(int)rintf(a.w[j][1] * inv) & 0xffu) << 8) |
                                               (((unsigned)(int)rintf(a.w[j][2] * inv) & 0xffu) << 16) | (((unsigned)(int)rintf(a.w[j][3] * inv) & 0xffu) << 24));
}
template <int HF> __device__ __forceinline__ void pb_s2(PeerB2& b, const PeerB1& a, const unsigned char* __restrict__ v8x, int lane, int hot = 0) {
    const int c = lane & 7;
#pragma unroll
    for (int m = 0; m < 8; ++m) { unsigned e = a.e[2 * HF + (m >> 2)][m & 3]; if (hot) e &= 255u; b.vr[m] = *(const v4u*)(v8x + (size_t)e * 128 + 16 * c); }
}
__device__ __forceinline__ float swap32_add(float lo, float hi) { const auto r = __builtin_amdgcn_permlane32_swap(__builtin_bit_cast(unsigned, lo), __builtin_bit_cast(unsigned, hi), false, false);
    return __builtin_bit_cast(float, r[0]) + __builtin_bit_cast(float, r[1]); }
__device__ __forceinline__ float swap16_add(float lo, float hi) { const auto r = __builtin_amdgcn_permlane16_swap(__builtin_bit_cast(unsigned, lo), __builtin_bit_cast(unsigned, hi), false, false);
    return __builtin_bit_cast(float, r[0]) + __builtin_bit_cast(float, r[1]); }
template <int HF> __device__ __forceinline__ void pb_s3(PeerBAcc& A, const PeerB2& b, const PeerB1& a, float* out, int tok, int x, int lane) {
    if (HF == 0) {
#pragma unroll
        for (int j = 0; j < 16; ++j) A.acc[j] = 0;
    }
#pragma unroll
    for (int gg = 0; gg < 2; ++gg)
#pragma unroll
        for (int d = 0; d < 4; ++d) { const unsigned ra = b.vr[4 * gg][d], rb = b.vr[4 * gg + 1][d], rc = b.vr[4 * gg + 2][d], rd = b.vr[4 * gg + 3][d];
            const unsigned t0 = __builtin_amdgcn_perm(rb, ra, 0x05010400u), t1 = __builtin_amdgcn_perm(rb, ra, 0x07030602u), t2 = __builtin_amdgcn_perm(rd, rc, 0x05010400u), t3 = __builtin_amdgcn_perm(rd, rc, 0x07030602u);
            const unsigned c0 = __builtin_amdgcn_perm(t2, t0, 0x05040100u), c1 = __builtin_amdgcn_perm(t2, t0, 0x07060302u), c2 = __builtin_amdgcn_perm(t3, t1, 0x05040100u), c3 = __builtin_amdgcn_perm(t3, t1, 0x07060302u);
            const int w4 = A.wq[2 * HF + gg];
            A.acc[4 * d] = __builtin_amdgcn_sdot4((int)c0, w4, A.acc[4 * d], false); A.acc[4 * d + 1] = __builtin_amdgcn_sdot4((int)c1, w4, A.acc[4 * d + 1], false);
            A.acc[4 * d + 2] = __builtin_amdgcn_sdot4((int)c2, w4, A.acc[4 * d + 2], false); A.acc[4 * d + 3] = __builtin_amdgcn_sdot4((int)c3, w4, A.acc[4 * d + 3], false); }
    if (HF == 1) {
        int r8[8], r4[4], r2[2];
#pragma unroll
        for (int j = 0; j < 8; ++j) { const bool up = (lane & 32) != 0; const int keep = up ? A.acc[j + 8] : A.acc[j], send = up ? A.acc[j] : A.acc[j + 8]; r8[j] = keep + __shfl_xor(send, 32); }
#pragma unroll
        for (int j = 0; j < 4; ++j) { const bool up = (lane & 16) != 0; const int keep = up ? r8[j + 4] : r8[j], send = up ? r8[j] : r8[j + 4]; r4[j] = keep + __shfl_xor(send, 16); }
#pragma unroll
        for (int j = 0; j < 2; ++j) { const bool up = (lane & 8) != 0; const int keep = up ? r4[j + 2] : r4[j], send = up ? r4[j] : r4[j + 2];
            r2[j] = keep + __builtin_amdgcn_update_dpp(0, send, 0x128, 0xf, 0xf, false); }
        f32x2v h2; h2.x = A.h0 + A.wsc * (float)r2[0]; h2.y = A.h1 + A.wsc * (float)r2[1];
        *(f32x2v*)(out + (size_t)tok * 1024 + 128 * x + pb_col(lane)) = h2;
    }
}
__device__ __forceinline__ void peer_b_run(const unsigned char* __restrict__ v8x, const int* __restrict__ te, const float* __restrict__ aw, const bf16* __restrict__ hb, float* out, int wrank, int wstep, int x, int lane, int hot = 0) {
    const int N = wrank < T ? (T - wrank + wstep - 1) / wstep : 0;
#define PB_TOK(n) (wrank + (n) * wstep)
#define PB_LOADH(n) do { const unsigned h2_ = *(const unsigned*)(hb + (size_t)PB_TOK(n) * 1024 + 128 * x + pb_col(lane)); A.h0 = bflo(h2_); A.h1 = bfhi(h2_); } while (0)
    if (N == 0) return;
    PeerB1 s0, s1; PeerB2 bA, bB; PeerBAcc A;
    pb_s1(s0, te, aw, PB_TOK(0), lane); if (N > 1) pb_s1(s1, te, aw, PB_TOK(1), lane);
    pb_s2<0>(bA, s0, v8x, lane, hot);
    for (int n = 0; n < N; n += 2) {
        pb_s2<1>(bB, s0, v8x, lane, hot); PB_LOADH(n); pb_quant(A, s0);
        pb_s3<0>(A, bA, s0, out, PB_TOK(n), x, lane);
        if (n + 1 < N) pb_s2<0>(bA, s1, v8x, lane, hot);
        pb_s3<1>(A, bB, s0, out, PB_TOK(n), x, lane);
        if (n + 2 < N) pb_s1(s0, te, aw, PB_TOK(n + 2), lane);
        if (n + 1 < N) {
            pb_s2<1>(bB, s1, v8x, lane, hot); PB_LOADH(n + 1); pb_quant(A, s1);
            pb_s3<0>(A, bA, s1, out, PB_TOK(n + 1), x, lane);
            if (n + 2 < N) pb_s2<0>(bA, s0, v8x, lane, hot);
            pb_s3<1>(A, bB, s1, out, PB_TOK(n + 1), x, lane);
            if (n + 3 < N) pb_s1(s1, te, aw, PB_TOK(n + 3), lane);
        }
    }
#undef PB_LOADH
#undef PB_TOK
}

__global__ void __launch_bounds__(NWAVES * 64, 2) mk_fwd(Args args) {
    extern __shared__ __attribute__((aligned(16))) unsigned char lds[];
    Frame F;
    F.lds = (LAS unsigned char*)lds;
    F.MISC = (volatile LAS unsigned*)(F.lds + MISC_OFF);
    F.tid = threadIdx.x; F.lane = F.tid & 63; F.wave = __builtin_amdgcn_readfirstlane(F.tid >> 6);
    F.G = gridDim.x; { const int bx = blockIdx.x; F.vcu = (F.G % 8 == 0) ? (bx % 8) * (F.G / 8) + bx / 8 : bx; }
    F.out = args.out; F.ws = args.ws;
    unsigned char* ws = args.ws;
    F.ctl = (gu32*)(ws + WS_CTL);
    for (int u = F.tid; u < (LDS_BYTES - LDSCTL_OFF) / 4; u += NWAVES * 64) ((LAS unsigned*)(F.lds + LDSCTL_OFF))[u] = 0u;
    __syncthreads();
    XcdBarrier bar; bar.bar = (unsigned*)(F.ctl + CW_BAR); bar.x = 0; bar.st = nullptr;
    if (N_LAUNCHES != PER_PHASE) bar = xcd_barrier_post((unsigned*)(F.ctl + CW_BAR), F.MISC + 8);
    if (N_LAUNCHES != PER_PHASE) { if (F.tid == 0) { const unsigned xid = xb_xcc_id(); F.MISC[12] = xid; F.MISC[13] = xb_add((unsigned*)(F.ctl + CW_TICKET) + 64 * xid, 1u); } __syncthreads(); }
#define GRID_BAR() do { if (N_LAUNCHES != PER_PHASE) xcd_barrier(bar); } while (0)
    const int lo = args.ph_lo, hi = args.ph_hi;
#define IN(k) (lo <= (k) && (k) < hi)
#define BOTH(k) (IN(k) && IN((k) + 1))
#ifndef DUP_PHASE
#define DUP_PHASE (-1)
#endif
#define NREP(k) ((DUP_PHASE == (k)) ? 2 : 1)
    const int gw = F.vcu * NWAVES + F.wave, NGW = F.G * NWAVES;
    bf16* const WinT = (bf16*)(ws + WS_WIN); bf16* const WvT = (bf16*)(ws + WS_WV); bf16* const WkvT = (bf16*)(ws + WS_WKV); bf16* const WbrT = (bf16*)(ws + WS_WBR);
    bf16* const WoutT = (bf16*)(ws + WS_WOUT); bf16* const WqT = (bf16*)(ws + WS_WQ); bf16* const KEYS = (bf16*)(ws + WS_KEYS); bf16* const PWT = (bf16*)(ws + WS_PWT);
    bf16* const MEMN = (bf16*)(ws + WS_MEMN); bf16* const KMEM = (bf16*)(ws + WS_KMEM); bf16* const VTMEM = (bf16*)(ws + WS_VTMEM); float* const RSTDX = (float*)(ws + WS_RSTDX);
    const unsigned char* const U8 = ws + WS_U8; const unsigned char* const V8 = ws + WS_V8; const float* const SU = (const float*)(ws + WS_SU); const float* const SV = (const float*)(ws + WS_SV);
    bf16* const QN = (bf16*)(ws + WS_QN); bf16* const KN = (bf16*)(ws + WS_KN); bf16* const VT = (bf16*)(ws + WS_VT); bf16* const PP = (bf16*)(ws + WS_PP); bf16* const XQ = (bf16*)(ws + WS_XQ);
    bf16* const GATE = (bf16*)(ws + WS_GATE); bf16* const MERGED = (bf16*)(ws + WS_MERGED); bf16* const HB = (bf16*)(ws + WS_HB); bf16* const QB = (bf16*)(ws + WS_QB);
    int* const TE = (int*)(ws + WS_TE); float* const TW = (float*)(ws + WS_TW); float* const AW = (float*)(ws + WS_AW); float* const ROWSQ = (float*)(ws + WS_ROWSQ);
    bf16* const XB = (bf16*)((unsigned char*)args.out + OUT_XB); bf16* const YNA = (bf16*)((unsigned char*)args.out + OUT_YNA);
    bf16* const YPOOL = (bf16*)((unsigned char*)args.out + OUT_YPOOL); bf16* const YXA = (bf16*)((unsigned char*)args.out + OUT_YXA);

    if (IN(0)) { for (int rep = 0; rep < NREP(0); ++rep) { p0_prologue(F, args); if (rep + 1 < NREP(0)) GRID_BAR(); } if (BOTH(0)) GRID_BAR(); }

    if (IN(1)) {
      for (int rep = 0; rep < NREP(1); ++rep) {
        { pg8::Sched1 S; S.so.init(T, IN_MAIN, F.G, (int)blockIdx.x); S.A = (const char*)XB; S.Bt = (const char*)WinT; S.tstep = (size_t)256 * 1024 * 2;
          pg8::EpiProj E{RSTDX, QN, KN, PP, XQ, GATE, args.in[I_NAQG], args.in[I_NAKG], args.in[I_GATEB]};
          pg8::gemm_phase<pg8::EpiProj, pg8::Sched1, true, true>(F.lds + RING_OFF, 1024, S, E); }
        { pg8::Sched1 S; S.so.init(512, T, F.G, (int)blockIdx.x); S.A = (const char*)WvT; S.Bt = (const char*)XB; S.tstep = (size_t)256 * 1024 * 2;
          pg8::EpiVt E{RSTDX, VT};
          pg8::gemm_phase<pg8::EpiVt, pg8::Sched1, false, true>(F.lds + RING_OFF, 1024, S, E); }
        for (int t = gw; t < 512; t += NGW) memkv_tile(MEMN, WkvT, args.in[I_XAKG], args.in[I_XAQG], KMEM, VTMEM, t, F.lane);
        if (rep + 1 < NREP(1)) GRID_BAR();
      }
        if (BOTH(1)) GRID_BAR();
    }

    if (IN(2)) {
      for (int rep = 0; rep < NREP(2); ++rep) {
        LAS float* rpl = (LAS float*)(F.lds + RING_OFF + F.wave * 16384);
        for (int i = F.lane; i < 15 * 31; i += 64) rpl[i] = args.in[I_RPB][F.wave * 15 * 31 + i];
        LDS_WAIT(); asm volatile("" ::: "memory");
        for (int i = F.vcu; i < 256; i += F.G)
            for (int k = 0; k < 8; ++k) { const int idx = i * 8 + k, b = idx >> 9, r = (idx >> 2) & 127, jb = idx & 3; na_item(QN, KN, VT, rpl, YNA, b, r, jb, F.wave, F.lane); }
        for (int i = F.vcu; i < 256; i += F.G) pool_wg(PP, PWT, YPOOL, F.lds + RING_OFF, i * 128, F.wave, F.lane);
        { const int pair = F.vcu & 15, xb = pair >> 2, xh = pair & 3, slot = F.vcu >> 4, nslot = F.G >> 4;
          __syncthreads(); xa_fill_lds(KMEM, VTMEM, F.lds + RING_OFF, xb, xh, F.tid); __syncthreads();
          if (slot < nslot) for (int n = slot * NWAVES + F.wave; n < 512; n += nslot * NWAVES) xa_item(XQ, F.lds + RING_OFF, YXA, (xb * 512 + n) * 16, xh, F.lane);
          __syncthreads(); }
        if (rep + 1 < NREP(2)) GRID_BAR();
      }
        if (BOTH(2)) GRID_BAR();
    }

    if (IN(3)) {
      for (int rep = 0; rep < NREP(3); ++rep) {
        pg8::Sched1 S; S.so.init(T, D, F.G, (int)blockIdx.x); S.A = (const char*)YNA; S.Bt = (const char*)WbrT; S.tstep = (size_t)256 * 1536 * 2;
        pg8::EpiMergeCat E{GATE, MERGED};
        pg8::gemm_phase<pg8::EpiMergeCat, pg8::Sched1, true, true>(F.lds + RING_OFF, 1536, S, E);
        if (rep + 1 < NREP(3)) GRID_BAR();
      }
        if (BOTH(3)) GRID_BAR();
    }

    if (IN(4)) {
      for (int rep = 0; rep < NREP(4); ++rep) {
        pg8::Sched1 S; S.so.init(T, D, F.G, (int)blockIdx.x); S.A = (const char*)MERGED; S.Bt = (const char*)WoutT; S.tstep = (size_t)256 * 1024 * 2;
        pg8::EpiH E{args.in[I_X], F.out, HB, ROWSQ, args.probe};
        pg8::gemm_phase<pg8::EpiH, pg8::Sched1, true, true>(F.lds + RING_OFF, 1024, S, E);
        if (rep + 1 < NREP(4)) { GRID_BAR(); for (int m = gw * 64 + F.lane; m < T; m += NGW * 64) ROWSQ[m] = 0.f; GRID_BAR(); }
      }
        if (BOTH(4)) GRID_BAR();
    }

    if (IN(5)) {
      for (int rep = 0; rep < NREP(5); ++rep) {
        pg8::Sched1 S; S.so.init(T, 2048, F.G, (int)blockIdx.x); S.A = (const char*)HB; S.Bt = (const char*)WqT; S.tstep = (size_t)256 * 1024 * 2;
        pg8::EpiQ E{ROWSQ, QB};
        pg8::gemm_phase<pg8::EpiQ, pg8::Sched1, true, true>(F.lds + RING_OFF, 1024, S, E);
        if (rep + 1 < NREP(5)) GRID_BAR();
      }
        if (BOTH(5)) GRID_BAR();
    }

    if (IN(6)) {
        LAS int* lscr = (LAS int*)(F.lds + RING_OFF + 65536 + F.wave * 8192);
        for (int tok = 4 * gw; tok < T; tok += 4 * NGW) {
            HqIn hin[4];
#pragma unroll
            for (int r = 0; r < 4; ++r) hq_load(hin[r], HB, ROWSQ, tok + r, F.lane);
#pragma unroll
            for (int r = 0; r < 4; ++r) hq_token(hin[r], ws + WS_HQ, (float*)(ws + WS_HS), tok + r, F.lane); }
        { const int th = F.vcu & 7, slot = F.vcu >> 3, nslot = F.G >> 3;
          __syncthreads(); topk_fill_lds(KEYS, F.lds + RING_OFF, th, F.tid); __syncthreads();
          for (int rep = 0; rep < NREP(6); ++rep) { { const int n0 = slot * NWAVES + F.wave, ns = nslot * NWAVES; TopkQ qA, qB;
              if (n0 < 2048) topk_loadq(qA, QB, n0 * 16, th, F.lane);
              for (int n = n0; n < 2048; n += 2 * ns) {
                  if (n + ns < 2048) topk_loadq(qB, QB, (n + ns) * 16, th, F.lane);
                  topk_item(qA, F.lds + RING_OFF, TE, TW, lscr, n * 16, th, F.lane);
                  if (n + ns < 2048) { if (n + 2 * ns < 2048) topk_loadq(qA, QB, (n + 2 * ns) * 16, th, F.lane);
                      topk_item(qB, F.lds + RING_OFF, TE, TW, lscr, (n + ns) * 16, th, F.lane); } } } if (rep + 1 < NREP(6)) GRID_BAR(); }
          __syncthreads(); }
        if (BOTH(6)) GRID_BAR();
    }

    if (IN(7)) {
        int x0 = 0, nxs = 8, wrank = (int)blockIdx.x * NWAVES + F.wave, wstep = F.G * NWAVES;
        if (N_LAUNCHES != PER_PHASE) { const unsigned xid = F.MISC[12], rk = F.MISC[13]; unsigned nx = 0, below = 0, mine = 0;
            for (unsigned j = 0; j < 16; ++j) { const unsigned c = xb_ld((unsigned*)(F.ctl + CW_BAR) + XB_XCNT(j)); nx += c > 0u; below += (c > 0u && j < xid); mine = (j == xid) ? c : mine; }
            if (nx == 8 && mine > 0 && rk < mine) { x0 = (int)below; nxs = 1; wrank = (int)rk * NWAVES + F.wave; wstep = (int)mine * NWAVES; } }
        else if ((F.G & 7) == 0) { x0 = (int)blockIdx.x & 7; nxs = 1; wrank = ((int)blockIdx.x >> 3) * NWAVES + F.wave; wstep = (F.G >> 3) * NWAVES; }
        for (int xs = 0; xs < nxs; ++xs) peer_a_run(ws + WS_HQ, (const float*)(ws + WS_HS), U8, SU, SV, TE, TW, args.probe ? (float*)QB : AW, (LAS int*)(F.lds + RING_OFF + F.wave * 16384), wrank, wstep, x0 + xs, F.lane, args.probe == 2);
        if (N_LAUNCHES != PER_PHASE) xcd_barrier(bar);
    }
    if (IN(8)) {
        int x0 = 0, nxs = 8, wrank = (int)blockIdx.x * NWAVES + F.wave, wstep = F.G * NWAVES;
        if (N_LAUNCHES != PER_PHASE) { const unsigned xid = F.MISC[12], rk = F.MISC[13]; unsigned nx = 0, below = 0, mine = 0;
            for (unsigned j = 0; j < 16; ++j) { const unsigned c = xb_ld((unsigned*)(F.ctl + CW_BAR) + XB_XCNT(j)); nx += c > 0u; below += (c > 0u && j < xid); mine = (j == xid) ? c : mine; }
            if (nx == 8 && mine > 0 && rk < mine) { x0 = (int)below; nxs = 1; wrank = (int)rk * NWAVES + F.wave; wstep = (int)mine * NWAVES; } }
        else if ((F.G & 7) == 0) { x0 = (int)blockIdx.x & 7; nxs = 1; wrank = ((int)blockIdx.x >> 3) * NWAVES + F.wave; wstep = (F.G >> 3) * NWAVES; }
        for (int xs = 0; xs < nxs; ++xs) peer_b_run(V8 + (size_t)(x0 + xs) * (2 * MiB), TE, AW, HB, args.probe ? (float*)QB : F.out, wrank, wstep, x0 + xs, F.lane, args.probe == 2);
    }
#undef IN
#undef BOTH
#undef GRID_BAR
}

extern "C" void kernel_launch(void* const* d_in, const int* in_sizes, int n_in, void* d_out, int out_size, void* d_ws, size_t ws_size, hipStream_t stream) {
    static int grid = 0;
    if (grid == 0) {
        if (n_in != 23 || in_sizes[0] != T * D || out_size != T * D || ws_size < WS_END) { fprintf(stderr, "kernel_launch: unexpected shapes: n_in %d in0 %d out %d ws %zu\n", n_in, n_in > 0 ? in_sizes[0] : -1, out_size, ws_size); grid = -1; return; }
        int dev = 0, cus = 0, per_cu = 0;
        if (hipGetDevice(&dev) != hipSuccess || hipDeviceGetAttribute(&cus, hipDeviceAttributeMultiprocessorCount, dev) != hipSuccess) { fprintf(stderr, "kernel_launch: device query failed\n"); grid = -1; return; }
        if (hipFuncSetAttribute((const void*)mk_fwd, hipFuncAttributeMaxDynamicSharedMemorySize, LDS_BYTES) != hipSuccess) { fprintf(stderr, "kernel_launch: hipFuncSetAttribute failed\n"); grid = -1; return; }
        if (hipOccupancyMaxActiveBlocksPerMultiprocessor(&per_cu, (const void*)mk_fwd, NWAVES * 64, LDS_BYTES) != hipSuccess || per_cu < 1)
            fprintf(stderr, "kernel_launch: note: occupancy query reports %d workgroups per CU\n", per_cu);
        (void)hipGetLastError();
        grid = cus;
    }
    if (grid < 0) return;
    if (hipMemsetAsync((char*)d_ws + WS_CTL, 0, CTL_ZERO_BYTES, stream) != hipSuccess) { fprintf(stderr, "kernel_launch: memset failed\n"); return; }
    Args a{};
    for (int i = 0; i < 23; ++i) a.in[i] = (const float*)d_in[i];
    a.out = (float*)d_out; a.ws = (unsigned char*)d_ws;
    for (int li = 0; li < N_LAUNCHES; ++li) {
        a.ph_lo = (N_LAUNCHES == PER_PHASE) ? li : 0; a.ph_hi = (N_LAUNCHES == PER_PHASE) ? li + 1 : PER_PHASE;
        hipLaunchKernelGGL(mk_fwd, dim3(grid), dim3(NWAVES * 64), LDS_BYTES, stream, a);
#ifdef HOST_DUP_PHASE
        if (N_LAUNCHES == PER_PHASE && li == HOST_DUP_PHASE) {
#ifndef PROBE_MODE
            if (li == 4) (void)hipMemsetAsync((char*)d_ws + WS_ROWSQ, 0, (size_t)T * 4, stream);
#endif
#ifdef PROBE_MODE
            a.probe = PROBE_MODE;
#endif
            hipLaunchKernelGGL(mk_fwd, dim3(grid), dim3(NWAVES * 64), LDS_BYTES, stream, a); a.probe = 0; }
#endif
        const hipError_t le = hipPeekAtLastError();
        if (le != hipSuccess) { fprintf(stderr, "kernel_launch: launch %d failed: %s\n", li, hipGetErrorName(le)); break; }
    }
}
```

```cpp
#include <hip/hip_runtime.h>
#include <cstdio>
#include <cstdint>

#ifndef MK_N_LAUNCHES
#define MK_N_LAUNCHES 1
#endif

namespace pg8 {
#define PG8_LAS __attribute__((address_space(3)))
typedef unsigned short bf16_t;
typedef short bf16x8 __attribute__((ext_vector_type(8)));
typedef float f32x4 __attribute__((ext_vector_type(4)));
typedef unsigned u32x4 __attribute__((ext_vector_type(4)));
typedef unsigned u32x2 __attribute__((ext_vector_type(2)));
constexpr int BM = 256, BK = 64, HALF = 128, HTB = HALF * BK * 2  , STAGE_BYTES = 8 * HTB, NXCD = 8, WGM = 8;

__host__ __device__ __forceinline__ int lds_byte(int r, int c) { const int st = (r >> 4) * 2 + (c >> 5), rr = r & 15, cc = c & 31, ob = rr * 64 + cc * 2; return st * 1024 + (ob ^ (((ob >> 9) & 1) << 5)); }
__host__ __device__ __forceinline__ void stage_rc(int b, int& R, int& C) { const int st = b / 1024, sb = b % 1024, swz = sb ^ (((sb >> 9) & 1) << 5); R = (st >> 1) * 16 + swz / 64; C = (st & 1) * 32 + (swz % 64) / 2; }
__host__ __device__ __forceinline__ int perm32(int rho) { const int n = rho >> 4, i = rho & 15; return 8 * (i >> 2) + 4 * n + (i & 3); }

struct Unit { int pm, pn, br; };

struct StaticOrder {
    int nM, nN, nwg, G, c;
    __host__ __device__ void init(int M, int N, int G_, int c_) { nM = M / BM; nN = N / BM; nwg = nM * nN; G = G_; c = c_; }
    __host__ __device__ bool next(int i, Unit& u) const {
        const long L = (long)i * G + c; if (L >= nwg) return false;
        int wgid = (int)L; { const int q = nwg / NXCD, r = nwg % NXCD, xcd = wgid % NXCD, off = wgid / NXCD; wgid = (xcd < r ? xcd * (q + 1) : r * (q + 1) + (xcd - r) * q) + off; }
        const int nig = WGM * nN, gid = wgid / nig, fm = gid * WGM, gsz = (nM - fm) < WGM ? (nM - fm) : WGM;
        u.pm = fm + ((wgid % nig) % gsz); u.pn = (wgid % nig) / gsz; return true;
    }
};
struct Sched1 {
    StaticOrder so; const char* A; const char* Bt; size_t tstep;
    __device__ __forceinline__ bool next(int i, Unit& u) const { u.br = 0; return so.next(i, u); }
    __device__ __forceinline__ const char* abase(const Unit& u) const { return A + (size_t)u.pm * tstep; }
    __device__ __forceinline__ const char* bbase(const Unit& u) const { return Bt + (size_t)u.pn * tstep; }
    __device__ __forceinline__ void a_ready(const Unit&) const {}
    __device__ __forceinline__ void done(const Unit&) const {}
};
struct Sched3 {
    StaticOrder so; const char* A; const char* Bt; size_t tstep, strideA, strideB;
    __device__ __forceinline__ bool next(int i, Unit& u) const { u.br = i % 3; return so.next(i / 3, u); }
    __device__ __forceinline__ const char* abase(const Unit& u) const { return A + (size_t)u.br * strideA + (size_t)u.pm * tstep; }
    __device__ __forceinline__ const char* bbase(const Unit& u) const { return Bt + (size_t)u.br * strideB + (size_t)u.pn * tstep; }
    __device__ __forceinline__ void a_ready(const Unit&) const {}
    __device__ __forceinline__ void done(const Unit&) const {}
};

typedef float f32x2_t __attribute__((ext_vector_type(2))); typedef __bf16 bf16x2v_t __attribute__((ext_vector_type(2)));
__device__ __forceinline__ unsigned cvt_pk_bf16(float lo, float hi) { const f32x2_t v = {lo, hi}; const bf16x2v_t b = __builtin_convertvector(v, bf16x2v_t); return __builtin_bit_cast(unsigned, b); }
__device__ __forceinline__ u32x4 pack8(const f32x4 a, const f32x4 b) { u32x4 w; w.x = cvt_pk_bf16(a[0], a[1]); w.y = cvt_pk_bf16(a[2], a[3]); w.z = cvt_pk_bf16(b[0], b[1]); w.w = cvt_pk_bf16(b[2], b[3]); return w; }
__device__ __forceinline__ float bflo(unsigned u) { return __builtin_bit_cast(float, u << 16); }
__device__ __forceinline__ float bfhi(unsigned u) { return __builtin_bit_cast(float, u & 0xffff0000u); }


constexpr float RMS_EPS = 1e-6f;

struct EpiProj {
    static constexpr bool PERM = true, AFTER_DRAIN = false, HAS_MID = false;
    const float* rstd; bf16_t *qn, *kn, *pp, *xq, *gates; const float *qg, *kg, *gate_b; int skip;
    __device__ __forceinline__ void operator()(const f32x4 (&acc)[2][2][4][2], const Unit& u, int wr, int wc, int fr, int fq) const {
        if (skip) { if (acc[0][0][0][0][0] == 1234.5f) qn[0] = 1; return; }
        const int pn = u.pn, row0 = u.pm * BM + wr * 64 + fr, lc0 = 64 * wc + 8 * fq;
        float rsv[2][4];
#pragma unroll
        for (int ai = 0; ai < 2; ++ai)
#pragma unroll
            for (int m = 0; m < 4; ++m) rsv[ai][m] = rstd[row0 + ai * HALF + m * 16];
        if (pn < 4) {
            const bool isq = pn < 2; bf16_t* O = isq ? qn : kn; const float* g = isq ? qg : kg; const float post = isq ? 0.125f : 1.0f;
            f32x4 gv[2][2];
#pragma unroll
            for (int bj = 0; bj < 2; ++bj)
#pragma unroll
                for (int n = 0; n < 2; ++n) gv[bj][n] = *(const f32x4*)(g + 32 * bj + 8 * fq + 4 * n);
            const int colbase = (pn & 1) * 256 + lc0;
#pragma unroll
            for (int ai = 0; ai < 2; ++ai)
#pragma unroll
                for (int m = 0; m < 4; ++m) {
                    const int row = row0 + ai * HALF + m * 16; const float rs = rsv[ai][m];
                    f32x4 v[2][2]; float ss = 0.f;
#pragma unroll
                    for (int bj = 0; bj < 2; ++bj)
#pragma unroll
                        for (int n = 0; n < 2; ++n) { v[bj][n] = acc[ai][bj][m][n] * rs; ss += (v[bj][n][0] * v[bj][n][0] + v[bj][n][1] * v[bj][n][1]) + (v[bj][n][2] * v[bj][n][2] + v[bj][n][3] * v[bj][n][3]); }
                    ss += __shfl_xor(ss, 16); ss += __shfl_xor(ss, 32);
                    const float r = rsqrtf(ss * (1.0f / 64.0f) + RMS_EPS) * post;
#pragma unroll
                    for (int bj = 0; bj < 2; ++bj) *(u32x4*)(O + (size_t)row * 512 + colbase + 32 * bj) = pack8(v[bj][0] * r * gv[bj][0], v[bj][1] * r * gv[bj][1]);
                }
        } else if (pn < 8) {
            bf16_t* O = pn < 6 ? pp : xq; const int colbase = (pn & 1) * 256 + lc0;
#pragma unroll
            for (int ai = 0; ai < 2; ++ai)
#pragma unroll
                for (int m = 0; m < 4; ++m) {
                    const int row = row0 + ai * HALF + m * 16; const float rs = rsv[ai][m];
#pragma unroll
                    for (int bj = 0; bj < 2; ++bj) *(u32x4*)(O + (size_t)row * 512 + colbase + 32 * bj) = pack8(acc[ai][bj][m][0] * rs, acc[ai][bj][m][1] * rs);
                }
        } else {
            const int gcol0 = (pn - 8) * 256 + lc0;
            f32x4 bv[2][2];
#pragma unroll
            for (int bj = 0; bj < 2; ++bj)
#pragma unroll
                for (int n = 0; n < 2; ++n) bv[bj][n] = *(const f32x4*)(gate_b + gcol0 + 32 * bj + 4 * n);
#pragma unroll
            for (int ai = 0; ai < 2; ++ai)
#pragma unroll
                for (int m = 0; m < 4; ++m) {
                    const int row = row0 + ai * HALF + m * 16; const float rs = rsv[ai][m];
#pragma unroll
                    for (int bj = 0; bj < 2; ++bj) {
                        f32x4 o[2];
#pragma unroll
                        for (int n = 0; n < 2; ++n) { const f32x4 z = acc[ai][bj][m][n] * rs + bv[bj][n];
#pragma unroll
                            for (int i = 0; i < 4; ++i) o[n][i] = __builtin_amdgcn_rcpf(1.0f + __expf(-z[i])); }
                        *(u32x4*)(gates + (size_t)row * 3072 + gcol0 + 32 * bj) = pack8(o[0], o[1]);
                    }
                }
        }
    }
};
struct EpiVt {
    static constexpr bool PERM = true, AFTER_DRAIN = false, HAS_MID = false;
    const float* rstd; bf16_t* Vt;
    __device__ __forceinline__ void operator()(const f32x4 (&acc)[2][2][4][2], const Unit& u, int wr, int wc, int fr, int fq) const {
        const int ch0 = u.pm * BM + wr * 64 + fr, tok0 = u.pn * BM + wc * 32 + 8 * fq, b = tok0 >> 13, t0 = tok0 & 8191;
        f32x4 rv[2][2];
#pragma unroll
        for (int bj = 0; bj < 2; ++bj)
#pragma unroll
            for (int n = 0; n < 2; ++n) rv[bj][n] = *(const f32x4*)(rstd + tok0 + bj * HALF + 4 * n);
#pragma unroll
        for (int ai = 0; ai < 2; ++ai)
#pragma unroll
            for (int m = 0; m < 4; ++m) { const int ch = ch0 + ai * HALF + m * 16; bf16_t* rowp = Vt + ((size_t)(b * 512 + ch) * 8192 + t0);
#pragma unroll
                for (int bj = 0; bj < 2; ++bj) *(u32x4*)(rowp + bj * HALF) = pack8(acc[ai][bj][m][0] * rv[bj][0], acc[ai][bj][m][1] * rv[bj][1]); }
    }
};
struct EpiMergeCat {
    static constexpr bool PERM = true, AFTER_DRAIN = false, HAS_MID = true;
    const bf16_t* gates; bf16_t* merged;
    __device__ __forceinline__ void mid(f32x4 (&acc)[2][2][4][2], const Unit& u, int nb  , int wr, int wc, int fr, int fq) const {
        const int row0 = u.pm * BM + wr * 64 + fr, col0 = u.pn * BM + wc * 32 + 8 * fq;
#pragma unroll
        for (int ai = 0; ai < 2; ++ai) {
            u32x4 ga[4][2], gb[4][2];
#pragma unroll
            for (int m = 0; m < 4; ++m)
#pragma unroll
                for (int bj = 0; bj < 2; ++bj) { const bf16_t* gp = gates + (size_t)(row0 + ai * HALF + m * 16) * 3072 + (nb - 1) * 1024 + col0 + bj * HALF;
                    ga[m][bj] = *(const u32x4*)gp; gb[m][bj] = *(const u32x4*)(gp + 1024); }
            __builtin_amdgcn_sched_barrier(0);
#pragma unroll
            for (int m = 0; m < 4; ++m)
#pragma unroll
                for (int bj = 0; bj < 2; ++bj) { const u32x4 a = ga[m][bj], b = gb[m][bj]; f32x4& x0 = acc[ai][bj][m][0]; f32x4& x1 = acc[ai][bj][m][1];
                    x0[0] *= bflo(a.x) * __builtin_amdgcn_rcpf(bflo(b.x)); x0[1] *= bfhi(a.x) * __builtin_amdgcn_rcpf(bfhi(b.x)); x0[2] *= bflo(a.y) * __builtin_amdgcn_rcpf(bflo(b.y)); x0[3] *= bfhi(a.y) * __builtin_amdgcn_rcpf(bfhi(b.y));
                    x1[0] *= bflo(a.z) * __builtin_amdgcn_rcpf(bflo(b.z)); x1[1] *= bfhi(a.z) * __builtin_amdgcn_rcpf(bfhi(b.z)); x1[2] *= bflo(a.w) * __builtin_amdgcn_rcpf(bflo(b.w)); x1[3] *= bfhi(a.w) * __builtin_amdgcn_rcpf(bfhi(b.w)); }
            __builtin_amdgcn_sched_barrier(0);
        }
    }
    __device__ __forceinline__ void operator()(const f32x4 (&acc)[2][2][4][2], const Unit& u, int wr, int wc, int fr, int fq) const {
        const int row0 = u.pm * BM + wr * 64 + fr, col0 = u.pn * BM + wc * 32 + 8 * fq;
#pragma unroll
        for (int ai = 0; ai < 2; ++ai) {
            u32x4 g8[4][2];
#pragma unroll
            for (int m = 0; m < 4; ++m)
#pragma unroll
                for (int bj = 0; bj < 2; ++bj) g8[m][bj] = *(const u32x4*)(gates + (size_t)(row0 + ai * HALF + m * 16) * 3072 + 2048 + col0 + bj * HALF);
            __builtin_amdgcn_sched_barrier(0);
#pragma unroll
            for (int m = 0; m < 4; ++m)
#pragma unroll
                for (int bj = 0; bj < 2; ++bj) { const u32x4 g = g8[m][bj]; f32x4 a = acc[ai][bj][m][0], b = acc[ai][bj][m][1];
                    a[0] *= bflo(g.x); a[1] *= bfhi(g.x); a[2] *= bflo(g.y); a[3] *= bfhi(g.y); b[0] *= bflo(g.z); b[1] *= bfhi(g.z); b[2] *= bflo(g.w); b[3] *= bfhi(g.w);
                    *(u32x4*)(merged + (size_t)(row0 + ai * HALF + m * 16) * 1024 + col0 + bj * HALF) = pack8(a, b); }
            __builtin_amdgcn_sched_barrier(0);
        }
    }
};
struct EpiH {
    static constexpr bool PERM = true, AFTER_DRAIN = false, HAS_MID = false;
    const float* x; float* out; bf16_t* hb; float* rowsq; int noatomic;
    __device__ __forceinline__ void operator()(const f32x4 (&acc)[2][2][4][2], const Unit& u, int wr, int wc, int fr, int fq) const {
        const int row0 = u.pm * BM + wr * 64 + fr, col0 = u.pn * BM + wc * 32 + 8 * fq;
#pragma unroll
        for (int ai = 0; ai < 2; ++ai) {
            f32x4 xv[4][2][2];
#pragma unroll
            for (int m = 0; m < 4; ++m)
#pragma unroll
                for (int bj = 0; bj < 2; ++bj) { const size_t o = (size_t)(row0 + ai * HALF + m * 16) * 1024 + col0 + bj * HALF; xv[m][bj][0] = *(const f32x4*)(x + o); xv[m][bj][1] = *(const f32x4*)(x + o + 4); }
            __builtin_amdgcn_sched_barrier(0);
#pragma unroll
            for (int m = 0; m < 4; ++m) { const int row = row0 + ai * HALF + m * 16; float ss = 0.f;
#pragma unroll
                for (int bj = 0; bj < 2; ++bj) { const size_t o = (size_t)row * 1024 + col0 + bj * HALF;
                    const f32x4 h0 = xv[m][bj][0] + acc[ai][bj][m][0], h1 = xv[m][bj][1] + acc[ai][bj][m][1];
                    *(u32x4*)(hb + o) = pack8(h0, h1);
                    ss += (h0[0] * h0[0] + h0[1] * h0[1]) + (h0[2] * h0[2] + h0[3] * h0[3]) + (h1[0] * h1[0] + h1[1] * h1[1]) + (h1[2] * h1[2] + h1[3] * h1[3]); }
                ss += __shfl_xor(ss, 16); ss += __shfl_xor(ss, 32);
                if (fq == 0 && !noatomic) atomicAdd(rowsq + row, ss); }
            __builtin_amdgcn_sched_barrier(0);
        }
    }
};
struct EpiQ {
    static constexpr bool PERM = true, AFTER_DRAIN = false, HAS_MID = false;
    const float* rowsq; bf16_t* qb;
    __device__ __forceinline__ void operator()(const f32x4 (&acc)[2][2][4][2], const Unit& u, int wr, int wc, int fr, int fq) const {
        const int row0 = u.pm * BM + wr * 64 + fr, col0 = u.pn * BM + wc * 32 + 8 * fq;
        float rq[2][4];
#pragma unroll
        for (int ai = 0; ai < 2; ++ai)
#pragma unroll
            for (int m = 0; m < 4; ++m) rq[ai][m] = rowsq[row0 + ai * HALF + m * 16];
#pragma unroll
        for (int ai = 0; ai < 2; ++ai)
#pragma unroll
            for (int m = 0; m < 4; ++m) { const int row = row0 + ai * HALF + m * 16; const float r = rsqrtf(rq[ai][m] * (1.0f / 1024.0f) + RMS_EPS);
#pragma unroll
                for (int bj = 0; bj < 2; ++bj) *(u32x4*)(qb + (size_t)row * 2048 + col0 + bj * HALF) = pack8(acc[ai][bj][m][0] * r, acc[ai][bj][m][1] * r); }
    }
};

template <class Epi, class Sched, bool ALIGN_EPI = false, bool SP2 = false>
__device__ __forceinline__ void gemm_phase(PG8_LAS unsigned char* lds, const int K, const Sched& S, const Epi& E) {
    const int tid = threadIdx.x, wid = __builtin_amdgcn_readfirstlane(tid >> 6), lane = tid & 63, wr = wid >> 2, wc = wid & 3, fr = lane & 15, fq = lane >> 4;
    const int nt = K / BK;
    unsigned voffA[2], voffB[2];
#pragma unroll
    for (int i = 0; i < 2; ++i) { int R, C; stage_rc(tid * 16 + i * 8192, R, C); const int Rb = Epi::PERM ? ((R & ~31) + perm32(R & 31)) : R;
        voffA[i] = (unsigned)(R * K + C) * 2u; voffB[i] = (unsigned)(Rb * K + C) * 2u; }
    const size_t kstep = (size_t)(BK * 2);
    const size_t hstep = (size_t)HALF * K * 2;
    const size_t tstep = 2 * hstep;
    const unsigned ldsw = (unsigned)wid * 1024u;
    const int aoff = lds_byte(wr * 64 + fr, fq * 8), boff = lds_byte(wc * 32 + fr, fq * 8);
#define PG8_SA(b, h) (((b) * 2 + (h)) * HTB)
#define PG8_SB(b, h) ((4 + (b) * 2 + (h)) * HTB)
#define PG8_STAGE(bufoff, gbase, voff) do { _Pragma("unroll") for (int _i = 0; _i < 2; ++_i) \
        __builtin_amdgcn_global_load_lds((const unsigned*)((const char*)(gbase) + (voff)[_i]), (PG8_LAS unsigned*)(lds + (bufoff) + ldsw + _i * 8192), 16, 0, 0); } while (0)
#define PG8_LDA(dst, b, h) do { _Pragma("unroll") for (int m = 0; m < 4; ++m) _Pragma("unroll") for (int k = 0; k < 2; ++k) dst[m][k] = *(const PG8_LAS bf16x8*)(lds + PG8_SA(b, h) + aoff + m * 2048 + k * 1024); } while (0)
#define PG8_LDB(dst, b, h) do { _Pragma("unroll") for (int n = 0; n < 2; ++n) _Pragma("unroll") for (int k = 0; k < 2; ++k) dst[n][k] = *(const PG8_LAS bf16x8*)(lds + PG8_SB(b, h) + boff + n * 2048 + k * 1024); } while (0)
#define PG8_MMA(ai, bj, At, Bt) do { __builtin_amdgcn_s_setprio(1); _Pragma("unroll") for (int m = 0; m < 4; ++m) _Pragma("unroll") for (int n = 0; n < 2; ++n) _Pragma("unroll") for (int k = 0; k < 2; ++k) \
        acc[ai][bj][m][n] = __builtin_amdgcn_mfma_f32_16x16x32_bf16(Bt[n][k], At[m][k], acc[ai][bj][m][n], 0, 0, 0); __builtin_amdgcn_s_setprio(0); } while (0)
#define PG8_WAIT_V(n) asm volatile("s_waitcnt vmcnt(" #n ")" ::: "memory")
#define PG8_WAIT_L(n) asm volatile("s_waitcnt lgkmcnt(" #n ")" ::: "memory")
#define PG8_BAR __builtin_amdgcn_s_barrier()
#define PG8_SCHED __builtin_amdgcn_sched_barrier(0)
    Unit cur, nxt; int ui = 0;
    if (!S.next(0, cur)) return;
    f32x4 acc[2][2][4][2];
#pragma unroll
    for (int a = 0; a < 2; ++a)
#pragma unroll
        for (int b = 0; b < 2; ++b)
#pragma unroll
            for (int m = 0; m < 4; ++m)
#pragma unroll
                for (int n = 0; n < 2; ++n) acc[a][b][m][n] = (f32x4){0.f, 0.f, 0.f, 0.f};
    bf16x8 At[4][2], B0[2][2], B1[2][2];
    const char* cA = S.abase(cur); const char* cB = S.bbase(cur);
    S.a_ready(cur);
    if constexpr (SP2) {
        PG8_STAGE(PG8_SB(0, 0), cB, voffB); PG8_STAGE(PG8_SB(0, 1), cB + hstep, voffB); PG8_STAGE(PG8_SA(0, 0), cA, voffA); PG8_STAGE(PG8_SA(0, 1), cA + hstep, voffA);
        if (wr == 1) PG8_BAR;
        PG8_WAIT_V(2); PG8_BAR;
        PG8_STAGE(PG8_SB(1, 0), cB + kstep, voffB); PG8_STAGE(PG8_SA(1, 0), cA + kstep, voffA); PG8_STAGE(PG8_SB(1, 1), cB + hstep + kstep, voffB);
        PG8_WAIT_V(6); PG8_BAR;
    } else {
        PG8_STAGE(PG8_SB(0, 0), cB, voffB); PG8_STAGE(PG8_SA(0, 0), cA, voffA); PG8_STAGE(PG8_SB(0, 1), cB + hstep, voffB); PG8_STAGE(PG8_SA(0, 1), cA + hstep, voffA);
        if (wr == 1) PG8_BAR;
        PG8_WAIT_V(4); PG8_BAR;
        PG8_STAGE(PG8_SB(1, 0), cB + kstep, voffB); PG8_STAGE(PG8_SA(1, 0), cA + kstep, voffA); PG8_STAGE(PG8_SB(1, 1), cB + hstep + kstep, voffB);
        PG8_WAIT_V(6); PG8_BAR;
    }
    for (;;) {
        const bool has_next = S.next(ui + 1, nxt);
        const char* nA = has_next ? S.abase(nxt) : cA; const char* nB = has_next ? S.bbase(nxt) : cB;
        for (int t = 0; t < nt; t += 2) {
            if constexpr (Epi::HAS_MID) { if (t == 8 || t == 16) E.mid(acc, cur, t >> 3, wr, wc, fr, fq); }
            const bool last = (t == nt - 2);
            const char* a1 = cA + (size_t)(t + 1) * kstep;
            const char* a2 = last ? nA : cA + (size_t)(t + 2) * kstep; const char* b2 = last ? nB : cB + (size_t)(t + 2) * kstep;
            const char* a3 = a2 + kstep; const char* b3 = b2 + kstep;
            if (last && has_next) S.a_ready(nxt);
            if constexpr (SP2) {
            PG8_LDB(B0, 0, 0); PG8_LDB(B1, 0, 1); PG8_SCHED; PG8_LDA(At, 0, 0); PG8_STAGE(PG8_SA(1, 1), a1 + hstep, voffA);
            PG8_WAIT_V(8); PG8_WAIT_L(0); PG8_BAR; PG8_MMA(0, 0, At, B0); PG8_MMA(0, 1, At, B1); PG8_BAR; PG8_SCHED;
            PG8_LDA(At, 0, 1); PG8_STAGE(PG8_SB(0, 0), b2, voffB); PG8_STAGE(PG8_SB(0, 1), b2 + hstep, voffB); PG8_STAGE(PG8_SA(0, 0), a2, voffA);
            PG8_WAIT_V(8); PG8_WAIT_L(0); PG8_BAR; PG8_MMA(1, 0, At, B0); PG8_MMA(1, 1, At, B1); PG8_BAR; PG8_SCHED;
            PG8_LDB(B0, 1, 0); PG8_LDB(B1, 1, 1); PG8_SCHED; PG8_LDA(At, 1, 0); PG8_STAGE(PG8_SA(0, 1), a2 + hstep, voffA);
            PG8_WAIT_V(8); PG8_WAIT_L(0); PG8_BAR; PG8_MMA(0, 0, At, B0); PG8_MMA(0, 1, At, B1); PG8_BAR; PG8_SCHED;
            PG8_LDA(At, 1, 1); PG8_STAGE(PG8_SB(1, 0), b3, voffB); PG8_STAGE(PG8_SB(1, 1), b3 + hstep, voffB); PG8_STAGE(PG8_SA(1, 0), a3, voffA);
            PG8_WAIT_V(8); PG8_WAIT_L(0); PG8_BAR; PG8_MMA(1, 0, At, B0); PG8_MMA(1, 1, At, B1); PG8_BAR; PG8_SCHED;
            } else {
            PG8_LDB(B0, 0, 0); PG8_SCHED; PG8_LDA(At, 0, 0); PG8_STAGE(PG8_SA(1, 1), a1 + hstep, voffA);
            PG8_WAIT_L(8); PG8_BAR; PG8_WAIT_L(0); PG8_MMA(0, 0, At, B0); PG8_BAR; PG8_SCHED;
            PG8_LDB(B1, 0, 1); PG8_STAGE(PG8_SB(0, 0), b2, voffB);
            PG8_BAR; PG8_WAIT_L(0); PG8_MMA(0, 1, At, B1); PG8_BAR;
            PG8_LDA(At, 0, 1); PG8_STAGE(PG8_SA(0, 0), a2, voffA);
            PG8_BAR; PG8_WAIT_L(0); PG8_MMA(1, 0, At, B0); PG8_BAR; PG8_SCHED;
            PG8_STAGE(PG8_SB(0, 1), b2 + hstep, voffB);
            PG8_WAIT_V(6); PG8_BAR; PG8_MMA(1, 1, At, B1); PG8_BAR;
            PG8_LDB(B0, 1, 0); PG8_SCHED; PG8_LDA(At, 1, 0); PG8_STAGE(PG8_SA(0, 1), a2 + hstep, voffA);
            PG8_WAIT_L(8); PG8_BAR; PG8_WAIT_L(0); PG8_MMA(0, 0, At, B0); PG8_BAR; PG8_SCHED;
            PG8_LDB(B1, 1, 1); PG8_STAGE(PG8_SB(1, 0), b3, voffB);
            PG8_BAR; PG8_WAIT_L(0); PG8_MMA(0, 1, At, B1); PG8_BAR;
            PG8_LDA(At, 1, 1); PG8_STAGE(PG8_SA(1, 0), a3, voffA);
            PG8_BAR; PG8_WAIT_L(0); PG8_MMA(1, 0, At, B0); PG8_BAR; PG8_SCHED;
            PG8_STAGE(PG8_SB(1, 1), b3 + hstep, voffB);
            PG8_WAIT_V(6); PG8_BAR; PG8_MMA(1, 1, At, B1); PG8_BAR;
            }
        }
        if constexpr (ALIGN_EPI) { if (wr == 0) PG8_BAR; }
        if constexpr (!Epi::AFTER_DRAIN) { E(acc, cur, wr, wc, fr, fq); S.done(cur); }
        if (!has_next) break;
#pragma unroll
        for (int a = 0; a < 2; ++a)
#pragma unroll
            for (int b = 0; b < 2; ++b)
#pragma unroll
                for (int m = 0; m < 4; ++m)
#pragma unroll
                    for (int n = 0; n < 2; ++n) acc[a][b][m][n] = (f32x4){0.f, 0.f, 0.f, 0.f};
        cur = nxt; cA = nA; cB = nB; ++ui;
        if constexpr (ALIGN_EPI) { if (wr == 1) PG8_BAR; }
    }
    PG8_WAIT_V(0);
    if constexpr (!ALIGN_EPI) { if (wr == 0) PG8_BAR; }
    PG8_BAR;
    if constexpr (Epi::AFTER_DRAIN) { E.fused(acc, cur, wr, wc, fr, fq, lds, wid, lane); S.done(cur); }
#undef PG8_SA
#undef PG8_SB
#undef PG8_STAGE
#undef PG8_LDA
#undef PG8_LDB
#undef PG8_MMA
#undef PG8_WAIT_V
#undef PG8_WAIT_L
#undef PG8_BAR
#undef PG8_SCHED
}
}

constexpr int NWAVES = 8;
constexpr int N_LAUNCHES = MK_N_LAUNCHES;
constexpr int PER_PHASE = 9;
constexpr int NBATCH = 4, SEQ = 8192, D = 1024, T = NBATCH * SEQ, MEMLEN = 256, NMEMTOK = NBATCH * MEMLEN;
constexpr int IN_MAIN = 5120;
constexpr int NEXP = 16384;

constexpr size_t MiB = 1u << 20;
constexpr size_t WS_CTL = 0, CTL_ZERO_BYTES = 512 * 1024;
constexpr size_t WS_ROWSQ = 256 * 1024;
constexpr size_t WS_WIN = 1 * MiB, WS_WV = 11 * MiB, WS_WKV = 12 * MiB, WS_WBR = 14 * MiB, WS_WOUT = 17 * MiB, WS_WQ = 19 * MiB, WS_KEYS = 23 * MiB, WS_PWT = 23 * MiB + 512 * 1024;
constexpr size_t WS_MEMN = 24 * MiB, WS_KMEM = 26 * MiB, WS_VTMEM = 27 * MiB, WS_RSTDX = 28 * MiB, WS_SU = 28 * MiB + 256 * 1024  , WS_SV = 28 * MiB + 512 * 1024  ;
constexpr size_t WS_U8 = 32 * MiB, WS_V8 = 48 * MiB;
constexpr size_t WS_QN = 96 * MiB, WS_KN = 128 * MiB, WS_VT = 160 * MiB, WS_PP = 192 * MiB, WS_XQ = 224 * MiB, WS_GATE = 256 * MiB, WS_END = 448 * MiB;
constexpr size_t WS_MERGED = WS_QN;
constexpr size_t WS_HB = WS_VT;
constexpr size_t WS_QB = WS_GATE;
constexpr size_t WS_TE = WS_GATE + 128 * MiB, WS_TW = WS_TE + 16 * MiB;
constexpr size_t WS_HQ = WS_TW + 16 * MiB;
constexpr size_t WS_HS = 28 * MiB + 768 * 1024;
constexpr size_t WS_AW = WS_MERGED;
constexpr size_t OUT_XB = 0, OUT_YNA = 0, OUT_YPOOL = 512 * 2, OUT_YXA = 1024 * 2;
constexpr int CW_TMO = 0, CW_BAR = 4096, CW_TICKET = 8192;

constexpr int RING_OFF = 0, RING_BYTES = 131072;
constexpr int LDSCTL_OFF = RING_BYTES, MISC_OFF = LDSCTL_OFF + 320;
constexpr int LDS_BYTES = 147456;

#define GAS __attribute__((address_space(1)))
#define LAS __attribute__((address_space(3)))
typedef unsigned short bf16;
typedef unsigned v4u __attribute__((ext_vector_type(4)));
typedef unsigned v2u __attribute__((ext_vector_type(2)));
typedef float f32x4 __attribute__((ext_vector_type(4)));
typedef short bf16x8 __attribute__((ext_vector_type(8)));
typedef __bf16 bf16x2_t __attribute__((ext_vector_type(2)));
typedef GAS unsigned gu32;
#define LDS_WAIT() asm volatile("s_waitcnt lgkmcnt(0)" ::: "memory")
#define VM_WAIT() asm volatile("s_waitcnt vmcnt(0)" ::: "memory")
__device__ __forceinline__ unsigned f2bf(float f) { unsigned u = __builtin_bit_cast(unsigned, f); return (u + 0x7fffu + ((u >> 16) & 1u)) >> 16; }
__device__ __forceinline__ unsigned pk2(float lo, float hi) { return f2bf(lo) | (f2bf(hi) << 16); }
__device__ __forceinline__ float bflo(unsigned u) { return __builtin_bit_cast(float, u << 16); }
__device__ __forceinline__ float bfhi(unsigned u) { return __builtin_bit_cast(float, u & 0xffff0000u); }
__device__ __forceinline__ float bf1(short s) { return __builtin_bit_cast(float, ((unsigned)(unsigned short)s) << 16); }
__device__ __forceinline__ f32x4 mfma16(bf16x8 a, bf16x8 b, f32x4 c) { return __builtin_amdgcn_mfma_f32_16x16x32_bf16(a, b, c, 0, 0, 0); }
__device__ __forceinline__ float wave_sum(float v) {
#pragma unroll
    for (int o = 1; o < 64; o <<= 1) v += __shfl_xor(v, o);
    return v;
}

#define XB_TMO      128
#define XB_XCNT(j)  (256  + 64 * (j))
#define XB_XSUB(j)  (1280 + 64 * (j))
#define XB_XGEN(j)  (2304 + 64 * (j))
#define XB_TOP      3328
#define XB_TOPGEN   3392
#define XCD_BAR_WORDS 3456
#define XB_SPIN_CAP (1u << 18)

__device__ __forceinline__ unsigned xb_ld(unsigned* p)              { return __hip_atomic_load(p, __ATOMIC_RELAXED, __HIP_MEMORY_SCOPE_AGENT); }
__device__ __forceinline__ unsigned xb_add(unsigned* p, unsigned v) { return __hip_atomic_fetch_add(p, v, __ATOMIC_RELAXED, __HIP_MEMORY_SCOPE_AGENT); }
__device__ __forceinline__ unsigned xb_xcc_id() { return (unsigned)__builtin_amdgcn_s_getreg((3 << 11) | 20) & 0xFu; }
#define XB_SPIN(cond, bar) do { unsigned _sp = 0; while (cond) { __builtin_amdgcn_s_sleep(1); \
    if ((++_sp & 255u) == 0u) { if (xb_ld(&(bar)[XB_TMO])) break; if (_sp > XB_SPIN_CAP) { atomicAdd(&(bar)[XB_TMO], 1u); break; } } } } while (0)

struct XcdBarrier {
    unsigned* bar; unsigned x;
    volatile LAS unsigned* st;
};

__device__ __forceinline__ XcdBarrier xcd_barrier_post(unsigned* bar, volatile LAS unsigned* st) {
    XcdBarrier b; b.bar = bar; b.x = xb_xcc_id(); b.st = st;
    if (threadIdx.x == 0) (void)xb_add(&bar[XB_XCNT(b.x)], 1u);
    return b;
}
__device__ __forceinline__ void xcd_barrier_complete(unsigned* bar, unsigned x, unsigned& nloc, unsigned& nx) {
    const unsigned G = gridDim.x * gridDim.y * gridDim.z;
    unsigned sum, cnt, mine, sp = 0u;
    for (;;) {
        sum = 0u; cnt = 0u; mine = 0u;
#pragma unroll
        for (unsigned j = 0; j < 16; ++j) { const unsigned c = xb_ld(&bar[XB_XCNT(j)]); sum += c; cnt += (c > 0u) ? 1u : 0u; mine = (j == x) ? c : mine; }
        if (sum == G) break;
        __builtin_amdgcn_s_sleep(1);
        if ((++sp & 255u) == 0u) { if (xb_ld(&bar[XB_TMO])) break; if (sp > XB_SPIN_CAP) { atomicAdd(&bar[XB_TMO], 1u); break; } }
    }
    nloc = mine > 0u ? mine : 1u; nx = cnt > 0u ? cnt : 1u;
}

__device__ __forceinline__ void xcd_barrier(const XcdBarrier& b) {
    asm volatile("s_waitcnt vmcnt(0)" ::: "memory");
    __syncthreads();
    if (threadIdx.x == 0) {
        unsigned* bar = b.bar;
        __builtin_amdgcn_s_waitcnt(0);
        unsigned nloc = b.st[0], nx = b.st[1];
        if (nloc == 0u) { xcd_barrier_complete(bar, b.x, nloc, nx); b.st[0] = nloc; b.st[1] = nx; }
        const unsigned old = xb_add(&bar[XB_XSUB(b.x)], 1u);
        const unsigned gen = old / nloc;
        if (old + 1u == (gen + 1u) * nloc) {
            __builtin_amdgcn_fence(__ATOMIC_RELEASE, "agent");
            asm volatile("s_waitcnt vmcnt(0)" ::: "memory");
            const unsigned og = xb_add(&bar[XB_TOP], 1u);
            const unsigned tg = og / nx;
            if (og + 1u == (tg + 1u) * nx) xb_add(&bar[XB_TOPGEN], 1u);
            else XB_SPIN(xb_ld(&bar[XB_TOPGEN]) == tg, bar);
            __builtin_amdgcn_fence(__ATOMIC_ACQUIRE, "agent");
            xb_add(&bar[XB_XGEN(b.x)], 1u);
            asm volatile("s_waitcnt vmcnt(0)" ::: "memory");
        } else {
            XB_SPIN(xb_ld(&bar[XB_XGEN(b.x)]) == gen, bar);
            __builtin_amdgcn_fence(__ATOMIC_ACQUIRE, "agent");
            asm volatile("s_waitcnt vmcnt(0)" ::: "memory");
        }
    }
    __syncthreads();
}

struct Frame {
    LAS unsigned char* lds;
    volatile LAS unsigned* MISC;
    gu32* ctl;
    int tid, lane, wave, vcu, G;
    float* out; unsigned char* ws;
};
struct Args { const float* in[23]; float* out; unsigned char* ws; int ph_lo, ph_hi, probe, pad; };
enum { I_X = 0, I_MEM, I_MIXG, I_MEMG, I_WIN, I_GATEB, I_WKV, I_NAQG, I_NAKG, I_RPB, I_POOLW, I_POOLSC, I_XAQG, I_XAKG, I_WB0, I_WB1, I_WB2, I_WOUT, I_FFNG, I_WQ, I_KEYS, I_PU, I_PV };

__device__ __forceinline__ void p0_transpose_item(const float* W, int K, int N, int k0, int n0, bf16* dst, const float* kscale, LAS float* scr, int lane, int dpitch = 0) {
    if (dpitch == 0) dpitch = K;
#pragma unroll 8
    for (int i = 0; i < 32; ++i) { const int kk = 2 * i + (lane >> 5); float v = W[(size_t)(k0 + kk) * N + n0 + (lane & 31)]; if (kscale) v *= kscale[k0 + kk]; scr[kk * 33 + (lane & 31)] = v; }
    LDS_WAIT(); asm volatile("" ::: "memory");
    const int c = lane & 7;
#pragma unroll
    for (int j = 0; j < 4; ++j) { const int n = (lane >> 3) + 8 * j; const LAS float* s = scr + (8 * c) * 33 + n;
        v4u o; o.x = pk2(s[0 * 33], s[1 * 33]); o.y = pk2(s[2 * 33], s[3 * 33]); o.z = pk2(s[4 * 33], s[5 * 33]); o.w = pk2(s[6 * 33], s[7 * 33]);
        *(GAS v4u*)(dst + (size_t)n * dpitch + k0 + 8 * c) = o; }
    LDS_WAIT(); asm volatile("" ::: "memory");
}
__device__ __forceinline__ void cvt_row1024(const float* src, bf16* dst, const float* colscale, float rowscale, int lane) {
    const GAS f32x4* xr = (const GAS f32x4*)src + lane; GAS unsigned long long* o8 = (GAS unsigned long long*)dst + lane;
#pragma unroll
    for (int j = 0; j < 4; ++j) { f32x4 v = xr[64 * j] * rowscale; if (colscale) v = v * ((const GAS f32x4*)colscale)[lane + 64 * j];
        o8[64 * j] = (unsigned long long)pk2(v.x, v.y) | ((unsigned long long)pk2(v.z, v.w) << 32); }
}
__device__ __forceinline__ float row_rstd1024(const float* src, int lane) {
    const GAS f32x4* xr = (const GAS f32x4*)src + lane; float s = 0.f;
#pragma unroll
    for (int j = 0; j < 4; ++j) { const f32x4 v = xr[64 * j]; s += (v.x * v.x + v.y * v.y) + (v.z * v.z + v.w * v.w); }
    return rsqrtf(wave_sum(s) * (1.0f / 1024.0f) + 1e-6f);
}
__device__ __forceinline__ void p0_prologue(Frame& F, const Args& A) {
    LAS float* scr = (LAS float*)(F.lds + RING_OFF + F.wave * 16384);
    const int gw = F.vcu * NWAVES + F.wave, NGW = F.G * NWAVES, lane = F.lane;
    unsigned char* ws = F.ws;
    constexpr int I_IN = 16 * 176, I_KV = 16 * 32, I_BR = 8 * 32, I_OUT = 16 * 32, I_Q = 16 * 64;
    constexpr int NITEMS = I_IN + I_KV + 3 * I_BR + I_OUT + I_Q;
    for (int it = gw; it < NITEMS; it += NGW) {
        int r = it;
        if (r < I_IN) { const int kb = r / 176, nb = r % 176, n0 = 32 * nb; bf16* dst;
            if (n0 >= 1024 && n0 < 1536) dst = (bf16*)(ws + WS_WV) + (size_t)(n0 - 1024) * 1024;
            else { const int np = n0 < 1024 ? n0 : n0 - 512, t = np >> 8, w = np & 255, wc = w >> 6, bj = (w >> 5) & 1; dst = (bf16*)(ws + WS_WIN) + (size_t)(256 * t + 128 * bj + 32 * wc) * 1024; }
            p0_transpose_item(A.in[I_WIN], 1024, 5632, 64 * kb, n0, dst, A.in[I_MIXG], scr, lane); continue; }
        r -= I_IN;
        if (r < I_KV) { const int kb = r / 32, nb = r % 32; p0_transpose_item(A.in[I_WKV], 1024, 1024, 64 * kb, 32 * nb, (bf16*)(ws + WS_WKV) + (size_t)(32 * nb) * 1024, nullptr, scr, lane); continue; }
        r -= I_KV;
        if (r < 3 * I_BR) { const int br = r / I_BR, rr = r % I_BR, kb = rr / 32, nb = rr % 32; const float* W = br == 0 ? A.in[I_WB0] : (br == 1 ? A.in[I_WB1] : A.in[I_WB2]);
            p0_transpose_item(W, 512, 1024, 64 * kb, 32 * nb, (bf16*)(ws + WS_WBR) + (size_t)(32 * nb) * 1536 + br * 512, nullptr, scr, lane, 1536); continue; }
        r -= 3 * I_BR;
        if (r < I_OUT) { const int kb = r / 32, nb = r % 32; p0_transpose_item(A.in[I_WOUT], 1024, 1024, 64 * kb, 32 * nb, (bf16*)(ws + WS_WOUT) + (size_t)(32 * nb) * 1024, nullptr, scr, lane); continue; }
        r -= I_OUT;
        { const int kb = r / 64, nb = r % 64; p0_transpose_item(A.in[I_WQ], 1024, 2048, 64 * kb, 32 * nb, (bf16*)(ws + WS_WQ) + (size_t)(32 * nb) * 1024, A.in[I_FFNG], scr, lane); }
    }
    { bf16* xb = (bf16*)((unsigned char*)F.out + OUT_XB); float* rstdx = (float*)(ws + WS_RSTDX);
      for (int m0 = 4 * gw; m0 < T; m0 += 4 * NGW) {
          f32x4 v[4][4];
#pragma unroll
          for (int r = 0; r < 4; ++r)
#pragma unroll
              for (int j = 0; j < 4; ++j) v[r][j] = ((const GAS f32x4*)(A.in[I_X] + (size_t)(m0 + r) * D))[lane + 64 * j];
#pragma unroll
          for (int r = 0; r < 4; ++r) { float s = 0.f;
#pragma unroll
              for (int j = 0; j < 4; ++j) s += (v[r][j].x * v[r][j].x + v[r][j].y * v[r][j].y) + (v[r][j].z * v[r][j].z + v[r][j].w * v[r][j].w);
              const float rs = rsqrtf(wave_sum(s) * (1.0f / 1024.0f) + 1e-6f);
              GAS unsigned long long* o8 = (GAS unsigned long long*)(xb + (size_t)(m0 + r) * D) + lane;
#pragma unroll
              for (int j = 0; j < 4; ++j) o8[64 * j] = (unsigned long long)pk2(v[r][j].x, v[r][j].y) | ((unsigned long long)pk2(v[r][j].z, v[r][j].w) << 32);
              if (lane == 0) rstdx[m0 + r] = rs; } } }
    for (int m = gw; m < NMEMTOK; m += NGW) { const float* xr = A.in[I_MEM] + (size_t)m * D; const float rs = row_rstd1024(xr, lane); cvt_row1024(xr, (bf16*)(ws + WS_MEMN) + (size_t)m * D, A.in[I_MEMG], rs, lane); }
    for (int mb = 4 * gw; mb < 2 * NEXP; mb += 4 * NGW) {
        const bool isu = mb < NEXP; const int e0 = isu ? mb : mb - NEXP;
        f32x4 v[4][4];
#pragma unroll
        for (int r = 0; r < 4; ++r) { const GAS f32x4* src = (const GAS f32x4*)((isu ? A.in[I_PU] : A.in[I_PV]) + (size_t)(e0 + r) * D) + 4 * lane;
#pragma unroll
            for (int d = 0; d < 4; ++d) v[r][d] = src[d]; }
        f32x4 gv[4];
#pragma unroll
        for (int d = 0; d < 4; ++d) gv[d] = isu ? ((const GAS f32x4*)A.in[I_FFNG])[4 * lane + d] : (f32x4){1.f, 1.f, 1.f, 1.f};
#pragma unroll
        for (int r = 0; r < 4; ++r) { const int e = e0 + r; float mx = 0.f;
#pragma unroll
            for (int d = 0; d < 4; ++d) { v[r][d] = v[r][d] * gv[d]; mx = fmaxf(mx, fmaxf(fmaxf(fabsf(v[r][d].x), fabsf(v[r][d].y)), fmaxf(fabsf(v[r][d].z), fabsf(v[r][d].w)))); }
#pragma unroll
            for (int o = 1; o < 64; o <<= 1) mx = fmaxf(mx, __shfl_xor(mx, o));
            const float inv = mx > 0.f ? 127.0f / mx : 0.f;
            v4u w;
#pragma unroll
            for (int d = 0; d < 4; ++d) { const unsigned b0 = (unsigned)(int)rintf(v[r][d].x * inv) & 0xffu, b1 = (unsigned)(int)rintf(v[r][d].y * inv) & 0xffu,
                                                         b2 = (unsigned)(int)rintf(v[r][d].z * inv) & 0xffu, b3 = (unsigned)(int)rintf(v[r][d].w * inv) & 0xffu;
                w[d] = b0 | (b1 << 8) | (b2 << 16) | (b3 << 24); }
            if (isu) ((GAS v4u*)(ws + WS_U8))[(size_t)e * 64 + lane] = w;
            else *(GAS v4u*)(ws + WS_V8 + (size_t)(lane >> 3) * (2 * MiB) + (size_t)e * 128 + (lane & 7) * 16) = w;
            if (lane == 0) ((float*)(ws + WS_SU))[2 * e + (isu ? 0 : 1)] = mx * (1.0f / 127.0f); }
    }
    for (int m = gw * 64 + lane; m < T; m += NGW * 64) ((float*)(ws + WS_ROWSQ))[m] = 0.f;
    for (int m = gw; m < 256; m += NGW) cvt_row1024(A.in[I_KEYS] + (size_t)m * 1024, (bf16*)(ws + WS_KEYS) + (size_t)m * 1024, nullptr, 1.0f, lane);
    for (int m = gw; m < 1024; m += NGW) { const int gd = m >> 1, c = (m & 1) * 64 + lane, g = gd >> 7, d = gd & 127;
        const float v = A.in[I_POOLW][(size_t)(g * 128 + c) * 128 + d] * A.in[I_POOLSC][gd];
        ((bf16*)(ws + WS_PWT))[(size_t)gd * 128 + c] = (bf16)f2bf(v); }
}

__device__ __forceinline__ void memkv_tile(const bf16* memn, const bf16* wkvT, const float* kg, const float* qg, bf16* kmem, bf16* vtmem, int tile, int lane) {
    const int q = lane & 15, hi = lane >> 4, rg = tile >> 3, cg = tile & 7, r0 = rg * 16, c0 = cg * 128;
    f32x4 acc[8];
#pragma unroll
    for (int i = 0; i < 8; ++i) acc[i] = (f32x4){0.f, 0.f, 0.f, 0.f};
    const bf16* ap = memn + (size_t)(r0 + q) * 1024 + 8 * hi; const bf16* bp = wkvT + (size_t)(c0 + q) * 1024 + 8 * hi;
#pragma unroll 1
    for (int kb = 0; kb < 8; ++kb) {
        bf16x8 a[4], b[4][8];
#pragma unroll
        for (int k4 = 0; k4 < 4; ++k4) { a[k4] = *(const bf16x8*)(ap + 32 * (4 * kb + k4));
#pragma unroll
            for (int nf = 0; nf < 8; ++nf) b[k4][nf] = *(const bf16x8*)(bp + (size_t)(16 * nf) * 1024 + 32 * (4 * kb + k4)); }
        __builtin_amdgcn_sched_barrier(0);
#pragma unroll
        for (int k4 = 0; k4 < 4; ++k4)
#pragma unroll
            for (int nf = 0; nf < 8; ++nf) acc[nf] = mfma16(a[k4], b[k4][nf], acc[nf]);
        __builtin_amdgcn_sched_barrier(0);
    }
    if (cg < 4) {
        float rr[4];
#pragma unroll
        for (int g = 0; g < 4; ++g) { float ss = 0.f;
#pragma unroll
            for (int nf = 0; nf < 8; ++nf) ss += acc[nf][g] * acc[nf][g];
            ss += __shfl_xor(ss, 1); ss += __shfl_xor(ss, 2); ss += __shfl_xor(ss, 4); ss += __shfl_xor(ss, 8);
            rr[g] = rsqrtf(ss * (1.0f / 128.0f) + 1e-6f); }
#pragma unroll
        for (int nf = 0; nf < 8; ++nf) { const int d = 16 * nf + q; const float gs = kg[d] * qg[d];
#pragma unroll
            for (int g = 0; g < 4; ++g) kmem[(size_t)(r0 + 4 * hi + g) * 512 + cg * 128 + d] = (bf16)f2bf(acc[nf][g] * rr[g] * gs); }
    } else {
        const int h = cg - 4, b = r0 >> 8, key0 = (r0 & 255) + 4 * hi;
#pragma unroll
        for (int nf = 0; nf < 8; ++nf) { const int d = 16 * nf + q; v2u w; w.x = pk2(acc[nf][0], acc[nf][1]); w.y = pk2(acc[nf][2], acc[nf][3]);
            *(v2u*)(vtmem + (size_t)(b * 512 + h * 128 + d) * 256 + key0) = w; }
    }
}

__device__ __forceinline__ void na_item(const bf16* __restrict__ qn, const bf16* __restrict__ kn, const bf16* __restrict__ vt, const LAS float* rpl, bf16* __restrict__ yna,
                                        int b, int r, int jb, int h, int lane) {
    const int q = lane & 15, hi = lane >> 4;
    int rs = r - 4; rs = rs < 0 ? 0 : (rs > 120 ? 120 : rs);
    int kb0 = jb * 16 - 8; kb0 = kb0 < 0 ? 0 : (kb0 > 32 ? 32 : kb0);
    const int qcol = jb * 16 + q; int cs = qcol - 8; cs = cs < 0 ? 0 : (cs > 48 ? 48 : cs);
    const size_t tokq = (size_t)b * SEQ + r * 64 + qcol;
    const bf16* qp = qn + tokq * 512 + h * 64 + 8 * hi;
    const bf16x8 qf0 = *(const bf16x8*)qp, qf1 = *(const bf16x8*)(qp + 32);
    const int kq = 8 * (q >> 2) + (q & 3);
    const bf16* kbase = kn + ((size_t)b * SEQ + rs * 64 + kb0 + kq) * 512 + h * 64 + 8 * hi;
    f32x4 s[16];
    {
        bf16x8 ka[16][2];
#pragma unroll
        for (int f = 0; f < 16; ++f) { const bf16* kp = kbase + (size_t)((f >> 1) * 64 + (f & 1) * 4) * 512; ka[f][0] = *(const bf16x8*)kp; ka[f][1] = *(const bf16x8*)(kp + 32); }
        __builtin_amdgcn_sched_barrier(0);
#pragma unroll
        for (int f = 0; f < 16; ++f) { f32x4 z = (f32x4){0.f, 0.f, 0.f, 0.f}; z = mfma16(ka[f][0], qf0, z); s[f] = mfma16(ka[f][1], qf1, z); }
    }
    const bf16* vbase = vt + ((size_t)(b * 512 + h * 64 + q) * SEQ + rs * 64 + kb0 + 8 * hi);
    bf16x8 va[8][4];
#pragma unroll
    for (int st = 0; st < 8; ++st)
#pragma unroll
        for (int mf = 0; mf < 4; ++mf) va[st][mf] = *(const bf16x8*)(vbase + (size_t)(16 * mf) * SEQ + st * 64);
    __builtin_amdgcn_sched_barrier(0);
    float mx = -3.0e38f;
#pragma unroll
    for (int f = 0; f < 16; ++f) {
        const int dr = rs + (f >> 1) - r + 7;
#pragma unroll
        for (int g = 0; g < 4; ++g) {
            const int kcol = kb0 + 8 * hi + 4 * (f & 1) + g;
            const bool ok = (kcol >= cs) && (kcol < cs + 16);
            int dc = kcol - qcol + 15; dc = dc < 0 ? 0 : (dc > 30 ? 30 : dc);
            const float v = ok ? s[f][g] + rpl[dr * 31 + dc] : -1.0e30f;
            s[f][g] = v; mx = fmaxf(mx, v);
        }
    }
    mx = fmaxf(mx, __shfl_xor(mx, 16)); mx = fmaxf(mx, __shfl_xor(mx, 32));
    float sum = 0.f;
#pragma unroll
    for (int f = 0; f < 16; ++f)
#pragma unroll
        for (int g = 0; g < 4; ++g) { const float p = __expf(s[f][g] - mx); s[f][g] = p; sum += p; }
    sum += __shfl_xor(sum, 16); sum += __shfl_xor(sum, 32);
    const float inv = 1.0f / sum;
    f32x4 o[4];
#pragma unroll
    for (int i = 0; i < 4; ++i) o[i] = (f32x4){0.f, 0.f, 0.f, 0.f};
#pragma unroll
    for (int st = 0; st < 8; ++st) {
        const bf16x8 pb = __builtin_bit_cast(bf16x8, pg8::pack8(s[2 * st], s[2 * st + 1]));
#pragma unroll
        for (int mf = 0; mf < 4; ++mf) o[mf] = mfma16(va[st][mf], pb, o[mf]);
    }
    bf16* yp = yna + tokq * 1536 + h * 64 + 4 * hi;
#pragma unroll
    for (int mf = 0; mf < 4; ++mf) { v2u w; w.x = pk2(o[mf][0] * inv, o[mf][1] * inv); w.y = pk2(o[mf][2] * inv, o[mf][3] * inv); *(v2u*)(yp + 16 * mf) = w; }
}
__device__ __forceinline__ void xa_fill_lds(const bf16* __restrict__ kmem, const bf16* __restrict__ vtmem, LAS unsigned char* lds, int b, int h, int tid) {
#pragma unroll
    for (int ps = 0; ps < 8; ++ps) { const int id = tid + 512 * ps, key = id >> 4, c = id & 15;
        *(LAS v4u*)(lds + key * 256 + ((c ^ (key & 15)) << 4)) = *(const v4u*)(kmem + ((size_t)b * 256 + key) * 512 + h * 128 + 8 * c); }
#pragma unroll
    for (int ps = 0; ps < 8; ++ps) { const int id = tid + 512 * ps, dim = id >> 5, c = id & 31;
        *(LAS v4u*)(lds + 65536 + dim * 512 + ((c ^ (dim & 15)) << 4)) = *(const v4u*)(vtmem + (size_t)(b * 512 + h * 128 + dim) * 256 + 8 * c); }
}
__device__ __forceinline__ void xa_item(const bf16* __restrict__ xq, const LAS unsigned char* lds, bf16* __restrict__ yxa, int tok0, int h, int lane) {
    const int q = lane & 15, hi = lane >> 4; const size_t tok = (size_t)tok0 + q;
    const bf16* qp = xq + tok * 512 + h * 128 + 8 * hi;
    bf16x8 qf[4]; float ssq = 0.f;
#pragma unroll
    for (int ks = 0; ks < 4; ++ks) qf[ks] = *(const bf16x8*)(qp + 32 * ks);
    __builtin_amdgcn_sched_barrier(0);
#pragma unroll
    for (int ks = 0; ks < 4; ++ks)
#pragma unroll
        for (int j = 0; j < 8; ++j) { const float v = bf1(qf[ks][j]); ssq += v * v; }
    ssq += __shfl_xor(ssq, 16); ssq += __shfl_xor(ssq, 32);
    const float cexp = rsqrtf(ssq * (1.0f / 128.0f) + 1e-6f) * 0.08838834764831845f * 1.4426950408889634f;
    const int kq = 8 * (q >> 2) + (q & 3);
    f32x4 s[16];
#pragma unroll
    for (int f = 0; f < 16; ++f) { const int key = 32 * (f >> 1) + 4 * (f & 1) + kq; const LAS unsigned char* kr = lds + key * 256; f32x4 z = (f32x4){0.f, 0.f, 0.f, 0.f};
#pragma unroll
        for (int ks = 0; ks < 4; ++ks) z = mfma16(*(const LAS bf16x8*)(kr + (((4 * ks + hi) ^ (key & 15)) << 4)), qf[ks], z);
        s[f] = z; }
    float mx = -3.0e38f;
#pragma unroll
    for (int f = 0; f < 16; ++f)
#pragma unroll
        for (int g = 0; g < 4; ++g) mx = fmaxf(mx, s[f][g]);
    mx = fmaxf(mx, __shfl_xor(mx, 16)); mx = fmaxf(mx, __shfl_xor(mx, 32));
    float sum = 0.f;
#pragma unroll
    for (int f = 0; f < 16; ++f)
#pragma unroll
        for (int g = 0; g < 4; ++g) { const float p = __builtin_amdgcn_exp2f((s[f][g] - mx) * cexp); s[f][g] = p; sum += p; }
    sum += __shfl_xor(sum, 16); sum += __shfl_xor(sum, 32);
    const float inv = 1.0f / sum;
    f32x4 o[8];
#pragma unroll
    for (int i = 0; i < 8; ++i) o[i] = (f32x4){0.f, 0.f, 0.f, 0.f};
#pragma unroll
    for (int st = 0; st < 8; ++st) {
        const bf16x8 pb = __builtin_bit_cast(bf16x8, pg8::pack8(s[2 * st], s[2 * st + 1]));
#pragma unroll
        for (int mf = 0; mf < 8; ++mf) { const int dim = 16 * mf + q; o[mf] = mfma16(*(const LAS bf16x8*)(lds + 65536 + dim * 512 + (((4 * st + hi) ^ (dim & 15)) << 4)), pb, o[mf]); }
    }
    bf16* yp = yxa + tok * 1536 + h * 128 + 4 * hi;
#pragma unroll
    for (int mf = 0; mf < 8; ++mf) { v2u w; w.x = pk2(o[mf][0] * inv, o[mf][1] * inv); w.y = pk2(o[mf][2] * inv, o[mf][3] * inv); *(v2u*)(yp + 16 * mf) = w; }
}
__device__ __forceinline__ void pool_wg(const bf16* __restrict__ pp, const bf16* __restrict__ pwT, bf16* __restrict__ ypool, LAS unsigned char* lds, int tokbase, int wave, int lane) {
    const int q = lane & 15, hi = lane >> 4;
    __syncthreads();
    {
        const int hw = 1 << hi, tw0 = tokbase + 16 * wave, b = tw0 >> 13, t0 = tw0 & 8191;
        const bf16* base = pp + (size_t)b * SEQ * 512 + 8 * lane;
        float s[8];
#pragma unroll
        for (int j = 0; j < 8; ++j) s[j] = 0.f;
#pragma unroll 4
        for (int d = -8; d < 8; ++d) { const int u = t0 + d; const bool ok = (d >= -hw) && (d < hw) && (u >= 0) && (u < SEQ);
            const bf16x8 v = *(const bf16x8*)(base + (size_t)(ok ? u : t0) * 512);
#pragma unroll
            for (int j = 0; j < 8; ++j) s[j] += ok ? bf1(v[j]) : 0.f; }
        LAS unsigned char* tile = lds + wave * 16384;
#pragma unroll 4
        for (int i = 0; i < 16; ++i) { const int t = t0 + i;
            int lo = t - hw; lo = lo < 0 ? 0 : lo; int ht = t + hw; ht = ht > SEQ ? SEQ : ht;
            const float inv = 1.0f / (float)(ht - lo);
            const bool oka = (t + hw) < SEQ, oks = (t - hw) >= 0;
            const bf16x8 sv = *(const bf16x8*)(base + (size_t)t * 512), av = *(const bf16x8*)(base + (size_t)(oka ? t + hw : t) * 512), bv = *(const bf16x8*)(base + (size_t)(oks ? t - hw : t) * 512);
            f32x4 p0, p1;
#pragma unroll
            for (int j = 0; j < 4; ++j) { p0[j] = s[j] * inv - bf1(sv[j]); p1[j] = s[j + 4] * inv - bf1(sv[j + 4]); }
            *(LAS v4u*)(tile + i * 1024 + ((lane ^ (i & 15)) << 4)) = pg8::pack8(p0, p1);
#pragma unroll
            for (int j = 0; j < 8; ++j) s[j] += (oka ? bf1(av[j]) : 0.f) - (oks ? bf1(bv[j]) : 0.f);
        }
    }
    __syncthreads();
#pragma unroll 1
    for (int k = 0; k < 4; ++k) {
        const int pair = wave * 4 + k, g = pair >> 3, mf = pair & 7;
        const bf16* wb = pwT + (size_t)(g * 128 + 16 * mf + q) * 128 + 8 * hi;
        bf16x8 a[4];
#pragma unroll
        for (int ks = 0; ks < 4; ++ks) a[ks] = *(const bf16x8*)(wb + 32 * ks);
#pragma unroll 2
        for (int tg = 0; tg < 8; ++tg) {
            const LAS unsigned char* trow = lds + tg * 16384 + q * 1024; f32x4 o = (f32x4){0.f, 0.f, 0.f, 0.f};
#pragma unroll
            for (int ks = 0; ks < 4; ++ks) { const int c = g * 16 + 4 * ks + hi; o = mfma16(a[ks], *(const LAS bf16x8*)(trow + ((c ^ q) << 4)), o); }
            v2u w; w.x = pk2(o[0], o[1]); w.y = pk2(o[2], o[3]);
            *(v2u*)(ypool + (size_t)(tokbase + 16 * tg + q) * 1536 + g * 128 + 16 * mf + 4 * hi) = w;
        }
    }
    __syncthreads();
}

__device__ __forceinline__ int f2key(float s, int idx, int mask) { int b = __builtin_bit_cast(int, s); b = b >= 0 ? b : (b ^ 0x7fffffff); return (b & ~mask) | idx; }
__device__ __forceinline__ float key2f(int k) { k = k >= 0 ? k : (k ^ 0x7fffffff); return __builtin_bit_cast(float, k); }
#define CE_DESC(x, y) do { const int _h = (x) > (y) ? (x) : (y), _l = (x) > (y) ? (y) : (x); (x) = _h; (y) = _l; } while (0)
__device__ __forceinline__ void sort16(int (&a)[16]) {
#pragma unroll
    for (int ks = 1; ks <= 4; ++ks)
#pragma unroll
        for (int js = ks - 1; js >= 0; --js)
#pragma unroll
            for (int i = 0; i < 16; ++i) { const int k = 1 << ks, j = 1 << js, l = i ^ j;
                if (l > i) { if ((i & k) == 0) CE_DESC(a[i], a[l]); else CE_DESC(a[l], a[i]); } }
}
__device__ __forceinline__ void merge16(int (&a)[16], const int (&b)[16]) {
#pragma unroll
    for (int i = 0; i < 16; ++i) a[i] = a[i] > b[15 - i] ? a[i] : b[15 - i];
#pragma unroll
    for (int js = 3; js >= 0; --js)
#pragma unroll
        for (int i = 0; i < 16; ++i) { const int j = 1 << js, l = i ^ j; if (l > i) CE_DESC(a[i], a[l]); }
}
__device__ __forceinline__ void merge16_lanes(int (&a)[16], int step) { int o[16];
#pragma unroll
    for (int k = 0; k < 16; ++k) o[k] = __shfl_xor(a[k], step);
    merge16(a, o); }
__device__ constexpr int cand_i(int hi, int m) {
    return hi == 0 ? 0
         : hi == 1 ? (m < 8 ? 1 : (m < 13 ? 2 : -1))
         : hi == 2 ? (m < 4 ? 3 : (m < 7 ? 4 : (m < 9 ? 5 : (m < 11 ? 6 : -1))))
         :           (m < 2 ? 7 : (m < 10 ? 8 + (m - 2) : -1));
}
__device__ constexpr int cand_j(int hi, int m) {
    return hi == 0 ? m
         : hi == 1 ? (m < 8 ? m : (m < 13 ? m - 8 : -1))
         : hi == 2 ? (m < 4 ? m : (m < 7 ? m - 4 : (m < 9 ? m - 7 : (m < 11 ? m - 9 : -1))))
         :           (m < 2 ? m : (m < 10 ? 0 : -1));
}
__device__ __forceinline__ void topk_fill_lds(const bf16* __restrict__ keys, LAS unsigned char* lds, int h, int tid) {
#pragma unroll
    for (int ps = 0; ps < 8; ++ps) { const int id = tid + 512 * ps, row = id >> 4, c = id & 15;
        *(LAS v4u*)(lds + row * 256 + ((c ^ (row & 15)) << 4)) = *(const v4u*)(keys + ((size_t)h * 256 + row) * 128 + 8 * c); }
}
struct TopkQ { bf16x8 q[2][4]; };
__device__ __forceinline__ void topk_loadq(TopkQ& Q, const bf16* __restrict__ qb, int tok0, int h, int lane) {
    const size_t tok = (size_t)tok0 + (lane & 15); const int hi = lane >> 4;
#pragma unroll
    for (int p = 0; p < 2; ++p)
#pragma unroll
        for (int ks = 0; ks < 4; ++ks) Q.q[p][ks] = *(const bf16x8*)(qb + tok * 2048 + h * 256 + p * 128 + 32 * ks + 8 * hi);
}
__device__ __forceinline__ void topk_item(const TopkQ& Q, const LAS unsigned char* klds, int* __restrict__ te, float* __restrict__ tw, LAS int* lscr, int tok0, int h, int lane) {
    const int q = lane & 15, hi = lane >> 4; const size_t tok = (size_t)tok0 + q;
    int L[2][16];
#pragma unroll
    for (int p = 0; p < 2; ++p) {
        int B[16];
#pragma unroll
        for (int mf = 0; mf < 8; ++mf) { f32x4 s = (f32x4){0.f, 0.f, 0.f, 0.f}; const int row = p * 128 + 16 * mf + q;
#pragma unroll
            for (int ks = 0; ks < 4; ++ks) s = mfma16(*(const LAS bf16x8*)(klds + row * 256 + (((4 * ks + hi) ^ (row & 15)) << 4)), Q.q[p][ks], s);
#pragma unroll
            for (int g = 0; g < 4; ++g) { const int key = f2key(s[g], 16 * mf + 4 * hi + g, 127); if (mf < 4) L[p][4 * mf + g] = key; else B[4 * (mf - 4) + g] = key; } }
        sort16(L[p]); sort16(B); merge16(L[p], B);
        merge16_lanes(L[p], 16); merge16_lanes(L[p], 32);
    }
    float v1[16], v2[16];
#pragma unroll
    for (int k = 0; k < 16; ++k) { v1[k] = key2f(L[0][k]); v2[k] = key2f(L[1][k]); }
    int Fk[16];
#pragma unroll
    for (int m = 0; m < 16; ++m) {
        float sm = v1[0] + v2[m]; int id = 255 - m;
        if (cand_i(1, m) >= 0) { if (hi == 1) { sm = v1[cand_i(1, m) < 0 ? 0 : cand_i(1, m)] + v2[cand_j(1, m) < 0 ? 0 : cand_j(1, m)]; id = 255 - ((cand_i(1, m) << 4) | cand_j(1, m)); } }
        if (cand_i(2, m) >= 0) { if (hi == 2) { sm = v1[cand_i(2, m) < 0 ? 0 : cand_i(2, m)] + v2[cand_j(2, m) < 0 ? 0 : cand_j(2, m)]; id = 255 - ((cand_i(2, m) << 4) | cand_j(2, m)); } }
        if (cand_i(3, m) >= 0) { if (hi == 3) { sm = v1[cand_i(3, m) < 0 ? 0 : cand_i(3, m)] + v2[cand_j(3, m) < 0 ? 0 : cand_j(3, m)]; id = 255 - ((cand_i(3, m) << 4) | cand_j(3, m)); } }
        int key = f2key(sm, id, 255);
        if ((hi == 1 && cand_i(1, m) < 0) || (hi == 2 && cand_i(2, m) < 0) || (hi == 3 && cand_i(3, m) < 0)) key = (int)0x80000000;
        Fk[m] = key;
    }
    sort16(Fk); merge16_lanes(Fk, 16); merge16_lanes(Fk, 32);
    LAS int* my = lscr + lane * 32;
#pragma unroll
    for (int k = 0; k < 16; ++k) { my[k] = L[0][k] & 127; my[16 + k] = L[1][k] & 127; }
    LDS_WAIT(); asm volatile("" ::: "memory");
    float e[16]; float sum = 0.f; const float mx = key2f(Fk[0]);
#pragma unroll
    for (int k = 0; k < 16; ++k) { e[k] = __expf(key2f(Fk[k]) - mx); sum += e[k]; }
    const float inv = 1.0f / sum;
    if (hi == 0) {
        int* tep = te + tok * 128; float* twp = tw + tok * 128;
#pragma unroll
        for (int kk = 0; kk < 16; ++kk) { const int ij = 255 - (Fk[kk] & 255), i = ij >> 4, j = ij & 15, slot = (kk & 7) * 16 + 2 * h + (kk >> 3);
            tep[slot] = my[i] * 128 + my[16 + j]; twp[slot] = e[kk] * inv; }
    }
    LDS_WAIT(); asm volatile("" ::: "memory");
}

__device__ __forceinline__ float ub2f(unsigned v, int b) { return (float)((v >> (8 * b)) & 0xffu); }
struct HqIn { v4u hA, hB; float rsq; };
__device__ __forceinline__ void hq_load(HqIn& in, const bf16* __restrict__ hb, const float* __restrict__ rowsq, int tok, int lane) {
    const bf16* hp = hb + (size_t)tok * 1024 + 16 * lane; in.hA = *(const v4u*)hp; in.hB = *(const v4u*)(hp + 8); in.rsq = rowsq[tok]; }
__device__ __forceinline__ void hq_token(const HqIn& in, unsigned char* __restrict__ hq, float* __restrict__ hs, int tok, int lane) {
    const v4u hA = in.hA, hB = in.hB;
    float hf[16];
#pragma unroll
    for (int d = 0; d < 4; ++d) { hf[2 * d] = bflo(hA[d]); hf[2 * d + 1] = bfhi(hA[d]); hf[8 + 2 * d] = bflo(hB[d]); hf[8 + 2 * d + 1] = bfhi(hB[d]); }
    float amax = 0.f;
#pragma unroll
    for (int j = 0; j < 16; ++j) amax = fmaxf(amax, fabsf(hf[j]));
#pragma unroll
    for (int o = 1; o < 64; o <<= 1) amax = fmaxf(amax, __shfl_xor(amax, o));
    const float hinv = amax > 0.f ? 127.0f / amax : 0.f;
    v4u w;
#pragma unroll
    for (int d = 0; d < 4; ++d) { const unsigned b0 = (unsigned)(int)rintf(hf[4 * d] * hinv) & 0xffu, b1 = (unsigned)(int)rintf(hf[4 * d + 1] * hinv) & 0xffu,
                                                 b2 = (unsigned)(int)rintf(hf[4 * d + 2] * hinv) & 0xffu, b3 = (unsigned)(int)rintf(hf[4 * d + 3] * hinv) & 0xffu;
        w[d] = b0 | (b1 << 8) | (b2 << 16) | (b3 << 24); }
    *(v4u*)(hq + (size_t)tok * 1024 + 16 * lane) = w;
    if (lane == 0) hs[tok] = rsqrtf(in.rsq * (1.0f / 1024.0f) + 1e-6f) * amax * (1.0f / 127.0f);
}
constexpr int PA_SLOTS = 12;
struct PeerA1 { int e; float g; };
struct PeerA2 { v4u ur[3][4]; float su, sv; int cnt, rk; bool m; unsigned long long rem; };
struct PeerAH { v4u hv[4]; float hsc; };
__device__ __forceinline__ void pa_s1(PeerA1& a, const int* __restrict__ te, const float* __restrict__ tw, int tok, int half, int lane) {
    a.e = te[(size_t)tok * 128 + 64 * half + lane]; a.g = tw[(size_t)tok * 128 + 64 * half + lane]; }
__device__ __forceinline__ void pa_s1h(PeerAH& h, const unsigned char* __restrict__ hq, const float* __restrict__ hs, int tok, int lane) {
    const int t = lane & 15;
#pragma unroll
    for (int i = 0; i < 4; ++i) h.hv[i] = *(const v4u*)(hq + (size_t)tok * 1024 + 16 * t + 256 * i);
    h.hsc = hs[tok]; }
__device__ __forceinline__ void pa_s2(PeerA2& b, const PeerA1& a, const unsigned char* __restrict__ u8, const float* __restrict__ su, LAS int* lst, int x, int lane, int hot) {
    b.m = (a.e >> 11) == x;
    const unsigned long long mask = __ballot(b.m);
    b.cnt = __popcll(mask); b.rk = (int)__builtin_amdgcn_mbcnt_hi((unsigned)(mask >> 32), __builtin_amdgcn_mbcnt_lo((unsigned)mask, 0u));
    if (b.m && b.rk < PA_SLOTS) lst[b.rk] = a.e;
    b.rem = 0ull; if (b.cnt > PA_SLOTS) { unsigned long long r = mask;
#pragma unroll
        for (int k = 0; k < PA_SLOTS; ++k) r &= r - 1ull;
        b.rem = r; }
    { typedef float f32x2s __attribute__((ext_vector_type(2))); f32x2s s2 = (f32x2s){0.f, 0.f}; if (b.m) s2 = ((const f32x2s*)su)[a.e]; b.su = s2.x; b.sv = s2.y; }
    const int r = lane >> 4, t = lane & 15;
    LDS_WAIT(); asm volatile("" ::: "memory");
    const int lim = b.cnt < PA_SLOTS ? b.cnt : PA_SLOTS;
#pragma unroll
    for (int q = 0; q < 3; ++q) { const int slot = 4 * q + r;
        if (slot < lim) { int e = lst[slot]; if (hot) e = (x << 11) | (e & 255); const unsigned char* rp = u8 + (size_t)e * 1024 + 16 * t;
#pragma unroll
            for (int i = 0; i < 4; ++i) b.ur[q][i] = *(const v4u*)(rp + 256 * i); } }
}
__device__ __forceinline__ int dot16(const v4u u, const v4u h) { int d = __builtin_amdgcn_sdot4((int)u.x, (int)h.x, 0, false); d = __builtin_amdgcn_sdot4((int)u.y, (int)h.y, d, false);
    d = __builtin_amdgcn_sdot4((int)u.z, (int)h.z, d, false); return __builtin_amdgcn_sdot4((int)u.w, (int)h.w, d, false); }
template <int CTRL, int RM> __device__ __forceinline__ int dpp_i(int x) { return __builtin_amdgcn_update_dpp(0, x, CTRL, RM, 0xf, false); }
__device__ __forceinline__ int wave_sum_to63(int x) { x += dpp_i<0xb1, 0xf>(x); x += dpp_i<0x4e, 0xf>(x); x += dpp_i<0x124, 0xf>(x); x += dpp_i<0x128, 0xf>(x); x += dpp_i<0x142, 0xa>(x); x += dpp_i<0x143, 0xc>(x); return x; }
__device__ __forceinline__ int row_sum16(int x) { x += dpp_i<0xb1, 0xf>(x); x += dpp_i<0x4e, 0xf>(x); x += dpp_i<0x124, 0xf>(x); x += dpp_i<0x128, 0xf>(x); return x; }
__device__ __forceinline__ float gelu_erf(float v) {
    const float av = fabsf(v), t = __builtin_amdgcn_rcpf(av * 0.2316418882f + 1.0f);
    float q = t * 0.5307027145f + (-0.7265760135f); q = q * t + 0.7107068705f; q = q * t + (-0.142248368f); q = q * t + 0.127414796f; q = q * t;
    const float e = __builtin_amdgcn_exp2f((v * v) * (-0.72134752044f)), m = v * (q * e);
    return v < 0.f ? m : v - m; }
__device__ __forceinline__ void pa_s3(const PeerA2& b, const PeerA1& a, const PeerAH& h, const unsigned char* __restrict__ u8, const unsigned char* __restrict__ hq, float* __restrict__ aw, int tok, int half, int lane) {
    int mine = 0;
#pragma unroll
    for (int q = 0; q < 3; ++q) { int d = dot16(b.ur[q][0], h.hv[0]); d += dot16(b.ur[q][1], h.hv[1]); d += dot16(b.ur[q][2], h.hv[2]); d += dot16(b.ur[q][3], h.hv[3]);
        d = row_sum16(d);
#pragma unroll
        for (int r = 0; r < 4; ++r) { const int s = __builtin_amdgcn_readlane(d, 16 * r); mine = (b.rk == 4 * q + r) ? s : mine; } }
    float* awp = aw + (size_t)tok * 128 + 64 * half + lane;
    if (b.m && b.rk < PA_SLOTS) *awp = a.g * gelu_erf((float)mine * h.hsc * b.su) * b.sv;
    if (b.cnt > PA_SLOTS) {
        unsigned long long rem = b.rem; const v4u hw = *(const v4u*)(hq + (size_t)tok * 1024 + 16 * lane);
        while (rem != 0ull) { const int idx = __builtin_ctzll(rem); rem &= rem - 1ull; const int e = __builtin_amdgcn_readlane(a.e, idx);
            const int d = __builtin_amdgcn_readlane(wave_sum_to63(dot16(*(const v4u*)(u8 + (size_t)e * 1024 + 16 * lane), hw)), 63);
            if (lane == idx) *awp = a.g * gelu_erf((float)d * h.hsc * b.su) * b.sv; }
    }
}
__device__ __forceinline__ void peer_a_run(const unsigned char* __restrict__ hq, const float* __restrict__ hs, const unsigned char* __restrict__ u8, const float* __restrict__ su,
                                           const float* __restrict__ sv, const int* __restrict__ te, const float* __restrict__ tw, float* __restrict__ aw, LAS int* lst, int wrank, int wstep, int x, int lane, int hot = 0) {
    const int ntok = wrank < T ? (T - wrank + wstep - 1) / wstep : 0, N = 2 * ntok; (void)sv;
#define PA_TOK(n) (wrank + ((n) >> 1) * wstep)
    if (N == 0) return;
    PeerA1 a0, a1, a2, a3; PeerA2 bA, bB; PeerAH h0, h1;
#pragma unroll
    for (int q = 0; q < 3; ++q)
#pragma unroll
        for (int i = 0; i < 4; ++i) { bA.ur[q][i] = (v4u){0u, 0u, 0u, 0u}; bB.ur[q][i] = (v4u){0u, 0u, 0u, 0u}; }
    pa_s1(a0, te, tw, PA_TOK(0), 0, lane); pa_s1(a1, te, tw, PA_TOK(1), 1, lane); pa_s1h(h0, hq, hs, PA_TOK(0), lane);
    if (N > 2) { pa_s1(a2, te, tw, PA_TOK(2), 0, lane); pa_s1(a3, te, tw, PA_TOK(3), 1, lane); pa_s1h(h1, hq, hs, PA_TOK(2), lane); }
    pa_s2(bA, a0, u8, su, lst, x, lane, hot);
#define PA_STEP(n, Bcur, Bnext, Acur, Anext, Hcur, LOADH) do { \
        if ((n) + 1 < N) pa_s2(Bnext, Anext, u8, su, lst, x, lane, hot); \
        pa_s3(Bcur, Acur, Hcur, u8, hq, aw, PA_TOK(n), (n) & 1, lane); \
        if ((n) + 4 < N) { pa_s1(Acur, te, tw, PA_TOK((n) + 4), (n) & 1, lane); } \
        if (LOADH && (n) + 3 < N) pa_s1h(Hcur, hq, hs, PA_TOK((n) + 3), lane); } while (0)
    for (int n = 0; n < N; n += 4) {
        PA_STEP(n, bA, bB, a0, a1, h0, 0);
        if (n + 1 < N) PA_STEP(n + 1, bB, bA, a1, a2, h0, 1);
        if (n + 2 < N) PA_STEP(n + 2, bA, bB, a2, a3, h1, 0);
        if (n + 3 < N) PA_STEP(n + 3, bB, bA, a3, a0, h1, 1);
    }
#undef PA_STEP
#undef PA_TOK
}
struct PeerB1 { v4u e[4]; f32x4 w[4]; unsigned h2; };
struct PeerB2 { v4u vr[8]; };
struct PeerBAcc { int acc[16]; int wq[4]; float wsc, h0, h1; };
typedef float f32x2v __attribute__((ext_vector_type(2)));
__device__ __forceinline__ void pb_s1(PeerB1& a, const int* __restrict__ te, const float* __restrict__ aw, int tok, int lane) {
    const v4u* ep = (const v4u*)(te + (size_t)tok * 128 + 16 * (lane >> 3)); const f32x4* wp = (const f32x4*)(aw + (size_t)tok * 128 + 16 * (lane >> 3));
#pragma unroll
    for (int j = 0; j < 4; ++j) { a.e[j] = ep[j]; a.w[j] = wp[j]; } }
__device__ __forceinline__ int pb_col(int lane) { return 16 * (lane & 7) + 8 * ((lane >> 5) & 1) + 4 * ((lane >> 4) & 1) + 2 * ((lane >> 3) & 1); }
template <int CTRL, int RM> __device__ __forceinline__ float dpp_f(float x) { return __builtin_bit_cast(float, __builtin_amdgcn_update_dpp(0, __builtin_bit_cast(int, x), CTRL, RM, 0xf, false)); }
__device__ __forceinline__ void pb_quant(PeerBAcc& A, const PeerB1& a) {
    float mx = 0.f;
#pragma unroll
    for (int j = 0; j < 4; ++j) mx = fmaxf(mx, fmaxf(fmaxf(fabsf(a.w[j][0]), fabsf(a.w[j][1])), fmaxf(fabsf(a.w[j][2]), fabsf(a.w[j][3]))));
    mx = fmaxf(mx, dpp_f<0xb1, 0xf>(mx)); mx = fmaxf(mx, dpp_f<0x4e, 0xf>(mx)); mx = fmaxf(mx, dpp_f<0x124, 0xf>(mx)); mx = fmaxf(mx, dpp_f<0x128, 0xf>(mx));
    mx = fmaxf(mx, dpp_f<0x142, 0xa>(mx)); mx = fmaxf(mx, dpp_f<0x143, 0xc>(mx));
    mx = __builtin_bit_cast(float, __builtin_amdgcn_readlane(__builtin_bit_cast(int, mx), 63));
    const float inv = mx > 0.f ? 127.0f / mx : 0.f; A.wsc = mx * (1.0f / 127.0f);
#pragma unroll
    for (int j = 0; j < 4; ++j) A.wq[j] = (int)(((unsigned)(int)rintf(a.w[j][0] * inv) & 0xffu) | (((unsigned)(int)rintf(a.w[j][1] * inv) & 0xffu) << 8) |
                                               (((unsigned)(int)rintf(a.w[j][2] * inv) & 0xffu) << 16) | (((unsigned)(int)rintf(a.w[j][3] * inv) & 0xffu) << 24));
}
template <int HF, int MODE> __device__ __forceinline__ void pb_s2(PeerB2& b, const PeerB1& a, const unsigned char* __restrict__ v8x, int lane) {
    const int c = lane & 7;
#pragma unroll
    for (int m = 0; m < 8; ++m) { unsigned e = a.e[2 * HF + (m >> 2)][m & 3]; if (MODE & 1) e &= 255u;
        if (MODE & 2) b.vr[m] = (v4u){e, e + 1u, e + 2u, e + 3u}; else b.vr[m] = *(const v4u*)(v8x + (size_t)e * 128 + 16 * c); }
}
__device__ __forceinline__ float swap32_add(float lo, float hi) { const auto r = __builtin_amdgcn_permlane32_swap(__builtin_bit_cast(unsigned, lo), __builtin_bit_cast(unsigned, hi), false, false);
    return __builtin_bit_cast(float, r[0]) + __builtin_bit_cast(float, r[1]); }
__device__ __forceinline__ float swap16_add(float lo, float hi) { const auto r = __builtin_amdgcn_permlane16_swap(__builtin_bit_cast(unsigned, lo), __builtin_bit_cast(unsigned, hi), false, false);
    return __builtin_bit_cast(float, r[0]) + __builtin_bit_cast(float, r[1]); }
template <int HF, int MODE> __device__ __forceinline__ void pb_s3(PeerBAcc& A, const PeerB2& b, const PeerB1& a, float* out, int tok, int x, int lane) {
    if (MODE & 8) { if (HF == 0) { A.acc[0] = 0; }
#pragma unroll
        for (int m = 0; m < 8; ++m) A.acc[0] += (int)(b.vr[m].x ^ b.vr[m].y ^ b.vr[m].z ^ b.vr[m].w);
        if (HF == 1) { f32x2v h2; h2.x = A.h0 + (float)A.acc[0]; h2.y = A.h1 + A.wsc; *(f32x2v*)(out + (size_t)tok * 1024 + 128 * x + pb_col(lane)) = h2; }
        return; }
    if (HF == 0) {
#pragma unroll
        for (int j = 0; j < 16; ++j) A.acc[j] = 0;
    }
#pragma unroll
    for (int gg = 0; gg < 2; ++gg)
#pragma unroll
        for (int d = 0; d < 4; ++d) { const unsigned ra = b.vr[4 * gg][d], rb = b.vr[4 * gg + 1][d], rc = b.vr[4 * gg + 2][d], rd = b.vr[4 * gg + 3][d];
            const unsigned t0 = __builtin_amdgcn_perm(rb, ra, 0x05010400u), t1 = __builtin_amdgcn_perm(rb, ra, 0x07030602u), t2 = __builtin_amdgcn_perm(rd, rc, 0x05010400u), t3 = __builtin_amdgcn_perm(rd, rc, 0x07030602u);
            const unsigned c0 = __builtin_amdgcn_perm(t2, t0, 0x05040100u), c1 = __builtin_amdgcn_perm(t2, t0, 0x07060302u), c2 = __builtin_amdgcn_perm(t3, t1, 0x05040100u), c3 = __builtin_amdgcn_perm(t3, t1, 0x07060302u);
            const int w4 = A.wq[2 * HF + gg];
            A.acc[4 * d] = __builtin_amdgcn_sdot4((int)c0, w4, A.acc[4 * d], false); A.acc[4 * d + 1] = __builtin_amdgcn_sdot4((int)c1, w4, A.acc[4 * d + 1], false);
            A.acc[4 * d + 2] = __builtin_amdgcn_sdot4((int)c2, w4, A.acc[4 * d + 2], false); A.acc[4 * d + 3] = __builtin_amdgcn_sdot4((int)c3, w4, A.acc[4 * d + 3], false); }
    if (HF == 1) {
        int r8[8], r4[4], r2[2];
#pragma unroll
        for (int j = 0; j < 8; ++j) { const bool up = (lane & 32) != 0; const int keep = up ? A.acc[j + 8] : A.acc[j], send = up ? A.acc[j] : A.acc[j + 8]; r8[j] = keep + __shfl_xor(send, 32); }
#pragma unroll
        for (int j = 0; j < 4; ++j) { const bool up = (lane & 16) != 0; const int keep = up ? r8[j + 4] : r8[j], send = up ? r8[j] : r8[j + 4]; r4[j] = keep + __shfl_xor(send, 16); }
#pragma unroll
        for (int j = 0; j < 2; ++j) { const bool up = (lane & 8) != 0; const int keep = up ? r4[j + 2] : r4[j], send = up ? r4[j] : r4[j + 2];
            r2[j] = keep + __builtin_amdgcn_update_dpp(0, send, 0x128, 0xf, 0xf, false); }
        f32x2v h2; h2.x = A.h0 + A.wsc * (float)r2[0]; h2.y = A.h1 + A.wsc * (float)r2[1];
        *(f32x2v*)(out + (size_t)tok * 1024 + 128 * x + pb_col(lane)) = h2;
    }
}
__device__ __forceinline__ void pb_s1h(PeerB1& a, const int* __restrict__ te, const float* __restrict__ aw, const bf16* __restrict__ hb, int tok, int x, int lane) {
    pb_s1(a, te, aw, tok, lane); a.h2 = *(const unsigned*)(hb + (size_t)tok * 1024 + 128 * x + pb_col(lane)); }
template <int MODE> __device__ __forceinline__ void peer_b_run(const unsigned char* __restrict__ v8x, const int* __restrict__ te, const float* __restrict__ aw, const bf16* __restrict__ hb, float* out, int wrank, int wstep, int x, int lane) {
    const int N = wrank < T ? (T - wrank + wstep - 1) / wstep : 0;
#define PB_TOK(n) (wrank + (n) * wstep)
#define PB_STOK(n) ((MODE & 4) ? wrank : PB_TOK(n))
    if (N == 0) return;
    PeerB1 s0, s1, s2; PeerB2 bA, bB; PeerBAcc A;
    pb_s1h(s0, te, aw, hb, PB_STOK(0), x, lane); if (N > 1) pb_s1h(s1, te, aw, hb, PB_STOK(1), x, lane);
    pb_s2<0, MODE>(bA, s0, v8x, lane);
#define PB_TOKEN(n, Scur, Snext, Snew) do { \
        if ((n) + 2 < N) pb_s1h(Snew, te, aw, hb, PB_STOK((n) + 2), x, lane); \
        pb_s2<1, MODE>(bB, Scur, v8x, lane); A.h0 = bflo(Scur.h2); A.h1 = bfhi(Scur.h2); pb_quant(A, Scur); \
        pb_s3<0, MODE>(A, bA, Scur, out, PB_TOK(n), x, lane); \
        if ((n) + 1 < N) pb_s2<0, MODE>(bA, Snext, v8x, lane); \
        pb_s3<1, MODE>(A, bB, Scur, out, PB_TOK(n), x, lane); } while (0)
    for (int n = 0; n < N; n += 3) {
        PB_TOKEN(n, s0, s1, s2);
        if (n + 1 < N) PB_TOKEN(n + 1, s1, s2, s0);
        if (n + 2 < N) PB_TOKEN(n + 2, s2, s0, s1);
    }
#undef PB_TOKEN
#undef PB_STOK
#undef PB_TOK
}

__global__ void __launch_bounds__(NWAVES * 64, 2) mk_fwd(Args args) {
    extern __shared__ __attribute__((aligned(16))) unsigned char lds[];
    Frame F;
    F.lds = (LAS unsigned char*)lds;
    F.MISC = (volatile LAS unsigned*)(F.lds + MISC_OFF);
    F.tid = threadIdx.x; F.lane = F.tid & 63; F.wave = __builtin_amdgcn_readfirstlane(F.tid >> 6);
    F.G = gridDim.x; { const int bx = blockIdx.x; F.vcu = (F.G % 8 == 0) ? (bx % 8) * (F.G / 8) + bx / 8 : bx; }
    F.out = nullptr; F.ws = args.ws;
    unsigned char* ws = args.ws;
    F.ctl = (gu32*)(ws + WS_CTL);
    for (int u = F.tid; u < (LDS_BYTES - LDSCTL_OFF) / 4; u += NWAVES * 64) ((LAS unsigned*)(F.lds + LDSCTL_OFF))[u] = 0u;
    __syncthreads();
    XcdBarrier bar; bar.bar = (unsigned*)(F.ctl + CW_BAR); bar.x = 0; bar.st = nullptr;
    if (N_LAUNCHES != PER_PHASE) bar = xcd_barrier_post((unsigned*)(F.ctl + CW_BAR), F.MISC + 8);
    if (N_LAUNCHES != PER_PHASE) { if (F.tid == 0) { const unsigned xid = xb_xcc_id(); F.MISC[12] = xid; F.MISC[13] = xb_add((unsigned*)(F.ctl + CW_TICKET) + 64 * xid, 1u); } __syncthreads(); }
#define GRID_BAR() do { if (N_LAUNCHES != PER_PHASE) xcd_barrier(bar); } while (0)
    const int lo = args.ph_lo, hi = args.ph_hi;
#define IN(k) (lo <= (k) && (k) < hi)
#define BOTH(k) (IN(k) && IN((k) + 1))
    const int gw = F.vcu * NWAVES + F.wave, NGW = F.G * NWAVES;
    bf16* const WinT = (bf16*)(ws + WS_WIN); bf16* const WvT = (bf16*)(ws + WS_WV); bf16* const WkvT = (bf16*)(ws + WS_WKV); bf16* const WbrT = (bf16*)(ws + WS_WBR);
    bf16* const WoutT = (bf16*)(ws + WS_WOUT); bf16* const WqT = (bf16*)(ws + WS_WQ); bf16* const KEYS = (bf16*)(ws + WS_KEYS); bf16* const PWT = (bf16*)(ws + WS_PWT);
    bf16* const MEMN = (bf16*)(ws + WS_MEMN); bf16* const KMEM = (bf16*)(ws + WS_KMEM); bf16* const VTMEM = (bf16*)(ws + WS_VTMEM); float* const RSTDX = (float*)(ws + WS_RSTDX);
    const unsigned char* const U8 = ws + WS_U8; const unsigned char* const V8 = ws + WS_V8; const float* const SU = (const float*)(ws + WS_SU); const float* const SV = (const float*)(ws + WS_SV);
    bf16* const QN = (bf16*)(ws + WS_QN); bf16* const KN = (bf16*)(ws + WS_KN); bf16* const VT = (bf16*)(ws + WS_VT); bf16* const PP = (bf16*)(ws + WS_PP); bf16* const XQ = (bf16*)(ws + WS_XQ);
    bf16* const GATE = (bf16*)(ws + WS_GATE); bf16* const MERGED = (bf16*)(ws + WS_MERGED); bf16* const HB = (bf16*)(ws + WS_HB); bf16* const QB = (bf16*)(ws + WS_QB);
    int* const TE = (int*)(ws + WS_TE); float* const TW = (float*)(ws + WS_TW); float* const AW = (float*)(ws + WS_AW); float* const ROWSQ = (float*)(ws + WS_ROWSQ);
#define RELOAD_OUT(p) do { asm volatile("s_load_dwordx2 %0, %1, 0xb8\n\ts_waitcnt lgkmcnt(0)" : "=s"(p) : "s"(__builtin_amdgcn_kernarg_segment_ptr()) : "memory"); } while (0)
#define XB ((bf16*)(outp + OUT_XB))
#define YNA ((bf16*)(outp + OUT_YNA))
#define YPOOL ((bf16*)(outp + OUT_YPOOL))
#define YXA ((bf16*)(outp + OUT_YXA))

#ifndef STAGGER_SLEEPS
#define STAGGER_SLEEPS 1
#endif
#define STAGGER() do { const int q_ = __builtin_amdgcn_readfirstlane((int)((blockIdx.x >> 3) & 3u) * STAGGER_SLEEPS); for (int i_ = 0; i_ < q_; ++i_) __builtin_amdgcn_s_sleep(127); } while (0)
    if (IN(0)) { unsigned char* outp; RELOAD_OUT(outp); F.out = (float*)outp; p0_prologue(F, args); F.out = nullptr; if (BOTH(0)) GRID_BAR(); }
    if (IN(1)) STAGGER();

    if (IN(1)) {
      { unsigned char* outp; RELOAD_OUT(outp);
        { pg8::Sched1 S; S.so.init(T, IN_MAIN, F.G, (int)blockIdx.x); S.A = (const char*)XB; S.Bt = (const char*)WinT; S.tstep = (size_t)256 * 1024 * 2;
          pg8::EpiProj E{RSTDX, QN, KN, PP, XQ, GATE, args.in[I_NAQG], args.in[I_NAKG], args.in[I_GATEB], (args.probe & 1)};
          pg8::gemm_phase<pg8::EpiProj, pg8::Sched1, true, true>(F.lds + RING_OFF, 1024, S, E); }
        if (!(args.probe & 4)) { pg8::Sched1 S; S.so.init(512, T, F.G, (int)blockIdx.x); S.A = (const char*)WvT; S.Bt = (const char*)XB; S.tstep = (size_t)256 * 1024 * 2;
          pg8::EpiVt E{RSTDX, VT};
          pg8::gemm_phase<pg8::EpiVt, pg8::Sched1, false, true>(F.lds + RING_OFF, 1024, S, E); }
        if (!(args.probe & 2)) for (int t = gw; t < 512; t += NGW) memkv_tile(MEMN, WkvT, args.in[I_XAKG], args.in[I_XAQG], KMEM, VTMEM, t, F.lane);
      }
        if (BOTH(1)) GRID_BAR();
    }

    if (IN(2)) {
      { unsigned char* outp; RELOAD_OUT(outp);
        LAS float* rpl = (LAS float*)(F.lds + RING_OFF + F.wave * 16384);
        for (int i = F.lane; i < 15 * 31; i += 64) rpl[i] = args.in[I_RPB][F.wave * 15 * 31 + i];
        LDS_WAIT(); asm volatile("" ::: "memory");
        for (int i = F.vcu; i < 256; i += F.G)
            for (int k = 0; k < 8; ++k) { const int idx = i * 8 + k, b = idx >> 9, r = (idx >> 2) & 127, jb = idx & 3; na_item(QN, KN, VT, rpl, YNA, b, r, jb, F.wave, F.lane); }
        for (int i = F.vcu; i < 256; i += F.G) pool_wg(PP, PWT, YPOOL, F.lds + RING_OFF, i * 128, F.wave, F.lane);
        { const int pair = F.vcu & 15, xb = pair >> 2, xh = pair & 3, slot = F.vcu >> 4, nslot = F.G >> 4;
          __syncthreads(); xa_fill_lds(KMEM, VTMEM, F.lds + RING_OFF, xb, xh, F.tid); __syncthreads();
          if (slot < nslot) for (int n = slot * NWAVES + F.wave; n < 512; n += nslot * NWAVES) xa_item(XQ, F.lds + RING_OFF, YXA, (xb * 512 + n) * 16, xh, F.lane);
          __syncthreads(); }
      }
        if (BOTH(2)) GRID_BAR();
    }

    if (IN(3)) {
      { unsigned char* outp; RELOAD_OUT(outp);
        pg8::Sched1 S; S.so.init(T, D, F.G, (int)blockIdx.x); S.A = (const char*)YNA; S.Bt = (const char*)WbrT; S.tstep = (size_t)256 * 1536 * 2;
        pg8::EpiMergeCat E{GATE, MERGED};
        pg8::gemm_phase<pg8::EpiMergeCat, pg8::Sched1, true, true>(F.lds + RING_OFF, 1536, S, E);
      }
        if (BOTH(3)) GRID_BAR();
    }

    if (IN(4)) {
      {
        pg8::Sched1 S; S.so.init(T, D, F.G, (int)blockIdx.x); S.A = (const char*)MERGED; S.Bt = (const char*)WoutT; S.tstep = (size_t)256 * 1024 * 2;
        pg8::EpiH E{args.in[I_X], nullptr, HB, ROWSQ, args.probe};
        pg8::gemm_phase<pg8::EpiH, pg8::Sched1, true, true>(F.lds + RING_OFF, 1024, S, E);
      }
        if (BOTH(4)) GRID_BAR();
    }

    if (IN(5)) {
      {
        pg8::Sched1 S; S.so.init(T, 2048, F.G, (int)blockIdx.x); S.A = (const char*)HB; S.Bt = (const char*)WqT; S.tstep = (size_t)256 * 1024 * 2;
        pg8::EpiQ E{ROWSQ, QB};
        pg8::gemm_phase<pg8::EpiQ, pg8::Sched1, true, true>(F.lds + RING_OFF, 1024, S, E);
      }
        if (BOTH(5)) GRID_BAR();
    }

    if (IN(6)) {
        LAS int* lscr = (LAS int*)(F.lds + RING_OFF + 65536 + F.wave * 8192);
        for (int tok = 4 * gw; tok < T; tok += 4 * NGW) {
            HqIn hin[4];
#pragma unroll
            for (int r = 0; r < 4; ++r) hq_load(hin[r], HB, ROWSQ, tok + r, F.lane);
#pragma unroll
            for (int r = 0; r < 4; ++r) hq_token(hin[r], ws + WS_HQ, (float*)(ws + WS_HS), tok + r, F.lane); }
        { const int th = F.vcu & 7, slot = F.vcu >> 3, nslot = F.G >> 3;
          __syncthreads(); topk_fill_lds(KEYS, F.lds + RING_OFF, th, F.tid); __syncthreads();
          { { const int n0 = slot * NWAVES + F.wave, ns = nslot * NWAVES; TopkQ qA, qB;
              if (n0 < 2048) topk_loadq(qA, QB, n0 * 16, th, F.lane);
              for (int n = n0; n < 2048; n += 2 * ns) {
                  if (n + ns < 2048) topk_loadq(qB, QB, (n + ns) * 16, th, F.lane);
                  topk_item(qA, F.lds + RING_OFF, TE, TW, lscr, n * 16, th, F.lane);
                  if (n + ns < 2048) { if (n + 2 * ns < 2048) topk_loadq(qA, QB, (n + 2 * ns) * 16, th, F.lane);
                      topk_item(qB, F.lds + RING_OFF, TE, TW, lscr, (n + ns) * 16, th, F.lane); } } } }
          __syncthreads(); }
        if (BOTH(6)) GRID_BAR();
    }

    if (IN(7)) {
        int x0 = 0, nxs = 8, wrank = (int)blockIdx.x * NWAVES + F.wave, wstep = F.G * NWAVES;
        if (N_LAUNCHES != PER_PHASE) { const unsigned xid = F.MISC[12], rk = F.MISC[13]; unsigned nx = 0, below = 0, mine = 0;
            for (unsigned j = 0; j < 16; ++j) { const unsigned c = xb_ld((unsigned*)(F.ctl + CW_BAR) + XB_XCNT(j)); nx += c > 0u; below += (c > 0u && j < xid); mine = (j == xid) ? c : mine; }
            if (nx == 8 && mine > 0 && rk < mine) { x0 = (int)below; nxs = 1; wrank = (int)rk * NWAVES + F.wave; wstep = (int)mine * NWAVES; } }
        else if ((F.G & 7) == 0) { x0 = (int)blockIdx.x & 7; nxs = 1; wrank = ((int)blockIdx.x >> 3) * NWAVES + F.wave; wstep = (F.G >> 3) * NWAVES; }
        for (int xs = 0; xs < nxs; ++xs) peer_a_run(ws + WS_HQ, (const float*)(ws + WS_HS), U8, SU, SV, TE, TW, args.probe ? (float*)QB : AW, (LAS int*)(F.lds + RING_OFF + F.wave * 16384), wrank, wstep, x0 + xs, F.lane, args.probe == 2);
        if (N_LAUNCHES != PER_PHASE) xcd_barrier(bar);
    }
    if (IN(8)) {
        int x0 = 0, nxs = 8, wrank = (int)blockIdx.x * NWAVES + F.wave, wstep = F.G * NWAVES;
        if (N_LAUNCHES != PER_PHASE) { const unsigned xid = F.MISC[12], rk = F.MISC[13]; unsigned nx = 0, below = 0, mine = 0;
            for (unsigned j = 0; j < 16; ++j) { const unsigned c = xb_ld((unsigned*)(F.ctl + CW_BAR) + XB_XCNT(j)); nx += c > 0u; below += (c > 0u && j < xid); mine = (j == xid) ? c : mine; }
            if (nx == 8 && mine > 0 && rk < mine) { x0 = (int)below; nxs = 1; wrank = (int)rk * NWAVES + F.wave; wstep = (int)mine * NWAVES; } }
        else if ((F.G & 7) == 0) { x0 = (int)blockIdx.x & 7; nxs = 1; wrank = ((int)blockIdx.x >> 3) * NWAVES + F.wave; wstep = (F.G >> 3) * NWAVES; }
        for (int xs = 0; xs < nxs; ++xs) {
#ifdef PROBE_BITS
            if (args.probe) peer_b_run<PROBE_BITS>(V8 + (size_t)(x0 + xs) * (2 * MiB), TE, AW, HB, (float*)QB, wrank, wstep, x0 + xs, F.lane); else
#endif
            { unsigned char* outp; RELOAD_OUT(outp); peer_b_run<0>(V8 + (size_t)(x0 + xs) * (2 * MiB), TE, AW, HB, (float*)outp, wrank, wstep, x0 + xs, F.lane); } }
    }
#undef XB
#undef YNA
#undef YPOOL
#undef YXA
#undef RELOAD_OUT
#undef IN
#undef BOTH
#undef GRID_BAR
}

extern "C" void kernel_launch(void* const* d_in, const int* in_sizes, int n_in, void* d_out, int out_size, void* d_ws, size_t ws_size, hipStream_t stream) {
    static int grid = 0;
    if (grid == 0) {
        if (n_in != 23 || in_sizes[0] != T * D || out_size != T * D || ws_size < WS_END) { fprintf(stderr, "kernel_launch: unexpected shapes: n_in %d in0 %d out %d ws %zu\n", n_in, n_in > 0 ? in_sizes[0] : -1, out_size, ws_size); grid = -1; return; }
        int dev = 0, cus = 0, per_cu = 0;
        if (hipGetDevice(&dev) != hipSuccess || hipDeviceGetAttribute(&cus, hipDeviceAttributeMultiprocessorCount, dev) != hipSuccess) { fprintf(stderr, "kernel_launch: device query failed\n"); grid = -1; return; }
        if (hipFuncSetAttribute((const void*)mk_fwd, hipFuncAttributeMaxDynamicSharedMemorySize, LDS_BYTES) != hipSuccess) { fprintf(stderr, "kernel_launch: hipFuncSetAttribute failed\n"); grid = -1; return; }
        if (hipOccupancyMaxActiveBlocksPerMultiprocessor(&per_cu, (const void*)mk_fwd, NWAVES * 64, LDS_BYTES) != hipSuccess || per_cu < 1)
            fprintf(stderr, "kernel_launch: note: occupancy query reports %d workgroups per CU\n", per_cu);
        (void)hipGetLastError();
        grid = cus;
    }
    if (grid < 0) return;
    if (hipMemsetAsync((char*)d_ws + WS_CTL, 0, CTL_ZERO_BYTES, stream) != hipSuccess) { fprintf(stderr, "kernel_launch: memset failed\n"); return; }
    Args a{};
    for (int i = 0; i < 23; ++i) a.in[i] = (const float*)d_in[i];
    a.out = (float*)d_out; a.ws = (unsigned char*)d_ws;
    for (int li = 0; li < N_LAUNCHES; ++li) {
        a.ph_lo = (N_LAUNCHES == PER_PHASE) ? li : 0; a.ph_hi = (N_LAUNCHES == PER_PHASE) ? li + 1 : PER_PHASE;
        hipLaunchKernelGGL(mk_fwd, dim3(grid), dim3(NWAVES * 64), LDS_BYTES, stream, a);
#ifdef HOST_DUP_PHASE
        if (N_LAUNCHES == PER_PHASE && li == HOST_DUP_PHASE) {
#ifndef PROBE_MODE
            if (li == 4) (void)hipMemsetAsync((char*)d_ws + WS_ROWSQ, 0, (size_t)T * 4, stream);
#endif
#ifdef PROBE_MODE
            a.probe = PROBE_MODE;
#endif
            hipLaunchKernelGGL(mk_fwd, dim3(grid), dim3(NWAVES * 64), LDS_BYTES, stream, a); a.probe = 0; }
#endif
        const hipError_t le = hipPeekAtLastError();
        if (le != hipSuccess) { fprintf(stderr, "kernel_launch: launch %d failed: %s\n", li, hipGetErrorName(le)); break; }
    }
}
```

```cpp
#include <hip/hip_runtime.h>
#include <cstdio>
#include <cstdint>

#ifndef MK_N_LAUNCHES
#define MK_N_LAUNCHES 1
#endif

namespace pg8 {
#define PG8_LAS __attribute__((address_space(3)))
typedef unsigned short bf16_t;
typedef short bf16x8 __attribute__((ext_vector_type(8)));
typedef float f32x4 __attribute__((ext_vector_type(4)));
typedef unsigned u32x4 __attribute__((ext_vector_type(4)));
typedef unsigned u32x2 __attribute__((ext_vector_type(2)));
constexpr int BM = 256, BK = 64, HALF = 128, HTB = HALF * BK * 2  , STAGE_BYTES = 8 * HTB, NXCD = 8, WGM = 8;

__host__ __device__ __forceinline__ int lds_byte(int r, int c) { const int st = (r >> 4) * 2 + (c >> 5), rr = r & 15, cc = c & 31, ob = rr * 64 + cc * 2; return st * 1024 + (ob ^ (((ob >> 9) & 1) << 5)); }
__host__ __device__ __forceinline__ void stage_rc(int b, int& R, int& C) { const int st = b / 1024, sb = b % 1024, swz = sb ^ (((sb >> 9) & 1) << 5); R = (st >> 1) * 16 + swz / 64; C = (st & 1) * 32 + (swz % 64) / 2; }
__host__ __device__ __forceinline__ int perm32(int rho) { const int n = rho >> 4, i = rho & 15; return 8 * (i >> 2) + 4 * n + (i & 3); }

struct Unit { int pm, pn, br; };

struct StaticOrder {
    int nM, nN, nwg, G, c;
    __host__ __device__ void init(int M, int N, int G_, int c_) { nM = M / BM; nN = N / BM; nwg = nM * nN; G = G_; c = c_; }
    __host__ __device__ bool next(int i, Unit& u) const {
        const long L = (long)i * G + c; if (L >= nwg) return false;
        int wgid = (int)L; { const int q = nwg / NXCD, r = nwg % NXCD, xcd = wgid % NXCD, off = wgid / NXCD; wgid = (xcd < r ? xcd * (q + 1) : r * (q + 1) + (xcd - r) * q) + off; }
        const int nig = WGM * nN, gid = wgid / nig, fm = gid * WGM, gsz = (nM - fm) < WGM ? (nM - fm) : WGM;
        u.pm = fm + ((wgid % nig) % gsz); u.pn = (wgid % nig) / gsz; return true;
    }
};
struct Sched1 {
    StaticOrder so; const char* A; const char* Bt; size_t tstep;
    __device__ __forceinline__ bool next(int i, Unit& u) const { u.br = 0; return so.next(i, u); }
    __device__ __forceinline__ const char* abase(const Unit& u) const { return A + (size_t)u.pm * tstep; }
    __device__ __forceinline__ const char* bbase(const Unit& u) const { return Bt + (size_t)u.pn * tstep; }
    __device__ __forceinline__ void a_ready(const Unit&) const {}
    __device__ __forceinline__ void done(const Unit&) const {}
};
struct Sched3 {
    StaticOrder so; const char* A; const char* Bt; size_t tstep, strideA, strideB;
    __device__ __forceinline__ bool next(int i, Unit& u) const { u.br = i % 3; return so.next(i / 3, u); }
    __device__ __forceinline__ const char* abase(const Unit& u) const { return A + (size_t)u.br * strideA + (size_t)u.pm * tstep; }
    __device__ __forceinline__ const char* bbase(const Unit& u) const { return Bt + (size_t)u.br * strideB + (size_t)u.pn * tstep; }
    __device__ __forceinline__ void a_ready(const Unit&) const {}
    __device__ __forceinline__ void done(const Unit&) const {}
};

typedef float f32x2_t __attribute__((ext_vector_type(2))); typedef __bf16 bf16x2v_t __attribute__((ext_vector_type(2)));
__device__ __forceinline__ unsigned cvt_pk_bf16(float lo, float hi) { const f32x2_t v = {lo, hi}; const bf16x2v_t b = __builtin_convertvector(v, bf16x2v_t); return __builtin_bit_cast(unsigned, b); }
__device__ __forceinline__ u32x4 pack8(const f32x4 a, const f32x4 b) { u32x4 w; w.x = cvt_pk_bf16(a[0], a[1]); w.y = cvt_pk_bf16(a[2], a[3]); w.z = cvt_pk_bf16(b[0], b[1]); w.w = cvt_pk_bf16(b[2], b[3]); return w; }
__device__ __forceinline__ float bflo(unsigned u) { return __builtin_bit_cast(float, u << 16); }
__device__ __forceinline__ float bfhi(unsigned u) { return __builtin_bit_cast(float, u & 0xffff0000u); }


constexpr float RMS_EPS = 1e-6f;

struct EpiProj {
    static constexpr bool PERM = true, AFTER_DRAIN = false, HAS_MID = false;
    const float* rstd; bf16_t *qn, *kn, *pp, *xq, *gates; const float *qg, *kg, *gate_b; int skip;
    __device__ __forceinline__ void operator()(const f32x4 (&acc)[2][2][4][2], const Unit& u, int wr, int wc, int fr, int fq) const {
        if (skip) { if (acc[0][0][0][0][0] == 1234.5f) qn[0] = 1; return; }
        const int pn = u.pn, row0 = u.pm * BM + wr * 64 + fr, lc0 = 64 * wc + 8 * fq;
        float rsv[2][4];
#pragma unroll
        for (int ai = 0; ai < 2; ++ai)
#pragma unroll
            for (int m = 0; m < 4; ++m) rsv[ai][m] = rstd[row0 + ai * HALF + m * 16];
        if (pn < 4) {
            const bool isq = pn < 2; bf16_t* O = isq ? qn : kn; const float* g = isq ? qg : kg; const float post = isq ? 0.125f : 1.0f;
            f32x4 gv[2][2];
#pragma unroll
            for (int bj = 0; bj < 2; ++bj)
#pragma unroll
                for (int n = 0; n < 2; ++n) gv[bj][n] = *(const f32x4*)(g + 32 * bj + 8 * fq + 4 * n);
            const int colbase = (pn & 1) * 256 + lc0;
#pragma unroll
            for (int ai = 0; ai < 2; ++ai)
#pragma unroll
                for (int m = 0; m < 4; ++m) {
                    const int row = row0 + ai * HALF + m * 16; const float rs = rsv[ai][m];
                    f32x4 v[2][2]; float ss = 0.f;
#pragma unroll
                    for (int bj = 0; bj < 2; ++bj)
#pragma unroll
                        for (int n = 0; n < 2; ++n) { v[bj][n] = acc[ai][bj][m][n] * rs; ss += (v[bj][n][0] * v[bj][n][0] + v[bj][n][1] * v[bj][n][1]) + (v[bj][n][2] * v[bj][n][2] + v[bj][n][3] * v[bj][n][3]); }
                    ss += __shfl_xor(ss, 16); ss += __shfl_xor(ss, 32);
                    const float r = rsqrtf(ss * (1.0f / 64.0f) + RMS_EPS) * post;
#pragma unroll
                    for (int bj = 0; bj < 2; ++bj) *(u32x4*)(O + (size_t)row * 512 + colbase + 32 * bj) = pack8(v[bj][0] * r * gv[bj][0], v[bj][1] * r * gv[bj][1]);
                }
        } else if (pn < 8) {
            bf16_t* O = pn < 6 ? pp : xq; const int colbase = (pn & 1) * 256 + lc0;
#pragma unroll
            for (int ai = 0; ai < 2; ++ai)
#pragma unroll
                for (int m = 0; m < 4; ++m) {
                    const int row = row0 + ai * HALF + m * 16; const float rs = rsv[ai][m];
#pragma unroll
                    for (int bj = 0; bj < 2; ++bj) *(u32x4*)(O + (size_t)row * 512 + colbase + 32 * bj) = pack8(acc[ai][bj][m][0] * rs, acc[ai][bj][m][1] * rs);
                }
        } else {
            const int gcol0 = (pn - 8) * 256 + lc0;
            f32x4 bv[2][2];
#pragma unroll
            for (int bj = 0; bj < 2; ++bj)
#pragma unroll
                for (int n = 0; n < 2; ++n) bv[bj][n] = *(const f32x4*)(gate_b + gcol0 + 32 * bj + 4 * n) * (-1.4426950408889634f);
#pragma unroll
            for (int ai = 0; ai < 2; ++ai)
#pragma unroll
                for (int m = 0; m < 4; ++m) {
                    const int row = row0 + ai * HALF + m * 16; const float rs = rsv[ai][m] * (-1.4426950408889634f);
#pragma unroll
                    for (int bj = 0; bj < 2; ++bj) {
                        f32x4 o[2];
#pragma unroll
                        for (int n = 0; n < 2; ++n) { const f32x4 z = acc[ai][bj][m][n] * rs + bv[bj][n];
#pragma unroll
                            for (int i = 0; i < 4; ++i) o[n][i] = __builtin_amdgcn_rcpf(1.0f + __builtin_amdgcn_exp2f(z[i])); }
                        *(u32x4*)(gates + (size_t)row * 3072 + gcol0 + 32 * bj) = pack8(o[0], o[1]);
                    }
                }
        }
    }
};
struct EpiVt {
    static constexpr bool PERM = true, AFTER_DRAIN = false, HAS_MID = false;
    const float* rstd; bf16_t* Vt;
    __device__ __forceinline__ void operator()(const f32x4 (&acc)[2][2][4][2], const Unit& u, int wr, int wc, int fr, int fq) const {
        const int ch0 = u.pm * BM + wr * 64 + fr, tok0 = u.pn * BM + wc * 32 + 8 * fq, b = tok0 >> 13, t0 = tok0 & 8191;
        f32x4 rv[2][2];
#pragma unroll
        for (int bj = 0; bj < 2; ++bj)
#pragma unroll
            for (int n = 0; n < 2; ++n) rv[bj][n] = *(const f32x4*)(rstd + tok0 + bj * HALF + 4 * n);
#pragma unroll
        for (int ai = 0; ai < 2; ++ai)
#pragma unroll
            for (int m = 0; m < 4; ++m) { const int ch = ch0 + ai * HALF + m * 16; bf16_t* rowp = Vt + ((size_t)(b * 512 + ch) * 8192 + t0);
#pragma unroll
                for (int bj = 0; bj < 2; ++bj) *(u32x4*)(rowp + bj * HALF) = pack8(acc[ai][bj][m][0] * rv[bj][0], acc[ai][bj][m][1] * rv[bj][1]); }
    }
};
struct EpiMergeCat {
    static constexpr bool PERM = true, AFTER_DRAIN = false, HAS_MID = true;
    const bf16_t* gates; bf16_t* merged;
    __device__ __forceinline__ void mid(f32x4 (&acc)[2][2][4][2], const Unit& u, int nb  , int wr, int wc, int fr, int fq) const {
        const int row0 = u.pm * BM + wr * 64 + fr, col0 = u.pn * BM + wc * 32 + 8 * fq;
#pragma unroll
        for (int ai = 0; ai < 2; ++ai) {
            u32x4 ga[4][2], gb[4][2];
#pragma unroll
            for (int m = 0; m < 4; ++m)
#pragma unroll
                for (int bj = 0; bj < 2; ++bj) { const bf16_t* gp = gates + (size_t)(row0 + ai * HALF + m * 16) * 3072 + (nb - 1) * 1024 + col0 + bj * HALF;
                    ga[m][bj] = *(const u32x4*)gp; gb[m][bj] = *(const u32x4*)(gp + 1024); }
            __builtin_amdgcn_sched_barrier(0);
#pragma unroll
            for (int m = 0; m < 4; ++m)
#pragma unroll
                for (int bj = 0; bj < 2; ++bj) { const u32x4 a = ga[m][bj], b = gb[m][bj]; f32x4& x0 = acc[ai][bj][m][0]; f32x4& x1 = acc[ai][bj][m][1];
                    x0[0] *= bflo(a.x) * __builtin_amdgcn_rcpf(bflo(b.x)); x0[1] *= bfhi(a.x) * __builtin_amdgcn_rcpf(bfhi(b.x)); x0[2] *= bflo(a.y) * __builtin_amdgcn_rcpf(bflo(b.y)); x0[3] *= bfhi(a.y) * __builtin_amdgcn_rcpf(bfhi(b.y));
                    x1[0] *= bflo(a.z) * __builtin_amdgcn_rcpf(bflo(b.z)); x1[1] *= bfhi(a.z) * __builtin_amdgcn_rcpf(bfhi(b.z)); x1[2] *= bflo(a.w) * __builtin_amdgcn_rcpf(bflo(b.w)); x1[3] *= bfhi(a.w) * __builtin_amdgcn_rcpf(bfhi(b.w)); }
            __builtin_amdgcn_sched_barrier(0);
        }
    }
    __device__ __forceinline__ void operator()(const f32x4 (&acc)[2][2][4][2], const Unit& u, int wr, int wc, int fr, int fq) const {
        const int row0 = u.pm * BM + wr * 64 + fr, col0 = u.pn * BM + wc * 32 + 8 * fq;
#pragma unroll
        for (int ai = 0; ai < 2; ++ai) {
            u32x4 g8[4][2];
#pragma unroll
            for (int m = 0; m < 4; ++m)
#pragma unroll
                for (int bj = 0; bj < 2; ++bj) g8[m][bj] = *(const u32x4*)(gates + (size_t)(row0 + ai * HALF + m * 16) * 3072 + 2048 + col0 + bj * HALF);
            __builtin_amdgcn_sched_barrier(0);
#pragma unroll
            for (int m = 0; m < 4; ++m)
#pragma unroll
                for (int bj = 0; bj < 2; ++bj) { const u32x4 g = g8[m][bj]; f32x4 a = acc[ai][bj][m][0], b = acc[ai][bj][m][1];
                    a[0] *= bflo(g.x); a[1] *= bfhi(g.x); a[2] *= bflo(g.y); a[3] *= bfhi(g.y); b[0] *= bflo(g.z); b[1] *= bfhi(g.z); b[2] *= bflo(g.w); b[3] *= bfhi(g.w);
                    *(u32x4*)(merged + (size_t)(row0 + ai * HALF + m * 16) * 1024 + col0 + bj * HALF) = pack8(a, b); }
            __builtin_amdgcn_sched_barrier(0);
        }
    }
};
struct EpiH {
    static constexpr bool PERM = true, AFTER_DRAIN = false, HAS_MID = false;
    const float* x; float* out; bf16_t* hb; float* rowsq; int noatomic;
    __device__ __forceinline__ void operator()(const f32x4 (&acc)[2][2][4][2], const Unit& u, int wr, int wc, int fr, int fq) const {
        const int row0 = u.pm * BM + wr * 64 + fr, col0 = u.pn * BM + wc * 32 + 8 * fq;
#pragma unroll
        for (int ai = 0; ai < 2; ++ai) {
            f32x4 xv[4][2][2];
#pragma unroll
            for (int m = 0; m < 4; ++m)
#pragma unroll
                for (int bj = 0; bj < 2; ++bj) { const size_t o = (size_t)(row0 + ai * HALF + m * 16) * 1024 + col0 + bj * HALF; xv[m][bj][0] = *(const f32x4*)(x + o); xv[m][bj][1] = *(const f32x4*)(x + o + 4); }
            __builtin_amdgcn_sched_barrier(0);
#pragma unroll
            for (int m = 0; m < 4; ++m) { const int row = row0 + ai * HALF + m * 16; float ss = 0.f;
#pragma unroll
                for (int bj = 0; bj < 2; ++bj) { const size_t o = (size_t)row * 1024 + col0 + bj * HALF;
                    const f32x4 h0 = xv[m][bj][0] + acc[ai][bj][m][0], h1 = xv[m][bj][1] + acc[ai][bj][m][1];
                    *(u32x4*)(hb + o) = pack8(h0, h1);
                    ss += (h0[0] * h0[0] + h0[1] * h0[1]) + (h0[2] * h0[2] + h0[3] * h0[3]) + (h1[0] * h1[0] + h1[1] * h1[1]) + (h1[2] * h1[2] + h1[3] * h1[3]); }
                ss += __shfl_xor(ss, 16); ss += __shfl_xor(ss, 32);
                if (fq == 0 && !noatomic) atomicAdd(rowsq + row, ss); }
            __builtin_amdgcn_sched_barrier(0);
        }
    }
};
struct EpiQ {
    static constexpr bool PERM = true, AFTER_DRAIN = false, HAS_MID = false;
    const float* rowsq; bf16_t* qb;
    __device__ __forceinline__ void operator()(const f32x4 (&acc)[2][2][4][2], const Unit& u, int wr, int wc, int fr, int fq) const {
        const int row0 = u.pm * BM + wr * 64 + fr, col0 = u.pn * BM + wc * 32 + 8 * fq;
        float rq[2][4];
#pragma unroll
        for (int ai = 0; ai < 2; ++ai)
#pragma unroll
            for (int m = 0; m < 4; ++m) rq[ai][m] = rowsq[row0 + ai * HALF + m * 16];
#pragma unroll
        for (int ai = 0; ai < 2; ++ai)
#pragma unroll
            for (int m = 0; m < 4; ++m) { const int row = row0 + ai * HALF + m * 16; const float r = rsqrtf(rq[ai][m] * (1.0f / 1024.0f) + RMS_EPS);
#pragma unroll
                for (int bj = 0; bj < 2; ++bj) *(u32x4*)(qb + (size_t)row * 2048 + col0 + bj * HALF) = pack8(acc[ai][bj][m][0] * r, acc[ai][bj][m][1] * r); }
    }
};

template <class Epi, class Sched, bool ALIGN_EPI = false, bool SP2 = false>
__device__ __forceinline__ void gemm_phase(PG8_LAS unsigned char* lds, const int K, const Sched& S, const Epi& E) {
    const int tid = threadIdx.x, wid = __builtin_amdgcn_readfirstlane(tid >> 6), lane = tid & 63, wr = wid >> 2, wc = wid & 3, fr = lane & 15, fq = lane >> 4;
    const int nt = K / BK;
    unsigned voffA[2], voffB[2];
#pragma unroll
    for (int i = 0; i < 2; ++i) { int R, C; stage_rc(tid * 16 + i * 8192, R, C); const int Rb = Epi::PERM ? ((R & ~31) + perm32(R & 31)) : R;
        voffA[i] = (unsigned)(R * K + C) * 2u; voffB[i] = (unsigned)(Rb * K + C) * 2u; }
    const size_t kstep = (size_t)(BK * 2);
    const size_t hstep = (size_t)HALF * K * 2;
    const size_t tstep = 2 * hstep;
    const unsigned ldsw = (unsigned)wid * 1024u;
    const int aoff = lds_byte(wr * 64 + fr, fq * 8), boff = lds_byte(wc * 32 + fr, fq * 8);
#define PG8_SA(b, h) (((b) * 2 + (h)) * HTB)
#define PG8_SB(b, h) ((4 + (b) * 2 + (h)) * HTB)
#define PG8_STAGE(bufoff, gbase, voff) do { _Pragma("unroll") for (int _i = 0; _i < 2; ++_i) \
        __builtin_amdgcn_global_load_lds((const unsigned*)((const char*)(gbase) + (voff)[_i]), (PG8_LAS unsigned*)(lds + (bufoff) + ldsw + _i * 8192), 16, 0, 0); } while (0)
#define PG8_LDA(dst, b, h) do { _Pragma("unroll") for (int m = 0; m < 4; ++m) _Pragma("unroll") for (int k = 0; k < 2; ++k) dst[m][k] = *(const PG8_LAS bf16x8*)(lds + PG8_SA(b, h) + aoff + m * 2048 + k * 1024); } while (0)
#define PG8_LDB(dst, b, h) do { _Pragma("unroll") for (int n = 0; n < 2; ++n) _Pragma("unroll") for (int k = 0; k < 2; ++k) dst[n][k] = *(const PG8_LAS bf16x8*)(lds + PG8_SB(b, h) + boff + n * 2048 + k * 1024); } while (0)
#define PG8_MMA(ai, bj, At, Bt) do { __builtin_amdgcn_s_setprio(1); _Pragma("unroll") for (int m = 0; m < 4; ++m) _Pragma("unroll") for (int n = 0; n < 2; ++n) _Pragma("unroll") for (int k = 0; k < 2; ++k) \
        acc[ai][bj][m][n] = __builtin_amdgcn_mfma_f32_16x16x32_bf16(Bt[n][k], At[m][k], acc[ai][bj][m][n], 0, 0, 0); __builtin_amdgcn_s_setprio(0); } while (0)
#define PG8_WAIT_V(n) asm volatile("s_waitcnt vmcnt(" #n ")" ::: "memory")
#define PG8_WAIT_L(n) asm volatile("s_waitcnt lgkmcnt(" #n ")" ::: "memory")
#define PG8_BAR __builtin_amdgcn_s_barrier()
#define PG8_SCHED __builtin_amdgcn_sched_barrier(0)
    Unit cur, nxt; int ui = 0;
    if (!S.next(0, cur)) return;
    f32x4 acc[2][2][4][2];
#pragma unroll
    for (int a = 0; a < 2; ++a)
#pragma unroll
        for (int b = 0; b < 2; ++b)
#pragma unroll
            for (int m = 0; m < 4; ++m)
#pragma unroll
                for (int n = 0; n < 2; ++n) acc[a][b][m][n] = (f32x4){0.f, 0.f, 0.f, 0.f};
    bf16x8 At[4][2], B0[2][2], B1[2][2];
    const char* cA = S.abase(cur); const char* cB = S.bbase(cur);
    S.a_ready(cur);
    if constexpr (SP2) {
        PG8_STAGE(PG8_SB(0, 0), cB, voffB); PG8_STAGE(PG8_SB(0, 1), cB + hstep, voffB); PG8_STAGE(PG8_SA(0, 0), cA, voffA); PG8_STAGE(PG8_SA(0, 1), cA + hstep, voffA);
        if (wr == 1) PG8_BAR;
        PG8_WAIT_V(2); PG8_BAR;
        PG8_STAGE(PG8_SB(1, 0), cB + kstep, voffB); PG8_STAGE(PG8_SA(1, 0), cA + kstep, voffA); PG8_STAGE(PG8_SB(1, 1), cB + hstep + kstep, voffB);
        PG8_WAIT_V(6); PG8_BAR;
    } else {
        PG8_STAGE(PG8_SB(0, 0), cB, voffB); PG8_STAGE(PG8_SA(0, 0), cA, voffA); PG8_STAGE(PG8_SB(0, 1), cB + hstep, voffB); PG8_STAGE(PG8_SA(0, 1), cA + hstep, voffA);
        if (wr == 1) PG8_BAR;
        PG8_WAIT_V(4); PG8_BAR;
        PG8_STAGE(PG8_SB(1, 0), cB + kstep, voffB); PG8_STAGE(PG8_SA(1, 0), cA + kstep, voffA); PG8_STAGE(PG8_SB(1, 1), cB + hstep + kstep, voffB);
        PG8_WAIT_V(6); PG8_BAR;
    }
    for (;;) {
        const bool has_next = S.next(ui + 1, nxt);
        const char* nA = has_next ? S.abase(nxt) : cA; const char* nB = has_next ? S.bbase(nxt) : cB;
        for (int t = 0; t < nt; t += 2) {
            if constexpr (Epi::HAS_MID) { if (t == 8 || t == 16) E.mid(acc, cur, t >> 3, wr, wc, fr, fq); }
            const bool last = (t == nt - 2);
            const char* a1 = cA + (size_t)(t + 1) * kstep;
            const char* a2 = last ? nA : cA + (size_t)(t + 2) * kstep; const char* b2 = last ? nB : cB + (size_t)(t + 2) * kstep;
            const char* a3 = a2 + kstep; const char* b3 = b2 + kstep;
            if (last && has_next) S.a_ready(nxt);
            if constexpr (SP2) {
            PG8_LDB(B0, 0, 0); PG8_LDB(B1, 0, 1); PG8_SCHED; PG8_LDA(At, 0, 0); PG8_STAGE(PG8_SA(1, 1), a1 + hstep, voffA);
            PG8_WAIT_V(8); PG8_WAIT_L(0); PG8_BAR; PG8_MMA(0, 0, At, B0); PG8_MMA(0, 1, At, B1); PG8_BAR; PG8_SCHED;
            PG8_LDA(At, 0, 1); PG8_STAGE(PG8_SB(0, 0), b2, voffB); PG8_STAGE(PG8_SB(0, 1), b2 + hstep, voffB); PG8_STAGE(PG8_SA(0, 0), a2, voffA);
            PG8_WAIT_V(8); PG8_WAIT_L(0); PG8_BAR; PG8_MMA(1, 0, At, B0); PG8_MMA(1, 1, At, B1); PG8_BAR; PG8_SCHED;
            PG8_LDB(B0, 1, 0); PG8_LDB(B1, 1, 1); PG8_SCHED; PG8_LDA(At, 1, 0); PG8_STAGE(PG8_SA(0, 1), a2 + hstep, voffA);
            PG8_WAIT_V(8); PG8_WAIT_L(0); PG8_BAR; PG8_MMA(0, 0, At, B0); PG8_MMA(0, 1, At, B1); PG8_BAR; PG8_SCHED;
            PG8_LDA(At, 1, 1); PG8_STAGE(PG8_SB(1, 0), b3, voffB); PG8_STAGE(PG8_SB(1, 1), b3 + hstep, voffB); PG8_STAGE(PG8_SA(1, 0), a3, voffA);
            PG8_WAIT_V(8); PG8_WAIT_L(0); PG8_BAR; PG8_MMA(1, 0, At, B0); PG8_MMA(1, 1, At, B1); PG8_BAR; PG8_SCHED;
            } else {
            PG8_LDB(B0, 0, 0); PG8_SCHED; PG8_LDA(At, 0, 0); PG8_STAGE(PG8_SA(1, 1), a1 + hstep, voffA);
            PG8_WAIT_L(8); PG8_BAR; PG8_WAIT_L(0); PG8_MMA(0, 0, At, B0); PG8_BAR; PG8_SCHED;
            PG8_LDB(B1, 0, 1); PG8_STAGE(PG8_SB(0, 0), b2, voffB);
            PG8_BAR; PG8_WAIT_L(0); PG8_MMA(0, 1, At, B1); PG8_BAR;
            PG8_LDA(At, 0, 1); PG8_STAGE(PG8_SA(0, 0), a2, voffA);
            PG8_BAR; PG8_WAIT_L(0); PG8_MMA(1, 0, At, B0); PG8_BAR; PG8_SCHED;
            PG8_STAGE(PG8_SB(0, 1), b2 + hstep, voffB);
            PG8_WAIT_V(6); PG8_BAR; PG8_MMA(1, 1, At, B1); PG8_BAR;
            PG8_LDB(B0, 1, 0); PG8_SCHED; PG8_LDA(At, 1, 0); PG8_STAGE(PG8_SA(0, 1), a2 + hstep, voffA);
            PG8_WAIT_L(8); PG8_BAR; PG8_WAIT_L(0); PG8_MMA(0, 0, At, B0); PG8_BAR; PG8_SCHED;
            PG8_LDB(B1, 1, 1); PG8_STAGE(PG8_SB(1, 0), b3, voffB);
            PG8_BAR; PG8_WAIT_L(0); PG8_MMA(0, 1, At, B1); PG8_BAR;
            PG8_LDA(At, 1, 1); PG8_STAGE(PG8_SA(1, 0), a3, voffA);
            PG8_BAR; PG8_WAIT_L(0); PG8_MMA(1, 0, At, B0); PG8_BAR; PG8_SCHED;
            PG8_STAGE(PG8_SB(1, 1), b3 + hstep, voffB);
            PG8_WAIT_V(6); PG8_BAR; PG8_MMA(1, 1, At, B1); PG8_BAR;
            }
        }
        if constexpr (ALIGN_EPI) { if (wr == 0) PG8_BAR; }
        if constexpr (!Epi::AFTER_DRAIN) { E(acc, cur, wr, wc, fr, fq); S.done(cur); }
        if (!has_next) break;
#pragma unroll
        for (int a = 0; a < 2; ++a)
#pragma unroll
            for (int b = 0; b < 2; ++b)
#pragma unroll
                for (int m = 0; m < 4; ++m)
#pragma unroll
                    for (int n = 0; n < 2; ++n) acc[a][b][m][n] = (f32x4){0.f, 0.f, 0.f, 0.f};
        cur = nxt; cA = nA; cB = nB; ++ui;
        if constexpr (ALIGN_EPI) { if (wr == 1) PG8_BAR; }
    }
    PG8_WAIT_V(0);
    if constexpr (!ALIGN_EPI) { if (wr == 0) PG8_BAR; }
    PG8_BAR;
    if constexpr (Epi::AFTER_DRAIN) { E.fused(acc, cur, wr, wc, fr, fq, lds, wid, lane); S.done(cur); }
#undef PG8_SA
#undef PG8_SB
#undef PG8_STAGE
#undef PG8_LDA
#undef PG8_LDB
#undef PG8_MMA
#undef PG8_WAIT_V
#undef PG8_WAIT_L
#undef PG8_BAR
#undef PG8_SCHED
}
}

constexpr int NWAVES = 8;
constexpr int N_LAUNCHES = MK_N_LAUNCHES;
constexpr int PER_PHASE = 9;
constexpr int NBATCH = 4, SEQ = 8192, D = 1024, T = NBATCH * SEQ, MEMLEN = 256, NMEMTOK = NBATCH * MEMLEN;
constexpr int IN_MAIN = 5120;
constexpr int NEXP = 16384;

constexpr size_t MiB = 1u << 20;
constexpr size_t WS_CTL = 0, CTL_ZERO_BYTES = 512 * 1024;
constexpr size_t WS_ROWSQ = 256 * 1024;
constexpr size_t WS_WIN = 1 * MiB, WS_WV = 11 * MiB, WS_WKV = 12 * MiB, WS_WBR = 14 * MiB, WS_WOUT = 17 * MiB, WS_WQ = 19 * MiB, WS_KEYS = 23 * MiB, WS_PWT = 23 * MiB + 512 * 1024;
constexpr size_t WS_MEMN = 24 * MiB, WS_KMEM = 26 * MiB, WS_VTMEM = 27 * MiB, WS_RSTDX = 28 * MiB, WS_SU = 28 * MiB + 256 * 1024  , WS_SV = 28 * MiB + 512 * 1024  ;
constexpr size_t WS_U8 = 32 * MiB, WS_V8 = 48 * MiB;
constexpr size_t WS_QN = 96 * MiB, WS_KN = 128 * MiB, WS_VT = 160 * MiB, WS_PP = 192 * MiB, WS_XQ = 224 * MiB, WS_GATE = 256 * MiB, WS_END = 448 * MiB;
constexpr size_t WS_MERGED = WS_QN;
constexpr size_t WS_HB = WS_VT;
constexpr size_t WS_QB = WS_GATE;
constexpr size_t WS_TE = WS_GATE + 128 * MiB, WS_TW = WS_TE + 16 * MiB;
constexpr size_t WS_HQ = WS_TW + 16 * MiB;
constexpr size_t WS_HS = 28 * MiB + 768 * 1024;
constexpr size_t WS_AW = WS_MERGED;
constexpr size_t OUT_XB = 0, OUT_YNA = 0, OUT_YPOOL = 512 * 2, OUT_YXA = 1024 * 2;
constexpr int CW_TMO = 0, CW_BAR = 4096, CW_TICKET = 8192;

constexpr int RING_OFF = 0, RING_BYTES = 131072;
constexpr int LDSCTL_OFF = RING_BYTES, MISC_OFF = LDSCTL_OFF + 320;
constexpr int LDS_BYTES = 147456;

#define GAS __attribute__((address_space(1)))
#define LAS __attribute__((address_space(3)))
typedef unsigned short bf16;
typedef unsigned v4u __attribute__((ext_vector_type(4)));
typedef unsigned v2u __attribute__((ext_vector_type(2)));
typedef float f32x4 __attribute__((ext_vector_type(4)));
typedef short bf16x8 __attribute__((ext_vector_type(8)));
typedef __bf16 bf16x2_t __attribute__((ext_vector_type(2)));
typedef GAS unsigned gu32;
#define LDS_WAIT() asm volatile("s_waitcnt lgkmcnt(0)" ::: "memory")
#define VM_WAIT() asm volatile("s_waitcnt vmcnt(0)" ::: "memory")
__device__ __forceinline__ unsigned f2bf(float f) { unsigned u = __builtin_bit_cast(unsigned, f); return (u + 0x7fffu + ((u >> 16) & 1u)) >> 16; }
__device__ __forceinline__ unsigned pk2(float lo, float hi) { return f2bf(lo) | (f2bf(hi) << 16); }
__device__ __forceinline__ float bflo(unsigned u) { return __builtin_bit_cast(float, u << 16); }
__device__ __forceinline__ float bfhi(unsigned u) { return __builtin_bit_cast(float, u & 0xffff0000u); }
__device__ __forceinline__ float bf1(short s) { return __builtin_bit_cast(float, ((unsigned)(unsigned short)s) << 16); }
__device__ __forceinline__ f32x4 mfma16(bf16x8 a, bf16x8 b, f32x4 c) { return __builtin_amdgcn_mfma_f32_16x16x32_bf16(a, b, c, 0, 0, 0); }
__device__ __forceinline__ float wave_sum(float v) {
#pragma unroll
    for (int o = 1; o < 64; o <<= 1) v += __shfl_xor(v, o);
    return v;
}

#define XB_TMO      128
#define XB_XCNT(j)  (256  + 64 * (j))
#define XB_XSUB(j)  (1280 + 64 * (j))
#define XB_XGEN(j)  (2304 + 64 * (j))
#define XB_TOP      3328
#define XB_TOPGEN   3392
#define XCD_BAR_WORDS 3456
#define XB_SPIN_CAP (1u << 18)

__device__ __forceinline__ unsigned xb_ld(unsigned* p)              { return __hip_atomic_load(p, __ATOMIC_RELAXED, __HIP_MEMORY_SCOPE_AGENT); }
__device__ __forceinline__ unsigned xb_add(unsigned* p, unsigned v) { return __hip_atomic_fetch_add(p, v, __ATOMIC_RELAXED, __HIP_MEMORY_SCOPE_AGENT); }
__device__ __forceinline__ unsigned xb_xcc_id() { return (unsigned)__builtin_amdgcn_s_getreg((3 << 11) | 20) & 0xFu; }
#define XB_SPIN(cond, bar) do { unsigned _sp = 0; while (cond) { __builtin_amdgcn_s_sleep(1); \
    if ((++_sp & 255u) == 0u) { if (xb_ld(&(bar)[XB_TMO])) break; if (_sp > XB_SPIN_CAP) { atomicAdd(&(bar)[XB_TMO], 1u); break; } } } } while (0)

struct XcdBarrier {
    unsigned* bar; unsigned x;
    volatile LAS unsigned* st;
};

__device__ __forceinline__ XcdBarrier xcd_barrier_post(unsigned* bar, volatile LAS unsigned* st) {
    XcdBarrier b; b.bar = bar; b.x = xb_xcc_id(); b.st = st;
    if (threadIdx.x == 0) (void)xb_add(&bar[XB_XCNT(b.x)], 1u);
    return b;
}
__device__ __forceinline__ void xcd_barrier_complete(unsigned* bar, unsigned x, unsigned& nloc, unsigned& nx) {
    const unsigned G = gridDim.x * gridDim.y * gridDim.z;
    unsigned sum, cnt, mine, sp = 0u;
    for (;;) {
        sum = 0u; cnt = 0u; mine = 0u;
#pragma unroll
        for (unsigned j = 0; j < 16; ++j) { const unsigned c = xb_ld(&bar[XB_XCNT(j)]); sum += c; cnt += (c > 0u) ? 1u : 0u; mine = (j == x) ? c : mine; }
        if (sum == G) break;
        __builtin_amdgcn_s_sleep(1);
        if ((++sp & 255u) == 0u) { if (xb_ld(&bar[XB_TMO])) break; if (sp > XB_SPIN_CAP) { atomicAdd(&bar[XB_TMO], 1u); break; } }
    }
    nloc = mine > 0u ? mine : 1u; nx = cnt > 0u ? cnt : 1u;
}

__device__ __forceinline__ void xcd_barrier(const XcdBarrier& b) {
    asm volatile("s_waitcnt vmcnt(0)" ::: "memory");
    __syncthreads();
    if (threadIdx.x == 0) {
        unsigned* bar = b.bar;
        __builtin_amdgcn_s_waitcnt(0);
        unsigned nloc = b.st[0], nx = b.st[1];
        if (nloc == 0u) { xcd_barrier_complete(bar, b.x, nloc, nx); b.st[0] = nloc; b.st[1] = nx; }
        const unsigned old = xb_add(&bar[XB_XSUB(b.x)], 1u);
        const unsigned gen = old / nloc;
        if (old + 1u == (gen + 1u) * nloc) {
            __builtin_amdgcn_fence(__ATOMIC_RELEASE, "agent");
            asm volatile("s_waitcnt vmcnt(0)" ::: "memory");
            const unsigned og = xb_add(&bar[XB_TOP], 1u);
            const unsigned tg = og / nx;
            if (og + 1u == (tg + 1u) * nx) xb_add(&bar[XB_TOPGEN], 1u);
            else XB_SPIN(xb_ld(&bar[XB_TOPGEN]) == tg, bar);
            __builtin_amdgcn_fence(__ATOMIC_ACQUIRE, "agent");
            xb_add(&bar[XB_XGEN(b.x)], 1u);
            asm volatile("s_waitcnt vmcnt(0)" ::: "memory");
        } else {
            XB_SPIN(xb_ld(&bar[XB_XGEN(b.x)]) == gen, bar);
            __builtin_amdgcn_fence(__ATOMIC_ACQUIRE, "agent");
            asm volatile("s_waitcnt vmcnt(0)" ::: "memory");
        }
    }
    __syncthreads();
}

struct Frame {
    LAS unsigned char* lds;
    volatile LAS unsigned* MISC;
    gu32* ctl;
    int tid, lane, wave, vcu, G;
    float* out; unsigned char* ws;
};
struct Args { const float* in[23]; float* out; unsigned char* ws; int ph_lo, ph_hi, probe, pad; };
enum { I_X = 0, I_MEM, I_MIXG, I_MEMG, I_WIN, I_GATEB, I_WKV, I_NAQG, I_NAKG, I_RPB, I_POOLW, I_POOLSC, I_XAQG, I_XAKG, I_WB0, I_WB1, I_WB2, I_WOUT, I_FFNG, I_WQ, I_KEYS, I_PU, I_PV };

__device__ __forceinline__ void p0_transpose_item(const float* W, int K, int N, int k0, int n0, bf16* dst, const float* kscale, LAS float* scr, int lane, int dpitch = 0) {
    if (dpitch == 0) dpitch = K;
#pragma unroll 8
    for (int i = 0; i < 32; ++i) { const int kk = 2 * i + (lane >> 5); float v = W[(size_t)(k0 + kk) * N + n0 + (lane & 31)]; if (kscale) v *= kscale[k0 + kk]; scr[kk * 33 + (lane & 31)] = v; }
    LDS_WAIT(); asm volatile("" ::: "memory");
    const int c = lane & 7;
#pragma unroll
    for (int j = 0; j < 4; ++j) { const int n = (lane >> 3) + 8 * j; const LAS float* s = scr + (8 * c) * 33 + n;
        v4u o; o.x = pk2(s[0 * 33], s[1 * 33]); o.y = pk2(s[2 * 33], s[3 * 33]); o.z = pk2(s[4 * 33], s[5 * 33]); o.w = pk2(s[6 * 33], s[7 * 33]);
        *(GAS v4u*)(dst + (size_t)n * dpitch + k0 + 8 * c) = o; }
    LDS_WAIT(); asm volatile("" ::: "memory");
}
__device__ __forceinline__ void cvt_row1024(const float* src, bf16* dst, const float* colscale, float rowscale, int lane) {
    const GAS f32x4* xr = (const GAS f32x4*)src + lane; GAS unsigned long long* o8 = (GAS unsigned long long*)dst + lane;
#pragma unroll
    for (int j = 0; j < 4; ++j) { f32x4 v = xr[64 * j] * rowscale; if (colscale) v = v * ((const GAS f32x4*)colscale)[lane + 64 * j];
        o8[64 * j] = (unsigned long long)pk2(v.x, v.y) | ((unsigned long long)pk2(v.z, v.w) << 32); }
}
__device__ __forceinline__ float row_rstd1024(const float* src, int lane) {
    const GAS f32x4* xr = (const GAS f32x4*)src + lane; float s = 0.f;
#pragma unroll
    for (int j = 0; j < 4; ++j) { const f32x4 v = xr[64 * j]; s += (v.x * v.x + v.y * v.y) + (v.z * v.z + v.w * v.w); }
    return rsqrtf(wave_sum(s) * (1.0f / 1024.0f) + 1e-6f);
}
__device__ __forceinline__ void p0_prologue(Frame& F, const Args& A) {
    LAS float* scr = (LAS float*)(F.lds + RING_OFF + F.wave * 16384);
    const int gw = F.vcu * NWAVES + F.wave, NGW = F.G * NWAVES, lane = F.lane;
    unsigned char* ws = F.ws;
    constexpr int I_IN = 16 * 176, I_KV = 16 * 32, I_BR = 8 * 32, I_OUT = 16 * 32, I_Q = 16 * 64;
    constexpr int NITEMS = I_IN + I_KV + 3 * I_BR + I_OUT + I_Q;
    for (int it = gw; it < NITEMS; it += NGW) {
        int r = it;
        if (r < I_IN) { const int kb = r / 176, nb = r % 176, n0 = 32 * nb; bf16* dst;
            if (n0 >= 1024 && n0 < 1536) dst = (bf16*)(ws + WS_WV) + (size_t)(n0 - 1024) * 1024;
            else { const int np = n0 < 1024 ? n0 : n0 - 512, t = np >> 8, w = np & 255, wc = w >> 6, bj = (w >> 5) & 1; dst = (bf16*)(ws + WS_WIN) + (size_t)(256 * t + 128 * bj + 32 * wc) * 1024; }
            p0_transpose_item(A.in[I_WIN], 1024, 5632, 64 * kb, n0, dst, A.in[I_MIXG], scr, lane); continue; }
        r -= I_IN;
        if (r < I_KV) { const int kb = r / 32, nb = r % 32; p0_transpose_item(A.in[I_WKV], 1024, 1024, 64 * kb, 32 * nb, (bf16*)(ws + WS_WKV) + (size_t)(32 * nb) * 1024, nullptr, scr, lane); continue; }
        r -= I_KV;
        if (r < 3 * I_BR) { const int br = r / I_BR, rr = r % I_BR, kb = rr / 32, nb = rr % 32; const float* W = br == 0 ? A.in[I_WB0] : (br == 1 ? A.in[I_WB1] : A.in[I_WB2]);
            p0_transpose_item(W, 512, 1024, 64 * kb, 32 * nb, (bf16*)(ws + WS_WBR) + (size_t)(32 * nb) * 1536 + br * 512, nullptr, scr, lane, 1536); continue; }
        r -= 3 * I_BR;
        if (r < I_OUT) { const int kb = r / 32, nb = r % 32; p0_transpose_item(A.in[I_WOUT], 1024, 1024, 64 * kb, 32 * nb, (bf16*)(ws + WS_WOUT) + (size_t)(32 * nb) * 1024, nullptr, scr, lane); continue; }
        r -= I_OUT;
        { const int kb = r / 64, nb = r % 64; p0_transpose_item(A.in[I_WQ], 1024, 2048, 64 * kb, 32 * nb, (bf16*)(ws + WS_WQ) + (size_t)(32 * nb) * 1024, A.in[I_FFNG], scr, lane); }
    }
    { bf16* xb = (bf16*)((unsigned char*)F.out + OUT_XB); float* rstdx = (float*)(ws + WS_RSTDX);
      for (int m0 = 4 * gw; m0 < T; m0 += 4 * NGW) {
          f32x4 v[4][4];
#pragma unroll
          for (int r = 0; r < 4; ++r)
#pragma unroll
              for (int j = 0; j < 4; ++j) v[r][j] = ((const GAS f32x4*)(A.in[I_X] + (size_t)(m0 + r) * D))[lane + 64 * j];
#pragma unroll
          for (int r = 0; r < 4; ++r) { float s = 0.f;
#pragma unroll
              for (int j = 0; j < 4; ++j) s += (v[r][j].x * v[r][j].x + v[r][j].y * v[r][j].y) + (v[r][j].z * v[r][j].z + v[r][j].w * v[r][j].w);
              const float rs = rsqrtf(wave_sum(s) * (1.0f / 1024.0f) + 1e-6f);
              GAS unsigned long long* o8 = (GAS unsigned long long*)(xb + (size_t)(m0 + r) * D) + lane;
#pragma unroll
              for (int j = 0; j < 4; ++j) o8[64 * j] = (unsigned long long)pk2(v[r][j].x, v[r][j].y) | ((unsigned long long)pk2(v[r][j].z, v[r][j].w) << 32);
              if (lane == 0) rstdx[m0 + r] = rs; } } }
    for (int m = gw; m < NMEMTOK; m += NGW) { const float* xr = A.in[I_MEM] + (size_t)m * D; const float rs = row_rstd1024(xr, lane); cvt_row1024(xr, (bf16*)(ws + WS_MEMN) + (size_t)m * D, A.in[I_MEMG], rs, lane); }
    for (int mb = 4 * gw; mb < 2 * NEXP; mb += 4 * NGW) {
        const bool isu = mb < NEXP; const int e0 = isu ? mb : mb - NEXP;
        f32x4 v[4][4];
#pragma unroll
        for (int r = 0; r < 4; ++r) { const GAS f32x4* src = (const GAS f32x4*)((isu ? A.in[I_PU] : A.in[I_PV]) + (size_t)(e0 + r) * D) + 4 * lane;
#pragma unroll
            for (int d = 0; d < 4; ++d) v[r][d] = src[d]; }
        f32x4 gv[4];
#pragma unroll
        for (int d = 0; d < 4; ++d) gv[d] = isu ? ((const GAS f32x4*)A.in[I_FFNG])[4 * lane + d] : (f32x4){1.f, 1.f, 1.f, 1.f};
#pragma unroll
        for (int r = 0; r < 4; ++r) { const int e = e0 + r; float mx = 0.f;
#pragma unroll
            for (int d = 0; d < 4; ++d) { v[r][d] = v[r][d] * gv[d]; mx = fmaxf(mx, fmaxf(fmaxf(fabsf(v[r][d].x), fabsf(v[r][d].y)), fmaxf(fabsf(v[r][d].z), fabsf(v[r][d].w)))); }
#pragma unroll
            for (int o = 1; o < 64; o <<= 1) mx = fmaxf(mx, __shfl_xor(mx, o));
            const float inv = mx > 0.f ? 127.0f / mx : 0.f;
            v4u w;
#pragma unroll
            for (int d = 0; d < 4; ++d) { const unsigned b0 = (unsigned)(int)rintf(v[r][d].x * inv) & 0xffu, b1 = (unsigned)(int)rintf(v[r][d].y * inv) & 0xffu,
                                                         b2 = (unsigned)(int)rintf(v[r][d].z * inv) & 0xffu, b3 = (unsigned)(int)rintf(v[r][d].w * inv) & 0xffu;
                w[d] = b0 | (b1 << 8) | (b2 << 16) | (b3 << 24); }
            if (isu) ((GAS v4u*)(ws + WS_U8))[(size_t)e * 64 + lane] = w;
            else *(GAS v4u*)(ws + WS_V8 + (size_t)(lane >> 3) * (2 * MiB) + (size_t)e * 128 + (lane & 7) * 16) = w;
            if (lane == 0) ((float*)(ws + WS_SU))[2 * e + (isu ? 0 : 1)] = mx * (1.0f / 127.0f); }
    }
    for (int m = gw * 64 + lane; m < T; m += NGW * 64) ((float*)(ws + WS_ROWSQ))[m] = 0.f;
    for (int m = gw; m < 256; m += NGW) cvt_row1024(A.in[I_KEYS] + (size_t)m * 1024, (bf16*)(ws + WS_KEYS) + (size_t)m * 1024, nullptr, 1.0f, lane);
    for (int m = gw; m < 1024; m += NGW) { const int gd = m >> 1, c = (m & 1) * 64 + lane, g = gd >> 7, d = gd & 127;
        const float v = A.in[I_POOLW][(size_t)(g * 128 + c) * 128 + d] * A.in[I_POOLSC][gd];
        ((bf16*)(ws + WS_PWT))[(size_t)gd * 128 + c] = (bf16)f2bf(v); }
}

__device__ __forceinline__ void memkv_tile(const bf16* memn, const bf16* wkvT, const float* kg, const float* qg, bf16* kmem, bf16* vtmem, LAS float* part, int tile, int kc, int lane) {
    const int q = lane & 15, hi = lane >> 4, rg = (tile < 0 ? 0 : tile) >> 3, cg = (tile < 0 ? 0 : tile) & 7, r0 = rg * 16, c0 = cg * 128;
    f32x4 acc[8];
#pragma unroll
    for (int i = 0; i < 8; ++i) acc[i] = (f32x4){0.f, 0.f, 0.f, 0.f};
    const bf16* ap = memn + (size_t)(r0 + q) * 1024 + 8 * hi; const bf16* bp = wkvT + (size_t)(c0 + q) * 1024 + 8 * hi;
    if (tile >= 0)
#pragma unroll 1
    for (int kb = 2 * kc; kb < 2 * kc + 2; ++kb) {
        bf16x8 a[4], b[4][8];
#pragma unroll
        for (int k4 = 0; k4 < 4; ++k4) { a[k4] = *(const bf16x8*)(ap + 32 * (4 * kb + k4));
#pragma unroll
            for (int nf = 0; nf < 8; ++nf) b[k4][nf] = *(const bf16x8*)(bp + (size_t)(16 * nf) * 1024 + 32 * (4 * kb + k4)); }
        __builtin_amdgcn_sched_barrier(0);
#pragma unroll
        for (int k4 = 0; k4 < 4; ++k4)
#pragma unroll
            for (int nf = 0; nf < 8; ++nf) acc[nf] = mfma16(a[k4], b[k4][nf], acc[nf]);
        __builtin_amdgcn_sched_barrier(0);
    }
    if (tile >= 0 && kc > 0) {
#pragma unroll
        for (int nf = 0; nf < 8; ++nf) *(LAS f32x4*)(part + ((kc - 1) * 8 + nf) * 256 + 4 * lane) = acc[nf]; }
    __syncthreads();
    if (tile < 0 || kc > 0) return;
#pragma unroll
    for (int p = 0; p < 3; ++p)
#pragma unroll
        for (int nf = 0; nf < 8; ++nf) acc[nf] = acc[nf] + *(const LAS f32x4*)(part + (p * 8 + nf) * 256 + 4 * lane);
    if (cg < 4) {
        float rr[4];
#pragma unroll
        for (int g = 0; g < 4; ++g) { float ss = 0.f;
#pragma unroll
            for (int nf = 0; nf < 8; ++nf) ss += acc[nf][g] * acc[nf][g];
            ss += __shfl_xor(ss, 1); ss += __shfl_xor(ss, 2); ss += __shfl_xor(ss, 4); ss += __shfl_xor(ss, 8);
            rr[g] = rsqrtf(ss * (1.0f / 128.0f) + 1e-6f); }
#pragma unroll
        for (int nf = 0; nf < 8; ++nf) { const int d = 16 * nf + q; const float gs = kg[d] * qg[d];
#pragma unroll
            for (int g = 0; g < 4; ++g) kmem[(size_t)(r0 + 4 * hi + g) * 512 + cg * 128 + d] = (bf16)f2bf(acc[nf][g] * rr[g] * gs); }
    } else {
        const int h = cg - 4, b = r0 >> 8, key0 = (r0 & 255) + 4 * hi;
#pragma unroll
        for (int nf = 0; nf < 8; ++nf) { const int d = 16 * nf + q; v2u w; w.x = pk2(acc[nf][0], acc[nf][1]); w.y = pk2(acc[nf][2], acc[nf][3]);
            *(v2u*)(vtmem + (size_t)(b * 512 + h * 128 + d) * 256 + key0) = w; }
    }
}

__device__ __forceinline__ void na_item(const bf16* __restrict__ qn, const bf16* __restrict__ kn, const bf16* __restrict__ vt, const LAS float* rpl, bf16* __restrict__ yna,
                                        int b, int r, int jb, int h, int lane) {
    const int q = lane & 15, hi = lane >> 4;
    int rs = r - 4; rs = rs < 0 ? 0 : (rs > 120 ? 120 : rs);
    int kb0 = jb * 16 - 8; kb0 = kb0 < 0 ? 0 : (kb0 > 32 ? 32 : kb0);
    const int qcol = jb * 16 + q; int cs = qcol - 8; cs = cs < 0 ? 0 : (cs > 48 ? 48 : cs);
    const size_t tokq = (size_t)b * SEQ + r * 64 + qcol;
    const bf16* qp = qn + tokq * 512 + h * 64 + 8 * hi;
    const bf16x8 qf0 = *(const bf16x8*)qp, qf1 = *(const bf16x8*)(qp + 32);
    const int kq = 8 * (q >> 2) + (q & 3);
    const bf16* kbase = kn + ((size_t)b * SEQ + rs * 64 + kb0 + kq) * 512 + h * 64 + 8 * hi;
    f32x4 s[16];
    {
        bf16x8 ka[16][2];
#pragma unroll
        for (int f = 0; f < 16; ++f) { const bf16* kp = kbase + (size_t)((f >> 1) * 64 + (f & 1) * 4) * 512; ka[f][0] = *(const bf16x8*)kp; ka[f][1] = *(const bf16x8*)(kp + 32); }
        __builtin_amdgcn_sched_barrier(0);
#pragma unroll
        for (int f = 0; f < 16; ++f) { f32x4 z = (f32x4){0.f, 0.f, 0.f, 0.f}; z = mfma16(ka[f][0], qf0, z); s[f] = mfma16(ka[f][1], qf1, z); }
    }
    const bf16* vbase = vt + ((size_t)(b * 512 + h * 64 + q) * SEQ + rs * 64 + kb0 + 8 * hi);
    bf16x8 va[8][4];
#pragma unroll
    for (int st = 0; st < 8; ++st)
#pragma unroll
        for (int mf = 0; mf < 4; ++mf) va[st][mf] = *(const bf16x8*)(vbase + (size_t)(16 * mf) * SEQ + st * 64);
    __builtin_amdgcn_sched_barrier(0);
    float mx = -3.0e38f;
#pragma unroll
    for (int f = 0; f < 16; ++f) {
        const int dr = rs + (f >> 1) - r + 7;
#pragma unroll
        for (int g = 0; g < 4; ++g) {
            const int kcol = kb0 + 8 * hi + 4 * (f & 1) + g;
            const bool ok = (kcol >= cs) && (kcol < cs + 16);
            int dc = kcol - qcol + 15; dc = dc < 0 ? 0 : (dc > 30 ? 30 : dc);
            const float v = ok ? s[f][g] + rpl[dr * 31 + dc] : -1.0e30f;
            s[f][g] = v; mx = fmaxf(mx, v);
        }
    }
    mx = fmaxf(mx, __shfl_xor(mx, 16)); mx = fmaxf(mx, __shfl_xor(mx, 32));
    float sum = 0.f;
#pragma unroll
    for (int f = 0; f < 16; ++f)
#pragma unroll
        for (int g = 0; g < 4; ++g) { const float p = __expf(s[f][g] - mx); s[f][g] = p; sum += p; }
    sum += __shfl_xor(sum, 16); sum += __shfl_xor(sum, 32);
    const float inv = 1.0f / sum;
    f32x4 o[4];
#pragma unroll
    for (int i = 0; i < 4; ++i) o[i] = (f32x4){0.f, 0.f, 0.f, 0.f};
#pragma unroll
    for (int st = 0; st < 8; ++st) {
        const bf16x8 pb = __builtin_bit_cast(bf16x8, pg8::pack8(s[2 * st], s[2 * st + 1]));
#pragma unroll
        for (int mf = 0; mf < 4; ++mf) o[mf] = mfma16(va[st][mf], pb, o[mf]);
    }
    bf16* yp = yna + tokq * 1536 + h * 64 + 4 * hi;
#pragma unroll
    for (int mf = 0; mf < 4; ++mf) { v2u w; w.x = pk2(o[mf][0] * inv, o[mf][1] * inv); w.y = pk2(o[mf][2] * inv, o[mf][3] * inv); *(v2u*)(yp + 16 * mf) = w; }
}
__device__ __forceinline__ void xa_fill_lds(const bf16* __restrict__ kmem, const bf16* __restrict__ vtmem, LAS unsigned char* lds, int b, int h, int tid) {
#pragma unroll
    for (int ps = 0; ps < 8; ++ps) { const int id = tid + 512 * ps, key = id >> 4, c = id & 15;
        *(LAS v4u*)(lds + key * 256 + ((c ^ (key & 15)) << 4)) = *(const v4u*)(kmem + ((size_t)b * 256 + key) * 512 + h * 128 + 8 * c); }
#pragma unroll
    for (int ps = 0; ps < 8; ++ps) { const int id = tid + 512 * ps, dim = id >> 5, c = id & 31;
        *(LAS v4u*)(lds + 65536 + dim * 512 + ((c ^ (dim & 15)) << 4)) = *(const v4u*)(vtmem + (size_t)(b * 512 + h * 128 + dim) * 256 + 8 * c); }
}
__device__ __forceinline__ void xa_item(const bf16* __restrict__ xq, const LAS unsigned char* lds, bf16* __restrict__ yxa, int tok0, int h, int lane) {
    const int q = lane & 15, hi = lane >> 4; const size_t tok = (size_t)tok0 + q;
    const bf16* qp = xq + tok * 512 + h * 128 + 8 * hi;
    bf16x8 qf[4]; float ssq = 0.f;
#pragma unroll
    for (int ks = 0; ks < 4; ++ks) qf[ks] = *(const bf16x8*)(qp + 32 * ks);
    __builtin_amdgcn_sched_barrier(0);
#pragma unroll
    for (int ks = 0; ks < 4; ++ks)
#pragma unroll
        for (int j = 0; j < 8; ++j) { const float v = bf1(qf[ks][j]); ssq += v * v; }
    ssq += __shfl_xor(ssq, 16); ssq += __shfl_xor(ssq, 32);
    const float cexp = rsqrtf(ssq * (1.0f / 128.0f) + 1e-6f) * 0.08838834764831845f * 1.4426950408889634f;
    const int kq = 8 * (q >> 2) + (q & 3);
    f32x4 s[16];
#pragma unroll
    for (int f = 0; f < 16; ++f) { const int key = 32 * (f >> 1) + 4 * (f & 1) + kq; const LAS unsigned char* kr = lds + key * 256; f32x4 z = (f32x4){0.f, 0.f, 0.f, 0.f};
#pragma unroll
        for (int ks = 0; ks < 4; ++ks) z = mfma16(*(const LAS bf16x8*)(kr + (((4 * ks + hi) ^ (key & 15)) << 4)), qf[ks], z);
        s[f] = z; }
    float mx = -3.0e38f;
#pragma unroll
    for (int f = 0; f < 16; ++f)
#pragma unroll
        for (int g = 0; g < 4; ++g) mx = fmaxf(mx, s[f][g]);
    mx = fmaxf(mx, __shfl_xor(mx, 16)); mx = fmaxf(mx, __shfl_xor(mx, 32));
    float sum = 0.f;
#pragma unroll
    for (int f = 0; f < 16; ++f)
#pragma unroll
        for (int g = 0; g < 4; ++g) { const float p = __builtin_amdgcn_exp2f((s[f][g] - mx) * cexp); s[f][g] = p; sum += p; }
    sum += __shfl_xor(sum, 16); sum += __shfl_xor(sum, 32);
    const float inv = 1.0f / sum;
    f32x4 o[8];
#pragma unroll
    for (int i = 0; i < 8; ++i) o[i] = (f32x4){0.f, 0.f, 0.f, 0.f};
#pragma unroll
    for (int st = 0; st < 8; ++st) {
        const bf16x8 pb = __builtin_bit_cast(bf16x8, pg8::pack8(s[2 * st], s[2 * st + 1]));
#pragma unroll
        for (int mf = 0; mf < 8; ++mf) { const int dim = 16 * mf + q; o[mf] = mfma16(*(const LAS bf16x8*)(lds + 65536 + dim * 512 + (((4 * st + hi) ^ (dim & 15)) << 4)), pb, o[mf]); }
    }
    bf16* yp = yxa + tok * 1536 + h * 128 + 4 * hi;
#pragma unroll
    for (int mf = 0; mf < 8; ++mf) { v2u w; w.x = pk2(o[mf][0] * inv, o[mf][1] * inv); w.y = pk2(o[mf][2] * inv, o[mf][3] * inv); *(v2u*)(yp + 16 * mf) = w; }
}
__device__ __forceinline__ void pool_wg(const bf16* __restrict__ pp, const bf16* __restrict__ pwT, bf16* __restrict__ ypool, LAS unsigned char* lds, int tokbase, int wave, int lane) {
    const int q = lane & 15, hi = lane >> 4;
    __syncthreads();
    {
        const int hw = 1 << hi, tw0 = tokbase + 16 * wave, b = tw0 >> 13, t0 = tw0 & 8191;
        const bf16* base = pp + (size_t)b * SEQ * 512 + 8 * lane;
        float s[8];
#pragma unroll
        for (int j = 0; j < 8; ++j) s[j] = 0.f;
#pragma unroll 4
        for (int d = -8; d < 8; ++d) { const int u = t0 + d; const bool ok = (d >= -hw) && (d < hw) && (u >= 0) && (u < SEQ);
            const bf16x8 v = *(const bf16x8*)(base + (size_t)(ok ? u : t0) * 512);
#pragma unroll
            for (int j = 0; j < 8; ++j) s[j] += ok ? bf1(v[j]) : 0.f; }
        LAS unsigned char* tile = lds + wave * 16384;
#pragma unroll 4
        for (int i = 0; i < 16; ++i) { const int t = t0 + i;
            int lo = t - hw; lo = lo < 0 ? 0 : lo; int ht = t + hw; ht = ht > SEQ ? SEQ : ht;
            const float inv = 1.0f / (float)(ht - lo);
            const bool oka = (t + hw) < SEQ, oks = (t - hw) >= 0;
            const bf16x8 sv = *(const bf16x8*)(base + (size_t)t * 512), av = *(const bf16x8*)(base + (size_t)(oka ? t + hw : t) * 512), bv = *(const bf16x8*)(base + (size_t)(oks ? t - hw : t) * 512);
            f32x4 p0, p1;
#pragma unroll
            for (int j = 0; j < 4; ++j) { p0[j] = s[j] * inv - bf1(sv[j]); p1[j] = s[j + 4] * inv - bf1(sv[j + 4]); }
            *(LAS v4u*)(tile + i * 1024 + ((lane ^ (i & 15)) << 4)) = pg8::pack8(p0, p1);
#pragma unroll
            for (int j = 0; j < 8; ++j) s[j] += (oka ? bf1(av[j]) : 0.f) - (oks ? bf1(bv[j]) : 0.f);
        }
    }
    __syncthreads();
#pragma unroll 1
    for (int k = 0; k < 4; ++k) {
        const int pair = wave * 4 + k, g = pair >> 3, mf = pair & 7;
        const bf16* wb = pwT + (size_t)(g * 128 + 16 * mf + q) * 128 + 8 * hi;
        bf16x8 a[4];
#pragma unroll
        for (int ks = 0; ks < 4; ++ks) a[ks] = *(const bf16x8*)(wb + 32 * ks);
#pragma unroll 2
        for (int tg = 0; tg < 8; ++tg) {
            const LAS unsigned char* trow = lds + tg * 16384 + q * 1024; f32x4 o = (f32x4){0.f, 0.f, 0.f, 0.f};
#pragma unroll
            for (int ks = 0; ks < 4; ++ks) { const int c = g * 16 + 4 * ks + hi; o = mfma16(a[ks], *(const LAS bf16x8*)(trow + ((c ^ q) << 4)), o); }
            v2u w; w.x = pk2(o[0], o[1]); w.y = pk2(o[2], o[3]);
            *(v2u*)(ypool + (size_t)(tokbase + 16 * tg + q) * 1536 + g * 128 + 16 * mf + 4 * hi) = w;
        }
    }
    __syncthreads();
}

__device__ __forceinline__ int f2key(float s, int idx, int mask) { int b = __builtin_bit_cast(int, s); b = b >= 0 ? b : (b ^ 0x7fffffff); return (b & ~mask) | idx; }
__device__ __forceinline__ float key2f(int k) { k = k >= 0 ? k : (k ^ 0x7fffffff); return __builtin_bit_cast(float, k); }
#define CE_DESC(x, y) do { const int _h = (x) > (y) ? (x) : (y), _l = (x) > (y) ? (y) : (x); (x) = _h; (y) = _l; } while (0)
__device__ __forceinline__ void sort16(int (&a)[16]) {
#pragma unroll
    for (int ks = 1; ks <= 4; ++ks)
#pragma unroll
        for (int js = ks - 1; js >= 0; --js)
#pragma unroll
            for (int i = 0; i < 16; ++i) { const int k = 1 << ks, j = 1 << js, l = i ^ j;
                if (l > i) { if ((i & k) == 0) CE_DESC(a[i], a[l]); else CE_DESC(a[l], a[i]); } }
}
__device__ __forceinline__ void merge16(int (&a)[16], const int (&b)[16]) {
#pragma unroll
    for (int i = 0; i < 16; ++i) a[i] = a[i] > b[15 - i] ? a[i] : b[15 - i];
#pragma unroll
    for (int js = 3; js >= 0; --js)
#pragma unroll
        for (int i = 0; i < 16; ++i) { const int j = 1 << js, l = i ^ j; if (l > i) CE_DESC(a[i], a[l]); }
}
__device__ __forceinline__ void merge16_lanes(int (&a)[16], int step) { int o[16];
#pragma unroll
    for (int k = 0; k < 16; ++k) o[k] = __shfl_xor(a[k], step);
    merge16(a, o); }
__device__ constexpr int cand_i(int hi, int m) {
    return hi == 0 ? 0
         : hi == 1 ? (m < 8 ? 1 : (m < 13 ? 2 : -1))
         : hi == 2 ? (m < 4 ? 3 : (m < 7 ? 4 : (m < 9 ? 5 : (m < 11 ? 6 : -1))))
         :           (m < 2 ? 7 : (m < 10 ? 8 + (m - 2) : -1));
}
__device__ constexpr int cand_j(int hi, int m) {
    return hi == 0 ? m
         : hi == 1 ? (m < 8 ? m : (m < 13 ? m - 8 : -1))
         : hi == 2 ? (m < 4 ? m : (m < 7 ? m - 4 : (m < 9 ? m - 7 : (m < 11 ? m - 9 : -1))))
         :           (m < 2 ? m : (m < 10 ? 0 : -1));
}
__device__ __forceinline__ void topk_fill_lds(const bf16* __restrict__ keys, LAS unsigned char* lds, int h, int tid) {
#pragma unroll
    for (int ps = 0; ps < 8; ++ps) { const int id = tid + 512 * ps, row = id >> 4, c = id & 15;
        *(LAS v4u*)(lds + row * 256 + ((c ^ (row & 15)) << 4)) = *(const v4u*)(keys + ((size_t)h * 256 + row) * 128 + 8 * c); }
}
struct TopkQ { bf16x8 q[2][4]; };
__device__ __forceinline__ void topk_loadq(TopkQ& Q, const bf16* __restrict__ qb, int tok0, int h, int lane) {
    const size_t tok = (size_t)tok0 + (lane & 15); const int hi = lane >> 4;
#pragma unroll
    for (int p = 0; p < 2; ++p)
#pragma unroll
        for (int ks = 0; ks < 4; ++ks) Q.q[p][ks] = *(const bf16x8*)(qb + tok * 2048 + h * 256 + p * 128 + 32 * ks + 8 * hi);
}
__device__ __forceinline__ void topk_item(const TopkQ& Q, const LAS unsigned char* klds, int* __restrict__ te, float* __restrict__ tw, LAS int* lscr, int tok0, int h, int lane) {
    const int q = lane & 15, hi = lane >> 4; const size_t tok = (size_t)tok0 + q;
    int L[2][16];
#pragma unroll
    for (int p = 0; p < 2; ++p) {
        int B[16];
#pragma unroll
        for (int mf = 0; mf < 8; ++mf) { f32x4 s = (f32x4){0.f, 0.f, 0.f, 0.f}; const int row = p * 128 + 16 * mf + q;
#pragma unroll
            for (int ks = 0; ks < 4; ++ks) s = mfma16(*(const LAS bf16x8*)(klds + row * 256 + (((4 * ks + hi) ^ (row & 15)) << 4)), Q.q[p][ks], s);
#pragma unroll
            for (int g = 0; g < 4; ++g) { const int key = f2key(s[g], 16 * mf + 4 * hi + g, 127); if (mf < 4) L[p][4 * mf + g] = key; else B[4 * (mf - 4) + g] = key; } }
        sort16(L[p]); sort16(B); merge16(L[p], B);
        merge16_lanes(L[p], 16); merge16_lanes(L[p], 32);
    }
    float v1[16], v2[16];
#pragma unroll
    for (int k = 0; k < 16; ++k) { v1[k] = key2f(L[0][k]); v2[k] = key2f(L[1][k]); }
    int Fk[16];
#pragma unroll
    for (int m = 0; m < 16; ++m) {
        float sm = v1[0] + v2[m]; int id = 255 - m;
        if (cand_i(1, m) >= 0) { if (hi == 1) { sm = v1[cand_i(1, m) < 0 ? 0 : cand_i(1, m)] + v2[cand_j(1, m) < 0 ? 0 : cand_j(1, m)]; id = 255 - ((cand_i(1, m) << 4) | cand_j(1, m)); } }
        if (cand_i(2, m) >= 0) { if (hi == 2) { sm = v1[cand_i(2, m) < 0 ? 0 : cand_i(2, m)] + v2[cand_j(2, m) < 0 ? 0 : cand_j(2, m)]; id = 255 - ((cand_i(2, m) << 4) | cand_j(2, m)); } }
        if (cand_i(3, m) >= 0) { if (hi == 3) { sm = v1[cand_i(3, m) < 0 ? 0 : cand_i(3, m)] + v2[cand_j(3, m) < 0 ? 0 : cand_j(3, m)]; id = 255 - ((cand_i(3, m) << 4) | cand_j(3, m)); } }
        int key = f2key(sm, id, 255);
        if ((hi == 1 && cand_i(1, m) < 0) || (hi == 2 && cand_i(2, m) < 0) || (hi == 3 && cand_i(3, m) < 0)) key = (int)0x80000000;
        Fk[m] = key;
    }
    sort16(Fk); merge16_lanes(Fk, 16); merge16_lanes(Fk, 32);
    LAS int* my = lscr + lane * 32;
#pragma unroll
    for (int k = 0; k < 16; ++k) { my[k] = L[0][k] & 127; my[16 + k] = L[1][k] & 127; }
    LDS_WAIT(); asm volatile("" ::: "memory");
    float e[16]; float sum = 0.f; const float mx = key2f(Fk[0]);
#pragma unroll
    for (int k = 0; k < 16; ++k) { e[k] = __expf(key2f(Fk[k]) - mx); sum += e[k]; }
    const float inv = 1.0f / sum;
    if (hi == 0) {
        int* tep = te + tok * 128; float* twp = tw + tok * 128;
#pragma unroll
        for (int kk = 0; kk < 16; ++kk) { const int ij = 255 - (Fk[kk] & 255), i = ij >> 4, j = ij & 15, slot = (kk & 7) * 16 + 2 * h + (kk >> 3);
            tep[slot] = my[i] * 128 + my[16 + j]; twp[slot] = e[kk] * inv; }
    }
    LDS_WAIT(); asm volatile("" ::: "memory");
}

__device__ __forceinline__ float ub2f(unsigned v, int b) { return (float)((v >> (8 * b)) & 0xffu); }
struct HqIn { v4u hA, hB; float rsq; };
__device__ __forceinline__ void hq_load(HqIn& in, const bf16* __restrict__ hb, const float* __restrict__ rowsq, int tok, int lane) {
    const bf16* hp = hb + (size_t)tok * 1024 + 16 * lane; in.hA = *(const v4u*)hp; in.hB = *(const v4u*)(hp + 8); in.rsq = rowsq[tok]; }
__device__ __forceinline__ void hq_token(const HqIn& in, unsigned char* __restrict__ hq, float* __restrict__ hs, int tok, int lane) {
    const v4u hA = in.hA, hB = in.hB;
    float hf[16];
#pragma unroll
    for (int d = 0; d < 4; ++d) { hf[2 * d] = bflo(hA[d]); hf[2 * d + 1] = bfhi(hA[d]); hf[8 + 2 * d] = bflo(hB[d]); hf[8 + 2 * d + 1] = bfhi(hB[d]); }
    float amax = 0.f;
#pragma unroll
    for (int j = 0; j < 16; ++j) amax = fmaxf(amax, fabsf(hf[j]));
#pragma unroll
    for (int o = 1; o < 64; o <<= 1) amax = fmaxf(amax, __shfl_xor(amax, o));
    const float hinv = amax > 0.f ? 127.0f / amax : 0.f;
    v4u w;
#pragma unroll
    for (int d = 0; d < 4; ++d) { const unsigned b0 = (unsigned)(int)rintf(hf[4 * d] * hinv) & 0xffu, b1 = (unsigned)(int)rintf(hf[4 * d + 1] * hinv) & 0xffu,
                                                 b2 = (unsigned)(int)rintf(hf[4 * d + 2] * hinv) & 0xffu, b3 = (unsigned)(int)rintf(hf[4 * d + 3] * hinv) & 0xffu;
        w[d] = b0 | (b1 << 8) | (b2 << 16) | (b3 << 24); }
    *(v4u*)(hq + (size_t)tok * 1024 + 16 * lane) = w;
    if (lane == 0) hs[tok] = rsqrtf(in.rsq * (1.0f / 1024.0f) + 1e-6f) * amax * (1.0f / 127.0f);
}
constexpr int PA_SLOTS = 12;
struct PeerA1 { int e; float g; };
struct PeerA2 { v4u ur[3][4]; float su, sv; int cnt, rk; bool m; unsigned long long rem; };
struct PeerAH { v4u hv[4]; float hsc; };
__device__ __forceinline__ void pa_s1(PeerA1& a, const int* __restrict__ te, const float* __restrict__ tw, int tok, int half, int lane) {
    a.e = te[(size_t)tok * 128 + 64 * half + lane]; a.g = tw[(size_t)tok * 128 + 64 * half + lane]; }
__device__ __forceinline__ void pa_s1h(PeerAH& h, const unsigned char* __restrict__ hq, const float* __restrict__ hs, int tok, int lane) {
    const int t = lane & 15;
#pragma unroll
    for (int i = 0; i < 4; ++i) h.hv[i] = *(const v4u*)(hq + (size_t)tok * 1024 + 16 * t + 256 * i);
    h.hsc = hs[tok]; }
__device__ __forceinline__ void pa_s2(PeerA2& b, const PeerA1& a, const unsigned char* __restrict__ u8, const float* __restrict__ su, LAS int* lst, int x, int lane, int hot) {
    b.m = (a.e >> 11) == x;
    const unsigned long long mask = __ballot(b.m);
    b.cnt = __popcll(mask); b.rk = (int)__builtin_amdgcn_mbcnt_hi((unsigned)(mask >> 32), __builtin_amdgcn_mbcnt_lo((unsigned)mask, 0u));
    if (b.m && b.rk < PA_SLOTS) lst[b.rk] = a.e;
    b.rem = 0ull; if (b.cnt > PA_SLOTS) { unsigned long long r = mask;
#pragma unroll
        for (int k = 0; k < PA_SLOTS; ++k) r &= r - 1ull;
        b.rem = r; }
    { typedef float f32x2s __attribute__((ext_vector_type(2))); f32x2s s2 = (f32x2s){0.f, 0.f}; if (b.m) s2 = ((const f32x2s*)su)[a.e]; b.su = s2.x; b.sv = s2.y; }
    const int r = lane >> 4, t = lane & 15;
    LDS_WAIT(); asm volatile("" ::: "memory");
    const int lim = b.cnt < PA_SLOTS ? b.cnt : PA_SLOTS;
#pragma unroll
    for (int q = 0; q < 3; ++q) { const int slot = 4 * q + r;
        if (slot < lim) { int e = lst[slot]; if (hot) e = (x << 11) | (e & 255); const unsigned char* rp = u8 + (size_t)e * 1024 + 16 * t;
#pragma unroll
            for (int i = 0; i < 4; ++i) b.ur[q][i] = *(const v4u*)(rp + 256 * i); } }
}
__device__ __forceinline__ int dot16(const v4u u, const v4u h) { int d = __builtin_amdgcn_sdot4((int)u.x, (int)h.x, 0, false); d = __builtin_amdgcn_sdot4((int)u.y, (int)h.y, d, false);
    d = __builtin_amdgcn_sdot4((int)u.z, (int)h.z, d, false); return __builtin_amdgcn_sdot4((int)u.w, (int)h.w, d, false); }
template <int CTRL, int RM> __device__ __forceinline__ int dpp_i(int x) { return __builtin_amdgcn_update_dpp(0, x, CTRL, RM, 0xf, false); }
__device__ __forceinline__ int wave_sum_to63(int x) { x += dpp_i<0xb1, 0xf>(x); x += dpp_i<0x4e, 0xf>(x); x += dpp_i<0x124, 0xf>(x); x += dpp_i<0x128, 0xf>(x); x += dpp_i<0x142, 0xa>(x); x += dpp_i<0x143, 0xc>(x); return x; }
__device__ __forceinline__ int row_sum16(int x) { x += dpp_i<0xb1, 0xf>(x); x += dpp_i<0x4e, 0xf>(x); x += dpp_i<0x124, 0xf>(x); x += dpp_i<0x128, 0xf>(x); return x; }
__device__ __forceinline__ float gelu_erf(float v) {
    const float av = fabsf(v), t = __builtin_amdgcn_rcpf(av * 0.2316418882f + 1.0f);
    float q = t * 0.5307027145f + (-0.7265760135f); q = q * t + 0.7107068705f; q = q * t + (-0.142248368f); q = q * t + 0.127414796f; q = q * t;
    const float e = __builtin_amdgcn_exp2f((v * v) * (-0.72134752044f)), m = v * (q * e);
    return v < 0.f ? m : v - m; }
__device__ __forceinline__ void pa_s3(const PeerA2& b, const PeerA1& a, const PeerAH& h, const unsigned char* __restrict__ u8, const unsigned char* __restrict__ hq, float* __restrict__ aw, int tok, int half, int lane) {
    int mine = 0;
#pragma unroll
    for (int q = 0; q < 3; ++q) { int d = dot16(b.ur[q][0], h.hv[0]); d += dot16(b.ur[q][1], h.hv[1]); d += dot16(b.ur[q][2], h.hv[2]); d += dot16(b.ur[q][3], h.hv[3]);
        d = row_sum16(d);
#pragma unroll
        for (int r = 0; r < 4; ++r) { const int s = __builtin_amdgcn_readlane(d, 16 * r); mine = (b.rk == 4 * q + r) ? s : mine; } }
    float* awp = aw + (size_t)tok * 128 + 64 * half + lane;
    if (b.m && b.rk < PA_SLOTS) *awp = a.g * gelu_erf((float)mine * h.hsc * b.su) * b.sv;
    if (b.cnt > PA_SLOTS) {
        unsigned long long rem = b.rem; const v4u hw = *(const v4u*)(hq + (size_t)tok * 1024 + 16 * lane);
        while (rem != 0ull) { const int idx = __builtin_ctzll(rem); rem &= rem - 1ull; const int e = __builtin_amdgcn_readlane(a.e, idx);
            const int d = __builtin_amdgcn_readlane(wave_sum_to63(dot16(*(const v4u*)(u8 + (size_t)e * 1024 + 16 * lane), hw)), 63);
            if (lane == idx) *awp = a.g * gelu_erf((float)d * h.hsc * b.su) * b.sv; }
    }
}
__device__ __forceinline__ void peer_a_run(const unsigned char* __restrict__ hq, const float* __restrict__ hs, const unsigned char* __restrict__ u8, const float* __restrict__ su,
                                           const float* __restrict__ sv, const int* __restrict__ te, const float* __restrict__ tw, float* __restrict__ aw, LAS int* lst, int wrank, int wstep, int x, int lane, int hot = 0) {
    const int ntok = wrank < T ? (T - wrank + wstep - 1) / wstep : 0, N = 2 * ntok; (void)sv;
#define PA_TOK(n) (wrank + ((n) >> 1) * wstep)
    if (N == 0) return;
    PeerA1 a0, a1, a2, a3; PeerA2 bA, bB; PeerAH h0, h1;
#pragma unroll
    for (int q = 0; q < 3; ++q)
#pragma unroll
        for (int i = 0; i < 4; ++i) { bA.ur[q][i] = (v4u){0u, 0u, 0u, 0u}; bB.ur[q][i] = (v4u){0u, 0u, 0u, 0u}; }
    pa_s1(a0, te, tw, PA_TOK(0), 0, lane); pa_s1(a1, te, tw, PA_TOK(1), 1, lane); pa_s1h(h0, hq, hs, PA_TOK(0), lane);
    if (N > 2) { pa_s1(a2, te, tw, PA_TOK(2), 0, lane); pa_s1(a3, te, tw, PA_TOK(3), 1, lane); pa_s1h(h1, hq, hs, PA_TOK(2), lane); }
    pa_s2(bA, a0, u8, su, lst, x, lane, hot);
#define PA_STEP(n, Bcur, Bnext, Acur, Anext, Hcur, LOADH) do { \
        if ((n) + 1 < N) pa_s2(Bnext, Anext, u8, su, lst, x, lane, hot); \
        pa_s3(Bcur, Acur, Hcur, u8, hq, aw, PA_TOK(n), (n) & 1, lane); \
        if ((n) + 4 < N) { pa_s1(Acur, te, tw, PA_TOK((n) + 4), (n) & 1, lane); } \
        if (LOADH && (n) + 3 < N) pa_s1h(Hcur, hq, hs, PA_TOK((n) + 3), lane); } while (0)
    for (int n = 0; n < N; n += 4) {
        PA_STEP(n, bA, bB, a0, a1, h0, 0);
        if (n + 1 < N) PA_STEP(n + 1, bB, bA, a1, a2, h0, 1);
        if (n + 2 < N) PA_STEP(n + 2, bA, bB, a2, a3, h1, 0);
        if (n + 3 < N) PA_STEP(n + 3, bB, bA, a3, a0, h1, 1);
    }
#undef PA_STEP
#undef PA_TOK
}
struct PeerB1 { v4u e[4]; f32x4 w[4]; unsigned h2; };
struct PeerB2 { v4u vr[8]; };
struct PeerBAcc { int acc[16]; int wq[4]; float wsc, h0, h1; };
typedef float f32x2v __attribute__((ext_vector_type(2)));
__device__ __forceinline__ void pb_s1(PeerB1& a, const int* __restrict__ te, const float* __restrict__ aw, int tok, int lane) {
    const v4u* ep = (const v4u*)(te + (size_t)tok * 128 + 16 * (lane >> 3)); const f32x4* wp = (const f32x4*)(aw + (size_t)tok * 128 + 16 * (lane >> 3));
#pragma unroll
    for (int j = 0; j < 4; ++j) { a.e[j] = ep[j]; a.w[j] = wp[j]; } }
__device__ __forceinline__ int pb_col(int lane) { return 16 * (lane & 7) + 8 * ((lane >> 5) & 1) + 4 * ((lane >> 4) & 1) + 2 * ((lane >> 3) & 1); }
template <int CTRL, int RM> __device__ __forceinline__ float dpp_f(float x) { return __builtin_bit_cast(float, __builtin_amdgcn_update_dpp(0, __builtin_bit_cast(int, x), CTRL, RM, 0xf, false)); }
__device__ __forceinline__ void pb_quant(PeerBAcc& A, const PeerB1& a) {
    float mx = 0.f;
#pragma unroll
    for (int j = 0; j < 4; ++j) mx = fmaxf(mx, fmaxf(fmaxf(fabsf(a.w[j][0]), fabsf(a.w[j][1])), fmaxf(fabsf(a.w[j][2]), fabsf(a.w[j][3]))));
    mx = fmaxf(mx, dpp_f<0xb1, 0xf>(mx)); mx = fmaxf(mx, dpp_f<0x4e, 0xf>(mx)); mx = fmaxf(mx, dpp_f<0x124, 0xf>(mx)); mx = fmaxf(mx, dpp_f<0x128, 0xf>(mx));
    mx = fmaxf(mx, dpp_f<0x142, 0xa>(mx)); mx = fmaxf(mx, dpp_f<0x143, 0xc>(mx));
    mx = __builtin_bit_cast(float, __builtin_amdgcn_readlane(__builtin_bit_cast(int, mx), 63));
    const float inv = mx > 0.f ? 127.0f / mx : 0.f; A.wsc = mx * (1.0f / 127.0f);
#pragma unroll
    for (int j = 0; j < 4; ++j) A.wq[j] = (int)(((unsigned)(int)rintf(a.w[j][0] * inv) & 0xffu) | (((unsigned)(int)rintf(a.w[j][1] * inv) & 0xffu) << 8) |
                                               (((unsigned)(int)rintf(a.w[j][2] * inv) & 0xffu) << 16) | (((unsigned)(int)rintf(a.w[j][3] * inv) & 0xffu) << 24));
}
template <int HF, int MODE> __device__ __forceinline__ void pb_s2(PeerB2& b, const PeerB1& a, const unsigned char* __restrict__ v8x, int lane) {
    const int c = lane & 7;
#pragma unroll
    for (int m = 0; m < 8; ++m) { unsigned e = a.e[2 * HF + (m >> 2)][m & 3]; if (MODE & 1) e &= 255u;
        if (MODE & 2) b.vr[m] = (v4u){e, e + 1u, e + 2u, e + 3u}; else b.vr[m] = *(const v4u*)(v8x + (size_t)e * 128 + 16 * c); }
}
__device__ __forceinline__ float swap32_add(float lo, float hi) { const auto r = __builtin_amdgcn_permlane32_swap(__builtin_bit_cast(unsigned, lo), __builtin_bit_cast(unsigned, hi), false, false);
    return __builtin_bit_cast(float, r[0]) + __builtin_bit_cast(float, r[1]); }
__device__ __forceinline__ float swap16_add(float lo, float hi) { const auto r = __builtin_amdgcn_permlane16_swap(__builtin_bit_cast(unsigned, lo), __builtin_bit_cast(unsigned, hi), false, false);
    return __builtin_bit_cast(float, r[0]) + __builtin_bit_cast(float, r[1]); }
template <int HF, int MODE> __device__ __forceinline__ void pb_s3(PeerBAcc& A, const PeerB2& b, const PeerB1& a, float* out, int tok, int x, int lane) {
    if (MODE & 8) { if (HF == 0) { A.acc[0] = 0; }
#pragma unroll
        for (int m = 0; m < 8; ++m) A.acc[0] += (int)(b.vr[m].x ^ b.vr[m].y ^ b.vr[m].z ^ b.vr[m].w);
        if (HF == 1) { f32x2v h2; h2.x = A.h0 + (float)A.acc[0]; h2.y = A.h1 + A.wsc; *(f32x2v*)(out + (size_t)tok * 1024 + 128 * x + pb_col(lane)) = h2; }
        return; }
    if (HF == 0) {
#pragma unroll
        for (int j = 0; j < 16; ++j) A.acc[j] = 0;
    }
#pragma unroll
    for (int gg = 0; gg < 2; ++gg)
#pragma unroll
        for (int d = 0; d < 4; ++d) { const unsigned ra = b.vr[4 * gg][d], rb = b.vr[4 * gg + 1][d], rc = b.vr[4 * gg + 2][d], rd = b.vr[4 * gg + 3][d];
            const unsigned t0 = __builtin_amdgcn_perm(rb, ra, 0x05010400u), t1 = __builtin_amdgcn_perm(rb, ra, 0x07030602u), t2 = __builtin_amdgcn_perm(rd, rc, 0x05010400u), t3 = __builtin_amdgcn_perm(rd, rc, 0x07030602u);
            const unsigned c0 = __builtin_amdgcn_perm(t2, t0, 0x05040100u), c1 = __builtin_amdgcn_perm(t2, t0, 0x07060302u), c2 = __builtin_amdgcn_perm(t3, t1, 0x05040100u), c3 = __builtin_amdgcn_perm(t3, t1, 0x07060302u);
            const int w4 = A.wq[2 * HF + gg];
            A.acc[4 * d] = __builtin_amdgcn_sdot4((int)c0, w4, A.acc[4 * d], false); A.acc[4 * d + 1] = __builtin_amdgcn_sdot4((int)c1, w4, A.acc[4 * d + 1], false);
            A.acc[4 * d + 2] = __builtin_amdgcn_sdot4((int)c2, w4, A.acc[4 * d + 2], false); A.acc[4 * d + 3] = __builtin_amdgcn_sdot4((int)c3, w4, A.acc[4 * d + 3], false); }
    if (HF == 1) {
        int r8[8], r4[4], r2[2];
#pragma unroll
        for (int j = 0; j < 8; ++j) { const bool up = (lane & 32) != 0; const int keep = up ? A.acc[j + 8] : A.acc[j], send = up ? A.acc[j] : A.acc[j + 8]; r8[j] = keep + __shfl_xor(send, 32); }
#pragma unroll
        for (int j = 0; j < 4; ++j) { const bool up = (lane & 16) != 0; const int keep = up ? r8[j + 4] : r8[j], send = up ? r8[j] : r8[j + 4]; r4[j] = keep + __shfl_xor(send, 16); }
#pragma unroll
        for (int j = 0; j < 2; ++j) { const bool up = (lane & 8) != 0; const int keep = up ? r4[j + 2] : r4[j], send = up ? r4[j] : r4[j + 2];
            r2[j] = keep + __builtin_amdgcn_update_dpp(0, send, 0x128, 0xf, 0xf, false); }
        f32x2v h2; h2.x = A.h0 + A.wsc * (float)r2[0]; h2.y = A.h1 + A.wsc * (float)r2[1];
        *(f32x2v*)(out + (size_t)tok * 1024 + 128 * x + pb_col(lane)) = h2;
    }
}
__device__ __forceinline__ void pb_s1h(PeerB1& a, const int* __restrict__ te, const float* __restrict__ aw, const bf16* __restrict__ hb, int tok, int x, int lane) {
    pb_s1(a, te, aw, tok, lane); a.h2 = *(const unsigned*)(hb + (size_t)tok * 1024 + 128 * x + pb_col(lane)); }
template <int MODE> __device__ __forceinline__ void peer_b_run(const unsigned char* __restrict__ v8x, const int* __restrict__ te, const float* __restrict__ aw, const bf16* __restrict__ hb, float* out, int wrank, int wstep, int x, int lane) {
    const int N = wrank < T ? (T - wrank + wstep - 1) / wstep : 0;
#define PB_TOK(n) (wrank + (n) * wstep)
#define PB_STOK(n) ((MODE & 4) ? wrank : PB_TOK(n))
    if (N == 0) return;
    PeerB1 s0, s1, s2; PeerB2 bA, bB; PeerBAcc A;
    pb_s1h(s0, te, aw, hb, PB_STOK(0), x, lane); if (N > 1) pb_s1h(s1, te, aw, hb, PB_STOK(1), x, lane);
    pb_s2<0, MODE>(bA, s0, v8x, lane);
#define PB_TOKEN(n, Scur, Snext, Snew) do { \
        if ((n) + 2 < N) pb_s1h(Snew, te, aw, hb, PB_STOK((n) + 2), x, lane); \
        pb_s2<1, MODE>(bB, Scur, v8x, lane); A.h0 = bflo(Scur.h2); A.h1 = bfhi(Scur.h2); pb_quant(A, Scur); \
        pb_s3<0, MODE>(A, bA, Scur, out, PB_TOK(n), x, lane); \
        if ((n) + 1 < N) pb_s2<0, MODE>(bA, Snext, v8x, lane); \
        pb_s3<1, MODE>(A, bB, Scur, out, PB_TOK(n), x, lane); } while (0)
    for (int n = 0; n < N; n += 3) {
        PB_TOKEN(n, s0, s1, s2);
        if (n + 1 < N) PB_TOKEN(n + 1, s1, s2, s0);
        if (n + 2 < N) PB_TOKEN(n + 2, s2, s0, s1);
    }
#undef PB_TOKEN
#undef PB_STOK
#undef PB_TOK
}

__global__ void __launch_bounds__(NWAVES * 64, 2) mk_fwd(Args args) {
    extern __shared__ __attribute__((aligned(16))) unsigned char lds[];
    Frame F;
    F.lds = (LAS unsigned char*)lds;
    F.MISC = (volatile LAS unsigned*)(F.lds + MISC_OFF);
    F.tid = threadIdx.x; F.lane = F.tid & 63; F.wave = __builtin_amdgcn_readfirstlane(F.tid >> 6);
    F.G = gridDim.x; { const int bx = blockIdx.x; F.vcu = (F.G % 8 == 0) ? (bx % 8) * (F.G / 8) + bx / 8 : bx; }
    F.out = nullptr; F.ws = args.ws;
    unsigned char* ws = args.ws;
    F.ctl = (gu32*)(ws + WS_CTL);
    for (int u = F.tid; u < (LDS_BYTES - LDSCTL_OFF) / 4; u += NWAVES * 64) ((LAS unsigned*)(F.lds + LDSCTL_OFF))[u] = 0u;
    __syncthreads();
    XcdBarrier bar; bar.bar = (unsigned*)(F.ctl + CW_BAR); bar.x = 0; bar.st = nullptr;
    if (N_LAUNCHES != PER_PHASE) bar = xcd_barrier_post((unsigned*)(F.ctl + CW_BAR), F.MISC + 8);
    if (N_LAUNCHES != PER_PHASE) { if (F.tid == 0) { const unsigned xid = xb_xcc_id(); F.MISC[12] = xid; F.MISC[13] = xb_add((unsigned*)(F.ctl + CW_TICKET) + 64 * xid, 1u); } __syncthreads(); }
#define GRID_BAR() do { if (N_LAUNCHES != PER_PHASE) xcd_barrier(bar); } while (0)
    const int lo = args.ph_lo, hi = args.ph_hi;
#define IN(k) (lo <= (k) && (k) < hi)
#define BOTH(k) (IN(k) && IN((k) + 1))
    const int gw = F.vcu * NWAVES + F.wave, NGW = F.G * NWAVES;
    bf16* const WinT = (bf16*)(ws + WS_WIN); bf16* const WvT = (bf16*)(ws + WS_WV); bf16* const WkvT = (bf16*)(ws + WS_WKV); bf16* const WbrT = (bf16*)(ws + WS_WBR);
    bf16* const WoutT = (bf16*)(ws + WS_WOUT); bf16* const WqT = (bf16*)(ws + WS_WQ); bf16* const KEYS = (bf16*)(ws + WS_KEYS); bf16* const PWT = (bf16*)(ws + WS_PWT);
    bf16* const MEMN = (bf16*)(ws + WS_MEMN); bf16* const KMEM = (bf16*)(ws + WS_KMEM); bf16* const VTMEM = (bf16*)(ws + WS_VTMEM); float* const RSTDX = (float*)(ws + WS_RSTDX);
    const unsigned char* const U8 = ws + WS_U8; const unsigned char* const V8 = ws + WS_V8; const float* const SU = (const float*)(ws + WS_SU); const float* const SV = (const float*)(ws + WS_SV);
    bf16* const QN = (bf16*)(ws + WS_QN); bf16* const KN = (bf16*)(ws + WS_KN); bf16* const VT = (bf16*)(ws + WS_VT); bf16* const PP = (bf16*)(ws + WS_PP); bf16* const XQ = (bf16*)(ws + WS_XQ);
    bf16* const GATE = (bf16*)(ws + WS_GATE); bf16* const MERGED = (bf16*)(ws + WS_MERGED); bf16* const HB = (bf16*)(ws + WS_HB); bf16* const QB = (bf16*)(ws + WS_QB);
    int* const TE = (int*)(ws + WS_TE); float* const TW = (float*)(ws + WS_TW); float* const AW = (float*)(ws + WS_AW); float* const ROWSQ = (float*)(ws + WS_ROWSQ);
#define RELOAD_OUT(p) do { asm volatile("s_load_dwordx2 %0, %1, 0xb8\n\ts_waitcnt lgkmcnt(0)" : "=s"(p) : "s"(__builtin_amdgcn_kernarg_segment_ptr()) : "memory"); } while (0)
#define XB ((bf16*)(outp + OUT_XB))
#define YNA ((bf16*)(outp + OUT_YNA))
#define YPOOL ((bf16*)(outp + OUT_YPOOL))
#define YXA ((bf16*)(outp + OUT_YXA))

#ifndef STAGGER_SLEEPS
#define STAGGER_SLEEPS 1
#endif
#define STAGGER() do { const int q_ = __builtin_amdgcn_readfirstlane((int)((blockIdx.x >> 3) & 3u) * STAGGER_SLEEPS); for (int i_ = 0; i_ < q_; ++i_) __builtin_amdgcn_s_sleep(127); } while (0)
    if (IN(0)) { unsigned char* outp; RELOAD_OUT(outp); F.out = (float*)outp; p0_prologue(F, args); F.out = nullptr; if (BOTH(0)) GRID_BAR(); }
    if (IN(1)) STAGGER();

    if (IN(1)) {
      { unsigned char* outp; RELOAD_OUT(outp);
        { pg8::Sched1 S; S.so.init(T, IN_MAIN, F.G, (int)blockIdx.x); S.A = (const char*)XB; S.Bt = (const char*)WinT; S.tstep = (size_t)256 * 1024 * 2;
          pg8::EpiProj E{RSTDX, QN, KN, PP, XQ, GATE, args.in[I_NAQG], args.in[I_NAKG], args.in[I_GATEB], (args.probe & 1)};
          pg8::gemm_phase<pg8::EpiProj, pg8::Sched1, true, true>(F.lds + RING_OFF, 1024, S, E); }
        if (!(args.probe & 4)) { pg8::Sched1 S; S.so.init(512, T, F.G, (int)blockIdx.x); S.A = (const char*)WvT; S.Bt = (const char*)XB; S.tstep = (size_t)256 * 1024 * 2;
          pg8::EpiVt E{RSTDX, VT};
          pg8::gemm_phase<pg8::EpiVt, pg8::Sched1, false, true>(F.lds + RING_OFF, 1024, S, E); }
        if (!(args.probe & 2)) {
            __syncthreads();
            for (int j = F.vcu; j < 256; j += F.G) memkv_tile(MEMN, WkvT, args.in[I_XAKG], args.in[I_XAQG], KMEM, VTMEM, (LAS float*)(F.lds + RING_OFF) + (F.wave >> 2) * 6144, 2 * j + (F.wave >> 2), F.wave & 3, F.lane);
            __syncthreads(); }
      }
        if (BOTH(1)) GRID_BAR();
    }

    if (IN(2)) {
      { unsigned char* outp; RELOAD_OUT(outp);
        LAS float* rpl = (LAS float*)(F.lds + RING_OFF + F.wave * 16384);
        for (int i = F.lane; i < 15 * 31; i += 64) rpl[i] = args.in[I_RPB][F.wave * 15 * 31 + i];
        LDS_WAIT(); asm volatile("" ::: "memory");
        for (int i = F.vcu; i < 256; i += F.G)
            for (int k = 0; k < 8; ++k) { const int idx = i * 8 + k, b = idx >> 9, r = (idx >> 2) & 127, jb = idx & 3; na_item(QN, KN, VT, rpl, YNA, b, r, jb, F.wave, F.lane); }
        for (int i = F.vcu; i < 256; i += F.G) pool_wg(PP, PWT, YPOOL, F.lds + RING_OFF, i * 128, F.wave, F.lane);
        { const int pair = F.vcu & 15, xb = pair >> 2, xh = pair & 3, slot = F.vcu >> 4, nslot = F.G >> 4;
          __syncthreads(); xa_fill_lds(KMEM, VTMEM, F.lds + RING_OFF, xb, xh, F.tid); __syncthreads();
          if (slot < nslot) for (int n = slot * NWAVES + F.wave; n < 512; n += nslot * NWAVES) xa_item(XQ, F.lds + RING_OFF, YXA, (xb * 512 + n) * 16, xh, F.lane);
          __syncthreads(); }
      }
        if (BOTH(2)) GRID_BAR();
    }

    if (IN(3)) {
      { unsigned char* outp; RELOAD_OUT(outp);
        pg8::Sched1 S; S.so.init(T, D, F.G, (int)blockIdx.x); S.A = (const char*)YNA; S.Bt = (const char*)WbrT; S.tstep = (size_t)256 * 1536 * 2;
        pg8::EpiMergeCat E{GATE, MERGED};
        pg8::gemm_phase<pg8::EpiMergeCat, pg8::Sched1, true, true>(F.lds + RING_OFF, 1536, S, E);
      }
        if (BOTH(3)) GRID_BAR();
    }

    if (IN(4)) {
      {
        pg8::Sched1 S; S.so.init(T, D, F.G, (int)blockIdx.x); S.A = (const char*)MERGED; S.Bt = (const char*)WoutT; S.tstep = (size_t)256 * 1024 * 2;
        pg8::EpiH E{args.in[I_X], nullptr, HB, ROWSQ, args.probe};
        pg8::gemm_phase<pg8::EpiH, pg8::Sched1, true, true>(F.lds + RING_OFF, 1024, S, E);
      }
        if (BOTH(4)) GRID_BAR();
    }

    if (IN(5)) {
      {
        pg8::Sched1 S; S.so.init(T, 2048, F.G, (int)blockIdx.x); S.A = (const char*)HB; S.Bt = (const char*)WqT; S.tstep = (size_t)256 * 1024 * 2;
        pg8::EpiQ E{ROWSQ, QB};
        pg8::gemm_phase<pg8::EpiQ, pg8::Sched1, true, true>(F.lds + RING_OFF, 1024, S, E);
      }
        if (BOTH(5)) GRID_BAR();
    }

    if (IN(6)) {
        LAS int* lscr = (LAS int*)(F.lds + RING_OFF + 65536 + F.wave * 8192);
        for (int tok = 4 * gw; tok < T; tok += 4 * NGW) {
            HqIn hin[4];
#pragma unroll
            for (int r = 0; r < 4; ++r) hq_load(hin[r], HB, ROWSQ, tok + r, F.lane);
#pragma unroll
            for (int r = 0; r < 4; ++r) hq_token(hin[r], ws + WS_HQ, (float*)(ws + WS_HS), tok + r, F.lane); }
        { const int th = F.vcu & 7, slot = F.vcu >> 3, nslot = F.G >> 3;
          __syncthreads(); topk_fill_lds(KEYS, F.lds + RING_OFF, th, F.tid); __syncthreads();
          { { const int n0 = slot * NWAVES + F.wave, ns = nslot * NWAVES; TopkQ qA, qB;
              if (n0 < 2048) topk_loadq(qA, QB, n0 * 16, th, F.lane);
              for (int n = n0; n < 2048; n += 2 * ns) {
                  if (n + ns < 2048) topk_loadq(qB, QB, (n + ns) * 16, th, F.lane);
                  topk_item(qA, F.lds + RING_OFF, TE, TW, lscr, n * 16, th, F.lane);
                  if (n + ns < 2048) { if (n + 2 * ns < 2048) topk_loadq(qA, QB, (n + 2 * ns) * 16, th, F.lane);
                      topk_item(qB, F.lds + RING_OFF, TE, TW, lscr, (n + ns) * 16, th, F.lane); } } } }
          __syncthreads(); }
        if (BOTH(6)) GRID_BAR();
    }

    if (IN(7)) {
        int x0 = 0, nxs = 8, wrank = (int)blockIdx.x * NWAVES + F.wave, wstep = F.G * NWAVES;
        if (N_LAUNCHES != PER_PHASE) { const unsigned xid = F.MISC[12], rk = F.MISC[13]; unsigned nx = 0, below = 0, mine = 0;
            for (unsigned j = 0; j < 16; ++j) { const unsigned c = xb_ld((unsigned*)(F.ctl + CW_BAR) + XB_XCNT(j)); nx += c > 0u; below += (c > 0u && j < xid); mine = (j == xid) ? c : mine; }
            if (nx == 8 && mine > 0 && rk < mine) { x0 = (int)below; nxs = 1; wrank = (int)rk * NWAVES + F.wave; wstep = (int)mine * NWAVES; } }
        else if ((F.G & 7) == 0) { x0 = (int)blockIdx.x & 7; nxs = 1; wrank = ((int)blockIdx.x >> 3) * NWAVES + F.wave; wstep = (F.G >> 3) * NWAVES; }
        for (int xs = 0; xs < nxs; ++xs) peer_a_run(ws + WS_HQ, (const float*)(ws + WS_HS), U8, SU, SV, TE, TW, args.probe ? (float*)QB : AW, (LAS int*)(F.lds + RING_OFF + F.wave * 16384), wrank, wstep, x0 + xs, F.lane, args.probe == 2);
        if (N_LAUNCHES != PER_PHASE) xcd_barrier(bar);
    }
    if (IN(8)) {
        int x0 = 0, nxs = 8, wrank = (int)blockIdx.x * NWAVES + F.wave, wstep = F.G * NWAVES;
        if (N_LAUNCHES != PER_PHASE) { const unsigned xid = F.MISC[12], rk = F.MISC[13]; unsigned nx = 0, below = 0, mine = 0;
            for (unsigned j = 0; j < 16; ++j) { const unsigned c = xb_ld((unsigned*)(F.ctl + CW_BAR) + XB_XCNT(j)); nx += c > 0u; below += (c > 0u && j < xid); mine = (j == xid) ? c : mine; }
            if (nx == 8 && mine > 0 && rk < mine) { x0 = (int)below; nxs = 1; wrank = (int)rk * NWAVES + F.wave; wstep = (int)mine * NWAVES; } }
        else if ((F.G & 7) == 0) { x0 = (int)blockIdx.x & 7; nxs = 1; wrank = ((int)blockIdx.x >> 3) * NWAVES + F.wave; wstep = (F.G >> 3) * NWAVES; }
        for (int xs = 0; xs < nxs; ++xs) {
#ifdef PROBE_BITS
            if (args.probe) peer_b_run<PROBE_BITS>(V8 + (size_t)(x0 + xs) * (2 * MiB), TE, AW, HB, (float*)QB, wrank, wstep, x0 + xs, F.lane); else
#endif
            { unsigned char* outp; RELOAD_OUT(outp); peer_b_run<0>(V8 + (size_t)(x0 + xs) * (2 * MiB), TE, AW, HB, (float*)outp, wrank, wstep, x0 + xs, F.lane); } }
    }
#undef XB
#undef YNA
#undef YPOOL
#undef YXA
#undef RELOAD_OUT
#undef IN
#undef BOTH
#undef GRID_BAR
}

extern "C" void kernel_launch(void* const* d_in, const int* in_sizes, int n_in, void* d_out, int out_size, void* d_ws, size_t ws_size, hipStream_t stream) {
    static int grid = 0;
    if (grid == 0) {
        if (n_in != 23 || in_sizes[0] != T * D || out_size != T * D || ws_size < WS_END) { fprintf(stderr, "kernel_launch: unexpected shapes: n_in %d in0 %d out %d ws %zu\n", n_in, n_in > 0 ? in_sizes[0] : -1, out_size, ws_size); grid = -1; return; }
        int dev = 0, cus = 0, per_cu = 0;
        if (hipGetDevice(&dev) != hipSuccess || hipDeviceGetAttribute(&cus, hipDeviceAttributeMultiprocessorCount, dev) != hipSuccess) { fprintf(stderr, "kernel_launch: device query failed\n"); grid = -1; return; }
        if (hipFuncSetAttribute((const void*)mk_fwd, hipFuncAttributeMaxDynamicSharedMemorySize, LDS_BYTES) != hipSuccess) { fprintf(stderr, "kernel_launch: hipFuncSetAttribute failed\n"); grid = -1; return; }
        if (hipOccupancyMaxActiveBlocksPerMultiprocessor(&per_cu, (const void*)mk_fwd, NWAVES * 64, LDS_BYTES) != hipSuccess || per_cu < 1)
            fprintf(stderr, "kernel_launch: note: occupancy query reports %d workgroups per CU\n", per_cu);
        (void)hipGetLastError();
        grid = cus;
    }
    if (grid < 0) return;
    if (hipMemsetAsync((char*)d_ws + WS_CTL, 0, CTL_ZERO_BYTES, stream) != hipSuccess) { fprintf(stderr, "kernel_launch: memset failed\n"); return; }
    Args a{};
    for (int i = 0; i < 23; ++i) a.in[i] = (const float*)d_in[i];
    a.out = (float*)d_out; a.ws = (unsigned char*)d_ws;
    for (int li = 0; li < N_LAUNCHES; ++li) {
        a.ph_lo = (N_LAUNCHES == PER_PHASE) ? li : 0; a.ph_hi = (N_LAUNCHES == PER_PHASE) ? li + 1 : PER_PHASE;
        hipLaunchKernelGGL(mk_fwd, dim3(grid), dim3(NWAVES * 64), LDS_BYTES, stream, a);
#ifdef HOST_DUP_PHASE
        if (N_LAUNCHES == PER_PHASE && li == HOST_DUP_PHASE) {
#ifndef PROBE_MODE
            if (li == 4) (void)hipMemsetAsync((char*)d_ws + WS_ROWSQ, 0, (size_t)T * 4, stream);
#endif
#ifdef PROBE_MODE
            a.probe = PROBE_MODE;
#endif
            hipLaunchKernelGGL(mk_fwd, dim3(grid), dim3(NWAVES * 64), LDS_BYTES, stream, a); a.probe = 0; }
#endif
        const hipError_t le = hipPeekAtLastError();
        if (le != hipSuccess) { fprintf(stderr, "kernel_launch: launch %d failed: %s\n", li, hipGetErrorName(le)); break; }
    }
}
```

```cpp
#include <hip/hip_runtime.h>
#include <cstdio>
#include <cstdint>

#ifndef MK_N_LAUNCHES
#define MK_N_LAUNCHES 1
#endif

namespace pg8 {
#define PG8_LAS __attribute__((address_space(3)))
typedef unsigned short bf16_t;
typedef short bf16x8 __attribute__((ext_vector_type(8)));
typedef float f32x4 __attribute__((ext_vector_type(4)));
typedef unsigned u32x4 __attribute__((ext_vector_type(4)));
typedef unsigned u32x2 __attribute__((ext_vector_type(2)));
constexpr int BM = 256, BK = 64, HALF = 128, HTB = HALF * BK * 2  , STAGE_BYTES = 8 * HTB, NXCD = 8, WGM = 8;

__host__ __device__ __forceinline__ int lds_byte(int r, int c) { const int st = (r >> 4) * 2 + (c >> 5), rr = r & 15, cc = c & 31, ob = rr * 64 + cc * 2; return st * 1024 + (ob ^ (((ob >> 9) & 1) << 5)); }
__host__ __device__ __forceinline__ void stage_rc(int b, int& R, int& C) { const int st = b / 1024, sb = b % 1024, swz = sb ^ (((sb >> 9) & 1) << 5); R = (st >> 1) * 16 + swz / 64; C = (st & 1) * 32 + (swz % 64) / 2; }
__host__ __device__ __forceinline__ int perm32(int rho) { const int n = rho >> 4, i = rho & 15; return 8 * (i >> 2) + 4 * n + (i & 3); }

struct Unit { int pm, pn, br; };

struct StaticOrder {
    int nM, nN, nwg, G, c;
    __host__ __device__ void init(int M, int N, int G_, int c_) { nM = M / BM; nN = N / BM; nwg = nM * nN; G = G_; c = c_; }
    __host__ __device__ bool next(int i, Unit& u) const {
        const long L = (long)i * G + c; if (L >= nwg) return false;
        int wgid = (int)L; { const int q = nwg / NXCD, r = nwg % NXCD, xcd = wgid % NXCD, off = wgid / NXCD; wgid = (xcd < r ? xcd * (q + 1) : r * (q + 1) + (xcd - r) * q) + off; }
        const int nig = WGM * nN, gid = wgid / nig, fm = gid * WGM, gsz = (nM - fm) < WGM ? (nM - fm) : WGM;
        u.pm = fm + ((wgid % nig) % gsz); u.pn = (wgid % nig) / gsz; return true;
    }
};
struct Sched1 {
    StaticOrder so; const char* A; const char* Bt; size_t tstep;
    __device__ __forceinline__ bool next(int i, Unit& u) const { u.br = 0; return so.next(i, u); }
    __device__ __forceinline__ const char* abase(const Unit& u) const { return A + (size_t)u.pm * tstep; }
    __device__ __forceinline__ const char* bbase(const Unit& u) const { return Bt + (size_t)u.pn * tstep; }
    __device__ __forceinline__ void a_ready(const Unit&) const {}
    __device__ __forceinline__ void done(const Unit&) const {}
};
struct Sched3 {
    StaticOrder so; const char* A; const char* Bt; size_t tstep, strideA, strideB;
    __device__ __forceinline__ bool next(int i, Unit& u) const { u.br = i % 3; return so.next(i / 3, u); }
    __device__ __forceinline__ const char* abase(const Unit& u) const { return A + (size_t)u.br * strideA + (size_t)u.pm * tstep; }
    __device__ __forceinline__ const char* bbase(const Unit& u) const { return Bt + (size_t)u.br * strideB + (size_t)u.pn * tstep; }
    __device__ __forceinline__ void a_ready(const Unit&) const {}
    __device__ __forceinline__ void done(const Unit&) const {}
};

typedef float f32x2_t __attribute__((ext_vector_type(2))); typedef __bf16 bf16x2v_t __attribute__((ext_vector_type(2)));
__device__ __forceinline__ unsigned cvt_pk_bf16(float lo, float hi) { const f32x2_t v = {lo, hi}; const bf16x2v_t b = __builtin_convertvector(v, bf16x2v_t); return __builtin_bit_cast(unsigned, b); }
__device__ __forceinline__ u32x4 pack8(const f32x4 a, const f32x4 b) { u32x4 w; w.x = cvt_pk_bf16(a[0], a[1]); w.y = cvt_pk_bf16(a[2], a[3]); w.z = cvt_pk_bf16(b[0], b[1]); w.w = cvt_pk_bf16(b[2], b[3]); return w; }
__device__ __forceinline__ float bflo(unsigned u) { return __builtin_bit_cast(float, u << 16); }
__device__ __forceinline__ float bfhi(unsigned u) { return __builtin_bit_cast(float, u & 0xffff0000u); }


constexpr float RMS_EPS = 1e-6f;

struct EpiProj {
    static constexpr bool PERM = true, AFTER_DRAIN = false, HAS_MID = false;
    const float* rstd; bf16_t *qn, *kn, *pp, *xq, *gates; const float *qg, *kg, *gate_b; int skip;
    __device__ __forceinline__ void operator()(const f32x4 (&acc)[2][2][4][2], const Unit& u, int wr, int wc, int fr, int fq) const {
        if (skip) { if (acc[0][0][0][0][0] == 1234.5f) qn[0] = 1; return; }
        const int pn = u.pn, row0 = u.pm * BM + wr * 64 + fr, lc0 = 64 * wc + 8 * fq;
        float rsv[2][4];
#pragma unroll
        for (int ai = 0; ai < 2; ++ai)
#pragma unroll
            for (int m = 0; m < 4; ++m) rsv[ai][m] = rstd[row0 + ai * HALF + m * 16];
        if (pn < 4) {
            const bool isq = pn < 2; bf16_t* O = isq ? qn : kn; const float* g = isq ? qg : kg; const float post = isq ? 0.125f : 1.0f;
            f32x4 gv[2][2];
#pragma unroll
            for (int bj = 0; bj < 2; ++bj)
#pragma unroll
                for (int n = 0; n < 2; ++n) gv[bj][n] = *(const f32x4*)(g + 32 * bj + 8 * fq + 4 * n);
            const int colbase = (pn & 1) * 256 + lc0;
#pragma unroll
            for (int ai = 0; ai < 2; ++ai)
#pragma unroll
                for (int m = 0; m < 4; ++m) {
                    const int row = row0 + ai * HALF + m * 16; const float rs = rsv[ai][m];
                    f32x4 v[2][2]; float ss = 0.f;
#pragma unroll
                    for (int bj = 0; bj < 2; ++bj)
#pragma unroll
                        for (int n = 0; n < 2; ++n) { v[bj][n] = acc[ai][bj][m][n] * rs; ss += (v[bj][n][0] * v[bj][n][0] + v[bj][n][1] * v[bj][n][1]) + (v[bj][n][2] * v[bj][n][2] + v[bj][n][3] * v[bj][n][3]); }
                    ss += __shfl_xor(ss, 16); ss += __shfl_xor(ss, 32);
                    const float r = rsqrtf(ss * (1.0f / 64.0f) + RMS_EPS) * post;
#pragma unroll
                    for (int bj = 0; bj < 2; ++bj) *(u32x4*)(O + (size_t)row * 512 + colbase + 32 * bj) = pack8(v[bj][0] * r * gv[bj][0], v[bj][1] * r * gv[bj][1]);
                }
        } else if (pn < 8) {
            bf16_t* O = pn < 6 ? pp : xq; const int colbase = (pn & 1) * 256 + lc0;
#pragma unroll
            for (int ai = 0; ai < 2; ++ai)
#pragma unroll
                for (int m = 0; m < 4; ++m) {
                    const int row = row0 + ai * HALF + m * 16; const float rs = rsv[ai][m];
#pragma unroll
                    for (int bj = 0; bj < 2; ++bj) *(u32x4*)(O + (size_t)row * 512 + colbase + 32 * bj) = pack8(acc[ai][bj][m][0] * rs, acc[ai][bj][m][1] * rs);
                }
        } else {
            const int gcol0 = (pn - 8) * 256 + lc0;
            f32x4 bv[2][2];
#pragma unroll
            for (int bj = 0; bj < 2; ++bj)
#pragma unroll
                for (int n = 0; n < 2; ++n) bv[bj][n] = *(const f32x4*)(gate_b + gcol0 + 32 * bj + 4 * n) * (-1.4426950408889634f);
#pragma unroll
            for (int ai = 0; ai < 2; ++ai)
#pragma unroll
                for (int m = 0; m < 4; ++m) {
                    const int row = row0 + ai * HALF + m * 16; const float rs = rsv[ai][m] * (-1.4426950408889634f);
#pragma unroll
                    for (int bj = 0; bj < 2; ++bj) {
                        f32x4 o[2];
#pragma unroll
                        for (int n = 0; n < 2; ++n) { const f32x4 z = acc[ai][bj][m][n] * rs + bv[bj][n];
#pragma unroll
                            for (int i = 0; i < 4; ++i) o[n][i] = __builtin_amdgcn_rcpf(1.0f + __builtin_amdgcn_exp2f(z[i])); }
                        *(u32x4*)(gates + (size_t)row * 3072 + gcol0 + 32 * bj) = pack8(o[0], o[1]);
                    }
                }
        }
    }
};
struct EpiVt {
    static constexpr bool PERM = true, AFTER_DRAIN = false, HAS_MID = false;
    const float* rstd; bf16_t* Vt;
    __device__ __forceinline__ void operator()(const f32x4 (&acc)[2][2][4][2], const Unit& u, int wr, int wc, int fr, int fq) const {
        const int ch0 = u.pm * BM + wr * 64 + fr, tok0 = u.pn * BM + wc * 32 + 8 * fq, b = tok0 >> 13, t0 = tok0 & 8191;
        f32x4 rv[2][2];
#pragma unroll
        for (int bj = 0; bj < 2; ++bj)
#pragma unroll
            for (int n = 0; n < 2; ++n) rv[bj][n] = *(const f32x4*)(rstd + tok0 + bj * HALF + 4 * n);
#pragma unroll
        for (int ai = 0; ai < 2; ++ai)
#pragma unroll
            for (int m = 0; m < 4; ++m) { const int ch = ch0 + ai * HALF + m * 16; bf16_t* rowp = Vt + ((size_t)(b * 512 + ch) * 8192 + t0);
#pragma unroll
                for (int bj = 0; bj < 2; ++bj) *(u32x4*)(rowp + bj * HALF) = pack8(acc[ai][bj][m][0] * rv[bj][0], acc[ai][bj][m][1] * rv[bj][1]); }
    }
};
struct EpiMergeCat {
    static constexpr bool PERM = true, AFTER_DRAIN = false, HAS_MID = true;
    const bf16_t* gates; bf16_t* merged;
    __device__ __forceinline__ void mid(f32x4 (&acc)[2][2][4][2], const Unit& u, int nb  , int wr, int wc, int fr, int fq) const {
        const int row0 = u.pm * BM + wr * 64 + fr, col0 = u.pn * BM + wc * 32 + 8 * fq;
#pragma unroll
        for (int ai = 0; ai < 2; ++ai) {
            u32x4 ga[4][2], gb[4][2];
#pragma unroll
            for (int m = 0; m < 4; ++m)
#pragma unroll
                for (int bj = 0; bj < 2; ++bj) { const bf16_t* gp = gates + (size_t)(row0 + ai * HALF + m * 16) * 3072 + (nb - 1) * 1024 + col0 + bj * HALF;
                    ga[m][bj] = *(const u32x4*)gp; gb[m][bj] = *(const u32x4*)(gp + 1024); }
            __builtin_amdgcn_sched_barrier(0);
#pragma unroll
            for (int m = 0; m < 4; ++m)
#pragma unroll
                for (int bj = 0; bj < 2; ++bj) { const u32x4 a = ga[m][bj], b = gb[m][bj]; f32x4& x0 = acc[ai][bj][m][0]; f32x4& x1 = acc[ai][bj][m][1];
                    x0[0] *= bflo(a.x) * __builtin_amdgcn_rcpf(bflo(b.x)); x0[1] *= bfhi(a.x) * __builtin_amdgcn_rcpf(bfhi(b.x)); x0[2] *= bflo(a.y) * __builtin_amdgcn_rcpf(bflo(b.y)); x0[3] *= bfhi(a.y) * __builtin_amdgcn_rcpf(bfhi(b.y));
                    x1[0] *= bflo(a.z) * __builtin_amdgcn_rcpf(bflo(b.z)); x1[1] *= bfhi(a.z) * __builtin_amdgcn_rcpf(bfhi(b.z)); x1[2] *= bflo(a.w) * __builtin_amdgcn_rcpf(bflo(b.w)); x1[3] *= bfhi(a.w) * __builtin_amdgcn_rcpf(bfhi(b.w)); }
            __builtin_amdgcn_sched_barrier(0);
        }
    }
    __device__ __forceinline__ void operator()(const f32x4 (&acc)[2][2][4][2], const Unit& u, int wr, int wc, int fr, int fq) const {
        const int row0 = u.pm * BM + wr * 64 + fr, col0 = u.pn * BM + wc * 32 + 8 * fq;
#pragma unroll
        for (int ai = 0; ai < 2; ++ai) {
            u32x4 g8[4][2];
#pragma unroll
            for (int m = 0; m < 4; ++m)
#pragma unroll
                for (int bj = 0; bj < 2; ++bj) g8[m][bj] = *(const u32x4*)(gates + (size_t)(row0 + ai * HALF + m * 16) * 3072 + 2048 + col0 + bj * HALF);
            __builtin_amdgcn_sched_barrier(0);
#pragma unroll
            for (int m = 0; m < 4; ++m)
#pragma unroll
                for (int bj = 0; bj < 2; ++bj) { const u32x4 g = g8[m][bj]; f32x4 a = acc[ai][bj][m][0], b = acc[ai][bj][m][1];
                    a[0] *= bflo(g.x); a[1] *= bfhi(g.x); a[2] *= bflo(g.y); a[3] *= bfhi(g.y); b[0] *= bflo(g.z); b[1] *= bfhi(g.z); b[2] *= bflo(g.w); b[3] *= bfhi(g.w);
                    *(u32x4*)(merged + (size_t)(row0 + ai * HALF + m * 16) * 1024 + col0 + bj * HALF) = pack8(a, b); }
            __builtin_amdgcn_sched_barrier(0);
        }
    }
};
struct EpiH {
    static constexpr bool PERM = true, AFTER_DRAIN = false, HAS_MID = false;
    const float* x; float* out; bf16_t* hb; float* rowsq; int noatomic;
    __device__ __forceinline__ void operator()(const f32x4 (&acc)[2][2][4][2], const Unit& u, int wr, int wc, int fr, int fq) const {
        const int row0 = u.pm * BM + wr * 64 + fr, col0 = u.pn * BM + wc * 32 + 8 * fq;
#pragma unroll
        for (int ai = 0; ai < 2; ++ai) {
            f32x4 xv[4][2][2];
#pragma unroll
            for (int m = 0; m < 4; ++m)
#pragma unroll
                for (int bj = 0; bj < 2; ++bj) { const size_t o = (size_t)(row0 + ai * HALF + m * 16) * 1024 + col0 + bj * HALF; xv[m][bj][0] = *(const f32x4*)(x + o); xv[m][bj][1] = *(const f32x4*)(x + o + 4); }
            __builtin_amdgcn_sched_barrier(0);
#pragma unroll
            for (int m = 0; m < 4; ++m) { const int row = row0 + ai * HALF + m * 16; float ss = 0.f;
#pragma unroll
                for (int bj = 0; bj < 2; ++bj) { const size_t o = (size_t)row * 1024 + col0 + bj * HALF;
                    const f32x4 h0 = xv[m][bj][0] + acc[ai][bj][m][0], h1 = xv[m][bj][1] + acc[ai][bj][m][1];
                    *(u32x4*)(hb + o) = pack8(h0, h1);
                    ss += (h0[0] * h0[0] + h0[1] * h0[1]) + (h0[2] * h0[2] + h0[3] * h0[3]) + (h1[0] * h1[0] + h1[1] * h1[1]) + (h1[2] * h1[2] + h1[3] * h1[3]); }
                ss += __shfl_xor(ss, 16); ss += __shfl_xor(ss, 32);
                if (fq == 0 && !noatomic) atomicAdd(rowsq + row, ss); }
            __builtin_amdgcn_sched_barrier(0);
        }
    }
};
struct EpiQ {
    static constexpr bool PERM = true, AFTER_DRAIN = false, HAS_MID = false;
    const float* rowsq; bf16_t* qb;
    __device__ __forceinline__ void operator()(const f32x4 (&acc)[2][2][4][2], const Unit& u, int wr, int wc, int fr, int fq) const {
        const int row0 = u.pm * BM + wr * 64 + fr, col0 = u.pn * BM + wc * 32 + 8 * fq;
        float rq[2][4];
#pragma unroll
        for (int ai = 0; ai < 2; ++ai)
#pragma unroll
            for (int m = 0; m < 4; ++m) rq[ai][m] = rowsq[row0 + ai * HALF + m * 16];
#pragma unroll
        for (int ai = 0; ai < 2; ++ai)
#pragma unroll
            for (int m = 0; m < 4; ++m) { const int row = row0 + ai * HALF + m * 16; const float r = rsqrtf(rq[ai][m] * (1.0f / 1024.0f) + RMS_EPS);
#pragma unroll
                for (int bj = 0; bj < 2; ++bj) *(u32x4*)(qb + (size_t)row * 2048 + col0 + bj * HALF) = pack8(acc[ai][bj][m][0] * r, acc[ai][bj][m][1] * r); }
    }
};

template <class Epi, class Sched, bool ALIGN_EPI = false, bool SP2 = false>
__device__ __forceinline__ void gemm_phase(PG8_LAS unsigned char* lds, const int K, const Sched& S, const Epi& E) {
    const int tid = threadIdx.x, wid = __builtin_amdgcn_readfirstlane(tid >> 6), lane = tid & 63, wr = wid >> 2, wc = wid & 3, fr = lane & 15, fq = lane >> 4;
    const int nt = K / BK;
    unsigned voffA[2], voffB[2];
#pragma unroll
    for (int i = 0; i < 2; ++i) { int R, C; stage_rc(tid * 16 + i * 8192, R, C); const int Rb = Epi::PERM ? ((R & ~31) + perm32(R & 31)) : R;
        voffA[i] = (unsigned)(R * K + C) * 2u; voffB[i] = (unsigned)(Rb * K + C) * 2u; }
    const size_t kstep = (size_t)(BK * 2);
    const size_t hstep = (size_t)HALF * K * 2;
    const size_t tstep = 2 * hstep;
    const unsigned ldsw = (unsigned)wid * 1024u;
    const int aoff = lds_byte(wr * 64 + fr, fq * 8), boff = lds_byte(wc * 32 + fr, fq * 8);
#define PG8_SA(b, h) (((b) * 2 + (h)) * HTB)
#define PG8_SB(b, h) ((4 + (b) * 2 + (h)) * HTB)
#define PG8_STAGE(bufoff, gbase, voff) do { _Pragma("unroll") for (int _i = 0; _i < 2; ++_i) \
        __builtin_amdgcn_global_load_lds((const unsigned*)((const char*)(gbase) + (voff)[_i]), (PG8_LAS unsigned*)(lds + (bufoff) + ldsw + _i * 8192), 16, 0, 0); } while (0)
#define PG8_LDA(dst, b, h) do { _Pragma("unroll") for (int m = 0; m < 4; ++m) _Pragma("unroll") for (int k = 0; k < 2; ++k) dst[m][k] = *(const PG8_LAS bf16x8*)(lds + PG8_SA(b, h) + aoff + m * 2048 + k * 1024); } while (0)
#define PG8_LDB(dst, b, h) do { _Pragma("unroll") for (int n = 0; n < 2; ++n) _Pragma("unroll") for (int k = 0; k < 2; ++k) dst[n][k] = *(const PG8_LAS bf16x8*)(lds + PG8_SB(b, h) + boff + n * 2048 + k * 1024); } while (0)
#define PG8_MMA(ai, bj, At, Bt) do { __builtin_amdgcn_s_setprio(1); _Pragma("unroll") for (int m = 0; m < 4; ++m) _Pragma("unroll") for (int n = 0; n < 2; ++n) _Pragma("unroll") for (int k = 0; k < 2; ++k) \
        acc[ai][bj][m][n] = __builtin_amdgcn_mfma_f32_16x16x32_bf16(Bt[n][k], At[m][k], acc[ai][bj][m][n], 0, 0, 0); __builtin_amdgcn_s_setprio(0); } while (0)
#define PG8_WAIT_V(n) asm volatile("s_waitcnt vmcnt(" #n ")" ::: "memory")
#define PG8_WAIT_L(n) asm volatile("s_waitcnt lgkmcnt(" #n ")" ::: "memory")
#define PG8_BAR __builtin_amdgcn_s_barrier()
#define PG8_SCHED __builtin_amdgcn_sched_barrier(0)
    Unit cur, nxt; int ui = 0;
    if (!S.next(0, cur)) return;
    f32x4 acc[2][2][4][2];
#pragma unroll
    for (int a = 0; a < 2; ++a)
#pragma unroll
        for (int b = 0; b < 2; ++b)
#pragma unroll
            for (int m = 0; m < 4; ++m)
#pragma unroll
                for (int n = 0; n < 2; ++n) acc[a][b][m][n] = (f32x4){0.f, 0.f, 0.f, 0.f};
    bf16x8 At[4][2], B0[2][2], B1[2][2];
    const char* cA = S.abase(cur); const char* cB = S.bbase(cur);
    S.a_ready(cur);
    if constexpr (SP2) {
        PG8_STAGE(PG8_SB(0, 0), cB, voffB); PG8_STAGE(PG8_SB(0, 1), cB + hstep, voffB); PG8_STAGE(PG8_SA(0, 0), cA, voffA); PG8_STAGE(PG8_SA(0, 1), cA + hstep, voffA);
        if (wr == 1) PG8_BAR;
        PG8_WAIT_V(2); PG8_BAR;
        PG8_STAGE(PG8_SB(1, 0), cB + kstep, voffB); PG8_STAGE(PG8_SA(1, 0), cA + kstep, voffA); PG8_STAGE(PG8_SB(1, 1), cB + hstep + kstep, voffB);
        PG8_WAIT_V(6); PG8_BAR;
    } else {
        PG8_STAGE(PG8_SB(0, 0), cB, voffB); PG8_STAGE(PG8_SA(0, 0), cA, voffA); PG8_STAGE(PG8_SB(0, 1), cB + hstep, voffB); PG8_STAGE(PG8_SA(0, 1), cA + hstep, voffA);
        if (wr == 1) PG8_BAR;
        PG8_WAIT_V(4); PG8_BAR;
        PG8_STAGE(PG8_SB(1, 0), cB + kstep, voffB); PG8_STAGE(PG8_SA(1, 0), cA + kstep, voffA); PG8_STAGE(PG8_SB(1, 1), cB + hstep + kstep, voffB);
        PG8_WAIT_V(6); PG8_BAR;
    }
    for (;;) {
        const bool has_next = S.next(ui + 1, nxt);
        const char* nA = has_next ? S.abase(nxt) : cA; const char* nB = has_next ? S.bbase(nxt) : cB;
        for (int t = 0; t < nt; t += 2) {
            if constexpr (Epi::HAS_MID) { if (t == 8 || t == 16) E.mid(acc, cur, t >> 3, wr, wc, fr, fq); }
            const bool last = (t == nt - 2);
            const char* a1 = cA + (size_t)(t + 1) * kstep;
            const char* a2 = last ? nA : cA + (size_t)(t + 2) * kstep; const char* b2 = last ? nB : cB + (size_t)(t + 2) * kstep;
            const char* a3 = a2 + kstep; const char* b3 = b2 + kstep;
            if (last && has_next) S.a_ready(nxt);
            if constexpr (SP2) {
            PG8_LDB(B0, 0, 0); PG8_LDB(B1, 0, 1); PG8_SCHED; PG8_LDA(At, 0, 0); PG8_STAGE(PG8_SA(1, 1), a1 + hstep, voffA);
            PG8_WAIT_V(8); PG8_WAIT_L(0); PG8_BAR; PG8_MMA(0, 0, At, B0); PG8_MMA(0, 1, At, B1); PG8_BAR; PG8_SCHED;
            PG8_LDA(At, 0, 1); PG8_STAGE(PG8_SB(0, 0), b2, voffB); PG8_STAGE(PG8_SB(0, 1), b2 + hstep, voffB); PG8_STAGE(PG8_SA(0, 0), a2, voffA);
            PG8_WAIT_V(8); PG8_WAIT_L(0); PG8_BAR; PG8_MMA(1, 0, At, B0); PG8_MMA(1, 1, At, B1); PG8_BAR; PG8_SCHED;
            PG8_LDB(B0, 1, 0); PG8_LDB(B1, 1, 1); PG8_SCHED; PG8_LDA(At, 1, 0); PG8_STAGE(PG8_SA(0, 1), a2 + hstep, voffA);
            PG8_WAIT_V(8); PG8_WAIT_L(0); PG8_BAR; PG8_MMA(0, 0, At, B0); PG8_MMA(0, 1, At, B1); PG8_BAR; PG8_SCHED;
            PG8_LDA(At, 1, 1); PG8_STAGE(PG8_SB(1, 0), b3, voffB); PG8_STAGE(PG8_SB(1, 1), b3 + hstep, voffB); PG8_STAGE(PG8_SA(1, 0), a3, voffA);
            PG8_WAIT_V(8); PG8_WAIT_L(0); PG8_BAR; PG8_MMA(1, 0, At, B0); PG8_MMA(1, 1, At, B1); PG8_BAR; PG8_SCHED;
            } else {
            PG8_LDB(B0, 0, 0); PG8_SCHED; PG8_LDA(At, 0, 0); PG8_STAGE(PG8_SA(1, 1), a1 + hstep, voffA);
            PG8_WAIT_L(8); PG8_BAR; PG8_WAIT_L(0); PG8_MMA(0, 0, At, B0); PG8_BAR; PG8_SCHED;
            PG8_LDB(B1, 0, 1); PG8_STAGE(PG8_SB(0, 0), b2, voffB);
            PG8_BAR; PG8_WAIT_L(0); PG8_MMA(0, 1, At, B1); PG8_BAR;
            PG8_LDA(At, 0, 1); PG8_STAGE(PG8_SA(0, 0), a2, voffA);
            PG8_BAR; PG8_WAIT_L(0); PG8_MMA(1, 0, At, B0); PG8_BAR; PG8_SCHED;
            PG8_STAGE(PG8_SB(0, 1), b2 + hstep, voffB);
            PG8_WAIT_V(6); PG8_BAR; PG8_MMA(1, 1, At, B1); PG8_BAR;
            PG8_LDB(B0, 1, 0); PG8_SCHED; PG8_LDA(At, 1, 0); PG8_STAGE(PG8_SA(0, 1), a2 + hstep, voffA);
            PG8_WAIT_L(8); PG8_BAR; PG8_WAIT_L(0); PG8_MMA(0, 0, At, B0); PG8_BAR; PG8_SCHED;
            PG8_LDB(B1, 1, 1); PG8_STAGE(PG8_SB(1, 0), b3, voffB);
            PG8_BAR; PG8_WAIT_L(0); PG8_MMA(0, 1, At, B1); PG8_BAR;
            PG8_LDA(At, 1, 1); PG8_STAGE(PG8_SA(1, 0), a3, voffA);
            PG8_BAR; PG8_WAIT_L(0); PG8_MMA(1, 0, At, B0); PG8_BAR; PG8_SCHED;
            PG8_STAGE(PG8_SB(1, 1), b3 + hstep, voffB);
            PG8_WAIT_V(6); PG8_BAR; PG8_MMA(1, 1, At, B1); PG8_BAR;
            }
        }
        if constexpr (ALIGN_EPI) { if (wr == 0) PG8_BAR; }
        if constexpr (!Epi::AFTER_DRAIN) { E(acc, cur, wr, wc, fr, fq); S.done(cur); }
        if (!has_next) break;
#pragma unroll
        for (int a = 0; a < 2; ++a)
#pragma unroll
            for (int b = 0; b < 2; ++b)
#pragma unroll
                for (int m = 0; m < 4; ++m)
#pragma unroll
                    for (int n = 0; n < 2; ++n) acc[a][b][m][n] = (f32x4){0.f, 0.f, 0.f, 0.f};
        cur = nxt; cA = nA; cB = nB; ++ui;
        if constexpr (ALIGN_EPI) { if (wr == 1) PG8_BAR; }
    }
    PG8_WAIT_V(0);
    if constexpr (!ALIGN_EPI) { if (wr == 0) PG8_BAR; }
    PG8_BAR;
    if constexpr (Epi::AFTER_DRAIN) { E.fused(acc, cur, wr, wc, fr, fq, lds, wid, lane); S.done(cur); }
#undef PG8_SA
#undef PG8_SB
#undef PG8_STAGE
#undef PG8_LDA
#undef PG8_LDB
#undef PG8_MMA
#undef PG8_WAIT_V
#undef PG8_WAIT_L
#undef PG8_BAR
#undef PG8_SCHED
}
}

constexpr int NWAVES = 8;
constexpr int N_LAUNCHES = MK_N_LAUNCHES;
constexpr int PER_PHASE = 9;
constexpr int NBATCH = 4, SEQ = 8192, D = 1024, T = NBATCH * SEQ, MEMLEN = 256, NMEMTOK = NBATCH * MEMLEN;
constexpr int IN_MAIN = 5120;
constexpr int NEXP = 16384;

constexpr size_t MiB = 1u << 20;
constexpr size_t WS_CTL = 0, CTL_ZERO_BYTES = 512 * 1024;
constexpr size_t WS_ROWSQ = 256 * 1024;
constexpr size_t WS_WIN = 1 * MiB, WS_WV = 11 * MiB, WS_WKV = 12 * MiB, WS_WBR = 14 * MiB, WS_WOUT = 17 * MiB, WS_WQ = 19 * MiB, WS_KEYS = 23 * MiB, WS_PWT = 23 * MiB + 512 * 1024;
constexpr size_t WS_MEMN = 24 * MiB, WS_KMEM = 26 * MiB, WS_VTMEM = 27 * MiB, WS_RSTDX = 28 * MiB, WS_SU = 28 * MiB + 256 * 1024  , WS_SV = 28 * MiB + 512 * 1024  ;
constexpr size_t WS_U8 = 32 * MiB, WS_V8 = 48 * MiB;
constexpr size_t WS_QN = 96 * MiB, WS_KN = 128 * MiB, WS_VT = 160 * MiB, WS_PP = 192 * MiB, WS_XQ = 224 * MiB, WS_GATE = 256 * MiB, WS_END = 448 * MiB;
constexpr size_t WS_MERGED = WS_QN;
constexpr size_t WS_HB = WS_VT;
constexpr size_t WS_QB = WS_GATE;
constexpr size_t WS_TE = WS_GATE + 128 * MiB, WS_TW = WS_TE + 16 * MiB;
constexpr size_t WS_HQ = WS_TW + 16 * MiB;
constexpr size_t WS_HS = 28 * MiB + 768 * 1024;
constexpr size_t WS_AW = WS_MERGED;
constexpr size_t OUT_XB = 0, OUT_YNA = 0, OUT_YPOOL = 512 * 2, OUT_YXA = 1024 * 2;
constexpr int CW_TMO = 0, CW_BAR = 4096, CW_TICKET = 8192;

constexpr int RING_OFF = 0, RING_BYTES = 131072;
constexpr int LDSCTL_OFF = RING_BYTES, MISC_OFF = LDSCTL_OFF + 320;
constexpr int LDS_BYTES = 147456;

#define GAS __attribute__((address_space(1)))
#define LAS __attribute__((address_space(3)))
typedef unsigned short bf16;
typedef unsigned v4u __attribute__((ext_vector_type(4)));
typedef unsigned v2u __attribute__((ext_vector_type(2)));
typedef float f32x4 __attribute__((ext_vector_type(4)));
typedef short bf16x8 __attribute__((ext_vector_type(8)));
typedef __bf16 bf16x2_t __attribute__((ext_vector_type(2)));
typedef GAS unsigned gu32;
#define LDS_WAIT() asm volatile("s_waitcnt lgkmcnt(0)" ::: "memory")
#define VM_WAIT() asm volatile("s_waitcnt vmcnt(0)" ::: "memory")
__device__ __forceinline__ unsigned f2bf(float f) { unsigned u = __builtin_bit_cast(unsigned, f); return (u + 0x7fffu + ((u >> 16) & 1u)) >> 16; }
__device__ __forceinline__ unsigned pk2(float lo, float hi) { return f2bf(lo) | (f2bf(hi) << 16); }
__device__ __forceinline__ float bflo(unsigned u) { return __builtin_bit_cast(float, u << 16); }
__device__ __forceinline__ float bfhi(unsigned u) { return __builtin_bit_cast(float, u & 0xffff0000u); }
__device__ __forceinline__ float bf1(short s) { return __builtin_bit_cast(float, ((unsigned)(unsigned short)s) << 16); }
__device__ __forceinline__ f32x4 mfma16(bf16x8 a, bf16x8 b, f32x4 c) { return __builtin_amdgcn_mfma_f32_16x16x32_bf16(a, b, c, 0, 0, 0); }
__device__ __forceinline__ float wave_sum(float v) {
#pragma unroll
    for (int o = 1; o < 64; o <<= 1) v += __shfl_xor(v, o);
    return v;
}

#define XB_TMO      128
#define XB_XCNT(j)  (256  + 64 * (j))
#define XB_XSUB(j)  (1280 + 64 * (j))
#define XB_XGEN(j)  (2304 + 64 * (j))
#define XB_TOP      3328
#define XB_TOPGEN   3392
#define XCD_BAR_WORDS 3456
#define XB_SPIN_CAP (1u << 18)

__device__ __forceinline__ unsigned xb_ld(unsigned* p)              { return __hip_atomic_load(p, __ATOMIC_RELAXED, __HIP_MEMORY_SCOPE_AGENT); }
__device__ __forceinline__ unsigned xb_add(unsigned* p, unsigned v) { return __hip_atomic_fetch_add(p, v, __ATOMIC_RELAXED, __HIP_MEMORY_SCOPE_AGENT); }
__device__ __forceinline__ unsigned xb_xcc_id() { return (unsigned)__builtin_amdgcn_s_getreg((3 << 11) | 20) & 0xFu; }
#define XB_SPIN(cond, bar) do { unsigned _sp = 0; while (cond) { __builtin_amdgcn_s_sleep(1); \
    if ((++_sp & 255u) == 0u) { if (xb_ld(&(bar)[XB_TMO])) break; if (_sp > XB_SPIN_CAP) { atomicAdd(&(bar)[XB_TMO], 1u); break; } } } } while (0)

struct XcdBarrier {
    unsigned* bar; unsigned x;
    volatile LAS unsigned* st;
};

__device__ __forceinline__ XcdBarrier xcd_barrier_post(unsigned* bar, volatile LAS unsigned* st) {
    XcdBarrier b; b.bar = bar; b.x = xb_xcc_id(); b.st = st;
    if (threadIdx.x == 0) (void)xb_add(&bar[XB_XCNT(b.x)], 1u);
    return b;
}
__device__ __forceinline__ void xcd_barrier_complete(unsigned* bar, unsigned x, unsigned& nloc, unsigned& nx) {
    const unsigned G = gridDim.x * gridDim.y * gridDim.z;
    unsigned sum, cnt, mine, sp = 0u;
    for (;;) {
        sum = 0u; cnt = 0u; mine = 0u;
#pragma unroll
        for (unsigned j = 0; j < 16; ++j) { const unsigned c = xb_ld(&bar[XB_XCNT(j)]); sum += c; cnt += (c > 0u) ? 1u : 0u; mine = (j == x) ? c : mine; }
        if (sum == G) break;
        __builtin_amdgcn_s_sleep(1);
        if ((++sp & 255u) == 0u) { if (xb_ld(&bar[XB_TMO])) break; if (sp > XB_SPIN_CAP) { atomicAdd(&bar[XB_TMO], 1u); break; } }
    }
    nloc = mine > 0u ? mine : 1u; nx = cnt > 0u ? cnt : 1u;
}

__device__ __forceinline__ void xcd_barrier(const XcdBarrier& b) {
    asm volatile("s_waitcnt vmcnt(0)" ::: "memory");
    __syncthreads();
    if (threadIdx.x == 0) {
        unsigned* bar = b.bar;
        __builtin_amdgcn_s_waitcnt(0);
        unsigned nloc = b.st[0], nx = b.st[1];
        if (nloc == 0u) { xcd_barrier_complete(bar, b.x, nloc, nx); b.st[0] = nloc; b.st[1] = nx; }
        const unsigned old = xb_add(&bar[XB_XSUB(b.x)], 1u);
        const unsigned gen = old / nloc;
        if (old + 1u == (gen + 1u) * nloc) {
            __builtin_amdgcn_fence(__ATOMIC_RELEASE, "agent");
            asm volatile("s_waitcnt vmcnt(0)" ::: "memory");
            const unsigned og = xb_add(&bar[XB_TOP], 1u);
            const unsigned tg = og / nx;
            if (og + 1u == (tg + 1u) * nx) xb_add(&bar[XB_TOPGEN], 1u);
            else XB_SPIN(xb_ld(&bar[XB_TOPGEN]) == tg, bar);
            __builtin_amdgcn_fence(__ATOMIC_ACQUIRE, "agent");
            xb_add(&bar[XB_XGEN(b.x)], 1u);
            asm volatile("s_waitcnt vmcnt(0)" ::: "memory");
        } else {
            XB_SPIN(xb_ld(&bar[XB_XGEN(b.x)]) == gen, bar);
            __builtin_amdgcn_fence(__ATOMIC_ACQUIRE, "agent");
            asm volatile("s_waitcnt vmcnt(0)" ::: "memory");
        }
    }
    __syncthreads();
}

struct Frame {
    LAS unsigned char* lds;
    volatile LAS unsigned* MISC;
    gu32* ctl;
    int tid, lane, wave, vcu, G;
    float* out; unsigned char* ws;
};
struct Args { const float* in[23]; float* out; unsigned char* ws; int ph_lo, ph_hi, probe, pad; };
enum { I_X = 0, I_MEM, I_MIXG, I_MEMG, I_WIN, I_GATEB, I_WKV, I_NAQG, I_NAKG, I_RPB, I_POOLW, I_POOLSC, I_XAQG, I_XAKG, I_WB0, I_WB1, I_WB2, I_WOUT, I_FFNG, I_WQ, I_KEYS, I_PU, I_PV };

__device__ __forceinline__ void p0_transpose_item(const float* W, int K, int N, int k0, int n0, bf16* dst, const float* kscale, LAS float* scr, int lane, int dpitch = 0) {
    if (dpitch == 0) dpitch = K;
#pragma unroll 8
    for (int i = 0; i < 32; ++i) { const int kk = 2 * i + (lane >> 5); float v = W[(size_t)(k0 + kk) * N + n0 + (lane & 31)]; if (kscale) v *= kscale[k0 + kk]; scr[kk * 33 + (lane & 31)] = v; }
    LDS_WAIT(); asm volatile("" ::: "memory");
    const int c = lane & 7;
#pragma unroll
    for (int j = 0; j < 4; ++j) { const int n = (lane >> 3) + 8 * j; const LAS float* s = scr + (8 * c) * 33 + n;
        v4u o; o.x = pk2(s[0 * 33], s[1 * 33]); o.y = pk2(s[2 * 33], s[3 * 33]); o.z = pk2(s[4 * 33], s[5 * 33]); o.w = pk2(s[6 * 33], s[7 * 33]);
        *(GAS v4u*)(dst + (size_t)n * dpitch + k0 + 8 * c) = o; }
    LDS_WAIT(); asm volatile("" ::: "memory");
}
__device__ __forceinline__ void cvt_row1024(const float* src, bf16* dst, const float* colscale, float rowscale, int lane) {
    const GAS f32x4* xr = (const GAS f32x4*)src + lane; GAS unsigned long long* o8 = (GAS unsigned long long*)dst + lane;
#pragma unroll
    for (int j = 0; j < 4; ++j) { f32x4 v = xr[64 * j] * rowscale; if (colscale) v = v * ((const GAS f32x4*)colscale)[lane + 64 * j];
        o8[64 * j] = (unsigned long long)pk2(v.x, v.y) | ((unsigned long long)pk2(v.z, v.w) << 32); }
}
__device__ __forceinline__ float row_rstd1024(const float* src, int lane) {
    const GAS f32x4* xr = (const GAS f32x4*)src + lane; float s = 0.f;
#pragma unroll
    for (int j = 0; j < 4; ++j) { const f32x4 v = xr[64 * j]; s += (v.x * v.x + v.y * v.y) + (v.z * v.z + v.w * v.w); }
    return rsqrtf(wave_sum(s) * (1.0f / 1024.0f) + 1e-6f);
}
__device__ __forceinline__ void p0_prologue(Frame& F, const Args& A) {
    LAS float* scr = (LAS float*)(F.lds + RING_OFF + F.wave * 16384);
    const int gw = F.vcu * NWAVES + F.wave, NGW = F.G * NWAVES, lane = F.lane;
    unsigned char* ws = F.ws;
    constexpr int I_IN = 16 * 176, I_KV = 16 * 32, I_BR = 8 * 32, I_OUT = 16 * 32, I_Q = 16 * 64;
    constexpr int NITEMS = I_IN + I_KV + 3 * I_BR + I_OUT + I_Q;
    for (int it = gw; it < NITEMS; it += NGW) {
        int r = it;
        if (r < I_IN) { const int kb = r / 176, nb = r % 176, n0 = 32 * nb; bf16* dst;
            if (n0 >= 1024 && n0 < 1536) dst = (bf16*)(ws + WS_WV) + (size_t)(n0 - 1024) * 1024;
            else { const int np = n0 < 1024 ? n0 : n0 - 512, t = np >> 8, w = np & 255, wc = w >> 6, bj = (w >> 5) & 1; dst = (bf16*)(ws + WS_WIN) + (size_t)(256 * t + 128 * bj + 32 * wc) * 1024; }
            p0_transpose_item(A.in[I_WIN], 1024, 5632, 64 * kb, n0, dst, A.in[I_MIXG], scr, lane); continue; }
        r -= I_IN;
        if (r < I_KV) { const int kb = r / 32, nb = r % 32; p0_transpose_item(A.in[I_WKV], 1024, 1024, 64 * kb, 32 * nb, (bf16*)(ws + WS_WKV) + (size_t)(32 * nb) * 1024, nullptr, scr, lane); continue; }
        r -= I_KV;
        if (r < 3 * I_BR) { const int br = r / I_BR, rr = r % I_BR, kb = rr / 32, nb = rr % 32; const float* W = br == 0 ? A.in[I_WB0] : (br == 1 ? A.in[I_WB1] : A.in[I_WB2]);
            p0_transpose_item(W, 512, 1024, 64 * kb, 32 * nb, (bf16*)(ws + WS_WBR) + (size_t)(32 * nb) * 1536 + br * 512, nullptr, scr, lane, 1536); continue; }
        r -= 3 * I_BR;
        if (r < I_OUT) { const int kb = r / 32, nb = r % 32; p0_transpose_item(A.in[I_WOUT], 1024, 1024, 64 * kb, 32 * nb, (bf16*)(ws + WS_WOUT) + (size_t)(32 * nb) * 1024, nullptr, scr, lane); continue; }
        r -= I_OUT;
        { const int kb = r / 64, nb = r % 64; p0_transpose_item(A.in[I_WQ], 1024, 2048, 64 * kb, 32 * nb, (bf16*)(ws + WS_WQ) + (size_t)(32 * nb) * 1024, A.in[I_FFNG], scr, lane); }
    }
    { bf16* xb = (bf16*)((unsigned char*)F.out + OUT_XB); float* rstdx = (float*)(ws + WS_RSTDX);
      for (int m0 = 4 * gw; m0 < T; m0 += 4 * NGW) {
          f32x4 v[4][4];
#pragma unroll
          for (int r = 0; r < 4; ++r)
#pragma unroll
              for (int j = 0; j < 4; ++j) v[r][j] = ((const GAS f32x4*)(A.in[I_X] + (size_t)(m0 + r) * D))[lane + 64 * j];
#pragma unroll
          for (int r = 0; r < 4; ++r) { float s = 0.f;
#pragma unroll
              for (int j = 0; j < 4; ++j) s += (v[r][j].x * v[r][j].x + v[r][j].y * v[r][j].y) + (v[r][j].z * v[r][j].z + v[r][j].w * v[r][j].w);
              const float rs = rsqrtf(wave_sum(s) * (1.0f / 1024.0f) + 1e-6f);
              GAS unsigned long long* o8 = (GAS unsigned long long*)(xb + (size_t)(m0 + r) * D) + lane;
#pragma unroll
              for (int j = 0; j < 4; ++j) o8[64 * j] = (unsigned long long)pk2(v[r][j].x, v[r][j].y) | ((unsigned long long)pk2(v[r][j].z, v[r][j].w) << 32);
              if (lane == 0) rstdx[m0 + r] = rs; } } }
    for (int m = gw; m < NMEMTOK; m += NGW) { const float* xr = A.in[I_MEM] + (size_t)m * D; const float rs = row_rstd1024(xr, lane); cvt_row1024(xr, (bf16*)(ws + WS_MEMN) + (size_t)m * D, A.in[I_MEMG], rs, lane); }
    for (int mb = 4 * gw; mb < 2 * NEXP; mb += 4 * NGW) {
        const bool isu = mb < NEXP; const int e0 = isu ? mb : mb - NEXP;
        f32x4 v[4][4];
#pragma unroll
        for (int r = 0; r < 4; ++r) { const GAS f32x4* src = (const GAS f32x4*)((isu ? A.in[I_PU] : A.in[I_PV]) + (size_t)(e0 + r) * D) + 4 * lane;
#pragma unroll
            for (int d = 0; d < 4; ++d) v[r][d] = src[d]; }
        f32x4 gv[4];
#pragma unroll
        for (int d = 0; d < 4; ++d) gv[d] = isu ? ((const GAS f32x4*)A.in[I_FFNG])[4 * lane + d] : (f32x4){1.f, 1.f, 1.f, 1.f};
#pragma unroll
        for (int r = 0; r < 4; ++r) { const int e = e0 + r; float mx = 0.f;
#pragma unroll
            for (int d = 0; d < 4; ++d) { v[r][d] = v[r][d] * gv[d]; mx = fmaxf(mx, fmaxf(fmaxf(fabsf(v[r][d].x), fabsf(v[r][d].y)), fmaxf(fabsf(v[r][d].z), fabsf(v[r][d].w)))); }
#pragma unroll
            for (int o = 1; o < 64; o <<= 1) mx = fmaxf(mx, __shfl_xor(mx, o));
            const float inv = mx > 0.f ? 127.0f / mx : 0.f;
            v4u w;
#pragma unroll
            for (int d = 0; d < 4; ++d) { const unsigned b0 = (unsigned)(int)rintf(v[r][d].x * inv) & 0xffu, b1 = (unsigned)(int)rintf(v[r][d].y * inv) & 0xffu,
                                                         b2 = (unsigned)(int)rintf(v[r][d].z * inv) & 0xffu, b3 = (unsigned)(int)rintf(v[r][d].w * inv) & 0xffu;
                w[d] = b0 | (b1 << 8) | (b2 << 16) | (b3 << 24); }
            if (isu) ((GAS v4u*)(ws + WS_U8))[(size_t)e * 64 + lane] = w;
            else *(GAS v4u*)(ws + WS_V8 + (size_t)(lane >> 3) * (2 * MiB) + (size_t)e * 128 + (lane & 7) * 16) = w;
            if (lane == 0) ((float*)(ws + WS_SU))[2 * e + (isu ? 0 : 1)] = mx * (1.0f / 127.0f); }
    }
    for (int m = gw * 64 + lane; m < T; m += NGW * 64) ((float*)(ws + WS_ROWSQ))[m] = 0.f;
    for (int m = gw; m < 256; m += NGW) cvt_row1024(A.in[I_KEYS] + (size_t)m * 1024, (bf16*)(ws + WS_KEYS) + (size_t)m * 1024, nullptr, 1.0f, lane);
    for (int m = gw; m < 1024; m += NGW) { const int gd = m >> 1, c = (m & 1) * 64 + lane, g = gd >> 7, d = gd & 127;
        const float v = A.in[I_POOLW][(size_t)(g * 128 + c) * 128 + d] * A.in[I_POOLSC][gd];
        ((bf16*)(ws + WS_PWT))[(size_t)gd * 128 + c] = (bf16)f2bf(v); }
}

__device__ __forceinline__ void memkv_tile(const bf16* memn, const bf16* wkvT, const float* kg, const float* qg, bf16* kmem, bf16* vtmem, LAS float* part, int tile, int kc, int lane) {
    const int q = lane & 15, hi = lane >> 4, rg = (tile < 0 ? 0 : tile) >> 3, cg = (tile < 0 ? 0 : tile) & 7, r0 = rg * 16, c0 = cg * 128;
    f32x4 acc[8];
#pragma unroll
    for (int i = 0; i < 8; ++i) acc[i] = (f32x4){0.f, 0.f, 0.f, 0.f};
    const bf16* ap = memn + (size_t)(r0 + q) * 1024 + 8 * hi; const bf16* bp = wkvT + (size_t)(c0 + q) * 1024 + 8 * hi;
    if (tile >= 0)
#pragma unroll 1
    for (int kb = 2 * kc; kb < 2 * kc + 2; ++kb) {
        bf16x8 a[4], b[4][8];
#pragma unroll
        for (int k4 = 0; k4 < 4; ++k4) { a[k4] = *(const bf16x8*)(ap + 32 * (4 * kb + k4));
#pragma unroll
            for (int nf = 0; nf < 8; ++nf) b[k4][nf] = *(const bf16x8*)(bp + (size_t)(16 * nf) * 1024 + 32 * (4 * kb + k4)); }
        __builtin_amdgcn_sched_barrier(0);
#pragma unroll
        for (int k4 = 0; k4 < 4; ++k4)
#pragma unroll
            for (int nf = 0; nf < 8; ++nf) acc[nf] = mfma16(a[k4], b[k4][nf], acc[nf]);
        __builtin_amdgcn_sched_barrier(0);
    }
    if (tile >= 0 && kc > 0) {
#pragma unroll
        for (int nf = 0; nf < 8; ++nf) *(LAS f32x4*)(part + ((kc - 1) * 8 + nf) * 256 + 4 * lane) = acc[nf]; }
    __syncthreads();
    if (tile < 0 || kc > 0) return;
#pragma unroll
    for (int p = 0; p < 3; ++p)
#pragma unroll
        for (int nf = 0; nf < 8; ++nf) acc[nf] = acc[nf] + *(const LAS f32x4*)(part + (p * 8 + nf) * 256 + 4 * lane);
    if (cg < 4) {
        float rr[4];
#pragma unroll
        for (int g = 0; g < 4; ++g) { float ss = 0.f;
#pragma unroll
            for (int nf = 0; nf < 8; ++nf) ss += acc[nf][g] * acc[nf][g];
            ss += __shfl_xor(ss, 1); ss += __shfl_xor(ss, 2); ss += __shfl_xor(ss, 4); ss += __shfl_xor(ss, 8);
            rr[g] = rsqrtf(ss * (1.0f / 128.0f) + 1e-6f); }
#pragma unroll
        for (int nf = 0; nf < 8; ++nf) { const int d = 16 * nf + q; const float gs = kg[d] * qg[d];
#pragma unroll
            for (int g = 0; g < 4; ++g) kmem[(size_t)(r0 + 4 * hi + g) * 512 + cg * 128 + d] = (bf16)f2bf(acc[nf][g] * rr[g] * gs); }
    } else {
        const int h = cg - 4, b = r0 >> 8, key0 = (r0 & 255) + 4 * hi;
#pragma unroll
        for (int nf = 0; nf < 8; ++nf) { const int d = 16 * nf + q; v2u w; w.x = pk2(acc[nf][0], acc[nf][1]); w.y = pk2(acc[nf][2], acc[nf][3]);
            *(v2u*)(vtmem + (size_t)(b * 512 + h * 128 + d) * 256 + key0) = w; }
    }
}

__device__ __forceinline__ void na_item(const bf16* __restrict__ qn, const bf16* __restrict__ kn, const bf16* __restrict__ vt, const LAS float* rpl, bf16* __restrict__ yna,
                                        int b, int r, int jb, int h, int lane) {
    const int q = lane & 15, hi = lane >> 4;
    int rs = r - 4; rs = rs < 0 ? 0 : (rs > 120 ? 120 : rs);
    int kb0 = jb * 16 - 8; kb0 = kb0 < 0 ? 0 : (kb0 > 32 ? 32 : kb0);
    const int qcol = jb * 16 + q; int cs = qcol - 8; cs = cs < 0 ? 0 : (cs > 48 ? 48 : cs);
    const size_t tokq = (size_t)b * SEQ + r * 64 + qcol;
    const bf16* qp = qn + tokq * 512 + h * 64 + 8 * hi;
    const bf16x8 qf0 = *(const bf16x8*)qp, qf1 = *(const bf16x8*)(qp + 32);
    const int kq = 8 * (q >> 2) + (q & 3);
    const bf16* kbase = kn + ((size_t)b * SEQ + rs * 64 + kb0 + kq) * 512 + h * 64 + 8 * hi;
    f32x4 s[16];
    {
        bf16x8 ka[16][2];
#pragma unroll
        for (int f = 0; f < 16; ++f) { const bf16* kp = kbase + (size_t)((f >> 1) * 64 + (f & 1) * 4) * 512; ka[f][0] = *(const bf16x8*)kp; ka[f][1] = *(const bf16x8*)(kp + 32); }
        __builtin_amdgcn_sched_barrier(0);
#pragma unroll
        for (int f = 0; f < 16; ++f) { f32x4 z = (f32x4){0.f, 0.f, 0.f, 0.f}; z = mfma16(ka[f][0], qf0, z); s[f] = mfma16(ka[f][1], qf1, z); }
    }
    const bf16* vbase = vt + ((size_t)(b * 512 + h * 64 + q) * SEQ + rs * 64 + kb0 + 8 * hi);
    bf16x8 va[8][4];
#pragma unroll
    for (int st = 0; st < 8; ++st)
#pragma unroll
        for (int mf = 0; mf < 4; ++mf) va[st][mf] = *(const bf16x8*)(vbase + (size_t)(16 * mf) * SEQ + st * 64);
    __builtin_amdgcn_sched_barrier(0);
    float mx = -3.0e38f;
#pragma unroll
    for (int c4 = 0; c4 < 4; ++c4) {
        float bb[4][4];
#pragma unroll
        for (int ff = 0; ff < 4; ++ff) { const int f = 4 * c4 + ff, dr = rs + (f >> 1) - r + 7;
#pragma unroll
            for (int g = 0; g < 4; ++g) { const int kcol = kb0 + 8 * hi + 4 * (f & 1) + g; int dc = kcol - qcol + 15; dc = dc < 0 ? 0 : (dc > 30 ? 30 : dc); bb[ff][g] = rpl[dr * 31 + dc]; } }
        __builtin_amdgcn_sched_barrier(0);
#pragma unroll
        for (int ff = 0; ff < 4; ++ff) { const int f = 4 * c4 + ff;
#pragma unroll
            for (int g = 0; g < 4; ++g) { const int kcol = kb0 + 8 * hi + 4 * (f & 1) + g; const bool ok = (kcol >= cs) && (kcol < cs + 16);
                const float v = ok ? s[f][g] + bb[ff][g] : -1.0e30f; s[f][g] = v; mx = fmaxf(mx, v); } }
    }
    mx = fmaxf(mx, __shfl_xor(mx, 16)); mx = fmaxf(mx, __shfl_xor(mx, 32));
    float sum = 0.f;
#pragma unroll
    for (int f = 0; f < 16; ++f)
#pragma unroll
        for (int g = 0; g < 4; ++g) { const float p = __expf(s[f][g] - mx); s[f][g] = p; sum += p; }
    sum += __shfl_xor(sum, 16); sum += __shfl_xor(sum, 32);
    const float inv = 1.0f / sum;
    f32x4 o[4];
#pragma unroll
    for (int i = 0; i < 4; ++i) o[i] = (f32x4){0.f, 0.f, 0.f, 0.f};
#pragma unroll
    for (int st = 0; st < 8; ++st) {
        const bf16x8 pb = __builtin_bit_cast(bf16x8, pg8::pack8(s[2 * st], s[2 * st + 1]));
#pragma unroll
        for (int mf = 0; mf < 4; ++mf) o[mf] = mfma16(va[st][mf], pb, o[mf]);
    }
    bf16* yp = yna + tokq * 1536 + h * 64 + 4 * hi;
#pragma unroll
    for (int mf = 0; mf < 4; ++mf) { v2u w; w.x = pk2(o[mf][0] * inv, o[mf][1] * inv); w.y = pk2(o[mf][2] * inv, o[mf][3] * inv); *(v2u*)(yp + 16 * mf) = w; }
}
__device__ __forceinline__ void xa_fill_lds(const bf16* __restrict__ kmem, const bf16* __restrict__ vtmem, LAS unsigned char* lds, int b, int h, int tid) {
#pragma unroll
    for (int ps = 0; ps < 8; ++ps) { const int id = tid + 512 * ps, key = id >> 4, c = id & 15;
        *(LAS v4u*)(lds + key * 256 + ((c ^ (key & 15)) << 4)) = *(const v4u*)(kmem + ((size_t)b * 256 + key) * 512 + h * 128 + 8 * c); }
#pragma unroll
    for (int ps = 0; ps < 8; ++ps) { const int id = tid + 512 * ps, dim = id >> 5, c = id & 31;
        *(LAS v4u*)(lds + 65536 + dim * 512 + ((c ^ (dim & 15)) << 4)) = *(const v4u*)(vtmem + (size_t)(b * 512 + h * 128 + dim) * 256 + 8 * c); }
}
__device__ __forceinline__ void xa_item(const bf16* __restrict__ xq, const LAS unsigned char* lds, bf16* __restrict__ yxa, int tok0, int h, int lane) {
    const int q = lane & 15, hi = lane >> 4; const size_t tok = (size_t)tok0 + q;
    const bf16* qp = xq + tok * 512 + h * 128 + 8 * hi;
    bf16x8 qf[4]; float ssq = 0.f;
#pragma unroll
    for (int ks = 0; ks < 4; ++ks) qf[ks] = *(const bf16x8*)(qp + 32 * ks);
    __builtin_amdgcn_sched_barrier(0);
#pragma unroll
    for (int ks = 0; ks < 4; ++ks)
#pragma unroll
        for (int j = 0; j < 8; ++j) { const float v = bf1(qf[ks][j]); ssq += v * v; }
    ssq += __shfl_xor(ssq, 16); ssq += __shfl_xor(ssq, 32);
    const float cexp = rsqrtf(ssq * (1.0f / 128.0f) + 1e-6f) * 0.08838834764831845f * 1.4426950408889634f;
    const int kq = 8 * (q >> 2) + (q & 3);
    f32x4 s[16];
#define XA_KLOAD(buf, fp) do { _Pragma("unroll") for (int f2 = 0; f2 < 2; ++f2) { const int f_ = 2 * (fp) + f2, key = 32 * (f_ >> 1) + 4 * (f_ & 1) + kq; const LAS unsigned char* kr = lds + key * 256; \
        _Pragma("unroll") for (int ks = 0; ks < 4; ++ks) buf[f2][ks] = *(const LAS bf16x8*)(kr + (((4 * ks + hi) ^ (key & 15)) << 4)); } } while (0)
    {
        bf16x8 kbA[2][4], kbB[2][4];
        XA_KLOAD(kbA, 0);
#pragma unroll
        for (int fp = 0; fp < 8; fp += 2) {
            XA_KLOAD(kbB, fp + 1); __builtin_amdgcn_sched_barrier(0);
#pragma unroll
            for (int f2 = 0; f2 < 2; ++f2) { f32x4 z = (f32x4){0.f, 0.f, 0.f, 0.f};
#pragma unroll
                for (int ks = 0; ks < 4; ++ks) z = mfma16(kbA[f2][ks], qf[ks], z);
                s[2 * fp + f2] = z; }
            __builtin_amdgcn_sched_barrier(0);
            if (fp + 2 < 8) XA_KLOAD(kbA, fp + 2);
            __builtin_amdgcn_sched_barrier(0);
#pragma unroll
            for (int f2 = 0; f2 < 2; ++f2) { f32x4 z = (f32x4){0.f, 0.f, 0.f, 0.f};
#pragma unroll
                for (int ks = 0; ks < 4; ++ks) z = mfma16(kbB[f2][ks], qf[ks], z);
                s[2 * (fp + 1) + f2] = z; }
            __builtin_amdgcn_sched_barrier(0);
        }
    }
#undef XA_KLOAD
    float mx = -3.0e38f;
#pragma unroll
    for (int f = 0; f < 16; ++f)
#pragma unroll
        for (int g = 0; g < 4; ++g) mx = fmaxf(mx, s[f][g]);
    mx = fmaxf(mx, __shfl_xor(mx, 16)); mx = fmaxf(mx, __shfl_xor(mx, 32));
    float sum = 0.f;
#pragma unroll
    for (int f = 0; f < 16; ++f)
#pragma unroll
        for (int g = 0; g < 4; ++g) { const float p = __builtin_amdgcn_exp2f((s[f][g] - mx) * cexp); s[f][g] = p; sum += p; }
    sum += __shfl_xor(sum, 16); sum += __shfl_xor(sum, 32);
    const float inv = 1.0f / sum;
    f32x4 o[8];
#pragma unroll
    for (int i = 0; i < 8; ++i) o[i] = (f32x4){0.f, 0.f, 0.f, 0.f};
#define XA_VLOAD(buf, st_) do { _Pragma("unroll") for (int mf = 0; mf < 8; ++mf) { const int dim = 16 * mf + q; buf[mf] = *(const LAS bf16x8*)(lds + 65536 + dim * 512 + (((4 * (st_) + hi) ^ (dim & 15)) << 4)); } } while (0)
    {
        bf16x8 vbA[8], vbB[8];
        XA_VLOAD(vbA, 0);
#pragma unroll
        for (int st = 0; st < 8; st += 2) {
            XA_VLOAD(vbB, st + 1); __builtin_amdgcn_sched_barrier(0);
            { const bf16x8 pb = __builtin_bit_cast(bf16x8, pg8::pack8(s[2 * st], s[2 * st + 1]));
#pragma unroll
              for (int mf = 0; mf < 8; ++mf) o[mf] = mfma16(vbA[mf], pb, o[mf]); }
            __builtin_amdgcn_sched_barrier(0);
            if (st + 2 < 8) XA_VLOAD(vbA, st + 2);
            __builtin_amdgcn_sched_barrier(0);
            { const bf16x8 pb = __builtin_bit_cast(bf16x8, pg8::pack8(s[2 * st + 2], s[2 * st + 3]));
#pragma unroll
              for (int mf = 0; mf < 8; ++mf) o[mf] = mfma16(vbB[mf], pb, o[mf]); }
            __builtin_amdgcn_sched_barrier(0);
        }
    }
#undef XA_VLOAD
    bf16* yp = yxa + tok * 1536 + h * 128 + 4 * hi;
#pragma unroll
    for (int mf = 0; mf < 8; ++mf) { v2u w; w.x = pk2(o[mf][0] * inv, o[mf][1] * inv); w.y = pk2(o[mf][2] * inv, o[mf][3] * inv); *(v2u*)(yp + 16 * mf) = w; }
}
__device__ __forceinline__ void pool_wg(const bf16* __restrict__ pp, const bf16* __restrict__ pwT, bf16* __restrict__ ypool, LAS unsigned char* lds, int tokbase, int wave, int lane) {
    const int q = lane & 15, hi = lane >> 4;
    __syncthreads();
    {
        const int hw = 1 << hi, tw0 = tokbase + 16 * wave, b = tw0 >> 13, t0 = tw0 & 8191;
        const bf16* base = pp + (size_t)b * SEQ * 512 + 8 * lane;
        float s[8];
#pragma unroll
        for (int j = 0; j < 8; ++j) s[j] = 0.f;
#pragma unroll 4
        for (int d = -8; d < 8; ++d) { const int u = t0 + d; const bool ok = (d >= -hw) && (d < hw) && (u >= 0) && (u < SEQ);
            const bf16x8 v = *(const bf16x8*)(base + (size_t)(ok ? u : t0) * 512);
#pragma unroll
            for (int j = 0; j < 8; ++j) s[j] += ok ? bf1(v[j]) : 0.f; }
        LAS unsigned char* tile = lds + wave * 16384;
#pragma unroll 4
        for (int i = 0; i < 16; ++i) { const int t = t0 + i;
            int lo = t - hw; lo = lo < 0 ? 0 : lo; int ht = t + hw; ht = ht > SEQ ? SEQ : ht;
            const float inv = 1.0f / (float)(ht - lo);
            const bool oka = (t + hw) < SEQ, oks = (t - hw) >= 0;
            const bf16x8 sv = *(const bf16x8*)(base + (size_t)t * 512), av = *(const bf16x8*)(base + (size_t)(oka ? t + hw : t) * 512), bv = *(const bf16x8*)(base + (size_t)(oks ? t - hw : t) * 512);
            f32x4 p0, p1;
#pragma unroll
            for (int j = 0; j < 4; ++j) { p0[j] = s[j] * inv - bf1(sv[j]); p1[j] = s[j + 4] * inv - bf1(sv[j + 4]); }
            *(LAS v4u*)(tile + i * 1024 + ((lane ^ (i & 15)) << 4)) = pg8::pack8(p0, p1);
#pragma unroll
            for (int j = 0; j < 8; ++j) s[j] += (oka ? bf1(av[j]) : 0.f) - (oks ? bf1(bv[j]) : 0.f);
        }
    }
    __syncthreads();
#pragma unroll 1
    for (int k = 0; k < 4; ++k) {
        const int pair = wave * 4 + k, g = pair >> 3, mf = pair & 7;
        const bf16* wb = pwT + (size_t)(g * 128 + 16 * mf + q) * 128 + 8 * hi;
        bf16x8 a[4];
#pragma unroll
        for (int ks = 0; ks < 4; ++ks) a[ks] = *(const bf16x8*)(wb + 32 * ks);
#pragma unroll 2
        for (int tg = 0; tg < 8; ++tg) {
            const LAS unsigned char* trow = lds + tg * 16384 + q * 1024; f32x4 o = (f32x4){0.f, 0.f, 0.f, 0.f};
#pragma unroll
            for (int ks = 0; ks < 4; ++ks) { const int c = g * 16 + 4 * ks + hi; o = mfma16(a[ks], *(const LAS bf16x8*)(trow + ((c ^ q) << 4)), o); }
            v2u w; w.x = pk2(o[0], o[1]); w.y = pk2(o[2], o[3]);
            *(v2u*)(ypool + (size_t)(tokbase + 16 * tg + q) * 1536 + g * 128 + 16 * mf + 4 * hi) = w;
        }
    }
    __syncthreads();
}

__device__ __forceinline__ int f2key(float s, int idx, int mask) { int b = __builtin_bit_cast(int, s); b = b >= 0 ? b : (b ^ 0x7fffffff); return (b & ~mask) | idx; }
__device__ __forceinline__ float key2f(int k) { k = k >= 0 ? k : (k ^ 0x7fffffff); return __builtin_bit_cast(float, k); }
#define CE_DESC(x, y) do { const int _h = (x) > (y) ? (x) : (y), _l = (x) > (y) ? (y) : (x); (x) = _h; (y) = _l; } while (0)
__device__ __forceinline__ void sort16(int (&a)[16]) {
#pragma unroll
    for (int ks = 1; ks <= 4; ++ks)
#pragma unroll
        for (int js = ks - 1; js >= 0; --js)
#pragma unroll
            for (int i = 0; i < 16; ++i) { const int k = 1 << ks, j = 1 << js, l = i ^ j;
                if (l > i) { if ((i & k) == 0) CE_DESC(a[i], a[l]); else CE_DESC(a[l], a[i]); } }
}
__device__ __forceinline__ void merge16(int (&a)[16], const int (&b)[16]) {
#pragma unroll
    for (int i = 0; i < 16; ++i) a[i] = a[i] > b[15 - i] ? a[i] : b[15 - i];
#pragma unroll
    for (int js = 3; js >= 0; --js)
#pragma unroll
        for (int i = 0; i < 16; ++i) { const int j = 1 << js, l = i ^ j; if (l > i) CE_DESC(a[i], a[l]); }
}
__device__ __forceinline__ void merge16_lanes(int (&a)[16], int step) { int o[16];
#pragma unroll
    for (int k = 0; k < 16; ++k) o[k] = __shfl_xor(a[k], step);
    merge16(a, o); }
__device__ constexpr int cand_i(int hi, int m) {
    return hi == 0 ? 0
         : hi == 1 ? (m < 8 ? 1 : (m < 13 ? 2 : -1))
         : hi == 2 ? (m < 4 ? 3 : (m < 7 ? 4 : (m < 9 ? 5 : (m < 11 ? 6 : -1))))
         :           (m < 2 ? 7 : (m < 10 ? 8 + (m - 2) : -1));
}
__device__ constexpr int cand_j(int hi, int m) {
    return hi == 0 ? m
         : hi == 1 ? (m < 8 ? m : (m < 13 ? m - 8 : -1))
         : hi == 2 ? (m < 4 ? m : (m < 7 ? m - 4 : (m < 9 ? m - 7 : (m < 11 ? m - 9 : -1))))
         :           (m < 2 ? m : (m < 10 ? 0 : -1));
}
__device__ __forceinline__ void topk_fill_lds(const bf16* __restrict__ keys, LAS unsigned char* lds, int h, int tid) {
#pragma unroll
    for (int ps = 0; ps < 8; ++ps) { const int id = tid + 512 * ps, row = id >> 4, c = id & 15;
        *(LAS v4u*)(lds + row * 256 + ((c ^ (row & 15)) << 4)) = *(const v4u*)(keys + ((size_t)h * 256 + row) * 128 + 8 * c); }
}
struct TopkQ { bf16x8 q[2][4]; };
__device__ __forceinline__ void topk_loadq(TopkQ& Q, const bf16* __restrict__ qb, int tok0, int h, int lane) {
    const size_t tok = (size_t)tok0 + (lane & 15); const int hi = lane >> 4;
#pragma unroll
    for (int p = 0; p < 2; ++p)
#pragma unroll
        for (int ks = 0; ks < 4; ++ks) Q.q[p][ks] = *(const bf16x8*)(qb + tok * 2048 + h * 256 + p * 128 + 32 * ks + 8 * hi);
}
__device__ __forceinline__ void topk_item(const TopkQ& Q, const LAS unsigned char* klds, int* __restrict__ te, float* __restrict__ tw, LAS int* lscr, int tok0, int h, int lane) {
    const int q = lane & 15, hi = lane >> 4; const size_t tok = (size_t)tok0 + q;
    int L[2][16];
#pragma unroll
    for (int p = 0; p < 2; ++p) {
        int B[16];
#define TK_KLOAD(buf, mp) do { _Pragma("unroll") for (int m2 = 0; m2 < 2; ++m2) { const int row = p * 128 + 16 * (2 * (mp) + m2) + q; \
        _Pragma("unroll") for (int ks = 0; ks < 4; ++ks) buf[m2][ks] = *(const LAS bf16x8*)(klds + row * 256 + (((4 * ks + hi) ^ (row & 15)) << 4)); } } while (0)
#define TK_MMA(buf, mp) do { _Pragma("unroll") for (int m2 = 0; m2 < 2; ++m2) { const int mf = 2 * (mp) + m2; f32x4 s = (f32x4){0.f, 0.f, 0.f, 0.f}; \
        _Pragma("unroll") for (int ks = 0; ks < 4; ++ks) s = mfma16(buf[m2][ks], Q.q[p][ks], s); \
          \
        _Pragma("unroll") for (int g = 0; g < 4; ++g) { const int key = f2key(s[g], 16 * mf + 4 * hi + g, 127); if (mf < 4) L[p][4 * mf + g] = key; else B[4 * (mf - 4) + g] = key; } } } while (0)
        { bf16x8 tkA[2][4], tkB[2][4];
          TK_KLOAD(tkA, 0);
          TK_KLOAD(tkB, 1); __builtin_amdgcn_sched_barrier(0); TK_MMA(tkA, 0); __builtin_amdgcn_sched_barrier(0);
          TK_KLOAD(tkA, 2); __builtin_amdgcn_sched_barrier(0); TK_MMA(tkB, 1); __builtin_amdgcn_sched_barrier(0);
          TK_KLOAD(tkB, 3); __builtin_amdgcn_sched_barrier(0); TK_MMA(tkA, 2); __builtin_amdgcn_sched_barrier(0);
          TK_MMA(tkB, 3); }
#undef TK_KLOAD
#undef TK_MMA
        sort16(L[p]); sort16(B); merge16(L[p], B);
        merge16_lanes(L[p], 16); merge16_lanes(L[p], 32);
    }
    float v1[16], v2[16];
#pragma unroll
    for (int k = 0; k < 16; ++k) { v1[k] = key2f(L[0][k]); v2[k] = key2f(L[1][k]); }
    int Fk[16];
#pragma unroll
    for (int m = 0; m < 16; ++m) {
        float sm = v1[0] + v2[m]; int id = 255 - m;
        if (cand_i(1, m) >= 0) { if (hi == 1) { sm = v1[cand_i(1, m) < 0 ? 0 : cand_i(1, m)] + v2[cand_j(1, m) < 0 ? 0 : cand_j(1, m)]; id = 255 - ((cand_i(1, m) << 4) | cand_j(1, m)); } }
        if (cand_i(2, m) >= 0) { if (hi == 2) { sm = v1[cand_i(2, m) < 0 ? 0 : cand_i(2, m)] + v2[cand_j(2, m) < 0 ? 0 : cand_j(2, m)]; id = 255 - ((cand_i(2, m) << 4) | cand_j(2, m)); } }
        if (cand_i(3, m) >= 0) { if (hi == 3) { sm = v1[cand_i(3, m) < 0 ? 0 : cand_i(3, m)] + v2[cand_j(3, m) < 0 ? 0 : cand_j(3, m)]; id = 255 - ((cand_i(3, m) << 4) | cand_j(3, m)); } }
        int key = f2key(sm, id, 255);
        if ((hi == 1 && cand_i(1, m) < 0) || (hi == 2 && cand_i(2, m) < 0) || (hi == 3 && cand_i(3, m) < 0)) key = (int)0x80000000;
        Fk[m] = key;
    }
    sort16(Fk); merge16_lanes(Fk, 16); merge16_lanes(Fk, 32);
    LAS int* my = lscr + lane * 32;
#pragma unroll
    for (int k = 0; k < 16; ++k) { my[k] = L[0][k] & 127; my[16 + k] = L[1][k] & 127; }
    LDS_WAIT(); asm volatile("" ::: "memory");
    float e[16]; float sum = 0.f; const float mx = key2f(Fk[0]);
#pragma unroll
    for (int k = 0; k < 16; ++k) { e[k] = __expf(key2f(Fk[k]) - mx); sum += e[k]; }
    const float inv = 1.0f / sum;
    if (hi == 0) {
        int* tep = te + tok * 128; float* twp = tw + tok * 128;
#pragma unroll
        for (int kk = 0; kk < 16; ++kk) { const int ij = 255 - (Fk[kk] & 255), i = ij >> 4, j = ij & 15, slot = (kk & 7) * 16 + 2 * h + (kk >> 3);
            tep[slot] = my[i] * 128 + my[16 + j]; twp[slot] = e[kk] * inv; }
    }
    LDS_WAIT(); asm volatile("" ::: "memory");
}

__device__ __forceinline__ float ub2f(unsigned v, int b) { return (float)((v >> (8 * b)) & 0xffu); }
struct HqIn { v4u hA, hB; float rsq; };
__device__ __forceinline__ void hq_load(HqIn& in, const bf16* __restrict__ hb, const float* __restrict__ rowsq, int tok, int lane) {
    const bf16* hp = hb + (size_t)tok * 1024 + 16 * lane; in.hA = *(const v4u*)hp; in.hB = *(const v4u*)(hp + 8); in.rsq = rowsq[tok]; }
__device__ __forceinline__ void hq_token(const HqIn& in, unsigned char* __restrict__ hq, float* __restrict__ hs, int tok, int lane) {
    const v4u hA = in.hA, hB = in.hB;
    float hf[16];
#pragma unroll
    for (int d = 0; d < 4; ++d) { hf[2 * d] = bflo(hA[d]); hf[2 * d + 1] = bfhi(hA[d]); hf[8 + 2 * d] = bflo(hB[d]); hf[8 + 2 * d + 1] = bfhi(hB[d]); }
    float amax = 0.f;
#pragma unroll
    for (int j = 0; j < 16; ++j) amax = fmaxf(amax, fabsf(hf[j]));
#pragma unroll
    for (int o = 1; o < 64; o <<= 1) amax = fmaxf(amax, __shfl_xor(amax, o));
    const float hinv = amax > 0.f ? 127.0f / amax : 0.f;
    v4u w;
#pragma unroll
    for (int d = 0; d < 4; ++d) { const unsigned b0 = (unsigned)(int)rintf(hf[4 * d] * hinv) & 0xffu, b1 = (unsigned)(int)rintf(hf[4 * d + 1] * hinv) & 0xffu,
                                                 b2 = (unsigned)(int)rintf(hf[4 * d + 2] * hinv) & 0xffu, b3 = (unsigned)(int)rintf(hf[4 * d + 3] * hinv) & 0xffu;
        w[d] = b0 | (b1 << 8) | (b2 << 16) | (b3 << 24); }
    *(v4u*)(hq + (size_t)tok * 1024 + 16 * lane) = w;
    if (lane == 0) hs[tok] = rsqrtf(in.rsq * (1.0f / 1024.0f) + 1e-6f) * amax * (1.0f / 127.0f);
}
constexpr int PA_SLOTS = 12;
struct PeerA1 { int e; float g; };
struct PeerA2 { v4u ur[3][4]; float su, sv; int cnt, rk; bool m; unsigned long long rem; };
struct PeerAH { v4u hv[4]; float hsc; };
__device__ __forceinline__ void pa_s1(PeerA1& a, const int* __restrict__ te, const float* __restrict__ tw, int tok, int half, int lane) {
    const unsigned o = (unsigned)tok * 128u + 64u * (unsigned)half + (unsigned)lane; a.e = te[o]; a.g = tw[o]; }
__device__ __forceinline__ void pa_s1h(PeerAH& h, const unsigned char* __restrict__ hq, const float* __restrict__ hs, int tok, int lane) {
    const int t = lane & 15;
#pragma unroll
    for (int i = 0; i < 4; ++i) h.hv[i] = *(const v4u*)(hq + ((unsigned)tok * 1024u + 16u * (unsigned)t + 256u * i));
    h.hsc = hs[tok + (int)__builtin_amdgcn_mbcnt_lo(0u, 0u)]; }
template <int MODE> __device__ __forceinline__ void pa_s2(PeerA2& b, const PeerA1& a, const unsigned char* __restrict__ u8, const float* __restrict__ su, LAS int* lst, int x, int lane) {
    b.m = (a.e >> 11) == x;
    const unsigned long long mask = __ballot(b.m);
    b.cnt = __popcll(mask); b.rk = (int)__builtin_amdgcn_mbcnt_hi((unsigned)(mask >> 32), __builtin_amdgcn_mbcnt_lo((unsigned)mask, 0u));
    if (b.m && b.rk < PA_SLOTS) lst[b.rk] = a.e;
    b.rem = 0ull; if (b.cnt > PA_SLOTS) { unsigned long long r = mask;
#pragma unroll
        for (int k = 0; k < PA_SLOTS; ++k) r &= r - 1ull;
        b.rem = r; }
    { typedef float f32x2s __attribute__((ext_vector_type(2))); f32x2s s2 = (f32x2s){0.f, 0.f}; if (b.m) s2 = ((const f32x2s*)su)[a.e]; b.su = s2.x; b.sv = s2.y; }
    const int r = lane >> 4, t = lane & 15;
    LDS_WAIT(); asm volatile("" ::: "memory");
    const int lim = b.cnt < PA_SLOTS ? b.cnt : PA_SLOTS;
    int es[3];
#pragma unroll
    for (int q = 0; q < 3; ++q) es[q] = lst[4 * q + r];
#pragma unroll
    for (int q = 0; q < 3; ++q) { int e = (4 * q + r) < lim ? es[q] : (x << 11);
        if (MODE & 1) e = (x << 11) | (e & 255);
        const unsigned off = (unsigned)e * 1024u + 16u * (unsigned)t;
#pragma unroll
        for (int i = 0; i < 4; ++i) { if (MODE & 2) b.ur[q][i] = (v4u){(unsigned)e, (unsigned)e + 1u, (unsigned)e + 2u, (unsigned)e + 3u}; else b.ur[q][i] = *(const v4u*)(u8 + (off + 256u * i)); } }
}
__device__ __forceinline__ int dot16(const v4u u, const v4u h) { int d = __builtin_amdgcn_sdot4((int)u.x, (int)h.x, 0, false); d = __builtin_amdgcn_sdot4((int)u.y, (int)h.y, d, false);
    d = __builtin_amdgcn_sdot4((int)u.z, (int)h.z, d, false); return __builtin_amdgcn_sdot4((int)u.w, (int)h.w, d, false); }
template <int CTRL, int RM> __device__ __forceinline__ int dpp_i(int x) { return __builtin_amdgcn_update_dpp(0, x, CTRL, RM, 0xf, false); }
__device__ __forceinline__ int wave_sum_to63(int x) { x += dpp_i<0xb1, 0xf>(x); x += dpp_i<0x4e, 0xf>(x); x += dpp_i<0x124, 0xf>(x); x += dpp_i<0x128, 0xf>(x); x += dpp_i<0x142, 0xa>(x); x += dpp_i<0x143, 0xc>(x); return x; }
__device__ __forceinline__ int row_sum16(int x) { x += dpp_i<0xb1, 0xf>(x); x += dpp_i<0x4e, 0xf>(x); x += dpp_i<0x124, 0xf>(x); x += dpp_i<0x128, 0xf>(x); return x; }
__device__ __forceinline__ float gelu_erf(float v) {
    const float av = fabsf(v), t = __builtin_amdgcn_rcpf(av * 0.2316418882f + 1.0f);
    float q = t * 0.5307027145f + (-0.7265760135f); q = q * t + 0.7107068705f; q = q * t + (-0.142248368f); q = q * t + 0.127414796f; q = q * t;
    const float e = __builtin_amdgcn_exp2f((v * v) * (-0.72134752044f)), m = v * (q * e);
    return v < 0.f ? m : v - m; }
template <int MODE> __device__ __forceinline__ void pa_s3(const PeerA2& b, const PeerA1& a, const PeerAH& h, const unsigned char* __restrict__ u8, const unsigned char* __restrict__ hq, float* __restrict__ aw, int tok, int half, int lane) {
    int mine = 0;
    if (MODE & 8) { mine = (int)(b.ur[0][0].x ^ b.ur[1][1].y ^ b.ur[2][2].z ^ h.hv[0].x); } else
    {
        int d[3];
#pragma unroll
        for (int q = 0; q < 3; ++q) { d[q] = dot16(b.ur[q][0], h.hv[0]); d[q] += dot16(b.ur[q][1], h.hv[1]); d[q] += dot16(b.ur[q][2], h.hv[2]); d[q] += dot16(b.ur[q][3], h.hv[3]); }
#pragma unroll
        for (int q = 0; q < 3; ++q) d[q] += dpp_i<0xb1, 0xf>(d[q]);
#pragma unroll
        for (int q = 0; q < 3; ++q) d[q] += dpp_i<0x4e, 0xf>(d[q]);
#pragma unroll
        for (int q = 0; q < 3; ++q) d[q] += dpp_i<0x124, 0xf>(d[q]);
#pragma unroll
        for (int q = 0; q < 3; ++q) d[q] += dpp_i<0x128, 0xf>(d[q]);
        const int src = 64 * (b.rk & 3);
#pragma unroll
        for (int q = 0; q < 3; ++q) { const int v = __builtin_amdgcn_ds_bpermute(src, d[q]); mine = ((b.rk >> 2) == q) ? v : mine; }
    }
    float* awp = aw + ((unsigned)tok * 128u + 64u * (unsigned)half + (unsigned)lane);
    if (b.m && b.rk < PA_SLOTS) *awp = a.g * gelu_erf((float)mine * h.hsc * b.su) * b.sv;
    if (b.cnt > PA_SLOTS) {
        unsigned long long rem = b.rem; const v4u hw = *(const v4u*)(hq + (size_t)tok * 1024 + 16 * lane);
        while (rem != 0ull) { const int idx = __builtin_ctzll(rem); rem &= rem - 1ull; const int e = __builtin_amdgcn_readlane(a.e, idx);
            const int d = __builtin_amdgcn_readlane(wave_sum_to63(dot16(*(const v4u*)(u8 + (size_t)e * 1024 + 16 * lane), hw)), 63);
            if (lane == idx) *awp = a.g * gelu_erf((float)d * h.hsc * b.su) * b.sv; }
    }
}
template <int MODE> __device__ __forceinline__ void peer_a_run(const unsigned char* __restrict__ hq, const float* __restrict__ hs, const unsigned char* __restrict__ u8, const float* __restrict__ su,
                                           const float* __restrict__ sv, const int* __restrict__ te, const float* __restrict__ tw, float* __restrict__ aw, LAS int* lst, int wrank, int wstep, int x, int lane) {
    const int ntok = wrank < T ? (T - wrank + wstep - 1) / wstep : 0, N = 2 * ntok; (void)sv;
#define PA_TOK(n) ((MODE & 4) ? wrank : wrank + ((n) >> 1) * wstep)
    if (N == 0) return;
    PeerA1 a0, a1, a2, a3; PeerA2 bA, bB; PeerAH h0, h1;
#pragma unroll
    for (int q = 0; q < 3; ++q)
#pragma unroll
        for (int i = 0; i < 4; ++i) { bA.ur[q][i] = (v4u){0u, 0u, 0u, 0u}; bB.ur[q][i] = (v4u){0u, 0u, 0u, 0u}; }
    pa_s1(a0, te, tw, PA_TOK(0), 0, lane); pa_s1(a1, te, tw, PA_TOK(1), 1, lane); pa_s1h(h0, hq, hs, PA_TOK(0), lane);
    if (N > 2) { pa_s1(a2, te, tw, PA_TOK(2), 0, lane); pa_s1(a3, te, tw, PA_TOK(3), 1, lane); pa_s1h(h1, hq, hs, PA_TOK(2), lane); }
    pa_s2<MODE>(bA, a0, u8, su, lst, x, lane);
#define PA_STEP(n, Bcur, Bnext, Acur, Anext, Hcur, LOADH) do { \
        if ((n) + 1 < N) pa_s2<MODE>(Bnext, Anext, u8, su, lst, x, lane); \
        pa_s3<MODE>(Bcur, Acur, Hcur, u8, hq, aw, wrank + ((n) >> 1) * wstep, (n) & 1, lane); \
        if ((n) + 4 < N) { pa_s1(Acur, te, tw, PA_TOK((n) + 4), (n) & 1, lane); } \
        if (LOADH && (n) + 3 < N) pa_s1h(Hcur, hq, hs, PA_TOK((n) + 3), lane); } while (0)
    for (int n = 0; n < N; n += 4) {
        PA_STEP(n, bA, bB, a0, a1, h0, 0);
        if (n + 1 < N) PA_STEP(n + 1, bB, bA, a1, a2, h0, 1);
        if (n + 2 < N) PA_STEP(n + 2, bA, bB, a2, a3, h1, 0);
        if (n + 3 < N) PA_STEP(n + 3, bB, bA, a3, a0, h1, 1);
    }
#undef PA_STEP
#undef PA_TOK
}
struct PeerB1 { v4u e[4]; f32x4 w[4]; unsigned h2; };
struct PeerB2 { v4u vr[8]; };
struct PeerBAcc { int acc[16]; int wq[4]; float wsc, h0, h1; };
typedef float f32x2v __attribute__((ext_vector_type(2)));
__device__ __forceinline__ void pb_s1(PeerB1& a, const int* __restrict__ te, const float* __restrict__ aw, int tok, int lane) {
    const v4u* ep = (const v4u*)(te + (size_t)tok * 128 + 16 * (lane >> 3)); const f32x4* wp = (const f32x4*)(aw + (size_t)tok * 128 + 16 * (lane >> 3));
#pragma unroll
    for (int j = 0; j < 4; ++j) { a.e[j] = ep[j]; a.w[j] = wp[j]; } }
__device__ __forceinline__ int pb_col(int lane) { return 16 * (lane & 7) + 8 * ((lane >> 5) & 1) + 4 * ((lane >> 4) & 1) + 2 * ((lane >> 3) & 1); }
template <int CTRL, int RM> __device__ __forceinline__ float dpp_f(float x) { return __builtin_bit_cast(float, __builtin_amdgcn_update_dpp(0, __builtin_bit_cast(int, x), CTRL, RM, 0xf, false)); }
__device__ __forceinline__ void pb_quant(PeerBAcc& A, const PeerB1& a) {
    float mx = 0.f;
#pragma unroll
    for (int j = 0; j < 4; ++j) mx = fmaxf(mx, fmaxf(fmaxf(fabsf(a.w[j][0]), fabsf(a.w[j][1])), fmaxf(fabsf(a.w[j][2]), fabsf(a.w[j][3]))));
    mx = fmaxf(mx, dpp_f<0xb1, 0xf>(mx)); mx = fmaxf(mx, dpp_f<0x4e, 0xf>(mx)); mx = fmaxf(mx, dpp_f<0x124, 0xf>(mx)); mx = fmaxf(mx, dpp_f<0x128, 0xf>(mx));
    mx = fmaxf(mx, dpp_f<0x142, 0xa>(mx)); mx = fmaxf(mx, dpp_f<0x143, 0xc>(mx));
    mx = __builtin_bit_cast(float, __builtin_amdgcn_readlane(__builtin_bit_cast(int, mx), 63));
    const float inv = mx > 0.f ? 127.0f / mx : 0.f; A.wsc = mx * (1.0f / 127.0f);
#pragma unroll
    for (int j = 0; j < 4; ++j) A.wq[j] = (int)(((unsigned)(int)rintf(a.w[j][0] * inv) & 0xffu) | (((unsigned)(int)rintf(a.w[j][1] * inv) & 0xffu) << 8) |
                                               (((unsigned)(int)rintf(a.w[j][2] * inv) & 0xffu) << 16) | (((unsigned)(int)rintf(a.w[j][3] * inv) & 0xffu) << 24));
}
template <int HF, int MODE> __device__ __forceinline__ void pb_s2(PeerB2& b, const PeerB1& a, const unsigned char* __restrict__ v8x, int lane) {
    const int c = lane & 7;
#pragma unroll
    for (int m = 0; m < 8; ++m) { unsigned e = a.e[2 * HF + (m >> 2)][m & 3]; if (MODE & 1) e &= 255u;
        if (MODE & 2) b.vr[m] = (v4u){e, e + 1u, e + 2u, e + 3u}; else b.vr[m] = *(const v4u*)(v8x + (size_t)e * 128 + 16 * c); }
}
__device__ __forceinline__ float swap32_add(float lo, float hi) { const auto r = __builtin_amdgcn_permlane32_swap(__builtin_bit_cast(unsigned, lo), __builtin_bit_cast(unsigned, hi), false, false);
    return __builtin_bit_cast(float, r[0]) + __builtin_bit_cast(float, r[1]); }
__device__ __forceinline__ float swap16_add(float lo, float hi) { const auto r = __builtin_amdgcn_permlane16_swap(__builtin_bit_cast(unsigned, lo), __builtin_bit_cast(unsigned, hi), false, false);
    return __builtin_bit_cast(float, r[0]) + __builtin_bit_cast(float, r[1]); }
template <int HF, int MODE> __device__ __forceinline__ void pb_s3(PeerBAcc& A, const PeerB2& b, const PeerB1& a, float* out, int tok, int x, int lane) {
    if (MODE & 8) { if (HF == 0) { A.acc[0] = 0; }
#pragma unroll
        for (int m = 0; m < 8; ++m) A.acc[0] += (int)(b.vr[m].x ^ b.vr[m].y ^ b.vr[m].z ^ b.vr[m].w);
        if (HF == 1) { f32x2v h2; h2.x = A.h0 + (float)A.acc[0]; h2.y = A.h1 + A.wsc; *(f32x2v*)(out + (size_t)tok * 1024 + 128 * x + pb_col(lane)) = h2; }
        return; }
    if (HF == 0) {
#pragma unroll
        for (int j = 0; j < 16; ++j) A.acc[j] = 0;
    }
#pragma unroll
    for (int gg = 0; gg < 2; ++gg)
#pragma unroll
        for (int d = 0; d < 4; ++d) { const unsigned ra = b.vr[4 * gg][d], rb = b.vr[4 * gg + 1][d], rc = b.vr[4 * gg + 2][d], rd = b.vr[4 * gg + 3][d];
            const unsigned t0 = __builtin_amdgcn_perm(rb, ra, 0x05010400u), t1 = __builtin_amdgcn_perm(rb, ra, 0x07030602u), t2 = __builtin_amdgcn_perm(rd, rc, 0x05010400u), t3 = __builtin_amdgcn_perm(rd, rc, 0x07030602u);
            const unsigned c0 = __builtin_amdgcn_perm(t2, t0, 0x05040100u), c1 = __builtin_amdgcn_perm(t2, t0, 0x07060302u), c2 = __builtin_amdgcn_perm(t3, t1, 0x05040100u), c3 = __builtin_amdgcn_perm(t3, t1, 0x07060302u);
            const int w4 = A.wq[2 * HF + gg];
            A.acc[4 * d] = __builtin_amdgcn_sdot4((int)c0, w4, A.acc[4 * d], false); A.acc[4 * d + 1] = __builtin_amdgcn_sdot4((int)c1, w4, A.acc[4 * d + 1], false);
            A.acc[4 * d + 2] = __builtin_amdgcn_sdot4((int)c2, w4, A.acc[4 * d + 2], false); A.acc[4 * d + 3] = __builtin_amdgcn_sdot4((int)c3, w4, A.acc[4 * d + 3], false); }
    if (HF == 1) {
        int r8[8], r4[4], r2[2];
#pragma unroll
        for (int j = 0; j < 8; ++j) { const bool up = (lane & 32) != 0; const int keep = up ? A.acc[j + 8] : A.acc[j], send = up ? A.acc[j] : A.acc[j + 8]; r8[j] = keep + __shfl_xor(send, 32); }
#pragma unroll
        for (int j = 0; j < 4; ++j) { const bool up = (lane & 16) != 0; const int keep = up ? r8[j + 4] : r8[j], send = up ? r8[j] : r8[j + 4]; r4[j] = keep + __shfl_xor(send, 16); }
#pragma unroll
        for (int j = 0; j < 2; ++j) { const bool up = (lane & 8) != 0; const int keep = up ? r4[j + 2] : r4[j], send = up ? r4[j] : r4[j + 2];
            r2[j] = keep + __builtin_amdgcn_update_dpp(0, send, 0x128, 0xf, 0xf, false); }
        f32x2v h2; h2.x = A.h0 + A.wsc * (float)r2[0]; h2.y = A.h1 + A.wsc * (float)r2[1];
        *(f32x2v*)(out + (size_t)tok * 1024 + 128 * x + pb_col(lane)) = h2;
    }
}
__device__ __forceinline__ void pb_s1h(PeerB1& a, const int* __restrict__ te, const float* __restrict__ aw, const bf16* __restrict__ hb, int tok, int x, int lane) {
    pb_s1(a, te, aw, tok, lane); a.h2 = *(const unsigned*)(hb + (size_t)tok * 1024 + 128 * x + pb_col(lane)); }
template <int MODE> __device__ __forceinline__ void peer_b_run(const unsigned char* __restrict__ v8x, const int* __restrict__ te, const float* __restrict__ aw, const bf16* __restrict__ hb, float* out, int wrank, int wstep, int x, int lane) {
    const int N = wrank < T ? (T - wrank + wstep - 1) / wstep : 0;
#define PB_TOK(n) (wrank + (n) * wstep)
#define PB_STOK(n) ((MODE & 4) ? wrank : PB_TOK(n))
    if (N == 0) return;
    PeerB1 s0, s1, s2; PeerB2 bA, bB; PeerBAcc A;
    pb_s1h(s0, te, aw, hb, PB_STOK(0), x, lane); if (N > 1) pb_s1h(s1, te, aw, hb, PB_STOK(1), x, lane);
    pb_s2<0, MODE>(bA, s0, v8x, lane);
#define PB_TOKEN(n, Scur, Snext, Snew) do { \
        if ((n) + 2 < N) pb_s1h(Snew, te, aw, hb, PB_STOK((n) + 2), x, lane); \
        pb_s2<1, MODE>(bB, Scur, v8x, lane); A.h0 = bflo(Scur.h2); A.h1 = bfhi(Scur.h2); pb_quant(A, Scur); \
        pb_s3<0, MODE>(A, bA, Scur, out, PB_TOK(n), x, lane); \
        if ((n) + 1 < N) pb_s2<0, MODE>(bA, Snext, v8x, lane); \
        pb_s3<1, MODE>(A, bB, Scur, out, PB_TOK(n), x, lane); } while (0)
    for (int n = 0; n < N; n += 3) {
        PB_TOKEN(n, s0, s1, s2);
        if (n + 1 < N) PB_TOKEN(n + 1, s1, s2, s0);
        if (n + 2 < N) PB_TOKEN(n + 2, s2, s0, s1);
    }
#undef PB_TOKEN
#undef PB_STOK
#undef PB_TOK
}

__global__ void __launch_bounds__(NWAVES * 64, 2) mk_fwd(Args args) {
    extern __shared__ __attribute__((aligned(16))) unsigned char lds[];
    Frame F;
    F.lds = (LAS unsigned char*)lds;
    F.MISC = (volatile LAS unsigned*)(F.lds + MISC_OFF);
    F.tid = threadIdx.x; F.lane = F.tid & 63; F.wave = __builtin_amdgcn_readfirstlane(F.tid >> 6);
    F.G = gridDim.x; { const int bx = blockIdx.x; F.vcu = (F.G % 8 == 0) ? (bx % 8) * (F.G / 8) + bx / 8 : bx; }
    F.out = nullptr; F.ws = args.ws;
    unsigned char* ws = args.ws;
    F.ctl = (gu32*)(ws + WS_CTL);
    for (int u = F.tid; u < (LDS_BYTES - LDSCTL_OFF) / 4; u += NWAVES * 64) ((LAS unsigned*)(F.lds + LDSCTL_OFF))[u] = 0u;
    __syncthreads();
    XcdBarrier bar; bar.bar = (unsigned*)(F.ctl + CW_BAR); bar.x = 0; bar.st = nullptr;
    if (N_LAUNCHES != PER_PHASE) bar = xcd_barrier_post((unsigned*)(F.ctl + CW_BAR), F.MISC + 8);
    if (N_LAUNCHES != PER_PHASE) { if (F.tid == 0) { const unsigned xid = xb_xcc_id(); F.MISC[12] = xid; F.MISC[13] = xb_add((unsigned*)(F.ctl + CW_TICKET) + 64 * xid, 1u); } __syncthreads(); }
#define GRID_BAR() do { if (N_LAUNCHES != PER_PHASE) xcd_barrier(bar); } while (0)
    const int lo = args.ph_lo, hi = args.ph_hi;
#define IN(k) (lo <= (k) && (k) < hi)
#define BOTH(k) (IN(k) && IN((k) + 1))
    const int gw = F.vcu * NWAVES + F.wave, NGW = F.G * NWAVES;
    bf16* const WinT = (bf16*)(ws + WS_WIN); bf16* const WvT = (bf16*)(ws + WS_WV); bf16* const WkvT = (bf16*)(ws + WS_WKV); bf16* const WbrT = (bf16*)(ws + WS_WBR);
    bf16* const WoutT = (bf16*)(ws + WS_WOUT); bf16* const WqT = (bf16*)(ws + WS_WQ); bf16* const KEYS = (bf16*)(ws + WS_KEYS); bf16* const PWT = (bf16*)(ws + WS_PWT);
    bf16* const MEMN = (bf16*)(ws + WS_MEMN); bf16* const KMEM = (bf16*)(ws + WS_KMEM); bf16* const VTMEM = (bf16*)(ws + WS_VTMEM); float* const RSTDX = (float*)(ws + WS_RSTDX);
    const unsigned char* const U8 = ws + WS_U8; const unsigned char* const V8 = ws + WS_V8; const float* const SU = (const float*)(ws + WS_SU); const float* const SV = (const float*)(ws + WS_SV);
    bf16* const QN = (bf16*)(ws + WS_QN); bf16* const KN = (bf16*)(ws + WS_KN); bf16* const VT = (bf16*)(ws + WS_VT); bf16* const PP = (bf16*)(ws + WS_PP); bf16* const XQ = (bf16*)(ws + WS_XQ);
    bf16* const GATE = (bf16*)(ws + WS_GATE); bf16* const MERGED = (bf16*)(ws + WS_MERGED); bf16* const HB = (bf16*)(ws + WS_HB); bf16* const QB = (bf16*)(ws + WS_QB);
    int* const TE = (int*)(ws + WS_TE); float* const TW = (float*)(ws + WS_TW); float* const AW = (float*)(ws + WS_AW); float* const ROWSQ = (float*)(ws + WS_ROWSQ);
#define RELOAD_OUT(p) do { asm volatile("s_load_dwordx2 %0, %1, 0xb8\n\ts_waitcnt lgkmcnt(0)" : "=s"(p) : "s"(__builtin_amdgcn_kernarg_segment_ptr()) : "memory"); } while (0)
#define XB ((bf16*)(outp + OUT_XB))
#define YNA ((bf16*)(outp + OUT_YNA))
#define YPOOL ((bf16*)(outp + OUT_YPOOL))
#define YXA ((bf16*)(outp + OUT_YXA))

#ifndef STAGGER_SLEEPS
#define STAGGER_SLEEPS 1
#endif
#define STAGGER() do { const int q_ = __builtin_amdgcn_readfirstlane((int)((blockIdx.x >> 3) & 3u) * STAGGER_SLEEPS); for (int i_ = 0; i_ < q_; ++i_) __builtin_amdgcn_s_sleep(127); } while (0)
    if (IN(0)) { unsigned char* outp; RELOAD_OUT(outp); F.out = (float*)outp; p0_prologue(F, args); F.out = nullptr; if (BOTH(0)) GRID_BAR(); }
    if (IN(1)) STAGGER();

    if (IN(1)) {
      { unsigned char* outp; RELOAD_OUT(outp);
        { pg8::Sched1 S; S.so.init(T, IN_MAIN, F.G, (int)blockIdx.x); S.A = (const char*)XB; S.Bt = (const char*)WinT; S.tstep = (size_t)256 * 1024 * 2;
          pg8::EpiProj E{RSTDX, QN, KN, PP, XQ, GATE, args.in[I_NAQG], args.in[I_NAKG], args.in[I_GATEB], (args.probe & 1)};
          pg8::gemm_phase<pg8::EpiProj, pg8::Sched1, true, true>(F.lds + RING_OFF, 1024, S, E); }
        if (!(args.probe & 4)) { pg8::Sched1 S; S.so.init(512, T, F.G, (int)blockIdx.x); S.A = (const char*)WvT; S.Bt = (const char*)XB; S.tstep = (size_t)256 * 1024 * 2;
          pg8::EpiVt E{RSTDX, VT};
          pg8::gemm_phase<pg8::EpiVt, pg8::Sched1, false, true>(F.lds + RING_OFF, 1024, S, E); }
        if (!(args.probe & 2)) {
            __syncthreads();
            for (int j = F.vcu; j < 256; j += F.G) memkv_tile(MEMN, WkvT, args.in[I_XAKG], args.in[I_XAQG], KMEM, VTMEM, (LAS float*)(F.lds + RING_OFF) + (F.wave >> 2) * 6144, 2 * j + (F.wave >> 2), F.wave & 3, F.lane);
            __syncthreads(); }
      }
        if (BOTH(1)) GRID_BAR();
    }

    if (IN(2)) {
      { unsigned char* outp; RELOAD_OUT(outp);
        LAS float* rpl = (LAS float*)(F.lds + RING_OFF + F.wave * 16384);
        for (int i = F.lane; i < 15 * 31; i += 64) rpl[i] = args.in[I_RPB][F.wave * 15 * 31 + i];
        LDS_WAIT(); asm volatile("" ::: "memory");
        if (!(args.probe & 1)) for (int i = F.vcu; i < 256; i += F.G)
            for (int k = 0; k < 8; ++k) { const int idx = i * 8 + k, b = idx >> 9, r = (idx >> 2) & 127, jb = idx & 3; na_item(QN, KN, VT, rpl, YNA, b, r, jb, F.wave, F.lane); }
        if (!(args.probe & 2)) for (int i = F.vcu; i < 256; i += F.G) pool_wg(PP, PWT, YPOOL, F.lds + RING_OFF, i * 128, F.wave, F.lane);
        if (!(args.probe & 4)) { const int pair = F.vcu & 15, xb = pair >> 2, xh = pair & 3, slot = F.vcu >> 4, nslot = F.G >> 4;
          __syncthreads(); xa_fill_lds(KMEM, VTMEM, F.lds + RING_OFF, xb, xh, F.tid); __syncthreads();
          if (slot < nslot) for (int n = slot * NWAVES + F.wave; n < 512; n += nslot * NWAVES) xa_item(XQ, F.lds + RING_OFF, YXA, (xb * 512 + n) * 16, xh, F.lane);
          __syncthreads(); }
      }
        if (BOTH(2)) GRID_BAR();
    }

    if (IN(3)) {
      { unsigned char* outp; RELOAD_OUT(outp);
        pg8::Sched1 S; S.so.init(T, D, F.G, (int)blockIdx.x); S.A = (const char*)YNA; S.Bt = (const char*)WbrT; S.tstep = (size_t)256 * 1536 * 2;
        pg8::EpiMergeCat E{GATE, MERGED};
        pg8::gemm_phase<pg8::EpiMergeCat, pg8::Sched1, true, true>(F.lds + RING_OFF, 1536, S, E);
      }
        if (BOTH(3)) GRID_BAR();
    }

    if (IN(4)) {
      {
        pg8::Sched1 S; S.so.init(T, D, F.G, (int)blockIdx.x); S.A = (const char*)MERGED; S.Bt = (const char*)WoutT; S.tstep = (size_t)256 * 1024 * 2;
        pg8::EpiH E{args.in[I_X], nullptr, HB, ROWSQ, args.probe};
        pg8::gemm_phase<pg8::EpiH, pg8::Sched1, true, true>(F.lds + RING_OFF, 1024, S, E);
      }
        if (BOTH(4)) GRID_BAR();
    }

    if (IN(5)) {
      {
        pg8::Sched1 S; S.so.init(T, 2048, F.G, (int)blockIdx.x); S.A = (const char*)HB; S.Bt = (const char*)WqT; S.tstep = (size_t)256 * 1024 * 2;
        pg8::EpiQ E{ROWSQ, QB};
        pg8::gemm_phase<pg8::EpiQ, pg8::Sched1, true, true>(F.lds + RING_OFF, 1024, S, E);
      }
        if (BOTH(5)) GRID_BAR();
    }

    if (IN(6)) {
        LAS int* lscr = (LAS int*)(F.lds + RING_OFF + 65536 + F.wave * 8192);
        for (int tok = 4 * gw; tok < T; tok += 4 * NGW) {
            HqIn hin[4];
#pragma unroll
            for (int r = 0; r < 4; ++r) hq_load(hin[r], HB, ROWSQ, tok + r, F.lane);
#pragma unroll
            for (int r = 0; r < 4; ++r) hq_token(hin[r], ws + WS_HQ, (float*)(ws + WS_HS), tok + r, F.lane); }
        { const int th = F.vcu & 7, slot = F.vcu >> 3, nslot = F.G >> 3;
          __syncthreads(); topk_fill_lds(KEYS, F.lds + RING_OFF, th, F.tid); __syncthreads();
          { { const int n0 = slot * NWAVES + F.wave, ns = nslot * NWAVES; TopkQ qA, qB;
              if (n0 < 2048) topk_loadq(qA, QB, n0 * 16, th, F.lane);
              for (int n = n0; n < 2048; n += 2 * ns) {
                  if (n + ns < 2048) topk_loadq(qB, QB, (n + ns) * 16, th, F.lane);
                  topk_item(qA, F.lds + RING_OFF, TE, TW, lscr, n * 16, th, F.lane);
                  if (n + ns < 2048) { if (n + 2 * ns < 2048) topk_loadq(qA, QB, (n + 2 * ns) * 16, th, F.lane);
                      topk_item(qB, F.lds + RING_OFF, TE, TW, lscr, (n + ns) * 16, th, F.lane); } } } }
          __syncthreads(); }
        if (BOTH(6)) GRID_BAR();
    }

    if (IN(7)) {
        int x0 = 0, nxs = 8, wrank = (int)blockIdx.x * NWAVES + F.wave, wstep = F.G * NWAVES;
        if (N_LAUNCHES != PER_PHASE) { const unsigned xid = F.MISC[12], rk = F.MISC[13]; unsigned nx = 0, below = 0, mine = 0;
            for (unsigned j = 0; j < 16; ++j) { const unsigned c = xb_ld((unsigned*)(F.ctl + CW_BAR) + XB_XCNT(j)); nx += c > 0u; below += (c > 0u && j < xid); mine = (j == xid) ? c : mine; }
            if (nx == 8 && mine > 0 && rk < mine) { x0 = (int)below; nxs = 1; wrank = (int)rk * NWAVES + F.wave; wstep = (int)mine * NWAVES; } }
        else if ((F.G & 7) == 0) { x0 = (int)blockIdx.x & 7; nxs = 1; wrank = ((int)blockIdx.x >> 3) * NWAVES + F.wave; wstep = (F.G >> 3) * NWAVES; }
        for (int xs = 0; xs < nxs; ++xs) {
#ifdef PROBE_BITS
            if (args.probe) peer_a_run<PROBE_BITS>(ws + WS_HQ, (const float*)(ws + WS_HS), U8, SU, SV, TE, TW, (float*)QB, (LAS int*)(F.lds + RING_OFF + F.wave * 16384), wrank, wstep, x0 + xs, F.lane); else
#endif
            peer_a_run<0>(ws + WS_HQ, (const float*)(ws + WS_HS), U8, SU, SV, TE, TW, AW, (LAS int*)(F.lds + RING_OFF + F.wave * 16384), wrank, wstep, x0 + xs, F.lane); }
        if (N_LAUNCHES != PER_PHASE) xcd_barrier(bar);
    }
    if (IN(8)) {
        int x0 = 0, nxs = 8, wrank = (int)blockIdx.x * NWAVES + F.wave, wstep = F.G * NWAVES;
        if (N_LAUNCHES != PER_PHASE) { const unsigned xid = F.MISC[12], rk = F.MISC[13]; unsigned nx = 0, below = 0, mine = 0;
            for (unsigned j = 0; j < 16; ++j) { const unsigned c = xb_ld((unsigned*)(F.ctl + CW_BAR) + XB_XCNT(j)); nx += c > 0u; below += (c > 0u && j < xid); mine = (j == xid) ? c : mine; }
            if (nx == 8 && mine > 0 && rk < mine) { x0 = (int)below; nxs = 1; wrank = (int)rk * NWAVES + F.wave; wstep = (int)mine * NWAVES; } }
        else if ((F.G & 7) == 0) { x0 = (int)blockIdx.x & 7; nxs = 1; wrank = ((int)blockIdx.x >> 3) * NWAVES + F.wave; wstep = (F.G >> 3) * NWAVES; }
        for (int xs = 0; xs < nxs; ++xs) {
#ifdef PROBE_BITS
            if (args.probe) peer_b_run<PROBE_BITS>(V8 + (size_t)(x0 + xs) * (2 * MiB), TE, AW, HB, (float*)QB, wrank, wstep, x0 + xs, F.lane); else
#endif
            { unsigned char* outp; RELOAD_OUT(outp); peer_b_run<0>(V8 + (size_t)(x0 + xs) * (2 * MiB), TE, AW, HB, (float*)outp, wrank, wstep, x0 + xs, F.lane); } }
    }
#undef XB
#undef YNA
#undef YPOOL
#undef YXA
#undef RELOAD_OUT
#undef IN
#undef BOTH
#undef GRID_BAR
}

extern "C" void kernel_launch(void* const* d_in, const int* in_sizes, int n_in, void* d_out, int out_size, void* d_ws, size_t ws_size, hipStream_t stream) {
    static int grid = 0;
    if (grid == 0) {
        if (n_in != 23 || in_sizes[0] != T * D || out_size != T * D || ws_size < WS_END) { fprintf(stderr, "kernel_launch: unexpected shapes: n_in %d in0 %d out %d ws %zu\n", n_in, n_in > 0 ? in_sizes[0] : -1, out_size, ws_size); grid = -1; return; }
        int dev = 0, cus = 0, per_cu = 0;
        if (hipGetDevice(&dev) != hipSuccess || hipDeviceGetAttribute(&cus, hipDeviceAttributeMultiprocessorCount, dev) != hipSuccess) { fprintf(stderr, "kernel_launch: device query failed\n"); grid = -1; return; }
        if (hipFuncSetAttribute((const void*)mk_fwd, hipFuncAttributeMaxDynamicSharedMemorySize, LDS_BYTES) != hipSuccess) { fprintf(stderr, "kernel_launch: hipFuncSetAttribute failed\n"); grid = -1; return; }
        if (hipOccupancyMaxActiveBlocksPerMultiprocessor(&per_cu, (const void*)mk_fwd, NWAVES * 64, LDS_BYTES) != hipSuccess || per_cu < 1)
            fprintf(stderr, "kernel_launch: note: occupancy query reports %d workgroups per CU\n", per_cu);
        (void)hipGetLastError();
        grid = cus;
    }
    if (grid < 0) return;
    if (hipMemsetAsync((char*)d_ws + WS_CTL, 0, CTL_ZERO_BYTES, stream) != hipSuccess) { fprintf(stderr, "kernel_launch: memset failed\n"); return; }
    Args a{};
    for (int i = 0; i < 23; ++i) a.in[i] = (const float*)d_in[i];
    a.out = (float*)d_out; a.ws = (unsigned char*)d_ws;
    for (int li = 0; li < N_LAUNCHES; ++li) {
        a.ph_lo = (N_LAUNCHES == PER_PHASE) ? li : 0; a.ph_hi = (N_LAUNCHES == PER_PHASE) ? li + 1 : PER_PHASE;
        hipLaunchKernelGGL(mk_fwd, dim3(grid), dim3(NWAVES * 64), LDS_BYTES, stream, a);
#ifdef HOST_DUP_PHASE
        if (N_LAUNCHES == PER_PHASE && li == HOST_DUP_PHASE) {
#ifndef PROBE_MODE
            if (li == 4) (void)hipMemsetAsync((char*)d_ws + WS_ROWSQ, 0, (size_t)T * 4, stream);
#endif
#ifdef PROBE_MODE
            a.probe = PROBE_MODE;
#endif
            hipLaunchKernelGGL(mk_fwd, dim3(grid), dim3(NWAVES * 64), LDS_BYTES, stream, a); a.probe = 0; }
#endif
        const hipError_t le = hipPeekAtLastError();
        if (le != hipSuccess) { fprintf(stderr, "kernel_launch: launch %d failed: %s\n", li, hipGetErrorName(le)); break; }
    }
}
```

```cpp
#include <hip/hip_runtime.h>
#include <cstdio>
#include <cstdint>

#ifndef MK_N_LAUNCHES
#define MK_N_LAUNCHES 1
#endif

namespace pg8 {
#define PG8_LAS __attribute__((address_space(3)))
typedef unsigned short bf16_t;
typedef short bf16x8 __attribute__((ext_vector_type(8)));
typedef float f32x4 __attribute__((ext_vector_type(4)));
typedef unsigned u32x4 __attribute__((ext_vector_type(4)));
typedef unsigned u32x2 __attribute__((ext_vector_type(2)));
constexpr int BM = 256, BK = 64, HALF = 128, HTB = HALF * BK * 2  , STAGE_BYTES = 8 * HTB, NXCD = 8, WGM = 8;

__host__ __device__ __forceinline__ int lds_byte(int r, int c) { const int st = (r >> 4) * 2 + (c >> 5), rr = r & 15, cc = c & 31, ob = rr * 64 + cc * 2; return st * 1024 + (ob ^ (((ob >> 9) & 1) << 5)); }
__host__ __device__ __forceinline__ void stage_rc(int b, int& R, int& C) { const int st = b / 1024, sb = b % 1024, swz = sb ^ (((sb >> 9) & 1) << 5); R = (st >> 1) * 16 + swz / 64; C = (st & 1) * 32 + (swz % 64) / 2; }
__host__ __device__ __forceinline__ int perm32(int rho) { const int n = rho >> 4, i = rho & 15; return 8 * (i >> 2) + 4 * n + (i & 3); }

struct Unit { int pm, pn, br; };

struct StaticOrder {
    int nM, nN, nwg, G, c;
    __host__ __device__ void init(int M, int N, int G_, int c_) { nM = M / BM; nN = N / BM; nwg = nM * nN; G = G_; c = c_; }
    __host__ __device__ bool next(int i, Unit& u) const {
        const long L = (long)i * G + c; if (L >= nwg) return false;
        int wgid = (int)L; { const int q = nwg / NXCD, r = nwg % NXCD, xcd = wgid % NXCD, off = wgid / NXCD; wgid = (xcd < r ? xcd * (q + 1) : r * (q + 1) + (xcd - r) * q) + off; }
        const int nig = WGM * nN, gid = wgid / nig, fm = gid * WGM, gsz = (nM - fm) < WGM ? (nM - fm) : WGM;
        u.pm = fm + ((wgid % nig) % gsz); u.pn = (wgid % nig) / gsz; return true;
    }
};
struct Sched1 {
    StaticOrder so; const char* A; const char* Bt; size_t tstep;
    __device__ __forceinline__ bool next(int i, Unit& u) const { u.br = 0; return so.next(i, u); }
    __device__ __forceinline__ const char* abase(const Unit& u) const { return A + (size_t)u.pm * tstep; }
    __device__ __forceinline__ const char* bbase(const Unit& u) const { return Bt + (size_t)u.pn * tstep; }
    __device__ __forceinline__ void a_ready(const Unit&) const {}
    __device__ __forceinline__ void done(const Unit&) const {}
};
struct Sched3 {
    StaticOrder so; const char* A; const char* Bt; size_t tstep, strideA, strideB;
    __device__ __forceinline__ bool next(int i, Unit& u) const { u.br = i % 3; return so.next(i / 3, u); }
    __device__ __forceinline__ const char* abase(const Unit& u) const { return A + (size_t)u.br * strideA + (size_t)u.pm * tstep; }
    __device__ __forceinline__ const char* bbase(const Unit& u) const { return Bt + (size_t)u.br * strideB + (size_t)u.pn * tstep; }
    __device__ __forceinline__ void a_ready(const Unit&) const {}
    __device__ __forceinline__ void done(const Unit&) const {}
};

typedef float f32x2_t __attribute__((ext_vector_type(2))); typedef __bf16 bf16x2v_t __attribute__((ext_vector_type(2)));
__device__ __forceinline__ unsigned cvt_pk_bf16(float lo, float hi) { const f32x2_t v = {lo, hi}; const bf16x2v_t b = __builtin_convertvector(v, bf16x2v_t); return __builtin_bit_cast(unsigned, b); }
__device__ __forceinline__ u32x4 pack8(const f32x4 a, const f32x4 b) { u32x4 w; w.x = cvt_pk_bf16(a[0], a[1]); w.y = cvt_pk_bf16(a[2], a[3]); w.z = cvt_pk_bf16(b[0], b[1]); w.w = cvt_pk_bf16(b[2], b[3]); return w; }
__device__ __forceinline__ float bflo(unsigned u) { return __builtin_bit_cast(float, u << 16); }
__device__ __forceinline__ float bfhi(unsigned u) { return __builtin_bit_cast(float, u & 0xffff0000u); }


constexpr float RMS_EPS = 1e-6f;

struct EpiProj {
    static constexpr bool PERM = true, AFTER_DRAIN = false, HAS_MID = false;
    const float* rstd; bf16_t *qn, *kn, *pp, *xq, *gates; const float *qg, *kg, *gate_b; int skip;
    __device__ __forceinline__ void operator()(const f32x4 (&acc)[2][2][4][2], const Unit& u, int wr, int wc, int fr, int fq) const {
        if (skip) { if (acc[0][0][0][0][0] == 1234.5f) qn[0] = 1; return; }
        const int pn = u.pn, row0 = u.pm * BM + wr * 64 + fr, lc0 = 64 * wc + 8 * fq;
        float rsv[2][4];
#pragma unroll
        for (int ai = 0; ai < 2; ++ai)
#pragma unroll
            for (int m = 0; m < 4; ++m) rsv[ai][m] = rstd[row0 + ai * HALF + m * 16];
        if (pn < 4) {
            const bool isq = pn < 2; bf16_t* O = isq ? qn : kn; const float* g = isq ? qg : kg; const float post = isq ? 0.125f : 1.0f;
            f32x4 gv[2][2];
#pragma unroll
            for (int bj = 0; bj < 2; ++bj)
#pragma unroll
                for (int n = 0; n < 2; ++n) gv[bj][n] = *(const f32x4*)(g + 32 * bj + 8 * fq + 4 * n);
            const int colbase = (pn & 1) * 256 + lc0;
#pragma unroll
            for (int ai = 0; ai < 2; ++ai)
#pragma unroll
                for (int m = 0; m < 4; ++m) {
                    const int row = row0 + ai * HALF + m * 16; const float rs = rsv[ai][m];
                    f32x4 v[2][2]; float ss = 0.f;
#pragma unroll
                    for (int bj = 0; bj < 2; ++bj)
#pragma unroll
                        for (int n = 0; n < 2; ++n) { v[bj][n] = acc[ai][bj][m][n] * rs; ss += (v[bj][n][0] * v[bj][n][0] + v[bj][n][1] * v[bj][n][1]) + (v[bj][n][2] * v[bj][n][2] + v[bj][n][3] * v[bj][n][3]); }
                    ss += __shfl_xor(ss, 16); ss += __shfl_xor(ss, 32);
                    const float r = rsqrtf(ss * (1.0f / 64.0f) + RMS_EPS) * post;
#pragma unroll
                    for (int bj = 0; bj < 2; ++bj) *(u32x4*)(O + (size_t)row * 512 + colbase + 32 * bj) = pack8(v[bj][0] * r * gv[bj][0], v[bj][1] * r * gv[bj][1]);
                }
        } else if (pn < 8) {
            bf16_t* O = pn < 6 ? pp : xq; const int colbase = (pn & 1) * 256 + lc0;
#pragma unroll
            for (int ai = 0; ai < 2; ++ai)
#pragma unroll
                for (int m = 0; m < 4; ++m) {
                    const int row = row0 + ai * HALF + m * 16; const float rs = rsv[ai][m];
#pragma unroll
                    for (int bj = 0; bj < 2; ++bj) *(u32x4*)(O + (size_t)row * 512 + colbase + 32 * bj) = pack8(acc[ai][bj][m][0] * rs, acc[ai][bj][m][1] * rs);
                }
        } else {
            const int gcol0 = (pn - 8) * 256 + lc0;
            f32x4 bv[2][2];
#pragma unroll
            for (int bj = 0; bj < 2; ++bj)
#pragma unroll
                for (int n = 0; n < 2; ++n) bv[bj][n] = *(const f32x4*)(gate_b + gcol0 + 32 * bj + 4 * n) * (-1.4426950408889634f);
#pragma unroll
            for (int ai = 0; ai < 2; ++ai)
#pragma unroll
                for (int m = 0; m < 4; ++m) {
                    const int row = row0 + ai * HALF + m * 16; const float rs = rsv[ai][m] * (-1.4426950408889634f);
#pragma unroll
                    for (int bj = 0; bj < 2; ++bj) {
                        f32x4 o[2];
#pragma unroll
                        for (int n = 0; n < 2; ++n) { const f32x4 z = acc[ai][bj][m][n] * rs + bv[bj][n];
#pragma unroll
                            for (int i = 0; i < 4; ++i) o[n][i] = __builtin_amdgcn_rcpf(1.0f + __builtin_amdgcn_exp2f(z[i])); }
                        *(u32x4*)(gates + (size_t)row * 3072 + gcol0 + 32 * bj) = pack8(o[0], o[1]);
                    }
                }
        }
    }
};
struct EpiVt {
    static constexpr bool PERM = true, AFTER_DRAIN = false, HAS_MID = false;
    const float* rstd; bf16_t* Vt;
    __device__ __forceinline__ void operator()(const f32x4 (&acc)[2][2][4][2], const Unit& u, int wr, int wc, int fr, int fq) const {
        const int ch0 = u.pm * BM + wr * 64 + fr, tok0 = u.pn * BM + wc * 32 + 8 * fq, b = tok0 >> 13, t0 = tok0 & 8191;
        f32x4 rv[2][2];
#pragma unroll
        for (int bj = 0; bj < 2; ++bj)
#pragma unroll
            for (int n = 0; n < 2; ++n) rv[bj][n] = *(const f32x4*)(rstd + tok0 + bj * HALF + 4 * n);
#pragma unroll
        for (int ai = 0; ai < 2; ++ai)
#pragma unroll
            for (int m = 0; m < 4; ++m) { const int ch = ch0 + ai * HALF + m * 16; bf16_t* rowp = Vt + ((size_t)(b * 512 + ch) * 8192 + t0);
#pragma unroll
                for (int bj = 0; bj < 2; ++bj) *(u32x4*)(rowp + bj * HALF) = pack8(acc[ai][bj][m][0] * rv[bj][0], acc[ai][bj][m][1] * rv[bj][1]); }
    }
};
struct EpiMergeCat {
    static constexpr bool PERM = true, AFTER_DRAIN = false, HAS_MID = true;
    const bf16_t* gates; bf16_t* merged;
    __device__ __forceinline__ void mid(f32x4 (&acc)[2][2][4][2], const Unit& u, int nb  , int wr, int wc, int fr, int fq) const {
        const int row0 = u.pm * BM + wr * 64 + fr, col0 = u.pn * BM + wc * 32 + 8 * fq;
#pragma unroll
        for (int ai = 0; ai < 2; ++ai) {
            u32x4 ga[4][2], gb[4][2];
#pragma unroll
            for (int m = 0; m < 4; ++m)
#pragma unroll
                for (int bj = 0; bj < 2; ++bj) { const bf16_t* gp = gates + (size_t)(row0 + ai * HALF + m * 16) * 3072 + (nb - 1) * 1024 + col0 + bj * HALF;
                    ga[m][bj] = *(const u32x4*)gp; gb[m][bj] = *(const u32x4*)(gp + 1024); }
            __builtin_amdgcn_sched_barrier(0);
#pragma unroll
            for (int m = 0; m < 4; ++m)
#pragma unroll
                for (int bj = 0; bj < 2; ++bj) { const u32x4 a = ga[m][bj], b = gb[m][bj]; f32x4& x0 = acc[ai][bj][m][0]; f32x4& x1 = acc[ai][bj][m][1];
                    x0[0] *= bflo(a.x) * __builtin_amdgcn_rcpf(bflo(b.x)); x0[1] *= bfhi(a.x) * __builtin_amdgcn_rcpf(bfhi(b.x)); x0[2] *= bflo(a.y) * __builtin_amdgcn_rcpf(bflo(b.y)); x0[3] *= bfhi(a.y) * __builtin_amdgcn_rcpf(bfhi(b.y));
                    x1[0] *= bflo(a.z) * __builtin_amdgcn_rcpf(bflo(b.z)); x1[1] *= bfhi(a.z) * __builtin_amdgcn_rcpf(bfhi(b.z)); x1[2] *= bflo(a.w) * __builtin_amdgcn_rcpf(bflo(b.w)); x1[3] *= bfhi(a.w) * __builtin_amdgcn_rcpf(bfhi(b.w)); }
            __builtin_amdgcn_sched_barrier(0);
        }
    }
    __device__ __forceinline__ void operator()(const f32x4 (&acc)[2][2][4][2], const Unit& u, int wr, int wc, int fr, int fq) const {
        const int row0 = u.pm * BM + wr * 64 + fr, col0 = u.pn * BM + wc * 32 + 8 * fq;
#pragma unroll
        for (int ai = 0; ai < 2; ++ai) {
            u32x4 g8[4][2];
#pragma unroll
            for (int m = 0; m < 4; ++m)
#pragma unroll
                for (int bj = 0; bj < 2; ++bj) g8[m][bj] = *(const u32x4*)(gates + (size_t)(row0 + ai * HALF + m * 16) * 3072 + 2048 + col0 + bj * HALF);
            __builtin_amdgcn_sched_barrier(0);
#pragma unroll
            for (int m = 0; m < 4; ++m)
#pragma unroll
                for (int bj = 0; bj < 2; ++bj) { const u32x4 g = g8[m][bj]; f32x4 a = acc[ai][bj][m][0], b = acc[ai][bj][m][1];
                    a[0] *= bflo(g.x); a[1] *= bfhi(g.x); a[2] *= bflo(g.y); a[3] *= bfhi(g.y); b[0] *= bflo(g.z); b[1] *= bfhi(g.z); b[2] *= bflo(g.w); b[3] *= bfhi(g.w);
                    *(u32x4*)(merged + (size_t)(row0 + ai * HALF + m * 16) * 1024 + col0 + bj * HALF) = pack8(a, b); }
            __builtin_amdgcn_sched_barrier(0);
        }
    }
};
struct EpiH {
    static constexpr bool PERM = true, AFTER_DRAIN = false, HAS_MID = false;
    const bf16_t* x; float* out; bf16_t* hb; float* rowsq; int noatomic;
    __device__ __forceinline__ void operator()(const f32x4 (&acc)[2][2][4][2], const Unit& u, int wr, int wc, int fr, int fq) const {
        const int row0 = u.pm * BM + wr * 64 + fr, col0 = u.pn * BM + wc * 32 + 8 * fq;
#pragma unroll
        for (int ai = 0; ai < 2; ++ai) {
            u32x4 xv[4][2];
#pragma unroll
            for (int m = 0; m < 4; ++m)
#pragma unroll
                for (int bj = 0; bj < 2; ++bj) xv[m][bj] = *(const u32x4*)(x + ((size_t)(row0 + ai * HALF + m * 16) * 1024 + col0 + bj * HALF));
            __builtin_amdgcn_sched_barrier(0);
#pragma unroll
            for (int m = 0; m < 4; ++m) { const int row = row0 + ai * HALF + m * 16; float ss = 0.f;
#pragma unroll
                for (int bj = 0; bj < 2; ++bj) { const size_t o = (size_t)row * 1024 + col0 + bj * HALF;
                    const u32x4 xq = xv[m][bj]; f32x4 h0 = acc[ai][bj][m][0], h1 = acc[ai][bj][m][1];
                    h0[0] += bflo(xq.x); h0[1] += bfhi(xq.x); h0[2] += bflo(xq.y); h0[3] += bfhi(xq.y); h1[0] += bflo(xq.z); h1[1] += bfhi(xq.z); h1[2] += bflo(xq.w); h1[3] += bfhi(xq.w);
                    *(u32x4*)(hb + o) = pack8(h0, h1);
                    ss += (h0[0] * h0[0] + h0[1] * h0[1]) + (h0[2] * h0[2] + h0[3] * h0[3]) + (h1[0] * h1[0] + h1[1] * h1[1]) + (h1[2] * h1[2] + h1[3] * h1[3]); }
                ss += __shfl_xor(ss, 16); ss += __shfl_xor(ss, 32);
                if (fq == 0 && !noatomic) atomicAdd(rowsq + row, ss); }
            __builtin_amdgcn_sched_barrier(0);
        }
    }
};
struct EpiQ {
    static constexpr bool PERM = true, AFTER_DRAIN = false, HAS_MID = false;
    const float* rowsq; bf16_t* qb;
    __device__ __forceinline__ void operator()(const f32x4 (&acc)[2][2][4][2], const Unit& u, int wr, int wc, int fr, int fq) const {
        const int row0 = u.pm * BM + wr * 64 + fr, col0 = u.pn * BM + wc * 32 + 8 * fq;
        float rq[2][4];
#pragma unroll
        for (int ai = 0; ai < 2; ++ai)
#pragma unroll
            for (int m = 0; m < 4; ++m) rq[ai][m] = rowsq[row0 + ai * HALF + m * 16];
#pragma unroll
        for (int ai = 0; ai < 2; ++ai)
#pragma unroll
            for (int m = 0; m < 4; ++m) { const int row = row0 + ai * HALF + m * 16; const float r = rsqrtf(rq[ai][m] * (1.0f / 1024.0f) + RMS_EPS);
#pragma unroll
                for (int bj = 0; bj < 2; ++bj) *(u32x4*)(qb + (size_t)row * 2048 + col0 + bj * HALF) = pack8(acc[ai][bj][m][0] * r, acc[ai][bj][m][1] * r); }
    }
};

template <class Epi, class Sched, bool ALIGN_EPI = false, bool SP2 = false>
__device__ __forceinline__ void gemm_phase(PG8_LAS unsigned char* lds, const int K, const Sched& S, const Epi& E) {
    const int tid = threadIdx.x, wid = __builtin_amdgcn_readfirstlane(tid >> 6), lane = tid & 63, wr = wid >> 2, wc = wid & 3, fr = lane & 15, fq = lane >> 4;
    const int nt = K / BK;
    unsigned voffA[2], voffB[2];
#pragma unroll
    for (int i = 0; i < 2; ++i) { int R, C; stage_rc(tid * 16 + i * 8192, R, C); const int Rb = Epi::PERM ? ((R & ~31) + perm32(R & 31)) : R;
        voffA[i] = (unsigned)(R * K + C) * 2u; voffB[i] = (unsigned)(Rb * K + C) * 2u; }
    const size_t kstep = (size_t)(BK * 2);
    const size_t hstep = (size_t)HALF * K * 2;
    const size_t tstep = 2 * hstep;
    const unsigned ldsw = (unsigned)wid * 1024u;
    const int aoff = lds_byte(wr * 64 + fr, fq * 8), boff = lds_byte(wc * 32 + fr, fq * 8);
#define PG8_SA(b, h) (((b) * 2 + (h)) * HTB)
#define PG8_SB(b, h) ((4 + (b) * 2 + (h)) * HTB)
#define PG8_STAGE(bufoff, gbase, voff) do { _Pragma("unroll") for (int _i = 0; _i < 2; ++_i) \
        __builtin_amdgcn_global_load_lds((const unsigned*)((const char*)(gbase) + (voff)[_i]), (PG8_LAS unsigned*)(lds + (bufoff) + ldsw + _i * 8192), 16, 0, 0); } while (0)
#define PG8_LDA(dst, b, h) do { _Pragma("unroll") for (int m = 0; m < 4; ++m) _Pragma("unroll") for (int k = 0; k < 2; ++k) dst[m][k] = *(const PG8_LAS bf16x8*)(lds + PG8_SA(b, h) + aoff + m * 2048 + k * 1024); } while (0)
#define PG8_LDB(dst, b, h) do { _Pragma("unroll") for (int n = 0; n < 2; ++n) _Pragma("unroll") for (int k = 0; k < 2; ++k) dst[n][k] = *(const PG8_LAS bf16x8*)(lds + PG8_SB(b, h) + boff + n * 2048 + k * 1024); } while (0)
#define PG8_MMA(ai, bj, At, Bt) do { __builtin_amdgcn_s_setprio(1); _Pragma("unroll") for (int m = 0; m < 4; ++m) _Pragma("unroll") for (int n = 0; n < 2; ++n) _Pragma("unroll") for (int k = 0; k < 2; ++k) \
        acc[ai][bj][m][n] = __builtin_amdgcn_mfma_f32_16x16x32_bf16(Bt[n][k], At[m][k], acc[ai][bj][m][n], 0, 0, 0); __builtin_amdgcn_s_setprio(0); } while (0)
#define PG8_WAIT_V(n) asm volatile("s_waitcnt vmcnt(" #n ")" ::: "memory")
#define PG8_WAIT_L(n) asm volatile("s_waitcnt lgkmcnt(" #n ")" ::: "memory")
#define PG8_BAR __builtin_amdgcn_s_barrier()
#define PG8_SCHED __builtin_amdgcn_sched_barrier(0)
    Unit cur, nxt; int ui = 0;
    if (!S.next(0, cur)) return;
    f32x4 acc[2][2][4][2];
#pragma unroll
    for (int a = 0; a < 2; ++a)
#pragma unroll
        for (int b = 0; b < 2; ++b)
#pragma unroll
            for (int m = 0; m < 4; ++m)
#pragma unroll
                for (int n = 0; n < 2; ++n) acc[a][b][m][n] = (f32x4){0.f, 0.f, 0.f, 0.f};
    bf16x8 At[4][2], B0[2][2], B1[2][2];
    const char* cA = S.abase(cur); const char* cB = S.bbase(cur);
    S.a_ready(cur);
    if constexpr (SP2) {
        PG8_STAGE(PG8_SB(0, 0), cB, voffB); PG8_STAGE(PG8_SB(0, 1), cB + hstep, voffB); PG8_STAGE(PG8_SA(0, 0), cA, voffA); PG8_STAGE(PG8_SA(0, 1), cA + hstep, voffA);
        if (wr == 1) PG8_BAR;
        PG8_WAIT_V(2); PG8_BAR;
        PG8_STAGE(PG8_SB(1, 0), cB + kstep, voffB); PG8_STAGE(PG8_SA(1, 0), cA + kstep, voffA); PG8_STAGE(PG8_SB(1, 1), cB + hstep + kstep, voffB);
        PG8_WAIT_V(6); PG8_BAR;
    } else {
        PG8_STAGE(PG8_SB(0, 0), cB, voffB); PG8_STAGE(PG8_SA(0, 0), cA, voffA); PG8_STAGE(PG8_SB(0, 1), cB + hstep, voffB); PG8_STAGE(PG8_SA(0, 1), cA + hstep, voffA);
        if (wr == 1) PG8_BAR;
        PG8_WAIT_V(4); PG8_BAR;
        PG8_STAGE(PG8_SB(1, 0), cB + kstep, voffB); PG8_STAGE(PG8_SA(1, 0), cA + kstep, voffA); PG8_STAGE(PG8_SB(1, 1), cB + hstep + kstep, voffB);
        PG8_WAIT_V(6); PG8_BAR;
    }
    for (;;) {
        const bool has_next = S.next(ui + 1, nxt);
        const char* nA = has_next ? S.abase(nxt) : cA; const char* nB = has_next ? S.bbase(nxt) : cB;
        for (int t = 0; t < nt; t += 2) {
            if constexpr (Epi::HAS_MID) { if (t == 8 || t == 16) E.mid(acc, cur, t >> 3, wr, wc, fr, fq); }
            const bool last = (t == nt - 2);
            const char* a1 = cA + (size_t)(t + 1) * kstep;
            const char* a2 = last ? nA : cA + (size_t)(t + 2) * kstep; const char* b2 = last ? nB : cB + (size_t)(t + 2) * kstep;
            const char* a3 = a2 + kstep; const char* b3 = b2 + kstep;
            if (last && has_next) S.a_ready(nxt);
            if constexpr (SP2) {
            PG8_LDB(B0, 0, 0); PG8_LDB(B1, 0, 1); PG8_SCHED; PG8_LDA(At, 0, 0); PG8_STAGE(PG8_SA(1, 1), a1 + hstep, voffA);
            PG8_WAIT_V(8); PG8_WAIT_L(0); PG8_BAR; PG8_MMA(0, 0, At, B0); PG8_MMA(0, 1, At, B1); PG8_BAR; PG8_SCHED;
            PG8_LDA(At, 0, 1); PG8_STAGE(PG8_SB(0, 0), b2, voffB); PG8_STAGE(PG8_SB(0, 1), b2 + hstep, voffB); PG8_STAGE(PG8_SA(0, 0), a2, voffA);
            PG8_WAIT_V(8); PG8_WAIT_L(0); PG8_BAR; PG8_MMA(1, 0, At, B0); PG8_MMA(1, 1, At, B1); PG8_BAR; PG8_SCHED;
            PG8_LDB(B0, 1, 0); PG8_LDB(B1, 1, 1); PG8_SCHED; PG8_LDA(At, 1, 0); PG8_STAGE(PG8_SA(0, 1), a2 + hstep, voffA);
            PG8_WAIT_V(8); PG8_WAIT_L(0); PG8_BAR; PG8_MMA(0, 0, At, B0); PG8_MMA(0, 1, At, B1); PG8_BAR; PG8_SCHED;
            PG8_LDA(At, 1, 1); PG8_STAGE(PG8_SB(1, 0), b3, voffB); PG8_STAGE(PG8_SB(1, 1), b3 + hstep, voffB); PG8_STAGE(PG8_SA(1, 0), a3, voffA);
            PG8_WAIT_V(8); PG8_WAIT_L(0); PG8_BAR; PG8_MMA(1, 0, At, B0); PG8_MMA(1, 1, At, B1); PG8_BAR; PG8_SCHED;
            } else {
            PG8_LDB(B0, 0, 0); PG8_SCHED; PG8_LDA(At, 0, 0); PG8_STAGE(PG8_SA(1, 1), a1 + hstep, voffA);
            PG8_WAIT_L(8); PG8_BAR; PG8_WAIT_L(0); PG8_MMA(0, 0, At, B0); PG8_BAR; PG8_SCHED;
            PG8_LDB(B1, 0, 1); PG8_STAGE(PG8_SB(0, 0), b2, voffB);
            PG8_BAR; PG8_WAIT_L(0); PG8_MMA(0, 1, At, B1); PG8_BAR;
            PG8_LDA(At, 0, 1); PG8_STAGE(PG8_SA(0, 0), a2, voffA);
            PG8_BAR; PG8_WAIT_L(0); PG8_MMA(1, 0, At, B0); PG8_BAR; PG8_SCHED;
            PG8_STAGE(PG8_SB(0, 1), b2 + hstep, voffB);
            PG8_WAIT_V(6); PG8_BAR; PG8_MMA(1, 1, At, B1); PG8_BAR;
            PG8_LDB(B0, 1, 0); PG8_SCHED; PG8_LDA(At, 1, 0); PG8_STAGE(PG8_SA(0, 1), a2 + hstep, voffA);
            PG8_WAIT_L(8); PG8_BAR; PG8_WAIT_L(0); PG8_MMA(0, 0, At, B0); PG8_BAR; PG8_SCHED;
            PG8_LDB(B1, 1, 1); PG8_STAGE(PG8_SB(1, 0), b3, voffB);
            PG8_BAR; PG8_WAIT_L(0); PG8_MMA(0, 1, At, B1); PG8_BAR;
            PG8_LDA(At, 1, 1); PG8_STAGE(PG8_SA(1, 0), a3, voffA);
            PG8_BAR; PG8_WAIT_L(0); PG8_MMA(1, 0, At, B0); PG8_BAR; PG8_SCHED;
            PG8_STAGE(PG8_SB(1, 1), b3 + hstep, voffB);
            PG8_WAIT_V(6); PG8_BAR; PG8_MMA(1, 1, At, B1); PG8_BAR;
            }
        }
        if constexpr (ALIGN_EPI) { if (wr == 0) PG8_BAR; }
        if constexpr (!Epi::AFTER_DRAIN) { E(acc, cur, wr, wc, fr, fq); S.done(cur); }
        if (!has_next) break;
#pragma unroll
        for (int a = 0; a < 2; ++a)
#pragma unroll
            for (int b = 0; b < 2; ++b)
#pragma unroll
                for (int m = 0; m < 4; ++m)
#pragma unroll
                    for (int n = 0; n < 2; ++n) acc[a][b][m][n] = (f32x4){0.f, 0.f, 0.f, 0.f};
        cur = nxt; cA = nA; cB = nB; ++ui;
        if constexpr (ALIGN_EPI) { if (wr == 1) PG8_BAR; }
    }
    PG8_WAIT_V(0);
    if constexpr (!ALIGN_EPI) { if (wr == 0) PG8_BAR; }
    PG8_BAR;
    if constexpr (Epi::AFTER_DRAIN) { E.fused(acc, cur, wr, wc, fr, fq, lds, wid, lane); S.done(cur); }
#undef PG8_SA
#undef PG8_SB
#undef PG8_STAGE
#undef PG8_LDA
#undef PG8_LDB
#undef PG8_MMA
#undef PG8_WAIT_V
#undef PG8_WAIT_L
#undef PG8_BAR
#undef PG8_SCHED
}
}

constexpr int NWAVES = 8;
constexpr int N_LAUNCHES = MK_N_LAUNCHES;
constexpr int PER_PHASE = 9;
constexpr int NBATCH = 4, SEQ = 8192, D = 1024, T = NBATCH * SEQ, MEMLEN = 256, NMEMTOK = NBATCH * MEMLEN;
constexpr int IN_MAIN = 5120;
constexpr int NEXP = 16384;

constexpr size_t MiB = 1u << 20;
constexpr size_t WS_CTL = 0, CTL_ZERO_BYTES = 512 * 1024;
constexpr size_t WS_ROWSQ = 256 * 1024;
constexpr size_t WS_WIN = 1 * MiB, WS_WV = 11 * MiB, WS_WKV = 12 * MiB, WS_WBR = 14 * MiB, WS_WOUT = 17 * MiB, WS_WQ = 19 * MiB, WS_KEYS = 23 * MiB, WS_PWT = 23 * MiB + 512 * 1024;
constexpr size_t WS_MEMN = 24 * MiB, WS_KMEM = 26 * MiB, WS_VTMEM = 27 * MiB, WS_RSTDX = 28 * MiB, WS_SU = 28 * MiB + 256 * 1024  , WS_SV = 28 * MiB + 512 * 1024  ;
constexpr size_t WS_U8 = 32 * MiB, WS_V8 = 48 * MiB;
constexpr size_t WS_QN = 96 * MiB, WS_KN = 128 * MiB, WS_VT = 160 * MiB, WS_PP = 192 * MiB, WS_XQ = 224 * MiB, WS_GATE = 256 * MiB, WS_XB = 448 * MiB  , WS_END = 512 * MiB;
constexpr size_t WS_MERGED = WS_QN;
constexpr size_t WS_HB = WS_VT;
constexpr size_t WS_QB = WS_GATE;
constexpr size_t WS_TE = WS_GATE + 128 * MiB, WS_TW = WS_TE + 16 * MiB;
constexpr size_t WS_HQ = WS_TW + 16 * MiB;
constexpr size_t WS_HS = 28 * MiB + 768 * 1024;
constexpr size_t WS_AW = WS_MERGED;
constexpr size_t OUT_XB = 0, OUT_YNA = 0, OUT_YPOOL = 512 * 2, OUT_YXA = 1024 * 2;
constexpr int CW_TMO = 0, CW_BAR = 4096, CW_TICKET = 8192;

constexpr int RING_OFF = 0, RING_BYTES = 131072;
constexpr int LDSCTL_OFF = RING_BYTES, MISC_OFF = LDSCTL_OFF + 320;
constexpr int LDS_BYTES = 147456;

#define GAS __attribute__((address_space(1)))
#define LAS __attribute__((address_space(3)))
typedef unsigned short bf16;
typedef unsigned v4u __attribute__((ext_vector_type(4)));
typedef unsigned v2u __attribute__((ext_vector_type(2)));
typedef float f32x4 __attribute__((ext_vector_type(4)));
typedef short bf16x8 __attribute__((ext_vector_type(8)));
typedef __bf16 bf16x2_t __attribute__((ext_vector_type(2)));
typedef GAS unsigned gu32;
#define LDS_WAIT() asm volatile("s_waitcnt lgkmcnt(0)" ::: "memory")
#define VM_WAIT() asm volatile("s_waitcnt vmcnt(0)" ::: "memory")
__device__ __forceinline__ unsigned f2bf(float f) { unsigned u = __builtin_bit_cast(unsigned, f); return (u + 0x7fffu + ((u >> 16) & 1u)) >> 16; }
__device__ __forceinline__ unsigned pk2(float lo, float hi) { return f2bf(lo) | (f2bf(hi) << 16); }
__device__ __forceinline__ float bflo(unsigned u) { return __builtin_bit_cast(float, u << 16); }
__device__ __forceinline__ float bfhi(unsigned u) { return __builtin_bit_cast(float, u & 0xffff0000u); }
__device__ __forceinline__ float bf1(short s) { return __builtin_bit_cast(float, ((unsigned)(unsigned short)s) << 16); }
__device__ __forceinline__ f32x4 mfma16(bf16x8 a, bf16x8 b, f32x4 c) { return __builtin_amdgcn_mfma_f32_16x16x32_bf16(a, b, c, 0, 0, 0); }
__device__ __forceinline__ float wave_sum(float v) {
#pragma unroll
    for (int o = 1; o < 64; o <<= 1) v += __shfl_xor(v, o);
    return v;
}

#define XB_TMO      128
#define XB_XCNT(j)  (256  + 64 * (j))
#define XB_XSUB(j)  (1280 + 64 * (j))
#define XB_XGEN(j)  (2304 + 64 * (j))
#define XB_TOP      3328
#define XB_TOPGEN   3392
#define XCD_BAR_WORDS 3456
#define XB_SPIN_CAP (1u << 18)

__device__ __forceinline__ unsigned xb_ld(unsigned* p)              { return __hip_atomic_load(p, __ATOMIC_RELAXED, __HIP_MEMORY_SCOPE_AGENT); }
__device__ __forceinline__ unsigned xb_add(unsigned* p, unsigned v) { return __hip_atomic_fetch_add(p, v, __ATOMIC_RELAXED, __HIP_MEMORY_SCOPE_AGENT); }
__device__ __forceinline__ unsigned xb_xcc_id() { return (unsigned)__builtin_amdgcn_s_getreg((3 << 11) | 20) & 0xFu; }
#define XB_SPIN(cond, bar) do { unsigned _sp = 0; while (cond) { __builtin_amdgcn_s_sleep(1); \
    if ((++_sp & 255u) == 0u) { if (xb_ld(&(bar)[XB_TMO])) break; if (_sp > XB_SPIN_CAP) { atomicAdd(&(bar)[XB_TMO], 1u); break; } } } } while (0)

struct XcdBarrier {
    unsigned* bar; unsigned x;
    volatile LAS unsigned* st;
};

__device__ __forceinline__ XcdBarrier xcd_barrier_post(unsigned* bar, volatile LAS unsigned* st) {
    XcdBarrier b; b.bar = bar; b.x = xb_xcc_id(); b.st = st;
    if (threadIdx.x == 0) (void)xb_add(&bar[XB_XCNT(b.x)], 1u);
    return b;
}
__device__ __forceinline__ void xcd_barrier_complete(unsigned* bar, unsigned x, unsigned& nloc, unsigned& nx) {
    const unsigned G = gridDim.x * gridDim.y * gridDim.z;
    unsigned sum, cnt, mine, sp = 0u;
    for (;;) {
        sum = 0u; cnt = 0u; mine = 0u;
#pragma unroll
        for (unsigned j = 0; j < 16; ++j) { const unsigned c = xb_ld(&bar[XB_XCNT(j)]); sum += c; cnt += (c > 0u) ? 1u : 0u; mine = (j == x) ? c : mine; }
        if (sum == G) break;
        __builtin_amdgcn_s_sleep(1);
        if ((++sp & 255u) == 0u) { if (xb_ld(&bar[XB_TMO])) break; if (sp > XB_SPIN_CAP) { atomicAdd(&bar[XB_TMO], 1u); break; } }
    }
    nloc = mine > 0u ? mine : 1u; nx = cnt > 0u ? cnt : 1u;
}

__device__ __forceinline__ void xcd_barrier(const XcdBarrier& b) {
    asm volatile("s_waitcnt vmcnt(0)" ::: "memory");
    __syncthreads();
    if (threadIdx.x == 0) {
        unsigned* bar = b.bar;
        __builtin_amdgcn_s_waitcnt(0);
        unsigned nloc = b.st[0], nx = b.st[1];
        if (nloc == 0u) { xcd_barrier_complete(bar, b.x, nloc, nx); b.st[0] = nloc; b.st[1] = nx; }
        const unsigned old = xb_add(&bar[XB_XSUB(b.x)], 1u);
        const unsigned gen = old / nloc;
        if (old + 1u == (gen + 1u) * nloc) {
            __builtin_amdgcn_fence(__ATOMIC_RELEASE, "agent");
            asm volatile("s_waitcnt vmcnt(0)" ::: "memory");
            const unsigned og = xb_add(&bar[XB_TOP], 1u);
            const unsigned tg = og / nx;
            if (og + 1u == (tg + 1u) * nx) xb_add(&bar[XB_TOPGEN], 1u);
            else XB_SPIN(xb_ld(&bar[XB_TOPGEN]) == tg, bar);
            __builtin_amdgcn_fence(__ATOMIC_ACQUIRE, "agent");
            xb_add(&bar[XB_XGEN(b.x)], 1u);
            asm volatile("s_waitcnt vmcnt(0)" ::: "memory");
        } else {
            XB_SPIN(xb_ld(&bar[XB_XGEN(b.x)]) == gen, bar);
            __builtin_amdgcn_fence(__ATOMIC_ACQUIRE, "agent");
            asm volatile("s_waitcnt vmcnt(0)" ::: "memory");
        }
    }
    __syncthreads();
}

struct Frame {
    LAS unsigned char* lds;
    volatile LAS unsigned* MISC;
    gu32* ctl;
    int tid, lane, wave, vcu, G;
    float* out; unsigned char* ws;
};
struct Args { const float* in[23]; float* out; unsigned char* ws; int ph_lo, ph_hi, probe, pad; };
enum { I_X = 0, I_MEM, I_MIXG, I_MEMG, I_WIN, I_GATEB, I_WKV, I_NAQG, I_NAKG, I_RPB, I_POOLW, I_POOLSC, I_XAQG, I_XAKG, I_WB0, I_WB1, I_WB2, I_WOUT, I_FFNG, I_WQ, I_KEYS, I_PU, I_PV };

__device__ __forceinline__ void p0_transpose_item(const float* W, int K, int N, int k0, int n0, bf16* dst, const float* kscale, LAS float* scr, int lane, int dpitch = 0) {
    if (dpitch == 0) dpitch = K;
#pragma unroll 8
    for (int i = 0; i < 32; ++i) { const int kk = 2 * i + (lane >> 5); float v = W[(size_t)(k0 + kk) * N + n0 + (lane & 31)]; if (kscale) v *= kscale[k0 + kk]; scr[kk * 33 + (lane & 31)] = v; }
    LDS_WAIT(); asm volatile("" ::: "memory");
    const int c = lane & 7;
#pragma unroll
    for (int j = 0; j < 4; ++j) { const int n = (lane >> 3) + 8 * j; const LAS float* s = scr + (8 * c) * 33 + n;
        v4u o; o.x = pk2(s[0 * 33], s[1 * 33]); o.y = pk2(s[2 * 33], s[3 * 33]); o.z = pk2(s[4 * 33], s[5 * 33]); o.w = pk2(s[6 * 33], s[7 * 33]);
        *(GAS v4u*)(dst + (size_t)n * dpitch + k0 + 8 * c) = o; }
    LDS_WAIT(); asm volatile("" ::: "memory");
}
__device__ __forceinline__ void cvt_row1024(const float* src, bf16* dst, const float* colscale, float rowscale, int lane) {
    const GAS f32x4* xr = (const GAS f32x4*)src + lane; GAS unsigned long long* o8 = (GAS unsigned long long*)dst + lane;
#pragma unroll
    for (int j = 0; j < 4; ++j) { f32x4 v = xr[64 * j] * rowscale; if (colscale) v = v * ((const GAS f32x4*)colscale)[lane + 64 * j];
        o8[64 * j] = (unsigned long long)pk2(v.x, v.y) | ((unsigned long long)pk2(v.z, v.w) << 32); }
}
__device__ __forceinline__ float row_rstd1024(const float* src, int lane) {
    const GAS f32x4* xr = (const GAS f32x4*)src + lane; float s = 0.f;
#pragma unroll
    for (int j = 0; j < 4; ++j) { const f32x4 v = xr[64 * j]; s += (v.x * v.x + v.y * v.y) + (v.z * v.z + v.w * v.w); }
    return rsqrtf(wave_sum(s) * (1.0f / 1024.0f) + 1e-6f);
}
__device__ __forceinline__ void p0_prologue(Frame& F, const Args& A) {
    LAS float* scr = (LAS float*)(F.lds + RING_OFF + F.wave * 16384);
    const int gw = F.vcu * NWAVES + F.wave, NGW = F.G * NWAVES, lane = F.lane;
    unsigned char* ws = F.ws;
    constexpr int I_IN = 16 * 176, I_KV = 16 * 32, I_BR = 8 * 32, I_OUT = 16 * 32, I_Q = 16 * 64;
    constexpr int NITEMS = I_IN + I_KV + 3 * I_BR + I_OUT + I_Q;
    if (!(A.probe & 1)) for (int it = gw; it < NITEMS; it += NGW) {
        int r = it;
        if (r < I_IN) { const int kb = r / 176, nb = r % 176, n0 = 32 * nb; bf16* dst;
            if (n0 >= 1024 && n0 < 1536) dst = (bf16*)(ws + WS_WV) + (size_t)(n0 - 1024) * 1024;
            else { const int np = n0 < 1024 ? n0 : n0 - 512, t = np >> 8, w = np & 255, wc = w >> 6, bj = (w >> 5) & 1; dst = (bf16*)(ws + WS_WIN) + (size_t)(256 * t + 128 * bj + 32 * wc) * 1024; }
            p0_transpose_item(A.in[I_WIN], 1024, 5632, 64 * kb, n0, dst, A.in[I_MIXG], scr, lane); continue; }
        r -= I_IN;
        if (r < I_KV) { const int kb = r / 32, nb = r % 32; p0_transpose_item(A.in[I_WKV], 1024, 1024, 64 * kb, 32 * nb, (bf16*)(ws + WS_WKV) + (size_t)(32 * nb) * 1024, nullptr, scr, lane); continue; }
        r -= I_KV;
        if (r < 3 * I_BR) { const int br = r / I_BR, rr = r % I_BR, kb = rr / 32, nb = rr % 32; const float* W = br == 0 ? A.in[I_WB0] : (br == 1 ? A.in[I_WB1] : A.in[I_WB2]);
            p0_transpose_item(W, 512, 1024, 64 * kb, 32 * nb, (bf16*)(ws + WS_WBR) + (size_t)(32 * nb) * 1536 + br * 512, nullptr, scr, lane, 1536); continue; }
        r -= 3 * I_BR;
        if (r < I_OUT) { const int kb = r / 32, nb = r % 32; p0_transpose_item(A.in[I_WOUT], 1024, 1024, 64 * kb, 32 * nb, (bf16*)(ws + WS_WOUT) + (size_t)(32 * nb) * 1024, nullptr, scr, lane); continue; }
        r -= I_OUT;
        { const int kb = r / 64, nb = r % 64; p0_transpose_item(A.in[I_WQ], 1024, 2048, 64 * kb, 32 * nb, (bf16*)(ws + WS_WQ) + (size_t)(32 * nb) * 1024, A.in[I_FFNG], scr, lane); }
    }
    { bf16* xb = (bf16*)(ws + WS_XB); float* rstdx = (float*)(ws + WS_RSTDX);
      if (!(A.probe & 2)) for (int m0 = 4 * gw; m0 < T; m0 += 4 * NGW) {
          f32x4 v[4][4];
#pragma unroll
          for (int r = 0; r < 4; ++r)
#pragma unroll
              for (int j = 0; j < 4; ++j) v[r][j] = ((const GAS f32x4*)(A.in[I_X] + (size_t)(m0 + r) * D))[lane + 64 * j];
#pragma unroll
          for (int r = 0; r < 4; ++r) { float s = 0.f;
#pragma unroll
              for (int j = 0; j < 4; ++j) s += (v[r][j].x * v[r][j].x + v[r][j].y * v[r][j].y) + (v[r][j].z * v[r][j].z + v[r][j].w * v[r][j].w);
              const float rs = rsqrtf(wave_sum(s) * (1.0f / 1024.0f) + 1e-6f);
              GAS unsigned long long* o8 = (GAS unsigned long long*)(xb + (size_t)(m0 + r) * D) + lane;
#pragma unroll
              for (int j = 0; j < 4; ++j) o8[64 * j] = (unsigned long long)pk2(v[r][j].x, v[r][j].y) | ((unsigned long long)pk2(v[r][j].z, v[r][j].w) << 32);
              if (lane == 0) rstdx[m0 + r] = rs; } } }
    for (int m = gw; m < NMEMTOK; m += NGW) { const float* xr = A.in[I_MEM] + (size_t)m * D; const float rs = row_rstd1024(xr, lane); cvt_row1024(xr, (bf16*)(ws + WS_MEMN) + (size_t)m * D, A.in[I_MEMG], rs, lane); }
    if (!(A.probe & 4)) for (int mb = 4 * gw; mb < 2 * NEXP; mb += 4 * NGW) {
        const bool isu = mb < NEXP; const int e0 = isu ? mb : mb - NEXP;
        f32x4 v[4][4];
#pragma unroll
        for (int r = 0; r < 4; ++r) { const GAS f32x4* src = (const GAS f32x4*)((isu ? A.in[I_PU] : A.in[I_PV]) + (size_t)(e0 + r) * D) + 4 * lane;
#pragma unroll
            for (int d = 0; d < 4; ++d) v[r][d] = src[d]; }
        f32x4 gv[4];
#pragma unroll
        for (int d = 0; d < 4; ++d) gv[d] = isu ? ((const GAS f32x4*)A.in[I_FFNG])[4 * lane + d] : (f32x4){1.f, 1.f, 1.f, 1.f};
#pragma unroll
        for (int r = 0; r < 4; ++r) { const int e = e0 + r; float mx = 0.f;
#pragma unroll
            for (int d = 0; d < 4; ++d) { v[r][d] = v[r][d] * gv[d]; mx = fmaxf(mx, fmaxf(fmaxf(fabsf(v[r][d].x), fabsf(v[r][d].y)), fmaxf(fabsf(v[r][d].z), fabsf(v[r][d].w)))); }
#pragma unroll
            for (int o = 1; o < 64; o <<= 1) mx = fmaxf(mx, __shfl_xor(mx, o));
            const float inv = mx > 0.f ? 127.0f / mx : 0.f;
            v4u w;
#pragma unroll
            for (int d = 0; d < 4; ++d) { const unsigned b0 = (unsigned)(int)rintf(v[r][d].x * inv) & 0xffu, b1 = (unsigned)(int)rintf(v[r][d].y * inv) & 0xffu,
                                                         b2 = (unsigned)(int)rintf(v[r][d].z * inv) & 0xffu, b3 = (unsigned)(int)rintf(v[r][d].w * inv) & 0xffu;
                w[d] = b0 | (b1 << 8) | (b2 << 16) | (b3 << 24); }
            if (isu) ((GAS v4u*)(ws + WS_U8))[(size_t)e * 64 + lane] = w;
            else *(GAS v4u*)(ws + WS_V8 + (size_t)(lane >> 3) * (2 * MiB) + (size_t)e * 128 + (lane & 7) * 16) = w;
            if (lane == 0) ((float*)(ws + WS_SU))[2 * e + (isu ? 0 : 1)] = mx * (1.0f / 127.0f); }
    }
    for (int m = gw * 64 + lane; m < T; m += NGW * 64) ((float*)(ws + WS_ROWSQ))[m] = 0.f;
    for (int m = gw; m < 256; m += NGW) cvt_row1024(A.in[I_KEYS] + (size_t)m * 1024, (bf16*)(ws + WS_KEYS) + (size_t)m * 1024, nullptr, 1.0f, lane);
    for (int m = gw; m < 1024; m += NGW) { const int gd = m >> 1, c = (m & 1) * 64 + lane, g = gd >> 7, d = gd & 127;
        const float v = A.in[I_POOLW][(size_t)(g * 128 + c) * 128 + d] * A.in[I_POOLSC][gd];
        ((bf16*)(ws + WS_PWT))[(size_t)gd * 128 + c] = (bf16)f2bf(v); }
}

__device__ __forceinline__ void memkv_tile(const bf16* memn, const bf16* wkvT, const float* kg, const float* qg, bf16* kmem, bf16* vtmem, LAS float* part, int tile, int kc, int lane) {
    const int q = lane & 15, hi = lane >> 4, rg = (tile < 0 ? 0 : tile) >> 3, cg = (tile < 0 ? 0 : tile) & 7, r0 = rg * 16, c0 = cg * 128;
    f32x4 acc[8];
#pragma unroll
    for (int i = 0; i < 8; ++i) acc[i] = (f32x4){0.f, 0.f, 0.f, 0.f};
    const bf16* ap = memn + (size_t)(r0 + q) * 1024 + 8 * hi; const bf16* bp = wkvT + (size_t)(c0 + q) * 1024 + 8 * hi;
    if (tile >= 0)
#pragma unroll 1
    for (int kb = 2 * kc; kb < 2 * kc + 2; ++kb) {
        bf16x8 a[4], b[4][8];
#pragma unroll
        for (int k4 = 0; k4 < 4; ++k4) { a[k4] = *(const bf16x8*)(ap + 32 * (4 * kb + k4));
#pragma unroll
            for (int nf = 0; nf < 8; ++nf) b[k4][nf] = *(const bf16x8*)(bp + (size_t)(16 * nf) * 1024 + 32 * (4 * kb + k4)); }
        __builtin_amdgcn_sched_barrier(0);
#pragma unroll
        for (int k4 = 0; k4 < 4; ++k4)
#pragma unroll
            for (int nf = 0; nf < 8; ++nf) acc[nf] = mfma16(a[k4], b[k4][nf], acc[nf]);
        __builtin_amdgcn_sched_barrier(0);
    }
    if (tile >= 0 && kc > 0) {
#pragma unroll
        for (int nf = 0; nf < 8; ++nf) *(LAS f32x4*)(part + ((kc - 1) * 8 + nf) * 256 + 4 * lane) = acc[nf]; }
    __syncthreads();
    if (tile < 0 || kc > 0) return;
#pragma unroll
    for (int p = 0; p < 3; ++p)
#pragma unroll
        for (int nf = 0; nf < 8; ++nf) acc[nf] = acc[nf] + *(const LAS f32x4*)(part + (p * 8 + nf) * 256 + 4 * lane);
    if (cg < 4) {
        float rr[4];
#pragma unroll
        for (int g = 0; g < 4; ++g) { float ss = 0.f;
#pragma unroll
            for (int nf = 0; nf < 8; ++nf) ss += acc[nf][g] * acc[nf][g];
            ss += __shfl_xor(ss, 1); ss += __shfl_xor(ss, 2); ss += __shfl_xor(ss, 4); ss += __shfl_xor(ss, 8);
            rr[g] = rsqrtf(ss * (1.0f / 128.0f) + 1e-6f); }
#pragma unroll
        for (int nf = 0; nf < 8; ++nf) { const int d = 16 * nf + q; const float gs = kg[d] * qg[d];
#pragma unroll
            for (int g = 0; g < 4; ++g) kmem[(size_t)(r0 + 4 * hi + g) * 512 + cg * 128 + d] = (bf16)f2bf(acc[nf][g] * rr[g] * gs); }
    } else {
        const int h = cg - 4, b = r0 >> 8, key0 = (r0 & 255) + 4 * hi;
#pragma unroll
        for (int nf = 0; nf < 8; ++nf) { const int d = 16 * nf + q; v2u w; w.x = pk2(acc[nf][0], acc[nf][1]); w.y = pk2(acc[nf][2], acc[nf][3]);
            *(v2u*)(vtmem + (size_t)(b * 512 + h * 128 + d) * 256 + key0) = w; }
    }
}

__device__ __forceinline__ void na_item(const bf16* __restrict__ qn, const bf16* __restrict__ kn, const bf16* __restrict__ vt, const LAS float* rpl, bf16* __restrict__ yna,
                                        int b, int r, int jb, int h, int lane) {
    const int q = lane & 15, hi = lane >> 4;
    int rs = r - 4; rs = rs < 0 ? 0 : (rs > 120 ? 120 : rs);
    int kb0 = jb * 16 - 8; kb0 = kb0 < 0 ? 0 : (kb0 > 32 ? 32 : kb0);
    const int qcol = jb * 16 + q; int cs = qcol - 8; cs = cs < 0 ? 0 : (cs > 48 ? 48 : cs);
    const size_t tokq = (size_t)b * SEQ + r * 64 + qcol;
    const bf16* qp = qn + tokq * 512 + h * 64 + 8 * hi;
    const bf16x8 qf0 = *(const bf16x8*)qp, qf1 = *(const bf16x8*)(qp + 32);
    const int kq = 8 * (q >> 2) + (q & 3);
    const bf16* kbase = kn + ((size_t)b * SEQ + rs * 64 + kb0 + kq) * 512 + h * 64 + 8 * hi;
    f32x4 s[16];
    {
        bf16x8 ka[16][2];
#pragma unroll
        for (int f = 0; f < 16; ++f) { const bf16* kp = kbase + (size_t)((f >> 1) * 64 + (f & 1) * 4) * 512; ka[f][0] = *(const bf16x8*)kp; ka[f][1] = *(const bf16x8*)(kp + 32); }
        __builtin_amdgcn_sched_barrier(0);
#pragma unroll
        for (int f = 0; f < 16; ++f) { f32x4 z = (f32x4){0.f, 0.f, 0.f, 0.f}; z = mfma16(ka[f][0], qf0, z); s[f] = mfma16(ka[f][1], qf1, z); }
    }
    const bf16* vbase = vt + ((size_t)(b * 512 + h * 64 + q) * SEQ + rs * 64 + kb0 + 8 * hi);
    bf16x8 va[8][4];
#pragma unroll
    for (int st = 0; st < 8; ++st)
#pragma unroll
        for (int mf = 0; mf < 4; ++mf) va[st][mf] = *(const bf16x8*)(vbase + (size_t)(16 * mf) * SEQ + st * 64);
    __builtin_amdgcn_sched_barrier(0);
    float mx = -3.0e38f;
#pragma unroll
    for (int c4 = 0; c4 < 4; ++c4) {
        float bb[4][4];
#pragma unroll
        for (int ff = 0; ff < 4; ++ff) { const int f = 4 * c4 + ff, dr = rs + (f >> 1) - r + 7;
#pragma unroll
            for (int g = 0; g < 4; ++g) { const int kcol = kb0 + 8 * hi + 4 * (f & 1) + g; int dc = kcol - qcol + 15; dc = dc < 0 ? 0 : (dc > 30 ? 30 : dc); bb[ff][g] = rpl[dr * 31 + dc]; } }
        __builtin_amdgcn_sched_barrier(0);
#pragma unroll
        for (int ff = 0; ff < 4; ++ff) { const int f = 4 * c4 + ff;
#pragma unroll
            for (int g = 0; g < 4; ++g) { const int kcol = kb0 + 8 * hi + 4 * (f & 1) + g; const bool ok = (kcol >= cs) && (kcol < cs + 16);
                const float v = ok ? s[f][g] + bb[ff][g] : -1.0e30f; s[f][g] = v; mx = fmaxf(mx, v); } }
    }
    mx = fmaxf(mx, __shfl_xor(mx, 16)); mx = fmaxf(mx, __shfl_xor(mx, 32));
    float sum = 0.f;
#pragma unroll
    for (int f = 0; f < 16; ++f)
#pragma unroll
        for (int g = 0; g < 4; ++g) { const float p = __expf(s[f][g] - mx); s[f][g] = p; sum += p; }
    sum += __shfl_xor(sum, 16); sum += __shfl_xor(sum, 32);
    const float inv = 1.0f / sum;
    f32x4 o[4];
#pragma unroll
    for (int i = 0; i < 4; ++i) o[i] = (f32x4){0.f, 0.f, 0.f, 0.f};
#pragma unroll
    for (int st = 0; st < 8; ++st) {
        const bf16x8 pb = __builtin_bit_cast(bf16x8, pg8::pack8(s[2 * st], s[2 * st + 1]));
#pragma unroll
        for (int mf = 0; mf < 4; ++mf) o[mf] = mfma16(va[st][mf], pb, o[mf]);
    }
    bf16* yp = yna + tokq * 1536 + h * 64 + 4 * hi;
#pragma unroll
    for (int mf = 0; mf < 4; ++mf) { v2u w; w.x = pk2(o[mf][0] * inv, o[mf][1] * inv); w.y = pk2(o[mf][2] * inv, o[mf][3] * inv); *(v2u*)(yp + 16 * mf) = w; }
}
__device__ __forceinline__ void xa_fill_lds(const bf16* __restrict__ kmem, const bf16* __restrict__ vtmem, LAS unsigned char* lds, int b, int h, int tid) {
#pragma unroll
    for (int ps = 0; ps < 8; ++ps) { const int id = tid + 512 * ps, key = id >> 4, c = id & 15;
        *(LAS v4u*)(lds + key * 256 + ((c ^ (key & 15)) << 4)) = *(const v4u*)(kmem + ((size_t)b * 256 + key) * 512 + h * 128 + 8 * c); }
#pragma unroll
    for (int ps = 0; ps < 8; ++ps) { const int id = tid + 512 * ps, dim = id >> 5, c = id & 31;
        *(LAS v4u*)(lds + 65536 + dim * 512 + ((c ^ (dim & 15)) << 4)) = *(const v4u*)(vtmem + (size_t)(b * 512 + h * 128 + dim) * 256 + 8 * c); }
}
__device__ __forceinline__ void xa_item(const bf16* __restrict__ xq, const LAS unsigned char* lds, bf16* __restrict__ yxa, int tok0, int h, int lane) {
    const int q = lane & 15, hi = lane >> 4; const size_t tok = (size_t)tok0 + q;
    const bf16* qp = xq + tok * 512 + h * 128 + 8 * hi;
    bf16x8 qf[4]; float ssq = 0.f;
#pragma unroll
    for (int ks = 0; ks < 4; ++ks) qf[ks] = *(const bf16x8*)(qp + 32 * ks);
    __builtin_amdgcn_sched_barrier(0);
#pragma unroll
    for (int ks = 0; ks < 4; ++ks)
#pragma unroll
        for (int j = 0; j < 8; ++j) { const float v = bf1(qf[ks][j]); ssq += v * v; }
    ssq += __shfl_xor(ssq, 16); ssq += __shfl_xor(ssq, 32);
    const float cexp = rsqrtf(ssq * (1.0f / 128.0f) + 1e-6f) * 0.08838834764831845f * 1.4426950408889634f;
    const int kq = 8 * (q >> 2) + (q & 3);
    f32x4 s[16];
#define XA_KLOAD(buf, fp) do { _Pragma("unroll") for (int f2 = 0; f2 < 2; ++f2) { const int f_ = 2 * (fp) + f2, key = 32 * (f_ >> 1) + 4 * (f_ & 1) + kq; const LAS unsigned char* kr = lds + key * 256; \
        _Pragma("unroll") for (int ks = 0; ks < 4; ++ks) buf[f2][ks] = *(const LAS bf16x8*)(kr + (((4 * ks + hi) ^ (key & 15)) << 4)); } } while (0)
    {
        bf16x8 kbA[2][4], kbB[2][4];
        XA_KLOAD(kbA, 0);
#pragma unroll
        for (int fp = 0; fp < 8; fp += 2) {
            XA_KLOAD(kbB, fp + 1); __builtin_amdgcn_sched_barrier(0);
#pragma unroll
            for (int f2 = 0; f2 < 2; ++f2) { f32x4 z = (f32x4){0.f, 0.f, 0.f, 0.f};
#pragma unroll
                for (int ks = 0; ks < 4; ++ks) z = mfma16(kbA[f2][ks], qf[ks], z);
                s[2 * fp + f2] = z; }
            __builtin_amdgcn_sched_barrier(0);
            if (fp + 2 < 8) XA_KLOAD(kbA, fp + 2);
            __builtin_amdgcn_sched_barrier(0);
#pragma unroll
            for (int f2 = 0; f2 < 2; ++f2) { f32x4 z = (f32x4){0.f, 0.f, 0.f, 0.f};
#pragma unroll
                for (int ks = 0; ks < 4; ++ks) z = mfma16(kbB[f2][ks], qf[ks], z);
                s[2 * (fp + 1) + f2] = z; }
            __builtin_amdgcn_sched_barrier(0);
        }
    }
#undef XA_KLOAD
    float mx = -3.0e38f;
#pragma unroll
    for (int f = 0; f < 16; ++f)
#pragma unroll
        for (int g = 0; g < 4; ++g) mx = fmaxf(mx, s[f][g]);
    mx = fmaxf(mx, __shfl_xor(mx, 16)); mx = fmaxf(mx, __shfl_xor(mx, 32));
    float sum = 0.f;
#pragma unroll
    for (int f = 0; f < 16; ++f)
#pragma unroll
        for (int g = 0; g < 4; ++g) { const float p = __builtin_amdgcn_exp2f((s[f][g] - mx) * cexp); s[f][g] = p; sum += p; }
    sum += __shfl_xor(sum, 16); sum += __shfl_xor(sum, 32);
    const float inv = 1.0f / sum;
    f32x4 o[8];
#pragma unroll
    for (int i = 0; i < 8; ++i) o[i] = (f32x4){0.f, 0.f, 0.f, 0.f};
#define XA_VLOAD(buf, st_) do { _Pragma("unroll") for (int mf = 0; mf < 8; ++mf) { const int dim = 16 * mf + q; buf[mf] = *(const LAS bf16x8*)(lds + 65536 + dim * 512 + (((4 * (st_) + hi) ^ (dim & 15)) << 4)); } } while (0)
    {
        bf16x8 vbA[8], vbB[8];
        XA_VLOAD(vbA, 0);
#pragma unroll
        for (int st = 0; st < 8; st += 2) {
            XA_VLOAD(vbB, st + 1); __builtin_amdgcn_sched_barrier(0);
            { const bf16x8 pb = __builtin_bit_cast(bf16x8, pg8::pack8(s[2 * st], s[2 * st + 1]));
#pragma unroll
              for (int mf = 0; mf < 8; ++mf) o[mf] = mfma16(vbA[mf], pb, o[mf]); }
            __builtin_amdgcn_sched_barrier(0);
            if (st + 2 < 8) XA_VLOAD(vbA, st + 2);
            __builtin_amdgcn_sched_barrier(0);
            { const bf16x8 pb = __builtin_bit_cast(bf16x8, pg8::pack8(s[2 * st + 2], s[2 * st + 3]));
#pragma unroll
              for (int mf = 0; mf < 8; ++mf) o[mf] = mfma16(vbB[mf], pb, o[mf]); }
            __builtin_amdgcn_sched_barrier(0);
        }
    }
#undef XA_VLOAD
    bf16* yp = yxa + tok * 1536 + h * 128 + 4 * hi;
#pragma unroll
    for (int mf = 0; mf < 8; ++mf) { v2u w; w.x = pk2(o[mf][0] * inv, o[mf][1] * inv); w.y = pk2(o[mf][2] * inv, o[mf][3] * inv); *(v2u*)(yp + 16 * mf) = w; }
}
__device__ __forceinline__ void pool_wg(const bf16* __restrict__ pp, const bf16* __restrict__ pwT, bf16* __restrict__ ypool, LAS unsigned char* lds, int tokbase, int wave, int lane) {
    const int q = lane & 15, hi = lane >> 4;
    __syncthreads();
    {
        const int hw = 1 << hi, tw0 = tokbase + 16 * wave, b = tw0 >> 13, t0 = tw0 & 8191;
        const bf16* base = pp + (size_t)b * SEQ * 512 + 8 * lane;
        float s[8];
#pragma unroll
        for (int j = 0; j < 8; ++j) s[j] = 0.f;
#pragma unroll 4
        for (int d = -8; d < 8; ++d) { const int u = t0 + d; const bool ok = (d >= -hw) && (d < hw) && (u >= 0) && (u < SEQ);
            const bf16x8 v = *(const bf16x8*)(base + (size_t)(ok ? u : t0) * 512);
#pragma unroll
            for (int j = 0; j < 8; ++j) s[j] += ok ? bf1(v[j]) : 0.f; }
        LAS unsigned char* tile = lds + wave * 16384;
#pragma unroll 4
        for (int i = 0; i < 16; ++i) { const int t = t0 + i;
            int lo = t - hw; lo = lo < 0 ? 0 : lo; int ht = t + hw; ht = ht > SEQ ? SEQ : ht;
            const float inv = 1.0f / (float)(ht - lo);
            const bool oka = (t + hw) < SEQ, oks = (t - hw) >= 0;
            const bf16x8 sv = *(const bf16x8*)(base + (size_t)t * 512), av = *(const bf16x8*)(base + (size_t)(oka ? t + hw : t) * 512), bv = *(const bf16x8*)(base + (size_t)(oks ? t - hw : t) * 512);
            f32x4 p0, p1;
#pragma unroll
            for (int j = 0; j < 4; ++j) { p0[j] = s[j] * inv - bf1(sv[j]); p1[j] = s[j + 4] * inv - bf1(sv[j + 4]); }
            *(LAS v4u*)(tile + i * 1024 + ((lane ^ (i & 15)) << 4)) = pg8::pack8(p0, p1);
#pragma unroll
            for (int j = 0; j < 8; ++j) s[j] += (oka ? bf1(av[j]) : 0.f) - (oks ? bf1(bv[j]) : 0.f);
        }
    }
    __syncthreads();
#pragma unroll 1
    for (int k = 0; k < 4; ++k) {
        const int pair = wave * 4 + k, g = pair >> 3, mf = pair & 7;
        const bf16* wb = pwT + (size_t)(g * 128 + 16 * mf + q) * 128 + 8 * hi;
        bf16x8 a[4];
#pragma unroll
        for (int ks = 0; ks < 4; ++ks) a[ks] = *(const bf16x8*)(wb + 32 * ks);
#pragma unroll 2
        for (int tg = 0; tg < 8; ++tg) {
            const LAS unsigned char* trow = lds + tg * 16384 + q * 1024; f32x4 o = (f32x4){0.f, 0.f, 0.f, 0.f};
#pragma unroll
            for (int ks = 0; ks < 4; ++ks) { const int c = g * 16 + 4 * ks + hi; o = mfma16(a[ks], *(const LAS bf16x8*)(trow + ((c ^ q) << 4)), o); }
            v2u w; w.x = pk2(o[0], o[1]); w.y = pk2(o[2], o[3]);
            *(v2u*)(ypool + (size_t)(tokbase + 16 * tg + q) * 1536 + g * 128 + 16 * mf + 4 * hi) = w;
        }
    }
    __syncthreads();
}

__device__ __forceinline__ int f2key(float s, int idx, int mask) { int b = __builtin_bit_cast(int, s); b = b >= 0 ? b : (b ^ 0x7fffffff); return (b & ~mask) | idx; }
__device__ __forceinline__ float key2f(int k) { k = k >= 0 ? k : (k ^ 0x7fffffff); return __builtin_bit_cast(float, k); }
#define CE_DESC(x, y) do { const int _h = (x) > (y) ? (x) : (y), _l = (x) > (y) ? (y) : (x); (x) = _h; (y) = _l; } while (0)
__device__ __forceinline__ void sort16(int (&a)[16]) {
#pragma unroll
    for (int ks = 1; ks <= 4; ++ks)
#pragma unroll
        for (int js = ks - 1; js >= 0; --js)
#pragma unroll
            for (int i = 0; i < 16; ++i) { const int k = 1 << ks, j = 1 << js, l = i ^ j;
                if (l > i) { if ((i & k) == 0) CE_DESC(a[i], a[l]); else CE_DESC(a[l], a[i]); } }
}
__device__ __forceinline__ void merge16(int (&a)[16], const int (&b)[16]) {
#pragma unroll
    for (int i = 0; i < 16; ++i) a[i] = a[i] > b[15 - i] ? a[i] : b[15 - i];
#pragma unroll
    for (int js = 3; js >= 0; --js)
#pragma unroll
        for (int i = 0; i < 16; ++i) { const int j = 1 << js, l = i ^ j; if (l > i) CE_DESC(a[i], a[l]); }
}
__device__ __forceinline__ void merge16_lanes(int (&a)[16], int step) { int o[16];
#pragma unroll
    for (int k = 0; k < 16; ++k) o[k] = __shfl_xor(a[k], step);
    merge16(a, o); }
__device__ constexpr int cand_i(int hi, int m) {
    return hi == 0 ? 0
         : hi == 1 ? (m < 8 ? 1 : (m < 13 ? 2 : -1))
         : hi == 2 ? (m < 4 ? 3 : (m < 7 ? 4 : (m < 9 ? 5 : (m < 11 ? 6 : -1))))
         :           (m < 2 ? 7 : (m < 10 ? 8 + (m - 2) : -1));
}
__device__ constexpr int cand_j(int hi, int m) {
    return hi == 0 ? m
         : hi == 1 ? (m < 8 ? m : (m < 13 ? m - 8 : -1))
         : hi == 2 ? (m < 4 ? m : (m < 7 ? m - 4 : (m < 9 ? m - 7 : (m < 11 ? m - 9 : -1))))
         :           (m < 2 ? m : (m < 10 ? 0 : -1));
}
__device__ __forceinline__ void topk_fill_lds(const bf16* __restrict__ keys, LAS unsigned char* lds, int h, int tid) {
#pragma unroll
    for (int ps = 0; ps < 8; ++ps) { const int id = tid + 512 * ps, row = id >> 4, c = id & 15;
        *(LAS v4u*)(lds + row * 256 + ((c ^ (row & 15)) << 4)) = *(const v4u*)(keys + ((size_t)h * 256 + row) * 128 + 8 * c); }
}
struct TopkQ { bf16x8 q[2][4]; };
__device__ __forceinline__ void topk_loadq(TopkQ& Q, const bf16* __restrict__ qb, int tok0, int h, int lane) {
    const size_t tok = (size_t)tok0 + (lane & 15); const int hi = lane >> 4;
#pragma unroll
    for (int p = 0; p < 2; ++p)
#pragma unroll
        for (int ks = 0; ks < 4; ++ks) Q.q[p][ks] = *(const bf16x8*)(qb + tok * 2048 + h * 256 + p * 128 + 32 * ks + 8 * hi);
}
__device__ __forceinline__ void topk_item(const TopkQ& Q, const LAS unsigned char* klds, int* __restrict__ te, float* __restrict__ tw, LAS int* lscr, int tok0, int h, int lane) {
    const int q = lane & 15, hi = lane >> 4; const size_t tok = (size_t)tok0 + q;
    int L[2][16];
#pragma unroll
    for (int p = 0; p < 2; ++p) {
        int B[16];
#define TK_KLOAD(buf, mp) do { _Pragma("unroll") for (int m2 = 0; m2 < 2; ++m2) { const int row = p * 128 + 16 * (2 * (mp) + m2) + q; \
        _Pragma("unroll") for (int ks = 0; ks < 4; ++ks) buf[m2][ks] = *(const LAS bf16x8*)(klds + row * 256 + (((4 * ks + hi) ^ (row & 15)) << 4)); } } while (0)
#define TK_MMA(buf, mp) do { _Pragma("unroll") for (int m2 = 0; m2 < 2; ++m2) { const int mf = 2 * (mp) + m2; f32x4 s = (f32x4){0.f, 0.f, 0.f, 0.f}; \
        _Pragma("unroll") for (int ks = 0; ks < 4; ++ks) s = mfma16(buf[m2][ks], Q.q[p][ks], s); \
          \
        _Pragma("unroll") for (int g = 0; g < 4; ++g) { const int key = f2key(s[g], 16 * mf + 4 * hi + g, 127); if (mf < 4) L[p][4 * mf + g] = key; else B[4 * (mf - 4) + g] = key; } } } while (0)
        { bf16x8 tkA[2][4], tkB[2][4];
          TK_KLOAD(tkA, 0);
          TK_KLOAD(tkB, 1); __builtin_amdgcn_sched_barrier(0); TK_MMA(tkA, 0); __builtin_amdgcn_sched_barrier(0);
          TK_KLOAD(tkA, 2); __builtin_amdgcn_sched_barrier(0); TK_MMA(tkB, 1); __builtin_amdgcn_sched_barrier(0);
          TK_KLOAD(tkB, 3); __builtin_amdgcn_sched_barrier(0); TK_MMA(tkA, 2); __builtin_amdgcn_sched_barrier(0);
          TK_MMA(tkB, 3); }
#undef TK_KLOAD
#undef TK_MMA
        sort16(L[p]); sort16(B); merge16(L[p], B);
        merge16_lanes(L[p], 16); merge16_lanes(L[p], 32);
    }
    float v1[16], v2[16];
#pragma unroll
    for (int k = 0; k < 16; ++k) { v1[k] = key2f(L[0][k]); v2[k] = key2f(L[1][k]); }
    int Fk[16];
#pragma unroll
    for (int m = 0; m < 16; ++m) {
        float sm = v1[0] + v2[m]; int id = 255 - m;
        if (cand_i(1, m) >= 0) { if (hi == 1) { sm = v1[cand_i(1, m) < 0 ? 0 : cand_i(1, m)] + v2[cand_j(1, m) < 0 ? 0 : cand_j(1, m)]; id = 255 - ((cand_i(1, m) << 4) | cand_j(1, m)); } }
        if (cand_i(2, m) >= 0) { if (hi == 2) { sm = v1[cand_i(2, m) < 0 ? 0 : cand_i(2, m)] + v2[cand_j(2, m) < 0 ? 0 : cand_j(2, m)]; id = 255 - ((cand_i(2, m) << 4) | cand_j(2, m)); } }
        if (cand_i(3, m) >= 0) { if (hi == 3) { sm = v1[cand_i(3, m) < 0 ? 0 : cand_i(3, m)] + v2[cand_j(3, m) < 0 ? 0 : cand_j(3, m)]; id = 255 - ((cand_i(3, m) << 4) | cand_j(3, m)); } }
        int key = f2key(sm, id, 255);
        if ((hi == 1 && cand_i(1, m) < 0) || (hi == 2 && cand_i(2, m) < 0) || (hi == 3 && cand_i(3, m) < 0)) key = (int)0x80000000;
        Fk[m] = key;
    }
    sort16(Fk); merge16_lanes(Fk, 16); merge16_lanes(Fk, 32);
    LAS int* my = lscr + lane * 32;
#pragma unroll
    for (int k = 0; k < 16; ++k) { my[k] = L[0][k] & 127; my[16 + k] = L[1][k] & 127; }
    LDS_WAIT(); asm volatile("" ::: "memory");
    float e[16]; float sum = 0.f; const float mx = key2f(Fk[0]);
#pragma unroll
    for (int k = 0; k < 16; ++k) { e[k] = __expf(key2f(Fk[k]) - mx); sum += e[k]; }
    const float inv = 1.0f / sum;
    if (hi == 0) {
        int* tep = te + tok * 128; float* twp = tw + tok * 128;
#pragma unroll
        for (int kk = 0; kk < 16; ++kk) { const int ij = 255 - (Fk[kk] & 255), i = ij >> 4, j = ij & 15, slot = (kk & 7) * 16 + 2 * h + (kk >> 3);
            tep[slot] = my[i] * 128 + my[16 + j]; twp[slot] = e[kk] * inv; }
    }
    LDS_WAIT(); asm volatile("" ::: "memory");
}

__device__ __forceinline__ float ub2f(unsigned v, int b) { return (float)((v >> (8 * b)) & 0xffu); }
struct HqIn { v4u hA, hB; float rsq; };
__device__ __forceinline__ void hq_load(HqIn& in, const bf16* __restrict__ hb, const float* __restrict__ rowsq, int tok, int lane) {
    const bf16* hp = hb + (size_t)tok * 1024 + 16 * lane; in.hA = *(const v4u*)hp; in.hB = *(const v4u*)(hp + 8); in.rsq = rowsq[tok]; }
__device__ __forceinline__ void hq_token(const HqIn& in, unsigned char* __restrict__ hq, float* __restrict__ hs, int tok, int lane) {
    const v4u hA = in.hA, hB = in.hB;
    float hf[16];
#pragma unroll
    for (int d = 0; d < 4; ++d) { hf[2 * d] = bflo(hA[d]); hf[2 * d + 1] = bfhi(hA[d]); hf[8 + 2 * d] = bflo(hB[d]); hf[8 + 2 * d + 1] = bfhi(hB[d]); }
    float amax = 0.f;
#pragma unroll
    for (int j = 0; j < 16; ++j) amax = fmaxf(amax, fabsf(hf[j]));
#pragma unroll
    for (int o = 1; o < 64; o <<= 1) amax = fmaxf(amax, __shfl_xor(amax, o));
    const float hinv = amax > 0.f ? 127.0f / amax : 0.f;
    v4u w;
#pragma unroll
    for (int d = 0; d < 4; ++d) { const unsigned b0 = (unsigned)(int)rintf(hf[4 * d] * hinv) & 0xffu, b1 = (unsigned)(int)rintf(hf[4 * d + 1] * hinv) & 0xffu,
                                                 b2 = (unsigned)(int)rintf(hf[4 * d + 2] * hinv) & 0xffu, b3 = (unsigned)(int)rintf(hf[4 * d + 3] * hinv) & 0xffu;
        w[d] = b0 | (b1 << 8) | (b2 << 16) | (b3 << 24); }
    *(v4u*)(hq + (size_t)tok * 1024 + 16 * lane) = w;
    if (lane == 0) hs[tok] = rsqrtf(in.rsq * (1.0f / 1024.0f) + 1e-6f) * amax * (1.0f / 127.0f);
}
constexpr int PA_SLOTS = 12;
struct PeerA1 { int e; float g; };
struct PeerA2 { v4u ur[3][4]; float su, sv; int cnt, rk; bool m; unsigned long long rem; };
struct PeerAH { v4u hv[4]; float hsc; };
__device__ __forceinline__ void pa_s1(PeerA1& a, const int* __restrict__ te, const float* __restrict__ tw, int tok, int half, int lane) {
    const unsigned o = (unsigned)tok * 128u + 64u * (unsigned)half + (unsigned)lane; a.e = te[o]; a.g = tw[o]; }
__device__ __forceinline__ void pa_s1h(PeerAH& h, const unsigned char* __restrict__ hq, const float* __restrict__ hs, int tok, int lane) {
    const int t = lane & 15;
#pragma unroll
    for (int i = 0; i < 4; ++i) h.hv[i] = *(const v4u*)(hq + ((unsigned)tok * 1024u + 16u * (unsigned)t + 256u * i));
    h.hsc = hs[tok + (int)__builtin_amdgcn_mbcnt_lo(0u, 0u)]; }
template <int MODE> __device__ __forceinline__ void pa_s2(PeerA2& b, const PeerA1& a, const unsigned char* __restrict__ u8, const float* __restrict__ su, LAS int* lst, int x, int lane) {
    b.m = (a.e >> 11) == x;
    const unsigned long long mask = __ballot(b.m);
    b.cnt = __popcll(mask); b.rk = (int)__builtin_amdgcn_mbcnt_hi((unsigned)(mask >> 32), __builtin_amdgcn_mbcnt_lo((unsigned)mask, 0u));
    if (b.m && b.rk < PA_SLOTS) lst[b.rk] = a.e;
    b.rem = 0ull; if (b.cnt > PA_SLOTS) { unsigned long long r = mask;
#pragma unroll
        for (int k = 0; k < PA_SLOTS; ++k) r &= r - 1ull;
        b.rem = r; }
    { typedef float f32x2s __attribute__((ext_vector_type(2))); f32x2s s2 = (f32x2s){0.f, 0.f}; if (b.m) s2 = ((const f32x2s*)su)[a.e]; b.su = s2.x; b.sv = s2.y; }
    const int r = lane >> 4, t = lane & 15;
    LDS_WAIT(); asm volatile("" ::: "memory");
    const int lim = b.cnt < PA_SLOTS ? b.cnt : PA_SLOTS;
    int es[3];
#pragma unroll
    for (int q = 0; q < 3; ++q) es[q] = lst[4 * q + r];
#pragma unroll
    for (int q = 0; q < 3; ++q) { int e = (4 * q + r) < lim ? es[q] : (x << 11);
        if (MODE & 1) e = (x << 11) | (e & 255);
        const unsigned off = (unsigned)e * 1024u + 16u * (unsigned)t;
#pragma unroll
        for (int i = 0; i < 4; ++i) { if (MODE & 2) b.ur[q][i] = (v4u){(unsigned)e, (unsigned)e + 1u, (unsigned)e + 2u, (unsigned)e + 3u}; else b.ur[q][i] = *(const v4u*)(u8 + (off + 256u * i)); } }
}
__device__ __forceinline__ int dot16(const v4u u, const v4u h) { int d = __builtin_amdgcn_sdot4((int)u.x, (int)h.x, 0, false); d = __builtin_amdgcn_sdot4((int)u.y, (int)h.y, d, false);
    d = __builtin_amdgcn_sdot4((int)u.z, (int)h.z, d, false); return __builtin_amdgcn_sdot4((int)u.w, (int)h.w, d, false); }
template <int CTRL, int RM> __device__ __forceinline__ int dpp_i(int x) { return __builtin_amdgcn_update_dpp(0, x, CTRL, RM, 0xf, false); }
__device__ __forceinline__ int wave_sum_to63(int x) { x += dpp_i<0xb1, 0xf>(x); x += dpp_i<0x4e, 0xf>(x); x += dpp_i<0x124, 0xf>(x); x += dpp_i<0x128, 0xf>(x); x += dpp_i<0x142, 0xa>(x); x += dpp_i<0x143, 0xc>(x); return x; }
__device__ __forceinline__ int row_sum16(int x) { x += dpp_i<0xb1, 0xf>(x); x += dpp_i<0x4e, 0xf>(x); x += dpp_i<0x124, 0xf>(x); x += dpp_i<0x128, 0xf>(x); return x; }
__device__ __forceinline__ float gelu_erf(float v) {
    const float av = fabsf(v), t = __builtin_amdgcn_rcpf(av * 0.2316418882f + 1.0f);
    float q = t * 0.5307027145f + (-0.7265760135f); q = q * t + 0.7107068705f; q = q * t + (-0.142248368f); q = q * t + 0.127414796f; q = q * t;
    const float e = __builtin_amdgcn_exp2f((v * v) * (-0.72134752044f)), m = v * (q * e);
    return v < 0.f ? m : v - m; }
template <int MODE> __device__ __forceinline__ void pa_s3(const PeerA2& b, const PeerA1& a, const PeerAH& h, const unsigned char* __restrict__ u8, const unsigned char* __restrict__ hq, float* __restrict__ aw, int tok, int half, int lane) {
    int mine = 0;
    if (MODE & 8) { mine = (int)(b.ur[0][0].x ^ b.ur[1][1].y ^ b.ur[2][2].z ^ h.hv[0].x); } else
    {
        int d[3];
#pragma unroll
        for (int q = 0; q < 3; ++q) { d[q] = dot16(b.ur[q][0], h.hv[0]); d[q] += dot16(b.ur[q][1], h.hv[1]); d[q] += dot16(b.ur[q][2], h.hv[2]); d[q] += dot16(b.ur[q][3], h.hv[3]); }
#pragma unroll
        for (int q = 0; q < 3; ++q) d[q] += dpp_i<0xb1, 0xf>(d[q]);
#pragma unroll
        for (int q = 0; q < 3; ++q) d[q] += dpp_i<0x4e, 0xf>(d[q]);
#pragma unroll
        for (int q = 0; q < 3; ++q) d[q] += dpp_i<0x124, 0xf>(d[q]);
#pragma unroll
        for (int q = 0; q < 3; ++q) d[q] += dpp_i<0x128, 0xf>(d[q]);
        const int src = 64 * (b.rk & 3);
#pragma unroll
        for (int q = 0; q < 3; ++q) { const int v = __builtin_amdgcn_ds_bpermute(src, d[q]); mine = ((b.rk >> 2) == q) ? v : mine; }
    }
    float* awp = aw + ((unsigned)tok * 128u + 64u * (unsigned)half + (unsigned)lane);
    if (b.m && b.rk < PA_SLOTS) *awp = a.g * gelu_erf((float)mine * h.hsc * b.su) * b.sv;
    if (b.cnt > PA_SLOTS) {
        unsigned long long rem = b.rem; const v4u hw = *(const v4u*)(hq + (size_t)tok * 1024 + 16 * lane);
        while (rem != 0ull) { const int idx = __builtin_ctzll(rem); rem &= rem - 1ull; const int e = __builtin_amdgcn_readlane(a.e, idx);
            const int d = __builtin_amdgcn_readlane(wave_sum_to63(dot16(*(const v4u*)(u8 + (size_t)e * 1024 + 16 * lane), hw)), 63);
            if (lane == idx) *awp = a.g * gelu_erf((float)d * h.hsc * b.su) * b.sv; }
    }
}
template <int MODE> __device__ __forceinline__ void peer_a_run(const unsigned char* __restrict__ hq, const float* __restrict__ hs, const unsigned char* __restrict__ u8, const float* __restrict__ su,
                                           const float* __restrict__ sv, const int* __restrict__ te, const float* __restrict__ tw, float* __restrict__ aw, LAS int* lst, int wrank, int wstep, int x, int lane) {
    const int ntok = wrank < T ? (T - wrank + wstep - 1) / wstep : 0, N = 2 * ntok; (void)sv;
#define PA_TOK(n) ((MODE & 4) ? wrank : wrank + ((n) >> 1) * wstep)
    if (N == 0) return;
    PeerA1 a0, a1, a2, a3; PeerA2 bA, bB; PeerAH h0, h1;
#pragma unroll
    for (int q = 0; q < 3; ++q)
#pragma unroll
        for (int i = 0; i < 4; ++i) { bA.ur[q][i] = (v4u){0u, 0u, 0u, 0u}; bB.ur[q][i] = (v4u){0u, 0u, 0u, 0u}; }
    pa_s1(a0, te, tw, PA_TOK(0), 0, lane); pa_s1(a1, te, tw, PA_TOK(1), 1, lane); pa_s1h(h0, hq, hs, PA_TOK(0), lane);
    if (N > 2) { pa_s1(a2, te, tw, PA_TOK(2), 0, lane); pa_s1(a3, te, tw, PA_TOK(3), 1, lane); pa_s1h(h1, hq, hs, PA_TOK(2), lane); }
    pa_s2<MODE>(bA, a0, u8, su, lst, x, lane);
#define PA_STEP(n, Bcur, Bnext, Acur, Anext, Hcur, LOADH) do { \
        if ((n) + 1 < N) pa_s2<MODE>(Bnext, Anext, u8, su, lst, x, lane); \
        pa_s3<MODE>(Bcur, Acur, Hcur, u8, hq, aw, wrank + ((n) >> 1) * wstep, (n) & 1, lane); \
        if ((n) + 4 < N) { pa_s1(Acur, te, tw, PA_TOK((n) + 4), (n) & 1, lane); } \
        if (LOADH && (n) + 3 < N) pa_s1h(Hcur, hq, hs, PA_TOK((n) + 3), lane); } while (0)
    for (int n = 0; n < N; n += 4) {
        PA_STEP(n, bA, bB, a0, a1, h0, 0);
        if (n + 1 < N) PA_STEP(n + 1, bB, bA, a1, a2, h0, 1);
        if (n + 2 < N) PA_STEP(n + 2, bA, bB, a2, a3, h1, 0);
        if (n + 3 < N) PA_STEP(n + 3, bB, bA, a3, a0, h1, 1);
    }
#undef PA_STEP
#undef PA_TOK
}
struct PeerB1 { v4u e[4]; f32x4 w[4]; unsigned h2; };
struct PeerB2 { v4u vr[8]; };
struct PeerBAcc { int acc[16]; int wq[4]; float wsc, h0, h1; };
typedef float f32x2v __attribute__((ext_vector_type(2)));
__device__ __forceinline__ void pb_s1(PeerB1& a, const int* __restrict__ te, const float* __restrict__ aw, int tok, int lane) {
    const unsigned o_ = (unsigned)tok * 128u + 16u * ((unsigned)lane >> 3);
    const v4u* ep = (const v4u*)(te + o_); const f32x4* wp = (const f32x4*)(aw + o_);
#pragma unroll
    for (int j = 0; j < 4; ++j) { a.e[j] = ep[j]; a.w[j] = wp[j]; } }
__device__ __forceinline__ int pb_col(int lane) { return 16 * (lane & 7) + 8 * ((lane >> 5) & 1) + 4 * ((lane >> 4) & 1) + 2 * ((lane >> 3) & 1); }
template <int CTRL, int RM> __device__ __forceinline__ float dpp_f(float x) { return __builtin_bit_cast(float, __builtin_amdgcn_update_dpp(0, __builtin_bit_cast(int, x), CTRL, RM, 0xf, false)); }
__device__ __forceinline__ void pb_quant(PeerBAcc& A, const PeerB1& a) {
    float mx = 0.f;
#pragma unroll
    for (int j = 0; j < 4; ++j) mx = fmaxf(mx, fmaxf(fmaxf(fabsf(a.w[j][0]), fabsf(a.w[j][1])), fmaxf(fabsf(a.w[j][2]), fabsf(a.w[j][3]))));
    mx = fmaxf(mx, dpp_f<0xb1, 0xf>(mx)); mx = fmaxf(mx, dpp_f<0x4e, 0xf>(mx)); mx = fmaxf(mx, dpp_f<0x124, 0xf>(mx)); mx = fmaxf(mx, dpp_f<0x128, 0xf>(mx));
    mx = fmaxf(mx, dpp_f<0x142, 0xa>(mx)); mx = fmaxf(mx, dpp_f<0x143, 0xc>(mx));
    mx = __builtin_bit_cast(float, __builtin_amdgcn_readlane(__builtin_bit_cast(int, mx), 63));
    const float inv = mx > 0.f ? 127.0f / mx : 0.f; A.wsc = mx * (1.0f / 127.0f);
#pragma unroll
    for (int j = 0; j < 4; ++j) A.wq[j] = (int)(((unsigned)(int)rintf(a.w[j][0] * inv) & 0xffu) | (((unsigned)(int)rintf(a.w[j][1] * inv) & 0xffu) << 8) |
                                               (((unsigned)(int)rintf(a.w[j][2] * inv) & 0xffu) << 16) | (((unsigned)(int)rintf(a.w[j][3] * inv) & 0xffu) << 24));
}
template <int HF, int MODE> __device__ __forceinline__ void pb_s2(PeerB2& b, const PeerB1& a, const unsigned char* __restrict__ v8x, int lane) {
    const int c = lane & 7;
#pragma unroll
    for (int m = 0; m < 8; ++m) { unsigned e = a.e[2 * HF + (m >> 2)][m & 3]; if (MODE & 1) e &= 255u;
        if (MODE & 2) b.vr[m] = (v4u){e, e + 1u, e + 2u, e + 3u}; else b.vr[m] = *(const v4u*)(v8x + (e * 128u + 16u * (unsigned)c)); }
}
__device__ __forceinline__ float swap32_add(float lo, float hi) { const auto r = __builtin_amdgcn_permlane32_swap(__builtin_bit_cast(unsigned, lo), __builtin_bit_cast(unsigned, hi), false, false);
    return __builtin_bit_cast(float, r[0]) + __builtin_bit_cast(float, r[1]); }
__device__ __forceinline__ float swap16_add(float lo, float hi) { const auto r = __builtin_amdgcn_permlane16_swap(__builtin_bit_cast(unsigned, lo), __builtin_bit_cast(unsigned, hi), false, false);
    return __builtin_bit_cast(float, r[0]) + __builtin_bit_cast(float, r[1]); }
template <int HF, int MODE> __device__ __forceinline__ void pb_s3(PeerBAcc& A, const PeerB2& b, const PeerB1& a, float* out, int tok, int x, int lane) {
    if (MODE & 8) { if (HF == 0) { A.acc[0] = 0; }
#pragma unroll
        for (int m = 0; m < 8; ++m) A.acc[0] += (int)(b.vr[m].x ^ b.vr[m].y ^ b.vr[m].z ^ b.vr[m].w);
        if (HF == 1) { f32x2v h2; h2.x = A.h0 + (float)A.acc[0]; h2.y = A.h1 + A.wsc; *(f32x2v*)(out + ((unsigned)tok * 1024u + 128u * (unsigned)x + (unsigned)pb_col(lane))) = h2; }
        return; }
    if (HF == 0) {
#pragma unroll
        for (int j = 0; j < 16; ++j) A.acc[j] = 0;
    }
#pragma unroll
    for (int gg = 0; gg < 2; ++gg)
#pragma unroll
        for (int d = 0; d < 4; ++d) { const unsigned ra = b.vr[4 * gg][d], rb = b.vr[4 * gg + 1][d], rc = b.vr[4 * gg + 2][d], rd = b.vr[4 * gg + 3][d];
            const unsigned t0 = __builtin_amdgcn_perm(rb, ra, 0x05010400u), t1 = __builtin_amdgcn_perm(rb, ra, 0x07030602u), t2 = __builtin_amdgcn_perm(rd, rc, 0x05010400u), t3 = __builtin_amdgcn_perm(rd, rc, 0x07030602u);
            const unsigned c0 = __builtin_amdgcn_perm(t2, t0, 0x05040100u), c1 = __builtin_amdgcn_perm(t2, t0, 0x07060302u), c2 = __builtin_amdgcn_perm(t3, t1, 0x05040100u), c3 = __builtin_amdgcn_perm(t3, t1, 0x07060302u);
            const int w4 = A.wq[2 * HF + gg];
            A.acc[4 * d] = __builtin_amdgcn_sdot4((int)c0, w4, A.acc[4 * d], false); A.acc[4 * d + 1] = __builtin_amdgcn_sdot4((int)c1, w4, A.acc[4 * d + 1], false);
            A.acc[4 * d + 2] = __builtin_amdgcn_sdot4((int)c2, w4, A.acc[4 * d + 2], false); A.acc[4 * d + 3] = __builtin_amdgcn_sdot4((int)c3, w4, A.acc[4 * d + 3], false); }
    if (HF == 1) {
        int r8[8], r4[4], r2[2];
#pragma unroll
        for (int j = 0; j < 8; ++j) { const bool up = (lane & 32) != 0; const int keep = up ? A.acc[j + 8] : A.acc[j], send = up ? A.acc[j] : A.acc[j + 8]; r8[j] = keep + __shfl_xor(send, 32); }
#pragma unroll
        for (int j = 0; j < 4; ++j) { const bool up = (lane & 16) != 0; const int keep = up ? r8[j + 4] : r8[j], send = up ? r8[j] : r8[j + 4]; r4[j] = keep + __shfl_xor(send, 16); }
#pragma unroll
        for (int j = 0; j < 2; ++j) { const bool up = (lane & 8) != 0; const int keep = up ? r4[j + 2] : r4[j], send = up ? r4[j] : r4[j + 2];
            r2[j] = keep + __builtin_amdgcn_update_dpp(0, send, 0x128, 0xf, 0xf, false); }
        f32x2v h2; h2.x = A.h0 + A.wsc * (float)r2[0]; h2.y = A.h1 + A.wsc * (float)r2[1];
        *(f32x2v*)(out + ((unsigned)tok * 1024u + 128u * (unsigned)x + (unsigned)pb_col(lane))) = h2;
    }
}
__device__ __forceinline__ void pb_s1h(PeerB1& a, const int* __restrict__ te, const float* __restrict__ aw, const bf16* __restrict__ hb, int tok, int x, int lane) {
    pb_s1(a, te, aw, tok, lane); a.h2 = *(const unsigned*)(hb + ((unsigned)tok * 1024u + 128u * (unsigned)x + (unsigned)pb_col(lane))); }
template <int MODE> __device__ __forceinline__ void peer_b_run(const unsigned char* __restrict__ v8x, const int* __restrict__ te, const float* __restrict__ aw, const bf16* __restrict__ hb, float* out, int wrank, int wstep, int x, int lane) {
    const int N = wrank < T ? (T - wrank + wstep - 1) / wstep : 0;
#define PB_TOK(n) (wrank + (n) * wstep)
#define PB_STOK(n) ((MODE & 4) ? wrank : PB_TOK(n))
    if (N == 0) return;
    PeerB1 s0, s1, s2; PeerB2 bA, bB; PeerBAcc A;
    pb_s1h(s0, te, aw, hb, PB_STOK(0), x, lane); if (N > 1) pb_s1h(s1, te, aw, hb, PB_STOK(1), x, lane);
    pb_s2<0, MODE>(bA, s0, v8x, lane);
#define PB_TOKEN(n, Scur, Snext, Snew) do { \
        if ((n) + 2 < N) pb_s1h(Snew, te, aw, hb, PB_STOK((n) + 2), x, lane); \
        pb_s2<1, MODE>(bB, Scur, v8x, lane); A.h0 = bflo(Scur.h2); A.h1 = bfhi(Scur.h2); pb_quant(A, Scur); \
        pb_s3<0, MODE>(A, bA, Scur, out, PB_TOK(n), x, lane); \
        if ((n) + 1 < N) pb_s2<0, MODE>(bA, Snext, v8x, lane); \
        pb_s3<1, MODE>(A, bB, Scur, out, PB_TOK(n), x, lane); } while (0)
    for (int n = 0; n < N; n += 3) {
        PB_TOKEN(n, s0, s1, s2);
        if (n + 1 < N) PB_TOKEN(n + 1, s1, s2, s0);
        if (n + 2 < N) PB_TOKEN(n + 2, s2, s0, s1);
    }
#undef PB_TOKEN
#undef PB_STOK
#undef PB_TOK
}

__global__ void __launch_bounds__(NWAVES * 64, 2) mk_fwd(Args args) {
    extern __shared__ __attribute__((aligned(16))) unsigned char lds[];
    Frame F;
    F.lds = (LAS unsigned char*)lds;
    F.MISC = (volatile LAS unsigned*)(F.lds + MISC_OFF);
    F.tid = threadIdx.x; F.lane = F.tid & 63; F.wave = __builtin_amdgcn_readfirstlane(F.tid >> 6);
    F.G = gridDim.x; { const int bx = blockIdx.x; F.vcu = (F.G % 8 == 0) ? (bx % 8) * (F.G / 8) + bx / 8 : bx; }
    F.out = nullptr; F.ws = args.ws;
    unsigned char* ws = args.ws;
    F.ctl = (gu32*)(ws + WS_CTL);
    for (int u = F.tid; u < (LDS_BYTES - LDSCTL_OFF) / 4; u += NWAVES * 64) ((LAS unsigned*)(F.lds + LDSCTL_OFF))[u] = 0u;
    __syncthreads();
    XcdBarrier bar; bar.bar = (unsigned*)(F.ctl + CW_BAR); bar.x = 0; bar.st = nullptr;
    if (N_LAUNCHES != PER_PHASE) bar = xcd_barrier_post((unsigned*)(F.ctl + CW_BAR), F.MISC + 8);
    if (N_LAUNCHES != PER_PHASE) { if (F.tid == 0) { const unsigned xid = xb_xcc_id(); F.MISC[12] = xid; F.MISC[13] = xb_add((unsigned*)(F.ctl + CW_TICKET) + 64 * xid, 1u); } __syncthreads(); }
#define GRID_BAR() do { if (N_LAUNCHES != PER_PHASE) xcd_barrier(bar); } while (0)
    const int lo = args.ph_lo, hi = args.ph_hi;
#define IN(k) (lo <= (k) && (k) < hi)
#define BOTH(k) (IN(k) && IN((k) + 1))
    const int gw = F.vcu * NWAVES + F.wave, NGW = F.G * NWAVES;
    bf16* const WinT = (bf16*)(ws + WS_WIN); bf16* const WvT = (bf16*)(ws + WS_WV); bf16* const WkvT = (bf16*)(ws + WS_WKV); bf16* const WbrT = (bf16*)(ws + WS_WBR);
    bf16* const WoutT = (bf16*)(ws + WS_WOUT); bf16* const WqT = (bf16*)(ws + WS_WQ); bf16* const KEYS = (bf16*)(ws + WS_KEYS); bf16* const PWT = (bf16*)(ws + WS_PWT);
    bf16* const MEMN = (bf16*)(ws + WS_MEMN); bf16* const KMEM = (bf16*)(ws + WS_KMEM); bf16* const VTMEM = (bf16*)(ws + WS_VTMEM); float* const RSTDX = (float*)(ws + WS_RSTDX);
    const unsigned char* const U8 = ws + WS_U8; const unsigned char* const V8 = ws + WS_V8; const float* const SU = (const float*)(ws + WS_SU); const float* const SV = (const float*)(ws + WS_SV);
    bf16* const QN = (bf16*)(ws + WS_QN); bf16* const KN = (bf16*)(ws + WS_KN); bf16* const VT = (bf16*)(ws + WS_VT); bf16* const PP = (bf16*)(ws + WS_PP); bf16* const XQ = (bf16*)(ws + WS_XQ);
    bf16* const GATE = (bf16*)(ws + WS_GATE); bf16* const MERGED = (bf16*)(ws + WS_MERGED); bf16* const HB = (bf16*)(ws + WS_HB); bf16* const QB = (bf16*)(ws + WS_QB);
    int* const TE = (int*)(ws + WS_TE); float* const TW = (float*)(ws + WS_TW); float* const AW = (float*)(ws + WS_AW); float* const ROWSQ = (float*)(ws + WS_ROWSQ);
#define RELOAD_OUT(p) do { asm volatile("s_load_dwordx2 %0, %1, 0xb8\n\ts_waitcnt lgkmcnt(0)" : "=s"(p) : "s"(__builtin_amdgcn_kernarg_segment_ptr()) : "memory"); } while (0)
#define XB ((bf16*)(ws + WS_XB))
#define YNA ((bf16*)(outp + OUT_YNA))
#define YPOOL ((bf16*)(outp + OUT_YPOOL))
#define YXA ((bf16*)(outp + OUT_YXA))

#ifndef STAGGER_SLEEPS
#define STAGGER_SLEEPS 1
#endif
#define STAGGER() do { const int q_ = __builtin_amdgcn_readfirstlane((int)((blockIdx.x >> 3) & 3u) * STAGGER_SLEEPS); for (int i_ = 0; i_ < q_; ++i_) __builtin_amdgcn_s_sleep(127); } while (0)
    if (IN(0)) { unsigned char* outp; RELOAD_OUT(outp); F.out = (float*)outp; p0_prologue(F, args); F.out = nullptr; if (BOTH(0)) GRID_BAR(); }
    if (IN(1)) STAGGER();

    if (IN(1)) {
      { unsigned char* outp; RELOAD_OUT(outp);
        { pg8::Sched1 S; S.so.init(T, IN_MAIN, F.G, (int)blockIdx.x); S.A = (const char*)XB; S.Bt = (const char*)WinT; S.tstep = (size_t)256 * 1024 * 2;
          pg8::EpiProj E{RSTDX, QN, KN, PP, XQ, GATE, args.in[I_NAQG], args.in[I_NAKG], args.in[I_GATEB], (args.probe & 1)};
          pg8::gemm_phase<pg8::EpiProj, pg8::Sched1, true, true>(F.lds + RING_OFF, 1024, S, E); }
        if (!(args.probe & 4)) { pg8::Sched1 S; S.so.init(512, T, F.G, (int)blockIdx.x); S.A = (const char*)WvT; S.Bt = (const char*)XB; S.tstep = (size_t)256 * 1024 * 2;
          pg8::EpiVt E{RSTDX, VT};
          pg8::gemm_phase<pg8::EpiVt, pg8::Sched1, false, true>(F.lds + RING_OFF, 1024, S, E); }
        if (!(args.probe & 2)) {
            __syncthreads();
            for (int j = F.vcu; j < 256; j += F.G) memkv_tile(MEMN, WkvT, args.in[I_XAKG], args.in[I_XAQG], KMEM, VTMEM, (LAS float*)(F.lds + RING_OFF) + (F.wave >> 2) * 6144, 2 * j + (F.wave >> 2), F.wave & 3, F.lane);
            __syncthreads(); }
      }
        if (BOTH(1)) GRID_BAR();
    }

    if (IN(2)) {
      { unsigned char* outp; RELOAD_OUT(outp);
        LAS float* rpl = (LAS float*)(F.lds + RING_OFF + F.wave * 16384);
        for (int i = F.lane; i < 15 * 31; i += 64) rpl[i] = args.in[I_RPB][F.wave * 15 * 31 + i];
        LDS_WAIT(); asm volatile("" ::: "memory");
        if (!(args.probe & 1)) for (int i = F.vcu; i < 256; i += F.G)
            for (int k = 0; k < 8; ++k) { const int idx = i * 8 + k, b = idx >> 9, r = (idx >> 2) & 127, jb = idx & 3; na_item(QN, KN, VT, rpl, YNA, b, r, jb, F.wave, F.lane); }
        if (!(args.probe & 2)) for (int i = F.vcu; i < 256; i += F.G) pool_wg(PP, PWT, YPOOL, F.lds + RING_OFF, i * 128, F.wave, F.lane);
        if (!(args.probe & 4)) { const int pair = F.vcu & 15, xb = pair >> 2, xh = pair & 3, slot = F.vcu >> 4, nslot = F.G >> 4;
          __syncthreads(); xa_fill_lds(KMEM, VTMEM, F.lds + RING_OFF, xb, xh, F.tid); __syncthreads();
          if (slot < nslot) for (int n = slot * NWAVES + F.wave; n < 512; n += nslot * NWAVES) xa_item(XQ, F.lds + RING_OFF, YXA, (xb * 512 + n) * 16, xh, F.lane);
          __syncthreads(); }
      }
        if (BOTH(2)) GRID_BAR();
    }

    if (IN(3)) {
      { unsigned char* outp; RELOAD_OUT(outp);
        pg8::Sched1 S; S.so.init(T, D, F.G, (int)blockIdx.x); S.A = (const char*)YNA; S.Bt = (const char*)WbrT; S.tstep = (size_t)256 * 1536 * 2;
        pg8::EpiMergeCat E{GATE, MERGED};
        pg8::gemm_phase<pg8::EpiMergeCat, pg8::Sched1, true, true>(F.lds + RING_OFF, 1536, S, E);
      }
        if (BOTH(3)) GRID_BAR();
    }

    if (IN(4)) {
      {
        pg8::Sched1 S; S.so.init(T, D, F.G, (int)blockIdx.x); S.A = (const char*)MERGED; S.Bt = (const char*)WoutT; S.tstep = (size_t)256 * 1024 * 2;
        pg8::EpiH E{(const pg8::bf16_t*)(ws + WS_XB), nullptr, HB, ROWSQ, args.probe};
        pg8::gemm_phase<pg8::EpiH, pg8::Sched1, true, true>(F.lds + RING_OFF, 1024, S, E);
      }
        if (BOTH(4)) GRID_BAR();
    }

    if (IN(5)) {
      {
        pg8::Sched1 S; S.so.init(T, 2048, F.G, (int)blockIdx.x); S.A = (const char*)HB; S.Bt = (const char*)WqT; S.tstep = (size_t)256 * 1024 * 2;
        pg8::EpiQ E{ROWSQ, QB};
        pg8::gemm_phase<pg8::EpiQ, pg8::Sched1, true, true>(F.lds + RING_OFF, 1024, S, E);
      }
        if (BOTH(5)) GRID_BAR();
    }

    if (IN(6)) {
        LAS int* lscr = (LAS int*)(F.lds + RING_OFF + 65536 + F.wave * 8192);
        for (int tok = 4 * gw; tok < T; tok += 4 * NGW) {
            HqIn hin[4];
#pragma unroll
            for (int r = 0; r < 4; ++r) hq_load(hin[r], HB, ROWSQ, tok + r, F.lane);
#pragma unroll
            for (int r = 0; r < 4; ++r) hq_token(hin[r], ws + WS_HQ, (float*)(ws + WS_HS), tok + r, F.lane); }
        { const int th = F.vcu & 7, slot = F.vcu >> 3, nslot = F.G >> 3;
          __syncthreads(); topk_fill_lds(KEYS, F.lds + RING_OFF, th, F.tid); __syncthreads();
          { { const int n0 = slot * NWAVES + F.wave, ns = nslot * NWAVES; TopkQ qA, qB;
              if (n0 < 2048) topk_loadq(qA, QB, n0 * 16, th, F.lane);
              for (int n = n0; n < 2048; n += 2 * ns) {
                  if (n + ns < 2048) topk_loadq(qB, QB, (n + ns) * 16, th, F.lane);
                  topk_item(qA, F.lds + RING_OFF, TE, TW, lscr, n * 16, th, F.lane);
                  if (n + ns < 2048) { if (n + 2 * ns < 2048) topk_loadq(qA, QB, (n + 2 * ns) * 16, th, F.lane);
                      topk_item(qB, F.lds + RING_OFF, TE, TW, lscr, (n + ns) * 16, th, F.lane); } } } }
          __syncthreads(); }
        if (BOTH(6)) GRID_BAR();
    }

    if (IN(7)) {
        int x0 = 0, nxs = 8, wrank = (int)blockIdx.x * NWAVES + F.wave, wstep = F.G * NWAVES;
        if (N_LAUNCHES != PER_PHASE) { const unsigned xid = F.MISC[12], rk = F.MISC[13]; unsigned nx = 0, below = 0, mine = 0;
            for (unsigned j = 0; j < 16; ++j) { const unsigned c = xb_ld((unsigned*)(F.ctl + CW_BAR) + XB_XCNT(j)); nx += c > 0u; below += (c > 0u && j < xid); mine = (j == xid) ? c : mine; }
            if (nx == 8 && mine > 0 && rk < mine) { x0 = (int)below; nxs = 1; wrank = (int)rk * NWAVES + F.wave; wstep = (int)mine * NWAVES; } }
        else if ((F.G & 7) == 0) { x0 = (int)blockIdx.x & 7; nxs = 1; wrank = ((int)blockIdx.x >> 3) * NWAVES + F.wave; wstep = (F.G >> 3) * NWAVES; }
        for (int xs = 0; xs < nxs; ++xs) {
#ifdef PROBE_BITS
            if (args.probe) peer_a_run<PROBE_BITS>(ws + WS_HQ, (const float*)(ws + WS_HS), U8, SU, SV, TE, TW, (float*)QB, (LAS int*)(F.lds + RING_OFF + F.wave * 16384), wrank, wstep, x0 + xs, F.lane); else
#endif
            peer_a_run<0>(ws + WS_HQ, (const float*)(ws + WS_HS), U8, SU, SV, TE, TW, AW, (LAS int*)(F.lds + RING_OFF + F.wave * 16384), wrank, wstep, x0 + xs, F.lane); }
        if (N_LAUNCHES != PER_PHASE) xcd_barrier(bar);
    }
    if (IN(8)) {
        int x0 = 0, nxs = 8, wrank = (int)blockIdx.x * NWAVES + F.wave, wstep = F.G * NWAVES;
        if (N_LAUNCHES != PER_PHASE) { const unsigned xid = F.MISC[12], rk = F.MISC[13]; unsigned nx = 0, below = 0, mine = 0;
            for (unsigned j = 0; j < 16; ++j) { const unsigned c = xb_ld((unsigned*)(F.ctl + CW_BAR) + XB_XCNT(j)); nx += c > 0u; below += (c > 0u && j < xid); mine = (j == xid) ? c : mine; }
            if (nx == 8 && mine > 0 && rk < mine) { x0 = (int)below; nxs = 1; wrank = (int)rk * NWAVES + F.wave; wstep = (int)mine * NWAVES; } }
        else if ((F.G & 7) == 0) { x0 = (int)blockIdx.x & 7; nxs = 1; wrank = ((int)blockIdx.x >> 3) * NWAVES + F.wave; wstep = (F.G >> 3) * NWAVES; }
        for (int xs = 0; xs < nxs; ++xs) {
#ifdef PROBE_BITS
            if (args.probe) peer_b_run<PROBE_BITS>(V8 + (size_t)(x0 + xs) * (2 * MiB), TE, AW, HB, (float*)QB, wrank, wstep, x0 + xs, F.lane); else
#endif
            { unsigned char* outp; RELOAD_OUT(outp); peer_b_run<0>(V8 + (size_t)(x0 + xs) * (2 * MiB), TE, AW, HB, (float*)outp, wrank, wstep, x0 + xs, F.lane); } }
    }
#undef XB
#undef YNA
#undef YPOOL
#undef YXA
#undef RELOAD_OUT
#undef IN
#undef BOTH
#undef GRID_BAR
}

extern "C" void kernel_launch(void* const* d_in, const int* in_sizes, int n_in, void* d_out, int out_size, void* d_ws, size_t ws_size, hipStream_t stream) {
    static int grid = 0;
    if (grid == 0) {
        if (n_in != 23 || in_sizes[0] != T * D || out_size != T * D || ws_size < WS_END) { fprintf(stderr, "kernel_launch: unexpected shapes: n_in %d in0 %d out %d ws %zu\n", n_in, n_in > 0 ? in_sizes[0] : -1, out_size, ws_size); grid = -1; return; }
        int dev = 0, cus = 0, per_cu = 0;
        if (hipGetDevice(&dev) != hipSuccess || hipDeviceGetAttribute(&cus, hipDeviceAttributeMultiprocessorCount, dev) != hipSuccess) { fprintf(stderr, "kernel_launch: device query failed\n"); grid = -1; return; }
        if (hipFuncSetAttribute((const void*)mk_fwd, hipFuncAttributeMaxDynamicSharedMemorySize, LDS_BYTES) != hipSuccess) { fprintf(stderr, "kernel_launch: hipFuncSetAttribute failed\n"); grid = -1; return; }
        if (hipOccupancyMaxActiveBlocksPerMultiprocessor(&per_cu, (const void*)mk_fwd, NWAVES * 64, LDS_BYTES) != hipSuccess || per_cu < 1)
            fprintf(stderr, "kernel_launch: note: occupancy query reports %d workgroups per CU\n", per_cu);
        (void)hipGetLastError();
        grid = cus;
    }
    if (grid < 0) return;
    if (hipMemsetAsync((char*)d_ws + WS_CTL, 0, CTL_ZERO_BYTES, stream) != hipSuccess) { fprintf(stderr, "kernel_launch: memset failed\n"); return; }
    Args a{};
    for (int i = 0; i < 23; ++i) a.in[i] = (const float*)d_in[i];
    a.out = (float*)d_out; a.ws = (unsigned char*)d_ws;
    for (int li = 0; li < N_LAUNCHES; ++li) {
        a.ph_lo = (N_LAUNCHES == PER_PHASE) ? li : 0; a.ph_hi = (N_LAUNCHES == PER_PHASE) ? li + 1 : PER_PHASE;
        hipLaunchKernelGGL(mk_fwd, dim3(grid), dim3(NWAVES * 64), LDS_BYTES, stream, a);
#ifdef HOST_DUP_PHASE
        if (N_LAUNCHES == PER_PHASE && li == HOST_DUP_PHASE) {
#ifndef PROBE_MODE
            if (li == 4) (void)hipMemsetAsync((char*)d_ws + WS_ROWSQ, 0, (size_t)T * 4, stream);
#endif
#ifdef PROBE_MODE
            a.probe = PROBE_MODE;
#endif
            hipLaunchKernelGGL(mk_fwd, dim3(grid), dim3(NWAVES * 64), LDS_BYTES, stream, a); a.probe = 0; }
#endif
        const hipError_t le = hipPeekAtLastError();
        if (le != hipSuccess) { fprintf(stderr, "kernel_launch: launch %d failed: %s\n", li, hipGetErrorName(le)); break; }
    }
}
```

```cpp
#include <hip/hip_runtime.h>
#include <cstdio>
#include <cstdint>

#ifndef MK_N_LAUNCHES
#define MK_N_LAUNCHES 1
#endif

namespace pg8 {
#define PG8_LAS __attribute__((address_space(3)))
typedef unsigned short bf16_t;
typedef short bf16x8 __attribute__((ext_vector_type(8)));
typedef float f32x4 __attribute__((ext_vector_type(4)));
typedef unsigned u32x4 __attribute__((ext_vector_type(4)));
typedef unsigned u32x2 __attribute__((ext_vector_type(2)));
constexpr int BM = 256, BK = 64, HALF = 128, HTB = HALF * BK * 2  , STAGE_BYTES = 8 * HTB, NXCD = 8, WGM = 8;

__host__ __device__ __forceinline__ int lds_byte(int r, int c) { const int st = (r >> 4) * 2 + (c >> 5), rr = r & 15, cc = c & 31, ob = rr * 64 + cc * 2; return st * 1024 + (ob ^ (((ob >> 9) & 1) << 5)); }
__host__ __device__ __forceinline__ void stage_rc(int b, int& R, int& C) { const int st = b / 1024, sb = b % 1024, swz = sb ^ (((sb >> 9) & 1) << 5); R = (st >> 1) * 16 + swz / 64; C = (st & 1) * 32 + (swz % 64) / 2; }
__host__ __device__ __forceinline__ int perm32(int rho) { const int n = rho >> 4, i = rho & 15; return 8 * (i >> 2) + 4 * n + (i & 3); }

struct Unit { int pm, pn, br; };

struct StaticOrder {
    int nM, nN, nwg, G, c;
    __host__ __device__ void init(int M, int N, int G_, int c_) { nM = M / BM; nN = N / BM; nwg = nM * nN; G = G_; c = c_; }
    __host__ __device__ bool next(int i, Unit& u) const {
        const long L = (long)i * G + c; if (L >= nwg) return false;
        int wgid = (int)L; { const int q = nwg / NXCD, r = nwg % NXCD, xcd = wgid % NXCD, off = wgid / NXCD; wgid = (xcd < r ? xcd * (q + 1) : r * (q + 1) + (xcd - r) * q) + off; }
        const int nig = WGM * nN, gid = wgid / nig, fm = gid * WGM, gsz = (nM - fm) < WGM ? (nM - fm) : WGM;
        u.pm = fm + ((wgid % nig) % gsz); u.pn = (wgid % nig) / gsz; return true;
    }
};
struct Sched1 {
    StaticOrder so; const char* A; const char* Bt; size_t tstep;
    __device__ __forceinline__ bool next(int i, Unit& u) const { u.br = 0; return so.next(i, u); }
    __device__ __forceinline__ const char* abase(const Unit& u) const { return A + (size_t)u.pm * tstep; }
    __device__ __forceinline__ const char* bbase(const Unit& u) const { return Bt + (size_t)u.pn * tstep; }
    __device__ __forceinline__ void a_ready(const Unit&) const {}
    __device__ __forceinline__ void done(const Unit&) const {}
};
struct Sched3 {
    StaticOrder so; const char* A; const char* Bt; size_t tstep, strideA, strideB;
    __device__ __forceinline__ bool next(int i, Unit& u) const { u.br = i % 3; return so.next(i / 3, u); }
    __device__ __forceinline__ const char* abase(const Unit& u) const { return A + (size_t)u.br * strideA + (size_t)u.pm * tstep; }
    __device__ __forceinline__ const char* bbase(const Unit& u) const { return Bt + (size_t)u.br * strideB + (size_t)u.pn * tstep; }
    __device__ __forceinline__ void a_ready(const Unit&) const {}
    __device__ __forceinline__ void done(const Unit&) const {}
};

typedef float f32x2_t __attribute__((ext_vector_type(2))); typedef __bf16 bf16x2v_t __attribute__((ext_vector_type(2)));
__device__ __forceinline__ unsigned cvt_pk_bf16(float lo, float hi) { const f32x2_t v = {lo, hi}; const bf16x2v_t b = __builtin_convertvector(v, bf16x2v_t); return __builtin_bit_cast(unsigned, b); }
__device__ __forceinline__ u32x4 pack8(const f32x4 a, const f32x4 b) { u32x4 w; w.x = cvt_pk_bf16(a[0], a[1]); w.y = cvt_pk_bf16(a[2], a[3]); w.z = cvt_pk_bf16(b[0], b[1]); w.w = cvt_pk_bf16(b[2], b[3]); return w; }
__device__ __forceinline__ float bflo(unsigned u) { return __builtin_bit_cast(float, u << 16); }
__device__ __forceinline__ float bfhi(unsigned u) { return __builtin_bit_cast(float, u & 0xffff0000u); }


constexpr float RMS_EPS = 1e-6f;

struct EpiProj {
    static constexpr bool PERM = true, AFTER_DRAIN = false, HAS_MID = false;
    const float* rstd; bf16_t *qn, *kn, *pp, *xq, *gates; const float *qg, *kg, *gate_b; int skip;
    __device__ __forceinline__ void operator()(const f32x4 (&acc)[2][2][4][2], const Unit& u, int wr, int wc, int fr, int fq) const {
        if (skip) { if (acc[0][0][0][0][0] == 1234.5f) qn[0] = 1; return; }
        const int pn = u.pn, row0 = u.pm * BM + wr * 64 + fr, lc0 = 64 * wc + 8 * fq;
        float rsv[2][4];
#pragma unroll
        for (int ai = 0; ai < 2; ++ai)
#pragma unroll
            for (int m = 0; m < 4; ++m) rsv[ai][m] = rstd[row0 + ai * HALF + m * 16];
        if (pn < 4) {
            const bool isq = pn < 2; bf16_t* O = isq ? qn : kn; const float* g = isq ? qg : kg; const float post = isq ? 0.125f : 1.0f;
            f32x4 gv[2][2];
#pragma unroll
            for (int bj = 0; bj < 2; ++bj)
#pragma unroll
                for (int n = 0; n < 2; ++n) gv[bj][n] = *(const f32x4*)(g + 32 * bj + 8 * fq + 4 * n);
            const int colbase = (pn & 1) * 256 + lc0;
#pragma unroll
            for (int ai = 0; ai < 2; ++ai)
#pragma unroll
                for (int m = 0; m < 4; ++m) {
                    const int row = row0 + ai * HALF + m * 16; const float rs = rsv[ai][m];
                    f32x4 v[2][2]; float ss = 0.f;
#pragma unroll
                    for (int bj = 0; bj < 2; ++bj)
#pragma unroll
                        for (int n = 0; n < 2; ++n) { v[bj][n] = acc[ai][bj][m][n] * rs; ss += (v[bj][n][0] * v[bj][n][0] + v[bj][n][1] * v[bj][n][1]) + (v[bj][n][2] * v[bj][n][2] + v[bj][n][3] * v[bj][n][3]); }
                    ss += __shfl_xor(ss, 16); ss += __shfl_xor(ss, 32);
                    const float r = rsqrtf(ss * (1.0f / 64.0f) + RMS_EPS) * post;
#pragma unroll
                    for (int bj = 0; bj < 2; ++bj) *(u32x4*)(O + (size_t)row * 512 + colbase + 32 * bj) = pack8(v[bj][0] * r * gv[bj][0], v[bj][1] * r * gv[bj][1]);
                }
        } else if (pn < 8) {
            bf16_t* O = pn < 6 ? pp : xq; const int colbase = (pn & 1) * 256 + lc0;
#pragma unroll
            for (int ai = 0; ai < 2; ++ai)
#pragma unroll
                for (int m = 0; m < 4; ++m) {
                    const int row = row0 + ai * HALF + m * 16; const float rs = rsv[ai][m];
#pragma unroll
                    for (int bj = 0; bj < 2; ++bj) *(u32x4*)(O + (size_t)row * 512 + colbase + 32 * bj) = pack8(acc[ai][bj][m][0] * rs, acc[ai][bj][m][1] * rs);
                }
        } else {
            const int gcol0 = (pn - 8) * 256 + lc0;
            f32x4 bv[2][2];
#pragma unroll
            for (int bj = 0; bj < 2; ++bj)
#pragma unroll
                for (int n = 0; n < 2; ++n) bv[bj][n] = *(const f32x4*)(gate_b + gcol0 + 32 * bj + 4 * n) * (-1.4426950408889634f);
#pragma unroll
            for (int ai = 0; ai < 2; ++ai)
#pragma unroll
                for (int m = 0; m < 4; ++m) {
                    const int row = row0 + ai * HALF + m * 16; const float rs = rsv[ai][m] * (-1.4426950408889634f);
#pragma unroll
                    for (int bj = 0; bj < 2; ++bj) {
                        f32x4 o[2];
#pragma unroll
                        for (int n = 0; n < 2; ++n) { const f32x4 z = acc[ai][bj][m][n] * rs + bv[bj][n];
#pragma unroll
                            for (int i = 0; i < 4; ++i) o[n][i] = __builtin_amdgcn_rcpf(1.0f + __builtin_amdgcn_exp2f(z[i])); }
                        *(u32x4*)(gates + (size_t)row * 3072 + gcol0 + 32 * bj) = pack8(o[0], o[1]);
                    }
                }
        }
    }
};
struct EpiVt {
    static constexpr bool PERM = true, AFTER_DRAIN = false, HAS_MID = false;
    const float* rstd; bf16_t* Vt;
    __device__ __forceinline__ void operator()(const f32x4 (&acc)[2][2][4][2], const Unit& u, int wr, int wc, int fr, int fq) const {
        const int ch0 = u.pm * BM + wr * 64 + fr, tok0 = u.pn * BM + wc * 32 + 8 * fq, b = tok0 >> 13, t0 = tok0 & 8191;
        f32x4 rv[2][2];
#pragma unroll
        for (int bj = 0; bj < 2; ++bj)
#pragma unroll
            for (int n = 0; n < 2; ++n) rv[bj][n] = *(const f32x4*)(rstd + tok0 + bj * HALF + 4 * n);
#pragma unroll
        for (int ai = 0; ai < 2; ++ai)
#pragma unroll
            for (int m = 0; m < 4; ++m) { const int ch = ch0 + ai * HALF + m * 16; bf16_t* rowp = Vt + ((size_t)(b * 512 + ch) * 8192 + t0);
#pragma unroll
                for (int bj = 0; bj < 2; ++bj) *(u32x4*)(rowp + bj * HALF) = pack8(acc[ai][bj][m][0] * rv[bj][0], acc[ai][bj][m][1] * rv[bj][1]); }
    }
};
struct EpiMergeCat {
    static constexpr bool PERM = true, AFTER_DRAIN = false, HAS_MID = true;
    const bf16_t* gates; bf16_t* merged;
    __device__ __forceinline__ void mid(f32x4 (&acc)[2][2][4][2], const Unit& u, int nb  , int wr, int wc, int fr, int fq) const {
        const int row0 = u.pm * BM + wr * 64 + fr, col0 = u.pn * BM + wc * 32 + 8 * fq;
#pragma unroll
        for (int ai = 0; ai < 2; ++ai) {
            u32x4 ga[4][2], gb[4][2];
#pragma unroll
            for (int m = 0; m < 4; ++m)
#pragma unroll
                for (int bj = 0; bj < 2; ++bj) { const bf16_t* gp = gates + (size_t)(row0 + ai * HALF + m * 16) * 3072 + (nb - 1) * 1024 + col0 + bj * HALF;
                    ga[m][bj] = *(const u32x4*)gp; gb[m][bj] = *(const u32x4*)(gp + 1024); }
            __builtin_amdgcn_sched_barrier(0);
#pragma unroll
            for (int m = 0; m < 4; ++m)
#pragma unroll
                for (int bj = 0; bj < 2; ++bj) { const u32x4 a = ga[m][bj], b = gb[m][bj]; f32x4& x0 = acc[ai][bj][m][0]; f32x4& x1 = acc[ai][bj][m][1];
                    x0[0] *= bflo(a.x) * __builtin_amdgcn_rcpf(bflo(b.x)); x0[1] *= bfhi(a.x) * __builtin_amdgcn_rcpf(bfhi(b.x)); x0[2] *= bflo(a.y) * __builtin_amdgcn_rcpf(bflo(b.y)); x0[3] *= bfhi(a.y) * __builtin_amdgcn_rcpf(bfhi(b.y));
                    x1[0] *= bflo(a.z) * __builtin_amdgcn_rcpf(bflo(b.z)); x1[1] *= bfhi(a.z) * __builtin_amdgcn_rcpf(bfhi(b.z)); x1[2] *= bflo(a.w) * __builtin_amdgcn_rcpf(bflo(b.w)); x1[3] *= bfhi(a.w) * __builtin_amdgcn_rcpf(bfhi(b.w)); }
            __builtin_amdgcn_sched_barrier(0);
        }
    }
    __device__ __forceinline__ void operator()(const f32x4 (&acc)[2][2][4][2], const Unit& u, int wr, int wc, int fr, int fq) const {
        const int row0 = u.pm * BM + wr * 64 + fr, col0 = u.pn * BM + wc * 32 + 8 * fq;
#pragma unroll
        for (int ai = 0; ai < 2; ++ai) {
            u32x4 g8[4][2];
#pragma unroll
            for (int m = 0; m < 4; ++m)
#pragma unroll
                for (int bj = 0; bj < 2; ++bj) g8[m][bj] = *(const u32x4*)(gates + (size_t)(row0 + ai * HALF + m * 16) * 3072 + 2048 + col0 + bj * HALF);
            __builtin_amdgcn_sched_barrier(0);
#pragma unroll
            for (int m = 0; m < 4; ++m)
#pragma unroll
                for (int bj = 0; bj < 2; ++bj) { const u32x4 g = g8[m][bj]; f32x4 a = acc[ai][bj][m][0], b = acc[ai][bj][m][1];
                    a[0] *= bflo(g.x); a[1] *= bfhi(g.x); a[2] *= bflo(g.y); a[3] *= bfhi(g.y); b[0] *= bflo(g.z); b[1] *= bfhi(g.z); b[2] *= bflo(g.w); b[3] *= bfhi(g.w);
                    *(u32x4*)(merged + (size_t)(row0 + ai * HALF + m * 16) * 1024 + col0 + bj * HALF) = pack8(a, b); }
            __builtin_amdgcn_sched_barrier(0);
        }
    }
};
struct EpiH {
    static constexpr bool PERM = true, AFTER_DRAIN = false, HAS_MID = false;
    const bf16_t* x; float* out; bf16_t* hb; float* rowsq; int noatomic;
    __device__ __forceinline__ void operator()(const f32x4 (&acc)[2][2][4][2], const Unit& u, int wr, int wc, int fr, int fq) const {
        const int row0 = u.pm * BM + wr * 64 + fr, col0 = u.pn * BM + wc * 32 + 8 * fq;
#pragma unroll
        for (int ai = 0; ai < 2; ++ai) {
            u32x4 xv[4][2];
#pragma unroll
            for (int m = 0; m < 4; ++m)
#pragma unroll
                for (int bj = 0; bj < 2; ++bj) xv[m][bj] = *(const u32x4*)(x + ((size_t)(row0 + ai * HALF + m * 16) * 1024 + col0 + bj * HALF));
            __builtin_amdgcn_sched_barrier(0);
#pragma unroll
            for (int m = 0; m < 4; ++m) { const int row = row0 + ai * HALF + m * 16; float ss = 0.f;
#pragma unroll
                for (int bj = 0; bj < 2; ++bj) { const size_t o = (size_t)row * 1024 + col0 + bj * HALF;
                    const u32x4 xq = xv[m][bj]; f32x4 h0 = acc[ai][bj][m][0], h1 = acc[ai][bj][m][1];
                    h0[0] += bflo(xq.x); h0[1] += bfhi(xq.x); h0[2] += bflo(xq.y); h0[3] += bfhi(xq.y); h1[0] += bflo(xq.z); h1[1] += bfhi(xq.z); h1[2] += bflo(xq.w); h1[3] += bfhi(xq.w);
                    *(u32x4*)(hb + o) = pack8(h0, h1);
                    ss += (h0[0] * h0[0] + h0[1] * h0[1]) + (h0[2] * h0[2] + h0[3] * h0[3]) + (h1[0] * h1[0] + h1[1] * h1[1]) + (h1[2] * h1[2] + h1[3] * h1[3]); }
                ss += __shfl_xor(ss, 16); ss += __shfl_xor(ss, 32);
                if (fq == 0 && !noatomic) atomicAdd(rowsq + row, ss); }
            __builtin_amdgcn_sched_barrier(0);
        }
    }
};
struct EpiQ {
    static constexpr bool PERM = true, AFTER_DRAIN = false, HAS_MID = false;
    const float* rowsq; bf16_t* qb;
    __device__ __forceinline__ void operator()(const f32x4 (&acc)[2][2][4][2], const Unit& u, int wr, int wc, int fr, int fq) const {
        const int row0 = u.pm * BM + wr * 64 + fr, col0 = u.pn * BM + wc * 32 + 8 * fq;
        float rq[2][4];
#pragma unroll
        for (int ai = 0; ai < 2; ++ai)
#pragma unroll
            for (int m = 0; m < 4; ++m) rq[ai][m] = rowsq[row0 + ai * HALF + m * 16];
#pragma unroll
        for (int ai = 0; ai < 2; ++ai)
#pragma unroll
            for (int m = 0; m < 4; ++m) { const int row = row0 + ai * HALF + m * 16; const float r = rsqrtf(rq[ai][m] * (1.0f / 1024.0f) + RMS_EPS);
#pragma unroll
                for (int bj = 0; bj < 2; ++bj) *(u32x4*)(qb + (size_t)row * 2048 + col0 + bj * HALF) = pack8(acc[ai][bj][m][0] * r, acc[ai][bj][m][1] * r); }
    }
};

template <class Epi, class Sched, bool ALIGN_EPI = false, bool SP2 = false>
__device__ __forceinline__ void gemm_phase(PG8_LAS unsigned char* lds, const int K, const Sched& S, const Epi& E) {
    const int tid = threadIdx.x, wid = __builtin_amdgcn_readfirstlane(tid >> 6), lane = tid & 63, wr = wid >> 2, wc = wid & 3, fr = lane & 15, fq = lane >> 4;
    const int nt = K / BK;
    unsigned voffA[2], voffB[2];
#pragma unroll
    for (int i = 0; i < 2; ++i) { int R, C; stage_rc(tid * 16 + i * 8192, R, C); const int Rb = Epi::PERM ? ((R & ~31) + perm32(R & 31)) : R;
        voffA[i] = (unsigned)(R * K + C) * 2u; voffB[i] = (unsigned)(Rb * K + C) * 2u; }
    const size_t kstep = (size_t)(BK * 2);
    const size_t hstep = (size_t)HALF * K * 2;
    const size_t tstep = 2 * hstep;
    const unsigned ldsw = (unsigned)wid * 1024u;
    const int aoff = lds_byte(wr * 64 + fr, fq * 8), boff = lds_byte(wc * 32 + fr, fq * 8);
#define PG8_SA(b, h) (((b) * 2 + (h)) * HTB)
#define PG8_SB(b, h) ((4 + (b) * 2 + (h)) * HTB)
#define PG8_STAGE(bufoff, gbase, voff) do { _Pragma("unroll") for (int _i = 0; _i < 2; ++_i) \
        __builtin_amdgcn_global_load_lds((const unsigned*)((const char*)(gbase) + (voff)[_i]), (PG8_LAS unsigned*)(lds + (bufoff) + ldsw + _i * 8192), 16, 0, 0); } while (0)
#define PG8_LDA(dst, b, h) do { _Pragma("unroll") for (int m = 0; m < 4; ++m) _Pragma("unroll") for (int k = 0; k < 2; ++k) dst[m][k] = *(const PG8_LAS bf16x8*)(lds + PG8_SA(b, h) + aoff + m * 2048 + k * 1024); } while (0)
#define PG8_LDB(dst, b, h) do { _Pragma("unroll") for (int n = 0; n < 2; ++n) _Pragma("unroll") for (int k = 0; k < 2; ++k) dst[n][k] = *(const PG8_LAS bf16x8*)(lds + PG8_SB(b, h) + boff + n * 2048 + k * 1024); } while (0)
#define PG8_MMA(ai, bj, At, Bt) do { __builtin_amdgcn_s_setprio(1); _Pragma("unroll") for (int m = 0; m < 4; ++m) _Pragma("unroll") for (int n = 0; n < 2; ++n) _Pragma("unroll") for (int k = 0; k < 2; ++k) \
        acc[ai][bj][m][n] = __builtin_amdgcn_mfma_f32_16x16x32_bf16(Bt[n][k], At[m][k], acc[ai][bj][m][n], 0, 0, 0); __builtin_amdgcn_s_setprio(0); } while (0)
#define PG8_WAIT_V(n) asm volatile("s_waitcnt vmcnt(" #n ")" ::: "memory")
#define PG8_WAIT_L(n) asm volatile("s_waitcnt lgkmcnt(" #n ")" ::: "memory")
#define PG8_BAR __builtin_amdgcn_s_barrier()
#define PG8_SCHED __builtin_amdgcn_sched_barrier(0)
    Unit cur, nxt; int ui = 0;
    if (!S.next(0, cur)) return;
    f32x4 acc[2][2][4][2];
#pragma unroll
    for (int a = 0; a < 2; ++a)
#pragma unroll
        for (int b = 0; b < 2; ++b)
#pragma unroll
            for (int m = 0; m < 4; ++m)
#pragma unroll
                for (int n = 0; n < 2; ++n) acc[a][b][m][n] = (f32x4){0.f, 0.f, 0.f, 0.f};
    bf16x8 At[4][2], B0[2][2], B1[2][2];
    const char* cA = S.abase(cur); const char* cB = S.bbase(cur);
    S.a_ready(cur);
    if constexpr (SP2) {
        PG8_STAGE(PG8_SB(0, 0), cB, voffB); PG8_STAGE(PG8_SB(0, 1), cB + hstep, voffB); PG8_STAGE(PG8_SA(0, 0), cA, voffA); PG8_STAGE(PG8_SA(0, 1), cA + hstep, voffA);
        if (wr == 1) PG8_BAR;
        PG8_WAIT_V(2); PG8_BAR;
        PG8_STAGE(PG8_SB(1, 0), cB + kstep, voffB); PG8_STAGE(PG8_SA(1, 0), cA + kstep, voffA); PG8_STAGE(PG8_SB(1, 1), cB + hstep + kstep, voffB);
        PG8_WAIT_V(6); PG8_BAR;
    } else {
        PG8_STAGE(PG8_SB(0, 0), cB, voffB); PG8_STAGE(PG8_SA(0, 0), cA, voffA); PG8_STAGE(PG8_SB(0, 1), cB + hstep, voffB); PG8_STAGE(PG8_SA(0, 1), cA + hstep, voffA);
        if (wr == 1) PG8_BAR;
        PG8_WAIT_V(4); PG8_BAR;
        PG8_STAGE(PG8_SB(1, 0), cB + kstep, voffB); PG8_STAGE(PG8_SA(1, 0), cA + kstep, voffA); PG8_STAGE(PG8_SB(1, 1), cB + hstep + kstep, voffB);
        PG8_WAIT_V(6); PG8_BAR;
    }
    for (;;) {
        const bool has_next = S.next(ui + 1, nxt);
        const char* nA = has_next ? S.abase(nxt) : cA; const char* nB = has_next ? S.bbase(nxt) : cB;
        for (int t = 0; t < nt; t += 2) {
            if constexpr (Epi::HAS_MID) { if (t == 8 || t == 16) E.mid(acc, cur, t >> 3, wr, wc, fr, fq); }
            const bool last = (t == nt - 2);
            const char* a1 = cA + (size_t)(t + 1) * kstep;
            const char* a2 = last ? nA : cA + (size_t)(t + 2) * kstep; const char* b2 = last ? nB : cB + (size_t)(t + 2) * kstep;
            const char* a3 = a2 + kstep; const char* b3 = b2 + kstep;
            if (last && has_next) S.a_ready(nxt);
            if constexpr (SP2) {
            PG8_LDB(B0, 0, 0); PG8_LDB(B1, 0, 1); PG8_SCHED; PG8_LDA(At, 0, 0); PG8_STAGE(PG8_SA(1, 1), a1 + hstep, voffA);
            PG8_WAIT_V(8); PG8_WAIT_L(0); PG8_BAR; PG8_MMA(0, 0, At, B0); PG8_MMA(0, 1, At, B1); PG8_BAR; PG8_SCHED;
            PG8_LDA(At, 0, 1); PG8_STAGE(PG8_SB(0, 0), b2, voffB); PG8_STAGE(PG8_SB(0, 1), b2 + hstep, voffB); PG8_STAGE(PG8_SA(0, 0), a2, voffA);
            PG8_WAIT_V(8); PG8_WAIT_L(0); PG8_BAR; PG8_MMA(1, 0, At, B0); PG8_MMA(1, 1, At, B1); PG8_BAR; PG8_SCHED;
            PG8_LDB(B0, 1, 0); PG8_LDB(B1, 1, 1); PG8_SCHED; PG8_LDA(At, 1, 0); PG8_STAGE(PG8_SA(0, 1), a2 + hstep, voffA);
            PG8_WAIT_V(8); PG8_WAIT_L(0); PG8_BAR; PG8_MMA(0, 0, At, B0); PG8_MMA(0, 1, At, B1); PG8_BAR; PG8_SCHED;
            PG8_LDA(At, 1, 1); PG8_STAGE(PG8_SB(1, 0), b3, voffB); PG8_STAGE(PG8_SB(1, 1), b3 + hstep, voffB); PG8_STAGE(PG8_SA(1, 0), a3, voffA);
            PG8_WAIT_V(8); PG8_WAIT_L(0); PG8_BAR; PG8_MMA(1, 0, At, B0); PG8_MMA(1, 1, At, B1); PG8_BAR; PG8_SCHED;
            } else {
            PG8_LDB(B0, 0, 0); PG8_SCHED; PG8_LDA(At, 0, 0); PG8_STAGE(PG8_SA(1, 1), a1 + hstep, voffA);
            PG8_WAIT_L(8); PG8_BAR; PG8_WAIT_L(0); PG8_MMA(0, 0, At, B0); PG8_BAR; PG8_SCHED;
            PG8_LDB(B1, 0, 1); PG8_STAGE(PG8_SB(0, 0), b2, voffB);
            PG8_BAR; PG8_WAIT_L(0); PG8_MMA(0, 1, At, B1); PG8_BAR;
            PG8_LDA(At, 0, 1); PG8_STAGE(PG8_SA(0, 0), a2, voffA);
            PG8_BAR; PG8_WAIT_L(0); PG8_MMA(1, 0, At, B0); PG8_BAR; PG8_SCHED;
            PG8_STAGE(PG8_SB(0, 1), b2 + hstep, voffB);
            PG8_WAIT_V(6); PG8_BAR; PG8_MMA(1, 1, At, B1); PG8_BAR;
            PG8_LDB(B0, 1, 0); PG8_SCHED; PG8_LDA(At, 1, 0); PG8_STAGE(PG8_SA(0, 1), a2 + hstep, voffA);
            PG8_WAIT_L(8); PG8_BAR; PG8_WAIT_L(0); PG8_MMA(0, 0, At, B0); PG8_BAR; PG8_SCHED;
            PG8_LDB(B1, 1, 1); PG8_STAGE(PG8_SB(1, 0), b3, voffB);
            PG8_BAR; PG8_WAIT_L(0); PG8_MMA(0, 1, At, B1); PG8_BAR;
            PG8_LDA(At, 1, 1); PG8_STAGE(PG8_SA(1, 0), a3, voffA);
            PG8_BAR; PG8_WAIT_L(0); PG8_MMA(1, 0, At, B0); PG8_BAR; PG8_SCHED;
            PG8_STAGE(PG8_SB(1, 1), b3 + hstep, voffB);
            PG8_WAIT_V(6); PG8_BAR; PG8_MMA(1, 1, At, B1); PG8_BAR;
            }
        }
        if constexpr (ALIGN_EPI) { if (wr == 0) PG8_BAR; }
        if constexpr (!Epi::AFTER_DRAIN) { E(acc, cur, wr, wc, fr, fq); S.done(cur); }
        if (!has_next) break;
#pragma unroll
        for (int a = 0; a < 2; ++a)
#pragma unroll
            for (int b = 0; b < 2; ++b)
#pragma unroll
                for (int m = 0; m < 4; ++m)
#pragma unroll
                    for (int n = 0; n < 2; ++n) acc[a][b][m][n] = (f32x4){0.f, 0.f, 0.f, 0.f};
        cur = nxt; cA = nA; cB = nB; ++ui;
        if constexpr (ALIGN_EPI) { if (wr == 1) PG8_BAR; }
    }
    PG8_WAIT_V(0);
    if constexpr (!ALIGN_EPI) { if (wr == 0) PG8_BAR; }
    PG8_BAR;
    if constexpr (Epi::AFTER_DRAIN) { E.fused(acc, cur, wr, wc, fr, fq, lds, wid, lane); S.done(cur); }
#undef PG8_SA
#undef PG8_SB
#undef PG8_STAGE
#undef PG8_LDA
#undef PG8_LDB
#undef PG8_MMA
#undef PG8_WAIT_V
#undef PG8_WAIT_L
#undef PG8_BAR
#undef PG8_SCHED
}
}

constexpr int NWAVES = 8;
constexpr int N_LAUNCHES = MK_N_LAUNCHES;
constexpr int PER_PHASE = 9;
constexpr int NBATCH = 4, SEQ = 8192, D = 1024, T = NBATCH * SEQ, MEMLEN = 256, NMEMTOK = NBATCH * MEMLEN;
constexpr int IN_MAIN = 5120;
constexpr int NEXP = 16384;

constexpr size_t MiB = 1u << 20;
constexpr size_t WS_CTL = 0, CTL_ZERO_BYTES = 512 * 1024;
constexpr size_t WS_ROWSQ = 256 * 1024;
constexpr size_t WS_WIN = 1 * MiB, WS_WV = 11 * MiB, WS_WKV = 12 * MiB, WS_WBR = 14 * MiB, WS_WOUT = 17 * MiB, WS_WQ = 19 * MiB, WS_KEYS = 23 * MiB, WS_PWT = 23 * MiB + 512 * 1024;
constexpr size_t WS_MEMN = 24 * MiB, WS_KMEM = 26 * MiB, WS_VTMEM = 27 * MiB, WS_RSTDX = 28 * MiB, WS_SU = 28 * MiB + 256 * 1024  , WS_SV = 28 * MiB + 512 * 1024  ;
constexpr size_t WS_U8 = 32 * MiB, WS_V8 = 48 * MiB;
constexpr size_t WS_QN = 96 * MiB, WS_KN = 128 * MiB, WS_VT = 160 * MiB, WS_PP = 192 * MiB, WS_XQ = 224 * MiB, WS_GATE = 256 * MiB, WS_XB = 448 * MiB  , WS_END = 512 * MiB;
constexpr size_t WS_MERGED = WS_QN;
constexpr size_t WS_HB = WS_VT;
constexpr size_t WS_QB = WS_GATE;
constexpr size_t WS_TE = WS_GATE + 128 * MiB, WS_TW = WS_TE + 16 * MiB;
constexpr size_t WS_HQ = WS_TW + 16 * MiB;
constexpr size_t WS_HS = 28 * MiB + 768 * 1024;
constexpr size_t WS_AW = WS_MERGED;
constexpr size_t OUT_XB = 0, OUT_YNA = 0, OUT_YPOOL = 512 * 2, OUT_YXA = 1024 * 2;
constexpr int CW_TMO = 0, CW_BAR = 4096, CW_TICKET = 8192;

constexpr int RING_OFF = 0, RING_BYTES = 131072;
constexpr int LDSCTL_OFF = RING_BYTES, MISC_OFF = LDSCTL_OFF + 320;
constexpr int LDS_BYTES = 147456;

#define GAS __attribute__((address_space(1)))
#define LAS __attribute__((address_space(3)))
typedef unsigned short bf16;
typedef unsigned v4u __attribute__((ext_vector_type(4)));
typedef unsigned v2u __attribute__((ext_vector_type(2)));
typedef float f32x4 __attribute__((ext_vector_type(4)));
typedef short bf16x8 __attribute__((ext_vector_type(8)));
typedef __bf16 bf16x2_t __attribute__((ext_vector_type(2)));
typedef GAS unsigned gu32;
#define LDS_WAIT() asm volatile("s_waitcnt lgkmcnt(0)" ::: "memory")
#define VM_WAIT() asm volatile("s_waitcnt vmcnt(0)" ::: "memory")
__device__ __forceinline__ unsigned f2bf(float f) { unsigned u = __builtin_bit_cast(unsigned, f); return (u + 0x7fffu + ((u >> 16) & 1u)) >> 16; }
__device__ __forceinline__ unsigned pk2(float lo, float hi) { return f2bf(lo) | (f2bf(hi) << 16); }
__device__ __forceinline__ float bflo(unsigned u) { return __builtin_bit_cast(float, u << 16); }
__device__ __forceinline__ float bfhi(unsigned u) { return __builtin_bit_cast(float, u & 0xffff0000u); }
__device__ __forceinline__ float bf1(short s) { return __builtin_bit_cast(float, ((unsigned)(unsigned short)s) << 16); }
__device__ __forceinline__ f32x4 mfma16(bf16x8 a, bf16x8 b, f32x4 c) { return __builtin_amdgcn_mfma_f32_16x16x32_bf16(a, b, c, 0, 0, 0); }
__device__ __forceinline__ float wave_sum(float v) {
#pragma unroll
    for (int o = 1; o < 64; o <<= 1) v += __shfl_xor(v, o);
    return v;
}

#define XB_TMO      128
#define XB_XCNT(j)  (256  + 64 * (j))
#define XB_XSUB(j)  (1280 + 64 * (j))
#define XB_XGEN(j)  (2304 + 64 * (j))
#define XB_TOP      3328
#define XB_TOPGEN   3392
#define XCD_BAR_WORDS 3456
#define XB_SPIN_CAP (1u << 18)

__device__ __forceinline__ unsigned xb_ld(unsigned* p)              { return __hip_atomic_load(p, __ATOMIC_RELAXED, __HIP_MEMORY_SCOPE_AGENT); }
__device__ __forceinline__ unsigned xb_add(unsigned* p, unsigned v) { return __hip_atomic_fetch_add(p, v, __ATOMIC_RELAXED, __HIP_MEMORY_SCOPE_AGENT); }
__device__ __forceinline__ unsigned xb_xcc_id() { return (unsigned)__builtin_amdgcn_s_getreg((3 << 11) | 20) & 0xFu; }
#define XB_SPIN(cond, bar) do { unsigned _sp = 0; while (cond) { __builtin_amdgcn_s_sleep(1); \
    if ((++_sp & 255u) == 0u) { if (xb_ld(&(bar)[XB_TMO])) break; if (_sp > XB_SPIN_CAP) { atomicAdd(&(bar)[XB_TMO], 1u); break; } } } } while (0)

struct XcdBarrier {
    unsigned* bar; unsigned x;
    volatile LAS unsigned* st;
};

__device__ __forceinline__ XcdBarrier xcd_barrier_post(unsigned* bar, volatile LAS unsigned* st) {
    XcdBarrier b; b.bar = bar; b.x = xb_xcc_id(); b.st = st;
    if (threadIdx.x == 0) (void)xb_add(&bar[XB_XCNT(b.x)], 1u);
    return b;
}
__device__ __forceinline__ void xcd_barrier_complete(unsigned* bar, unsigned x, unsigned& nloc, unsigned& nx) {
    const unsigned G = gridDim.x * gridDim.y * gridDim.z;
    unsigned sum, cnt, mine, sp = 0u;
    for (;;) {
        sum = 0u; cnt = 0u; mine = 0u;
#pragma unroll
        for (unsigned j = 0; j < 16; ++j) { const unsigned c = xb_ld(&bar[XB_XCNT(j)]); sum += c; cnt += (c > 0u) ? 1u : 0u; mine = (j == x) ? c : mine; }
        if (sum == G) break;
        __builtin_amdgcn_s_sleep(1);
        if ((++sp & 255u) == 0u) { if (xb_ld(&bar[XB_TMO])) break; if (sp > XB_SPIN_CAP) { atomicAdd(&bar[XB_TMO], 1u); break; } }
    }
    nloc = mine > 0u ? mine : 1u; nx = cnt > 0u ? cnt : 1u;
}

__device__ __forceinline__ void xcd_barrier(const XcdBarrier& b) {
    asm volatile("s_waitcnt vmcnt(0)" ::: "memory");
    __syncthreads();
    if (threadIdx.x == 0) {
        unsigned* bar = b.bar;
        __builtin_amdgcn_s_waitcnt(0);
        unsigned nloc = b.st[0], nx = b.st[1];
        if (nloc == 0u) { xcd_barrier_complete(bar, b.x, nloc, nx); b.st[0] = nloc; b.st[1] = nx; }
        const unsigned old = xb_add(&bar[XB_XSUB(b.x)], 1u);
        const unsigned gen = old / nloc;
        if (old + 1u == (gen + 1u) * nloc) {
            __builtin_amdgcn_fence(__ATOMIC_RELEASE, "agent");
            asm volatile("s_waitcnt vmcnt(0)" ::: "memory");
            const unsigned og = xb_add(&bar[XB_TOP], 1u);
            const unsigned tg = og / nx;
            if (og + 1u == (tg + 1u) * nx) xb_add(&bar[XB_TOPGEN], 1u);
            else XB_SPIN(xb_ld(&bar[XB_TOPGEN]) == tg, bar);
            __builtin_amdgcn_fence(__ATOMIC_ACQUIRE, "agent");
            xb_add(&bar[XB_XGEN(b.x)], 1u);
            asm volatile("s_waitcnt vmcnt(0)" ::: "memory");
        } else {
            XB_SPIN(xb_ld(&bar[XB_XGEN(b.x)]) == gen, bar);
            __builtin_amdgcn_fence(__ATOMIC_ACQUIRE, "agent");
            asm volatile("s_waitcnt vmcnt(0)" ::: "memory");
        }
    }
    __syncthreads();
}

struct Frame {
    LAS unsigned char* lds;
    volatile LAS unsigned* MISC;
    gu32* ctl;
    int tid, lane, wave, vcu, G;
    float* out; unsigned char* ws;
};
struct Args { const float* in[23]; float* out; unsigned char* ws; int ph_lo, ph_hi, probe, pad; };
enum { I_X = 0, I_MEM, I_MIXG, I_MEMG, I_WIN, I_GATEB, I_WKV, I_NAQG, I_NAKG, I_RPB, I_POOLW, I_POOLSC, I_XAQG, I_XAKG, I_WB0, I_WB1, I_WB2, I_WOUT, I_FFNG, I_WQ, I_KEYS, I_PU, I_PV };

__device__ __forceinline__ void p0_transpose_item(const float* W, int K, int N, int k0, int n0, bf16* dst, const float* kscale, LAS float* scr, int lane, int dpitch = 0) {
    if (dpitch == 0) dpitch = K;
#pragma unroll 8
    for (int i = 0; i < 32; ++i) { const int kk = 2 * i + (lane >> 5); float v = W[(size_t)(k0 + kk) * N + n0 + (lane & 31)]; if (kscale) v *= kscale[k0 + kk]; scr[kk * 33 + (lane & 31)] = v; }
    LDS_WAIT(); asm volatile("" ::: "memory");
    const int c = lane & 7;
#pragma unroll
    for (int j = 0; j < 4; ++j) { const int n = (lane >> 3) + 8 * j; const LAS float* s = scr + (8 * c) * 33 + n;
        v4u o; o.x = pk2(s[0 * 33], s[1 * 33]); o.y = pk2(s[2 * 33], s[3 * 33]); o.z = pk2(s[4 * 33], s[5 * 33]); o.w = pk2(s[6 * 33], s[7 * 33]);
        *(GAS v4u*)(dst + (size_t)n * dpitch + k0 + 8 * c) = o; }
    LDS_WAIT(); asm volatile("" ::: "memory");
}
__device__ __forceinline__ void cvt_row1024(const float* src, bf16* dst, const float* colscale, float rowscale, int lane) {
    const GAS f32x4* xr = (const GAS f32x4*)src + lane; GAS unsigned long long* o8 = (GAS unsigned long long*)dst + lane;
#pragma unroll
    for (int j = 0; j < 4; ++j) { f32x4 v = xr[64 * j] * rowscale; if (colscale) v = v * ((const GAS f32x4*)colscale)[lane + 64 * j];
        o8[64 * j] = (unsigned long long)pk2(v.x, v.y) | ((unsigned long long)pk2(v.z, v.w) << 32); }
}
__device__ __forceinline__ float row_rstd1024(const float* src, int lane) {
    const GAS f32x4* xr = (const GAS f32x4*)src + lane; float s = 0.f;
#pragma unroll
    for (int j = 0; j < 4; ++j) { const f32x4 v = xr[64 * j]; s += (v.x * v.x + v.y * v.y) + (v.z * v.z + v.w * v.w); }
    return rsqrtf(wave_sum(s) * (1.0f / 1024.0f) + 1e-6f);
}
__device__ __forceinline__ void p0_prologue(Frame& F, const Args& A) {
    LAS float* scr = (LAS float*)(F.lds + RING_OFF + F.wave * 16384);
    const int gw = F.vcu * NWAVES + F.wave, NGW = F.G * NWAVES, lane = F.lane;
    unsigned char* ws = F.ws;
    constexpr int I_IN = 16 * 176, I_KV = 16 * 32, I_BR = 8 * 32, I_OUT = 16 * 32, I_Q = 16 * 64;
    constexpr int NITEMS = I_IN + I_KV + 3 * I_BR + I_OUT + I_Q;
    if (!(A.probe & 1)) for (int it = gw; it < NITEMS; it += NGW) {
        int r = it;
        if (r < I_IN) { const int kb = r / 176, nb = r % 176, n0 = 32 * nb; bf16* dst;
            if (n0 >= 1024 && n0 < 1536) dst = (bf16*)(ws + WS_WV) + (size_t)(n0 - 1024) * 1024;
            else { const int np = n0 < 1024 ? n0 : n0 - 512, t = np >> 8, w = np & 255, wc = w >> 6, bj = (w >> 5) & 1; dst = (bf16*)(ws + WS_WIN) + (size_t)(256 * t + 128 * bj + 32 * wc) * 1024; }
            p0_transpose_item(A.in[I_WIN], 1024, 5632, 64 * kb, n0, dst, A.in[I_MIXG], scr, lane); continue; }
        r -= I_IN;
        if (r < I_KV) { const int kb = r / 32, nb = r % 32; p0_transpose_item(A.in[I_WKV], 1024, 1024, 64 * kb, 32 * nb, (bf16*)(ws + WS_WKV) + (size_t)(32 * nb) * 1024, nullptr, scr, lane); continue; }
        r -= I_KV;
        if (r < 3 * I_BR) { const int br = r / I_BR, rr = r % I_BR, kb = rr / 32, nb = rr % 32; const float* W = br == 0 ? A.in[I_WB0] : (br == 1 ? A.in[I_WB1] : A.in[I_WB2]);
            p0_transpose_item(W, 512, 1024, 64 * kb, 32 * nb, (bf16*)(ws + WS_WBR) + (size_t)(32 * nb) * 1536 + br * 512, nullptr, scr, lane, 1536); continue; }
        r -= 3 * I_BR;
        if (r < I_OUT) { const int kb = r / 32, nb = r % 32; p0_transpose_item(A.in[I_WOUT], 1024, 1024, 64 * kb, 32 * nb, (bf16*)(ws + WS_WOUT) + (size_t)(32 * nb) * 1024, nullptr, scr, lane); continue; }
        r -= I_OUT;
        { const int kb = r / 64, nb = r % 64; p0_transpose_item(A.in[I_WQ], 1024, 2048, 64 * kb, 32 * nb, (bf16*)(ws + WS_WQ) + (size_t)(32 * nb) * 1024, A.in[I_FFNG], scr, lane); }
    }
    { bf16* xb = (bf16*)(ws + WS_XB); float* rstdx = (float*)(ws + WS_RSTDX);
      if (!(A.probe & 2)) for (int m0 = 4 * gw; m0 < T; m0 += 4 * NGW) {
          f32x4 v[4][4];
#pragma unroll
          for (int r = 0; r < 4; ++r)
#pragma unroll
              for (int j = 0; j < 4; ++j) v[r][j] = ((const GAS f32x4*)(A.in[I_X] + (size_t)(m0 + r) * D))[lane + 64 * j];
#pragma unroll
          for (int r = 0; r < 4; ++r) { float s = 0.f;
#pragma unroll
              for (int j = 0; j < 4; ++j) s += (v[r][j].x * v[r][j].x + v[r][j].y * v[r][j].y) + (v[r][j].z * v[r][j].z + v[r][j].w * v[r][j].w);
              const float rs = rsqrtf(wave_sum(s) * (1.0f / 1024.0f) + 1e-6f);
              GAS unsigned long long* o8 = (GAS unsigned long long*)(xb + (size_t)(m0 + r) * D) + lane;
#pragma unroll
              for (int j = 0; j < 4; ++j) o8[64 * j] = (unsigned long long)pk2(v[r][j].x, v[r][j].y) | ((unsigned long long)pk2(v[r][j].z, v[r][j].w) << 32);
              if (lane == 0) rstdx[m0 + r] = rs; } } }
    for (int m = gw; m < NMEMTOK; m += NGW) { const float* xr = A.in[I_MEM] + (size_t)m * D; const float rs = row_rstd1024(xr, lane); cvt_row1024(xr, (bf16*)(ws + WS_MEMN) + (size_t)m * D, A.in[I_MEMG], rs, lane); }
    if (!(A.probe & 4)) for (int mb = 4 * gw; mb < 2 * NEXP; mb += 4 * NGW) {
        const bool isu = mb < NEXP; const int e0 = isu ? mb : mb - NEXP;
        f32x4 v[4][4];
#pragma unroll
        for (int r = 0; r < 4; ++r) { const GAS f32x4* src = (const GAS f32x4*)((isu ? A.in[I_PU] : A.in[I_PV]) + (size_t)(e0 + r) * D) + 4 * lane;
#pragma unroll
            for (int d = 0; d < 4; ++d) v[r][d] = src[d]; }
        f32x4 gv[4];
#pragma unroll
        for (int d = 0; d < 4; ++d) gv[d] = isu ? ((const GAS f32x4*)A.in[I_FFNG])[4 * lane + d] : (f32x4){1.f, 1.f, 1.f, 1.f};
#pragma unroll
        for (int r = 0; r < 4; ++r) { const int e = e0 + r; float mx = 0.f;
#pragma unroll
            for (int d = 0; d < 4; ++d) { v[r][d] = v[r][d] * gv[d]; mx = fmaxf(mx, fmaxf(fmaxf(fabsf(v[r][d].x), fabsf(v[r][d].y)), fmaxf(fabsf(v[r][d].z), fabsf(v[r][d].w)))); }
#pragma unroll
            for (int o = 1; o < 64; o <<= 1) mx = fmaxf(mx, __shfl_xor(mx, o));
            const float inv = mx > 0.f ? 127.0f / mx : 0.f;
            v4u w;
#pragma unroll
            for (int d = 0; d < 4; ++d) { const unsigned b0 = (unsigned)(int)rintf(v[r][d].x * inv) & 0xffu, b1 = (unsigned)(int)rintf(v[r][d].y * inv) & 0xffu,
                                                         b2 = (unsigned)(int)rintf(v[r][d].z * inv) & 0xffu, b3 = (unsigned)(int)rintf(v[r][d].w * inv) & 0xffu;
                w[d] = b0 | (b1 << 8) | (b2 << 16) | (b3 << 24); }
            if (isu) ((GAS v4u*)(ws + WS_U8))[(size_t)e * 64 + lane] = w;
            else *(GAS v4u*)(ws + WS_V8 + (size_t)(lane >> 3) * (2 * MiB) + (size_t)e * 128 + (lane & 7) * 16) = w;
            if (lane == 0) ((float*)(ws + WS_SU))[2 * e + (isu ? 0 : 1)] = mx * (1.0f / 127.0f); }
    }
    for (int m = gw * 64 + lane; m < T; m += NGW * 64) ((float*)(ws + WS_ROWSQ))[m] = 0.f;
    for (int m = gw; m < 256; m += NGW) cvt_row1024(A.in[I_KEYS] + (size_t)m * 1024, (bf16*)(ws + WS_KEYS) + (size_t)m * 1024, nullptr, 1.0f, lane);
    for (int m = gw; m < 1024; m += NGW) { const int gd = m >> 1, c = (m & 1) * 64 + lane, g = gd >> 7, d = gd & 127;
        const float v = A.in[I_POOLW][(size_t)(g * 128 + c) * 128 + d] * A.in[I_POOLSC][gd];
        ((bf16*)(ws + WS_PWT))[(size_t)gd * 128 + c] = (bf16)f2bf(v); }
}

__device__ __forceinline__ void memkv_tile(const bf16* memn, const bf16* wkvT, const float* kg, const float* qg, bf16* kmem, bf16* vtmem, LAS float* part, int tile, int kc, int lane) {
    const int q = lane & 15, hi = lane >> 4, rg = (tile < 0 ? 0 : tile) >> 3, cg = (tile < 0 ? 0 : tile) & 7, r0 = rg * 16, c0 = cg * 128;
    f32x4 acc[8];
#pragma unroll
    for (int i = 0; i < 8; ++i) acc[i] = (f32x4){0.f, 0.f, 0.f, 0.f};
    const bf16* ap = memn + (size_t)(r0 + q) * 1024 + 8 * hi; const bf16* bp = wkvT + (size_t)(c0 + q) * 1024 + 8 * hi;
    if (tile >= 0)
#pragma unroll 1
    for (int kb = 2 * kc; kb < 2 * kc + 2; ++kb) {
        bf16x8 a[4], b[4][8];
#pragma unroll
        for (int k4 = 0; k4 < 4; ++k4) { a[k4] = *(const bf16x8*)(ap + 32 * (4 * kb + k4));
#pragma unroll
            for (int nf = 0; nf < 8; ++nf) b[k4][nf] = *(const bf16x8*)(bp + (size_t)(16 * nf) * 1024 + 32 * (4 * kb + k4)); }
        __builtin_amdgcn_sched_barrier(0);
#pragma unroll
        for (int k4 = 0; k4 < 4; ++k4)
#pragma unroll
            for (int nf = 0; nf < 8; ++nf) acc[nf] = mfma16(a[k4], b[k4][nf], acc[nf]);
        __builtin_amdgcn_sched_barrier(0);
    }
    if (tile >= 0 && kc > 0) {
#pragma unroll
        for (int nf = 0; nf < 8; ++nf) *(LAS f32x4*)(part + ((kc - 1) * 8 + nf) * 256 + 4 * lane) = acc[nf]; }
    __syncthreads();
    if (tile < 0 || kc > 0) return;
#pragma unroll
    for (int p = 0; p < 3; ++p)
#pragma unroll
        for (int nf = 0; nf < 8; ++nf) acc[nf] = acc[nf] + *(const LAS f32x4*)(part + (p * 8 + nf) * 256 + 4 * lane);
    if (cg < 4) {
        float rr[4];
#pragma unroll
        for (int g = 0; g < 4; ++g) { float ss = 0.f;
#pragma unroll
            for (int nf = 0; nf < 8; ++nf) ss += acc[nf][g] * acc[nf][g];
            ss += __shfl_xor(ss, 1); ss += __shfl_xor(ss, 2); ss += __shfl_xor(ss, 4); ss += __shfl_xor(ss, 8);
            rr[g] = rsqrtf(ss * (1.0f / 128.0f) + 1e-6f); }
#pragma unroll
        for (int nf = 0; nf < 8; ++nf) { const int d = 16 * nf + q; const float gs = kg[d] * qg[d];
#pragma unroll
            for (int g = 0; g < 4; ++g) kmem[(size_t)(r0 + 4 * hi + g) * 512 + cg * 128 + d] = (bf16)f2bf(acc[nf][g] * rr[g] * gs); }
    } else {
        const int h = cg - 4, b = r0 >> 8, key0 = (r0 & 255) + 4 * hi;
#pragma unroll
        for (int nf = 0; nf < 8; ++nf) { const int d = 16 * nf + q; v2u w; w.x = pk2(acc[nf][0], acc[nf][1]); w.y = pk2(acc[nf][2], acc[nf][3]);
            *(v2u*)(vtmem + (size_t)(b * 512 + h * 128 + d) * 256 + key0) = w; }
    }
}

__device__ __forceinline__ void na_item(const bf16* __restrict__ qn, const bf16* __restrict__ kn, const bf16* __restrict__ vt, const LAS float* rpl, bf16* __restrict__ yna,
                                        int b, int r, int jb, int h, int lane) {
    const int q = lane & 15, hi = lane >> 4;
    int rs = r - 4; rs = rs < 0 ? 0 : (rs > 120 ? 120 : rs);
    int kb0 = jb * 16 - 8; kb0 = kb0 < 0 ? 0 : (kb0 > 32 ? 32 : kb0);
    const int qcol = jb * 16 + q; int cs = qcol - 8; cs = cs < 0 ? 0 : (cs > 48 ? 48 : cs);
    const size_t tokq = (size_t)b * SEQ + r * 64 + qcol;
    const bf16* qp = qn + tokq * 512 + h * 64 + 8 * hi;
    const bf16x8 qf0 = *(const bf16x8*)qp, qf1 = *(const bf16x8*)(qp + 32);
    const int kq = 8 * (q >> 2) + (q & 3);
    const bf16* kbase = kn + ((size_t)b * SEQ + rs * 64 + kb0 + kq) * 512 + h * 64 + 8 * hi;
    f32x4 s[16];
    {
        bf16x8 ka[16][2];
#pragma unroll
        for (int f = 0; f < 16; ++f) { const bf16* kp = kbase + (size_t)((f >> 1) * 64 + (f & 1) * 4) * 512; ka[f][0] = *(const bf16x8*)kp; ka[f][1] = *(const bf16x8*)(kp + 32); }
        __builtin_amdgcn_sched_barrier(0);
#pragma unroll
        for (int f = 0; f < 16; ++f) { f32x4 z = (f32x4){0.f, 0.f, 0.f, 0.f}; z = mfma16(ka[f][0], qf0, z); s[f] = mfma16(ka[f][1], qf1, z); }
    }
    const bf16* vbase = vt + ((size_t)(b * 512 + h * 64 + q) * SEQ + rs * 64 + kb0 + 8 * hi);
    bf16x8 va[8][4];
#pragma unroll
    for (int st = 0; st < 8; ++st)
#pragma unroll
        for (int mf = 0; mf < 4; ++mf) va[st][mf] = *(const bf16x8*)(vbase + (size_t)(16 * mf) * SEQ + st * 64);
    __builtin_amdgcn_sched_barrier(0);
    float mx = -3.0e38f;
#pragma unroll
    for (int c4 = 0; c4 < 4; ++c4) {
        float bb[4][4];
#pragma unroll
        for (int ff = 0; ff < 4; ++ff) { const int f = 4 * c4 + ff, dr = rs + (f >> 1) - r + 7;
#pragma unroll
            for (int g = 0; g < 4; ++g) { const int kcol = kb0 + 8 * hi + 4 * (f & 1) + g; int dc = kcol - qcol + 15; dc = dc < 0 ? 0 : (dc > 30 ? 30 : dc); bb[ff][g] = rpl[dr * 31 + dc]; } }
        __builtin_amdgcn_sched_barrier(0);
#pragma unroll
        for (int ff = 0; ff < 4; ++ff) { const int f = 4 * c4 + ff;
#pragma unroll
            for (int g = 0; g < 4; ++g) { const int kcol = kb0 + 8 * hi + 4 * (f & 1) + g; const bool ok = (kcol >= cs) && (kcol < cs + 16);
                const float v = ok ? s[f][g] + bb[ff][g] : -1.0e30f; s[f][g] = v; mx = fmaxf(mx, v); } }
    }
    mx = fmaxf(mx, __shfl_xor(mx, 16)); mx = fmaxf(mx, __shfl_xor(mx, 32));
    float sum = 0.f;
#pragma unroll
    for (int f = 0; f < 16; ++f)
#pragma unroll
        for (int g = 0; g < 4; ++g) { const float p = __expf(s[f][g] - mx); s[f][g] = p; sum += p; }
    sum += __shfl_xor(sum, 16); sum += __shfl_xor(sum, 32);
    const float inv = 1.0f / sum;
    f32x4 o[4];
#pragma unroll
    for (int i = 0; i < 4; ++i) o[i] = (f32x4){0.f, 0.f, 0.f, 0.f};
#pragma unroll
    for (int st = 0; st < 8; ++st) {
        const bf16x8 pb = __builtin_bit_cast(bf16x8, pg8::pack8(s[2 * st], s[2 * st + 1]));
#pragma unroll
        for (int mf = 0; mf < 4; ++mf) o[mf] = mfma16(va[st][mf], pb, o[mf]);
    }
    bf16* yp = yna + tokq * 1536 + h * 64 + 4 * hi;
#pragma unroll
    for (int mf = 0; mf < 4; ++mf) { v2u w; w.x = pk2(o[mf][0] * inv, o[mf][1] * inv); w.y = pk2(o[mf][2] * inv, o[mf][3] * inv); *(v2u*)(yp + 16 * mf) = w; }
}
__device__ __forceinline__ void xa_fill_lds(const bf16* __restrict__ kmem, const bf16* __restrict__ vtmem, LAS unsigned char* lds, int b, int h, int tid) {
#pragma unroll
    for (int ps = 0; ps < 8; ++ps) { const int id = tid + 512 * ps, key = id >> 4, c = id & 15;
        *(LAS v4u*)(lds + key * 256 + ((c ^ (key & 15)) << 4)) = *(const v4u*)(kmem + ((size_t)b * 256 + key) * 512 + h * 128 + 8 * c); }
#pragma unroll
    for (int ps = 0; ps < 8; ++ps) { const int id = tid + 512 * ps, dim = id >> 5, c = id & 31;
        *(LAS v4u*)(lds + 65536 + dim * 512 + ((c ^ (dim & 15)) << 4)) = *(const v4u*)(vtmem + (size_t)(b * 512 + h * 128 + dim) * 256 + 8 * c); }
}
__device__ __forceinline__ void xa_item(const bf16* __restrict__ xq, const LAS unsigned char* lds, bf16* __restrict__ yxa, int tok0, int h, int lane) {
    const int q = lane & 15, hi = lane >> 4; const size_t tok = (size_t)tok0 + q;
    const bf16* qp = xq + tok * 512 + h * 128 + 8 * hi;
    bf16x8 qf[4]; float ssq = 0.f;
#pragma unroll
    for (int ks = 0; ks < 4; ++ks) qf[ks] = *(const bf16x8*)(qp + 32 * ks);
    __builtin_amdgcn_sched_barrier(0);
#pragma unroll
    for (int ks = 0; ks < 4; ++ks)
#pragma unroll
        for (int j = 0; j < 8; ++j) { const float v = bf1(qf[ks][j]); ssq += v * v; }
    ssq += __shfl_xor(ssq, 16); ssq += __shfl_xor(ssq, 32);
    const float cexp = rsqrtf(ssq * (1.0f / 128.0f) + 1e-6f) * 0.08838834764831845f * 1.4426950408889634f;
    const int kq = 8 * (q >> 2) + (q & 3);
    f32x4 s[16];
#define XA_KLOAD(buf, fp) do { _Pragma("unroll") for (int f2 = 0; f2 < 2; ++f2) { const int f_ = 2 * (fp) + f2, key = 32 * (f_ >> 1) + 4 * (f_ & 1) + kq; const LAS unsigned char* kr = lds + key * 256; \
        _Pragma("unroll") for (int ks = 0; ks < 4; ++ks) buf[f2][ks] = *(const LAS bf16x8*)(kr + (((4 * ks + hi) ^ (key & 15)) << 4)); } } while (0)
    {
        bf16x8 kbA[2][4], kbB[2][4];
        XA_KLOAD(kbA, 0);
#pragma unroll
        for (int fp = 0; fp < 8; fp += 2) {
            XA_KLOAD(kbB, fp + 1); __builtin_amdgcn_sched_barrier(0);
#pragma unroll
            for (int f2 = 0; f2 < 2; ++f2) { f32x4 z = (f32x4){0.f, 0.f, 0.f, 0.f};
#pragma unroll
                for (int ks = 0; ks < 4; ++ks) z = mfma16(kbA[f2][ks], qf[ks], z);
                s[2 * fp + f2] = z; }
            __builtin_amdgcn_sched_barrier(0);
            if (fp + 2 < 8) XA_KLOAD(kbA, fp + 2);
            __builtin_amdgcn_sched_barrier(0);
#pragma unroll
            for (int f2 = 0; f2 < 2; ++f2) { f32x4 z = (f32x4){0.f, 0.f, 0.f, 0.f};
#pragma unroll
                for (int ks = 0; ks < 4; ++ks) z = mfma16(kbB[f2][ks], qf[ks], z);
                s[2 * (fp + 1) + f2] = z; }
            __builtin_amdgcn_sched_barrier(0);
        }
    }
#undef XA_KLOAD
    float mx = -3.0e38f;
#pragma unroll
    for (int f = 0; f < 16; ++f)
#pragma unroll
        for (int g = 0; g < 4; ++g) mx = fmaxf(mx, s[f][g]);
    mx = fmaxf(mx, __shfl_xor(mx, 16)); mx = fmaxf(mx, __shfl_xor(mx, 32));
    float sum = 0.f;
#pragma unroll
    for (int f = 0; f < 16; ++f)
#pragma unroll
        for (int g = 0; g < 4; ++g) { const float p = __builtin_amdgcn_exp2f((s[f][g] - mx) * cexp); s[f][g] = p; sum += p; }
    sum += __shfl_xor(sum, 16); sum += __shfl_xor(sum, 32);
    const float inv = 1.0f / sum;
    f32x4 o[8];
#pragma unroll
    for (int i = 0; i < 8; ++i) o[i] = (f32x4){0.f, 0.f, 0.f, 0.f};
#define XA_VLOAD(buf, st_) do { _Pragma("unroll") for (int mf = 0; mf < 8; ++mf) { const int dim = 16 * mf + q; buf[mf] = *(const LAS bf16x8*)(lds + 65536 + dim * 512 + (((4 * (st_) + hi) ^ (dim & 15)) << 4)); } } while (0)
    {
        bf16x8 vbA[8], vbB[8];
        XA_VLOAD(vbA, 0);
#pragma unroll
        for (int st = 0; st < 8; st += 2) {
            XA_VLOAD(vbB, st + 1); __builtin_amdgcn_sched_barrier(0);
            { const bf16x8 pb = __builtin_bit_cast(bf16x8, pg8::pack8(s[2 * st], s[2 * st + 1]));
#pragma unroll
              for (int mf = 0; mf < 8; ++mf) o[mf] = mfma16(vbA[mf], pb, o[mf]); }
            __builtin_amdgcn_sched_barrier(0);
            if (st + 2 < 8) XA_VLOAD(vbA, st + 2);
            __builtin_amdgcn_sched_barrier(0);
            { const bf16x8 pb = __builtin_bit_cast(bf16x8, pg8::pack8(s[2 * st + 2], s[2 * st + 3]));
#pragma unroll
              for (int mf = 0; mf < 8; ++mf) o[mf] = mfma16(vbB[mf], pb, o[mf]); }
            __builtin_amdgcn_sched_barrier(0);
        }
    }
#undef XA_VLOAD
    bf16* yp = yxa + tok * 1536 + h * 128 + 4 * hi;
#pragma unroll
    for (int mf = 0; mf < 8; ++mf) { v2u w; w.x = pk2(o[mf][0] * inv, o[mf][1] * inv); w.y = pk2(o[mf][2] * inv, o[mf][3] * inv); *(v2u*)(yp + 16 * mf) = w; }
}
__device__ __forceinline__ void pool_wg(const bf16* __restrict__ pp, const bf16* __restrict__ pwT, bf16* __restrict__ ypool, LAS unsigned char* lds, int tokbase, int wave, int lane) {
    const int q = lane & 15, hi = lane >> 4;
    __syncthreads();
    {
        const int hw = 1 << hi, tw0 = tokbase + 16 * wave, b = tw0 >> 13, t0 = tw0 & 8191;
        const bf16* base = pp + (size_t)b * SEQ * 512 + 8 * lane;
        float s[8];
#pragma unroll
        for (int j = 0; j < 8; ++j) s[j] = 0.f;
#pragma unroll 4
        for (int d = -8; d < 8; ++d) { const int u = t0 + d; const bool ok = (d >= -hw) && (d < hw) && (u >= 0) && (u < SEQ);
            const bf16x8 v = *(const bf16x8*)(base + (size_t)(ok ? u : t0) * 512);
#pragma unroll
            for (int j = 0; j < 8; ++j) s[j] += ok ? bf1(v[j]) : 0.f; }
        LAS unsigned char* tile = lds + wave * 16384;
#pragma unroll 4
        for (int i = 0; i < 16; ++i) { const int t = t0 + i;
            int lo = t - hw; lo = lo < 0 ? 0 : lo; int ht = t + hw; ht = ht > SEQ ? SEQ : ht;
            const float inv = 1.0f / (float)(ht - lo);
            const bool oka = (t + hw) < SEQ, oks = (t - hw) >= 0;
            const bf16x8 sv = *(const bf16x8*)(base + (size_t)t * 512), av = *(const bf16x8*)(base + (size_t)(oka ? t + hw : t) * 512), bv = *(const bf16x8*)(base + (size_t)(oks ? t - hw : t) * 512);
            f32x4 p0, p1;
#pragma unroll
            for (int j = 0; j < 4; ++j) { p0[j] = s[j] * inv - bf1(sv[j]); p1[j] = s[j + 4] * inv - bf1(sv[j + 4]); }
            *(LAS v4u*)(tile + i * 1024 + ((lane ^ (i & 15)) << 4)) = pg8::pack8(p0, p1);
#pragma unroll
            for (int j = 0; j < 8; ++j) s[j] += (oka ? bf1(av[j]) : 0.f) - (oks ? bf1(bv[j]) : 0.f);
        }
    }
    __syncthreads();
#pragma unroll 1
    for (int k = 0; k < 4; ++k) {
        const int pair = wave * 4 + k, g = pair >> 3, mf = pair & 7;
        const bf16* wb = pwT + (size_t)(g * 128 + 16 * mf + q) * 128 + 8 * hi;
        bf16x8 a[4];
#pragma unroll
        for (int ks = 0; ks < 4; ++ks) a[ks] = *(const bf16x8*)(wb + 32 * ks);
#pragma unroll 2
        for (int tg = 0; tg < 8; ++tg) {
            const LAS unsigned char* trow = lds + tg * 16384 + q * 1024; f32x4 o = (f32x4){0.f, 0.f, 0.f, 0.f};
#pragma unroll
            for (int ks = 0; ks < 4; ++ks) { const int c = g * 16 + 4 * ks + hi; o = mfma16(a[ks], *(const LAS bf16x8*)(trow + ((c ^ q) << 4)), o); }
            v2u w; w.x = pk2(o[0], o[1]); w.y = pk2(o[2], o[3]);
            *(v2u*)(ypool + (size_t)(tokbase + 16 * tg + q) * 1536 + g * 128 + 16 * mf + 4 * hi) = w;
        }
    }
    __syncthreads();
}

__device__ __forceinline__ int f2key(float s, int idx, int mask) { int b = __builtin_bit_cast(int, s); b = b >= 0 ? b : (b ^ 0x7fffffff); return (b & ~mask) | idx; }
__device__ __forceinline__ float key2f(int k) { k = k >= 0 ? k : (k ^ 0x7fffffff); return __builtin_bit_cast(float, k); }
#define CE_DESC(x, y) do { const int _h = (x) > (y) ? (x) : (y), _l = (x) > (y) ? (y) : (x); (x) = _h; (y) = _l; } while (0)
__device__ __forceinline__ void sort16(int (&a)[16]) {
#pragma unroll
    for (int ks = 1; ks <= 4; ++ks)
#pragma unroll
        for (int js = ks - 1; js >= 0; --js)
#pragma unroll
            for (int i = 0; i < 16; ++i) { const int k = 1 << ks, j = 1 << js, l = i ^ j;
                if (l > i) { if ((i & k) == 0) CE_DESC(a[i], a[l]); else CE_DESC(a[l], a[i]); } }
}
__device__ __forceinline__ void merge16(int (&a)[16], const int (&b)[16]) {
#pragma unroll
    for (int i = 0; i < 16; ++i) a[i] = a[i] > b[15 - i] ? a[i] : b[15 - i];
#pragma unroll
    for (int js = 3; js >= 0; --js)
#pragma unroll
        for (int i = 0; i < 16; ++i) { const int j = 1 << js, l = i ^ j; if (l > i) CE_DESC(a[i], a[l]); }
}
__device__ __forceinline__ void merge16_lanes(int (&a)[16], int step) { int o[16];
#pragma unroll
    for (int k = 0; k < 16; ++k) o[k] = __shfl_xor(a[k], step);
    merge16(a, o); }
__device__ constexpr int cand_i(int hi, int m) {
    return hi == 0 ? 0
         : hi == 1 ? (m < 8 ? 1 : (m < 13 ? 2 : -1))
         : hi == 2 ? (m < 4 ? 3 : (m < 7 ? 4 : (m < 9 ? 5 : (m < 11 ? 6 : -1))))
         :           (m < 2 ? 7 : (m < 10 ? 8 + (m - 2) : -1));
}
__device__ constexpr int cand_j(int hi, int m) {
    return hi == 0 ? m
         : hi == 1 ? (m < 8 ? m : (m < 13 ? m - 8 : -1))
         : hi == 2 ? (m < 4 ? m : (m < 7 ? m - 4 : (m < 9 ? m - 7 : (m < 11 ? m - 9 : -1))))
         :           (m < 2 ? m : (m < 10 ? 0 : -1));
}
__device__ __forceinline__ void topk_fill_lds(const bf16* __restrict__ keys, LAS unsigned char* lds, int h, int tid) {
#pragma unroll
    for (int ps = 0; ps < 8; ++ps) { const int id = tid + 512 * ps, row = id >> 4, c = id & 15;
        *(LAS v4u*)(lds + row * 256 + ((c ^ (row & 15)) << 4)) = *(const v4u*)(keys + ((size_t)h * 256 + row) * 128 + 8 * c); }
}
struct TopkQ { bf16x8 q[2][4]; };
__device__ __forceinline__ void topk_loadq(TopkQ& Q, const bf16* __restrict__ qb, int tok0, int h, int lane) {
    const size_t tok = (size_t)tok0 + (lane & 15); const int hi = lane >> 4;
#pragma unroll
    for (int p = 0; p < 2; ++p)
#pragma unroll
        for (int ks = 0; ks < 4; ++ks) Q.q[p][ks] = *(const bf16x8*)(qb + tok * 2048 + h * 256 + p * 128 + 32 * ks + 8 * hi);
}
__device__ __forceinline__ void topk_item(const TopkQ& Q, const LAS unsigned char* klds, int* __restrict__ te, float* __restrict__ tw, LAS int* lscr, int tok0, int h, int lane) {
    const int q = lane & 15, hi = lane >> 4; const size_t tok = (size_t)tok0 + q;
    int L[2][16];
#pragma unroll
    for (int p = 0; p < 2; ++p) {
        int B[16];
#define TK_KLOAD(buf, mp) do { _Pragma("unroll") for (int m2 = 0; m2 < 2; ++m2) { const int row = p * 128 + 16 * (2 * (mp) + m2) + q; \
        _Pragma("unroll") for (int ks = 0; ks < 4; ++ks) buf[m2][ks] = *(const LAS bf16x8*)(klds + row * 256 + (((4 * ks + hi) ^ (row & 15)) << 4)); } } while (0)
#define TK_MMA(buf, mp) do { _Pragma("unroll") for (int m2 = 0; m2 < 2; ++m2) { const int mf = 2 * (mp) + m2; f32x4 s = (f32x4){0.f, 0.f, 0.f, 0.f}; \
        _Pragma("unroll") for (int ks = 0; ks < 4; ++ks) s = mfma16(buf[m2][ks], Q.q[p][ks], s); \
          \
        _Pragma("unroll") for (int g = 0; g < 4; ++g) { const int key = f2key(s[g], 16 * mf + 4 * hi + g, 127); if (mf < 4) L[p][4 * mf + g] = key; else B[4 * (mf - 4) + g] = key; } } } while (0)
        { bf16x8 tkA[2][4], tkB[2][4];
          TK_KLOAD(tkA, 0);
          TK_KLOAD(tkB, 1); __builtin_amdgcn_sched_barrier(0); TK_MMA(tkA, 0); __builtin_amdgcn_sched_barrier(0);
          TK_KLOAD(tkA, 2); __builtin_amdgcn_sched_barrier(0); TK_MMA(tkB, 1); __builtin_amdgcn_sched_barrier(0);
          TK_KLOAD(tkB, 3); __builtin_amdgcn_sched_barrier(0); TK_MMA(tkA, 2); __builtin_amdgcn_sched_barrier(0);
          TK_MMA(tkB, 3); }
#undef TK_KLOAD
#undef TK_MMA
        sort16(L[p]); sort16(B); merge16(L[p], B);
        merge16_lanes(L[p], 16); merge16_lanes(L[p], 32);
    }
    float v1[16], v2[16];
#pragma unroll
    for (int k = 0; k < 16; ++k) { v1[k] = key2f(L[0][k]); v2[k] = key2f(L[1][k]); }
    int Fk[16];
#pragma unroll
    for (int m = 0; m < 16; ++m) {
        float sm = v1[0] + v2[m]; int id = 255 - m;
        if (cand_i(1, m) >= 0) { if (hi == 1) { sm = v1[cand_i(1, m) < 0 ? 0 : cand_i(1, m)] + v2[cand_j(1, m) < 0 ? 0 : cand_j(1, m)]; id = 255 - ((cand_i(1, m) << 4) | cand_j(1, m)); } }
        if (cand_i(2, m) >= 0) { if (hi == 2) { sm = v1[cand_i(2, m) < 0 ? 0 : cand_i(2, m)] + v2[cand_j(2, m) < 0 ? 0 : cand_j(2, m)]; id = 255 - ((cand_i(2, m) << 4) | cand_j(2, m)); } }
        if (cand_i(3, m) >= 0) { if (hi == 3) { sm = v1[cand_i(3, m) < 0 ? 0 : cand_i(3, m)] + v2[cand_j(3, m) < 0 ? 0 : cand_j(3, m)]; id = 255 - ((cand_i(3, m) << 4) | cand_j(3, m)); } }
        int key = f2key(sm, id, 255);
        if ((hi == 1 && cand_i(1, m) < 0) || (hi == 2 && cand_i(2, m) < 0) || (hi == 3 && cand_i(3, m) < 0)) key = (int)0x80000000;
        Fk[m] = key;
    }
    sort16(Fk); merge16_lanes(Fk, 16); merge16_lanes(Fk, 32);
    LAS int* my = lscr + lane * 32;
#pragma unroll
    for (int k = 0; k < 16; ++k) { my[k] = L[0][k] & 127; my[16 + k] = L[1][k] & 127; }
    LDS_WAIT(); asm volatile("" ::: "memory");
    float e[16]; float sum = 0.f; const float mx = key2f(Fk[0]);
#pragma unroll
    for (int k = 0; k < 16; ++k) { e[k] = __expf(key2f(Fk[k]) - mx); sum += e[k]; }
    const float inv = 1.0f / sum;
    if (hi == 0) {
        int* tep = te + tok * 128; float* twp = tw + tok * 128;
#pragma unroll
        for (int kk = 0; kk < 16; ++kk) { const int ij = 255 - (Fk[kk] & 255), i = ij >> 4, j = ij & 15, slot = (kk & 7) * 16 + 2 * h + (kk >> 3);
            tep[slot] = my[i] * 128 + my[16 + j]; twp[slot] = e[kk] * inv; }
    }
    LDS_WAIT(); asm volatile("" ::: "memory");
}

__device__ __forceinline__ float ub2f(unsigned v, int b) { return (float)((v >> (8 * b)) & 0xffu); }
struct HqIn { v4u hA, hB; float rsq; };
__device__ __forceinline__ void hq_load(HqIn& in, const bf16* __restrict__ hb, const float* __restrict__ rowsq, int tok, int lane) {
    const bf16* hp = hb + (size_t)tok * 1024 + 16 * lane; in.hA = *(const v4u*)hp; in.hB = *(const v4u*)(hp + 8); in.rsq = rowsq[tok]; }
__device__ __forceinline__ void hq_token(const HqIn& in, unsigned char* __restrict__ hq, float* __restrict__ hs, int tok, int lane) {
    const v4u hA = in.hA, hB = in.hB;
    float hf[16];
#pragma unroll
    for (int d = 0; d < 4; ++d) { hf[2 * d] = bflo(hA[d]); hf[2 * d + 1] = bfhi(hA[d]); hf[8 + 2 * d] = bflo(hB[d]); hf[8 + 2 * d + 1] = bfhi(hB[d]); }
    float amax = 0.f;
#pragma unroll
    for (int j = 0; j < 16; ++j) amax = fmaxf(amax, fabsf(hf[j]));
#pragma unroll
    for (int o = 1; o < 64; o <<= 1) amax = fmaxf(amax, __shfl_xor(amax, o));
    const float hinv = amax > 0.f ? 127.0f / amax : 0.f;
    v4u w;
#pragma unroll
    for (int d = 0; d < 4; ++d) { const unsigned b0 = (unsigned)(int)rintf(hf[4 * d] * hinv) & 0xffu, b1 = (unsigned)(int)rintf(hf[4 * d + 1] * hinv) & 0xffu,
                                                 b2 = (unsigned)(int)rintf(hf[4 * d + 2] * hinv) & 0xffu, b3 = (unsigned)(int)rintf(hf[4 * d + 3] * hinv) & 0xffu;
        w[d] = b0 | (b1 << 8) | (b2 << 16) | (b3 << 24); }
    *(v4u*)(hq + (size_t)tok * 1024 + 16 * lane) = w;
    if (lane == 0) hs[tok] = rsqrtf(in.rsq * (1.0f / 1024.0f) + 1e-6f) * amax * (1.0f / 127.0f);
}
constexpr int PA_SLOTS = 12;
struct PeerA1 { int e; float g; };
struct PeerA2 { v4u ur[3][4]; float su, sv; int cnt, rk; bool m; unsigned long long rem; };
struct PeerAH { v4u hv[4]; float hsc; };
__device__ __forceinline__ void pa_s1(PeerA1& a, const int* __restrict__ te, const float* __restrict__ tw, int tok, int half, int lane) {
    const unsigned o = (unsigned)tok * 128u + 64u * (unsigned)half + (unsigned)lane; a.e = te[o]; a.g = tw[o]; }
__device__ __forceinline__ void pa_s1h(PeerAH& h, const unsigned char* __restrict__ hq, const float* __restrict__ hs, int tok, int lane) {
    const int t = lane & 15;
#pragma unroll
    for (int i = 0; i < 4; ++i) h.hv[i] = *(const v4u*)(hq + ((unsigned)tok * 1024u + 16u * (unsigned)t + 256u * i));
    h.hsc = hs[tok + (int)__builtin_amdgcn_mbcnt_lo(0u, 0u)]; }
template <int MODE> __device__ __forceinline__ void pa_s2(PeerA2& b, const PeerA1& a, const unsigned char* __restrict__ u8, const float* __restrict__ su, LAS int* lst, int x, int lane) {
    b.m = (a.e >> 11) == x;
    const unsigned long long mask = __ballot(b.m);
    b.cnt = __popcll(mask); b.rk = (int)__builtin_amdgcn_mbcnt_hi((unsigned)(mask >> 32), __builtin_amdgcn_mbcnt_lo((unsigned)mask, 0u));
    if (b.m && b.rk < PA_SLOTS) lst[b.rk] = a.e;
    b.rem = 0ull; if (b.cnt > PA_SLOTS) { unsigned long long r = mask;
#pragma unroll
        for (int k = 0; k < PA_SLOTS; ++k) r &= r - 1ull;
        b.rem = r; }
    { typedef float f32x2s __attribute__((ext_vector_type(2))); const f32x2s s2 = ((const f32x2s*)su)[b.m ? a.e : 0]; b.su = s2.x; b.sv = s2.y; }
    const int r = lane >> 4, t = lane & 15;
    LDS_WAIT(); asm volatile("" ::: "memory");
    const int lim = b.cnt < PA_SLOTS ? b.cnt : PA_SLOTS;
    int es[3];
#pragma unroll
    for (int q = 0; q < 3; ++q) es[q] = lst[4 * q + r];
#pragma unroll
    for (int q = 0; q < 3; ++q) { int e = (4 * q + r) < lim ? es[q] : (x << 11);
        if (MODE & 1) e = (x << 11) | (e & 255);
        const unsigned off = (unsigned)e * 1024u + 16u * (unsigned)t;
#pragma unroll
        for (int i = 0; i < 4; ++i) { if (MODE & 2) b.ur[q][i] = (v4u){(unsigned)e, (unsigned)e + 1u, (unsigned)e + 2u, (unsigned)e + 3u}; else b.ur[q][i] = *(const v4u*)(u8 + (off + 256u * i)); } }
}
__device__ __forceinline__ int dot16(const v4u u, const v4u h) { int d = __builtin_amdgcn_sdot4((int)u.x, (int)h.x, 0, false); d = __builtin_amdgcn_sdot4((int)u.y, (int)h.y, d, false);
    d = __builtin_amdgcn_sdot4((int)u.z, (int)h.z, d, false); return __builtin_amdgcn_sdot4((int)u.w, (int)h.w, d, false); }
template <int CTRL, int RM> __device__ __forceinline__ int dpp_i(int x) { return __builtin_amdgcn_update_dpp(0, x, CTRL, RM, 0xf, false); }
__device__ __forceinline__ int wave_sum_to63(int x) { x += dpp_i<0xb1, 0xf>(x); x += dpp_i<0x4e, 0xf>(x); x += dpp_i<0x124, 0xf>(x); x += dpp_i<0x128, 0xf>(x); x += dpp_i<0x142, 0xa>(x); x += dpp_i<0x143, 0xc>(x); return x; }
__device__ __forceinline__ int row_sum16(int x) { x += dpp_i<0xb1, 0xf>(x); x += dpp_i<0x4e, 0xf>(x); x += dpp_i<0x124, 0xf>(x); x += dpp_i<0x128, 0xf>(x); return x; }
__device__ __forceinline__ float gelu_erf(float v) {
    const float av = fabsf(v), t = __builtin_amdgcn_rcpf(av * 0.2316418882f + 1.0f);
    float q = t * 0.5307027145f + (-0.7265760135f); q = q * t + 0.7107068705f; q = q * t + (-0.142248368f); q = q * t + 0.127414796f; q = q * t;
    const float e = __builtin_amdgcn_exp2f((v * v) * (-0.72134752044f)), m = v * (q * e);
    return v < 0.f ? m : v - m; }
template <int MODE> __device__ __forceinline__ void pa_s3(const PeerA2& b, const PeerA1& a, const PeerAH& h, const unsigned char* __restrict__ u8, const unsigned char* __restrict__ hq, float* __restrict__ aw, int tok, int half, int lane) {
    int mine = 0;
    if (MODE & 8) { mine = (int)(b.ur[0][0].x ^ b.ur[1][1].y ^ b.ur[2][2].z ^ h.hv[0].x); } else
    {
        int d[3];
#pragma unroll
        for (int q = 0; q < 3; ++q) { d[q] = dot16(b.ur[q][0], h.hv[0]); d[q] += dot16(b.ur[q][1], h.hv[1]); d[q] += dot16(b.ur[q][2], h.hv[2]); d[q] += dot16(b.ur[q][3], h.hv[3]); }
#pragma unroll
        for (int q = 0; q < 3; ++q) d[q] += dpp_i<0xb1, 0xf>(d[q]);
#pragma unroll
        for (int q = 0; q < 3; ++q) d[q] += dpp_i<0x4e, 0xf>(d[q]);
#pragma unroll
        for (int q = 0; q < 3; ++q) d[q] += dpp_i<0x124, 0xf>(d[q]);
#pragma unroll
        for (int q = 0; q < 3; ++q) d[q] += dpp_i<0x128, 0xf>(d[q]);
        const int src = 64 * (b.rk & 3);
#pragma unroll
        for (int q = 0; q < 3; ++q) { const int v = __builtin_amdgcn_ds_bpermute(src, d[q]); mine = ((b.rk >> 2) == q) ? v : mine; }
    }
    float* awp = aw + ((unsigned)tok * 128u + 64u * (unsigned)half + (unsigned)lane);
    if (b.m && b.rk < PA_SLOTS) *awp = a.g * gelu_erf((float)mine * h.hsc * b.su) * b.sv;
    if (b.cnt > PA_SLOTS) {
        unsigned long long rem = b.rem; const v4u hw = *(const v4u*)(hq + (size_t)tok * 1024 + 16 * lane);
        while (rem != 0ull) { const int idx = __builtin_ctzll(rem); rem &= rem - 1ull; const int e = __builtin_amdgcn_readlane(a.e, idx);
            const int d = __builtin_amdgcn_readlane(wave_sum_to63(dot16(*(const v4u*)(u8 + (size_t)e * 1024 + 16 * lane), hw)), 63);
            if (lane == idx) *awp = a.g * gelu_erf((float)d * h.hsc * b.su) * b.sv; }
    }
}
template <int MODE> __device__ __forceinline__ void peer_a_run(const unsigned char* __restrict__ hq, const float* __restrict__ hs, const unsigned char* __restrict__ u8, const float* __restrict__ su,
                                           const float* __restrict__ sv, const int* __restrict__ te, const float* __restrict__ tw, float* __restrict__ aw, LAS int* lst, int wrank, int wstep, int x, int lane) {
    const int ntok = wrank < T ? (T - wrank + wstep - 1) / wstep : 0, N = 2 * ntok; (void)sv;
    if (N == 0) return;
    const int tlast = wrank + (ntok - 1) * wstep;
#define PA_TOK(n) ((MODE & 4) ? wrank : min(wrank + ((n) >> 1) * wstep, tlast))
    PeerA1 a0, a1, a2, a3; PeerA2 bA, bB; PeerAH h0, h1;
    pa_s1(a0, te, tw, PA_TOK(0), 0, lane); pa_s1(a1, te, tw, PA_TOK(1), 1, lane); pa_s1h(h0, hq, hs, PA_TOK(0), lane);
    pa_s1(a2, te, tw, PA_TOK(2), 0, lane); pa_s1(a3, te, tw, PA_TOK(3), 1, lane); pa_s1h(h1, hq, hs, PA_TOK(2), lane);
    pa_s2<MODE>(bA, a0, u8, su, lst, x, lane);
#define PA_STEP(n, Bcur, Bnext, Acur, Anext, Hcur, LOADH) do { \
        pa_s2<MODE>(Bnext, Anext, u8, su, lst, x, lane); \
        pa_s3<MODE>(Bcur, Acur, Hcur, u8, hq, aw, PA_TOK(n), (n) & 1, lane); \
        pa_s1(Acur, te, tw, PA_TOK((n) + 4), (n) & 1, lane); \
        if (LOADH) pa_s1h(Hcur, hq, hs, PA_TOK((n) + 3), lane); } while (0)
    for (int n = 0; n < N; n += 4) {
        PA_STEP(n, bA, bB, a0, a1, h0, 0);
        PA_STEP(n + 1, bB, bA, a1, a2, h0, 1);
        PA_STEP(n + 2, bA, bB, a2, a3, h1, 0);
        PA_STEP(n + 3, bB, bA, a3, a0, h1, 1);
    }
#undef PA_STEP
#undef PA_TOK
}
struct PeerB1 { v4u e[4]; f32x4 w[4]; unsigned h2; };
struct PeerB2 { v4u vr[8]; };
struct PeerBAcc { int acc[16]; int wq[4]; float wsc, h0, h1; };
typedef float f32x2v __attribute__((ext_vector_type(2)));
__device__ __forceinline__ void pb_s1(PeerB1& a, const int* __restrict__ te, const float* __restrict__ aw, int tok, int lane) {
    const unsigned o_ = (unsigned)tok * 128u + 16u * ((unsigned)lane >> 3);
    const v4u* ep = (const v4u*)(te + o_); const f32x4* wp = (const f32x4*)(aw + o_);
#pragma unroll
    for (int j = 0; j < 4; ++j) { a.e[j] = ep[j]; a.w[j] = wp[j]; } }
__device__ __forceinline__ int pb_col(int lane) { return 16 * (lane & 7) + 8 * ((lane >> 5) & 1) + 4 * ((lane >> 4) & 1) + 2 * ((lane >> 3) & 1); }
template <int CTRL, int RM> __device__ __forceinline__ float dpp_f(float x) { return __builtin_bit_cast(float, __builtin_amdgcn_update_dpp(0, __builtin_bit_cast(int, x), CTRL, RM, 0xf, false)); }
__device__ __forceinline__ void pb_quant(PeerBAcc& A, const PeerB1& a) {
    float mx = 0.f;
#pragma unroll
    for (int j = 0; j < 4; ++j) mx = fmaxf(mx, fmaxf(fmaxf(fabsf(a.w[j][0]), fabsf(a.w[j][1])), fmaxf(fabsf(a.w[j][2]), fabsf(a.w[j][3]))));
    mx = fmaxf(mx, dpp_f<0xb1, 0xf>(mx)); mx = fmaxf(mx, dpp_f<0x4e, 0xf>(mx)); mx = fmaxf(mx, dpp_f<0x124, 0xf>(mx)); mx = fmaxf(mx, dpp_f<0x128, 0xf>(mx));
    mx = fmaxf(mx, dpp_f<0x142, 0xa>(mx)); mx = fmaxf(mx, dpp_f<0x143, 0xc>(mx));
    mx = __builtin_bit_cast(float, __builtin_amdgcn_readlane(__builtin_bit_cast(int, mx), 63));
    const float inv = mx > 0.f ? 127.0f / mx : 0.f; A.wsc = mx * (1.0f / 127.0f);
#pragma unroll
    for (int j = 0; j < 4; ++j) A.wq[j] = (int)(((unsigned)(int)rintf(a.w[j][0] * inv) & 0xffu) | (((unsigned)(int)rintf(a.w[j][1] * inv) & 0xffu) << 8) |
                                               (((unsigned)(int)rintf(a.w[j][2] * inv) & 0xffu) << 16) | (((unsigned)(int)rintf(a.w[j][3] * inv) & 0xffu) << 24));
}
template <int HF, int MODE> __device__ __forceinline__ void pb_s2(PeerB2& b, const PeerB1& a, const unsigned char* __restrict__ v8x, int lane) {
    const int c = lane & 7;
#pragma unroll
    for (int m = 0; m < 8; ++m) { unsigned e = a.e[2 * HF + (m >> 2)][m & 3]; if (MODE & 1) e &= 255u;
        if (MODE & 2) b.vr[m] = (v4u){e, e + 1u, e + 2u, e + 3u}; else b.vr[m] = *(const v4u*)(v8x + (e * 128u + 16u * (unsigned)c)); }
}
__device__ __forceinline__ float swap32_add(float lo, float hi) { const auto r = __builtin_amdgcn_permlane32_swap(__builtin_bit_cast(unsigned, lo), __builtin_bit_cast(unsigned, hi), false, false);
    return __builtin_bit_cast(float, r[0]) + __builtin_bit_cast(float, r[1]); }
__device__ __forceinline__ float swap16_add(float lo, float hi) { const auto r = __builtin_amdgcn_permlane16_swap(__builtin_bit_cast(unsigned, lo), __builtin_bit_cast(unsigned, hi), false, false);
    return __builtin_bit_cast(float, r[0]) + __builtin_bit_cast(float, r[1]); }
template <int HF, int MODE> __device__ __forceinline__ void pb_s3(PeerBAcc& A, const PeerB2& b, const PeerB1& a, float* out, int tok, int x, int lane) {
    if (MODE & 8) { if (HF == 0) { A.acc[0] = 0; }
#pragma unroll
        for (int m = 0; m < 8; ++m) A.acc[0] += (int)(b.vr[m].x ^ b.vr[m].y ^ b.vr[m].z ^ b.vr[m].w);
        if (HF == 1) { f32x2v h2; h2.x = A.h0 + (float)A.acc[0]; h2.y = A.h1 + A.wsc; *(f32x2v*)(out + ((unsigned)tok * 1024u + 128u * (unsigned)x + (unsigned)pb_col(lane))) = h2; }
        return; }
    if (HF == 0) {
#pragma unroll
        for (int j = 0; j < 16; ++j) A.acc[j] = 0;
    }
#pragma unroll
    for (int gg = 0; gg < 2; ++gg)
#pragma unroll
        for (int d = 0; d < 4; ++d) { const unsigned ra = b.vr[4 * gg][d], rb = b.vr[4 * gg + 1][d], rc = b.vr[4 * gg + 2][d], rd = b.vr[4 * gg + 3][d];
            const unsigned t0 = __builtin_amdgcn_perm(rb, ra, 0x05010400u), t1 = __builtin_amdgcn_perm(rb, ra, 0x07030602u), t2 = __builtin_amdgcn_perm(rd, rc, 0x05010400u), t3 = __builtin_amdgcn_perm(rd, rc, 0x07030602u);
            const unsigned c0 = __builtin_amdgcn_perm(t2, t0, 0x05040100u), c1 = __builtin_amdgcn_perm(t2, t0, 0x07060302u), c2 = __builtin_amdgcn_perm(t3, t1, 0x05040100u), c3 = __builtin_amdgcn_perm(t3, t1, 0x07060302u);
            const int w4 = A.wq[2 * HF + gg];
            A.acc[4 * d] = __builtin_amdgcn_sdot4((int)c0, w4, A.acc[4 * d], false); A.acc[4 * d + 1] = __builtin_amdgcn_sdot4((int)c1, w4, A.acc[4 * d + 1], false);
            A.acc[4 * d + 2] = __builtin_amdgcn_sdot4((int)c2, w4, A.acc[4 * d + 2], false); A.acc[4 * d + 3] = __builtin_amdgcn_sdot4((int)c3, w4, A.acc[4 * d + 3], false); }
    if (HF == 1) {
        int r8[8], r4[4], r2[2];
#pragma unroll
        for (int j = 0; j < 8; ++j) { const bool up = (lane & 32) != 0; const int keep = up ? A.acc[j + 8] : A.acc[j], send = up ? A.acc[j] : A.acc[j + 8]; r8[j] = keep + __shfl_xor(send, 32); }
#pragma unroll
        for (int j = 0; j < 4; ++j) { const bool up = (lane & 16) != 0; const int keep = up ? r8[j + 4] : r8[j], send = up ? r8[j] : r8[j + 4]; r4[j] = keep + __shfl_xor(send, 16); }
#pragma unroll
        for (int j = 0; j < 2; ++j) { const bool up = (lane & 8) != 0; const int keep = up ? r4[j + 2] : r4[j], send = up ? r4[j] : r4[j + 2];
            r2[j] = keep + __builtin_amdgcn_update_dpp(0, send, 0x128, 0xf, 0xf, false); }
        f32x2v h2; h2.x = A.h0 + A.wsc * (float)r2[0]; h2.y = A.h1 + A.wsc * (float)r2[1];
        *(f32x2v*)(out + ((unsigned)tok * 1024u + 128u * (unsigned)x + (unsigned)pb_col(lane))) = h2;
    }
}
__device__ __forceinline__ void pb_s1h(PeerB1& a, const int* __restrict__ te, const float* __restrict__ aw, const bf16* __restrict__ hb, int tok, int x, int lane) {
    pb_s1(a, te, aw, tok, lane); a.h2 = *(const unsigned*)(hb + ((unsigned)tok * 1024u + 128u * (unsigned)x + (unsigned)pb_col(lane))); }
template <int MODE> __device__ __forceinline__ void peer_b_run(const unsigned char* __restrict__ v8x, const int* __restrict__ te, const float* __restrict__ aw, const bf16* __restrict__ hb, float* out, int wrank, int wstep, int x, int lane) {
    const int N = wrank < T ? (T - wrank + wstep - 1) / wstep : 0;
    if (N == 0) return;
    const int tlast = wrank + (N - 1) * wstep;
#define PB_TOK(n) min(wrank + (n) * wstep, tlast)
#define PB_STOK(n) ((MODE & 4) ? wrank : PB_TOK(n))
    PeerB1 s0, s1, s2; PeerB2 bA, bB; PeerBAcc A;
    pb_s1h(s0, te, aw, hb, PB_STOK(0), x, lane); pb_s1h(s1, te, aw, hb, PB_STOK(1), x, lane);
    pb_s2<0, MODE>(bA, s0, v8x, lane);
#define PB_TOKEN(n, Scur, Snext, Snew) do { \
        pb_s1h(Snew, te, aw, hb, PB_STOK((n) + 2), x, lane); \
        pb_s2<1, MODE>(bB, Scur, v8x, lane); __builtin_amdgcn_sched_barrier(0); A.h0 = bflo(Scur.h2); A.h1 = bfhi(Scur.h2); pb_quant(A, Scur); \
        pb_s3<0, MODE>(A, bA, Scur, out, PB_TOK(n), x, lane); \
        pb_s2<0, MODE>(bA, Snext, v8x, lane); __builtin_amdgcn_sched_barrier(0); \
        pb_s3<1, MODE>(A, bB, Scur, out, PB_TOK(n), x, lane); } while (0)
    for (int n = 0; n < N; n += 3) {
        PB_TOKEN(n, s0, s1, s2);
        PB_TOKEN(n + 1, s1, s2, s0);
        PB_TOKEN(n + 2, s2, s0, s1);
    }
#undef PB_TOKEN
#undef PB_STOK
#undef PB_TOK
}

__global__ void __launch_bounds__(NWAVES * 64, 2) mk_fwd(Args args) {
    extern __shared__ __attribute__((aligned(16))) unsigned char lds[];
    Frame F;
    F.lds = (LAS unsigned char*)lds;
    F.MISC = (volatile LAS unsigned*)(F.lds + MISC_OFF);
    F.tid = threadIdx.x; F.lane = F.tid & 63; F.wave = __builtin_amdgcn_readfirstlane(F.tid >> 6);
    F.G = gridDim.x; { const int bx = blockIdx.x; F.vcu = (F.G % 8 == 0) ? (bx % 8) * (F.G / 8) + bx / 8 : bx; }
    F.out = nullptr; F.ws = args.ws;
    unsigned char* ws = args.ws;
    F.ctl = (gu32*)(ws + WS_CTL);
    for (int u = F.tid; u < (LDS_BYTES - LDSCTL_OFF) / 4; u += NWAVES * 64) ((LAS unsigned*)(F.lds + LDSCTL_OFF))[u] = 0u;
    __syncthreads();
    XcdBarrier bar; bar.bar = (unsigned*)(F.ctl + CW_BAR); bar.x = 0; bar.st = nullptr;
    if (N_LAUNCHES != PER_PHASE) bar = xcd_barrier_post((unsigned*)(F.ctl + CW_BAR), F.MISC + 8);
    if (N_LAUNCHES != PER_PHASE) { if (F.tid == 0) { const unsigned xid = xb_xcc_id(); F.MISC[12] = xid; F.MISC[13] = xb_add((unsigned*)(F.ctl + CW_TICKET) + 64 * xid, 1u); } __syncthreads(); }
#define GRID_BAR() do { if (N_LAUNCHES != PER_PHASE) xcd_barrier(bar); } while (0)
    const int lo = args.ph_lo, hi = args.ph_hi;
#define IN(k) (lo <= (k) && (k) < hi)
#define BOTH(k) (IN(k) && IN((k) + 1))
    const int gw = F.vcu * NWAVES + F.wave, NGW = F.G * NWAVES;
    bf16* const WinT = (bf16*)(ws + WS_WIN); bf16* const WvT = (bf16*)(ws + WS_WV); bf16* const WkvT = (bf16*)(ws + WS_WKV); bf16* const WbrT = (bf16*)(ws + WS_WBR);
    bf16* const WoutT = (bf16*)(ws + WS_WOUT); bf16* const WqT = (bf16*)(ws + WS_WQ); bf16* const KEYS = (bf16*)(ws + WS_KEYS); bf16* const PWT = (bf16*)(ws + WS_PWT);
    bf16* const MEMN = (bf16*)(ws + WS_MEMN); bf16* const KMEM = (bf16*)(ws + WS_KMEM); bf16* const VTMEM = (bf16*)(ws + WS_VTMEM); float* const RSTDX = (float*)(ws + WS_RSTDX);
    const unsigned char* const U8 = ws + WS_U8; const unsigned char* const V8 = ws + WS_V8; const float* const SU = (const float*)(ws + WS_SU); const float* const SV = (const float*)(ws + WS_SV);
    bf16* const QN = (bf16*)(ws + WS_QN); bf16* const KN = (bf16*)(ws + WS_KN); bf16* const VT = (bf16*)(ws + WS_VT); bf16* const PP = (bf16*)(ws + WS_PP); bf16* const XQ = (bf16*)(ws + WS_XQ);
    bf16* const GATE = (bf16*)(ws + WS_GATE); bf16* const MERGED = (bf16*)(ws + WS_MERGED); bf16* const HB = (bf16*)(ws + WS_HB); bf16* const QB = (bf16*)(ws + WS_QB);
    int* const TE = (int*)(ws + WS_TE); float* const TW = (float*)(ws + WS_TW); float* const AW = (float*)(ws + WS_AW); float* const ROWSQ = (float*)(ws + WS_ROWSQ);
#define RELOAD_OUT(p) do { GAS unsigned char* p_; asm volatile("s_load_dwordx2 %0, %1, 0xb8\n\ts_waitcnt lgkmcnt(0)" : "=s"(p_) : "s"(__builtin_amdgcn_kernarg_segment_ptr()) : "memory"); p = (unsigned char*)p_; } while (0)
#define XB ((bf16*)(ws + WS_XB))
#define YNA ((bf16*)(outp + OUT_YNA))
#define YPOOL ((bf16*)(outp + OUT_YPOOL))
#define YXA ((bf16*)(outp + OUT_YXA))

#ifndef STAGGER_SLEEPS
#define STAGGER_SLEEPS 1
#endif
#define STAGGER() do { const int q_ = __builtin_amdgcn_readfirstlane((int)((blockIdx.x >> 3) & 3u) * STAGGER_SLEEPS); for (int i_ = 0; i_ < q_; ++i_) __builtin_amdgcn_s_sleep(127); } while (0)
    if (IN(0)) { unsigned char* outp; RELOAD_OUT(outp); F.out = (float*)outp; p0_prologue(F, args); F.out = nullptr; if (BOTH(0)) GRID_BAR(); }
    if (IN(1)) STAGGER();

    if (IN(1)) {
      { unsigned char* outp; RELOAD_OUT(outp);
        { pg8::Sched1 S; S.so.init(T, IN_MAIN, F.G, (int)blockIdx.x); S.A = (const char*)XB; S.Bt = (const char*)WinT; S.tstep = (size_t)256 * 1024 * 2;
          pg8::EpiProj E{RSTDX, QN, KN, PP, XQ, GATE, args.in[I_NAQG], args.in[I_NAKG], args.in[I_GATEB], (args.probe & 1)};
          pg8::gemm_phase<pg8::EpiProj, pg8::Sched1, true, true>(F.lds + RING_OFF, 1024, S, E); }
        if (!(args.probe & 4)) { pg8::Sched1 S; S.so.init(512, T, F.G, (int)blockIdx.x); S.A = (const char*)WvT; S.Bt = (const char*)XB; S.tstep = (size_t)256 * 1024 * 2;
          pg8::EpiVt E{RSTDX, VT};
          pg8::gemm_phase<pg8::EpiVt, pg8::Sched1, false, true>(F.lds + RING_OFF, 1024, S, E); }
        if (!(args.probe & 2)) {
            __syncthreads();
            for (int j = F.vcu; j < 256; j += F.G) memkv_tile(MEMN, WkvT, args.in[I_XAKG], args.in[I_XAQG], KMEM, VTMEM, (LAS float*)(F.lds + RING_OFF) + (F.wave >> 2) * 6144, 2 * j + (F.wave >> 2), F.wave & 3, F.lane);
            __syncthreads(); }
      }
        if (BOTH(1)) GRID_BAR();
    }

    if (IN(2)) {
      { unsigned char* outp; RELOAD_OUT(outp);
        LAS float* rpl = (LAS float*)(F.lds + RING_OFF + F.wave * 16384);
        for (int i = F.lane; i < 15 * 31; i += 64) rpl[i] = args.in[I_RPB][F.wave * 15 * 31 + i];
        LDS_WAIT(); asm volatile("" ::: "memory");
        if (!(args.probe & 1)) for (int i = F.vcu; i < 256; i += F.G)
            for (int k = 0; k < 8; ++k) { const int idx = i * 8 + k, b = idx >> 9, r = (idx >> 2) & 127, jb = idx & 3; na_item(QN, KN, VT, rpl, YNA, b, r, jb, F.wave, F.lane); }
        if (!(args.probe & 2)) for (int i = F.vcu; i < 256; i += F.G) pool_wg(PP, PWT, YPOOL, F.lds + RING_OFF, i * 128, F.wave, F.lane);
        if (!(args.probe & 4)) { const int pair = F.vcu & 15, xb = pair >> 2, xh = pair & 3, slot = F.vcu >> 4, nslot = F.G >> 4;
          __syncthreads(); xa_fill_lds(KMEM, VTMEM, F.lds + RING_OFF, xb, xh, F.tid); __syncthreads();
          if (slot < nslot) for (int n = slot * NWAVES + F.wave; n < 512; n += nslot * NWAVES) xa_item(XQ, F.lds + RING_OFF, YXA, (xb * 512 + n) * 16, xh, F.lane);
          __syncthreads(); }
      }
        if (BOTH(2)) GRID_BAR();
    }

    if (IN(3)) {
      { unsigned char* outp; RELOAD_OUT(outp);
        pg8::Sched1 S; S.so.init(T, D, F.G, (int)blockIdx.x); S.A = (const char*)YNA; S.Bt = (const char*)WbrT; S.tstep = (size_t)256 * 1536 * 2;
        pg8::EpiMergeCat E{GATE, MERGED};
        pg8::gemm_phase<pg8::EpiMergeCat, pg8::Sched1, true, true>(F.lds + RING_OFF, 1536, S, E);
      }
        if (BOTH(3)) GRID_BAR();
    }

    if (IN(4)) {
      {
        pg8::Sched1 S; S.so.init(T, D, F.G, (int)blockIdx.x); S.A = (const char*)MERGED; S.Bt = (const char*)WoutT; S.tstep = (size_t)256 * 1024 * 2;
        pg8::EpiH E{(const pg8::bf16_t*)(ws + WS_XB), nullptr, HB, ROWSQ, args.probe};
        pg8::gemm_phase<pg8::EpiH, pg8::Sched1, true, true>(F.lds + RING_OFF, 1024, S, E);
      }
        if (BOTH(4)) GRID_BAR();
    }

    if (IN(5)) {
      {
        pg8::Sched1 S; S.so.init(T, 2048, F.G, (int)blockIdx.x); S.A = (const char*)HB; S.Bt = (const char*)WqT; S.tstep = (size_t)256 * 1024 * 2;
        pg8::EpiQ E{ROWSQ, QB};
        pg8::gemm_phase<pg8::EpiQ, pg8::Sched1, true, true>(F.lds + RING_OFF, 1024, S, E);
      }
        if (BOTH(5)) GRID_BAR();
    }

    if (IN(6)) {
        LAS int* lscr = (LAS int*)(F.lds + RING_OFF + 65536 + F.wave * 8192);
        for (int tok = 4 * gw; tok < T; tok += 4 * NGW) {
            HqIn hin[4];
#pragma unroll
            for (int r = 0; r < 4; ++r) hq_load(hin[r], HB, ROWSQ, tok + r, F.lane);
#pragma unroll
            for (int r = 0; r < 4; ++r) hq_token(hin[r], ws + WS_HQ, (float*)(ws + WS_HS), tok + r, F.lane); }
        { const int th = F.vcu & 7, slot = F.vcu >> 3, nslot = F.G >> 3;
          __syncthreads(); topk_fill_lds(KEYS, F.lds + RING_OFF, th, F.tid); __syncthreads();
          { { const int n0 = slot * NWAVES + F.wave, ns = nslot * NWAVES; TopkQ qA, qB;
              if (n0 < 2048) topk_loadq(qA, QB, n0 * 16, th, F.lane);
              for (int n = n0; n < 2048; n += 2 * ns) {
                  if (n + ns < 2048) topk_loadq(qB, QB, (n + ns) * 16, th, F.lane);
                  topk_item(qA, F.lds + RING_OFF, TE, TW, lscr, n * 16, th, F.lane);
                  if (n + ns < 2048) { if (n + 2 * ns < 2048) topk_loadq(qA, QB, (n + 2 * ns) * 16, th, F.lane);
                      topk_item(qB, F.lds + RING_OFF, TE, TW, lscr, (n + ns) * 16, th, F.lane); } } } }
          __syncthreads(); }
        if (BOTH(6)) GRID_BAR();
    }

    if (IN(7)) {
        int x0 = 0, nxs = 8, wrank = (int)blockIdx.x * NWAVES + F.wave, wstep = F.G * NWAVES;
        if (N_LAUNCHES != PER_PHASE) { const unsigned xid = F.MISC[12], rk = F.MISC[13]; unsigned nx = 0, below = 0, mine = 0;
            for (unsigned j = 0; j < 16; ++j) { const unsigned c = xb_ld((unsigned*)(F.ctl + CW_BAR) + XB_XCNT(j)); nx += c > 0u; below += (c > 0u && j < xid); mine = (j == xid) ? c : mine; }
            if (nx == 8 && mine > 0 && rk < mine) { x0 = (int)below; nxs = 1; wrank = (int)rk * NWAVES + F.wave; wstep = (int)mine * NWAVES; } }
        else if ((F.G & 7) == 0) { x0 = (int)blockIdx.x & 7; nxs = 1; wrank = ((int)blockIdx.x >> 3) * NWAVES + F.wave; wstep = (F.G >> 3) * NWAVES; }
        for (int xs = 0; xs < nxs; ++xs) {
#ifdef PROBE_BITS
            if (args.probe) peer_a_run<PROBE_BITS>(ws + WS_HQ, (const float*)(ws + WS_HS), U8, SU, SV, TE, TW, (float*)QB, (LAS int*)(F.lds + RING_OFF + F.wave * 16384), wrank, wstep, x0 + xs, F.lane); else
#endif
            peer_a_run<0>(ws + WS_HQ, (const float*)(ws + WS_HS), U8, SU, SV, TE, TW, AW, (LAS int*)(F.lds + RING_OFF + F.wave * 16384), wrank, wstep, x0 + xs, F.lane); }
        if (N_LAUNCHES != PER_PHASE) xcd_barrier(bar);
    }
    if (IN(8)) {
        int x0 = 0, nxs = 8, wrank = (int)blockIdx.x * NWAVES + F.wave, wstep = F.G * NWAVES;
        if (N_LAUNCHES != PER_PHASE) { const unsigned xid = F.MISC[12], rk = F.MISC[13]; unsigned nx = 0, below = 0, mine = 0;
            for (unsigned j = 0; j < 16; ++j) { const unsigned c = xb_ld((unsigned*)(F.ctl + CW_BAR) + XB_XCNT(j)); nx += c > 0u; below += (c > 0u && j < xid); mine = (j == xid) ? c : mine; }
            if (nx == 8 && mine > 0 && rk < mine) { x0 = (int)below; nxs = 1; wrank = (int)rk * NWAVES + F.wave; wstep = (int)mine * NWAVES; } }
        else if ((F.G & 7) == 0) { x0 = (int)blockIdx.x & 7; nxs = 1; wrank = ((int)blockIdx.x >> 3) * NWAVES + F.wave; wstep = (F.G >> 3) * NWAVES; }
        for (int xs = 0; xs < nxs; ++xs) {
#ifdef PROBE_BITS
            if (args.probe) peer_b_run<PROBE_BITS>(V8 + (size_t)(x0 + xs) * (2 * MiB), TE, AW, HB, (float*)QB, wrank, wstep, x0 + xs, F.lane); else
#endif
            { unsigned char* outp; RELOAD_OUT(outp); peer_b_run<0>(V8 + (size_t)(x0 + xs) * (2 * MiB), TE, AW, HB, (float*)outp, wrank, wstep, x0 + xs, F.lane); } }
    }
#undef XB
#undef YNA
#undef YPOOL
#undef YXA
#undef RELOAD_OUT
#undef IN
#undef BOTH
#undef GRID_BAR
}

extern "C" void kernel_launch(void* const* d_in, const int* in_sizes, int n_in, void* d_out, int out_size, void* d_ws, size_t ws_size, hipStream_t stream) {
    static int grid = 0;
    if (grid == 0) {
        if (n_in != 23 || in_sizes[0] != T * D || out_size != T * D || ws_size < WS_END) { fprintf(stderr, "kernel_launch: unexpected shapes: n_in %d in0 %d out %d ws %zu\n", n_in, n_in > 0 ? in_sizes[0] : -1, out_size, ws_size); grid = -1; return; }
        int dev = 0, cus = 0, per_cu = 0;
        if (hipGetDevice(&dev) != hipSuccess || hipDeviceGetAttribute(&cus, hipDeviceAttributeMultiprocessorCount, dev) != hipSuccess) { fprintf(stderr, "kernel_launch: device query failed\n"); grid = -1; return; }
        if (hipFuncSetAttribute((const void*)mk_fwd, hipFuncAttributeMaxDynamicSharedMemorySize, LDS_BYTES) != hipSuccess) { fprintf(stderr, "kernel_launch: hipFuncSetAttribute failed\n"); grid = -1; return; }
        if (hipOccupancyMaxActiveBlocksPerMultiprocessor(&per_cu, (const void*)mk_fwd, NWAVES * 64, LDS_BYTES) != hipSuccess || per_cu < 1)
            fprintf(stderr, "kernel_launch: note: occupancy query reports %d workgroups per CU\n", per_cu);
        (void)hipGetLastError();
        grid = cus;
    }
    if (grid < 0) return;
    if (hipMemsetAsync((char*)d_ws + WS_CTL, 0, CTL_ZERO_BYTES, stream) != hipSuccess) { fprintf(stderr, "kernel_launch: memset failed\n"); return; }
    Args a{};
    for (int i = 0; i < 23; ++i) a.in[i] = (const float*)d_in[i];
    a.out = (float*)d_out; a.ws = (unsigned char*)d_ws;
    for (int li = 0; li < N_LAUNCHES; ++li) {
        a.ph_lo = (N_LAUNCHES == PER_PHASE) ? li : 0; a.ph_hi = (N_LAUNCHES == PER_PHASE) ? li + 1 : PER_PHASE;
        hipLaunchKernelGGL(mk_fwd, dim3(grid), dim3(NWAVES * 64), LDS_BYTES, stream, a);
#ifdef HOST_DUP_PHASE
        if (N_LAUNCHES == PER_PHASE && li == HOST_DUP_PHASE) {
#ifndef PROBE_MODE
            if (li == 4) (void)hipMemsetAsync((char*)d_ws + WS_ROWSQ, 0, (size_t)T * 4, stream);
#endif
#ifdef PROBE_MODE
            a.probe = PROBE_MODE;
#endif
            hipLaunchKernelGGL(mk_fwd, dim3(grid), dim3(NWAVES * 64), LDS_BYTES, stream, a); a.probe = 0; }
#endif
        const hipError_t le = hipPeekAtLastError();
        if (le != hipSuccess) { fprintf(stderr, "kernel_launch: launch %d failed: %s\n", li, hipGetErrorName(le)); break; }
    }
}
```

```cpp
#include <hip/hip_runtime.h>
#include <cstdio>
#include <cstdint>

#ifndef MK_N_LAUNCHES
#define MK_N_LAUNCHES 1
#endif

namespace pg8 {
#define PG8_LAS __attribute__((address_space(3)))
typedef unsigned short bf16_t;
typedef short bf16x8 __attribute__((ext_vector_type(8)));
typedef float f32x4 __attribute__((ext_vector_type(4)));
typedef unsigned u32x4 __attribute__((ext_vector_type(4)));
typedef unsigned u32x2 __attribute__((ext_vector_type(2)));
constexpr int BM = 256, BK = 64, HALF = 128, HTB = HALF * BK * 2  , STAGE_BYTES = 8 * HTB, NXCD = 8, WGM = 8;

__host__ __device__ __forceinline__ int lds_byte(int r, int c) { const int st = (r >> 4) * 2 + (c >> 5), rr = r & 15, cc = c & 31, ob = rr * 64 + cc * 2; return st * 1024 + (ob ^ (((ob >> 9) & 1) << 5)); }
__host__ __device__ __forceinline__ void stage_rc(int b, int& R, int& C) { const int st = b / 1024, sb = b % 1024, swz = sb ^ (((sb >> 9) & 1) << 5); R = (st >> 1) * 16 + swz / 64; C = (st & 1) * 32 + (swz % 64) / 2; }
__host__ __device__ __forceinline__ int perm32(int rho) { const int n = rho >> 4, i = rho & 15; return 8 * (i >> 2) + 4 * n + (i & 3); }

struct Unit { int pm, pn, br; };

struct StaticOrder {
    int nM, nN, nwg, G, c;
    __host__ __device__ void init(int M, int N, int G_, int c_) { nM = M / BM; nN = N / BM; nwg = nM * nN; G = G_; c = c_; }
    __host__ __device__ bool next(int i, Unit& u) const {
        const long L = (long)i * G + c; if (L >= nwg) return false;
        int wgid = (int)L; { const int q = nwg / NXCD, r = nwg % NXCD, xcd = wgid % NXCD, off = wgid / NXCD; wgid = (xcd < r ? xcd * (q + 1) : r * (q + 1) + (xcd - r) * q) + off; }
        const int nig = WGM * nN, gid = wgid / nig, fm = gid * WGM, gsz = (nM - fm) < WGM ? (nM - fm) : WGM;
        u.pm = fm + ((wgid % nig) % gsz); u.pn = (wgid % nig) / gsz; return true;
    }
};
struct Sched1 {
    StaticOrder so; const char* A; const char* Bt; size_t tstep;
    __device__ __forceinline__ bool next(int i, Unit& u) const { u.br = 0; return so.next(i, u); }
    __device__ __forceinline__ const char* abase(const Unit& u) const { return A + (size_t)u.pm * tstep; }
    __device__ __forceinline__ const char* bbase(const Unit& u) const { return Bt + (size_t)u.pn * tstep; }
    __device__ __forceinline__ void a_ready(const Unit&) const {}
    __device__ __forceinline__ void done(const Unit&) const {}
};
struct Sched3 {
    StaticOrder so; const char* A; const char* Bt; size_t tstep, strideA, strideB;
    __device__ __forceinline__ bool next(int i, Unit& u) const { u.br = i % 3; return so.next(i / 3, u); }
    __device__ __forceinline__ const char* abase(const Unit& u) const { return A + (size_t)u.br * strideA + (size_t)u.pm * tstep; }
    __device__ __forceinline__ const char* bbase(const Unit& u) const { return Bt + (size_t)u.br * strideB + (size_t)u.pn * tstep; }
    __device__ __forceinline__ void a_ready(const Unit&) const {}
    __device__ __forceinline__ void done(const Unit&) const {}
};

typedef float f32x2_t __attribute__((ext_vector_type(2))); typedef __bf16 bf16x2v_t __attribute__((ext_vector_type(2)));
__device__ __forceinline__ unsigned cvt_pk_bf16(float lo, float hi) { const f32x2_t v = {lo, hi}; const bf16x2v_t b = __builtin_convertvector(v, bf16x2v_t); return __builtin_bit_cast(unsigned, b); }
__device__ __forceinline__ u32x4 pack8(const f32x4 a, const f32x4 b) { u32x4 w; w.x = cvt_pk_bf16(a[0], a[1]); w.y = cvt_pk_bf16(a[2], a[3]); w.z = cvt_pk_bf16(b[0], b[1]); w.w = cvt_pk_bf16(b[2], b[3]); return w; }
__device__ __forceinline__ float bflo(unsigned u) { return __builtin_bit_cast(float, u << 16); }
__device__ __forceinline__ float bfhi(unsigned u) { return __builtin_bit_cast(float, u & 0xffff0000u); }


constexpr float RMS_EPS = 1e-6f;

struct EpiProj {
    static constexpr bool PERM = true, AFTER_DRAIN = false, HAS_MID = false;
    const float* rstd; bf16_t *qn, *kn, *pp, *xq, *gates; const float *qg, *kg, *gate_b; int skip;
    __device__ __forceinline__ void operator()(const f32x4 (&acc)[2][2][4][2], const Unit& u, int wr, int wc, int fr, int fq) const {
        if (skip) { if (acc[0][0][0][0][0] == 1234.5f) qn[0] = 1; return; }
        const int pn = u.pn, row0 = u.pm * BM + wr * 64 + fr, lc0 = 64 * wc + 8 * fq;
        float rsv[2][4];
#pragma unroll
        for (int ai = 0; ai < 2; ++ai)
#pragma unroll
            for (int m = 0; m < 4; ++m) rsv[ai][m] = rstd[row0 + ai * HALF + m * 16];
        if (pn < 4) {
            const bool isq = pn < 2; bf16_t* O = isq ? qn : kn; const float* g = isq ? qg : kg; const float post = isq ? 0.125f : 1.0f;
            f32x4 gv[2][2];
#pragma unroll
            for (int bj = 0; bj < 2; ++bj)
#pragma unroll
                for (int n = 0; n < 2; ++n) gv[bj][n] = *(const f32x4*)(g + 32 * bj + 8 * fq + 4 * n);
            const int colbase = (pn & 1) * 256 + lc0;
#pragma unroll
            for (int ai = 0; ai < 2; ++ai)
#pragma unroll
                for (int m = 0; m < 4; ++m) {
                    const int row = row0 + ai * HALF + m * 16; const float rs = rsv[ai][m];
                    f32x4 v[2][2]; float ss = 0.f;
#pragma unroll
                    for (int bj = 0; bj < 2; ++bj)
#pragma unroll
                        for (int n = 0; n < 2; ++n) { v[bj][n] = acc[ai][bj][m][n] * rs; ss += (v[bj][n][0] * v[bj][n][0] + v[bj][n][1] * v[bj][n][1]) + (v[bj][n][2] * v[bj][n][2] + v[bj][n][3] * v[bj][n][3]); }
                    ss += __shfl_xor(ss, 16); ss += __shfl_xor(ss, 32);
                    const float r = rsqrtf(ss * (1.0f / 64.0f) + RMS_EPS) * post;
#pragma unroll
                    for (int bj = 0; bj < 2; ++bj) *(u32x4*)(O + (size_t)row * 512 + colbase + 32 * bj) = pack8(v[bj][0] * r * gv[bj][0], v[bj][1] * r * gv[bj][1]);
                }
        } else if (pn < 8) {
            bf16_t* O = pn < 6 ? pp : xq; const int colbase = (pn & 1) * 256 + lc0;
#pragma unroll
            for (int ai = 0; ai < 2; ++ai)
#pragma unroll
                for (int m = 0; m < 4; ++m) {
                    const int row = row0 + ai * HALF + m * 16; const float rs = rsv[ai][m];
#pragma unroll
                    for (int bj = 0; bj < 2; ++bj) *(u32x4*)(O + (size_t)row * 512 + colbase + 32 * bj) = pack8(acc[ai][bj][m][0] * rs, acc[ai][bj][m][1] * rs);
                }
        } else {
            const int gcol0 = (pn - 8) * 256 + lc0;
            f32x4 bv[2][2];
#pragma unroll
            for (int bj = 0; bj < 2; ++bj)
#pragma unroll
                for (int n = 0; n < 2; ++n) bv[bj][n] = *(const f32x4*)(gate_b + gcol0 + 32 * bj + 4 * n) * (-1.4426950408889634f);
#pragma unroll
            for (int ai = 0; ai < 2; ++ai)
#pragma unroll
                for (int m = 0; m < 4; ++m) {
                    const int row = row0 + ai * HALF + m * 16; const float rs = rsv[ai][m] * (-1.4426950408889634f);
#pragma unroll
                    for (int bj = 0; bj < 2; ++bj) {
                        f32x4 o[2];
#pragma unroll
                        for (int n = 0; n < 2; ++n) { const f32x4 z = acc[ai][bj][m][n] * rs + bv[bj][n];
#pragma unroll
                            for (int i = 0; i < 4; ++i) o[n][i] = __builtin_amdgcn_rcpf(1.0f + __builtin_amdgcn_exp2f(z[i])); }
                        *(u32x4*)(gates + (size_t)row * 3072 + gcol0 + 32 * bj) = pack8(o[0], o[1]);
                    }
                }
        }
    }
};
struct EpiVt {
    static constexpr bool PERM = true, AFTER_DRAIN = false, HAS_MID = false;
    const float* rstd; bf16_t* Vt;
    __device__ __forceinline__ void operator()(const f32x4 (&acc)[2][2][4][2], const Unit& u, int wr, int wc, int fr, int fq) const {
        const int ch0 = u.pm * BM + wr * 64 + fr, tok0 = u.pn * BM + wc * 32 + 8 * fq, b = tok0 >> 13, t0 = tok0 & 8191;
        f32x4 rv[2][2];
#pragma unroll
        for (int bj = 0; bj < 2; ++bj)
#pragma unroll
            for (int n = 0; n < 2; ++n) rv[bj][n] = *(const f32x4*)(rstd + tok0 + bj * HALF + 4 * n);
#pragma unroll
        for (int ai = 0; ai < 2; ++ai)
#pragma unroll
            for (int m = 0; m < 4; ++m) { const int ch = ch0 + ai * HALF + m * 16; bf16_t* rowp = Vt + ((size_t)(b * 512 + ch) * 8192 + t0);
#pragma unroll
                for (int bj = 0; bj < 2; ++bj) *(u32x4*)(rowp + bj * HALF) = pack8(acc[ai][bj][m][0] * rv[bj][0], acc[ai][bj][m][1] * rv[bj][1]); }
    }
};
struct EpiMergeCat {
    static constexpr bool PERM = true, AFTER_DRAIN = false, HAS_MID = true;
    const bf16_t* gates; bf16_t* merged;
    __device__ __forceinline__ void mid(f32x4 (&acc)[2][2][4][2], const Unit& u, int nb  , int wr, int wc, int fr, int fq) const {
        const int row0 = u.pm * BM + wr * 64 + fr, col0 = u.pn * BM + wc * 32 + 8 * fq;
#pragma unroll
        for (int ai = 0; ai < 2; ++ai) {
            u32x4 ga[4][2], gb[4][2];
#pragma unroll
            for (int m = 0; m < 4; ++m)
#pragma unroll
                for (int bj = 0; bj < 2; ++bj) { const bf16_t* gp = gates + (size_t)(row0 + ai * HALF + m * 16) * 3072 + (nb - 1) * 1024 + col0 + bj * HALF;
                    ga[m][bj] = *(const u32x4*)gp; gb[m][bj] = *(const u32x4*)(gp + 1024); }
            __builtin_amdgcn_sched_barrier(0);
#pragma unroll
            for (int m = 0; m < 4; ++m)
#pragma unroll
                for (int bj = 0; bj < 2; ++bj) { const u32x4 a = ga[m][bj], b = gb[m][bj]; f32x4& x0 = acc[ai][bj][m][0]; f32x4& x1 = acc[ai][bj][m][1];
                    x0[0] *= bflo(a.x) * __builtin_amdgcn_rcpf(bflo(b.x)); x0[1] *= bfhi(a.x) * __builtin_amdgcn_rcpf(bfhi(b.x)); x0[2] *= bflo(a.y) * __builtin_amdgcn_rcpf(bflo(b.y)); x0[3] *= bfhi(a.y) * __builtin_amdgcn_rcpf(bfhi(b.y));
                    x1[0] *= bflo(a.z) * __builtin_amdgcn_rcpf(bflo(b.z)); x1[1] *= bfhi(a.z) * __builtin_amdgcn_rcpf(bfhi(b.z)); x1[2] *= bflo(a.w) * __builtin_amdgcn_rcpf(bflo(b.w)); x1[3] *= bfhi(a.w) * __builtin_amdgcn_rcpf(bfhi(b.w)); }
            __builtin_amdgcn_sched_barrier(0);
        }
    }
    __device__ __forceinline__ void operator()(const f32x4 (&acc)[2][2][4][2], const Unit& u, int wr, int wc, int fr, int fq) const {
        const int row0 = u.pm * BM + wr * 64 + fr, col0 = u.pn * BM + wc * 32 + 8 * fq;
#pragma unroll
        for (int ai = 0; ai < 2; ++ai) {
            u32x4 g8[4][2];
#pragma unroll
            for (int m = 0; m < 4; ++m)
#pragma unroll
                for (int bj = 0; bj < 2; ++bj) g8[m][bj] = *(const u32x4*)(gates + (size_t)(row0 + ai * HALF + m * 16) * 3072 + 2048 + col0 + bj * HALF);
            __builtin_amdgcn_sched_barrier(0);
#pragma unroll
            for (int m = 0; m < 4; ++m)
#pragma unroll
                for (int bj = 0; bj < 2; ++bj) { const u32x4 g = g8[m][bj]; f32x4 a = acc[ai][bj][m][0], b = acc[ai][bj][m][1];
                    a[0] *= bflo(g.x); a[1] *= bfhi(g.x); a[2] *= bflo(g.y); a[3] *= bfhi(g.y); b[0] *= bflo(g.z); b[1] *= bfhi(g.z); b[2] *= bflo(g.w); b[3] *= bfhi(g.w);
                    *(u32x4*)(merged + (size_t)(row0 + ai * HALF + m * 16) * 1024 + col0 + bj * HALF) = pack8(a, b); }
            __builtin_amdgcn_sched_barrier(0);
        }
    }
};
struct EpiH {
    static constexpr bool PERM = true, AFTER_DRAIN = false, HAS_MID = false;
    const bf16_t* x; float* out; bf16_t* hb; float* rowsq; int noatomic;
    __device__ __forceinline__ void operator()(const f32x4 (&acc)[2][2][4][2], const Unit& u, int wr, int wc, int fr, int fq) const {
        const int row0 = u.pm * BM + wr * 64 + fr, col0 = u.pn * BM + wc * 32 + 8 * fq;
#pragma unroll
        for (int ai = 0; ai < 2; ++ai) {
            u32x4 xv[4][2];
#pragma unroll
            for (int m = 0; m < 4; ++m)
#pragma unroll
                for (int bj = 0; bj < 2; ++bj) xv[m][bj] = *(const u32x4*)(x + ((size_t)(row0 + ai * HALF + m * 16) * 1024 + col0 + bj * HALF));
            __builtin_amdgcn_sched_barrier(0);
#pragma unroll
            for (int m = 0; m < 4; ++m) { const int row = row0 + ai * HALF + m * 16; float ss = 0.f;
#pragma unroll
                for (int bj = 0; bj < 2; ++bj) { const size_t o = (size_t)row * 1024 + col0 + bj * HALF;
                    const u32x4 xq = xv[m][bj]; f32x4 h0 = acc[ai][bj][m][0], h1 = acc[ai][bj][m][1];
                    h0[0] += bflo(xq.x); h0[1] += bfhi(xq.x); h0[2] += bflo(xq.y); h0[3] += bfhi(xq.y); h1[0] += bflo(xq.z); h1[1] += bfhi(xq.z); h1[2] += bflo(xq.w); h1[3] += bfhi(xq.w);
                    *(u32x4*)(hb + o) = pack8(h0, h1);
                    ss += (h0[0] * h0[0] + h0[1] * h0[1]) + (h0[2] * h0[2] + h0[3] * h0[3]) + (h1[0] * h1[0] + h1[1] * h1[1]) + (h1[2] * h1[2] + h1[3] * h1[3]); }
                ss += __shfl_xor(ss, 16); ss += __shfl_xor(ss, 32);
                if (fq == 0 && !noatomic) atomicAdd(rowsq + row, ss); }
            __builtin_amdgcn_sched_barrier(0);
        }
    }
};
struct EpiQ {
    static constexpr bool PERM = true, AFTER_DRAIN = false, HAS_MID = false;
    const float* rowsq; bf16_t* qb;
    __device__ __forceinline__ void operator()(const f32x4 (&acc)[2][2][4][2], const Unit& u, int wr, int wc, int fr, int fq) const {
        const int row0 = u.pm * BM + wr * 64 + fr, col0 = u.pn * BM + wc * 32 + 8 * fq;
        float rq[2][4];
#pragma unroll
        for (int ai = 0; ai < 2; ++ai)
#pragma unroll
            for (int m = 0; m < 4; ++m) rq[ai][m] = rowsq[row0 + ai * HALF + m * 16];
#pragma unroll
        for (int ai = 0; ai < 2; ++ai)
#pragma unroll
            for (int m = 0; m < 4; ++m) { const int row = row0 + ai * HALF + m * 16; const float r = rsqrtf(rq[ai][m] * (1.0f / 1024.0f) + RMS_EPS);
#pragma unroll
                for (int bj = 0; bj < 2; ++bj) *(u32x4*)(qb + (size_t)row * 2048 + col0 + bj * HALF) = pack8(acc[ai][bj][m][0] * r, acc[ai][bj][m][1] * r); }
    }
};

template <class Epi, class Sched, bool ALIGN_EPI = false, bool SP2 = false>
__device__ __forceinline__ void gemm_phase(PG8_LAS unsigned char* lds, const int K, const Sched& S, const Epi& E, const int wid, const int lane) {
    const int tid = wid * 64 + lane, wr = wid >> 2, wc = wid & 3, fr = lane & 15, fq = lane >> 4;
    const int nt = K / BK;
    unsigned voffA[2], voffB[2];
#pragma unroll
    for (int i = 0; i < 2; ++i) { int R, C; stage_rc(tid * 16 + i * 8192, R, C); const int Rb = Epi::PERM ? ((R & ~31) + perm32(R & 31)) : R;
        voffA[i] = (unsigned)(R * K + C) * 2u; voffB[i] = (unsigned)(Rb * K + C) * 2u; }
    const size_t kstep = (size_t)(BK * 2);
    const size_t hstep = (size_t)HALF * K * 2;
    const size_t tstep = 2 * hstep;
    const unsigned ldsw = (unsigned)wid * 1024u;
    const int aoff = lds_byte(wr * 64 + fr, fq * 8), boff = lds_byte(wc * 32 + fr, fq * 8);
#define PG8_SA(b, h) (((b) * 2 + (h)) * HTB)
#define PG8_SB(b, h) ((4 + (b) * 2 + (h)) * HTB)
#define PG8_STAGE(bufoff, gbase, voff) do { _Pragma("unroll") for (int _i = 0; _i < 2; ++_i) \
        __builtin_amdgcn_global_load_lds((const unsigned*)((const char*)(gbase) + (voff)[_i]), (PG8_LAS unsigned*)(lds + (bufoff) + ldsw + _i * 8192), 16, 0, 0); } while (0)
#define PG8_LDA(dst, b, h) do { _Pragma("unroll") for (int m = 0; m < 4; ++m) _Pragma("unroll") for (int k = 0; k < 2; ++k) dst[m][k] = *(const PG8_LAS bf16x8*)(lds + PG8_SA(b, h) + aoff + m * 2048 + k * 1024); } while (0)
#define PG8_LDB(dst, b, h) do { _Pragma("unroll") for (int n = 0; n < 2; ++n) _Pragma("unroll") for (int k = 0; k < 2; ++k) dst[n][k] = *(const PG8_LAS bf16x8*)(lds + PG8_SB(b, h) + boff + n * 2048 + k * 1024); } while (0)
#define PG8_MMA(ai, bj, At, Bt) do { __builtin_amdgcn_s_setprio(1); _Pragma("unroll") for (int m = 0; m < 4; ++m) _Pragma("unroll") for (int n = 0; n < 2; ++n) _Pragma("unroll") for (int k = 0; k < 2; ++k) \
        acc[ai][bj][m][n] = __builtin_amdgcn_mfma_f32_16x16x32_bf16(Bt[n][k], At[m][k], acc[ai][bj][m][n], 0, 0, 0); __builtin_amdgcn_s_setprio(0); } while (0)
#define PG8_WAIT_V(n) asm volatile("s_waitcnt vmcnt(" #n ")" ::: "memory")
#define PG8_WAIT_L(n) asm volatile("s_waitcnt lgkmcnt(" #n ")" ::: "memory")
#define PG8_BAR __builtin_amdgcn_s_barrier()
#define PG8_SCHED __builtin_amdgcn_sched_barrier(0)
    Unit cur, nxt; int ui = 0;
    if (!S.next(0, cur)) return;
    f32x4 acc[2][2][4][2];
#pragma unroll
    for (int a = 0; a < 2; ++a)
#pragma unroll
        for (int b = 0; b < 2; ++b)
#pragma unroll
            for (int m = 0; m < 4; ++m)
#pragma unroll
                for (int n = 0; n < 2; ++n) acc[a][b][m][n] = (f32x4){0.f, 0.f, 0.f, 0.f};
    bf16x8 At[4][2], B0[2][2], B1[2][2];
    const char* cA = S.abase(cur); const char* cB = S.bbase(cur);
    S.a_ready(cur);
    if constexpr (SP2) {
        PG8_STAGE(PG8_SB(0, 0), cB, voffB); PG8_STAGE(PG8_SB(0, 1), cB + hstep, voffB); PG8_STAGE(PG8_SA(0, 0), cA, voffA); PG8_STAGE(PG8_SA(0, 1), cA + hstep, voffA);
        if (wr == 1) PG8_BAR;
        PG8_WAIT_V(2); PG8_BAR;
        PG8_STAGE(PG8_SB(1, 0), cB + kstep, voffB); PG8_STAGE(PG8_SA(1, 0), cA + kstep, voffA); PG8_STAGE(PG8_SB(1, 1), cB + hstep + kstep, voffB);
        PG8_WAIT_V(6); PG8_BAR;
    } else {
        PG8_STAGE(PG8_SB(0, 0), cB, voffB); PG8_STAGE(PG8_SA(0, 0), cA, voffA); PG8_STAGE(PG8_SB(0, 1), cB + hstep, voffB); PG8_STAGE(PG8_SA(0, 1), cA + hstep, voffA);
        if (wr == 1) PG8_BAR;
        PG8_WAIT_V(4); PG8_BAR;
        PG8_STAGE(PG8_SB(1, 0), cB + kstep, voffB); PG8_STAGE(PG8_SA(1, 0), cA + kstep, voffA); PG8_STAGE(PG8_SB(1, 1), cB + hstep + kstep, voffB);
        PG8_WAIT_V(6); PG8_BAR;
    }
    for (;;) {
        const bool has_next = S.next(ui + 1, nxt);
        const char* nA = has_next ? S.abase(nxt) : cA; const char* nB = has_next ? S.bbase(nxt) : cB;
        for (int t = 0; t < nt; t += 2) {
            if constexpr (Epi::HAS_MID) { if (t == 8 || t == 16) E.mid(acc, cur, t >> 3, wr, wc, fr, fq); }
            const bool last = (t == nt - 2);
            const char* a1 = cA + (size_t)(t + 1) * kstep;
            const char* a2 = last ? nA : cA + (size_t)(t + 2) * kstep; const char* b2 = last ? nB : cB + (size_t)(t + 2) * kstep;
            const char* a3 = a2 + kstep; const char* b3 = b2 + kstep;
            if (last && has_next) S.a_ready(nxt);
            if constexpr (SP2) {
            PG8_LDB(B0, 0, 0); PG8_LDB(B1, 0, 1); PG8_SCHED; PG8_LDA(At, 0, 0); PG8_STAGE(PG8_SA(1, 1), a1 + hstep, voffA);
            PG8_WAIT_V(8); PG8_WAIT_L(0); PG8_BAR; PG8_MMA(0, 0, At, B0); PG8_MMA(0, 1, At, B1); PG8_BAR; PG8_SCHED;
            PG8_LDA(At, 0, 1); PG8_STAGE(PG8_SB(0, 0), b2, voffB); PG8_STAGE(PG8_SB(0, 1), b2 + hstep, voffB); PG8_STAGE(PG8_SA(0, 0), a2, voffA);
            PG8_WAIT_V(8); PG8_WAIT_L(0); PG8_BAR; PG8_MMA(1, 0, At, B0); PG8_MMA(1, 1, At, B1); PG8_BAR; PG8_SCHED;
            PG8_LDB(B0, 1, 0); PG8_LDB(B1, 1, 1); PG8_SCHED; PG8_LDA(At, 1, 0); PG8_STAGE(PG8_SA(0, 1), a2 + hstep, voffA);
            PG8_WAIT_V(8); PG8_WAIT_L(0); PG8_BAR; PG8_MMA(0, 0, At, B0); PG8_MMA(0, 1, At, B1); PG8_BAR; PG8_SCHED;
            PG8_LDA(At, 1, 1); PG8_STAGE(PG8_SB(1, 0), b3, voffB); PG8_STAGE(PG8_SB(1, 1), b3 + hstep, voffB); PG8_STAGE(PG8_SA(1, 0), a3, voffA);
            PG8_WAIT_V(8); PG8_WAIT_L(0); PG8_BAR; PG8_MMA(1, 0, At, B0); PG8_MMA(1, 1, At, B1); PG8_BAR; PG8_SCHED;
            } else {
            PG8_LDB(B0, 0, 0); PG8_SCHED; PG8_LDA(At, 0, 0); PG8_STAGE(PG8_SA(1, 1), a1 + hstep, voffA);
            PG8_WAIT_L(8); PG8_BAR; PG8_WAIT_L(0); PG8_MMA(0, 0, At, B0); PG8_BAR; PG8_SCHED;
            PG8_LDB(B1, 0, 1); PG8_STAGE(PG8_SB(0, 0), b2, voffB);
            PG8_BAR; PG8_WAIT_L(0); PG8_MMA(0, 1, At, B1); PG8_BAR;
            PG8_LDA(At, 0, 1); PG8_STAGE(PG8_SA(0, 0), a2, voffA);
            PG8_BAR; PG8_WAIT_L(0); PG8_MMA(1, 0, At, B0); PG8_BAR; PG8_SCHED;
            PG8_STAGE(PG8_SB(0, 1), b2 + hstep, voffB);
            PG8_WAIT_V(6); PG8_BAR; PG8_MMA(1, 1, At, B1); PG8_BAR;
            PG8_LDB(B0, 1, 0); PG8_SCHED; PG8_LDA(At, 1, 0); PG8_STAGE(PG8_SA(0, 1), a2 + hstep, voffA);
            PG8_WAIT_L(8); PG8_BAR; PG8_WAIT_L(0); PG8_MMA(0, 0, At, B0); PG8_BAR; PG8_SCHED;
            PG8_LDB(B1, 1, 1); PG8_STAGE(PG8_SB(1, 0), b3, voffB);
            PG8_BAR; PG8_WAIT_L(0); PG8_MMA(0, 1, At, B1); PG8_BAR;
            PG8_LDA(At, 1, 1); PG8_STAGE(PG8_SA(1, 0), a3, voffA);
            PG8_BAR; PG8_WAIT_L(0); PG8_MMA(1, 0, At, B0); PG8_BAR; PG8_SCHED;
            PG8_STAGE(PG8_SB(1, 1), b3 + hstep, voffB);
            PG8_WAIT_V(6); PG8_BAR; PG8_MMA(1, 1, At, B1); PG8_BAR;
            }
        }
        if constexpr (ALIGN_EPI) { if (wr == 0) PG8_BAR; }
        if constexpr (!Epi::AFTER_DRAIN) { E(acc, cur, wr, wc, fr, fq); S.done(cur); }
        if (!has_next) break;
#pragma unroll
        for (int a = 0; a < 2; ++a)
#pragma unroll
            for (int b = 0; b < 2; ++b)
#pragma unroll
                for (int m = 0; m < 4; ++m)
#pragma unroll
                    for (int n = 0; n < 2; ++n) acc[a][b][m][n] = (f32x4){0.f, 0.f, 0.f, 0.f};
        cur = nxt; cA = nA; cB = nB; ++ui;
        if constexpr (ALIGN_EPI) { if (wr == 1) PG8_BAR; }
    }
    PG8_WAIT_V(0);
    if constexpr (!ALIGN_EPI) { if (wr == 0) PG8_BAR; }
    PG8_BAR;
    if constexpr (Epi::AFTER_DRAIN) { E.fused(acc, cur, wr, wc, fr, fq, lds, wid, lane); S.done(cur); }
#undef PG8_SA
#undef PG8_SB
#undef PG8_STAGE
#undef PG8_LDA
#undef PG8_LDB
#undef PG8_MMA
#undef PG8_WAIT_V
#undef PG8_WAIT_L
#undef PG8_BAR
#undef PG8_SCHED
}
}

constexpr int NWAVES = 8;
constexpr int N_LAUNCHES = MK_N_LAUNCHES;
constexpr int PER_PHASE = 9;
constexpr int NBATCH = 4, SEQ = 8192, D = 1024, T = NBATCH * SEQ, MEMLEN = 256, NMEMTOK = NBATCH * MEMLEN;
constexpr int IN_MAIN = 5120;
constexpr int NEXP = 16384;

constexpr size_t MiB = 1u << 20;
constexpr size_t WS_CTL = 0, CTL_ZERO_BYTES = 512 * 1024;
constexpr size_t WS_ROWSQ = 256 * 1024;
constexpr size_t WS_WIN = 1 * MiB, WS_WV = 11 * MiB, WS_WKV = 12 * MiB, WS_WBR = 14 * MiB, WS_WOUT = 17 * MiB, WS_WQ = 19 * MiB, WS_KEYS = 23 * MiB, WS_PWT = 23 * MiB + 512 * 1024;
constexpr size_t WS_MEMN = 24 * MiB, WS_KMEM = 26 * MiB, WS_VTMEM = 27 * MiB, WS_RSTDX = 28 * MiB, WS_SU = 28 * MiB + 256 * 1024  , WS_SV = 28 * MiB + 512 * 1024  ;
constexpr size_t WS_U8 = 32 * MiB, WS_V8 = 48 * MiB;
constexpr size_t WS_QN = 96 * MiB, WS_KN = 128 * MiB, WS_VT = 160 * MiB, WS_PP = 192 * MiB, WS_XQ = 224 * MiB, WS_GATE = 256 * MiB, WS_XB = 448 * MiB  , WS_END = 512 * MiB;
constexpr size_t WS_MERGED = WS_QN;
constexpr size_t WS_HB = WS_VT;
constexpr size_t WS_QB = WS_GATE;
constexpr size_t WS_TE = WS_GATE + 128 * MiB, WS_TW = WS_TE + 16 * MiB;
constexpr size_t WS_HQ = WS_TW + 16 * MiB;
constexpr size_t WS_HS = 28 * MiB + 768 * 1024;
constexpr size_t WS_AW = WS_MERGED;
constexpr size_t OUT_XB = 0, OUT_YNA = 0, OUT_YPOOL = 512 * 2, OUT_YXA = 1024 * 2;
constexpr int CW_TMO = 0, CW_BAR = 4096, CW_TICKET = 8192;

constexpr int RING_OFF = 0, RING_BYTES = 131072;
constexpr int LDSCTL_OFF = RING_BYTES, MISC_OFF = LDSCTL_OFF + 320;
constexpr int LDS_BYTES = 147456;

#define GAS __attribute__((address_space(1)))
#define LAS __attribute__((address_space(3)))
typedef unsigned short bf16;
typedef unsigned v4u __attribute__((ext_vector_type(4)));
typedef unsigned v2u __attribute__((ext_vector_type(2)));
typedef float f32x4 __attribute__((ext_vector_type(4)));
typedef short bf16x8 __attribute__((ext_vector_type(8)));
typedef __bf16 bf16x2_t __attribute__((ext_vector_type(2)));
typedef GAS unsigned gu32;
#define LDS_WAIT() asm volatile("s_waitcnt lgkmcnt(0)" ::: "memory")
#define VM_WAIT() asm volatile("s_waitcnt vmcnt(0)" ::: "memory")
__device__ __forceinline__ unsigned f2bf(float f) { unsigned u = __builtin_bit_cast(unsigned, f); return (u + 0x7fffu + ((u >> 16) & 1u)) >> 16; }
__device__ __forceinline__ unsigned pk2(float lo, float hi) { return f2bf(lo) | (f2bf(hi) << 16); }
__device__ __forceinline__ float bflo(unsigned u) { return __builtin_bit_cast(float, u << 16); }
__device__ __forceinline__ float bfhi(unsigned u) { return __builtin_bit_cast(float, u & 0xffff0000u); }
__device__ __forceinline__ float bf1(short s) { return __builtin_bit_cast(float, ((unsigned)(unsigned short)s) << 16); }
__device__ __forceinline__ f32x4 mfma16(bf16x8 a, bf16x8 b, f32x4 c) { return __builtin_amdgcn_mfma_f32_16x16x32_bf16(a, b, c, 0, 0, 0); }
__device__ __forceinline__ float wave_sum(float v) {
#pragma unroll
    for (int o = 1; o < 64; o <<= 1) v += __shfl_xor(v, o);
    return v;
}

#define XB_TMO      128
#define XB_XCNT(j)  (256  + 64 * (j))
#define XB_XSUB(j)  (1280 + 64 * (j))
#define XB_XGEN(j)  (2304 + 64 * (j))
#define XB_TOP      3328
#define XB_TOPGEN   3392
#define XCD_BAR_WORDS 3456
#define XB_SPIN_CAP (1u << 18)

__device__ __forceinline__ unsigned xb_ld(unsigned* p)              { return __hip_atomic_load(p, __ATOMIC_RELAXED, __HIP_MEMORY_SCOPE_AGENT); }
__device__ __forceinline__ unsigned xb_add(unsigned* p, unsigned v) { return __hip_atomic_fetch_add(p, v, __ATOMIC_RELAXED, __HIP_MEMORY_SCOPE_AGENT); }
__device__ __forceinline__ unsigned xb_xcc_id() { return (unsigned)__builtin_amdgcn_s_getreg((3 << 11) | 20) & 0xFu; }
#define XB_SPIN(cond, bar) do { unsigned _sp = 0; while (cond) { __builtin_amdgcn_s_sleep(1); \
    if ((++_sp & 255u) == 0u) { if (xb_ld(&(bar)[XB_TMO])) break; if (_sp > XB_SPIN_CAP) { atomicAdd(&(bar)[XB_TMO], 1u); break; } } } } while (0)

struct XcdBarrier {
    unsigned* bar; unsigned x;
    volatile LAS unsigned* st;
};

__device__ __forceinline__ XcdBarrier xcd_barrier_post(unsigned* bar, volatile LAS unsigned* st) {
    XcdBarrier b; b.bar = bar; b.x = xb_xcc_id(); b.st = st;
    if (threadIdx.x == 0) (void)xb_add(&bar[XB_XCNT(b.x)], 1u);
    return b;
}
__device__ __forceinline__ void xcd_barrier_complete(unsigned* bar, unsigned x, unsigned& nloc, unsigned& nx) {
    const unsigned G = gridDim.x * gridDim.y * gridDim.z;
    unsigned sum, cnt, mine, sp = 0u;
    for (;;) {
        sum = 0u; cnt = 0u; mine = 0u;
#pragma unroll
        for (unsigned j = 0; j < 16; ++j) { const unsigned c = xb_ld(&bar[XB_XCNT(j)]); sum += c; cnt += (c > 0u) ? 1u : 0u; mine = (j == x) ? c : mine; }
        if (sum == G) break;
        __builtin_amdgcn_s_sleep(1);
        if ((++sp & 255u) == 0u) { if (xb_ld(&bar[XB_TMO])) break; if (sp > XB_SPIN_CAP) { atomicAdd(&bar[XB_TMO], 1u); break; } }
    }
    nloc = mine > 0u ? mine : 1u; nx = cnt > 0u ? cnt : 1u;
}

__device__ __forceinline__ void xcd_barrier(const XcdBarrier& b, const bool leader) {
    asm volatile("s_waitcnt vmcnt(0)" ::: "memory");
    __syncthreads();
    if (leader) {
        unsigned* bar = b.bar;
        __builtin_amdgcn_s_waitcnt(0);
        unsigned nloc = b.st[0], nx = b.st[1];
        if (nloc == 0u) { xcd_barrier_complete(bar, b.x, nloc, nx); b.st[0] = nloc; b.st[1] = nx; }
        const unsigned old = xb_add(&bar[XB_XSUB(b.x)], 1u);
        const unsigned gen = old / nloc;
        if (old + 1u == (gen + 1u) * nloc) {
            __builtin_amdgcn_fence(__ATOMIC_RELEASE, "agent");
            asm volatile("s_waitcnt vmcnt(0)" ::: "memory");
            const unsigned og = xb_add(&bar[XB_TOP], 1u);
            const unsigned tg = og / nx;
            if (og + 1u == (tg + 1u) * nx) xb_add(&bar[XB_TOPGEN], 1u);
            else XB_SPIN(xb_ld(&bar[XB_TOPGEN]) == tg, bar);
            __builtin_amdgcn_fence(__ATOMIC_ACQUIRE, "agent");
            xb_add(&bar[XB_XGEN(b.x)], 1u);
            asm volatile("s_waitcnt vmcnt(0)" ::: "memory");
        } else {
            XB_SPIN(xb_ld(&bar[XB_XGEN(b.x)]) == gen, bar);
            __builtin_amdgcn_fence(__ATOMIC_ACQUIRE, "agent");
            asm volatile("s_waitcnt vmcnt(0)" ::: "memory");
        }
    }
    __syncthreads();
}

struct Frame {
    LAS unsigned char* lds;
    volatile LAS unsigned* MISC;
    gu32* ctl;
    int tid, lane, wave, vcu, G;
    float* out; unsigned char* ws;
};
struct Args { const float* in[23]; float* out; unsigned char* ws; int ph_lo, ph_hi, probe, pad; };
enum { I_X = 0, I_MEM, I_MIXG, I_MEMG, I_WIN, I_GATEB, I_WKV, I_NAQG, I_NAKG, I_RPB, I_POOLW, I_POOLSC, I_XAQG, I_XAKG, I_WB0, I_WB1, I_WB2, I_WOUT, I_FFNG, I_WQ, I_KEYS, I_PU, I_PV };

__device__ __forceinline__ void p0_transpose_item(const float* W, int K, int N, int k0, int n0, bf16* dst, const float* kscale, LAS float* scr, int lane, int dpitch = 0) {
    if (dpitch == 0) dpitch = K;
#pragma unroll 8
    for (int i = 0; i < 32; ++i) { const int kk = 2 * i + (lane >> 5); float v = W[(size_t)(k0 + kk) * N + n0 + (lane & 31)]; if (kscale) v *= kscale[k0 + kk]; scr[kk * 33 + (lane & 31)] = v; }
    LDS_WAIT(); asm volatile("" ::: "memory");
    const int c = lane & 7;
#pragma unroll
    for (int j = 0; j < 4; ++j) { const int n = (lane >> 3) + 8 * j; const LAS float* s = scr + (8 * c) * 33 + n;
        v4u o; o.x = pk2(s[0 * 33], s[1 * 33]); o.y = pk2(s[2 * 33], s[3 * 33]); o.z = pk2(s[4 * 33], s[5 * 33]); o.w = pk2(s[6 * 33], s[7 * 33]);
        *(GAS v4u*)(dst + (size_t)n * dpitch + k0 + 8 * c) = o; }
    LDS_WAIT(); asm volatile("" ::: "memory");
}
__device__ __forceinline__ void cvt_row1024(const float* src, bf16* dst, const float* colscale, float rowscale, int lane) {
    const GAS f32x4* xr = (const GAS f32x4*)src + lane; GAS unsigned long long* o8 = (GAS unsigned long long*)dst + lane;
#pragma unroll
    for (int j = 0; j < 4; ++j) { f32x4 v = xr[64 * j] * rowscale; if (colscale) v = v * ((const GAS f32x4*)colscale)[lane + 64 * j];
        o8[64 * j] = (unsigned long long)pk2(v.x, v.y) | ((unsigned long long)pk2(v.z, v.w) << 32); }
}
__device__ __forceinline__ float row_rstd1024(const float* src, int lane) {
    const GAS f32x4* xr = (const GAS f32x4*)src + lane; float s = 0.f;
#pragma unroll
    for (int j = 0; j < 4; ++j) { const f32x4 v = xr[64 * j]; s += (v.x * v.x + v.y * v.y) + (v.z * v.z + v.w * v.w); }
    return rsqrtf(wave_sum(s) * (1.0f / 1024.0f) + 1e-6f);
}
__device__ __forceinline__ void p0_prologue(Frame& F, const Args& A) {
    LAS float* scr = (LAS float*)(F.lds + RING_OFF + F.wave * 16384);
    const int gw = F.vcu * NWAVES + F.wave, NGW = F.G * NWAVES, lane = F.lane;
    unsigned char* ws = F.ws;
    constexpr int I_IN = 16 * 176, I_KV = 16 * 32, I_BR = 8 * 32, I_OUT = 16 * 32, I_Q = 16 * 64;
    constexpr int NITEMS = I_IN + I_KV + 3 * I_BR + I_OUT + I_Q;
    if (!(A.probe & 1)) for (int it = gw; it < NITEMS; it += NGW) {
        int r = it;
        if (r < I_IN) { const int kb = r / 176, nb = r % 176, n0 = 32 * nb; bf16* dst;
            if (n0 >= 1024 && n0 < 1536) dst = (bf16*)(ws + WS_WV) + (size_t)(n0 - 1024) * 1024;
            else { const int np = n0 < 1024 ? n0 : n0 - 512, t = np >> 8, w = np & 255, wc = w >> 6, bj = (w >> 5) & 1; dst = (bf16*)(ws + WS_WIN) + (size_t)(256 * t + 128 * bj + 32 * wc) * 1024; }
            p0_transpose_item(A.in[I_WIN], 1024, 5632, 64 * kb, n0, dst, A.in[I_MIXG], scr, lane); continue; }
        r -= I_IN;
        if (r < I_KV) { const int kb = r / 32, nb = r % 32; p0_transpose_item(A.in[I_WKV], 1024, 1024, 64 * kb, 32 * nb, (bf16*)(ws + WS_WKV) + (size_t)(32 * nb) * 1024, nullptr, scr, lane); continue; }
        r -= I_KV;
        if (r < 3 * I_BR) { const int br = r / I_BR, rr = r % I_BR, kb = rr / 32, nb = rr % 32; const float* W = br == 0 ? A.in[I_WB0] : (br == 1 ? A.in[I_WB1] : A.in[I_WB2]);
            p0_transpose_item(W, 512, 1024, 64 * kb, 32 * nb, (bf16*)(ws + WS_WBR) + (size_t)(32 * nb) * 1536 + br * 512, nullptr, scr, lane, 1536); continue; }
        r -= 3 * I_BR;
        if (r < I_OUT) { const int kb = r / 32, nb = r % 32; p0_transpose_item(A.in[I_WOUT], 1024, 1024, 64 * kb, 32 * nb, (bf16*)(ws + WS_WOUT) + (size_t)(32 * nb) * 1024, nullptr, scr, lane); continue; }
        r -= I_OUT;
        { const int kb = r / 64, nb = r % 64; p0_transpose_item(A.in[I_WQ], 1024, 2048, 64 * kb, 32 * nb, (bf16*)(ws + WS_WQ) + (size_t)(32 * nb) * 1024, A.in[I_FFNG], scr, lane); }
    }
    { bf16* xb = (bf16*)(ws + WS_XB); float* rstdx = (float*)(ws + WS_RSTDX);
      if (!(A.probe & 2)) for (int m0 = 4 * gw; m0 < T; m0 += 4 * NGW) {
          f32x4 v[4][4];
#pragma unroll
          for (int r = 0; r < 4; ++r)
#pragma unroll
              for (int j = 0; j < 4; ++j) v[r][j] = ((const GAS f32x4*)(A.in[I_X] + (size_t)(m0 + r) * D))[lane + 64 * j];
#pragma unroll
          for (int r = 0; r < 4; ++r) { float s = 0.f;
#pragma unroll
              for (int j = 0; j < 4; ++j) s += (v[r][j].x * v[r][j].x + v[r][j].y * v[r][j].y) + (v[r][j].z * v[r][j].z + v[r][j].w * v[r][j].w);
              const float rs = rsqrtf(wave_sum(s) * (1.0f / 1024.0f) + 1e-6f);
              GAS unsigned long long* o8 = (GAS unsigned long long*)(xb + (size_t)(m0 + r) * D) + lane;
#pragma unroll
              for (int j = 0; j < 4; ++j) o8[64 * j] = (unsigned long long)pk2(v[r][j].x, v[r][j].y) | ((unsigned long long)pk2(v[r][j].z, v[r][j].w) << 32);
              if (lane == 0) rstdx[m0 + r] = rs; } } }
    for (int m = gw; m < NMEMTOK; m += NGW) { const float* xr = A.in[I_MEM] + (size_t)m * D; const float rs = row_rstd1024(xr, lane); cvt_row1024(xr, (bf16*)(ws + WS_MEMN) + (size_t)m * D, A.in[I_MEMG], rs, lane); }
    if (!(A.probe & 4)) for (int mb = 4 * gw; mb < 2 * NEXP; mb += 4 * NGW) {
        const bool isu = mb < NEXP; const int e0 = isu ? mb : mb - NEXP;
        f32x4 v[4][4];
#pragma unroll
        for (int r = 0; r < 4; ++r) { const GAS f32x4* src = (const GAS f32x4*)((isu ? A.in[I_PU] : A.in[I_PV]) + (size_t)(e0 + r) * D) + 4 * lane;
#pragma unroll
            for (int d = 0; d < 4; ++d) v[r][d] = src[d]; }
        f32x4 gv[4];
#pragma unroll
        for (int d = 0; d < 4; ++d) gv[d] = isu ? ((const GAS f32x4*)A.in[I_FFNG])[4 * lane + d] : (f32x4){1.f, 1.f, 1.f, 1.f};
#pragma unroll
        for (int r = 0; r < 4; ++r) { const int e = e0 + r; float mx = 0.f;
#pragma unroll
            for (int d = 0; d < 4; ++d) { v[r][d] = v[r][d] * gv[d]; mx = fmaxf(mx, fmaxf(fmaxf(fabsf(v[r][d].x), fabsf(v[r][d].y)), fmaxf(fabsf(v[r][d].z), fabsf(v[r][d].w)))); }
#pragma unroll
            for (int o = 1; o < 64; o <<= 1) mx = fmaxf(mx, __shfl_xor(mx, o));
            const float inv = mx > 0.f ? 127.0f / mx : 0.f;
            v4u w;
#pragma unroll
            for (int d = 0; d < 4; ++d) { const unsigned b0 = (unsigned)(int)rintf(v[r][d].x * inv) & 0xffu, b1 = (unsigned)(int)rintf(v[r][d].y * inv) & 0xffu,
                                                         b2 = (unsigned)(int)rintf(v[r][d].z * inv) & 0xffu, b3 = (unsigned)(int)rintf(v[r][d].w * inv) & 0xffu;
                w[d] = b0 | (b1 << 8) | (b2 << 16) | (b3 << 24); }
            if (isu) ((GAS v4u*)(ws + WS_U8))[(size_t)e * 64 + lane] = w;
            else *(GAS v4u*)(ws + WS_V8 + (size_t)(lane >> 3) * (2 * MiB) + (size_t)e * 128 + (lane & 7) * 16) = w;
            if (lane == 0) ((float*)(ws + WS_SU))[2 * e + (isu ? 0 : 1)] = mx * (1.0f / 127.0f); }
    }
    for (int m = gw * 64 + lane; m < T; m += NGW * 64) ((float*)(ws + WS_ROWSQ))[m] = 0.f;
    for (int m = gw; m < 256; m += NGW) cvt_row1024(A.in[I_KEYS] + (size_t)m * 1024, (bf16*)(ws + WS_KEYS) + (size_t)m * 1024, nullptr, 1.0f, lane);
    for (int m = gw; m < 1024; m += NGW) { const int gd = m >> 1, c = (m & 1) * 64 + lane, g = gd >> 7, d = gd & 127;
        const float v = A.in[I_POOLW][(size_t)(g * 128 + c) * 128 + d] * A.in[I_POOLSC][gd];
        ((bf16*)(ws + WS_PWT))[(size_t)gd * 128 + c] = (bf16)f2bf(v); }
}

__device__ __forceinline__ void memkv_tile(const bf16* memn, const bf16* wkvT, const float* kg, const float* qg, bf16* kmem, bf16* vtmem, LAS float* part, int tile, int kc, int lane) {
    const int q = lane & 15, hi = lane >> 4, rg = (tile < 0 ? 0 : tile) >> 3, cg = (tile < 0 ? 0 : tile) & 7, r0 = rg * 16, c0 = cg * 128;
    f32x4 acc[8];
#pragma unroll
    for (int i = 0; i < 8; ++i) acc[i] = (f32x4){0.f, 0.f, 0.f, 0.f};
    const bf16* ap = memn + (size_t)(r0 + q) * 1024 + 8 * hi; const bf16* bp = wkvT + (size_t)(c0 + q) * 1024 + 8 * hi;
    if (tile >= 0)
#pragma unroll 1
    for (int kb = 2 * kc; kb < 2 * kc + 2; ++kb) {
        bf16x8 a[4], b[4][8];
#pragma unroll
        for (int k4 = 0; k4 < 4; ++k4) { a[k4] = *(const bf16x8*)(ap + 32 * (4 * kb + k4));
#pragma unroll
            for (int nf = 0; nf < 8; ++nf) b[k4][nf] = *(const bf16x8*)(bp + (size_t)(16 * nf) * 1024 + 32 * (4 * kb + k4)); }
        __builtin_amdgcn_sched_barrier(0);
#pragma unroll
        for (int k4 = 0; k4 < 4; ++k4)
#pragma unroll
            for (int nf = 0; nf < 8; ++nf) acc[nf] = mfma16(a[k4], b[k4][nf], acc[nf]);
        __builtin_amdgcn_sched_barrier(0);
    }
    if (tile >= 0 && kc > 0) {
#pragma unroll
        for (int nf = 0; nf < 8; ++nf) *(LAS f32x4*)(part + ((kc - 1) * 8 + nf) * 256 + 4 * lane) = acc[nf]; }
    __syncthreads();
    if (tile < 0 || kc > 0) return;
#pragma unroll
    for (int p = 0; p < 3; ++p)
#pragma unroll
        for (int nf = 0; nf < 8; ++nf) acc[nf] = acc[nf] + *(const LAS f32x4*)(part + (p * 8 + nf) * 256 + 4 * lane);
    if (cg < 4) {
        float rr[4];
#pragma unroll
        for (int g = 0; g < 4; ++g) { float ss = 0.f;
#pragma unroll
            for (int nf = 0; nf < 8; ++nf) ss += acc[nf][g] * acc[nf][g];
            ss += __shfl_xor(ss, 1); ss += __shfl_xor(ss, 2); ss += __shfl_xor(ss, 4); ss += __shfl_xor(ss, 8);
            rr[g] = rsqrtf(ss * (1.0f / 128.0f) + 1e-6f); }
#pragma unroll
        for (int nf = 0; nf < 8; ++nf) { const int d = 16 * nf + q; const float gs = kg[d] * qg[d];
#pragma unroll
            for (int g = 0; g < 4; ++g) kmem[(size_t)(r0 + 4 * hi + g) * 512 + cg * 128 + d] = (bf16)f2bf(acc[nf][g] * rr[g] * gs); }
    } else {
        const int h = cg - 4, b = r0 >> 8, key0 = (r0 & 255) + 4 * hi;
#pragma unroll
        for (int nf = 0; nf < 8; ++nf) { const int d = 16 * nf + q; v2u w; w.x = pk2(acc[nf][0], acc[nf][1]); w.y = pk2(acc[nf][2], acc[nf][3]);
            *(v2u*)(vtmem + (size_t)(b * 512 + h * 128 + d) * 256 + key0) = w; }
    }
}

__device__ __forceinline__ void na_item(const bf16* __restrict__ qn, const bf16* __restrict__ kn, const bf16* __restrict__ vt, const LAS float* rpl, bf16* __restrict__ yna,
                                        int b, int r, int jb, int h, int lane) {
    const int q = lane & 15, hi = lane >> 4;
    int rs = r - 4; rs = rs < 0 ? 0 : (rs > 120 ? 120 : rs);
    int kb0 = jb * 16 - 8; kb0 = kb0 < 0 ? 0 : (kb0 > 32 ? 32 : kb0);
    const int qcol = jb * 16 + q; int cs = qcol - 8; cs = cs < 0 ? 0 : (cs > 48 ? 48 : cs);
    const size_t tokq = (size_t)b * SEQ + r * 64 + qcol;
    const bf16* qp = qn + tokq * 512 + h * 64 + 8 * hi;
    const bf16x8 qf0 = *(const bf16x8*)qp, qf1 = *(const bf16x8*)(qp + 32);
    const int kq = 8 * (q >> 2) + (q & 3);
    const bf16* kbase = kn + ((size_t)b * SEQ + rs * 64 + kb0 + kq) * 512 + h * 64 + 8 * hi;
    f32x4 s[16];
    {
        bf16x8 ka[16][2];
#pragma unroll
        for (int f = 0; f < 16; ++f) { const bf16* kp = kbase + (size_t)((f >> 1) * 64 + (f & 1) * 4) * 512; ka[f][0] = *(const bf16x8*)kp; ka[f][1] = *(const bf16x8*)(kp + 32); }
        __builtin_amdgcn_sched_barrier(0);
#pragma unroll
        for (int f = 0; f < 16; ++f) { f32x4 z = (f32x4){0.f, 0.f, 0.f, 0.f}; z = mfma16(ka[f][0], qf0, z); s[f] = mfma16(ka[f][1], qf1, z); }
    }
    const bf16* vbase = vt + ((size_t)(b * 512 + h * 64 + q) * SEQ + rs * 64 + kb0 + 8 * hi);
    bf16x8 va[8][4];
#pragma unroll
    for (int st = 0; st < 8; ++st)
#pragma unroll
        for (int mf = 0; mf < 4; ++mf) va[st][mf] = *(const bf16x8*)(vbase + (size_t)(16 * mf) * SEQ + st * 64);
    __builtin_amdgcn_sched_barrier(0);
    float mx = -3.0e38f;
#pragma unroll
    for (int c4 = 0; c4 < 4; ++c4) {
        float bb[4][4];
#pragma unroll
        for (int ff = 0; ff < 4; ++ff) { const int f = 4 * c4 + ff, dr = rs + (f >> 1) - r + 7;
#pragma unroll
            for (int g = 0; g < 4; ++g) { const int kcol = kb0 + 8 * hi + 4 * (f & 1) + g; int dc = kcol - qcol + 15; dc = dc < 0 ? 0 : (dc > 30 ? 30 : dc); bb[ff][g] = rpl[dr * 31 + dc]; } }
        __builtin_amdgcn_sched_barrier(0);
#pragma unroll
        for (int ff = 0; ff < 4; ++ff) { const int f = 4 * c4 + ff;
#pragma unroll
            for (int g = 0; g < 4; ++g) { const int kcol = kb0 + 8 * hi + 4 * (f & 1) + g; const bool ok = (kcol >= cs) && (kcol < cs + 16);
                const float v = ok ? s[f][g] + bb[ff][g] : -1.0e30f; s[f][g] = v; mx = fmaxf(mx, v); } }
    }
    mx = fmaxf(mx, __shfl_xor(mx, 16)); mx = fmaxf(mx, __shfl_xor(mx, 32));
    float sum = 0.f;
#pragma unroll
    for (int f = 0; f < 16; ++f)
#pragma unroll
        for (int g = 0; g < 4; ++g) { const float p = __expf(s[f][g] - mx); s[f][g] = p; sum += p; }
    sum += __shfl_xor(sum, 16); sum += __shfl_xor(sum, 32);
    const float inv = 1.0f / sum;
    f32x4 o[4];
#pragma unroll
    for (int i = 0; i < 4; ++i) o[i] = (f32x4){0.f, 0.f, 0.f, 0.f};
#pragma unroll
    for (int st = 0; st < 8; ++st) {
        const bf16x8 pb = __builtin_bit_cast(bf16x8, pg8::pack8(s[2 * st], s[2 * st + 1]));
#pragma unroll
        for (int mf = 0; mf < 4; ++mf) o[mf] = mfma16(va[st][mf], pb, o[mf]);
    }
    bf16* yp = yna + tokq * 1536 + h * 64 + 4 * hi;
#pragma unroll
    for (int mf = 0; mf < 4; ++mf) { v2u w; w.x = pk2(o[mf][0] * inv, o[mf][1] * inv); w.y = pk2(o[mf][2] * inv, o[mf][3] * inv); *(v2u*)(yp + 16 * mf) = w; }
}
__device__ __forceinline__ void xa_fill_lds(const bf16* __restrict__ kmem, const bf16* __restrict__ vtmem, LAS unsigned char* lds, int b, int h, int tid) {
#pragma unroll
    for (int ps = 0; ps < 8; ++ps) { const int id = tid + 512 * ps, key = id >> 4, c = id & 15;
        *(LAS v4u*)(lds + key * 256 + ((c ^ (key & 15)) << 4)) = *(const v4u*)(kmem + ((size_t)b * 256 + key) * 512 + h * 128 + 8 * c); }
#pragma unroll
    for (int ps = 0; ps < 8; ++ps) { const int id = tid + 512 * ps, dim = id >> 5, c = id & 31;
        *(LAS v4u*)(lds + 65536 + dim * 512 + ((c ^ (dim & 15)) << 4)) = *(const v4u*)(vtmem + (size_t)(b * 512 + h * 128 + dim) * 256 + 8 * c); }
}
__device__ __forceinline__ void xa_item(const bf16* __restrict__ xq, const LAS unsigned char* lds, bf16* __restrict__ yxa, int tok0, int h, int lane) {
    const int q = lane & 15, hi = lane >> 4; const size_t tok = (size_t)tok0 + q;
    const bf16* qp = xq + tok * 512 + h * 128 + 8 * hi;
    bf16x8 qf[4]; float ssq = 0.f;
#pragma unroll
    for (int ks = 0; ks < 4; ++ks) qf[ks] = *(const bf16x8*)(qp + 32 * ks);
    __builtin_amdgcn_sched_barrier(0);
#pragma unroll
    for (int ks = 0; ks < 4; ++ks)
#pragma unroll
        for (int j = 0; j < 8; ++j) { const float v = bf1(qf[ks][j]); ssq += v * v; }
    ssq += __shfl_xor(ssq, 16); ssq += __shfl_xor(ssq, 32);
    const float cexp = rsqrtf(ssq * (1.0f / 128.0f) + 1e-6f) * 0.08838834764831845f * 1.4426950408889634f;
    const int kq = 8 * (q >> 2) + (q & 3);
    f32x4 s[16];
#define XA_KLOAD(buf, fp) do { _Pragma("unroll") for (int f2 = 0; f2 < 2; ++f2) { const int f_ = 2 * (fp) + f2, key = 32 * (f_ >> 1) + 4 * (f_ & 1) + kq; const LAS unsigned char* kr = lds + key * 256; \
        _Pragma("unroll") for (int ks = 0; ks < 4; ++ks) buf[f2][ks] = *(const LAS bf16x8*)(kr + (((4 * ks + hi) ^ (key & 15)) << 4)); } } while (0)
    {
        bf16x8 kbA[2][4], kbB[2][4];
        XA_KLOAD(kbA, 0);
#pragma unroll
        for (int fp = 0; fp < 8; fp += 2) {
            XA_KLOAD(kbB, fp + 1); __builtin_amdgcn_sched_barrier(0);
#pragma unroll
            for (int f2 = 0; f2 < 2; ++f2) { f32x4 z = (f32x4){0.f, 0.f, 0.f, 0.f};
#pragma unroll
                for (int ks = 0; ks < 4; ++ks) z = mfma16(kbA[f2][ks], qf[ks], z);
                s[2 * fp + f2] = z; }
            __builtin_amdgcn_sched_barrier(0);
            if (fp + 2 < 8) XA_KLOAD(kbA, fp + 2);
            __builtin_amdgcn_sched_barrier(0);
#pragma unroll
            for (int f2 = 0; f2 < 2; ++f2) { f32x4 z = (f32x4){0.f, 0.f, 0.f, 0.f};
#pragma unroll
                for (int ks = 0; ks < 4; ++ks) z = mfma16(kbB[f2][ks], qf[ks], z);
                s[2 * (fp + 1) + f2] = z; }
            __builtin_amdgcn_sched_barrier(0);
        }
    }
#undef XA_KLOAD
    float mx = -3.0e38f;
#pragma unroll
    for (int f = 0; f < 16; ++f)
#pragma unroll
        for (int g = 0; g < 4; ++g) mx = fmaxf(mx, s[f][g]);
    mx = fmaxf(mx, __shfl_xor(mx, 16)); mx = fmaxf(mx, __shfl_xor(mx, 32));
    float sum = 0.f;
#pragma unroll
    for (int f = 0; f < 16; ++f)
#pragma unroll
        for (int g = 0; g < 4; ++g) { const float p = __builtin_amdgcn_exp2f((s[f][g] - mx) * cexp); s[f][g] = p; sum += p; }
    sum += __shfl_xor(sum, 16); sum += __shfl_xor(sum, 32);
    const float inv = 1.0f / sum;
    f32x4 o[8];
#pragma unroll
    for (int i = 0; i < 8; ++i) o[i] = (f32x4){0.f, 0.f, 0.f, 0.f};
#define XA_VLOAD(buf, st_) do { _Pragma("unroll") for (int mf = 0; mf < 8; ++mf) { const int dim = 16 * mf + q; buf[mf] = *(const LAS bf16x8*)(lds + 65536 + dim * 512 + (((4 * (st_) + hi) ^ (dim & 15)) << 4)); } } while (0)
    {
        bf16x8 vbA[8], vbB[8];
        XA_VLOAD(vbA, 0);
#pragma unroll
        for (int st = 0; st < 8; st += 2) {
            XA_VLOAD(vbB, st + 1); __builtin_amdgcn_sched_barrier(0);
            { const bf16x8 pb = __builtin_bit_cast(bf16x8, pg8::pack8(s[2 * st], s[2 * st + 1]));
#pragma unroll
              for (int mf = 0; mf < 8; ++mf) o[mf] = mfma16(vbA[mf], pb, o[mf]); }
            __builtin_amdgcn_sched_barrier(0);
            if (st + 2 < 8) XA_VLOAD(vbA, st + 2);
            __builtin_amdgcn_sched_barrier(0);
            { const bf16x8 pb = __builtin_bit_cast(bf16x8, pg8::pack8(s[2 * st + 2], s[2 * st + 3]));
#pragma unroll
              for (int mf = 0; mf < 8; ++mf) o[mf] = mfma16(vbB[mf], pb, o[mf]); }
            __builtin_amdgcn_sched_barrier(0);
        }
    }
#undef XA_VLOAD
    bf16* yp = yxa + tok * 1536 + h * 128 + 4 * hi;
#pragma unroll
    for (int mf = 0; mf < 8; ++mf) { v2u w; w.x = pk2(o[mf][0] * inv, o[mf][1] * inv); w.y = pk2(o[mf][2] * inv, o[mf][3] * inv); *(v2u*)(yp + 16 * mf) = w; }
}
__device__ __forceinline__ void pool_wg(const bf16* __restrict__ pp, const bf16* __restrict__ pwT, bf16* __restrict__ ypool, LAS unsigned char* lds, int tokbase, int wave, int lane) {
    const int q = lane & 15, hi = lane >> 4;
    __syncthreads();
    {
        const int hw = 1 << hi, tw0 = tokbase + 16 * wave, b = tw0 >> 13, t0 = tw0 & 8191;
        const bf16* base = pp + (size_t)b * SEQ * 512 + 8 * lane;
        float s[8];
#pragma unroll
        for (int j = 0; j < 8; ++j) s[j] = 0.f;
#pragma unroll 4
        for (int d = -8; d < 8; ++d) { const int u = t0 + d; const bool ok = (d >= -hw) && (d < hw) && (u >= 0) && (u < SEQ);
            const bf16x8 v = *(const bf16x8*)(base + (size_t)(ok ? u : t0) * 512);
#pragma unroll
            for (int j = 0; j < 8; ++j) s[j] += ok ? bf1(v[j]) : 0.f; }
        LAS unsigned char* tile = lds + wave * 16384;
#pragma unroll 4
        for (int i = 0; i < 16; ++i) { const int t = t0 + i;
            int lo = t - hw; lo = lo < 0 ? 0 : lo; int ht = t + hw; ht = ht > SEQ ? SEQ : ht;
            const float inv = 1.0f / (float)(ht - lo);
            const bool oka = (t + hw) < SEQ, oks = (t - hw) >= 0;
            const bf16x8 sv = *(const bf16x8*)(base + (size_t)t * 512), av = *(const bf16x8*)(base + (size_t)(oka ? t + hw : t) * 512), bv = *(const bf16x8*)(base + (size_t)(oks ? t - hw : t) * 512);
            f32x4 p0, p1;
#pragma unroll
            for (int j = 0; j < 4; ++j) { p0[j] = s[j] * inv - bf1(sv[j]); p1[j] = s[j + 4] * inv - bf1(sv[j + 4]); }
            *(LAS v4u*)(tile + i * 1024 + ((lane ^ (i & 15)) << 4)) = pg8::pack8(p0, p1);
#pragma unroll
            for (int j = 0; j < 8; ++j) s[j] += (oka ? bf1(av[j]) : 0.f) - (oks ? bf1(bv[j]) : 0.f);
        }
    }
    __syncthreads();
#pragma unroll 1
    for (int k = 0; k < 4; ++k) {
        const int pair = wave * 4 + k, g = pair >> 3, mf = pair & 7;
        const bf16* wb = pwT + (size_t)(g * 128 + 16 * mf + q) * 128 + 8 * hi;
        bf16x8 a[4];
#pragma unroll
        for (int ks = 0; ks < 4; ++ks) a[ks] = *(const bf16x8*)(wb + 32 * ks);
#pragma unroll 2
        for (int tg = 0; tg < 8; ++tg) {
            const LAS unsigned char* trow = lds + tg * 16384 + q * 1024; f32x4 o = (f32x4){0.f, 0.f, 0.f, 0.f};
#pragma unroll
            for (int ks = 0; ks < 4; ++ks) { const int c = g * 16 + 4 * ks + hi; o = mfma16(a[ks], *(const LAS bf16x8*)(trow + ((c ^ q) << 4)), o); }
            v2u w; w.x = pk2(o[0], o[1]); w.y = pk2(o[2], o[3]);
            *(v2u*)(ypool + (size_t)(tokbase + 16 * tg + q) * 1536 + g * 128 + 16 * mf + 4 * hi) = w;
        }
    }
    __syncthreads();
}

__device__ __forceinline__ int f2key(float s, int idx, int mask) { int b = __builtin_bit_cast(int, s); b = b >= 0 ? b : (b ^ 0x7fffffff); return (b & ~mask) | idx; }
__device__ __forceinline__ float key2f(int k) { k = k >= 0 ? k : (k ^ 0x7fffffff); return __builtin_bit_cast(float, k); }
#define CE_DESC(x, y) do { const int _h = (x) > (y) ? (x) : (y), _l = (x) > (y) ? (y) : (x); (x) = _h; (y) = _l; } while (0)
__device__ __forceinline__ void sort16(int (&a)[16]) {
#pragma unroll
    for (int ks = 1; ks <= 4; ++ks)
#pragma unroll
        for (int js = ks - 1; js >= 0; --js)
#pragma unroll
            for (int i = 0; i < 16; ++i) { const int k = 1 << ks, j = 1 << js, l = i ^ j;
                if (l > i) { if ((i & k) == 0) CE_DESC(a[i], a[l]); else CE_DESC(a[l], a[i]); } }
}
__device__ __forceinline__ void merge16(int (&a)[16], const int (&b)[16]) {
#pragma unroll
    for (int i = 0; i < 16; ++i) a[i] = a[i] > b[15 - i] ? a[i] : b[15 - i];
#pragma unroll
    for (int js = 3; js >= 0; --js)
#pragma unroll
        for (int i = 0; i < 16; ++i) { const int j = 1 << js, l = i ^ j; if (l > i) CE_DESC(a[i], a[l]); }
}
__device__ __forceinline__ void merge16_lanes(int (&a)[16], int step) { int o[16];
#pragma unroll
    for (int k = 0; k < 16; ++k) o[k] = __shfl_xor(a[k], step);
    merge16(a, o); }
__device__ constexpr int cand_i(int hi, int m) {
    return hi == 0 ? 0
         : hi == 1 ? (m < 8 ? 1 : (m < 13 ? 2 : -1))
         : hi == 2 ? (m < 4 ? 3 : (m < 7 ? 4 : (m < 9 ? 5 : (m < 11 ? 6 : -1))))
         :           (m < 2 ? 7 : (m < 10 ? 8 + (m - 2) : -1));
}
__device__ constexpr int cand_j(int hi, int m) {
    return hi == 0 ? m
         : hi == 1 ? (m < 8 ? m : (m < 13 ? m - 8 : -1))
         : hi == 2 ? (m < 4 ? m : (m < 7 ? m - 4 : (m < 9 ? m - 7 : (m < 11 ? m - 9 : -1))))
         :           (m < 2 ? m : (m < 10 ? 0 : -1));
}
__device__ __forceinline__ void topk_fill_lds(const bf16* __restrict__ keys, LAS unsigned char* lds, int h, int tid) {
#pragma unroll
    for (int ps = 0; ps < 8; ++ps) { const int id = tid + 512 * ps, row = id >> 4, c = id & 15;
        *(LAS v4u*)(lds + row * 256 + ((c ^ (row & 15)) << 4)) = *(const v4u*)(keys + ((size_t)h * 256 + row) * 128 + 8 * c); }
}
struct TopkQ { bf16x8 q[2][4]; };
__device__ __forceinline__ void topk_loadq(TopkQ& Q, const bf16* __restrict__ qb, int tok0, int h, int lane) {
    const size_t tok = (size_t)tok0 + (lane & 15); const int hi = lane >> 4;
#pragma unroll
    for (int p = 0; p < 2; ++p)
#pragma unroll
        for (int ks = 0; ks < 4; ++ks) Q.q[p][ks] = *(const bf16x8*)(qb + tok * 2048 + h * 256 + p * 128 + 32 * ks + 8 * hi);
}
__device__ __forceinline__ void topk_item(const TopkQ& Q, const LAS unsigned char* klds, int* __restrict__ te, float* __restrict__ tw, LAS int* lscr, int tok0, int h, int lane) {
    const int q = lane & 15, hi = lane >> 4; const size_t tok = (size_t)tok0 + q;
    int L[2][16];
#pragma unroll
    for (int p = 0; p < 2; ++p) {
        int B[16];
#define TK_KLOAD(buf, mp) do { _Pragma("unroll") for (int m2 = 0; m2 < 2; ++m2) { const int row = p * 128 + 16 * (2 * (mp) + m2) + q; \
        _Pragma("unroll") for (int ks = 0; ks < 4; ++ks) buf[m2][ks] = *(const LAS bf16x8*)(klds + row * 256 + (((4 * ks + hi) ^ (row & 15)) << 4)); } } while (0)
#define TK_MMA(buf, mp) do { _Pragma("unroll") for (int m2 = 0; m2 < 2; ++m2) { const int mf = 2 * (mp) + m2; f32x4 s = (f32x4){0.f, 0.f, 0.f, 0.f}; \
        _Pragma("unroll") for (int ks = 0; ks < 4; ++ks) s = mfma16(buf[m2][ks], Q.q[p][ks], s); \
          \
        _Pragma("unroll") for (int g = 0; g < 4; ++g) { const int key = f2key(s[g], 16 * mf + 4 * hi + g, 127); if (mf < 4) L[p][4 * mf + g] = key; else B[4 * (mf - 4) + g] = key; } } } while (0)
        { bf16x8 tkA[2][4], tkB[2][4];
          TK_KLOAD(tkA, 0);
          TK_KLOAD(tkB, 1); __builtin_amdgcn_sched_barrier(0); TK_MMA(tkA, 0); __builtin_amdgcn_sched_barrier(0);
          TK_KLOAD(tkA, 2); __builtin_amdgcn_sched_barrier(0); TK_MMA(tkB, 1); __builtin_amdgcn_sched_barrier(0);
          TK_KLOAD(tkB, 3); __builtin_amdgcn_sched_barrier(0); TK_MMA(tkA, 2); __builtin_amdgcn_sched_barrier(0);
          TK_MMA(tkB, 3); }
#undef TK_KLOAD
#undef TK_MMA
        sort16(L[p]); sort16(B); merge16(L[p], B);
        merge16_lanes(L[p], 16); merge16_lanes(L[p], 32);
    }
    float v1[16], v2[16];
#pragma unroll
    for (int k = 0; k < 16; ++k) { v1[k] = key2f(L[0][k]); v2[k] = key2f(L[1][k]); }
    int Fk[16];
#pragma unroll
    for (int m = 0; m < 16; ++m) {
        float sm = v1[0] + v2[m]; int id = 255 - m;
        if (cand_i(1, m) >= 0) { if (hi == 1) { sm = v1[cand_i(1, m) < 0 ? 0 : cand_i(1, m)] + v2[cand_j(1, m) < 0 ? 0 : cand_j(1, m)]; id = 255 - ((cand_i(1, m) << 4) | cand_j(1, m)); } }
        if (cand_i(2, m) >= 0) { if (hi == 2) { sm = v1[cand_i(2, m) < 0 ? 0 : cand_i(2, m)] + v2[cand_j(2, m) < 0 ? 0 : cand_j(2, m)]; id = 255 - ((cand_i(2, m) << 4) | cand_j(2, m)); } }
        if (cand_i(3, m) >= 0) { if (hi == 3) { sm = v1[cand_i(3, m) < 0 ? 0 : cand_i(3, m)] + v2[cand_j(3, m) < 0 ? 0 : cand_j(3, m)]; id = 255 - ((cand_i(3, m) << 4) | cand_j(3, m)); } }
        int key = f2key(sm, id, 255);
        if ((hi == 1 && cand_i(1, m) < 0) || (hi == 2 && cand_i(2, m) < 0) || (hi == 3 && cand_i(3, m) < 0)) key = (int)0x80000000;
        Fk[m] = key;
    }
    sort16(Fk); merge16_lanes(Fk, 16); merge16_lanes(Fk, 32);
    LAS int* my = lscr + lane * 32;
#pragma unroll
    for (int k = 0; k < 16; ++k) { my[k] = L[0][k] & 127; my[16 + k] = L[1][k] & 127; }
    LDS_WAIT(); asm volatile("" ::: "memory");
    float e[16]; float sum = 0.f; const float mx = key2f(Fk[0]);
#pragma unroll
    for (int k = 0; k < 16; ++k) { e[k] = __expf(key2f(Fk[k]) - mx); sum += e[k]; }
    const float inv = 1.0f / sum;
    if (hi == 0) {
        int* tep = te + tok * 128; float* twp = tw + tok * 128;
#pragma unroll
        for (int kk = 0; kk < 16; ++kk) { const int ij = 255 - (Fk[kk] & 255), i = ij >> 4, j = ij & 15, slot = (kk & 7) * 16 + 2 * h + (kk >> 3);
            tep[slot] = my[i] * 128 + my[16 + j]; twp[slot] = e[kk] * inv; }
    }
    LDS_WAIT(); asm volatile("" ::: "memory");
}

__device__ __forceinline__ float ub2f(unsigned v, int b) { return (float)((v >> (8 * b)) & 0xffu); }
struct HqIn { v4u hA, hB; float rsq; };
__device__ __forceinline__ void hq_load(HqIn& in, const bf16* __restrict__ hb, const float* __restrict__ rowsq, int tok, int lane) {
    const bf16* hp = hb + (size_t)tok * 1024 + 16 * lane; in.hA = *(const v4u*)hp; in.hB = *(const v4u*)(hp + 8); in.rsq = rowsq[tok]; }
__device__ __forceinline__ void hq_token(const HqIn& in, unsigned char* __restrict__ hq, float* __restrict__ hs, int tok, int lane) {
    const v4u hA = in.hA, hB = in.hB;
    float hf[16];
#pragma unroll
    for (int d = 0; d < 4; ++d) { hf[2 * d] = bflo(hA[d]); hf[2 * d + 1] = bfhi(hA[d]); hf[8 + 2 * d] = bflo(hB[d]); hf[8 + 2 * d + 1] = bfhi(hB[d]); }
    float amax = 0.f;
#pragma unroll
    for (int j = 0; j < 16; ++j) amax = fmaxf(amax, fabsf(hf[j]));
#pragma unroll
    for (int o = 1; o < 64; o <<= 1) amax = fmaxf(amax, __shfl_xor(amax, o));
    const float hinv = amax > 0.f ? 127.0f / amax : 0.f;
    v4u w;
#pragma unroll
    for (int d = 0; d < 4; ++d) { const unsigned b0 = (unsigned)(int)rintf(hf[4 * d] * hinv) & 0xffu, b1 = (unsigned)(int)rintf(hf[4 * d + 1] * hinv) & 0xffu,
                                                 b2 = (unsigned)(int)rintf(hf[4 * d + 2] * hinv) & 0xffu, b3 = (unsigned)(int)rintf(hf[4 * d + 3] * hinv) & 0xffu;
        w[d] = b0 | (b1 << 8) | (b2 << 16) | (b3 << 24); }
    *(v4u*)(hq + (size_t)tok * 1024 + 16 * lane) = w;
    if (lane == 0) hs[tok] = rsqrtf(in.rsq * (1.0f / 1024.0f) + 1e-6f) * amax * (1.0f / 127.0f);
}
constexpr int PA_SLOTS = 12;
struct PeerA1 { int e; float g; float su, sv; int cnt, rk; };
struct PeerA2 { v4u ur[3][4]; };
struct PeerAH { v4u hv[4]; float hsc; };
__device__ __forceinline__ void pa_s1(PeerA1& a, const int* __restrict__ te, const float* __restrict__ tw, int tok, int half, int lane) {
    const unsigned o = ((unsigned)tok * 128u + 64u * (unsigned)half + (unsigned)lane) * 4u; a.e = *(const int*)((const unsigned char*)te + o); a.g = *(const float*)((const unsigned char*)tw + o); }
__device__ __forceinline__ void pa_s1h(PeerAH& h, const unsigned char* __restrict__ hq, const float* __restrict__ hs, int tok, int lane) {
    const int t = lane & 15;
#pragma unroll
    for (int i = 0; i < 4; ++i) h.hv[i] = *(const v4u*)(hq + ((unsigned)tok * 1024u + 16u * (unsigned)t + 256u * i));
    h.hsc = *(const float*)((const unsigned char*)hs + ((unsigned)tok * 4u + __builtin_amdgcn_mbcnt_lo(0u, 0u))); }
template <int MODE> __device__ __forceinline__ void pa_front(unsigned (&off)[3], PeerA1& a, const float* __restrict__ su, LAS int* lst, int x, int lane) {
    const bool m = (a.e >> 11) == x;
    const unsigned long long mask = __ballot(m);
    a.cnt = __popcll(mask); a.rk = (int)__builtin_amdgcn_mbcnt_hi((unsigned)(mask >> 32), __builtin_amdgcn_mbcnt_lo((unsigned)mask, 0u));
    if (m && a.rk < PA_SLOTS) lst[a.rk] = a.e;
    { typedef float f32x2s __attribute__((ext_vector_type(2))); const f32x2s s2 = *(const f32x2s*)((const unsigned char*)su + (m ? (unsigned)a.e * 8u : 0u)); a.su = s2.x; a.sv = s2.y; }
    const int r = lane >> 4, t = lane & 15;
    LDS_WAIT(); asm volatile("" ::: "memory");
    const int lim = a.cnt < PA_SLOTS ? a.cnt : PA_SLOTS;
    int es[3];
#pragma unroll
    for (int q = 0; q < 3; ++q) es[q] = lst[4 * q + r];
#pragma unroll
    for (int q = 0; q < 3; ++q) { int e = es[q]; if (MODE & 1) e = (x << 11) | (e & 7); off[q] = (4 * q + r) < lim ? (unsigned)e * 1024u + 16u * (unsigned)t : 0x40000000u; }
}
template <int MODE> __device__ __forceinline__ void pa_gather(PeerA2& b, int q, const unsigned (&off)[3], const __amdgpu_buffer_rsrc_t rs) {
#pragma unroll
    for (int i = 0; i < 4; ++i) { if (MODE & 2) b.ur[q][i] = (v4u){off[q], off[q] + 1u, off[q] + 2u, off[q] + 3u}; else b.ur[q][i] = __builtin_bit_cast(v4u, __builtin_amdgcn_raw_buffer_load_b128(rs, (int)(off[q] + 256u * i), 0, 0)); }
}
__device__ __forceinline__ int dot16(const v4u u, const v4u h) { int d = __builtin_amdgcn_sdot4((int)u.x, (int)h.x, 0, false); d = __builtin_amdgcn_sdot4((int)u.y, (int)h.y, d, false);
    d = __builtin_amdgcn_sdot4((int)u.z, (int)h.z, d, false); return __builtin_amdgcn_sdot4((int)u.w, (int)h.w, d, false); }
template <int CTRL, int RM> __device__ __forceinline__ int dpp_i(int x) { return __builtin_amdgcn_update_dpp(0, x, CTRL, RM, 0xf, false); }
__device__ __forceinline__ int wave_sum_to63(int x) { x += dpp_i<0xb1, 0xf>(x); x += dpp_i<0x4e, 0xf>(x); x += dpp_i<0x124, 0xf>(x); x += dpp_i<0x128, 0xf>(x); x += dpp_i<0x142, 0xa>(x); x += dpp_i<0x143, 0xc>(x); return x; }
__device__ __forceinline__ int row_sum16(int x) { x += dpp_i<0xb1, 0xf>(x); x += dpp_i<0x4e, 0xf>(x); x += dpp_i<0x124, 0xf>(x); x += dpp_i<0x128, 0xf>(x); return x; }
__device__ __forceinline__ float gelu_erf(float v) {
    const float av = fabsf(v), t = __builtin_amdgcn_rcpf(av * 0.2316418882f + 1.0f);
    float q = t * 0.5307027145f + (-0.7265760135f); q = q * t + 0.7107068705f; q = q * t + (-0.142248368f); q = q * t + 0.127414796f; q = q * t;
    const float e = __builtin_amdgcn_exp2f((v * v) * (-0.72134752044f)), m = v * (q * e);
    return v < 0.f ? m : v - m; }
template <int MODE> __device__ __forceinline__ void pa_s3(PeerA2& b, const unsigned (&off2)[3], const __amdgpu_buffer_rsrc_t rs, const PeerA1& a, const PeerAH& h, const unsigned char* __restrict__ u8, const unsigned char* __restrict__ hq, float* __restrict__ aw, int tok, int half, int x, int lane) {
    int mine = 0;
    if (MODE & 8) { mine = (int)(b.ur[0][0].x ^ b.ur[1][1].y ^ b.ur[2][2].z ^ h.hv[0].x);
#pragma unroll
        for (int q = 0; q < 3; ++q) pa_gather<MODE>(b, q, off2, rs); } else
    {
        int d[3];
#pragma unroll
        for (int q = 0; q < 3; ++q) { d[q] = dot16(b.ur[q][0], h.hv[0]); d[q] += dot16(b.ur[q][1], h.hv[1]); d[q] += dot16(b.ur[q][2], h.hv[2]); d[q] += dot16(b.ur[q][3], h.hv[3]);
            pa_gather<MODE>(b, q, off2, rs); }
#pragma unroll
        for (int q = 0; q < 3; ++q) d[q] += dpp_i<0xb1, 0xf>(d[q]);
#pragma unroll
        for (int q = 0; q < 3; ++q) d[q] += dpp_i<0x4e, 0xf>(d[q]);
#pragma unroll
        for (int q = 0; q < 3; ++q) d[q] += dpp_i<0x124, 0xf>(d[q]);
#pragma unroll
        for (int q = 0; q < 3; ++q) d[q] += dpp_i<0x128, 0xf>(d[q]);
        const int src = 64 * (a.rk & 3);
#pragma unroll
        for (int q = 0; q < 3; ++q) { const int v = __builtin_amdgcn_ds_bpermute(src, d[q]); mine = ((a.rk >> 2) == q) ? v : mine; }
    }
    float* awp = (float*)((unsigned char*)aw + ((unsigned)tok * 128u + 64u * (unsigned)half + (unsigned)lane) * 4u);
    const bool am = (a.e >> 11) == x;
    if (am && a.rk < PA_SLOTS) *awp = a.g * gelu_erf((float)mine * h.hsc * a.su) * a.sv;
    if (__builtin_expect(a.cnt > PA_SLOTS, 0)) {
        unsigned long long rem = __ballot(am);
#pragma unroll
        for (int k = 0; k < PA_SLOTS; ++k) rem &= rem - 1ull;
        const v4u hw = *(const v4u*)(hq + (size_t)tok * 1024 + 16 * lane);
        while (rem != 0ull) { const int idx = __builtin_ctzll(rem); rem &= rem - 1ull; const int e = __builtin_amdgcn_readlane(a.e, idx);
            const int d = __builtin_amdgcn_readlane(wave_sum_to63(dot16(*(const v4u*)(u8 + (size_t)e * 1024 + 16 * lane), hw)), 63);
            if (lane == idx) *awp = a.g * gelu_erf((float)d * h.hsc * a.su) * a.sv; }
    }
}
template <int MODE> __device__ __forceinline__ void peer_a_run(const unsigned char* __restrict__ hq, const float* __restrict__ hs, const unsigned char* __restrict__ u8, const float* __restrict__ su,
                                           const float* __restrict__ sv, const int* __restrict__ te, const float* __restrict__ tw, float* __restrict__ aw, LAS int* lst, int wrank, int wstep, int x, int lane) {
    const int ntok = wrank < T ? (T - wrank + wstep - 1) / wstep : 0, N = 2 * ntok; (void)sv;
    if (N == 0) return;
    const int tlast = wrank + (ntok - 1) * wstep;
#define PA_TOK(n) ((MODE & 4) ? wrank : min(wrank + ((n) >> 1) * wstep, tlast))
    PeerA1 a0, a1, a2, a3; PeerA2 bA, bB; PeerAH h0, h1; unsigned off[3];
    const __amdgpu_buffer_rsrc_t rs = __builtin_amdgcn_make_buffer_rsrc((void*)u8, (short)0, (int)(16u << 20), 0x00020000);
    pa_s1(a0, te, tw, PA_TOK(0), 0, lane); pa_s1(a1, te, tw, PA_TOK(1), 1, lane); pa_s1h(h0, hq, hs, PA_TOK(0), lane);
    pa_s1(a2, te, tw, PA_TOK(2), 0, lane); pa_s1(a3, te, tw, PA_TOK(3), 1, lane); pa_s1h(h1, hq, hs, PA_TOK(2), lane);
    pa_front<MODE>(off, a0, su, lst, x, lane);
#pragma unroll
    for (int q = 0; q < 3; ++q) pa_gather<MODE>(bA, q, off, rs);
    pa_front<MODE>(off, a1, su, lst, x, lane);
#pragma unroll
    for (int q = 0; q < 3; ++q) pa_gather<MODE>(bB, q, off, rs);
#define PA_STEP(n, Bcur, Acur, Anext2, Hcur, LOADH) do { \
        pa_front<MODE>(off, Anext2, su, lst, x, lane); \
        pa_s3<MODE>(Bcur, off, rs, Acur, Hcur, u8, hq, aw, PA_TOK(n), (n) & 1, x, lane); \
        pa_s1(Acur, te, tw, PA_TOK((n) + 4), (n) & 1, lane); \
        if (LOADH) pa_s1h(Hcur, hq, hs, PA_TOK((n) + 3), lane); } while (0)
    for (int n = 0; n < N; n += 4) {
        PA_STEP(n, bA, a0, a2, h0, 0);
        PA_STEP(n + 1, bB, a1, a3, h0, 1);
        PA_STEP(n + 2, bA, a2, a0, h1, 0);
        PA_STEP(n + 3, bB, a3, a1, h1, 1);
    }
#undef PA_STEP
#undef PA_TOK
}
struct PeerB1 { v4u e[4]; f32x4 w[4]; unsigned h2; };
struct PeerB2 { v4u vr[8]; };
struct PeerBAcc { int acc[16]; int wq[4]; float wsc, h0, h1; };
typedef float f32x2v __attribute__((ext_vector_type(2)));
__device__ __forceinline__ void pb_s1(PeerB1& a, const int* __restrict__ te, const float* __restrict__ aw, int tok, int lane) {
    const unsigned o_ = (unsigned)tok * 128u + 16u * ((unsigned)lane >> 3);
    const v4u* ep = (const v4u*)(te + o_); const f32x4* wp = (const f32x4*)(aw + o_);
#pragma unroll
    for (int j = 0; j < 4; ++j) { a.e[j] = ep[j]; a.w[j] = wp[j]; } }
__device__ __forceinline__ int pb_col(int lane) { return 16 * (lane & 7) + 8 * ((lane >> 5) & 1) + 4 * ((lane >> 4) & 1) + 2 * ((lane >> 3) & 1); }
template <int CTRL, int RM> __device__ __forceinline__ float dpp_f(float x) { return __builtin_bit_cast(float, __builtin_amdgcn_update_dpp(0, __builtin_bit_cast(int, x), CTRL, RM, 0xf, false)); }
__device__ __forceinline__ void pb_quant(PeerBAcc& A, const PeerB1& a) {
    float mx = 0.f;
#pragma unroll
    for (int j = 0; j < 4; ++j) mx = fmaxf(mx, fmaxf(fmaxf(fabsf(a.w[j][0]), fabsf(a.w[j][1])), fmaxf(fabsf(a.w[j][2]), fabsf(a.w[j][3]))));
    mx = fmaxf(mx, dpp_f<0xb1, 0xf>(mx)); mx = fmaxf(mx, dpp_f<0x4e, 0xf>(mx)); mx = fmaxf(mx, dpp_f<0x124, 0xf>(mx)); mx = fmaxf(mx, dpp_f<0x128, 0xf>(mx));
    mx = fmaxf(mx, dpp_f<0x142, 0xa>(mx)); mx = fmaxf(mx, dpp_f<0x143, 0xc>(mx));
    mx = __builtin_bit_cast(float, __builtin_amdgcn_readlane(__builtin_bit_cast(int, mx), 63));
    const float inv = mx > 0.f ? 127.0f / mx : 0.f; A.wsc = mx * (1.0f / 127.0f);
#pragma unroll
    for (int j = 0; j < 4; ++j) A.wq[j] = (int)(((unsigned)(int)rintf(a.w[j][0] * inv) & 0xffu) | (((unsigned)(int)rintf(a.w[j][1] * inv) & 0xffu) << 8) |
                                               (((unsigned)(int)rintf(a.w[j][2] * inv) & 0xffu) << 16) | (((unsigned)(int)rintf(a.w[j][3] * inv) & 0xffu) << 24));
}
template <int HF, int MODE> __device__ __forceinline__ void pb_s2(PeerB2& b, const PeerB1& a, const unsigned char* __restrict__ v8x, int lane) {
    const int c = lane & 7;
#pragma unroll
    for (int m = 0; m < 8; ++m) { unsigned e = a.e[2 * HF + (m >> 2)][m & 3]; if (MODE & 1) e &= 255u;
        if (MODE & 2) b.vr[m] = (v4u){e, e + 1u, e + 2u, e + 3u}; else b.vr[m] = *(const v4u*)(v8x + (e * 128u + 16u * (unsigned)c)); }
}
__device__ __forceinline__ float swap32_add(float lo, float hi) { const auto r = __builtin_amdgcn_permlane32_swap(__builtin_bit_cast(unsigned, lo), __builtin_bit_cast(unsigned, hi), false, false);
    return __builtin_bit_cast(float, r[0]) + __builtin_bit_cast(float, r[1]); }
__device__ __forceinline__ float swap16_add(float lo, float hi) { const auto r = __builtin_amdgcn_permlane16_swap(__builtin_bit_cast(unsigned, lo), __builtin_bit_cast(unsigned, hi), false, false);
    return __builtin_bit_cast(float, r[0]) + __builtin_bit_cast(float, r[1]); }
template <int HF, int MODE> __device__ __forceinline__ void pb_s3(PeerBAcc& A, const PeerB2& b, const PeerB1& a, float* out, int tok, int x, int lane) {
    if (MODE & 8) { if (HF == 0) { A.acc[0] = 0; }
#pragma unroll
        for (int m = 0; m < 8; ++m) A.acc[0] += (int)(b.vr[m].x ^ b.vr[m].y ^ b.vr[m].z ^ b.vr[m].w);
        if (HF == 1) { f32x2v h2; h2.x = A.h0 + (float)A.acc[0]; h2.y = A.h1 + A.wsc; *(f32x2v*)(out + ((unsigned)tok * 1024u + 128u * (unsigned)x + (unsigned)pb_col(lane))) = h2; }
        return; }
    if (HF == 0) {
#pragma unroll
        for (int j = 0; j < 16; ++j) A.acc[j] = 0;
    }
#pragma unroll
    for (int gg = 0; gg < 2; ++gg)
#pragma unroll
        for (int d = 0; d < 4; ++d) { const unsigned ra = b.vr[4 * gg][d], rb = b.vr[4 * gg + 1][d], rc = b.vr[4 * gg + 2][d], rd = b.vr[4 * gg + 3][d];
            const unsigned t0 = __builtin_amdgcn_perm(rb, ra, 0x05010400u), t1 = __builtin_amdgcn_perm(rb, ra, 0x07030602u), t2 = __builtin_amdgcn_perm(rd, rc, 0x05010400u), t3 = __builtin_amdgcn_perm(rd, rc, 0x07030602u);
            const unsigned c0 = __builtin_amdgcn_perm(t2, t0, 0x05040100u), c1 = __builtin_amdgcn_perm(t2, t0, 0x07060302u), c2 = __builtin_amdgcn_perm(t3, t1, 0x05040100u), c3 = __builtin_amdgcn_perm(t3, t1, 0x07060302u);
            const int w4 = A.wq[2 * HF + gg];
            A.acc[4 * d] = __builtin_amdgcn_sdot4((int)c0, w4, A.acc[4 * d], false); A.acc[4 * d + 1] = __builtin_amdgcn_sdot4((int)c1, w4, A.acc[4 * d + 1], false);
            A.acc[4 * d + 2] = __builtin_amdgcn_sdot4((int)c2, w4, A.acc[4 * d + 2], false); A.acc[4 * d + 3] = __builtin_amdgcn_sdot4((int)c3, w4, A.acc[4 * d + 3], false); }
    if (HF == 1) {
        int r8[8], r4[4], r2[2];
#pragma unroll
        for (int j = 0; j < 8; ++j) { const bool up = (lane & 32) != 0; const int keep = up ? A.acc[j + 8] : A.acc[j], send = up ? A.acc[j] : A.acc[j + 8]; r8[j] = keep + __shfl_xor(send, 32); }
#pragma unroll
        for (int j = 0; j < 4; ++j) { const bool up = (lane & 16) != 0; const int keep = up ? r8[j + 4] : r8[j], send = up ? r8[j] : r8[j + 4]; r4[j] = keep + __shfl_xor(send, 16); }
#pragma unroll
        for (int j = 0; j < 2; ++j) { const bool up = (lane & 8) != 0; const int keep = up ? r4[j + 2] : r4[j], send = up ? r4[j] : r4[j + 2];
            r2[j] = keep + __builtin_amdgcn_update_dpp(0, send, 0x128, 0xf, 0xf, false); }
        f32x2v h2; h2.x = A.h0 + A.wsc * (float)r2[0]; h2.y = A.h1 + A.wsc * (float)r2[1];
        *(f32x2v*)(out + ((unsigned)tok * 1024u + 128u * (unsigned)x + (unsigned)pb_col(lane))) = h2;
    }
}
__device__ __forceinline__ void pb_s1h(PeerB1& a, const int* __restrict__ te, const float* __restrict__ aw, const bf16* __restrict__ hb, int tok, int x, int lane) {
    pb_s1(a, te, aw, tok, lane); a.h2 = *(const unsigned*)(hb + ((unsigned)tok * 1024u + 128u * (unsigned)x + (unsigned)pb_col(lane))); }
template <int MODE> __device__ __forceinline__ void peer_b_run(const unsigned char* __restrict__ v8x, const int* __restrict__ te, const float* __restrict__ aw, const bf16* __restrict__ hb, float* out, int wrank, int wstep, int x, int lane) {
    const int N = wrank < T ? (T - wrank + wstep - 1) / wstep : 0;
    if (N == 0) return;
    const int tlast = wrank + (N - 1) * wstep;
#define PB_TOK(n) min(wrank + (n) * wstep, tlast)
#define PB_STOK(n) ((MODE & 4) ? wrank : PB_TOK(n))
    PeerB1 s0, s1, s2; PeerB2 bA, bB; PeerBAcc A;
    pb_s1h(s0, te, aw, hb, PB_STOK(0), x, lane); pb_s1h(s1, te, aw, hb, PB_STOK(1), x, lane);
    pb_s2<0, MODE>(bA, s0, v8x, lane);
#define PB_TOKEN(n, Scur, Snext, Snew) do { \
        pb_s1h(Snew, te, aw, hb, PB_STOK((n) + 2), x, lane); \
        pb_s2<1, MODE>(bB, Scur, v8x, lane); __builtin_amdgcn_sched_barrier(0); A.h0 = bflo(Scur.h2); A.h1 = bfhi(Scur.h2); pb_quant(A, Scur); \
        pb_s3<0, MODE>(A, bA, Scur, out, PB_TOK(n), x, lane); \
        pb_s2<0, MODE>(bA, Snext, v8x, lane); __builtin_amdgcn_sched_barrier(0); \
        pb_s3<1, MODE>(A, bB, Scur, out, PB_TOK(n), x, lane); } while (0)
    for (int n = 0; n < N; n += 3) {
        PB_TOKEN(n, s0, s1, s2);
        PB_TOKEN(n + 1, s1, s2, s0);
        PB_TOKEN(n + 2, s2, s0, s1);
    }
#undef PB_TOKEN
#undef PB_STOK
#undef PB_TOK
}

__global__ void __launch_bounds__(NWAVES * 64, 2) mk_fwd(Args args) {
    extern __shared__ __attribute__((aligned(16))) unsigned char lds[];
    Frame F;
    F.lds = (LAS unsigned char*)lds;
    F.MISC = (volatile LAS unsigned*)(F.lds + MISC_OFF);
    F.tid = threadIdx.x; F.lane = F.tid & 63; F.wave = __builtin_amdgcn_readfirstlane(F.tid >> 6);
    F.G = gridDim.x; { const int bx = blockIdx.x; F.vcu = (F.G % 8 == 0) ? (bx % 8) * (F.G / 8) + bx / 8 : bx; }
    F.out = nullptr; F.ws = args.ws;
    unsigned char* ws = args.ws;
    F.ctl = (gu32*)(ws + WS_CTL);
    for (int u = F.tid; u < (LDS_BYTES - LDSCTL_OFF) / 4; u += NWAVES * 64) ((LAS unsigned*)(F.lds + LDSCTL_OFF))[u] = 0u;
    __syncthreads();
    XcdBarrier bar; bar.bar = (unsigned*)(F.ctl + CW_BAR); bar.x = 0; bar.st = nullptr;
    if (N_LAUNCHES != PER_PHASE) bar = xcd_barrier_post((unsigned*)(F.ctl + CW_BAR), F.MISC + 8);
    if (N_LAUNCHES != PER_PHASE) { if (F.tid == 0) { const unsigned xid = xb_xcc_id(); F.MISC[12] = xid; F.MISC[13] = xb_add((unsigned*)(F.ctl + CW_TICKET) + 64 * xid, 1u); } __syncthreads(); }
#define REFRESH_TID() do { int l_; asm volatile("v_mbcnt_lo_u32_b32 %0, -1, 0\n\tv_mbcnt_hi_u32_b32 %0, -1, %0" : "=v"(l_)); F.lane = l_; F.tid = (F.wave << 6) | l_; } while (0)
#define GRID_BAR() do { if (N_LAUNCHES != PER_PHASE) { REFRESH_TID(); xcd_barrier(bar, F.tid == 0); } } while (0)
    const int lo = args.ph_lo, hi = args.ph_hi;
#define IN(k) (lo <= (k) && (k) < hi)
#define BOTH(k) (IN(k) && IN((k) + 1))
    const int gw = F.vcu * NWAVES + F.wave, NGW = F.G * NWAVES;
#define WinT ((bf16*)(ws + WS_WIN))
#define WvT ((bf16*)(ws + WS_WV))
#define WkvT ((bf16*)(ws + WS_WKV))
#define WbrT ((bf16*)(ws + WS_WBR))
#define WoutT ((bf16*)(ws + WS_WOUT))
#define WqT ((bf16*)(ws + WS_WQ))
#define KEYS ((bf16*)(ws + WS_KEYS))
#define PWT ((bf16*)(ws + WS_PWT))
#define MEMN ((bf16*)(ws + WS_MEMN))
#define KMEM ((bf16*)(ws + WS_KMEM))
#define VTMEM ((bf16*)(ws + WS_VTMEM))
#define RSTDX ((float*)(ws + WS_RSTDX))
#define U8 ((const unsigned char*)(ws + WS_U8))
#define V8 ((const unsigned char*)(ws + WS_V8))
#define SU ((const float*)(ws + WS_SU))
#define SV ((const float*)(ws + WS_SV))
#define QN ((bf16*)(ws + WS_QN))
#define KN ((bf16*)(ws + WS_KN))
#define VT ((bf16*)(ws + WS_VT))
#define PP ((bf16*)(ws + WS_PP))
#define XQ ((bf16*)(ws + WS_XQ))
#define GATE ((bf16*)(ws + WS_GATE))
#define MERGED ((bf16*)(ws + WS_MERGED))
#define HB ((bf16*)(ws + WS_HB))
#define QB ((bf16*)(ws + WS_QB))
#define TE ((int*)(ws + WS_TE))
#define TW ((float*)(ws + WS_TW))
#define AW ((float*)(ws + WS_AW))
#define ROWSQ ((float*)(ws + WS_ROWSQ))
#define RELOAD_OUT(p) do { GAS unsigned char* p_; asm volatile("s_load_dwordx2 %0, %1, 0xb8\n\ts_waitcnt lgkmcnt(0)" : "=s"(p_) : "s"(__builtin_amdgcn_kernarg_segment_ptr()) : "memory"); p = (unsigned char*)p_; } while (0)
#define RELOAD_WS() GAS unsigned char* ws_; asm volatile("s_load_dwordx2 %0, %1, 0xc0\n\ts_waitcnt lgkmcnt(0)" : "=s"(ws_) : "s"(__builtin_amdgcn_kernarg_segment_ptr()) : "memory"); unsigned char* const ws = (unsigned char*)ws_; REFRESH_TID()
#define XB ((bf16*)(ws + WS_XB))
#define YNA ((bf16*)(outp + OUT_YNA))
#define YPOOL ((bf16*)(outp + OUT_YPOOL))
#define YXA ((bf16*)(outp + OUT_YXA))

#ifndef STAGGER_SLEEPS
#define STAGGER_SLEEPS 1
#endif
#define STAGGER() do { const int q_ = __builtin_amdgcn_readfirstlane((int)((blockIdx.x >> 3) & 3u) * STAGGER_SLEEPS); for (int i_ = 0; i_ < q_; ++i_) __builtin_amdgcn_s_sleep(127); } while (0)
    if (IN(0)) { unsigned char* outp; RELOAD_OUT(outp); F.out = (float*)outp; p0_prologue(F, args); F.out = nullptr; if (BOTH(0)) GRID_BAR(); }
    if (IN(1)) STAGGER();

    if (IN(1)) { RELOAD_WS();
      { unsigned char* outp; RELOAD_OUT(outp);
        { pg8::Sched1 S; S.so.init(T, IN_MAIN, F.G, (int)blockIdx.x); S.A = (const char*)XB; S.Bt = (const char*)WinT; S.tstep = (size_t)256 * 1024 * 2;
          pg8::EpiProj E{RSTDX, QN, KN, PP, XQ, GATE, args.in[I_NAQG], args.in[I_NAKG], args.in[I_GATEB], (args.probe & 1)};
          pg8::gemm_phase<pg8::EpiProj, pg8::Sched1, true, true>(F.lds + RING_OFF, 1024, S, E, F.wave, F.lane); REFRESH_TID(); }
        if (!(args.probe & 4)) { pg8::Sched1 S; S.so.init(512, T, F.G, (int)blockIdx.x); S.A = (const char*)WvT; S.Bt = (const char*)XB; S.tstep = (size_t)256 * 1024 * 2;
          pg8::EpiVt E{RSTDX, VT};
          pg8::gemm_phase<pg8::EpiVt, pg8::Sched1, false, true>(F.lds + RING_OFF, 1024, S, E, F.wave, F.lane); REFRESH_TID(); }
        if (!(args.probe & 2)) {
            __syncthreads();
            for (int j = F.vcu; j < 256; j += F.G) memkv_tile(MEMN, WkvT, args.in[I_XAKG], args.in[I_XAQG], KMEM, VTMEM, (LAS float*)(F.lds + RING_OFF) + (F.wave >> 2) * 6144, 2 * j + (F.wave >> 2), F.wave & 3, F.lane);
            __syncthreads(); }
      }
        if (BOTH(1)) GRID_BAR();
    }

    if (IN(2)) { RELOAD_WS();
      { unsigned char* outp; RELOAD_OUT(outp);
        LAS float* rpl = (LAS float*)(F.lds + RING_OFF + F.wave * 16384);
        for (int i = F.lane; i < 15 * 31; i += 64) rpl[i] = args.in[I_RPB][F.wave * 15 * 31 + i];
        LDS_WAIT(); asm volatile("" ::: "memory");
        if (!(args.probe & 1)) for (int i = F.vcu; i < 256; i += F.G)
            for (int k = 0; k < 8; ++k) { const int idx = i * 8 + k, b = idx >> 9, r = (idx >> 2) & 127, jb = idx & 3; na_item(QN, KN, VT, rpl, YNA, b, r, jb, F.wave, F.lane); }
        if (!(args.probe & 2)) for (int i = F.vcu; i < 256; i += F.G) pool_wg(PP, PWT, YPOOL, F.lds + RING_OFF, i * 128, F.wave, F.lane);
        if (!(args.probe & 4)) { const int pair = F.vcu & 15, xb = pair >> 2, xh = pair & 3, slot = F.vcu >> 4, nslot = F.G >> 4;
          __syncthreads(); xa_fill_lds(KMEM, VTMEM, F.lds + RING_OFF, xb, xh, F.tid); __syncthreads();
          if (slot < nslot) for (int n = slot * NWAVES + F.wave; n < 512; n += nslot * NWAVES) xa_item(XQ, F.lds + RING_OFF, YXA, (xb * 512 + n) * 16, xh, F.lane);
          __syncthreads(); }
      }
        if (BOTH(2)) GRID_BAR();
    }

    if (IN(3)) { RELOAD_WS();
      { unsigned char* outp; RELOAD_OUT(outp);
        pg8::Sched1 S; S.so.init(T, D, F.G, (int)blockIdx.x); S.A = (const char*)YNA; S.Bt = (const char*)WbrT; S.tstep = (size_t)256 * 1536 * 2;
        pg8::EpiMergeCat E{GATE, MERGED};
        pg8::gemm_phase<pg8::EpiMergeCat, pg8::Sched1, true, true>(F.lds + RING_OFF, 1536, S, E, F.wave, F.lane); REFRESH_TID();
      }
        if (BOTH(3)) GRID_BAR();
    }

    if (IN(4)) { RELOAD_WS();
      {
        pg8::Sched1 S; S.so.init(T, D, F.G, (int)blockIdx.x); S.A = (const char*)MERGED; S.Bt = (const char*)WoutT; S.tstep = (size_t)256 * 1024 * 2;
        pg8::EpiH E{(const pg8::bf16_t*)(ws + WS_XB), nullptr, HB, ROWSQ, args.probe};
        pg8::gemm_phase<pg8::EpiH, pg8::Sched1, true, true>(F.lds + RING_OFF, 1024, S, E, F.wave, F.lane); REFRESH_TID();
      }
        if (BOTH(4)) GRID_BAR();
    }

    if (IN(5)) { RELOAD_WS();
      {
        pg8::Sched1 S; S.so.init(T, 2048, F.G, (int)blockIdx.x); S.A = (const char*)HB; S.Bt = (const char*)WqT; S.tstep = (size_t)256 * 1024 * 2;
        pg8::EpiQ E{ROWSQ, QB};
        pg8::gemm_phase<pg8::EpiQ, pg8::Sched1, true, true>(F.lds + RING_OFF, 1024, S, E, F.wave, F.lane); REFRESH_TID();
      }
        if (BOTH(5)) GRID_BAR();
    }

    if (IN(6)) { RELOAD_WS();
        LAS int* lscr = (LAS int*)(F.lds + RING_OFF + 65536 + F.wave * 8192);
        for (int tok = 4 * gw; tok < T; tok += 4 * NGW) {
            HqIn hin[4];
#pragma unroll
            for (int r = 0; r < 4; ++r) hq_load(hin[r], HB, ROWSQ, tok + r, F.lane);
#pragma unroll
            for (int r = 0; r < 4; ++r) hq_token(hin[r], ws + WS_HQ, (float*)(ws + WS_HS), tok + r, F.lane); }
        { const int th = F.vcu & 7, slot = F.vcu >> 3, nslot = F.G >> 3;
          __syncthreads(); topk_fill_lds(KEYS, F.lds + RING_OFF, th, F.tid); __syncthreads();
          { { const int n0 = slot * NWAVES + F.wave, ns = nslot * NWAVES; TopkQ qA, qB;
              if (n0 < 2048) topk_loadq(qA, QB, n0 * 16, th, F.lane);
              for (int n = n0; n < 2048; n += 2 * ns) {
                  if (n + ns < 2048) topk_loadq(qB, QB, (n + ns) * 16, th, F.lane);
                  topk_item(qA, F.lds + RING_OFF, TE, TW, lscr, n * 16, th, F.lane);
                  if (n + ns < 2048) { if (n + 2 * ns < 2048) topk_loadq(qA, QB, (n + 2 * ns) * 16, th, F.lane);
                      topk_item(qB, F.lds + RING_OFF, TE, TW, lscr, (n + ns) * 16, th, F.lane); } } } }
          __syncthreads(); }
        if (BOTH(6)) GRID_BAR();
    }

    if (IN(7)) { RELOAD_WS();
        int x0 = 0, nxs = 8, wrank = (int)blockIdx.x * NWAVES + F.wave, wstep = F.G * NWAVES;
        if (N_LAUNCHES != PER_PHASE) { const unsigned xid = F.MISC[12], rk = F.MISC[13]; unsigned nx = 0, below = 0, mine = 0;
            for (unsigned j = 0; j < 16; ++j) { const unsigned c = xb_ld((unsigned*)(F.ctl + CW_BAR) + XB_XCNT(j)); nx += c > 0u; below += (c > 0u && j < xid); mine = (j == xid) ? c : mine; }
            if (nx == 8 && mine > 0 && rk < mine) { x0 = (int)below; nxs = 1; wrank = (int)rk * NWAVES + F.wave; wstep = (int)mine * NWAVES; }
            x0 = __builtin_amdgcn_readfirstlane(x0); nxs = __builtin_amdgcn_readfirstlane(nxs); wrank = __builtin_amdgcn_readfirstlane(wrank); wstep = __builtin_amdgcn_readfirstlane(wstep); }
        else if ((F.G & 7) == 0) { x0 = (int)blockIdx.x & 7; nxs = 1; wrank = ((int)blockIdx.x >> 3) * NWAVES + F.wave; wstep = (F.G >> 3) * NWAVES; }
        for (int xs = 0; xs < nxs; ++xs) {
#ifdef PROBE_BITS
            if (args.probe) peer_a_run<PROBE_BITS>(ws + WS_HQ, (const float*)(ws + WS_HS), U8, SU, SV, TE, TW, (float*)QB, (LAS int*)(F.lds + RING_OFF + F.wave * 16384), wrank, wstep, x0 + xs, F.lane); else
#endif
            peer_a_run<0>(ws + WS_HQ, (const float*)(ws + WS_HS), U8, SU, SV, TE, TW, AW, (LAS int*)(F.lds + RING_OFF + F.wave * 16384), wrank, wstep, x0 + xs, F.lane); }
        GRID_BAR();
    }
    if (IN(8)) { RELOAD_WS();
        int x0 = 0, nxs = 8, wrank = (int)blockIdx.x * NWAVES + F.wave, wstep = F.G * NWAVES;
        if (N_LAUNCHES != PER_PHASE) { const unsigned xid = F.MISC[12], rk = F.MISC[13]; unsigned nx = 0, below = 0, mine = 0;
            for (unsigned j = 0; j < 16; ++j) { const unsigned c = xb_ld((unsigned*)(F.ctl + CW_BAR) + XB_XCNT(j)); nx += c > 0u; below += (c > 0u && j < xid); mine = (j == xid) ? c : mine; }
            if (nx == 8 && mine > 0 && rk < mine) { x0 = (int)below; nxs = 1; wrank = (int)rk * NWAVES + F.wave; wstep = (int)mine * NWAVES; }
            x0 = __builtin_amdgcn_readfirstlane(x0); nxs = __builtin_amdgcn_readfirstlane(nxs); wrank = __builtin_amdgcn_readfirstlane(wrank); wstep = __builtin_amdgcn_readfirstlane(wstep); }
        else if ((F.G & 7) == 0) { x0 = (int)blockIdx.x & 7; nxs = 1; wrank = ((int)blockIdx.x >> 3) * NWAVES + F.wave; wstep = (F.G >> 3) * NWAVES; }
        for (int xs = 0; xs < nxs; ++xs) {
#ifdef PROBE_BITS
            if (args.probe) peer_b_run<PROBE_BITS>(V8 + (size_t)(x0 + xs) * (2 * MiB), TE, AW, HB, (float*)QB, wrank, wstep, x0 + xs, F.lane); else
#endif
            { unsigned char* outp; RELOAD_OUT(outp); peer_b_run<0>(V8 + (size_t)(x0 + xs) * (2 * MiB), TE, AW, HB, (float*)outp, wrank, wstep, x0 + xs, F.lane); } }
    }
#undef XB
#undef YNA
#undef YPOOL
#undef YXA
#undef RELOAD_OUT
#undef IN
#undef BOTH
#undef GRID_BAR
}

extern "C" void kernel_launch(void* const* d_in, const int* in_sizes, int n_in, void* d_out, int out_size, void* d_ws, size_t ws_size, hipStream_t stream) {
    static int grid = 0;
    if (grid == 0) {
        if (n_in != 23 || in_sizes[0] != T * D || out_size != T * D || ws_size < WS_END) { fprintf(stderr, "kernel_launch: unexpected shapes: n_in %d in0 %d out %d ws %zu\n", n_in, n_in > 0 ? in_sizes[0] : -1, out_size, ws_size); grid = -1; return; }
        int dev = 0, cus = 0, per_cu = 0;
        if (hipGetDevice(&dev) != hipSuccess || hipDeviceGetAttribute(&cus, hipDeviceAttributeMultiprocessorCount, dev) != hipSuccess) { fprintf(stderr, "kernel_launch: device query failed\n"); grid = -1; return; }
        if (hipFuncSetAttribute((const void*)mk_fwd, hipFuncAttributeMaxDynamicSharedMemorySize, LDS_BYTES) != hipSuccess) { fprintf(stderr, "kernel_launch: hipFuncSetAttribute failed\n"); grid = -1; return; }
        if (hipOccupancyMaxActiveBlocksPerMultiprocessor(&per_cu, (const void*)mk_fwd, NWAVES * 64, LDS_BYTES) != hipSuccess || per_cu < 1)
            fprintf(stderr, "kernel_launch: note: occupancy query reports %d workgroups per CU\n", per_cu);
        (void)hipGetLastError();
        grid = cus;
    }
    if (grid < 0) return;
    if (hipMemsetAsync((char*)d_ws + WS_CTL, 0, CTL_ZERO_BYTES, stream) != hipSuccess) { fprintf(stderr, "kernel_launch: memset failed\n"); return; }
    Args a{};
    for (int i = 0; i < 23; ++i) a.in[i] = (const float*)d_in[i];
    a.out = (float*)d_out; a.ws = (unsigned char*)d_ws;
    for (int li = 0; li < N_LAUNCHES; ++li) {
        a.ph_lo = (N_LAUNCHES == PER_PHASE) ? li : 0; a.ph_hi = (N_LAUNCHES == PER_PHASE) ? li + 1 : PER_PHASE;
        hipLaunchKernelGGL(mk_fwd, dim3(grid), dim3(NWAVES * 64), LDS_BYTES, stream, a);
#ifdef HOST_DUP_PHASE
        if (N_LAUNCHES == PER_PHASE && li == HOST_DUP_PHASE) {
#ifndef PROBE_MODE
            if (li == 4) (void)hipMemsetAsync((char*)d_ws + WS_ROWSQ, 0, (size_t)T * 4, stream);
#endif
#ifdef PROBE_MODE
            a.probe = PROBE_MODE;
#endif
            hipLaunchKernelGGL(mk_fwd, dim3(grid), dim3(NWAVES * 64), LDS_BYTES, stream, a); a.probe = 0; }
#endif
        const hipError_t le = hipPeekAtLastError();
        if (le != hipSuccess) { fprintf(stderr, "kernel_launch: launch %d failed: %s\n", li, hipGetErrorName(le)); break; }
    }
}
```

```cpp
#include <hip/hip_runtime.h>
#include <cstdio>
#include <cstdint>

#ifndef MK_N_LAUNCHES
#define MK_N_LAUNCHES 1
#endif

namespace pg8 {
#define PG8_LAS __attribute__((address_space(3)))
typedef unsigned short bf16_t;
typedef short bf16x8 __attribute__((ext_vector_type(8)));
typedef float f32x4 __attribute__((ext_vector_type(4)));
typedef unsigned u32x4 __attribute__((ext_vector_type(4)));
typedef unsigned u32x2 __attribute__((ext_vector_type(2)));
constexpr int BM = 256, BK = 64, HALF = 128, HTB = HALF * BK * 2  , STAGE_BYTES = 8 * HTB, NXCD = 8, WGM = 4;

__host__ __device__ __forceinline__ int lds_byte(int r, int c) { const int st = (r >> 4) * 2 + (c >> 5), rr = r & 15, cc = c & 31, ob = rr * 64 + cc * 2; return st * 1024 + (ob ^ (((ob >> 9) & 1) << 5)); }
__host__ __device__ __forceinline__ void stage_rc(int b, int& R, int& C) { const int st = b / 1024, sb = b % 1024, swz = sb ^ (((sb >> 9) & 1) << 5); R = (st >> 1) * 16 + swz / 64; C = (st & 1) * 32 + (swz % 64) / 2; }
__host__ __device__ __forceinline__ int perm32(int rho) { const int n = rho >> 4, i = rho & 15; return 8 * (i >> 2) + 4 * n + (i & 3); }

struct Unit { int pm, pn, br; };

struct StaticOrder {
    int nM, nN, nwg, G, c;
    __host__ __device__ void init(int M, int N, int G_, int c_) { nM = M / BM; nN = N / BM; nwg = nM * nN; G = G_; c = c_; }
    __host__ __device__ bool next(int i, Unit& u) const {
        const long L = (long)i * G + c; if (L >= nwg) return false;
        int wgid = (int)L; { const int q = nwg / NXCD, r = nwg % NXCD, xcd = wgid % NXCD, off = wgid / NXCD; wgid = (xcd < r ? xcd * (q + 1) : r * (q + 1) + (xcd - r) * q) + off; }
        const int nig = WGM * nN, gid = wgid / nig, fm = gid * WGM, gsz = (nM - fm) < WGM ? (nM - fm) : WGM;
        u.pm = fm + ((wgid % nig) % gsz); u.pn = (wgid % nig) / gsz; return true;
    }
};
struct Sched1 {
    StaticOrder so; const char* A; const char* Bt; size_t tstep;
    __device__ __forceinline__ bool next(int i, Unit& u) const { u.br = 0; return so.next(i, u); }
    __device__ __forceinline__ const char* abase(const Unit& u) const { return A + (size_t)u.pm * tstep; }
    __device__ __forceinline__ const char* bbase(const Unit& u) const { return Bt + (size_t)u.pn * tstep; }
    __device__ __forceinline__ void a_ready(const Unit&) const {}
    __device__ __forceinline__ void done(const Unit&) const {}
};
struct Sched3 {
    StaticOrder so; const char* A; const char* Bt; size_t tstep, strideA, strideB;
    __device__ __forceinline__ bool next(int i, Unit& u) const { u.br = i % 3; return so.next(i / 3, u); }
    __device__ __forceinline__ const char* abase(const Unit& u) const { return A + (size_t)u.br * strideA + (size_t)u.pm * tstep; }
    __device__ __forceinline__ const char* bbase(const Unit& u) const { return Bt + (size_t)u.br * strideB + (size_t)u.pn * tstep; }
    __device__ __forceinline__ void a_ready(const Unit&) const {}
    __device__ __forceinline__ void done(const Unit&) const {}
};

typedef float f32x2_t __attribute__((ext_vector_type(2))); typedef __bf16 bf16x2v_t __attribute__((ext_vector_type(2)));
__device__ __forceinline__ unsigned cvt_pk_bf16(float lo, float hi) { const f32x2_t v = {lo, hi}; const bf16x2v_t b = __builtin_convertvector(v, bf16x2v_t); return __builtin_bit_cast(unsigned, b); }
__device__ __forceinline__ u32x4 pack8(const f32x4 a, const f32x4 b) { u32x4 w; w.x = cvt_pk_bf16(a[0], a[1]); w.y = cvt_pk_bf16(a[2], a[3]); w.z = cvt_pk_bf16(b[0], b[1]); w.w = cvt_pk_bf16(b[2], b[3]); return w; }
__device__ __forceinline__ float bflo(unsigned u) { return __builtin_bit_cast(float, u << 16); }
__device__ __forceinline__ float bfhi(unsigned u) { return __builtin_bit_cast(float, u & 0xffff0000u); }


constexpr float RMS_EPS = 1e-6f;

__device__ __forceinline__ size_t il4(int row, int col, int ncols) { return ((size_t)(((row >> 2) * (ncols >> 3) + (col >> 3)) * 4 + (row & 3))) * 8; }
__device__ __forceinline__ float ubf(unsigned v, int k) { return (float)((v >> (8 * k)) & 0xffu); }
__device__ __forceinline__ unsigned q4_u8(float a, float b, float c, float d) {
    const unsigned q0 = __builtin_bit_cast(unsigned, a + 12582912.0f), q1 = __builtin_bit_cast(unsigned, b + 12582912.0f), q2 = __builtin_bit_cast(unsigned, c + 12582912.0f), q3 = __builtin_bit_cast(unsigned, d + 12582912.0f);
    return __builtin_amdgcn_perm(q1, q0, 0x0c0c0400u) | __builtin_amdgcn_perm(q3, q2, 0x04000c0cu);
}
struct EpiProj {
    static constexpr bool PERM = true, AFTER_DRAIN = false, HAS_MID = false;
    const float* rstd; bf16_t *qn, *kn, *pp, *xq, *gates; const float *qg, *kg, *gate_b; int skip;
    __device__ __forceinline__ void operator()(const f32x4 (&acc)[2][2][4][2], const Unit& u, int wr, int wc, int fr, int fq) const {
        if (skip) { if (acc[0][0][0][0][0] == 1234.5f) qn[0] = 1; return; }
        const int pn = u.pn, row0 = u.pm * BM + wr * 64 + fr, lc0 = 64 * wc + 8 * fq;
        float rsv[2][4];
#pragma unroll
        for (int ai = 0; ai < 2; ++ai)
#pragma unroll
            for (int m = 0; m < 4; ++m) rsv[ai][m] = rstd[row0 + ai * HALF + m * 16];
        if (pn < 4) {
            const bool isq = pn < 2; bf16_t* O = isq ? qn : kn; const float* g = isq ? qg : kg; const float post = isq ? 0.125f : 1.0f;
            f32x4 gv[2][2];
#pragma unroll
            for (int bj = 0; bj < 2; ++bj)
#pragma unroll
                for (int n = 0; n < 2; ++n) gv[bj][n] = *(const f32x4*)(g + 32 * bj + 8 * fq + 4 * n);
            const int colbase = (pn & 1) * 256 + lc0;
#pragma unroll
            for (int ai = 0; ai < 2; ++ai)
#pragma unroll
                for (int m = 0; m < 4; ++m) {
                    const int row = row0 + ai * HALF + m * 16; const float rs = rsv[ai][m];
                    f32x4 v[2][2]; float ss = 0.f;
#pragma unroll
                    for (int bj = 0; bj < 2; ++bj)
#pragma unroll
                        for (int n = 0; n < 2; ++n) { v[bj][n] = acc[ai][bj][m][n] * rs; ss += (v[bj][n][0] * v[bj][n][0] + v[bj][n][1] * v[bj][n][1]) + (v[bj][n][2] * v[bj][n][2] + v[bj][n][3] * v[bj][n][3]); }
                    ss += __shfl_xor(ss, 16); ss += __shfl_xor(ss, 32);
                    const float r = rsqrtf(ss * (1.0f / 64.0f) + RMS_EPS) * post;
#pragma unroll
                    for (int bj = 0; bj < 2; ++bj) {
                        bf16_t* dst = isq ? O + il4(row, colbase + 32 * bj, 512)
                                          : O + ((size_t)((((row >> 2) * 8 + ((pn & 1) * 4 + wc)) * 8 + (fq + 4 * bj)) * 4 + (row & 3))) * 8;
                        *(u32x4*)dst = pack8(v[bj][0] * r * gv[bj][0], v[bj][1] * r * gv[bj][1]); }
                }
        } else if (pn < 8) {
            bf16_t* O = pn < 6 ? pp : xq; const int colbase = (pn & 1) * 256 + lc0;
#pragma unroll
            for (int ai = 0; ai < 2; ++ai)
#pragma unroll
                for (int m = 0; m < 4; ++m) {
                    const int row = row0 + ai * HALF + m * 16; const float rs = rsv[ai][m];
#pragma unroll
                    for (int bj = 0; bj < 2; ++bj) *(u32x4*)(O + (pn < 6 ? (size_t)row * 512 + colbase + 32 * bj : il4(row, colbase + 32 * bj, 512))) = pack8(acc[ai][bj][m][0] * rs, acc[ai][bj][m][1] * rs);
                }
        } else {
            const int gcol0 = (pn - 8) * 256 + lc0;
            f32x4 bv[2][2];
#pragma unroll
            for (int bj = 0; bj < 2; ++bj)
#pragma unroll
                for (int n = 0; n < 2; ++n) bv[bj][n] = *(const f32x4*)(gate_b + gcol0 + 32 * bj + 4 * n) * (-1.4426950408889634f);
#pragma unroll
            for (int ai = 0; ai < 2; ++ai)
#pragma unroll
                for (int m = 0; m < 4; ++m) {
                    const int row = row0 + ai * HALF + m * 16; const float rs = rsv[ai][m] * (-1.4426950408889634f);
#pragma unroll
                    for (int bj = 0; bj < 2; ++bj) {
                        f32x4 o[2];
#pragma unroll
                        for (int n = 0; n < 2; ++n) { const f32x4 z = acc[ai][bj][m][n] * rs + bv[bj][n];
#pragma unroll
                            for (int i = 0; i < 4; ++i) o[n][i] = fmaxf(__builtin_amdgcn_rcpf(__builtin_amdgcn_exp2f(z[i]) * (1.0f / 255.0f) + (1.0f / 255.0f)), 1.0f); }
                        u32x2 w8; w8.x = q4_u8(o[0][0], o[0][1], o[0][2], o[0][3]); w8.y = q4_u8(o[1][0], o[1][1], o[1][2], o[1][3]);
                        *(u32x2*)((unsigned char*)gates + il4(row, gcol0 + 32 * bj, 3072)) = w8;
                    }
                }
        }
    }
};
struct EpiVt {
    static constexpr bool PERM = true, AFTER_DRAIN = false, HAS_MID = false;
    const float* rstd; bf16_t* Vt;
    __device__ __forceinline__ void operator()(const f32x4 (&acc)[2][2][4][2], const Unit& u, int wr, int wc, int fr, int fq) const {
        const int ch0 = u.pm * BM + wr * 64 + fr, tok0 = u.pn * BM + wc * 32 + 8 * fq, b = tok0 >> 13, t0 = tok0 & 8191;
        f32x4 rv[2][2];
#pragma unroll
        for (int bj = 0; bj < 2; ++bj)
#pragma unroll
            for (int n = 0; n < 2; ++n) rv[bj][n] = *(const f32x4*)(rstd + tok0 + bj * HALF + 4 * n);
#pragma unroll
        for (int ai = 0; ai < 2; ++ai)
#pragma unroll
            for (int m = 0; m < 4; ++m) { const int R = b * 512 + ch0 + ai * HALF + m * 16;
#pragma unroll
                for (int bj = 0; bj < 2; ++bj) *(u32x4*)(Vt + ((size_t)(((R >> 2) * 1024 + ((t0 + bj * HALF) >> 3)) * 4 + (R & 3))) * 8) = pack8(acc[ai][bj][m][0] * rv[bj][0], acc[ai][bj][m][1] * rv[bj][1]); }
    }
};
struct EpiMergeCat {
    static constexpr bool PERM = true, AFTER_DRAIN = false, HAS_MID = true;
    const bf16_t* gates; bf16_t* merged;
    __device__ __forceinline__ void mid(f32x4 (&acc)[2][2][4][2], const Unit& u, int nb  , int wr, int wc, int fr, int fq) const {
        const int row0 = u.pm * BM + wr * 64 + fr, col0 = u.pn * BM + wc * 32 + 8 * fq;
#pragma unroll
        for (int ai = 0; ai < 2; ++ai) {
            u32x2 ga[4][2], gb[4][2];
#pragma unroll
            for (int m = 0; m < 4; ++m)
#pragma unroll
                for (int bj = 0; bj < 2; ++bj) { const unsigned char* gp = (const unsigned char*)gates + il4(row0 + ai * HALF + m * 16, (nb - 1) * 1024 + col0 + bj * HALF, 3072);
                    ga[m][bj] = *(const u32x2*)gp; gb[m][bj] = *(const u32x2*)(gp + 4096); }
            __builtin_amdgcn_sched_barrier(0);
#pragma unroll
            for (int m = 0; m < 4; ++m)
#pragma unroll
                for (int bj = 0; bj < 2; ++bj) { const u32x2 a = ga[m][bj], b = gb[m][bj]; f32x4& x0 = acc[ai][bj][m][0]; f32x4& x1 = acc[ai][bj][m][1];
#pragma unroll
                    for (int i = 0; i < 4; ++i) { x0[i] *= ubf(a.x, i) * __builtin_amdgcn_rcpf(ubf(b.x, i)); x1[i] *= ubf(a.y, i) * __builtin_amdgcn_rcpf(ubf(b.y, i)); } }
            __builtin_amdgcn_sched_barrier(0);
        }
    }
    __device__ __forceinline__ void operator()(const f32x4 (&acc)[2][2][4][2], const Unit& u, int wr, int wc, int fr, int fq) const {
        const int row0 = u.pm * BM + wr * 64 + fr, col0 = u.pn * BM + wc * 32 + 8 * fq;
#pragma unroll
        for (int ai = 0; ai < 2; ++ai) {
            u32x2 g8[4][2];
#pragma unroll
            for (int m = 0; m < 4; ++m)
#pragma unroll
                for (int bj = 0; bj < 2; ++bj) g8[m][bj] = *(const u32x2*)((const unsigned char*)gates + il4(row0 + ai * HALF + m * 16, 2048 + col0 + bj * HALF, 3072));
            __builtin_amdgcn_sched_barrier(0);
#pragma unroll
            for (int m = 0; m < 4; ++m)
#pragma unroll
                for (int bj = 0; bj < 2; ++bj) { const u32x2 g = g8[m][bj]; f32x4 a = acc[ai][bj][m][0], b = acc[ai][bj][m][1];
#pragma unroll
                    for (int i = 0; i < 4; ++i) { a[i] *= ubf(g.x, i) * (1.0f / 255.0f); b[i] *= ubf(g.y, i) * (1.0f / 255.0f); }
                    *(u32x4*)(merged + (size_t)(row0 + ai * HALF + m * 16) * 1024 + col0 + bj * HALF) = pack8(a, b); }
            __builtin_amdgcn_sched_barrier(0);
        }
    }
};
struct EpiH {
    static constexpr bool PERM = true, AFTER_DRAIN = false, HAS_MID = false;
    const bf16_t* x; float* out; bf16_t* hb; float* rowsq; int noatomic;
    __device__ __forceinline__ void operator()(const f32x4 (&acc)[2][2][4][2], const Unit& u, int wr, int wc, int fr, int fq) const {
        const int row0 = u.pm * BM + wr * 64 + fr, col0 = u.pn * BM + wc * 32 + 8 * fq;
#pragma unroll
        for (int ai = 0; ai < 2; ++ai) {
            u32x4 xv[4][2];
#pragma unroll
            for (int m = 0; m < 4; ++m)
#pragma unroll
                for (int bj = 0; bj < 2; ++bj) xv[m][bj] = *(const u32x4*)(x + ((size_t)(row0 + ai * HALF + m * 16) * 1024 + col0 + bj * HALF));
            __builtin_amdgcn_sched_barrier(0);
#pragma unroll
            for (int m = 0; m < 4; ++m) { const int row = row0 + ai * HALF + m * 16; float ss = 0.f;
#pragma unroll
                for (int bj = 0; bj < 2; ++bj) { const size_t o = (size_t)row * 1024 + col0 + bj * HALF;
                    const u32x4 xq = xv[m][bj]; f32x4 h0 = acc[ai][bj][m][0], h1 = acc[ai][bj][m][1];
                    h0[0] += bflo(xq.x); h0[1] += bfhi(xq.x); h0[2] += bflo(xq.y); h0[3] += bfhi(xq.y); h1[0] += bflo(xq.z); h1[1] += bfhi(xq.z); h1[2] += bflo(xq.w); h1[3] += bfhi(xq.w);
                    *(u32x4*)(hb + o) = pack8(h0, h1);
                    ss += (h0[0] * h0[0] + h0[1] * h0[1]) + (h0[2] * h0[2] + h0[3] * h0[3]) + (h1[0] * h1[0] + h1[1] * h1[1]) + (h1[2] * h1[2] + h1[3] * h1[3]); }
                ss += __shfl_xor(ss, 16); ss += __shfl_xor(ss, 32);
                if (fq == 0 && !noatomic) atomicAdd(rowsq + row, ss); }
            __builtin_amdgcn_sched_barrier(0);
        }
    }
};
struct EpiQ {
    static constexpr bool PERM = true, AFTER_DRAIN = false, HAS_MID = false;
    const float* rowsq; bf16_t* qb;
    __device__ __forceinline__ void operator()(const f32x4 (&acc)[2][2][4][2], const Unit& u, int wr, int wc, int fr, int fq) const {
        const int row0 = u.pm * BM + wr * 64 + fr, col0 = u.pn * BM + wc * 32 + 8 * fq;
        float rq[2][4];
#pragma unroll
        for (int ai = 0; ai < 2; ++ai)
#pragma unroll
            for (int m = 0; m < 4; ++m) rq[ai][m] = rowsq[row0 + ai * HALF + m * 16];
#pragma unroll
        for (int ai = 0; ai < 2; ++ai)
#pragma unroll
            for (int m = 0; m < 4; ++m) { const int row = row0 + ai * HALF + m * 16; const float r = rsqrtf(rq[ai][m] * (1.0f / 1024.0f) + RMS_EPS);
#pragma unroll
                for (int bj = 0; bj < 2; ++bj) *(u32x4*)(qb + il4(row, col0 + bj * HALF, 2048)) = pack8(acc[ai][bj][m][0] * r, acc[ai][bj][m][1] * r); }
    }
};

template <class Epi, class Sched, bool ALIGN_EPI = false, bool SP2 = false>
__device__ __forceinline__ void gemm_phase(PG8_LAS unsigned char* lds, const int K, const Sched& S, const Epi& E, const int wid, const int lane) {
    const int tid = wid * 64 + lane, wr = wid >> 2, wc = wid & 3, fr = lane & 15, fq = lane >> 4;
    const int nt = K / BK;
    unsigned voffA[2], voffB[2];
#pragma unroll
    for (int i = 0; i < 2; ++i) { int R, C; stage_rc(tid * 16 + i * 8192, R, C); const int Rb = Epi::PERM ? ((R & ~31) + perm32(R & 31)) : R;
        voffA[i] = (unsigned)(R * K + C) * 2u; voffB[i] = (unsigned)(Rb * K + C) * 2u; }
    const size_t kstep = (size_t)(BK * 2);
    const size_t hstep = (size_t)HALF * K * 2;
    const size_t tstep = 2 * hstep;
    const unsigned ldsw = (unsigned)wid * 1024u;
    const int aoff = lds_byte(wr * 64 + fr, fq * 8), boff = lds_byte(wc * 32 + fr, fq * 8);
#define PG8_SA(b, h) (((b) * 2 + (h)) * HTB)
#define PG8_SB(b, h) ((4 + (b) * 2 + (h)) * HTB)
#define PG8_STAGE(bufoff, gbase, voff) do { _Pragma("unroll") for (int _i = 0; _i < 2; ++_i) \
        __builtin_amdgcn_global_load_lds((const unsigned*)((const char*)(gbase) + (voff)[_i]), (PG8_LAS unsigned*)(lds + (bufoff) + ldsw + _i * 8192), 16, 0, 0); } while (0)
#define PG8_LDA(dst, b, h) do { _Pragma("unroll") for (int m = 0; m < 4; ++m) _Pragma("unroll") for (int k = 0; k < 2; ++k) dst[m][k] = *(const PG8_LAS bf16x8*)(lds + PG8_SA(b, h) + aoff + m * 2048 + k * 1024); } while (0)
#define PG8_LDB(dst, b, h) do { _Pragma("unroll") for (int n = 0; n < 2; ++n) _Pragma("unroll") for (int k = 0; k < 2; ++k) dst[n][k] = *(const PG8_LAS bf16x8*)(lds + PG8_SB(b, h) + boff + n * 2048 + k * 1024); } while (0)
#define PG8_MMA(ai, bj, At, Bt) do { __builtin_amdgcn_s_setprio(1); _Pragma("unroll") for (int m = 0; m < 4; ++m) _Pragma("unroll") for (int n = 0; n < 2; ++n) _Pragma("unroll") for (int k = 0; k < 2; ++k) \
        acc[ai][bj][m][n] = __builtin_amdgcn_mfma_f32_16x16x32_bf16(Bt[n][k], At[m][k], acc[ai][bj][m][n], 0, 0, 0); __builtin_amdgcn_s_setprio(0); } while (0)
#define PG8_WAIT_V(n) asm volatile("s_waitcnt vmcnt(" #n ")" ::: "memory")
#define PG8_WAIT_L(n) asm volatile("s_waitcnt lgkmcnt(" #n ")" ::: "memory")
#define PG8_BAR __builtin_amdgcn_s_barrier()
#define PG8_SCHED __builtin_amdgcn_sched_barrier(0)
    Unit cur, nxt; int ui = 0;
    if (!S.next(0, cur)) return;
    f32x4 acc[2][2][4][2];
#pragma unroll
    for (int a = 0; a < 2; ++a)
#pragma unroll
        for (int b = 0; b < 2; ++b)
#pragma unroll
            for (int m = 0; m < 4; ++m)
#pragma unroll
                for (int n = 0; n < 2; ++n) acc[a][b][m][n] = (f32x4){0.f, 0.f, 0.f, 0.f};
    bf16x8 At[4][2], B0[2][2], B1[2][2];
    const char* cA = S.abase(cur); const char* cB = S.bbase(cur);
    S.a_ready(cur);
    if constexpr (SP2) {
        PG8_STAGE(PG8_SB(0, 0), cB, voffB); PG8_STAGE(PG8_SB(0, 1), cB + hstep, voffB); PG8_STAGE(PG8_SA(0, 0), cA, voffA); PG8_STAGE(PG8_SA(0, 1), cA + hstep, voffA);
        if (wr == 1) PG8_BAR;
        PG8_WAIT_V(2); PG8_BAR;
        PG8_STAGE(PG8_SB(1, 0), cB + kstep, voffB); PG8_STAGE(PG8_SA(1, 0), cA + kstep, voffA); PG8_STAGE(PG8_SB(1, 1), cB + hstep + kstep, voffB);
        PG8_WAIT_V(6); PG8_BAR;
    } else {
        PG8_STAGE(PG8_SB(0, 0), cB, voffB); PG8_STAGE(PG8_SA(0, 0), cA, voffA); PG8_STAGE(PG8_SB(0, 1), cB + hstep, voffB); PG8_STAGE(PG8_SA(0, 1), cA + hstep, voffA);
        if (wr == 1) PG8_BAR;
        PG8_WAIT_V(4); PG8_BAR;
        PG8_STAGE(PG8_SB(1, 0), cB + kstep, voffB); PG8_STAGE(PG8_SA(1, 0), cA + kstep, voffA); PG8_STAGE(PG8_SB(1, 1), cB + hstep + kstep, voffB);
        PG8_WAIT_V(6); PG8_BAR;
    }
    for (;;) {
        const bool has_next = S.next(ui + 1, nxt);
        const char* nA = has_next ? S.abase(nxt) : cA; const char* nB = has_next ? S.bbase(nxt) : cB;
        asm volatile(".p2align 8");
        for (int t = 0; t < nt; t += 2) {
            if constexpr (Epi::HAS_MID) { if (t == 8 || t == 16) E.mid(acc, cur, t >> 3, wr, wc, fr, fq); }
            const bool last = (t == nt - 2);
            const char* a1 = cA + (size_t)(t + 1) * kstep;
            const char* a2 = last ? nA : cA + (size_t)(t + 2) * kstep; const char* b2 = last ? nB : cB + (size_t)(t + 2) * kstep;
            const char* a3 = a2 + kstep; const char* b3 = b2 + kstep;
            if (last && has_next) S.a_ready(nxt);
            if constexpr (SP2) {
            PG8_LDB(B0, 0, 0); PG8_LDB(B1, 0, 1); PG8_SCHED; PG8_LDA(At, 0, 0); PG8_STAGE(PG8_SA(1, 1), a1 + hstep, voffA);
            PG8_WAIT_V(8); PG8_WAIT_L(0); PG8_BAR; PG8_MMA(0, 0, At, B0); PG8_MMA(0, 1, At, B1); PG8_BAR; PG8_SCHED;
            PG8_LDA(At, 0, 1); PG8_STAGE(PG8_SB(0, 0), b2, voffB); PG8_STAGE(PG8_SB(0, 1), b2 + hstep, voffB); PG8_STAGE(PG8_SA(0, 0), a2, voffA);
            PG8_WAIT_V(8); PG8_WAIT_L(0); PG8_BAR; PG8_MMA(1, 0, At, B0); PG8_MMA(1, 1, At, B1); PG8_BAR; PG8_SCHED;
            PG8_LDB(B0, 1, 0); PG8_LDB(B1, 1, 1); PG8_SCHED; PG8_LDA(At, 1, 0); PG8_STAGE(PG8_SA(0, 1), a2 + hstep, voffA);
            PG8_WAIT_V(8); PG8_WAIT_L(0); PG8_BAR; PG8_MMA(0, 0, At, B0); PG8_MMA(0, 1, At, B1); PG8_BAR; PG8_SCHED;
            PG8_LDA(At, 1, 1); PG8_STAGE(PG8_SB(1, 0), b3, voffB); PG8_STAGE(PG8_SB(1, 1), b3 + hstep, voffB); PG8_STAGE(PG8_SA(1, 0), a3, voffA);
            PG8_WAIT_V(8); PG8_WAIT_L(0); PG8_BAR; PG8_MMA(1, 0, At, B0); PG8_MMA(1, 1, At, B1); PG8_BAR; PG8_SCHED;
            } else {
            PG8_LDB(B0, 0, 0); PG8_SCHED; PG8_LDA(At, 0, 0); PG8_STAGE(PG8_SA(1, 1), a1 + hstep, voffA);
            PG8_WAIT_L(8); PG8_BAR; PG8_WAIT_L(0); PG8_MMA(0, 0, At, B0); PG8_BAR; PG8_SCHED;
            PG8_LDB(B1, 0, 1); PG8_STAGE(PG8_SB(0, 0), b2, voffB);
            PG8_BAR; PG8_WAIT_L(0); PG8_MMA(0, 1, At, B1); PG8_BAR;
            PG8_LDA(At, 0, 1); PG8_STAGE(PG8_SA(0, 0), a2, voffA);
            PG8_BAR; PG8_WAIT_L(0); PG8_MMA(1, 0, At, B0); PG8_BAR; PG8_SCHED;
            PG8_STAGE(PG8_SB(0, 1), b2 + hstep, voffB);
            PG8_WAIT_V(6); PG8_BAR; PG8_MMA(1, 1, At, B1); PG8_BAR;
            PG8_LDB(B0, 1, 0); PG8_SCHED; PG8_LDA(At, 1, 0); PG8_STAGE(PG8_SA(0, 1), a2 + hstep, voffA);
            PG8_WAIT_L(8); PG8_BAR; PG8_WAIT_L(0); PG8_MMA(0, 0, At, B0); PG8_BAR; PG8_SCHED;
            PG8_LDB(B1, 1, 1); PG8_STAGE(PG8_SB(1, 0), b3, voffB);
            PG8_BAR; PG8_WAIT_L(0); PG8_MMA(0, 1, At, B1); PG8_BAR;
            PG8_LDA(At, 1, 1); PG8_STAGE(PG8_SA(1, 0), a3, voffA);
            PG8_BAR; PG8_WAIT_L(0); PG8_MMA(1, 0, At, B0); PG8_BAR; PG8_SCHED;
            PG8_STAGE(PG8_SB(1, 1), b3 + hstep, voffB);
            PG8_WAIT_V(6); PG8_BAR; PG8_MMA(1, 1, At, B1); PG8_BAR;
            }
        }
        if constexpr (ALIGN_EPI) { if (wr == 0) PG8_BAR; }
        if constexpr (!Epi::AFTER_DRAIN) { E(acc, cur, wr, wc, fr, fq); S.done(cur); }
        if (!has_next) break;
#pragma unroll
        for (int a = 0; a < 2; ++a)
#pragma unroll
            for (int b = 0; b < 2; ++b)
#pragma unroll
                for (int m = 0; m < 4; ++m)
#pragma unroll
                    for (int n = 0; n < 2; ++n) acc[a][b][m][n] = (f32x4){0.f, 0.f, 0.f, 0.f};
        cur = nxt; cA = nA; cB = nB; ++ui;
        if constexpr (ALIGN_EPI) { if (wr == 1) PG8_BAR; }
    }
    PG8_WAIT_V(0);
    if constexpr (!ALIGN_EPI) { if (wr == 0) PG8_BAR; }
    PG8_BAR;
    if constexpr (Epi::AFTER_DRAIN) { E.fused(acc, cur, wr, wc, fr, fq, lds, wid, lane); S.done(cur); }
#undef PG8_SA
#undef PG8_SB
#undef PG8_STAGE
#undef PG8_LDA
#undef PG8_LDB
#undef PG8_MMA
#undef PG8_WAIT_V
#undef PG8_WAIT_L
#undef PG8_BAR
#undef PG8_SCHED
}
}

constexpr int NWAVES = 8;
constexpr int N_LAUNCHES = MK_N_LAUNCHES;
constexpr int PER_PHASE = 9;
constexpr int NBATCH = 4, SEQ = 8192, D = 1024, T = NBATCH * SEQ, MEMLEN = 256, NMEMTOK = NBATCH * MEMLEN;
constexpr int IN_MAIN = 5120;
constexpr int NEXP = 16384;

constexpr size_t MiB = 1u << 20;
constexpr size_t WS_CTL = 0, CTL_ZERO_BYTES = 512 * 1024;
constexpr size_t WS_ROWSQ = 256 * 1024;
constexpr size_t WS_WIN = 1 * MiB, WS_WV = 11 * MiB, WS_WKV = 12 * MiB, WS_WBR = 14 * MiB, WS_WOUT = 17 * MiB, WS_WQ = 19 * MiB, WS_KEYS = 23 * MiB, WS_PWT = 23 * MiB + 512 * 1024;
constexpr size_t WS_MEMN = 24 * MiB, WS_KMEM = 26 * MiB, WS_VTMEM = 27 * MiB, WS_RSTDX = 28 * MiB, WS_SU = 28 * MiB + 256 * 1024  , WS_SV = 28 * MiB + 512 * 1024  ;
constexpr size_t WS_U8 = 32 * MiB, WS_V8 = 48 * MiB;
constexpr size_t WS_QN = 96 * MiB, WS_KN = 128 * MiB, WS_VT = 160 * MiB, WS_PP = 192 * MiB, WS_XQ = 224 * MiB, WS_GATE = 256 * MiB, WS_XB = 448 * MiB  , WS_END = 512 * MiB;
constexpr size_t WS_MERGED = WS_QN;
constexpr size_t WS_HB = WS_VT;
constexpr size_t WS_QB = WS_GATE;
constexpr size_t WS_TE = WS_GATE + 128 * MiB, WS_TW = WS_TE + 16 * MiB;
constexpr size_t WS_HQ = WS_TW + 16 * MiB;
constexpr size_t WS_HS = 28 * MiB + 768 * 1024;
constexpr size_t WS_AW = WS_MERGED;
constexpr size_t OUT_XB = 0, OUT_YNA = 0, OUT_YPOOL = 512 * 2, OUT_YXA = 1024 * 2;
constexpr int CW_TMO = 0, CW_BAR = 4096, CW_TICKET = 8192;

constexpr int RING_OFF = 0, RING_BYTES = 131072;
constexpr int LDSCTL_OFF = RING_BYTES, MISC_OFF = LDSCTL_OFF + 320;
constexpr int LDS_BYTES = 147456;

#define GAS __attribute__((address_space(1)))
#define LAS __attribute__((address_space(3)))
typedef unsigned short bf16;
typedef unsigned v4u __attribute__((ext_vector_type(4)));
typedef unsigned v2u __attribute__((ext_vector_type(2)));
typedef float f32x4 __attribute__((ext_vector_type(4)));
typedef short bf16x8 __attribute__((ext_vector_type(8)));
typedef __bf16 bf16x2_t __attribute__((ext_vector_type(2)));
typedef GAS unsigned gu32;
#define LDS_WAIT() asm volatile("s_waitcnt lgkmcnt(0)" ::: "memory")
#define VM_WAIT() asm volatile("s_waitcnt vmcnt(0)" ::: "memory")
__device__ __forceinline__ unsigned f2bf(float f) { unsigned u = __builtin_bit_cast(unsigned, f); return (u + 0x7fffu + ((u >> 16) & 1u)) >> 16; }
__device__ __forceinline__ unsigned pk2(float lo, float hi) { return pg8::cvt_pk_bf16(lo, hi); }
__device__ __forceinline__ float bflo(unsigned u) { return __builtin_bit_cast(float, u << 16); }
__device__ __forceinline__ float bfhi(unsigned u) { return __builtin_bit_cast(float, u & 0xffff0000u); }
__device__ __forceinline__ float bf1(short s) { return __builtin_bit_cast(float, ((unsigned)(unsigned short)s) << 16); }
__device__ __forceinline__ f32x4 mfma16(bf16x8 a, bf16x8 b, f32x4 c) { return __builtin_amdgcn_mfma_f32_16x16x32_bf16(a, b, c, 0, 0, 0); }
template <int CTRL, int RM> __device__ __forceinline__ float dppf_(float x, float idn) { return __builtin_bit_cast(float, __builtin_amdgcn_update_dpp(__builtin_bit_cast(int, idn), __builtin_bit_cast(int, x), CTRL, RM, 0xf, false)); }
__device__ __forceinline__ float wave_sum(float v) {
    v += dppf_<0xb1, 0xf>(v, 0.f); v += dppf_<0x4e, 0xf>(v, 0.f); v += dppf_<0x124, 0xf>(v, 0.f); v += dppf_<0x128, 0xf>(v, 0.f); v += dppf_<0x142, 0xa>(v, 0.f); v += dppf_<0x143, 0xc>(v, 0.f);
    return __builtin_bit_cast(float, __builtin_amdgcn_readlane(__builtin_bit_cast(int, v), 63));
}
__device__ __forceinline__ float wave_absmax(unsigned mb) {
#define WUMAX_(CTRL, RM) do { const unsigned y_ = (unsigned)__builtin_amdgcn_update_dpp((int)mb, (int)mb, CTRL, RM, 0xf, false); mb = y_ > mb ? y_ : mb; } while (0)
    WUMAX_(0xb1, 0xf); WUMAX_(0x4e, 0xf); WUMAX_(0x124, 0xf); WUMAX_(0x128, 0xf); WUMAX_(0x142, 0xa); WUMAX_(0x143, 0xc);
#undef WUMAX_
    return __builtin_bit_cast(float, __builtin_amdgcn_readlane((int)mb, 63));
}
__device__ __forceinline__ unsigned q4_i8(float a, float b, float c, float d, float inv) {
    const unsigned q0 = __builtin_bit_cast(unsigned, a * inv + 12582912.0f), q1 = __builtin_bit_cast(unsigned, b * inv + 12582912.0f), q2 = __builtin_bit_cast(unsigned, c * inv + 12582912.0f), q3 = __builtin_bit_cast(unsigned, d * inv + 12582912.0f);
    return __builtin_amdgcn_perm(q1, q0, 0x0c0c0400u) | __builtin_amdgcn_perm(q3, q2, 0x04000c0cu);
}

#define XB_TMO      128
#define XB_XCNT(j)  (256  + 64 * (j))
#define XB_XSUB(j)  (1280 + 64 * (j))
#define XB_XGEN(j)  (2304 + 64 * (j))
#define XB_TOP      3328
#define XB_TOPGEN   3392
#define XCD_BAR_WORDS 3456
#define XB_SPIN_CAP (1u << 18)

__device__ __forceinline__ unsigned xb_ld(unsigned* p)              { return __hip_atomic_load(p, __ATOMIC_RELAXED, __HIP_MEMORY_SCOPE_AGENT); }
__device__ __forceinline__ unsigned xb_add(unsigned* p, unsigned v) { return __hip_atomic_fetch_add(p, v, __ATOMIC_RELAXED, __HIP_MEMORY_SCOPE_AGENT); }
__device__ __forceinline__ unsigned xb_xcc_id() { return (unsigned)__builtin_amdgcn_s_getreg((3 << 11) | 20) & 0xFu; }
#define XB_SPIN(cond, bar) do { unsigned _sp = 0; while (cond) { __builtin_amdgcn_s_sleep(1); \
    if ((++_sp & 255u) == 0u) { if (xb_ld(&(bar)[XB_TMO])) break; if (_sp > XB_SPIN_CAP) { atomicAdd(&(bar)[XB_TMO], 1u); break; } } } } while (0)

struct XcdBarrier {
    unsigned* bar; unsigned x;
    volatile LAS unsigned* st;
};

__device__ __forceinline__ XcdBarrier xcd_barrier_post(unsigned* bar, volatile LAS unsigned* st) {
    XcdBarrier b; b.bar = bar; b.x = xb_xcc_id(); b.st = st;
    if (threadIdx.x == 0) (void)xb_add(&bar[XB_XCNT(b.x)], 1u);
    return b;
}
__device__ __forceinline__ void xcd_barrier_complete(unsigned* bar, unsigned x, unsigned& nloc, unsigned& nx) {
    const unsigned G = gridDim.x * gridDim.y * gridDim.z;
    unsigned sum, cnt, mine, sp = 0u;
    for (;;) {
        sum = 0u; cnt = 0u; mine = 0u;
#pragma unroll
        for (unsigned j = 0; j < 16; ++j) { const unsigned c = xb_ld(&bar[XB_XCNT(j)]); sum += c; cnt += (c > 0u) ? 1u : 0u; mine = (j == x) ? c : mine; }
        if (sum == G) break;
        __builtin_amdgcn_s_sleep(1);
        if ((++sp & 255u) == 0u) { if (xb_ld(&bar[XB_TMO])) break; if (sp > XB_SPIN_CAP) { atomicAdd(&bar[XB_TMO], 1u); break; } }
    }
    nloc = mine > 0u ? mine : 1u; nx = cnt > 0u ? cnt : 1u;
}

__device__ __forceinline__ void xcd_barrier(const XcdBarrier& b, const bool leader) {
    asm volatile("s_waitcnt vmcnt(0)" ::: "memory");
    __syncthreads();
    if (leader) {
        unsigned* bar = b.bar;
        __builtin_amdgcn_s_waitcnt(0);
        unsigned nloc = b.st[0], nx = b.st[1];
        if (nloc == 0u) { xcd_barrier_complete(bar, b.x, nloc, nx); b.st[0] = nloc; b.st[1] = nx; }
        const unsigned old = xb_add(&bar[XB_XSUB(b.x)], 1u);
        const unsigned gen = old / nloc;
        if (old + 1u == (gen + 1u) * nloc) {
            __builtin_amdgcn_fence(__ATOMIC_RELEASE, "agent");
            asm volatile("s_waitcnt vmcnt(0)" ::: "memory");
            const unsigned og = xb_add(&bar[XB_TOP], 1u);
            const unsigned tg = og / nx;
            if (og + 1u == (tg + 1u) * nx) xb_add(&bar[XB_TOPGEN], 1u);
            else XB_SPIN(xb_ld(&bar[XB_TOPGEN]) == tg, bar);
            __builtin_amdgcn_fence(__ATOMIC_ACQUIRE, "agent");
            xb_add(&bar[XB_XGEN(b.x)], 1u);
            asm volatile("s_waitcnt vmcnt(0)" ::: "memory");
        } else {
            XB_SPIN(xb_ld(&bar[XB_XGEN(b.x)]) == gen, bar);
            __builtin_amdgcn_fence(__ATOMIC_ACQUIRE, "agent");
            asm volatile("s_waitcnt vmcnt(0)" ::: "memory");
        }
    }
    __syncthreads();
}

struct Frame {
    LAS unsigned char* lds;
    volatile LAS unsigned* MISC;
    gu32* ctl;
    int tid, lane, wave, vcu, G;
    float* out; unsigned char* ws;
};
struct Args { const float* in[23]; float* out; unsigned char* ws; int ph_lo, ph_hi, probe, pad; };
enum { I_X = 0, I_MEM, I_MIXG, I_MEMG, I_WIN, I_GATEB, I_WKV, I_NAQG, I_NAKG, I_RPB, I_POOLW, I_POOLSC, I_XAQG, I_XAKG, I_WB0, I_WB1, I_WB2, I_WOUT, I_FFNG, I_WQ, I_KEYS, I_PU, I_PV };

template <bool HAS_SCALE, bool IL4 = false> __device__ __forceinline__ void p0_transpose_item(const float* W, int K, int N, int k0, int n0, bf16* dst, const float* kscale, LAS float* scr, int lane, int dpitch = 0) {
    if (dpitch == 0) dpitch = K;
    const int c = lane & 7;
    float v[32];
    const GAS float* wp = (const GAS float*)W + ((size_t)(k0 + (lane >> 5)) * N + n0 + (lane & 31));
#pragma unroll
    for (int i = 0; i < 32; ++i) v[i] = wp[(size_t)(2 * i) * N];
    f32x4 s0 = (f32x4){1.f, 1.f, 1.f, 1.f}, s1 = s0;
    if (HAS_SCALE) { s0 = *(const GAS f32x4*)(kscale + k0 + 8 * c); s1 = *(const GAS f32x4*)(kscale + k0 + 8 * c + 4); }
    __builtin_amdgcn_sched_barrier(0);
#pragma unroll
    for (int i = 0; i < 32; ++i) scr[(2 * i + (lane >> 5)) * 33 + (lane & 31)] = v[i];
    LDS_WAIT(); asm volatile("" ::: "memory");
#pragma unroll
    for (int j = 0; j < 4; ++j) { const int n = (lane >> 3) + 8 * j; const LAS float* s = scr + (8 * c) * 33 + n;
        v4u o; o.x = pk2(s[0 * 33] * s0.x, s[1 * 33] * s0.y); o.y = pk2(s[2 * 33] * s0.z, s[3 * 33] * s0.w); o.z = pk2(s[4 * 33] * s1.x, s[5 * 33] * s1.y); o.w = pk2(s[6 * 33] * s1.z, s[7 * 33] * s1.w);
        if (IL4) *(GAS v4u*)(dst + pg8::il4(n0 + n, k0 + 8 * c, K)) = o; else *(GAS v4u*)(dst + (size_t)n * dpitch + k0 + 8 * c) = o; }
    LDS_WAIT(); asm volatile("" ::: "memory");
}
__device__ __forceinline__ void cvt_row1024(const float* src, bf16* dst, const float* colscale, float rowscale, int lane) {
    const GAS f32x4* xr = (const GAS f32x4*)src + lane; GAS unsigned long long* o8 = (GAS unsigned long long*)dst + lane;
#pragma unroll
    for (int j = 0; j < 4; ++j) { f32x4 v = xr[64 * j] * rowscale; if (colscale) v = v * ((const GAS f32x4*)colscale)[lane + 64 * j];
        o8[64 * j] = (unsigned long long)pk2(v.x, v.y) | ((unsigned long long)pk2(v.z, v.w) << 32); }
}
__device__ __forceinline__ float row_rstd1024(const float* src, int lane) {
    const GAS f32x4* xr = (const GAS f32x4*)src + lane; float s = 0.f;
#pragma unroll
    for (int j = 0; j < 4; ++j) { const f32x4 v = xr[64 * j]; s += (v.x * v.x + v.y * v.y) + (v.z * v.z + v.w * v.w); }
    return rsqrtf(wave_sum(s) * (1.0f / 1024.0f) + 1e-6f);
}
__device__ __forceinline__ void p0_prologue(Frame& F, const Args& A) {
    LAS float* scr = (LAS float*)(F.lds + RING_OFF + F.wave * 16384);
    const int gw = F.vcu * NWAVES + F.wave, NGW = F.G * NWAVES, lane = F.lane;
    unsigned char* ws = F.ws;
    constexpr int I_IN = 16 * 176, I_KV = 16 * 32, I_BR = 8 * 32, I_OUT = 16 * 32, I_Q = 16 * 64;
    constexpr int NITEMS = I_IN + I_KV + 3 * I_BR + I_OUT + I_Q;
    if (!(A.probe & 1)) for (int it = gw; it < NITEMS; it += NGW) {
        int r = it;
        if (r < I_IN) { const int kb = r / 176, nb = r % 176, n0 = 32 * nb; bf16* dst;
            if (n0 >= 1024 && n0 < 1536) dst = (bf16*)(ws + WS_WV) + (size_t)(n0 - 1024) * 1024;
            else { const int np = n0 < 1024 ? n0 : n0 - 512, t = np >> 8, w = np & 255, wc = w >> 6, bj = (w >> 5) & 1; dst = (bf16*)(ws + WS_WIN) + (size_t)(256 * t + 128 * bj + 32 * wc) * 1024; }
            p0_transpose_item<true>(A.in[I_WIN], 1024, 5632, 64 * kb, n0, dst, A.in[I_MIXG], scr, lane); continue; }
        r -= I_IN;
        if (r < I_KV) { const int kb = r / 32, nb = r % 32; p0_transpose_item<false, true>(A.in[I_WKV], 1024, 1024, 64 * kb, 32 * nb, (bf16*)(ws + WS_WKV), nullptr, scr, lane); continue; }
        r -= I_KV;
        if (r < 3 * I_BR) { const int br = r / I_BR, rr = r % I_BR, kb = rr / 32, nb = rr % 32; const float* W = br == 0 ? A.in[I_WB0] : (br == 1 ? A.in[I_WB1] : A.in[I_WB2]);
            p0_transpose_item<false>(W, 512, 1024, 64 * kb, 32 * nb, (bf16*)(ws + WS_WBR) + (size_t)(32 * nb) * 1536 + br * 512, nullptr, scr, lane, 1536); continue; }
        r -= 3 * I_BR;
        if (r < I_OUT) { const int kb = r / 32, nb = r % 32; p0_transpose_item<false>(A.in[I_WOUT], 1024, 1024, 64 * kb, 32 * nb, (bf16*)(ws + WS_WOUT) + (size_t)(32 * nb) * 1024, nullptr, scr, lane); continue; }
        r -= I_OUT;
        { const int kb = r / 64, nb = r % 64; p0_transpose_item<true>(A.in[I_WQ], 1024, 2048, 64 * kb, 32 * nb, (bf16*)(ws + WS_WQ) + (size_t)(32 * nb) * 1024, A.in[I_FFNG], scr, lane); }
    }
    { bf16* xb = (bf16*)(ws + WS_XB); float* rstdx = (float*)(ws + WS_RSTDX);
      if (!(A.probe & 2)) for (int m0 = 4 * gw; m0 < T; m0 += 4 * NGW) {
          f32x4 v[4][4];
#pragma unroll
          for (int r = 0; r < 4; ++r)
#pragma unroll
              for (int j = 0; j < 4; ++j) v[r][j] = ((const GAS f32x4*)(A.in[I_X] + (size_t)(m0 + r) * D))[lane + 64 * j];
#pragma unroll
          for (int r = 0; r < 4; ++r) { float s = 0.f;
#pragma unroll
              for (int j = 0; j < 4; ++j) s += (v[r][j].x * v[r][j].x + v[r][j].y * v[r][j].y) + (v[r][j].z * v[r][j].z + v[r][j].w * v[r][j].w);
              const float rs = rsqrtf(wave_sum(s) * (1.0f / 1024.0f) + 1e-6f);
              GAS unsigned long long* o8 = (GAS unsigned long long*)(xb + (size_t)(m0 + r) * D) + lane;
#pragma unroll
              for (int j = 0; j < 4; ++j) o8[64 * j] = (unsigned long long)pk2(v[r][j].x, v[r][j].y) | ((unsigned long long)pk2(v[r][j].z, v[r][j].w) << 32);
              if (lane == 0) rstdx[m0 + r] = rs; } } }
    for (int m = gw; m < NMEMTOK; m += NGW) { const float* xr = A.in[I_MEM] + (size_t)m * D; const float rs = row_rstd1024(xr, lane);
        { const GAS f32x4* xv = (const GAS f32x4*)xr + lane; bf16* mb = (bf16*)(ws + WS_MEMN);
#pragma unroll
          for (int j = 0; j < 4; ++j) { const f32x4 v = xv[64 * j] * rs * ((const GAS f32x4*)A.in[I_MEMG])[lane + 64 * j]; const int c = 4 * (lane + 64 * j);
              *(GAS unsigned long long*)(mb + pg8::il4(m, c & ~7, 1024) + (c & 7)) = (unsigned long long)pk2(v.x, v.y) | ((unsigned long long)pk2(v.z, v.w) << 32); } } }
    if (!(A.probe & 4)) for (int mb = 4 * gw; mb < 2 * NEXP; mb += 4 * NGW) {
        const bool isu = mb < NEXP; const int e0 = isu ? mb : mb - NEXP;
        f32x4 v[4][4];
#pragma unroll
        for (int r = 0; r < 4; ++r) { const GAS f32x4* src = (const GAS f32x4*)((isu ? A.in[I_PU] : A.in[I_PV]) + (size_t)(e0 + r) * D) + 4 * lane;
#pragma unroll
            for (int d = 0; d < 4; ++d) v[r][d] = src[d]; }
        f32x4 gv[4];
#pragma unroll
        for (int d = 0; d < 4; ++d) gv[d] = isu ? ((const GAS f32x4*)A.in[I_FFNG])[4 * lane + d] : (f32x4){1.f, 1.f, 1.f, 1.f};
#pragma unroll
        for (int r = 0; r < 4; ++r) { const int e = e0 + r; unsigned mb = 0u;
#pragma unroll
            for (int d = 0; d < 4; ++d) { v[r][d] = v[r][d] * gv[d];
#pragma unroll
                for (int i = 0; i < 4; ++i) { const float f = v[r][d][i]; const unsigned b = __builtin_bit_cast(unsigned, f) & 0x7fffffffu; mb = b > mb ? b : mb; } }
            const float mx = wave_absmax(mb);
            const float inv = mx > 0.f ? 127.0f * __builtin_amdgcn_rcpf(mx) : 0.f;
            v4u w;
#pragma unroll
            for (int d = 0; d < 4; ++d) w[d] = q4_i8(v[r][d].x, v[r][d].y, v[r][d].z, v[r][d].w, inv);
            if (isu) ((GAS v4u*)(ws + WS_U8))[(size_t)e * 64 + lane] = w;
            else *(GAS v4u*)(ws + WS_V8 + (size_t)(lane >> 3) * (2 * MiB) + (size_t)e * 128 + (lane & 7) * 16) = w;
            if (lane == 0) ((float*)(ws + WS_SU))[2 * e + (isu ? 0 : 1)] = mx * (1.0f / 127.0f); }
    }
    for (int m = gw * 64 + lane; m < T; m += NGW * 64) ((float*)(ws + WS_ROWSQ))[m] = 0.f;
    for (int m = gw; m < 256; m += NGW) cvt_row1024(A.in[I_KEYS] + (size_t)m * 1024, (bf16*)(ws + WS_KEYS) + (size_t)m * 1024, nullptr, 1.0f, lane);
    for (int m = gw; m < 1024; m += NGW) { const int gd = m >> 1, c = (m & 1) * 64 + lane, g = gd >> 7, d = gd & 127;
        const float v = A.in[I_POOLW][(size_t)(g * 128 + c) * 128 + d] * A.in[I_POOLSC][gd];
        ((bf16*)(ws + WS_PWT))[pg8::il4(gd, c & ~7, 128) + (c & 7)] = (bf16)f2bf(v); }
}

__device__ __forceinline__ void memkv_tile(const bf16* memn, const bf16* wkvT, const float* kg, const float* qg, bf16* kmem, bf16* vtmem, LAS float* part, int tile, int kc, int lane) {
    const int q = lane & 15, hi = lane >> 4, rg = (tile < 0 ? 0 : tile) >> 3, cg = (tile < 0 ? 0 : tile) & 7, r0 = rg * 16, c0 = cg * 128;
    f32x4 acc[8];
#pragma unroll
    for (int i = 0; i < 8; ++i) acc[i] = (f32x4){0.f, 0.f, 0.f, 0.f};
    const bf16* ap = memn + pg8::il4(r0 + q, 8 * hi, 1024); const bf16* bp = wkvT + pg8::il4(c0 + q, 8 * hi, 1024);
    if (tile >= 0)
#pragma unroll 1
    for (int kb = 2 * kc; kb < 2 * kc + 2; ++kb) {
        bf16x8 a[4], b[4][8];
#pragma unroll
        for (int k4 = 0; k4 < 4; ++k4) { a[k4] = *(const bf16x8*)(ap + 128 * (4 * kb + k4));
#pragma unroll
            for (int nf = 0; nf < 8; ++nf) b[k4][nf] = *(const bf16x8*)(bp + (size_t)nf * 16384 + 128 * (4 * kb + k4)); }
        __builtin_amdgcn_sched_barrier(0);
#pragma unroll
        for (int k4 = 0; k4 < 4; ++k4)
#pragma unroll
            for (int nf = 0; nf < 8; ++nf) acc[nf] = mfma16(a[k4], b[k4][nf], acc[nf]);
        __builtin_amdgcn_sched_barrier(0);
    }
    if (tile >= 0 && kc > 0) {
#pragma unroll
        for (int nf = 0; nf < 8; ++nf) *(LAS f32x4*)(part + ((kc - 1) * 8 + nf) * 256 + 4 * lane) = acc[nf]; }
    __syncthreads();
    if (tile < 0 || kc > 0) return;
#pragma unroll
    for (int p = 0; p < 3; ++p)
#pragma unroll
        for (int nf = 0; nf < 8; ++nf) acc[nf] = acc[nf] + *(const LAS f32x4*)(part + (p * 8 + nf) * 256 + 4 * lane);
    if (cg < 4) {
        float rr[4];
#pragma unroll
        for (int g = 0; g < 4; ++g) { float ss = 0.f;
#pragma unroll
            for (int nf = 0; nf < 8; ++nf) ss += acc[nf][g] * acc[nf][g];
            ss += __shfl_xor(ss, 1); ss += __shfl_xor(ss, 2); ss += __shfl_xor(ss, 4); ss += __shfl_xor(ss, 8);
            rr[g] = rsqrtf(ss * (1.0f / 128.0f) + 1e-6f); }
#pragma unroll
        for (int nf = 0; nf < 8; ++nf) { const int d = 16 * nf + q; const float gs = kg[d] * qg[d];
#pragma unroll
            for (int g = 0; g < 4; ++g) kmem[(size_t)(r0 + 4 * hi + g) * 512 + cg * 128 + d] = (bf16)f2bf(acc[nf][g] * rr[g] * gs); }
    } else {
        const int h = cg - 4, b = r0 >> 8, key0 = (r0 & 255) + 4 * hi;
#pragma unroll
        for (int nf = 0; nf < 8; ++nf) { const int d = 16 * nf + q; v2u w; w.x = pk2(acc[nf][0], acc[nf][1]); w.y = pk2(acc[nf][2], acc[nf][3]);
            *(v2u*)(vtmem + (size_t)(b * 512 + h * 128 + d) * 256 + key0) = w; }
    }
}

__device__ __forceinline__ void na_item(const bf16* __restrict__ qn, const bf16* __restrict__ kn, const bf16* __restrict__ vt, const LAS float* rpl, bf16* __restrict__ yna,
                                        int b, int r, int jb, int h, int lane) {
    const int q = lane & 15, hi = lane >> 4;
    int rs = r - 4; rs = rs < 0 ? 0 : (rs > 120 ? 120 : rs);
    int kb0 = jb * 16 - 8; kb0 = kb0 < 0 ? 0 : (kb0 > 32 ? 32 : kb0);
    const int qcol = jb * 16 + q; int cs = qcol - 8; cs = cs < 0 ? 0 : (cs > 48 ? 48 : cs);
    const size_t tokq = (size_t)b * SEQ + r * 64 + qcol;
    const bf16* qp = qn + pg8::il4((int)tokq, h * 64 + 8 * hi, 512);
    const bf16x8 qf0 = *(const bf16x8*)qp, qf1 = *(const bf16x8*)(qp + 128);
    const int kq = 8 * (q >> 2) + (q & 3);
    const int tokb = b * SEQ + rs * 64 + kb0 + 8 * (q >> 2); (void)kq;
    const bf16* kbase = kn + ((size_t)((((tokb >> 2) * 8 + h) * 8 + hi) * 4 + (q & 3))) * 8;
    f32x4 s[16];
    {
        bf16x8 ka[16][2];
#pragma unroll
        for (int f = 0; f < 16; ++f) { const bf16* kp = kbase + (size_t)((f >> 1) * 16 + (f & 1)) * 2048; ka[f][0] = *(const bf16x8*)kp; ka[f][1] = *(const bf16x8*)(kp + 128); }
        __builtin_amdgcn_sched_barrier(0);
#pragma unroll
        for (int f = 0; f < 16; ++f) { f32x4 z = (f32x4){0.f, 0.f, 0.f, 0.f}; z = mfma16(ka[f][0], qf0, z); s[f] = mfma16(ka[f][1], qf1, z); }
    }
    const bf16* vbase = vt + ((size_t)(((b * 128 + h * 16 + (q >> 2)) * 1024 + ((rs * 64 + kb0) >> 3) + hi) * 4 + (q & 3))) * 8;
    bf16x8 va[8][4];
#pragma unroll
    for (int st = 0; st < 8; ++st)
#pragma unroll
        for (int mf = 0; mf < 4; ++mf) va[st][mf] = *(const bf16x8*)(vbase + (size_t)mf * 131072 + st * 256);
    __builtin_amdgcn_sched_barrier(0);
    float mx = -3.0e38f;
#pragma unroll
    for (int c4 = 0; c4 < 4; ++c4) {
        float bb[4][4];
#pragma unroll
        for (int ff = 0; ff < 4; ++ff) { const int f = 4 * c4 + ff, dr = rs + (f >> 1) - r + 7;
#pragma unroll
            for (int g = 0; g < 4; ++g) { const int kcol = kb0 + 8 * hi + 4 * (f & 1) + g; int dc = kcol - qcol + 15; dc = dc < 0 ? 0 : (dc > 30 ? 30 : dc); bb[ff][g] = rpl[dr * 31 + dc]; } }
        __builtin_amdgcn_sched_barrier(0);
#pragma unroll
        for (int ff = 0; ff < 4; ++ff) { const int f = 4 * c4 + ff;
#pragma unroll
            for (int g = 0; g < 4; ++g) { const int kcol = kb0 + 8 * hi + 4 * (f & 1) + g; const bool ok = (kcol >= cs) && (kcol < cs + 16);
                const float v = ok ? s[f][g] + bb[ff][g] : -1.0e30f; s[f][g] = v; mx = fmaxf(mx, v); } }
    }
    mx = fmaxf(mx, __shfl_xor(mx, 16)); mx = fmaxf(mx, __shfl_xor(mx, 32));
    float sum = 0.f;
#pragma unroll
    for (int f = 0; f < 16; ++f)
#pragma unroll
        for (int g = 0; g < 4; ++g) { const float p = __expf(s[f][g] - mx); s[f][g] = p; sum += p; }
    sum += __shfl_xor(sum, 16); sum += __shfl_xor(sum, 32);
    const float inv = 1.0f / sum;
    f32x4 o[4];
#pragma unroll
    for (int i = 0; i < 4; ++i) o[i] = (f32x4){0.f, 0.f, 0.f, 0.f};
#pragma unroll
    for (int st = 0; st < 8; ++st) {
        const bf16x8 pb = __builtin_bit_cast(bf16x8, pg8::pack8(s[2 * st], s[2 * st + 1]));
#pragma unroll
        for (int mf = 0; mf < 4; ++mf) o[mf] = mfma16(va[st][mf], pb, o[mf]);
    }
    { LAS unsigned char* ot = (LAS unsigned char*)rpl + 4096;
#pragma unroll
      for (int mf = 0; mf < 4; ++mf) { v2u w; w.x = pk2(o[mf][0] * inv, o[mf][1] * inv); w.y = pk2(o[mf][2] * inv, o[mf][3] * inv); *(LAS v2u*)(ot + q * 144 + 32 * mf + 8 * hi) = w; }
      LDS_WAIT(); asm volatile("" ::: "memory");
      const int qr = lane >> 2, ch = lane & 3;
      const v4u t0 = *(const LAS v4u*)(ot + qr * 144 + 32 * ch), t1 = *(const LAS v4u*)(ot + qr * 144 + 32 * ch + 16);
      bf16* yp = yna + (tokq - q + qr) * 1536 + h * 64 + 16 * ch;
      *(v4u*)yp = t0; *(v4u*)(yp + 8) = t1;
      asm volatile("" ::: "memory"); }
}
__device__ __forceinline__ void xa_fill_lds(const bf16* __restrict__ kmem, const bf16* __restrict__ vtmem, LAS unsigned char* lds, int b, int h, int tid) {
#pragma unroll
    for (int ps = 0; ps < 8; ++ps) { const int id = tid + 512 * ps, key = id >> 4, c = id & 15;
        *(LAS v4u*)(lds + key * 256 + ((c ^ (key & 15)) << 4)) = *(const v4u*)(kmem + ((size_t)b * 256 + key) * 512 + h * 128 + 8 * c); }
#pragma unroll
    for (int ps = 0; ps < 8; ++ps) { const int id = tid + 512 * ps, dim = id >> 5, c = id & 31;
        *(LAS v4u*)(lds + 65536 + dim * 512 + ((c ^ (dim & 15)) << 4)) = *(const v4u*)(vtmem + (size_t)(b * 512 + h * 128 + dim) * 256 + 8 * c); }
}
struct XaQ { bf16x8 qf[4]; };
__device__ __forceinline__ void xa_loadq(XaQ& Q, const bf16* __restrict__ xq, int tok0, int h, int lane) {
    const int q = lane & 15, hi = lane >> 4;
    const bf16* qp = xq + pg8::il4(tok0 + q, h * 128 + 8 * hi, 512);
#pragma unroll
    for (int ks = 0; ks < 4; ++ks) Q.qf[ks] = *(const bf16x8*)(qp + 128 * ks);
}
__device__ __forceinline__ void xa_item(const XaQ& Q, const LAS unsigned char* lds, bf16* __restrict__ yxa, int tok0, int h, int lane) {
    const int q = lane & 15, hi = lane >> 4; const size_t tok = (size_t)tok0 + q;
    bf16x8 qf[4]; float ssq = 0.f;
#pragma unroll
    for (int ks = 0; ks < 4; ++ks) qf[ks] = Q.qf[ks];
#pragma unroll
    for (int ks = 0; ks < 4; ++ks)
#pragma unroll
        for (int j = 0; j < 8; ++j) { const float v = bf1(qf[ks][j]); ssq += v * v; }
    ssq += __shfl_xor(ssq, 16); ssq += __shfl_xor(ssq, 32);
    const float cexp = rsqrtf(ssq * (1.0f / 128.0f) + 1e-6f) * 0.08838834764831845f * 1.4426950408889634f;
    const int kq = 8 * (q >> 2) + (q & 3);
    f32x4 s[16];
#define XA_KLOAD(buf, fp) do { _Pragma("unroll") for (int f2 = 0; f2 < 2; ++f2) { const int f_ = 2 * (fp) + f2, key = 32 * (f_ >> 1) + 4 * (f_ & 1) + kq; const LAS unsigned char* kr = lds + key * 256; \
        _Pragma("unroll") for (int ks = 0; ks < 4; ++ks) buf[f2][ks] = *(const LAS bf16x8*)(kr + (((4 * ks + hi) ^ (key & 15)) << 4)); } } while (0)
    {
        bf16x8 kbA[2][4], kbB[2][4];
        XA_KLOAD(kbA, 0);
#pragma unroll
        for (int fp = 0; fp < 8; fp += 2) {
            XA_KLOAD(kbB, fp + 1); __builtin_amdgcn_sched_barrier(0);
#pragma unroll
            for (int f2 = 0; f2 < 2; ++f2) { f32x4 z = (f32x4){0.f, 0.f, 0.f, 0.f};
#pragma unroll
                for (int ks = 0; ks < 4; ++ks) z = mfma16(kbA[f2][ks], qf[ks], z);
                s[2 * fp + f2] = z; }
            __builtin_amdgcn_sched_barrier(0);
            if (fp + 2 < 8) XA_KLOAD(kbA, fp + 2);
            __builtin_amdgcn_sched_barrier(0);
#pragma unroll
            for (int f2 = 0; f2 < 2; ++f2) { f32x4 z = (f32x4){0.f, 0.f, 0.f, 0.f};
#pragma unroll
                for (int ks = 0; ks < 4; ++ks) z = mfma16(kbB[f2][ks], qf[ks], z);
                s[2 * (fp + 1) + f2] = z; }
            __builtin_amdgcn_sched_barrier(0);
        }
    }
#undef XA_KLOAD
    float mx = -3.0e38f;
#pragma unroll
    for (int f = 0; f < 16; ++f)
#pragma unroll
        for (int g = 0; g < 4; ++g) mx = fmaxf(mx, s[f][g]);
    mx = fmaxf(mx, __shfl_xor(mx, 16)); mx = fmaxf(mx, __shfl_xor(mx, 32));
    float sum = 0.f;
#pragma unroll
    for (int f = 0; f < 16; ++f)
#pragma unroll
        for (int g = 0; g < 4; ++g) { const float p = __builtin_amdgcn_exp2f((s[f][g] - mx) * cexp); s[f][g] = p; sum += p; }
    sum += __shfl_xor(sum, 16); sum += __shfl_xor(sum, 32);
    const float inv = 1.0f / sum;
    f32x4 o[8];
#pragma unroll
    for (int i = 0; i < 8; ++i) o[i] = (f32x4){0.f, 0.f, 0.f, 0.f};
#define XA_VLOAD(buf, st_) do { _Pragma("unroll") for (int mf = 0; mf < 8; ++mf) { const int dim = 16 * mf + q; buf[mf] = *(const LAS bf16x8*)(lds + 65536 + dim * 512 + (((4 * (st_) + hi) ^ (dim & 15)) << 4)); } } while (0)
    {
        bf16x8 vbA[8], vbB[8];
        XA_VLOAD(vbA, 0);
#pragma unroll
        for (int st = 0; st < 8; st += 2) {
            XA_VLOAD(vbB, st + 1); __builtin_amdgcn_sched_barrier(0);
            { const bf16x8 pb = __builtin_bit_cast(bf16x8, pg8::pack8(s[2 * st], s[2 * st + 1]));
#pragma unroll
              for (int mf = 0; mf < 8; ++mf) o[mf] = mfma16(vbA[mf], pb, o[mf]); }
            __builtin_amdgcn_sched_barrier(0);
            if (st + 2 < 8) XA_VLOAD(vbA, st + 2);
            __builtin_amdgcn_sched_barrier(0);
            { const bf16x8 pb = __builtin_bit_cast(bf16x8, pg8::pack8(s[2 * st + 2], s[2 * st + 3]));
#pragma unroll
              for (int mf = 0; mf < 8; ++mf) o[mf] = mfma16(vbB[mf], pb, o[mf]); }
            __builtin_amdgcn_sched_barrier(0);
        }
    }
#undef XA_VLOAD
    bf16* yp = yxa + tok * 1536 + h * 128 + 4 * hi;
#pragma unroll
    for (int mf = 0; mf < 8; ++mf) { v2u w; w.x = pk2(o[mf][0] * inv, o[mf][1] * inv); w.y = pk2(o[mf][2] * inv, o[mf][3] * inv); *(v2u*)(yp + 16 * mf) = w; }
}
__device__ __forceinline__ void pool_wg(const bf16* __restrict__ pp, const bf16* __restrict__ pwT, bf16* __restrict__ ypool, LAS unsigned char* lds, int tokbase, int wave, int lane) {
    const int q = lane & 15, hi = lane >> 4;
    __syncthreads();
    {
        const int hw = 1 << hi, tw0 = tokbase + 16 * wave, b = tw0 >> 13, t0 = tw0 & 8191;
        const bf16* base = pp + (size_t)b * SEQ * 512 + 8 * lane;
        float s[8];
#pragma unroll
        for (int j = 0; j < 8; ++j) s[j] = 0.f;
        { bf16x8 wv[16];
#pragma unroll
          for (int d = -8; d < 8; ++d) { const int u = t0 + d; const bool ok = (d >= -hw) && (d < hw) && (u >= 0) && (u < SEQ); wv[d + 8] = *(const bf16x8*)(base + (size_t)(ok ? u : t0) * 512); }
          __builtin_amdgcn_sched_barrier(0);
#pragma unroll
          for (int d = -8; d < 8; ++d) { const int u = t0 + d; const bool ok = (d >= -hw) && (d < hw) && (u >= 0) && (u < SEQ);
#pragma unroll
              for (int j = 0; j < 8; ++j) s[j] += ok ? bf1(wv[d + 8][j]) : 0.f; } }
        LAS unsigned char* tile = lds + wave * 16384;
#pragma unroll
        for (int i8 = 0; i8 < 16; i8 += 8) {
        bf16x8 svv[8], avv[8], bvv[8];
#pragma unroll
        for (int ii = 0; ii < 8; ++ii) { const int t = t0 + i8 + ii; const bool oka = (t + hw) < SEQ, oks = (t - hw) >= 0;
            svv[ii] = *(const bf16x8*)(base + (size_t)t * 512); avv[ii] = *(const bf16x8*)(base + (size_t)(oka ? t + hw : t) * 512); bvv[ii] = *(const bf16x8*)(base + (size_t)(oks ? t - hw : t) * 512); }
        __builtin_amdgcn_sched_barrier(0);
#pragma unroll
        for (int ii = 0; ii < 8; ++ii) { const int i = i8 + ii; const int t = t0 + i;
            int lo = t - hw; lo = lo < 0 ? 0 : lo; int ht = t + hw; ht = ht > SEQ ? SEQ : ht;
            const float inv = 1.0f / (float)(ht - lo);
            const bool oka = (t + hw) < SEQ, oks = (t - hw) >= 0;
            const bf16x8 sv = svv[ii], av = avv[ii], bv = bvv[ii];
            f32x4 p0, p1;
#pragma unroll
            for (int j = 0; j < 4; ++j) { p0[j] = s[j] * inv - bf1(sv[j]); p1[j] = s[j + 4] * inv - bf1(sv[j + 4]); }
            *(LAS v4u*)(tile + i * 1024 + ((lane ^ (i & 15)) << 4)) = pg8::pack8(p0, p1);
#pragma unroll
            for (int j = 0; j < 8; ++j) s[j] += (oka ? bf1(av[j]) : 0.f) - (oks ? bf1(bv[j]) : 0.f);
        }
        }
    }
    __syncthreads();
    bf16x8 aw4[4][4];
#pragma unroll
    for (int k = 0; k < 4; ++k) { const int pair = wave * 4 + k, g = pair >> 3, mf = pair & 7; const bf16* wb = pwT + pg8::il4(g * 128 + 16 * mf + q, 8 * hi, 128);
#pragma unroll
        for (int ks = 0; ks < 4; ++ks) aw4[k][ks] = *(const bf16x8*)(wb + 128 * ks); }
#pragma unroll
    for (int k = 0; k < 4; ++k) {
        const int pair = wave * 4 + k, g = pair >> 3, mf = pair & 7;
        bf16x8 a[4];
#pragma unroll
        for (int ks = 0; ks < 4; ++ks) a[ks] = aw4[k][ks];
#pragma unroll 2
        for (int tg = 0; tg < 8; ++tg) {
            const LAS unsigned char* trow = lds + tg * 16384 + q * 1024; f32x4 o = (f32x4){0.f, 0.f, 0.f, 0.f};
#pragma unroll
            for (int ks = 0; ks < 4; ++ks) { const int c = g * 16 + 4 * ks + hi; o = mfma16(a[ks], *(const LAS bf16x8*)(trow + ((c ^ q) << 4)), o); }
            v2u w; w.x = pk2(o[0], o[1]); w.y = pk2(o[2], o[3]);
            *(v2u*)(ypool + (size_t)(tokbase + 16 * tg + q) * 1536 + g * 128 + 16 * mf + 4 * hi) = w;
        }
    }
    __syncthreads();
}

__device__ __forceinline__ int f2key(float s, int idx, int mask) { int b = __builtin_bit_cast(int, s); b = b >= 0 ? b : (b ^ 0x7fffffff); return (b & ~mask) | idx; }
__device__ __forceinline__ float key2f(int k) { k = k >= 0 ? k : (k ^ 0x7fffffff); return __builtin_bit_cast(float, k); }
#define CE_DESC(x, y) do { const int _h = (x) > (y) ? (x) : (y), _l = (x) > (y) ? (y) : (x); (x) = _h; (y) = _l; } while (0)
__device__ __forceinline__ void sort16(int (&a)[16]) {
#pragma unroll
    for (int ks = 1; ks <= 4; ++ks)
#pragma unroll
        for (int js = ks - 1; js >= 0; --js)
#pragma unroll
            for (int i = 0; i < 16; ++i) { const int k = 1 << ks, j = 1 << js, l = i ^ j;
                if (l > i) { if ((i & k) == 0) CE_DESC(a[i], a[l]); else CE_DESC(a[l], a[i]); } }
}
__device__ __forceinline__ void merge16(int (&a)[16], const int (&b)[16]) {
#pragma unroll
    for (int i = 0; i < 16; ++i) a[i] = a[i] > b[15 - i] ? a[i] : b[15 - i];
#pragma unroll
    for (int js = 3; js >= 0; --js)
#pragma unroll
        for (int i = 0; i < 16; ++i) { const int j = 1 << js, l = i ^ j; if (l > i) CE_DESC(a[i], a[l]); }
}
__device__ __forceinline__ void merge16_lanes(int (&a)[16], int step) { int o[16];
#pragma unroll
    for (int k = 0; k < 16; ++k) o[k] = __shfl_xor(a[k], step);
    merge16(a, o); }
__device__ constexpr int cand_i(int hi, int m) {
    return hi == 0 ? 0
         : hi == 1 ? (m < 8 ? 1 : (m < 13 ? 2 : -1))
         : hi == 2 ? (m < 4 ? 3 : (m < 7 ? 4 : (m < 9 ? 5 : (m < 11 ? 6 : -1))))
         :           (m < 2 ? 7 : (m < 10 ? 8 + (m - 2) : -1));
}
__device__ constexpr int cand_j(int hi, int m) {
    return hi == 0 ? m
         : hi == 1 ? (m < 8 ? m : (m < 13 ? m - 8 : -1))
         : hi == 2 ? (m < 4 ? m : (m < 7 ? m - 4 : (m < 9 ? m - 7 : (m < 11 ? m - 9 : -1))))
         :           (m < 2 ? m : (m < 10 ? 0 : -1));
}
__device__ __forceinline__ void topk_fill_lds(const bf16* __restrict__ keys, LAS unsigned char* lds, int h, int tid) {
#pragma unroll
    for (int ps = 0; ps < 8; ++ps) { const int id = tid + 512 * ps, row = id >> 4, c = id & 15;
        *(LAS v4u*)(lds + row * 256 + ((c ^ (row & 15)) << 4)) = *(const v4u*)(keys + ((size_t)h * 256 + row) * 128 + 8 * c); }
}
struct TopkQ { bf16x8 q[2][4]; };
__device__ __forceinline__ void topk_loadq(TopkQ& Q, const bf16* __restrict__ qb, int tok0, int h, int lane) {
    const int tok = tok0 + (lane & 15); const int hi = lane >> 4;
#pragma unroll
    for (int p = 0; p < 2; ++p)
#pragma unroll
        for (int ks = 0; ks < 4; ++ks) Q.q[p][ks] = *(const bf16x8*)(qb + pg8::il4(tok, h * 256 + p * 128 + 32 * ks + 8 * hi, 2048));
}
__device__ __forceinline__ void topk_item(const TopkQ& Q, const LAS unsigned char* klds, int* __restrict__ te, float* __restrict__ tw, LAS int* lscr, int tok0, int h, int lane) {
    const int q = lane & 15, hi = lane >> 4; const size_t tok = (size_t)tok0 + q;
    int L[2][16];
#pragma unroll
    for (int p = 0; p < 2; ++p) {
        int B[16];
#define TK_KLOAD(buf, mp) do { _Pragma("unroll") for (int m2 = 0; m2 < 2; ++m2) { const int row = p * 128 + 16 * (2 * (mp) + m2) + q; \
        _Pragma("unroll") for (int ks = 0; ks < 4; ++ks) buf[m2][ks] = *(const LAS bf16x8*)(klds + row * 256 + (((4 * ks + hi) ^ (row & 15)) << 4)); } } while (0)
#define TK_MMA(buf, mp) do { _Pragma("unroll") for (int m2 = 0; m2 < 2; ++m2) { const int mf = 2 * (mp) + m2; f32x4 s = (f32x4){0.f, 0.f, 0.f, 0.f}; \
        _Pragma("unroll") for (int ks = 0; ks < 4; ++ks) s = mfma16(buf[m2][ks], Q.q[p][ks], s); \
          \
        _Pragma("unroll") for (int g = 0; g < 4; ++g) { const int key = f2key(s[g], 16 * mf + 4 * hi + g, 127); if (mf < 4) L[p][4 * mf + g] = key; else B[4 * (mf - 4) + g] = key; } } } while (0)
        { bf16x8 tkA[2][4], tkB[2][4];
          TK_KLOAD(tkA, 0);
          TK_KLOAD(tkB, 1); __builtin_amdgcn_sched_barrier(0); TK_MMA(tkA, 0); __builtin_amdgcn_sched_barrier(0);
          TK_KLOAD(tkA, 2); __builtin_amdgcn_sched_barrier(0); TK_MMA(tkB, 1); __builtin_amdgcn_sched_barrier(0);
          TK_KLOAD(tkB, 3); __builtin_amdgcn_sched_barrier(0); TK_MMA(tkA, 2); __builtin_amdgcn_sched_barrier(0);
          TK_MMA(tkB, 3); }
#undef TK_KLOAD
#undef TK_MMA
        sort16(L[p]); sort16(B); merge16(L[p], B);
        merge16_lanes(L[p], 16); merge16_lanes(L[p], 32);
    }
    float v1[16], v2[16];
#pragma unroll
    for (int k = 0; k < 16; ++k) { v1[k] = key2f(L[0][k]); v2[k] = key2f(L[1][k]); }
    int Fk[16];
#pragma unroll
    for (int m = 0; m < 16; ++m) {
        float sm = v1[0] + v2[m]; int id = 255 - m;
        if (cand_i(1, m) >= 0) { if (hi == 1) { sm = v1[cand_i(1, m) < 0 ? 0 : cand_i(1, m)] + v2[cand_j(1, m) < 0 ? 0 : cand_j(1, m)]; id = 255 - ((cand_i(1, m) << 4) | cand_j(1, m)); } }
        if (cand_i(2, m) >= 0) { if (hi == 2) { sm = v1[cand_i(2, m) < 0 ? 0 : cand_i(2, m)] + v2[cand_j(2, m) < 0 ? 0 : cand_j(2, m)]; id = 255 - ((cand_i(2, m) << 4) | cand_j(2, m)); } }
        if (cand_i(3, m) >= 0) { if (hi == 3) { sm = v1[cand_i(3, m) < 0 ? 0 : cand_i(3, m)] + v2[cand_j(3, m) < 0 ? 0 : cand_j(3, m)]; id = 255 - ((cand_i(3, m) << 4) | cand_j(3, m)); } }
        int key = f2key(sm, id, 255);
        if ((hi == 1 && cand_i(1, m) < 0) || (hi == 2 && cand_i(2, m) < 0) || (hi == 3 && cand_i(3, m) < 0)) key = (int)0x80000000;
        Fk[m] = key;
    }
    sort16(Fk); merge16_lanes(Fk, 16); merge16_lanes(Fk, 32);
    LAS int* my = lscr + lane * 32;
#pragma unroll
    for (int k = 0; k < 16; ++k) { my[k] = L[0][k] & 127; my[16 + k] = L[1][k] & 127; }
    LDS_WAIT(); asm volatile("" ::: "memory");
    float e[16]; float sum = 0.f; const float mx = key2f(Fk[0]);
#pragma unroll
    for (int k = 0; k < 16; ++k) { e[k] = __expf(key2f(Fk[k]) - mx); sum += e[k]; }
    const float inv = 1.0f / sum;
    {
        int fk4[4]; float e4[4];
#pragma unroll
        for (int j = 0; j < 4; ++j) { fk4[j] = hi == 0 ? Fk[j] : hi == 1 ? Fk[4 + j] : hi == 2 ? Fk[8 + j] : Fk[12 + j]; e4[j] = hi == 0 ? e[j] : hi == 1 ? e[4 + j] : hi == 2 ? e[8 + j] : e[12 + j]; }
        v4u ids; f32x4 gs;
#pragma unroll
        for (int j = 0; j < 4; ++j) { const int ij = 255 - (fk4[j] & 255), i = ij >> 4, jj = ij & 15; ids[j] = (unsigned)(my[i] * 128 + my[16 + jj]); gs[j] = e4[j] * inv; }
        *(v4u*)(te + tok * 128 + 16 * h + 4 * hi) = ids; *(f32x4*)(tw + tok * 128 + 16 * h + 4 * hi) = gs;
    }
    LDS_WAIT(); asm volatile("" ::: "memory");
}

__device__ __forceinline__ float ub2f(unsigned v, int b) { return (float)((v >> (8 * b)) & 0xffu); }
struct HqIn { v4u hA, hB; float rsq; };
__device__ __forceinline__ void hq_load(HqIn& in, const bf16* __restrict__ hb, const float* __restrict__ rowsq, int tok, int lane) {
    const bf16* hp = hb + (size_t)tok * 1024 + 16 * lane; in.hA = *(const v4u*)hp; in.hB = *(const v4u*)(hp + 8); in.rsq = rowsq[tok]; }
__device__ __forceinline__ void hq_token(const HqIn& in, unsigned char* __restrict__ hq, float* __restrict__ hs, int tok, int lane) {
    const v4u hA = in.hA, hB = in.hB;
    float hf[16];
#pragma unroll
    for (int d = 0; d < 4; ++d) { hf[2 * d] = bflo(hA[d]); hf[2 * d + 1] = bfhi(hA[d]); hf[8 + 2 * d] = bflo(hB[d]); hf[8 + 2 * d + 1] = bfhi(hB[d]); }
    unsigned mb = 0u;
#pragma unroll
    for (int j = 0; j < 16; ++j) { const unsigned b = __builtin_bit_cast(unsigned, hf[j]) & 0x7fffffffu; mb = b > mb ? b : mb; }
    const float amax = wave_absmax(mb);
    const float hinv = amax > 0.f ? 127.0f * __builtin_amdgcn_rcpf(amax) : 0.f;
    v4u w;
#pragma unroll
    for (int d = 0; d < 4; ++d) w[d] = q4_i8(hf[4 * d], hf[4 * d + 1], hf[4 * d + 2], hf[4 * d + 3], hinv);
    *(v4u*)(hq + (size_t)tok * 1024 + 16 * lane) = w;
    if (lane == 0) hs[tok] = rsqrtf(in.rsq * (1.0f / 1024.0f) + 1e-6f) * amax * (1.0f / 127.0f);
}
constexpr int PA_SLOTS = 12;
struct PeerA1 { int e; float g; float su, sv; int cnt, rk; };
struct PeerA2 { v4u ur[3][4]; };
struct PeerAH { v4u hv[4]; float hsc; };
constexpr int PA_BUF = 8192;
__device__ __forceinline__ void pa_dma(const __amdgpu_buffer_rsrc_t wsr, unsigned te_off, unsigned tw_off, unsigned hq_off, LAS unsigned char* buf, int t0, int t1, int t2, int t3, int lane) {
    const int ta = (lane & 32) ? t1 : t0, tb = (lane & 32) ? t3 : t2;
    const unsigned oa = (unsigned)ta * 512u + 16u * (unsigned)(lane & 31), ob = (unsigned)tb * 512u + 16u * (unsigned)(lane & 31);
    __builtin_amdgcn_raw_ptr_buffer_load_lds(wsr, (LAS void*)(buf), 16, (int)(te_off + oa), 0, 0, 0);
    __builtin_amdgcn_raw_ptr_buffer_load_lds(wsr, (LAS void*)(buf + 1024), 16, (int)(te_off + ob), 0, 0, 0);
    __builtin_amdgcn_raw_ptr_buffer_load_lds(wsr, (LAS void*)(buf + 2048), 16, (int)(tw_off + oa), 0, 0, 0);
    __builtin_amdgcn_raw_ptr_buffer_load_lds(wsr, (LAS void*)(buf + 3072), 16, (int)(tw_off + ob), 0, 0, 0);
    const unsigned ol = hq_off + 16u * (unsigned)lane;
    __builtin_amdgcn_raw_ptr_buffer_load_lds(wsr, (LAS void*)(buf + 4096), 16, (int)(ol + (unsigned)t0 * 1024u), 0, 0, 0);
    __builtin_amdgcn_raw_ptr_buffer_load_lds(wsr, (LAS void*)(buf + 5120), 16, (int)(ol + (unsigned)t1 * 1024u), 0, 0, 0);
    __builtin_amdgcn_raw_ptr_buffer_load_lds(wsr, (LAS void*)(buf + 6144), 16, (int)(ol + (unsigned)t2 * 1024u), 0, 0, 0);
    __builtin_amdgcn_raw_ptr_buffer_load_lds(wsr, (LAS void*)(buf + 7168), 16, (int)(ol + (unsigned)t3 * 1024u), 0, 0, 0);
}
__device__ __forceinline__ void pa_s1l(PeerA1& a, const LAS unsigned char* buf, int slot, int half, int lane) {
    const LAS unsigned char* pe = buf + slot * 512 + 256 * half + 4 * lane; a.e = *(const LAS int*)pe; a.g = *(const LAS float*)(pe + 2048); }
__device__ __forceinline__ void pa_hl(PeerAH& h, const LAS unsigned char* buf, int slot, const float* __restrict__ hs, int tok, int lane) {
    const LAS unsigned char* ph = buf + 4096 + slot * 1024 + 16 * (lane & 15);
#pragma unroll
    for (int i = 0; i < 4; ++i) h.hv[i] = *(const LAS v4u*)(ph + 256 * i);
    h.hsc = *(const float*)((const unsigned char*)hs + ((unsigned)tok * 4u + __builtin_amdgcn_mbcnt_lo(0u, 0u))); }
constexpr int PA_TSLOTS = 24;
template <int MODE> __device__ __forceinline__ void pa_front2(unsigned (&offA)[3], unsigned (&offB)[3], PeerA1& a, PeerA1& b, const float* __restrict__ su, LAS int* lst, int x, int lane) {
    typedef float f32x2s __attribute__((ext_vector_type(2)));
    const bool mA = (a.e >> 11) == x, mB = (b.e >> 11) == x;
    const unsigned long long maskA = __ballot(mA), maskB = __ballot(mB);
    const int cntA = __popcll(maskA);
    a.cnt = cntA + __popcll(maskB); b.cnt = a.cnt;
    a.rk = (int)__builtin_amdgcn_mbcnt_hi((unsigned)(maskA >> 32), __builtin_amdgcn_mbcnt_lo((unsigned)maskA, 0u));
    b.rk = cntA + (int)__builtin_amdgcn_mbcnt_hi((unsigned)(maskB >> 32), __builtin_amdgcn_mbcnt_lo((unsigned)maskB, 0u));
    if (mA && a.rk < PA_TSLOTS) lst[a.rk] = a.e;
    if (mB && b.rk < PA_TSLOTS) lst[b.rk] = b.e;
    { const f32x2s s2 = *(const f32x2s*)((const unsigned char*)su + (mA ? (unsigned)a.e * 8u : 0u)); a.su = s2.x; a.sv = s2.y; }
    { const f32x2s s2 = *(const f32x2s*)((const unsigned char*)su + (mB ? (unsigned)b.e * 8u : 0u)); b.su = s2.x; b.sv = s2.y; }
    const int r = lane >> 4, t = lane & 15;
    LDS_WAIT(); asm volatile("" ::: "memory");
    const int lim = a.cnt < PA_TSLOTS ? a.cnt : PA_TSLOTS;
    int esA[3], esB[3];
#pragma unroll
    for (int q = 0; q < 3; ++q) { esA[q] = lst[4 * q + r]; esB[q] = lst[12 + 4 * q + r]; }
#pragma unroll
    for (int q = 0; q < 3; ++q) { int eA = esA[q], eB = esB[q]; if (MODE & 1) { eA = (x << 11) | (eA & 7); eB = (x << 11) | (eB & 7); }
        offA[q] = (4 * q + r) < lim ? (unsigned)eA * 1024u + 16u * (unsigned)t : 0x40000000u; offB[q] = (12 + 4 * q + r) < lim ? (unsigned)eB * 1024u + 16u * (unsigned)t : 0x40000000u; }
}
template <int MODE> __device__ __forceinline__ void pa_gather(PeerA2& b, int q, const unsigned (&off)[3], const __amdgpu_buffer_rsrc_t rs) {
    v4u t[4];
#pragma unroll
    for (int i = 0; i < 4; ++i) asm volatile("" : "=v"(t[i]));
    if ((MODE & 16) || off[q] < 0x40000000u) {
#pragma unroll
        for (int i = 0; i < 4; ++i) { if (MODE & 2) t[i] = (v4u){off[q], off[q] + 1u, off[q] + 2u, off[q] + 3u}; else t[i] = __builtin_bit_cast(v4u, __builtin_amdgcn_raw_buffer_load_b128(rs, (int)(off[q] + 256u * i), 0, 0)); } }
#pragma unroll
    for (int i = 0; i < 4; ++i) b.ur[q][i] = t[i];
}
__device__ __forceinline__ int dot16(const v4u u, const v4u h) { int d = __builtin_amdgcn_sdot4((int)u.x, (int)h.x, 0, false); d = __builtin_amdgcn_sdot4((int)u.y, (int)h.y, d, false);
    d = __builtin_amdgcn_sdot4((int)u.z, (int)h.z, d, false); return __builtin_amdgcn_sdot4((int)u.w, (int)h.w, d, false); }
__device__ __forceinline__ int dot16c(const v4u u, const v4u h, int d) { d = __builtin_amdgcn_sdot4((int)u.x, (int)h.x, d, false); d = __builtin_amdgcn_sdot4((int)u.y, (int)h.y, d, false);
    d = __builtin_amdgcn_sdot4((int)u.z, (int)h.z, d, false); return __builtin_amdgcn_sdot4((int)u.w, (int)h.w, d, false); }
template <int CTRL, int RM> __device__ __forceinline__ int dpp_i(int x) { return __builtin_amdgcn_update_dpp(0, x, CTRL, RM, 0xf, false); }
__device__ __forceinline__ int wave_sum_to63(int x) { x += dpp_i<0xb1, 0xf>(x); x += dpp_i<0x4e, 0xf>(x); x += dpp_i<0x124, 0xf>(x); x += dpp_i<0x128, 0xf>(x); x += dpp_i<0x142, 0xa>(x); x += dpp_i<0x143, 0xc>(x); return x; }
__device__ __forceinline__ int row_sum16(int x) { x += dpp_i<0xb1, 0xf>(x); x += dpp_i<0x4e, 0xf>(x); x += dpp_i<0x124, 0xf>(x); x += dpp_i<0x128, 0xf>(x); return x; }
__device__ __forceinline__ float gelu_erf(float v) {
    const float av = fabsf(v), t = __builtin_amdgcn_rcpf(av * 0.2316418882f + 1.0f);
    float q = t * 0.5307027145f + (-0.7265760135f); q = q * t + 0.7107068705f; q = q * t + (-0.142248368f); q = q * t + 0.127414796f; q = q * t;
    const float e = __builtin_amdgcn_exp2f((v * v) * (-0.72134752044f)), m = v * (q * e);
    return v < 0.f ? m : v - m; }
template <int MODE> __device__ __forceinline__ void pa_dots(int (&d)[3], PeerA2& b, const unsigned (&off2)[3], const __amdgpu_buffer_rsrc_t rs, const PeerAH& h) {
    if (MODE & 8) { d[0] = (int)(b.ur[0][0].x ^ h.hv[0].x); d[1] = (int)b.ur[1][1].y; d[2] = (int)b.ur[2][2].z;
#pragma unroll
        for (int q = 0; q < 3; ++q) pa_gather<MODE>(b, q, off2, rs);
        return; }
#pragma unroll
    for (int q = 0; q < 3; ++q) { d[q] = dot16c(b.ur[q][1], h.hv[1], dot16(b.ur[q][0], h.hv[0])) + dot16c(b.ur[q][3], h.hv[3], dot16(b.ur[q][2], h.hv[2]));
        if (MODE & 32) { int d2 = d[q]; asm volatile("" : "+v"(d2)); v4u hx = h.hv[0]; asm volatile("" : "+v"(hx)); d[q] = dot16c(b.ur[q][1], h.hv[1], dot16(b.ur[q][0], hx)) + dot16c(b.ur[q][3], h.hv[3], dot16(b.ur[q][2], h.hv[2])) + (d2 & 1); }
        asm volatile("" : "+v"(d[q]) : : "memory");
        pa_gather<MODE>(b, q, off2, rs); }
}
template <int MODE> __device__ __forceinline__ void pa_epi2(int (&dA)[3], int (&dB)[3], const PeerA1& a, const PeerA1& b, const PeerAH& h, const unsigned char* __restrict__ u8, const unsigned char* __restrict__ hq,
                                                           float* __restrict__ aw, int tok, int x, int lane) {
    int mineA = 0, mineB = 0;
    if (MODE & 8) { mineA = dA[0] ^ dA[1] ^ dA[2]; mineB = dB[0] ^ dB[1] ^ dB[2]; } else {
        if (!(MODE & 2048)) {
#pragma unroll
        for (int q = 0; q < 3; ++q) { dA[q] += dpp_i<0xb1, 0xf>(dA[q]); dB[q] += dpp_i<0xb1, 0xf>(dB[q]); }
#pragma unroll
        for (int q = 0; q < 3; ++q) { dA[q] += dpp_i<0x4e, 0xf>(dA[q]); dB[q] += dpp_i<0x4e, 0xf>(dB[q]); }
#pragma unroll
        for (int q = 0; q < 3; ++q) { dA[q] += dpp_i<0x124, 0xf>(dA[q]); dB[q] += dpp_i<0x124, 0xf>(dB[q]); }
#pragma unroll
        for (int q = 0; q < 3; ++q) { dA[q] += dpp_i<0x128, 0xf>(dA[q]); dB[q] += dpp_i<0x128, 0xf>(dB[q]); }
        }
        const int t = lane & 15;
        const int keep = t == 0 ? dA[0] : t == 1 ? dA[1] : t == 2 ? dA[2] : t == 3 ? dB[0] : t == 4 ? dB[1] : dB[2];
        if (MODE & 1024) { mineA = keep + a.rk; mineB = keep ^ b.rk; } else {
        mineA = __builtin_amdgcn_ds_bpermute(64 * (a.rk & 3) + 4 * (a.rk >> 2), keep); mineB = __builtin_amdgcn_ds_bpermute(64 * (b.rk & 3) + 4 * (b.rk >> 2), keep); }
    }
    const float valA = (MODE & 512) ? a.g * ((float)mineA * h.hsc * a.su) * a.sv : a.g * gelu_erf((float)mineA * h.hsc * a.su) * a.sv, valB = (MODE & 512) ? b.g * ((float)mineB * h.hsc * b.su) * b.sv : b.g * gelu_erf((float)mineB * h.hsc * b.su) * b.sv;
    float* awpA = (float*)((unsigned char*)aw + ((unsigned)tok * 128u + (unsigned)lane) * 4u); float* awpB = awpA + 64;
    const bool amA = (a.e >> 11) == x, amB = (b.e >> 11) == x;
    if (MODE & 256) { if (valA + valB == 12345.678f) *awpA = valA; } else {
    if (amA && a.rk < PA_TSLOTS) *awpA = valA;
    if (amB && b.rk < PA_TSLOTS) *awpB = valB; }
    if (!(MODE & 4) && __builtin_expect(a.cnt > PA_TSLOTS, 0)) {
        const v4u hw = *(const v4u*)(hq + ((unsigned)tok * 1024u + 16u * (unsigned)lane));
#pragma unroll
        for (int hf = 0; hf < 2; ++hf) { const PeerA1& c = hf ? b : a; float* awp = hf ? awpB : awpA;
            unsigned long long rem = __ballot((hf ? amB : amA) && c.rk >= PA_TSLOTS);
            while (rem != 0ull) { const int idx = __builtin_ctzll(rem); rem &= rem - 1ull; const int e = __builtin_amdgcn_readlane(c.e, idx);
                const int d = __builtin_amdgcn_readlane(wave_sum_to63(dot16(*(const v4u*)(u8 + ((unsigned)e * 1024u + 16u * (unsigned)lane)), hw)), 63);
                if (lane == idx) *awp = c.g * gelu_erf((float)d * h.hsc * c.su) * c.sv; } }
    }
}
template <int MODE> __device__ __forceinline__ void peer_a_run(const unsigned char* wsbase, unsigned te_off, unsigned tw_off, unsigned hq_off, const float* __restrict__ hs, const unsigned char* __restrict__ u8,
                                           const float* __restrict__ su, float* __restrict__ aw, LAS unsigned char* wl, LAS int* lst, int wrank, int wstep, int x, int lane) {
    const int ntok = wrank < T ? (T - wrank + wstep - 1) / wstep : 0, N = 2 * ntok;
    if (N == 0) return;
    const int tlast = wrank + (ntok - 1) * wstep;
    const unsigned char* const hq = wsbase + hq_off;
#define PA_TOKI(m) ((MODE & 4) ? wrank : min(wrank + (m) * wstep, tlast))
#define PA_TOK(n) PA_TOKI((n) >> 1)
#define PA_DMA(b) pa_dma(wsr, te_off, tw_off, hq_off, wl + ((b) & 1) * PA_BUF, PA_TOKI(4 * (b)), PA_TOKI(4 * (b) + 1), PA_TOKI(4 * (b) + 2), PA_TOKI(4 * (b) + 3), lane)
    PeerA1 a0, a1, a2, a3; PeerA2 bA, bB; PeerAH h; unsigned off[3];
    const __amdgpu_buffer_rsrc_t rs = __builtin_amdgcn_make_buffer_rsrc((void*)u8, (short)0, (int)(16u << 20), 0x00020000);
    const __amdgpu_buffer_rsrc_t wsr = __builtin_amdgcn_make_buffer_rsrc((void*)wsbase, (short)0, (int)(WS_END), 0x00020000);
    PA_DMA(0); PA_DMA(1);
    VM_WAIT(); asm volatile("" ::: "memory");
    unsigned offB[3];
    pa_s1l(a0, wl, 0, 0, lane); pa_s1l(a1, wl, 0, 1, lane); pa_s1l(a2, wl, 1, 0, lane); pa_s1l(a3, wl, 1, 1, lane);
    pa_front2<MODE>(off, offB, a0, a1, su, lst, x, lane);
#pragma unroll
    for (int q = 0; q < 3; ++q) { pa_gather<MODE>(bA, q, off, rs); pa_gather<MODE>(bB, q, offB, rs); }
#define PA_STEP(p, Ac0, Ac1, An0, An1, NBUF, NSLOT) do { int dA[3], dB[3]; \
        pa_hl(h, cur, (p), hs, PA_TOKI(4 * b + (p)), lane); \
        if ((p) == 3) { LDS_WAIT(); asm volatile("" ::: "memory"); PA_DMA(b + 2); } \
        pa_front2<MODE>(off, offB, An0, An1, su, lst, x, lane); \
        if (MODE & 64) { asm volatile("" ::: "memory"); pa_front2<MODE>(off, offB, An0, An1, su, lst, x, lane); } \
        asm volatile("" :: "v"(h.hsc), "v"(Ac0.su), "v"(Ac0.sv), "v"(Ac1.su), "v"(Ac1.sv));     \
        pa_dots<MODE>(dA, bA, off, rs, h); pa_dots<MODE>(dB, bB, offB, rs, h); \
        if (MODE & 128) { int eA[3] = {dA[0], dA[1], dA[2]}, eB[3] = {dB[0], dB[1], dB[2]}; pa_epi2<MODE>(eA, eB, Ac0, Ac1, h, u8, hq, aw, PA_TOKI(4 * b + (p)), x, lane); asm volatile("" ::: "memory"); } \
        pa_epi2<MODE>(dA, dB, Ac0, Ac1, h, u8, hq, aw, PA_TOKI(4 * b + (p)), x, lane); \
        pa_s1l(Ac0, NBUF, NSLOT, 0, lane); pa_s1l(Ac1, NBUF, NSLOT, 1, lane); } while (0)
    for (int b = 0; 8 * b < N; ++b) {
        LAS unsigned char* const cur = wl + (b & 1) * PA_BUF; LAS unsigned char* const nxt = wl + ((b + 1) & 1) * PA_BUF;
        PA_STEP(0, a0, a1, a2, a3, cur, 2);
        PA_STEP(1, a2, a3, a0, a1, cur, 3);
        PA_STEP(2, a0, a1, a2, a3, nxt, 0);
        PA_STEP(3, a2, a3, a0, a1, nxt, 1);
    }
#undef PA_STEP
#undef PA_DMA
#undef PA_TOK
#undef PA_TOKI
}
struct PeerB1 { v4u e[4]; f32x4 w[4]; unsigned h2; };
struct PeerB2 { v4u vr[8]; };
struct PeerBAcc { int acc[16]; int wq[4]; float wsc, h0, h1; };
typedef float f32x2v __attribute__((ext_vector_type(2)));
__device__ __forceinline__ void pb_s1(PeerB1& a, const int* __restrict__ te, const float* __restrict__ aw, int tok, int lane) {
    const unsigned o_ = (unsigned)tok * 128u + 16u * ((unsigned)lane >> 3);
    const v4u* ep = (const v4u*)(te + o_); const f32x4* wp = (const f32x4*)(aw + o_);
#pragma unroll
    for (int j = 0; j < 4; ++j) { a.e[j] = ep[j]; a.w[j] = wp[j]; } }
__device__ __forceinline__ int pb_col(int lane) { return 16 * (lane & 7) + 8 * ((lane >> 5) & 1) + 4 * ((lane >> 4) & 1) + 2 * ((lane >> 3) & 1); }
template <int CTRL, int RM> __device__ __forceinline__ float dpp_f(float x) { return __builtin_bit_cast(float, __builtin_amdgcn_update_dpp(0, __builtin_bit_cast(int, x), CTRL, RM, 0xf, false)); }
template <int CTRL, int RM> __device__ __forceinline__ unsigned dpp_umax(unsigned x) { const unsigned y = (unsigned)__builtin_amdgcn_update_dpp((int)x, (int)x, CTRL, RM, 0xf, false); return y > x ? y : x; }
__device__ __forceinline__ void pb_quant(PeerBAcc& A, const PeerB1& a) {
    unsigned mb = 0u;
#pragma unroll
    for (int j = 0; j < 4; ++j)
#pragma unroll
        for (int d = 0; d < 4; ++d) { const float f = a.w[j][d]; const unsigned b = __builtin_bit_cast(unsigned, f) & 0x7fffffffu; mb = b > mb ? b : mb; }
    mb = dpp_umax<0xb1, 0xf>(mb); mb = dpp_umax<0x4e, 0xf>(mb); mb = dpp_umax<0x124, 0xf>(mb); mb = dpp_umax<0x128, 0xf>(mb);
    mb = dpp_umax<0x142, 0xa>(mb); mb = dpp_umax<0x143, 0xc>(mb);
    const float mx = __builtin_bit_cast(float, __builtin_amdgcn_readlane((int)mb, 63));
    const float inv = mx > 0.f ? 127.0f * __builtin_amdgcn_rcpf(mx) : 0.f; A.wsc = mx * (1.0f / 127.0f);
#pragma unroll
    for (int j = 0; j < 4; ++j) { const unsigned q0 = __builtin_bit_cast(unsigned, a.w[j][0] * inv + 12582912.0f), q1 = __builtin_bit_cast(unsigned, a.w[j][1] * inv + 12582912.0f),
                                                 q2 = __builtin_bit_cast(unsigned, a.w[j][2] * inv + 12582912.0f), q3 = __builtin_bit_cast(unsigned, a.w[j][3] * inv + 12582912.0f);
        const unsigned lo = __builtin_amdgcn_perm(q1, q0, 0x0c0c0400u), hi = __builtin_amdgcn_perm(q3, q2, 0x04000c0cu);
        A.wq[j] = (int)(lo | hi); }
}
template <int HF, int MODE> __device__ __forceinline__ void pb_s2(PeerB2& b, const PeerB1& a, const unsigned char* __restrict__ v8x, int lane) {
    const int c = lane & 7;
#pragma unroll
    for (int m = 0; m < 8; ++m) { unsigned e = a.e[2 * HF + (m >> 2)][m & 3]; if (MODE & 1) e &= 255u;
        if (MODE & 2) b.vr[m] = (v4u){e, e + 1u, e + 2u, e + 3u}; else b.vr[m] = *(const v4u*)(v8x + (e * 128u + 16u * (unsigned)c)); }
}
__device__ __forceinline__ float swap32_add(float lo, float hi) { const auto r = __builtin_amdgcn_permlane32_swap(__builtin_bit_cast(unsigned, lo), __builtin_bit_cast(unsigned, hi), false, false);
    return __builtin_bit_cast(float, r[0]) + __builtin_bit_cast(float, r[1]); }
__device__ __forceinline__ float swap16_add(float lo, float hi) { const auto r = __builtin_amdgcn_permlane16_swap(__builtin_bit_cast(unsigned, lo), __builtin_bit_cast(unsigned, hi), false, false);
    return __builtin_bit_cast(float, r[0]) + __builtin_bit_cast(float, r[1]); }
template <int HF, int MODE> __device__ __forceinline__ void pb_s3(PeerBAcc& A, const PeerB2& b, const PeerB1& a, float* out, int tok, int x, int lane) {
    if (MODE & 8) { if (HF == 0) { A.acc[0] = 0; }
#pragma unroll
        for (int m = 0; m < 8; ++m) A.acc[0] += (int)(b.vr[m].x ^ b.vr[m].y ^ b.vr[m].z ^ b.vr[m].w);
        if (HF == 1) { f32x2v h2; h2.x = A.h0 + (float)A.acc[0]; h2.y = A.h1 + A.wsc; *(f32x2v*)(out + ((unsigned)tok * 1024u + 128u * (unsigned)x + (unsigned)pb_col(lane))) = h2; }
        return; }
    if (HF == 0) {
#pragma unroll
        for (int j = 0; j < 16; ++j) A.acc[j] = 0;
    }
#pragma unroll
    for (int gg = 0; gg < 2; ++gg)
#pragma unroll
        for (int d = 0; d < 4; ++d) { const unsigned ra = b.vr[4 * gg][d], rb = b.vr[4 * gg + 1][d], rc = b.vr[4 * gg + 2][d], rd = b.vr[4 * gg + 3][d];
            const unsigned t0 = __builtin_amdgcn_perm(rb, ra, 0x05010400u), t1 = __builtin_amdgcn_perm(rb, ra, 0x07030602u), t2 = __builtin_amdgcn_perm(rd, rc, 0x05010400u), t3 = __builtin_amdgcn_perm(rd, rc, 0x07030602u);
            const unsigned c0 = __builtin_amdgcn_perm(t2, t0, 0x05040100u), c1 = __builtin_amdgcn_perm(t2, t0, 0x07060302u), c2 = __builtin_amdgcn_perm(t3, t1, 0x05040100u), c3 = __builtin_amdgcn_perm(t3, t1, 0x07060302u);
            const int w4 = A.wq[2 * HF + gg];
            A.acc[4 * d] = __builtin_amdgcn_sdot4((int)c0, w4, A.acc[4 * d], false); A.acc[4 * d + 1] = __builtin_amdgcn_sdot4((int)c1, w4, A.acc[4 * d + 1], false);
            A.acc[4 * d + 2] = __builtin_amdgcn_sdot4((int)c2, w4, A.acc[4 * d + 2], false); A.acc[4 * d + 3] = __builtin_amdgcn_sdot4((int)c3, w4, A.acc[4 * d + 3], false); }
    if (HF == 1) {
        int r8[8], r4[4], r2[2];
#pragma unroll
        for (int j = 0; j < 8; ++j) { const bool up = (lane & 32) != 0; const int keep = up ? A.acc[j + 8] : A.acc[j], send = up ? A.acc[j] : A.acc[j + 8]; r8[j] = keep + __shfl_xor(send, 32); }
#pragma unroll
        for (int j = 0; j < 4; ++j) { const bool up = (lane & 16) != 0; const int keep = up ? r8[j + 4] : r8[j], send = up ? r8[j] : r8[j + 4]; r4[j] = keep + __shfl_xor(send, 16); }
#pragma unroll
        for (int j = 0; j < 2; ++j) { const bool up = (lane & 8) != 0; const int keep = up ? r4[j + 2] : r4[j], send = up ? r4[j] : r4[j + 2];
            r2[j] = keep + __builtin_amdgcn_update_dpp(0, send, 0x128, 0xf, 0xf, false); }
        f32x2v h2; h2.x = A.h0 + A.wsc * (float)r2[0]; h2.y = A.h1 + A.wsc * (float)r2[1];
        *(f32x2v*)(out + ((unsigned)tok * 1024u + 128u * (unsigned)x + (unsigned)pb_col(lane))) = h2;
    }
}
constexpr int PB_BATCH = 4, PB_BUF = 5120;
__device__ __forceinline__ void pb_dma(const __amdgpu_buffer_rsrc_t wsr, unsigned te_off, unsigned aw_off, unsigned hb_off, LAS unsigned char* buf, int t0, int t1, int t2, int t3, int x, int lane) {
    const int ta = (lane & 32) ? t1 : t0, tb = (lane & 32) ? t3 : t2;
    const unsigned oa = (unsigned)ta * 512u + 16u * (unsigned)(lane & 31), ob = (unsigned)tb * 512u + 16u * (unsigned)(lane & 31);
    __builtin_amdgcn_raw_ptr_buffer_load_lds(wsr, (LAS void*)(buf), 16, (int)(te_off + oa), 0, 0, 0);
    __builtin_amdgcn_raw_ptr_buffer_load_lds(wsr, (LAS void*)(buf + 1024), 16, (int)(te_off + ob), 0, 0, 0);
    __builtin_amdgcn_raw_ptr_buffer_load_lds(wsr, (LAS void*)(buf + 2048), 16, (int)(aw_off + oa), 0, 0, 0);
    __builtin_amdgcn_raw_ptr_buffer_load_lds(wsr, (LAS void*)(buf + 3072), 16, (int)(aw_off + ob), 0, 0, 0);
    const int q = lane >> 4, th = q == 0 ? t0 : q == 1 ? t1 : q == 2 ? t2 : t3;
    __builtin_amdgcn_raw_ptr_buffer_load_lds(wsr, (LAS void*)(buf + 4096), 16, (int)(hb_off + (unsigned)th * 2048u + 256u * (unsigned)x + 16u * (unsigned)(lane & 15)), 0, 0, 0);
}
__device__ __forceinline__ void pb_s1l(PeerB1& a, const LAS unsigned char* buf, int j, int lane) {
    const LAS unsigned char* pe = buf + j * 512 + 64 * (lane >> 3);
#pragma unroll
    for (int m = 0; m < 4; ++m) { a.e[m] = *(const LAS v4u*)(pe + 16 * m); a.w[m] = *(const LAS f32x4*)(pe + 2048 + 16 * m); }
    a.h2 = *(const LAS unsigned*)(buf + 4096 + j * 256 + 2 * pb_col(lane));
}
template <int MODE> __device__ __forceinline__ void peer_b_run(const unsigned char* __restrict__ v8x, const unsigned char* wsbase, unsigned te_off, unsigned aw_off, unsigned hb_off, float* out, LAS unsigned char* wl, int wrank, int wstep, int x, int lane) {
    const int N = wrank < T ? (T - wrank + wstep - 1) / wstep : 0;
    if (N == 0) return;
    const int tlast = wrank + (N - 1) * wstep;
#define PB_TOK(n) min(wrank + (n) * wstep, tlast)
#define PB_STOK(n) ((MODE & 4) ? wrank : PB_TOK(n))
#define PB_DMA(k) pb_dma(wsr, te_off, aw_off, hb_off, wl + ((k) & 1) * PB_BUF, PB_STOK(4 * (k)), PB_STOK(4 * (k) + 1), PB_STOK(4 * (k) + 2), PB_STOK(4 * (k) + 3), x, lane)
    PeerB1 sA, sB; PeerB2 bA, bB; PeerBAcc A;
    const __amdgpu_buffer_rsrc_t wsr = __builtin_amdgcn_make_buffer_rsrc((void*)wsbase, (short)0, (int)(WS_END), 0x00020000);
    PB_DMA(0); PB_DMA(1);
    VM_WAIT(); asm volatile("" ::: "memory");
    pb_s1l(sA, wl, 0, lane);
    pb_s2<0, MODE>(bA, sA, v8x, lane);
#define PB_TOKEN(n, Scur, Snext) do { \
        pb_s2<1, MODE>(bB, Scur, v8x, lane); __builtin_amdgcn_sched_barrier(0); A.h0 = bflo(Scur.h2); A.h1 = bfhi(Scur.h2); pb_quant(A, Scur); \
        pb_s3<0, MODE>(A, bA, Scur, out, PB_TOK(n), x, lane); \
        pb_s2<0, MODE>(bA, Snext, v8x, lane); __builtin_amdgcn_sched_barrier(0); \
        pb_s3<1, MODE>(A, bB, Scur, out, PB_TOK(n), x, lane); } while (0)
    for (int k = 0; 4 * k < N; ++k) {
        LAS unsigned char* const cur = wl + (k & 1) * PB_BUF; LAS unsigned char* const nxt = wl + ((k + 1) & 1) * PB_BUF;
        pb_s1l(sB, cur, 1, lane); PB_TOKEN(4 * k, sA, sB);
        pb_s1l(sA, cur, 2, lane); PB_TOKEN(4 * k + 1, sB, sA);
        pb_s1l(sB, cur, 3, lane); PB_TOKEN(4 * k + 2, sA, sB);
        pb_s1l(sA, nxt, 0, lane);
        LDS_WAIT(); asm volatile("" ::: "memory");
        PB_DMA(k + 2);
        PB_TOKEN(4 * k + 3, sB, sA);
    }
#undef PB_TOKEN
#undef PB_DMA
#undef PB_STOK
#undef PB_TOK
}

__global__ void __launch_bounds__(NWAVES * 64, 2) mk_fwd(Args args) {
    extern __shared__ __attribute__((aligned(16))) unsigned char lds[];
    Frame F;
    F.lds = (LAS unsigned char*)lds;
    F.MISC = (volatile LAS unsigned*)(F.lds + MISC_OFF);
    F.tid = threadIdx.x; F.lane = F.tid & 63; F.wave = __builtin_amdgcn_readfirstlane(F.tid >> 6);
    F.G = gridDim.x; { const int bx = blockIdx.x; F.vcu = (F.G % 8 == 0) ? (bx % 8) * (F.G / 8) + bx / 8 : bx; }
    F.out = nullptr; F.ws = args.ws;
    unsigned char* ws = args.ws;
    F.ctl = (gu32*)(ws + WS_CTL);
    for (int u = F.tid; u < (LDS_BYTES - LDSCTL_OFF) / 4; u += NWAVES * 64) ((LAS unsigned*)(F.lds + LDSCTL_OFF))[u] = 0u;
    __syncthreads();
    XcdBarrier bar; bar.bar = (unsigned*)(F.ctl + CW_BAR); bar.x = 0; bar.st = nullptr;
    if (N_LAUNCHES != PER_PHASE) bar = xcd_barrier_post((unsigned*)(F.ctl + CW_BAR), F.MISC + 8);
    if (N_LAUNCHES != PER_PHASE) { if (F.tid == 0) { const unsigned xid = xb_xcc_id(); F.MISC[12] = xid; F.MISC[13] = xb_add((unsigned*)(F.ctl + CW_TICKET) + 64 * xid, 1u); } __syncthreads(); }
#define REFRESH_TID() do { int l_; asm volatile("v_mbcnt_lo_u32_b32 %0, -1, 0\n\tv_mbcnt_hi_u32_b32 %0, -1, %0" : "=v"(l_)); F.lane = l_; F.tid = (F.wave << 6) | l_; } while (0)
#define GRID_BAR() do { if (N_LAUNCHES != PER_PHASE) { REFRESH_TID(); xcd_barrier(bar, F.tid == 0); } } while (0)
    const int lo = args.ph_lo, hi = args.ph_hi;
#define IN(k) (lo <= (k) && (k) < hi)
#define BOTH(k) (IN(k) && IN((k) + 1))
    const int gw = F.vcu * NWAVES + F.wave, NGW = F.G * NWAVES;
#define WinT ((bf16*)(ws + WS_WIN))
#define WvT ((bf16*)(ws + WS_WV))
#define WkvT ((bf16*)(ws + WS_WKV))
#define WbrT ((bf16*)(ws + WS_WBR))
#define WoutT ((bf16*)(ws + WS_WOUT))
#define WqT ((bf16*)(ws + WS_WQ))
#define KEYS ((bf16*)(ws + WS_KEYS))
#define PWT ((bf16*)(ws + WS_PWT))
#define MEMN ((bf16*)(ws + WS_MEMN))
#define KMEM ((bf16*)(ws + WS_KMEM))
#define VTMEM ((bf16*)(ws + WS_VTMEM))
#define RSTDX ((float*)(ws + WS_RSTDX))
#define U8 ((const unsigned char*)(ws + WS_U8))
#define V8 ((const unsigned char*)(ws + WS_V8))
#define SU ((const float*)(ws + WS_SU))
#define SV ((const float*)(ws + WS_SV))
#define QN ((bf16*)(ws + WS_QN))
#define KN ((bf16*)(ws + WS_KN))
#define VT ((bf16*)(ws + WS_VT))
#define PP ((bf16*)(ws + WS_PP))
#define XQ ((bf16*)(ws + WS_XQ))
#define GATE ((bf16*)(ws + WS_GATE))
#define MERGED ((bf16*)(ws + WS_MERGED))
#define HB ((bf16*)(ws + WS_HB))
#define QB ((bf16*)(ws + WS_QB))
#define TE ((int*)(ws + WS_TE))
#define TW ((float*)(ws + WS_TW))
#define AW ((float*)(ws + WS_AW))
#define ROWSQ ((float*)(ws + WS_ROWSQ))
#define RELOAD_OUT(p) do { GAS unsigned char* p_; asm volatile("s_load_dwordx2 %0, %1, 0xb8\n\ts_waitcnt lgkmcnt(0)" : "=s"(p_) : "s"(__builtin_amdgcn_kernarg_segment_ptr()) : "memory"); p = (unsigned char*)p_; } while (0)
#define RELOAD_WS() GAS unsigned char* ws_; asm volatile("s_load_dwordx2 %0, %1, 0xc0\n\ts_waitcnt lgkmcnt(0)" : "=s"(ws_) : "s"(__builtin_amdgcn_kernarg_segment_ptr()) : "memory"); unsigned char* const ws = (unsigned char*)ws_; REFRESH_TID()
#define XB ((bf16*)(ws + WS_XB))
#define YNA ((bf16*)(outp + OUT_YNA))
#define YPOOL ((bf16*)(outp + OUT_YPOOL))
#define YXA ((bf16*)(outp + OUT_YXA))

#ifndef STAGGER_SLEEPS
#define STAGGER_SLEEPS 1
#endif
#define STAGGER() do { const int q_ = __builtin_amdgcn_readfirstlane((int)((blockIdx.x >> 3) & 3u) * STAGGER_SLEEPS); for (int i_ = 0; i_ < q_; ++i_) __builtin_amdgcn_s_sleep(127); } while (0)
    if (IN(0)) { unsigned char* outp; RELOAD_OUT(outp); F.out = (float*)outp; p0_prologue(F, args); F.out = nullptr; if (BOTH(0)) GRID_BAR(); }
    if (IN(1)) STAGGER();

    if (IN(1)) { RELOAD_WS();
      { unsigned char* outp; RELOAD_OUT(outp);
        { pg8::Sched1 S; S.so.init(T, IN_MAIN, F.G, (int)blockIdx.x); S.A = (const char*)XB; S.Bt = (const char*)WinT; S.tstep = (size_t)256 * 1024 * 2;
          pg8::EpiProj E{RSTDX, QN, KN, PP, XQ, GATE, args.in[I_NAQG], args.in[I_NAKG], args.in[I_GATEB], (args.probe & 1)};
          pg8::gemm_phase<pg8::EpiProj, pg8::Sched1, true, true>(F.lds + RING_OFF, 1024, S, E, F.wave, F.lane); REFRESH_TID(); }
        if (!(args.probe & 4)) { pg8::Sched1 S; S.so.init(512, T, F.G, (int)blockIdx.x); S.A = (const char*)WvT; S.Bt = (const char*)XB; S.tstep = (size_t)256 * 1024 * 2;
          pg8::EpiVt E{RSTDX, VT};
          pg8::gemm_phase<pg8::EpiVt, pg8::Sched1, false, true>(F.lds + RING_OFF, 1024, S, E, F.wave, F.lane); REFRESH_TID(); }
        if (!(args.probe & 2)) {
            __syncthreads();
            for (int j = F.vcu; j < 256; j += F.G) memkv_tile(MEMN, WkvT, args.in[I_XAKG], args.in[I_XAQG], KMEM, VTMEM, (LAS float*)(F.lds + RING_OFF) + (F.wave >> 2) * 6144, 2 * j + (F.wave >> 2), F.wave & 3, F.lane);
            __syncthreads(); }
      }
        if (BOTH(1)) GRID_BAR();
    }

    if (IN(2)) { RELOAD_WS();
      { unsigned char* outp; RELOAD_OUT(outp);
        LAS float* rpl = (LAS float*)(F.lds + RING_OFF + F.wave * 16384);
        for (int i = F.lane; i < 15 * 31; i += 64) rpl[i] = args.in[I_RPB][F.wave * 15 * 31 + i];
        LDS_WAIT(); asm volatile("" ::: "memory");
        if (!(args.probe & 1)) for (int i = F.vcu; i < 256; i += F.G)
            for (int k = 0; k < 8; ++k) {
                const int idx = (F.G == 256) ? (i >> 5) * 256 + k * 32 + (i & 31) : i * 8 + k, b = idx >> 9, r = (idx >> 2) & 127, jb = idx & 3; na_item(QN, KN, VT, rpl, YNA, b, r, jb, F.wave, F.lane); }
        if (!(args.probe & 2)) for (int i = F.vcu; i < 256; i += F.G) pool_wg(PP, PWT, YPOOL, F.lds + RING_OFF, i * 128, F.wave, F.lane);
        if (!(args.probe & 4)) { const int pair = F.vcu & 15, xb = pair >> 2, xh = pair & 3, slot = F.vcu >> 4, nslot = F.G >> 4;
          __syncthreads(); xa_fill_lds(KMEM, VTMEM, F.lds + RING_OFF, xb, xh, F.tid); __syncthreads();
          if (slot < nslot) { const int n0 = slot * NWAVES + F.wave, ns = nslot * NWAVES;
              if (n0 < 512) { const int nl = n0 + ((511 - n0) / ns) * ns; XaQ qa, qb;
                  xa_loadq(qa, XQ, (xb * 512 + n0) * 16, xh, F.lane);
                  for (int n = n0; n < 512; n += 2 * ns) {
                      xa_loadq(qb, XQ, (xb * 512 + min(n + ns, nl)) * 16, xh, F.lane);
                      xa_item(qa, F.lds + RING_OFF, YXA, (xb * 512 + n) * 16, xh, F.lane);
                      xa_loadq(qa, XQ, (xb * 512 + min(n + 2 * ns, nl)) * 16, xh, F.lane);
                      if (n + ns < 512) xa_item(qb, F.lds + RING_OFF, YXA, (xb * 512 + n + ns) * 16, xh, F.lane); } } }
          __syncthreads(); }
      }
        if (BOTH(2)) GRID_BAR();
    }

    if (IN(3)) { RELOAD_WS();
      { unsigned char* outp; RELOAD_OUT(outp);
        pg8::Sched1 S; S.so.init(T, D, F.G, (int)blockIdx.x); S.A = (const char*)YNA; S.Bt = (const char*)WbrT; S.tstep = (size_t)256 * 1536 * 2;
        pg8::EpiMergeCat E{GATE, MERGED};
        pg8::gemm_phase<pg8::EpiMergeCat, pg8::Sched1, true, true>(F.lds + RING_OFF, 1536, S, E, F.wave, F.lane); REFRESH_TID();
      }
        if (BOTH(3)) GRID_BAR();
    }

    if (IN(4)) { RELOAD_WS();
      {
        pg8::Sched1 S; S.so.init(T, D, F.G, (int)blockIdx.x); S.A = (const char*)MERGED; S.Bt = (const char*)WoutT; S.tstep = (size_t)256 * 1024 * 2;
        pg8::EpiH E{(const pg8::bf16_t*)(ws + WS_XB), nullptr, HB, ROWSQ, args.probe};
        pg8::gemm_phase<pg8::EpiH, pg8::Sched1, true, true>(F.lds + RING_OFF, 1024, S, E, F.wave, F.lane); REFRESH_TID();
      }
        if (BOTH(4)) GRID_BAR();
    }

    if (IN(5)) { RELOAD_WS();
      {
        pg8::Sched1 S; S.so.init(T, 2048, F.G, (int)blockIdx.x); S.A = (const char*)HB; S.Bt = (const char*)WqT; S.tstep = (size_t)256 * 1024 * 2;
        pg8::EpiQ E{ROWSQ, QB};
        pg8::gemm_phase<pg8::EpiQ, pg8::Sched1, true, true>(F.lds + RING_OFF, 1024, S, E, F.wave, F.lane); REFRESH_TID();
      }
        if (BOTH(5)) GRID_BAR();
    }

    if (IN(6)) { RELOAD_WS();
        LAS int* lscr = (LAS int*)(F.lds + RING_OFF + 65536 + F.wave * 8192);
        for (int tok = 4 * gw; tok < T; tok += 4 * NGW) {
            HqIn hin[4];
#pragma unroll
            for (int r = 0; r < 4; ++r) hq_load(hin[r], HB, ROWSQ, tok + r, F.lane);
#pragma unroll
            for (int r = 0; r < 4; ++r) hq_token(hin[r], ws + WS_HQ, (float*)(ws + WS_HS), tok + r, F.lane); }
        { const int th = F.vcu & 7, slot = F.vcu >> 3, nslot = F.G >> 3;
          __syncthreads(); topk_fill_lds(KEYS, F.lds + RING_OFF, th, F.tid); __syncthreads();
          { { const int n0 = slot * NWAVES + F.wave, ns = nslot * NWAVES; TopkQ qA, qB;
              if (n0 < 2048) {
                  const int nl = n0 + ((2047 - n0) / ns) * ns;
                  topk_loadq(qA, QB, n0 * 16, th, F.lane);
                  for (int n = n0; n < 2048; n += 2 * ns) {
                      topk_loadq(qB, QB, min(n + ns, nl) * 16, th, F.lane);
                      topk_item(qA, F.lds + RING_OFF, TE, TW, lscr, n * 16, th, F.lane);
                      topk_loadq(qA, QB, min(n + 2 * ns, nl) * 16, th, F.lane);
                      if (n + ns < 2048) topk_item(qB, F.lds + RING_OFF, TE, TW, lscr, (n + ns) * 16, th, F.lane); } } } }
          __syncthreads(); }
        if (BOTH(6)) GRID_BAR();
    }

    if (IN(7)) { RELOAD_WS();
        int x0 = 0, nxs = 8, wrank = (int)blockIdx.x * NWAVES + F.wave, wstep = F.G * NWAVES;
        if (N_LAUNCHES != PER_PHASE) { const unsigned xid = F.MISC[12], rk = F.MISC[13]; unsigned nx = 0, below = 0, mine = 0;
            for (unsigned j = 0; j < 16; ++j) { const unsigned c = xb_ld((unsigned*)(F.ctl + CW_BAR) + XB_XCNT(j)); nx += c > 0u; below += (c > 0u && j < xid); mine = (j == xid) ? c : mine; }
            if (nx == 8 && mine > 0 && rk < mine) { x0 = (int)below; nxs = 1; wrank = (int)rk * NWAVES + F.wave; wstep = (int)mine * NWAVES; }
            x0 = __builtin_amdgcn_readfirstlane(x0); nxs = __builtin_amdgcn_readfirstlane(nxs); wrank = __builtin_amdgcn_readfirstlane(wrank); wstep = __builtin_amdgcn_readfirstlane(wstep); }
        else if ((F.G & 7) == 0) { x0 = (int)blockIdx.x & 7; nxs = 1; wrank = ((int)blockIdx.x >> 3) * NWAVES + F.wave; wstep = (F.G >> 3) * NWAVES; }
#ifdef PROBE_HALFWAVES
        if (args.probe) { if (F.wave & 1) nxs = 0; wrank = (wrank - F.wave) / 2 + (F.wave >> 1); wstep /= 2; }
#endif
        for (int xs = 0; xs < nxs; ++xs) {
#ifdef PROBE_BITS
            if (args.probe) peer_a_run<PROBE_BITS>(ws, (unsigned)WS_TE, (unsigned)WS_TW, (unsigned)WS_HQ, (const float*)(ws + WS_HS), U8, SU, (float*)QB, F.lds + RING_OFF + F.wave * 16384, (LAS int*)(F.lds + MISC_OFF + 1024 + F.wave * 128), wrank, wstep, x0 + xs, F.lane); else
#endif
            peer_a_run<0>(ws, (unsigned)WS_TE, (unsigned)WS_TW, (unsigned)WS_HQ, (const float*)(ws + WS_HS), U8, SU, AW, F.lds + RING_OFF + F.wave * 16384, (LAS int*)(F.lds + MISC_OFF + 1024 + F.wave * 128), wrank, wstep, x0 + xs, F.lane); }
        GRID_BAR();
    }
    if (IN(8)) { RELOAD_WS();
        int x0 = 0, nxs = 8, wrank = (int)blockIdx.x * NWAVES + F.wave, wstep = F.G * NWAVES;
        if (N_LAUNCHES != PER_PHASE) { const unsigned xid = F.MISC[12], rk = F.MISC[13]; unsigned nx = 0, below = 0, mine = 0;
            for (unsigned j = 0; j < 16; ++j) { const unsigned c = xb_ld((unsigned*)(F.ctl + CW_BAR) + XB_XCNT(j)); nx += c > 0u; below += (c > 0u && j < xid); mine = (j == xid) ? c : mine; }
            if (nx == 8 && mine > 0 && rk < mine) { x0 = (int)below; nxs = 1; wrank = (int)rk * NWAVES + F.wave; wstep = (int)mine * NWAVES; }
            x0 = __builtin_amdgcn_readfirstlane(x0); nxs = __builtin_amdgcn_readfirstlane(nxs); wrank = __builtin_amdgcn_readfirstlane(wrank); wstep = __builtin_amdgcn_readfirstlane(wstep); }
        else if ((F.G & 7) == 0) { x0 = (int)blockIdx.x & 7; nxs = 1; wrank = ((int)blockIdx.x >> 3) * NWAVES + F.wave; wstep = (F.G >> 3) * NWAVES; }
#ifdef PROBE_HALFWAVES
        if (args.probe) { if (F.wave & 1) nxs = 0; wrank = (wrank - F.wave) / 2 + (F.wave >> 1); wstep /= 2; }
#endif
        for (int xs = 0; xs < nxs; ++xs) {
#ifdef PROBE_BITS
            if (args.probe) peer_b_run<PROBE_BITS>(V8 + (size_t)(x0 + xs) * (2 * MiB), ws, (unsigned)WS_TE, (unsigned)WS_AW, (unsigned)WS_HB, (float*)QB, F.lds + RING_OFF + F.wave * 16384, wrank, wstep, x0 + xs, F.lane); else
#endif
            { unsigned char* outp; RELOAD_OUT(outp); peer_b_run<0>(V8 + (size_t)(x0 + xs) * (2 * MiB), ws, (unsigned)WS_TE, (unsigned)WS_AW, (unsigned)WS_HB, (float*)outp, F.lds + RING_OFF + F.wave * 16384, wrank, wstep, x0 + xs, F.lane); } }
    }
#undef XB
#undef YNA
#undef YPOOL
#undef YXA
#undef RELOAD_OUT
#undef IN
#undef BOTH
#undef GRID_BAR
}

extern "C" void kernel_launch(void* const* d_in, const int* in_sizes, int n_in, void* d_out, int out_size, void* d_ws, size_t ws_size, hipStream_t stream) {
    static int grid = 0;
    if (grid == 0) {
        if (n_in != 23 || in_sizes[0] != T * D || out_size != T * D || ws_size < WS_END) { fprintf(stderr, "kernel_launch: unexpected shapes: n_in %d in0 %d out %d ws %zu\n", n_in, n_in > 0 ? in_sizes[0] : -1, out_size, ws_size); grid = -1; return; }
        int dev = 0, cus = 0, per_cu = 0;
        if (hipGetDevice(&dev) != hipSuccess || hipDeviceGetAttribute(&cus, hipDeviceAttributeMultiprocessorCount, dev) != hipSuccess) { fprintf(stderr, "kernel_launch: device query failed\n"); grid = -1; return; }
        if (hipFuncSetAttribute((const void*)mk_fwd, hipFuncAttributeMaxDynamicSharedMemorySize, LDS_BYTES) != hipSuccess) { fprintf(stderr, "kernel_launch: hipFuncSetAttribute failed\n"); grid = -1; return; }
        if (hipOccupancyMaxActiveBlocksPerMultiprocessor(&per_cu, (const void*)mk_fwd, NWAVES * 64, LDS_BYTES) != hipSuccess || per_cu < 1)
            fprintf(stderr, "kernel_launch: note: occupancy query reports %d workgroups per CU\n", per_cu);
        (void)hipGetLastError();
        grid = cus;
    }
    if (grid < 0) return;
    if (hipMemsetAsync((char*)d_ws + WS_CTL, 0, CTL_ZERO_BYTES, stream) != hipSuccess) { fprintf(stderr, "kernel_launch: memset failed\n"); return; }
    Args a{};
    for (int i = 0; i < 23; ++i) a.in[i] = (const float*)d_in[i];
    a.out = (float*)d_out; a.ws = (unsigned char*)d_ws;
    for (int li = 0; li < N_LAUNCHES; ++li) {
        a.ph_lo = (N_LAUNCHES == PER_PHASE) ? li : 0; a.ph_hi = (N_LAUNCHES == PER_PHASE) ? li + 1 : PER_PHASE;
        hipLaunchKernelGGL(mk_fwd, dim3(grid), dim3(NWAVES * 64), LDS_BYTES, stream, a);
#ifdef HOST_DUP_PHASE
        if (N_LAUNCHES == PER_PHASE && li == HOST_DUP_PHASE) {
#ifndef PROBE_MODE
            if (li == 4) (void)hipMemsetAsync((char*)d_ws + WS_ROWSQ, 0, (size_t)T * 4, stream);
#endif
#ifdef PROBE_MODE
            a.probe = PROBE_MODE;
#endif
            hipLaunchKernelGGL(mk_fwd, dim3(grid), dim3(NWAVES * 64), LDS_BYTES, stream, a); a.probe = 0; }
#endif
        const hipError_t le = hipPeekAtLastError();
        if (le != hipSuccess) { fprintf(stderr, "kernel_launch: launch %d failed: %s\n", li, hipGetErrorName(le)); break; }
    }
}
```
